# Optimizing an MI355X kernel written in HIP

```python
import jax, jax.numpy as jnp
from jax import lax
import numpy as np

D_MODEL = 2048
BATCH = 4
SEQ = 2048
DEPTH = 1

CHUNK = 128
SGU_GROUPS = 8
SGU_GROUP_DIM = D_MODEL // 16
SGU_WIDTH = SGU_GROUPS * SGU_GROUP_DIM
FOX_HEADS = 8
HEAD_DIM = 128
FOX_WIDTH = FOX_HEADS * HEAD_DIM
Q_BLOCK = 128
N_GROUPS = 4
EXPERTS_PER_GROUP = 8
N_EXPERTS = N_GROUPS * EXPERTS_PER_GROUP
TOP_K = 2
D_EXPERT = D_MODEL // 4
EXPERT_BLOCK = 128
EPS = 1e-6

OFF_U = 0
OFF_V = OFF_U + SGU_WIDTH
OFF_Q = OFF_V + SGU_WIDTH
OFF_K = OFF_Q + FOX_WIDTH
OFF_VA = OFF_K + FOX_WIDTH
OFF_F = OFF_VA + FOX_WIDTH
OFF_GATE = OFF_F + FOX_HEADS
IN_COLS = OFF_GATE + 2 * D_MODEL

kernel_name = 'hybrid_sgu_fox_hmoe_block'


def rms_norm(x, g):
    xf = x.astype(jnp.float32)
    y = xf * lax.rsqrt(jnp.mean(xf * xf, axis=-1, keepdims=True) + EPS)
    return (y * g.astype(jnp.float32)).astype(x.dtype)


def layer_norm(x, g, b):
    xf = x.astype(jnp.float32)
    mu = jnp.mean(xf, axis=-1, keepdims=True)
    var = jnp.mean(jnp.square(xf - mu), axis=-1, keepdims=True)
    y = (xf - mu) * lax.rsqrt(var + EPS)
    return (y * g.astype(jnp.float32) + b.astype(jnp.float32)).astype(x.dtype)


def chunked_sgu(u, v, ln_g, ln_b, w_s, b_s):
    B, S, _ = u.shape
    nc = S // CHUNK
    v = layer_norm(v, ln_g, ln_b)
    vg = v.reshape(B, nc, CHUNK, SGU_GROUPS, SGU_GROUP_DIM)
    causal = jnp.tril(jnp.ones((CHUNK, CHUNK), dtype=bool))
    w = jnp.where(causal[None], w_s, jnp.zeros_like(w_s))
    s = jnp.einsum('gts,bcsgd->bctgd', w, vg) + b_s.T[None, None, :, :, None]
    return u * s.reshape(B, S, SGU_WIDTH)


def forgetting_attention(q, k, v, f_logit, q_g, k_g):
    B, S, H, Dh = q.shape
    q = rms_norm(q, q_g)
    k = rms_norm(k, k_g)
    log_f = jax.nn.log_sigmoid(f_logit.astype(jnp.float32))
    c = jnp.cumsum(log_f, axis=1)
    c_k = c.transpose(0, 2, 1)
    nb = S // Q_BLOCK
    qb = q.reshape(B, nb, Q_BLOCK, H, Dh).transpose(1, 0, 2, 3, 4)
    cqb = c.reshape(B, nb, Q_BLOCK, H).transpose(1, 0, 3, 2)
    kpos = jnp.arange(S)
    scale = HEAD_DIM ** -0.5

    def block(args):
        qi, cqi, i = args
        s = jnp.einsum('bqhd,bkhd->bhqk', qi, k).astype(jnp.float32) * scale
        s = s + cqi[..., :, None] - c_k[:, :, None, :]
        qpos = i * Q_BLOCK + jnp.arange(Q_BLOCK)
        s = jnp.where(qpos[:, None] >= kpos[None, :], s, -jnp.inf)
        p = jax.nn.softmax(s, axis=-1)
        return jnp.einsum('bhqk,bkhd->bqhd', p.astype(v.dtype), v)

    o = lax.map(block, (qb, cqb, jnp.arange(nb)))
    return o.transpose(1, 0, 2, 3, 4).reshape(B, S, H * Dh)


def hierarchical_moe(h, w_rg, b_rg, w_re, b_re, w_g, w_u, w_d):
    B, S, D = h.shape
    T = B * S
    xt = h.reshape(T, D)
    g_logits = (xt @ w_rg + b_rg).astype(jnp.float32)
    g_prob = jax.nn.softmax(g_logits, axis=-1)
    grp = jnp.argmax(g_logits, axis=-1)
    p_grp = jnp.take_along_axis(g_prob, grp[:, None], axis=1)
    e_logits = (xt @ w_re + b_re).astype(jnp.float32).reshape(T, N_GROUPS, EXPERTS_PER_GROUP)
    e_logits = jnp.take_along_axis(e_logits, grp[:, None, None], axis=1)[:, 0]
    top_v, top_i = lax.top_k(e_logits, TOP_K)
    w_top = jax.nn.softmax(top_v, axis=-1) * p_grp
    eid = grp[:, None] * EXPERTS_PER_GROUP + top_i
    A = T * TOP_K
    eid_f = eid.reshape(A)
    tok_f = jnp.repeat(jnp.arange(T, dtype=jnp.int32), TOP_K)
    gate_f = w_top.reshape(A)
    order = jnp.argsort(eid_f)
    e_sorted = eid_f[order]
    counts = jnp.bincount(eid_f, length=N_EXPERTS)
    starts = jnp.cumsum(counts) - counts
    padded = ((counts + EXPERT_BLOCK - 1) // EXPERT_BLOCK) * EXPERT_BLOCK
    pad_ends = jnp.cumsum(padded)
    pad_starts = pad_ends - padded
    dest = pad_starts[e_sorted] + (jnp.arange(A) - starts[e_sorted])
    P = A + N_EXPERTS * EXPERT_BLOCK
    NB = P // EXPERT_BLOCK
    buf_tok = jnp.full((P,), T, dtype=jnp.int32).at[dest].set(tok_f[order])
    buf_gate = jnp.zeros((P,), jnp.float32).at[dest].set(gate_f[order])
    blk_e = jnp.minimum(jnp.searchsorted(pad_ends, jnp.arange(NB) * EXPERT_BLOCK, side='right'), N_EXPERTS - 1)
    x_pad = jnp.concatenate([xt, jnp.zeros((1, D), xt.dtype)], axis=0)
    xb = x_pad[buf_tok].reshape(NB, EXPERT_BLOCK, D)

    def expert_block(args):
        xi, e = args
        return (jax.nn.silu(xi @ w_g[e]) * (xi @ w_u[e])) @ w_d[e]

    yb = lax.map(expert_block, (xb, blk_e)).reshape(P, D)
    y = jnp.zeros((T + 1, D), jnp.float32).at[buf_tok].add(yb.astype(jnp.float32) * buf_gate[:, None])[:T]
    return y.astype(h.dtype).reshape(B, S, D)


def setup_inputs(seed: int = 0) -> dict:
    key = jax.random.key(seed)
    ks = jax.random.split(key, 24)
    f32 = jnp.float32
    nrm = lambda k, shape, s: jax.random.normal(k, shape, f32) * s
    L = DEPTH
    return {
        'x': jax.random.normal(ks[0], (BATCH, SEQ, D_MODEL), f32),
        'norm1_g': 1.0 + nrm(ks[1], (L, D_MODEL), 0.05),
        'w_in': nrm(ks[2], (L, D_MODEL, IN_COLS), D_MODEL ** -0.5),
        'b_gate': nrm(ks[3], (L, 2 * D_MODEL), 0.1),
        'b_forget': 2.0 + nrm(ks[4], (L, FOX_HEADS), 0.5),
        'sgu_ln_g': 1.0 + nrm(ks[5], (L, SGU_WIDTH), 0.05),
        'sgu_ln_b': nrm(ks[6], (L, SGU_WIDTH), 0.05),
        'w_spatial': nrm(ks[7], (L, SGU_GROUPS, CHUNK, CHUNK), CHUNK ** -0.5),
        'b_spatial': 1.0 + nrm(ks[8], (L, SGU_GROUPS, CHUNK), 0.1),
        'q_norm_g': 1.0 + nrm(ks[9], (L, HEAD_DIM), 0.05),
        'k_norm_g': 1.0 + nrm(ks[10], (L, HEAD_DIM), 0.05),
        'w_proj_sgu': nrm(ks[11], (L, SGU_WIDTH, D_MODEL), SGU_WIDTH ** -0.5),
        'w_proj_fox': nrm(ks[12], (L, FOX_WIDTH, D_MODEL), FOX_WIDTH ** -0.5),
        'w_out': nrm(ks[13], (L, D_MODEL, D_MODEL), D_MODEL ** -0.5),
        'norm2_g': 1.0 + nrm(ks[14], (L, D_MODEL), 0.05),
        'w_router_group': nrm(ks[15], (L, D_MODEL, N_GROUPS), D_MODEL ** -0.5),
        'b_router_group': nrm(ks[16], (L, N_GROUPS), 0.01),
        'w_router_expert': nrm(ks[17], (L, D_MODEL, N_EXPERTS), D_MODEL ** -0.5),
        'b_router_expert': nrm(ks[18], (L, N_EXPERTS), 0.01),
        'w_expert_gate': nrm(ks[19], (L, N_EXPERTS, D_MODEL, D_EXPERT), D_MODEL ** -0.5),
        'w_expert_up': nrm(ks[20], (L, N_EXPERTS, D_MODEL, D_EXPERT), D_MODEL ** -0.5),
        'w_expert_down': nrm(ks[21], (L, N_EXPERTS, D_EXPERT, D_MODEL), D_EXPERT ** -0.5),
    }


def reference(x, norm1_g, w_in, b_gate, b_forget, sgu_ln_g, sgu_ln_b, w_spatial, b_spatial,
              q_norm_g, k_norm_g, w_proj_sgu, w_proj_fox, w_out, norm2_g,
              w_router_group, b_router_group, w_router_expert, b_router_expert,
              w_expert_gate, w_expert_up, w_expert_down):
    B, S, D = x.shape
    for l in range(DEPTH):
        h = rms_norm(x, norm1_g[l])
        z = h @ w_in[l]
        u = jax.nn.gelu(z[..., OFF_U:OFF_V])
        v = jax.nn.gelu(z[..., OFF_V:OFF_Q])
        q = z[..., OFF_Q:OFF_K].reshape(B, S, FOX_HEADS, HEAD_DIM)
        k = z[..., OFF_K:OFF_VA].reshape(B, S, FOX_HEADS, HEAD_DIM)
        va = z[..., OFF_VA:OFF_F].reshape(B, S, FOX_HEADS, HEAD_DIM)
        f_logit = z[..., OFF_F:OFF_GATE] + b_forget[l]
        gates = jax.nn.sigmoid(z[..., OFF_GATE:] + b_gate[l])
        g_sgu = gates[..., :D]
        g_fox = gates[..., D:]
        y_sgu = chunked_sgu(u, v, sgu_ln_g[l], sgu_ln_b[l], w_spatial[l], b_spatial[l]) @ w_proj_sgu[l]
        y_fox = forgetting_attention(q, k, va, f_logit, q_norm_g[l], k_norm_g[l]) @ w_proj_fox[l]
        x = x + (g_sgu * y_sgu + g_fox * y_fox) @ w_out[l]
        h2 = rms_norm(x, norm2_g[l])
        x = x + hierarchical_moe(h2, w_router_group[l], b_router_group[l], w_router_expert[l],
                                 b_router_expert[l], w_expert_gate[l], w_expert_up[l], w_expert_down[l])
    return x
```

```cpp
#include <hip/hip_runtime.h>
#include <hip/hip_cooperative_groups.h>
#include <cstdio>
#include <cstdint>
namespace cg = cooperative_groups;

constexpr int T = 8192, SEQ = 2048, NB = 4, DM = 2048, SGUW = 1024, FOXW = 1024, NH = 8, HD = 128, CHUNK = 128, NG = 8;
constexpr int INCOLS = 9224, OFF_F = 5120, OFF_GATE = 5128;
constexpr int NEXP = 32, EPG = 8, NGRP = 4, DEXP = 512;
constexpr float EPS = 1e-6f;
constexpr float LOG2E = 1.4426950408889634f;
constexpr float QSCALE = 0.08838834764831845f * LOG2E;
constexpr int NTHREADS = 512, NWAVES = 8;
constexpr int LDS_BYTES = 160 * 1024;
constexpr int MTILE = 256;
constexpr int PMAX = 2 * T + NEXP * MTILE;

typedef unsigned short bf16_t;
typedef float f32x4 __attribute__((ext_vector_type(4)));
typedef unsigned u32x4 __attribute__((ext_vector_type(4)));
typedef unsigned u32x2 __attribute__((ext_vector_type(2)));

constexpr size_t MiB = 1u << 20;
constexpr size_t WS_CTL = 0;
constexpr size_t WS_LOGF = 1 * MiB;
constexpr size_t WS_CKL = 2 * MiB;
constexpr size_t WS_TOK = 3 * MiB;
constexpr size_t WS_GATE = 4 * MiB;
constexpr size_t WS_ASG = 5 * MiB;
constexpr size_t WS_WIN = 8 * MiB;
constexpr size_t WS_WPROJ = 44 * MiB;
constexpr size_t WS_WOUT = 52 * MiB;
constexpr size_t WS_WGU = 60 * MiB;
constexpr size_t WS_WD = 188 * MiB;
constexpr size_t WS_H = 252 * MiB;
constexpr size_t WS_MIXED = WS_H;
constexpr size_t WS_U = 284 * MiB;
constexpr size_t WS_V = 300 * MiB;
constexpr size_t WS_G = 316 * MiB;
constexpr size_t WS_YBUF = WS_U;
constexpr size_t WS_Q = 380 * MiB;
constexpr size_t WS_K = 396 * MiB;
constexpr size_t WS_VA = 412 * MiB;
constexpr size_t WS_ACT = WS_Q;
constexpr size_t WS_MIXIN = 428 * MiB;
constexpr size_t WS_H2 = WS_MIXIN;
constexpr size_t WS_END = 460 * MiB;
static_assert((size_t)PMAX * 2048 * 2 <= 96 * MiB && (size_t)PMAX * 512 * 2 <= 32 * MiB, "overlay sizes");

constexpr int CW_CNT = 0;

__device__ __forceinline__ float bf2f(bf16_t v) { return __uint_as_float((unsigned)v << 16); }
__device__ __forceinline__ bf16_t f2bf(float f) { unsigned u = __float_as_uint(f); return (bf16_t)((u + 0x7fffu + ((u >> 16) & 1u)) >> 16); }
__device__ __forceinline__ unsigned pk2(float lo, float hi) { return (unsigned)f2bf(lo) | ((unsigned)f2bf(hi) << 16); }
__device__ __forceinline__ float wave_sum(float v) {
#pragma unroll
    for (int o = 1; o < 64; o <<= 1) v += __shfl_xor(v, o);
    return v;
}
__device__ __forceinline__ float wave_max(float v) {
#pragma unroll
    for (int o = 1; o < 64; o <<= 1) v = fmaxf(v, __shfl_xor(v, o));
    return v;
}
__device__ __forceinline__ float gelu_tanh(float x) {
    const float c = 0.7978845608028654f; const float y = c * (x + 0.044715f * x * x * x);
    return x / (1.0f + __expf(-2.0f * y));
}
__device__ __forceinline__ float sigmoidf_(float x) { return 1.0f / (1.0f + __expf(-x)); }
__device__ __forceinline__ float log_sigmoid(float z) { return fminf(z, 0.f) - log1pf(__expf(-fabsf(z))); }

struct Args {
    const float* in[22];
    float* out;
    unsigned char* ws;
    int ph_lo, ph_hi;
};

template <class AF, class BF, class EF>
__device__ __forceinline__ void naive_gemm_tile(float* lds, int m0, int n0, int M, int N, int K, int Ksplit, AF a, BF b, EF epi) {
    float* As = lds;
    float* Bs = lds + 16 * 132;
    const int tid = threadIdx.x, ty = tid >> 4, tx = tid & 15;
    float acc[4][8], acc1[4][8];
#pragma unroll
    for (int i = 0; i < 4; ++i)
#pragma unroll
        for (int j = 0; j < 8; ++j) { acc[i][j] = 0.f; acc1[i][j] = 0.f; }
    const bool split = Ksplit < K;
#pragma unroll 1
    for (int pass = 0; pass < 2; ++pass) {
        const int kb = pass == 0 ? 0 : Ksplit, ke = pass == 0 ? (split ? Ksplit : K) : K;
        if (pass == 1) {
            if (!split) break;
#pragma unroll
            for (int i = 0; i < 4; ++i)
#pragma unroll
                for (int j = 0; j < 8; ++j) { acc1[i][j] = acc[i][j]; acc[i][j] = 0.f; }
        }
#pragma unroll 1
        for (int k0 = kb; k0 < ke; k0 += 16) {
#pragma unroll
            for (int i = 0; i < 4; ++i) { const int idx = tid + i * 512, r = idx >> 4, kk = idx & 15; const int m = m0 + r; As[kk * 132 + r] = (m < M) ? a(m, k0 + kk) : 0.f; }
#pragma unroll
            for (int i = 0; i < 4; ++i) { const int idx = tid + i * 512, kk = idx >> 7, n = idx & 127; Bs[kk * 132 + n] = (n0 + n < N) ? b(k0 + kk, n0 + n) : 0.f; }
            __syncthreads();
#pragma unroll 4
            for (int kk = 0; kk < 16; ++kk) {
                float av[4], bv[8];
#pragma unroll
                for (int i = 0; i < 4; ++i) av[i] = As[kk * 132 + ty * 4 + i];
#pragma unroll
                for (int j = 0; j < 8; ++j) bv[j] = Bs[kk * 132 + tx * 8 + j];
#pragma unroll
                for (int i = 0; i < 4; ++i)
#pragma unroll
                    for (int j = 0; j < 8; ++j) acc[i][j] = fmaf(av[i], bv[j], acc[i][j]);
            }
            __syncthreads();
        }
    }
#pragma unroll
    for (int i = 0; i < 4; ++i)
#pragma unroll
        for (int j = 0; j < 8; ++j) { const int m = m0 + ty * 4 + i, n = n0 + tx * 8 + j; if (m < M && n < N) epi(m, n, split ? acc1[i][j] : acc[i][j], split ? acc[i][j] : 0.f); }
}
template <class AF, class BF, class EF>
__device__ __forceinline__ void naive_gemm(float* lds, int M, int N, int K, int Ksplit, AF a, BF b, EF epi) {
    const int ntm = (M + 127) / 128, ntn = (N + 127) / 128;
    for (int t = blockIdx.x; t < ntm * ntn; t += gridDim.x) naive_gemm_tile(lds, (t / ntn) * 128, (t % ntn) * 128, M, N, K, Ksplit, a, b, epi);
}

__device__ __forceinline__ void p0_rows(const Args& A, float* ldsf) {
    const float* x = A.in[0]; const float* g1 = A.in[1]; const float* w_in = A.in[2]; const float* b_forget = A.in[4];
    bf16_t* H = (bf16_t*)(A.ws + WS_H); float* LOGF = (float*)(A.ws + WS_LOGF);
    const int tid = threadIdx.x, lane = tid & 63, wave = tid >> 6;
    for (int i = tid; i < DM * 8; i += NTHREADS) ldsf[i] = w_in[(size_t)(i >> 3) * INCOLS + OFF_F + (i & 7)];
    __syncthreads();
    const int gw = blockIdx.x * NWAVES + wave, NGW = gridDim.x * NWAVES;
    for (int row = gw; row < T; row += NGW) {
        const f32x4* xr = (const f32x4*)(x + (size_t)row * DM) + lane;
        float ss = 0.f;
#pragma unroll
        for (int j = 0; j < 8; ++j) { const f32x4 v = xr[64 * j]; ss += v.x * v.x + v.y * v.y + v.z * v.z + v.w * v.w; }
        const float rstd = rsqrtf(wave_sum(ss) * (1.f / DM) + EPS);
        float f[8];
#pragma unroll
        for (int h = 0; h < 8; ++h) f[h] = 0.f;
#pragma unroll 1
        for (int j = 0; j < 8; ++j) {
            const int c0 = 256 * j + 4 * lane; const f32x4 g = *(const f32x4*)(g1 + c0); const f32x4 xv = xr[64 * j];
            f32x4 hv; hv.x = xv.x * rstd * g.x; hv.y = xv.y * rstd * g.y; hv.z = xv.z * rstd * g.z; hv.w = xv.w * rstd * g.w;
            u32x2 o; o.x = pk2(hv.x, hv.y); o.y = pk2(hv.z, hv.w);
            *(u32x2*)(H + (size_t)row * DM + c0) = o;
#pragma unroll
            for (int e = 0; e < 4; ++e) { const float hx = hv[e]; const float* wf = ldsf + (c0 + e) * 8;
#pragma unroll
                for (int h = 0; h < 8; ++h) f[h] = fmaf(hx, wf[h], f[h]); }
        }
#pragma unroll
        for (int h = 0; h < 8; ++h) f[h] = wave_sum(f[h]);
        if (lane < 8) { float z = 0.f;
#pragma unroll
            for (int h = 0; h < 8; ++h) if (lane == h) z = f[h];
            LOGF[(size_t)row * 8 + lane] = log_sigmoid(z + b_forget[lane]); }
    }
    if (blockIdx.x == 0 && tid < 64) ((unsigned*)(A.ws + WS_CTL))[tid] = 0u;
}

__device__ __forceinline__ void p1_naive(const Args& A, float* ldsf) {
    const bf16_t* H = (const bf16_t*)(A.ws + WS_H); const float* w_in = A.in[2]; const float* b_gate = A.in[3];
    bf16_t* U = (bf16_t*)(A.ws + WS_U); bf16_t* V = (bf16_t*)(A.ws + WS_V); bf16_t* Q = (bf16_t*)(A.ws + WS_Q); bf16_t* K = (bf16_t*)(A.ws + WS_K);
    bf16_t* VA = (bf16_t*)(A.ws + WS_VA); bf16_t* G = (bf16_t*)(A.ws + WS_G);
    naive_gemm(ldsf, T, 9216, DM, DM,
        [=](int m, int k) { return bf2f(H[(size_t)m * DM + k]); },
        [=](int k, int n) { const int c = n < 5120 ? n : n + 8; return w_in[(size_t)k * INCOLS + c]; },
        [=](int m, int n, float s, float) {
            if (n < 1024) U[(size_t)m * 1024 + n] = f2bf(gelu_tanh(s));
            else if (n < 2048) V[(size_t)m * 1024 + n - 1024] = f2bf(gelu_tanh(s));
            else if (n < 3072) Q[(size_t)m * 1024 + n - 2048] = f2bf(s);
            else if (n < 4096) K[(size_t)m * 1024 + n - 3072] = f2bf(s);
            else if (n < 5120) VA[(size_t)m * 1024 + n - 4096] = f2bf(s);
            else G[(size_t)m * 4096 + n - 5120] = f2bf(sigmoidf_(s + b_gate[n - 5120]));
        });
}

__device__ __forceinline__ void p1b_fix(const Args& A, float* ldsf) {
    bf16_t* V = (bf16_t*)(A.ws + WS_V); bf16_t* Q = (bf16_t*)(A.ws + WS_Q); bf16_t* K = (bf16_t*)(A.ws + WS_K);
    const float* ln_g = A.in[5]; const float* ln_b = A.in[6]; const float* qg = A.in[9]; const float* kg = A.in[10];
    const int tid = threadIdx.x, lane = tid & 63, wave = tid >> 6;
    const int gw = blockIdx.x * NWAVES + wave, NGW = gridDim.x * NWAVES;
    for (int row = gw; row < T; row += NGW) {
        {
            bf16_t* vr = V + (size_t)row * 1024; float v[16]; float s = 0.f;
#pragma unroll
            for (int j = 0; j < 2; ++j) { const u32x4 w = *(const u32x4*)(vr + 512 * j + 8 * lane);
#pragma unroll
                for (int e = 0; e < 4; ++e) { v[8 * j + 2 * e] = __uint_as_float(w[e] << 16); v[8 * j + 2 * e + 1] = __uint_as_float(w[e] & 0xffff0000u); } }
#pragma unroll
            for (int i = 0; i < 16; ++i) s += v[i];
            const float mean = wave_sum(s) * (1.f / 1024.f); float q = 0.f;
#pragma unroll
            for (int i = 0; i < 16; ++i) { v[i] -= mean; q += v[i] * v[i]; }
            const float rstd = rsqrtf(wave_sum(q) * (1.f / 1024.f) + EPS);
#pragma unroll
            for (int j = 0; j < 2; ++j) { const int c0 = 512 * j + 8 * lane; u32x4 o;
#pragma unroll
                for (int e = 0; e < 4; ++e) o[e] = pk2(v[8 * j + 2 * e] * rstd * ln_g[c0 + 2 * e] + ln_b[c0 + 2 * e], v[8 * j + 2 * e + 1] * rstd * ln_g[c0 + 2 * e + 1] + ln_b[c0 + 2 * e + 1]);
                *(u32x4*)(vr + c0) = o; }
        }
#pragma unroll
        for (int which = 0; which < 2; ++which) {
            bf16_t* pr = (which == 0 ? Q : K) + (size_t)row * 1024 + 16 * lane; const float* gg = which == 0 ? qg : kg; float v[16]; float s = 0.f;
#pragma unroll
            for (int j = 0; j < 2; ++j) { const u32x4 w = *(const u32x4*)(pr + 8 * j);
#pragma unroll
                for (int e = 0; e < 4; ++e) { v[8 * j + 2 * e] = __uint_as_float(w[e] << 16); v[8 * j + 2 * e + 1] = __uint_as_float(w[e] & 0xffff0000u); } }
#pragma unroll
            for (int i = 0; i < 16; ++i) s += v[i] * v[i];
            s += __shfl_xor(s, 1); s += __shfl_xor(s, 2); s += __shfl_xor(s, 4);
            const float sc = rsqrtf(s * (1.f / 128.f) + EPS) * (which == 0 ? QSCALE : 1.f); const int d0 = (16 * lane) & 127;
#pragma unroll
            for (int j = 0; j < 2; ++j) { u32x4 o;
#pragma unroll
                for (int e = 0; e < 4; ++e) o[e] = pk2(v[8 * j + 2 * e] * sc * gg[d0 + 8 * j + 2 * e], v[8 * j + 2 * e + 1] * sc * gg[d0 + 8 * j + 2 * e + 1]);
                *(u32x4*)(pr + 8 * j) = o; }
        }
    }
    if (blockIdx.x < NB * NH) {
        const int b = blockIdx.x / NH, h = blockIdx.x % NH; const float* LOGF = (const float*)(A.ws + WS_LOGF); float* CKL = (float*)(A.ws + WS_CKL) + (size_t)blockIdx.x * SEQ;
        float v[4]; float s = 0.f;
#pragma unroll
        for (int i = 0; i < 4; ++i) { v[i] = LOGF[(size_t)(b * SEQ + tid * 4 + i) * 8 + h]; s += v[i]; }
        float incl = s;
#pragma unroll
        for (int o = 1; o < 64; o <<= 1) { const float t = __shfl_up(incl, o); if (lane >= o) incl += t; }
        __syncthreads();
        if (lane == 63) ldsf[wave] = incl;
        __syncthreads();
        float base = 0.f;
        for (int w = 0; w < wave; ++w) base += ldsf[w];
        float run = base + incl - s;
#pragma unroll
        for (int i = 0; i < 4; ++i) { run += v[i]; CKL[tid * 4 + i] = run * LOG2E; }
        __syncthreads();
    }
}

__device__ __forceinline__ void p2_sgu_naive(const Args& A) {
    const bf16_t* U = (const bf16_t*)(A.ws + WS_U); const bf16_t* V = (const bf16_t*)(A.ws + WS_V); bf16_t* MIXIN = (bf16_t*)(A.ws + WS_MIXIN);
    const float* wsp = A.in[7]; const float* bsp = A.in[8];
    const int tid = threadIdx.x, tt = tid >> 2, dp = tid & 3;
    for (int u = blockIdx.x; u < (T / CHUNK) * NG; u += gridDim.x) {
        const int rc = u / NG, g = u % NG; const int row0 = rc * CHUNK;
        float acc[32];
#pragma unroll
        for (int i = 0; i < 32; ++i) acc[i] = 0.f;
        for (int ss = 0; ss <= tt; ++ss) {
            const float w = wsp[((size_t)g * CHUNK + tt) * CHUNK + ss];
            const bf16_t* vr = V + (size_t)(row0 + ss) * 1024 + g * 128 + dp * 32;
#pragma unroll
            for (int i = 0; i < 32; ++i) acc[i] = fmaf(w, bf2f(vr[i]), acc[i]);
        }
        const float bb = bsp[g * CHUNK + tt];
        const bf16_t* ur = U + (size_t)(row0 + tt) * 1024 + g * 128 + dp * 32; bf16_t* orow = MIXIN + (size_t)(row0 + tt) * 2048 + g * 128 + dp * 32;
#pragma unroll
        for (int i = 0; i < 32; ++i) orow[i] = f2bf(bf2f(ur[i]) * (acc[i] + bb));
    }
}
__device__ __forceinline__ void p2_attn_naive(const Args& A, float* ldsf) {
    const bf16_t* Q = (const bf16_t*)(A.ws + WS_Q); const bf16_t* K = (const bf16_t*)(A.ws + WS_K); const bf16_t* VA = (const bf16_t*)(A.ws + WS_VA);
    const float* CKL = (const float*)(A.ws + WS_CKL); bf16_t* MIXIN = (bf16_t*)(A.ws + WS_MIXIN);
    const int tid = threadIdx.x, lane = tid & 63, wave = tid >> 6;
    float* qs = ldsf + wave * 128;
    const int gw = blockIdx.x * NWAVES + wave, NGW = gridDim.x * NWAVES;
    for (int item = gw; item < T * NH; item += NGW) {
        const int row = item / NH, h = item % NH, b = row / SEQ, t = row % SEQ;
        const bf16_t* qr = Q + (size_t)row * 1024 + h * 128;
        qs[lane] = bf2f(qr[lane]); qs[64 + lane] = bf2f(qr[64 + lane]);
        __builtin_amdgcn_s_waitcnt(0);
        const float* ck = CKL + (size_t)(b * NH + h) * SEQ;
        float m = -1e30f, l = 0.f, o0 = 0.f, o1 = 0.f;
        for (int s0 = 0; s0 <= t; s0 += 64) {
            const int s = s0 + lane; float sc = -INFINITY;
            if (s <= t) { const bf16_t* kr = K + (size_t)(b * SEQ + s) * 1024 + h * 128; float d = 0.f;
                for (int c = 0; c < 16; ++c) { const u32x4 w = *(const u32x4*)(kr + 8 * c);
#pragma unroll
                    for (int e = 0; e < 4; ++e) { d = fmaf(qs[8 * c + 2 * e], __uint_as_float(w[e] << 16), d); d = fmaf(qs[8 * c + 2 * e + 1], __uint_as_float(w[e] & 0xffff0000u), d); } }
                sc = d - ck[s]; }
            const float mn = fmaxf(m, wave_max(sc)); const float alpha = exp2f(m - mn); const float p = exp2f(sc - mn);
            l = l * alpha + wave_sum(p); o0 *= alpha; o1 *= alpha; m = mn;
            const int nk = min(64, t - s0 + 1);
            for (int j = 0; j < nk; ++j) { const float pj = __shfl(p, j); const unsigned w = *(const unsigned*)(VA + (size_t)(b * SEQ + s0 + j) * 1024 + h * 128 + 2 * lane);
                o0 = fmaf(pj, __uint_as_float(w << 16), o0); o1 = fmaf(pj, __uint_as_float(w & 0xffff0000u), o1); }
        }
        const float il = 1.f / l;
        *(unsigned*)(MIXIN + (size_t)row * 2048 + 1024 + h * 128 + 2 * lane) = pk2(o0 * il, o1 * il);
    }
}

__device__ __forceinline__ void p3_naive(const Args& A, float* ldsf) {
    const bf16_t* MIXIN = (const bf16_t*)(A.ws + WS_MIXIN); const bf16_t* G = (const bf16_t*)(A.ws + WS_G); bf16_t* MIXED = (bf16_t*)(A.ws + WS_MIXED);
    const float* wps = A.in[11]; const float* wpf = A.in[12];
    naive_gemm(ldsf, T, DM, 2048, 1024,
        [=](int m, int k) { return bf2f(MIXIN[(size_t)m * 2048 + k]); },
        [=](int k, int n) { return k < 1024 ? wps[(size_t)k * DM + n] : wpf[(size_t)(k - 1024) * DM + n]; },
        [=](int m, int n, float s1, float s2) { MIXED[(size_t)m * DM + n] = f2bf(bf2f(G[(size_t)m * 4096 + n]) * s1 + bf2f(G[(size_t)m * 4096 + 2048 + n]) * s2); });
}
__device__ __forceinline__ void p4_naive(const Args& A, float* ldsf) {
    const bf16_t* MIXED = (const bf16_t*)(A.ws + WS_MIXED); const float* wo = A.in[13]; const float* x = A.in[0]; float* X1 = A.out;
    naive_gemm(ldsf, T, DM, DM, DM,
        [=](int m, int k) { return bf2f(MIXED[(size_t)m * DM + k]); },
        [=](int k, int n) { return wo[(size_t)k * DM + n]; },
        [=](int m, int n, float s, float) { X1[(size_t)m * DM + n] = x[(size_t)m * DM + n] + s; });
}

__device__ __forceinline__ void p5_router(const Args& A, float* ldsf) {
    const float* X1 = A.out; const float* g2 = A.in[14]; const float* wrg = A.in[15]; const float* brg = A.in[16]; const float* wre = A.in[17]; const float* bre = A.in[18];
    bf16_t* H2 = (bf16_t*)(A.ws + WS_H2); unsigned* cnt = (unsigned*)(A.ws + WS_CTL) + CW_CNT;
    int* TOK = (int*)(A.ws + WS_TOK); float* GATE = (float*)(A.ws + WS_GATE); int* ASG = (int*)(A.ws + WS_ASG);
    const int tid = threadIdx.x, lane = tid & 63, wave = tid >> 6, r = tid >> 4, ks = tid & 15;
    float* Ws = ldsf;
    float* Xs = ldsf + 256 * 36;
    float* rs = Xs + 32 * 260;
    int* hist = (int*)(rs + 32);
    int* hbase = hist + 32;
    int* sel = hbase + 32;
    int* lpos = sel + 64;
    float* selw = (float*)(lpos + 64);
    for (int rb = blockIdx.x; rb < T / 32; rb += gridDim.x) {
        const int row0 = rb * 32;
        for (int i = 0; i < 4; ++i) { const int rr = wave * 4 + i; const f32x4* xr = (const f32x4*)(X1 + (size_t)(row0 + rr) * DM) + lane; float ss = 0.f;
#pragma unroll
            for (int j = 0; j < 8; ++j) { const f32x4 v = xr[64 * j]; ss += v.x * v.x + v.y * v.y + v.z * v.z + v.w * v.w; }
            ss = wave_sum(ss); if (lane == 0) rs[rr] = rsqrtf(ss * (1.f / DM) + EPS); }
        if (tid < 32) hist[tid] = 0;
        __syncthreads();
        float acc[36];
#pragma unroll
        for (int j = 0; j < 36; ++j) acc[j] = 0.f;
        for (int k0 = 0; k0 < DM; k0 += 256) {
            for (int i = tid; i < 256 * 36; i += NTHREADS) { const int kk = i / 36, j = i % 36; Ws[i] = j < 4 ? wrg[(size_t)(k0 + kk) * 4 + j] : wre[(size_t)(k0 + kk) * 32 + j - 4]; }
            for (int i = tid; i < 32 * 256; i += NTHREADS) { const int rr = i >> 8, kk = i & 255; const float hv = X1[(size_t)(row0 + rr) * DM + k0 + kk] * rs[rr] * g2[k0 + kk];
                Xs[rr * 260 + kk] = hv; H2[(size_t)(row0 + rr) * DM + k0 + kk] = f2bf(hv); }
            __syncthreads();
            for (int kk = ks; kk < 256; kk += 16) { const float xv = Xs[r * 260 + kk]; const float* wr = Ws + kk * 36;
#pragma unroll
                for (int j = 0; j < 36; ++j) acc[j] = fmaf(xv, wr[j], acc[j]); }
            __syncthreads();
        }
#pragma unroll
        for (int j = 0; j < 36; ++j) { float v = acc[j]; v += __shfl_xor(v, 1); v += __shfl_xor(v, 2); v += __shfl_xor(v, 4); v += __shfl_xor(v, 8); acc[j] = v; }
        if (ks == 0) {
            float gl[4]; int grp = 0; float gm;
#pragma unroll
            for (int j = 0; j < 4; ++j) gl[j] = acc[j] + brg[j];
            gm = gl[0];
#pragma unroll
            for (int j = 1; j < 4; ++j) if (gl[j] > gm) { gm = gl[j]; grp = j; }
            float den = 0.f;
#pragma unroll
            for (int j = 0; j < 4; ++j) den += __expf(gl[j] - gm);
            const float pg = 1.f / den;
            float el[8];
#pragma unroll
            for (int j = 0; j < 8; ++j) { float v = 0.f;
#pragma unroll
                for (int g = 0; g < 4; ++g) if (g == grp) v = acc[4 + g * 8 + j] + bre[g * 8 + j];
                el[j] = v; }
            int i0 = 0; float v0 = el[0];
#pragma unroll
            for (int j = 1; j < 8; ++j) if (el[j] > v0) { v0 = el[j]; i0 = j; }
            int i1 = -1; float v1 = -INFINITY;
#pragma unroll
            for (int j = 0; j < 8; ++j) if (j != i0 && el[j] > v1) { v1 = el[j]; i1 = j; }
            const float e1 = __expf(v1 - v0); const float w0 = pg / (1.f + e1), w1 = pg * e1 / (1.f + e1);
            const int ea = grp * 8 + i0, eb = grp * 8 + i1;
            sel[r * 2] = ea; sel[r * 2 + 1] = eb; selw[r * 2] = w0; selw[r * 2 + 1] = w1;
            lpos[r * 2] = atomicAdd(&hist[ea], 1); lpos[r * 2 + 1] = atomicAdd(&hist[eb], 1);
        }
        __syncthreads();
        if (tid < 32) hbase[tid] = hist[tid] > 0 ? (int)atomicAdd(&cnt[tid], (unsigned)hist[tid]) : 0;
        __syncthreads();
        if (tid < 64) { const int e = sel[tid], pos = hbase[e] + lpos[tid]; const int tok = row0 + (tid >> 1);
            TOK[(size_t)e * T + pos] = tok; GATE[(size_t)e * T + pos] = selw[tid]; ASG[tok * 2 + (tid & 1)] = (e << 16) | pos; }
        __syncthreads();
    }
}

__device__ __forceinline__ void expert_layout(const unsigned* cnt, int* pstart  ) {
    int acc = 0;
    for (int e = 0; e < NEXP; ++e) { pstart[e] = acc; acc += ((int)cnt[e] + MTILE - 1) / MTILE * MTILE; }
    pstart[NEXP] = acc;
}

__device__ __forceinline__ void p6_naive(const Args& A, float* ldsf) {
    const bf16_t* H2 = (const bf16_t*)(A.ws + WS_H2); const float* wg = A.in[19]; const float* wu = A.in[20]; bf16_t* ACT = (bf16_t*)(A.ws + WS_ACT);
    const unsigned* cnt = (const unsigned*)(A.ws + WS_CTL) + CW_CNT; const int* TOK = (const int*)(A.ws + WS_TOK);
    int* ps = (int*)(ldsf + 2 * 16 * 132);
    if (threadIdx.x == 0) expert_layout(cnt, ps);
    __syncthreads();
    int ntot = 0;
    for (int e = 0; e < NEXP; ++e) ntot += (((int)cnt[e] + 127) / 128) * 4;
    for (int t = blockIdx.x; t < ntot; t += gridDim.x) {
        int e = 0, rem = t;
        for (; e < NEXP; ++e) { const int n = (((int)cnt[e] + 127) / 128) * 4; if (rem < n) break; rem -= n; }
        const int c = (int)cnt[e]; const int tm = rem / 4, tn = rem % 4; const int* tl = TOK + (size_t)e * T; const int prow = ps[e];
        const float* wge = wg + (size_t)e * DM * DEXP; const float* wue = wu + (size_t)e * DM * DEXP;
        naive_gemm_tile(ldsf, tm * 128, tn * 128, c, DEXP, 2 * DM, DM,
            [=](int m, int k) { return bf2f(H2[(size_t)tl[m] * DM + (k & (DM - 1))]); },
            [=](int k, int n) { return k < DM ? wge[(size_t)k * DEXP + n] : wue[(size_t)(k - DM) * DEXP + n]; },
            [=](int m, int n, float sg, float su) { ACT[(size_t)(prow + m) * DEXP + n] = f2bf(sg / (1.f + __expf(-sg)) * su); });
    }
}
__device__ __forceinline__ void p7_naive(const Args& A, float* ldsf) {
    const bf16_t* ACT = (const bf16_t*)(A.ws + WS_ACT); const float* wd = A.in[21]; bf16_t* YBUF = (bf16_t*)(A.ws + WS_YBUF);
    const unsigned* cnt = (const unsigned*)(A.ws + WS_CTL) + CW_CNT; const float* GATE = (const float*)(A.ws + WS_GATE);
    int* ps = (int*)(ldsf + 2 * 16 * 132);
    if (threadIdx.x == 0) expert_layout(cnt, ps);
    __syncthreads();
    int ntot = 0;
    for (int e = 0; e < NEXP; ++e) ntot += (((int)cnt[e] + 127) / 128) * 16;
    for (int t = blockIdx.x; t < ntot; t += gridDim.x) {
        int e = 0, rem = t;
        for (; e < NEXP; ++e) { const int n = (((int)cnt[e] + 127) / 128) * 16; if (rem < n) break; rem -= n; }
        const int c = (int)cnt[e]; const int tm = rem / 16, tn = rem % 16; const float* gl = GATE + (size_t)e * T; const int prow = ps[e];
        const float* wde = wd + (size_t)e * DEXP * DM;
        naive_gemm_tile(ldsf, tm * 128, tn * 128, c, DM, DEXP, DEXP,
            [=](int m, int k) { return bf2f(ACT[(size_t)(prow + m) * DEXP + k]); },
            [=](int k, int n) { return wde[(size_t)k * DM + n]; },
            [=](int m, int n, float s, float) { YBUF[(size_t)(prow + m) * DM + n] = f2bf(s * gl[m]); });
    }
}

__device__ __forceinline__ void p8_combine(const Args& A, float* ldsf) {
    float* X1 = A.out; const bf16_t* YBUF = (const bf16_t*)(A.ws + WS_YBUF); const int* ASG = (const int*)(A.ws + WS_ASG);
    const unsigned* cnt = (const unsigned*)(A.ws + WS_CTL) + CW_CNT;
    int* ps = (int*)ldsf;
    if (threadIdx.x == 0) expert_layout(cnt, ps);
    __syncthreads();
    const int tid = threadIdx.x, lane = tid & 63, wave = tid >> 6;
    const int gw = blockIdx.x * NWAVES + wave, NGW = gridDim.x * NWAVES;
    for (int row = gw; row < T; row += NGW) {
        const int a0 = ASG[row * 2], a1 = ASG[row * 2 + 1];
        const bf16_t* y0 = YBUF + (size_t)(ps[a0 >> 16] + (a0 & 0xffff)) * DM; const bf16_t* y1 = YBUF + (size_t)(ps[a1 >> 16] + (a1 & 0xffff)) * DM;
        float* xr = X1 + (size_t)row * DM;
#pragma unroll
        for (int j = 0; j < 4; ++j) { const int c0 = 512 * j + 8 * lane; const u32x4 w0 = *(const u32x4*)(y0 + c0), w1 = *(const u32x4*)(y1 + c0);
            f32x4 xa = *(const f32x4*)(xr + c0), xb = *(const f32x4*)(xr + c0 + 4);
            xa.x += __uint_as_float(w0[0] << 16) + __uint_as_float(w1[0] << 16); xa.y += __uint_as_float(w0[0] & 0xffff0000u) + __uint_as_float(w1[0] & 0xffff0000u);
            xa.z += __uint_as_float(w0[1] << 16) + __uint_as_float(w1[1] << 16); xa.w += __uint_as_float(w0[1] & 0xffff0000u) + __uint_as_float(w1[1] & 0xffff0000u);
            xb.x += __uint_as_float(w0[2] << 16) + __uint_as_float(w1[2] << 16); xb.y += __uint_as_float(w0[2] & 0xffff0000u) + __uint_as_float(w1[2] & 0xffff0000u);
            xb.z += __uint_as_float(w0[3] << 16) + __uint_as_float(w1[3] << 16); xb.w += __uint_as_float(w0[3] & 0xffff0000u) + __uint_as_float(w1[3] & 0xffff0000u);
            *(f32x4*)(xr + c0) = xa; *(f32x4*)(xr + c0 + 4) = xb; }
    }
}

constexpr int N_PHASES = 10;
__global__ void __launch_bounds__(NTHREADS, 2) fwd(Args A) {
    extern __shared__ __attribute__((aligned(16))) unsigned char lds[];
    float* ldsf = (float*)lds;
    cg::grid_group grid = cg::this_grid();
    const int lo = A.ph_lo, hi = A.ph_hi;
#define IN(k) (lo <= (k) && (k) < hi)
#define SEAM(k) do { if (IN(k) && IN((k) + 1)) grid.sync(); } while (0)
    if (IN(0)) { p0_rows(A, ldsf); } SEAM(0);
    if (IN(1)) { p1_naive(A, ldsf); } SEAM(1);
    if (IN(2)) { p1b_fix(A, ldsf); } SEAM(2);
    if (IN(3)) { p2_sgu_naive(A); p2_attn_naive(A, ldsf); } SEAM(3);
    if (IN(4)) { p3_naive(A, ldsf); } SEAM(4);
    if (IN(5)) { p4_naive(A, ldsf); } SEAM(5);
    if (IN(6)) { p5_router(A, ldsf); } SEAM(6);
    if (IN(7)) { p6_naive(A, ldsf); } SEAM(7);
    if (IN(8)) { p7_naive(A, ldsf); } SEAM(8);
    if (IN(9)) { p8_combine(A, ldsf); }
#undef IN
#undef SEAM
}

#ifndef MK_N_LAUNCHES
#define MK_N_LAUNCHES 1
#endif
extern "C" void kernel_launch(void* const* d_in, const int* in_sizes, int n_in, void* d_out, int out_size, void* d_ws, size_t ws_size, hipStream_t stream) {
    static int grid = 0;
    if (grid == 0) {
        if (n_in != 22 || out_size != T * DM || ws_size < WS_END) { fprintf(stderr, "kernel_launch: unexpected shapes (n_in %d out %d ws %zu)\n", n_in, out_size, ws_size); grid = -1; return; }
        int dev = 0, cus = 0, per_cu = 0;
        hipGetDevice(&dev); hipDeviceGetAttribute(&cus, hipDeviceAttributeMultiprocessorCount, dev);
        hipFuncSetAttribute((const void*)fwd, hipFuncAttributeMaxDynamicSharedMemorySize, LDS_BYTES);
        hipOccupancyMaxActiveBlocksPerMultiprocessor(&per_cu, (const void*)fwd, NTHREADS, LDS_BYTES);
        if (per_cu < 1) { fprintf(stderr, "kernel_launch: occupancy query says %d blocks per CU\n", per_cu); per_cu = 1; }
        (void)hipGetLastError();
        grid = cus;
    }
    if (grid < 0) return;
    Args a{};
    for (int i = 0; i < 22; ++i) a.in[i] = (const float*)d_in[i];
    a.out = (float*)d_out; a.ws = (unsigned char*)d_ws;
    if (MK_N_LAUNCHES == 1) {
        a.ph_lo = 0; a.ph_hi = N_PHASES;
        void* args[] = {&a};
        hipError_t e = hipLaunchCooperativeKernel((const void*)fwd, dim3(grid), dim3(NTHREADS), args, LDS_BYTES, stream);
        if (e != hipSuccess) fprintf(stderr, "cooperative launch failed: %s (grid %d)\n", hipGetErrorString(e), grid);
    } else {
        for (int p = 0; p < N_PHASES; ++p) { a.ph_lo = p; a.ph_hi = p + 1; hipLaunchKernelGGL(fwd, dim3(grid), dim3(NTHREADS), LDS_BYTES, stream, a); }
    }
}
```

```cpp
#include <hip/hip_runtime.h>
#include <hip/hip_cooperative_groups.h>
#include <cstdio>
#include <cstdint>
namespace cg = cooperative_groups;

constexpr int T = 8192, SEQ = 2048, NB = 4, DM = 2048, SGUW = 1024, FOXW = 1024, NH = 8, HD = 128, CHUNK = 128, NG = 8;
constexpr int INCOLS = 9224, OFF_F = 5120, OFF_GATE = 5128;
constexpr int NEXP = 32, EPG = 8, NGRP = 4, DEXP = 512;
constexpr float EPS = 1e-6f;
constexpr float LOG2E = 1.4426950408889634f;
constexpr float QSCALE = 0.08838834764831845f * LOG2E;
constexpr int NTHREADS = 512, NWAVES = 8;
constexpr int LDS_BYTES = 160 * 1024;
constexpr int MTILE = 256;
constexpr int PMAX = 2 * T + NEXP * MTILE;

typedef unsigned short bf16_t;
typedef float f32x4 __attribute__((ext_vector_type(4)));
typedef unsigned u32x4 __attribute__((ext_vector_type(4)));
typedef unsigned u32x2 __attribute__((ext_vector_type(2)));

constexpr size_t MiB = 1u << 20;
constexpr size_t WS_CTL = 0;
constexpr size_t WS_LOGF = 1 * MiB;
constexpr size_t WS_CKL = 2 * MiB;
constexpr size_t WS_TOK = 3 * MiB;
constexpr size_t WS_GATE = 4 * MiB;
constexpr size_t WS_ASG = 5 * MiB;
constexpr size_t WS_WIN = 8 * MiB;
constexpr size_t WS_WPROJ = 44 * MiB;
constexpr size_t WS_WOUT = 52 * MiB;
constexpr size_t WS_WGU = 60 * MiB;
constexpr size_t WS_WD = 188 * MiB;
constexpr size_t WS_H = 252 * MiB;
constexpr size_t WS_MIXED = WS_H;
constexpr size_t WS_U = 284 * MiB;
constexpr size_t WS_V = 300 * MiB;
constexpr size_t WS_G = 316 * MiB;
constexpr size_t WS_YBUF = WS_U;
constexpr size_t WS_Q = 380 * MiB;
constexpr size_t WS_K = 396 * MiB;
constexpr size_t WS_VA = 412 * MiB;
constexpr size_t WS_ACT = WS_Q;
constexpr size_t WS_MIXIN = 428 * MiB;
constexpr size_t WS_H2 = WS_MIXIN;
constexpr size_t WS_END = 460 * MiB;
static_assert((size_t)PMAX * 2048 * 2 <= 96 * MiB && (size_t)PMAX * 512 * 2 <= 32 * MiB, "overlay sizes");

constexpr int CW_CNT = 0;

__device__ __forceinline__ float bf2f(bf16_t v) { return __uint_as_float((unsigned)v << 16); }
__device__ __forceinline__ bf16_t f2bf(float f) { unsigned u = __float_as_uint(f); return (bf16_t)((u + 0x7fffu + ((u >> 16) & 1u)) >> 16); }
__device__ __forceinline__ unsigned pk2(float lo, float hi) { return (unsigned)f2bf(lo) | ((unsigned)f2bf(hi) << 16); }
__device__ __forceinline__ float wave_sum(float v) {
#pragma unroll
    for (int o = 1; o < 64; o <<= 1) v += __shfl_xor(v, o);
    return v;
}
__device__ __forceinline__ float wave_max(float v) {
#pragma unroll
    for (int o = 1; o < 64; o <<= 1) v = fmaxf(v, __shfl_xor(v, o));
    return v;
}
__device__ __forceinline__ float gelu_tanh(float x) {
    const float c = 0.7978845608028654f; const float y = c * (x + 0.044715f * x * x * x);
    return x / (1.0f + __expf(-2.0f * y));
}
__device__ __forceinline__ float sigmoidf_(float x) { return 1.0f / (1.0f + __expf(-x)); }
__device__ __forceinline__ float log_sigmoid(float z) { return fminf(z, 0.f) - log1pf(__expf(-fabsf(z))); }

struct Args {
    const float* in[22];
    float* out;
    unsigned char* ws;
    int ph_lo, ph_hi;
};

template <class AF, class BF, class EF>
__device__ __forceinline__ void naive_gemm_tile(float* lds, int m0, int n0, int M, int N, int K, int Ksplit, AF a, BF b, EF epi) {
    float* As = lds;
    float* Bs = lds + 16 * 132;
    const int tid = threadIdx.x, ty = tid >> 4, tx = tid & 15;
    float acc[4][8], acc1[4][8];
#pragma unroll
    for (int i = 0; i < 4; ++i)
#pragma unroll
        for (int j = 0; j < 8; ++j) { acc[i][j] = 0.f; acc1[i][j] = 0.f; }
    const bool split = Ksplit < K;
#pragma unroll 1
    for (int pass = 0; pass < 2; ++pass) {
        const int kb = pass == 0 ? 0 : Ksplit, ke = pass == 0 ? (split ? Ksplit : K) : K;
        if (pass == 1) {
            if (!split) break;
#pragma unroll
            for (int i = 0; i < 4; ++i)
#pragma unroll
                for (int j = 0; j < 8; ++j) { acc1[i][j] = acc[i][j]; acc[i][j] = 0.f; }
        }
#pragma unroll 1
        for (int k0 = kb; k0 < ke; k0 += 16) {
#pragma unroll
            for (int i = 0; i < 4; ++i) { const int idx = tid + i * 512, r = idx >> 4, kk = idx & 15; const int m = m0 + r; As[kk * 132 + r] = (m < M) ? a(m, k0 + kk) : 0.f; }
#pragma unroll
            for (int i = 0; i < 4; ++i) { const int idx = tid + i * 512, kk = idx >> 7, n = idx & 127; Bs[kk * 132 + n] = (n0 + n < N) ? b(k0 + kk, n0 + n) : 0.f; }
            __syncthreads();
#pragma unroll 4
            for (int kk = 0; kk < 16; ++kk) {
                float av[4], bv[8];
#pragma unroll
                for (int i = 0; i < 4; ++i) av[i] = As[kk * 132 + ty * 4 + i];
#pragma unroll
                for (int j = 0; j < 8; ++j) bv[j] = Bs[kk * 132 + tx * 8 + j];
#pragma unroll
                for (int i = 0; i < 4; ++i)
#pragma unroll
                    for (int j = 0; j < 8; ++j) acc[i][j] = fmaf(av[i], bv[j], acc[i][j]);
            }
            __syncthreads();
        }
    }
#pragma unroll
    for (int i = 0; i < 4; ++i)
#pragma unroll
        for (int j = 0; j < 8; ++j) { const int m = m0 + ty * 4 + i, n = n0 + tx * 8 + j; if (m < M && n < N) epi(m, n, split ? acc1[i][j] : acc[i][j], split ? acc[i][j] : 0.f); }
}
template <class AF, class BF, class EF>
__device__ __forceinline__ void naive_gemm(float* lds, int M, int N, int K, int Ksplit, AF a, BF b, EF epi) {
    const int ntm = (M + 127) / 128, ntn = (N + 127) / 128;
    for (int t = blockIdx.x; t < ntm * ntn; t += gridDim.x) naive_gemm_tile(lds, (t / ntn) * 128, (t % ntn) * 128, M, N, K, Ksplit, a, b, epi);
}

__device__ __forceinline__ void p0_rows(const Args& A, float* ldsf) {
    const float* x = A.in[0]; const float* g1 = A.in[1]; const float* w_in = A.in[2]; const float* b_forget = A.in[4];
    bf16_t* H = (bf16_t*)(A.ws + WS_H); float* LOGF = (float*)(A.ws + WS_LOGF);
    const int tid = threadIdx.x, lane = tid & 63, wave = tid >> 6;
    for (int i = tid; i < DM * 8; i += NTHREADS) ldsf[i] = w_in[(size_t)(i >> 3) * INCOLS + OFF_F + (i & 7)];
    __syncthreads();
    const int gw = blockIdx.x * NWAVES + wave, NGW = gridDim.x * NWAVES;
    for (int row = gw; row < T; row += NGW) {
        const f32x4* xr = (const f32x4*)(x + (size_t)row * DM) + lane;
        float ss = 0.f;
#pragma unroll
        for (int j = 0; j < 8; ++j) { const f32x4 v = xr[64 * j]; ss += v.x * v.x + v.y * v.y + v.z * v.z + v.w * v.w; }
        const float rstd = rsqrtf(wave_sum(ss) * (1.f / DM) + EPS);
        float f[8];
#pragma unroll
        for (int h = 0; h < 8; ++h) f[h] = 0.f;
#pragma unroll 1
        for (int j = 0; j < 8; ++j) {
            const int c0 = 256 * j + 4 * lane; const f32x4 g = *(const f32x4*)(g1 + c0); const f32x4 xv = xr[64 * j];
            f32x4 hv; hv.x = xv.x * rstd * g.x; hv.y = xv.y * rstd * g.y; hv.z = xv.z * rstd * g.z; hv.w = xv.w * rstd * g.w;
            u32x2 o; o.x = pk2(hv.x, hv.y); o.y = pk2(hv.z, hv.w);
            *(u32x2*)(H + (size_t)row * DM + c0) = o;
#pragma unroll
            for (int e = 0; e < 4; ++e) { const float hx = hv[e]; const float* wf = ldsf + (c0 + e) * 8;
#pragma unroll
                for (int h = 0; h < 8; ++h) f[h] = fmaf(hx, wf[h], f[h]); }
        }
#pragma unroll
        for (int h = 0; h < 8; ++h) f[h] = wave_sum(f[h]);
        if (lane < 8) { float z = 0.f;
#pragma unroll
            for (int h = 0; h < 8; ++h) if (lane == h) z = f[h];
            LOGF[(size_t)row * 8 + lane] = log_sigmoid(z + b_forget[lane]); }
    }
    if (blockIdx.x == 0 && tid < 64) ((unsigned*)(A.ws + WS_CTL))[tid] = 0u;
}

__device__ __forceinline__ void p1_naive(const Args& A, float* ldsf) {
    const bf16_t* H = (const bf16_t*)(A.ws + WS_H); const float* w_in = A.in[2]; const float* b_gate = A.in[3];
    bf16_t* U = (bf16_t*)(A.ws + WS_U); bf16_t* V = (bf16_t*)(A.ws + WS_V); bf16_t* Q = (bf16_t*)(A.ws + WS_Q); bf16_t* K = (bf16_t*)(A.ws + WS_K);
    bf16_t* VA = (bf16_t*)(A.ws + WS_VA); bf16_t* G = (bf16_t*)(A.ws + WS_G);
    naive_gemm(ldsf, T, 9216, DM, DM,
        [=](int m, int k) { return bf2f(H[(size_t)m * DM + k]); },
        [=](int k, int n) { const int c = n < 5120 ? n : n + 8; return w_in[(size_t)k * INCOLS + c]; },
        [=](int m, int n, float s, float) {
            if (n < 1024) U[(size_t)m * 1024 + n] = f2bf(gelu_tanh(s));
            else if (n < 2048) V[(size_t)m * 1024 + n - 1024] = f2bf(gelu_tanh(s));
            else if (n < 3072) Q[(size_t)m * 1024 + n - 2048] = f2bf(s);
            else if (n < 4096) K[(size_t)m * 1024 + n - 3072] = f2bf(s);
            else if (n < 5120) VA[(size_t)m * 1024 + n - 4096] = f2bf(s);
            else G[(size_t)m * 4096 + n - 5120] = f2bf(sigmoidf_(s + b_gate[n - 5120]));
        });
}

__device__ __forceinline__ void p1b_fix(const Args& A, float* ldsf) {
    bf16_t* V = (bf16_t*)(A.ws + WS_V); bf16_t* Q = (bf16_t*)(A.ws + WS_Q); bf16_t* K = (bf16_t*)(A.ws + WS_K);
    const float* ln_g = A.in[5]; const float* ln_b = A.in[6]; const float* qg = A.in[9]; const float* kg = A.in[10];
    const int tid = threadIdx.x, lane = tid & 63, wave = tid >> 6;
    const int gw = blockIdx.x * NWAVES + wave, NGW = gridDim.x * NWAVES;
    for (int row = gw; row < T; row += NGW) {
        {
            bf16_t* vr = V + (size_t)row * 1024; float v[16]; float s = 0.f;
#pragma unroll
            for (int j = 0; j < 2; ++j) { const u32x4 w = *(const u32x4*)(vr + 512 * j + 8 * lane);
#pragma unroll
                for (int e = 0; e < 4; ++e) { v[8 * j + 2 * e] = __uint_as_float(w[e] << 16); v[8 * j + 2 * e + 1] = __uint_as_float(w[e] & 0xffff0000u); } }
#pragma unroll
            for (int i = 0; i < 16; ++i) s += v[i];
            const float mean = wave_sum(s) * (1.f / 1024.f); float q = 0.f;
#pragma unroll
            for (int i = 0; i < 16; ++i) { v[i] -= mean; q += v[i] * v[i]; }
            const float rstd = rsqrtf(wave_sum(q) * (1.f / 1024.f) + EPS);
#pragma unroll
            for (int j = 0; j < 2; ++j) { const int c0 = 512 * j + 8 * lane; u32x4 o;
#pragma unroll
                for (int e = 0; e < 4; ++e) o[e] = pk2(v[8 * j + 2 * e] * rstd * ln_g[c0 + 2 * e] + ln_b[c0 + 2 * e], v[8 * j + 2 * e + 1] * rstd * ln_g[c0 + 2 * e + 1] + ln_b[c0 + 2 * e + 1]);
                *(u32x4*)(vr + c0) = o; }
        }
#pragma unroll
        for (int which = 0; which < 2; ++which) {
            bf16_t* pr = (which == 0 ? Q : K) + (size_t)row * 1024 + 16 * lane; const float* gg = which == 0 ? qg : kg; float v[16]; float s = 0.f;
#pragma unroll
            for (int j = 0; j < 2; ++j) { const u32x4 w = *(const u32x4*)(pr + 8 * j);
#pragma unroll
                for (int e = 0; e < 4; ++e) { v[8 * j + 2 * e] = __uint_as_float(w[e] << 16); v[8 * j + 2 * e + 1] = __uint_as_float(w[e] & 0xffff0000u); } }
#pragma unroll
            for (int i = 0; i < 16; ++i) s += v[i] * v[i];
            s += __shfl_xor(s, 1); s += __shfl_xor(s, 2); s += __shfl_xor(s, 4);
            const float sc = rsqrtf(s * (1.f / 128.f) + EPS) * (which == 0 ? QSCALE : 1.f); const int d0 = (16 * lane) & 127;
#pragma unroll
            for (int j = 0; j < 2; ++j) { u32x4 o;
#pragma unroll
                for (int e = 0; e < 4; ++e) o[e] = pk2(v[8 * j + 2 * e] * sc * gg[d0 + 8 * j + 2 * e], v[8 * j + 2 * e + 1] * sc * gg[d0 + 8 * j + 2 * e + 1]);
                *(u32x4*)(pr + 8 * j) = o; }
        }
    }
    if (blockIdx.x < NB * NH) {
        const int b = blockIdx.x / NH, h = blockIdx.x % NH; const float* LOGF = (const float*)(A.ws + WS_LOGF); float* CKL = (float*)(A.ws + WS_CKL) + (size_t)blockIdx.x * SEQ;
        float v[4]; float s = 0.f;
#pragma unroll
        for (int i = 0; i < 4; ++i) { v[i] = LOGF[(size_t)(b * SEQ + tid * 4 + i) * 8 + h]; s += v[i]; }
        float incl = s;
#pragma unroll
        for (int o = 1; o < 64; o <<= 1) { const float t = __shfl_up(incl, o); if (lane >= o) incl += t; }
        __syncthreads();
        if (lane == 63) ldsf[wave] = incl;
        __syncthreads();
        float base = 0.f;
        for (int w = 0; w < wave; ++w) base += ldsf[w];
        float run = base + incl - s;
#pragma unroll
        for (int i = 0; i < 4; ++i) { run += v[i]; CKL[tid * 4 + i] = run * LOG2E; }
        __syncthreads();
    }
}

__device__ __forceinline__ void p2_sgu_naive(const Args& A) {
    const bf16_t* U = (const bf16_t*)(A.ws + WS_U); const bf16_t* V = (const bf16_t*)(A.ws + WS_V); bf16_t* MIXIN = (bf16_t*)(A.ws + WS_MIXIN);
    const float* wsp = A.in[7]; const float* bsp = A.in[8];
    const int tid = threadIdx.x, tt = tid >> 2, dp = tid & 3;
    for (int u = blockIdx.x; u < (T / CHUNK) * NG; u += gridDim.x) {
        const int rc = u / NG, g = u % NG; const int row0 = rc * CHUNK;
        float acc[32];
#pragma unroll
        for (int i = 0; i < 32; ++i) acc[i] = 0.f;
        for (int ss = 0; ss <= tt; ++ss) {
            const float w = wsp[((size_t)g * CHUNK + tt) * CHUNK + ss];
            const bf16_t* vr = V + (size_t)(row0 + ss) * 1024 + g * 128 + dp * 32;
#pragma unroll
            for (int i = 0; i < 32; ++i) acc[i] = fmaf(w, bf2f(vr[i]), acc[i]);
        }
        const float bb = bsp[g * CHUNK + tt];
        const bf16_t* ur = U + (size_t)(row0 + tt) * 1024 + g * 128 + dp * 32; bf16_t* orow = MIXIN + (size_t)(row0 + tt) * 2048 + g * 128 + dp * 32;
#pragma unroll
        for (int i = 0; i < 32; ++i) orow[i] = f2bf(bf2f(ur[i]) * (acc[i] + bb));
    }
}
__device__ __forceinline__ void p2_attn_naive(const Args& A, float* ldsf) {
    const bf16_t* Q = (const bf16_t*)(A.ws + WS_Q); const bf16_t* K = (const bf16_t*)(A.ws + WS_K); const bf16_t* VA = (const bf16_t*)(A.ws + WS_VA);
    const float* CKL = (const float*)(A.ws + WS_CKL); bf16_t* MIXIN = (bf16_t*)(A.ws + WS_MIXIN);
    const int tid = threadIdx.x, lane = tid & 63, wave = tid >> 6;
    float* qs = ldsf + wave * 128;
    const int gw = blockIdx.x * NWAVES + wave, NGW = gridDim.x * NWAVES;
    for (int item = gw; item < T * NH; item += NGW) {
        const int row = item / NH, h = item % NH, b = row / SEQ, t = row % SEQ;
        const bf16_t* qr = Q + (size_t)row * 1024 + h * 128;
        qs[lane] = bf2f(qr[lane]); qs[64 + lane] = bf2f(qr[64 + lane]);
        __builtin_amdgcn_s_waitcnt(0);
        const float* ck = CKL + (size_t)(b * NH + h) * SEQ;
        float m = -1e30f, l = 0.f, o0 = 0.f, o1 = 0.f;
        for (int s0 = 0; s0 <= t; s0 += 64) {
            const int s = s0 + lane; float sc = -INFINITY;
            if (s <= t) { const bf16_t* kr = K + (size_t)(b * SEQ + s) * 1024 + h * 128; float d = 0.f;
                for (int c = 0; c < 16; ++c) { const u32x4 w = *(const u32x4*)(kr + 8 * c);
#pragma unroll
                    for (int e = 0; e < 4; ++e) { d = fmaf(qs[8 * c + 2 * e], __uint_as_float(w[e] << 16), d); d = fmaf(qs[8 * c + 2 * e + 1], __uint_as_float(w[e] & 0xffff0000u), d); } }
                sc = d - ck[s]; }
            const float mn = fmaxf(m, wave_max(sc)); const float alpha = exp2f(m - mn); const float p = exp2f(sc - mn);
            l = l * alpha + wave_sum(p); o0 *= alpha; o1 *= alpha; m = mn;
            const int nk = min(64, t - s0 + 1);
            for (int j = 0; j < nk; ++j) { const float pj = __shfl(p, j); const unsigned w = *(const unsigned*)(VA + (size_t)(b * SEQ + s0 + j) * 1024 + h * 128 + 2 * lane);
                o0 = fmaf(pj, __uint_as_float(w << 16), o0); o1 = fmaf(pj, __uint_as_float(w & 0xffff0000u), o1); }
        }
        const float il = 1.f / l;
        *(unsigned*)(MIXIN + (size_t)row * 2048 + 1024 + h * 128 + 2 * lane) = pk2(o0 * il, o1 * il);
    }
}

__device__ __forceinline__ void p3_naive(const Args& A, float* ldsf) {
    const bf16_t* MIXIN = (const bf16_t*)(A.ws + WS_MIXIN); const bf16_t* G = (const bf16_t*)(A.ws + WS_G); bf16_t* MIXED = (bf16_t*)(A.ws + WS_MIXED);
    const float* wps = A.in[11]; const float* wpf = A.in[12];
    naive_gemm(ldsf, T, DM, 2048, 1024,
        [=](int m, int k) { return bf2f(MIXIN[(size_t)m * 2048 + k]); },
        [=](int k, int n) { return k < 1024 ? wps[(size_t)k * DM + n] : wpf[(size_t)(k - 1024) * DM + n]; },
        [=](int m, int n, float s1, float s2) { MIXED[(size_t)m * DM + n] = f2bf(bf2f(G[(size_t)m * 4096 + n]) * s1 + bf2f(G[(size_t)m * 4096 + 2048 + n]) * s2); });
}
__device__ __forceinline__ void p4_naive(const Args& A, float* ldsf) {
    const bf16_t* MIXED = (const bf16_t*)(A.ws + WS_MIXED); const float* wo = A.in[13]; const float* x = A.in[0]; float* X1 = A.out;
    naive_gemm(ldsf, T, DM, DM, DM,
        [=](int m, int k) { return bf2f(MIXED[(size_t)m * DM + k]); },
        [=](int k, int n) { return wo[(size_t)k * DM + n]; },
        [=](int m, int n, float s, float) { X1[(size_t)m * DM + n] = x[(size_t)m * DM + n] + s; });
}

__device__ __forceinline__ void p5_router(const Args& A, float* ldsf) {
    const float* X1 = A.out; const float* g2 = A.in[14]; const float* wrg = A.in[15]; const float* brg = A.in[16]; const float* wre = A.in[17]; const float* bre = A.in[18];
    bf16_t* H2 = (bf16_t*)(A.ws + WS_H2); unsigned* cnt = (unsigned*)(A.ws + WS_CTL) + CW_CNT;
    int* TOK = (int*)(A.ws + WS_TOK); float* GATE = (float*)(A.ws + WS_GATE); int* ASG = (int*)(A.ws + WS_ASG);
    const int tid = threadIdx.x, lane = tid & 63, wave = tid >> 6, r = tid >> 4, ks = tid & 15;
    float* Ws = ldsf;
    float* Xs = ldsf + 256 * 36;
    float* rs = Xs + 32 * 260;
    int* hist = (int*)(rs + 32);
    int* hbase = hist + 32;
    int* sel = hbase + 32;
    int* lpos = sel + 64;
    float* selw = (float*)(lpos + 64);
    for (int rb = blockIdx.x; rb < T / 32; rb += gridDim.x) {
        const int row0 = rb * 32;
        for (int i = 0; i < 4; ++i) { const int rr = wave * 4 + i; const f32x4* xr = (const f32x4*)(X1 + (size_t)(row0 + rr) * DM) + lane; float ss = 0.f;
#pragma unroll
            for (int j = 0; j < 8; ++j) { const f32x4 v = xr[64 * j]; ss += v.x * v.x + v.y * v.y + v.z * v.z + v.w * v.w; }
            ss = wave_sum(ss); if (lane == 0) rs[rr] = rsqrtf(ss * (1.f / DM) + EPS); }
        if (tid < 32) hist[tid] = 0;
        __syncthreads();
        float acc[36];
#pragma unroll
        for (int j = 0; j < 36; ++j) acc[j] = 0.f;
        for (int k0 = 0; k0 < DM; k0 += 256) {
            for (int i = tid; i < 256 * 36; i += NTHREADS) { const int kk = i / 36, j = i % 36; Ws[i] = j < 4 ? wrg[(size_t)(k0 + kk) * 4 + j] : wre[(size_t)(k0 + kk) * 32 + j - 4]; }
            for (int i = tid; i < 32 * 256; i += NTHREADS) { const int rr = i >> 8, kk = i & 255; const float hv = X1[(size_t)(row0 + rr) * DM + k0 + kk] * rs[rr] * g2[k0 + kk];
                Xs[rr * 260 + kk] = hv; H2[(size_t)(row0 + rr) * DM + k0 + kk] = f2bf(hv); }
            __syncthreads();
            for (int kk = ks; kk < 256; kk += 16) { const float xv = Xs[r * 260 + kk]; const float* wr = Ws + kk * 36;
#pragma unroll
                for (int j = 0; j < 36; ++j) acc[j] = fmaf(xv, wr[j], acc[j]); }
            __syncthreads();
        }
#pragma unroll
        for (int j = 0; j < 36; ++j) { float v = acc[j]; v += __shfl_xor(v, 1); v += __shfl_xor(v, 2); v += __shfl_xor(v, 4); v += __shfl_xor(v, 8); acc[j] = v; }
        if (ks == 0) {
            float gl[4]; int grp = 0; float gm;
#pragma unroll
            for (int j = 0; j < 4; ++j) gl[j] = acc[j] + brg[j];
            gm = gl[0];
#pragma unroll
            for (int j = 1; j < 4; ++j) if (gl[j] > gm) { gm = gl[j]; grp = j; }
            float den = 0.f;
#pragma unroll
            for (int j = 0; j < 4; ++j) den += __expf(gl[j] - gm);
            const float pg = 1.f / den;
            float el[8];
#pragma unroll
            for (int j = 0; j < 8; ++j) { float v = 0.f;
#pragma unroll
                for (int g = 0; g < 4; ++g) if (g == grp) v = acc[4 + g * 8 + j] + bre[g * 8 + j];
                el[j] = v; }
            int i0 = 0; float v0 = el[0];
#pragma unroll
            for (int j = 1; j < 8; ++j) if (el[j] > v0) { v0 = el[j]; i0 = j; }
            int i1 = -1; float v1 = -INFINITY;
#pragma unroll
            for (int j = 0; j < 8; ++j) if (j != i0 && el[j] > v1) { v1 = el[j]; i1 = j; }
            const float e1 = __expf(v1 - v0); const float w0 = pg / (1.f + e1), w1 = pg * e1 / (1.f + e1);
            const int ea = grp * 8 + i0, eb = grp * 8 + i1;
            sel[r * 2] = ea; sel[r * 2 + 1] = eb; selw[r * 2] = w0; selw[r * 2 + 1] = w1;
            lpos[r * 2] = atomicAdd(&hist[ea], 1); lpos[r * 2 + 1] = atomicAdd(&hist[eb], 1);
        }
        __syncthreads();
        if (tid < 32) hbase[tid] = hist[tid] > 0 ? (int)atomicAdd(&cnt[tid], (unsigned)hist[tid]) : 0;
        __syncthreads();
        if (tid < 64) { const int e = sel[tid], pos = hbase[e] + lpos[tid]; const int tok = row0 + (tid >> 1);
            TOK[(size_t)e * T + pos] = tok; GATE[(size_t)e * T + pos] = selw[tid]; ASG[tok * 2 + (tid & 1)] = (e << 16) | pos; }
        __syncthreads();
    }
}

__device__ __forceinline__ void expert_layout(const unsigned* cnt, int* pstart  ) {
    int acc = 0;
    for (int e = 0; e < NEXP; ++e) { pstart[e] = acc; acc += ((int)cnt[e] + MTILE - 1) / MTILE * MTILE; }
    pstart[NEXP] = acc;
}

__device__ __forceinline__ void p6_naive(const Args& A, float* ldsf) {
    const bf16_t* H2 = (const bf16_t*)(A.ws + WS_H2); const float* wg = A.in[19]; const float* wu = A.in[20]; bf16_t* ACT = (bf16_t*)(A.ws + WS_ACT);
    const unsigned* cnt = (const unsigned*)(A.ws + WS_CTL) + CW_CNT; const int* TOK = (const int*)(A.ws + WS_TOK);
    int* ps = (int*)(ldsf + 2 * 16 * 132);
    if (threadIdx.x == 0) expert_layout(cnt, ps);
    __syncthreads();
    int ntot = 0;
    for (int e = 0; e < NEXP; ++e) ntot += (((int)cnt[e] + 127) / 128) * 4;
    for (int t = blockIdx.x; t < ntot; t += gridDim.x) {
        int e = 0, rem = t;
        for (; e < NEXP; ++e) { const int n = (((int)cnt[e] + 127) / 128) * 4; if (rem < n) break; rem -= n; }
        const int c = (int)cnt[e]; const int tm = rem / 4, tn = rem % 4; const int* tl = TOK + (size_t)e * T; const int prow = ps[e];
        const float* wge = wg + (size_t)e * DM * DEXP; const float* wue = wu + (size_t)e * DM * DEXP;
        naive_gemm_tile(ldsf, tm * 128, tn * 128, c, DEXP, 2 * DM, DM,
            [=](int m, int k) { return bf2f(H2[(size_t)tl[m] * DM + (k & (DM - 1))]); },
            [=](int k, int n) { return k < DM ? wge[(size_t)k * DEXP + n] : wue[(size_t)(k - DM) * DEXP + n]; },
            [=](int m, int n, float sg, float su) { ACT[(size_t)(prow + m) * DEXP + n] = f2bf(sg / (1.f + __expf(-sg)) * su); });
    }
}
__device__ __forceinline__ void p7_naive(const Args& A, float* ldsf) {
    const bf16_t* ACT = (const bf16_t*)(A.ws + WS_ACT); const float* wd = A.in[21]; bf16_t* YBUF = (bf16_t*)(A.ws + WS_YBUF);
    const unsigned* cnt = (const unsigned*)(A.ws + WS_CTL) + CW_CNT; const float* GATE = (const float*)(A.ws + WS_GATE);
    int* ps = (int*)(ldsf + 2 * 16 * 132);
    if (threadIdx.x == 0) expert_layout(cnt, ps);
    __syncthreads();
    int ntot = 0;
    for (int e = 0; e < NEXP; ++e) ntot += (((int)cnt[e] + 127) / 128) * 16;
    for (int t = blockIdx.x; t < ntot; t += gridDim.x) {
        int e = 0, rem = t;
        for (; e < NEXP; ++e) { const int n = (((int)cnt[e] + 127) / 128) * 16; if (rem < n) break; rem -= n; }
        const int c = (int)cnt[e]; const int tm = rem / 16, tn = rem % 16; const float* gl = GATE + (size_t)e * T; const int prow = ps[e];
        const float* wde = wd + (size_t)e * DEXP * DM;
        naive_gemm_tile(ldsf, tm * 128, tn * 128, c, DM, DEXP, DEXP,
            [=](int m, int k) { return bf2f(ACT[(size_t)(prow + m) * DEXP + k]); },
            [=](int k, int n) { return wde[(size_t)k * DM + n]; },
            [=](int m, int n, float s, float) { YBUF[(size_t)(prow + m) * DM + n] = f2bf(s * gl[m]); });
    }
}

__device__ __forceinline__ void p8_combine(const Args& A, float* ldsf) {
    float* X1 = A.out; const bf16_t* YBUF = (const bf16_t*)(A.ws + WS_YBUF); const int* ASG = (const int*)(A.ws + WS_ASG);
    const unsigned* cnt = (const unsigned*)(A.ws + WS_CTL) + CW_CNT;
    int* ps = (int*)ldsf;
    if (threadIdx.x == 0) expert_layout(cnt, ps);
    __syncthreads();
    const int tid = threadIdx.x, lane = tid & 63, wave = tid >> 6;
    const int gw = blockIdx.x * NWAVES + wave, NGW = gridDim.x * NWAVES;
    for (int row = gw; row < T; row += NGW) {
        const int a0 = ASG[row * 2], a1 = ASG[row * 2 + 1];
        const bf16_t* y0 = YBUF + (size_t)(ps[a0 >> 16] + (a0 & 0xffff)) * DM; const bf16_t* y1 = YBUF + (size_t)(ps[a1 >> 16] + (a1 & 0xffff)) * DM;
        float* xr = X1 + (size_t)row * DM;
#pragma unroll
        for (int j = 0; j < 4; ++j) { const int c0 = 512 * j + 8 * lane; const u32x4 w0 = *(const u32x4*)(y0 + c0), w1 = *(const u32x4*)(y1 + c0);
            f32x4 xa = *(const f32x4*)(xr + c0), xb = *(const f32x4*)(xr + c0 + 4);
            xa.x += __uint_as_float(w0[0] << 16) + __uint_as_float(w1[0] << 16); xa.y += __uint_as_float(w0[0] & 0xffff0000u) + __uint_as_float(w1[0] & 0xffff0000u);
            xa.z += __uint_as_float(w0[1] << 16) + __uint_as_float(w1[1] << 16); xa.w += __uint_as_float(w0[1] & 0xffff0000u) + __uint_as_float(w1[1] & 0xffff0000u);
            xb.x += __uint_as_float(w0[2] << 16) + __uint_as_float(w1[2] << 16); xb.y += __uint_as_float(w0[2] & 0xffff0000u) + __uint_as_float(w1[2] & 0xffff0000u);
            xb.z += __uint_as_float(w0[3] << 16) + __uint_as_float(w1[3] << 16); xb.w += __uint_as_float(w0[3] & 0xffff0000u) + __uint_as_float(w1[3] & 0xffff0000u);
            *(f32x4*)(xr + c0) = xa; *(f32x4*)(xr + c0 + 4) = xb; }
    }
}

namespace pg8 {
#define PG8_LAS __attribute__((address_space(3)))
typedef short bf16x8 __attribute__((ext_vector_type(8)));
constexpr int BM = 256, BK = 64, HALF = 128, HTB = HALF * BK * 2, STAGE_BYTES = 8 * HTB, NXCD = 8, WGM = 8;
__host__ __device__ __forceinline__ int lds_byte(int r, int c) { const int st = (r >> 4) * 2 + (c >> 5), rr = r & 15, cc = c & 31, ob = rr * 64 + cc * 2; return st * 1024 + (ob ^ (((ob >> 9) & 1) << 5)); }
__host__ __device__ __forceinline__ void stage_rc(int b, int& R, int& C) { const int st = b / 1024, sb = b % 1024, swz = sb ^ (((sb >> 9) & 1) << 5); R = (st >> 1) * 16 + swz / 64; C = (st & 1) * 32 + (swz % 64) / 2; }
__host__ __device__ __forceinline__ int perm32(int rho) { const int n = rho >> 4, i = rho & 15; return 8 * (i >> 2) + 4 * n + (i & 3); }

struct Unit { const char* A; const char* B; int pm, pn, x0, x1, x2, x3; };

struct DenseOrder {
    const char* A; const char* Bt; int K, nM, nN, nwg, G, c;
    __device__ void init(const void* A_, const void* Bt_, int M, int N, int K_, int G_, int c_) { A = (const char*)A_; Bt = (const char*)Bt_; K = K_; nM = M / BM; nN = N / BM; nwg = nM * nN; G = G_; c = c_; }
    __device__ bool next(int i, Unit& u) const {
        const long L = (long)i * G + c; if (L >= nwg) return false;
        int wgid = (int)L; { const int q = nwg / NXCD, r = nwg % NXCD, xcd = wgid % NXCD, off = wgid / NXCD; wgid = (xcd < r ? xcd * (q + 1) : r * (q + 1) + (xcd - r) * q) + off; }
        const int nig = WGM * nN, gid = wgid / nig, fm = gid * WGM, gsz = (nM - fm) < WGM ? (nM - fm) : WGM;
        u.pm = fm + ((wgid % nig) % gsz); u.pn = (wgid % nig) / gsz; u.x0 = 0; u.x1 = 0; u.x2 = 0; u.x3 = 0;
        u.A = A + (size_t)u.pm * BM * K * 2; u.B = Bt + (size_t)u.pn * BM * K * 2; return true;
    }
    __device__ __forceinline__ void rows(const Unit&, unsigned (&)[2][2], const int (&)[2]) const {}
};

__device__ __forceinline__ unsigned cvt_pk_bf16(float lo, float hi) { unsigned r; asm volatile("v_cvt_pk_bf16_f32 %0, %1, %2" : "=v"(r) : "v"(lo), "v"(hi)); return r; }

template <class Epi, class Sched, bool ALIGN_EPI, bool GATHER>
__device__ __forceinline__ void gemm_phase(PG8_LAS unsigned char* lds, const int K, const Sched& S, const Epi& E) {
    const int tid = threadIdx.x, wid = __builtin_amdgcn_readfirstlane(tid >> 6), lane = tid & 63, wr = wid >> 2, wc = wid & 3, fr = lane & 15, fq = lane >> 4;
    const int nt = K / BK;
    unsigned voffA[2], voffB[2]; int RA[2];
#pragma unroll
    for (int i = 0; i < 2; ++i) { int R, C; stage_rc(tid * 16 + i * 8192, R, C); const int Rb = Epi::PERM ? ((R & ~31) + perm32(R & 31)) : R;
        voffA[i] = GATHER ? (unsigned)(C * 2) : (unsigned)(R * K + C) * 2u; voffB[i] = (unsigned)(Rb * K + C) * 2u; RA[i] = R; }
    const size_t kstep = (size_t)(BK * 2);
    const size_t hstep = (size_t)HALF * K * 2;
    const size_t hstepA = GATHER ? 0 : hstep;
    const unsigned ldsw = (unsigned)wid * 1024u;
    const int aoff = lds_byte(wr * 64 + fr, fq * 8), boff = lds_byte(wc * 32 + fr, fq * 8);
    unsigned gA[2][2], gAn[2][2];
#define PG8_SA(b, h) (((b) * 2 + (h)) * HTB)
#define PG8_SB(b, h) ((4 + (b) * 2 + (h)) * HTB)
#define PG8_STAGE(bufoff, gbase, voff) do { _Pragma("unroll") for (int _i = 0; _i < 2; ++_i) \
        __builtin_amdgcn_global_load_lds((const unsigned*)((const char*)(gbase) + (voff)[_i]), (PG8_LAS unsigned*)(lds + (bufoff) + ldsw + _i * 8192), 16, 0, 0); } while (0)
#define PG8_STAGE_A(bufoff, gbase, h, nx) do { _Pragma("unroll") for (int _i = 0; _i < 2; ++_i) { \
        const unsigned _o = GATHER ? ((nx) ? gAn[h][_i] : gA[h][_i]) + voffA[_i] : voffA[_i]; \
        __builtin_amdgcn_global_load_lds((const unsigned*)((const char*)(gbase) + (h) * hstepA + _o), (PG8_LAS unsigned*)(lds + (bufoff) + ldsw + _i * 8192), 16, 0, 0); } } while (0)
#define PG8_LDA(dst, b, h) do { _Pragma("unroll") for (int m = 0; m < 4; ++m) _Pragma("unroll") for (int k = 0; k < 2; ++k) dst[m][k] = *(const PG8_LAS bf16x8*)(lds + PG8_SA(b, h) + aoff + m * 2048 + k * 1024); } while (0)
#define PG8_LDB(dst, b, h) do { _Pragma("unroll") for (int n = 0; n < 2; ++n) _Pragma("unroll") for (int k = 0; k < 2; ++k) dst[n][k] = *(const PG8_LAS bf16x8*)(lds + PG8_SB(b, h) + boff + n * 2048 + k * 1024); } while (0)
#define PG8_MMA(ai, bj, At, Bt) do { __builtin_amdgcn_s_setprio(1); _Pragma("unroll") for (int m = 0; m < 4; ++m) _Pragma("unroll") for (int n = 0; n < 2; ++n) _Pragma("unroll") for (int k = 0; k < 2; ++k) \
        acc[ai][bj][m][n] = __builtin_amdgcn_mfma_f32_16x16x32_bf16(Bt[n][k], At[m][k], acc[ai][bj][m][n], 0, 0, 0); __builtin_amdgcn_s_setprio(0); } while (0)
#define PG8_WAIT_V(n) asm volatile("s_waitcnt vmcnt(" #n ")" ::: "memory")
#define PG8_WAIT_L(n) asm volatile("s_waitcnt lgkmcnt(" #n ")" ::: "memory")
#define PG8_BAR __builtin_amdgcn_s_barrier()
#define PG8_SCHED __builtin_amdgcn_sched_barrier(0)
    Unit cur, nxt; int ui = 0;
    if (!S.next(0, cur)) return;
    f32x4 acc[2][2][4][2];
#pragma unroll
    for (int a = 0; a < 2; ++a)
#pragma unroll
        for (int b = 0; b < 2; ++b)
#pragma unroll
            for (int m = 0; m < 4; ++m)
#pragma unroll
                for (int n = 0; n < 2; ++n) acc[a][b][m][n] = (f32x4){0.f, 0.f, 0.f, 0.f};
    bf16x8 At[4][2], B0[2][2], B1[2][2];
    const char* cA = cur.A; const char* cB = cur.B;
    if constexpr (GATHER) { S.rows(cur, gA, RA);
#pragma unroll
        for (int h = 0; h < 2; ++h)
#pragma unroll
            for (int i = 0; i < 2; ++i) gAn[h][i] = gA[h][i]; }
    PG8_STAGE(PG8_SB(0, 0), cB, voffB); PG8_STAGE(PG8_SB(0, 1), cB + hstep, voffB); PG8_STAGE_A(PG8_SA(0, 0), cA, 0, false); PG8_STAGE_A(PG8_SA(0, 1), cA, 1, false);
    if (wr == 1) PG8_BAR;
    PG8_WAIT_V(2); PG8_BAR;
    PG8_STAGE(PG8_SB(1, 0), cB + kstep, voffB); PG8_STAGE_A(PG8_SA(1, 0), cA + kstep, 0, false); PG8_STAGE(PG8_SB(1, 1), cB + hstep + kstep, voffB);
    PG8_WAIT_V(6); PG8_BAR;
    for (;;) {
        const bool has_next = S.next(ui + 1, nxt);
        const char* nA = has_next ? nxt.A : cA; const char* nB = has_next ? nxt.B : cB;
        if constexpr (GATHER) { if (has_next) { S.rows(nxt, gAn, RA); } }
        for (int t = 0; t < nt; t += 2) {
            const bool last = (t == nt - 2);
            const char* a1 = cA + (size_t)(t + 1) * kstep;
            const char* a2 = last ? nA : cA + (size_t)(t + 2) * kstep; const char* b2 = last ? nB : cB + (size_t)(t + 2) * kstep;
            const char* a3 = a2 + kstep; const char* b3 = b2 + kstep;
            if constexpr (Epi::HAS_MID) { if (t == nt / 2) { int frl = fr, fql = fq; asm volatile("" : "+v"(frl), "+v"(fql)); E.mid(acc, cur, wr, wc, frl, fql); } }
            PG8_LDB(B0, 0, 0); PG8_LDB(B1, 0, 1); PG8_SCHED; PG8_LDA(At, 0, 0); PG8_STAGE_A(PG8_SA(1, 1), a1, 1, false);
            PG8_WAIT_V(8); PG8_WAIT_L(0); PG8_BAR; PG8_MMA(0, 0, At, B0); PG8_MMA(0, 1, At, B1); PG8_BAR; PG8_SCHED;
            PG8_LDA(At, 0, 1); PG8_STAGE(PG8_SB(0, 0), b2, voffB); PG8_STAGE(PG8_SB(0, 1), b2 + hstep, voffB); PG8_STAGE_A(PG8_SA(0, 0), a2, 0, last);
            PG8_WAIT_V(8); PG8_WAIT_L(0); PG8_BAR; PG8_MMA(1, 0, At, B0); PG8_MMA(1, 1, At, B1); PG8_BAR; PG8_SCHED;
            PG8_LDB(B0, 1, 0); PG8_LDB(B1, 1, 1); PG8_SCHED; PG8_LDA(At, 1, 0); PG8_STAGE_A(PG8_SA(0, 1), a2, 1, last);
            PG8_WAIT_V(8); PG8_WAIT_L(0); PG8_BAR; PG8_MMA(0, 0, At, B0); PG8_MMA(0, 1, At, B1); PG8_BAR; PG8_SCHED;
            PG8_LDA(At, 1, 1); PG8_STAGE(PG8_SB(1, 0), b3, voffB); PG8_STAGE(PG8_SB(1, 1), b3 + hstep, voffB); PG8_STAGE_A(PG8_SA(1, 0), a3, 0, last);
            PG8_WAIT_V(8); PG8_WAIT_L(0); PG8_BAR; PG8_MMA(1, 0, At, B0); PG8_MMA(1, 1, At, B1); PG8_BAR; PG8_SCHED;
        }
        if constexpr (ALIGN_EPI) { if (wr == 0) PG8_BAR; }
        { int frl = fr, fql = fq; asm volatile("" : "+v"(frl), "+v"(fql)); E(acc, cur, wr, wc, frl, fql); }
        if (!has_next) break;
#pragma unroll
        for (int a = 0; a < 2; ++a)
#pragma unroll
            for (int b = 0; b < 2; ++b)
#pragma unroll
                for (int m = 0; m < 4; ++m)
#pragma unroll
                    for (int n = 0; n < 2; ++n) acc[a][b][m][n] = (f32x4){0.f, 0.f, 0.f, 0.f};
        cur = nxt; cA = nA; cB = nB; ++ui;
        if constexpr (GATHER) {
#pragma unroll
            for (int h = 0; h < 2; ++h)
#pragma unroll
                for (int i = 0; i < 2; ++i) gA[h][i] = gAn[h][i]; }
        if constexpr (ALIGN_EPI) { if (wr == 1) PG8_BAR; }
    }
    PG8_WAIT_V(0);
    if constexpr (!ALIGN_EPI) { if (wr == 0) PG8_BAR; }
    PG8_BAR;
#undef PG8_SA
#undef PG8_SB
#undef PG8_STAGE
#undef PG8_STAGE_A
#undef PG8_LDA
#undef PG8_LDB
#undef PG8_MMA
#undef PG8_WAIT_V
#undef PG8_WAIT_L
#undef PG8_BAR
#undef PG8_SCHED
}
}

constexpr int LDS_MISC_OFF = 131072;
__device__ __forceinline__ float fast_gelu(float x) { const float y = x + 0.044715f * x * x * x; return x * __builtin_amdgcn_rcpf(1.0f + __builtin_amdgcn_exp2f(-2.0f * 0.7978845608028654f * LOG2E * y)); }
__device__ __forceinline__ float fast_sigmoid(float x) { return __builtin_amdgcn_rcpf(1.0f + __builtin_amdgcn_exp2f(-LOG2E * x)); }
__device__ __forceinline__ void unpack8(const u32x4 w, float (&v)[8]) {
#pragma unroll
    for (int e = 0; e < 4; ++e) { v[2 * e] = __uint_as_float(w[e] << 16); v[2 * e + 1] = __uint_as_float(w[e] & 0xffff0000u); } }

struct EpiIn {
    static constexpr bool PERM = true, HAS_MID = false;
    bf16_t *U, *V, *Q, *K, *VA, *G; const float* b_gate;
    __device__ __forceinline__ void mid(f32x4 (&)[2][2][4][2], const pg8::Unit&, int, int, int, int) const {}
    __device__ __forceinline__ void operator()(f32x4 (&acc)[2][2][4][2], const pg8::Unit& u, int wr, int wc, int fr, int fq) const {
        const int pn = u.pn; bf16_t* base; int ld, colt, mode;
        if (pn < 4) { base = U; ld = 1024; colt = pn * 256; mode = 1; }
        else if (pn < 8) { base = V; ld = 1024; colt = (pn - 4) * 256; mode = 1; }
        else if (pn < 12) { base = Q; ld = 1024; colt = (pn - 8) * 256; mode = 0; }
        else if (pn < 16) { base = K; ld = 1024; colt = (pn - 12) * 256; mode = 0; }
        else if (pn < 20) { base = VA; ld = 1024; colt = (pn - 16) * 256; mode = 0; }
        else { base = G; ld = 4096; colt = (pn - 20) * 256; mode = 2; }
        const int row0 = u.pm * 256 + wr * 64 + fr, col0 = colt + wc * 32 + 8 * fq;
        f32x4 bv[2][2];
#pragma unroll
        for (int bj = 0; bj < 2; ++bj)
#pragma unroll
            for (int n = 0; n < 2; ++n) bv[bj][n] = (mode == 2) ? *(const f32x4*)(b_gate + col0 + bj * 128 + 4 * n) : (f32x4){0.f, 0.f, 0.f, 0.f};
#pragma unroll
        for (int ai = 0; ai < 2; ++ai)
#pragma unroll
            for (int m = 0; m < 4; ++m) { bf16_t* rowp = base + (size_t)(row0 + ai * 128 + m * 16) * ld + col0;
#pragma unroll
                for (int bj = 0; bj < 2; ++bj) { f32x4 v0 = acc[ai][bj][m][0], v1 = acc[ai][bj][m][1];
                    if (mode == 1) {
#pragma unroll
                        for (int j = 0; j < 4; ++j) { v0[j] = fast_gelu(v0[j]); v1[j] = fast_gelu(v1[j]); } }
                    else if (mode == 2) { v0 += bv[bj][0]; v1 += bv[bj][1];
#pragma unroll
                        for (int j = 0; j < 4; ++j) { v0[j] = fast_sigmoid(v0[j]); v1[j] = fast_sigmoid(v1[j]); } }
                    u32x4 w; w.x = pg8::cvt_pk_bf16(v0[0], v0[1]); w.y = pg8::cvt_pk_bf16(v0[2], v0[3]); w.z = pg8::cvt_pk_bf16(v1[0], v1[1]); w.w = pg8::cvt_pk_bf16(v1[2], v1[3]);
                    *(u32x4*)(rowp + bj * 128) = w; } }
    }
};
struct EpiProj {
    static constexpr bool PERM = true, HAS_MID = true;
    const bf16_t* G; bf16_t* O;
    __device__ __forceinline__ void mid(f32x4 (&acc)[2][2][4][2], const pg8::Unit& u, int wr, int wc, int fr, int fq) const {
        const int row0 = u.pm * 256 + wr * 64 + fr, col0 = u.pn * 256 + wc * 32 + 8 * fq;
#pragma unroll
        for (int ai = 0; ai < 2; ++ai)
#pragma unroll
            for (int m = 0; m < 4; ++m) { const bf16_t* gp = G + (size_t)(row0 + ai * 128 + m * 16) * 4096 + col0;
#pragma unroll
                for (int bj = 0; bj < 2; ++bj) { float gs[8], gf[8]; unpack8(*(const u32x4*)(gp + bj * 128), gs); unpack8(*(const u32x4*)(gp + 2048 + bj * 128), gf);
#pragma unroll
                    for (int j = 0; j < 4; ++j) { acc[ai][bj][m][0][j] *= gs[j] * __builtin_amdgcn_rcpf(gf[j]); acc[ai][bj][m][1][j] *= gs[4 + j] * __builtin_amdgcn_rcpf(gf[4 + j]); }
                    asm volatile("" : "+v"(acc[ai][bj][m][0]), "+v"(acc[ai][bj][m][1]) :: "memory"); } }
    }
    __device__ __forceinline__ void operator()(f32x4 (&acc)[2][2][4][2], const pg8::Unit& u, int wr, int wc, int fr, int fq) const {
        const int row0 = u.pm * 256 + wr * 64 + fr, col0 = u.pn * 256 + wc * 32 + 8 * fq;
#pragma unroll
        for (int ai = 0; ai < 2; ++ai)
#pragma unroll
            for (int m = 0; m < 4; ++m) { const size_t r = (size_t)(row0 + ai * 128 + m * 16);
#pragma unroll
                for (int bj = 0; bj < 2; ++bj) { float gf[8]; unpack8(*(const u32x4*)(G + r * 4096 + 2048 + col0 + bj * 128), gf);
                    const f32x4 v0 = acc[ai][bj][m][0], v1 = acc[ai][bj][m][1];
                    u32x4 w; w.x = pg8::cvt_pk_bf16(v0[0] * gf[0], v0[1] * gf[1]); w.y = pg8::cvt_pk_bf16(v0[2] * gf[2], v0[3] * gf[3]); w.z = pg8::cvt_pk_bf16(v1[0] * gf[4], v1[1] * gf[5]); w.w = pg8::cvt_pk_bf16(v1[2] * gf[6], v1[3] * gf[7]);
                    *(u32x4*)(O + r * 2048 + col0 + bj * 128) = w; }
                asm volatile("" ::: "memory"); }
    }
};
struct EpiOut {
    static constexpr bool PERM = false, HAS_MID = false;
    const float* X; float* O;
    __device__ __forceinline__ void mid(f32x4 (&)[2][2][4][2], const pg8::Unit&, int, int, int, int) const {}
    __device__ __forceinline__ void operator()(f32x4 (&acc)[2][2][4][2], const pg8::Unit& u, int wr, int wc, int fr, int fq) const {
        const int row0 = u.pm * 256 + wr * 64 + fr, col0 = u.pn * 256 + wc * 32 + 4 * fq;
#pragma unroll
        for (int ai = 0; ai < 2; ++ai)
#pragma unroll
            for (int m = 0; m < 4; ++m) { const size_t off = (size_t)(row0 + ai * 128 + m * 16) * DM + col0;
#pragma unroll
                for (int bj = 0; bj < 2; ++bj)
#pragma unroll
                    for (int n = 0; n < 2; ++n) *(f32x4*)(O + off + bj * 128 + n * 16) = *(const f32x4*)(X + off + bj * 128 + n * 16) + acc[ai][bj][m][n]; }
    }
};
struct EpiGateUp {
    static constexpr bool PERM = true, HAS_MID = false;
    bf16_t* ACT;
    __device__ __forceinline__ void mid(f32x4 (&)[2][2][4][2], const pg8::Unit&, int, int, int, int) const {}
    __device__ __forceinline__ void operator()(f32x4 (&acc)[2][2][4][2], const pg8::Unit& u, int wr, int wc, int fr, int fq) const {
        const int row0 = u.x0 + wr * 64 + fr, col0 = u.pn * 128 + wc * 32 + 8 * fq;
#pragma unroll
        for (int ai = 0; ai < 2; ++ai)
#pragma unroll
            for (int m = 0; m < 4; ++m) { float o[8];
#pragma unroll
                for (int n = 0; n < 2; ++n)
#pragma unroll
                    for (int j = 0; j < 4; ++j) { const float g = acc[ai][0][m][n][j], up = acc[ai][1][m][n][j]; o[4 * n + j] = g * fast_sigmoid(g) * up; }
                u32x4 w; w.x = pg8::cvt_pk_bf16(o[0], o[1]); w.y = pg8::cvt_pk_bf16(o[2], o[3]); w.z = pg8::cvt_pk_bf16(o[4], o[5]); w.w = pg8::cvt_pk_bf16(o[6], o[7]);
                *(u32x4*)(ACT + (size_t)(row0 + ai * 128 + m * 16) * DEXP + col0) = w; }
    }
};
struct EpiDown {
    static constexpr bool PERM = true, HAS_MID = false;
    bf16_t* Y; const float* GATE;
    __device__ __forceinline__ void mid(f32x4 (&)[2][2][4][2], const pg8::Unit&, int, int, int, int) const {}
    __device__ __forceinline__ void operator()(f32x4 (&acc)[2][2][4][2], const pg8::Unit& u, int wr, int wc, int fr, int fq) const {
        const int rl0 = wr * 64 + fr, col0 = u.pn * 256 + wc * 32 + 8 * fq;
#pragma unroll
        for (int ai = 0; ai < 2; ++ai)
#pragma unroll
            for (int m = 0; m < 4; ++m) { const int rl = rl0 + ai * 128 + m * 16; const float gt = GATE[u.x1 + rl];
#pragma unroll
                for (int bj = 0; bj < 2; ++bj) { const f32x4 v0 = acc[ai][bj][m][0] * gt, v1 = acc[ai][bj][m][1] * gt;
                    u32x4 w; w.x = pg8::cvt_pk_bf16(v0[0], v0[1]); w.y = pg8::cvt_pk_bf16(v0[2], v0[3]); w.z = pg8::cvt_pk_bf16(v1[0], v1[1]); w.w = pg8::cvt_pk_bf16(v1[2], v1[3]);
                    *(u32x4*)(Y + (size_t)(u.x0 + rl) * DM + col0 + bj * 128) = w; } }
    }
};
struct MoeOrder {
    const char* Abase; const char* Bbase; size_t Bstride; int K, nN, G, c; bool gather;
    const PG8_LAS int* ps;
    const unsigned* cnt; const int* TOK;
    __device__ bool next(int i, pg8::Unit& u) const {
        const int L = i * G + c; const int ntile = (ps[NEXP] / MTILE) * nN; if (L >= ntile) return false;
        const int mtg = L / nN, pn = L % nN, prow = mtg * MTILE; int e = 0;
        for (int j = 1; j < NEXP; ++j) if (ps[j] <= prow) e = j;
        const int mt = (prow - ps[e]) / MTILE;
        u.pm = mt; u.pn = pn; u.x0 = prow; u.x1 = e * T + mt * MTILE; u.x2 = (int)cnt[e] - mt * MTILE; u.x3 = e;
        u.A = gather ? Abase : Abase + (size_t)prow * K * 2; u.B = Bbase + (size_t)e * Bstride + (size_t)pn * 256 * K * 2; return true;
    }
    __device__ __forceinline__ void rows(const pg8::Unit& u, unsigned (&g)[2][2], const int (&RA)[2]) const {
#pragma unroll
        for (int h = 0; h < 2; ++h)
#pragma unroll
            for (int i = 0; i < 2; ++i) { int r = RA[i] + 128 * h; r = r < u.x2 ? r : u.x2 - 1; g[h][i] = (unsigned)TOK[u.x1 + r] * (unsigned)(K * 2); }
    }
};

__device__ __forceinline__ void transpose_item(const float* src, int ld_src, int k0, int n0src, bf16_t* dst, int ld_dst, int kdst, PG8_LAS float* scr, int lane) {
#pragma unroll 8
    for (int i = 0; i < 32; ++i) { const int kk = 2 * i + (lane >> 5); scr[kk * 33 + (lane & 31)] = src[(size_t)(k0 + kk) * ld_src + n0src + (lane & 31)]; }
    asm volatile("s_waitcnt lgkmcnt(0)" ::: "memory");
    const int c = lane & 7;
#pragma unroll
    for (int j = 0; j < 4; ++j) { const int n = (lane >> 3) + 8 * j; const PG8_LAS float* s = scr + (8 * c) * 33 + n;
        u32x4 o; o.x = pk2(s[0 * 33], s[1 * 33]); o.y = pk2(s[2 * 33], s[3 * 33]); o.z = pk2(s[4 * 33], s[5 * 33]); o.w = pk2(s[6 * 33], s[7 * 33]);
        *(u32x4*)(dst + (size_t)n * ld_dst + kdst + k0 + 8 * c) = o; }
    asm volatile("s_waitcnt lgkmcnt(0)" ::: "memory");
}
__device__ __forceinline__ void p0_weights(const Args& A, PG8_LAS unsigned char* lds) {
    const int tid = threadIdx.x, lane = tid & 63, wave = tid >> 6;
    PG8_LAS float* scr = (PG8_LAS float*)(lds + wave * 16384);
    const int gw = blockIdx.x * NWAVES + wave, NGW = gridDim.x * NWAVES;
    bf16_t* WIN = (bf16_t*)(A.ws + WS_WIN); bf16_t* WPROJ = (bf16_t*)(A.ws + WS_WPROJ); bf16_t* WOUT = (bf16_t*)(A.ws + WS_WOUT); bf16_t* WGU = (bf16_t*)(A.ws + WS_WGU); bf16_t* WD = (bf16_t*)(A.ws + WS_WD);
    constexpr int I0 = 32 * 288, I1 = 16 * 64, I2 = 16 * 64, I3 = 32 * 64, I4 = 32 * 512, I5 = 32 * 512, I6 = 32 * 512;
    constexpr int NITEMS = I0 + I1 + I2 + I3 + I4 + I5 + I6;
    for (int it = gw; it < NITEMS; it += NGW) {
        int r = it;
        if (r < I0) { const int kb = r / 288, nb = r % 288; transpose_item(A.in[2], INCOLS, 64 * kb, 32 * nb + (nb >= 160 ? 8 : 0), WIN + (size_t)(32 * nb) * 2048, 2048, 0, scr, lane); continue; } r -= I0;
        if (r < I1) { const int kb = r / 64, nb = r % 64; transpose_item(A.in[11], DM, 64 * kb, 32 * nb, WPROJ + (size_t)(32 * nb) * 2048, 2048, 0, scr, lane); continue; } r -= I1;
        if (r < I2) { const int kb = r / 64, nb = r % 64; transpose_item(A.in[12], DM, 64 * kb, 32 * nb, WPROJ + (size_t)(32 * nb) * 2048, 2048, 1024, scr, lane); continue; } r -= I2;
        if (r < I3) { const int kb = r / 64, nb = r % 64; transpose_item(A.in[13], DM, 64 * kb, 32 * nb, WOUT + (size_t)(32 * nb) * 2048, 2048, 0, scr, lane); continue; } r -= I3;
        if (r < I4 + I5) { const int up = r >= I4; if (up) r -= I4; const int e = r / 512, q = r % 512, kb = q / 16, nb = q % 16, n = 32 * nb, drow = 256 * (n >> 7) + (n & 127) + (up ? 128 : 0);
            transpose_item(A.in[up ? 20 : 19] + (size_t)e * DM * DEXP, DEXP, 64 * kb, n, WGU + ((size_t)e * 1024 + drow) * 2048, 2048, 0, scr, lane); continue; } r -= I4 + I5;
        { const int e = r / 512, q = r % 512, kb = q / 64, nb = q % 64; transpose_item(A.in[21] + (size_t)e * DEXP * DM, DM, 64 * kb, 32 * nb, WD + ((size_t)e * 2048 + 32 * nb) * 512, 512, 0, scr, lane); }
    }
}

__device__ __forceinline__ void p1_fast(const Args& A, PG8_LAS unsigned char* lds) {
    pg8::DenseOrder S; S.init(A.ws + WS_H, A.ws + WS_WIN, T, 9216, DM, gridDim.x, blockIdx.x);
    EpiIn E{(bf16_t*)(A.ws + WS_U), (bf16_t*)(A.ws + WS_V), (bf16_t*)(A.ws + WS_Q), (bf16_t*)(A.ws + WS_K), (bf16_t*)(A.ws + WS_VA), (bf16_t*)(A.ws + WS_G), A.in[3]};
    pg8::gemm_phase<EpiIn, pg8::DenseOrder, true, false>(lds, DM, S, E);
}
__device__ __forceinline__ void p3_fast(const Args& A, PG8_LAS unsigned char* lds) {
    pg8::DenseOrder S; S.init(A.ws + WS_MIXIN, A.ws + WS_WPROJ, T, DM, 2048, gridDim.x, blockIdx.x);
    EpiProj E{(const bf16_t*)(A.ws + WS_G), (bf16_t*)(A.ws + WS_MIXED)};
    pg8::gemm_phase<EpiProj, pg8::DenseOrder, true, false>(lds, 2048, S, E);
}
__device__ __forceinline__ void p4_fast(const Args& A, PG8_LAS unsigned char* lds) {
    pg8::DenseOrder S; S.init(A.ws + WS_MIXED, A.ws + WS_WOUT, T, DM, DM, gridDim.x, blockIdx.x);
    EpiOut E{A.in[0], A.out};
    pg8::gemm_phase<EpiOut, pg8::DenseOrder, true, false>(lds, DM, S, E);
}
__device__ __forceinline__ void moe_layout_lds(const Args& A, PG8_LAS unsigned char* lds) {
    PG8_LAS int* ps = (PG8_LAS int*)(lds + LDS_MISC_OFF);
    if (threadIdx.x == 0) { const unsigned* cnt = (const unsigned*)(A.ws + WS_CTL) + CW_CNT; int acc = 0;
        for (int e = 0; e < NEXP; ++e) { ps[e] = acc; acc += ((int)cnt[e] + MTILE - 1) / MTILE * MTILE; }
        ps[NEXP] = acc; }
    __syncthreads();
}
__device__ __forceinline__ void p6_fast(const Args& A, PG8_LAS unsigned char* lds) {
    moe_layout_lds(A, lds);
    MoeOrder S{(const char*)(A.ws + WS_H2), (const char*)(A.ws + WS_WGU), (size_t)1024 * 2048 * 2, DM, 4, (int)gridDim.x, (int)blockIdx.x, true,
               (const PG8_LAS int*)(lds + LDS_MISC_OFF), (const unsigned*)(A.ws + WS_CTL) + CW_CNT, (const int*)(A.ws + WS_TOK)};
    EpiGateUp E{(bf16_t*)(A.ws + WS_ACT)};
    pg8::gemm_phase<EpiGateUp, MoeOrder, true, true>(lds, DM, S, E);
}
__device__ __forceinline__ void p7_fast(const Args& A, PG8_LAS unsigned char* lds) {
    moe_layout_lds(A, lds);
    MoeOrder S{(const char*)(A.ws + WS_ACT), (const char*)(A.ws + WS_WD), (size_t)2048 * 512 * 2, DEXP, 8, (int)gridDim.x, (int)blockIdx.x, false,
               (const PG8_LAS int*)(lds + LDS_MISC_OFF), (const unsigned*)(A.ws + WS_CTL) + CW_CNT, (const int*)(A.ws + WS_TOK)};
    EpiDown E{(bf16_t*)(A.ws + WS_YBUF), (const float*)(A.ws + WS_GATE)};
    pg8::gemm_phase<EpiDown, MoeOrder, true, false>(lds, DEXP, S, E);
}

namespace fa {
typedef short bf16x8 __attribute__((ext_vector_type(8)));
typedef short v4i16 __attribute__((ext_vector_type(4)));
typedef float f32x16 __attribute__((ext_vector_type(16)));
#define FA_LAS __attribute__((address_space(3)))
constexpr int KVBUF = 65536, LDS_CK = 131072, LDS_ML = 131072 + 8192;
__device__ __forceinline__ unsigned cvtpk(float lo, float hi) { unsigned r; asm("v_cvt_pk_bf16_f32 %0, %1, %2" : "=v"(r) : "v"(lo), "v"(hi)); return r; }
__device__ __forceinline__ bf16x8 pack8(const f32x16& p, int b) { u32x4 w; w.x = cvtpk(p[b], p[b + 1]); w.y = cvtpk(p[b + 2], p[b + 3]); w.z = cvtpk(p[b + 4], p[b + 5]); w.w = cvtpk(p[b + 6], p[b + 7]); return __builtin_bit_cast(bf16x8, w); }
__device__ __forceinline__ float swapmax(float v) { auto rr = __builtin_amdgcn_permlane32_swap(__float_as_uint(v), __float_as_uint(v), false, false); return fmaxf(__uint_as_float(rr[0]), __uint_as_float(rr[1])); }
__device__ __forceinline__ float swapsum(float v) { auto rr = __builtin_amdgcn_permlane32_swap(__float_as_uint(v), __float_as_uint(v), false, false); return __uint_as_float(rr[0]) + __uint_as_float(rr[1]); }
#define FA_WAITBAR() do { asm volatile("s_waitcnt vmcnt(0) lgkmcnt(0)" ::: "memory"); __builtin_amdgcn_s_barrier(); asm volatile("" ::: "memory"); } while (0)

__device__ __forceinline__ void attn_phase(const Args& A, FA_LAS unsigned char* lds) {
    const bf16_t* Q = (const bf16_t*)(A.ws + WS_Q); const bf16_t* Kt = (const bf16_t*)(A.ws + WS_K); const bf16_t* Vt = (const bf16_t*)(A.ws + WS_VA);
    const float* CKL = (const float*)(A.ws + WS_CKL); bf16_t* MIXIN = (bf16_t*)(A.ws + WS_MIXIN);
    const int tid = threadIdx.x, lane = tid & 63, wid = __builtin_amdgcn_readfirstlane(tid >> 6), rg = wid & 3, kh = wid >> 2, r32 = lane & 31, hi = lane >> 5;
    int koff[4];
#pragma unroll
    for (int i = 0; i < 4; ++i) { const int rl = 4 * i + (lane >> 4); koff[i] = rl * 1024 + (((lane & 15) ^ rl) * 8); }
    const int voff = (lane >> 4) * 1024 + (((lane & 15) ^ ((lane >> 4) << 2)) * 8);
    int kfo[8];
#pragma unroll
    for (int d0 = 0; d0 < 8; ++d0) kfo[d0] = (kh * 64 + r32) * 256 + (((2 * d0 + hi) ^ (r32 & 15)) * 16);
    int vfo[4];
    { const int dh = (lane >> 4) & 1, q = (lane & 15) >> 2, p = lane & 3;
#pragma unroll
      for (int db = 0; db < 4; ++db) vfo[db] = 32768 + (kh * 64 + 4 * hi + q) * 256 + ((db ^ q) * 64) + dh * 32 + p * 8; }
    const int G = gridDim.x;
    for (int vb = blockIdx.x; vb < 256; vb += G) {
        const int item = (G % 8 == 0) ? ((vb % 8) * 32 + (vb / 8)) % 256 : vb;
        const int bh = item >> 3, ii = item & 7, b = bh >> 3, h = bh & 7;
        const bf16_t* Kg = Kt + (size_t)b * SEQ * 1024 + h * 128; const bf16_t* Vg = Vt + (size_t)b * SEQ * 1024 + h * 128;
        { const f32x4 c = *(const f32x4*)(CKL + (size_t)bh * SEQ + tid * 4); *(FA_LAS f32x4*)(lds + LDS_CK + tid * 16) = (f32x4){-c.x, -c.y, -c.z, -c.w}; }
#define FA_ISSUE(key0, bufoff) do { const bf16_t* kg_ = Kg + (size_t)((key0) + 16 * wid) * 1024; const bf16_t* vg_ = Vg + (size_t)((key0) + 16 * wid) * 1024; \
        _Pragma("unroll") for (int i_ = 0; i_ < 4; ++i_) { \
            __builtin_amdgcn_global_load_lds((const unsigned*)(kg_ + koff[i_]), (FA_LAS unsigned*)(lds + (bufoff) + (wid * 4 + i_) * 1024), 16, 0, 0); \
            __builtin_amdgcn_global_load_lds((const unsigned*)(vg_ + i_ * 4096 + voff), (FA_LAS unsigned*)(lds + (bufoff) + 32768 + (wid * 4 + i_) * 1024), 16, 0, 0); } } while (0)
        int u = 0, qb = ii, kb = 0, cur = 0;
        FA_ISSUE(0, 0);
        bf16x8 qf[8]; f32x16 o[4]; float m = -1e30f, l = 0.f;
        { const bf16_t* qp = Q + (size_t)(b * SEQ + qb * 128 + rg * 32 + r32) * 1024 + h * 128 + 8 * hi;
#pragma unroll
          for (int d0 = 0; d0 < 8; ++d0) qf[d0] = *(const bf16x8*)(qp + 16 * d0); }
#pragma unroll
        for (int db = 0; db < 4; ++db)
#pragma unroll
            for (int r = 0; r < 16; ++r) o[db][r] = 0.f;
        FA_WAITBAR();
        for (;;) {
            const bool lastb = (kb == qb); const bool more = !(lastb && u == 1);
            const int nkb = lastb ? 0 : kb + 1;
            if (more) FA_ISSUE(nkb * 128, (cur ^ 1) * KVBUF);
            {
                FA_LAS const unsigned char* buf = lds + cur * KVBUF;
                FA_LAS const float* nck = (FA_LAS const float*)(lds + LDS_CK) + kb * 128 + kh * 64 + 4 * hi;
                f32x16 p0, p1;
#pragma unroll
                for (int g = 0; g < 4; ++g) { const f32x4 t0 = *(FA_LAS const f32x4*)(nck + 8 * g), t1 = *(FA_LAS const f32x4*)(nck + 32 + 8 * g);
#pragma unroll
                    for (int j = 0; j < 4; ++j) { p0[4 * g + j] = t0[j]; p1[4 * g + j] = t1[j]; } }
#pragma unroll
                for (int d0 = 0; d0 < 8; ++d0) { const bf16x8 ka = *(FA_LAS const bf16x8*)(buf + kfo[d0]), kc = *(FA_LAS const bf16x8*)(buf + kfo[d0] + 8192);
                    p0 = __builtin_amdgcn_mfma_f32_32x32x16_bf16(ka, qf[d0], p0, 0, 0, 0); p1 = __builtin_amdgcn_mfma_f32_32x32x16_bf16(kc, qf[d0], p1, 0, 0, 0); }
                if (lastb) { const int qrel = rg * 32 + r32, k0 = kh * 64 + 4 * hi;
#pragma unroll
                    for (int r = 0; r < 16; ++r) { const int kr = k0 + (r & 3) + 8 * (r >> 2); if (kr > qrel) p0[r] = -INFINITY; if (kr + 32 > qrel) p1[r] = -INFINITY; } }
                float mx = fmaxf(p0[0], p1[0]);
#pragma unroll
                for (int r = 1; r < 16; ++r) mx = fmaxf(mx, fmaxf(p0[r], p1[r]));
                mx = swapmax(mx);
                const float mn = fmaxf(m, mx), alpha = __builtin_amdgcn_exp2f(m - mn); m = mn;
                float ps = 0.f;
#pragma unroll
                for (int r = 0; r < 16; ++r) { p0[r] = __builtin_amdgcn_exp2f(p0[r] - mn); p1[r] = __builtin_amdgcn_exp2f(p1[r] - mn); ps += p0[r] + p1[r]; }
                l = l * alpha + ps;
                if (!__all(alpha == 1.0f)) {
#pragma unroll
                    for (int db = 0; db < 4; ++db)
#pragma unroll
                        for (int r = 0; r < 16; ++r) o[db][r] *= alpha; }
                bf16x8 pf[4]; pf[0] = pack8(p0, 0); pf[1] = pack8(p0, 8); pf[2] = pack8(p1, 0); pf[3] = pack8(p1, 8);
#pragma unroll
                for (int db = 0; db < 4; ++db)
#pragma unroll
                    for (int s = 0; s < 4; ++s) {
                        const v4i16 lo = __builtin_amdgcn_ds_read_tr16_b64_v4i16((FA_LAS v4i16*)(buf + vfo[db] + s * 4096));
                        const v4i16 hh = __builtin_amdgcn_ds_read_tr16_b64_v4i16((FA_LAS v4i16*)(buf + vfo[db] + s * 4096 + 2048));
                        const bf16x8 vf = (bf16x8){lo[0], lo[1], lo[2], lo[3], hh[0], hh[1], hh[2], hh[3]};
                        o[db] = __builtin_amdgcn_mfma_f32_32x32x16_bf16(vf, pf[s], o[db], 0, 0, 0); }
            }
            FA_WAITBAR();
            if (lastb) {
                FA_LAS float* mb = (FA_LAS float*)(lds + cur * KVBUF) + rg * 4096; FA_LAS float* ml = (FA_LAS float*)(lds + LDS_ML) + rg * 128;
                const float lt = swapsum(l);
                if (kh == 1) {
#pragma unroll
                    for (int db = 0; db < 4; ++db)
#pragma unroll
                        for (int r = 0; r < 16; ++r) mb[(db * 16 + r) * 64 + lane] = o[db][r];
                    ml[lane] = m; ml[64 + lane] = lt; }
                FA_WAITBAR();
                if (kh == 0) {
                    const float m2 = ml[lane], l2 = ml[64 + lane], mm = fmaxf(m, m2), a1 = __builtin_amdgcn_exp2f(m - mm), a2 = __builtin_amdgcn_exp2f(m2 - mm);
                    const float inv = 1.0f / (lt * a1 + l2 * a2), s1 = a1 * inv, s2 = a2 * inv;
                    bf16_t* op = MIXIN + (size_t)(b * SEQ + qb * 128 + rg * 32 + r32) * 2048 + 1024 + h * 128 + 4 * hi;
#pragma unroll
                    for (int db = 0; db < 4; ++db)
#pragma unroll
                        for (int g = 0; g < 4; ++g) { float v[4];
#pragma unroll
                            for (int j = 0; j < 4; ++j) v[j] = o[db][4 * g + j] * s1 + mb[(db * 16 + 4 * g + j) * 64 + lane] * s2;
                            u32x2 w; w.x = cvtpk(v[0], v[1]); w.y = cvtpk(v[2], v[3]); *(u32x2*)(op + 32 * db + 8 * g) = w; } }
                FA_WAITBAR();
                if (u == 1) break;
                u = 1; qb = 15 - ii;
                { const bf16_t* qp = Q + (size_t)(b * SEQ + qb * 128 + rg * 32 + r32) * 1024 + h * 128 + 8 * hi;
#pragma unroll
                  for (int d0 = 0; d0 < 8; ++d0) qf[d0] = *(const bf16x8*)(qp + 16 * d0); }
#pragma unroll
                for (int db = 0; db < 4; ++db)
#pragma unroll
                    for (int r = 0; r < 16; ++r) o[db][r] = 0.f;
                m = -1e30f; l = 0.f;
            }
            cur ^= 1; kb = nkb;
        }
#undef FA_ISSUE
    }
}
}

namespace fs {
#define FS_LAS __attribute__((address_space(3)))
__device__ __forceinline__ void sgu_phase(const Args& A, FS_LAS unsigned char* lds) {
    const bf16_t* U = (const bf16_t*)(A.ws + WS_U); const bf16_t* V = (const bf16_t*)(A.ws + WS_V); bf16_t* MIXIN = (bf16_t*)(A.ws + WS_MIXIN);
    const float* wsp = A.in[7]; const float* bsp = A.in[8];
    const int tid = threadIdx.x, lane = tid & 63, wid = __builtin_amdgcn_readfirstlane(tid >> 6), tb = wid & 3, dh = wid >> 2, r32 = lane & 31, hi = lane >> 5;
    const int frow = tid >> 2, fq4 = tid & 3;
    int vfo[2];
    { const int d16 = (lane >> 4) & 1, q = (lane & 15) >> 2, p = lane & 3;
#pragma unroll
      for (int j = 0; j < 2; ++j) vfo[j] = 32768 + (8 * hi + q) * 256 + (((2 * dh + j) ^ q) * 64) + d16 * 32 + p * 8; }
    const int wfo = (32 * tb + r32) * 256;
    for (int u = blockIdx.x; u < (T / CHUNK) * NG; u += gridDim.x) {
        const int rc = u / NG, g = u % NG, row0 = rc * CHUNK;
        { const float* wr = wsp + ((size_t)g * CHUNK + frow) * CHUNK + fq4 * 32;
#pragma unroll
          for (int c = 0; c < 4; ++c) { const f32x4 a = *(const f32x4*)(wr + 8 * c), b2 = *(const f32x4*)(wr + 8 * c + 4); const int s0 = fq4 * 32 + 8 * c; float v[8] = {a.x, a.y, a.z, a.w, b2.x, b2.y, b2.z, b2.w};
#pragma unroll
              for (int j = 0; j < 8; ++j) if (s0 + j > frow) v[j] = 0.f;
              u32x4 w; w.x = pk2(v[0], v[1]); w.y = pk2(v[2], v[3]); w.z = pk2(v[4], v[5]); w.w = pk2(v[6], v[7]);
              *(FS_LAS u32x4*)(lds + frow * 256 + (((4 * fq4 + c) ^ (frow & 15)) * 16)) = w; }
          const bf16_t* vr = V + (size_t)(row0 + frow) * 1024 + g * 128 + fq4 * 32;
#pragma unroll
          for (int c = 0; c < 4; ++c) { const u32x4 w = *(const u32x4*)(vr + 8 * c); *(FS_LAS u32x4*)(lds + 32768 + frow * 256 + (((4 * fq4 + c) ^ ((frow & 3) << 2)) * 16)) = w; } }
        __syncthreads();
        fa::f32x16 acc[2];
#pragma unroll
        for (int j = 0; j < 2; ++j)
#pragma unroll
            for (int r = 0; r < 16; ++r) acc[j][r] = 0.f;
        for (int s = 0; s <= 2 * tb + 1; ++s) {
            const fa::bf16x8 wf = *(FS_LAS const fa::bf16x8*)(lds + wfo + (((2 * s + hi) ^ (r32 & 15)) * 16));
#pragma unroll
            for (int j = 0; j < 2; ++j) {
                const fa::v4i16 lo = __builtin_amdgcn_ds_read_tr16_b64_v4i16((FS_LAS fa::v4i16*)(lds + vfo[j] + s * 4096));
                const fa::v4i16 hh = __builtin_amdgcn_ds_read_tr16_b64_v4i16((FS_LAS fa::v4i16*)(lds + vfo[j] + s * 4096 + 1024));
                const fa::bf16x8 vf = (fa::bf16x8){lo[0], lo[1], lo[2], lo[3], hh[0], hh[1], hh[2], hh[3]};
                acc[j] = __builtin_amdgcn_mfma_f32_32x32x16_bf16(vf, wf, acc[j], 0, 0, 0); }
        }
        { const int tt = 32 * tb + r32; const float bb = bsp[g * CHUNK + tt]; const size_t rw = (size_t)(row0 + tt);
#pragma unroll
          for (int j = 0; j < 2; ++j)
#pragma unroll
              for (int g4 = 0; g4 < 4; ++g4) { const int d = 32 * (2 * dh + j) + 8 * g4 + 4 * hi; const u32x2 uu = *(const u32x2*)(U + rw * 1024 + g * 128 + d);
                  const float u0 = __uint_as_float(uu.x << 16), u1 = __uint_as_float(uu.x & 0xffff0000u), u2 = __uint_as_float(uu.y << 16), u3 = __uint_as_float(uu.y & 0xffff0000u);
                  u32x2 w; w.x = fa::cvtpk(u0 * (acc[j][4 * g4] + bb), u1 * (acc[j][4 * g4 + 1] + bb)); w.y = fa::cvtpk(u2 * (acc[j][4 * g4 + 2] + bb), u3 * (acc[j][4 * g4 + 3] + bb));
                  *(u32x2*)(MIXIN + rw * 2048 + g * 128 + d) = w; } }
        __syncthreads();
    }
}
}

constexpr bool FAST_P1 = true, FAST_P3 = true, FAST_P4 = true, FAST_P6 = true, FAST_P7 = true;
constexpr bool FAST_ATTN = true, FAST_SGU = true;
constexpr bool FAST_ANY = FAST_P1 || FAST_P3 || FAST_P4 || FAST_P6 || FAST_P7;
constexpr int N_PHASES = 10;
__global__ void __launch_bounds__(NTHREADS, 2) fwd(Args A) {
    extern __shared__ __attribute__((aligned(16))) unsigned char lds[];
    float* ldsf = (float*)lds;
    cg::grid_group grid = cg::this_grid();
    const int lo = A.ph_lo, hi = A.ph_hi;
#define IN(k) (lo <= (k) && (k) < hi)
#define SEAM(k) do { if (IN(k) && IN((k) + 1)) grid.sync(); } while (0)
    PG8_LAS unsigned char* l3 = (PG8_LAS unsigned char*)lds;
    if (IN(0)) { if (FAST_ANY) { p0_weights(A, l3); __syncthreads(); } p0_rows(A, ldsf); } SEAM(0);
    if (IN(1)) { if (FAST_P1) p1_fast(A, l3); else p1_naive(A, ldsf); } SEAM(1);
    if (IN(2)) { p1b_fix(A, ldsf); } SEAM(2);
    if (IN(3)) { if (FAST_SGU) fs::sgu_phase(A, l3); else p2_sgu_naive(A); if (FAST_ATTN) { __syncthreads(); fa::attn_phase(A, l3); } else p2_attn_naive(A, ldsf); } SEAM(3);
    if (IN(4)) { if (FAST_P3) p3_fast(A, l3); else p3_naive(A, ldsf); } SEAM(4);
    if (IN(5)) { if (FAST_P4) p4_fast(A, l3); else p4_naive(A, ldsf); } SEAM(5);
    if (IN(6)) { p5_router(A, ldsf); } SEAM(6);
    if (IN(7)) { if (FAST_P6) p6_fast(A, l3); else p6_naive(A, ldsf); } SEAM(7);
    if (IN(8)) { if (FAST_P7) p7_fast(A, l3); else p7_naive(A, ldsf); } SEAM(8);
    if (IN(9)) { p8_combine(A, ldsf); }
#undef IN
#undef SEAM
}

#ifndef MK_N_LAUNCHES
#define MK_N_LAUNCHES 1
#endif
extern "C" void kernel_launch(void* const* d_in, const int* in_sizes, int n_in, void* d_out, int out_size, void* d_ws, size_t ws_size, hipStream_t stream) {
    static int grid = 0;
    if (grid == 0) {
        if (n_in != 22 || out_size != T * DM || ws_size < WS_END) { fprintf(stderr, "kernel_launch: unexpected shapes (n_in %d out %d ws %zu)\n", n_in, out_size, ws_size); grid = -1; return; }
        int dev = 0, cus = 0, per_cu = 0;
        hipGetDevice(&dev); hipDeviceGetAttribute(&cus, hipDeviceAttributeMultiprocessorCount, dev);
        hipFuncSetAttribute((const void*)fwd, hipFuncAttributeMaxDynamicSharedMemorySize, LDS_BYTES);
        hipOccupancyMaxActiveBlocksPerMultiprocessor(&per_cu, (const void*)fwd, NTHREADS, LDS_BYTES);
        if (per_cu < 1) { fprintf(stderr, "kernel_launch: occupancy query says %d blocks per CU\n", per_cu); per_cu = 1; }
        (void)hipGetLastError();
        grid = cus;
    }
    if (grid < 0) return;
    Args a{};
    for (int i = 0; i < 22; ++i) a.in[i] = (const float*)d_in[i];
    a.out = (float*)d_out; a.ws = (unsigned char*)d_ws;
    if (MK_N_LAUNCHES == 1) {
        a.ph_lo = 0; a.ph_hi = N_PHASES;
        void* args[] = {&a};
        hipError_t e = hipLaunchCooperativeKernel((const void*)fwd, dim3(grid), dim3(NTHREADS), args, LDS_BYTES, stream);
        if (e != hipSuccess) fprintf(stderr, "cooperative launch failed: %s (grid %d)\n", hipGetErrorString(e), grid);
    } else {
        for (int p = 0; p < N_PHASES; ++p) { a.ph_lo = p; a.ph_hi = p + 1; hipLaunchKernelGGL(fwd, dim3(grid), dim3(NTHREADS), LDS_BYTES, stream, a); }
    }
}
```

```cpp
#include <hip/hip_runtime.h>
#include <hip/hip_cooperative_groups.h>
#include <cstdio>
#include <cstdint>
namespace cg = cooperative_groups;

constexpr int T = 8192, SEQ = 2048, NB = 4, DM = 2048, SGUW = 1024, FOXW = 1024, NH = 8, HD = 128, CHUNK = 128, NG = 8;
constexpr int INCOLS = 9224, OFF_F = 5120, OFF_GATE = 5128;
constexpr int NEXP = 32, EPG = 8, NGRP = 4, DEXP = 512;
constexpr float EPS = 1e-6f;
constexpr float LOG2E = 1.4426950408889634f;
constexpr float QSCALE = 0.08838834764831845f * LOG2E;
constexpr int NTHREADS = 512, NWAVES = 8;
constexpr int LDS_BYTES = 160 * 1024;
constexpr int MTILE = 256;
constexpr int PMAX = 2 * T + NEXP * MTILE;

typedef unsigned short bf16_t;
typedef float f32x4 __attribute__((ext_vector_type(4)));
typedef unsigned u32x4 __attribute__((ext_vector_type(4)));
typedef unsigned u32x2 __attribute__((ext_vector_type(2)));

constexpr size_t MiB = 1u << 20;
constexpr size_t WS_CTL = 0;
constexpr size_t WS_LOGF = 1 * MiB;
constexpr size_t WS_CKL = 2 * MiB;
constexpr size_t WS_TOK = 3 * MiB;
constexpr size_t WS_GATE = 4 * MiB;
constexpr size_t WS_ASG = 5 * MiB;
constexpr size_t WS_WIN = 8 * MiB;
constexpr size_t WS_WPROJ = 44 * MiB;
constexpr size_t WS_WOUT = 52 * MiB;
constexpr size_t WS_WGU = 60 * MiB;
constexpr size_t WS_WD = 188 * MiB;
constexpr size_t WS_H = 252 * MiB;
constexpr size_t WS_MIXED = WS_H;
constexpr size_t WS_U = 284 * MiB;
constexpr size_t WS_V = 300 * MiB;
constexpr size_t WS_G = 316 * MiB;
constexpr size_t WS_YBUF = WS_U;
constexpr size_t WS_Q = 380 * MiB;
constexpr size_t WS_K = 396 * MiB;
constexpr size_t WS_VA = 412 * MiB;
constexpr size_t WS_ACT = WS_Q;
constexpr size_t WS_MIXIN = 428 * MiB;
constexpr size_t WS_H2 = WS_MIXIN;
constexpr size_t WS_END = 460 * MiB;
static_assert((size_t)PMAX * 2048 * 2 <= 96 * MiB && (size_t)PMAX * 512 * 2 <= 32 * MiB, "overlay sizes");

constexpr int CW_CNT = 0;

__device__ __forceinline__ float bf2f(bf16_t v) { return __uint_as_float((unsigned)v << 16); }
__device__ __forceinline__ bf16_t f2bf(float f) { unsigned u = __float_as_uint(f); return (bf16_t)((u + 0x7fffu + ((u >> 16) & 1u)) >> 16); }
__device__ __forceinline__ unsigned pk2(float lo, float hi) { return (unsigned)f2bf(lo) | ((unsigned)f2bf(hi) << 16); }
__device__ __forceinline__ float wave_sum(float v) {
#pragma unroll
    for (int o = 1; o < 64; o <<= 1) v += __shfl_xor(v, o);
    return v;
}
__device__ __forceinline__ float wave_max(float v) {
#pragma unroll
    for (int o = 1; o < 64; o <<= 1) v = fmaxf(v, __shfl_xor(v, o));
    return v;
}
__device__ __forceinline__ float gelu_tanh(float x) {
    const float c = 0.7978845608028654f; const float y = c * (x + 0.044715f * x * x * x);
    return x / (1.0f + __expf(-2.0f * y));
}
__device__ __forceinline__ float sigmoidf_(float x) { return 1.0f / (1.0f + __expf(-x)); }
__device__ __forceinline__ float log_sigmoid(float z) { return fminf(z, 0.f) - log1pf(__expf(-fabsf(z))); }

struct Args {
    const float* in[22];
    float* out;
    unsigned char* ws;
    int ph_lo, ph_hi;
};

template <class AF, class BF, class EF>
__device__ __forceinline__ void naive_gemm_tile(float* lds, int m0, int n0, int M, int N, int K, int Ksplit, AF a, BF b, EF epi) {
    float* As = lds;
    float* Bs = lds + 16 * 132;
    const int tid = threadIdx.x, ty = tid >> 4, tx = tid & 15;
    float acc[4][8], acc1[4][8];
#pragma unroll
    for (int i = 0; i < 4; ++i)
#pragma unroll
        for (int j = 0; j < 8; ++j) { acc[i][j] = 0.f; acc1[i][j] = 0.f; }
    const bool split = Ksplit < K;
#pragma unroll 1
    for (int pass = 0; pass < 2; ++pass) {
        const int kb = pass == 0 ? 0 : Ksplit, ke = pass == 0 ? (split ? Ksplit : K) : K;
        if (pass == 1) {
            if (!split) break;
#pragma unroll
            for (int i = 0; i < 4; ++i)
#pragma unroll
                for (int j = 0; j < 8; ++j) { acc1[i][j] = acc[i][j]; acc[i][j] = 0.f; }
        }
#pragma unroll 1
        for (int k0 = kb; k0 < ke; k0 += 16) {
#pragma unroll
            for (int i = 0; i < 4; ++i) { const int idx = tid + i * 512, r = idx >> 4, kk = idx & 15; const int m = m0 + r; As[kk * 132 + r] = (m < M) ? a(m, k0 + kk) : 0.f; }
#pragma unroll
            for (int i = 0; i < 4; ++i) { const int idx = tid + i * 512, kk = idx >> 7, n = idx & 127; Bs[kk * 132 + n] = (n0 + n < N) ? b(k0 + kk, n0 + n) : 0.f; }
            __syncthreads();
#pragma unroll 4
            for (int kk = 0; kk < 16; ++kk) {
                float av[4], bv[8];
#pragma unroll
                for (int i = 0; i < 4; ++i) av[i] = As[kk * 132 + ty * 4 + i];
#pragma unroll
                for (int j = 0; j < 8; ++j) bv[j] = Bs[kk * 132 + tx * 8 + j];
#pragma unroll
                for (int i = 0; i < 4; ++i)
#pragma unroll
                    for (int j = 0; j < 8; ++j) acc[i][j] = fmaf(av[i], bv[j], acc[i][j]);
            }
            __syncthreads();
        }
    }
#pragma unroll
    for (int i = 0; i < 4; ++i)
#pragma unroll
        for (int j = 0; j < 8; ++j) { const int m = m0 + ty * 4 + i, n = n0 + tx * 8 + j; if (m < M && n < N) epi(m, n, split ? acc1[i][j] : acc[i][j], split ? acc[i][j] : 0.f); }
}
template <class AF, class BF, class EF>
__device__ __forceinline__ void naive_gemm(float* lds, int M, int N, int K, int Ksplit, AF a, BF b, EF epi) {
    const int ntm = (M + 127) / 128, ntn = (N + 127) / 128;
    for (int t = blockIdx.x; t < ntm * ntn; t += gridDim.x) naive_gemm_tile(lds, (t / ntn) * 128, (t % ntn) * 128, M, N, K, Ksplit, a, b, epi);
}

__device__ __forceinline__ void p0_rows(const Args& A, float* ldsf) {
    const float* x = A.in[0]; const float* g1 = A.in[1]; const float* w_in = A.in[2]; const float* b_forget = A.in[4];
    bf16_t* H = (bf16_t*)(A.ws + WS_H); float* LOGF = (float*)(A.ws + WS_LOGF);
    const int tid = threadIdx.x, lane = tid & 63, wave = tid >> 6;
    for (int i = tid; i < DM * 8; i += NTHREADS) ldsf[i] = w_in[(size_t)(i >> 3) * INCOLS + OFF_F + (i & 7)];
    __syncthreads();
    const int gw = blockIdx.x * NWAVES + wave, NGW = gridDim.x * NWAVES;
    for (int row = gw; row < T; row += NGW) {
        const f32x4* xr = (const f32x4*)(x + (size_t)row * DM) + lane;
        float ss = 0.f;
#pragma unroll
        for (int j = 0; j < 8; ++j) { const f32x4 v = xr[64 * j]; ss += v.x * v.x + v.y * v.y + v.z * v.z + v.w * v.w; }
        const float rstd = rsqrtf(wave_sum(ss) * (1.f / DM) + EPS);
        float f[8];
#pragma unroll
        for (int h = 0; h < 8; ++h) f[h] = 0.f;
#pragma unroll 1
        for (int j = 0; j < 8; ++j) {
            const int c0 = 256 * j + 4 * lane; const f32x4 g = *(const f32x4*)(g1 + c0); const f32x4 xv = xr[64 * j];
            f32x4 hv; hv.x = xv.x * rstd * g.x; hv.y = xv.y * rstd * g.y; hv.z = xv.z * rstd * g.z; hv.w = xv.w * rstd * g.w;
            u32x2 o; o.x = pk2(hv.x, hv.y); o.y = pk2(hv.z, hv.w);
            *(u32x2*)(H + (size_t)row * DM + c0) = o;
#pragma unroll
            for (int e = 0; e < 4; ++e) { const float hx = hv[e]; const float* wf = ldsf + (c0 + e) * 8;
#pragma unroll
                for (int h = 0; h < 8; ++h) f[h] = fmaf(hx, wf[h], f[h]); }
        }
#pragma unroll
        for (int h = 0; h < 8; ++h) f[h] = wave_sum(f[h]);
        if (lane < 8) { float z = 0.f;
#pragma unroll
            for (int h = 0; h < 8; ++h) if (lane == h) z = f[h];
            LOGF[(size_t)row * 8 + lane] = log_sigmoid(z + b_forget[lane]); }
    }
}

__device__ __forceinline__ void p1_naive(const Args& A, float* ldsf) {
    const bf16_t* H = (const bf16_t*)(A.ws + WS_H); const float* w_in = A.in[2]; const float* b_gate = A.in[3];
    bf16_t* U = (bf16_t*)(A.ws + WS_U); bf16_t* V = (bf16_t*)(A.ws + WS_V); bf16_t* Q = (bf16_t*)(A.ws + WS_Q); bf16_t* K = (bf16_t*)(A.ws + WS_K);
    bf16_t* VA = (bf16_t*)(A.ws + WS_VA); bf16_t* G = (bf16_t*)(A.ws + WS_G);
    naive_gemm(ldsf, T, 9216, DM, DM,
        [=](int m, int k) { return bf2f(H[(size_t)m * DM + k]); },
        [=](int k, int n) { const int c = n < 5120 ? n : n + 8; return w_in[(size_t)k * INCOLS + c]; },
        [=](int m, int n, float s, float) {
            if (n < 1024) U[(size_t)m * 1024 + n] = f2bf(gelu_tanh(s));
            else if (n < 2048) V[(size_t)m * 1024 + n - 1024] = f2bf(gelu_tanh(s));
            else if (n < 3072) Q[(size_t)m * 1024 + n - 2048] = f2bf(s);
            else if (n < 4096) K[(size_t)m * 1024 + n - 3072] = f2bf(s);
            else if (n < 5120) VA[(size_t)m * 1024 + n - 4096] = f2bf(s);
            else G[(size_t)m * 4096 + n - 5120] = f2bf(sigmoidf_(s + b_gate[n - 5120]));
        });
}

__device__ __forceinline__ void p1b_fix(const Args& A, float* ldsf) {
    bf16_t* V = (bf16_t*)(A.ws + WS_V); bf16_t* Q = (bf16_t*)(A.ws + WS_Q); bf16_t* K = (bf16_t*)(A.ws + WS_K);
    const float* ln_g = A.in[5]; const float* ln_b = A.in[6]; const float* qg = A.in[9]; const float* kg = A.in[10];
    const int tid = threadIdx.x, lane = tid & 63, wave = tid >> 6;
    const int gw = blockIdx.x * NWAVES + wave, NGW = gridDim.x * NWAVES;
    for (int row = gw; row < T; row += NGW) {
        {
            bf16_t* vr = V + (size_t)row * 1024; float v[16]; float s = 0.f;
#pragma unroll
            for (int j = 0; j < 2; ++j) { const u32x4 w = *(const u32x4*)(vr + 512 * j + 8 * lane);
#pragma unroll
                for (int e = 0; e < 4; ++e) { v[8 * j + 2 * e] = __uint_as_float(w[e] << 16); v[8 * j + 2 * e + 1] = __uint_as_float(w[e] & 0xffff0000u); } }
#pragma unroll
            for (int i = 0; i < 16; ++i) s += v[i];
            const float mean = wave_sum(s) * (1.f / 1024.f); float q = 0.f;
#pragma unroll
            for (int i = 0; i < 16; ++i) { v[i] -= mean; q += v[i] * v[i]; }
            const float rstd = rsqrtf(wave_sum(q) * (1.f / 1024.f) + EPS);
#pragma unroll
            for (int j = 0; j < 2; ++j) { const int c0 = 512 * j + 8 * lane; u32x4 o;
#pragma unroll
                for (int e = 0; e < 4; ++e) o[e] = pk2(v[8 * j + 2 * e] * rstd * ln_g[c0 + 2 * e] + ln_b[c0 + 2 * e], v[8 * j + 2 * e + 1] * rstd * ln_g[c0 + 2 * e + 1] + ln_b[c0 + 2 * e + 1]);
                *(u32x4*)(vr + c0) = o; }
        }
#pragma unroll
        for (int which = 0; which < 2; ++which) {
            bf16_t* pr = (which == 0 ? Q : K) + (size_t)row * 1024 + 16 * lane; const float* gg = which == 0 ? qg : kg; float v[16]; float s = 0.f;
#pragma unroll
            for (int j = 0; j < 2; ++j) { const u32x4 w = *(const u32x4*)(pr + 8 * j);
#pragma unroll
                for (int e = 0; e < 4; ++e) { v[8 * j + 2 * e] = __uint_as_float(w[e] << 16); v[8 * j + 2 * e + 1] = __uint_as_float(w[e] & 0xffff0000u); } }
#pragma unroll
            for (int i = 0; i < 16; ++i) s += v[i] * v[i];
            s += __shfl_xor(s, 1); s += __shfl_xor(s, 2); s += __shfl_xor(s, 4);
            const float sc = rsqrtf(s * (1.f / 128.f) + EPS) * (which == 0 ? QSCALE : 1.f); const int d0 = (16 * lane) & 127;
#pragma unroll
            for (int j = 0; j < 2; ++j) { u32x4 o;
#pragma unroll
                for (int e = 0; e < 4; ++e) o[e] = pk2(v[8 * j + 2 * e] * sc * gg[d0 + 8 * j + 2 * e], v[8 * j + 2 * e + 1] * sc * gg[d0 + 8 * j + 2 * e + 1]);
                *(u32x4*)(pr + 8 * j) = o; }
        }
    }
    if (blockIdx.x < NB * NH) {
        const int b = blockIdx.x / NH, h = blockIdx.x % NH; const float* LOGF = (const float*)(A.ws + WS_LOGF); float* CKL = (float*)(A.ws + WS_CKL) + (size_t)blockIdx.x * SEQ;
        float v[4]; float s = 0.f;
#pragma unroll
        for (int i = 0; i < 4; ++i) { v[i] = LOGF[(size_t)(b * SEQ + tid * 4 + i) * 8 + h]; s += v[i]; }
        float incl = s;
#pragma unroll
        for (int o = 1; o < 64; o <<= 1) { const float t = __shfl_up(incl, o); if (lane >= o) incl += t; }
        __syncthreads();
        if (lane == 63) ldsf[wave] = incl;
        __syncthreads();
        float base = 0.f;
        for (int w = 0; w < wave; ++w) base += ldsf[w];
        float run = base + incl - s;
#pragma unroll
        for (int i = 0; i < 4; ++i) { run += v[i]; CKL[tid * 4 + i] = run * LOG2E; }
        __syncthreads();
    }
}

__device__ __forceinline__ void p2_sgu_naive(const Args& A) {
    const bf16_t* U = (const bf16_t*)(A.ws + WS_U); const bf16_t* V = (const bf16_t*)(A.ws + WS_V); bf16_t* MIXIN = (bf16_t*)(A.ws + WS_MIXIN);
    const float* wsp = A.in[7]; const float* bsp = A.in[8];
    const int tid = threadIdx.x, tt = tid >> 2, dp = tid & 3;
    for (int u = blockIdx.x; u < (T / CHUNK) * NG; u += gridDim.x) {
        const int rc = u / NG, g = u % NG; const int row0 = rc * CHUNK;
        float acc[32];
#pragma unroll
        for (int i = 0; i < 32; ++i) acc[i] = 0.f;
        for (int ss = 0; ss <= tt; ++ss) {
            const float w = wsp[((size_t)g * CHUNK + tt) * CHUNK + ss];
            const bf16_t* vr = V + (size_t)(row0 + ss) * 1024 + g * 128 + dp * 32;
#pragma unroll
            for (int i = 0; i < 32; ++i) acc[i] = fmaf(w, bf2f(vr[i]), acc[i]);
        }
        const float bb = bsp[g * CHUNK + tt];
        const bf16_t* ur = U + (size_t)(row0 + tt) * 1024 + g * 128 + dp * 32; bf16_t* orow = MIXIN + (size_t)(row0 + tt) * 2048 + g * 128 + dp * 32;
#pragma unroll
        for (int i = 0; i < 32; ++i) orow[i] = f2bf(bf2f(ur[i]) * (acc[i] + bb));
    }
}
__device__ __forceinline__ void p2_attn_naive(const Args& A, float* ldsf) {
    const bf16_t* Q = (const bf16_t*)(A.ws + WS_Q); const bf16_t* K = (const bf16_t*)(A.ws + WS_K); const bf16_t* VA = (const bf16_t*)(A.ws + WS_VA);
    const float* CKL = (const float*)(A.ws + WS_CKL); bf16_t* MIXIN = (bf16_t*)(A.ws + WS_MIXIN);
    const int tid = threadIdx.x, lane = tid & 63, wave = tid >> 6;
    float* qs = ldsf + wave * 128;
    const int gw = blockIdx.x * NWAVES + wave, NGW = gridDim.x * NWAVES;
    for (int item = gw; item < T * NH; item += NGW) {
        const int row = item / NH, h = item % NH, b = row / SEQ, t = row % SEQ;
        const bf16_t* qr = Q + (size_t)row * 1024 + h * 128;
        qs[lane] = bf2f(qr[lane]); qs[64 + lane] = bf2f(qr[64 + lane]);
        __builtin_amdgcn_s_waitcnt(0);
        const float* ck = CKL + (size_t)(b * NH + h) * SEQ;
        float m = -1e30f, l = 0.f, o0 = 0.f, o1 = 0.f;
        for (int s0 = 0; s0 <= t; s0 += 64) {
            const int s = s0 + lane; float sc = -INFINITY;
            if (s <= t) { const bf16_t* kr = K + (size_t)(b * SEQ + s) * 1024 + h * 128; float d = 0.f;
                for (int c = 0; c < 16; ++c) { const u32x4 w = *(const u32x4*)(kr + 8 * c);
#pragma unroll
                    for (int e = 0; e < 4; ++e) { d = fmaf(qs[8 * c + 2 * e], __uint_as_float(w[e] << 16), d); d = fmaf(qs[8 * c + 2 * e + 1], __uint_as_float(w[e] & 0xffff0000u), d); } }
                sc = d - ck[s]; }
            const float mn = fmaxf(m, wave_max(sc)); const float alpha = exp2f(m - mn); const float p = exp2f(sc - mn);
            l = l * alpha + wave_sum(p); o0 *= alpha; o1 *= alpha; m = mn;
            const int nk = min(64, t - s0 + 1);
            for (int j = 0; j < nk; ++j) { const float pj = __shfl(p, j); const unsigned w = *(const unsigned*)(VA + (size_t)(b * SEQ + s0 + j) * 1024 + h * 128 + 2 * lane);
                o0 = fmaf(pj, __uint_as_float(w << 16), o0); o1 = fmaf(pj, __uint_as_float(w & 0xffff0000u), o1); }
        }
        const float il = 1.f / l;
        *(unsigned*)(MIXIN + (size_t)row * 2048 + 1024 + h * 128 + 2 * lane) = pk2(o0 * il, o1 * il);
    }
}

__device__ __forceinline__ void p3_naive(const Args& A, float* ldsf) {
    const bf16_t* MIXIN = (const bf16_t*)(A.ws + WS_MIXIN); const bf16_t* G = (const bf16_t*)(A.ws + WS_G); bf16_t* MIXED = (bf16_t*)(A.ws + WS_MIXED);
    const float* wps = A.in[11]; const float* wpf = A.in[12];
    naive_gemm(ldsf, T, DM, 2048, 1024,
        [=](int m, int k) { return bf2f(MIXIN[(size_t)m * 2048 + k]); },
        [=](int k, int n) { return k < 1024 ? wps[(size_t)k * DM + n] : wpf[(size_t)(k - 1024) * DM + n]; },
        [=](int m, int n, float s1, float s2) { MIXED[(size_t)m * DM + n] = f2bf(bf2f(G[(size_t)m * 4096 + n]) * s1 + bf2f(G[(size_t)m * 4096 + 2048 + n]) * s2); });
}
__device__ __forceinline__ void p4_naive(const Args& A, float* ldsf) {
    const bf16_t* MIXED = (const bf16_t*)(A.ws + WS_MIXED); const float* wo = A.in[13]; const float* x = A.in[0]; float* X1 = A.out;
    naive_gemm(ldsf, T, DM, DM, DM,
        [=](int m, int k) { return bf2f(MIXED[(size_t)m * DM + k]); },
        [=](int k, int n) { return wo[(size_t)k * DM + n]; },
        [=](int m, int n, float s, float) { X1[(size_t)m * DM + n] = x[(size_t)m * DM + n] + s; });
}

__device__ __forceinline__ void p5_router(const Args& A, float* ldsf) {
    const float* X1 = A.out; const float* g2 = A.in[14]; const float* wrg = A.in[15]; const float* brg = A.in[16]; const float* wre = A.in[17]; const float* bre = A.in[18];
    bf16_t* H2 = (bf16_t*)(A.ws + WS_H2); unsigned* cnt = (unsigned*)(A.ws + WS_CTL) + CW_CNT;
    int* TOK = (int*)(A.ws + WS_TOK); float* GATE = (float*)(A.ws + WS_GATE); int* ASG = (int*)(A.ws + WS_ASG);
    const int tid = threadIdx.x, lane = tid & 63, wave = tid >> 6, r = tid >> 4, ks = tid & 15;
    float* Ws = ldsf;
    float* Xs = ldsf + 256 * 36;
    float* rs = Xs + 32 * 260;
    int* hist = (int*)(rs + 32);
    int* hbase = hist + 32;
    int* sel = hbase + 32;
    int* lpos = sel + 64;
    float* selw = (float*)(lpos + 64);
    for (int rb = blockIdx.x; rb < T / 32; rb += gridDim.x) {
        const int row0 = rb * 32;
        for (int i = 0; i < 4; ++i) { const int rr = wave * 4 + i; const f32x4* xr = (const f32x4*)(X1 + (size_t)(row0 + rr) * DM) + lane; float ss = 0.f;
#pragma unroll
            for (int j = 0; j < 8; ++j) { const f32x4 v = xr[64 * j]; ss += v.x * v.x + v.y * v.y + v.z * v.z + v.w * v.w; }
            ss = wave_sum(ss); if (lane == 0) rs[rr] = rsqrtf(ss * (1.f / DM) + EPS); }
        if (tid < 32) hist[tid] = 0;
        __syncthreads();
        float acc[36];
#pragma unroll
        for (int j = 0; j < 36; ++j) acc[j] = 0.f;
        for (int k0 = 0; k0 < DM; k0 += 256) {
            for (int i = tid; i < 256 * 36; i += NTHREADS) { const int kk = i / 36, j = i % 36; Ws[i] = j < 4 ? wrg[(size_t)(k0 + kk) * 4 + j] : wre[(size_t)(k0 + kk) * 32 + j - 4]; }
            for (int i = tid; i < 32 * 256; i += NTHREADS) { const int rr = i >> 8, kk = i & 255; const float hv = X1[(size_t)(row0 + rr) * DM + k0 + kk] * rs[rr] * g2[k0 + kk];
                Xs[rr * 260 + kk] = hv; H2[(size_t)(row0 + rr) * DM + k0 + kk] = f2bf(hv); }
            __syncthreads();
            for (int kk = ks; kk < 256; kk += 16) { const float xv = Xs[r * 260 + kk]; const float* wr = Ws + kk * 36;
#pragma unroll
                for (int j = 0; j < 36; ++j) acc[j] = fmaf(xv, wr[j], acc[j]); }
            __syncthreads();
        }
#pragma unroll
        for (int j = 0; j < 36; ++j) { float v = acc[j]; v += __shfl_xor(v, 1); v += __shfl_xor(v, 2); v += __shfl_xor(v, 4); v += __shfl_xor(v, 8); acc[j] = v; }
        if (ks == 0) {
            float gl[4]; int grp = 0; float gm;
#pragma unroll
            for (int j = 0; j < 4; ++j) gl[j] = acc[j] + brg[j];
            gm = gl[0];
#pragma unroll
            for (int j = 1; j < 4; ++j) if (gl[j] > gm) { gm = gl[j]; grp = j; }
            float den = 0.f;
#pragma unroll
            for (int j = 0; j < 4; ++j) den += __expf(gl[j] - gm);
            const float pg = 1.f / den;
            float el[8];
#pragma unroll
            for (int j = 0; j < 8; ++j) { float v = 0.f;
#pragma unroll
                for (int g = 0; g < 4; ++g) if (g == grp) v = acc[4 + g * 8 + j] + bre[g * 8 + j];
                el[j] = v; }
            int i0 = 0; float v0 = el[0];
#pragma unroll
            for (int j = 1; j < 8; ++j) if (el[j] > v0) { v0 = el[j]; i0 = j; }
            int i1 = -1; float v1 = -INFINITY;
#pragma unroll
            for (int j = 0; j < 8; ++j) if (j != i0 && el[j] > v1) { v1 = el[j]; i1 = j; }
            const float e1 = __expf(v1 - v0); const float w0 = pg / (1.f + e1), w1 = pg * e1 / (1.f + e1);
            const int ea = grp * 8 + i0, eb = grp * 8 + i1;
            sel[r * 2] = ea; sel[r * 2 + 1] = eb; selw[r * 2] = w0; selw[r * 2 + 1] = w1;
            lpos[r * 2] = atomicAdd(&hist[ea], 1); lpos[r * 2 + 1] = atomicAdd(&hist[eb], 1);
        }
        __syncthreads();
        if (tid < 32) hbase[tid] = hist[tid] > 0 ? (int)atomicAdd(&cnt[tid], (unsigned)hist[tid]) : 0;
        __syncthreads();
        if (tid < 64) { const int e = sel[tid], pos = hbase[e] + lpos[tid]; const int tok = row0 + (tid >> 1);
            TOK[(size_t)e * T + pos] = tok; GATE[(size_t)e * T + pos] = selw[tid]; ASG[tok * 2 + (tid & 1)] = (e << 16) | pos; }
        __syncthreads();
    }
}

__device__ __forceinline__ void expert_layout(const unsigned* cnt, int* pstart  ) {
    int acc = 0;
    for (int e = 0; e < NEXP; ++e) { pstart[e] = acc; acc += ((int)cnt[e] + MTILE - 1) / MTILE * MTILE; }
    pstart[NEXP] = acc;
}

__device__ __forceinline__ void p6_naive(const Args& A, float* ldsf) {
    const bf16_t* H2 = (const bf16_t*)(A.ws + WS_H2); const float* wg = A.in[19]; const float* wu = A.in[20]; bf16_t* ACT = (bf16_t*)(A.ws + WS_ACT);
    const unsigned* cnt = (const unsigned*)(A.ws + WS_CTL) + CW_CNT; const int* TOK = (const int*)(A.ws + WS_TOK);
    int* ps = (int*)(ldsf + 2 * 16 * 132);
    if (threadIdx.x == 0) expert_layout(cnt, ps);
    __syncthreads();
    int ntot = 0;
    for (int e = 0; e < NEXP; ++e) ntot += (((int)cnt[e] + 127) / 128) * 4;
    for (int t = blockIdx.x; t < ntot; t += gridDim.x) {
        int e = 0, rem = t;
        for (; e < NEXP; ++e) { const int n = (((int)cnt[e] + 127) / 128) * 4; if (rem < n) break; rem -= n; }
        const int c = (int)cnt[e]; const int tm = rem / 4, tn = rem % 4; const int* tl = TOK + (size_t)e * T; const int prow = ps[e];
        const float* wge = wg + (size_t)e * DM * DEXP; const float* wue = wu + (size_t)e * DM * DEXP;
        naive_gemm_tile(ldsf, tm * 128, tn * 128, c, DEXP, 2 * DM, DM,
            [=](int m, int k) { return bf2f(H2[(size_t)tl[m] * DM + (k & (DM - 1))]); },
            [=](int k, int n) { return k < DM ? wge[(size_t)k * DEXP + n] : wue[(size_t)(k - DM) * DEXP + n]; },
            [=](int m, int n, float sg, float su) { ACT[(size_t)(prow + m) * DEXP + n] = f2bf(sg / (1.f + __expf(-sg)) * su); });
    }
}
__device__ __forceinline__ void p7_naive(const Args& A, float* ldsf) {
    const bf16_t* ACT = (const bf16_t*)(A.ws + WS_ACT); const float* wd = A.in[21]; bf16_t* YBUF = (bf16_t*)(A.ws + WS_YBUF);
    const unsigned* cnt = (const unsigned*)(A.ws + WS_CTL) + CW_CNT; const float* GATE = (const float*)(A.ws + WS_GATE);
    int* ps = (int*)(ldsf + 2 * 16 * 132);
    if (threadIdx.x == 0) expert_layout(cnt, ps);
    __syncthreads();
    int ntot = 0;
    for (int e = 0; e < NEXP; ++e) ntot += (((int)cnt[e] + 127) / 128) * 16;
    for (int t = blockIdx.x; t < ntot; t += gridDim.x) {
        int e = 0, rem = t;
        for (; e < NEXP; ++e) { const int n = (((int)cnt[e] + 127) / 128) * 16; if (rem < n) break; rem -= n; }
        const int c = (int)cnt[e]; const int tm = rem / 16, tn = rem % 16; const float* gl = GATE + (size_t)e * T; const int prow = ps[e];
        const float* wde = wd + (size_t)e * DEXP * DM;
        naive_gemm_tile(ldsf, tm * 128, tn * 128, c, DM, DEXP, DEXP,
            [=](int m, int k) { return bf2f(ACT[(size_t)(prow + m) * DEXP + k]); },
            [=](int k, int n) { return wde[(size_t)k * DM + n]; },
            [=](int m, int n, float s, float) { YBUF[(size_t)(prow + m) * DM + n] = f2bf(s * gl[m]); });
    }
}

__device__ __forceinline__ void p8_combine(const Args& A, float* ldsf) {
    float* X1 = A.out; const bf16_t* YBUF = (const bf16_t*)(A.ws + WS_YBUF); const int* ASG = (const int*)(A.ws + WS_ASG);
    const unsigned* cnt = (const unsigned*)(A.ws + WS_CTL) + CW_CNT;
    int* ps = (int*)ldsf;
    if (threadIdx.x == 0) expert_layout(cnt, ps);
    __syncthreads();
    const int tid = threadIdx.x, lane = tid & 63, wave = tid >> 6;
    const int gw = blockIdx.x * NWAVES + wave, NGW = gridDim.x * NWAVES;
    for (int row = gw; row < T; row += NGW) {
        const int a0 = ASG[row * 2], a1 = ASG[row * 2 + 1];
        const bf16_t* y0 = YBUF + (size_t)(ps[a0 >> 16] + (a0 & 0xffff)) * DM; const bf16_t* y1 = YBUF + (size_t)(ps[a1 >> 16] + (a1 & 0xffff)) * DM;
        float* xr = X1 + (size_t)row * DM;
#pragma unroll
        for (int j = 0; j < 4; ++j) { const int c0 = 512 * j + 8 * lane; const u32x4 w0 = *(const u32x4*)(y0 + c0), w1 = *(const u32x4*)(y1 + c0);
            f32x4 xa = *(const f32x4*)(xr + c0), xb = *(const f32x4*)(xr + c0 + 4);
            xa.x += __uint_as_float(w0[0] << 16) + __uint_as_float(w1[0] << 16); xa.y += __uint_as_float(w0[0] & 0xffff0000u) + __uint_as_float(w1[0] & 0xffff0000u);
            xa.z += __uint_as_float(w0[1] << 16) + __uint_as_float(w1[1] << 16); xa.w += __uint_as_float(w0[1] & 0xffff0000u) + __uint_as_float(w1[1] & 0xffff0000u);
            xb.x += __uint_as_float(w0[2] << 16) + __uint_as_float(w1[2] << 16); xb.y += __uint_as_float(w0[2] & 0xffff0000u) + __uint_as_float(w1[2] & 0xffff0000u);
            xb.z += __uint_as_float(w0[3] << 16) + __uint_as_float(w1[3] << 16); xb.w += __uint_as_float(w0[3] & 0xffff0000u) + __uint_as_float(w1[3] & 0xffff0000u);
            *(f32x4*)(xr + c0) = xa; *(f32x4*)(xr + c0 + 4) = xb; }
    }
}

namespace pg8 {
#define PG8_LAS __attribute__((address_space(3)))
typedef short bf16x8 __attribute__((ext_vector_type(8)));
constexpr int BM = 256, BK = 64, HALF = 128, HTB = HALF * BK * 2, STAGE_BYTES = 8 * HTB, NXCD = 8, WGM = 8;
__host__ __device__ __forceinline__ int lds_byte(int r, int c) { const int st = (r >> 4) * 2 + (c >> 5), rr = r & 15, cc = c & 31, ob = rr * 64 + cc * 2; return st * 1024 + (ob ^ (((ob >> 9) & 1) << 5)); }
__host__ __device__ __forceinline__ void stage_rc(int b, int& R, int& C) { const int st = b / 1024, sb = b % 1024, swz = sb ^ (((sb >> 9) & 1) << 5); R = (st >> 1) * 16 + swz / 64; C = (st & 1) * 32 + (swz % 64) / 2; }
__host__ __device__ __forceinline__ int perm32(int rho) { const int n = rho >> 4, i = rho & 15; return 8 * (i >> 2) + 4 * n + (i & 3); }

struct Unit { const char* A; const char* B; int pm, pn, x0, x1, x2, x3; };

struct DenseOrder {
    const char* A; const char* Bt; int K, nM, nN, nwg, G, c;
    __device__ void init(const void* A_, const void* Bt_, int M, int N, int K_, int G_, int c_) { A = (const char*)A_; Bt = (const char*)Bt_; K = K_; nM = M / BM; nN = N / BM; nwg = nM * nN; G = G_; c = c_; }
    __device__ bool next(int i, Unit& u) const {
        const long L = (long)i * G + c; if (L >= nwg) return false;
        int wgid = (int)L; { const int q = nwg / NXCD, r = nwg % NXCD, xcd = wgid % NXCD, off = wgid / NXCD; wgid = (xcd < r ? xcd * (q + 1) : r * (q + 1) + (xcd - r) * q) + off; }
        const int nig = WGM * nN, gid = wgid / nig, fm = gid * WGM, gsz = (nM - fm) < WGM ? (nM - fm) : WGM;
        u.pm = fm + ((wgid % nig) % gsz); u.pn = (wgid % nig) / gsz; u.x0 = 0; u.x1 = 0; u.x2 = 0; u.x3 = 0;
        u.A = A + (size_t)u.pm * BM * K * 2; u.B = Bt + (size_t)u.pn * BM * K * 2; return true;
    }
    __device__ __forceinline__ void rows(const Unit&, unsigned (&)[2][2], const int (&)[2]) const {}
};

__device__ __forceinline__ unsigned cvt_pk_bf16(float lo, float hi) { unsigned r; asm volatile("v_cvt_pk_bf16_f32 %0, %1, %2" : "=v"(r) : "v"(lo), "v"(hi)); return r; }

template <class Epi, class Sched, bool ALIGN_EPI, bool GATHER>
__device__ __forceinline__ void gemm_phase(PG8_LAS unsigned char* lds, const int K, const Sched& S, const Epi& E) {
    const int tid = threadIdx.x, wid = __builtin_amdgcn_readfirstlane(tid >> 6), lane = tid & 63, wr = wid >> 2, wc = wid & 3, fr = lane & 15, fq = lane >> 4;
    const int nt = K / BK;
    unsigned voffA[2], voffB[2]; int RA[2];
#pragma unroll
    for (int i = 0; i < 2; ++i) { int R, C; stage_rc(tid * 16 + i * 8192, R, C); const int Rb = Epi::PERM ? ((R & ~31) + perm32(R & 31)) : R;
        voffA[i] = GATHER ? (unsigned)(C * 2) : (unsigned)(R * K + C) * 2u; voffB[i] = (unsigned)(Rb * K + C) * 2u; RA[i] = R; }
    const size_t kstep = (size_t)(BK * 2);
    const size_t hstep = (size_t)HALF * K * 2;
    const size_t hstepA = GATHER ? 0 : hstep;
    const unsigned ldsw = (unsigned)wid * 1024u;
    const int aoff = lds_byte(wr * 64 + fr, fq * 8), boff = lds_byte(wc * 32 + fr, fq * 8);
    unsigned gA[2][2], gAn[2][2];
#define PG8_SA(b, h) (((b) * 2 + (h)) * HTB)
#define PG8_SB(b, h) ((4 + (b) * 2 + (h)) * HTB)
#define PG8_STAGE(bufoff, gbase, voff) do { _Pragma("unroll") for (int _i = 0; _i < 2; ++_i) \
        __builtin_amdgcn_global_load_lds((const unsigned*)((const char*)(gbase) + (voff)[_i]), (PG8_LAS unsigned*)(lds + (bufoff) + ldsw + _i * 8192), 16, 0, 0); } while (0)
#define PG8_STAGE_A(bufoff, gbase, h, nx) do { _Pragma("unroll") for (int _i = 0; _i < 2; ++_i) { \
        const unsigned _o = GATHER ? ((nx) ? gAn[h][_i] : gA[h][_i]) + voffA[_i] : voffA[_i]; \
        __builtin_amdgcn_global_load_lds((const unsigned*)((const char*)(gbase) + (h) * hstepA + _o), (PG8_LAS unsigned*)(lds + (bufoff) + ldsw + _i * 8192), 16, 0, 0); } } while (0)
#define PG8_LDA(dst, b, h) do { _Pragma("unroll") for (int m = 0; m < 4; ++m) _Pragma("unroll") for (int k = 0; k < 2; ++k) dst[m][k] = *(const PG8_LAS bf16x8*)(lds + PG8_SA(b, h) + aoff + m * 2048 + k * 1024); } while (0)
#define PG8_LDB(dst, b, h) do { _Pragma("unroll") for (int n = 0; n < 2; ++n) _Pragma("unroll") for (int k = 0; k < 2; ++k) dst[n][k] = *(const PG8_LAS bf16x8*)(lds + PG8_SB(b, h) + boff + n * 2048 + k * 1024); } while (0)
#define PG8_MMA(ai, bj, At, Bt) do { __builtin_amdgcn_s_setprio(1); _Pragma("unroll") for (int m = 0; m < 4; ++m) _Pragma("unroll") for (int n = 0; n < 2; ++n) _Pragma("unroll") for (int k = 0; k < 2; ++k) \
        acc[ai][bj][m][n] = __builtin_amdgcn_mfma_f32_16x16x32_bf16(Bt[n][k], At[m][k], acc[ai][bj][m][n], 0, 0, 0); __builtin_amdgcn_s_setprio(0); } while (0)
#define PG8_WAIT_V(n) asm volatile("s_waitcnt vmcnt(" #n ")" ::: "memory")
#define PG8_WAIT_L(n) asm volatile("s_waitcnt lgkmcnt(" #n ")" ::: "memory")
#define PG8_BAR __builtin_amdgcn_s_barrier()
#define PG8_SCHED __builtin_amdgcn_sched_barrier(0)
    Unit cur, nxt; int ui = 0;
    if (!S.next(0, cur)) return;
    f32x4 acc[2][2][4][2];
#pragma unroll
    for (int a = 0; a < 2; ++a)
#pragma unroll
        for (int b = 0; b < 2; ++b)
#pragma unroll
            for (int m = 0; m < 4; ++m)
#pragma unroll
                for (int n = 0; n < 2; ++n) acc[a][b][m][n] = (f32x4){0.f, 0.f, 0.f, 0.f};
    bf16x8 At[4][2], B0[2][2], B1[2][2];
    const char* cA = cur.A; const char* cB = cur.B;
    if constexpr (GATHER) { S.rows(cur, gA, RA);
#pragma unroll
        for (int h = 0; h < 2; ++h)
#pragma unroll
            for (int i = 0; i < 2; ++i) gAn[h][i] = gA[h][i]; }
    PG8_STAGE(PG8_SB(0, 0), cB, voffB); PG8_STAGE(PG8_SB(0, 1), cB + hstep, voffB); PG8_STAGE_A(PG8_SA(0, 0), cA, 0, false); PG8_STAGE_A(PG8_SA(0, 1), cA, 1, false);
    if (wr == 1) PG8_BAR;
    PG8_WAIT_V(2); PG8_BAR;
    PG8_STAGE(PG8_SB(1, 0), cB + kstep, voffB); PG8_STAGE_A(PG8_SA(1, 0), cA + kstep, 0, false); PG8_STAGE(PG8_SB(1, 1), cB + hstep + kstep, voffB);
    PG8_WAIT_V(6); PG8_BAR;
    for (;;) {
        const bool has_next = S.next(ui + 1, nxt);
        const char* nA = has_next ? nxt.A : cA; const char* nB = has_next ? nxt.B : cB;
        if constexpr (GATHER) { if (has_next) { S.rows(nxt, gAn, RA); } }
        for (int t = 0; t < nt; t += 2) {
            const bool last = (t == nt - 2);
            const char* a1 = cA + (size_t)(t + 1) * kstep;
            const char* a2 = last ? nA : cA + (size_t)(t + 2) * kstep; const char* b2 = last ? nB : cB + (size_t)(t + 2) * kstep;
            const char* a3 = a2 + kstep; const char* b3 = b2 + kstep;
            if constexpr (Epi::HAS_MID) { if (t == nt / 2) { int frl = fr, fql = fq; asm volatile("" : "+v"(frl), "+v"(fql)); E.mid(acc, cur, wr, wc, frl, fql); } }
            PG8_LDB(B0, 0, 0); PG8_LDB(B1, 0, 1); PG8_SCHED; PG8_LDA(At, 0, 0); PG8_STAGE_A(PG8_SA(1, 1), a1, 1, false);
            PG8_WAIT_V(8); PG8_WAIT_L(0); PG8_BAR; PG8_MMA(0, 0, At, B0); PG8_MMA(0, 1, At, B1); PG8_BAR; PG8_SCHED;
            PG8_LDA(At, 0, 1); PG8_STAGE(PG8_SB(0, 0), b2, voffB); PG8_STAGE(PG8_SB(0, 1), b2 + hstep, voffB); PG8_STAGE_A(PG8_SA(0, 0), a2, 0, last);
            PG8_WAIT_V(8); PG8_WAIT_L(0); PG8_BAR; PG8_MMA(1, 0, At, B0); PG8_MMA(1, 1, At, B1); PG8_BAR; PG8_SCHED;
            PG8_LDB(B0, 1, 0); PG8_LDB(B1, 1, 1); PG8_SCHED; PG8_LDA(At, 1, 0); PG8_STAGE_A(PG8_SA(0, 1), a2, 1, last);
            PG8_WAIT_V(8); PG8_WAIT_L(0); PG8_BAR; PG8_MMA(0, 0, At, B0); PG8_MMA(0, 1, At, B1); PG8_BAR; PG8_SCHED;
            PG8_LDA(At, 1, 1); PG8_STAGE(PG8_SB(1, 0), b3, voffB); PG8_STAGE(PG8_SB(1, 1), b3 + hstep, voffB); PG8_STAGE_A(PG8_SA(1, 0), a3, 0, last);
            PG8_WAIT_V(8); PG8_WAIT_L(0); PG8_BAR; PG8_MMA(1, 0, At, B0); PG8_MMA(1, 1, At, B1); PG8_BAR; PG8_SCHED;
        }
        if constexpr (ALIGN_EPI) { if (wr == 0) PG8_BAR; }
        { int frl = fr, fql = fq; asm volatile("" : "+v"(frl), "+v"(fql)); E(acc, cur, wr, wc, frl, fql); }
        if (!has_next) break;
#pragma unroll
        for (int a = 0; a < 2; ++a)
#pragma unroll
            for (int b = 0; b < 2; ++b)
#pragma unroll
                for (int m = 0; m < 4; ++m)
#pragma unroll
                    for (int n = 0; n < 2; ++n) acc[a][b][m][n] = (f32x4){0.f, 0.f, 0.f, 0.f};
        cur = nxt; cA = nA; cB = nB; ++ui;
        if constexpr (GATHER) {
#pragma unroll
            for (int h = 0; h < 2; ++h)
#pragma unroll
                for (int i = 0; i < 2; ++i) gA[h][i] = gAn[h][i]; }
        if constexpr (ALIGN_EPI) { if (wr == 1) PG8_BAR; }
    }
    PG8_WAIT_V(0);
    if constexpr (!ALIGN_EPI) { if (wr == 0) PG8_BAR; }
    PG8_BAR;
#undef PG8_SA
#undef PG8_SB
#undef PG8_STAGE
#undef PG8_STAGE_A
#undef PG8_LDA
#undef PG8_LDB
#undef PG8_MMA
#undef PG8_WAIT_V
#undef PG8_WAIT_L
#undef PG8_BAR
#undef PG8_SCHED
}
}

constexpr int LDS_MISC_OFF = 131072;
__device__ __forceinline__ float fast_gelu(float x) { const float y = x + 0.044715f * x * x * x; return x * __builtin_amdgcn_rcpf(1.0f + __builtin_amdgcn_exp2f(-2.0f * 0.7978845608028654f * LOG2E * y)); }
__device__ __forceinline__ float fast_sigmoid(float x) { return __builtin_amdgcn_rcpf(1.0f + __builtin_amdgcn_exp2f(-LOG2E * x)); }
__device__ __forceinline__ void unpack8(const u32x4 w, float (&v)[8]) {
#pragma unroll
    for (int e = 0; e < 4; ++e) { v[2 * e] = __uint_as_float(w[e] << 16); v[2 * e + 1] = __uint_as_float(w[e] & 0xffff0000u); } }

struct EpiIn {
    static constexpr bool PERM = true, HAS_MID = false;
    bf16_t *U, *V, *Q, *K, *VA, *G; const float* b_gate;
    __device__ __forceinline__ void mid(f32x4 (&)[2][2][4][2], const pg8::Unit&, int, int, int, int) const {}
    __device__ __forceinline__ void operator()(f32x4 (&acc)[2][2][4][2], const pg8::Unit& u, int wr, int wc, int fr, int fq) const {
        const int pn = u.pn; bf16_t* base; int ld, colt, mode;
        if (pn < 4) { base = U; ld = 1024; colt = pn * 256; mode = 1; }
        else if (pn < 8) { base = V; ld = 1024; colt = (pn - 4) * 256; mode = 1; }
        else if (pn < 12) { base = Q; ld = 1024; colt = (pn - 8) * 256; mode = 0; }
        else if (pn < 16) { base = K; ld = 1024; colt = (pn - 12) * 256; mode = 0; }
        else if (pn < 20) { base = VA; ld = 1024; colt = (pn - 16) * 256; mode = 0; }
        else { base = G; ld = 4096; colt = (pn - 20) * 256; mode = 2; }
        const int row0 = u.pm * 256 + wr * 64 + fr, col0 = colt + wc * 32 + 8 * fq;
        f32x4 bv[2][2];
#pragma unroll
        for (int bj = 0; bj < 2; ++bj)
#pragma unroll
            for (int n = 0; n < 2; ++n) bv[bj][n] = (mode == 2) ? *(const f32x4*)(b_gate + col0 + bj * 128 + 4 * n) : (f32x4){0.f, 0.f, 0.f, 0.f};
#pragma unroll
        for (int ai = 0; ai < 2; ++ai)
#pragma unroll
            for (int m = 0; m < 4; ++m) { bf16_t* rowp = base + (size_t)(row0 + ai * 128 + m * 16) * ld + col0;
#pragma unroll
                for (int bj = 0; bj < 2; ++bj) { f32x4 v0 = acc[ai][bj][m][0], v1 = acc[ai][bj][m][1];
                    if (mode == 1) {
#pragma unroll
                        for (int j = 0; j < 4; ++j) { v0[j] = fast_gelu(v0[j]); v1[j] = fast_gelu(v1[j]); } }
                    else if (mode == 2) { v0 += bv[bj][0]; v1 += bv[bj][1];
#pragma unroll
                        for (int j = 0; j < 4; ++j) { v0[j] = fast_sigmoid(v0[j]); v1[j] = fast_sigmoid(v1[j]); } }
                    u32x4 w; w.x = pg8::cvt_pk_bf16(v0[0], v0[1]); w.y = pg8::cvt_pk_bf16(v0[2], v0[3]); w.z = pg8::cvt_pk_bf16(v1[0], v1[1]); w.w = pg8::cvt_pk_bf16(v1[2], v1[3]);
                    *(u32x4*)(rowp + bj * 128) = w; } }
    }
};
struct EpiProj {
    static constexpr bool PERM = true, HAS_MID = true;
    const bf16_t* G; bf16_t* O;
    __device__ __forceinline__ void mid(f32x4 (&acc)[2][2][4][2], const pg8::Unit& u, int wr, int wc, int fr, int fq) const {
        const int row0 = u.pm * 256 + wr * 64 + fr, col0 = u.pn * 256 + wc * 32 + 8 * fq;
#pragma unroll
        for (int ai = 0; ai < 2; ++ai)
#pragma unroll
            for (int m = 0; m < 4; ++m) { const bf16_t* gp = G + (size_t)(row0 + ai * 128 + m * 16) * 4096 + col0;
#pragma unroll
                for (int bj = 0; bj < 2; ++bj) { float gs[8], gf[8]; unpack8(*(const u32x4*)(gp + bj * 128), gs); unpack8(*(const u32x4*)(gp + 2048 + bj * 128), gf);
#pragma unroll
                    for (int j = 0; j < 4; ++j) { acc[ai][bj][m][0][j] *= gs[j] * __builtin_amdgcn_rcpf(gf[j]); acc[ai][bj][m][1][j] *= gs[4 + j] * __builtin_amdgcn_rcpf(gf[4 + j]); }
                    asm volatile("" : "+v"(acc[ai][bj][m][0]), "+v"(acc[ai][bj][m][1]) :: "memory"); } }
    }
    __device__ __forceinline__ void operator()(f32x4 (&acc)[2][2][4][2], const pg8::Unit& u, int wr, int wc, int fr, int fq) const {
        const int row0 = u.pm * 256 + wr * 64 + fr, col0 = u.pn * 256 + wc * 32 + 8 * fq;
#pragma unroll
        for (int ai = 0; ai < 2; ++ai)
#pragma unroll
            for (int m = 0; m < 4; ++m) { const size_t r = (size_t)(row0 + ai * 128 + m * 16);
#pragma unroll
                for (int bj = 0; bj < 2; ++bj) { float gf[8]; unpack8(*(const u32x4*)(G + r * 4096 + 2048 + col0 + bj * 128), gf);
                    const f32x4 v0 = acc[ai][bj][m][0], v1 = acc[ai][bj][m][1];
                    u32x4 w; w.x = pg8::cvt_pk_bf16(v0[0] * gf[0], v0[1] * gf[1]); w.y = pg8::cvt_pk_bf16(v0[2] * gf[2], v0[3] * gf[3]); w.z = pg8::cvt_pk_bf16(v1[0] * gf[4], v1[1] * gf[5]); w.w = pg8::cvt_pk_bf16(v1[2] * gf[6], v1[3] * gf[7]);
                    *(u32x4*)(O + r * 2048 + col0 + bj * 128) = w; }
                asm volatile("" ::: "memory"); }
    }
};
struct EpiOut {
    static constexpr bool PERM = false, HAS_MID = false;
    const float* X; float* O;
    __device__ __forceinline__ void mid(f32x4 (&)[2][2][4][2], const pg8::Unit&, int, int, int, int) const {}
    __device__ __forceinline__ void operator()(f32x4 (&acc)[2][2][4][2], const pg8::Unit& u, int wr, int wc, int fr, int fq) const {
        const int row0 = u.pm * 256 + wr * 64 + fr, col0 = u.pn * 256 + wc * 32 + 4 * fq;
#pragma unroll
        for (int ai = 0; ai < 2; ++ai)
#pragma unroll
            for (int m = 0; m < 4; ++m) { const size_t off = (size_t)(row0 + ai * 128 + m * 16) * DM + col0;
#pragma unroll
                for (int bj = 0; bj < 2; ++bj)
#pragma unroll
                    for (int n = 0; n < 2; ++n) *(f32x4*)(O + off + bj * 128 + n * 16) = *(const f32x4*)(X + off + bj * 128 + n * 16) + acc[ai][bj][m][n]; }
    }
};
struct EpiGateUp {
    static constexpr bool PERM = true, HAS_MID = false;
    bf16_t* ACT;
    __device__ __forceinline__ void mid(f32x4 (&)[2][2][4][2], const pg8::Unit&, int, int, int, int) const {}
    __device__ __forceinline__ void operator()(f32x4 (&acc)[2][2][4][2], const pg8::Unit& u, int wr, int wc, int fr, int fq) const {
        const int row0 = u.x0 + wr * 64 + fr, col0 = u.pn * 128 + wc * 32 + 8 * fq;
#pragma unroll
        for (int ai = 0; ai < 2; ++ai)
#pragma unroll
            for (int m = 0; m < 4; ++m) { float o[8];
#pragma unroll
                for (int n = 0; n < 2; ++n)
#pragma unroll
                    for (int j = 0; j < 4; ++j) { const float g = acc[ai][0][m][n][j], up = acc[ai][1][m][n][j]; o[4 * n + j] = g * fast_sigmoid(g) * up; }
                u32x4 w; w.x = pg8::cvt_pk_bf16(o[0], o[1]); w.y = pg8::cvt_pk_bf16(o[2], o[3]); w.z = pg8::cvt_pk_bf16(o[4], o[5]); w.w = pg8::cvt_pk_bf16(o[6], o[7]);
                *(u32x4*)(ACT + (size_t)(row0 + ai * 128 + m * 16) * DEXP + col0) = w; }
    }
};
struct EpiDown {
    static constexpr bool PERM = true, HAS_MID = false;
    bf16_t* Y; const float* GATE;
    __device__ __forceinline__ void mid(f32x4 (&)[2][2][4][2], const pg8::Unit&, int, int, int, int) const {}
    __device__ __forceinline__ void operator()(f32x4 (&acc)[2][2][4][2], const pg8::Unit& u, int wr, int wc, int fr, int fq) const {
        const int rl0 = wr * 64 + fr, col0 = u.pn * 256 + wc * 32 + 8 * fq;
#pragma unroll
        for (int ai = 0; ai < 2; ++ai)
#pragma unroll
            for (int m = 0; m < 4; ++m) { const int rl = rl0 + ai * 128 + m * 16; const float gt = GATE[u.x1 + rl];
#pragma unroll
                for (int bj = 0; bj < 2; ++bj) { const f32x4 v0 = acc[ai][bj][m][0] * gt, v1 = acc[ai][bj][m][1] * gt;
                    u32x4 w; w.x = pg8::cvt_pk_bf16(v0[0], v0[1]); w.y = pg8::cvt_pk_bf16(v0[2], v0[3]); w.z = pg8::cvt_pk_bf16(v1[0], v1[1]); w.w = pg8::cvt_pk_bf16(v1[2], v1[3]);
                    *(u32x4*)(Y + (size_t)(u.x0 + rl) * DM + col0 + bj * 128) = w; } }
    }
};
struct MoeOrder {
    const char* Abase; const char* Bbase; size_t Bstride; int K, nN, G, c; bool gather;
    const PG8_LAS int* ps;
    const unsigned* cnt; const int* TOK;
    __device__ bool next(int i, pg8::Unit& u) const {
        const int L = i * G + c; const int ntile = (ps[NEXP] / MTILE) * nN; if (L >= ntile) return false;
        const int mtg = L / nN, pn = L % nN, prow = mtg * MTILE; int e = 0;
        for (int j = 1; j < NEXP; ++j) if (ps[j] <= prow) e = j;
        const int mt = (prow - ps[e]) / MTILE;
        u.pm = mt; u.pn = pn; u.x0 = prow; u.x1 = e * T + mt * MTILE; u.x2 = (int)cnt[e] - mt * MTILE; u.x3 = e;
        u.A = gather ? Abase : Abase + (size_t)prow * K * 2; u.B = Bbase + (size_t)e * Bstride + (size_t)pn * 256 * K * 2; return true;
    }
    __device__ __forceinline__ void rows(const pg8::Unit& u, unsigned (&g)[2][2], const int (&RA)[2]) const {
#pragma unroll
        for (int h = 0; h < 2; ++h)
#pragma unroll
            for (int i = 0; i < 2; ++i) { int r = RA[i] + 128 * h; r = r < u.x2 ? r : u.x2 - 1; g[h][i] = (unsigned)TOK[u.x1 + r] * (unsigned)(K * 2); }
    }
};

__device__ __forceinline__ void transpose_item(const float* src, int ld_src, int k0, int n0src, bf16_t* dst, int ld_dst, int kdst, PG8_LAS float* scr, int lane) {
#pragma unroll 8
    for (int i = 0; i < 32; ++i) { const int kk = 2 * i + (lane >> 5); scr[kk * 33 + (lane & 31)] = src[(size_t)(k0 + kk) * ld_src + n0src + (lane & 31)]; }
    asm volatile("s_waitcnt lgkmcnt(0)" ::: "memory");
    const int c = lane & 7;
#pragma unroll
    for (int j = 0; j < 4; ++j) { const int n = (lane >> 3) + 8 * j; const PG8_LAS float* s = scr + (8 * c) * 33 + n;
        u32x4 o; o.x = pk2(s[0 * 33], s[1 * 33]); o.y = pk2(s[2 * 33], s[3 * 33]); o.z = pk2(s[4 * 33], s[5 * 33]); o.w = pk2(s[6 * 33], s[7 * 33]);
        *(u32x4*)(dst + (size_t)n * ld_dst + kdst + k0 + 8 * c) = o; }
    asm volatile("s_waitcnt lgkmcnt(0)" ::: "memory");
}
__device__ __forceinline__ void p0_weights(const Args& A, PG8_LAS unsigned char* lds) {
    const int tid = threadIdx.x, lane = tid & 63, wave = tid >> 6;
    PG8_LAS float* scr = (PG8_LAS float*)(lds + wave * 16384);
    const int gw = blockIdx.x * NWAVES + wave, NGW = gridDim.x * NWAVES;
    bf16_t* WIN = (bf16_t*)(A.ws + WS_WIN); bf16_t* WPROJ = (bf16_t*)(A.ws + WS_WPROJ); bf16_t* WOUT = (bf16_t*)(A.ws + WS_WOUT); bf16_t* WGU = (bf16_t*)(A.ws + WS_WGU); bf16_t* WD = (bf16_t*)(A.ws + WS_WD);
    constexpr int I0 = 32 * 288, I1 = 16 * 64, I2 = 16 * 64, I3 = 32 * 64, I4 = 32 * 512, I5 = 32 * 512, I6 = 32 * 512;
    constexpr int NITEMS = I0 + I1 + I2 + I3 + I4 + I5 + I6;
    for (int it = gw; it < NITEMS; it += NGW) {
        int r = it;
        if (r < I0) { const int kb = r / 288, nb = r % 288; transpose_item(A.in[2], INCOLS, 64 * kb, 32 * nb + (nb >= 160 ? 8 : 0), WIN + (size_t)(32 * nb) * 2048, 2048, 0, scr, lane); continue; } r -= I0;
        if (r < I1) { const int kb = r / 64, nb = r % 64; transpose_item(A.in[11], DM, 64 * kb, 32 * nb, WPROJ + (size_t)(32 * nb) * 2048, 2048, 0, scr, lane); continue; } r -= I1;
        if (r < I2) { const int kb = r / 64, nb = r % 64; transpose_item(A.in[12], DM, 64 * kb, 32 * nb, WPROJ + (size_t)(32 * nb) * 2048, 2048, 1024, scr, lane); continue; } r -= I2;
        if (r < I3) { const int kb = r / 64, nb = r % 64; transpose_item(A.in[13], DM, 64 * kb, 32 * nb, WOUT + (size_t)(32 * nb) * 2048, 2048, 0, scr, lane); continue; } r -= I3;
        if (r < I4 + I5) { const int up = r >= I4; if (up) r -= I4; const int e = r / 512, q = r % 512, kb = q / 16, nb = q % 16, n = 32 * nb, drow = 256 * (n >> 7) + (n & 127) + (up ? 128 : 0);
            transpose_item(A.in[up ? 20 : 19] + (size_t)e * DM * DEXP, DEXP, 64 * kb, n, WGU + ((size_t)e * 1024 + drow) * 2048, 2048, 0, scr, lane); continue; } r -= I4 + I5;
        { const int e = r / 512, q = r % 512, kb = q / 64, nb = q % 64; transpose_item(A.in[21] + (size_t)e * DEXP * DM, DM, 64 * kb, 32 * nb, WD + ((size_t)e * 2048 + 32 * nb) * 512, 512, 0, scr, lane); }
    }
}

__device__ __forceinline__ void p1_fast(const Args& A, PG8_LAS unsigned char* lds) {
    pg8::DenseOrder S; S.init(A.ws + WS_H, A.ws + WS_WIN, T, 9216, DM, gridDim.x, blockIdx.x);
    EpiIn E{(bf16_t*)(A.ws + WS_U), (bf16_t*)(A.ws + WS_V), (bf16_t*)(A.ws + WS_Q), (bf16_t*)(A.ws + WS_K), (bf16_t*)(A.ws + WS_VA), (bf16_t*)(A.ws + WS_G), A.in[3]};
    pg8::gemm_phase<EpiIn, pg8::DenseOrder, true, false>(lds, DM, S, E);
}
__device__ __forceinline__ void p3_fast(const Args& A, PG8_LAS unsigned char* lds) {
    pg8::DenseOrder S; S.init(A.ws + WS_MIXIN, A.ws + WS_WPROJ, T, DM, 2048, gridDim.x, blockIdx.x);
    EpiProj E{(const bf16_t*)(A.ws + WS_G), (bf16_t*)(A.ws + WS_MIXED)};
    pg8::gemm_phase<EpiProj, pg8::DenseOrder, true, false>(lds, 2048, S, E);
}
__device__ __forceinline__ void p4_fast(const Args& A, PG8_LAS unsigned char* lds) {
    pg8::DenseOrder S; S.init(A.ws + WS_MIXED, A.ws + WS_WOUT, T, DM, DM, gridDim.x, blockIdx.x);
    EpiOut E{A.in[0], A.out};
    pg8::gemm_phase<EpiOut, pg8::DenseOrder, true, false>(lds, DM, S, E);
}
__device__ __forceinline__ void moe_layout_lds(const Args& A, PG8_LAS unsigned char* lds) {
    PG8_LAS int* ps = (PG8_LAS int*)(lds + LDS_MISC_OFF);
    if (threadIdx.x == 0) { const unsigned* cnt = (const unsigned*)(A.ws + WS_CTL) + CW_CNT; int acc = 0;
        for (int e = 0; e < NEXP; ++e) { ps[e] = acc; acc += ((int)cnt[e] + MTILE - 1) / MTILE * MTILE; }
        ps[NEXP] = acc; }
    __syncthreads();
}
__device__ __forceinline__ void p6_fast(const Args& A, PG8_LAS unsigned char* lds) {
    moe_layout_lds(A, lds);
    MoeOrder S{(const char*)(A.ws + WS_H2), (const char*)(A.ws + WS_WGU), (size_t)1024 * 2048 * 2, DM, 4, (int)gridDim.x, (int)blockIdx.x, true,
               (const PG8_LAS int*)(lds + LDS_MISC_OFF), (const unsigned*)(A.ws + WS_CTL) + CW_CNT, (const int*)(A.ws + WS_TOK)};
    EpiGateUp E{(bf16_t*)(A.ws + WS_ACT)};
    pg8::gemm_phase<EpiGateUp, MoeOrder, true, true>(lds, DM, S, E);
}
__device__ __forceinline__ void p7_fast(const Args& A, PG8_LAS unsigned char* lds) {
    moe_layout_lds(A, lds);
    MoeOrder S{(const char*)(A.ws + WS_ACT), (const char*)(A.ws + WS_WD), (size_t)2048 * 512 * 2, DEXP, 8, (int)gridDim.x, (int)blockIdx.x, false,
               (const PG8_LAS int*)(lds + LDS_MISC_OFF), (const unsigned*)(A.ws + WS_CTL) + CW_CNT, (const int*)(A.ws + WS_TOK)};
    EpiDown E{(bf16_t*)(A.ws + WS_YBUF), (const float*)(A.ws + WS_GATE)};
    pg8::gemm_phase<EpiDown, MoeOrder, true, false>(lds, DEXP, S, E);
}

namespace fa {
typedef short bf16x8 __attribute__((ext_vector_type(8)));
typedef short v4i16 __attribute__((ext_vector_type(4)));
typedef float f32x16 __attribute__((ext_vector_type(16)));
#define FA_LAS __attribute__((address_space(3)))
constexpr int KVBUF = 65536, LDS_CK = 131072, LDS_ML = 131072 + 8192;
__device__ __forceinline__ unsigned cvtpk(float lo, float hi) { unsigned r; asm("v_cvt_pk_bf16_f32 %0, %1, %2" : "=v"(r) : "v"(lo), "v"(hi)); return r; }
__device__ __forceinline__ bf16x8 pack8(const f32x16& p, int b) { u32x4 w; w.x = cvtpk(p[b], p[b + 1]); w.y = cvtpk(p[b + 2], p[b + 3]); w.z = cvtpk(p[b + 4], p[b + 5]); w.w = cvtpk(p[b + 6], p[b + 7]); return __builtin_bit_cast(bf16x8, w); }
__device__ __forceinline__ float swapmax(float v) { auto rr = __builtin_amdgcn_permlane32_swap(__float_as_uint(v), __float_as_uint(v), false, false); return fmaxf(__uint_as_float(rr[0]), __uint_as_float(rr[1])); }
__device__ __forceinline__ float swapsum(float v) { auto rr = __builtin_amdgcn_permlane32_swap(__float_as_uint(v), __float_as_uint(v), false, false); return __uint_as_float(rr[0]) + __uint_as_float(rr[1]); }
#define FA_WAITBAR() do { asm volatile("s_waitcnt vmcnt(0) lgkmcnt(0)" ::: "memory"); __builtin_amdgcn_s_barrier(); asm volatile("" ::: "memory"); } while (0)

__device__ __forceinline__ void attn_phase(const Args& A, FA_LAS unsigned char* lds) {
    const bf16_t* Q = (const bf16_t*)(A.ws + WS_Q); const bf16_t* Kt = (const bf16_t*)(A.ws + WS_K); const bf16_t* Vt = (const bf16_t*)(A.ws + WS_VA);
    const float* CKL = (const float*)(A.ws + WS_CKL); bf16_t* MIXIN = (bf16_t*)(A.ws + WS_MIXIN);
    const int tid = threadIdx.x, lane = tid & 63, wid = __builtin_amdgcn_readfirstlane(tid >> 6), rg = wid & 3, kh = wid >> 2, r32 = lane & 31, hi = lane >> 5;
    int koff[4];
#pragma unroll
    for (int i = 0; i < 4; ++i) { const int rl = 4 * i + (lane >> 4); koff[i] = rl * 1024 + (((lane & 15) ^ rl) * 8); }
    const int voff = (lane >> 4) * 1024 + (((lane & 15) ^ ((lane >> 4) << 2)) * 8);
    int kfo[8];
#pragma unroll
    for (int d0 = 0; d0 < 8; ++d0) kfo[d0] = (kh * 64 + r32) * 256 + (((2 * d0 + hi) ^ (r32 & 15)) * 16);
    int vfo[4];
    { const int dh = (lane >> 4) & 1, q = (lane & 15) >> 2, p = lane & 3;
#pragma unroll
      for (int db = 0; db < 4; ++db) vfo[db] = 32768 + (kh * 64 + 4 * hi + q) * 256 + ((db ^ q) * 64) + dh * 32 + p * 8; }
    const int G = gridDim.x;
    for (int vb = blockIdx.x; vb < 256; vb += G) {
        const int item = (G % 8 == 0) ? ((vb % 8) * 32 + (vb / 8)) % 256 : vb;
        const int bh = item >> 3, ii = item & 7, b = bh >> 3, h = bh & 7;
        const bf16_t* Kg = Kt + (size_t)b * SEQ * 1024 + h * 128; const bf16_t* Vg = Vt + (size_t)b * SEQ * 1024 + h * 128;
        { const f32x4 c = *(const f32x4*)(CKL + (size_t)bh * SEQ + tid * 4); *(FA_LAS f32x4*)(lds + LDS_CK + tid * 16) = (f32x4){-c.x, -c.y, -c.z, -c.w}; }
#define FA_ISSUE(key0, bufoff) do { const bf16_t* kg_ = Kg + (size_t)((key0) + 16 * wid) * 1024; const bf16_t* vg_ = Vg + (size_t)((key0) + 16 * wid) * 1024; \
        _Pragma("unroll") for (int i_ = 0; i_ < 4; ++i_) { \
            __builtin_amdgcn_global_load_lds((const unsigned*)(kg_ + koff[i_]), (FA_LAS unsigned*)(lds + (bufoff) + (wid * 4 + i_) * 1024), 16, 0, 0); \
            __builtin_amdgcn_global_load_lds((const unsigned*)(vg_ + i_ * 4096 + voff), (FA_LAS unsigned*)(lds + (bufoff) + 32768 + (wid * 4 + i_) * 1024), 16, 0, 0); } } while (0)
        int u = 0, qb = ii, kb = 0, cur = 0;
        FA_ISSUE(0, 0);
        bf16x8 qf[8]; f32x16 o[4]; float m = -1e30f, l = 0.f;
        { const bf16_t* qp = Q + (size_t)(b * SEQ + qb * 128 + rg * 32 + r32) * 1024 + h * 128 + 8 * hi;
#pragma unroll
          for (int d0 = 0; d0 < 8; ++d0) qf[d0] = *(const bf16x8*)(qp + 16 * d0); }
#pragma unroll
        for (int db = 0; db < 4; ++db)
#pragma unroll
            for (int r = 0; r < 16; ++r) o[db][r] = 0.f;
        FA_WAITBAR();
        for (;;) {
            const bool lastb = (kb == qb); const bool more = !(lastb && u == 1);
            const int nkb = lastb ? 0 : kb + 1;
            if (more) FA_ISSUE(nkb * 128, (cur ^ 1) * KVBUF);
            {
                FA_LAS const unsigned char* buf = lds + cur * KVBUF;
                FA_LAS const float* nck = (FA_LAS const float*)(lds + LDS_CK) + kb * 128 + kh * 64 + 4 * hi;
                f32x16 p0, p1;
#pragma unroll
                for (int g = 0; g < 4; ++g) { const f32x4 t0 = *(FA_LAS const f32x4*)(nck + 8 * g), t1 = *(FA_LAS const f32x4*)(nck + 32 + 8 * g);
#pragma unroll
                    for (int j = 0; j < 4; ++j) { p0[4 * g + j] = t0[j]; p1[4 * g + j] = t1[j]; } }
#pragma unroll
                for (int d0 = 0; d0 < 8; ++d0) { const bf16x8 ka = *(FA_LAS const bf16x8*)(buf + kfo[d0]), kc = *(FA_LAS const bf16x8*)(buf + kfo[d0] + 8192);
                    p0 = __builtin_amdgcn_mfma_f32_32x32x16_bf16(ka, qf[d0], p0, 0, 0, 0); p1 = __builtin_amdgcn_mfma_f32_32x32x16_bf16(kc, qf[d0], p1, 0, 0, 0); }
                if (lastb) { const int qrel = rg * 32 + r32, k0 = kh * 64 + 4 * hi;
#pragma unroll
                    for (int r = 0; r < 16; ++r) { const int kr = k0 + (r & 3) + 8 * (r >> 2); if (kr > qrel) p0[r] = -INFINITY; if (kr + 32 > qrel) p1[r] = -INFINITY; } }
                float mx = fmaxf(p0[0], p1[0]);
#pragma unroll
                for (int r = 1; r < 16; ++r) mx = fmaxf(mx, fmaxf(p0[r], p1[r]));
                mx = swapmax(mx);
                const float mn = fmaxf(m, mx), alpha = __builtin_amdgcn_exp2f(m - mn); m = mn;
                float ps = 0.f;
#pragma unroll
                for (int r = 0; r < 16; ++r) { p0[r] = __builtin_amdgcn_exp2f(p0[r] - mn); p1[r] = __builtin_amdgcn_exp2f(p1[r] - mn); ps += p0[r] + p1[r]; }
                l = l * alpha + ps;
                if (!__all(alpha == 1.0f)) {
#pragma unroll
                    for (int db = 0; db < 4; ++db)
#pragma unroll
                        for (int r = 0; r < 16; ++r) o[db][r] *= alpha; }
                bf16x8 pf[4]; pf[0] = pack8(p0, 0); pf[1] = pack8(p0, 8); pf[2] = pack8(p1, 0); pf[3] = pack8(p1, 8);
#pragma unroll
                for (int db = 0; db < 4; ++db)
#pragma unroll
                    for (int s = 0; s < 4; ++s) {
                        const v4i16 lo = __builtin_amdgcn_ds_read_tr16_b64_v4i16((FA_LAS v4i16*)(buf + vfo[db] + s * 4096));
                        const v4i16 hh = __builtin_amdgcn_ds_read_tr16_b64_v4i16((FA_LAS v4i16*)(buf + vfo[db] + s * 4096 + 2048));
                        const bf16x8 vf = (bf16x8){lo[0], lo[1], lo[2], lo[3], hh[0], hh[1], hh[2], hh[3]};
                        o[db] = __builtin_amdgcn_mfma_f32_32x32x16_bf16(vf, pf[s], o[db], 0, 0, 0); }
            }
            FA_WAITBAR();
            if (lastb) {
                FA_LAS float* mb = (FA_LAS float*)(lds + cur * KVBUF) + rg * 4096; FA_LAS float* ml = (FA_LAS float*)(lds + LDS_ML) + rg * 128;
                const float lt = swapsum(l);
                if (kh == 1) {
#pragma unroll
                    for (int db = 0; db < 4; ++db)
#pragma unroll
                        for (int r = 0; r < 16; ++r) mb[(db * 16 + r) * 64 + lane] = o[db][r];
                    ml[lane] = m; ml[64 + lane] = lt; }
                FA_WAITBAR();
                if (kh == 0) {
                    const float m2 = ml[lane], l2 = ml[64 + lane], mm = fmaxf(m, m2), a1 = __builtin_amdgcn_exp2f(m - mm), a2 = __builtin_amdgcn_exp2f(m2 - mm);
                    const float inv = 1.0f / (lt * a1 + l2 * a2), s1 = a1 * inv, s2 = a2 * inv;
                    bf16_t* op = MIXIN + (size_t)(b * SEQ + qb * 128 + rg * 32 + r32) * 2048 + 1024 + h * 128 + 4 * hi;
#pragma unroll
                    for (int db = 0; db < 4; ++db)
#pragma unroll
                        for (int g = 0; g < 4; ++g) { float v[4];
#pragma unroll
                            for (int j = 0; j < 4; ++j) v[j] = o[db][4 * g + j] * s1 + mb[(db * 16 + 4 * g + j) * 64 + lane] * s2;
                            u32x2 w; w.x = cvtpk(v[0], v[1]); w.y = cvtpk(v[2], v[3]); *(u32x2*)(op + 32 * db + 8 * g) = w; } }
                FA_WAITBAR();
                if (u == 1) break;
                u = 1; qb = 15 - ii;
                { const bf16_t* qp = Q + (size_t)(b * SEQ + qb * 128 + rg * 32 + r32) * 1024 + h * 128 + 8 * hi;
#pragma unroll
                  for (int d0 = 0; d0 < 8; ++d0) qf[d0] = *(const bf16x8*)(qp + 16 * d0); }
#pragma unroll
                for (int db = 0; db < 4; ++db)
#pragma unroll
                    for (int r = 0; r < 16; ++r) o[db][r] = 0.f;
                m = -1e30f; l = 0.f;
            }
            cur ^= 1; kb = nkb;
        }
#undef FA_ISSUE
    }
}
}

namespace fs {
#define FS_LAS __attribute__((address_space(3)))
__device__ __forceinline__ void sgu_phase(const Args& A, FS_LAS unsigned char* lds) {
    const bf16_t* U = (const bf16_t*)(A.ws + WS_U); const bf16_t* V = (const bf16_t*)(A.ws + WS_V); bf16_t* MIXIN = (bf16_t*)(A.ws + WS_MIXIN);
    const float* wsp = A.in[7]; const float* bsp = A.in[8];
    const int tid = threadIdx.x, lane = tid & 63, wid = __builtin_amdgcn_readfirstlane(tid >> 6), tb = wid & 3, dh = wid >> 2, r32 = lane & 31, hi = lane >> 5;
    const int frow = tid >> 2, fq4 = tid & 3;
    int vfo[2];
    { const int d16 = (lane >> 4) & 1, q = (lane & 15) >> 2, p = lane & 3;
#pragma unroll
      for (int j = 0; j < 2; ++j) vfo[j] = 32768 + (8 * hi + q) * 256 + (((2 * dh + j) ^ q) * 64) + d16 * 32 + p * 8; }
    const int wfo = (32 * tb + r32) * 256;
    for (int u = blockIdx.x; u < (T / CHUNK) * NG; u += gridDim.x) {
        const int rc = u / NG, g = u % NG, row0 = rc * CHUNK;
        { const float* wr = wsp + ((size_t)g * CHUNK + frow) * CHUNK + fq4 * 32;
#pragma unroll
          for (int c = 0; c < 4; ++c) { const f32x4 a = *(const f32x4*)(wr + 8 * c), b2 = *(const f32x4*)(wr + 8 * c + 4); const int s0 = fq4 * 32 + 8 * c; float v[8] = {a.x, a.y, a.z, a.w, b2.x, b2.y, b2.z, b2.w};
#pragma unroll
              for (int j = 0; j < 8; ++j) if (s0 + j > frow) v[j] = 0.f;
              u32x4 w; w.x = pk2(v[0], v[1]); w.y = pk2(v[2], v[3]); w.z = pk2(v[4], v[5]); w.w = pk2(v[6], v[7]);
              *(FS_LAS u32x4*)(lds + frow * 256 + (((4 * fq4 + c) ^ (frow & 15)) * 16)) = w; }
          const bf16_t* vr = V + (size_t)(row0 + frow) * 1024 + g * 128 + fq4 * 32;
#pragma unroll
          for (int c = 0; c < 4; ++c) { const u32x4 w = *(const u32x4*)(vr + 8 * c); *(FS_LAS u32x4*)(lds + 32768 + frow * 256 + (((4 * fq4 + c) ^ ((frow & 3) << 2)) * 16)) = w; } }
        __syncthreads();
        fa::f32x16 acc[2];
#pragma unroll
        for (int j = 0; j < 2; ++j)
#pragma unroll
            for (int r = 0; r < 16; ++r) acc[j][r] = 0.f;
        for (int s = 0; s <= 2 * tb + 1; ++s) {
            const fa::bf16x8 wf = *(FS_LAS const fa::bf16x8*)(lds + wfo + (((2 * s + hi) ^ (r32 & 15)) * 16));
#pragma unroll
            for (int j = 0; j < 2; ++j) {
                const fa::v4i16 lo = __builtin_amdgcn_ds_read_tr16_b64_v4i16((FS_LAS fa::v4i16*)(lds + vfo[j] + s * 4096));
                const fa::v4i16 hh = __builtin_amdgcn_ds_read_tr16_b64_v4i16((FS_LAS fa::v4i16*)(lds + vfo[j] + s * 4096 + 1024));
                const fa::bf16x8 vf = (fa::bf16x8){lo[0], lo[1], lo[2], lo[3], hh[0], hh[1], hh[2], hh[3]};
                acc[j] = __builtin_amdgcn_mfma_f32_32x32x16_bf16(vf, wf, acc[j], 0, 0, 0); }
        }
        { const int tt = 32 * tb + r32; const float bb = bsp[g * CHUNK + tt]; const size_t rw = (size_t)(row0 + tt);
#pragma unroll
          for (int j = 0; j < 2; ++j)
#pragma unroll
              for (int g4 = 0; g4 < 4; ++g4) { const int d = 32 * (2 * dh + j) + 8 * g4 + 4 * hi; const u32x2 uu = *(const u32x2*)(U + rw * 1024 + g * 128 + d);
                  const float u0 = __uint_as_float(uu.x << 16), u1 = __uint_as_float(uu.x & 0xffff0000u), u2 = __uint_as_float(uu.y << 16), u3 = __uint_as_float(uu.y & 0xffff0000u);
                  u32x2 w; w.x = fa::cvtpk(u0 * (acc[j][4 * g4] + bb), u1 * (acc[j][4 * g4 + 1] + bb)); w.y = fa::cvtpk(u2 * (acc[j][4 * g4 + 2] + bb), u3 * (acc[j][4 * g4 + 3] + bb));
                  *(u32x2*)(MIXIN + rw * 2048 + g * 128 + d) = w; } }
        __syncthreads();
    }
}
}


#define XB_TMO      128
#define XB_XCNT(j)  (256  + 64 * (j))
#define XB_XSUB(j)  (1280 + 64 * (j))
#define XB_XGEN(j)  (2304 + 64 * (j))
#define XB_TOP      3328
#define XB_TOPGEN   3392
#define XCD_BAR_WORDS 3456
#define XB_SPIN_CAP (1u << 18)
#define XLAS __attribute__((address_space(3)))
__device__ __forceinline__ unsigned xb_ld(unsigned* p)              { return __hip_atomic_load(p, __ATOMIC_RELAXED, __HIP_MEMORY_SCOPE_AGENT); }
__device__ __forceinline__ unsigned xb_add(unsigned* p, unsigned v) { return __hip_atomic_fetch_add(p, v, __ATOMIC_RELAXED, __HIP_MEMORY_SCOPE_AGENT); }
__device__ __forceinline__ unsigned xb_xcc_id() { return (unsigned)__builtin_amdgcn_s_getreg((3 << 11) | 20) & 0xFu; }
#define XB_SPIN(cond, bar) do { unsigned _sp = 0; while (cond) { __builtin_amdgcn_s_sleep(1); \
    if ((++_sp & 255u) == 0u) { if (xb_ld(&(bar)[XB_TMO])) break; if (_sp > XB_SPIN_CAP) { atomicAdd(&(bar)[XB_TMO], 1u); break; } } } } while (0)
struct XcdBarrier { unsigned* bar; unsigned x; volatile XLAS unsigned* st; };
__device__ __forceinline__ XcdBarrier xcd_barrier_post(unsigned* bar, volatile XLAS unsigned* st) {
    XcdBarrier b; b.bar = bar; b.x = xb_xcc_id(); b.st = st;
    if (threadIdx.x == 0) (void)xb_add(&bar[XB_XCNT(b.x)], 1u);
    return b;
}
__device__ __forceinline__ void xcd_barrier_complete(unsigned* bar, unsigned x, unsigned& nloc, unsigned& nx) {
    const unsigned G = gridDim.x * gridDim.y * gridDim.z;
    unsigned sum, cnt, mine, sp = 0u;
    for (;;) {
        sum = 0u; cnt = 0u; mine = 0u;
#pragma unroll
        for (unsigned j = 0; j < 16; ++j) { const unsigned c = xb_ld(&bar[XB_XCNT(j)]); sum += c; cnt += (c > 0u) ? 1u : 0u; mine = (j == x) ? c : mine; }
        if (sum == G) break;
        __builtin_amdgcn_s_sleep(1);
        if ((++sp & 255u) == 0u) { if (xb_ld(&bar[XB_TMO])) break; if (sp > XB_SPIN_CAP) { atomicAdd(&bar[XB_TMO], 1u); break; } }
    }
    nloc = mine > 0u ? mine : 1u; nx = cnt > 0u ? cnt : 1u;
}
__device__ __forceinline__ void xcd_barrier(const XcdBarrier& b) {
    asm volatile("s_waitcnt vmcnt(0)" ::: "memory");
    __syncthreads();
    if (threadIdx.x == 0) {
        unsigned* bar = b.bar;
        __builtin_amdgcn_s_waitcnt(0);
        unsigned nloc = b.st[0], nx = b.st[1];
        if (nloc == 0u) { xcd_barrier_complete(bar, b.x, nloc, nx); b.st[0] = nloc; b.st[1] = nx; }
        const unsigned old = xb_add(&bar[XB_XSUB(b.x)], 1u);
        const unsigned gen = old / nloc;
        if (old + 1u == (gen + 1u) * nloc) {
            __builtin_amdgcn_fence(__ATOMIC_RELEASE, "agent");
            asm volatile("s_waitcnt vmcnt(0)" ::: "memory");
            const unsigned og = xb_add(&bar[XB_TOP], 1u);
            const unsigned tg = og / nx;
            if (og + 1u == (tg + 1u) * nx) xb_add(&bar[XB_TOPGEN], 1u);
            else XB_SPIN(xb_ld(&bar[XB_TOPGEN]) == tg, bar);
            __builtin_amdgcn_fence(__ATOMIC_ACQUIRE, "agent");
            xb_add(&bar[XB_XGEN(b.x)], 1u);
            asm volatile("s_waitcnt vmcnt(0)" ::: "memory");
        } else {
            XB_SPIN(xb_ld(&bar[XB_XGEN(b.x)]) == gen, bar);
            __builtin_amdgcn_fence(__ATOMIC_ACQUIRE, "agent");
            asm volatile("s_waitcnt vmcnt(0)" ::: "memory");
        }
    }
    __syncthreads();
}
constexpr int CW_BAR = 4096;
constexpr size_t CTL_ZERO_BYTES = 65536;
constexpr int LDS_BARST_OFF = 131072 + 12288;

constexpr bool FAST_P1 = true, FAST_P3 = true, FAST_P4 = true, FAST_P6 = true, FAST_P7 = true;
constexpr bool FAST_ATTN = true, FAST_SGU = true;
constexpr bool FAST_ANY = FAST_P1 || FAST_P3 || FAST_P4 || FAST_P6 || FAST_P7;
constexpr int N_PHASES = 10;
__global__ void __launch_bounds__(NTHREADS, 2) fwd(Args A) {
    extern __shared__ __attribute__((aligned(16))) unsigned char lds[];
    float* ldsf = (float*)lds;
    const int lo = A.ph_lo, hi = A.ph_hi;
    if (threadIdx.x < 4) ((volatile XLAS unsigned*)((XLAS unsigned char*)lds + LDS_BARST_OFF))[threadIdx.x] = 0u;
    __syncthreads();
    XcdBarrier bar = xcd_barrier_post((unsigned*)(A.ws + WS_CTL) + CW_BAR, (volatile XLAS unsigned*)((XLAS unsigned char*)lds + LDS_BARST_OFF));
#define IN(k) (lo <= (k) && (k) < hi)
#define SEAM(k) do { if (IN(k) && IN((k) + 1)) xcd_barrier(bar); } while (0)
    PG8_LAS unsigned char* l3 = (PG8_LAS unsigned char*)lds;
    if (IN(0)) { if (FAST_ANY) { p0_weights(A, l3); __syncthreads(); } p0_rows(A, ldsf); } SEAM(0);
    if (IN(1)) { if (FAST_P1) p1_fast(A, l3); else p1_naive(A, ldsf); } SEAM(1);
    if (IN(2)) { p1b_fix(A, ldsf); } SEAM(2);
    if (IN(3)) { if (FAST_SGU) fs::sgu_phase(A, l3); else p2_sgu_naive(A); if (FAST_ATTN) { __syncthreads(); fa::attn_phase(A, l3); } else p2_attn_naive(A, ldsf); } SEAM(3);
    if (IN(4)) { if (FAST_P3) p3_fast(A, l3); else p3_naive(A, ldsf); } SEAM(4);
    if (IN(5)) { if (FAST_P4) p4_fast(A, l3); else p4_naive(A, ldsf); } SEAM(5);
    if (IN(6)) { p5_router(A, ldsf); } SEAM(6);
    if (IN(7)) { if (FAST_P6) p6_fast(A, l3); else p6_naive(A, ldsf); } SEAM(7);
    if (IN(8)) { if (FAST_P7) p7_fast(A, l3); else p7_naive(A, ldsf); } SEAM(8);
    if (IN(9)) { p8_combine(A, ldsf); }
#undef IN
#undef SEAM
}

#ifndef MK_N_LAUNCHES
#define MK_N_LAUNCHES 1
#endif
extern "C" void kernel_launch(void* const* d_in, const int* in_sizes, int n_in, void* d_out, int out_size, void* d_ws, size_t ws_size, hipStream_t stream) {
    static int grid = 0;
    if (grid == 0) {
        if (n_in != 22 || out_size != T * DM || ws_size < WS_END) { fprintf(stderr, "kernel_launch: unexpected shapes (n_in %d out %d ws %zu)\n", n_in, out_size, ws_size); grid = -1; return; }
        int dev = 0, cus = 0, per_cu = 0;
        hipGetDevice(&dev); hipDeviceGetAttribute(&cus, hipDeviceAttributeMultiprocessorCount, dev);
        hipFuncSetAttribute((const void*)fwd, hipFuncAttributeMaxDynamicSharedMemorySize, LDS_BYTES);
        hipOccupancyMaxActiveBlocksPerMultiprocessor(&per_cu, (const void*)fwd, NTHREADS, LDS_BYTES);
        if (per_cu < 1) { fprintf(stderr, "kernel_launch: occupancy query says %d blocks per CU\n", per_cu); per_cu = 1; }
        (void)hipGetLastError();
        grid = cus;
    }
    if (grid < 0) return;
    Args a{};
    for (int i = 0; i < 22; ++i) a.in[i] = (const float*)d_in[i];
    a.out = (float*)d_out; a.ws = (unsigned char*)d_ws;
    if (hipMemsetAsync((char*)d_ws + WS_CTL, 0, CTL_ZERO_BYTES, stream) != hipSuccess) { fprintf(stderr, "kernel_launch: memset failed\n"); return; }
    if (MK_N_LAUNCHES == 1) {
        a.ph_lo = 0; a.ph_hi = N_PHASES;
        hipLaunchKernelGGL(fwd, dim3(grid), dim3(NTHREADS), LDS_BYTES, stream, a);
    } else {
        for (int p = 0; p < N_PHASES; ++p) { a.ph_lo = p; a.ph_hi = p + 1; hipLaunchKernelGGL(fwd, dim3(grid), dim3(NTHREADS), LDS_BYTES, stream, a); }
    }
}
```

```cpp
#include <hip/hip_runtime.h>
#include <hip/hip_cooperative_groups.h>
#include <cstdio>
#include <cstdint>
namespace cg = cooperative_groups;

#ifndef STAMP_PHASE
#define STAMP_PHASE -1
#endif
#ifndef STAMP_SEL
#define STAMP_SEL 0
#endif
#ifndef STAMP_SCALE
#define STAMP_SCALE 0.5f
#endif
#ifndef PROBE_ALT
#define PROBE_ALT -1
#endif
constexpr int T = 8192, SEQ = 2048, NB = 4, DM = 2048, SGUW = 1024, FOXW = 1024, NH = 8, HD = 128, CHUNK = 128, NG = 8;
constexpr int INCOLS = 9224, OFF_F = 5120, OFF_GATE = 5128;
constexpr int NEXP = 32, EPG = 8, NGRP = 4, DEXP = 512;
constexpr float EPS = 1e-6f;
constexpr float LOG2E = 1.4426950408889634f;
constexpr float QSCALE = 0.08838834764831845f * LOG2E;
constexpr int NTHREADS = 512, NWAVES = 8;
constexpr int LDS_BYTES = 160 * 1024;
constexpr int MTILE = 256;
constexpr int PMAX = 2 * T + NEXP * MTILE;
constexpr int MT_MAX = PMAX / MTILE;
constexpr int TINY_ROWS = 0;

typedef unsigned short bf16_t;
typedef float f32x4 __attribute__((ext_vector_type(4)));
typedef unsigned u32x4 __attribute__((ext_vector_type(4)));
typedef unsigned u32x2 __attribute__((ext_vector_type(2)));

constexpr size_t MiB = 1u << 20;
constexpr size_t WS_CTL = 0;
constexpr size_t WS_LOGF = 1 * MiB;
constexpr size_t WS_CKL = 2 * MiB;
constexpr size_t WS_TOK = 3 * MiB;
constexpr size_t WS_GATE = 4 * MiB;
constexpr size_t WS_ASG = 5 * MiB;
constexpr size_t WS_WIN = 8 * MiB;
constexpr size_t WS_WPROJ = 44 * MiB;
constexpr size_t WS_WOUT = 52 * MiB;
constexpr size_t WS_WGU = 60 * MiB;
constexpr size_t WS_WD = 188 * MiB;
constexpr size_t WS_H = 252 * MiB;
constexpr size_t WS_MIXED = WS_H;
constexpr size_t WS_U = 284 * MiB;
constexpr size_t WS_V = 300 * MiB;
constexpr size_t WS_G = 316 * MiB;
constexpr size_t WS_YBUF = WS_U;
constexpr size_t WS_Q = 380 * MiB;
constexpr size_t WS_K = 396 * MiB;
constexpr size_t WS_VA = 412 * MiB;
constexpr size_t WS_ACT = WS_Q;
constexpr size_t WS_MIXIN = 428 * MiB;
constexpr size_t WS_H2 = WS_MIXIN;
constexpr size_t WS_END = 460 * MiB;
static_assert((size_t)PMAX * 2048 * 2 <= 96 * MiB && (size_t)PMAX * 512 * 2 <= 32 * MiB, "overlay sizes");

constexpr int CW_CNT = 0;

__device__ __forceinline__ float bf2f(bf16_t v) { return __uint_as_float((unsigned)v << 16); }
__device__ __forceinline__ bf16_t f2bf(float f) { unsigned u = __float_as_uint(f); return (bf16_t)((u + 0x7fffu + ((u >> 16) & 1u)) >> 16); }
__device__ __forceinline__ unsigned pk2(float lo, float hi) { return (unsigned)f2bf(lo) | ((unsigned)f2bf(hi) << 16); }
__device__ __forceinline__ float wave_sum(float v) {
#pragma unroll
    for (int o = 1; o < 64; o <<= 1) v += __shfl_xor(v, o);
    return v;
}
__device__ __forceinline__ float wave_max(float v) {
#pragma unroll
    for (int o = 1; o < 64; o <<= 1) v = fmaxf(v, __shfl_xor(v, o));
    return v;
}
__device__ __forceinline__ float gelu_tanh(float x) {
    const float c = 0.7978845608028654f; const float y = c * (x + 0.044715f * x * x * x);
    return x / (1.0f + __expf(-2.0f * y));
}
__device__ __forceinline__ float sigmoidf_(float x) { return 1.0f / (1.0f + __expf(-x)); }
__device__ __forceinline__ float log_sigmoid(float z) { return fminf(z, 0.f) - log1pf(__expf(-fabsf(z))); }

struct Args {
    const float* in[22];
    float* out;
    unsigned char* ws;
    int ph_lo, ph_hi;
};

template <class AF, class BF, class EF>
__device__ __forceinline__ void naive_gemm_tile(float* lds, int m0, int n0, int M, int N, int K, int Ksplit, AF a, BF b, EF epi) {
    float* As = lds;
    float* Bs = lds + 16 * 132;
    const int tid = threadIdx.x, ty = tid >> 4, tx = tid & 15;
    float acc[4][8], acc1[4][8];
#pragma unroll
    for (int i = 0; i < 4; ++i)
#pragma unroll
        for (int j = 0; j < 8; ++j) { acc[i][j] = 0.f; acc1[i][j] = 0.f; }
    const bool split = Ksplit < K;
#pragma unroll 1
    for (int pass = 0; pass < 2; ++pass) {
        const int kb = pass == 0 ? 0 : Ksplit, ke = pass == 0 ? (split ? Ksplit : K) : K;
        if (pass == 1) {
            if (!split) break;
#pragma unroll
            for (int i = 0; i < 4; ++i)
#pragma unroll
                for (int j = 0; j < 8; ++j) { acc1[i][j] = acc[i][j]; acc[i][j] = 0.f; }
        }
#pragma unroll 1
        for (int k0 = kb; k0 < ke; k0 += 16) {
#pragma unroll
            for (int i = 0; i < 4; ++i) { const int idx = tid + i * 512, r = idx >> 4, kk = idx & 15; const int m = m0 + r; As[kk * 132 + r] = (m < M) ? a(m, k0 + kk) : 0.f; }
#pragma unroll
            for (int i = 0; i < 4; ++i) { const int idx = tid + i * 512, kk = idx >> 7, n = idx & 127; Bs[kk * 132 + n] = (n0 + n < N) ? b(k0 + kk, n0 + n) : 0.f; }
            __syncthreads();
#pragma unroll 4
            for (int kk = 0; kk < 16; ++kk) {
                float av[4], bv[8];
#pragma unroll
                for (int i = 0; i < 4; ++i) av[i] = As[kk * 132 + ty * 4 + i];
#pragma unroll
                for (int j = 0; j < 8; ++j) bv[j] = Bs[kk * 132 + tx * 8 + j];
#pragma unroll
                for (int i = 0; i < 4; ++i)
#pragma unroll
                    for (int j = 0; j < 8; ++j) acc[i][j] = fmaf(av[i], bv[j], acc[i][j]);
            }
            __syncthreads();
        }
    }
#pragma unroll
    for (int i = 0; i < 4; ++i)
#pragma unroll
        for (int j = 0; j < 8; ++j) { const int m = m0 + ty * 4 + i, n = n0 + tx * 8 + j; if (m < M && n < N) epi(m, n, split ? acc1[i][j] : acc[i][j], split ? acc[i][j] : 0.f); }
}
template <class AF, class BF, class EF>
__device__ __forceinline__ void naive_gemm(float* lds, int M, int N, int K, int Ksplit, AF a, BF b, EF epi) {
    const int ntm = (M + 127) / 128, ntn = (N + 127) / 128;
    for (int t = blockIdx.x; t < ntm * ntn; t += gridDim.x) naive_gemm_tile(lds, (t / ntn) * 128, (t % ntn) * 128, M, N, K, Ksplit, a, b, epi);
}

__device__ __forceinline__ void p0_rows(const Args& A, float* ldsf) {
    const float* x = A.in[0]; const float* g1 = A.in[1]; const float* w_in = A.in[2]; const float* b_forget = A.in[4];
    bf16_t* H = (bf16_t*)(A.ws + WS_H); float* LOGF = (float*)(A.ws + WS_LOGF);
    const int tid = threadIdx.x, lane = tid & 63, wave = tid >> 6;
    for (int i = tid; i < DM * 8; i += NTHREADS) ldsf[i] = w_in[(size_t)(i >> 3) * INCOLS + OFF_F + (i & 7)];
    __syncthreads();
    const int gw = blockIdx.x * NWAVES + wave, NGW = gridDim.x * NWAVES;
    for (int row = gw; row < T; row += NGW) {
        const f32x4* xr = (const f32x4*)(x + (size_t)row * DM) + lane;
        float ss = 0.f;
#pragma unroll
        for (int j = 0; j < 8; ++j) { const f32x4 v = xr[64 * j]; ss += v.x * v.x + v.y * v.y + v.z * v.z + v.w * v.w; }
        const float rstd = rsqrtf(wave_sum(ss) * (1.f / DM) + EPS);
        float f[8];
#pragma unroll
        for (int h = 0; h < 8; ++h) f[h] = 0.f;
#pragma unroll 1
        for (int j = 0; j < 8; ++j) {
            const int c0 = 256 * j + 4 * lane; const f32x4 g = *(const f32x4*)(g1 + c0); const f32x4 xv = xr[64 * j];
            f32x4 hv; hv.x = xv.x * rstd * g.x; hv.y = xv.y * rstd * g.y; hv.z = xv.z * rstd * g.z; hv.w = xv.w * rstd * g.w;
            u32x2 o; o.x = pk2(hv.x, hv.y); o.y = pk2(hv.z, hv.w);
            *(u32x2*)(H + (size_t)row * DM + c0) = o;
#pragma unroll
            for (int e = 0; e < 4; ++e) { const float hx = hv[e]; const float* wf = ldsf + (c0 + e) * 8;
#pragma unroll
                for (int h = 0; h < 8; ++h) f[h] = fmaf(hx, wf[h], f[h]); }
        }
#pragma unroll
        for (int h = 0; h < 8; ++h) f[h] = wave_sum(f[h]);
        if (lane < 8) { float z = 0.f;
#pragma unroll
            for (int h = 0; h < 8; ++h) if (lane == h) z = f[h];
            LOGF[(size_t)row * 8 + lane] = log_sigmoid(z + b_forget[lane]); }
    }
}

__device__ __forceinline__ void p1_naive(const Args& A, float* ldsf) {
    const bf16_t* H = (const bf16_t*)(A.ws + WS_H); const float* w_in = A.in[2]; const float* b_gate = A.in[3];
    bf16_t* U = (bf16_t*)(A.ws + WS_U); bf16_t* V = (bf16_t*)(A.ws + WS_V); bf16_t* Q = (bf16_t*)(A.ws + WS_Q); bf16_t* K = (bf16_t*)(A.ws + WS_K);
    bf16_t* VA = (bf16_t*)(A.ws + WS_VA); bf16_t* G = (bf16_t*)(A.ws + WS_G);
    naive_gemm(ldsf, T, 9216, DM, DM,
        [=](int m, int k) { return bf2f(H[(size_t)m * DM + k]); },
        [=](int k, int n) { const int c = n < 5120 ? n : n + 8; return w_in[(size_t)k * INCOLS + c]; },
        [=](int m, int n, float s, float) {
            if (n < 1024) U[(size_t)m * 1024 + n] = f2bf(gelu_tanh(s));
            else if (n < 2048) V[(size_t)m * 1024 + n - 1024] = f2bf(gelu_tanh(s));
            else if (n < 3072) Q[(size_t)m * 1024 + n - 2048] = f2bf(s);
            else if (n < 4096) K[(size_t)m * 1024 + n - 3072] = f2bf(s);
            else if (n < 5120) VA[(size_t)m * 1024 + n - 4096] = f2bf(s);
            else G[(size_t)m * 4096 + n - 5120] = f2bf(sigmoidf_(s + b_gate[n - 5120]));
        });
}

template <int ALT> __device__ __forceinline__ void p1b_fix(const Args& A, float* ldsf) {
    bf16_t* V = (bf16_t*)(A.ws + WS_V); bf16_t* Q = (bf16_t*)(A.ws + WS_Q); bf16_t* K = (bf16_t*)(A.ws + WS_K);
    const size_t altoff = ALT ? ((size_t)((unsigned char*)A.out - (A.ws + WS_V))) / 2 : 0;
    const size_t altq = ALT ? ((size_t)((unsigned char*)A.out + 16 * MiB - (A.ws + WS_Q))) / 2 : 0, altk = ALT ? ((size_t)((unsigned char*)A.out + 32 * MiB - (A.ws + WS_K))) / 2 : 0;
    const float* ln_g = A.in[5]; const float* ln_b = A.in[6]; const float* qg = A.in[9]; const float* kg = A.in[10];
    const int tid = threadIdx.x, lane = tid & 63, wave = tid >> 6;
    const int gw = blockIdx.x * NWAVES + wave, NGW = gridDim.x * NWAVES;
    for (int row = gw; row < T; row += NGW) {
        {
            bf16_t* vr = V + (size_t)row * 1024; float v[16]; float s = 0.f;
#pragma unroll
            for (int j = 0; j < 2; ++j) { const u32x4 w = *(const u32x4*)(vr + 512 * j + 8 * lane);
#pragma unroll
                for (int e = 0; e < 4; ++e) { v[8 * j + 2 * e] = __uint_as_float(w[e] << 16); v[8 * j + 2 * e + 1] = __uint_as_float(w[e] & 0xffff0000u); } }
#pragma unroll
            for (int i = 0; i < 16; ++i) s += v[i];
            const float mean = wave_sum(s) * (1.f / 1024.f); float q = 0.f;
#pragma unroll
            for (int i = 0; i < 16; ++i) { v[i] -= mean; q += v[i] * v[i]; }
            const float rstd = rsqrtf(wave_sum(q) * (1.f / 1024.f) + EPS);
#pragma unroll
            for (int j = 0; j < 2; ++j) { const int c0 = 512 * j + 8 * lane; u32x4 o;
#pragma unroll
                for (int e = 0; e < 4; ++e) o[e] = pk2(v[8 * j + 2 * e] * rstd * ln_g[c0 + 2 * e] + ln_b[c0 + 2 * e], v[8 * j + 2 * e + 1] * rstd * ln_g[c0 + 2 * e + 1] + ln_b[c0 + 2 * e + 1]);
                *(u32x4*)(vr + altoff + c0) = o; }
        }
#pragma unroll
        for (int which = 0; which < 2; ++which) {
            bf16_t* pr = (which == 0 ? Q : K) + (size_t)row * 1024 + 16 * lane; const float* gg = which == 0 ? qg : kg; float v[16]; float s = 0.f;
#pragma unroll
            for (int j = 0; j < 2; ++j) { const u32x4 w = *(const u32x4*)(pr + 8 * j);
#pragma unroll
                for (int e = 0; e < 4; ++e) { v[8 * j + 2 * e] = __uint_as_float(w[e] << 16); v[8 * j + 2 * e + 1] = __uint_as_float(w[e] & 0xffff0000u); } }
#pragma unroll
            for (int i = 0; i < 16; ++i) s += v[i] * v[i];
            s += __shfl_xor(s, 1); s += __shfl_xor(s, 2); s += __shfl_xor(s, 4);
            const float sc = rsqrtf(s * (1.f / 128.f) + EPS) * (which == 0 ? QSCALE : 1.f); const int d0 = (16 * lane) & 127;
#pragma unroll
            for (int j = 0; j < 2; ++j) { u32x4 o;
#pragma unroll
                for (int e = 0; e < 4; ++e) o[e] = pk2(v[8 * j + 2 * e] * sc * gg[d0 + 8 * j + 2 * e], v[8 * j + 2 * e + 1] * sc * gg[d0 + 8 * j + 2 * e + 1]);
                *(u32x4*)(pr + (which == 0 ? altq : altk) + 8 * j) = o; }
        }
    }
    if (blockIdx.x < NB * NH) {
        const int b = blockIdx.x / NH, h = blockIdx.x % NH; const float* LOGF = (const float*)(A.ws + WS_LOGF); float* CKL = (float*)(A.ws + WS_CKL) + (size_t)blockIdx.x * SEQ + (ALT ? 65536 : 0);
        float v[4]; float s = 0.f;
#pragma unroll
        for (int i = 0; i < 4; ++i) { v[i] = LOGF[(size_t)(b * SEQ + tid * 4 + i) * 8 + h]; s += v[i]; }
        float incl = s;
#pragma unroll
        for (int o = 1; o < 64; o <<= 1) { const float t = __shfl_up(incl, o); if (lane >= o) incl += t; }
        __syncthreads();
        if (lane == 63) ldsf[wave] = incl;
        __syncthreads();
        float base = 0.f;
        for (int w = 0; w < wave; ++w) base += ldsf[w];
        float run = base + incl - s;
#pragma unroll
        for (int i = 0; i < 4; ++i) { run += v[i]; CKL[tid * 4 + i] = run * LOG2E; }
        __syncthreads();
    }
}

__device__ __forceinline__ void p2_sgu_naive(const Args& A) {
    const bf16_t* U = (const bf16_t*)(A.ws + WS_U); const bf16_t* V = (const bf16_t*)(A.ws + WS_V); bf16_t* MIXIN = (bf16_t*)(A.ws + WS_MIXIN);
    const float* wsp = A.in[7]; const float* bsp = A.in[8];
    const int tid = threadIdx.x, tt = tid >> 2, dp = tid & 3;
    for (int u = blockIdx.x; u < (T / CHUNK) * NG; u += gridDim.x) {
        const int rc = u / NG, g = u % NG; const int row0 = rc * CHUNK;
        float acc[32];
#pragma unroll
        for (int i = 0; i < 32; ++i) acc[i] = 0.f;
        for (int ss = 0; ss <= tt; ++ss) {
            const float w = wsp[((size_t)g * CHUNK + tt) * CHUNK + ss];
            const bf16_t* vr = V + (size_t)(row0 + ss) * 1024 + g * 128 + dp * 32;
#pragma unroll
            for (int i = 0; i < 32; ++i) acc[i] = fmaf(w, bf2f(vr[i]), acc[i]);
        }
        const float bb = bsp[g * CHUNK + tt];
        const bf16_t* ur = U + (size_t)(row0 + tt) * 1024 + g * 128 + dp * 32; bf16_t* orow = MIXIN + (size_t)(row0 + tt) * 2048 + g * 128 + dp * 32;
#pragma unroll
        for (int i = 0; i < 32; ++i) orow[i] = f2bf(bf2f(ur[i]) * (acc[i] + bb));
    }
}
__device__ __forceinline__ void p2_attn_naive(const Args& A, float* ldsf) {
    const bf16_t* Q = (const bf16_t*)(A.ws + WS_Q); const bf16_t* K = (const bf16_t*)(A.ws + WS_K); const bf16_t* VA = (const bf16_t*)(A.ws + WS_VA);
    const float* CKL = (const float*)(A.ws + WS_CKL); bf16_t* MIXIN = (bf16_t*)(A.ws + WS_MIXIN);
    const int tid = threadIdx.x, lane = tid & 63, wave = tid >> 6;
    float* qs = ldsf + wave * 128;
    const int gw = blockIdx.x * NWAVES + wave, NGW = gridDim.x * NWAVES;
    for (int item = gw; item < T * NH; item += NGW) {
        const int row = item / NH, h = item % NH, b = row / SEQ, t = row % SEQ;
        const bf16_t* qr = Q + (size_t)row * 1024 + h * 128;
        qs[lane] = bf2f(qr[lane]); qs[64 + lane] = bf2f(qr[64 + lane]);
        __builtin_amdgcn_s_waitcnt(0);
        const float* ck = CKL + (size_t)(b * NH + h) * SEQ;
        float m = -1e30f, l = 0.f, o0 = 0.f, o1 = 0.f;
        for (int s0 = 0; s0 <= t; s0 += 64) {
            const int s = s0 + lane; float sc = -INFINITY;
            if (s <= t) { const bf16_t* kr = K + (size_t)(b * SEQ + s) * 1024 + h * 128; float d = 0.f;
                for (int c = 0; c < 16; ++c) { const u32x4 w = *(const u32x4*)(kr + 8 * c);
#pragma unroll
                    for (int e = 0; e < 4; ++e) { d = fmaf(qs[8 * c + 2 * e], __uint_as_float(w[e] << 16), d); d = fmaf(qs[8 * c + 2 * e + 1], __uint_as_float(w[e] & 0xffff0000u), d); } }
                sc = d - ck[s]; }
            const float mn = fmaxf(m, wave_max(sc)); const float alpha = exp2f(m - mn); const float p = exp2f(sc - mn);
            l = l * alpha + wave_sum(p); o0 *= alpha; o1 *= alpha; m = mn;
            const int nk = min(64, t - s0 + 1);
            for (int j = 0; j < nk; ++j) { const float pj = __shfl(p, j); const unsigned w = *(const unsigned*)(VA + (size_t)(b * SEQ + s0 + j) * 1024 + h * 128 + 2 * lane);
                o0 = fmaf(pj, __uint_as_float(w << 16), o0); o1 = fmaf(pj, __uint_as_float(w & 0xffff0000u), o1); }
        }
        const float il = 1.f / l;
        *(unsigned*)(MIXIN + (size_t)row * 2048 + 1024 + h * 128 + 2 * lane) = pk2(o0 * il, o1 * il);
    }
}

__device__ __forceinline__ void p3_naive(const Args& A, float* ldsf) {
    const bf16_t* MIXIN = (const bf16_t*)(A.ws + WS_MIXIN); const bf16_t* G = (const bf16_t*)(A.ws + WS_G); bf16_t* MIXED = (bf16_t*)(A.ws + WS_MIXED);
    const float* wps = A.in[11]; const float* wpf = A.in[12];
    naive_gemm(ldsf, T, DM, 2048, 1024,
        [=](int m, int k) { return bf2f(MIXIN[(size_t)m * 2048 + k]); },
        [=](int k, int n) { return k < 1024 ? wps[(size_t)k * DM + n] : wpf[(size_t)(k - 1024) * DM + n]; },
        [=](int m, int n, float s1, float s2) { MIXED[(size_t)m * DM + n] = f2bf(bf2f(G[(size_t)m * 4096 + n]) * s1 + bf2f(G[(size_t)m * 4096 + 2048 + n]) * s2); });
}
__device__ __forceinline__ void p4_naive(const Args& A, float* ldsf) {
    const bf16_t* MIXED = (const bf16_t*)(A.ws + WS_MIXED); const float* wo = A.in[13]; const float* x = A.in[0]; float* X1 = A.out;
    naive_gemm(ldsf, T, DM, DM, DM,
        [=](int m, int k) { return bf2f(MIXED[(size_t)m * DM + k]); },
        [=](int k, int n) { return wo[(size_t)k * DM + n]; },
        [=](int m, int n, float s, float) { X1[(size_t)m * DM + n] = x[(size_t)m * DM + n] + s; });
}

template <int ALT> __device__ __forceinline__ void p5_router(const Args& A, float* ldsf) {
    const float* X1 = A.out; const float* g2 = A.in[14]; const float* wrg = A.in[15]; const float* brg = A.in[16]; const float* wre = A.in[17]; const float* bre = A.in[18];
    bf16_t* H2 = (bf16_t*)(A.ws + WS_H2); unsigned* cnt = (unsigned*)(A.ws + WS_CTL) + CW_CNT + (ALT ? 64 : 0);
    int* TOK = (int*)(A.ws + (ALT ? WS_H : WS_TOK)); float* GATE = (float*)(A.ws + (ALT ? WS_H + 2 * MiB : WS_GATE)); int* ASG = (int*)(A.ws + (ALT ? WS_H + 4 * MiB : WS_ASG));
    const int tid = threadIdx.x, lane = tid & 63, wave = tid >> 6, r = tid >> 4, ks = tid & 15;
    float* Ws = ldsf;
    float* Xs = ldsf + 256 * 36;
    float* rs = Xs + 32 * 260;
    int* hist = (int*)(rs + 32);
    int* hbase = hist + 32;
    int* sel = hbase + 32;
    int* lpos = sel + 64;
    float* selw = (float*)(lpos + 64);
    for (int rb = blockIdx.x; rb < T / 32; rb += gridDim.x) {
        const int row0 = rb * 32;
        for (int i = 0; i < 4; ++i) { const int rr = wave * 4 + i; const f32x4* xr = (const f32x4*)(X1 + (size_t)(row0 + rr) * DM) + lane; float ss = 0.f;
#pragma unroll
            for (int j = 0; j < 8; ++j) { const f32x4 v = xr[64 * j]; ss += v.x * v.x + v.y * v.y + v.z * v.z + v.w * v.w; }
            ss = wave_sum(ss); if (lane == 0) rs[rr] = rsqrtf(ss * (1.f / DM) + EPS); }
        if (tid < 32) hist[tid] = 0;
        __syncthreads();
        float acc[36];
#pragma unroll
        for (int j = 0; j < 36; ++j) acc[j] = 0.f;
        for (int k0 = 0; k0 < DM; k0 += 256) {
            for (int i = tid; i < 256 * 36; i += NTHREADS) { const int kk = i / 36, j = i % 36; Ws[i] = j < 4 ? wrg[(size_t)(k0 + kk) * 4 + j] : wre[(size_t)(k0 + kk) * 32 + j - 4]; }
            for (int i = tid; i < 32 * 256; i += NTHREADS) { const int rr = i >> 8, kk = i & 255; const float hv = X1[(size_t)(row0 + rr) * DM + k0 + kk] * rs[rr] * g2[k0 + kk];
                Xs[rr * 260 + kk] = hv; H2[(size_t)(row0 + rr) * DM + k0 + kk] = f2bf(hv); }
            __syncthreads();
            for (int kk = ks; kk < 256; kk += 16) { const float xv = Xs[r * 260 + kk]; const float* wr = Ws + kk * 36;
#pragma unroll
                for (int j = 0; j < 36; ++j) acc[j] = fmaf(xv, wr[j], acc[j]); }
            __syncthreads();
        }
#pragma unroll
        for (int j = 0; j < 36; ++j) { float v = acc[j]; v += __shfl_xor(v, 1); v += __shfl_xor(v, 2); v += __shfl_xor(v, 4); v += __shfl_xor(v, 8); acc[j] = v; }
        if (ks == 0) {
            float gl[4]; int grp = 0; float gm;
#pragma unroll
            for (int j = 0; j < 4; ++j) gl[j] = acc[j] + brg[j];
            gm = gl[0];
#pragma unroll
            for (int j = 1; j < 4; ++j) if (gl[j] > gm) { gm = gl[j]; grp = j; }
            float den = 0.f;
#pragma unroll
            for (int j = 0; j < 4; ++j) den += __expf(gl[j] - gm);
            const float pg = 1.f / den;
            float el[8];
#pragma unroll
            for (int j = 0; j < 8; ++j) { float v = 0.f;
#pragma unroll
                for (int g = 0; g < 4; ++g) if (g == grp) v = acc[4 + g * 8 + j] + bre[g * 8 + j];
                el[j] = v; }
            int i0 = 0; float v0 = el[0];
#pragma unroll
            for (int j = 1; j < 8; ++j) if (el[j] > v0) { v0 = el[j]; i0 = j; }
            int i1 = -1; float v1 = -INFINITY;
#pragma unroll
            for (int j = 0; j < 8; ++j) if (j != i0 && el[j] > v1) { v1 = el[j]; i1 = j; }
            const float e1 = __expf(v1 - v0); const float w0 = pg / (1.f + e1), w1 = pg * e1 / (1.f + e1);
            const int ea = grp * 8 + i0, eb = grp * 8 + i1;
            sel[r * 2] = ea; sel[r * 2 + 1] = eb; selw[r * 2] = w0; selw[r * 2 + 1] = w1;
            lpos[r * 2] = atomicAdd(&hist[ea], 1); lpos[r * 2 + 1] = atomicAdd(&hist[eb], 1);
        }
        __syncthreads();
        if (tid < 32) hbase[tid] = hist[tid] > 0 ? (int)atomicAdd(&cnt[tid], (unsigned)hist[tid]) : 0;
        __syncthreads();
        if (tid < 64) { const int e = sel[tid], pos = hbase[e] + lpos[tid]; const int tok = row0 + (tid >> 1);
            TOK[(size_t)e * T + pos] = tok; GATE[(size_t)e * T + pos] = selw[tid]; ASG[tok * 2 + (tid & 1)] = (e << 16) | pos; }
        __syncthreads();
    }
}

template <int ALT> __device__ __forceinline__ void p5_router2(const Args& A, float* ldsf) {
    const float* X1 = A.out; const float* g2 = A.in[14]; const float* wrg = A.in[15]; const float* brg = A.in[16]; const float* wre = A.in[17]; const float* bre = A.in[18];
    bf16_t* H2 = (bf16_t*)(A.ws + WS_H2); unsigned* cnt = (unsigned*)(A.ws + WS_CTL) + CW_CNT + (ALT ? 64 : 0);
    int* TOK = (int*)(A.ws + (ALT ? WS_H : WS_TOK)); float* GATE = (float*)(A.ws + (ALT ? WS_H + 2 * MiB : WS_GATE)); int* ASG = (int*)(A.ws + (ALT ? WS_H + 4 * MiB : WS_ASG));
    const int tid = threadIdx.x, lane = tid & 63, wave = tid >> 6;
    constexpr int XP = 260, XB = 32 * XP, WP = 40, WB = 256 * WP;
    float* Xs = ldsf;
    float* Ws = ldsf + 2 * XB;
    float* misc = ldsf + 2 * XB + 2 * WB;
    float* rs = misc;
    float* lg = misc + 32;
    int* hist = (int*)(misc + 32 + 1280); int* hbase = hist + 32; int* sel = hbase + 32; int* lpos = sel + 64; float* selw = (float*)(lpos + 64);
    const int kh2 = lane >> 5, rp = (lane >> 1) & 15, cg = lane & 1;
    for (int rb = blockIdx.x; rb < T / 32; rb += gridDim.x) {
        const int row0 = rb * 32;
        float ssq[4] = {0.f, 0.f, 0.f, 0.f};
        float acc0[20], acc1[20];
#pragma unroll
        for (int j = 0; j < 20; ++j) { acc0[j] = 0.f; acc1[j] = 0.f; }
        if (tid < 32) hist[tid] = 0;
        f32x4 xr[4], wv[5], gv;
        for (int i = tid; i < 2 * 256; i += NTHREADS) *(f32x4*)(Ws + (i >> 8) * WB + (i & 255) * WP + 36) = (f32x4){0.f, 0.f, 0.f, 0.f};
#define R2_LOAD(k0) do { gv = *(const f32x4*)(g2 + (k0) + 4 * (tid & 63)); \
        _Pragma("unroll") for (int i = 0; i < 4; ++i) xr[i] = *(const f32x4*)(X1 + (size_t)(row0 + wave + 8 * i) * DM + (k0) + 4 * (tid & 63)); \
        _Pragma("unroll") for (int i = 0; i < 5; ++i) { const int idx = tid + i * 512; if (idx < 2304) { const int kk = idx / 9, j4 = idx - kk * 9; \
            wv[i] = j4 == 0 ? *(const f32x4*)(wrg + (size_t)((k0) + kk) * 4) : *(const f32x4*)(wre + (size_t)((k0) + kk) * 32 + 4 * (j4 - 1)); } } } while (0)
#define R2_STORE(buf) do { \
        _Pragma("unroll") for (int i = 0; i < 4; ++i) { ssq[i] += xr[i].x * xr[i].x + xr[i].y * xr[i].y + xr[i].z * xr[i].z + xr[i].w * xr[i].w; \
            *(f32x4*)(Xs + (buf) * XB + (wave + 8 * i) * XP + 4 * (tid & 63)) = xr[i] * gv; } \
        _Pragma("unroll") for (int i = 0; i < 5; ++i) { const int idx = tid + i * 512; if (idx < 2304) { const int kk = idx / 9, j4 = idx - kk * 9; *(f32x4*)(Ws + (buf) * WB + kk * WP + 4 * j4) = wv[i]; } } } while (0)
        R2_LOAD(0); R2_STORE(0);
        __syncthreads();
#pragma unroll 1
        for (int c = 0; c < 8; ++c) {
            const int buf = c & 1;
            if (c < 7) R2_LOAD((c + 1) * 256);
            const float* xa = Xs + buf * XB + (2 * rp) * XP + (wave * 2 + kh2) * 16; const float* wa = Ws + buf * WB + ((wave * 2 + kh2) * 16) * WP + 20 * cg;
#pragma unroll 1
            for (int k4 = 0; k4 < 4; ++k4) {
                const f32x4 x0 = *(const f32x4*)(xa + 4 * k4), x1 = *(const f32x4*)(xa + XP + 4 * k4);
#pragma unroll
                for (int kk = 0; kk < 4; ++kk) { const float* wr = wa + (4 * k4 + kk) * WP;
#pragma unroll
                    for (int j4 = 0; j4 < 5; ++j4) { const f32x4 w = *(const f32x4*)(wr + 4 * j4);
#pragma unroll
                        for (int e = 0; e < 4; ++e) { acc0[4 * j4 + e] = fmaf(x0[kk], w[e], acc0[4 * j4 + e]); acc1[4 * j4 + e] = fmaf(x1[kk], w[e], acc1[4 * j4 + e]); } }
                    asm volatile("" ::: "memory"); }
            }
            if (c < 7) R2_STORE(buf ^ 1);
            __syncthreads();
        }
#undef R2_LOAD
#undef R2_STORE
#pragma unroll
        for (int j = 0; j < 20; ++j) { acc0[j] += __shfl_xor(acc0[j], 32); acc1[j] += __shfl_xor(acc1[j], 32); }
        float* red = Xs;
        if (kh2 == 0) {
#pragma unroll
            for (int j = 0; j < 20; ++j) { red[(wave * 32 + 2 * rp) * 40 + 20 * cg + j] = acc0[j]; red[(wave * 32 + 2 * rp + 1) * 40 + 20 * cg + j] = acc1[j]; } }
#pragma unroll
        for (int i = 0; i < 4; ++i) { const float s = wave_sum(ssq[i]); if (lane == 0) rs[wave + 8 * i] = rsqrtf(s * (1.f / DM) + EPS); }
        __syncthreads();
        for (int i = tid; i < 32 * 40; i += NTHREADS) { float s = 0.f;
#pragma unroll
            for (int w = 0; w < 8; ++w) s += red[w * 1280 + i];
            lg[i] = s * rs[i / 40]; }
        __syncthreads();
#pragma unroll 1
        for (int i = 0; i < 4; ++i) { const int rr = wave + 8 * i; const float rstd = rs[rr]; const float* xp = X1 + (size_t)(row0 + rr) * DM; bf16_t* hp = H2 + (size_t)(row0 + rr) * DM;
#pragma unroll 2
            for (int j = 0; j < 8; ++j) { const int c0 = 256 * j + 4 * lane; const f32x4 v = *(const f32x4*)(xp + c0), g = *(const f32x4*)(g2 + c0);
                u32x2 o; o.x = pk2(v.x * rstd * g.x, v.y * rstd * g.y); o.y = pk2(v.z * rstd * g.z, v.w * rstd * g.w); *(u32x2*)(hp + c0) = o; } }
        if (tid < 32) {
            const int r = tid; const float* L = lg + r * 40;
            float gl[4]; int grp = 0;
#pragma unroll
            for (int j = 0; j < 4; ++j) gl[j] = L[j] + brg[j];
            float gm = gl[0];
#pragma unroll
            for (int j = 1; j < 4; ++j) if (gl[j] > gm) { gm = gl[j]; grp = j; }
            float den = 0.f;
#pragma unroll
            for (int j = 0; j < 4; ++j) den += __expf(gl[j] - gm);
            const float pg = 1.f / den;
            float el[8];
#pragma unroll
            for (int j = 0; j < 8; ++j) el[j] = L[4 + grp * 8 + j] + bre[grp * 8 + j];
            int i0 = 0; float v0 = el[0];
#pragma unroll
            for (int j = 1; j < 8; ++j) if (el[j] > v0) { v0 = el[j]; i0 = j; }
            int i1 = -1; float v1 = -INFINITY;
#pragma unroll
            for (int j = 0; j < 8; ++j) if (j != i0 && el[j] > v1) { v1 = el[j]; i1 = j; }
            const float e1 = __expf(v1 - v0); const float w0 = pg / (1.f + e1), w1 = pg * e1 / (1.f + e1);
            const int ea = grp * 8 + i0, eb = grp * 8 + i1;
            sel[r * 2] = ea; sel[r * 2 + 1] = eb; selw[r * 2] = w0; selw[r * 2 + 1] = w1;
            lpos[r * 2] = atomicAdd(&hist[ea], 1); lpos[r * 2 + 1] = atomicAdd(&hist[eb], 1);
        }
        __syncthreads();
        if (tid < 32) hbase[tid] = hist[tid] > 0 ? (int)atomicAdd(&cnt[tid], (unsigned)hist[tid]) : 0;
        __syncthreads();
        if (tid < 64) { const int e = sel[tid], pos = hbase[e] + lpos[tid]; const int tok = row0 + (tid >> 1);
            TOK[(size_t)e * T + pos] = tok; GATE[(size_t)e * T + pos] = selw[tid]; ASG[tok * 2 + (tid & 1)] = (e << 16) | pos; }
        __syncthreads();
    }
}

__device__ __forceinline__ void expert_layout(const unsigned* cnt, int* pstart  ) {
    int acc = 0;
    for (int e = 0; e < NEXP; ++e) { pstart[e] = acc; acc += ((int)cnt[e] + MTILE - 1) / MTILE * MTILE; }
    pstart[NEXP] = acc;
}

__device__ __forceinline__ void p6_naive(const Args& A, float* ldsf) {
    const bf16_t* H2 = (const bf16_t*)(A.ws + WS_H2); const float* wg = A.in[19]; const float* wu = A.in[20]; bf16_t* ACT = (bf16_t*)(A.ws + WS_ACT);
    const unsigned* cnt = (const unsigned*)(A.ws + WS_CTL) + CW_CNT; const int* TOK = (const int*)(A.ws + WS_TOK);
    int* ps = (int*)(ldsf + 2 * 16 * 132);
    if (threadIdx.x == 0) expert_layout(cnt, ps);
    __syncthreads();
    int ntot = 0;
    for (int e = 0; e < NEXP; ++e) ntot += (((int)cnt[e] + 127) / 128) * 4;
    for (int t = blockIdx.x; t < ntot; t += gridDim.x) {
        int e = 0, rem = t;
        for (; e < NEXP; ++e) { const int n = (((int)cnt[e] + 127) / 128) * 4; if (rem < n) break; rem -= n; }
        const int c = (int)cnt[e]; const int tm = rem / 4, tn = rem % 4; const int* tl = TOK + (size_t)e * T; const int prow = ps[e];
        const float* wge = wg + (size_t)e * DM * DEXP; const float* wue = wu + (size_t)e * DM * DEXP;
        naive_gemm_tile(ldsf, tm * 128, tn * 128, c, DEXP, 2 * DM, DM,
            [=](int m, int k) { return bf2f(H2[(size_t)tl[m] * DM + (k & (DM - 1))]); },
            [=](int k, int n) { return k < DM ? wge[(size_t)k * DEXP + n] : wue[(size_t)(k - DM) * DEXP + n]; },
            [=](int m, int n, float sg, float su) { ACT[(size_t)(prow + m) * DEXP + n] = f2bf(sg / (1.f + __expf(-sg)) * su); });
    }
}
__device__ __forceinline__ void p7_naive(const Args& A, float* ldsf) {
    const bf16_t* ACT = (const bf16_t*)(A.ws + WS_ACT); const float* wd = A.in[21]; bf16_t* YBUF = (bf16_t*)(A.ws + WS_YBUF);
    const unsigned* cnt = (const unsigned*)(A.ws + WS_CTL) + CW_CNT; const float* GATE = (const float*)(A.ws + WS_GATE);
    int* ps = (int*)(ldsf + 2 * 16 * 132);
    if (threadIdx.x == 0) expert_layout(cnt, ps);
    __syncthreads();
    int ntot = 0;
    for (int e = 0; e < NEXP; ++e) ntot += (((int)cnt[e] + 127) / 128) * 16;
    for (int t = blockIdx.x; t < ntot; t += gridDim.x) {
        int e = 0, rem = t;
        for (; e < NEXP; ++e) { const int n = (((int)cnt[e] + 127) / 128) * 16; if (rem < n) break; rem -= n; }
        const int c = (int)cnt[e]; const int tm = rem / 16, tn = rem % 16; const float* gl = GATE + (size_t)e * T; const int prow = ps[e];
        const float* wde = wd + (size_t)e * DEXP * DM;
        naive_gemm_tile(ldsf, tm * 128, tn * 128, c, DM, DEXP, DEXP,
            [=](int m, int k) { return bf2f(ACT[(size_t)(prow + m) * DEXP + k]); },
            [=](int k, int n) { return wde[(size_t)k * DM + n]; },
            [=](int m, int n, float s, float) { YBUF[(size_t)(prow + m) * DM + n] = f2bf(s * gl[m]); });
    }
}

template <int ALT> __device__ __forceinline__ void p8_combine(const Args& A, float* ldsf, const float dlt = 0.f) {
    float* X1 = A.out; float* XO = ALT ? (float*)(A.ws + WS_WGU) : A.out; const bf16_t* YBUF = (const bf16_t*)(A.ws + WS_YBUF); const int* ASG = (const int*)(A.ws + WS_ASG);
    const unsigned* cnt = (const unsigned*)(A.ws + WS_CTL) + CW_CNT;
    int* ps = (int*)ldsf;
    if (threadIdx.x == 0) expert_layout(cnt, ps);
    __syncthreads();
    float dl2 = dlt;
    if (STAMP_PHASE == 97) { int v = 0, mx = 0, mn = 1 << 30, nt_ = 0, tiny = 0, half = 0; for (int e = 0; e < NEXP; ++e) { const int c = (int)cnt[e]; mx = c > mx ? c : mx; mn = c < mn ? c : mn; nt_ += (c + 255) / 256; const int rem = c % 256; tiny += (rem > 0 && rem <= 64) ? 1 : 0; half += (rem > 0 && rem <= 128) ? 1 : 0; }
        v = STAMP_SEL == 0 ? nt_ : STAMP_SEL == 1 ? mx : STAMP_SEL == 2 ? mn : STAMP_SEL == 3 ? tiny : half; dl2 = 0.01f * (float)v; }
    const int tid = threadIdx.x, lane = tid & 63, wave = tid >> 6;
    const int gw = blockIdx.x * NWAVES + wave, NGW = gridDim.x * NWAVES;
    for (int row = gw; row < T; row += NGW) {
        const int a0 = ASG[row * 2], a1 = ASG[row * 2 + 1];
        const bf16_t* y0 = YBUF + (size_t)(ps[a0 >> 16] + (a0 & 0xffff)) * DM; const bf16_t* y1 = YBUF + (size_t)(ps[a1 >> 16] + (a1 & 0xffff)) * DM;
        float* xr = X1 + (size_t)row * DM;
#pragma unroll
        for (int j = 0; j < 4; ++j) { const int c0 = 512 * j + 8 * lane; const u32x4 w0 = *(const u32x4*)(y0 + c0), w1 = *(const u32x4*)(y1 + c0);
            f32x4 xa = *(const f32x4*)(xr + c0), xb = *(const f32x4*)(xr + c0 + 4);
            xa.x += __uint_as_float(w0[0] << 16) + __uint_as_float(w1[0] << 16); xa.y += __uint_as_float(w0[0] & 0xffff0000u) + __uint_as_float(w1[0] & 0xffff0000u);
            xa.z += __uint_as_float(w0[1] << 16) + __uint_as_float(w1[1] << 16); xa.w += __uint_as_float(w0[1] & 0xffff0000u) + __uint_as_float(w1[1] & 0xffff0000u);
            xb.x += __uint_as_float(w0[2] << 16) + __uint_as_float(w1[2] << 16); xb.y += __uint_as_float(w0[2] & 0xffff0000u) + __uint_as_float(w1[2] & 0xffff0000u);
            xb.z += __uint_as_float(w0[3] << 16) + __uint_as_float(w1[3] << 16); xb.w += __uint_as_float(w0[3] & 0xffff0000u) + __uint_as_float(w1[3] & 0xffff0000u);
            if (STAMP_PHASE >= 0) { xa += dl2; xb += dl2; }
            *(f32x4*)(XO + (size_t)row * DM + c0) = xa; *(f32x4*)(XO + (size_t)row * DM + c0 + 4) = xb; }
    }
}

namespace pg8 {
#define PG8_LAS __attribute__((address_space(3)))
typedef short bf16x8 __attribute__((ext_vector_type(8)));
constexpr int BM = 256, BK = 64, HALF = 128, HTB = HALF * BK * 2, STAGE_BYTES = 8 * HTB, NXCD = 8, WGM = 8;
__host__ __device__ __forceinline__ int lds_byte(int r, int c) { const int st = (r >> 4) * 2 + (c >> 5), rr = r & 15, cc = c & 31, ob = rr * 64 + cc * 2; return st * 1024 + (ob ^ (((ob >> 9) & 1) << 5)); }
__host__ __device__ __forceinline__ void stage_rc(int b, int& R, int& C) { const int st = b / 1024, sb = b % 1024, swz = sb ^ (((sb >> 9) & 1) << 5); R = (st >> 1) * 16 + swz / 64; C = (st & 1) * 32 + (swz % 64) / 2; }
__host__ __device__ __forceinline__ int perm32(int rho) { const int n = rho >> 4, i = rho & 15; return 8 * (i >> 2) + 4 * n + (i & 3); }

struct Unit { const char* A; const char* B; int pm, pn, x0, x1, x2, x3; };

struct DenseOrder {
    const char* A; const char* Bt; int K, nM, nN, nwg, G, c;
    __device__ void init(const void* A_, const void* Bt_, int M, int N, int K_, int G_, int c_) { A = (const char*)A_; Bt = (const char*)Bt_; K = K_; nM = M / BM; nN = N / BM; nwg = nM * nN; G = G_; c = c_; }
    __device__ bool next(int i, Unit& u) const {
        const long L = (long)i * G + c; if (L >= nwg) return false;
        int wgid = (int)L; { const int q = nwg / NXCD, r = nwg % NXCD, xcd = wgid % NXCD, off = wgid / NXCD; wgid = (xcd < r ? xcd * (q + 1) : r * (q + 1) + (xcd - r) * q) + off; }
        const int nig = WGM * nN, gid = wgid / nig, fm = gid * WGM, gsz = (nM - fm) < WGM ? (nM - fm) : WGM;
        u.pm = fm + ((wgid % nig) % gsz); u.pn = (wgid % nig) / gsz; u.x0 = 0; u.x1 = 0; u.x2 = 0; u.x3 = 0;
        u.A = A + (size_t)u.pm * BM * K * 2; u.B = Bt + (size_t)u.pn * BM * K * 2; return true;
    }
    __device__ __forceinline__ void rows(const Unit&, unsigned (&)[2][2], const int (&)[2]) const {}
};

__device__ __forceinline__ unsigned cvt_pk_bf16(float lo, float hi) { unsigned r; asm volatile("v_cvt_pk_bf16_f32 %0, %1, %2" : "=v"(r) : "v"(lo), "v"(hi)); return r; }

template <class Epi, class Sched, bool ALIGN_EPI, bool GATHER, bool SKIP = false>
__device__ __forceinline__ void gemm_phase(PG8_LAS unsigned char* lds, const int K, const Sched& S, const Epi& E) {
    const int tid = threadIdx.x, wid = __builtin_amdgcn_readfirstlane(tid >> 6), lane = tid & 63, wr = wid >> 2, wc = wid & 3, fr = lane & 15, fq = lane >> 4;
    const int nt = K / BK;
    unsigned voffA[2], voffB[2]; int RA[2];
#pragma unroll
    for (int i = 0; i < 2; ++i) { int R, C; stage_rc(tid * 16 + i * 8192, R, C); const int Rb = Epi::PERM ? ((R & ~31) + perm32(R & 31)) : R;
        voffA[i] = GATHER ? (unsigned)(C * 2) : (unsigned)(R * K + C) * 2u; voffB[i] = (unsigned)(Rb * K + C) * 2u; RA[i] = R; }
    const size_t kstep = (size_t)(BK * 2);
    const size_t hstep = (size_t)HALF * K * 2;
    const size_t hstepA = GATHER ? 0 : hstep;
    const unsigned ldsw = (unsigned)wid * 1024u;
    const int aoff = lds_byte(wr * 64 + fr, fq * 8), boff = lds_byte(wc * 32 + fr, fq * 8);
    unsigned gA[2][2], gAn[2][2];
#define PG8_SA(b, h) (((b) * 2 + (h)) * HTB)
#define PG8_SB(b, h) ((4 + (b) * 2 + (h)) * HTB)
#define PG8_STAGE(bufoff, gbase, voff) do { _Pragma("unroll") for (int _i = 0; _i < 2; ++_i) \
        __builtin_amdgcn_global_load_lds((const unsigned*)((const char*)(gbase) + (voff)[_i]), (PG8_LAS unsigned*)(lds + (bufoff) + ldsw + _i * 8192), 16, 0, 0); } while (0)
#define PG8_STAGE_A(bufoff, gbase, h, nx) do { _Pragma("unroll") for (int _i = 0; _i < 2; ++_i) { \
        const unsigned _o = GATHER ? ((nx) ? gAn[h][_i] : gA[h][_i]) + voffA[_i] : voffA[_i]; \
        __builtin_amdgcn_global_load_lds((const unsigned*)((const char*)(gbase) + (h) * hstepA + _o), (PG8_LAS unsigned*)(lds + (bufoff) + ldsw + _i * 8192), 16, 0, 0); } } while (0)
#define PG8_LDA(dst, b, h) do { _Pragma("unroll") for (int m = 0; m < 4; ++m) _Pragma("unroll") for (int k = 0; k < 2; ++k) dst[m][k] = *(const PG8_LAS bf16x8*)(lds + PG8_SA(b, h) + aoff + m * 2048 + k * 1024); } while (0)
#define PG8_LDB(dst, b, h) do { _Pragma("unroll") for (int n = 0; n < 2; ++n) _Pragma("unroll") for (int k = 0; k < 2; ++k) dst[n][k] = *(const PG8_LAS bf16x8*)(lds + PG8_SB(b, h) + boff + n * 2048 + k * 1024); } while (0)
#define PG8_MMA(ai, bj, At, Bt) do { __builtin_amdgcn_s_setprio(1); _Pragma("unroll") for (int m = 0; m < 4; ++m) { if (!SKIP || m < ((ai) == 0 ? mc0 : mc1)) { _Pragma("unroll") for (int n = 0; n < 2; ++n) _Pragma("unroll") for (int k = 0; k < 2; ++k) \
        acc[ai][bj][m][n] = __builtin_amdgcn_mfma_f32_16x16x32_bf16(Bt[n][k], At[m][k], acc[ai][bj][m][n], 0, 0, 0); } } __builtin_amdgcn_s_setprio(0); } while (0)
#define PG8_WAIT_V(n) asm volatile("s_waitcnt vmcnt(" #n ")" ::: "memory")
#define PG8_WAIT_L(n) asm volatile("s_waitcnt lgkmcnt(" #n ")" ::: "memory")
#define PG8_BAR __builtin_amdgcn_s_barrier()
#define PG8_SCHED __builtin_amdgcn_sched_barrier(0)
    Unit cur, nxt; int ui = 0;
    if (!S.next(0, cur)) return;
    int mc0 = 4, mc1 = 4;
#define PG8_MC(u) do { if (SKIP) { const int a_ = ((u).x2 - 64 * wr + 15) >> 4, b_ = ((u).x2 - 128 - 64 * wr + 15) >> 4; mc0 = a_ < 0 ? 0 : (a_ > 4 ? 4 : a_); mc1 = b_ < 0 ? 0 : (b_ > 4 ? 4 : b_); } } while (0)
    PG8_MC(cur);
    f32x4 acc[2][2][4][2];
#pragma unroll
    for (int a = 0; a < 2; ++a)
#pragma unroll
        for (int b = 0; b < 2; ++b)
#pragma unroll
            for (int m = 0; m < 4; ++m)
#pragma unroll
                for (int n = 0; n < 2; ++n) acc[a][b][m][n] = (f32x4){0.f, 0.f, 0.f, 0.f};
    bf16x8 At[4][2], B0[2][2], B1[2][2];
    const char* cA = cur.A; const char* cB = cur.B;
    if constexpr (GATHER) { S.rows(cur, gA, RA);
#pragma unroll
        for (int h = 0; h < 2; ++h)
#pragma unroll
            for (int i = 0; i < 2; ++i) gAn[h][i] = gA[h][i]; }
    PG8_STAGE(PG8_SB(0, 0), cB, voffB); PG8_STAGE(PG8_SB(0, 1), cB + hstep, voffB); PG8_STAGE_A(PG8_SA(0, 0), cA, 0, false); PG8_STAGE_A(PG8_SA(0, 1), cA, 1, false);
    if (wr == 1) PG8_BAR;
    PG8_WAIT_V(2); PG8_BAR;
    PG8_STAGE(PG8_SB(1, 0), cB + kstep, voffB); PG8_STAGE_A(PG8_SA(1, 0), cA + kstep, 0, false); PG8_STAGE(PG8_SB(1, 1), cB + hstep + kstep, voffB);
    PG8_WAIT_V(6); PG8_BAR;
    for (;;) {
        const bool has_next = S.next(ui + 1, nxt);
        const char* nA = has_next ? nxt.A : cA; const char* nB = has_next ? nxt.B : cB;
        if constexpr (GATHER) { if (has_next) { S.rows(nxt, gAn, RA); } }
        for (int t = 0; t < nt; t += 2) {
            const bool last = (t == nt - 2);
            const char* a1 = cA + (size_t)(t + 1) * kstep;
            const char* a2 = last ? nA : cA + (size_t)(t + 2) * kstep; const char* b2 = last ? nB : cB + (size_t)(t + 2) * kstep;
            const char* a3 = a2 + kstep; const char* b3 = b2 + kstep;
            if constexpr (Epi::HAS_MID) { if (t == nt / 2) { int frl = fr, fql = fq; asm volatile("" : "+v"(frl), "+v"(fql)); E.mid(acc, cur, wr, wc, frl, fql); } }
            PG8_LDB(B0, 0, 0); PG8_LDB(B1, 0, 1); PG8_SCHED; PG8_LDA(At, 0, 0); PG8_STAGE_A(PG8_SA(1, 1), a1, 1, false);
            PG8_WAIT_V(8); PG8_WAIT_L(0); PG8_BAR; PG8_MMA(0, 0, At, B0); PG8_MMA(0, 1, At, B1); PG8_BAR; PG8_SCHED;
            PG8_LDA(At, 0, 1); PG8_STAGE(PG8_SB(0, 0), b2, voffB); PG8_STAGE(PG8_SB(0, 1), b2 + hstep, voffB); PG8_STAGE_A(PG8_SA(0, 0), a2, 0, last);
            PG8_WAIT_V(8); PG8_WAIT_L(0); PG8_BAR; PG8_MMA(1, 0, At, B0); PG8_MMA(1, 1, At, B1); PG8_BAR; PG8_SCHED;
            PG8_LDB(B0, 1, 0); PG8_LDB(B1, 1, 1); PG8_SCHED; PG8_LDA(At, 1, 0); PG8_STAGE_A(PG8_SA(0, 1), a2, 1, last);
            PG8_WAIT_V(8); PG8_WAIT_L(0); PG8_BAR; PG8_MMA(0, 0, At, B0); PG8_MMA(0, 1, At, B1); PG8_BAR; PG8_SCHED;
            PG8_LDA(At, 1, 1); PG8_STAGE(PG8_SB(1, 0), b3, voffB); PG8_STAGE(PG8_SB(1, 1), b3 + hstep, voffB); PG8_STAGE_A(PG8_SA(1, 0), a3, 0, last);
            PG8_WAIT_V(8); PG8_WAIT_L(0); PG8_BAR; PG8_MMA(1, 0, At, B0); PG8_MMA(1, 1, At, B1); PG8_BAR; PG8_SCHED;
        }
        if constexpr (ALIGN_EPI) { if (wr == 0) PG8_BAR; }
        { int frl = fr, fql = fq; asm volatile("" : "+v"(frl), "+v"(fql)); E(acc, cur, wr, wc, frl, fql); }
        if (!has_next) break;
#pragma unroll
        for (int a = 0; a < 2; ++a)
#pragma unroll
            for (int b = 0; b < 2; ++b)
#pragma unroll
                for (int m = 0; m < 4; ++m)
#pragma unroll
                    for (int n = 0; n < 2; ++n) acc[a][b][m][n] = (f32x4){0.f, 0.f, 0.f, 0.f};
        cur = nxt; cA = nA; cB = nB; ++ui; PG8_MC(cur);
        if constexpr (GATHER) {
#pragma unroll
            for (int h = 0; h < 2; ++h)
#pragma unroll
                for (int i = 0; i < 2; ++i) gA[h][i] = gAn[h][i]; }
        if constexpr (ALIGN_EPI) { if (wr == 1) PG8_BAR; }
    }
    PG8_WAIT_V(0);
    if constexpr (!ALIGN_EPI) { if (wr == 0) PG8_BAR; }
    PG8_BAR;
#undef PG8_SA
#undef PG8_SB
#undef PG8_STAGE
#undef PG8_STAGE_A
#undef PG8_LDA
#undef PG8_LDB
#undef PG8_MMA
#undef PG8_WAIT_V
#undef PG8_WAIT_L
#undef PG8_BAR
#undef PG8_SCHED
#undef PG8_MC
}
}

constexpr int LDS_MISC_OFF = 131072;
__device__ __forceinline__ float fast_gelu(float x) { const float y = x + 0.044715f * x * x * x; return x * __builtin_amdgcn_rcpf(1.0f + __builtin_amdgcn_exp2f(-2.0f * 0.7978845608028654f * LOG2E * y)); }
__device__ __forceinline__ float fast_sigmoid(float x) { return __builtin_amdgcn_rcpf(1.0f + __builtin_amdgcn_exp2f(-LOG2E * x)); }
__device__ __forceinline__ void unpack8(const u32x4 w, float (&v)[8]) {
#pragma unroll
    for (int e = 0; e < 4; ++e) { v[2 * e] = __uint_as_float(w[e] << 16); v[2 * e + 1] = __uint_as_float(w[e] & 0xffff0000u); } }

struct EpiIn {
    static constexpr bool PERM = true, HAS_MID = false;
    bf16_t *U, *V, *Q, *K, *VA, *G; const float* b_gate;
    __device__ __forceinline__ void mid(f32x4 (&)[2][2][4][2], const pg8::Unit&, int, int, int, int) const {}
    __device__ __forceinline__ void operator()(f32x4 (&acc)[2][2][4][2], const pg8::Unit& u, int wr, int wc, int fr, int fq) const {
        const int pn = u.pn; bf16_t* base; int ld, colt, mode;
        if (pn < 4) { base = U; ld = 1024; colt = pn * 256; mode = 1; }
        else if (pn < 8) { base = V; ld = 1024; colt = (pn - 4) * 256; mode = 1; }
        else if (pn < 12) { base = Q; ld = 1024; colt = (pn - 8) * 256; mode = 0; }
        else if (pn < 16) { base = K; ld = 1024; colt = (pn - 12) * 256; mode = 0; }
        else if (pn < 20) { base = VA; ld = 1024; colt = (pn - 16) * 256; mode = 0; }
        else { base = G; ld = 4096; colt = (pn - 20) * 256; mode = 2; }
        const int row0 = u.pm * 256 + wr * 64 + fr, col0 = colt + wc * 32 + 8 * fq;
        f32x4 bv[2][2];
#pragma unroll
        for (int bj = 0; bj < 2; ++bj)
#pragma unroll
            for (int n = 0; n < 2; ++n) bv[bj][n] = (mode == 2) ? *(const f32x4*)(b_gate + col0 + bj * 128 + 4 * n) : (f32x4){0.f, 0.f, 0.f, 0.f};
#pragma unroll
        for (int ai = 0; ai < 2; ++ai)
#pragma unroll
            for (int m = 0; m < 4; ++m) { bf16_t* rowp = base + (size_t)(row0 + ai * 128 + m * 16) * ld + col0;
#pragma unroll
                for (int bj = 0; bj < 2; ++bj) { f32x4 v0 = acc[ai][bj][m][0], v1 = acc[ai][bj][m][1];
                    if (mode == 1) {
#pragma unroll
                        for (int j = 0; j < 4; ++j) { v0[j] = fast_gelu(v0[j]); v1[j] = fast_gelu(v1[j]); } }
                    else if (mode == 2) { v0 += bv[bj][0]; v1 += bv[bj][1];
#pragma unroll
                        for (int j = 0; j < 4; ++j) { v0[j] = fast_sigmoid(v0[j]); v1[j] = fast_sigmoid(v1[j]); } }
                    u32x4 w; w.x = pg8::cvt_pk_bf16(v0[0], v0[1]); w.y = pg8::cvt_pk_bf16(v0[2], v0[3]); w.z = pg8::cvt_pk_bf16(v1[0], v1[1]); w.w = pg8::cvt_pk_bf16(v1[2], v1[3]);
                    *(u32x4*)(rowp + bj * 128) = w; } }
    }
};
struct EpiProj {
    static constexpr bool PERM = true, HAS_MID = true;
    const bf16_t* G; bf16_t* O;
    __device__ __forceinline__ void mid(f32x4 (&acc)[2][2][4][2], const pg8::Unit& u, int wr, int wc, int fr, int fq) const {
        const int row0 = u.pm * 256 + wr * 64 + fr, col0 = u.pn * 256 + wc * 32 + 8 * fq;
#pragma unroll
        for (int ai = 0; ai < 2; ++ai)
#pragma unroll
            for (int m = 0; m < 4; ++m) { const bf16_t* gp = G + (size_t)(row0 + ai * 128 + m * 16) * 4096 + col0;
#pragma unroll
                for (int bj = 0; bj < 2; ++bj) { float gs[8], gf[8]; unpack8(*(const u32x4*)(gp + bj * 128), gs); unpack8(*(const u32x4*)(gp + 2048 + bj * 128), gf);
#pragma unroll
                    for (int j = 0; j < 4; ++j) { acc[ai][bj][m][0][j] *= gs[j] * __builtin_amdgcn_rcpf(gf[j]); acc[ai][bj][m][1][j] *= gs[4 + j] * __builtin_amdgcn_rcpf(gf[4 + j]); }
                    asm volatile("" : "+v"(acc[ai][bj][m][0]), "+v"(acc[ai][bj][m][1]) :: "memory"); } }
    }
    __device__ __forceinline__ void operator()(f32x4 (&acc)[2][2][4][2], const pg8::Unit& u, int wr, int wc, int fr, int fq) const {
        const int row0 = u.pm * 256 + wr * 64 + fr, col0 = u.pn * 256 + wc * 32 + 8 * fq;
#pragma unroll
        for (int ai = 0; ai < 2; ++ai)
#pragma unroll
            for (int m = 0; m < 4; ++m) { const size_t r = (size_t)(row0 + ai * 128 + m * 16);
#pragma unroll
                for (int bj = 0; bj < 2; ++bj) { float gf[8]; unpack8(*(const u32x4*)(G + r * 4096 + 2048 + col0 + bj * 128), gf);
                    const f32x4 v0 = acc[ai][bj][m][0], v1 = acc[ai][bj][m][1];
                    u32x4 w; w.x = pg8::cvt_pk_bf16(v0[0] * gf[0], v0[1] * gf[1]); w.y = pg8::cvt_pk_bf16(v0[2] * gf[2], v0[3] * gf[3]); w.z = pg8::cvt_pk_bf16(v1[0] * gf[4], v1[1] * gf[5]); w.w = pg8::cvt_pk_bf16(v1[2] * gf[6], v1[3] * gf[7]);
                    *(u32x4*)(O + r * 2048 + col0 + bj * 128) = w; }
                asm volatile("" ::: "memory"); }
    }
};
struct EpiOut {
    static constexpr bool PERM = false, HAS_MID = false;
    const float* X; float* O;
    __device__ __forceinline__ void mid(f32x4 (&)[2][2][4][2], const pg8::Unit&, int, int, int, int) const {}
    __device__ __forceinline__ void operator()(f32x4 (&acc)[2][2][4][2], const pg8::Unit& u, int wr, int wc, int fr, int fq) const {
        const int row0 = u.pm * 256 + wr * 64 + fr, col0 = u.pn * 256 + wc * 32 + 4 * fq;
#pragma unroll
        for (int ai = 0; ai < 2; ++ai)
#pragma unroll
            for (int m = 0; m < 4; ++m) { const size_t off = (size_t)(row0 + ai * 128 + m * 16) * DM + col0;
#pragma unroll
                for (int bj = 0; bj < 2; ++bj)
#pragma unroll
                    for (int n = 0; n < 2; ++n) *(f32x4*)(O + off + bj * 128 + n * 16) = *(const f32x4*)(X + off + bj * 128 + n * 16) + acc[ai][bj][m][n]; }
    }
};
struct EpiGateUp {
    static constexpr bool PERM = true, HAS_MID = false;
    bf16_t* ACT;
    __device__ __forceinline__ void mid(f32x4 (&)[2][2][4][2], const pg8::Unit&, int, int, int, int) const {}
    __device__ __forceinline__ void operator()(f32x4 (&acc)[2][2][4][2], const pg8::Unit& u, int wr, int wc, int fr, int fq) const {
        const int row0 = u.x0 + wr * 64 + fr, col0 = u.pn * 128 + wc * 32 + 8 * fq;
#pragma unroll
        for (int ai = 0; ai < 2; ++ai)
#pragma unroll
            for (int m = 0; m < 4; ++m) { float o[8];
#pragma unroll
                for (int n = 0; n < 2; ++n)
#pragma unroll
                    for (int j = 0; j < 4; ++j) { const float g = acc[ai][0][m][n][j], up = acc[ai][1][m][n][j]; o[4 * n + j] = g * fast_sigmoid(g) * up; }
                u32x4 w; w.x = pg8::cvt_pk_bf16(o[0], o[1]); w.y = pg8::cvt_pk_bf16(o[2], o[3]); w.z = pg8::cvt_pk_bf16(o[4], o[5]); w.w = pg8::cvt_pk_bf16(o[6], o[7]);
                *(u32x4*)(ACT + (size_t)(row0 + ai * 128 + m * 16) * DEXP + col0) = w; }
    }
};
struct EpiDown {
    static constexpr bool PERM = true, HAS_MID = false;
    bf16_t* Y; const float* GATE;
    __device__ __forceinline__ void mid(f32x4 (&)[2][2][4][2], const pg8::Unit&, int, int, int, int) const {}
    __device__ __forceinline__ void operator()(f32x4 (&acc)[2][2][4][2], const pg8::Unit& u, int wr, int wc, int fr, int fq) const {
        const int rl0 = wr * 64 + fr, col0 = u.pn * 256 + wc * 32 + 8 * fq;
#pragma unroll
        for (int ai = 0; ai < 2; ++ai)
#pragma unroll
            for (int m = 0; m < 4; ++m) { const int rl = rl0 + ai * 128 + m * 16; const float gt = GATE[u.x1 + rl];
#pragma unroll
                for (int bj = 0; bj < 2; ++bj) { const f32x4 v0 = acc[ai][bj][m][0] * gt, v1 = acc[ai][bj][m][1] * gt;
                    u32x4 w; w.x = pg8::cvt_pk_bf16(v0[0], v0[1]); w.y = pg8::cvt_pk_bf16(v0[2], v0[3]); w.z = pg8::cvt_pk_bf16(v1[0], v1[1]); w.w = pg8::cvt_pk_bf16(v1[2], v1[3]);
                    *(u32x4*)(Y + (size_t)(u.x0 + rl) * DM + col0 + bj * 128) = w; } }
    }
};
struct MoeOrder {
    const char* Abase; const char* Bbase; size_t Bstride; int K, nN, G, c; bool gather;
    const PG8_LAS int* ps;
    const unsigned* cnt; const int* TOK;
    __device__ bool next(int i, pg8::Unit& u) const {
        const int L = i * G + c; const int ntile = ps[NEXP + 2] * nN; if (L >= ntile) return false;
        const int sidx = L / nN, pn = L % nN; const int prow = ps[40 + sidx], info = ps[40 + MT_MAX + sidx], valid = ps[40 + 2 * MT_MAX + sidx];
        const int e = info >> 16, mt = info & 0xffff;
        u.pm = mt; u.pn = pn; u.x0 = prow; u.x1 = e * T + mt * MTILE; u.x2 = valid; u.x3 = e;
        u.A = gather ? Abase : Abase + (size_t)prow * K * 2; u.B = Bbase + (size_t)e * Bstride + (size_t)pn * 256 * K * 2; return true;
    }
    __device__ __forceinline__ void rows(const pg8::Unit& u, unsigned (&g)[2][2], const int (&RA)[2]) const {
#pragma unroll
        for (int h = 0; h < 2; ++h)
#pragma unroll
            for (int i = 0; i < 2; ++i) { int r = RA[i] + 128 * h; r = r < u.x2 ? r : u.x2 - 1; g[h][i] = (unsigned)TOK[u.x1 + r] * (unsigned)(K * 2); }
    }
};

struct TItem { const float* src; bf16_t* dst; int ld_src, ld_dst; };
__device__ __forceinline__ void titem_load(const TItem& t, f32x4 (&v)[8], int lane) {
#pragma unroll
    for (int i = 0; i < 8; ++i) v[i] = *(const f32x4*)(t.src + (size_t)((lane >> 3) + 8 * i) * t.ld_src + 4 * (lane & 7));
}
__device__ __forceinline__ void titem_store(const TItem& t, const f32x4 (&v)[8], PG8_LAS float* scr, int lane) {
#pragma unroll
    for (int i = 0; i < 8; ++i) { PG8_LAS float* d = scr + ((lane >> 3) + 8 * i) * 33 + 4 * (lane & 7); d[0] = v[i].x; d[1] = v[i].y; d[2] = v[i].z; d[3] = v[i].w; }
    asm volatile("s_waitcnt lgkmcnt(0)" ::: "memory");
    const int c = lane & 7;
#pragma unroll
    for (int j = 0; j < 4; ++j) { const int n = (lane >> 3) + 8 * j; const PG8_LAS float* s = scr + (8 * c) * 33 + n;
        u32x4 o; o.x = pk2(s[0 * 33], s[1 * 33]); o.y = pk2(s[2 * 33], s[3 * 33]); o.z = pk2(s[4 * 33], s[5 * 33]); o.w = pk2(s[6 * 33], s[7 * 33]);
        *(u32x4*)(t.dst + (size_t)n * t.ld_dst + 8 * c) = o; }
    asm volatile("s_waitcnt lgkmcnt(0)" ::: "memory");
}
constexpr int TI0 = 32 * 288, TI1 = 16 * 64, TI2 = 16 * 64, TI3 = 32 * 64, TI4 = 32 * 512, TI5 = 32 * 512, TI6 = 32 * 512;
constexpr int TI_ALL = TI0 + TI1 + TI2 + TI3 + TI4 + TI5 + TI6;
#ifndef TAIL1_ITEMS
#define TAIL1_ITEMS (TI5)
#endif
__device__ __forceinline__ TItem titem_decode(const Args& A, int r) {
    bf16_t* WIN = (bf16_t*)(A.ws + WS_WIN); bf16_t* WPROJ = (bf16_t*)(A.ws + WS_WPROJ); bf16_t* WOUT = (bf16_t*)(A.ws + WS_WOUT); bf16_t* WGU = (bf16_t*)(A.ws + WS_WGU); bf16_t* WD = (bf16_t*)(A.ws + WS_WD);
    TItem t;
    if (r < TI0) { const int kb = r / 288, nb = r % 288; t.src = A.in[2] + (size_t)(64 * kb) * INCOLS + 32 * nb + (nb >= 160 ? 8 : 0); t.ld_src = INCOLS; t.dst = WIN + (size_t)(32 * nb) * 2048 + 64 * kb; t.ld_dst = 2048; return t; } r -= TI0;
    if (r < TI1) { const int kb = r / 64, nb = r % 64; t.src = A.in[11] + (size_t)(64 * kb) * DM + 32 * nb; t.ld_src = DM; t.dst = WPROJ + (size_t)(32 * nb) * 2048 + 64 * kb; t.ld_dst = 2048; return t; } r -= TI1;
    if (r < TI2) { const int kb = r / 64, nb = r % 64; t.src = A.in[12] + (size_t)(64 * kb) * DM + 32 * nb; t.ld_src = DM; t.dst = WPROJ + (size_t)(32 * nb) * 2048 + 1024 + 64 * kb; t.ld_dst = 2048; return t; } r -= TI2;
    if (r < TI3) { const int kb = r / 64, nb = r % 64; t.src = A.in[13] + (size_t)(64 * kb) * DM + 32 * nb; t.ld_src = DM; t.dst = WOUT + (size_t)(32 * nb) * 2048 + 64 * kb; t.ld_dst = 2048; return t; } r -= TI3;
    if (r < TI4 + TI5) { const int up = r >= TI4; if (up) r -= TI4; const int e = r / 512, q = r % 512, kb = q / 16, nb = q % 16, n = 32 * nb, drow = 256 * (n >> 7) + (n & 127) + (up ? 128 : 0);
        t.src = A.in[up ? 20 : 19] + (size_t)e * DM * DEXP + (size_t)(64 * kb) * DEXP + n; t.ld_src = DEXP; t.dst = WGU + ((size_t)e * 1024 + drow) * 2048 + 64 * kb; t.ld_dst = 2048; return t; } r -= TI4 + TI5;
    { const int e = r / 512, q = r % 512, kb = q / 64, nb = q % 64; t.src = A.in[21] + (size_t)e * DEXP * DM + (size_t)(64 * kb) * DM + 32 * nb; t.ld_src = DM; t.dst = WD + ((size_t)e * 2048 + 32 * nb) * 512 + 64 * kb; t.ld_dst = 512; return t; }
}
__device__ __forceinline__ void p0_weights(const Args& A, PG8_LAS unsigned char* lds, const int part, const int wg0) {
    const int tid = threadIdx.x, lane = tid & 63, wave = tid >> 6;
    PG8_LAS float* scr = (PG8_LAS float*)(lds + wave * 16384);
    if ((int)blockIdx.x < wg0) return;
    const int gw = ((int)blockIdx.x - wg0) * NWAVES + wave, NGW = ((int)gridDim.x - wg0) * NWAVES;
    const int cut1 = TI_ALL - TI6 - TAIL1_ITEMS, cut2 = TI_ALL - TI6;
    const int it_lo = part == 0 ? 0 : (part == 1 ? cut1 : cut2), it_hi = part == 0 ? cut1 : (part == 1 ? cut2 : TI_ALL);
    int it = it_lo + gw; if (it >= it_hi) return;
    TItem cur = titem_decode(A, it); f32x4 va[8], vb[8];
    titem_load(cur, va, lane);
    for (;;) {
        const int itn = it + NGW; const bool more = itn < it_hi; TItem nx = cur;
        if (more) { nx = titem_decode(A, itn); titem_load(nx, vb, lane); }
        titem_store(cur, va, scr, lane);
        if (!more) break;
#pragma unroll
        for (int i = 0; i < 8; ++i) va[i] = vb[i];
        cur = nx; it = itn;
    }
}

__device__ __forceinline__ void p1_fast(const Args& A, PG8_LAS unsigned char* lds) {
    pg8::DenseOrder S; S.init(A.ws + WS_H, A.ws + WS_WIN, T, 9216, DM, gridDim.x, blockIdx.x);
    EpiIn E{(bf16_t*)(A.ws + WS_U), (bf16_t*)(A.ws + WS_V), (bf16_t*)(A.ws + WS_Q), (bf16_t*)(A.ws + WS_K), (bf16_t*)(A.ws + WS_VA), (bf16_t*)(A.ws + WS_G), A.in[3]};
    pg8::gemm_phase<EpiIn, pg8::DenseOrder, true, false>(lds, DM, S, E);
}
__device__ __forceinline__ void p3_fast(const Args& A, PG8_LAS unsigned char* lds) {
    pg8::DenseOrder S; S.init(A.ws + WS_MIXIN, A.ws + WS_WPROJ, T, DM, 2048, gridDim.x, blockIdx.x);
    EpiProj E{(const bf16_t*)(A.ws + WS_G), (bf16_t*)(A.ws + WS_MIXED)};
    pg8::gemm_phase<EpiProj, pg8::DenseOrder, true, false>(lds, 2048, S, E);
}
__device__ __forceinline__ void p4_fast(const Args& A, PG8_LAS unsigned char* lds) {
    pg8::DenseOrder S; S.init(A.ws + WS_MIXED, A.ws + WS_WOUT, T, DM, DM, gridDim.x, blockIdx.x);
    EpiOut E{A.in[0], A.out};
    pg8::gemm_phase<EpiOut, pg8::DenseOrder, true, false>(lds, DM, S, E);
}
__device__ __forceinline__ void moe_layout_lds(const Args& A, PG8_LAS unsigned char* lds) {
    PG8_LAS int* ps = (PG8_LAS int*)(lds + LDS_MISC_OFF); PG8_LAS int* tprow = ps + 40; PG8_LAS int* tinfo = tprow + MT_MAX; PG8_LAS int* tvalid = tinfo + MT_MAX;
    const unsigned* cnt = (const unsigned*)(A.ws + WS_CTL) + CW_CNT;
    if (threadIdx.x == 0) { int acc = 0;
        for (int e = 0; e < NEXP; ++e) { ps[e] = acc; acc += ((int)cnt[e] + MTILE - 1) / MTILE * MTILE; }
        ps[NEXP] = acc; ps[NEXP + 1] = acc / MTILE; }
    __syncthreads();
    const int nt = ps[NEXP + 1]; PG8_LAS int* uval = tvalid + MT_MAX;
    int prow = 0, e = 0, mt = 0, valid = 0;
    if ((int)threadIdx.x < nt) { prow = (int)threadIdx.x * MTILE;
        for (int j = 1; j < NEXP; ++j) if (ps[j] <= prow) e = j;
        mt = (prow - ps[e]) / MTILE; valid = (int)cnt[e] - mt * MTILE; valid = valid > MTILE ? MTILE : valid; uval[threadIdx.x] = valid; }
    __syncthreads();
    if ((int)threadIdx.x < nt) { int rank = 0;
        for (int j = 0; j < nt; ++j) { const int vj = uval[j]; rank += (vj > valid || (vj == valid && j < (int)threadIdx.x)) ? 1 : 0; }
        tprow[rank] = prow; tinfo[rank] = (e << 16) | mt; tvalid[rank] = valid; }
    if (threadIdx.x == 0) { int nb = 0; for (int j = 0; j < nt; ++j) nb += uval[j] > TINY_ROWS ? 1 : 0; ps[NEXP + 2] = nb; }
    __syncthreads();
}
namespace sm {
typedef short bf16x8 __attribute__((ext_vector_type(8))); typedef float f32x16 __attribute__((ext_vector_type(16)));
constexpr int TINY = 64;
__device__ __forceinline__ void gateup_small(const Args& A, PG8_LAS unsigned char* lds) {
    const PG8_LAS int* ps = (const PG8_LAS int*)(lds + LDS_MISC_OFF); const int nt = ps[NEXP + 1], nbig = ps[NEXP + 2];
    const bf16_t* H2 = (const bf16_t*)(A.ws + WS_H2); const bf16_t* WGU = (const bf16_t*)(A.ws + WS_WGU); bf16_t* ACT = (bf16_t*)(A.ws + WS_ACT); const int* TOK = (const int*)(A.ws + WS_TOK);
    const int tid = threadIdx.x, lane = tid & 63, w = __builtin_amdgcn_readfirstlane(tid >> 6), r32 = lane & 31, hi = lane >> 5;
    PG8_LAS float* red = (PG8_LAS float*)lds;
    for (int su = blockIdx.x; su < (nt - nbig) * 16; su += gridDim.x) {
        const int sidx = nbig + (su >> 4), sl = su & 15; const int prow = ps[40 + sidx], info = ps[40 + MT_MAX + sidx], valid = ps[40 + 2 * MT_MAX + sidx];
        const int e = info >> 16, mt = info & 0xffff, lbase = e * T + mt * MTILE;
        const int ra = r32 < valid ? r32 : valid - 1, rb = 32 + r32 < valid ? 32 + r32 : valid - 1;
        const bf16_t* a0p = H2 + (size_t)TOK[lbase + ra] * DM + 256 * w + 8 * hi; const bf16_t* a1p = H2 + (size_t)TOK[lbase + rb] * DM + 256 * w + 8 * hi;
        const bf16_t* b0p = WGU + ((size_t)e * 1024 + 256 * (sl >> 2) + 32 * (sl & 3) + r32) * DM + 256 * w + 8 * hi; const bf16_t* b1p = b0p + (size_t)128 * DM;
        f32x16 acc[2][2];
#pragma unroll
        for (int i = 0; i < 2; ++i)
#pragma unroll
            for (int j = 0; j < 2; ++j)
#pragma unroll
                for (int r = 0; r < 16; ++r) acc[i][j][r] = 0.f;
#pragma unroll 4
        for (int ks = 0; ks < 16; ++ks) { const bf16x8 a0 = *(const bf16x8*)(a0p + 16 * ks), a1 = *(const bf16x8*)(a1p + 16 * ks), b0 = *(const bf16x8*)(b0p + 16 * ks), b1 = *(const bf16x8*)(b1p + 16 * ks);
            acc[0][0] = __builtin_amdgcn_mfma_f32_32x32x16_bf16(a0, b0, acc[0][0], 0, 0, 0); acc[0][1] = __builtin_amdgcn_mfma_f32_32x32x16_bf16(a0, b1, acc[0][1], 0, 0, 0);
            acc[1][0] = __builtin_amdgcn_mfma_f32_32x32x16_bf16(a1, b0, acc[1][0], 0, 0, 0); acc[1][1] = __builtin_amdgcn_mfma_f32_32x32x16_bf16(a1, b1, acc[1][1], 0, 0, 0); }
#pragma unroll
        for (int i = 0; i < 2; ++i)
#pragma unroll
            for (int j = 0; j < 2; ++j)
#pragma unroll
                for (int r = 0; r < 16; ++r) red[(((w * 2 + i) * 2 + j) * 16 + r) * 64 + lane] = acc[i][j][r];
        __syncthreads();
#pragma unroll
        for (int i = 0; i < 2; ++i)
#pragma unroll
            for (int rr = 0; rr < 2; ++rr) { const int r = 2 * w + rr; float g = 0.f, u = 0.f;
#pragma unroll
                for (int w2 = 0; w2 < 8; ++w2) { g += red[(((w2 * 2 + i) * 2 + 0) * 16 + r) * 64 + lane]; u += red[(((w2 * 2 + i) * 2 + 1) * 16 + r) * 64 + lane]; }
                const int row = 32 * i + (r & 3) + 8 * (r >> 2) + 4 * hi;
                ACT[(size_t)(prow + row) * DEXP + 32 * sl + r32] = f2bf(g * fast_sigmoid(g) * u); }
        __syncthreads();
    }
}
__device__ __forceinline__ void down_small(const Args& A, PG8_LAS unsigned char* lds) {
    const PG8_LAS int* ps = (const PG8_LAS int*)(lds + LDS_MISC_OFF); const int nt = ps[NEXP + 1], nbig = ps[NEXP + 2];
    const bf16_t* ACT = (const bf16_t*)(A.ws + WS_ACT); const bf16_t* WD = (const bf16_t*)(A.ws + WS_WD); bf16_t* Y = (bf16_t*)(A.ws + WS_YBUF); const float* GATE = (const float*)(A.ws + WS_GATE);
    const int tid = threadIdx.x, lane = tid & 63, w = __builtin_amdgcn_readfirstlane(tid >> 6), wn = w & 3, wk = w >> 2, r32 = lane & 31, hi = lane >> 5;
    PG8_LAS float* red = (PG8_LAS float*)lds;
    for (int su = blockIdx.x; su < (nt - nbig) * 16; su += gridDim.x) {
        const int sidx = nbig + (su >> 4), sl = su & 15; const int prow = ps[40 + sidx], info = ps[40 + MT_MAX + sidx], valid = ps[40 + 2 * MT_MAX + sidx];
        const int e = info >> 16, mt = info & 0xffff, lbase = e * T + mt * MTILE;
        const int ra = r32 < valid ? r32 : valid - 1, rb = 32 + r32 < valid ? 32 + r32 : valid - 1;
        const bf16_t* a0p = ACT + (size_t)(prow + ra) * DEXP + 256 * wk + 8 * hi; const bf16_t* a1p = ACT + (size_t)(prow + rb) * DEXP + 256 * wk + 8 * hi;
        const bf16_t* bp = WD + ((size_t)e * 2048 + 128 * sl + 32 * wn + r32) * DEXP + 256 * wk + 8 * hi;
        f32x16 acc[2];
#pragma unroll
        for (int i = 0; i < 2; ++i)
#pragma unroll
            for (int r = 0; r < 16; ++r) acc[i][r] = 0.f;
#pragma unroll 4
        for (int ks = 0; ks < 16; ++ks) { const bf16x8 a0 = *(const bf16x8*)(a0p + 16 * ks), a1 = *(const bf16x8*)(a1p + 16 * ks), b = *(const bf16x8*)(bp + 16 * ks);
            acc[0] = __builtin_amdgcn_mfma_f32_32x32x16_bf16(a0, b, acc[0], 0, 0, 0); acc[1] = __builtin_amdgcn_mfma_f32_32x32x16_bf16(a1, b, acc[1], 0, 0, 0); }
        if (wk == 1) {
#pragma unroll
            for (int i = 0; i < 2; ++i)
#pragma unroll
                for (int r = 0; r < 16; ++r) red[((wn * 2 + i) * 16 + r) * 64 + lane] = acc[i][r]; }
        __syncthreads();
        if (wk == 0) {
#pragma unroll
            for (int i = 0; i < 2; ++i)
#pragma unroll
                for (int r = 0; r < 16; ++r) { const int row = 32 * i + (r & 3) + 8 * (r >> 2) + 4 * hi; const float gt = GATE[lbase + (row < valid ? row : valid - 1)];
                    Y[(size_t)(prow + row) * DM + 128 * sl + 32 * wn + r32] = f2bf((acc[i][r] + red[((wn * 2 + i) * 16 + r) * 64 + lane]) * gt); } }
        __syncthreads();
    }
}
}

__device__ __forceinline__ void p6_fast(const Args& A, PG8_LAS unsigned char* lds) {
    moe_layout_lds(A, lds);
    MoeOrder S{(const char*)(A.ws + WS_H2), (const char*)(A.ws + WS_WGU), (size_t)1024 * 2048 * 2, DM, 4, (int)gridDim.x, (int)blockIdx.x, true,
               (const PG8_LAS int*)(lds + LDS_MISC_OFF), (const unsigned*)(A.ws + WS_CTL) + CW_CNT, (const int*)(A.ws + WS_TOK)};
    EpiGateUp E{(bf16_t*)(A.ws + WS_ACT)};
    pg8::gemm_phase<EpiGateUp, MoeOrder, true, true>(lds, DM, S, E);
    sm::gateup_small(A, lds);
    { const int ntile = ((const PG8_LAS int*)(lds + LDS_MISC_OFF))[NEXP + 2] * 4; __syncthreads(); p0_weights(A, lds, 2, ntile % (int)gridDim.x); }
}
__device__ __forceinline__ void p7_fast(const Args& A, PG8_LAS unsigned char* lds) {
    moe_layout_lds(A, lds);
    MoeOrder S{(const char*)(A.ws + WS_ACT), (const char*)(A.ws + WS_WD), (size_t)2048 * 512 * 2, DEXP, 8, (int)gridDim.x, (int)blockIdx.x, false,
               (const PG8_LAS int*)(lds + LDS_MISC_OFF), (const unsigned*)(A.ws + WS_CTL) + CW_CNT, (const int*)(A.ws + WS_TOK)};
    EpiDown E{(bf16_t*)(A.ws + WS_YBUF), (const float*)(A.ws + WS_GATE)};
    pg8::gemm_phase<EpiDown, MoeOrder, true, false>(lds, DEXP, S, E);
    sm::down_small(A, lds);
}

namespace fa {
typedef short bf16x8 __attribute__((ext_vector_type(8)));
typedef short v4i16 __attribute__((ext_vector_type(4)));
typedef float f32x16 __attribute__((ext_vector_type(16)));
#define FA_LAS __attribute__((address_space(3)))
constexpr int KVBUF = 65536, LDS_CK = 131072, LDS_ML = 131072 + 8192;
__device__ __forceinline__ unsigned cvtpk(float lo, float hi) { unsigned r; asm("v_cvt_pk_bf16_f32 %0, %1, %2" : "=v"(r) : "v"(lo), "v"(hi)); return r; }
__device__ __forceinline__ bf16x8 pack8(const f32x16& p, int b) { u32x4 w; w.x = cvtpk(p[b], p[b + 1]); w.y = cvtpk(p[b + 2], p[b + 3]); w.z = cvtpk(p[b + 4], p[b + 5]); w.w = cvtpk(p[b + 6], p[b + 7]); return __builtin_bit_cast(bf16x8, w); }
__device__ __forceinline__ float swapmax(float v) { auto rr = __builtin_amdgcn_permlane32_swap(__float_as_uint(v), __float_as_uint(v), false, false); return fmaxf(__uint_as_float(rr[0]), __uint_as_float(rr[1])); }
__device__ __forceinline__ float swapsum(float v) { auto rr = __builtin_amdgcn_permlane32_swap(__float_as_uint(v), __float_as_uint(v), false, false); return __uint_as_float(rr[0]) + __uint_as_float(rr[1]); }
#define FA_WAITBAR() do { asm volatile("s_waitcnt vmcnt(0) lgkmcnt(0)" ::: "memory"); __builtin_amdgcn_s_barrier(); asm volatile("" ::: "memory"); } while (0)

__device__ __forceinline__ void attn_phase(const Args& A, FA_LAS unsigned char* lds) {
    const bf16_t* Q = (const bf16_t*)(A.ws + WS_Q); const bf16_t* Kt = (const bf16_t*)(A.ws + WS_K); const bf16_t* Vt = (const bf16_t*)(A.ws + WS_VA);
    const float* CKL = (const float*)(A.ws + WS_CKL); bf16_t* MIXIN = (bf16_t*)(A.ws + WS_MIXIN);
    const int tid = threadIdx.x, lane = tid & 63, wid = __builtin_amdgcn_readfirstlane(tid >> 6), rg = wid & 3, kh = wid >> 2, r32 = lane & 31, hi = lane >> 5;
    int koff[4];
#pragma unroll
    for (int i = 0; i < 4; ++i) { const int rl = 4 * i + (lane >> 4); koff[i] = rl * 1024 + (((lane & 15) ^ rl) * 8); }
    const int voff = (lane >> 4) * 1024 + (((lane & 15) ^ ((lane >> 4) << 2)) * 8);
    int kfo[8];
#pragma unroll
    for (int d0 = 0; d0 < 8; ++d0) kfo[d0] = (kh * 64 + r32) * 256 + (((2 * d0 + hi) ^ (r32 & 15)) * 16);
    int vfo[4];
    { const int dh = (lane >> 4) & 1, q = (lane & 15) >> 2, p = lane & 3;
#pragma unroll
      for (int db = 0; db < 4; ++db) vfo[db] = 32768 + (kh * 64 + 4 * hi + q) * 256 + ((db ^ q) * 64) + dh * 32 + p * 8; }
    const int G = gridDim.x;
    for (int vb = blockIdx.x; vb < 256; vb += G) {
        const int item = (G % 8 == 0) ? ((vb % 8) * 32 + (vb / 8)) % 256 : vb;
        const int bh = item >> 3, ii = item & 7, b = bh >> 3, h = bh & 7;
        const bf16_t* Kg = Kt + (size_t)b * SEQ * 1024 + h * 128; const bf16_t* Vg = Vt + (size_t)b * SEQ * 1024 + h * 128;
        { const f32x4 c = *(const f32x4*)(CKL + (size_t)bh * SEQ + tid * 4); *(FA_LAS f32x4*)(lds + LDS_CK + tid * 16) = (f32x4){-c.x, -c.y, -c.z, -c.w}; }
#define FA_ISSUE(key0, bufoff) do { const bf16_t* kg_ = Kg + (size_t)((key0) + 16 * wid) * 1024; const bf16_t* vg_ = Vg + (size_t)((key0) + 16 * wid) * 1024; \
        _Pragma("unroll") for (int i_ = 0; i_ < 4; ++i_) { \
            __builtin_amdgcn_global_load_lds((const unsigned*)(kg_ + koff[i_]), (FA_LAS unsigned*)(lds + (bufoff) + (wid * 4 + i_) * 1024), 16, 0, 0); \
            __builtin_amdgcn_global_load_lds((const unsigned*)(vg_ + i_ * 4096 + voff), (FA_LAS unsigned*)(lds + (bufoff) + 32768 + (wid * 4 + i_) * 1024), 16, 0, 0); } } while (0)
        int u = 0, qb = ii, kb = 0, cur = 0;
        FA_ISSUE(0, 0);
        bf16x8 qf[8]; f32x16 o[4]; float m = -1e30f, l = 0.f;
        { const bf16_t* qp = Q + (size_t)(b * SEQ + qb * 128 + rg * 32 + r32) * 1024 + h * 128 + 8 * hi;
#pragma unroll
          for (int d0 = 0; d0 < 8; ++d0) qf[d0] = *(const bf16x8*)(qp + 16 * d0); }
#pragma unroll
        for (int db = 0; db < 4; ++db)
#pragma unroll
            for (int r = 0; r < 16; ++r) o[db][r] = 0.f;
        FA_WAITBAR();
        for (;;) {
            const bool lastb = (kb == qb); const bool more = !(lastb && u == 1);
            const int nkb = lastb ? 0 : kb + 1;
            if (more) FA_ISSUE(nkb * 128, (cur ^ 1) * KVBUF);
            {
                FA_LAS const unsigned char* buf = lds + cur * KVBUF;
                FA_LAS const float* nck = (FA_LAS const float*)(lds + LDS_CK) + kb * 128 + kh * 64 + 4 * hi;
                f32x16 p0, p1;
#pragma unroll
                for (int g = 0; g < 4; ++g) { const f32x4 t0 = *(FA_LAS const f32x4*)(nck + 8 * g), t1 = *(FA_LAS const f32x4*)(nck + 32 + 8 * g);
#pragma unroll
                    for (int j = 0; j < 4; ++j) { p0[4 * g + j] = t0[j]; p1[4 * g + j] = t1[j]; } }
#pragma unroll
                for (int d0 = 0; d0 < 8; ++d0) { const bf16x8 ka = *(FA_LAS const bf16x8*)(buf + kfo[d0]), kc = *(FA_LAS const bf16x8*)(buf + kfo[d0] + 8192);
                    p0 = __builtin_amdgcn_mfma_f32_32x32x16_bf16(ka, qf[d0], p0, 0, 0, 0); p1 = __builtin_amdgcn_mfma_f32_32x32x16_bf16(kc, qf[d0], p1, 0, 0, 0); }
                if (lastb) { const int qrel = rg * 32 + r32, k0 = kh * 64 + 4 * hi;
#pragma unroll
                    for (int r = 0; r < 16; ++r) { const int kr = k0 + (r & 3) + 8 * (r >> 2); if (kr > qrel) p0[r] = -INFINITY; if (kr + 32 > qrel) p1[r] = -INFINITY; } }
                float mx = fmaxf(p0[0], p1[0]);
#pragma unroll
                for (int r = 1; r < 16; ++r) mx = fmaxf(mx, fmaxf(p0[r], p1[r]));
                mx = swapmax(mx);
                const float mn = fmaxf(m, mx), alpha = __builtin_amdgcn_exp2f(m - mn); m = mn;
                float ps = 0.f;
#pragma unroll
                for (int r = 0; r < 16; ++r) { p0[r] = __builtin_amdgcn_exp2f(p0[r] - mn); p1[r] = __builtin_amdgcn_exp2f(p1[r] - mn); ps += p0[r] + p1[r]; }
                l = l * alpha + ps;
                if (!__all(alpha == 1.0f)) {
#pragma unroll
                    for (int db = 0; db < 4; ++db)
#pragma unroll
                        for (int r = 0; r < 16; ++r) o[db][r] *= alpha; }
                bf16x8 pf[4]; pf[0] = pack8(p0, 0); pf[1] = pack8(p0, 8); pf[2] = pack8(p1, 0); pf[3] = pack8(p1, 8);
#pragma unroll
                for (int db = 0; db < 4; ++db)
#pragma unroll
                    for (int s = 0; s < 4; ++s) {
                        const v4i16 lo = __builtin_amdgcn_ds_read_tr16_b64_v4i16((FA_LAS v4i16*)(buf + vfo[db] + s * 4096));
                        const v4i16 hh = __builtin_amdgcn_ds_read_tr16_b64_v4i16((FA_LAS v4i16*)(buf + vfo[db] + s * 4096 + 2048));
                        const bf16x8 vf = (bf16x8){lo[0], lo[1], lo[2], lo[3], hh[0], hh[1], hh[2], hh[3]};
                        o[db] = __builtin_amdgcn_mfma_f32_32x32x16_bf16(vf, pf[s], o[db], 0, 0, 0); }
            }
            FA_WAITBAR();
            if (lastb) {
                FA_LAS float* mb = (FA_LAS float*)(lds + cur * KVBUF) + rg * 4096; FA_LAS float* ml = (FA_LAS float*)(lds + LDS_ML) + rg * 128;
                const float lt = swapsum(l);
                if (kh == 1) {
#pragma unroll
                    for (int db = 0; db < 4; ++db)
#pragma unroll
                        for (int r = 0; r < 16; ++r) mb[(db * 16 + r) * 64 + lane] = o[db][r];
                    ml[lane] = m; ml[64 + lane] = lt; }
                FA_WAITBAR();
                if (kh == 0) {
                    const float m2 = ml[lane], l2 = ml[64 + lane], mm = fmaxf(m, m2), a1 = __builtin_amdgcn_exp2f(m - mm), a2 = __builtin_amdgcn_exp2f(m2 - mm);
                    const float inv = 1.0f / (lt * a1 + l2 * a2), s1 = a1 * inv, s2 = a2 * inv;
                    bf16_t* op = MIXIN + (size_t)(b * SEQ + qb * 128 + rg * 32 + r32) * 2048 + 1024 + h * 128 + 4 * hi;
#pragma unroll
                    for (int db = 0; db < 4; ++db)
#pragma unroll
                        for (int g = 0; g < 4; ++g) { float v[4];
#pragma unroll
                            for (int j = 0; j < 4; ++j) v[j] = o[db][4 * g + j] * s1 + mb[(db * 16 + 4 * g + j) * 64 + lane] * s2;
                            u32x2 w; w.x = cvtpk(v[0], v[1]); w.y = cvtpk(v[2], v[3]); *(u32x2*)(op + 32 * db + 8 * g) = w; } }
                FA_WAITBAR();
                if (u == 1) break;
                u = 1; qb = 15 - ii;
                { const bf16_t* qp = Q + (size_t)(b * SEQ + qb * 128 + rg * 32 + r32) * 1024 + h * 128 + 8 * hi;
#pragma unroll
                  for (int d0 = 0; d0 < 8; ++d0) qf[d0] = *(const bf16x8*)(qp + 16 * d0); }
#pragma unroll
                for (int db = 0; db < 4; ++db)
#pragma unroll
                    for (int r = 0; r < 16; ++r) o[db][r] = 0.f;
                m = -1e30f; l = 0.f;
            }
            cur ^= 1; kb = nkb;
        }
#undef FA_ISSUE
    }
}
}

namespace fs {
#define FS_LAS __attribute__((address_space(3)))
__device__ __forceinline__ void sgu_phase(const Args& A, FS_LAS unsigned char* lds) {
    const bf16_t* U = (const bf16_t*)(A.ws + WS_U); const bf16_t* V = (const bf16_t*)(A.ws + WS_V); bf16_t* MIXIN = (bf16_t*)(A.ws + WS_MIXIN);
    const float* wsp = A.in[7]; const float* bsp = A.in[8];
    const int tid = threadIdx.x, lane = tid & 63, wid = __builtin_amdgcn_readfirstlane(tid >> 6), tb = wid & 3, dh = wid >> 2, r32 = lane & 31, hi = lane >> 5;
    const int frow = tid >> 2, fq4 = tid & 3;
    int vfo[2];
    { const int d16 = (lane >> 4) & 1, q = (lane & 15) >> 2, p = lane & 3;
#pragma unroll
      for (int j = 0; j < 2; ++j) vfo[j] = 32768 + (8 * hi + q) * 256 + (((2 * dh + j) ^ q) * 64) + d16 * 32 + p * 8; }
    const int wfo = (32 * tb + r32) * 256;
    for (int u = blockIdx.x; u < (T / CHUNK) * NG; u += gridDim.x) {
        const int rc = u / NG, g = u % NG, row0 = rc * CHUNK;
        { const float* wr = wsp + ((size_t)g * CHUNK + frow) * CHUNK + fq4 * 32;
#pragma unroll
          for (int c = 0; c < 4; ++c) { const f32x4 a = *(const f32x4*)(wr + 8 * c), b2 = *(const f32x4*)(wr + 8 * c + 4); const int s0 = fq4 * 32 + 8 * c; float v[8] = {a.x, a.y, a.z, a.w, b2.x, b2.y, b2.z, b2.w};
#pragma unroll
              for (int j = 0; j < 8; ++j) if (s0 + j > frow) v[j] = 0.f;
              u32x4 w; w.x = pk2(v[0], v[1]); w.y = pk2(v[2], v[3]); w.z = pk2(v[4], v[5]); w.w = pk2(v[6], v[7]);
              *(FS_LAS u32x4*)(lds + frow * 256 + (((4 * fq4 + c) ^ (frow & 15)) * 16)) = w; }
          const bf16_t* vr = V + (size_t)(row0 + frow) * 1024 + g * 128 + fq4 * 32;
#pragma unroll
          for (int c = 0; c < 4; ++c) { const u32x4 w = *(const u32x4*)(vr + 8 * c); *(FS_LAS u32x4*)(lds + 32768 + frow * 256 + (((4 * fq4 + c) ^ ((frow & 3) << 2)) * 16)) = w; } }
        __syncthreads();
        fa::f32x16 acc[2];
#pragma unroll
        for (int j = 0; j < 2; ++j)
#pragma unroll
            for (int r = 0; r < 16; ++r) acc[j][r] = 0.f;
        for (int s = 0; s <= 2 * tb + 1; ++s) {
            const fa::bf16x8 wf = *(FS_LAS const fa::bf16x8*)(lds + wfo + (((2 * s + hi) ^ (r32 & 15)) * 16));
#pragma unroll
            for (int j = 0; j < 2; ++j) {
                const fa::v4i16 lo = __builtin_amdgcn_ds_read_tr16_b64_v4i16((FS_LAS fa::v4i16*)(lds + vfo[j] + s * 4096));
                const fa::v4i16 hh = __builtin_amdgcn_ds_read_tr16_b64_v4i16((FS_LAS fa::v4i16*)(lds + vfo[j] + s * 4096 + 1024));
                const fa::bf16x8 vf = (fa::bf16x8){lo[0], lo[1], lo[2], lo[3], hh[0], hh[1], hh[2], hh[3]};
                acc[j] = __builtin_amdgcn_mfma_f32_32x32x16_bf16(vf, wf, acc[j], 0, 0, 0); }
        }
        { const int tt = 32 * tb + r32; const float bb = bsp[g * CHUNK + tt]; const size_t rw = (size_t)(row0 + tt);
#pragma unroll
          for (int j = 0; j < 2; ++j)
#pragma unroll
              for (int g4 = 0; g4 < 4; ++g4) { const int d = 32 * (2 * dh + j) + 8 * g4 + 4 * hi; const u32x2 uu = *(const u32x2*)(U + rw * 1024 + g * 128 + d);
                  const float u0 = __uint_as_float(uu.x << 16), u1 = __uint_as_float(uu.x & 0xffff0000u), u2 = __uint_as_float(uu.y << 16), u3 = __uint_as_float(uu.y & 0xffff0000u);
                  u32x2 w; w.x = fa::cvtpk(u0 * (acc[j][4 * g4] + bb), u1 * (acc[j][4 * g4 + 1] + bb)); w.y = fa::cvtpk(u2 * (acc[j][4 * g4 + 2] + bb), u3 * (acc[j][4 * g4 + 3] + bb));
                  *(u32x2*)(MIXIN + rw * 2048 + g * 128 + d) = w; } }
        __syncthreads();
    }
}
}


#define XB_TMO      128
#define XB_XCNT(j)  (256  + 64 * (j))
#define XB_XSUB(j)  (1280 + 64 * (j))
#define XB_XGEN(j)  (2304 + 64 * (j))
#define XB_TOP      3328
#define XB_TOPGEN   3392
#define XCD_BAR_WORDS 3456
#define XB_SPIN_CAP (1u << 18)
#define XLAS __attribute__((address_space(3)))
__device__ __forceinline__ unsigned xb_ld(unsigned* p)              { return __hip_atomic_load(p, __ATOMIC_RELAXED, __HIP_MEMORY_SCOPE_AGENT); }
__device__ __forceinline__ unsigned xb_add(unsigned* p, unsigned v) { return __hip_atomic_fetch_add(p, v, __ATOMIC_RELAXED, __HIP_MEMORY_SCOPE_AGENT); }
__device__ __forceinline__ unsigned xb_xcc_id() { return (unsigned)__builtin_amdgcn_s_getreg((3 << 11) | 20) & 0xFu; }
#define XB_SPIN(cond, bar) do { unsigned _sp = 0; while (cond) { __builtin_amdgcn_s_sleep(1); \
    if ((++_sp & 255u) == 0u) { if (xb_ld(&(bar)[XB_TMO])) break; if (_sp > XB_SPIN_CAP) { atomicAdd(&(bar)[XB_TMO], 1u); break; } } } } while (0)
struct XcdBarrier { unsigned* bar; unsigned x; volatile XLAS unsigned* st; };
__device__ __forceinline__ XcdBarrier xcd_barrier_post(unsigned* bar, volatile XLAS unsigned* st) {
    XcdBarrier b; b.bar = bar; b.x = xb_xcc_id(); b.st = st;
    if (threadIdx.x == 0) (void)xb_add(&bar[XB_XCNT(b.x)], 1u);
    return b;
}
__device__ __forceinline__ void xcd_barrier_complete(unsigned* bar, unsigned x, unsigned& nloc, unsigned& nx) {
    const unsigned G = gridDim.x * gridDim.y * gridDim.z;
    unsigned sum, cnt, mine, sp = 0u;
    for (;;) {
        sum = 0u; cnt = 0u; mine = 0u;
#pragma unroll
        for (unsigned j = 0; j < 16; ++j) { const unsigned c = xb_ld(&bar[XB_XCNT(j)]); sum += c; cnt += (c > 0u) ? 1u : 0u; mine = (j == x) ? c : mine; }
        if (sum == G) break;
        __builtin_amdgcn_s_sleep(1);
        if ((++sp & 255u) == 0u) { if (xb_ld(&bar[XB_TMO])) break; if (sp > XB_SPIN_CAP) { atomicAdd(&bar[XB_TMO], 1u); break; } }
    }
    nloc = mine > 0u ? mine : 1u; nx = cnt > 0u ? cnt : 1u;
}
__device__ __forceinline__ void xcd_barrier(const XcdBarrier& b) {
    asm volatile("s_waitcnt vmcnt(0)" ::: "memory");
    __syncthreads();
    if (threadIdx.x == 0) {
        unsigned* bar = b.bar;
        __builtin_amdgcn_s_waitcnt(0);
        unsigned nloc = b.st[0], nx = b.st[1];
        if (nloc == 0u) { xcd_barrier_complete(bar, b.x, nloc, nx); b.st[0] = nloc; b.st[1] = nx; }
        const unsigned old = xb_add(&bar[XB_XSUB(b.x)], 1u);
        const unsigned gen = old / nloc;
        if (old + 1u == (gen + 1u) * nloc) {
            __builtin_amdgcn_fence(__ATOMIC_RELEASE, "agent");
            asm volatile("s_waitcnt vmcnt(0)" ::: "memory");
            const unsigned og = xb_add(&bar[XB_TOP], 1u);
            const unsigned tg = og / nx;
            if (og + 1u == (tg + 1u) * nx) xb_add(&bar[XB_TOPGEN], 1u);
            else XB_SPIN(xb_ld(&bar[XB_TOPGEN]) == tg, bar);
            __builtin_amdgcn_fence(__ATOMIC_ACQUIRE, "agent");
            xb_add(&bar[XB_XGEN(b.x)], 1u);
            asm volatile("s_waitcnt vmcnt(0)" ::: "memory");
        } else {
            XB_SPIN(xb_ld(&bar[XB_XGEN(b.x)]) == gen, bar);
            __builtin_amdgcn_fence(__ATOMIC_ACQUIRE, "agent");
            asm volatile("s_waitcnt vmcnt(0)" ::: "memory");
        }
    }
    __syncthreads();
}
constexpr int CW_BAR = 4096;
constexpr size_t CTL_ZERO_BYTES = 65536;
constexpr int LDS_BARST_OFF = LDS_BYTES - 16;

constexpr bool FAST_P1 = true, FAST_P3 = true, FAST_P4 = true, FAST_P6 = true, FAST_P7 = true;
constexpr bool FAST_ATTN = true, FAST_SGU = true;
constexpr bool FAST_ANY = FAST_P1 || FAST_P3 || FAST_P4 || FAST_P6 || FAST_P7;
constexpr int N_PHASES = 10;
__global__ void __launch_bounds__(NTHREADS, 2) fwd(Args A) {
    extern __shared__ __attribute__((aligned(16))) unsigned char lds[];
    float* ldsf = (float*)lds;
    const int lo = A.ph_lo, hi = A.ph_hi;
    if (threadIdx.x < 4) ((volatile XLAS unsigned*)((XLAS unsigned char*)lds + LDS_BARST_OFF))[threadIdx.x] = 0u;
    __syncthreads();
    XcdBarrier bar = xcd_barrier_post((unsigned*)(A.ws + WS_CTL) + CW_BAR, (volatile XLAS unsigned*)((XLAS unsigned char*)lds + LDS_BARST_OFF));
#define IN(k) (lo <= (k) && (k) < hi)
#define SEAM(k) do { if (IN(k) && IN((k) + 1)) xcd_barrier(bar); STAMP((k) + 1); } while (0)
    unsigned long long t_lo = 0, t_hi = 0;
#define STAMP(i) do { if (STAMP_PHASE >= 0) { if ((i) == STAMP_PHASE || (STAMP_PHASE == 98 && (i) == 0)) t_lo = __builtin_amdgcn_s_memrealtime(); if ((i) == STAMP_PHASE + 1 || (STAMP_PHASE == 98 && (i) == 9)) t_hi = __builtin_amdgcn_s_memrealtime(); } } while (0)
    STAMP(0);
    PG8_LAS unsigned char* l3 = (PG8_LAS unsigned char*)lds;
    if (IN(0)) { if (FAST_ANY) { p0_weights(A, l3, 0, 0); __syncthreads(); } p0_rows(A, ldsf); } SEAM(0);
    if (IN(1)) { if (FAST_P1) p1_fast(A, l3); else p1_naive(A, ldsf); if (FAST_ANY) { __syncthreads(); p0_weights(A, l3, 1, (1152 % (int)gridDim.x == 0) ? 0 : 1152 % (int)gridDim.x); } } SEAM(1);
    if (IN(2)) { if (PROBE_ALT == 2) { p1b_fix<1>(A, ldsf); __syncthreads(); } p1b_fix<0>(A, ldsf); } SEAM(2);
    if (IN(3)) { if (FAST_SGU) fs::sgu_phase(A, l3); else p2_sgu_naive(A); if (FAST_ATTN) { __syncthreads(); fa::attn_phase(A, l3); } else p2_attn_naive(A, ldsf); } SEAM(3);
    if (IN(4)) { if (FAST_P3) p3_fast(A, l3); else p3_naive(A, ldsf); } SEAM(4);
    if (IN(5)) { if (FAST_P4) p4_fast(A, l3); else p4_naive(A, ldsf); } SEAM(5);
    if (IN(6)) { if (PROBE_ALT == 6) { p5_router2<1>(A, ldsf); __syncthreads(); } p5_router2<0>(A, ldsf); } SEAM(6);
    if (IN(7)) { if (FAST_P6) p6_fast(A, l3); else p6_naive(A, ldsf); } SEAM(7);
    if (IN(8)) { if (FAST_P7) p7_fast(A, l3); else p7_naive(A, ldsf); } SEAM(8);
    if (IN(9)) { if (PROBE_ALT == 9) { p8_combine<1>(A, ldsf); __syncthreads(); } p8_combine<0>(A, ldsf, STAMP_PHASE < 0 ? 0.f : (STAMP_PHASE == 99 ? 1.0f : (float)(t_hi - t_lo) * 0.01f * 0.001f * STAMP_SCALE)); }
#undef IN
#undef SEAM
}

#ifndef MK_N_LAUNCHES
#define MK_N_LAUNCHES 1
#endif
extern "C" void kernel_launch(void* const* d_in, const int* in_sizes, int n_in, void* d_out, int out_size, void* d_ws, size_t ws_size, hipStream_t stream) {
    static int grid = 0;
    if (grid == 0) {
        if (n_in != 22 || out_size != T * DM || ws_size < WS_END) { fprintf(stderr, "kernel_launch: unexpected shapes (n_in %d out %d ws %zu)\n", n_in, out_size, ws_size); grid = -1; return; }
        int dev = 0, cus = 0, per_cu = 0;
        hipGetDevice(&dev); hipDeviceGetAttribute(&cus, hipDeviceAttributeMultiprocessorCount, dev);
        hipFuncSetAttribute((const void*)fwd, hipFuncAttributeMaxDynamicSharedMemorySize, LDS_BYTES);
        hipOccupancyMaxActiveBlocksPerMultiprocessor(&per_cu, (const void*)fwd, NTHREADS, LDS_BYTES);
        if (per_cu < 1) { fprintf(stderr, "kernel_launch: occupancy query says %d blocks per CU\n", per_cu); per_cu = 1; }
        (void)hipGetLastError();
        grid = cus;
    }
    if (grid < 0) return;
    Args a{};
    for (int i = 0; i < 22; ++i) a.in[i] = (const float*)d_in[i];
    a.out = (float*)d_out; a.ws = (unsigned char*)d_ws;
    if (hipMemsetAsync((char*)d_ws + WS_CTL, 0, CTL_ZERO_BYTES, stream) != hipSuccess) { fprintf(stderr, "kernel_launch: memset failed\n"); return; }
    if (MK_N_LAUNCHES == 1) {
        a.ph_lo = 0; a.ph_hi = N_PHASES;
        hipLaunchKernelGGL(fwd, dim3(grid), dim3(NTHREADS), LDS_BYTES, stream, a);
    } else {
        for (int p = 0; p < N_PHASES; ++p) { a.ph_lo = p; a.ph_hi = p + 1; hipLaunchKernelGGL(fwd, dim3(grid), dim3(NTHREADS), LDS_BYTES, stream, a); }
    }
}
```

```cpp
#include <hip/hip_runtime.h>
#include <hip/hip_cooperative_groups.h>
#include <cstdio>
#include <cstdint>
namespace cg = cooperative_groups;

#ifndef STAMP_PHASE
#define STAMP_PHASE -1
#endif
#ifndef STAMP_SEL
#define STAMP_SEL 0
#endif
#ifndef STAMP_SCALE
#define STAMP_SCALE 0.5f
#endif
#ifndef PROBE_ALT
#define PROBE_ALT -1
#endif
constexpr int T = 8192, SEQ = 2048, NB = 4, DM = 2048, SGUW = 1024, FOXW = 1024, NH = 8, HD = 128, CHUNK = 128, NG = 8;
constexpr int INCOLS = 9224, OFF_F = 5120, OFF_GATE = 5128;
constexpr int NEXP = 32, EPG = 8, NGRP = 4, DEXP = 512;
constexpr float EPS = 1e-6f;
constexpr float LOG2E = 1.4426950408889634f;
constexpr float QSCALE = 0.08838834764831845f * LOG2E;
constexpr int NTHREADS = 512, NWAVES = 8;
constexpr int LDS_BYTES = 160 * 1024;
constexpr int MTILE = 256;
constexpr int PMAX = 2 * T + NEXP * MTILE;
constexpr int MT_MAX = PMAX / MTILE;
constexpr int TINY_ROWS = 0;

typedef unsigned short bf16_t;
typedef float f32x4 __attribute__((ext_vector_type(4)));
typedef unsigned u32x4 __attribute__((ext_vector_type(4)));
typedef unsigned u32x2 __attribute__((ext_vector_type(2)));

constexpr size_t MiB = 1u << 20;
constexpr size_t WS_CTL = 0;
constexpr size_t WS_LOGF = 1 * MiB;
constexpr size_t WS_CKL = 2 * MiB;
constexpr size_t WS_TOK = 3 * MiB;
constexpr size_t WS_GATE = 4 * MiB;
constexpr size_t WS_ASG = 5 * MiB;
constexpr size_t WS_WIN = 8 * MiB;
constexpr size_t WS_WPROJ = 44 * MiB;
constexpr size_t WS_WOUT = 52 * MiB;
constexpr size_t WS_WGU = 60 * MiB;
constexpr size_t WS_WD = 188 * MiB;
constexpr size_t WS_H = 252 * MiB;
constexpr size_t WS_MIXED = WS_H;
constexpr size_t WS_U = 284 * MiB;
constexpr size_t WS_V = 300 * MiB;
constexpr size_t WS_G = 316 * MiB;
constexpr size_t WS_YBUF = WS_U;
constexpr size_t WS_Q = 380 * MiB;
constexpr size_t WS_K = 396 * MiB;
constexpr size_t WS_VA = 412 * MiB;
constexpr size_t WS_ACT = WS_Q;
constexpr size_t WS_MIXIN = 428 * MiB;
constexpr size_t WS_H2 = WS_MIXIN;
constexpr size_t WS_END = 460 * MiB;
static_assert((size_t)PMAX * 2048 * 2 <= 96 * MiB && (size_t)PMAX * 512 * 2 <= 32 * MiB, "overlay sizes");

constexpr int CW_CNT = 0;

__device__ __forceinline__ float bf2f(bf16_t v) { return __uint_as_float((unsigned)v << 16); }
__device__ __forceinline__ bf16_t f2bf(float f) { unsigned u = __float_as_uint(f); return (bf16_t)((u + 0x7fffu + ((u >> 16) & 1u)) >> 16); }
__device__ __forceinline__ unsigned pk2(float lo, float hi) { return (unsigned)f2bf(lo) | ((unsigned)f2bf(hi) << 16); }
__device__ __forceinline__ float wave_sum(float v) {
#pragma unroll
    for (int o = 1; o < 64; o <<= 1) v += __shfl_xor(v, o);
    return v;
}
__device__ __forceinline__ float wave_max(float v) {
#pragma unroll
    for (int o = 1; o < 64; o <<= 1) v = fmaxf(v, __shfl_xor(v, o));
    return v;
}
__device__ __forceinline__ float gelu_tanh(float x) {
    const float c = 0.7978845608028654f; const float y = c * (x + 0.044715f * x * x * x);
    return x / (1.0f + __expf(-2.0f * y));
}
__device__ __forceinline__ float sigmoidf_(float x) { return 1.0f / (1.0f + __expf(-x)); }
__device__ __forceinline__ float log_sigmoid(float z) { return fminf(z, 0.f) - log1pf(__expf(-fabsf(z))); }

struct Args {
    const float* in[22];
    float* out;
    unsigned char* ws;
    int ph_lo, ph_hi;
};

template <class AF, class BF, class EF>
__device__ __forceinline__ void naive_gemm_tile(float* lds, int m0, int n0, int M, int N, int K, int Ksplit, AF a, BF b, EF epi) {
    float* As = lds;
    float* Bs = lds + 16 * 132;
    const int tid = threadIdx.x, ty = tid >> 4, tx = tid & 15;
    float acc[4][8], acc1[4][8];
#pragma unroll
    for (int i = 0; i < 4; ++i)
#pragma unroll
        for (int j = 0; j < 8; ++j) { acc[i][j] = 0.f; acc1[i][j] = 0.f; }
    const bool split = Ksplit < K;
#pragma unroll 1
    for (int pass = 0; pass < 2; ++pass) {
        const int kb = pass == 0 ? 0 : Ksplit, ke = pass == 0 ? (split ? Ksplit : K) : K;
        if (pass == 1) {
            if (!split) break;
#pragma unroll
            for (int i = 0; i < 4; ++i)
#pragma unroll
                for (int j = 0; j < 8; ++j) { acc1[i][j] = acc[i][j]; acc[i][j] = 0.f; }
        }
#pragma unroll 1
        for (int k0 = kb; k0 < ke; k0 += 16) {
#pragma unroll
            for (int i = 0; i < 4; ++i) { const int idx = tid + i * 512, r = idx >> 4, kk = idx & 15; const int m = m0 + r; As[kk * 132 + r] = (m < M) ? a(m, k0 + kk) : 0.f; }
#pragma unroll
            for (int i = 0; i < 4; ++i) { const int idx = tid + i * 512, kk = idx >> 7, n = idx & 127; Bs[kk * 132 + n] = (n0 + n < N) ? b(k0 + kk, n0 + n) : 0.f; }
            __syncthreads();
#pragma unroll 4
            for (int kk = 0; kk < 16; ++kk) {
                float av[4], bv[8];
#pragma unroll
                for (int i = 0; i < 4; ++i) av[i] = As[kk * 132 + ty * 4 + i];
#pragma unroll
                for (int j = 0; j < 8; ++j) bv[j] = Bs[kk * 132 + tx * 8 + j];
#pragma unroll
                for (int i = 0; i < 4; ++i)
#pragma unroll
                    for (int j = 0; j < 8; ++j) acc[i][j] = fmaf(av[i], bv[j], acc[i][j]);
            }
            __syncthreads();
        }
    }
#pragma unroll
    for (int i = 0; i < 4; ++i)
#pragma unroll
        for (int j = 0; j < 8; ++j) { const int m = m0 + ty * 4 + i, n = n0 + tx * 8 + j; if (m < M && n < N) epi(m, n, split ? acc1[i][j] : acc[i][j], split ? acc[i][j] : 0.f); }
}
template <class AF, class BF, class EF>
__device__ __forceinline__ void naive_gemm(float* lds, int M, int N, int K, int Ksplit, AF a, BF b, EF epi) {
    const int ntm = (M + 127) / 128, ntn = (N + 127) / 128;
    for (int t = blockIdx.x; t < ntm * ntn; t += gridDim.x) naive_gemm_tile(lds, (t / ntn) * 128, (t % ntn) * 128, M, N, K, Ksplit, a, b, epi);
}

__device__ __forceinline__ void p0_rows(const Args& A, float* ldsf) {
    const float* x = A.in[0]; const float* g1 = A.in[1]; const float* w_in = A.in[2]; const float* b_forget = A.in[4];
    bf16_t* H = (bf16_t*)(A.ws + WS_H); float* LOGF = (float*)(A.ws + WS_LOGF);
    const int tid = threadIdx.x, lane = tid & 63, wave = tid >> 6;
    for (int i = tid; i < DM * 8; i += NTHREADS) ldsf[i] = w_in[(size_t)(i >> 3) * INCOLS + OFF_F + (i & 7)];
    __syncthreads();
    const int gw = blockIdx.x * NWAVES + wave, NGW = gridDim.x * NWAVES;
    for (int row = gw; row < T; row += NGW) {
        const f32x4* xr = (const f32x4*)(x + (size_t)row * DM) + lane;
        float ss = 0.f;
#pragma unroll
        for (int j = 0; j < 8; ++j) { const f32x4 v = xr[64 * j]; ss += v.x * v.x + v.y * v.y + v.z * v.z + v.w * v.w; }
        const float rstd = rsqrtf(wave_sum(ss) * (1.f / DM) + EPS);
        float f[8];
#pragma unroll
        for (int h = 0; h < 8; ++h) f[h] = 0.f;
#pragma unroll 1
        for (int j = 0; j < 8; ++j) {
            const int c0 = 256 * j + 4 * lane; const f32x4 g = *(const f32x4*)(g1 + c0); const f32x4 xv = xr[64 * j];
            f32x4 hv; hv.x = xv.x * rstd * g.x; hv.y = xv.y * rstd * g.y; hv.z = xv.z * rstd * g.z; hv.w = xv.w * rstd * g.w;
            u32x2 o; o.x = pk2(hv.x, hv.y); o.y = pk2(hv.z, hv.w);
            *(u32x2*)(H + (size_t)row * DM + c0) = o;
#pragma unroll
            for (int e = 0; e < 4; ++e) { const float hx = hv[e]; const float* wf = ldsf + (c0 + e) * 8;
#pragma unroll
                for (int h = 0; h < 8; ++h) f[h] = fmaf(hx, wf[h], f[h]); }
        }
#pragma unroll
        for (int h = 0; h < 8; ++h) f[h] = wave_sum(f[h]);
        if (lane < 8) { float z = 0.f;
#pragma unroll
            for (int h = 0; h < 8; ++h) if (lane == h) z = f[h];
            LOGF[(size_t)row * 8 + lane] = log_sigmoid(z + b_forget[lane]); }
    }
}

__device__ __forceinline__ void p1_naive(const Args& A, float* ldsf) {
    const bf16_t* H = (const bf16_t*)(A.ws + WS_H); const float* w_in = A.in[2]; const float* b_gate = A.in[3];
    bf16_t* U = (bf16_t*)(A.ws + WS_U); bf16_t* V = (bf16_t*)(A.ws + WS_V); bf16_t* Q = (bf16_t*)(A.ws + WS_Q); bf16_t* K = (bf16_t*)(A.ws + WS_K);
    bf16_t* VA = (bf16_t*)(A.ws + WS_VA); bf16_t* G = (bf16_t*)(A.ws + WS_G);
    naive_gemm(ldsf, T, 9216, DM, DM,
        [=](int m, int k) { return bf2f(H[(size_t)m * DM + k]); },
        [=](int k, int n) { const int c = n < 5120 ? n : n + 8; return w_in[(size_t)k * INCOLS + c]; },
        [=](int m, int n, float s, float) {
            if (n < 1024) U[(size_t)m * 1024 + n] = f2bf(gelu_tanh(s));
            else if (n < 2048) V[(size_t)m * 1024 + n - 1024] = f2bf(gelu_tanh(s));
            else if (n < 3072) Q[(size_t)m * 1024 + n - 2048] = f2bf(s);
            else if (n < 4096) K[(size_t)m * 1024 + n - 3072] = f2bf(s);
            else if (n < 5120) VA[(size_t)m * 1024 + n - 4096] = f2bf(s);
            else G[(size_t)m * 4096 + n - 5120] = f2bf(sigmoidf_(s + b_gate[n - 5120]));
        });
}

template <int ALT> __device__ __forceinline__ void p1b_fix(const Args& A, float* ldsf) {
    bf16_t* V = (bf16_t*)(A.ws + WS_V); bf16_t* Q = (bf16_t*)(A.ws + WS_Q); bf16_t* K = (bf16_t*)(A.ws + WS_K);
    const size_t altoff = ALT ? ((size_t)((unsigned char*)A.out - (A.ws + WS_V))) / 2 : 0;
    const size_t altq = ALT ? ((size_t)((unsigned char*)A.out + 16 * MiB - (A.ws + WS_Q))) / 2 : 0, altk = ALT ? ((size_t)((unsigned char*)A.out + 32 * MiB - (A.ws + WS_K))) / 2 : 0;
    const float* ln_g = A.in[5]; const float* ln_b = A.in[6]; const float* qg = A.in[9]; const float* kg = A.in[10];
    const int tid = threadIdx.x, lane = tid & 63, wave = tid >> 6;
    const int gw = blockIdx.x * NWAVES + wave, NGW = gridDim.x * NWAVES;
    for (int row = gw; row < T; row += NGW) {
        {
            bf16_t* vr = V + (size_t)row * 1024; float v[16]; float s = 0.f;
#pragma unroll
            for (int j = 0; j < 2; ++j) { const u32x4 w = *(const u32x4*)(vr + 512 * j + 8 * lane);
#pragma unroll
                for (int e = 0; e < 4; ++e) { v[8 * j + 2 * e] = __uint_as_float(w[e] << 16); v[8 * j + 2 * e + 1] = __uint_as_float(w[e] & 0xffff0000u); } }
#pragma unroll
            for (int i = 0; i < 16; ++i) s += v[i];
            const float mean = wave_sum(s) * (1.f / 1024.f); float q = 0.f;
#pragma unroll
            for (int i = 0; i < 16; ++i) { v[i] -= mean; q += v[i] * v[i]; }
            const float rstd = rsqrtf(wave_sum(q) * (1.f / 1024.f) + EPS);
#pragma unroll
            for (int j = 0; j < 2; ++j) { const int c0 = 512 * j + 8 * lane; u32x4 o;
#pragma unroll
                for (int e = 0; e < 4; ++e) o[e] = pk2(v[8 * j + 2 * e] * rstd * ln_g[c0 + 2 * e] + ln_b[c0 + 2 * e], v[8 * j + 2 * e + 1] * rstd * ln_g[c0 + 2 * e + 1] + ln_b[c0 + 2 * e + 1]);
                *(u32x4*)(vr + altoff + c0) = o; }
        }
#pragma unroll
        for (int which = 0; which < 2; ++which) {
            bf16_t* pr = (which == 0 ? Q : K) + (size_t)row * 1024 + 16 * lane; const float* gg = which == 0 ? qg : kg; float v[16]; float s = 0.f;
#pragma unroll
            for (int j = 0; j < 2; ++j) { const u32x4 w = *(const u32x4*)(pr + 8 * j);
#pragma unroll
                for (int e = 0; e < 4; ++e) { v[8 * j + 2 * e] = __uint_as_float(w[e] << 16); v[8 * j + 2 * e + 1] = __uint_as_float(w[e] & 0xffff0000u); } }
#pragma unroll
            for (int i = 0; i < 16; ++i) s += v[i] * v[i];
            s += __shfl_xor(s, 1); s += __shfl_xor(s, 2); s += __shfl_xor(s, 4);
            const float sc = rsqrtf(s * (1.f / 128.f) + EPS) * (which == 0 ? QSCALE : 1.f); const int d0 = (16 * lane) & 127;
#pragma unroll
            for (int j = 0; j < 2; ++j) { u32x4 o;
#pragma unroll
                for (int e = 0; e < 4; ++e) o[e] = pk2(v[8 * j + 2 * e] * sc * gg[d0 + 8 * j + 2 * e], v[8 * j + 2 * e + 1] * sc * gg[d0 + 8 * j + 2 * e + 1]);
                *(u32x4*)(pr + (which == 0 ? altq : altk) + 8 * j) = o; }
        }
    }
    if (blockIdx.x < NB * NH) {
        const int b = blockIdx.x / NH, h = blockIdx.x % NH; const float* LOGF = (const float*)(A.ws + WS_LOGF); float* CKL = (float*)(A.ws + WS_CKL) + (size_t)blockIdx.x * SEQ + (ALT ? 65536 : 0);
        float v[4]; float s = 0.f;
#pragma unroll
        for (int i = 0; i < 4; ++i) { v[i] = LOGF[(size_t)(b * SEQ + tid * 4 + i) * 8 + h]; s += v[i]; }
        float incl = s;
#pragma unroll
        for (int o = 1; o < 64; o <<= 1) { const float t = __shfl_up(incl, o); if (lane >= o) incl += t; }
        __syncthreads();
        if (lane == 63) ldsf[wave] = incl;
        __syncthreads();
        float base = 0.f;
        for (int w = 0; w < wave; ++w) base += ldsf[w];
        float run = base + incl - s;
#pragma unroll
        for (int i = 0; i < 4; ++i) { run += v[i]; CKL[tid * 4 + i] = run * LOG2E; }
        __syncthreads();
    }
}

__device__ __forceinline__ void p2_sgu_naive(const Args& A) {
    const bf16_t* U = (const bf16_t*)(A.ws + WS_U); const bf16_t* V = (const bf16_t*)(A.ws + WS_V); bf16_t* MIXIN = (bf16_t*)(A.ws + WS_MIXIN);
    const float* wsp = A.in[7]; const float* bsp = A.in[8];
    const int tid = threadIdx.x, tt = tid >> 2, dp = tid & 3;
    for (int u = blockIdx.x; u < (T / CHUNK) * NG; u += gridDim.x) {
        const int rc = u / NG, g = u % NG; const int row0 = rc * CHUNK;
        float acc[32];
#pragma unroll
        for (int i = 0; i < 32; ++i) acc[i] = 0.f;
        for (int ss = 0; ss <= tt; ++ss) {
            const float w = wsp[((size_t)g * CHUNK + tt) * CHUNK + ss];
            const bf16_t* vr = V + (size_t)(row0 + ss) * 1024 + g * 128 + dp * 32;
#pragma unroll
            for (int i = 0; i < 32; ++i) acc[i] = fmaf(w, bf2f(vr[i]), acc[i]);
        }
        const float bb = bsp[g * CHUNK + tt];
        const bf16_t* ur = U + (size_t)(row0 + tt) * 1024 + g * 128 + dp * 32; bf16_t* orow = MIXIN + (size_t)(row0 + tt) * 2048 + g * 128 + dp * 32;
#pragma unroll
        for (int i = 0; i < 32; ++i) orow[i] = f2bf(bf2f(ur[i]) * (acc[i] + bb));
    }
}
__device__ __forceinline__ void p2_attn_naive(const Args& A, float* ldsf) {
    const bf16_t* Q = (const bf16_t*)(A.ws + WS_Q); const bf16_t* K = (const bf16_t*)(A.ws + WS_K); const bf16_t* VA = (const bf16_t*)(A.ws + WS_VA);
    const float* CKL = (const float*)(A.ws + WS_CKL); bf16_t* MIXIN = (bf16_t*)(A.ws + WS_MIXIN);
    const int tid = threadIdx.x, lane = tid & 63, wave = tid >> 6;
    float* qs = ldsf + wave * 128;
    const int gw = blockIdx.x * NWAVES + wave, NGW = gridDim.x * NWAVES;
    for (int item = gw; item < T * NH; item += NGW) {
        const int row = item / NH, h = item % NH, b = row / SEQ, t = row % SEQ;
        const bf16_t* qr = Q + (size_t)row * 1024 + h * 128;
        qs[lane] = bf2f(qr[lane]); qs[64 + lane] = bf2f(qr[64 + lane]);
        __builtin_amdgcn_s_waitcnt(0);
        const float* ck = CKL + (size_t)(b * NH + h) * SEQ;
        float m = -1e30f, l = 0.f, o0 = 0.f, o1 = 0.f;
        for (int s0 = 0; s0 <= t; s0 += 64) {
            const int s = s0 + lane; float sc = -INFINITY;
            if (s <= t) { const bf16_t* kr = K + (size_t)(b * SEQ + s) * 1024 + h * 128; float d = 0.f;
                for (int c = 0; c < 16; ++c) { const u32x4 w = *(const u32x4*)(kr + 8 * c);
#pragma unroll
                    for (int e = 0; e < 4; ++e) { d = fmaf(qs[8 * c + 2 * e], __uint_as_float(w[e] << 16), d); d = fmaf(qs[8 * c + 2 * e + 1], __uint_as_float(w[e] & 0xffff0000u), d); } }
                sc = d - ck[s]; }
            const float mn = fmaxf(m, wave_max(sc)); const float alpha = exp2f(m - mn); const float p = exp2f(sc - mn);
            l = l * alpha + wave_sum(p); o0 *= alpha; o1 *= alpha; m = mn;
            const int nk = min(64, t - s0 + 1);
            for (int j = 0; j < nk; ++j) { const float pj = __shfl(p, j); const unsigned w = *(const unsigned*)(VA + (size_t)(b * SEQ + s0 + j) * 1024 + h * 128 + 2 * lane);
                o0 = fmaf(pj, __uint_as_float(w << 16), o0); o1 = fmaf(pj, __uint_as_float(w & 0xffff0000u), o1); }
        }
        const float il = 1.f / l;
        *(unsigned*)(MIXIN + (size_t)row * 2048 + 1024 + h * 128 + 2 * lane) = pk2(o0 * il, o1 * il);
    }
}

__device__ __forceinline__ void p3_naive(const Args& A, float* ldsf) {
    const bf16_t* MIXIN = (const bf16_t*)(A.ws + WS_MIXIN); const bf16_t* G = (const bf16_t*)(A.ws + WS_G); bf16_t* MIXED = (bf16_t*)(A.ws + WS_MIXED);
    const float* wps = A.in[11]; const float* wpf = A.in[12];
    naive_gemm(ldsf, T, DM, 2048, 1024,
        [=](int m, int k) { return bf2f(MIXIN[(size_t)m * 2048 + k]); },
        [=](int k, int n) { return k < 1024 ? wps[(size_t)k * DM + n] : wpf[(size_t)(k - 1024) * DM + n]; },
        [=](int m, int n, float s1, float s2) { MIXED[(size_t)m * DM + n] = f2bf(bf2f(G[(size_t)m * 4096 + n]) * s1 + bf2f(G[(size_t)m * 4096 + 2048 + n]) * s2); });
}
__device__ __forceinline__ void p4_naive(const Args& A, float* ldsf) {
    const bf16_t* MIXED = (const bf16_t*)(A.ws + WS_MIXED); const float* wo = A.in[13]; const float* x = A.in[0]; float* X1 = A.out;
    naive_gemm(ldsf, T, DM, DM, DM,
        [=](int m, int k) { return bf2f(MIXED[(size_t)m * DM + k]); },
        [=](int k, int n) { return wo[(size_t)k * DM + n]; },
        [=](int m, int n, float s, float) { X1[(size_t)m * DM + n] = x[(size_t)m * DM + n] + s; });
}

template <int ALT> __device__ __forceinline__ void p5_router(const Args& A, float* ldsf) {
    const float* X1 = A.out; const float* g2 = A.in[14]; const float* wrg = A.in[15]; const float* brg = A.in[16]; const float* wre = A.in[17]; const float* bre = A.in[18];
    bf16_t* H2 = (bf16_t*)(A.ws + WS_H2); unsigned* cnt = (unsigned*)(A.ws + WS_CTL) + CW_CNT + (ALT ? 64 : 0);
    int* TOK = (int*)(A.ws + (ALT ? WS_H : WS_TOK)); float* GATE = (float*)(A.ws + (ALT ? WS_H + 2 * MiB : WS_GATE)); int* ASG = (int*)(A.ws + (ALT ? WS_H + 4 * MiB : WS_ASG));
    const int tid = threadIdx.x, lane = tid & 63, wave = tid >> 6, r = tid >> 4, ks = tid & 15;
    float* Ws = ldsf;
    float* Xs = ldsf + 256 * 36;
    float* rs = Xs + 32 * 260;
    int* hist = (int*)(rs + 32);
    int* hbase = hist + 32;
    int* sel = hbase + 32;
    int* lpos = sel + 64;
    float* selw = (float*)(lpos + 64);
    for (int rb = blockIdx.x; rb < T / 32; rb += gridDim.x) {
        const int row0 = rb * 32;
        for (int i = 0; i < 4; ++i) { const int rr = wave * 4 + i; const f32x4* xr = (const f32x4*)(X1 + (size_t)(row0 + rr) * DM) + lane; float ss = 0.f;
#pragma unroll
            for (int j = 0; j < 8; ++j) { const f32x4 v = xr[64 * j]; ss += v.x * v.x + v.y * v.y + v.z * v.z + v.w * v.w; }
            ss = wave_sum(ss); if (lane == 0) rs[rr] = rsqrtf(ss * (1.f / DM) + EPS); }
        if (tid < 32) hist[tid] = 0;
        __syncthreads();
        float acc[36];
#pragma unroll
        for (int j = 0; j < 36; ++j) acc[j] = 0.f;
        for (int k0 = 0; k0 < DM; k0 += 256) {
            for (int i = tid; i < 256 * 36; i += NTHREADS) { const int kk = i / 36, j = i % 36; Ws[i] = j < 4 ? wrg[(size_t)(k0 + kk) * 4 + j] : wre[(size_t)(k0 + kk) * 32 + j - 4]; }
            for (int i = tid; i < 32 * 256; i += NTHREADS) { const int rr = i >> 8, kk = i & 255; const float hv = X1[(size_t)(row0 + rr) * DM + k0 + kk] * rs[rr] * g2[k0 + kk];
                Xs[rr * 260 + kk] = hv; H2[(size_t)(row0 + rr) * DM + k0 + kk] = f2bf(hv); }
            __syncthreads();
            for (int kk = ks; kk < 256; kk += 16) { const float xv = Xs[r * 260 + kk]; const float* wr = Ws + kk * 36;
#pragma unroll
                for (int j = 0; j < 36; ++j) acc[j] = fmaf(xv, wr[j], acc[j]); }
            __syncthreads();
        }
#pragma unroll
        for (int j = 0; j < 36; ++j) { float v = acc[j]; v += __shfl_xor(v, 1); v += __shfl_xor(v, 2); v += __shfl_xor(v, 4); v += __shfl_xor(v, 8); acc[j] = v; }
        if (ks == 0) {
            float gl[4]; int grp = 0; float gm;
#pragma unroll
            for (int j = 0; j < 4; ++j) gl[j] = acc[j] + brg[j];
            gm = gl[0];
#pragma unroll
            for (int j = 1; j < 4; ++j) if (gl[j] > gm) { gm = gl[j]; grp = j; }
            float den = 0.f;
#pragma unroll
            for (int j = 0; j < 4; ++j) den += __expf(gl[j] - gm);
            const float pg = 1.f / den;
            float el[8];
#pragma unroll
            for (int j = 0; j < 8; ++j) { float v = 0.f;
#pragma unroll
                for (int g = 0; g < 4; ++g) if (g == grp) v = acc[4 + g * 8 + j] + bre[g * 8 + j];
                el[j] = v; }
            int i0 = 0; float v0 = el[0];
#pragma unroll
            for (int j = 1; j < 8; ++j) if (el[j] > v0) { v0 = el[j]; i0 = j; }
            int i1 = -1; float v1 = -INFINITY;
#pragma unroll
            for (int j = 0; j < 8; ++j) if (j != i0 && el[j] > v1) { v1 = el[j]; i1 = j; }
            const float e1 = __expf(v1 - v0); const float w0 = pg / (1.f + e1), w1 = pg * e1 / (1.f + e1);
            const int ea = grp * 8 + i0, eb = grp * 8 + i1;
            sel[r * 2] = ea; sel[r * 2 + 1] = eb; selw[r * 2] = w0; selw[r * 2 + 1] = w1;
            lpos[r * 2] = atomicAdd(&hist[ea], 1); lpos[r * 2 + 1] = atomicAdd(&hist[eb], 1);
        }
        __syncthreads();
        if (tid < 32) hbase[tid] = hist[tid] > 0 ? (int)atomicAdd(&cnt[tid], (unsigned)hist[tid]) : 0;
        __syncthreads();
        if (tid < 64) { const int e = sel[tid], pos = hbase[e] + lpos[tid]; const int tok = row0 + (tid >> 1);
            TOK[(size_t)e * T + pos] = tok; GATE[(size_t)e * T + pos] = selw[tid]; ASG[tok * 2 + (tid & 1)] = (e << 16) | pos; }
        __syncthreads();
    }
}

template <int ALT> __device__ __forceinline__ void p5_router2(const Args& A, float* ldsf) {
    const float* X1 = A.out; const float* g2 = A.in[14]; const float* wrg = A.in[15]; const float* brg = A.in[16]; const float* wre = A.in[17]; const float* bre = A.in[18];
    bf16_t* H2 = (bf16_t*)(A.ws + WS_H2); unsigned* cnt = (unsigned*)(A.ws + WS_CTL) + CW_CNT + (ALT ? 64 : 0);
    int* TOK = (int*)(A.ws + (ALT ? WS_H : WS_TOK)); float* GATE = (float*)(A.ws + (ALT ? WS_H + 2 * MiB : WS_GATE)); int* ASG = (int*)(A.ws + (ALT ? WS_H + 4 * MiB : WS_ASG));
    const int tid = threadIdx.x, lane = tid & 63, wave = tid >> 6;
    constexpr int XP = 260, XB = 32 * XP, WP = 40, WB = 256 * WP;
    float* Xs = ldsf;
    float* Ws = ldsf + 2 * XB;
    float* misc = ldsf + 2 * XB + 2 * WB;
    float* rs = misc;
    float* lg = misc + 32;
    int* hist = (int*)(misc + 32 + 1280); int* hbase = hist + 32; int* sel = hbase + 32; int* lpos = sel + 64; float* selw = (float*)(lpos + 64);
    const int kh2 = lane >> 5, rp = (lane >> 1) & 15, cg = lane & 1;
    for (int rb = blockIdx.x; rb < T / 32; rb += gridDim.x) {
        const int row0 = rb * 32;
        float ssq[4] = {0.f, 0.f, 0.f, 0.f};
        float acc0[20], acc1[20];
#pragma unroll
        for (int j = 0; j < 20; ++j) { acc0[j] = 0.f; acc1[j] = 0.f; }
        if (tid < 32) hist[tid] = 0;
        f32x4 xr[4], wv[5], gv;
        for (int i = tid; i < 2 * 256; i += NTHREADS) *(f32x4*)(Ws + (i >> 8) * WB + (i & 255) * WP + 36) = (f32x4){0.f, 0.f, 0.f, 0.f};
#define R2_LOAD(k0) do { gv = *(const f32x4*)(g2 + (k0) + 4 * (tid & 63)); \
        _Pragma("unroll") for (int i = 0; i < 4; ++i) xr[i] = *(const f32x4*)(X1 + (size_t)(row0 + wave + 8 * i) * DM + (k0) + 4 * (tid & 63)); \
        _Pragma("unroll") for (int i = 0; i < 5; ++i) { const int idx = tid + i * 512; if (idx < 2304) { const int kk = idx / 9, j4 = idx - kk * 9; \
            wv[i] = j4 == 0 ? *(const f32x4*)(wrg + (size_t)((k0) + kk) * 4) : *(const f32x4*)(wre + (size_t)((k0) + kk) * 32 + 4 * (j4 - 1)); } } } while (0)
#define R2_STORE(buf) do { \
        _Pragma("unroll") for (int i = 0; i < 4; ++i) { ssq[i] += xr[i].x * xr[i].x + xr[i].y * xr[i].y + xr[i].z * xr[i].z + xr[i].w * xr[i].w; \
            *(f32x4*)(Xs + (buf) * XB + (wave + 8 * i) * XP + 4 * (tid & 63)) = xr[i] * gv; } \
        _Pragma("unroll") for (int i = 0; i < 5; ++i) { const int idx = tid + i * 512; if (idx < 2304) { const int kk = idx / 9, j4 = idx - kk * 9; *(f32x4*)(Ws + (buf) * WB + kk * WP + 4 * j4) = wv[i]; } } } while (0)
        R2_LOAD(0); R2_STORE(0);
        __syncthreads();
#pragma unroll 1
        for (int c = 0; c < 8; ++c) {
            const int buf = c & 1;
            if (c < 7) R2_LOAD((c + 1) * 256);
            const float* xa = Xs + buf * XB + (2 * rp) * XP + (wave * 2 + kh2) * 16; const float* wa = Ws + buf * WB + ((wave * 2 + kh2) * 16) * WP + 20 * cg;
#pragma unroll 1
            for (int k4 = 0; k4 < 4; ++k4) {
                const f32x4 x0 = *(const f32x4*)(xa + 4 * k4), x1 = *(const f32x4*)(xa + XP + 4 * k4);
#pragma unroll
                for (int kk = 0; kk < 4; ++kk) { const float* wr = wa + (4 * k4 + kk) * WP;
#pragma unroll
                    for (int j4 = 0; j4 < 5; ++j4) { const f32x4 w = *(const f32x4*)(wr + 4 * j4);
#pragma unroll
                        for (int e = 0; e < 4; ++e) { acc0[4 * j4 + e] = fmaf(x0[kk], w[e], acc0[4 * j4 + e]); acc1[4 * j4 + e] = fmaf(x1[kk], w[e], acc1[4 * j4 + e]); } }
                    asm volatile("" ::: "memory"); }
            }
            if (c < 7) R2_STORE(buf ^ 1);
            __syncthreads();
        }
#undef R2_LOAD
#undef R2_STORE
#pragma unroll
        for (int j = 0; j < 20; ++j) { acc0[j] += __shfl_xor(acc0[j], 32); acc1[j] += __shfl_xor(acc1[j], 32); }
        float* red = Xs;
        if (kh2 == 0) {
#pragma unroll
            for (int j = 0; j < 20; ++j) { red[(wave * 32 + 2 * rp) * 40 + 20 * cg + j] = acc0[j]; red[(wave * 32 + 2 * rp + 1) * 40 + 20 * cg + j] = acc1[j]; } }
#pragma unroll
        for (int i = 0; i < 4; ++i) { const float s = wave_sum(ssq[i]); if (lane == 0) rs[wave + 8 * i] = rsqrtf(s * (1.f / DM) + EPS); }
        __syncthreads();
        for (int i = tid; i < 32 * 40; i += NTHREADS) { float s = 0.f;
#pragma unroll
            for (int w = 0; w < 8; ++w) s += red[w * 1280 + i];
            lg[i] = s * rs[i / 40]; }
        __syncthreads();
#pragma unroll 1
        for (int i = 0; i < 4; ++i) { const int rr = wave + 8 * i; const float rstd = rs[rr]; const float* xp = X1 + (size_t)(row0 + rr) * DM; bf16_t* hp = H2 + (size_t)(row0 + rr) * DM;
#pragma unroll 2
            for (int j = 0; j < 8; ++j) { const int c0 = 256 * j + 4 * lane; const f32x4 v = *(const f32x4*)(xp + c0), g = *(const f32x4*)(g2 + c0);
                u32x2 o; o.x = pk2(v.x * rstd * g.x, v.y * rstd * g.y); o.y = pk2(v.z * rstd * g.z, v.w * rstd * g.w); *(u32x2*)(hp + c0) = o; } }
        if (tid < 32) {
            const int r = tid; const float* L = lg + r * 40;
            float gl[4]; int grp = 0;
#pragma unroll
            for (int j = 0; j < 4; ++j) gl[j] = L[j] + brg[j];
            float gm = gl[0];
#pragma unroll
            for (int j = 1; j < 4; ++j) if (gl[j] > gm) { gm = gl[j]; grp = j; }
            float den = 0.f;
#pragma unroll
            for (int j = 0; j < 4; ++j) den += __expf(gl[j] - gm);
            const float pg = 1.f / den;
            float el[8];
#pragma unroll
            for (int j = 0; j < 8; ++j) el[j] = L[4 + grp * 8 + j] + bre[grp * 8 + j];
            int i0 = 0; float v0 = el[0];
#pragma unroll
            for (int j = 1; j < 8; ++j) if (el[j] > v0) { v0 = el[j]; i0 = j; }
            int i1 = -1; float v1 = -INFINITY;
#pragma unroll
            for (int j = 0; j < 8; ++j) if (j != i0 && el[j] > v1) { v1 = el[j]; i1 = j; }
            const float e1 = __expf(v1 - v0); const float w0 = pg / (1.f + e1), w1 = pg * e1 / (1.f + e1);
            const int ea = grp * 8 + i0, eb = grp * 8 + i1;
            sel[r * 2] = ea; sel[r * 2 + 1] = eb; selw[r * 2] = w0; selw[r * 2 + 1] = w1;
            lpos[r * 2] = atomicAdd(&hist[ea], 1); lpos[r * 2 + 1] = atomicAdd(&hist[eb], 1);
        }
        __syncthreads();
        if (tid < 32) hbase[tid] = hist[tid] > 0 ? (int)atomicAdd(&cnt[tid], (unsigned)hist[tid]) : 0;
        __syncthreads();
        if (tid < 64) { const int e = sel[tid], pos = hbase[e] + lpos[tid]; const int tok = row0 + (tid >> 1);
            TOK[(size_t)e * T + pos] = tok; GATE[(size_t)e * T + pos] = selw[tid]; ASG[tok * 2 + (tid & 1)] = (e << 16) | pos; }
        __syncthreads();
    }
}

__device__ __forceinline__ void expert_layout(const unsigned* cnt, int* pstart  ) {
    int acc = 0;
    for (int e = 0; e < NEXP; ++e) { pstart[e] = acc; acc += ((int)cnt[e] + MTILE - 1) / MTILE * MTILE; }
    pstart[NEXP] = acc;
}

__device__ __forceinline__ void p6_naive(const Args& A, float* ldsf) {
    const bf16_t* H2 = (const bf16_t*)(A.ws + WS_H2); const float* wg = A.in[19]; const float* wu = A.in[20]; bf16_t* ACT = (bf16_t*)(A.ws + WS_ACT);
    const unsigned* cnt = (const unsigned*)(A.ws + WS_CTL) + CW_CNT; const int* TOK = (const int*)(A.ws + WS_TOK);
    int* ps = (int*)(ldsf + 2 * 16 * 132);
    if (threadIdx.x == 0) expert_layout(cnt, ps);
    __syncthreads();
    int ntot = 0;
    for (int e = 0; e < NEXP; ++e) ntot += (((int)cnt[e] + 127) / 128) * 4;
    for (int t = blockIdx.x; t < ntot; t += gridDim.x) {
        int e = 0, rem = t;
        for (; e < NEXP; ++e) { const int n = (((int)cnt[e] + 127) / 128) * 4; if (rem < n) break; rem -= n; }
        const int c = (int)cnt[e]; const int tm = rem / 4, tn = rem % 4; const int* tl = TOK + (size_t)e * T; const int prow = ps[e];
        const float* wge = wg + (size_t)e * DM * DEXP; const float* wue = wu + (size_t)e * DM * DEXP;
        naive_gemm_tile(ldsf, tm * 128, tn * 128, c, DEXP, 2 * DM, DM,
            [=](int m, int k) { return bf2f(H2[(size_t)tl[m] * DM + (k & (DM - 1))]); },
            [=](int k, int n) { return k < DM ? wge[(size_t)k * DEXP + n] : wue[(size_t)(k - DM) * DEXP + n]; },
            [=](int m, int n, float sg, float su) { ACT[(size_t)(prow + m) * DEXP + n] = f2bf(sg / (1.f + __expf(-sg)) * su); });
    }
}
__device__ __forceinline__ void p7_naive(const Args& A, float* ldsf) {
    const bf16_t* ACT = (const bf16_t*)(A.ws + WS_ACT); const float* wd = A.in[21]; bf16_t* YBUF = (bf16_t*)(A.ws + WS_YBUF);
    const unsigned* cnt = (const unsigned*)(A.ws + WS_CTL) + CW_CNT; const float* GATE = (const float*)(A.ws + WS_GATE);
    int* ps = (int*)(ldsf + 2 * 16 * 132);
    if (threadIdx.x == 0) expert_layout(cnt, ps);
    __syncthreads();
    int ntot = 0;
    for (int e = 0; e < NEXP; ++e) ntot += (((int)cnt[e] + 127) / 128) * 16;
    for (int t = blockIdx.x; t < ntot; t += gridDim.x) {
        int e = 0, rem = t;
        for (; e < NEXP; ++e) { const int n = (((int)cnt[e] + 127) / 128) * 16; if (rem < n) break; rem -= n; }
        const int c = (int)cnt[e]; const int tm = rem / 16, tn = rem % 16; const float* gl = GATE + (size_t)e * T; const int prow = ps[e];
        const float* wde = wd + (size_t)e * DEXP * DM;
        naive_gemm_tile(ldsf, tm * 128, tn * 128, c, DM, DEXP, DEXP,
            [=](int m, int k) { return bf2f(ACT[(size_t)(prow + m) * DEXP + k]); },
            [=](int k, int n) { return wde[(size_t)k * DM + n]; },
            [=](int m, int n, float s, float) { YBUF[(size_t)(prow + m) * DM + n] = f2bf(s * gl[m]); });
    }
}

template <int ALT> __device__ __forceinline__ void p8_combine(const Args& A, float* ldsf, const float dlt = 0.f) {
    float* X1 = A.out; float* XO = ALT ? (float*)(A.ws + WS_WGU) : A.out; const bf16_t* YBUF = (const bf16_t*)(A.ws + WS_YBUF); const int* ASG = (const int*)(A.ws + WS_ASG);
    const unsigned* cnt = (const unsigned*)(A.ws + WS_CTL) + CW_CNT;
    int* ps = (int*)ldsf;
    if (threadIdx.x == 0) expert_layout(cnt, ps);
    __syncthreads();
    float dl2 = dlt;
    if (STAMP_PHASE == 97) { int v = 0, mx = 0, mn = 1 << 30, nt_ = 0, tiny = 0, half = 0; for (int e = 0; e < NEXP; ++e) { const int c = (int)cnt[e]; mx = c > mx ? c : mx; mn = c < mn ? c : mn; nt_ += (c + 255) / 256; const int rem = c % 256; tiny += (rem > 0 && rem <= 64) ? 1 : 0; half += (rem > 0 && rem <= 128) ? 1 : 0; }
        v = STAMP_SEL == 0 ? nt_ : STAMP_SEL == 1 ? mx : STAMP_SEL == 2 ? mn : STAMP_SEL == 3 ? tiny : half; dl2 = 0.01f * (float)v; }
    const int tid = threadIdx.x, lane = tid & 63, wave = tid >> 6;
    const int gw = blockIdx.x * NWAVES + wave, NGW = gridDim.x * NWAVES;
    for (int row = gw; row < T; row += NGW) {
        const int a0 = ASG[row * 2], a1 = ASG[row * 2 + 1];
        const bf16_t* y0 = YBUF + (size_t)(ps[a0 >> 16] + (a0 & 0xffff)) * DM; const bf16_t* y1 = YBUF + (size_t)(ps[a1 >> 16] + (a1 & 0xffff)) * DM;
        float* xr = X1 + (size_t)row * DM;
#pragma unroll
        for (int j = 0; j < 4; ++j) { const int c0 = 512 * j + 8 * lane; const u32x4 w0 = *(const u32x4*)(y0 + c0), w1 = *(const u32x4*)(y1 + c0);
            f32x4 xa = *(const f32x4*)(xr + c0), xb = *(const f32x4*)(xr + c0 + 4);
            xa.x += __uint_as_float(w0[0] << 16) + __uint_as_float(w1[0] << 16); xa.y += __uint_as_float(w0[0] & 0xffff0000u) + __uint_as_float(w1[0] & 0xffff0000u);
            xa.z += __uint_as_float(w0[1] << 16) + __uint_as_float(w1[1] << 16); xa.w += __uint_as_float(w0[1] & 0xffff0000u) + __uint_as_float(w1[1] & 0xffff0000u);
            xb.x += __uint_as_float(w0[2] << 16) + __uint_as_float(w1[2] << 16); xb.y += __uint_as_float(w0[2] & 0xffff0000u) + __uint_as_float(w1[2] & 0xffff0000u);
            xb.z += __uint_as_float(w0[3] << 16) + __uint_as_float(w1[3] << 16); xb.w += __uint_as_float(w0[3] & 0xffff0000u) + __uint_as_float(w1[3] & 0xffff0000u);
            if (STAMP_PHASE >= 0) { xa += dl2; xb += dl2; }
            *(f32x4*)(XO + (size_t)row * DM + c0) = xa; *(f32x4*)(XO + (size_t)row * DM + c0 + 4) = xb; }
    }
}

namespace pg8 {
#define PG8_LAS __attribute__((address_space(3)))
typedef short bf16x8 __attribute__((ext_vector_type(8)));
constexpr int BM = 256, BK = 64, HALF = 128, HTB = HALF * BK * 2, STAGE_BYTES = 8 * HTB, NXCD = 8, WGM = 8;
__host__ __device__ __forceinline__ int lds_byte(int r, int c) { const int st = (r >> 4) * 2 + (c >> 5), rr = r & 15, cc = c & 31, ob = rr * 64 + cc * 2; return st * 1024 + (ob ^ (((ob >> 9) & 1) << 5)); }
__host__ __device__ __forceinline__ void stage_rc(int b, int& R, int& C) { const int st = b / 1024, sb = b % 1024, swz = sb ^ (((sb >> 9) & 1) << 5); R = (st >> 1) * 16 + swz / 64; C = (st & 1) * 32 + (swz % 64) / 2; }
__host__ __device__ __forceinline__ int perm32(int rho) { const int n = rho >> 4, i = rho & 15; return 8 * (i >> 2) + 4 * n + (i & 3); }

struct Unit { const char* A; const char* B; int pm, pn, x0, x1, x2, x3; };

struct DenseOrder {
    const char* A; const char* Bt; int K, nM, nN, nwg, G, c;
    __device__ void init(const void* A_, const void* Bt_, int M, int N, int K_, int G_, int c_) { A = (const char*)A_; Bt = (const char*)Bt_; K = K_; nM = M / BM; nN = N / BM; nwg = nM * nN; G = G_; c = c_; }
    __device__ bool next(int i, Unit& u) const {
        const long L = (long)i * G + c; if (L >= nwg) return false;
        int wgid = (int)L; { const int q = nwg / NXCD, r = nwg % NXCD, xcd = wgid % NXCD, off = wgid / NXCD; wgid = (xcd < r ? xcd * (q + 1) : r * (q + 1) + (xcd - r) * q) + off; }
        const int nig = WGM * nN, gid = wgid / nig, fm = gid * WGM, gsz = (nM - fm) < WGM ? (nM - fm) : WGM;
        u.pm = fm + ((wgid % nig) % gsz); u.pn = (wgid % nig) / gsz; u.x0 = 0; u.x1 = 0; u.x2 = 0; u.x3 = 0;
        u.A = A + (size_t)u.pm * BM * K * 2; u.B = Bt + (size_t)u.pn * BM * K * 2; return true;
    }
    __device__ __forceinline__ void rows(const Unit&, unsigned (&)[2][2], const int (&)[2]) const {}
};

__device__ __forceinline__ unsigned cvt_pk_bf16(float lo, float hi) { unsigned r; asm volatile("v_cvt_pk_bf16_f32 %0, %1, %2" : "=v"(r) : "v"(lo), "v"(hi)); return r; }

template <class Epi, class Sched, bool ALIGN_EPI, bool GATHER, bool SKIP = false>
__device__ __forceinline__ void gemm_phase(PG8_LAS unsigned char* lds, const int K, const Sched& S, const Epi& E) {
    const int tid = threadIdx.x, wid = __builtin_amdgcn_readfirstlane(tid >> 6), lane = tid & 63, wr = wid >> 2, wc = wid & 3, fr = lane & 15, fq = lane >> 4;
    const int nt = K / BK;
    unsigned voffA[2], voffB[2]; int RA[2];
#pragma unroll
    for (int i = 0; i < 2; ++i) { int R, C; stage_rc(tid * 16 + i * 8192, R, C); const int Rb = Epi::PERM ? ((R & ~31) + perm32(R & 31)) : R;
        voffA[i] = GATHER ? (unsigned)(C * 2) : (unsigned)(R * K + C) * 2u; voffB[i] = (unsigned)(Rb * K + C) * 2u; RA[i] = R; }
    const size_t kstep = (size_t)(BK * 2);
    const size_t hstep = (size_t)HALF * K * 2;
    const size_t hstepA = GATHER ? 0 : hstep;
    const unsigned ldsw = (unsigned)wid * 1024u;
    const int aoff = lds_byte(wr * 64 + fr, fq * 8), boff = lds_byte(wc * 32 + fr, fq * 8);
    unsigned gA[2][2], gAn[2][2];
#define PG8_SA(b, h) (((b) * 2 + (h)) * HTB)
#define PG8_SB(b, h) ((4 + (b) * 2 + (h)) * HTB)
#define PG8_STAGE(bufoff, gbase, voff) do { _Pragma("unroll") for (int _i = 0; _i < 2; ++_i) \
        __builtin_amdgcn_global_load_lds((const unsigned*)((const char*)(gbase) + (voff)[_i]), (PG8_LAS unsigned*)(lds + (bufoff) + ldsw + _i * 8192), 16, 0, 0); } while (0)
#define PG8_STAGE_A(bufoff, gbase, h, nx) do { _Pragma("unroll") for (int _i = 0; _i < 2; ++_i) { \
        const unsigned _o = GATHER ? ((nx) ? gAn[h][_i] : gA[h][_i]) + voffA[_i] : voffA[_i]; \
        __builtin_amdgcn_global_load_lds((const unsigned*)((const char*)(gbase) + (h) * hstepA + _o), (PG8_LAS unsigned*)(lds + (bufoff) + ldsw + _i * 8192), 16, 0, 0); } } while (0)
#define PG8_LDA(dst, b, h) do { _Pragma("unroll") for (int m = 0; m < 4; ++m) _Pragma("unroll") for (int k = 0; k < 2; ++k) dst[m][k] = *(const PG8_LAS bf16x8*)(lds + PG8_SA(b, h) + aoff + m * 2048 + k * 1024); } while (0)
#define PG8_LDB(dst, b, h) do { _Pragma("unroll") for (int n = 0; n < 2; ++n) _Pragma("unroll") for (int k = 0; k < 2; ++k) dst[n][k] = *(const PG8_LAS bf16x8*)(lds + PG8_SB(b, h) + boff + n * 2048 + k * 1024); } while (0)
#define PG8_MMA(ai, bj, At, Bt) do { __builtin_amdgcn_s_setprio(1); _Pragma("unroll") for (int m = 0; m < 4; ++m) { if (!SKIP || m < ((ai) == 0 ? mc0 : mc1)) { _Pragma("unroll") for (int n = 0; n < 2; ++n) _Pragma("unroll") for (int k = 0; k < 2; ++k) \
        acc[ai][bj][m][n] = __builtin_amdgcn_mfma_f32_16x16x32_bf16(Bt[n][k], At[m][k], acc[ai][bj][m][n], 0, 0, 0); } } __builtin_amdgcn_s_setprio(0); } while (0)
#define PG8_WAIT_V(n) asm volatile("s_waitcnt vmcnt(" #n ")" ::: "memory")
#define PG8_WAIT_L(n) asm volatile("s_waitcnt lgkmcnt(" #n ")" ::: "memory")
#define PG8_BAR __builtin_amdgcn_s_barrier()
#define PG8_SCHED __builtin_amdgcn_sched_barrier(0)
    Unit cur, nxt; int ui = 0;
    if (!S.next(0, cur)) return;
    int mc0 = 4, mc1 = 4;
#define PG8_MC(u) do { if (SKIP) { const int a_ = ((u).x2 - 64 * wr + 15) >> 4, b_ = ((u).x2 - 128 - 64 * wr + 15) >> 4; mc0 = a_ < 0 ? 0 : (a_ > 4 ? 4 : a_); mc1 = b_ < 0 ? 0 : (b_ > 4 ? 4 : b_); } } while (0)
    PG8_MC(cur);
    f32x4 acc[2][2][4][2];
#pragma unroll
    for (int a = 0; a < 2; ++a)
#pragma unroll
        for (int b = 0; b < 2; ++b)
#pragma unroll
            for (int m = 0; m < 4; ++m)
#pragma unroll
                for (int n = 0; n < 2; ++n) acc[a][b][m][n] = (f32x4){0.f, 0.f, 0.f, 0.f};
    bf16x8 At[4][2], B0[2][2], B1[2][2];
    const char* cA = cur.A; const char* cB = cur.B;
    if constexpr (GATHER) { S.rows(cur, gA, RA);
#pragma unroll
        for (int h = 0; h < 2; ++h)
#pragma unroll
            for (int i = 0; i < 2; ++i) gAn[h][i] = gA[h][i]; }
    PG8_STAGE(PG8_SB(0, 0), cB, voffB); PG8_STAGE(PG8_SB(0, 1), cB + hstep, voffB); PG8_STAGE_A(PG8_SA(0, 0), cA, 0, false); PG8_STAGE_A(PG8_SA(0, 1), cA, 1, false);
    if (wr == 1) PG8_BAR;
    PG8_WAIT_V(2); PG8_BAR;
    PG8_STAGE(PG8_SB(1, 0), cB + kstep, voffB); PG8_STAGE_A(PG8_SA(1, 0), cA + kstep, 0, false); PG8_STAGE(PG8_SB(1, 1), cB + hstep + kstep, voffB);
    PG8_WAIT_V(6); PG8_BAR;
    for (;;) {
        const bool has_next = S.next(ui + 1, nxt);
        const char* nA = has_next ? nxt.A : cA; const char* nB = has_next ? nxt.B : cB;
        if constexpr (GATHER) { if (has_next) { S.rows(nxt, gAn, RA); } }
        for (int t = 0; t < nt; t += 2) {
            const bool last = (t == nt - 2);
            const char* a1 = cA + (size_t)(t + 1) * kstep;
            const char* a2 = last ? nA : cA + (size_t)(t + 2) * kstep; const char* b2 = last ? nB : cB + (size_t)(t + 2) * kstep;
            const char* a3 = a2 + kstep; const char* b3 = b2 + kstep;
            if constexpr (Epi::HAS_MID) { if (t == nt / 2) { int frl = fr, fql = fq; asm volatile("" : "+v"(frl), "+v"(fql)); E.mid(acc, cur, wr, wc, frl, fql); } }
            PG8_LDB(B0, 0, 0); PG8_LDB(B1, 0, 1); PG8_SCHED; PG8_LDA(At, 0, 0); PG8_STAGE_A(PG8_SA(1, 1), a1, 1, false);
            PG8_WAIT_V(8); PG8_WAIT_L(0); PG8_BAR; PG8_MMA(0, 0, At, B0); PG8_MMA(0, 1, At, B1); PG8_BAR; PG8_SCHED;
            PG8_LDA(At, 0, 1); PG8_STAGE(PG8_SB(0, 0), b2, voffB); PG8_STAGE(PG8_SB(0, 1), b2 + hstep, voffB); PG8_STAGE_A(PG8_SA(0, 0), a2, 0, last);
            PG8_WAIT_V(8); PG8_WAIT_L(0); PG8_BAR; PG8_MMA(1, 0, At, B0); PG8_MMA(1, 1, At, B1); PG8_BAR; PG8_SCHED;
            PG8_LDB(B0, 1, 0); PG8_LDB(B1, 1, 1); PG8_SCHED; PG8_LDA(At, 1, 0); PG8_STAGE_A(PG8_SA(0, 1), a2, 1, last);
            PG8_WAIT_V(8); PG8_WAIT_L(0); PG8_BAR; PG8_MMA(0, 0, At, B0); PG8_MMA(0, 1, At, B1); PG8_BAR; PG8_SCHED;
            PG8_LDA(At, 1, 1); PG8_STAGE(PG8_SB(1, 0), b3, voffB); PG8_STAGE(PG8_SB(1, 1), b3 + hstep, voffB); PG8_STAGE_A(PG8_SA(1, 0), a3, 0, last);
            PG8_WAIT_V(8); PG8_WAIT_L(0); PG8_BAR; PG8_MMA(1, 0, At, B0); PG8_MMA(1, 1, At, B1); PG8_BAR; PG8_SCHED;
        }
        if constexpr (ALIGN_EPI) { if (wr == 0) PG8_BAR; }
        { int frl = fr, fql = fq; asm volatile("" : "+v"(frl), "+v"(fql)); E(acc, cur, wr, wc, frl, fql); }
        if (!has_next) break;
#pragma unroll
        for (int a = 0; a < 2; ++a)
#pragma unroll
            for (int b = 0; b < 2; ++b)
#pragma unroll
                for (int m = 0; m < 4; ++m)
#pragma unroll
                    for (int n = 0; n < 2; ++n) acc[a][b][m][n] = (f32x4){0.f, 0.f, 0.f, 0.f};
        cur = nxt; cA = nA; cB = nB; ++ui; PG8_MC(cur);
        if constexpr (GATHER) {
#pragma unroll
            for (int h = 0; h < 2; ++h)
#pragma unroll
                for (int i = 0; i < 2; ++i) gA[h][i] = gAn[h][i]; }
        if constexpr (ALIGN_EPI) { if (wr == 1) PG8_BAR; }
    }
    PG8_WAIT_V(0);
    if constexpr (!ALIGN_EPI) { if (wr == 0) PG8_BAR; }
    PG8_BAR;
#undef PG8_SA
#undef PG8_SB
#undef PG8_STAGE
#undef PG8_STAGE_A
#undef PG8_LDA
#undef PG8_LDB
#undef PG8_MMA
#undef PG8_WAIT_V
#undef PG8_WAIT_L
#undef PG8_BAR
#undef PG8_SCHED
#undef PG8_MC
}
}

constexpr int LDS_MISC_OFF = 131072;
__device__ __forceinline__ float fast_gelu(float x) { const float y = x + 0.044715f * x * x * x; return x * __builtin_amdgcn_rcpf(1.0f + __builtin_amdgcn_exp2f(-2.0f * 0.7978845608028654f * LOG2E * y)); }
__device__ __forceinline__ float fast_sigmoid(float x) { return __builtin_amdgcn_rcpf(1.0f + __builtin_amdgcn_exp2f(-LOG2E * x)); }
__device__ __forceinline__ void unpack8(const u32x4 w, float (&v)[8]) {
#pragma unroll
    for (int e = 0; e < 4; ++e) { v[2 * e] = __uint_as_float(w[e] << 16); v[2 * e + 1] = __uint_as_float(w[e] & 0xffff0000u); } }

constexpr size_t WS_VSTAT = 6 * MiB;
constexpr int LDS_EPI_OFF = 131072 + 4096;
struct EpiIn {
    static constexpr bool PERM = true, HAS_MID = false;
    bf16_t *U, *V, *Q, *K, *VA, *G; const float* b_gate; const float* qg; const float* kg; float* VSTAT; PG8_LAS unsigned char* lds;
    __device__ __forceinline__ void mid(f32x4 (&)[2][2][4][2], const pg8::Unit&, int, int, int, int) const {}
    __device__ __forceinline__ void operator()(f32x4 (&acc)[2][2][4][2], const pg8::Unit& u, int wr, int wc, int fr, int fq) const {
        const int pn = u.pn; bf16_t* base; int ld, colt, mode;
        if (pn < 4) { base = U; ld = 1024; colt = pn * 256; mode = 1; }
        else if (pn < 8) { base = V; ld = 1024; colt = (pn - 4) * 256; mode = 3; }
        else if (pn < 12) { base = Q; ld = 1024; colt = (pn - 8) * 256; mode = 4; }
        else if (pn < 16) { base = K; ld = 1024; colt = (pn - 12) * 256; mode = 5; }
        else if (pn < 20) { base = VA; ld = 1024; colt = (pn - 16) * 256; mode = 0; }
        else { base = G; ld = 4096; colt = (pn - 20) * 256; mode = 2; }
        const int row0 = u.pm * 256 + wr * 64 + fr, col0 = colt + wc * 32 + 8 * fq;
        if (mode >= 4) {
            PG8_LAS float* P = (PG8_LAS float*)(lds + LDS_EPI_OFF);
#pragma unroll
            for (int ai = 0; ai < 2; ++ai)
#pragma unroll
                for (int m = 0; m < 4; ++m)
#pragma unroll
                    for (int bj = 0; bj < 2; ++bj) { const f32x4 a = acc[ai][bj][m][0], b = acc[ai][bj][m][1];
                        float s = (a[0] * a[0] + a[1] * a[1]) + (a[2] * a[2] + a[3] * a[3]) + (b[0] * b[0] + b[1] * b[1]) + (b[2] * b[2] + b[3] * b[3]);
                        s += __shfl_xor(s, 16); s += __shfl_xor(s, 32);
                        if (fq == 0) P[((ai * 128 + wr * 64 + m * 16 + fr) * 2 + bj) * 4 + wc] = s; }
            asm volatile("s_waitcnt lgkmcnt(0)" ::: "memory"); __builtin_amdgcn_s_barrier(); asm volatile("" ::: "memory");
            const float* gg = mode == 4 ? qg : kg; const float qs = mode == 4 ? QSCALE : 1.0f;
            const f32x4 g0 = *(const f32x4*)(gg + wc * 32 + 8 * fq), g1 = *(const f32x4*)(gg + wc * 32 + 8 * fq + 4);
#pragma unroll
            for (int ai = 0; ai < 2; ++ai)
#pragma unroll
                for (int m = 0; m < 4; ++m) { bf16_t* rowp = base + (size_t)(row0 + ai * 128 + m * 16) * ld + col0;
#pragma unroll
                    for (int bj = 0; bj < 2; ++bj) { const f32x4 pp = *(const PG8_LAS f32x4*)(P + ((ai * 128 + wr * 64 + m * 16 + fr) * 2 + bj) * 4);
                        const float sc = rsqrtf(((pp[0] + pp[1]) + (pp[2] + pp[3])) * (1.f / 128.f) + EPS) * qs;
                        const f32x4 v0 = acc[ai][bj][m][0] * g0 * sc, v1 = acc[ai][bj][m][1] * g1 * sc;
                        u32x4 w; w.x = pg8::cvt_pk_bf16(v0[0], v0[1]); w.y = pg8::cvt_pk_bf16(v0[2], v0[3]); w.z = pg8::cvt_pk_bf16(v1[0], v1[1]); w.w = pg8::cvt_pk_bf16(v1[2], v1[3]);
                        *(u32x4*)(rowp + bj * 128) = w; } }
            return;
        }
        f32x4 bv[2][2];
#pragma unroll
        for (int bj = 0; bj < 2; ++bj)
#pragma unroll
            for (int n = 0; n < 2; ++n) bv[bj][n] = (mode == 2) ? *(const f32x4*)(b_gate + col0 + bj * 128 + 4 * n) : (f32x4){0.f, 0.f, 0.f, 0.f};
#pragma unroll
        for (int ai = 0; ai < 2; ++ai)
#pragma unroll
            for (int m = 0; m < 4; ++m) { bf16_t* rowp = base + (size_t)(row0 + ai * 128 + m * 16) * ld + col0; float s1 = 0.f, s2 = 0.f;
#pragma unroll
                for (int bj = 0; bj < 2; ++bj) { f32x4 v0 = acc[ai][bj][m][0], v1 = acc[ai][bj][m][1];
                    if (mode == 1 || mode == 3) {
#pragma unroll
                        for (int j = 0; j < 4; ++j) { v0[j] = fast_gelu(v0[j]); v1[j] = fast_gelu(v1[j]); } }
                    else if (mode == 2) { v0 += bv[bj][0]; v1 += bv[bj][1];
#pragma unroll
                        for (int j = 0; j < 4; ++j) { v0[j] = fast_sigmoid(v0[j]); v1[j] = fast_sigmoid(v1[j]); } }
                    if (mode == 3) {
#pragma unroll
                        for (int j = 0; j < 4; ++j) { s1 += v0[j] + v1[j]; s2 += v0[j] * v0[j] + v1[j] * v1[j]; } }
                    u32x4 w; w.x = pg8::cvt_pk_bf16(v0[0], v0[1]); w.y = pg8::cvt_pk_bf16(v0[2], v0[3]); w.z = pg8::cvt_pk_bf16(v1[0], v1[1]); w.w = pg8::cvt_pk_bf16(v1[2], v1[3]);
                    *(u32x4*)(rowp + bj * 128) = w; }
                if (mode == 3) { s1 += __shfl_xor(s1, 16); s1 += __shfl_xor(s1, 32); s2 += __shfl_xor(s2, 16); s2 += __shfl_xor(s2, 32);
                    if (fq == 0) { typedef float f32x2_ __attribute__((ext_vector_type(2))); *(f32x2_*)(VSTAT + ((size_t)(row0 + ai * 128 + m * 16) * 16 + (pn - 4) * 4 + wc) * 2) = (f32x2_){s1, s2}; } } }
    }
};
struct EpiProj {
    static constexpr bool PERM = true, HAS_MID = true;
    const bf16_t* G; bf16_t* O;
    __device__ __forceinline__ void mid(f32x4 (&acc)[2][2][4][2], const pg8::Unit& u, int wr, int wc, int fr, int fq) const {
        const int row0 = u.pm * 256 + wr * 64 + fr, col0 = u.pn * 256 + wc * 32 + 8 * fq;
#pragma unroll
        for (int ai = 0; ai < 2; ++ai)
#pragma unroll
            for (int m = 0; m < 4; ++m) { const bf16_t* gp = G + (size_t)(row0 + ai * 128 + m * 16) * 4096 + col0;
#pragma unroll
                for (int bj = 0; bj < 2; ++bj) { float gs[8], gf[8]; unpack8(*(const u32x4*)(gp + bj * 128), gs); unpack8(*(const u32x4*)(gp + 2048 + bj * 128), gf);
#pragma unroll
                    for (int j = 0; j < 4; ++j) { acc[ai][bj][m][0][j] *= gs[j] * __builtin_amdgcn_rcpf(gf[j]); acc[ai][bj][m][1][j] *= gs[4 + j] * __builtin_amdgcn_rcpf(gf[4 + j]); }
                    asm volatile("" : "+v"(acc[ai][bj][m][0]), "+v"(acc[ai][bj][m][1]) :: "memory"); } }
    }
    __device__ __forceinline__ void operator()(f32x4 (&acc)[2][2][4][2], const pg8::Unit& u, int wr, int wc, int fr, int fq) const {
        const int row0 = u.pm * 256 + wr * 64 + fr, col0 = u.pn * 256 + wc * 32 + 8 * fq;
#pragma unroll
        for (int ai = 0; ai < 2; ++ai)
#pragma unroll
            for (int m = 0; m < 4; ++m) { const size_t r = (size_t)(row0 + ai * 128 + m * 16);
#pragma unroll
                for (int bj = 0; bj < 2; ++bj) { float gf[8]; unpack8(*(const u32x4*)(G + r * 4096 + 2048 + col0 + bj * 128), gf);
                    const f32x4 v0 = acc[ai][bj][m][0], v1 = acc[ai][bj][m][1];
                    u32x4 w; w.x = pg8::cvt_pk_bf16(v0[0] * gf[0], v0[1] * gf[1]); w.y = pg8::cvt_pk_bf16(v0[2] * gf[2], v0[3] * gf[3]); w.z = pg8::cvt_pk_bf16(v1[0] * gf[4], v1[1] * gf[5]); w.w = pg8::cvt_pk_bf16(v1[2] * gf[6], v1[3] * gf[7]);
                    *(u32x4*)(O + r * 2048 + col0 + bj * 128) = w; }
                asm volatile("" ::: "memory"); }
    }
};
struct EpiOut {
    static constexpr bool PERM = false, HAS_MID = false;
    const float* X; float* O;
    __device__ __forceinline__ void mid(f32x4 (&)[2][2][4][2], const pg8::Unit&, int, int, int, int) const {}
    __device__ __forceinline__ void operator()(f32x4 (&acc)[2][2][4][2], const pg8::Unit& u, int wr, int wc, int fr, int fq) const {
        const int row0 = u.pm * 256 + wr * 64 + fr, col0 = u.pn * 256 + wc * 32 + 4 * fq;
#pragma unroll
        for (int ai = 0; ai < 2; ++ai)
#pragma unroll
            for (int m = 0; m < 4; ++m) { const size_t off = (size_t)(row0 + ai * 128 + m * 16) * DM + col0;
#pragma unroll
                for (int bj = 0; bj < 2; ++bj)
#pragma unroll
                    for (int n = 0; n < 2; ++n) *(f32x4*)(O + off + bj * 128 + n * 16) = *(const f32x4*)(X + off + bj * 128 + n * 16) + acc[ai][bj][m][n]; }
    }
};
struct EpiGateUp {
    static constexpr bool PERM = true, HAS_MID = false;
    bf16_t* ACT;
    __device__ __forceinline__ void mid(f32x4 (&)[2][2][4][2], const pg8::Unit&, int, int, int, int) const {}
    __device__ __forceinline__ void operator()(f32x4 (&acc)[2][2][4][2], const pg8::Unit& u, int wr, int wc, int fr, int fq) const {
        const int row0 = u.x0 + wr * 64 + fr, col0 = u.pn * 128 + wc * 32 + 8 * fq;
#pragma unroll
        for (int ai = 0; ai < 2; ++ai)
#pragma unroll
            for (int m = 0; m < 4; ++m) { float o[8];
#pragma unroll
                for (int n = 0; n < 2; ++n)
#pragma unroll
                    for (int j = 0; j < 4; ++j) { const float g = acc[ai][0][m][n][j], up = acc[ai][1][m][n][j]; o[4 * n + j] = g * fast_sigmoid(g) * up; }
                u32x4 w; w.x = pg8::cvt_pk_bf16(o[0], o[1]); w.y = pg8::cvt_pk_bf16(o[2], o[3]); w.z = pg8::cvt_pk_bf16(o[4], o[5]); w.w = pg8::cvt_pk_bf16(o[6], o[7]);
                *(u32x4*)(ACT + (size_t)(row0 + ai * 128 + m * 16) * DEXP + col0) = w; }
    }
};
struct EpiDown {
    static constexpr bool PERM = true, HAS_MID = false;
    bf16_t* Y; const float* GATE;
    __device__ __forceinline__ void mid(f32x4 (&)[2][2][4][2], const pg8::Unit&, int, int, int, int) const {}
    __device__ __forceinline__ void operator()(f32x4 (&acc)[2][2][4][2], const pg8::Unit& u, int wr, int wc, int fr, int fq) const {
        const int rl0 = wr * 64 + fr, col0 = u.pn * 256 + wc * 32 + 8 * fq;
#pragma unroll
        for (int ai = 0; ai < 2; ++ai)
#pragma unroll
            for (int m = 0; m < 4; ++m) { const int rl = rl0 + ai * 128 + m * 16; const float gt = GATE[u.x1 + rl];
#pragma unroll
                for (int bj = 0; bj < 2; ++bj) { const f32x4 v0 = acc[ai][bj][m][0] * gt, v1 = acc[ai][bj][m][1] * gt;
                    u32x4 w; w.x = pg8::cvt_pk_bf16(v0[0], v0[1]); w.y = pg8::cvt_pk_bf16(v0[2], v0[3]); w.z = pg8::cvt_pk_bf16(v1[0], v1[1]); w.w = pg8::cvt_pk_bf16(v1[2], v1[3]);
                    *(u32x4*)(Y + (size_t)(u.x0 + rl) * DM + col0 + bj * 128) = w; } }
    }
};
struct MoeOrder {
    const char* Abase; const char* Bbase; size_t Bstride; int K, nN, G, c; bool gather;
    const PG8_LAS int* ps;
    const unsigned* cnt; const int* TOK;
    __device__ bool next(int i, pg8::Unit& u) const {
        const int L = i * G + c; const int ntile = ps[NEXP + 2] * nN; if (L >= ntile) return false;
        const int sidx = L / nN, pn = L % nN; const int prow = ps[40 + sidx], info = ps[40 + MT_MAX + sidx], valid = ps[40 + 2 * MT_MAX + sidx];
        const int e = info >> 16, mt = info & 0xffff;
        u.pm = mt; u.pn = pn; u.x0 = prow; u.x1 = e * T + mt * MTILE; u.x2 = valid; u.x3 = e;
        u.A = gather ? Abase : Abase + (size_t)prow * K * 2; u.B = Bbase + (size_t)e * Bstride + (size_t)pn * 256 * K * 2; return true;
    }
    __device__ __forceinline__ void rows(const pg8::Unit& u, unsigned (&g)[2][2], const int (&RA)[2]) const {
#pragma unroll
        for (int h = 0; h < 2; ++h)
#pragma unroll
            for (int i = 0; i < 2; ++i) { int r = RA[i] + 128 * h; r = r < u.x2 ? r : u.x2 - 1; g[h][i] = (unsigned)TOK[u.x1 + r] * (unsigned)(K * 2); }
    }
};

struct TItem { const float* src; bf16_t* dst; int ld_src, ld_dst; };
__device__ __forceinline__ void titem_load(const TItem& t, f32x4 (&v)[8], int lane) {
#pragma unroll
    for (int i = 0; i < 8; ++i) v[i] = *(const f32x4*)(t.src + (size_t)((lane >> 3) + 8 * i) * t.ld_src + 4 * (lane & 7));
}
__device__ __forceinline__ void titem_store(const TItem& t, const f32x4 (&v)[8], PG8_LAS float* scr, int lane) {
#pragma unroll
    for (int i = 0; i < 8; ++i) { PG8_LAS float* d = scr + ((lane >> 3) + 8 * i) * 33 + 4 * (lane & 7); d[0] = v[i].x; d[1] = v[i].y; d[2] = v[i].z; d[3] = v[i].w; }
    asm volatile("s_waitcnt lgkmcnt(0)" ::: "memory");
    const int c = lane & 7;
#pragma unroll
    for (int j = 0; j < 4; ++j) { const int n = (lane >> 3) + 8 * j; const PG8_LAS float* s = scr + (8 * c) * 33 + n;
        u32x4 o; o.x = pk2(s[0 * 33], s[1 * 33]); o.y = pk2(s[2 * 33], s[3 * 33]); o.z = pk2(s[4 * 33], s[5 * 33]); o.w = pk2(s[6 * 33], s[7 * 33]);
        *(u32x4*)(t.dst + (size_t)n * t.ld_dst + 8 * c) = o; }
    asm volatile("s_waitcnt lgkmcnt(0)" ::: "memory");
}
constexpr int TI0 = 32 * 288, TI1 = 16 * 64, TI2 = 16 * 64, TI3 = 32 * 64, TI4 = 32 * 512, TI5 = 32 * 512, TI6 = 32 * 512;
constexpr int TI_ALL = TI0 + TI1 + TI2 + TI3 + TI4 + TI5 + TI6;
#ifndef TAIL1_ITEMS
#define TAIL1_ITEMS (TI5)
#endif
__device__ __forceinline__ TItem titem_decode(const Args& A, int r) {
    bf16_t* WIN = (bf16_t*)(A.ws + WS_WIN); bf16_t* WPROJ = (bf16_t*)(A.ws + WS_WPROJ); bf16_t* WOUT = (bf16_t*)(A.ws + WS_WOUT); bf16_t* WGU = (bf16_t*)(A.ws + WS_WGU); bf16_t* WD = (bf16_t*)(A.ws + WS_WD);
    TItem t;
    if (r < TI0) { const int kb = r / 288, nb = r % 288; t.src = A.in[2] + (size_t)(64 * kb) * INCOLS + 32 * nb + (nb >= 160 ? 8 : 0); t.ld_src = INCOLS; t.dst = WIN + (size_t)(32 * nb) * 2048 + 64 * kb; t.ld_dst = 2048; return t; } r -= TI0;
    if (r < TI1) { const int kb = r / 64, nb = r % 64; t.src = A.in[11] + (size_t)(64 * kb) * DM + 32 * nb; t.ld_src = DM; t.dst = WPROJ + (size_t)(32 * nb) * 2048 + 64 * kb; t.ld_dst = 2048; return t; } r -= TI1;
    if (r < TI2) { const int kb = r / 64, nb = r % 64; t.src = A.in[12] + (size_t)(64 * kb) * DM + 32 * nb; t.ld_src = DM; t.dst = WPROJ + (size_t)(32 * nb) * 2048 + 1024 + 64 * kb; t.ld_dst = 2048; return t; } r -= TI2;
    if (r < TI3) { const int kb = r / 64, nb = r % 64; t.src = A.in[13] + (size_t)(64 * kb) * DM + 32 * nb; t.ld_src = DM; t.dst = WOUT + (size_t)(32 * nb) * 2048 + 64 * kb; t.ld_dst = 2048; return t; } r -= TI3;
    if (r < TI4 + TI5) { const int up = r >= TI4; if (up) r -= TI4; const int e = r / 512, q = r % 512, kb = q / 16, nb = q % 16, n = 32 * nb, drow = 256 * (n >> 7) + (n & 127) + (up ? 128 : 0);
        t.src = A.in[up ? 20 : 19] + (size_t)e * DM * DEXP + (size_t)(64 * kb) * DEXP + n; t.ld_src = DEXP; t.dst = WGU + ((size_t)e * 1024 + drow) * 2048 + 64 * kb; t.ld_dst = 2048; return t; } r -= TI4 + TI5;
    { const int e = r / 512, q = r % 512, kb = q / 64, nb = q % 64; t.src = A.in[21] + (size_t)e * DEXP * DM + (size_t)(64 * kb) * DM + 32 * nb; t.ld_src = DM; t.dst = WD + ((size_t)e * 2048 + 32 * nb) * 512 + 64 * kb; t.ld_dst = 512; return t; }
}
__device__ __forceinline__ void p0_weights(const Args& A, PG8_LAS unsigned char* lds, const int part, const int wg0) {
    const int tid = threadIdx.x, lane = tid & 63, wave = tid >> 6;
    PG8_LAS float* scr = (PG8_LAS float*)(lds + wave * 16384);
    if ((int)blockIdx.x < wg0) return;
    const int gw = ((int)blockIdx.x - wg0) * NWAVES + wave, NGW = ((int)gridDim.x - wg0) * NWAVES;
    const int cut1 = TI_ALL - TI6 - TAIL1_ITEMS, cut2 = TI_ALL - TI6;
    const int it_lo = part == 0 ? 0 : (part == 1 ? cut1 : cut2), it_hi = part == 0 ? cut1 : (part == 1 ? cut2 : TI_ALL);
    int it = it_lo + gw; if (it >= it_hi) return;
    TItem cur = titem_decode(A, it); f32x4 va[8], vb[8];
    titem_load(cur, va, lane);
    for (;;) {
        const int itn = it + NGW; const bool more = itn < it_hi; TItem nx = cur;
        if (more) { nx = titem_decode(A, itn); titem_load(nx, vb, lane); }
        titem_store(cur, va, scr, lane);
        if (!more) break;
#pragma unroll
        for (int i = 0; i < 8; ++i) va[i] = vb[i];
        cur = nx; it = itn;
    }
}

__device__ __forceinline__ void p1_fast(const Args& A, PG8_LAS unsigned char* lds) {
    pg8::DenseOrder S; S.init(A.ws + WS_H, A.ws + WS_WIN, T, 9216, DM, gridDim.x, blockIdx.x);
    EpiIn E{(bf16_t*)(A.ws + WS_U), (bf16_t*)(A.ws + WS_V), (bf16_t*)(A.ws + WS_Q), (bf16_t*)(A.ws + WS_K), (bf16_t*)(A.ws + WS_VA), (bf16_t*)(A.ws + WS_G), A.in[3], A.in[9], A.in[10], (float*)(A.ws + WS_VSTAT), lds};
    pg8::gemm_phase<EpiIn, pg8::DenseOrder, true, false>(lds, DM, S, E);
}
__device__ __forceinline__ void p3_fast(const Args& A, PG8_LAS unsigned char* lds) {
    pg8::DenseOrder S; S.init(A.ws + WS_MIXIN, A.ws + WS_WPROJ, T, DM, 2048, gridDim.x, blockIdx.x);
    EpiProj E{(const bf16_t*)(A.ws + WS_G), (bf16_t*)(A.ws + WS_MIXED)};
    pg8::gemm_phase<EpiProj, pg8::DenseOrder, true, false>(lds, 2048, S, E);
}
__device__ __forceinline__ void p4_fast(const Args& A, PG8_LAS unsigned char* lds) {
    pg8::DenseOrder S; S.init(A.ws + WS_MIXED, A.ws + WS_WOUT, T, DM, DM, gridDim.x, blockIdx.x);
    EpiOut E{A.in[0], A.out};
    pg8::gemm_phase<EpiOut, pg8::DenseOrder, true, false>(lds, DM, S, E);
}
__device__ __forceinline__ void moe_layout_lds(const Args& A, PG8_LAS unsigned char* lds) {
    PG8_LAS int* ps = (PG8_LAS int*)(lds + LDS_MISC_OFF); PG8_LAS int* tprow = ps + 40; PG8_LAS int* tinfo = tprow + MT_MAX; PG8_LAS int* tvalid = tinfo + MT_MAX;
    const unsigned* cnt = (const unsigned*)(A.ws + WS_CTL) + CW_CNT;
    if (threadIdx.x == 0) { int acc = 0;
        for (int e = 0; e < NEXP; ++e) { ps[e] = acc; acc += ((int)cnt[e] + MTILE - 1) / MTILE * MTILE; }
        ps[NEXP] = acc; ps[NEXP + 1] = acc / MTILE; }
    __syncthreads();
    const int nt = ps[NEXP + 1]; PG8_LAS int* uval = tvalid + MT_MAX;
    int prow = 0, e = 0, mt = 0, valid = 0;
    if ((int)threadIdx.x < nt) { prow = (int)threadIdx.x * MTILE;
        for (int j = 1; j < NEXP; ++j) if (ps[j] <= prow) e = j;
        mt = (prow - ps[e]) / MTILE; valid = (int)cnt[e] - mt * MTILE; valid = valid > MTILE ? MTILE : valid; uval[threadIdx.x] = valid; }
    __syncthreads();
    if ((int)threadIdx.x < nt) { int rank = 0;
        for (int j = 0; j < nt; ++j) { const int vj = uval[j]; rank += (vj > valid || (vj == valid && j < (int)threadIdx.x)) ? 1 : 0; }
        tprow[rank] = prow; tinfo[rank] = (e << 16) | mt; tvalid[rank] = valid; }
    if (threadIdx.x == 0) { int nb = 0; for (int j = 0; j < nt; ++j) nb += uval[j] > TINY_ROWS ? 1 : 0; ps[NEXP + 2] = nb; }
    __syncthreads();
}
namespace sm {
typedef short bf16x8 __attribute__((ext_vector_type(8))); typedef float f32x16 __attribute__((ext_vector_type(16)));
constexpr int TINY = 64;
__device__ __forceinline__ void gateup_small(const Args& A, PG8_LAS unsigned char* lds) {
    const PG8_LAS int* ps = (const PG8_LAS int*)(lds + LDS_MISC_OFF); const int nt = ps[NEXP + 1], nbig = ps[NEXP + 2];
    const bf16_t* H2 = (const bf16_t*)(A.ws + WS_H2); const bf16_t* WGU = (const bf16_t*)(A.ws + WS_WGU); bf16_t* ACT = (bf16_t*)(A.ws + WS_ACT); const int* TOK = (const int*)(A.ws + WS_TOK);
    const int tid = threadIdx.x, lane = tid & 63, w = __builtin_amdgcn_readfirstlane(tid >> 6), r32 = lane & 31, hi = lane >> 5;
    PG8_LAS float* red = (PG8_LAS float*)lds;
    for (int su = blockIdx.x; su < (nt - nbig) * 16; su += gridDim.x) {
        const int sidx = nbig + (su >> 4), sl = su & 15; const int prow = ps[40 + sidx], info = ps[40 + MT_MAX + sidx], valid = ps[40 + 2 * MT_MAX + sidx];
        const int e = info >> 16, mt = info & 0xffff, lbase = e * T + mt * MTILE;
        const int ra = r32 < valid ? r32 : valid - 1, rb = 32 + r32 < valid ? 32 + r32 : valid - 1;
        const bf16_t* a0p = H2 + (size_t)TOK[lbase + ra] * DM + 256 * w + 8 * hi; const bf16_t* a1p = H2 + (size_t)TOK[lbase + rb] * DM + 256 * w + 8 * hi;
        const bf16_t* b0p = WGU + ((size_t)e * 1024 + 256 * (sl >> 2) + 32 * (sl & 3) + r32) * DM + 256 * w + 8 * hi; const bf16_t* b1p = b0p + (size_t)128 * DM;
        f32x16 acc[2][2];
#pragma unroll
        for (int i = 0; i < 2; ++i)
#pragma unroll
            for (int j = 0; j < 2; ++j)
#pragma unroll
                for (int r = 0; r < 16; ++r) acc[i][j][r] = 0.f;
#pragma unroll 4
        for (int ks = 0; ks < 16; ++ks) { const bf16x8 a0 = *(const bf16x8*)(a0p + 16 * ks), a1 = *(const bf16x8*)(a1p + 16 * ks), b0 = *(const bf16x8*)(b0p + 16 * ks), b1 = *(const bf16x8*)(b1p + 16 * ks);
            acc[0][0] = __builtin_amdgcn_mfma_f32_32x32x16_bf16(a0, b0, acc[0][0], 0, 0, 0); acc[0][1] = __builtin_amdgcn_mfma_f32_32x32x16_bf16(a0, b1, acc[0][1], 0, 0, 0);
            acc[1][0] = __builtin_amdgcn_mfma_f32_32x32x16_bf16(a1, b0, acc[1][0], 0, 0, 0); acc[1][1] = __builtin_amdgcn_mfma_f32_32x32x16_bf16(a1, b1, acc[1][1], 0, 0, 0); }
#pragma unroll
        for (int i = 0; i < 2; ++i)
#pragma unroll
            for (int j = 0; j < 2; ++j)
#pragma unroll
                for (int r = 0; r < 16; ++r) red[(((w * 2 + i) * 2 + j) * 16 + r) * 64 + lane] = acc[i][j][r];
        __syncthreads();
#pragma unroll
        for (int i = 0; i < 2; ++i)
#pragma unroll
            for (int rr = 0; rr < 2; ++rr) { const int r = 2 * w + rr; float g = 0.f, u = 0.f;
#pragma unroll
                for (int w2 = 0; w2 < 8; ++w2) { g += red[(((w2 * 2 + i) * 2 + 0) * 16 + r) * 64 + lane]; u += red[(((w2 * 2 + i) * 2 + 1) * 16 + r) * 64 + lane]; }
                const int row = 32 * i + (r & 3) + 8 * (r >> 2) + 4 * hi;
                ACT[(size_t)(prow + row) * DEXP + 32 * sl + r32] = f2bf(g * fast_sigmoid(g) * u); }
        __syncthreads();
    }
}
__device__ __forceinline__ void down_small(const Args& A, PG8_LAS unsigned char* lds) {
    const PG8_LAS int* ps = (const PG8_LAS int*)(lds + LDS_MISC_OFF); const int nt = ps[NEXP + 1], nbig = ps[NEXP + 2];
    const bf16_t* ACT = (const bf16_t*)(A.ws + WS_ACT); const bf16_t* WD = (const bf16_t*)(A.ws + WS_WD); bf16_t* Y = (bf16_t*)(A.ws + WS_YBUF); const float* GATE = (const float*)(A.ws + WS_GATE);
    const int tid = threadIdx.x, lane = tid & 63, w = __builtin_amdgcn_readfirstlane(tid >> 6), wn = w & 3, wk = w >> 2, r32 = lane & 31, hi = lane >> 5;
    PG8_LAS float* red = (PG8_LAS float*)lds;
    for (int su = blockIdx.x; su < (nt - nbig) * 16; su += gridDim.x) {
        const int sidx = nbig + (su >> 4), sl = su & 15; const int prow = ps[40 + sidx], info = ps[40 + MT_MAX + sidx], valid = ps[40 + 2 * MT_MAX + sidx];
        const int e = info >> 16, mt = info & 0xffff, lbase = e * T + mt * MTILE;
        const int ra = r32 < valid ? r32 : valid - 1, rb = 32 + r32 < valid ? 32 + r32 : valid - 1;
        const bf16_t* a0p = ACT + (size_t)(prow + ra) * DEXP + 256 * wk + 8 * hi; const bf16_t* a1p = ACT + (size_t)(prow + rb) * DEXP + 256 * wk + 8 * hi;
        const bf16_t* bp = WD + ((size_t)e * 2048 + 128 * sl + 32 * wn + r32) * DEXP + 256 * wk + 8 * hi;
        f32x16 acc[2];
#pragma unroll
        for (int i = 0; i < 2; ++i)
#pragma unroll
            for (int r = 0; r < 16; ++r) acc[i][r] = 0.f;
#pragma unroll 4
        for (int ks = 0; ks < 16; ++ks) { const bf16x8 a0 = *(const bf16x8*)(a0p + 16 * ks), a1 = *(const bf16x8*)(a1p + 16 * ks), b = *(const bf16x8*)(bp + 16 * ks);
            acc[0] = __builtin_amdgcn_mfma_f32_32x32x16_bf16(a0, b, acc[0], 0, 0, 0); acc[1] = __builtin_amdgcn_mfma_f32_32x32x16_bf16(a1, b, acc[1], 0, 0, 0); }
        if (wk == 1) {
#pragma unroll
            for (int i = 0; i < 2; ++i)
#pragma unroll
                for (int r = 0; r < 16; ++r) red[((wn * 2 + i) * 16 + r) * 64 + lane] = acc[i][r]; }
        __syncthreads();
        if (wk == 0) {
#pragma unroll
            for (int i = 0; i < 2; ++i)
#pragma unroll
                for (int r = 0; r < 16; ++r) { const int row = 32 * i + (r & 3) + 8 * (r >> 2) + 4 * hi; const float gt = GATE[lbase + (row < valid ? row : valid - 1)];
                    Y[(size_t)(prow + row) * DM + 128 * sl + 32 * wn + r32] = f2bf((acc[i][r] + red[((wn * 2 + i) * 16 + r) * 64 + lane]) * gt); } }
        __syncthreads();
    }
}
}

__device__ __forceinline__ void p6_fast(const Args& A, PG8_LAS unsigned char* lds) {
    moe_layout_lds(A, lds);
    MoeOrder S{(const char*)(A.ws + WS_H2), (const char*)(A.ws + WS_WGU), (size_t)1024 * 2048 * 2, DM, 4, (int)gridDim.x, (int)blockIdx.x, true,
               (const PG8_LAS int*)(lds + LDS_MISC_OFF), (const unsigned*)(A.ws + WS_CTL) + CW_CNT, (const int*)(A.ws + WS_TOK)};
    EpiGateUp E{(bf16_t*)(A.ws + WS_ACT)};
    pg8::gemm_phase<EpiGateUp, MoeOrder, true, true>(lds, DM, S, E);
    sm::gateup_small(A, lds);
    { const int ntile = ((const PG8_LAS int*)(lds + LDS_MISC_OFF))[NEXP + 2] * 4; __syncthreads(); p0_weights(A, lds, 2, ntile % (int)gridDim.x); }
}
__device__ __forceinline__ void p7_fast(const Args& A, PG8_LAS unsigned char* lds) {
    moe_layout_lds(A, lds);
    MoeOrder S{(const char*)(A.ws + WS_ACT), (const char*)(A.ws + WS_WD), (size_t)2048 * 512 * 2, DEXP, 8, (int)gridDim.x, (int)blockIdx.x, false,
               (const PG8_LAS int*)(lds + LDS_MISC_OFF), (const unsigned*)(A.ws + WS_CTL) + CW_CNT, (const int*)(A.ws + WS_TOK)};
    EpiDown E{(bf16_t*)(A.ws + WS_YBUF), (const float*)(A.ws + WS_GATE)};
    pg8::gemm_phase<EpiDown, MoeOrder, true, false>(lds, DEXP, S, E);
    sm::down_small(A, lds);
}

namespace fa {
typedef short bf16x8 __attribute__((ext_vector_type(8)));
typedef short v4i16 __attribute__((ext_vector_type(4)));
typedef float f32x16 __attribute__((ext_vector_type(16)));
#define FA_LAS __attribute__((address_space(3)))
constexpr int KVBUF = 65536, LDS_CK = 131072, LDS_ML = 131072 + 8192;
__device__ __forceinline__ unsigned cvtpk(float lo, float hi) { unsigned r; asm("v_cvt_pk_bf16_f32 %0, %1, %2" : "=v"(r) : "v"(lo), "v"(hi)); return r; }
__device__ __forceinline__ bf16x8 pack8(const f32x16& p, int b) { u32x4 w; w.x = cvtpk(p[b], p[b + 1]); w.y = cvtpk(p[b + 2], p[b + 3]); w.z = cvtpk(p[b + 4], p[b + 5]); w.w = cvtpk(p[b + 6], p[b + 7]); return __builtin_bit_cast(bf16x8, w); }
__device__ __forceinline__ float swapmax(float v) { auto rr = __builtin_amdgcn_permlane32_swap(__float_as_uint(v), __float_as_uint(v), false, false); return fmaxf(__uint_as_float(rr[0]), __uint_as_float(rr[1])); }
__device__ __forceinline__ float swapsum(float v) { auto rr = __builtin_amdgcn_permlane32_swap(__float_as_uint(v), __float_as_uint(v), false, false); return __uint_as_float(rr[0]) + __uint_as_float(rr[1]); }
#define FA_WAITBAR() do { asm volatile("s_waitcnt vmcnt(0) lgkmcnt(0)" ::: "memory"); __builtin_amdgcn_s_barrier(); asm volatile("" ::: "memory"); } while (0)

__device__ __forceinline__ void attn_phase(const Args& A, FA_LAS unsigned char* lds) {
    const bf16_t* Q = (const bf16_t*)(A.ws + WS_Q); const bf16_t* Kt = (const bf16_t*)(A.ws + WS_K); const bf16_t* Vt = (const bf16_t*)(A.ws + WS_VA);
    const float* CKL = (const float*)(A.ws + WS_CKL); bf16_t* MIXIN = (bf16_t*)(A.ws + WS_MIXIN);
    const int tid = threadIdx.x, lane = tid & 63, wid = __builtin_amdgcn_readfirstlane(tid >> 6), rg = wid & 3, kh = wid >> 2, r32 = lane & 31, hi = lane >> 5;
    int koff[4];
#pragma unroll
    for (int i = 0; i < 4; ++i) { const int rl = 4 * i + (lane >> 4); koff[i] = rl * 1024 + (((lane & 15) ^ rl) * 8); }
    const int voff = (lane >> 4) * 1024 + (((lane & 15) ^ ((lane >> 4) << 2)) * 8);
    int kfo[8];
#pragma unroll
    for (int d0 = 0; d0 < 8; ++d0) kfo[d0] = (kh * 64 + r32) * 256 + (((2 * d0 + hi) ^ (r32 & 15)) * 16);
    int vfo[4];
    { const int dh = (lane >> 4) & 1, q = (lane & 15) >> 2, p = lane & 3;
#pragma unroll
      for (int db = 0; db < 4; ++db) vfo[db] = 32768 + (kh * 64 + 4 * hi + q) * 256 + ((db ^ q) * 64) + dh * 32 + p * 8; }
    const int G = gridDim.x;
    for (int vb = blockIdx.x; vb < 256; vb += G) {
        const int item = (G % 8 == 0) ? ((vb % 8) * 32 + (vb / 8)) % 256 : vb;
        const int bh = item >> 3, ii = item & 7, b = bh >> 3, h = bh & 7;
        const bf16_t* Kg = Kt + (size_t)b * SEQ * 1024 + h * 128; const bf16_t* Vg = Vt + (size_t)b * SEQ * 1024 + h * 128;
        {
            const float* LOGF = (const float*)(A.ws + WS_LOGF) + (size_t)b * SEQ * 8 + h; float v[4]; float sm = 0.f;
#pragma unroll
            for (int i = 0; i < 4; ++i) { v[i] = LOGF[(size_t)(tid * 4 + i) * 8]; sm += v[i]; }
            float incl = sm;
#pragma unroll
            for (int o2 = 1; o2 < 64; o2 <<= 1) { const float t2 = __shfl_up(incl, o2); if (lane >= o2) incl += t2; }
            FA_LAS float* wt = (FA_LAS float*)(lds + LDS_ML);
            if (lane == 63) wt[wid] = incl;
            asm volatile("s_waitcnt lgkmcnt(0)" ::: "memory"); __builtin_amdgcn_s_barrier(); asm volatile("" ::: "memory");
            float run = incl - sm;
            for (int w2 = 0; w2 < wid; ++w2) run += wt[w2];
            f32x4 o4;
#pragma unroll
            for (int i = 0; i < 4; ++i) { run += v[i]; o4[i] = -run * LOG2E; }
            *(FA_LAS f32x4*)(lds + LDS_CK + tid * 16) = o4; }
#define FA_ISSUE(key0, bufoff) do { const bf16_t* kg_ = Kg + (size_t)((key0) + 16 * wid) * 1024; const bf16_t* vg_ = Vg + (size_t)((key0) + 16 * wid) * 1024; \
        _Pragma("unroll") for (int i_ = 0; i_ < 4; ++i_) { \
            __builtin_amdgcn_global_load_lds((const unsigned*)(kg_ + koff[i_]), (FA_LAS unsigned*)(lds + (bufoff) + (wid * 4 + i_) * 1024), 16, 0, 0); \
            __builtin_amdgcn_global_load_lds((const unsigned*)(vg_ + i_ * 4096 + voff), (FA_LAS unsigned*)(lds + (bufoff) + 32768 + (wid * 4 + i_) * 1024), 16, 0, 0); } } while (0)
        int u = 0, qb = ii, kb = 0, cur = 0;
        FA_ISSUE(0, 0);
        bf16x8 qf[8]; f32x16 o[4]; float m = -1e30f, l = 0.f;
        { const bf16_t* qp = Q + (size_t)(b * SEQ + qb * 128 + rg * 32 + r32) * 1024 + h * 128 + 8 * hi;
#pragma unroll
          for (int d0 = 0; d0 < 8; ++d0) qf[d0] = *(const bf16x8*)(qp + 16 * d0); }
#pragma unroll
        for (int db = 0; db < 4; ++db)
#pragma unroll
            for (int r = 0; r < 16; ++r) o[db][r] = 0.f;
        FA_WAITBAR();
        for (;;) {
            const bool lastb = (kb == qb); const bool more = !(lastb && u == 1);
            const int nkb = lastb ? 0 : kb + 1;
            if (more) FA_ISSUE(nkb * 128, (cur ^ 1) * KVBUF);
            {
                FA_LAS const unsigned char* buf = lds + cur * KVBUF;
                FA_LAS const float* nck = (FA_LAS const float*)(lds + LDS_CK) + kb * 128 + kh * 64 + 4 * hi;
                f32x16 p0, p1;
#pragma unroll
                for (int g = 0; g < 4; ++g) { const f32x4 t0 = *(FA_LAS const f32x4*)(nck + 8 * g), t1 = *(FA_LAS const f32x4*)(nck + 32 + 8 * g);
#pragma unroll
                    for (int j = 0; j < 4; ++j) { p0[4 * g + j] = t0[j]; p1[4 * g + j] = t1[j]; } }
#pragma unroll
                for (int d0 = 0; d0 < 8; ++d0) { const bf16x8 ka = *(FA_LAS const bf16x8*)(buf + kfo[d0]), kc = *(FA_LAS const bf16x8*)(buf + kfo[d0] + 8192);
                    p0 = __builtin_amdgcn_mfma_f32_32x32x16_bf16(ka, qf[d0], p0, 0, 0, 0); p1 = __builtin_amdgcn_mfma_f32_32x32x16_bf16(kc, qf[d0], p1, 0, 0, 0); }
                if (lastb) { const int qrel = rg * 32 + r32, k0 = kh * 64 + 4 * hi;
#pragma unroll
                    for (int r = 0; r < 16; ++r) { const int kr = k0 + (r & 3) + 8 * (r >> 2); if (kr > qrel) p0[r] = -INFINITY; if (kr + 32 > qrel) p1[r] = -INFINITY; } }
                float mx = fmaxf(p0[0], p1[0]);
#pragma unroll
                for (int r = 1; r < 16; ++r) mx = fmaxf(mx, fmaxf(p0[r], p1[r]));
                mx = swapmax(mx);
                const float mn = fmaxf(m, mx), alpha = __builtin_amdgcn_exp2f(m - mn); m = mn;
                float ps = 0.f;
#pragma unroll
                for (int r = 0; r < 16; ++r) { p0[r] = __builtin_amdgcn_exp2f(p0[r] - mn); p1[r] = __builtin_amdgcn_exp2f(p1[r] - mn); ps += p0[r] + p1[r]; }
                l = l * alpha + ps;
                if (!__all(alpha == 1.0f)) {
#pragma unroll
                    for (int db = 0; db < 4; ++db)
#pragma unroll
                        for (int r = 0; r < 16; ++r) o[db][r] *= alpha; }
                bf16x8 pf[4]; pf[0] = pack8(p0, 0); pf[1] = pack8(p0, 8); pf[2] = pack8(p1, 0); pf[3] = pack8(p1, 8);
#pragma unroll
                for (int db = 0; db < 4; ++db)
#pragma unroll
                    for (int s = 0; s < 4; ++s) {
                        const v4i16 lo = __builtin_amdgcn_ds_read_tr16_b64_v4i16((FA_LAS v4i16*)(buf + vfo[db] + s * 4096));
                        const v4i16 hh = __builtin_amdgcn_ds_read_tr16_b64_v4i16((FA_LAS v4i16*)(buf + vfo[db] + s * 4096 + 2048));
                        const bf16x8 vf = (bf16x8){lo[0], lo[1], lo[2], lo[3], hh[0], hh[1], hh[2], hh[3]};
                        o[db] = __builtin_amdgcn_mfma_f32_32x32x16_bf16(vf, pf[s], o[db], 0, 0, 0); }
            }
            FA_WAITBAR();
            if (lastb) {
                FA_LAS float* mb = (FA_LAS float*)(lds + cur * KVBUF) + rg * 4096; FA_LAS float* ml = (FA_LAS float*)(lds + LDS_ML) + rg * 128;
                const float lt = swapsum(l);
                if (kh == 1) {
#pragma unroll
                    for (int db = 0; db < 4; ++db)
#pragma unroll
                        for (int r = 0; r < 16; ++r) mb[(db * 16 + r) * 64 + lane] = o[db][r];
                    ml[lane] = m; ml[64 + lane] = lt; }
                FA_WAITBAR();
                if (kh == 0) {
                    const float m2 = ml[lane], l2 = ml[64 + lane], mm = fmaxf(m, m2), a1 = __builtin_amdgcn_exp2f(m - mm), a2 = __builtin_amdgcn_exp2f(m2 - mm);
                    const float inv = 1.0f / (lt * a1 + l2 * a2), s1 = a1 * inv, s2 = a2 * inv;
                    bf16_t* op = MIXIN + (size_t)(b * SEQ + qb * 128 + rg * 32 + r32) * 2048 + 1024 + h * 128 + 4 * hi;
#pragma unroll
                    for (int db = 0; db < 4; ++db)
#pragma unroll
                        for (int g = 0; g < 4; ++g) { float v[4];
#pragma unroll
                            for (int j = 0; j < 4; ++j) v[j] = o[db][4 * g + j] * s1 + mb[(db * 16 + 4 * g + j) * 64 + lane] * s2;
                            u32x2 w; w.x = cvtpk(v[0], v[1]); w.y = cvtpk(v[2], v[3]); *(u32x2*)(op + 32 * db + 8 * g) = w; } }
                FA_WAITBAR();
                if (u == 1) break;
                u = 1; qb = 15 - ii;
                { const bf16_t* qp = Q + (size_t)(b * SEQ + qb * 128 + rg * 32 + r32) * 1024 + h * 128 + 8 * hi;
#pragma unroll
                  for (int d0 = 0; d0 < 8; ++d0) qf[d0] = *(const bf16x8*)(qp + 16 * d0); }
#pragma unroll
                for (int db = 0; db < 4; ++db)
#pragma unroll
                    for (int r = 0; r < 16; ++r) o[db][r] = 0.f;
                m = -1e30f; l = 0.f;
            }
            cur ^= 1; kb = nkb;
        }
#undef FA_ISSUE
    }
}
}

namespace fs {
#define FS_LAS __attribute__((address_space(3)))
__device__ __forceinline__ void sgu_phase(const Args& A, FS_LAS unsigned char* lds) {
    const bf16_t* U = (const bf16_t*)(A.ws + WS_U); const bf16_t* V = (const bf16_t*)(A.ws + WS_V); bf16_t* MIXIN = (bf16_t*)(A.ws + WS_MIXIN);
    const float* wsp = A.in[7]; const float* bsp = A.in[8]; const float* ln_g = A.in[5]; const float* ln_b = A.in[6]; const float* VSTAT = (const float*)(A.ws + WS_VSTAT);
    const int tid = threadIdx.x, lane = tid & 63, wid = __builtin_amdgcn_readfirstlane(tid >> 6), tb = wid & 3, dh = wid >> 2, r32 = lane & 31, hi = lane >> 5;
    const int frow = tid >> 2, fq4 = tid & 3;
    int vfo[2];
    { const int d16 = (lane >> 4) & 1, q = (lane & 15) >> 2, p = lane & 3;
#pragma unroll
      for (int j = 0; j < 2; ++j) vfo[j] = 32768 + (8 * hi + q) * 256 + (((2 * dh + j) ^ q) * 64) + d16 * 32 + p * 8; }
    const int wfo = (32 * tb + r32) * 256;
    for (int u = blockIdx.x; u < (T / CHUNK) * NG; u += gridDim.x) {
        const int rc = u / NG, g = u % NG, row0 = rc * CHUNK;
        { const float* wr = wsp + ((size_t)g * CHUNK + frow) * CHUNK + fq4 * 32;
#pragma unroll
          for (int c = 0; c < 4; ++c) { const f32x4 a = *(const f32x4*)(wr + 8 * c), b2 = *(const f32x4*)(wr + 8 * c + 4); const int s0 = fq4 * 32 + 8 * c; float v[8] = {a.x, a.y, a.z, a.w, b2.x, b2.y, b2.z, b2.w};
#pragma unroll
              for (int j = 0; j < 8; ++j) if (s0 + j > frow) v[j] = 0.f;
              u32x4 w; w.x = pk2(v[0], v[1]); w.y = pk2(v[2], v[3]); w.z = pk2(v[4], v[5]); w.w = pk2(v[6], v[7]);
              *(FS_LAS u32x4*)(lds + frow * 256 + (((4 * fq4 + c) ^ (frow & 15)) * 16)) = w; }
          const bf16_t* vr = V + (size_t)(row0 + frow) * 1024 + g * 128 + fq4 * 32;
          float mean, rstd;
          { const f32x4 pa = *(const f32x4*)(VSTAT + ((size_t)(row0 + frow) * 16 + 4 * fq4) * 2), pb = *(const f32x4*)(VSTAT + ((size_t)(row0 + frow) * 16 + 4 * fq4) * 2 + 4);
            float s1 = (pa[0] + pa[2]) + (pb[0] + pb[2]), s2 = (pa[1] + pa[3]) + (pb[1] + pb[3]);
            s1 += __shfl_xor(s1, 1); s1 += __shfl_xor(s1, 2); s2 += __shfl_xor(s2, 1); s2 += __shfl_xor(s2, 2);
            mean = s1 * (1.f / 1024.f); rstd = rsqrtf(fmaxf(s2 * (1.f / 1024.f) - mean * mean, 0.f) + EPS); }
#pragma unroll
          for (int c = 0; c < 4; ++c) { const u32x4 w = *(const u32x4*)(vr + 8 * c); const int cb = g * 128 + fq4 * 32 + 8 * c;
              const f32x4 ga = *(const f32x4*)(ln_g + cb), gb = *(const f32x4*)(ln_g + cb + 4), ba = *(const f32x4*)(ln_b + cb), bb = *(const f32x4*)(ln_b + cb + 4);
              float v[8];
#pragma unroll
              for (int e2 = 0; e2 < 4; ++e2) { v[2 * e2] = __uint_as_float(w[e2] << 16); v[2 * e2 + 1] = __uint_as_float(w[e2] & 0xffff0000u); }
              u32x4 o; o.x = pk2((v[0] - mean) * rstd * ga[0] + ba[0], (v[1] - mean) * rstd * ga[1] + ba[1]); o.y = pk2((v[2] - mean) * rstd * ga[2] + ba[2], (v[3] - mean) * rstd * ga[3] + ba[3]);
              o.z = pk2((v[4] - mean) * rstd * gb[0] + bb[0], (v[5] - mean) * rstd * gb[1] + bb[1]); o.w = pk2((v[6] - mean) * rstd * gb[2] + bb[2], (v[7] - mean) * rstd * gb[3] + bb[3]);
              *(FS_LAS u32x4*)(lds + 32768 + frow * 256 + (((4 * fq4 + c) ^ ((frow & 3) << 2)) * 16)) = o; } }
        __syncthreads();
        fa::f32x16 acc[2];
#pragma unroll
        for (int j = 0; j < 2; ++j)
#pragma unroll
            for (int r = 0; r < 16; ++r) acc[j][r] = 0.f;
        for (int s = 0; s <= 2 * tb + 1; ++s) {
            const fa::bf16x8 wf = *(FS_LAS const fa::bf16x8*)(lds + wfo + (((2 * s + hi) ^ (r32 & 15)) * 16));
#pragma unroll
            for (int j = 0; j < 2; ++j) {
                const fa::v4i16 lo = __builtin_amdgcn_ds_read_tr16_b64_v4i16((FS_LAS fa::v4i16*)(lds + vfo[j] + s * 4096));
                const fa::v4i16 hh = __builtin_amdgcn_ds_read_tr16_b64_v4i16((FS_LAS fa::v4i16*)(lds + vfo[j] + s * 4096 + 1024));
                const fa::bf16x8 vf = (fa::bf16x8){lo[0], lo[1], lo[2], lo[3], hh[0], hh[1], hh[2], hh[3]};
                acc[j] = __builtin_amdgcn_mfma_f32_32x32x16_bf16(vf, wf, acc[j], 0, 0, 0); }
        }
        { const int tt = 32 * tb + r32; const float bb = bsp[g * CHUNK + tt]; const size_t rw = (size_t)(row0 + tt);
#pragma unroll
          for (int j = 0; j < 2; ++j)
#pragma unroll
              for (int g4 = 0; g4 < 4; ++g4) { const int d = 32 * (2 * dh + j) + 8 * g4 + 4 * hi; const u32x2 uu = *(const u32x2*)(U + rw * 1024 + g * 128 + d);
                  const float u0 = __uint_as_float(uu.x << 16), u1 = __uint_as_float(uu.x & 0xffff0000u), u2 = __uint_as_float(uu.y << 16), u3 = __uint_as_float(uu.y & 0xffff0000u);
                  u32x2 w; w.x = fa::cvtpk(u0 * (acc[j][4 * g4] + bb), u1 * (acc[j][4 * g4 + 1] + bb)); w.y = fa::cvtpk(u2 * (acc[j][4 * g4 + 2] + bb), u3 * (acc[j][4 * g4 + 3] + bb));
                  *(u32x2*)(MIXIN + rw * 2048 + g * 128 + d) = w; } }
        __syncthreads();
    }
}
}


#define XB_TMO      128
#define XB_XCNT(j)  (256  + 64 * (j))
#define XB_XSUB(j)  (1280 + 64 * (j))
#define XB_XGEN(j)  (2304 + 64 * (j))
#define XB_TOP      3328
#define XB_TOPGEN   3392
#define XCD_BAR_WORDS 3456
#define XB_SPIN_CAP (1u << 18)
#define XLAS __attribute__((address_space(3)))
__device__ __forceinline__ unsigned xb_ld(unsigned* p)              { return __hip_atomic_load(p, __ATOMIC_RELAXED, __HIP_MEMORY_SCOPE_AGENT); }
__device__ __forceinline__ unsigned xb_add(unsigned* p, unsigned v) { return __hip_atomic_fetch_add(p, v, __ATOMIC_RELAXED, __HIP_MEMORY_SCOPE_AGENT); }
__device__ __forceinline__ unsigned xb_xcc_id() { return (unsigned)__builtin_amdgcn_s_getreg((3 << 11) | 20) & 0xFu; }
#define XB_SPIN(cond, bar) do { unsigned _sp = 0; while (cond) { __builtin_amdgcn_s_sleep(1); \
    if ((++_sp & 255u) == 0u) { if (xb_ld(&(bar)[XB_TMO])) break; if (_sp > XB_SPIN_CAP) { atomicAdd(&(bar)[XB_TMO], 1u); break; } } } } while (0)
struct XcdBarrier { unsigned* bar; unsigned x; volatile XLAS unsigned* st; };
__device__ __forceinline__ XcdBarrier xcd_barrier_post(unsigned* bar, volatile XLAS unsigned* st) {
    XcdBarrier b; b.bar = bar; b.x = xb_xcc_id(); b.st = st;
    if (threadIdx.x == 0) (void)xb_add(&bar[XB_XCNT(b.x)], 1u);
    return b;
}
__device__ __forceinline__ void xcd_barrier_complete(unsigned* bar, unsigned x, unsigned& nloc, unsigned& nx) {
    const unsigned G = gridDim.x * gridDim.y * gridDim.z;
    unsigned sum, cnt, mine, sp = 0u;
    for (;;) {
        sum = 0u; cnt = 0u; mine = 0u;
#pragma unroll
        for (unsigned j = 0; j < 16; ++j) { const unsigned c = xb_ld(&bar[XB_XCNT(j)]); sum += c; cnt += (c > 0u) ? 1u : 0u; mine = (j == x) ? c : mine; }
        if (sum == G) break;
        __builtin_amdgcn_s_sleep(1);
        if ((++sp & 255u) == 0u) { if (xb_ld(&bar[XB_TMO])) break; if (sp > XB_SPIN_CAP) { atomicAdd(&bar[XB_TMO], 1u); break; } }
    }
    nloc = mine > 0u ? mine : 1u; nx = cnt > 0u ? cnt : 1u;
}
__device__ __forceinline__ void xcd_barrier(const XcdBarrier& b) {
    asm volatile("s_waitcnt vmcnt(0)" ::: "memory");
    __syncthreads();
    if (threadIdx.x == 0) {
        unsigned* bar = b.bar;
        __builtin_amdgcn_s_waitcnt(0);
        unsigned nloc = b.st[0], nx = b.st[1];
        if (nloc == 0u) { xcd_barrier_complete(bar, b.x, nloc, nx); b.st[0] = nloc; b.st[1] = nx; }
        const unsigned old = xb_add(&bar[XB_XSUB(b.x)], 1u);
        const unsigned gen = old / nloc;
        if (old + 1u == (gen + 1u) * nloc) {
            __builtin_amdgcn_fence(__ATOMIC_RELEASE, "agent");
            asm volatile("s_waitcnt vmcnt(0)" ::: "memory");
            const unsigned og = xb_add(&bar[XB_TOP], 1u);
            const unsigned tg = og / nx;
            if (og + 1u == (tg + 1u) * nx) xb_add(&bar[XB_TOPGEN], 1u);
            else XB_SPIN(xb_ld(&bar[XB_TOPGEN]) == tg, bar);
            __builtin_amdgcn_fence(__ATOMIC_ACQUIRE, "agent");
            xb_add(&bar[XB_XGEN(b.x)], 1u);
            asm volatile("s_waitcnt vmcnt(0)" ::: "memory");
        } else {
            XB_SPIN(xb_ld(&bar[XB_XGEN(b.x)]) == gen, bar);
            __builtin_amdgcn_fence(__ATOMIC_ACQUIRE, "agent");
            asm volatile("s_waitcnt vmcnt(0)" ::: "memory");
        }
    }
    __syncthreads();
}
constexpr int CW_BAR = 4096;
constexpr size_t CTL_ZERO_BYTES = 65536;
constexpr int LDS_BARST_OFF = LDS_BYTES - 16;

constexpr bool FAST_P1 = true, FAST_P3 = true, FAST_P4 = true, FAST_P6 = true, FAST_P7 = true;
constexpr bool FAST_ATTN = true, FAST_SGU = true;
constexpr bool FAST_ANY = FAST_P1 || FAST_P3 || FAST_P4 || FAST_P6 || FAST_P7;
constexpr int N_PHASES = 10;
__global__ void __launch_bounds__(NTHREADS, 2) fwd(Args A) {
    extern __shared__ __attribute__((aligned(16))) unsigned char lds[];
    float* ldsf = (float*)lds;
    const int lo = A.ph_lo, hi = A.ph_hi;
    if (threadIdx.x < 4) ((volatile XLAS unsigned*)((XLAS unsigned char*)lds + LDS_BARST_OFF))[threadIdx.x] = 0u;
    __syncthreads();
    XcdBarrier bar = xcd_barrier_post((unsigned*)(A.ws + WS_CTL) + CW_BAR, (volatile XLAS unsigned*)((XLAS unsigned char*)lds + LDS_BARST_OFF));
#define IN(k) (lo <= (k) && (k) < hi)
#define SEAM(k) do { if (IN(k) && IN((k) + 1)) xcd_barrier(bar); STAMP((k) + 1); } while (0)
    unsigned long long t_lo = 0, t_hi = 0;
#define STAMP(i) do { if (STAMP_PHASE >= 0) { if ((i) == STAMP_PHASE || (STAMP_PHASE == 98 && (i) == 0)) t_lo = __builtin_amdgcn_s_memrealtime(); if ((i) == STAMP_PHASE + 1 || (STAMP_PHASE == 98 && (i) == 9)) t_hi = __builtin_amdgcn_s_memrealtime(); } } while (0)
    STAMP(0);
    PG8_LAS unsigned char* l3 = (PG8_LAS unsigned char*)lds;
    if (IN(0)) { if (FAST_ANY) { p0_weights(A, l3, 0, 0); __syncthreads(); } p0_rows(A, ldsf); } SEAM(0);
    if (IN(1)) { if (FAST_P1) p1_fast(A, l3); else p1_naive(A, ldsf); if (FAST_ANY) { __syncthreads(); p0_weights(A, l3, 1, (1152 % (int)gridDim.x == 0) ? 0 : 1152 % (int)gridDim.x); } } SEAM(1);
    if (!(FAST_P1 && FAST_SGU && FAST_ATTN)) { if (IN(2)) { p1b_fix<0>(A, ldsf); } SEAM(2); }
    if (IN(3)) { if (FAST_SGU) fs::sgu_phase(A, l3); else p2_sgu_naive(A); if (FAST_ATTN) { __syncthreads(); fa::attn_phase(A, l3); } else p2_attn_naive(A, ldsf); } SEAM(3);
    if (IN(4)) { if (FAST_P3) p3_fast(A, l3); else p3_naive(A, ldsf); } SEAM(4);
    if (IN(5)) { if (FAST_P4) p4_fast(A, l3); else p4_naive(A, ldsf); } SEAM(5);
    if (IN(6)) { if (PROBE_ALT == 6) { p5_router2<1>(A, ldsf); __syncthreads(); } p5_router2<0>(A, ldsf); } SEAM(6);
    if (IN(7)) { if (FAST_P6) p6_fast(A, l3); else p6_naive(A, ldsf); } SEAM(7);
    if (IN(8)) { if (FAST_P7) p7_fast(A, l3); else p7_naive(A, ldsf); } SEAM(8);
    if (IN(9)) { if (PROBE_ALT == 9) { p8_combine<1>(A, ldsf); __syncthreads(); } p8_combine<0>(A, ldsf, STAMP_PHASE < 0 ? 0.f : (STAMP_PHASE == 99 ? 1.0f : (float)(t_hi - t_lo) * 0.01f * 0.001f * STAMP_SCALE)); }
#undef IN
#undef SEAM
}

#ifndef MK_N_LAUNCHES
#define MK_N_LAUNCHES 1
#endif
extern "C" void kernel_launch(void* const* d_in, const int* in_sizes, int n_in, void* d_out, int out_size, void* d_ws, size_t ws_size, hipStream_t stream) {
    static int grid = 0;
    if (grid == 0) {
        if (n_in != 22 || out_size != T * DM || ws_size < WS_END) { fprintf(stderr, "kernel_launch: unexpected shapes (n_in %d out %d ws %zu)\n", n_in, out_size, ws_size); grid = -1; return; }
        int dev = 0, cus = 0, per_cu = 0;
        hipGetDevice(&dev); hipDeviceGetAttribute(&cus, hipDeviceAttributeMultiprocessorCount, dev);
        hipFuncSetAttribute((const void*)fwd, hipFuncAttributeMaxDynamicSharedMemorySize, LDS_BYTES);
        hipOccupancyMaxActiveBlocksPerMultiprocessor(&per_cu, (const void*)fwd, NTHREADS, LDS_BYTES);
        if (per_cu < 1) { fprintf(stderr, "kernel_launch: occupancy query says %d blocks per CU\n", per_cu); per_cu = 1; }
        (void)hipGetLastError();
        grid = cus;
    }
    if (grid < 0) return;
    Args a{};
    for (int i = 0; i < 22; ++i) a.in[i] = (const float*)d_in[i];
    a.out = (float*)d_out; a.ws = (unsigned char*)d_ws;
    if (hipMemsetAsync((char*)d_ws + WS_CTL, 0, CTL_ZERO_BYTES, stream) != hipSuccess) { fprintf(stderr, "kernel_launch: memset failed\n"); return; }
    if (MK_N_LAUNCHES == 1) {
        a.ph_lo = 0; a.ph_hi = N_PHASES;
        hipLaunchKernelGGL(fwd, dim3(grid), dim3(NTHREADS), LDS_BYTES, stream, a);
    } else {
        for (int p = 0; p < N_PHASES; ++p) { a.ph_lo = p; a.ph_hi = p + 1; hipLaunchKernelGGL(fwd, dim3(grid), dim3(NTHREADS), LDS_BYTES, stream, a); }
    }
}
```

```cpp
#include <hip/hip_runtime.h>
#include <hip/hip_cooperative_groups.h>
#include <cstdio>
#include <cstdint>
namespace cg = cooperative_groups;

#ifndef STAMP_PHASE
#define STAMP_PHASE -1
#endif
#ifndef STAMP_SEL
#define STAMP_SEL 0
#endif
#ifndef STAMP_SCALE
#define STAMP_SCALE 0.5f
#endif
#ifndef PROBE_ALT
#define PROBE_ALT -1
#endif
constexpr int T = 8192, SEQ = 2048, NB = 4, DM = 2048, SGUW = 1024, FOXW = 1024, NH = 8, HD = 128, CHUNK = 128, NG = 8;
constexpr int INCOLS = 9224, OFF_F = 5120, OFF_GATE = 5128;
constexpr int NEXP = 32, EPG = 8, NGRP = 4, DEXP = 512;
constexpr float EPS = 1e-6f;
constexpr float LOG2E = 1.4426950408889634f;
constexpr float QSCALE = 0.08838834764831845f * LOG2E;
constexpr int NTHREADS = 512, NWAVES = 8;
constexpr int LDS_BYTES = 160 * 1024;
constexpr int MTILE = 256;
constexpr int PMAX = 2 * T + NEXP * MTILE;
constexpr int MT_MAX = PMAX / MTILE;
constexpr int TINY_ROWS = 0;

typedef unsigned short bf16_t;
typedef float f32x4 __attribute__((ext_vector_type(4)));
typedef unsigned u32x4 __attribute__((ext_vector_type(4)));
typedef unsigned u32x2 __attribute__((ext_vector_type(2)));

constexpr size_t MiB = 1u << 20;
constexpr size_t WS_CTL = 0;
constexpr size_t WS_LOGF = 1 * MiB;
constexpr size_t WS_CKL = 2 * MiB;
constexpr size_t WS_TOK = 3 * MiB;
constexpr size_t WS_GATE = 4 * MiB;
constexpr size_t WS_ASG = 5 * MiB;
constexpr size_t WS_WIN = 8 * MiB;
constexpr size_t WS_WPROJ = 44 * MiB;
constexpr size_t WS_WOUT = 52 * MiB;
constexpr size_t WS_WGU = 60 * MiB;
constexpr size_t WS_WD = 188 * MiB;
constexpr size_t WS_H = 252 * MiB;
constexpr size_t WS_MIXED = WS_H;
constexpr size_t WS_U = 284 * MiB;
constexpr size_t WS_V = 300 * MiB;
constexpr size_t WS_G = 316 * MiB;
constexpr size_t WS_YBUF = WS_U;
constexpr size_t WS_Q = 380 * MiB;
constexpr size_t WS_K = 396 * MiB;
constexpr size_t WS_VA = 412 * MiB;
constexpr size_t WS_ACT = WS_Q;
constexpr size_t WS_MIXIN = 428 * MiB;
constexpr size_t WS_H2 = WS_MIXIN;
constexpr size_t WS_END = 460 * MiB;
static_assert((size_t)PMAX * 2048 * 2 <= 96 * MiB && (size_t)PMAX * 512 * 2 <= 32 * MiB, "overlay sizes");

constexpr int CW_CNT = 0;
constexpr int CNT_STRIDE = 64;

__device__ __forceinline__ float bf2f(bf16_t v) { return __uint_as_float((unsigned)v << 16); }
__device__ __forceinline__ bf16_t f2bf(float f) { unsigned u = __float_as_uint(f); return (bf16_t)((u + 0x7fffu + ((u >> 16) & 1u)) >> 16); }
__device__ __forceinline__ unsigned pk2(float lo, float hi) { return (unsigned)f2bf(lo) | ((unsigned)f2bf(hi) << 16); }
__device__ __forceinline__ unsigned cvtpk_rne(float lo, float hi) { unsigned r; asm("v_cvt_pk_bf16_f32 %0, %1, %2" : "=v"(r) : "v"(lo), "v"(hi)); return r; }
__device__ __forceinline__ float wave_sum(float v) {
#pragma unroll
    for (int o = 1; o < 64; o <<= 1) v += __shfl_xor(v, o);
    return v;
}
__device__ __forceinline__ float wave_max(float v) {
#pragma unroll
    for (int o = 1; o < 64; o <<= 1) v = fmaxf(v, __shfl_xor(v, o));
    return v;
}
__device__ __forceinline__ float gelu_tanh(float x) {
    const float c = 0.7978845608028654f; const float y = c * (x + 0.044715f * x * x * x);
    return x / (1.0f + __expf(-2.0f * y));
}
__device__ __forceinline__ float sigmoidf_(float x) { return 1.0f / (1.0f + __expf(-x)); }
__device__ __forceinline__ float log_sigmoid(float z) { return fminf(z, 0.f) - log1pf(__expf(-fabsf(z))); }

struct Args {
    const float* in[22];
    float* out;
    unsigned char* ws;
    int ph_lo, ph_hi;
};

template <class AF, class BF, class EF>
__device__ __forceinline__ void naive_gemm_tile(float* lds, int m0, int n0, int M, int N, int K, int Ksplit, AF a, BF b, EF epi) {
    float* As = lds;
    float* Bs = lds + 16 * 132;
    const int tid = threadIdx.x, ty = tid >> 4, tx = tid & 15;
    float acc[4][8], acc1[4][8];
#pragma unroll
    for (int i = 0; i < 4; ++i)
#pragma unroll
        for (int j = 0; j < 8; ++j) { acc[i][j] = 0.f; acc1[i][j] = 0.f; }
    const bool split = Ksplit < K;
#pragma unroll 1
    for (int pass = 0; pass < 2; ++pass) {
        const int kb = pass == 0 ? 0 : Ksplit, ke = pass == 0 ? (split ? Ksplit : K) : K;
        if (pass == 1) {
            if (!split) break;
#pragma unroll
            for (int i = 0; i < 4; ++i)
#pragma unroll
                for (int j = 0; j < 8; ++j) { acc1[i][j] = acc[i][j]; acc[i][j] = 0.f; }
        }
#pragma unroll 1
        for (int k0 = kb; k0 < ke; k0 += 16) {
#pragma unroll
            for (int i = 0; i < 4; ++i) { const int idx = tid + i * 512, r = idx >> 4, kk = idx & 15; const int m = m0 + r; As[kk * 132 + r] = (m < M) ? a(m, k0 + kk) : 0.f; }
#pragma unroll
            for (int i = 0; i < 4; ++i) { const int idx = tid + i * 512, kk = idx >> 7, n = idx & 127; Bs[kk * 132 + n] = (n0 + n < N) ? b(k0 + kk, n0 + n) : 0.f; }
            __syncthreads();
#pragma unroll 4
            for (int kk = 0; kk < 16; ++kk) {
                float av[4], bv[8];
#pragma unroll
                for (int i = 0; i < 4; ++i) av[i] = As[kk * 132 + ty * 4 + i];
#pragma unroll
                for (int j = 0; j < 8; ++j) bv[j] = Bs[kk * 132 + tx * 8 + j];
#pragma unroll
                for (int i = 0; i < 4; ++i)
#pragma unroll
                    for (int j = 0; j < 8; ++j) acc[i][j] = fmaf(av[i], bv[j], acc[i][j]);
            }
            __syncthreads();
        }
    }
#pragma unroll
    for (int i = 0; i < 4; ++i)
#pragma unroll
        for (int j = 0; j < 8; ++j) { const int m = m0 + ty * 4 + i, n = n0 + tx * 8 + j; if (m < M && n < N) epi(m, n, split ? acc1[i][j] : acc[i][j], split ? acc[i][j] : 0.f); }
}
template <class AF, class BF, class EF>
__device__ __forceinline__ void naive_gemm(float* lds, int M, int N, int K, int Ksplit, AF a, BF b, EF epi) {
    const int ntm = (M + 127) / 128, ntn = (N + 127) / 128;
    for (int t = blockIdx.x; t < ntm * ntn; t += gridDim.x) naive_gemm_tile(lds, (t / ntn) * 128, (t % ntn) * 128, M, N, K, Ksplit, a, b, epi);
}

__device__ __forceinline__ void p0_rows(const Args& A, float* ldsf) {
    const float* x = A.in[0]; const float* g1 = A.in[1]; const float* w_in = A.in[2]; const float* b_forget = A.in[4];
    bf16_t* H = (bf16_t*)(A.ws + WS_H); float* LOGF = (float*)(A.ws + WS_LOGF);
    const int tid = threadIdx.x, lane = tid & 63, wave = tid >> 6;
    for (int i = tid; i < DM * 8; i += NTHREADS) ldsf[i] = w_in[(size_t)(i >> 3) * INCOLS + OFF_F + (i & 7)];
    __syncthreads();
    const int gw = blockIdx.x * NWAVES + wave, NGW = gridDim.x * NWAVES;
    for (int row = gw; row < T; row += NGW) {
        const f32x4* xr = (const f32x4*)(x + (size_t)row * DM) + lane;
        f32x4 xv[8]; float ss = 0.f;
#pragma unroll
        for (int j = 0; j < 8; ++j) xv[j] = xr[64 * j];
#pragma unroll
        for (int j = 0; j < 8; ++j) ss += xv[j].x * xv[j].x + xv[j].y * xv[j].y + xv[j].z * xv[j].z + xv[j].w * xv[j].w;
        const float rstd = rsqrtf(wave_sum(ss) * (1.f / DM) + EPS);
        float f[8];
#pragma unroll
        for (int h = 0; h < 8; ++h) f[h] = 0.f;
#pragma unroll
        for (int j = 0; j < 8; ++j) {
            const int c0 = 256 * j + 4 * lane; const f32x4 g = *(const f32x4*)(g1 + c0);
            f32x4 hv; hv.x = xv[j].x * rstd * g.x; hv.y = xv[j].y * rstd * g.y; hv.z = xv[j].z * rstd * g.z; hv.w = xv[j].w * rstd * g.w;
            u32x2 o; o.x = pk2(hv.x, hv.y); o.y = pk2(hv.z, hv.w);
            *(u32x2*)(H + (size_t)row * DM + c0) = o;
#pragma unroll
            for (int e = 0; e < 4; ++e) { const float hx = hv[e]; const float* wf = ldsf + (c0 + e) * 8;
#pragma unroll
                for (int h = 0; h < 8; ++h) f[h] = fmaf(hx, wf[h], f[h]); }
            asm volatile("" ::: "memory");
        }
#pragma unroll
        for (int h = 0; h < 8; ++h) f[h] = wave_sum(f[h]);
        if (lane < 8) { float z = 0.f;
#pragma unroll
            for (int h = 0; h < 8; ++h) if (lane == h) z = f[h];
            LOGF[(size_t)row * 8 + lane] = log_sigmoid(z + b_forget[lane]); }
    }
}

__device__ __forceinline__ void p1_naive(const Args& A, float* ldsf) {
    const bf16_t* H = (const bf16_t*)(A.ws + WS_H); const float* w_in = A.in[2]; const float* b_gate = A.in[3];
    bf16_t* U = (bf16_t*)(A.ws + WS_U); bf16_t* V = (bf16_t*)(A.ws + WS_V); bf16_t* Q = (bf16_t*)(A.ws + WS_Q); bf16_t* K = (bf16_t*)(A.ws + WS_K);
    bf16_t* VA = (bf16_t*)(A.ws + WS_VA); bf16_t* G = (bf16_t*)(A.ws + WS_G);
    naive_gemm(ldsf, T, 9216, DM, DM,
        [=](int m, int k) { return bf2f(H[(size_t)m * DM + k]); },
        [=](int k, int n) { const int c = n < 5120 ? n : n + 8; return w_in[(size_t)k * INCOLS + c]; },
        [=](int m, int n, float s, float) {
            if (n < 1024) U[(size_t)m * 1024 + n] = f2bf(gelu_tanh(s));
            else if (n < 2048) V[(size_t)m * 1024 + n - 1024] = f2bf(gelu_tanh(s));
            else if (n < 3072) Q[(size_t)m * 1024 + n - 2048] = f2bf(s);
            else if (n < 4096) K[(size_t)m * 1024 + n - 3072] = f2bf(s);
            else if (n < 5120) VA[(size_t)m * 1024 + n - 4096] = f2bf(s);
            else G[(size_t)m * 4096 + n - 5120] = f2bf(sigmoidf_(s + b_gate[n - 5120]));
        });
}

template <int ALT> __device__ __forceinline__ void p1b_fix(const Args& A, float* ldsf) {
    bf16_t* V = (bf16_t*)(A.ws + WS_V); bf16_t* Q = (bf16_t*)(A.ws + WS_Q); bf16_t* K = (bf16_t*)(A.ws + WS_K);
    const size_t altoff = ALT ? ((size_t)((unsigned char*)A.out - (A.ws + WS_V))) / 2 : 0;
    const size_t altq = ALT ? ((size_t)((unsigned char*)A.out + 16 * MiB - (A.ws + WS_Q))) / 2 : 0, altk = ALT ? ((size_t)((unsigned char*)A.out + 32 * MiB - (A.ws + WS_K))) / 2 : 0;
    const float* ln_g = A.in[5]; const float* ln_b = A.in[6]; const float* qg = A.in[9]; const float* kg = A.in[10];
    const int tid = threadIdx.x, lane = tid & 63, wave = tid >> 6;
    const int gw = blockIdx.x * NWAVES + wave, NGW = gridDim.x * NWAVES;
    for (int row = gw; row < T; row += NGW) {
        {
            bf16_t* vr = V + (size_t)row * 1024; float v[16]; float s = 0.f;
#pragma unroll
            for (int j = 0; j < 2; ++j) { const u32x4 w = *(const u32x4*)(vr + 512 * j + 8 * lane);
#pragma unroll
                for (int e = 0; e < 4; ++e) { v[8 * j + 2 * e] = __uint_as_float(w[e] << 16); v[8 * j + 2 * e + 1] = __uint_as_float(w[e] & 0xffff0000u); } }
#pragma unroll
            for (int i = 0; i < 16; ++i) s += v[i];
            const float mean = wave_sum(s) * (1.f / 1024.f); float q = 0.f;
#pragma unroll
            for (int i = 0; i < 16; ++i) { v[i] -= mean; q += v[i] * v[i]; }
            const float rstd = rsqrtf(wave_sum(q) * (1.f / 1024.f) + EPS);
#pragma unroll
            for (int j = 0; j < 2; ++j) { const int c0 = 512 * j + 8 * lane; u32x4 o;
#pragma unroll
                for (int e = 0; e < 4; ++e) o[e] = pk2(v[8 * j + 2 * e] * rstd * ln_g[c0 + 2 * e] + ln_b[c0 + 2 * e], v[8 * j + 2 * e + 1] * rstd * ln_g[c0 + 2 * e + 1] + ln_b[c0 + 2 * e + 1]);
                *(u32x4*)(vr + altoff + c0) = o; }
        }
#pragma unroll
        for (int which = 0; which < 2; ++which) {
            bf16_t* pr = (which == 0 ? Q : K) + (size_t)row * 1024 + 16 * lane; const float* gg = which == 0 ? qg : kg; float v[16]; float s = 0.f;
#pragma unroll
            for (int j = 0; j < 2; ++j) { const u32x4 w = *(const u32x4*)(pr + 8 * j);
#pragma unroll
                for (int e = 0; e < 4; ++e) { v[8 * j + 2 * e] = __uint_as_float(w[e] << 16); v[8 * j + 2 * e + 1] = __uint_as_float(w[e] & 0xffff0000u); } }
#pragma unroll
            for (int i = 0; i < 16; ++i) s += v[i] * v[i];
            s += __shfl_xor(s, 1); s += __shfl_xor(s, 2); s += __shfl_xor(s, 4);
            const float sc = rsqrtf(s * (1.f / 128.f) + EPS) * (which == 0 ? QSCALE : 1.f); const int d0 = (16 * lane) & 127;
#pragma unroll
            for (int j = 0; j < 2; ++j) { u32x4 o;
#pragma unroll
                for (int e = 0; e < 4; ++e) o[e] = pk2(v[8 * j + 2 * e] * sc * gg[d0 + 8 * j + 2 * e], v[8 * j + 2 * e + 1] * sc * gg[d0 + 8 * j + 2 * e + 1]);
                *(u32x4*)(pr + (which == 0 ? altq : altk) + 8 * j) = o; }
        }
    }
    if (blockIdx.x < NB * NH) {
        const int b = blockIdx.x / NH, h = blockIdx.x % NH; const float* LOGF = (const float*)(A.ws + WS_LOGF); float* CKL = (float*)(A.ws + WS_CKL) + (size_t)blockIdx.x * SEQ + (ALT ? 65536 : 0);
        float v[4]; float s = 0.f;
#pragma unroll
        for (int i = 0; i < 4; ++i) { v[i] = LOGF[(size_t)(b * SEQ + tid * 4 + i) * 8 + h]; s += v[i]; }
        float incl = s;
#pragma unroll
        for (int o = 1; o < 64; o <<= 1) { const float t = __shfl_up(incl, o); if (lane >= o) incl += t; }
        __syncthreads();
        if (lane == 63) ldsf[wave] = incl;
        __syncthreads();
        float base = 0.f;
        for (int w = 0; w < wave; ++w) base += ldsf[w];
        float run = base + incl - s;
#pragma unroll
        for (int i = 0; i < 4; ++i) { run += v[i]; CKL[tid * 4 + i] = run * LOG2E; }
        __syncthreads();
    }
}

__device__ __forceinline__ void p2_sgu_naive(const Args& A) {
    const bf16_t* U = (const bf16_t*)(A.ws + WS_U); const bf16_t* V = (const bf16_t*)(A.ws + WS_V); bf16_t* MIXIN = (bf16_t*)(A.ws + WS_MIXIN);
    const float* wsp = A.in[7]; const float* bsp = A.in[8];
    const int tid = threadIdx.x, tt = tid >> 2, dp = tid & 3;
    for (int u = blockIdx.x; u < (T / CHUNK) * NG; u += gridDim.x) {
        const int rc = u / NG, g = u % NG; const int row0 = rc * CHUNK;
        float acc[32];
#pragma unroll
        for (int i = 0; i < 32; ++i) acc[i] = 0.f;
        for (int ss = 0; ss <= tt; ++ss) {
            const float w = wsp[((size_t)g * CHUNK + tt) * CHUNK + ss];
            const bf16_t* vr = V + (size_t)(row0 + ss) * 1024 + g * 128 + dp * 32;
#pragma unroll
            for (int i = 0; i < 32; ++i) acc[i] = fmaf(w, bf2f(vr[i]), acc[i]);
        }
        const float bb = bsp[g * CHUNK + tt];
        const bf16_t* ur = U + (size_t)(row0 + tt) * 1024 + g * 128 + dp * 32; bf16_t* orow = MIXIN + (size_t)(row0 + tt) * 2048 + g * 128 + dp * 32;
#pragma unroll
        for (int i = 0; i < 32; ++i) orow[i] = f2bf(bf2f(ur[i]) * (acc[i] + bb));
    }
}
__device__ __forceinline__ void p2_attn_naive(const Args& A, float* ldsf) {
    const bf16_t* Q = (const bf16_t*)(A.ws + WS_Q); const bf16_t* K = (const bf16_t*)(A.ws + WS_K); const bf16_t* VA = (const bf16_t*)(A.ws + WS_VA);
    const float* CKL = (const float*)(A.ws + WS_CKL); bf16_t* MIXIN = (bf16_t*)(A.ws + WS_MIXIN);
    const int tid = threadIdx.x, lane = tid & 63, wave = tid >> 6;
    float* qs = ldsf + wave * 128;
    const int gw = blockIdx.x * NWAVES + wave, NGW = gridDim.x * NWAVES;
    for (int item = gw; item < T * NH; item += NGW) {
        const int row = item / NH, h = item % NH, b = row / SEQ, t = row % SEQ;
        const bf16_t* qr = Q + (size_t)row * 1024 + h * 128;
        qs[lane] = bf2f(qr[lane]); qs[64 + lane] = bf2f(qr[64 + lane]);
        __builtin_amdgcn_s_waitcnt(0);
        const float* ck = CKL + (size_t)(b * NH + h) * SEQ;
        float m = -1e30f, l = 0.f, o0 = 0.f, o1 = 0.f;
        for (int s0 = 0; s0 <= t; s0 += 64) {
            const int s = s0 + lane; float sc = -INFINITY;
            if (s <= t) { const bf16_t* kr = K + (size_t)(b * SEQ + s) * 1024 + h * 128; float d = 0.f;
                for (int c = 0; c < 16; ++c) { const u32x4 w = *(const u32x4*)(kr + 8 * c);
#pragma unroll
                    for (int e = 0; e < 4; ++e) { d = fmaf(qs[8 * c + 2 * e], __uint_as_float(w[e] << 16), d); d = fmaf(qs[8 * c + 2 * e + 1], __uint_as_float(w[e] & 0xffff0000u), d); } }
                sc = d - ck[s]; }
            const float mn = fmaxf(m, wave_max(sc)); const float alpha = exp2f(m - mn); const float p = exp2f(sc - mn);
            l = l * alpha + wave_sum(p); o0 *= alpha; o1 *= alpha; m = mn;
            const int nk = min(64, t - s0 + 1);
            for (int j = 0; j < nk; ++j) { const float pj = __shfl(p, j); const unsigned w = *(const unsigned*)(VA + (size_t)(b * SEQ + s0 + j) * 1024 + h * 128 + 2 * lane);
                o0 = fmaf(pj, __uint_as_float(w << 16), o0); o1 = fmaf(pj, __uint_as_float(w & 0xffff0000u), o1); }
        }
        const float il = 1.f / l;
        *(unsigned*)(MIXIN + (size_t)row * 2048 + 1024 + h * 128 + 2 * lane) = pk2(o0 * il, o1 * il);
    }
}

__device__ __forceinline__ void p3_naive(const Args& A, float* ldsf) {
    const bf16_t* MIXIN = (const bf16_t*)(A.ws + WS_MIXIN); const bf16_t* G = (const bf16_t*)(A.ws + WS_G); bf16_t* MIXED = (bf16_t*)(A.ws + WS_MIXED);
    const float* wps = A.in[11]; const float* wpf = A.in[12];
    naive_gemm(ldsf, T, DM, 2048, 1024,
        [=](int m, int k) { return bf2f(MIXIN[(size_t)m * 2048 + k]); },
        [=](int k, int n) { return k < 1024 ? wps[(size_t)k * DM + n] : wpf[(size_t)(k - 1024) * DM + n]; },
        [=](int m, int n, float s1, float s2) { MIXED[(size_t)m * DM + n] = f2bf(bf2f(G[(size_t)m * 4096 + n]) * s1 + bf2f(G[(size_t)m * 4096 + 2048 + n]) * s2); });
}
__device__ __forceinline__ void p4_naive(const Args& A, float* ldsf) {
    const bf16_t* MIXED = (const bf16_t*)(A.ws + WS_MIXED); const float* wo = A.in[13]; const float* x = A.in[0]; float* X1 = A.out;
    naive_gemm(ldsf, T, DM, DM, DM,
        [=](int m, int k) { return bf2f(MIXED[(size_t)m * DM + k]); },
        [=](int k, int n) { return wo[(size_t)k * DM + n]; },
        [=](int m, int n, float s, float) { X1[(size_t)m * DM + n] = x[(size_t)m * DM + n] + s; });
}

template <int ALT> __device__ __forceinline__ void p5_router(const Args& A, float* ldsf) {
    const float* X1 = A.out; const float* g2 = A.in[14]; const float* wrg = A.in[15]; const float* brg = A.in[16]; const float* wre = A.in[17]; const float* bre = A.in[18];
    bf16_t* H2 = (bf16_t*)(A.ws + WS_H2); unsigned* cnt = (unsigned*)(A.ws + WS_CTL) + CW_CNT + (ALT ? 2048 : 0);
    int* TOK = (int*)(A.ws + (ALT ? WS_H : WS_TOK)); float* GATE = (float*)(A.ws + (ALT ? WS_H + 2 * MiB : WS_GATE)); int* ASG = (int*)(A.ws + (ALT ? WS_H + 4 * MiB : WS_ASG));
    const int tid = threadIdx.x, lane = tid & 63, wave = tid >> 6, r = tid >> 4, ks = tid & 15;
    float* Ws = ldsf;
    float* Xs = ldsf + 256 * 36;
    float* rs = Xs + 32 * 260;
    int* hist = (int*)(rs + 32);
    int* hbase = hist + 32;
    int* sel = hbase + 32;
    int* lpos = sel + 64;
    float* selw = (float*)(lpos + 64);
    for (int rb = blockIdx.x; rb < T / 32; rb += gridDim.x) {
        const int row0 = rb * 32;
        for (int i = 0; i < 4; ++i) { const int rr = wave * 4 + i; const f32x4* xr = (const f32x4*)(X1 + (size_t)(row0 + rr) * DM) + lane; float ss = 0.f;
#pragma unroll
            for (int j = 0; j < 8; ++j) { const f32x4 v = xr[64 * j]; ss += v.x * v.x + v.y * v.y + v.z * v.z + v.w * v.w; }
            ss = wave_sum(ss); if (lane == 0) rs[rr] = rsqrtf(ss * (1.f / DM) + EPS); }
        if (tid < 32) hist[tid] = 0;
        __syncthreads();
        float acc[36];
#pragma unroll
        for (int j = 0; j < 36; ++j) acc[j] = 0.f;
        for (int k0 = 0; k0 < DM; k0 += 256) {
            for (int i = tid; i < 256 * 36; i += NTHREADS) { const int kk = i / 36, j = i % 36; Ws[i] = j < 4 ? wrg[(size_t)(k0 + kk) * 4 + j] : wre[(size_t)(k0 + kk) * 32 + j - 4]; }
            for (int i = tid; i < 32 * 256; i += NTHREADS) { const int rr = i >> 8, kk = i & 255; const float hv = X1[(size_t)(row0 + rr) * DM + k0 + kk] * rs[rr] * g2[k0 + kk];
                Xs[rr * 260 + kk] = hv; H2[(size_t)(row0 + rr) * DM + k0 + kk] = f2bf(hv); }
            __syncthreads();
            for (int kk = ks; kk < 256; kk += 16) { const float xv = Xs[r * 260 + kk]; const float* wr = Ws + kk * 36;
#pragma unroll
                for (int j = 0; j < 36; ++j) acc[j] = fmaf(xv, wr[j], acc[j]); }
            __syncthreads();
        }
#pragma unroll
        for (int j = 0; j < 36; ++j) { float v = acc[j]; v += __shfl_xor(v, 1); v += __shfl_xor(v, 2); v += __shfl_xor(v, 4); v += __shfl_xor(v, 8); acc[j] = v; }
        if (ks == 0) {
            float gl[4]; int grp = 0; float gm;
#pragma unroll
            for (int j = 0; j < 4; ++j) gl[j] = acc[j] + brg[j];
            gm = gl[0];
#pragma unroll
            for (int j = 1; j < 4; ++j) if (gl[j] > gm) { gm = gl[j]; grp = j; }
            float den = 0.f;
#pragma unroll
            for (int j = 0; j < 4; ++j) den += __expf(gl[j] - gm);
            const float pg = 1.f / den;
            float el[8];
#pragma unroll
            for (int j = 0; j < 8; ++j) { float v = 0.f;
#pragma unroll
                for (int g = 0; g < 4; ++g) if (g == grp) v = acc[4 + g * 8 + j] + bre[g * 8 + j];
                el[j] = v; }
            int i0 = 0; float v0 = el[0];
#pragma unroll
            for (int j = 1; j < 8; ++j) if (el[j] > v0) { v0 = el[j]; i0 = j; }
            int i1 = -1; float v1 = -INFINITY;
#pragma unroll
            for (int j = 0; j < 8; ++j) if (j != i0 && el[j] > v1) { v1 = el[j]; i1 = j; }
            const float e1 = __expf(v1 - v0); const float w0 = pg / (1.f + e1), w1 = pg * e1 / (1.f + e1);
            const int ea = grp * 8 + i0, eb = grp * 8 + i1;
            sel[r * 2] = ea; sel[r * 2 + 1] = eb; selw[r * 2] = w0; selw[r * 2 + 1] = w1;
            lpos[r * 2] = atomicAdd(&hist[ea], 1); lpos[r * 2 + 1] = atomicAdd(&hist[eb], 1);
        }
        __syncthreads();
        if (tid < 32) hbase[tid] = hist[tid] > 0 ? (int)atomicAdd(&cnt[(tid) * CNT_STRIDE], (unsigned)hist[tid]) : 0;
        __syncthreads();
        if (tid < 64) { const int e = sel[tid], pos = hbase[e] + lpos[tid]; const int tok = row0 + (tid >> 1);
            TOK[(size_t)e * T + pos] = tok; GATE[(size_t)e * T + pos] = selw[tid]; ASG[tok * 2 + (tid & 1)] = (e << 16) | pos; }
        __syncthreads();
    }
}

template <int ALT> __device__ __forceinline__ void p5_router2(const Args& A, float* ldsf) {
    const float* X1 = A.out; const float* g2 = A.in[14]; const float* wrg = A.in[15]; const float* brg = A.in[16]; const float* wre = A.in[17]; const float* bre = A.in[18];
    bf16_t* H2 = (bf16_t*)(A.ws + WS_H2); unsigned* cnt = (unsigned*)(A.ws + WS_CTL) + CW_CNT + (ALT ? 2048 : 0);
    int* TOK = (int*)(A.ws + (ALT ? WS_H : WS_TOK)); float* GATE = (float*)(A.ws + (ALT ? WS_H + 2 * MiB : WS_GATE)); int* ASG = (int*)(A.ws + (ALT ? WS_H + 4 * MiB : WS_ASG));
    const int tid = threadIdx.x, lane = tid & 63, wave = tid >> 6;
    constexpr int XP = 260, XB = 32 * XP, WP = 40, WB = 256 * WP;
    float* Xs = ldsf;
    float* Ws = ldsf + 2 * XB;
    float* misc = ldsf + 2 * XB + 2 * WB;
    float* rs = misc;
    float* lg = misc + 32;
    int* hist = (int*)(misc + 32 + 1280); int* hbase = hist + 32; int* sel = hbase + 32; int* lpos = sel + 64; float* selw = (float*)(lpos + 64);
    const int kh2 = lane >> 5, rp = (lane >> 1) & 15, cg = lane & 1;
    for (int rb = blockIdx.x; rb < T / 32; rb += gridDim.x) {
        const int row0 = rb * 32;
        float ssq[4] = {0.f, 0.f, 0.f, 0.f};
        float acc0[20], acc1[20];
#pragma unroll
        for (int j = 0; j < 20; ++j) { acc0[j] = 0.f; acc1[j] = 0.f; }
        if (tid < 32) hist[tid] = 0;
        f32x4 xr[4], wv[5], gv;
        for (int i = tid; i < 2 * 256; i += NTHREADS) *(f32x4*)(Ws + (i >> 8) * WB + (i & 255) * WP + 36) = (f32x4){0.f, 0.f, 0.f, 0.f};
#define R2_LOAD(k0) do { gv = *(const f32x4*)(g2 + (k0) + 4 * (tid & 63)); \
        _Pragma("unroll") for (int i = 0; i < 4; ++i) xr[i] = *(const f32x4*)(X1 + (size_t)(row0 + wave + 8 * i) * DM + (k0) + 4 * (tid & 63)); \
        _Pragma("unroll") for (int i = 0; i < 5; ++i) { const int idx = tid + i * 512; if (idx < 2304) { const int kk = idx / 9, j4 = idx - kk * 9; \
            wv[i] = j4 == 0 ? *(const f32x4*)(wrg + (size_t)((k0) + kk) * 4) : *(const f32x4*)(wre + (size_t)((k0) + kk) * 32 + 4 * (j4 - 1)); } } } while (0)
#define R2_STORE(buf) do { \
        _Pragma("unroll") for (int i = 0; i < 4; ++i) { ssq[i] += xr[i].x * xr[i].x + xr[i].y * xr[i].y + xr[i].z * xr[i].z + xr[i].w * xr[i].w; \
            *(f32x4*)(Xs + (buf) * XB + (wave + 8 * i) * XP + 4 * (tid & 63)) = xr[i] * gv; } \
        _Pragma("unroll") for (int i = 0; i < 5; ++i) { const int idx = tid + i * 512; if (idx < 2304) { const int kk = idx / 9, j4 = idx - kk * 9; *(f32x4*)(Ws + (buf) * WB + kk * WP + 4 * j4) = wv[i]; } } } while (0)
        R2_LOAD(0); R2_STORE(0);
        __syncthreads();
#pragma unroll 1
        for (int c = 0; c < 8; ++c) {
            const int buf = c & 1;
            if (c < 7) R2_LOAD((c + 1) * 256);
            const float* xa = Xs + buf * XB + (2 * rp) * XP + (wave * 2 + kh2) * 16; const float* wa = Ws + buf * WB + ((wave * 2 + kh2) * 16) * WP + 20 * cg;
#pragma unroll 1
            for (int k4 = 0; k4 < 4; ++k4) {
                const f32x4 x0 = *(const f32x4*)(xa + 4 * k4), x1 = *(const f32x4*)(xa + XP + 4 * k4);
#pragma unroll
                for (int kk = 0; kk < 4; ++kk) { const float* wr = wa + (4 * k4 + kk) * WP;
#pragma unroll
                    for (int j4 = 0; j4 < 5; ++j4) { const f32x4 w = *(const f32x4*)(wr + 4 * j4);
#pragma unroll
                        for (int e = 0; e < 4; ++e) { acc0[4 * j4 + e] = fmaf(x0[kk], w[e], acc0[4 * j4 + e]); acc1[4 * j4 + e] = fmaf(x1[kk], w[e], acc1[4 * j4 + e]); } }
                    asm volatile("" ::: "memory"); }
            }
            if (c < 7) R2_STORE(buf ^ 1);
            __syncthreads();
        }
#undef R2_LOAD
#undef R2_STORE
#pragma unroll
        for (int j = 0; j < 20; ++j) { acc0[j] += __shfl_xor(acc0[j], 32); acc1[j] += __shfl_xor(acc1[j], 32); }
        float* red = Xs;
        if (kh2 == 0) {
#pragma unroll
            for (int j = 0; j < 20; ++j) { red[(wave * 32 + 2 * rp) * 40 + 20 * cg + j] = acc0[j]; red[(wave * 32 + 2 * rp + 1) * 40 + 20 * cg + j] = acc1[j]; } }
#pragma unroll
        for (int i = 0; i < 4; ++i) { const float s = wave_sum(ssq[i]); if (lane == 0) rs[wave + 8 * i] = rsqrtf(s * (1.f / DM) + EPS); }
        __syncthreads();
        for (int i = tid; i < 32 * 40; i += NTHREADS) { float s = 0.f;
#pragma unroll
            for (int w = 0; w < 8; ++w) s += red[w * 1280 + i];
            lg[i] = s * rs[i / 40]; }
        __syncthreads();
#pragma unroll 1
        for (int i = 0; i < 4; ++i) { const int rr = wave + 8 * i; const float rstd = rs[rr]; const float* xp = X1 + (size_t)(row0 + rr) * DM; bf16_t* hp = H2 + (size_t)(row0 + rr) * DM;
#pragma unroll 2
            for (int j = 0; j < 8; ++j) { const int c0 = 256 * j + 4 * lane; const f32x4 v = *(const f32x4*)(xp + c0), g = *(const f32x4*)(g2 + c0);
                u32x2 o; o.x = pk2(v.x * rstd * g.x, v.y * rstd * g.y); o.y = pk2(v.z * rstd * g.z, v.w * rstd * g.w); *(u32x2*)(hp + c0) = o; } }
        if (tid < 32) {
            const int r = tid; const float* L = lg + r * 40;
            float gl[4]; int grp = 0;
#pragma unroll
            for (int j = 0; j < 4; ++j) gl[j] = L[j] + brg[j];
            float gm = gl[0];
#pragma unroll
            for (int j = 1; j < 4; ++j) if (gl[j] > gm) { gm = gl[j]; grp = j; }
            float den = 0.f;
#pragma unroll
            for (int j = 0; j < 4; ++j) den += __expf(gl[j] - gm);
            const float pg = 1.f / den;
            float el[8];
#pragma unroll
            for (int j = 0; j < 8; ++j) el[j] = L[4 + grp * 8 + j] + bre[grp * 8 + j];
            int i0 = 0; float v0 = el[0];
#pragma unroll
            for (int j = 1; j < 8; ++j) if (el[j] > v0) { v0 = el[j]; i0 = j; }
            int i1 = -1; float v1 = -INFINITY;
#pragma unroll
            for (int j = 0; j < 8; ++j) if (j != i0 && el[j] > v1) { v1 = el[j]; i1 = j; }
            const float e1 = __expf(v1 - v0); const float w0 = pg / (1.f + e1), w1 = pg * e1 / (1.f + e1);
            const int ea = grp * 8 + i0, eb = grp * 8 + i1;
            sel[r * 2] = ea; sel[r * 2 + 1] = eb; selw[r * 2] = w0; selw[r * 2 + 1] = w1;
            lpos[r * 2] = atomicAdd(&hist[ea], 1); lpos[r * 2 + 1] = atomicAdd(&hist[eb], 1);
        }
        __syncthreads();
        if (tid < 32) hbase[tid] = hist[tid] > 0 ? (int)atomicAdd(&cnt[(tid) * CNT_STRIDE], (unsigned)hist[tid]) : 0;
        __syncthreads();
        if (tid < 64) { const int e = sel[tid], pos = hbase[e] + lpos[tid]; const int tok = row0 + (tid >> 1);
            TOK[(size_t)e * T + pos] = tok; GATE[(size_t)e * T + pos] = selw[tid]; ASG[tok * 2 + (tid & 1)] = (e << 16) | pos; }
        __syncthreads();
    }
}

constexpr size_t WS_WR = 7 * MiB;
__device__ __forceinline__ void p0_router_weights(const Args& A) {
    const float* g2 = A.in[14]; const float* wrg = A.in[15]; const float* wre = A.in[17]; bf16_t* WR = (bf16_t*)(A.ws + WS_WR);
    for (int i = blockIdx.x * NTHREADS + threadIdx.x; i < 64 * DM; i += gridDim.x * NTHREADS) { const int n = i >> 11, k = i & (DM - 1);
        const float w = n < 4 ? wrg[(size_t)k * 4 + n] * g2[k] : (n < 36 ? wre[(size_t)k * 32 + n - 4] * g2[k] : 0.f);
        const bf16_t h = f2bf(w); WR[i] = h; WR[64 * DM + i] = f2bf(w - bf2f(h)); }
}
constexpr size_t WS_RSTL = WS_CKL;
template <int ALT> __device__ __forceinline__ void p5_router3(const Args& A, float* ldsf) {
    float* RSTL = (float*)(A.ws + (ALT ? WS_H + 6 * MiB : WS_RSTL));
    typedef short bf16x8 __attribute__((ext_vector_type(8))); typedef float f32x16 __attribute__((ext_vector_type(16)));
    const float* X1 = A.out; const float* g2 = A.in[14]; const float* brg = A.in[16]; const float* bre = A.in[18]; const bf16_t* WR = (const bf16_t*)(A.ws + WS_WR);
    bf16_t* H2 = (bf16_t*)(A.ws + WS_H2); unsigned* cnt = (unsigned*)(A.ws + WS_CTL) + CW_CNT + (ALT ? 2048 : 0);
    int* TOK = (int*)(A.ws + (ALT ? WS_H : WS_TOK)); float* GATE = (float*)(A.ws + (ALT ? WS_H + 2 * MiB : WS_GATE)); int* ASG = (int*)(A.ws + (ALT ? WS_H + 4 * MiB : WS_ASG));
    const int tid = threadIdx.x, lane = tid & 63, wave = tid >> 6, r32 = lane & 31, hi = lane >> 5;
    float* red = ldsf;
    float* lg = ldsf + 16384;
    float* sq = lg + 2048;
    float* rs = sq + 256;
    int* hist = (int*)(rs + 32); int* hbase = hist + 32; int* sel = hbase + 32; int* lpos = sel + 64; float* selw = (float*)(lpos + 64);
    for (int rb = blockIdx.x; rb < T / 32; rb += gridDim.x) {
        const int row0 = rb * 32;
        if (tid < 32) hist[tid] = 0;
        const float* xp = X1 + (size_t)(row0 + r32) * DM + 256 * wave + 8 * hi;
        const bf16_t* wp = WR + (size_t)r32 * DM + 256 * wave + 8 * hi;
        f32x16 acc[2];
#pragma unroll
        for (int j = 0; j < 2; ++j)
#pragma unroll
            for (int r = 0; r < 16; ++r) acc[j][r] = 0.f;
        float ssq = 0.f;
        f32x4 xa[4], xb[4], xna[4], xnb[4];
#pragma unroll
        for (int i = 0; i < 4; ++i) { xa[i] = *(const f32x4*)(xp + 16 * i); xb[i] = *(const f32x4*)(xp + 16 * i + 4); }
#pragma unroll 1
        for (int kb = 0; kb < (ALT == 3 ? 0 : 4); ++kb) {
            bf16x8 wh0[4], wh1[4], wl0[4], wl1[4]; f32x4 ga[4], gb[4];
#pragma unroll
            for (int i = 0; i < 4; ++i) { const int ko = 64 * kb + 16 * i;
                wh0[i] = *(const bf16x8*)(wp + ko); wh1[i] = *(const bf16x8*)(wp + (size_t)32 * DM + ko); wl0[i] = *(const bf16x8*)(wp + (size_t)64 * DM + ko); wl1[i] = *(const bf16x8*)(wp + (size_t)96 * DM + ko);
                ga[i] = *(const f32x4*)(g2 + 256 * wave + 8 * hi + ko); gb[i] = *(const f32x4*)(g2 + 256 * wave + 8 * hi + ko + 4); }
            asm volatile("" ::: "memory");
            if (kb < 3) {
#pragma unroll
                for (int i = 0; i < 4; ++i) { xna[i] = *(const f32x4*)(xp + 64 * (kb + 1) + 16 * i); xnb[i] = *(const f32x4*)(xp + 64 * (kb + 1) + 16 * i + 4); } }
            asm volatile("" ::: "memory");
#pragma unroll
            for (int i = 0; i < 4; ++i) { const int ko = 64 * kb + 16 * i;
                { u32x4 hw; hw.x = cvtpk_rne(xa[i][0] * ga[i][0], xa[i][1] * ga[i][1]); hw.y = cvtpk_rne(xa[i][2] * ga[i][2], xa[i][3] * ga[i][3]); hw.z = cvtpk_rne(xb[i][0] * gb[i][0], xb[i][1] * gb[i][1]); hw.w = cvtpk_rne(xb[i][2] * gb[i][2], xb[i][3] * gb[i][3]);
                  *(u32x4*)(H2 + (size_t)(row0 + r32) * DM + 256 * wave + 8 * hi + ko) = hw; }
                float xv[8] = {xa[i][0], xa[i][1], xa[i][2], xa[i][3], xb[i][0], xb[i][1], xb[i][2], xb[i][3]}; u32x4 ph, pl;
#pragma unroll
                for (int e = 0; e < 4; ++e) { const float a = xv[2 * e], b2 = xv[2 * e + 1]; ssq += a * a + b2 * b2; const unsigned hh = cvtpk_rne(a, b2); ph[e] = hh;
                    pl[e] = cvtpk_rne(a - __uint_as_float(hh << 16), b2 - __uint_as_float(hh & 0xffff0000u)); }
                const bf16x8 xh = __builtin_bit_cast(bf16x8, ph), xl = __builtin_bit_cast(bf16x8, pl);
                acc[0] = __builtin_amdgcn_mfma_f32_32x32x16_bf16(xh, wh0[i], acc[0], 0, 0, 0); acc[0] = __builtin_amdgcn_mfma_f32_32x32x16_bf16(xl, wh0[i], acc[0], 0, 0, 0); acc[0] = __builtin_amdgcn_mfma_f32_32x32x16_bf16(xh, wl0[i], acc[0], 0, 0, 0);
                acc[1] = __builtin_amdgcn_mfma_f32_32x32x16_bf16(xh, wh1[i], acc[1], 0, 0, 0); acc[1] = __builtin_amdgcn_mfma_f32_32x32x16_bf16(xl, wh1[i], acc[1], 0, 0, 0); acc[1] = __builtin_amdgcn_mfma_f32_32x32x16_bf16(xh, wl1[i], acc[1], 0, 0, 0); }
#pragma unroll
            for (int i = 0; i < 4; ++i) { xa[i] = xna[i]; xb[i] = xnb[i]; }
        }
#pragma unroll
        for (int j = 0; j < 2; ++j)
#pragma unroll
            for (int r = 0; r < 16; ++r) red[((wave * 2 + j) * 16 + r) * 64 + lane] = acc[j][r];
        ssq += __shfl_xor(ssq, 32);
        if (hi == 0) sq[wave * 32 + r32] = ssq;
        __syncthreads();
        if (ALT == 2) continue;
#pragma unroll
        for (int j = 0; j < 2; ++j)
#pragma unroll
            for (int rr = 0; rr < 2; ++rr) { const int r = 2 * wave + rr; float s = 0.f;
#pragma unroll
                for (int w2 = 0; w2 < 8; ++w2) s += red[((w2 * 2 + j) * 16 + r) * 64 + lane];
                lg[((r & 3) + 8 * (r >> 2) + 4 * hi) * 64 + 32 * j + r32] = s; }
        if (tid < 32) { float s = 0.f;
#pragma unroll
            for (int w2 = 0; w2 < 8; ++w2) s += sq[w2 * 32 + tid];
            rs[tid] = rsqrtf(s * (1.f / DM) + EPS); }
        __syncthreads();
        if (tid < 32) {
            const int r = tid; const float* L = lg + r * 64; const float rstd = rs[r];
            float gl[4]; int grp = 0;
#pragma unroll
            for (int j = 0; j < 4; ++j) gl[j] = L[j] * rstd + brg[j];
            float gm = gl[0];
#pragma unroll
            for (int j = 1; j < 4; ++j) if (gl[j] > gm) { gm = gl[j]; grp = j; }
            float den = 0.f;
#pragma unroll
            for (int j = 0; j < 4; ++j) den += __expf(gl[j] - gm);
            const float pg = 1.f / den;
            float el[8];
#pragma unroll
            for (int j = 0; j < 8; ++j) el[j] = L[4 + grp * 8 + j] * rstd + bre[grp * 8 + j];
            int i0 = 0; float v0 = el[0];
#pragma unroll
            for (int j = 1; j < 8; ++j) if (el[j] > v0) { v0 = el[j]; i0 = j; }
            int i1 = -1; float v1 = -INFINITY;
#pragma unroll
            for (int j = 0; j < 8; ++j) if (j != i0 && el[j] > v1) { v1 = el[j]; i1 = j; }
            const float e1 = __expf(v1 - v0); const float w0 = pg / (1.f + e1), w1 = pg * e1 / (1.f + e1);
            const int ea = grp * 8 + i0, eb = grp * 8 + i1;
            sel[r * 2] = ea; sel[r * 2 + 1] = eb; selw[r * 2] = w0; selw[r * 2 + 1] = w1;
            lpos[r * 2] = atomicAdd(&hist[ea], 1); lpos[r * 2 + 1] = atomicAdd(&hist[eb], 1);
        }
        __syncthreads();
        if (tid < 32) hbase[tid] = hist[tid] > 0 ? (int)atomicAdd(&cnt[(tid) * CNT_STRIDE], (unsigned)hist[tid]) : 0;
        __syncthreads();
        if (tid < 64) { const int e = sel[tid], pos = hbase[e] + lpos[tid]; const int tok = row0 + (tid >> 1);
            TOK[(size_t)e * T + pos] = tok; GATE[(size_t)e * T + pos] = selw[tid]; RSTL[(size_t)e * T + pos] = rs[tid >> 1]; ASG[tok * 2 + (tid & 1)] = (e << 16) | pos; }
        __syncthreads();
    }
}

__device__ __forceinline__ void expert_layout(const unsigned* cnt, int* pstart  ) {
    int acc = 0;
    for (int e = 0; e < NEXP; ++e) { pstart[e] = acc; acc += ((int)cnt[(e) * CNT_STRIDE] + MTILE - 1) / MTILE * MTILE; }
    pstart[NEXP] = acc;
}

__device__ __forceinline__ void p6_naive(const Args& A, float* ldsf) {
    const bf16_t* H2 = (const bf16_t*)(A.ws + WS_H2); const float* wg = A.in[19]; const float* wu = A.in[20]; bf16_t* ACT = (bf16_t*)(A.ws + WS_ACT);
    const unsigned* cnt = (const unsigned*)(A.ws + WS_CTL) + CW_CNT; const int* TOK = (const int*)(A.ws + WS_TOK);
    int* ps = (int*)(ldsf + 2 * 16 * 132);
    if (threadIdx.x == 0) expert_layout(cnt, ps);
    __syncthreads();
    int ntot = 0;
    for (int e = 0; e < NEXP; ++e) ntot += (((int)cnt[(e) * CNT_STRIDE] + 127) / 128) * 4;
    for (int t = blockIdx.x; t < ntot; t += gridDim.x) {
        int e = 0, rem = t;
        for (; e < NEXP; ++e) { const int n = (((int)cnt[(e) * CNT_STRIDE] + 127) / 128) * 4; if (rem < n) break; rem -= n; }
        const int c = (int)cnt[(e) * CNT_STRIDE]; const int tm = rem / 4, tn = rem % 4; const int* tl = TOK + (size_t)e * T; const int prow = ps[e];
        const float* wge = wg + (size_t)e * DM * DEXP; const float* wue = wu + (size_t)e * DM * DEXP;
        naive_gemm_tile(ldsf, tm * 128, tn * 128, c, DEXP, 2 * DM, DM,
            [=](int m, int k) { return bf2f(H2[(size_t)tl[m] * DM + (k & (DM - 1))]); },
            [=](int k, int n) { return k < DM ? wge[(size_t)k * DEXP + n] : wue[(size_t)(k - DM) * DEXP + n]; },
            [=](int m, int n, float sg, float su) { ACT[(size_t)(prow + m) * DEXP + n] = f2bf(sg / (1.f + __expf(-sg)) * su); });
    }
}
__device__ __forceinline__ void p7_naive(const Args& A, float* ldsf) {
    const bf16_t* ACT = (const bf16_t*)(A.ws + WS_ACT); const float* wd = A.in[21]; bf16_t* YBUF = (bf16_t*)(A.ws + WS_YBUF);
    const unsigned* cnt = (const unsigned*)(A.ws + WS_CTL) + CW_CNT; const float* GATE = (const float*)(A.ws + WS_GATE);
    int* ps = (int*)(ldsf + 2 * 16 * 132);
    if (threadIdx.x == 0) expert_layout(cnt, ps);
    __syncthreads();
    int ntot = 0;
    for (int e = 0; e < NEXP; ++e) ntot += (((int)cnt[(e) * CNT_STRIDE] + 127) / 128) * 16;
    for (int t = blockIdx.x; t < ntot; t += gridDim.x) {
        int e = 0, rem = t;
        for (; e < NEXP; ++e) { const int n = (((int)cnt[(e) * CNT_STRIDE] + 127) / 128) * 16; if (rem < n) break; rem -= n; }
        const int c = (int)cnt[(e) * CNT_STRIDE]; const int tm = rem / 16, tn = rem % 16; const float* gl = GATE + (size_t)e * T; const int prow = ps[e];
        const float* wde = wd + (size_t)e * DEXP * DM;
        naive_gemm_tile(ldsf, tm * 128, tn * 128, c, DM, DEXP, DEXP,
            [=](int m, int k) { return bf2f(ACT[(size_t)(prow + m) * DEXP + k]); },
            [=](int k, int n) { return wde[(size_t)k * DM + n]; },
            [=](int m, int n, float s, float) { YBUF[(size_t)(prow + m) * DM + n] = f2bf(s * gl[m]); });
    }
}

template <int ALT> __device__ __forceinline__ void p8_combine(const Args& A, float* ldsf, const float dlt = 0.f) {
    float* X1 = A.out; float* XO = ALT ? (float*)(A.ws + WS_WGU) : A.out; const bf16_t* YBUF = (const bf16_t*)(A.ws + WS_YBUF); const int* ASG = (const int*)(A.ws + WS_ASG);
    const unsigned* cnt = (const unsigned*)(A.ws + WS_CTL) + CW_CNT;
    int* ps = (int*)ldsf;
    if (threadIdx.x == 0) expert_layout(cnt, ps);
    __syncthreads();
    float dl2 = dlt;
    if (STAMP_PHASE == 97) { int v = 0, mx = 0, mn = 1 << 30, nt_ = 0, tiny = 0, half = 0; for (int e = 0; e < NEXP; ++e) { const int c = (int)cnt[(e) * CNT_STRIDE]; mx = c > mx ? c : mx; mn = c < mn ? c : mn; nt_ += (c + 255) / 256; const int rem = c % 256; tiny += (rem > 0 && rem <= 64) ? 1 : 0; half += (rem > 0 && rem <= 128) ? 1 : 0; }
        v = STAMP_SEL == 0 ? nt_ : STAMP_SEL == 1 ? mx : STAMP_SEL == 2 ? mn : STAMP_SEL == 3 ? tiny : half; dl2 = 0.01f * (float)v; }
    const int tid = threadIdx.x, lane = tid & 63, wave = tid >> 6;
    const int gw = blockIdx.x * NWAVES + wave, NGW = gridDim.x * NWAVES;
    for (int row = gw; row < T; row += NGW) {
        const int a0 = ASG[row * 2], a1 = ASG[row * 2 + 1];
        const bf16_t* y0 = YBUF + (size_t)(ps[a0 >> 16] + (a0 & 0xffff)) * DM; const bf16_t* y1 = YBUF + (size_t)(ps[a1 >> 16] + (a1 & 0xffff)) * DM;
        const float* xr = X1 + (size_t)row * DM; float* xo = XO + (size_t)row * DM;
        u32x4 w0[4], w1[4]; f32x4 xa[4], xb[4];
#pragma unroll
        for (int j = 0; j < 4; ++j) { const int c0 = 512 * j + 8 * lane; w0[j] = *(const u32x4*)(y0 + c0); w1[j] = *(const u32x4*)(y1 + c0); xa[j] = *(const f32x4*)(xr + c0); xb[j] = *(const f32x4*)(xr + c0 + 4); }
#pragma unroll
        for (int j = 0; j < 4; ++j) { const int c0 = 512 * j + 8 * lane; f32x4 a = xa[j], b2 = xb[j];
            a.x += __uint_as_float(w0[j][0] << 16) + __uint_as_float(w1[j][0] << 16); a.y += __uint_as_float(w0[j][0] & 0xffff0000u) + __uint_as_float(w1[j][0] & 0xffff0000u);
            a.z += __uint_as_float(w0[j][1] << 16) + __uint_as_float(w1[j][1] << 16); a.w += __uint_as_float(w0[j][1] & 0xffff0000u) + __uint_as_float(w1[j][1] & 0xffff0000u);
            b2.x += __uint_as_float(w0[j][2] << 16) + __uint_as_float(w1[j][2] << 16); b2.y += __uint_as_float(w0[j][2] & 0xffff0000u) + __uint_as_float(w1[j][2] & 0xffff0000u);
            b2.z += __uint_as_float(w0[j][3] << 16) + __uint_as_float(w1[j][3] << 16); b2.w += __uint_as_float(w0[j][3] & 0xffff0000u) + __uint_as_float(w1[j][3] & 0xffff0000u);
            if (STAMP_PHASE >= 0) { a += dl2; b2 += dl2; }
            *(f32x4*)(xo + c0) = a; *(f32x4*)(xo + c0 + 4) = b2; }
    }
}

namespace pg8 {
#define PG8_LAS __attribute__((address_space(3)))
typedef short bf16x8 __attribute__((ext_vector_type(8)));
constexpr int BM = 256, BK = 64, HALF = 128, HTB = HALF * BK * 2, STAGE_BYTES = 8 * HTB, NXCD = 8, WGM = 8;
__host__ __device__ __forceinline__ int lds_byte(int r, int c) { const int st = (r >> 4) * 2 + (c >> 5), rr = r & 15, cc = c & 31, ob = rr * 64 + cc * 2; return st * 1024 + (ob ^ (((ob >> 9) & 1) << 5)); }
__host__ __device__ __forceinline__ void stage_rc(int b, int& R, int& C) { const int st = b / 1024, sb = b % 1024, swz = sb ^ (((sb >> 9) & 1) << 5); R = (st >> 1) * 16 + swz / 64; C = (st & 1) * 32 + (swz % 64) / 2; }
__host__ __device__ __forceinline__ int perm32(int rho) { const int n = rho >> 4, i = rho & 15; return 8 * (i >> 2) + 4 * n + (i & 3); }

struct Unit { const char* A; const char* B; int pm, pn, x0, x1, x2, x3; };

struct DenseOrder {
    const char* A; const char* Bt; int K, nM, nN, nwg, G, c;
    __device__ void init(const void* A_, const void* Bt_, int M, int N, int K_, int G_, int c_) { A = (const char*)A_; Bt = (const char*)Bt_; K = K_; nM = M / BM; nN = N / BM; nwg = nM * nN; G = G_; c = c_; }
    __device__ bool next(int i, Unit& u) const {
        const long L = (long)i * G + c; if (L >= nwg) return false;
        int wgid = (int)L; { const int q = nwg / NXCD, r = nwg % NXCD, xcd = wgid % NXCD, off = wgid / NXCD; wgid = (xcd < r ? xcd * (q + 1) : r * (q + 1) + (xcd - r) * q) + off; }
        const int nig = WGM * nN, gid = wgid / nig, fm = gid * WGM, gsz = (nM - fm) < WGM ? (nM - fm) : WGM;
        u.pm = fm + ((wgid % nig) % gsz); u.pn = (wgid % nig) / gsz; u.x0 = 0; u.x1 = 0; u.x2 = 0; u.x3 = 0;
        u.A = A + (size_t)u.pm * BM * K * 2; u.B = Bt + (size_t)u.pn * BM * K * 2; return true;
    }
    __device__ __forceinline__ void rows(const Unit&, unsigned (&)[2][2], const int (&)[2]) const {}
};

__device__ __forceinline__ unsigned cvt_pk_bf16(float lo, float hi) { unsigned r; asm volatile("v_cvt_pk_bf16_f32 %0, %1, %2" : "=v"(r) : "v"(lo), "v"(hi)); return r; }

template <class Epi, class Sched, bool ALIGN_EPI, bool GATHER, bool SKIP = false>
__device__ __forceinline__ void gemm_phase(PG8_LAS unsigned char* lds, const int K, const Sched& S, const Epi& E) {
    const int tid = threadIdx.x, wid = __builtin_amdgcn_readfirstlane(tid >> 6), lane = tid & 63, wr = wid >> 2, wc = wid & 3, fr = lane & 15, fq = lane >> 4;
    const int nt = K / BK;
    unsigned voffA[2], voffB[2]; int RA[2];
#pragma unroll
    for (int i = 0; i < 2; ++i) { int R, C; stage_rc(tid * 16 + i * 8192, R, C); const int Rb = Epi::PERM ? ((R & ~31) + perm32(R & 31)) : R;
        voffA[i] = GATHER ? (unsigned)(C * 2) : (unsigned)(R * K + C) * 2u; voffB[i] = (unsigned)(Rb * K + C) * 2u; RA[i] = R; }
    const size_t kstep = (size_t)(BK * 2);
    const size_t hstep = (size_t)HALF * K * 2;
    const size_t hstepA = GATHER ? 0 : hstep;
    const unsigned ldsw = (unsigned)wid * 1024u;
    const int aoff = lds_byte(wr * 64 + fr, fq * 8), boff = lds_byte(wc * 32 + fr, fq * 8);
    unsigned gA[2][2], gAn[2][2];
#define PG8_SA(b, h) (((b) * 2 + (h)) * HTB)
#define PG8_SB(b, h) ((4 + (b) * 2 + (h)) * HTB)
#define PG8_STAGE(bufoff, gbase, voff) do { _Pragma("unroll") for (int _i = 0; _i < 2; ++_i) \
        __builtin_amdgcn_global_load_lds((const unsigned*)((const char*)(gbase) + (voff)[_i]), (PG8_LAS unsigned*)(lds + (bufoff) + ldsw + _i * 8192), 16, 0, 0); } while (0)
#define PG8_STAGE_A(bufoff, gbase, h, nx) do { _Pragma("unroll") for (int _i = 0; _i < 2; ++_i) { \
        const unsigned _o = GATHER ? ((nx) ? gAn[h][_i] : gA[h][_i]) + voffA[_i] : voffA[_i]; \
        __builtin_amdgcn_global_load_lds((const unsigned*)((const char*)(gbase) + (h) * hstepA + _o), (PG8_LAS unsigned*)(lds + (bufoff) + ldsw + _i * 8192), 16, 0, 0); } } while (0)
#define PG8_LDA(dst, b, h) do { _Pragma("unroll") for (int m = 0; m < 4; ++m) _Pragma("unroll") for (int k = 0; k < 2; ++k) dst[m][k] = *(const PG8_LAS bf16x8*)(lds + PG8_SA(b, h) + aoff + m * 2048 + k * 1024); } while (0)
#define PG8_LDB(dst, b, h) do { _Pragma("unroll") for (int n = 0; n < 2; ++n) _Pragma("unroll") for (int k = 0; k < 2; ++k) dst[n][k] = *(const PG8_LAS bf16x8*)(lds + PG8_SB(b, h) + boff + n * 2048 + k * 1024); } while (0)
#define PG8_MMA(ai, bj, At, Bt) do { __builtin_amdgcn_s_setprio(1); _Pragma("unroll") for (int m = 0; m < 4; ++m) { if (!SKIP || m < ((ai) == 0 ? mc0 : mc1)) { _Pragma("unroll") for (int n = 0; n < 2; ++n) _Pragma("unroll") for (int k = 0; k < 2; ++k) \
        acc[ai][bj][m][n] = __builtin_amdgcn_mfma_f32_16x16x32_bf16(Bt[n][k], At[m][k], acc[ai][bj][m][n], 0, 0, 0); } } __builtin_amdgcn_s_setprio(0); } while (0)
#define PG8_WAIT_V(n) asm volatile("s_waitcnt vmcnt(" #n ")" ::: "memory")
#define PG8_WAIT_L(n) asm volatile("s_waitcnt lgkmcnt(" #n ")" ::: "memory")
#define PG8_BAR __builtin_amdgcn_s_barrier()
#define PG8_SCHED __builtin_amdgcn_sched_barrier(0)
    Unit cur, nxt; int ui = 0;
    if (!S.next(0, cur)) return;
    int mc0 = 4, mc1 = 4;
#define PG8_MC(u) do { if (SKIP) { const int a_ = ((u).x2 - 64 * wr + 15) >> 4, b_ = ((u).x2 - 128 - 64 * wr + 15) >> 4; mc0 = a_ < 0 ? 0 : (a_ > 4 ? 4 : a_); mc1 = b_ < 0 ? 0 : (b_ > 4 ? 4 : b_); } } while (0)
    PG8_MC(cur);
    f32x4 acc[2][2][4][2];
#pragma unroll
    for (int a = 0; a < 2; ++a)
#pragma unroll
        for (int b = 0; b < 2; ++b)
#pragma unroll
            for (int m = 0; m < 4; ++m)
#pragma unroll
                for (int n = 0; n < 2; ++n) acc[a][b][m][n] = (f32x4){0.f, 0.f, 0.f, 0.f};
    bf16x8 At[4][2], B0[2][2], B1[2][2];
    const char* cA = cur.A; const char* cB = cur.B;
    if constexpr (GATHER) { S.rows(cur, gA, RA);
#pragma unroll
        for (int h = 0; h < 2; ++h)
#pragma unroll
            for (int i = 0; i < 2; ++i) gAn[h][i] = gA[h][i]; }
    PG8_STAGE(PG8_SB(0, 0), cB, voffB); PG8_STAGE(PG8_SB(0, 1), cB + hstep, voffB); PG8_STAGE_A(PG8_SA(0, 0), cA, 0, false); PG8_STAGE_A(PG8_SA(0, 1), cA, 1, false);
    if (wr == 1) PG8_BAR;
    PG8_WAIT_V(2); PG8_BAR;
    PG8_STAGE(PG8_SB(1, 0), cB + kstep, voffB); PG8_STAGE_A(PG8_SA(1, 0), cA + kstep, 0, false); PG8_STAGE(PG8_SB(1, 1), cB + hstep + kstep, voffB);
    PG8_WAIT_V(6); PG8_BAR;
    for (;;) {
        const bool has_next = S.next(ui + 1, nxt);
        const char* nA = has_next ? nxt.A : cA; const char* nB = has_next ? nxt.B : cB;
        if constexpr (GATHER) { if (has_next) { S.rows(nxt, gAn, RA); } }
        for (int t = 0; t < nt; t += 2) {
            const bool last = (t == nt - 2);
            const char* a1 = cA + (size_t)(t + 1) * kstep;
            const char* a2 = last ? nA : cA + (size_t)(t + 2) * kstep; const char* b2 = last ? nB : cB + (size_t)(t + 2) * kstep;
            const char* a3 = a2 + kstep; const char* b3 = b2 + kstep;
            if constexpr (Epi::HAS_MID) { if (t == nt / 2) { int frl = fr, fql = fq; asm volatile("" : "+v"(frl), "+v"(fql)); E.mid(acc, cur, wr, wc, frl, fql); } }
            PG8_LDB(B0, 0, 0); PG8_LDB(B1, 0, 1); PG8_SCHED; PG8_LDA(At, 0, 0); PG8_STAGE_A(PG8_SA(1, 1), a1, 1, false);
            PG8_WAIT_V(8); PG8_WAIT_L(0); PG8_BAR; PG8_MMA(0, 0, At, B0); PG8_MMA(0, 1, At, B1); PG8_BAR; PG8_SCHED;
            PG8_LDA(At, 0, 1); PG8_STAGE(PG8_SB(0, 0), b2, voffB); PG8_STAGE(PG8_SB(0, 1), b2 + hstep, voffB); PG8_STAGE_A(PG8_SA(0, 0), a2, 0, last);
            PG8_WAIT_V(8); PG8_WAIT_L(0); PG8_BAR; PG8_MMA(1, 0, At, B0); PG8_MMA(1, 1, At, B1); PG8_BAR; PG8_SCHED;
            PG8_LDB(B0, 1, 0); PG8_LDB(B1, 1, 1); PG8_SCHED; PG8_LDA(At, 1, 0); PG8_STAGE_A(PG8_SA(0, 1), a2, 1, last);
            PG8_WAIT_V(8); PG8_WAIT_L(0); PG8_BAR; PG8_MMA(0, 0, At, B0); PG8_MMA(0, 1, At, B1); PG8_BAR; PG8_SCHED;
            PG8_LDA(At, 1, 1); PG8_STAGE(PG8_SB(1, 0), b3, voffB); PG8_STAGE(PG8_SB(1, 1), b3 + hstep, voffB); PG8_STAGE_A(PG8_SA(1, 0), a3, 0, last);
            PG8_WAIT_V(8); PG8_WAIT_L(0); PG8_BAR; PG8_MMA(1, 0, At, B0); PG8_MMA(1, 1, At, B1); PG8_BAR; PG8_SCHED;
        }
        if constexpr (ALIGN_EPI) { if (wr == 0) PG8_BAR; }
        { int frl = fr, fql = fq; asm volatile("" : "+v"(frl), "+v"(fql)); E(acc, cur, wr, wc, frl, fql); }
        if (!has_next) break;
#pragma unroll
        for (int a = 0; a < 2; ++a)
#pragma unroll
            for (int b = 0; b < 2; ++b)
#pragma unroll
                for (int m = 0; m < 4; ++m)
#pragma unroll
                    for (int n = 0; n < 2; ++n) acc[a][b][m][n] = (f32x4){0.f, 0.f, 0.f, 0.f};
        cur = nxt; cA = nA; cB = nB; ++ui; PG8_MC(cur);
        if constexpr (GATHER) {
#pragma unroll
            for (int h = 0; h < 2; ++h)
#pragma unroll
                for (int i = 0; i < 2; ++i) gA[h][i] = gAn[h][i]; }
        if constexpr (ALIGN_EPI) { if (wr == 1) PG8_BAR; }
    }
    PG8_WAIT_V(0);
    if constexpr (!ALIGN_EPI) { if (wr == 0) PG8_BAR; }
    PG8_BAR;
#undef PG8_SA
#undef PG8_SB
#undef PG8_STAGE
#undef PG8_STAGE_A
#undef PG8_LDA
#undef PG8_LDB
#undef PG8_MMA
#undef PG8_WAIT_V
#undef PG8_WAIT_L
#undef PG8_BAR
#undef PG8_SCHED
#undef PG8_MC
}
}

constexpr int LDS_MISC_OFF = 131072;
__device__ __forceinline__ float fast_gelu(float x) { const float y = x + 0.044715f * x * x * x; return x * __builtin_amdgcn_rcpf(1.0f + __builtin_amdgcn_exp2f(-2.0f * 0.7978845608028654f * LOG2E * y)); }
__device__ __forceinline__ float fast_sigmoid(float x) { return __builtin_amdgcn_rcpf(1.0f + __builtin_amdgcn_exp2f(-LOG2E * x)); }
__device__ __forceinline__ void unpack8(const u32x4 w, float (&v)[8]) {
#pragma unroll
    for (int e = 0; e < 4; ++e) { v[2 * e] = __uint_as_float(w[e] << 16); v[2 * e + 1] = __uint_as_float(w[e] & 0xffff0000u); } }

constexpr size_t WS_VSTAT = 6 * MiB;
constexpr int LDS_EPI_OFF = 131072 + 4096;
struct EpiIn {
    static constexpr bool PERM = true, HAS_MID = false;
    bf16_t *U, *V, *Q, *K, *VA, *G; const float* b_gate; const float* qg; const float* kg; float* VSTAT; PG8_LAS unsigned char* lds;
    __device__ __forceinline__ void mid(f32x4 (&)[2][2][4][2], const pg8::Unit&, int, int, int, int) const {}
    __device__ __forceinline__ void operator()(f32x4 (&acc)[2][2][4][2], const pg8::Unit& u, int wr, int wc, int fr, int fq) const {
        const int pn = u.pn; bf16_t* base; int ld, colt, mode;
        if (pn < 4) { base = U; ld = 1024; colt = pn * 256; mode = 1; }
        else if (pn < 8) { base = V; ld = 1024; colt = (pn - 4) * 256; mode = 3; }
        else if (pn < 12) { base = Q; ld = 1024; colt = (pn - 8) * 256; mode = 4; }
        else if (pn < 16) { base = K; ld = 1024; colt = (pn - 12) * 256; mode = 5; }
        else if (pn < 20) { base = VA; ld = 1024; colt = (pn - 16) * 256; mode = 0; }
        else { base = G; ld = 4096; colt = (pn - 20) * 256; mode = 2; }
        const int row0 = u.pm * 256 + wr * 64 + fr, col0 = colt + wc * 32 + 8 * fq;
        if (mode >= 4) {
            PG8_LAS float* P = (PG8_LAS float*)(lds + LDS_EPI_OFF);
#pragma unroll
            for (int ai = 0; ai < 2; ++ai)
#pragma unroll
                for (int m = 0; m < 4; ++m)
#pragma unroll
                    for (int bj = 0; bj < 2; ++bj) { const f32x4 a = acc[ai][bj][m][0], b = acc[ai][bj][m][1];
                        float s = (a[0] * a[0] + a[1] * a[1]) + (a[2] * a[2] + a[3] * a[3]) + (b[0] * b[0] + b[1] * b[1]) + (b[2] * b[2] + b[3] * b[3]);
                        s += __shfl_xor(s, 16); s += __shfl_xor(s, 32);
                        if (fq == 0) P[((ai * 128 + wr * 64 + m * 16 + fr) * 2 + bj) * 4 + wc] = s; }
            asm volatile("s_waitcnt lgkmcnt(0)" ::: "memory"); __builtin_amdgcn_s_barrier(); asm volatile("" ::: "memory");
            const float* gg = mode == 4 ? qg : kg; const float qs = mode == 4 ? QSCALE : 1.0f;
            const f32x4 g0 = *(const f32x4*)(gg + wc * 32 + 8 * fq), g1 = *(const f32x4*)(gg + wc * 32 + 8 * fq + 4);
#pragma unroll
            for (int ai = 0; ai < 2; ++ai)
#pragma unroll
                for (int m = 0; m < 4; ++m) { bf16_t* rowp = base + (size_t)(row0 + ai * 128 + m * 16) * ld + col0;
#pragma unroll
                    for (int bj = 0; bj < 2; ++bj) { const f32x4 pp = *(const PG8_LAS f32x4*)(P + ((ai * 128 + wr * 64 + m * 16 + fr) * 2 + bj) * 4);
                        const float sc = rsqrtf(((pp[0] + pp[1]) + (pp[2] + pp[3])) * (1.f / 128.f) + EPS) * qs;
                        const f32x4 v0 = acc[ai][bj][m][0] * g0 * sc, v1 = acc[ai][bj][m][1] * g1 * sc;
                        u32x4 w; w.x = pg8::cvt_pk_bf16(v0[0], v0[1]); w.y = pg8::cvt_pk_bf16(v0[2], v0[3]); w.z = pg8::cvt_pk_bf16(v1[0], v1[1]); w.w = pg8::cvt_pk_bf16(v1[2], v1[3]);
                        *(u32x4*)(rowp + bj * 128) = w; } }
            return;
        }
        f32x4 bv[2][2];
#pragma unroll
        for (int bj = 0; bj < 2; ++bj)
#pragma unroll
            for (int n = 0; n < 2; ++n) bv[bj][n] = (mode == 2) ? *(const f32x4*)(b_gate + col0 + bj * 128 + 4 * n) : (f32x4){0.f, 0.f, 0.f, 0.f};
#pragma unroll
        for (int ai = 0; ai < 2; ++ai)
#pragma unroll
            for (int m = 0; m < 4; ++m) { bf16_t* rowp = base + (size_t)(row0 + ai * 128 + m * 16) * ld + col0; float s1 = 0.f, s2 = 0.f;
#pragma unroll
                for (int bj = 0; bj < 2; ++bj) { f32x4 v0 = acc[ai][bj][m][0], v1 = acc[ai][bj][m][1];
                    if (mode == 1 || mode == 3) {
#pragma unroll
                        for (int j = 0; j < 4; ++j) { v0[j] = fast_gelu(v0[j]); v1[j] = fast_gelu(v1[j]); } }
                    else if (mode == 2) { v0 += bv[bj][0]; v1 += bv[bj][1];
#pragma unroll
                        for (int j = 0; j < 4; ++j) { v0[j] = fast_sigmoid(v0[j]); v1[j] = fast_sigmoid(v1[j]); } }
                    if (mode == 3) {
#pragma unroll
                        for (int j = 0; j < 4; ++j) { s1 += v0[j] + v1[j]; s2 += v0[j] * v0[j] + v1[j] * v1[j]; } }
                    u32x4 w; w.x = pg8::cvt_pk_bf16(v0[0], v0[1]); w.y = pg8::cvt_pk_bf16(v0[2], v0[3]); w.z = pg8::cvt_pk_bf16(v1[0], v1[1]); w.w = pg8::cvt_pk_bf16(v1[2], v1[3]);
                    *(u32x4*)(rowp + bj * 128) = w; }
                if (mode == 3) { s1 += __shfl_xor(s1, 16); s1 += __shfl_xor(s1, 32); s2 += __shfl_xor(s2, 16); s2 += __shfl_xor(s2, 32);
                    if (fq == 0) { typedef float f32x2_ __attribute__((ext_vector_type(2))); *(f32x2_*)(VSTAT + ((size_t)(row0 + ai * 128 + m * 16) * 16 + (pn - 4) * 4 + wc) * 2) = (f32x2_){s1, s2}; } } }
    }
};
struct EpiProj {
    static constexpr bool PERM = true, HAS_MID = true;
    const bf16_t* G; bf16_t* O;
    __device__ __forceinline__ void mid(f32x4 (&acc)[2][2][4][2], const pg8::Unit& u, int wr, int wc, int fr, int fq) const {
        const int row0 = u.pm * 256 + wr * 64 + fr, col0 = u.pn * 256 + wc * 32 + 8 * fq;
#pragma unroll
        for (int ai = 0; ai < 2; ++ai)
#pragma unroll
            for (int m = 0; m < 4; ++m) { const bf16_t* gp = G + (size_t)(row0 + ai * 128 + m * 16) * 4096 + col0;
#pragma unroll
                for (int bj = 0; bj < 2; ++bj) { float gs[8], gf[8]; unpack8(*(const u32x4*)(gp + bj * 128), gs); unpack8(*(const u32x4*)(gp + 2048 + bj * 128), gf);
#pragma unroll
                    for (int j = 0; j < 4; ++j) { acc[ai][bj][m][0][j] *= gs[j] * __builtin_amdgcn_rcpf(gf[j]); acc[ai][bj][m][1][j] *= gs[4 + j] * __builtin_amdgcn_rcpf(gf[4 + j]); }
                    asm volatile("" : "+v"(acc[ai][bj][m][0]), "+v"(acc[ai][bj][m][1]) :: "memory"); } }
    }
    __device__ __forceinline__ void operator()(f32x4 (&acc)[2][2][4][2], const pg8::Unit& u, int wr, int wc, int fr, int fq) const {
        const int row0 = u.pm * 256 + wr * 64 + fr, col0 = u.pn * 256 + wc * 32 + 8 * fq;
#pragma unroll
        for (int ai = 0; ai < 2; ++ai)
#pragma unroll
            for (int m = 0; m < 4; ++m) { const size_t r = (size_t)(row0 + ai * 128 + m * 16);
#pragma unroll
                for (int bj = 0; bj < 2; ++bj) { float gf[8]; unpack8(*(const u32x4*)(G + r * 4096 + 2048 + col0 + bj * 128), gf);
                    const f32x4 v0 = acc[ai][bj][m][0], v1 = acc[ai][bj][m][1];
                    u32x4 w; w.x = pg8::cvt_pk_bf16(v0[0] * gf[0], v0[1] * gf[1]); w.y = pg8::cvt_pk_bf16(v0[2] * gf[2], v0[3] * gf[3]); w.z = pg8::cvt_pk_bf16(v1[0] * gf[4], v1[1] * gf[5]); w.w = pg8::cvt_pk_bf16(v1[2] * gf[6], v1[3] * gf[7]);
                    *(u32x4*)(O + r * 2048 + col0 + bj * 128) = w; }
                asm volatile("" ::: "memory"); }
    }
};
struct EpiOut {
    static constexpr bool PERM = false, HAS_MID = false;
    const float* X; float* O;
    __device__ __forceinline__ void mid(f32x4 (&)[2][2][4][2], const pg8::Unit&, int, int, int, int) const {}
    __device__ __forceinline__ void operator()(f32x4 (&acc)[2][2][4][2], const pg8::Unit& u, int wr, int wc, int fr, int fq) const {
        const int row0 = u.pm * 256 + wr * 64 + fr, col0 = u.pn * 256 + wc * 32 + 4 * fq;
#pragma unroll
        for (int ai = 0; ai < 2; ++ai)
#pragma unroll
            for (int m = 0; m < 4; ++m) { const size_t off = (size_t)(row0 + ai * 128 + m * 16) * DM + col0;
#pragma unroll
                for (int bj = 0; bj < 2; ++bj)
#pragma unroll
                    for (int n = 0; n < 2; ++n) *(f32x4*)(O + off + bj * 128 + n * 16) = *(const f32x4*)(X + off + bj * 128 + n * 16) + acc[ai][bj][m][n]; }
    }
};
struct EpiGateUp {
    static constexpr bool PERM = true, HAS_MID = false;
    bf16_t* ACT; const float* RSTL;
    __device__ __forceinline__ void mid(f32x4 (&)[2][2][4][2], const pg8::Unit&, int, int, int, int) const {}
    __device__ __forceinline__ void operator()(f32x4 (&acc)[2][2][4][2], const pg8::Unit& u, int wr, int wc, int fr, int fq) const {
        const int row0 = u.x0 + wr * 64 + fr, col0 = u.pn * 128 + wc * 32 + 8 * fq;
#pragma unroll
        for (int ai = 0; ai < 2; ++ai)
#pragma unroll
            for (int m = 0; m < 4; ++m) { float o[8]; const float rr = RSTL[u.x1 + wr * 64 + fr + ai * 128 + m * 16];
#pragma unroll
                for (int n = 0; n < 2; ++n)
#pragma unroll
                    for (int j = 0; j < 4; ++j) { const float g = acc[ai][0][m][n][j] * rr, up = acc[ai][1][m][n][j] * rr; o[4 * n + j] = g * fast_sigmoid(g) * up; }
                u32x4 w; w.x = pg8::cvt_pk_bf16(o[0], o[1]); w.y = pg8::cvt_pk_bf16(o[2], o[3]); w.z = pg8::cvt_pk_bf16(o[4], o[5]); w.w = pg8::cvt_pk_bf16(o[6], o[7]);
                *(u32x4*)(ACT + (size_t)(row0 + ai * 128 + m * 16) * DEXP + col0) = w; }
    }
};
struct EpiDown {
    static constexpr bool PERM = true, HAS_MID = false;
    bf16_t* Y; const float* GATE;
    __device__ __forceinline__ void mid(f32x4 (&)[2][2][4][2], const pg8::Unit&, int, int, int, int) const {}
    __device__ __forceinline__ void operator()(f32x4 (&acc)[2][2][4][2], const pg8::Unit& u, int wr, int wc, int fr, int fq) const {
        const int rl0 = wr * 64 + fr, col0 = u.pn * 256 + wc * 32 + 8 * fq;
#pragma unroll
        for (int ai = 0; ai < 2; ++ai)
#pragma unroll
            for (int m = 0; m < 4; ++m) { const int rl = rl0 + ai * 128 + m * 16; const float gt = GATE[u.x1 + rl];
#pragma unroll
                for (int bj = 0; bj < 2; ++bj) { const f32x4 v0 = acc[ai][bj][m][0] * gt, v1 = acc[ai][bj][m][1] * gt;
                    u32x4 w; w.x = pg8::cvt_pk_bf16(v0[0], v0[1]); w.y = pg8::cvt_pk_bf16(v0[2], v0[3]); w.z = pg8::cvt_pk_bf16(v1[0], v1[1]); w.w = pg8::cvt_pk_bf16(v1[2], v1[3]);
                    *(u32x4*)(Y + (size_t)(u.x0 + rl) * DM + col0 + bj * 128) = w; } }
    }
};
struct MoeOrder {
    const char* Abase; const char* Bbase; size_t Bstride; int K, nN, G, c; bool gather;
    const PG8_LAS int* ps;
    const unsigned* cnt; const int* TOK;
    __device__ bool next(int i, pg8::Unit& u) const {
        const int L = i * G + c; const int ntile = ps[NEXP + 2] * nN; if (L >= ntile) return false;
        const int sidx = L / nN, pn = L % nN; const int prow = ps[40 + sidx], info = ps[40 + MT_MAX + sidx], valid = ps[40 + 2 * MT_MAX + sidx];
        const int e = info >> 16, mt = info & 0xffff;
        u.pm = mt; u.pn = pn; u.x0 = prow; u.x1 = e * T + mt * MTILE; u.x2 = valid; u.x3 = e;
        u.A = gather ? Abase : Abase + (size_t)prow * K * 2; u.B = Bbase + (size_t)e * Bstride + (size_t)pn * 256 * K * 2; return true;
    }
    __device__ __forceinline__ void rows(const pg8::Unit& u, unsigned (&g)[2][2], const int (&RA)[2]) const {
#pragma unroll
        for (int h = 0; h < 2; ++h)
#pragma unroll
            for (int i = 0; i < 2; ++i) { int r = RA[i] + 128 * h; r = r < u.x2 ? r : u.x2 - 1; g[h][i] = (unsigned)TOK[u.x1 + r] * (unsigned)(K * 2); }
    }
};

struct TItem { const float* src; bf16_t* dst; int ld_src, ld_dst; };
__device__ __forceinline__ void titem_load(const TItem& t, f32x4 (&v)[8], int lane) {
#pragma unroll
    for (int i = 0; i < 8; ++i) v[i] = *(const f32x4*)(t.src + (size_t)((lane >> 3) + 8 * i) * t.ld_src + 4 * (lane & 7));
}
__device__ __forceinline__ void titem_store(const TItem& t, const f32x4 (&v)[8], PG8_LAS float* scr, int lane) {
#pragma unroll
    for (int i = 0; i < 8; ++i) { PG8_LAS float* d = scr + ((lane >> 3) + 8 * i) * 33 + 4 * (lane & 7); d[0] = v[i].x; d[1] = v[i].y; d[2] = v[i].z; d[3] = v[i].w; }
    asm volatile("s_waitcnt lgkmcnt(0)" ::: "memory");
    const int c = lane & 7;
#pragma unroll
    for (int j = 0; j < 4; ++j) { const int n = (lane >> 3) + 8 * j; const PG8_LAS float* s = scr + (8 * c) * 33 + n;
        u32x4 o; o.x = pk2(s[0 * 33], s[1 * 33]); o.y = pk2(s[2 * 33], s[3 * 33]); o.z = pk2(s[4 * 33], s[5 * 33]); o.w = pk2(s[6 * 33], s[7 * 33]);
        *(u32x4*)(t.dst + (size_t)n * t.ld_dst + 8 * c) = o; }
    asm volatile("s_waitcnt lgkmcnt(0)" ::: "memory");
}
constexpr int TI0 = 32 * 288, TI1 = 16 * 64, TI2 = 16 * 64, TI3 = 32 * 64, TI4 = 32 * 512, TI5 = 32 * 512, TI6 = 32 * 512;
constexpr int TI_ALL = TI0 + TI1 + TI2 + TI3 + TI4 + TI5 + TI6;
#ifndef TAIL1_ITEMS
#define TAIL1_ITEMS (TI5)
#endif
__device__ __forceinline__ TItem titem_decode(const Args& A, int r) {
    bf16_t* WIN = (bf16_t*)(A.ws + WS_WIN); bf16_t* WPROJ = (bf16_t*)(A.ws + WS_WPROJ); bf16_t* WOUT = (bf16_t*)(A.ws + WS_WOUT); bf16_t* WGU = (bf16_t*)(A.ws + WS_WGU); bf16_t* WD = (bf16_t*)(A.ws + WS_WD);
    TItem t;
    if (r < TI0) { const int kb = r / 288, nb = r % 288; t.src = A.in[2] + (size_t)(64 * kb) * INCOLS + 32 * nb + (nb >= 160 ? 8 : 0); t.ld_src = INCOLS; t.dst = WIN + (size_t)(32 * nb) * 2048 + 64 * kb; t.ld_dst = 2048; return t; } r -= TI0;
    if (r < TI1) { const int kb = r / 64, nb = r % 64; t.src = A.in[11] + (size_t)(64 * kb) * DM + 32 * nb; t.ld_src = DM; t.dst = WPROJ + (size_t)(32 * nb) * 2048 + 64 * kb; t.ld_dst = 2048; return t; } r -= TI1;
    if (r < TI2) { const int kb = r / 64, nb = r % 64; t.src = A.in[12] + (size_t)(64 * kb) * DM + 32 * nb; t.ld_src = DM; t.dst = WPROJ + (size_t)(32 * nb) * 2048 + 1024 + 64 * kb; t.ld_dst = 2048; return t; } r -= TI2;
    if (r < TI3) { const int kb = r / 64, nb = r % 64; t.src = A.in[13] + (size_t)(64 * kb) * DM + 32 * nb; t.ld_src = DM; t.dst = WOUT + (size_t)(32 * nb) * 2048 + 64 * kb; t.ld_dst = 2048; return t; } r -= TI3;
    if (r < TI4 + TI5) { const int up = r >= TI4; if (up) r -= TI4; const int e = r / 512, q = r % 512, kb = q / 16, nb = q % 16, n = 32 * nb, drow = 256 * (n >> 7) + (n & 127) + (up ? 128 : 0);
        t.src = A.in[up ? 20 : 19] + (size_t)e * DM * DEXP + (size_t)(64 * kb) * DEXP + n; t.ld_src = DEXP; t.dst = WGU + ((size_t)e * 1024 + drow) * 2048 + 64 * kb; t.ld_dst = 2048; return t; } r -= TI4 + TI5;
    { const int e = r / 512, q = r % 512, kb = q / 64, nb = q % 64; t.src = A.in[21] + (size_t)e * DEXP * DM + (size_t)(64 * kb) * DM + 32 * nb; t.ld_src = DM; t.dst = WD + ((size_t)e * 2048 + 32 * nb) * 512 + 64 * kb; t.ld_dst = 512; return t; }
}
__device__ __forceinline__ void p0_weights(const Args& A, PG8_LAS unsigned char* lds, const int part, const int wg0) {
    const int tid = threadIdx.x, lane = tid & 63, wave = tid >> 6;
    PG8_LAS float* scr = (PG8_LAS float*)(lds + wave * 16384);
    if ((int)blockIdx.x < wg0) return;
    const int gw = ((int)blockIdx.x - wg0) * NWAVES + wave, NGW = ((int)gridDim.x - wg0) * NWAVES;
    const int cut1 = TI_ALL - TI6 - TAIL1_ITEMS, cut2 = TI_ALL - TI6;
    const int it_lo = part == 0 ? 0 : (part == 1 ? cut1 : cut2), it_hi = part == 0 ? cut1 : (part == 1 ? cut2 : TI_ALL);
    int it = it_lo + gw; if (it >= it_hi) return;
    TItem cur = titem_decode(A, it); f32x4 va[8], vb[8];
    titem_load(cur, va, lane);
    for (;;) {
        const int itn = it + NGW; const bool more = itn < it_hi; TItem nx = cur;
        if (more) { nx = titem_decode(A, itn); titem_load(nx, vb, lane); }
        titem_store(cur, va, scr, lane);
        if (!more) break;
#pragma unroll
        for (int i = 0; i < 8; ++i) va[i] = vb[i];
        cur = nx; it = itn;
    }
}

__device__ __forceinline__ void p1_fast(const Args& A, PG8_LAS unsigned char* lds) {
    pg8::DenseOrder S; S.init(A.ws + WS_H, A.ws + WS_WIN, T, 9216, DM, gridDim.x, blockIdx.x);
    EpiIn E{(bf16_t*)(A.ws + WS_U), (bf16_t*)(A.ws + WS_V), (bf16_t*)(A.ws + WS_Q), (bf16_t*)(A.ws + WS_K), (bf16_t*)(A.ws + WS_VA), (bf16_t*)(A.ws + WS_G), A.in[3], A.in[9], A.in[10], (float*)(A.ws + WS_VSTAT), lds};
    pg8::gemm_phase<EpiIn, pg8::DenseOrder, true, false>(lds, DM, S, E);
}
__device__ __forceinline__ void p3_fast(const Args& A, PG8_LAS unsigned char* lds) {
    pg8::DenseOrder S; S.init(A.ws + WS_MIXIN, A.ws + WS_WPROJ, T, DM, 2048, gridDim.x, blockIdx.x);
    EpiProj E{(const bf16_t*)(A.ws + WS_G), (bf16_t*)(A.ws + WS_MIXED)};
    pg8::gemm_phase<EpiProj, pg8::DenseOrder, true, false>(lds, 2048, S, E);
}
__device__ __forceinline__ void p4_fast(const Args& A, PG8_LAS unsigned char* lds) {
    pg8::DenseOrder S; S.init(A.ws + WS_MIXED, A.ws + WS_WOUT, T, DM, DM, gridDim.x, blockIdx.x);
    EpiOut E{A.in[0], A.out};
    pg8::gemm_phase<EpiOut, pg8::DenseOrder, true, false>(lds, DM, S, E);
}
__device__ __forceinline__ void moe_layout_lds(const Args& A, PG8_LAS unsigned char* lds) {
    PG8_LAS int* ps = (PG8_LAS int*)(lds + LDS_MISC_OFF); PG8_LAS int* tprow = ps + 40; PG8_LAS int* tinfo = tprow + MT_MAX; PG8_LAS int* tvalid = tinfo + MT_MAX;
    const unsigned* cnt = (const unsigned*)(A.ws + WS_CTL) + CW_CNT;
    if (threadIdx.x == 0) { int acc = 0;
        for (int e = 0; e < NEXP; ++e) { ps[e] = acc; acc += ((int)cnt[(e) * CNT_STRIDE] + MTILE - 1) / MTILE * MTILE; }
        ps[NEXP] = acc; ps[NEXP + 1] = acc / MTILE; }
    __syncthreads();
    const int nt = ps[NEXP + 1]; PG8_LAS int* uval = tvalid + MT_MAX;
    int prow = 0, e = 0, mt = 0, valid = 0;
    if ((int)threadIdx.x < nt) { prow = (int)threadIdx.x * MTILE;
        for (int j = 1; j < NEXP; ++j) if (ps[j] <= prow) e = j;
        mt = (prow - ps[e]) / MTILE; valid = (int)cnt[(e) * CNT_STRIDE] - mt * MTILE; valid = valid > MTILE ? MTILE : valid; uval[threadIdx.x] = valid; }
    __syncthreads();
    if ((int)threadIdx.x < nt) { int rank = 0;
        for (int j = 0; j < nt; ++j) { const int vj = uval[j]; rank += (vj > valid || (vj == valid && j < (int)threadIdx.x)) ? 1 : 0; }
        tprow[rank] = prow; tinfo[rank] = (e << 16) | mt; tvalid[rank] = valid; }
    if (threadIdx.x == 0) { int nb = 0; for (int j = 0; j < nt; ++j) nb += uval[j] > TINY_ROWS ? 1 : 0; ps[NEXP + 2] = nb; }
    __syncthreads();
}
namespace sm {
typedef short bf16x8 __attribute__((ext_vector_type(8))); typedef float f32x16 __attribute__((ext_vector_type(16)));
constexpr int TINY = 64;
__device__ __forceinline__ void gateup_small(const Args& A, PG8_LAS unsigned char* lds) {
    const PG8_LAS int* ps = (const PG8_LAS int*)(lds + LDS_MISC_OFF); const int nt = ps[NEXP + 1], nbig = ps[NEXP + 2];
    const bf16_t* H2 = (const bf16_t*)(A.ws + WS_H2); const bf16_t* WGU = (const bf16_t*)(A.ws + WS_WGU); bf16_t* ACT = (bf16_t*)(A.ws + WS_ACT); const int* TOK = (const int*)(A.ws + WS_TOK);
    const int tid = threadIdx.x, lane = tid & 63, w = __builtin_amdgcn_readfirstlane(tid >> 6), r32 = lane & 31, hi = lane >> 5;
    PG8_LAS float* red = (PG8_LAS float*)lds;
    for (int su = blockIdx.x; su < (nt - nbig) * 16; su += gridDim.x) {
        const int sidx = nbig + (su >> 4), sl = su & 15; const int prow = ps[40 + sidx], info = ps[40 + MT_MAX + sidx], valid = ps[40 + 2 * MT_MAX + sidx];
        const int e = info >> 16, mt = info & 0xffff, lbase = e * T + mt * MTILE;
        const int ra = r32 < valid ? r32 : valid - 1, rb = 32 + r32 < valid ? 32 + r32 : valid - 1;
        const bf16_t* a0p = H2 + (size_t)TOK[lbase + ra] * DM + 256 * w + 8 * hi; const bf16_t* a1p = H2 + (size_t)TOK[lbase + rb] * DM + 256 * w + 8 * hi;
        const bf16_t* b0p = WGU + ((size_t)e * 1024 + 256 * (sl >> 2) + 32 * (sl & 3) + r32) * DM + 256 * w + 8 * hi; const bf16_t* b1p = b0p + (size_t)128 * DM;
        f32x16 acc[2][2];
#pragma unroll
        for (int i = 0; i < 2; ++i)
#pragma unroll
            for (int j = 0; j < 2; ++j)
#pragma unroll
                for (int r = 0; r < 16; ++r) acc[i][j][r] = 0.f;
#pragma unroll 4
        for (int ks = 0; ks < 16; ++ks) { const bf16x8 a0 = *(const bf16x8*)(a0p + 16 * ks), a1 = *(const bf16x8*)(a1p + 16 * ks), b0 = *(const bf16x8*)(b0p + 16 * ks), b1 = *(const bf16x8*)(b1p + 16 * ks);
            acc[0][0] = __builtin_amdgcn_mfma_f32_32x32x16_bf16(a0, b0, acc[0][0], 0, 0, 0); acc[0][1] = __builtin_amdgcn_mfma_f32_32x32x16_bf16(a0, b1, acc[0][1], 0, 0, 0);
            acc[1][0] = __builtin_amdgcn_mfma_f32_32x32x16_bf16(a1, b0, acc[1][0], 0, 0, 0); acc[1][1] = __builtin_amdgcn_mfma_f32_32x32x16_bf16(a1, b1, acc[1][1], 0, 0, 0); }
#pragma unroll
        for (int i = 0; i < 2; ++i)
#pragma unroll
            for (int j = 0; j < 2; ++j)
#pragma unroll
                for (int r = 0; r < 16; ++r) red[(((w * 2 + i) * 2 + j) * 16 + r) * 64 + lane] = acc[i][j][r];
        __syncthreads();
#pragma unroll
        for (int i = 0; i < 2; ++i)
#pragma unroll
            for (int rr = 0; rr < 2; ++rr) { const int r = 2 * w + rr; float g = 0.f, u = 0.f;
#pragma unroll
                for (int w2 = 0; w2 < 8; ++w2) { g += red[(((w2 * 2 + i) * 2 + 0) * 16 + r) * 64 + lane]; u += red[(((w2 * 2 + i) * 2 + 1) * 16 + r) * 64 + lane]; }
                const int row = 32 * i + (r & 3) + 8 * (r >> 2) + 4 * hi; const float rr2 = ((const float*)(A.ws + WS_RSTL))[lbase + (row < valid ? row : valid - 1)]; g *= rr2; u *= rr2;
                ACT[(size_t)(prow + row) * DEXP + 32 * sl + r32] = f2bf(g * fast_sigmoid(g) * u); }
        __syncthreads();
    }
}
__device__ __forceinline__ void down_small(const Args& A, PG8_LAS unsigned char* lds) {
    const PG8_LAS int* ps = (const PG8_LAS int*)(lds + LDS_MISC_OFF); const int nt = ps[NEXP + 1], nbig = ps[NEXP + 2];
    const bf16_t* ACT = (const bf16_t*)(A.ws + WS_ACT); const bf16_t* WD = (const bf16_t*)(A.ws + WS_WD); bf16_t* Y = (bf16_t*)(A.ws + WS_YBUF); const float* GATE = (const float*)(A.ws + WS_GATE);
    const int tid = threadIdx.x, lane = tid & 63, w = __builtin_amdgcn_readfirstlane(tid >> 6), wn = w & 3, wk = w >> 2, r32 = lane & 31, hi = lane >> 5;
    PG8_LAS float* red = (PG8_LAS float*)lds;
    for (int su = blockIdx.x; su < (nt - nbig) * 16; su += gridDim.x) {
        const int sidx = nbig + (su >> 4), sl = su & 15; const int prow = ps[40 + sidx], info = ps[40 + MT_MAX + sidx], valid = ps[40 + 2 * MT_MAX + sidx];
        const int e = info >> 16, mt = info & 0xffff, lbase = e * T + mt * MTILE;
        const int ra = r32 < valid ? r32 : valid - 1, rb = 32 + r32 < valid ? 32 + r32 : valid - 1;
        const bf16_t* a0p = ACT + (size_t)(prow + ra) * DEXP + 256 * wk + 8 * hi; const bf16_t* a1p = ACT + (size_t)(prow + rb) * DEXP + 256 * wk + 8 * hi;
        const bf16_t* bp = WD + ((size_t)e * 2048 + 128 * sl + 32 * wn + r32) * DEXP + 256 * wk + 8 * hi;
        f32x16 acc[2];
#pragma unroll
        for (int i = 0; i < 2; ++i)
#pragma unroll
            for (int r = 0; r < 16; ++r) acc[i][r] = 0.f;
#pragma unroll 4
        for (int ks = 0; ks < 16; ++ks) { const bf16x8 a0 = *(const bf16x8*)(a0p + 16 * ks), a1 = *(const bf16x8*)(a1p + 16 * ks), b = *(const bf16x8*)(bp + 16 * ks);
            acc[0] = __builtin_amdgcn_mfma_f32_32x32x16_bf16(a0, b, acc[0], 0, 0, 0); acc[1] = __builtin_amdgcn_mfma_f32_32x32x16_bf16(a1, b, acc[1], 0, 0, 0); }
        if (wk == 1) {
#pragma unroll
            for (int i = 0; i < 2; ++i)
#pragma unroll
                for (int r = 0; r < 16; ++r) red[((wn * 2 + i) * 16 + r) * 64 + lane] = acc[i][r]; }
        __syncthreads();
        if (wk == 0) {
#pragma unroll
            for (int i = 0; i < 2; ++i)
#pragma unroll
                for (int r = 0; r < 16; ++r) { const int row = 32 * i + (r & 3) + 8 * (r >> 2) + 4 * hi; const float gt = GATE[lbase + (row < valid ? row : valid - 1)];
                    Y[(size_t)(prow + row) * DM + 128 * sl + 32 * wn + r32] = f2bf((acc[i][r] + red[((wn * 2 + i) * 16 + r) * 64 + lane]) * gt); } }
        __syncthreads();
    }
}
}

__device__ __forceinline__ void p6_fast(const Args& A, PG8_LAS unsigned char* lds) {
    moe_layout_lds(A, lds);
    MoeOrder S{(const char*)(A.ws + WS_H2), (const char*)(A.ws + WS_WGU), (size_t)1024 * 2048 * 2, DM, 4, (int)gridDim.x, (int)blockIdx.x, true,
               (const PG8_LAS int*)(lds + LDS_MISC_OFF), (const unsigned*)(A.ws + WS_CTL) + CW_CNT, (const int*)(A.ws + WS_TOK)};
    EpiGateUp E{(bf16_t*)(A.ws + WS_ACT), (const float*)(A.ws + WS_RSTL)};
    pg8::gemm_phase<EpiGateUp, MoeOrder, true, true>(lds, DM, S, E);
    sm::gateup_small(A, lds);
    { const int ntile = ((const PG8_LAS int*)(lds + LDS_MISC_OFF))[NEXP + 2] * 4; __syncthreads(); p0_weights(A, lds, 2, ntile % (int)gridDim.x); }
}
__device__ __forceinline__ void p7_fast(const Args& A, PG8_LAS unsigned char* lds) {
    moe_layout_lds(A, lds);
    MoeOrder S{(const char*)(A.ws + WS_ACT), (const char*)(A.ws + WS_WD), (size_t)2048 * 512 * 2, DEXP, 8, (int)gridDim.x, (int)blockIdx.x, false,
               (const PG8_LAS int*)(lds + LDS_MISC_OFF), (const unsigned*)(A.ws + WS_CTL) + CW_CNT, (const int*)(A.ws + WS_TOK)};
    EpiDown E{(bf16_t*)(A.ws + WS_YBUF), (const float*)(A.ws + WS_GATE)};
    pg8::gemm_phase<EpiDown, MoeOrder, true, false>(lds, DEXP, S, E);
    sm::down_small(A, lds);
}

namespace fa {
typedef short bf16x8 __attribute__((ext_vector_type(8)));
typedef short v4i16 __attribute__((ext_vector_type(4)));
typedef float f32x16 __attribute__((ext_vector_type(16)));
#define FA_LAS __attribute__((address_space(3)))
constexpr int KVBUF = 65536, LDS_CK = 131072, LDS_ML = 131072 + 8192;
__device__ __forceinline__ unsigned cvtpk(float lo, float hi) { unsigned r; asm("v_cvt_pk_bf16_f32 %0, %1, %2" : "=v"(r) : "v"(lo), "v"(hi)); return r; }
__device__ __forceinline__ bf16x8 pack8(const f32x16& p, int b) { u32x4 w; w.x = cvtpk(p[b], p[b + 1]); w.y = cvtpk(p[b + 2], p[b + 3]); w.z = cvtpk(p[b + 4], p[b + 5]); w.w = cvtpk(p[b + 6], p[b + 7]); return __builtin_bit_cast(bf16x8, w); }
__device__ __forceinline__ float swapmax(float v) { auto rr = __builtin_amdgcn_permlane32_swap(__float_as_uint(v), __float_as_uint(v), false, false); return fmaxf(__uint_as_float(rr[0]), __uint_as_float(rr[1])); }
__device__ __forceinline__ float swapsum(float v) { auto rr = __builtin_amdgcn_permlane32_swap(__float_as_uint(v), __float_as_uint(v), false, false); return __uint_as_float(rr[0]) + __uint_as_float(rr[1]); }
#define FA_WAITBAR() do { asm volatile("s_waitcnt vmcnt(0) lgkmcnt(0)" ::: "memory"); __builtin_amdgcn_s_barrier(); asm volatile("" ::: "memory"); } while (0)

__device__ __forceinline__ void attn_phase(const Args& A, FA_LAS unsigned char* lds) {
    const bf16_t* Q = (const bf16_t*)(A.ws + WS_Q); const bf16_t* Kt = (const bf16_t*)(A.ws + WS_K); const bf16_t* Vt = (const bf16_t*)(A.ws + WS_VA);
    const float* CKL = (const float*)(A.ws + WS_CKL); bf16_t* MIXIN = (bf16_t*)(A.ws + WS_MIXIN);
    const int tid = threadIdx.x, lane = tid & 63, wid = __builtin_amdgcn_readfirstlane(tid >> 6), rg = wid & 3, kh = wid >> 2, r32 = lane & 31, hi = lane >> 5;
    int koff[4];
#pragma unroll
    for (int i = 0; i < 4; ++i) { const int rl = 4 * i + (lane >> 4); koff[i] = rl * 1024 + (((lane & 15) ^ rl) * 8); }
    const int voff = (lane >> 4) * 1024 + (((lane & 15) ^ ((lane >> 4) << 2)) * 8);
    int kfo[8];
#pragma unroll
    for (int d0 = 0; d0 < 8; ++d0) kfo[d0] = (kh * 64 + r32) * 256 + (((2 * d0 + hi) ^ (r32 & 15)) * 16);
    int vfo[4];
    { const int dh = (lane >> 4) & 1, q = (lane & 15) >> 2, p = lane & 3;
#pragma unroll
      for (int db = 0; db < 4; ++db) vfo[db] = 32768 + (kh * 64 + 4 * hi + q) * 256 + ((db ^ q) * 64) + dh * 32 + p * 8; }
    const int G = gridDim.x;
    for (int vb = blockIdx.x; vb < 256; vb += G) {
        const int item = (G % 8 == 0) ? ((vb % 8) * 32 + (vb / 8)) % 256 : vb;
        const int bh = item >> 3, ii = item & 7, b = bh >> 3, h = bh & 7;
        const bf16_t* Kg = Kt + (size_t)b * SEQ * 1024 + h * 128; const bf16_t* Vg = Vt + (size_t)b * SEQ * 1024 + h * 128;
        {
            const float* LOGF = (const float*)(A.ws + WS_LOGF) + (size_t)b * SEQ * 8 + h; float v[4]; float sm = 0.f;
#pragma unroll
            for (int i = 0; i < 4; ++i) { v[i] = LOGF[(size_t)(tid * 4 + i) * 8]; sm += v[i]; }
            float incl = sm;
#pragma unroll
            for (int o2 = 1; o2 < 64; o2 <<= 1) { const float t2 = __shfl_up(incl, o2); if (lane >= o2) incl += t2; }
            FA_LAS float* wt = (FA_LAS float*)(lds + LDS_ML);
            if (lane == 63) wt[wid] = incl;
            asm volatile("s_waitcnt lgkmcnt(0)" ::: "memory"); __builtin_amdgcn_s_barrier(); asm volatile("" ::: "memory");
            float run = incl - sm;
            for (int w2 = 0; w2 < wid; ++w2) run += wt[w2];
            f32x4 o4;
#pragma unroll
            for (int i = 0; i < 4; ++i) { run += v[i]; o4[i] = -run * LOG2E; }
            *(FA_LAS f32x4*)(lds + LDS_CK + tid * 16) = o4; }
#define FA_ISSUE(key0, bufoff) do { const bf16_t* kg_ = Kg + (size_t)((key0) + 16 * wid) * 1024; const bf16_t* vg_ = Vg + (size_t)((key0) + 16 * wid) * 1024; \
        _Pragma("unroll") for (int i_ = 0; i_ < 4; ++i_) { \
            __builtin_amdgcn_global_load_lds((const unsigned*)(kg_ + koff[i_]), (FA_LAS unsigned*)(lds + (bufoff) + (wid * 4 + i_) * 1024), 16, 0, 0); \
            __builtin_amdgcn_global_load_lds((const unsigned*)(vg_ + i_ * 4096 + voff), (FA_LAS unsigned*)(lds + (bufoff) + 32768 + (wid * 4 + i_) * 1024), 16, 0, 0); } } while (0)
        int u = 0, qb = ii, kb = 0, cur = 0;
        FA_ISSUE(0, 0);
        bf16x8 qf[8]; f32x16 o[4]; float m = -1e30f, l = 0.f;
        { const bf16_t* qp = Q + (size_t)(b * SEQ + qb * 128 + rg * 32 + r32) * 1024 + h * 128 + 8 * hi;
#pragma unroll
          for (int d0 = 0; d0 < 8; ++d0) qf[d0] = *(const bf16x8*)(qp + 16 * d0); }
#pragma unroll
        for (int db = 0; db < 4; ++db)
#pragma unroll
            for (int r = 0; r < 16; ++r) o[db][r] = 0.f;
        FA_WAITBAR();
        for (;;) {
            const bool lastb = (kb == qb); const bool more = !(lastb && u == 1);
            const int nkb = lastb ? 0 : kb + 1;
            if (more) FA_ISSUE(nkb * 128, (cur ^ 1) * KVBUF);
            {
                FA_LAS const unsigned char* buf = lds + cur * KVBUF;
                FA_LAS const float* nck = (FA_LAS const float*)(lds + LDS_CK) + kb * 128 + kh * 64 + 4 * hi;
                f32x16 p0, p1;
#pragma unroll
                for (int g = 0; g < 4; ++g) { const f32x4 t0 = *(FA_LAS const f32x4*)(nck + 8 * g), t1 = *(FA_LAS const f32x4*)(nck + 32 + 8 * g);
#pragma unroll
                    for (int j = 0; j < 4; ++j) { p0[4 * g + j] = t0[j]; p1[4 * g + j] = t1[j]; } }
#pragma unroll
                for (int d0 = 0; d0 < 8; ++d0) { const bf16x8 ka = *(FA_LAS const bf16x8*)(buf + kfo[d0]), kc = *(FA_LAS const bf16x8*)(buf + kfo[d0] + 8192);
                    p0 = __builtin_amdgcn_mfma_f32_32x32x16_bf16(ka, qf[d0], p0, 0, 0, 0); p1 = __builtin_amdgcn_mfma_f32_32x32x16_bf16(kc, qf[d0], p1, 0, 0, 0); }
                if (lastb) { const int qrel = rg * 32 + r32, k0 = kh * 64 + 4 * hi;
#pragma unroll
                    for (int r = 0; r < 16; ++r) { const int kr = k0 + (r & 3) + 8 * (r >> 2); if (kr > qrel) p0[r] = -INFINITY; if (kr + 32 > qrel) p1[r] = -INFINITY; } }
                float mx = fmaxf(p0[0], p1[0]);
#pragma unroll
                for (int r = 1; r < 16; ++r) mx = fmaxf(mx, fmaxf(p0[r], p1[r]));
                mx = swapmax(mx);
                const float mn = fmaxf(m, mx), alpha = __builtin_amdgcn_exp2f(m - mn); m = mn;
                float ps = 0.f;
#pragma unroll
                for (int r = 0; r < 16; ++r) { p0[r] = __builtin_amdgcn_exp2f(p0[r] - mn); p1[r] = __builtin_amdgcn_exp2f(p1[r] - mn); ps += p0[r] + p1[r]; }
                l = l * alpha + ps;
                if (!__all(alpha == 1.0f)) {
#pragma unroll
                    for (int db = 0; db < 4; ++db)
#pragma unroll
                        for (int r = 0; r < 16; ++r) o[db][r] *= alpha; }
                bf16x8 pf[4]; pf[0] = pack8(p0, 0); pf[1] = pack8(p0, 8); pf[2] = pack8(p1, 0); pf[3] = pack8(p1, 8);
#pragma unroll
                for (int db = 0; db < 4; ++db)
#pragma unroll
                    for (int s = 0; s < 4; ++s) {
                        const v4i16 lo = __builtin_amdgcn_ds_read_tr16_b64_v4i16((FA_LAS v4i16*)(buf + vfo[db] + s * 4096));
                        const v4i16 hh = __builtin_amdgcn_ds_read_tr16_b64_v4i16((FA_LAS v4i16*)(buf + vfo[db] + s * 4096 + 2048));
                        const bf16x8 vf = (bf16x8){lo[0], lo[1], lo[2], lo[3], hh[0], hh[1], hh[2], hh[3]};
                        o[db] = __builtin_amdgcn_mfma_f32_32x32x16_bf16(vf, pf[s], o[db], 0, 0, 0); }
            }
            FA_WAITBAR();
            if (lastb) {
                FA_LAS float* mb = (FA_LAS float*)(lds + cur * KVBUF) + rg * 4096; FA_LAS float* ml = (FA_LAS float*)(lds + LDS_ML) + rg * 128;
                const float lt = swapsum(l);
                if (kh == 1) {
#pragma unroll
                    for (int db = 0; db < 4; ++db)
#pragma unroll
                        for (int r = 0; r < 16; ++r) mb[(db * 16 + r) * 64 + lane] = o[db][r];
                    ml[lane] = m; ml[64 + lane] = lt; }
                FA_WAITBAR();
                if (kh == 0) {
                    const float m2 = ml[lane], l2 = ml[64 + lane], mm = fmaxf(m, m2), a1 = __builtin_amdgcn_exp2f(m - mm), a2 = __builtin_amdgcn_exp2f(m2 - mm);
                    const float inv = 1.0f / (lt * a1 + l2 * a2), s1 = a1 * inv, s2 = a2 * inv;
                    bf16_t* op = MIXIN + (size_t)(b * SEQ + qb * 128 + rg * 32 + r32) * 2048 + 1024 + h * 128 + 4 * hi;
#pragma unroll
                    for (int db = 0; db < 4; ++db)
#pragma unroll
                        for (int g = 0; g < 4; ++g) { float v[4];
#pragma unroll
                            for (int j = 0; j < 4; ++j) v[j] = o[db][4 * g + j] * s1 + mb[(db * 16 + 4 * g + j) * 64 + lane] * s2;
                            u32x2 w; w.x = cvtpk(v[0], v[1]); w.y = cvtpk(v[2], v[3]); *(u32x2*)(op + 32 * db + 8 * g) = w; } }
                FA_WAITBAR();
                if (u == 1) break;
                u = 1; qb = 15 - ii;
                { const bf16_t* qp = Q + (size_t)(b * SEQ + qb * 128 + rg * 32 + r32) * 1024 + h * 128 + 8 * hi;
#pragma unroll
                  for (int d0 = 0; d0 < 8; ++d0) qf[d0] = *(const bf16x8*)(qp + 16 * d0); }
#pragma unroll
                for (int db = 0; db < 4; ++db)
#pragma unroll
                    for (int r = 0; r < 16; ++r) o[db][r] = 0.f;
                m = -1e30f; l = 0.f;
            }
            cur ^= 1; kb = nkb;
        }
#undef FA_ISSUE
    }
}
}

namespace fs {
#define FS_LAS __attribute__((address_space(3)))
__device__ __forceinline__ void sgu_phase(const Args& A, FS_LAS unsigned char* lds) {
    const bf16_t* U = (const bf16_t*)(A.ws + WS_U); const bf16_t* V = (const bf16_t*)(A.ws + WS_V); bf16_t* MIXIN = (bf16_t*)(A.ws + WS_MIXIN);
    const float* wsp = A.in[7]; const float* bsp = A.in[8]; const float* ln_g = A.in[5]; const float* ln_b = A.in[6]; const float* VSTAT = (const float*)(A.ws + WS_VSTAT);
    const int tid = threadIdx.x, lane = tid & 63, wid = __builtin_amdgcn_readfirstlane(tid >> 6), tb = wid & 3, dh = wid >> 2, r32 = lane & 31, hi = lane >> 5;
    const int frow = tid >> 2, fq4 = tid & 3;
    int vfo[2];
    { const int d16 = (lane >> 4) & 1, q = (lane & 15) >> 2, p = lane & 3;
#pragma unroll
      for (int j = 0; j < 2; ++j) vfo[j] = 32768 + (8 * hi + q) * 256 + (((2 * dh + j) ^ q) * 64) + d16 * 32 + p * 8; }
    const int wfo = (32 * tb + r32) * 256;
    for (int u = blockIdx.x; u < (T / CHUNK) * NG; u += gridDim.x) {
        const int rc = u / NG, g = u % NG, row0 = rc * CHUNK;
        { const float* wr = wsp + ((size_t)g * CHUNK + frow) * CHUNK + fq4 * 32;
#pragma unroll
          for (int c = 0; c < 4; ++c) { const f32x4 a = *(const f32x4*)(wr + 8 * c), b2 = *(const f32x4*)(wr + 8 * c + 4); const int s0 = fq4 * 32 + 8 * c; float v[8] = {a.x, a.y, a.z, a.w, b2.x, b2.y, b2.z, b2.w};
#pragma unroll
              for (int j = 0; j < 8; ++j) if (s0 + j > frow) v[j] = 0.f;
              u32x4 w; w.x = pk2(v[0], v[1]); w.y = pk2(v[2], v[3]); w.z = pk2(v[4], v[5]); w.w = pk2(v[6], v[7]);
              *(FS_LAS u32x4*)(lds + frow * 256 + (((4 * fq4 + c) ^ (frow & 15)) * 16)) = w; }
          const bf16_t* vr = V + (size_t)(row0 + frow) * 1024 + g * 128 + fq4 * 32;
          float mean, rstd;
          { const f32x4 pa = *(const f32x4*)(VSTAT + ((size_t)(row0 + frow) * 16 + 4 * fq4) * 2), pb = *(const f32x4*)(VSTAT + ((size_t)(row0 + frow) * 16 + 4 * fq4) * 2 + 4);
            float s1 = (pa[0] + pa[2]) + (pb[0] + pb[2]), s2 = (pa[1] + pa[3]) + (pb[1] + pb[3]);
            s1 += __shfl_xor(s1, 1); s1 += __shfl_xor(s1, 2); s2 += __shfl_xor(s2, 1); s2 += __shfl_xor(s2, 2);
            mean = s1 * (1.f / 1024.f); rstd = rsqrtf(fmaxf(s2 * (1.f / 1024.f) - mean * mean, 0.f) + EPS); }
#pragma unroll
          for (int c = 0; c < 4; ++c) { const u32x4 w = *(const u32x4*)(vr + 8 * c); const int cb = g * 128 + fq4 * 32 + 8 * c;
              const f32x4 ga = *(const f32x4*)(ln_g + cb), gb = *(const f32x4*)(ln_g + cb + 4), ba = *(const f32x4*)(ln_b + cb), bb = *(const f32x4*)(ln_b + cb + 4);
              float v[8];
#pragma unroll
              for (int e2 = 0; e2 < 4; ++e2) { v[2 * e2] = __uint_as_float(w[e2] << 16); v[2 * e2 + 1] = __uint_as_float(w[e2] & 0xffff0000u); }
              u32x4 o; o.x = pk2((v[0] - mean) * rstd * ga[0] + ba[0], (v[1] - mean) * rstd * ga[1] + ba[1]); o.y = pk2((v[2] - mean) * rstd * ga[2] + ba[2], (v[3] - mean) * rstd * ga[3] + ba[3]);
              o.z = pk2((v[4] - mean) * rstd * gb[0] + bb[0], (v[5] - mean) * rstd * gb[1] + bb[1]); o.w = pk2((v[6] - mean) * rstd * gb[2] + bb[2], (v[7] - mean) * rstd * gb[3] + bb[3]);
              *(FS_LAS u32x4*)(lds + 32768 + frow * 256 + (((4 * fq4 + c) ^ ((frow & 3) << 2)) * 16)) = o; } }
        __syncthreads();
        fa::f32x16 acc[2];
#pragma unroll
        for (int j = 0; j < 2; ++j)
#pragma unroll
            for (int r = 0; r < 16; ++r) acc[j][r] = 0.f;
        for (int s = 0; s <= 2 * tb + 1; ++s) {
            const fa::bf16x8 wf = *(FS_LAS const fa::bf16x8*)(lds + wfo + (((2 * s + hi) ^ (r32 & 15)) * 16));
#pragma unroll
            for (int j = 0; j < 2; ++j) {
                const fa::v4i16 lo = __builtin_amdgcn_ds_read_tr16_b64_v4i16((FS_LAS fa::v4i16*)(lds + vfo[j] + s * 4096));
                const fa::v4i16 hh = __builtin_amdgcn_ds_read_tr16_b64_v4i16((FS_LAS fa::v4i16*)(lds + vfo[j] + s * 4096 + 1024));
                const fa::bf16x8 vf = (fa::bf16x8){lo[0], lo[1], lo[2], lo[3], hh[0], hh[1], hh[2], hh[3]};
                acc[j] = __builtin_amdgcn_mfma_f32_32x32x16_bf16(vf, wf, acc[j], 0, 0, 0); }
        }
        { const int tt = 32 * tb + r32; const float bb = bsp[g * CHUNK + tt]; const size_t rw = (size_t)(row0 + tt);
#pragma unroll
          for (int j = 0; j < 2; ++j)
#pragma unroll
              for (int g4 = 0; g4 < 4; ++g4) { const int d = 32 * (2 * dh + j) + 8 * g4 + 4 * hi; const u32x2 uu = *(const u32x2*)(U + rw * 1024 + g * 128 + d);
                  const float u0 = __uint_as_float(uu.x << 16), u1 = __uint_as_float(uu.x & 0xffff0000u), u2 = __uint_as_float(uu.y << 16), u3 = __uint_as_float(uu.y & 0xffff0000u);
                  u32x2 w; w.x = fa::cvtpk(u0 * (acc[j][4 * g4] + bb), u1 * (acc[j][4 * g4 + 1] + bb)); w.y = fa::cvtpk(u2 * (acc[j][4 * g4 + 2] + bb), u3 * (acc[j][4 * g4 + 3] + bb));
                  *(u32x2*)(MIXIN + rw * 2048 + g * 128 + d) = w; } }
        __syncthreads();
    }
}
}


#define XB_TMO      128
#define XB_XCNT(j)  (256  + 64 * (j))
#define XB_XSUB(j)  (1280 + 64 * (j))
#define XB_XGEN(j)  (2304 + 64 * (j))
#define XB_TOP      3328
#define XB_TOPGEN   3392
#define XCD_BAR_WORDS 3456
#define XB_SPIN_CAP (1u << 18)
#define XLAS __attribute__((address_space(3)))
__device__ __forceinline__ unsigned xb_ld(unsigned* p)              { return __hip_atomic_load(p, __ATOMIC_RELAXED, __HIP_MEMORY_SCOPE_AGENT); }
__device__ __forceinline__ unsigned xb_add(unsigned* p, unsigned v) { return __hip_atomic_fetch_add(p, v, __ATOMIC_RELAXED, __HIP_MEMORY_SCOPE_AGENT); }
__device__ __forceinline__ unsigned xb_xcc_id() { return (unsigned)__builtin_amdgcn_s_getreg((3 << 11) | 20) & 0xFu; }
#define XB_SPIN(cond, bar) do { unsigned _sp = 0; while (cond) { __builtin_amdgcn_s_sleep(1); \
    if ((++_sp & 255u) == 0u) { if (xb_ld(&(bar)[XB_TMO])) break; if (_sp > XB_SPIN_CAP) { atomicAdd(&(bar)[XB_TMO], 1u); break; } } } } while (0)
struct XcdBarrier { unsigned* bar; unsigned x; volatile XLAS unsigned* st; };
__device__ __forceinline__ XcdBarrier xcd_barrier_post(unsigned* bar, volatile XLAS unsigned* st) {
    XcdBarrier b; b.bar = bar; b.x = xb_xcc_id(); b.st = st;
    if (threadIdx.x == 0) (void)xb_add(&bar[XB_XCNT(b.x)], 1u);
    return b;
}
__device__ __forceinline__ void xcd_barrier_complete(unsigned* bar, unsigned x, unsigned& nloc, unsigned& nx) {
    const unsigned G = gridDim.x * gridDim.y * gridDim.z;
    unsigned sum, cnt, mine, sp = 0u;
    for (;;) {
        sum = 0u; cnt = 0u; mine = 0u;
#pragma unroll
        for (unsigned j = 0; j < 16; ++j) { const unsigned c = xb_ld(&bar[XB_XCNT(j)]); sum += c; cnt += (c > 0u) ? 1u : 0u; mine = (j == x) ? c : mine; }
        if (sum == G) break;
        __builtin_amdgcn_s_sleep(1);
        if ((++sp & 255u) == 0u) { if (xb_ld(&bar[XB_TMO])) break; if (sp > XB_SPIN_CAP) { atomicAdd(&bar[XB_TMO], 1u); break; } }
    }
    nloc = mine > 0u ? mine : 1u; nx = cnt > 0u ? cnt : 1u;
}
__device__ __forceinline__ void xcd_barrier(const XcdBarrier& b) {
    asm volatile("s_waitcnt vmcnt(0)" ::: "memory");
    __syncthreads();
    if (threadIdx.x == 0) {
        unsigned* bar = b.bar;
        __builtin_amdgcn_s_waitcnt(0);
        unsigned nloc = b.st[0], nx = b.st[1];
        if (nloc == 0u) { xcd_barrier_complete(bar, b.x, nloc, nx); b.st[0] = nloc; b.st[1] = nx; }
        const unsigned old = xb_add(&bar[XB_XSUB(b.x)], 1u);
        const unsigned gen = old / nloc;
        if (old + 1u == (gen + 1u) * nloc) {
            __builtin_amdgcn_fence(__ATOMIC_RELEASE, "agent");
            asm volatile("s_waitcnt vmcnt(0)" ::: "memory");
            const unsigned og = xb_add(&bar[XB_TOP], 1u);
            const unsigned tg = og / nx;
            if (og + 1u == (tg + 1u) * nx) xb_add(&bar[XB_TOPGEN], 1u);
            else XB_SPIN(xb_ld(&bar[XB_TOPGEN]) == tg, bar);
            __builtin_amdgcn_fence(__ATOMIC_ACQUIRE, "agent");
            xb_add(&bar[XB_XGEN(b.x)], 1u);
            asm volatile("s_waitcnt vmcnt(0)" ::: "memory");
        } else {
            XB_SPIN(xb_ld(&bar[XB_XGEN(b.x)]) == gen, bar);
            __builtin_amdgcn_fence(__ATOMIC_ACQUIRE, "agent");
            asm volatile("s_waitcnt vmcnt(0)" ::: "memory");
        }
    }
    __syncthreads();
}
constexpr int CW_BAR = 4096;
constexpr size_t CTL_ZERO_BYTES = 65536;
constexpr int LDS_BARST_OFF = LDS_BYTES - 16;

constexpr bool FAST_P1 = true, FAST_P3 = true, FAST_P4 = true, FAST_P6 = true, FAST_P7 = true;
constexpr bool FAST_ATTN = true, FAST_SGU = true;
constexpr bool FAST_ANY = FAST_P1 || FAST_P3 || FAST_P4 || FAST_P6 || FAST_P7;
constexpr int N_PHASES = 10;
__global__ void __launch_bounds__(NTHREADS, 2) fwd(Args A) {
    extern __shared__ __attribute__((aligned(16))) unsigned char lds[];
    float* ldsf = (float*)lds;
    const int lo = A.ph_lo, hi = A.ph_hi;
    if (threadIdx.x < 4) ((volatile XLAS unsigned*)((XLAS unsigned char*)lds + LDS_BARST_OFF))[threadIdx.x] = 0u;
    __syncthreads();
    XcdBarrier bar = xcd_barrier_post((unsigned*)(A.ws + WS_CTL) + CW_BAR, (volatile XLAS unsigned*)((XLAS unsigned char*)lds + LDS_BARST_OFF));
#define IN(k) (lo <= (k) && (k) < hi)
#define SEAM(k) do { if (IN(k) && IN((k) + 1)) xcd_barrier(bar); STAMP((k) + 1); } while (0)
    unsigned long long t_lo = 0, t_hi = 0;
#define STAMP(i) do { if (STAMP_PHASE >= 0) { if ((i) == STAMP_PHASE || (STAMP_PHASE == 98 && (i) == 0)) t_lo = __builtin_amdgcn_s_memrealtime(); if ((i) == STAMP_PHASE + 1 || (STAMP_PHASE == 98 && (i) == 9)) t_hi = __builtin_amdgcn_s_memrealtime(); } } while (0)
    STAMP(0);
    PG8_LAS unsigned char* l3 = (PG8_LAS unsigned char*)lds;
    if (IN(0)) { if (FAST_ANY) { p0_weights(A, l3, 0, 0); __syncthreads(); } p0_router_weights(A); p0_rows(A, ldsf); } SEAM(0);
    if (IN(1)) { if (FAST_P1) p1_fast(A, l3); else p1_naive(A, ldsf); if (FAST_ANY) { __syncthreads(); p0_weights(A, l3, 1, (1152 % (int)gridDim.x == 0) ? 0 : 1152 % (int)gridDim.x); } } SEAM(1);
    if (!(FAST_P1 && FAST_SGU && FAST_ATTN)) { if (IN(2)) { p1b_fix<0>(A, ldsf); } SEAM(2); }
    if (IN(3)) { if (FAST_SGU) fs::sgu_phase(A, l3); else p2_sgu_naive(A); if (FAST_ATTN) { __syncthreads(); fa::attn_phase(A, l3); } else p2_attn_naive(A, ldsf); } SEAM(3);
    if (IN(4)) { if (FAST_P3) p3_fast(A, l3); else p3_naive(A, ldsf); } SEAM(4);
    if (IN(5)) { if (FAST_P4) p4_fast(A, l3); else p4_naive(A, ldsf); } SEAM(5);
    if (IN(6)) { if (PROBE_ALT == 6) { p5_router3<1>(A, ldsf); __syncthreads(); } if (PROBE_ALT == 62) { p5_router3<2>(A, ldsf); __syncthreads(); } if (PROBE_ALT == 63) { p5_router3<3>(A, ldsf); __syncthreads(); } p5_router3<0>(A, ldsf); } SEAM(6);
    if (IN(7)) { if (FAST_P6) p6_fast(A, l3); else p6_naive(A, ldsf); } SEAM(7);
    if (IN(8)) { if (FAST_P7) p7_fast(A, l3); else p7_naive(A, ldsf); } SEAM(8);
    if (IN(9)) { if (PROBE_ALT == 9) { p8_combine<1>(A, ldsf); __syncthreads(); } p8_combine<0>(A, ldsf, STAMP_PHASE < 0 ? 0.f : (STAMP_PHASE == 99 ? 1.0f : (float)(t_hi - t_lo) * 0.01f * 0.001f * STAMP_SCALE)); }
#undef IN
#undef SEAM
}

#ifndef MK_N_LAUNCHES
#define MK_N_LAUNCHES 1
#endif
extern "C" void kernel_launch(void* const* d_in, const int* in_sizes, int n_in, void* d_out, int out_size, void* d_ws, size_t ws_size, hipStream_t stream) {
    static int grid = 0;
    if (grid == 0) {
        if (n_in != 22 || out_size != T * DM || ws_size < WS_END) { fprintf(stderr, "kernel_launch: unexpected shapes (n_in %d out %d ws %zu)\n", n_in, out_size, ws_size); grid = -1; return; }
        int dev = 0, cus = 0, per_cu = 0;
        hipGetDevice(&dev); hipDeviceGetAttribute(&cus, hipDeviceAttributeMultiprocessorCount, dev);
        hipFuncSetAttribute((const void*)fwd, hipFuncAttributeMaxDynamicSharedMemorySize, LDS_BYTES);
        hipOccupancyMaxActiveBlocksPerMultiprocessor(&per_cu, (const void*)fwd, NTHREADS, LDS_BYTES);
        if (per_cu < 1) { fprintf(stderr, "kernel_launch: occupancy query says %d blocks per CU\n", per_cu); per_cu = 1; }
        (void)hipGetLastError();
        grid = cus;
    }
    if (grid < 0) return;
    Args a{};
    for (int i = 0; i < 22; ++i) a.in[i] = (const float*)d_in[i];
    a.out = (float*)d_out; a.ws = (unsigned char*)d_ws;
    if (hipMemsetAsync((char*)d_ws + WS_CTL, 0, CTL_ZERO_BYTES, stream) != hipSuccess) { fprintf(stderr, "kernel_launch: memset failed\n"); return; }
    if (MK_N_LAUNCHES == 1) {
        a.ph_lo = 0; a.ph_hi = N_PHASES;
        hipLaunchKernelGGL(fwd, dim3(grid), dim3(NTHREADS), LDS_BYTES, stream, a);
    } else {
        for (int p = 0; p < N_PHASES; ++p) { a.ph_lo = p; a.ph_hi = p + 1; hipLaunchKernelGGL(fwd, dim3(grid), dim3(NTHREADS), LDS_BYTES, stream, a); }
    }
}
```

```cpp
#include <hip/hip_runtime.h>
#include <hip/hip_cooperative_groups.h>
#include <cstdio>
#include <cstdint>
namespace cg = cooperative_groups;

#ifndef STAMP_PHASE
#define STAMP_PHASE -1
#endif
#ifndef STAMP_SEL
#define STAMP_SEL 0
#endif
#ifndef STAMP_SCALE
#define STAMP_SCALE 0.5f
#endif
#ifndef PROBE_REP_P1
#define PROBE_REP_P1 1
#endif
#ifndef PROBE_REP_P4
#define PROBE_REP_P4 1
#endif
#ifndef PROBE_REP_P5
#define PROBE_REP_P5 1
#endif
#ifndef PROBE_REP_MOE
#define PROBE_REP_MOE 1
#endif
#ifndef PROBE_REP_ATTN
#define PROBE_REP_ATTN 1
#endif
#ifndef PROBE_REP_SGU
#define PROBE_REP_SGU 1
#endif
#ifndef PROBE_ATTN_VAR
#define PROBE_ATTN_VAR 0
#endif
#ifndef PROBE_ALT
#define PROBE_ALT -1
#endif
constexpr int T = 8192, SEQ = 2048, NB = 4, DM = 2048, SGUW = 1024, FOXW = 1024, NH = 8, HD = 128, CHUNK = 128, NG = 8;
constexpr int INCOLS = 9224, OFF_F = 5120, OFF_GATE = 5128;
constexpr int NEXP = 32, EPG = 8, NGRP = 4, DEXP = 512;
constexpr float EPS = 1e-6f;
constexpr float LOG2E = 1.4426950408889634f;
constexpr float QSCALE = 0.08838834764831845f * LOG2E;
constexpr int NTHREADS = 512, NWAVES = 8;
constexpr int LDS_BYTES = 160 * 1024;
constexpr int MTILE = 256;
constexpr int PMAX = 2 * T + NEXP * MTILE;
constexpr int MT_MAX = PMAX / MTILE;
constexpr int TINY_ROWS = 0;

typedef unsigned short bf16_t;
typedef float f32x4 __attribute__((ext_vector_type(4)));
typedef unsigned u32x4 __attribute__((ext_vector_type(4)));
typedef unsigned u32x2 __attribute__((ext_vector_type(2)));

constexpr size_t MiB = 1u << 20;
constexpr size_t WS_CTL = 0;
constexpr size_t WS_LOGF = 1 * MiB;
constexpr size_t WS_CKL = 2 * MiB;
constexpr size_t WS_TOK = 3 * MiB;
constexpr size_t WS_GATE = 4 * MiB;
constexpr size_t WS_ASG = 5 * MiB;
constexpr size_t WS_WIN = 8 * MiB;
constexpr size_t WS_WPROJ = 44 * MiB;
constexpr size_t WS_WOUT = 52 * MiB;
constexpr size_t WS_WGU = 60 * MiB;
constexpr size_t WS_WD = 188 * MiB;
constexpr size_t WS_H = 252 * MiB;
constexpr size_t WS_MIXED = WS_H;
constexpr size_t WS_U = 284 * MiB;
constexpr size_t WS_V = 300 * MiB;
constexpr size_t WS_G = 316 * MiB;
constexpr size_t WS_YBUF = WS_U;
constexpr size_t WS_Q = 380 * MiB;
constexpr size_t WS_K = 396 * MiB;
constexpr size_t WS_VA = 412 * MiB;
constexpr size_t WS_ACT = WS_Q;
constexpr size_t WS_MIXIN = 428 * MiB;
constexpr size_t WS_H2 = WS_MIXIN;
constexpr size_t WS_END = 460 * MiB;
static_assert((size_t)PMAX * 2048 * 2 <= 96 * MiB && (size_t)PMAX * 512 * 2 <= 32 * MiB, "overlay sizes");

constexpr int CW_CNT = 0;
constexpr int CNT_STRIDE = 64;

__device__ __forceinline__ float bf2f(bf16_t v) { return __uint_as_float((unsigned)v << 16); }
__device__ __forceinline__ bf16_t f2bf(float f) { unsigned u = __float_as_uint(f); return (bf16_t)((u + 0x7fffu + ((u >> 16) & 1u)) >> 16); }
__device__ __forceinline__ unsigned pk2(float lo, float hi) { return (unsigned)f2bf(lo) | ((unsigned)f2bf(hi) << 16); }
__device__ __forceinline__ unsigned cvtpk_rne(float lo, float hi) { unsigned r; asm("v_cvt_pk_bf16_f32 %0, %1, %2" : "=v"(r) : "v"(lo), "v"(hi)); return r; }
__device__ __forceinline__ float wave_sum(float v) {
#pragma unroll
    for (int o = 1; o < 64; o <<= 1) v += __shfl_xor(v, o);
    return v;
}
__device__ __forceinline__ float wave_max(float v) {
#pragma unroll
    for (int o = 1; o < 64; o <<= 1) v = fmaxf(v, __shfl_xor(v, o));
    return v;
}
__device__ __forceinline__ float gelu_tanh(float x) {
    const float c = 0.7978845608028654f; const float y = c * (x + 0.044715f * x * x * x);
    return x / (1.0f + __expf(-2.0f * y));
}
__device__ __forceinline__ float sigmoidf_(float x) { return 1.0f / (1.0f + __expf(-x)); }
__device__ __forceinline__ float log_sigmoid(float z) { return fminf(z, 0.f) - log1pf(__expf(-fabsf(z))); }

struct Args {
    const float* in[22];
    float* out;
    unsigned char* ws;
    int ph_lo, ph_hi;
};

template <class AF, class BF, class EF>
__device__ __forceinline__ void naive_gemm_tile(float* lds, int m0, int n0, int M, int N, int K, int Ksplit, AF a, BF b, EF epi) {
    float* As = lds;
    float* Bs = lds + 16 * 132;
    const int tid = threadIdx.x, ty = tid >> 4, tx = tid & 15;
    float acc[4][8], acc1[4][8];
#pragma unroll
    for (int i = 0; i < 4; ++i)
#pragma unroll
        for (int j = 0; j < 8; ++j) { acc[i][j] = 0.f; acc1[i][j] = 0.f; }
    const bool split = Ksplit < K;
#pragma unroll 1
    for (int pass = 0; pass < 2; ++pass) {
        const int kb = pass == 0 ? 0 : Ksplit, ke = pass == 0 ? (split ? Ksplit : K) : K;
        if (pass == 1) {
            if (!split) break;
#pragma unroll
            for (int i = 0; i < 4; ++i)
#pragma unroll
                for (int j = 0; j < 8; ++j) { acc1[i][j] = acc[i][j]; acc[i][j] = 0.f; }
        }
#pragma unroll 1
        for (int k0 = kb; k0 < ke; k0 += 16) {
#pragma unroll
            for (int i = 0; i < 4; ++i) { const int idx = tid + i * 512, r = idx >> 4, kk = idx & 15; const int m = m0 + r; As[kk * 132 + r] = (m < M) ? a(m, k0 + kk) : 0.f; }
#pragma unroll
            for (int i = 0; i < 4; ++i) { const int idx = tid + i * 512, kk = idx >> 7, n = idx & 127; Bs[kk * 132 + n] = (n0 + n < N) ? b(k0 + kk, n0 + n) : 0.f; }
            __syncthreads();
#pragma unroll 4
            for (int kk = 0; kk < 16; ++kk) {
                float av[4], bv[8];
#pragma unroll
                for (int i = 0; i < 4; ++i) av[i] = As[kk * 132 + ty * 4 + i];
#pragma unroll
                for (int j = 0; j < 8; ++j) bv[j] = Bs[kk * 132 + tx * 8 + j];
#pragma unroll
                for (int i = 0; i < 4; ++i)
#pragma unroll
                    for (int j = 0; j < 8; ++j) acc[i][j] = fmaf(av[i], bv[j], acc[i][j]);
            }
            __syncthreads();
        }
    }
#pragma unroll
    for (int i = 0; i < 4; ++i)
#pragma unroll
        for (int j = 0; j < 8; ++j) { const int m = m0 + ty * 4 + i, n = n0 + tx * 8 + j; if (m < M && n < N) epi(m, n, split ? acc1[i][j] : acc[i][j], split ? acc[i][j] : 0.f); }
}
template <class AF, class BF, class EF>
__device__ __forceinline__ void naive_gemm(float* lds, int M, int N, int K, int Ksplit, AF a, BF b, EF epi) {
    const int ntm = (M + 127) / 128, ntn = (N + 127) / 128;
    for (int t = blockIdx.x; t < ntm * ntn; t += gridDim.x) naive_gemm_tile(lds, (t / ntn) * 128, (t % ntn) * 128, M, N, K, Ksplit, a, b, epi);
}

__device__ __forceinline__ void p0_rows(const Args& A, float* ldsf) {
    const float* x = A.in[0]; const float* g1 = A.in[1]; const float* w_in = A.in[2]; const float* b_forget = A.in[4];
    bf16_t* H = (bf16_t*)(A.ws + WS_H); float* LOGF = (float*)(A.ws + WS_LOGF);
    const int tid = threadIdx.x, lane = tid & 63, wave = tid >> 6;
    for (int i = tid; i < DM * 8; i += NTHREADS) ldsf[i] = w_in[(size_t)(i >> 3) * INCOLS + OFF_F + (i & 7)];
    __syncthreads();
    const int gw = blockIdx.x * NWAVES + wave, NGW = gridDim.x * NWAVES;
    for (int row = gw; row < T; row += NGW) {
        const f32x4* xr = (const f32x4*)(x + (size_t)row * DM) + lane;
        f32x4 xv[8]; float ss = 0.f;
#pragma unroll
        for (int j = 0; j < 8; ++j) xv[j] = xr[64 * j];
#pragma unroll
        for (int j = 0; j < 8; ++j) ss += xv[j].x * xv[j].x + xv[j].y * xv[j].y + xv[j].z * xv[j].z + xv[j].w * xv[j].w;
        const float rstd = rsqrtf(wave_sum(ss) * (1.f / DM) + EPS);
        float f[8];
#pragma unroll
        for (int h = 0; h < 8; ++h) f[h] = 0.f;
#pragma unroll
        for (int j = 0; j < 8; ++j) {
            const int c0 = 256 * j + 4 * lane; const f32x4 g = *(const f32x4*)(g1 + c0);
            f32x4 hv; hv.x = xv[j].x * rstd * g.x; hv.y = xv[j].y * rstd * g.y; hv.z = xv[j].z * rstd * g.z; hv.w = xv[j].w * rstd * g.w;
            u32x2 o; o.x = pk2(hv.x, hv.y); o.y = pk2(hv.z, hv.w);
            *(u32x2*)(H + (size_t)row * DM + c0) = o;
#pragma unroll
            for (int e = 0; e < 4; ++e) { const float hx = hv[e]; const float* wf = ldsf + (c0 + e) * 8;
#pragma unroll
                for (int h = 0; h < 8; ++h) f[h] = fmaf(hx, wf[h], f[h]); }
            asm volatile("" ::: "memory");
        }
#pragma unroll
        for (int h = 0; h < 8; ++h) f[h] = wave_sum(f[h]);
        if (lane < 8) { float z = 0.f;
#pragma unroll
            for (int h = 0; h < 8; ++h) if (lane == h) z = f[h];
            LOGF[(size_t)row * 8 + lane] = log_sigmoid(z + b_forget[lane]); }
    }
}

__device__ __forceinline__ void p1_naive(const Args& A, float* ldsf) {
    const bf16_t* H = (const bf16_t*)(A.ws + WS_H); const float* w_in = A.in[2]; const float* b_gate = A.in[3];
    bf16_t* U = (bf16_t*)(A.ws + WS_U); bf16_t* V = (bf16_t*)(A.ws + WS_V); bf16_t* Q = (bf16_t*)(A.ws + WS_Q); bf16_t* K = (bf16_t*)(A.ws + WS_K);
    bf16_t* VA = (bf16_t*)(A.ws + WS_VA); bf16_t* G = (bf16_t*)(A.ws + WS_G);
    naive_gemm(ldsf, T, 9216, DM, DM,
        [=](int m, int k) { return bf2f(H[(size_t)m * DM + k]); },
        [=](int k, int n) { const int c = n < 5120 ? n : n + 8; return w_in[(size_t)k * INCOLS + c]; },
        [=](int m, int n, float s, float) {
            if (n < 1024) U[(size_t)m * 1024 + n] = f2bf(gelu_tanh(s));
            else if (n < 2048) V[(size_t)m * 1024 + n - 1024] = f2bf(gelu_tanh(s));
            else if (n < 3072) Q[(size_t)m * 1024 + n - 2048] = f2bf(s);
            else if (n < 4096) K[(size_t)m * 1024 + n - 3072] = f2bf(s);
            else if (n < 5120) VA[(size_t)m * 1024 + n - 4096] = f2bf(s);
            else G[(size_t)m * 4096 + n - 5120] = f2bf(sigmoidf_(s + b_gate[n - 5120]));
        });
}

template <int ALT> __device__ __forceinline__ void p1b_fix(const Args& A, float* ldsf) {
    bf16_t* V = (bf16_t*)(A.ws + WS_V); bf16_t* Q = (bf16_t*)(A.ws + WS_Q); bf16_t* K = (bf16_t*)(A.ws + WS_K);
    const size_t altoff = ALT ? ((size_t)((unsigned char*)A.out - (A.ws + WS_V))) / 2 : 0;
    const size_t altq = ALT ? ((size_t)((unsigned char*)A.out + 16 * MiB - (A.ws + WS_Q))) / 2 : 0, altk = ALT ? ((size_t)((unsigned char*)A.out + 32 * MiB - (A.ws + WS_K))) / 2 : 0;
    const float* ln_g = A.in[5]; const float* ln_b = A.in[6]; const float* qg = A.in[9]; const float* kg = A.in[10];
    const int tid = threadIdx.x, lane = tid & 63, wave = tid >> 6;
    const int gw = blockIdx.x * NWAVES + wave, NGW = gridDim.x * NWAVES;
    for (int row = gw; row < T; row += NGW) {
        {
            bf16_t* vr = V + (size_t)row * 1024; float v[16]; float s = 0.f;
#pragma unroll
            for (int j = 0; j < 2; ++j) { const u32x4 w = *(const u32x4*)(vr + 512 * j + 8 * lane);
#pragma unroll
                for (int e = 0; e < 4; ++e) { v[8 * j + 2 * e] = __uint_as_float(w[e] << 16); v[8 * j + 2 * e + 1] = __uint_as_float(w[e] & 0xffff0000u); } }
#pragma unroll
            for (int i = 0; i < 16; ++i) s += v[i];
            const float mean = wave_sum(s) * (1.f / 1024.f); float q = 0.f;
#pragma unroll
            for (int i = 0; i < 16; ++i) { v[i] -= mean; q += v[i] * v[i]; }
            const float rstd = rsqrtf(wave_sum(q) * (1.f / 1024.f) + EPS);
#pragma unroll
            for (int j = 0; j < 2; ++j) { const int c0 = 512 * j + 8 * lane; u32x4 o;
#pragma unroll
                for (int e = 0; e < 4; ++e) o[e] = pk2(v[8 * j + 2 * e] * rstd * ln_g[c0 + 2 * e] + ln_b[c0 + 2 * e], v[8 * j + 2 * e + 1] * rstd * ln_g[c0 + 2 * e + 1] + ln_b[c0 + 2 * e + 1]);
                *(u32x4*)(vr + altoff + c0) = o; }
        }
#pragma unroll
        for (int which = 0; which < 2; ++which) {
            bf16_t* pr = (which == 0 ? Q : K) + (size_t)row * 1024 + 16 * lane; const float* gg = which == 0 ? qg : kg; float v[16]; float s = 0.f;
#pragma unroll
            for (int j = 0; j < 2; ++j) { const u32x4 w = *(const u32x4*)(pr + 8 * j);
#pragma unroll
                for (int e = 0; e < 4; ++e) { v[8 * j + 2 * e] = __uint_as_float(w[e] << 16); v[8 * j + 2 * e + 1] = __uint_as_float(w[e] & 0xffff0000u); } }
#pragma unroll
            for (int i = 0; i < 16; ++i) s += v[i] * v[i];
            s += __shfl_xor(s, 1); s += __shfl_xor(s, 2); s += __shfl_xor(s, 4);
            const float sc = rsqrtf(s * (1.f / 128.f) + EPS) * (which == 0 ? QSCALE : 1.f); const int d0 = (16 * lane) & 127;
#pragma unroll
            for (int j = 0; j < 2; ++j) { u32x4 o;
#pragma unroll
                for (int e = 0; e < 4; ++e) o[e] = pk2(v[8 * j + 2 * e] * sc * gg[d0 + 8 * j + 2 * e], v[8 * j + 2 * e + 1] * sc * gg[d0 + 8 * j + 2 * e + 1]);
                *(u32x4*)(pr + (which == 0 ? altq : altk) + 8 * j) = o; }
        }
    }
    if (blockIdx.x < NB * NH) {
        const int b = blockIdx.x / NH, h = blockIdx.x % NH; const float* LOGF = (const float*)(A.ws + WS_LOGF); float* CKL = (float*)(A.ws + WS_CKL) + (size_t)blockIdx.x * SEQ + (ALT ? 65536 : 0);
        float v[4]; float s = 0.f;
#pragma unroll
        for (int i = 0; i < 4; ++i) { v[i] = LOGF[(size_t)(b * SEQ + tid * 4 + i) * 8 + h]; s += v[i]; }
        float incl = s;
#pragma unroll
        for (int o = 1; o < 64; o <<= 1) { const float t = __shfl_up(incl, o); if (lane >= o) incl += t; }
        __syncthreads();
        if (lane == 63) ldsf[wave] = incl;
        __syncthreads();
        float base = 0.f;
        for (int w = 0; w < wave; ++w) base += ldsf[w];
        float run = base + incl - s;
#pragma unroll
        for (int i = 0; i < 4; ++i) { run += v[i]; CKL[tid * 4 + i] = run * LOG2E; }
        __syncthreads();
    }
}


__device__ __forceinline__ void cumsum_bh(const Args& A, int bh, float* ldsf) {
    const int tid = threadIdx.x, lane = tid & 63, wave = tid >> 6, b = bh / NH, h = bh % NH;
    const float* LOGF = (const float*)(A.ws + WS_LOGF); float* CKL = (float*)(A.ws + WS_CKL) + (size_t)bh * SEQ;
    float v[4]; float sm = 0.f;
#pragma unroll
    for (int i = 0; i < 4; ++i) { v[i] = LOGF[(size_t)(b * SEQ + tid * 4 + i) * 8 + h]; sm += v[i]; }
    float incl = sm;
#pragma unroll
    for (int o = 1; o < 64; o <<= 1) { const float t = __shfl_up(incl, o); if (lane >= o) incl += t; }
    if (lane == 63) ldsf[wave] = incl;
    __syncthreads();
    float run = incl - sm;
    for (int w = 0; w < wave; ++w) run += ldsf[w];
    f32x4 o4;
#pragma unroll
    for (int i = 0; i < 4; ++i) { run += v[i]; o4[i] = run * LOG2E; }
    *(f32x4*)(CKL + tid * 4) = o4;
    __syncthreads();
}

__device__ __forceinline__ void p2_sgu_naive(const Args& A) {
    const bf16_t* U = (const bf16_t*)(A.ws + WS_U); const bf16_t* V = (const bf16_t*)(A.ws + WS_V); bf16_t* MIXIN = (bf16_t*)(A.ws + WS_MIXIN);
    const float* wsp = A.in[7]; const float* bsp = A.in[8];
    const int tid = threadIdx.x, tt = tid >> 2, dp = tid & 3;
    for (int u = blockIdx.x; u < (T / CHUNK) * NG; u += gridDim.x) {
        const int rc = u / NG, g = u % NG; const int row0 = rc * CHUNK;
        float acc[32];
#pragma unroll
        for (int i = 0; i < 32; ++i) acc[i] = 0.f;
        for (int ss = 0; ss <= tt; ++ss) {
            const float w = wsp[((size_t)g * CHUNK + tt) * CHUNK + ss];
            const bf16_t* vr = V + (size_t)(row0 + ss) * 1024 + g * 128 + dp * 32;
#pragma unroll
            for (int i = 0; i < 32; ++i) acc[i] = fmaf(w, bf2f(vr[i]), acc[i]);
        }
        const float bb = bsp[g * CHUNK + tt];
        const bf16_t* ur = U + (size_t)(row0 + tt) * 1024 + g * 128 + dp * 32; bf16_t* orow = MIXIN + (size_t)(row0 + tt) * 2048 + g * 128 + dp * 32;
#pragma unroll
        for (int i = 0; i < 32; ++i) orow[i] = f2bf(bf2f(ur[i]) * (acc[i] + bb));
    }
}
__device__ __forceinline__ void p2_attn_naive(const Args& A, float* ldsf) {
    const bf16_t* Q = (const bf16_t*)(A.ws + WS_Q); const bf16_t* K = (const bf16_t*)(A.ws + WS_K); const bf16_t* VA = (const bf16_t*)(A.ws + WS_VA);
    const float* CKL = (const float*)(A.ws + WS_CKL); bf16_t* MIXIN = (bf16_t*)(A.ws + WS_MIXIN);
    const int tid = threadIdx.x, lane = tid & 63, wave = tid >> 6;
    float* qs = ldsf + wave * 128;
    const int gw = blockIdx.x * NWAVES + wave, NGW = gridDim.x * NWAVES;
    for (int item = gw; item < T * NH; item += NGW) {
        const int row = item / NH, h = item % NH, b = row / SEQ, t = row % SEQ;
        const bf16_t* qr = Q + (size_t)row * 1024 + h * 128;
        qs[lane] = bf2f(qr[lane]); qs[64 + lane] = bf2f(qr[64 + lane]);
        __builtin_amdgcn_s_waitcnt(0);
        const float* ck = CKL + (size_t)(b * NH + h) * SEQ;
        float m = -1e30f, l = 0.f, o0 = 0.f, o1 = 0.f;
        for (int s0 = 0; s0 <= t; s0 += 64) {
            const int s = s0 + lane; float sc = -INFINITY;
            if (s <= t) { const bf16_t* kr = K + (size_t)(b * SEQ + s) * 1024 + h * 128; float d = 0.f;
                for (int c = 0; c < 16; ++c) { const u32x4 w = *(const u32x4*)(kr + 8 * c);
#pragma unroll
                    for (int e = 0; e < 4; ++e) { d = fmaf(qs[8 * c + 2 * e], __uint_as_float(w[e] << 16), d); d = fmaf(qs[8 * c + 2 * e + 1], __uint_as_float(w[e] & 0xffff0000u), d); } }
                sc = d - ck[s]; }
            const float mn = fmaxf(m, wave_max(sc)); const float alpha = exp2f(m - mn); const float p = exp2f(sc - mn);
            l = l * alpha + wave_sum(p); o0 *= alpha; o1 *= alpha; m = mn;
            const int nk = min(64, t - s0 + 1);
            for (int j = 0; j < nk; ++j) { const float pj = __shfl(p, j); const unsigned w = *(const unsigned*)(VA + (size_t)(b * SEQ + s0 + j) * 1024 + h * 128 + 2 * lane);
                o0 = fmaf(pj, __uint_as_float(w << 16), o0); o1 = fmaf(pj, __uint_as_float(w & 0xffff0000u), o1); }
        }
        const float il = 1.f / l;
        *(unsigned*)(MIXIN + (size_t)row * 2048 + 1024 + h * 128 + 2 * lane) = pk2(o0 * il, o1 * il);
    }
}

__device__ __forceinline__ void p3_naive(const Args& A, float* ldsf) {
    const bf16_t* MIXIN = (const bf16_t*)(A.ws + WS_MIXIN); const bf16_t* G = (const bf16_t*)(A.ws + WS_G); bf16_t* MIXED = (bf16_t*)(A.ws + WS_MIXED);
    const float* wps = A.in[11]; const float* wpf = A.in[12];
    naive_gemm(ldsf, T, DM, 2048, 1024,
        [=](int m, int k) { return bf2f(MIXIN[(size_t)m * 2048 + k]); },
        [=](int k, int n) { return k < 1024 ? wps[(size_t)k * DM + n] : wpf[(size_t)(k - 1024) * DM + n]; },
        [=](int m, int n, float s1, float s2) { MIXED[(size_t)m * DM + n] = f2bf(bf2f(G[(size_t)m * 4096 + n]) * s1 + bf2f(G[(size_t)m * 4096 + 2048 + n]) * s2); });
}
__device__ __forceinline__ void p4_naive(const Args& A, float* ldsf) {
    const bf16_t* MIXED = (const bf16_t*)(A.ws + WS_MIXED); const float* wo = A.in[13]; const float* x = A.in[0]; float* X1 = A.out;
    naive_gemm(ldsf, T, DM, DM, DM,
        [=](int m, int k) { return bf2f(MIXED[(size_t)m * DM + k]); },
        [=](int k, int n) { return wo[(size_t)k * DM + n]; },
        [=](int m, int n, float s, float) { X1[(size_t)m * DM + n] = x[(size_t)m * DM + n] + s; });
}

template <int ALT> __device__ __forceinline__ void p5_router(const Args& A, float* ldsf) {
    const float* X1 = A.out; const float* g2 = A.in[14]; const float* wrg = A.in[15]; const float* brg = A.in[16]; const float* wre = A.in[17]; const float* bre = A.in[18];
    bf16_t* H2 = (bf16_t*)(A.ws + WS_H2); unsigned* cnt = (unsigned*)(A.ws + WS_CTL) + CW_CNT + (ALT ? 2048 : 0);
    int* TOK = (int*)(A.ws + (ALT ? WS_H : WS_TOK)); float* GATE = (float*)(A.ws + (ALT ? WS_H + 2 * MiB : WS_GATE)); int* ASG = (int*)(A.ws + (ALT ? WS_H + 4 * MiB : WS_ASG));
    const int tid = threadIdx.x, lane = tid & 63, wave = tid >> 6, r = tid >> 4, ks = tid & 15;
    float* Ws = ldsf;
    float* Xs = ldsf + 256 * 36;
    float* rs = Xs + 32 * 260;
    int* hist = (int*)(rs + 32);
    int* hbase = hist + 32;
    int* sel = hbase + 32;
    int* lpos = sel + 64;
    float* selw = (float*)(lpos + 64);
    for (int rb = blockIdx.x; rb < T / 32; rb += gridDim.x) {
        const int row0 = rb * 32;
        for (int i = 0; i < 4; ++i) { const int rr = wave * 4 + i; const f32x4* xr = (const f32x4*)(X1 + (size_t)(row0 + rr) * DM) + lane; float ss = 0.f;
#pragma unroll
            for (int j = 0; j < 8; ++j) { const f32x4 v = xr[64 * j]; ss += v.x * v.x + v.y * v.y + v.z * v.z + v.w * v.w; }
            ss = wave_sum(ss); if (lane == 0) rs[rr] = rsqrtf(ss * (1.f / DM) + EPS); }
        if (tid < 32) hist[tid] = 0;
        __syncthreads();
        float acc[36];
#pragma unroll
        for (int j = 0; j < 36; ++j) acc[j] = 0.f;
        for (int k0 = 0; k0 < DM; k0 += 256) {
            for (int i = tid; i < 256 * 36; i += NTHREADS) { const int kk = i / 36, j = i % 36; Ws[i] = j < 4 ? wrg[(size_t)(k0 + kk) * 4 + j] : wre[(size_t)(k0 + kk) * 32 + j - 4]; }
            for (int i = tid; i < 32 * 256; i += NTHREADS) { const int rr = i >> 8, kk = i & 255; const float hv = X1[(size_t)(row0 + rr) * DM + k0 + kk] * rs[rr] * g2[k0 + kk];
                Xs[rr * 260 + kk] = hv; H2[(size_t)(row0 + rr) * DM + k0 + kk] = f2bf(hv); }
            __syncthreads();
            for (int kk = ks; kk < 256; kk += 16) { const float xv = Xs[r * 260 + kk]; const float* wr = Ws + kk * 36;
#pragma unroll
                for (int j = 0; j < 36; ++j) acc[j] = fmaf(xv, wr[j], acc[j]); }
            __syncthreads();
        }
#pragma unroll
        for (int j = 0; j < 36; ++j) { float v = acc[j]; v += __shfl_xor(v, 1); v += __shfl_xor(v, 2); v += __shfl_xor(v, 4); v += __shfl_xor(v, 8); acc[j] = v; }
        if (ks == 0) {
            float gl[4]; int grp = 0; float gm;
#pragma unroll
            for (int j = 0; j < 4; ++j) gl[j] = acc[j] + brg[j];
            gm = gl[0];
#pragma unroll
            for (int j = 1; j < 4; ++j) if (gl[j] > gm) { gm = gl[j]; grp = j; }
            float den = 0.f;
#pragma unroll
            for (int j = 0; j < 4; ++j) den += __expf(gl[j] - gm);
            const float pg = 1.f / den;
            float el[8];
#pragma unroll
            for (int j = 0; j < 8; ++j) { float v = 0.f;
#pragma unroll
                for (int g = 0; g < 4; ++g) if (g == grp) v = acc[4 + g * 8 + j] + bre[g * 8 + j];
                el[j] = v; }
            int i0 = 0; float v0 = el[0];
#pragma unroll
            for (int j = 1; j < 8; ++j) if (el[j] > v0) { v0 = el[j]; i0 = j; }
            int i1 = -1; float v1 = -INFINITY;
#pragma unroll
            for (int j = 0; j < 8; ++j) if (j != i0 && el[j] > v1) { v1 = el[j]; i1 = j; }
            const float e1 = __expf(v1 - v0); const float w0 = pg / (1.f + e1), w1 = pg * e1 / (1.f + e1);
            const int ea = grp * 8 + i0, eb = grp * 8 + i1;
            sel[r * 2] = ea; sel[r * 2 + 1] = eb; selw[r * 2] = w0; selw[r * 2 + 1] = w1;
            lpos[r * 2] = atomicAdd(&hist[ea], 1); lpos[r * 2 + 1] = atomicAdd(&hist[eb], 1);
        }
        __syncthreads();
        if (tid < 32) hbase[tid] = hist[tid] > 0 ? (int)atomicAdd(&cnt[(tid) * CNT_STRIDE], (unsigned)hist[tid]) : 0;
        __syncthreads();
        if (tid < 64) { const int e = sel[tid], pos = hbase[e] + lpos[tid]; const int tok = row0 + (tid >> 1);
            TOK[(size_t)e * T + pos] = tok; GATE[(size_t)e * T + pos] = selw[tid]; ASG[tok * 2 + (tid & 1)] = (e << 16) | pos; }
        __syncthreads();
    }
}

template <int ALT> __device__ __forceinline__ void p5_router2(const Args& A, float* ldsf) {
    const float* X1 = A.out; const float* g2 = A.in[14]; const float* wrg = A.in[15]; const float* brg = A.in[16]; const float* wre = A.in[17]; const float* bre = A.in[18];
    bf16_t* H2 = (bf16_t*)(A.ws + WS_H2); unsigned* cnt = (unsigned*)(A.ws + WS_CTL) + CW_CNT + (ALT ? 2048 : 0);
    int* TOK = (int*)(A.ws + (ALT ? WS_H : WS_TOK)); float* GATE = (float*)(A.ws + (ALT ? WS_H + 2 * MiB : WS_GATE)); int* ASG = (int*)(A.ws + (ALT ? WS_H + 4 * MiB : WS_ASG));
    const int tid = threadIdx.x, lane = tid & 63, wave = tid >> 6;
    constexpr int XP = 260, XB = 32 * XP, WP = 40, WB = 256 * WP;
    float* Xs = ldsf;
    float* Ws = ldsf + 2 * XB;
    float* misc = ldsf + 2 * XB + 2 * WB;
    float* rs = misc;
    float* lg = misc + 32;
    int* hist = (int*)(misc + 32 + 1280); int* hbase = hist + 32; int* sel = hbase + 32; int* lpos = sel + 64; float* selw = (float*)(lpos + 64);
    const int kh2 = lane >> 5, rp = (lane >> 1) & 15, cg = lane & 1;
    for (int rb = blockIdx.x; rb < T / 32; rb += gridDim.x) {
        const int row0 = rb * 32;
        float ssq[4] = {0.f, 0.f, 0.f, 0.f};
        float acc0[20], acc1[20];
#pragma unroll
        for (int j = 0; j < 20; ++j) { acc0[j] = 0.f; acc1[j] = 0.f; }
        if (tid < 32) hist[tid] = 0;
        f32x4 xr[4], wv[5], gv;
        for (int i = tid; i < 2 * 256; i += NTHREADS) *(f32x4*)(Ws + (i >> 8) * WB + (i & 255) * WP + 36) = (f32x4){0.f, 0.f, 0.f, 0.f};
#define R2_LOAD(k0) do { gv = *(const f32x4*)(g2 + (k0) + 4 * (tid & 63)); \
        _Pragma("unroll") for (int i = 0; i < 4; ++i) xr[i] = *(const f32x4*)(X1 + (size_t)(row0 + wave + 8 * i) * DM + (k0) + 4 * (tid & 63)); \
        _Pragma("unroll") for (int i = 0; i < 5; ++i) { const int idx = tid + i * 512; if (idx < 2304) { const int kk = idx / 9, j4 = idx - kk * 9; \
            wv[i] = j4 == 0 ? *(const f32x4*)(wrg + (size_t)((k0) + kk) * 4) : *(const f32x4*)(wre + (size_t)((k0) + kk) * 32 + 4 * (j4 - 1)); } } } while (0)
#define R2_STORE(buf) do { \
        _Pragma("unroll") for (int i = 0; i < 4; ++i) { ssq[i] += xr[i].x * xr[i].x + xr[i].y * xr[i].y + xr[i].z * xr[i].z + xr[i].w * xr[i].w; \
            *(f32x4*)(Xs + (buf) * XB + (wave + 8 * i) * XP + 4 * (tid & 63)) = xr[i] * gv; } \
        _Pragma("unroll") for (int i = 0; i < 5; ++i) { const int idx = tid + i * 512; if (idx < 2304) { const int kk = idx / 9, j4 = idx - kk * 9; *(f32x4*)(Ws + (buf) * WB + kk * WP + 4 * j4) = wv[i]; } } } while (0)
        R2_LOAD(0); R2_STORE(0);
        __syncthreads();
#pragma unroll 1
        for (int c = 0; c < 8; ++c) {
            const int buf = c & 1;
            if (c < 7) R2_LOAD((c + 1) * 256);
            const float* xa = Xs + buf * XB + (2 * rp) * XP + (wave * 2 + kh2) * 16; const float* wa = Ws + buf * WB + ((wave * 2 + kh2) * 16) * WP + 20 * cg;
#pragma unroll 1
            for (int k4 = 0; k4 < 4; ++k4) {
                const f32x4 x0 = *(const f32x4*)(xa + 4 * k4), x1 = *(const f32x4*)(xa + XP + 4 * k4);
#pragma unroll
                for (int kk = 0; kk < 4; ++kk) { const float* wr = wa + (4 * k4 + kk) * WP;
#pragma unroll
                    for (int j4 = 0; j4 < 5; ++j4) { const f32x4 w = *(const f32x4*)(wr + 4 * j4);
#pragma unroll
                        for (int e = 0; e < 4; ++e) { acc0[4 * j4 + e] = fmaf(x0[kk], w[e], acc0[4 * j4 + e]); acc1[4 * j4 + e] = fmaf(x1[kk], w[e], acc1[4 * j4 + e]); } }
                    asm volatile("" ::: "memory"); }
            }
            if (c < 7) R2_STORE(buf ^ 1);
            __syncthreads();
        }
#undef R2_LOAD
#undef R2_STORE
#pragma unroll
        for (int j = 0; j < 20; ++j) { acc0[j] += __shfl_xor(acc0[j], 32); acc1[j] += __shfl_xor(acc1[j], 32); }
        float* red = Xs;
        if (kh2 == 0) {
#pragma unroll
            for (int j = 0; j < 20; ++j) { red[(wave * 32 + 2 * rp) * 40 + 20 * cg + j] = acc0[j]; red[(wave * 32 + 2 * rp + 1) * 40 + 20 * cg + j] = acc1[j]; } }
#pragma unroll
        for (int i = 0; i < 4; ++i) { const float s = wave_sum(ssq[i]); if (lane == 0) rs[wave + 8 * i] = rsqrtf(s * (1.f / DM) + EPS); }
        __syncthreads();
        for (int i = tid; i < 32 * 40; i += NTHREADS) { float s = 0.f;
#pragma unroll
            for (int w = 0; w < 8; ++w) s += red[w * 1280 + i];
            lg[i] = s * rs[i / 40]; }
        __syncthreads();
#pragma unroll 1
        for (int i = 0; i < 4; ++i) { const int rr = wave + 8 * i; const float rstd = rs[rr]; const float* xp = X1 + (size_t)(row0 + rr) * DM; bf16_t* hp = H2 + (size_t)(row0 + rr) * DM;
#pragma unroll 2
            for (int j = 0; j < 8; ++j) { const int c0 = 256 * j + 4 * lane; const f32x4 v = *(const f32x4*)(xp + c0), g = *(const f32x4*)(g2 + c0);
                u32x2 o; o.x = pk2(v.x * rstd * g.x, v.y * rstd * g.y); o.y = pk2(v.z * rstd * g.z, v.w * rstd * g.w); *(u32x2*)(hp + c0) = o; } }
        if (tid < 32) {
            const int r = tid; const float* L = lg + r * 40;
            float gl[4]; int grp = 0;
#pragma unroll
            for (int j = 0; j < 4; ++j) gl[j] = L[j] + brg[j];
            float gm = gl[0];
#pragma unroll
            for (int j = 1; j < 4; ++j) if (gl[j] > gm) { gm = gl[j]; grp = j; }
            float den = 0.f;
#pragma unroll
            for (int j = 0; j < 4; ++j) den += __expf(gl[j] - gm);
            const float pg = 1.f / den;
            float el[8];
#pragma unroll
            for (int j = 0; j < 8; ++j) el[j] = L[4 + grp * 8 + j] + bre[grp * 8 + j];
            int i0 = 0; float v0 = el[0];
#pragma unroll
            for (int j = 1; j < 8; ++j) if (el[j] > v0) { v0 = el[j]; i0 = j; }
            int i1 = -1; float v1 = -INFINITY;
#pragma unroll
            for (int j = 0; j < 8; ++j) if (j != i0 && el[j] > v1) { v1 = el[j]; i1 = j; }
            const float e1 = __expf(v1 - v0); const float w0 = pg / (1.f + e1), w1 = pg * e1 / (1.f + e1);
            const int ea = grp * 8 + i0, eb = grp * 8 + i1;
            sel[r * 2] = ea; sel[r * 2 + 1] = eb; selw[r * 2] = w0; selw[r * 2 + 1] = w1;
            lpos[r * 2] = atomicAdd(&hist[ea], 1); lpos[r * 2 + 1] = atomicAdd(&hist[eb], 1);
        }
        __syncthreads();
        if (tid < 32) hbase[tid] = hist[tid] > 0 ? (int)atomicAdd(&cnt[(tid) * CNT_STRIDE], (unsigned)hist[tid]) : 0;
        __syncthreads();
        if (tid < 64) { const int e = sel[tid], pos = hbase[e] + lpos[tid]; const int tok = row0 + (tid >> 1);
            TOK[(size_t)e * T + pos] = tok; GATE[(size_t)e * T + pos] = selw[tid]; ASG[tok * 2 + (tid & 1)] = (e << 16) | pos; }
        __syncthreads();
    }
}

constexpr size_t WS_WR = 7 * MiB;
__device__ __forceinline__ void p0_router_weights(const Args& A) {
    const float* g2 = A.in[14]; const float* wrg = A.in[15]; const float* wre = A.in[17]; bf16_t* WR = (bf16_t*)(A.ws + WS_WR);
    for (int i = blockIdx.x * NTHREADS + threadIdx.x; i < 64 * DM; i += gridDim.x * NTHREADS) { const int n = i >> 11, k = i & (DM - 1);
        const float w = n < 4 ? wrg[(size_t)k * 4 + n] * g2[k] : (n < 36 ? wre[(size_t)k * 32 + n - 4] * g2[k] : 0.f);
        const bf16_t h = f2bf(w); WR[i] = h; WR[64 * DM + i] = f2bf(w - bf2f(h)); }
}
constexpr size_t WS_RSTL = WS_CKL;
template <int ALT> __device__ __forceinline__ void p5_router3(const Args& A, float* ldsf) {
    float* RSTL = (float*)(A.ws + (ALT ? WS_H + 6 * MiB : WS_RSTL));
    typedef short bf16x8 __attribute__((ext_vector_type(8))); typedef float f32x16 __attribute__((ext_vector_type(16)));
    const float* X1 = A.out; const float* g2 = A.in[14]; const float* brg = A.in[16]; const float* bre = A.in[18]; const bf16_t* WR = (const bf16_t*)(A.ws + WS_WR);
    bf16_t* H2 = (bf16_t*)(A.ws + WS_H2); unsigned* cnt = (unsigned*)(A.ws + WS_CTL) + CW_CNT + (ALT ? 2048 : 0);
    int* TOK = (int*)(A.ws + (ALT ? WS_H : WS_TOK)); float* GATE = (float*)(A.ws + (ALT ? WS_H + 2 * MiB : WS_GATE)); int* ASG = (int*)(A.ws + (ALT ? WS_H + 4 * MiB : WS_ASG));
    const int tid = threadIdx.x, lane = tid & 63, wave = tid >> 6, r32 = lane & 31, hi = lane >> 5;
    float* red = ldsf;
    float* lg = ldsf + 16384;
    float* sq = lg + 2048;
    float* rs = sq + 256;
    int* hist = (int*)(rs + 32); int* hbase = hist + 32; int* sel = hbase + 32; int* lpos = sel + 64; float* selw = (float*)(lpos + 64);
    for (int rb = blockIdx.x; rb < T / 32; rb += gridDim.x) {
        const int row0 = rb * 32;
        if (tid < 32) hist[tid] = 0;
        const float* xp = X1 + (size_t)(row0 + r32) * DM + 256 * wave + 8 * hi;
        const bf16_t* wp = WR + (size_t)r32 * DM + 256 * wave + 8 * hi;
        f32x16 acc[2];
#pragma unroll
        for (int j = 0; j < 2; ++j)
#pragma unroll
            for (int r = 0; r < 16; ++r) acc[j][r] = 0.f;
        float ssq = 0.f;
        f32x4 xa[4], xb[4], xna[4], xnb[4];
#pragma unroll
        for (int i = 0; i < 4; ++i) { xa[i] = *(const f32x4*)(xp + 16 * i); xb[i] = *(const f32x4*)(xp + 16 * i + 4); }
#pragma unroll 1
        for (int kb = 0; kb < (ALT == 3 ? 0 : 4); ++kb) {
            bf16x8 wh0[4], wh1[4], wl0[4], wl1[4]; f32x4 ga[4], gb[4];
#pragma unroll
            for (int i = 0; i < 4; ++i) { const int ko = 64 * kb + 16 * i;
                wh0[i] = *(const bf16x8*)(wp + ko); wh1[i] = *(const bf16x8*)(wp + (size_t)32 * DM + ko); wl0[i] = *(const bf16x8*)(wp + (size_t)64 * DM + ko); wl1[i] = *(const bf16x8*)(wp + (size_t)96 * DM + ko);
                ga[i] = *(const f32x4*)(g2 + 256 * wave + 8 * hi + ko); gb[i] = *(const f32x4*)(g2 + 256 * wave + 8 * hi + ko + 4); }
            asm volatile("" ::: "memory");
            if (kb < 3) {
#pragma unroll
                for (int i = 0; i < 4; ++i) { xna[i] = *(const f32x4*)(xp + 64 * (kb + 1) + 16 * i); xnb[i] = *(const f32x4*)(xp + 64 * (kb + 1) + 16 * i + 4); } }
            asm volatile("" ::: "memory");
#pragma unroll
            for (int i = 0; i < 4; ++i) { const int ko = 64 * kb + 16 * i;
                { u32x4 hw; hw.x = cvtpk_rne(xa[i][0] * ga[i][0], xa[i][1] * ga[i][1]); hw.y = cvtpk_rne(xa[i][2] * ga[i][2], xa[i][3] * ga[i][3]); hw.z = cvtpk_rne(xb[i][0] * gb[i][0], xb[i][1] * gb[i][1]); hw.w = cvtpk_rne(xb[i][2] * gb[i][2], xb[i][3] * gb[i][3]);
                  *(u32x4*)(H2 + (size_t)(row0 + r32) * DM + 256 * wave + 8 * hi + ko) = hw; }
                float xv[8] = {xa[i][0], xa[i][1], xa[i][2], xa[i][3], xb[i][0], xb[i][1], xb[i][2], xb[i][3]}; u32x4 ph, pl;
#pragma unroll
                for (int e = 0; e < 4; ++e) { const float a = xv[2 * e], b2 = xv[2 * e + 1]; ssq += a * a + b2 * b2; const unsigned hh = cvtpk_rne(a, b2); ph[e] = hh;
                    pl[e] = cvtpk_rne(a - __uint_as_float(hh << 16), b2 - __uint_as_float(hh & 0xffff0000u)); }
                const bf16x8 xh = __builtin_bit_cast(bf16x8, ph), xl = __builtin_bit_cast(bf16x8, pl);
                acc[0] = __builtin_amdgcn_mfma_f32_32x32x16_bf16(xh, wh0[i], acc[0], 0, 0, 0); acc[0] = __builtin_amdgcn_mfma_f32_32x32x16_bf16(xl, wh0[i], acc[0], 0, 0, 0); acc[0] = __builtin_amdgcn_mfma_f32_32x32x16_bf16(xh, wl0[i], acc[0], 0, 0, 0);
                acc[1] = __builtin_amdgcn_mfma_f32_32x32x16_bf16(xh, wh1[i], acc[1], 0, 0, 0); acc[1] = __builtin_amdgcn_mfma_f32_32x32x16_bf16(xl, wh1[i], acc[1], 0, 0, 0); acc[1] = __builtin_amdgcn_mfma_f32_32x32x16_bf16(xh, wl1[i], acc[1], 0, 0, 0); }
#pragma unroll
            for (int i = 0; i < 4; ++i) { xa[i] = xna[i]; xb[i] = xnb[i]; }
        }
#pragma unroll
        for (int j = 0; j < 2; ++j)
#pragma unroll
            for (int r = 0; r < 16; ++r) red[((wave * 2 + j) * 16 + r) * 64 + lane] = acc[j][r];
        ssq += __shfl_xor(ssq, 32);
        if (hi == 0) sq[wave * 32 + r32] = ssq;
        __syncthreads();
        if (ALT == 2) continue;
#pragma unroll
        for (int j = 0; j < 2; ++j)
#pragma unroll
            for (int rr = 0; rr < 2; ++rr) { const int r = 2 * wave + rr; float s = 0.f;
#pragma unroll
                for (int w2 = 0; w2 < 8; ++w2) s += red[((w2 * 2 + j) * 16 + r) * 64 + lane];
                lg[((r & 3) + 8 * (r >> 2) + 4 * hi) * 64 + 32 * j + r32] = s; }
        if (tid < 32) { float s = 0.f;
#pragma unroll
            for (int w2 = 0; w2 < 8; ++w2) s += sq[w2 * 32 + tid];
            rs[tid] = rsqrtf(s * (1.f / DM) + EPS); }
        __syncthreads();
        if (tid < 32) {
            const int r = tid; const float* L = lg + r * 64; const float rstd = rs[r];
            float gl[4]; int grp = 0;
#pragma unroll
            for (int j = 0; j < 4; ++j) gl[j] = L[j] * rstd + brg[j];
            float gm = gl[0];
#pragma unroll
            for (int j = 1; j < 4; ++j) if (gl[j] > gm) { gm = gl[j]; grp = j; }
            float den = 0.f;
#pragma unroll
            for (int j = 0; j < 4; ++j) den += __expf(gl[j] - gm);
            const float pg = 1.f / den;
            float el[8];
#pragma unroll
            for (int j = 0; j < 8; ++j) el[j] = L[4 + grp * 8 + j] * rstd + bre[grp * 8 + j];
            int i0 = 0; float v0 = el[0];
#pragma unroll
            for (int j = 1; j < 8; ++j) if (el[j] > v0) { v0 = el[j]; i0 = j; }
            int i1 = -1; float v1 = -INFINITY;
#pragma unroll
            for (int j = 0; j < 8; ++j) if (j != i0 && el[j] > v1) { v1 = el[j]; i1 = j; }
            const float e1 = __expf(v1 - v0); const float w0 = pg / (1.f + e1), w1 = pg * e1 / (1.f + e1);
            const int ea = grp * 8 + i0, eb = grp * 8 + i1;
            sel[r * 2] = ea; sel[r * 2 + 1] = eb; selw[r * 2] = w0; selw[r * 2 + 1] = w1;
            lpos[r * 2] = atomicAdd(&hist[ea], 1); lpos[r * 2 + 1] = atomicAdd(&hist[eb], 1);
        }
        __syncthreads();
        if (tid < 32) hbase[tid] = hist[tid] > 0 ? (int)atomicAdd(&cnt[(tid) * CNT_STRIDE], (unsigned)hist[tid]) : 0;
        __syncthreads();
        if (tid < 64) { const int e = sel[tid], pos = hbase[e] + lpos[tid]; const int tok = row0 + (tid >> 1);
            TOK[(size_t)e * T + pos] = tok; GATE[(size_t)e * T + pos] = selw[tid]; RSTL[(size_t)e * T + pos] = rs[tid >> 1]; ASG[tok * 2 + (tid & 1)] = (e << 16) | pos; }
        __syncthreads();
    }
}

__device__ __forceinline__ void expert_layout(const unsigned* cnt, int* pstart  ) {
    int acc = 0;
    for (int e = 0; e < NEXP; ++e) { pstart[e] = acc; acc += ((int)cnt[(e) * CNT_STRIDE] + MTILE - 1) / MTILE * MTILE; }
    pstart[NEXP] = acc;
}

__device__ __forceinline__ void p6_naive(const Args& A, float* ldsf) {
    const bf16_t* H2 = (const bf16_t*)(A.ws + WS_H2); const float* wg = A.in[19]; const float* wu = A.in[20]; bf16_t* ACT = (bf16_t*)(A.ws + WS_ACT);
    const unsigned* cnt = (const unsigned*)(A.ws + WS_CTL) + CW_CNT; const int* TOK = (const int*)(A.ws + WS_TOK);
    int* ps = (int*)(ldsf + 2 * 16 * 132);
    if (threadIdx.x == 0) expert_layout(cnt, ps);
    __syncthreads();
    int ntot = 0;
    for (int e = 0; e < NEXP; ++e) ntot += (((int)cnt[(e) * CNT_STRIDE] + 127) / 128) * 4;
    for (int t = blockIdx.x; t < ntot; t += gridDim.x) {
        int e = 0, rem = t;
        for (; e < NEXP; ++e) { const int n = (((int)cnt[(e) * CNT_STRIDE] + 127) / 128) * 4; if (rem < n) break; rem -= n; }
        const int c = (int)cnt[(e) * CNT_STRIDE]; const int tm = rem / 4, tn = rem % 4; const int* tl = TOK + (size_t)e * T; const int prow = ps[e];
        const float* wge = wg + (size_t)e * DM * DEXP; const float* wue = wu + (size_t)e * DM * DEXP;
        naive_gemm_tile(ldsf, tm * 128, tn * 128, c, DEXP, 2 * DM, DM,
            [=](int m, int k) { return bf2f(H2[(size_t)tl[m] * DM + (k & (DM - 1))]); },
            [=](int k, int n) { return k < DM ? wge[(size_t)k * DEXP + n] : wue[(size_t)(k - DM) * DEXP + n]; },
            [=](int m, int n, float sg, float su) { ACT[(size_t)(prow + m) * DEXP + n] = f2bf(sg / (1.f + __expf(-sg)) * su); });
    }
}
__device__ __forceinline__ void p7_naive(const Args& A, float* ldsf) {
    const bf16_t* ACT = (const bf16_t*)(A.ws + WS_ACT); const float* wd = A.in[21]; bf16_t* YBUF = (bf16_t*)(A.ws + WS_YBUF);
    const unsigned* cnt = (const unsigned*)(A.ws + WS_CTL) + CW_CNT; const float* GATE = (const float*)(A.ws + WS_GATE);
    int* ps = (int*)(ldsf + 2 * 16 * 132);
    if (threadIdx.x == 0) expert_layout(cnt, ps);
    __syncthreads();
    int ntot = 0;
    for (int e = 0; e < NEXP; ++e) ntot += (((int)cnt[(e) * CNT_STRIDE] + 127) / 128) * 16;
    for (int t = blockIdx.x; t < ntot; t += gridDim.x) {
        int e = 0, rem = t;
        for (; e < NEXP; ++e) { const int n = (((int)cnt[(e) * CNT_STRIDE] + 127) / 128) * 16; if (rem < n) break; rem -= n; }
        const int c = (int)cnt[(e) * CNT_STRIDE]; const int tm = rem / 16, tn = rem % 16; const float* gl = GATE + (size_t)e * T; const int prow = ps[e];
        const float* wde = wd + (size_t)e * DEXP * DM;
        naive_gemm_tile(ldsf, tm * 128, tn * 128, c, DM, DEXP, DEXP,
            [=](int m, int k) { return bf2f(ACT[(size_t)(prow + m) * DEXP + k]); },
            [=](int k, int n) { return wde[(size_t)k * DM + n]; },
            [=](int m, int n, float s, float) { YBUF[(size_t)(prow + m) * DM + n] = f2bf(s * gl[m]); });
    }
}

template <int ALT> __device__ __forceinline__ void p8_combine(const Args& A, float* ldsf, const float dlt = 0.f) {
    float* X1 = A.out; float* XO = ALT ? (float*)(A.ws + WS_WGU) : A.out; const bf16_t* YBUF = (const bf16_t*)(A.ws + WS_YBUF); const int* ASG = (const int*)(A.ws + WS_ASG);
    const unsigned* cnt = (const unsigned*)(A.ws + WS_CTL) + CW_CNT;
    int* ps = (int*)ldsf;
    if (threadIdx.x == 0) expert_layout(cnt, ps);
    __syncthreads();
    float dl2 = dlt;
    if (STAMP_PHASE == 97) { int v = 0, mx = 0, mn = 1 << 30, nt_ = 0, tiny = 0, half = 0; for (int e = 0; e < NEXP; ++e) { const int c = (int)cnt[(e) * CNT_STRIDE]; mx = c > mx ? c : mx; mn = c < mn ? c : mn; nt_ += (c + 255) / 256; const int rem = c % 256; tiny += (rem > 0 && rem <= 64) ? 1 : 0; half += (rem > 0 && rem <= 128) ? 1 : 0; }
        v = STAMP_SEL == 0 ? nt_ : STAMP_SEL == 1 ? mx : STAMP_SEL == 2 ? mn : STAMP_SEL == 3 ? tiny : half; dl2 = 0.01f * (float)v; }
    const int tid = threadIdx.x, lane = tid & 63, wave = tid >> 6;
    const int gw = blockIdx.x * NWAVES + wave, NGW = gridDim.x * NWAVES;
    for (int row = gw; row < T; row += NGW) {
        const int a0 = ASG[row * 2], a1 = ASG[row * 2 + 1];
        const bf16_t* y0 = YBUF + (size_t)(ps[a0 >> 16] + (a0 & 0xffff)) * DM; const bf16_t* y1 = YBUF + (size_t)(ps[a1 >> 16] + (a1 & 0xffff)) * DM;
        const float* xr = X1 + (size_t)row * DM; float* xo = XO + (size_t)row * DM;
        u32x4 w0[4], w1[4]; f32x4 xa[4], xb[4];
#pragma unroll
        for (int j = 0; j < 4; ++j) { const int c0 = 512 * j + 8 * lane; w0[j] = *(const u32x4*)(y0 + c0); w1[j] = *(const u32x4*)(y1 + c0); xa[j] = *(const f32x4*)(xr + c0); xb[j] = *(const f32x4*)(xr + c0 + 4); }
#pragma unroll
        for (int j = 0; j < 4; ++j) { const int c0 = 512 * j + 8 * lane; f32x4 a = xa[j], b2 = xb[j];
            a.x += __uint_as_float(w0[j][0] << 16) + __uint_as_float(w1[j][0] << 16); a.y += __uint_as_float(w0[j][0] & 0xffff0000u) + __uint_as_float(w1[j][0] & 0xffff0000u);
            a.z += __uint_as_float(w0[j][1] << 16) + __uint_as_float(w1[j][1] << 16); a.w += __uint_as_float(w0[j][1] & 0xffff0000u) + __uint_as_float(w1[j][1] & 0xffff0000u);
            b2.x += __uint_as_float(w0[j][2] << 16) + __uint_as_float(w1[j][2] << 16); b2.y += __uint_as_float(w0[j][2] & 0xffff0000u) + __uint_as_float(w1[j][2] & 0xffff0000u);
            b2.z += __uint_as_float(w0[j][3] << 16) + __uint_as_float(w1[j][3] << 16); b2.w += __uint_as_float(w0[j][3] & 0xffff0000u) + __uint_as_float(w1[j][3] & 0xffff0000u);
            if (STAMP_PHASE >= 0) { a += dl2; b2 += dl2; }
            *(f32x4*)(xo + c0) = a; *(f32x4*)(xo + c0 + 4) = b2; }
    }
}

namespace pg8 {
#define PG8_LAS __attribute__((address_space(3)))
typedef short bf16x8 __attribute__((ext_vector_type(8)));
constexpr int BM = 256, BK = 64, HALF = 128, HTB = HALF * BK * 2, STAGE_BYTES = 8 * HTB, NXCD = 8, WGM = 8;
__host__ __device__ __forceinline__ int lds_byte(int r, int c) { const int st = (r >> 4) * 2 + (c >> 5), rr = r & 15, cc = c & 31, ob = rr * 64 + cc * 2; return st * 1024 + (ob ^ (((ob >> 9) & 1) << 5)); }
__host__ __device__ __forceinline__ void stage_rc(int b, int& R, int& C) { const int st = b / 1024, sb = b % 1024, swz = sb ^ (((sb >> 9) & 1) << 5); R = (st >> 1) * 16 + swz / 64; C = (st & 1) * 32 + (swz % 64) / 2; }
__host__ __device__ __forceinline__ int perm32(int rho) { const int n = rho >> 4, i = rho & 15; return 8 * (i >> 2) + 4 * n + (i & 3); }

struct Unit { const char* A; const char* B; int pm, pn, x0, x1, x2, x3; };

struct DenseOrder {
    const char* A; const char* Bt; int K, nM, nN, nwg, G, c, rep;
    __device__ void init(const void* A_, const void* Bt_, int M, int N, int K_, int G_, int c_, int rep_ = 1) { A = (const char*)A_; Bt = (const char*)Bt_; K = K_; nM = M / BM; nN = N / BM; nwg = nM * nN; G = G_; c = c_; rep = rep_; }
    __device__ bool next(int i, Unit& u) const {
        const long L = (long)i * G + c; if (L >= (long)nwg * rep) return false;
        int wgid = (int)(L % nwg); { const int q = nwg / NXCD, r = nwg % NXCD, xcd = wgid % NXCD, off = wgid / NXCD; wgid = (xcd < r ? xcd * (q + 1) : r * (q + 1) + (xcd - r) * q) + off; }
        const int nig = WGM * nN, gid = wgid / nig, fm = gid * WGM, gsz = (nM - fm) < WGM ? (nM - fm) : WGM;
        u.pm = fm + ((wgid % nig) % gsz); u.pn = (wgid % nig) / gsz; u.x0 = 0; u.x1 = 0; u.x2 = 0; u.x3 = 0;
        u.A = A + (size_t)u.pm * BM * K * 2; u.B = Bt + (size_t)u.pn * BM * K * 2; return true;
    }
    __device__ __forceinline__ void rows(const Unit&, unsigned (&)[2][2], const int (&)[2]) const {}
};

__device__ __forceinline__ unsigned cvt_pk_bf16(float lo, float hi) { unsigned r; asm volatile("v_cvt_pk_bf16_f32 %0, %1, %2" : "=v"(r) : "v"(lo), "v"(hi)); return r; }

template <class Epi, class Sched, bool ALIGN_EPI, bool GATHER, bool SKIP = false>
__device__ __forceinline__ void gemm_phase(PG8_LAS unsigned char* lds, const int K, const Sched& S, const Epi& E) {
    const int tid = threadIdx.x, wid = __builtin_amdgcn_readfirstlane(tid >> 6), lane = tid & 63, wr = wid >> 2, wc = wid & 3, fr = lane & 15, fq = lane >> 4;
    const int nt = K / BK;
    unsigned voffA[2], voffB[2]; int RA[2];
#pragma unroll
    for (int i = 0; i < 2; ++i) { int R, C; stage_rc(tid * 16 + i * 8192, R, C); const int Rb = Epi::PERM ? ((R & ~31) + perm32(R & 31)) : R;
        voffA[i] = GATHER ? (unsigned)(C * 2) : (unsigned)(R * K + C) * 2u; voffB[i] = (unsigned)(Rb * K + C) * 2u; RA[i] = R; }
    const size_t kstep = (size_t)(BK * 2);
    const size_t hstep = (size_t)HALF * K * 2;
    const size_t hstepA = GATHER ? 0 : hstep;
    const unsigned ldsw = (unsigned)wid * 1024u;
    const int aoff = lds_byte(wr * 64 + fr, fq * 8), boff = lds_byte(wc * 32 + fr, fq * 8);
    unsigned gA[2][2], gAn[2][2];
#define PG8_SA(b, h) (((b) * 2 + (h)) * HTB)
#define PG8_SB(b, h) ((4 + (b) * 2 + (h)) * HTB)
#define PG8_STAGE(bufoff, gbase, voff) do { _Pragma("unroll") for (int _i = 0; _i < 2; ++_i) \
        __builtin_amdgcn_global_load_lds((const unsigned*)((const char*)(gbase) + (voff)[_i]), (PG8_LAS unsigned*)(lds + (bufoff) + ldsw + _i * 8192), 16, 0, 0); } while (0)
#define PG8_STAGE_A(bufoff, gbase, h, nx) do { _Pragma("unroll") for (int _i = 0; _i < 2; ++_i) { \
        const unsigned _o = GATHER ? ((nx) ? gAn[h][_i] : gA[h][_i]) + voffA[_i] : voffA[_i]; \
        __builtin_amdgcn_global_load_lds((const unsigned*)((const char*)(gbase) + (h) * hstepA + _o), (PG8_LAS unsigned*)(lds + (bufoff) + ldsw + _i * 8192), 16, 0, 0); } } while (0)
#define PG8_LDA(dst, b, h) do { _Pragma("unroll") for (int m = 0; m < 4; ++m) _Pragma("unroll") for (int k = 0; k < 2; ++k) dst[m][k] = *(const PG8_LAS bf16x8*)(lds + PG8_SA(b, h) + aoff + m * 2048 + k * 1024); } while (0)
#define PG8_LDB(dst, b, h) do { _Pragma("unroll") for (int n = 0; n < 2; ++n) _Pragma("unroll") for (int k = 0; k < 2; ++k) dst[n][k] = *(const PG8_LAS bf16x8*)(lds + PG8_SB(b, h) + boff + n * 2048 + k * 1024); } while (0)
#define PG8_MMA(ai, bj, At, Bt) do { __builtin_amdgcn_s_setprio(1); _Pragma("unroll") for (int m = 0; m < 4; ++m) { if (!SKIP || m < ((ai) == 0 ? mc0 : mc1)) { _Pragma("unroll") for (int n = 0; n < 2; ++n) _Pragma("unroll") for (int k = 0; k < 2; ++k) \
        acc[ai][bj][m][n] = __builtin_amdgcn_mfma_f32_16x16x32_bf16(Bt[n][k], At[m][k], acc[ai][bj][m][n], 0, 0, 0); } } __builtin_amdgcn_s_setprio(0); } while (0)
#define PG8_WAIT_V(n) asm volatile("s_waitcnt vmcnt(" #n ")" ::: "memory")
#define PG8_WAIT_L(n) asm volatile("s_waitcnt lgkmcnt(" #n ")" ::: "memory")
#define PG8_BAR __builtin_amdgcn_s_barrier()
#define PG8_SCHED __builtin_amdgcn_sched_barrier(0)
    Unit cur, nxt; int ui = 0;
    if (!S.next(0, cur)) return;
    int mc0 = 4, mc1 = 4;
#define PG8_MC(u) do { if (SKIP) { const int a_ = ((u).x2 - 64 * wr + 15) >> 4, b_ = ((u).x2 - 128 - 64 * wr + 15) >> 4; mc0 = a_ < 0 ? 0 : (a_ > 4 ? 4 : a_); mc1 = b_ < 0 ? 0 : (b_ > 4 ? 4 : b_); } } while (0)
    PG8_MC(cur);
    f32x4 acc[2][2][4][2];
#pragma unroll
    for (int a = 0; a < 2; ++a)
#pragma unroll
        for (int b = 0; b < 2; ++b)
#pragma unroll
            for (int m = 0; m < 4; ++m)
#pragma unroll
                for (int n = 0; n < 2; ++n) acc[a][b][m][n] = (f32x4){0.f, 0.f, 0.f, 0.f};
    bf16x8 At[4][2], B0[2][2], B1[2][2];
    const char* cA = cur.A; const char* cB = cur.B;
    if constexpr (GATHER) { S.rows(cur, gA, RA);
#pragma unroll
        for (int h = 0; h < 2; ++h)
#pragma unroll
            for (int i = 0; i < 2; ++i) gAn[h][i] = gA[h][i]; }
    PG8_STAGE(PG8_SB(0, 0), cB, voffB); PG8_STAGE(PG8_SB(0, 1), cB + hstep, voffB); PG8_STAGE_A(PG8_SA(0, 0), cA, 0, false); PG8_STAGE_A(PG8_SA(0, 1), cA, 1, false);
    if (wr == 1) PG8_BAR;
    PG8_WAIT_V(2); PG8_BAR;
    PG8_STAGE(PG8_SB(1, 0), cB + kstep, voffB); PG8_STAGE_A(PG8_SA(1, 0), cA + kstep, 0, false); PG8_STAGE(PG8_SB(1, 1), cB + hstep + kstep, voffB);
    PG8_WAIT_V(6); PG8_BAR;
    for (;;) {
        const bool has_next = S.next(ui + 1, nxt);
        const char* nA = has_next ? nxt.A : cA; const char* nB = has_next ? nxt.B : cB;
        if constexpr (GATHER) { if (has_next) { S.rows(nxt, gAn, RA); } }
        for (int t = 0; t < nt; t += 2) {
            const bool last = (t == nt - 2);
            const char* a1 = cA + (size_t)(t + 1) * kstep;
            const char* a2 = last ? nA : cA + (size_t)(t + 2) * kstep; const char* b2 = last ? nB : cB + (size_t)(t + 2) * kstep;
            const char* a3 = a2 + kstep; const char* b3 = b2 + kstep;
            if constexpr (Epi::HAS_MID) { if (t == nt / 2) { int frl = fr, fql = fq; asm volatile("" : "+v"(frl), "+v"(fql)); E.mid(acc, cur, wr, wc, frl, fql); } }
            PG8_LDB(B0, 0, 0); PG8_LDB(B1, 0, 1); PG8_SCHED; PG8_LDA(At, 0, 0); PG8_STAGE_A(PG8_SA(1, 1), a1, 1, false);
            PG8_WAIT_V(8); PG8_WAIT_L(0); PG8_BAR; PG8_MMA(0, 0, At, B0); PG8_MMA(0, 1, At, B1); PG8_BAR; PG8_SCHED;
            PG8_LDA(At, 0, 1); PG8_STAGE(PG8_SB(0, 0), b2, voffB); PG8_STAGE(PG8_SB(0, 1), b2 + hstep, voffB); PG8_STAGE_A(PG8_SA(0, 0), a2, 0, last);
            PG8_WAIT_V(8); PG8_WAIT_L(0); PG8_BAR; PG8_MMA(1, 0, At, B0); PG8_MMA(1, 1, At, B1); PG8_BAR; PG8_SCHED;
            PG8_LDB(B0, 1, 0); PG8_LDB(B1, 1, 1); PG8_SCHED; PG8_LDA(At, 1, 0); PG8_STAGE_A(PG8_SA(0, 1), a2, 1, last);
            PG8_WAIT_V(8); PG8_WAIT_L(0); PG8_BAR; PG8_MMA(0, 0, At, B0); PG8_MMA(0, 1, At, B1); PG8_BAR; PG8_SCHED;
            PG8_LDA(At, 1, 1); PG8_STAGE(PG8_SB(1, 0), b3, voffB); PG8_STAGE(PG8_SB(1, 1), b3 + hstep, voffB); PG8_STAGE_A(PG8_SA(1, 0), a3, 0, last);
            PG8_WAIT_V(8); PG8_WAIT_L(0); PG8_BAR; PG8_MMA(1, 0, At, B0); PG8_MMA(1, 1, At, B1); PG8_BAR; PG8_SCHED;
        }
        if constexpr (ALIGN_EPI) { if (wr == 0) PG8_BAR; }
        { int frl = fr, fql = fq; asm volatile("" : "+v"(frl), "+v"(fql)); E(acc, cur, wr, wc, frl, fql); }
        if (!has_next) break;
#pragma unroll
        for (int a = 0; a < 2; ++a)
#pragma unroll
            for (int b = 0; b < 2; ++b)
#pragma unroll
                for (int m = 0; m < 4; ++m)
#pragma unroll
                    for (int n = 0; n < 2; ++n) acc[a][b][m][n] = (f32x4){0.f, 0.f, 0.f, 0.f};
        cur = nxt; cA = nA; cB = nB; ++ui; PG8_MC(cur);
        if constexpr (GATHER) {
#pragma unroll
            for (int h = 0; h < 2; ++h)
#pragma unroll
                for (int i = 0; i < 2; ++i) gA[h][i] = gAn[h][i]; }
        if constexpr (ALIGN_EPI) { if (wr == 1) PG8_BAR; }
    }
    PG8_WAIT_V(0);
    if constexpr (!ALIGN_EPI) { if (wr == 0) PG8_BAR; }
    PG8_BAR;
#undef PG8_SA
#undef PG8_SB
#undef PG8_STAGE
#undef PG8_STAGE_A
#undef PG8_LDA
#undef PG8_LDB
#undef PG8_MMA
#undef PG8_WAIT_V
#undef PG8_WAIT_L
#undef PG8_BAR
#undef PG8_SCHED
#undef PG8_MC
}
}

constexpr int LDS_MISC_OFF = 131072;
__device__ __forceinline__ float fast_gelu(float x) { const float y = x + 0.044715f * x * x * x; return x * __builtin_amdgcn_rcpf(1.0f + __builtin_amdgcn_exp2f(-2.0f * 0.7978845608028654f * LOG2E * y)); }
__device__ __forceinline__ float fast_sigmoid(float x) { return __builtin_amdgcn_rcpf(1.0f + __builtin_amdgcn_exp2f(-LOG2E * x)); }
__device__ __forceinline__ void unpack8(const u32x4 w, float (&v)[8]) {
#pragma unroll
    for (int e = 0; e < 4; ++e) { v[2 * e] = __uint_as_float(w[e] << 16); v[2 * e + 1] = __uint_as_float(w[e] & 0xffff0000u); } }

constexpr size_t WS_VSTAT = 6 * MiB;
constexpr int LDS_EPI_OFF = 131072 + 4096;
struct EpiIn {
    static constexpr bool PERM = true, HAS_MID = false;
    bf16_t *U, *V, *Q, *K, *VA, *G; const float* b_gate; const float* qg; const float* kg; float* VSTAT; PG8_LAS unsigned char* lds;
    __device__ __forceinline__ void mid(f32x4 (&)[2][2][4][2], const pg8::Unit&, int, int, int, int) const {}
    __device__ __forceinline__ void operator()(f32x4 (&acc)[2][2][4][2], const pg8::Unit& u, int wr, int wc, int fr, int fq) const {
        const int pn = u.pn; bf16_t* base; int ld, colt, mode;
        if (pn < 4) { base = U; ld = 1024; colt = pn * 256; mode = 1; }
        else if (pn < 8) { base = V; ld = 1024; colt = (pn - 4) * 256; mode = 3; }
        else if (pn < 12) { base = Q; ld = 1024; colt = (pn - 8) * 256; mode = 4; }
        else if (pn < 16) { base = K; ld = 1024; colt = (pn - 12) * 256; mode = 5; }
        else if (pn < 20) { base = VA; ld = 1024; colt = (pn - 16) * 256; mode = 0; }
        else { base = G; ld = 4096; colt = (pn - 20) * 256; mode = 2; }
        const int row0 = u.pm * 256 + wr * 64 + fr, col0 = colt + wc * 32 + 8 * fq;
        if (mode >= 4) {
            PG8_LAS float* P = (PG8_LAS float*)(lds + LDS_EPI_OFF);
#pragma unroll
            for (int ai = 0; ai < 2; ++ai)
#pragma unroll
                for (int m = 0; m < 4; ++m)
#pragma unroll
                    for (int bj = 0; bj < 2; ++bj) { const f32x4 a = acc[ai][bj][m][0], b = acc[ai][bj][m][1];
                        float s = (a[0] * a[0] + a[1] * a[1]) + (a[2] * a[2] + a[3] * a[3]) + (b[0] * b[0] + b[1] * b[1]) + (b[2] * b[2] + b[3] * b[3]);
                        s += __shfl_xor(s, 16); s += __shfl_xor(s, 32);
                        if (fq == 0) P[((ai * 128 + wr * 64 + m * 16 + fr) * 2 + bj) * 4 + wc] = s; }
            asm volatile("s_waitcnt lgkmcnt(0)" ::: "memory"); __builtin_amdgcn_s_barrier(); asm volatile("" ::: "memory");
            const float* gg = mode == 4 ? qg : kg; const float qs = mode == 4 ? QSCALE : 1.0f;
            const f32x4 g0 = *(const f32x4*)(gg + wc * 32 + 8 * fq), g1 = *(const f32x4*)(gg + wc * 32 + 8 * fq + 4);
#pragma unroll
            for (int ai = 0; ai < 2; ++ai)
#pragma unroll
                for (int m = 0; m < 4; ++m) { bf16_t* rowp = base + (size_t)(row0 + ai * 128 + m * 16) * ld + col0;
#pragma unroll
                    for (int bj = 0; bj < 2; ++bj) { const f32x4 pp = *(const PG8_LAS f32x4*)(P + ((ai * 128 + wr * 64 + m * 16 + fr) * 2 + bj) * 4);
                        const float sc = rsqrtf(((pp[0] + pp[1]) + (pp[2] + pp[3])) * (1.f / 128.f) + EPS) * qs;
                        const f32x4 v0 = acc[ai][bj][m][0] * g0 * sc, v1 = acc[ai][bj][m][1] * g1 * sc;
                        u32x4 w; w.x = pg8::cvt_pk_bf16(v0[0], v0[1]); w.y = pg8::cvt_pk_bf16(v0[2], v0[3]); w.z = pg8::cvt_pk_bf16(v1[0], v1[1]); w.w = pg8::cvt_pk_bf16(v1[2], v1[3]);
                        *(u32x4*)(rowp + bj * 128) = w; } }
            return;
        }
        f32x4 bv[2][2];
#pragma unroll
        for (int bj = 0; bj < 2; ++bj)
#pragma unroll
            for (int n = 0; n < 2; ++n) bv[bj][n] = (mode == 2) ? *(const f32x4*)(b_gate + col0 + bj * 128 + 4 * n) : (f32x4){0.f, 0.f, 0.f, 0.f};
#pragma unroll
        for (int ai = 0; ai < 2; ++ai)
#pragma unroll
            for (int m = 0; m < 4; ++m) { bf16_t* rowp = base + (size_t)(row0 + ai * 128 + m * 16) * ld + col0; float s1 = 0.f, s2 = 0.f;
#pragma unroll
                for (int bj = 0; bj < 2; ++bj) { f32x4 v0 = acc[ai][bj][m][0], v1 = acc[ai][bj][m][1];
                    if (mode == 1 || mode == 3) {
#pragma unroll
                        for (int j = 0; j < 4; ++j) { v0[j] = fast_gelu(v0[j]); v1[j] = fast_gelu(v1[j]); } }
                    else if (mode == 2) { v0 += bv[bj][0]; v1 += bv[bj][1];
#pragma unroll
                        for (int j = 0; j < 4; ++j) { v0[j] = fast_sigmoid(v0[j]); v1[j] = fast_sigmoid(v1[j]); } }
                    if (mode == 3) {
#pragma unroll
                        for (int j = 0; j < 4; ++j) { s1 += v0[j] + v1[j]; s2 += v0[j] * v0[j] + v1[j] * v1[j]; } }
                    u32x4 w; w.x = pg8::cvt_pk_bf16(v0[0], v0[1]); w.y = pg8::cvt_pk_bf16(v0[2], v0[3]); w.z = pg8::cvt_pk_bf16(v1[0], v1[1]); w.w = pg8::cvt_pk_bf16(v1[2], v1[3]);
                    *(u32x4*)(rowp + bj * 128) = w; }
                if (mode == 3) { s1 += __shfl_xor(s1, 16); s1 += __shfl_xor(s1, 32); s2 += __shfl_xor(s2, 16); s2 += __shfl_xor(s2, 32);
                    if (fq == 0) { typedef float f32x2_ __attribute__((ext_vector_type(2))); *(f32x2_*)(VSTAT + ((size_t)(row0 + ai * 128 + m * 16) * 16 + (pn - 4) * 4 + wc) * 2) = (f32x2_){s1, s2}; } } }
    }
};
struct EpiProj {
    static constexpr bool PERM = true, HAS_MID = true;
    const bf16_t* G; bf16_t* O;
    __device__ __forceinline__ void mid(f32x4 (&acc)[2][2][4][2], const pg8::Unit& u, int wr, int wc, int fr, int fq) const {
        const int row0 = u.pm * 256 + wr * 64 + fr, col0 = u.pn * 256 + wc * 32 + 8 * fq;
#pragma unroll
        for (int ai = 0; ai < 2; ++ai)
#pragma unroll
            for (int m = 0; m < 4; ++m) { const bf16_t* gp = G + (size_t)(row0 + ai * 128 + m * 16) * 4096 + col0;
#pragma unroll
                for (int bj = 0; bj < 2; ++bj) { float gs[8], gf[8]; unpack8(*(const u32x4*)(gp + bj * 128), gs); unpack8(*(const u32x4*)(gp + 2048 + bj * 128), gf);
#pragma unroll
                    for (int j = 0; j < 4; ++j) { acc[ai][bj][m][0][j] *= gs[j] * __builtin_amdgcn_rcpf(gf[j]); acc[ai][bj][m][1][j] *= gs[4 + j] * __builtin_amdgcn_rcpf(gf[4 + j]); }
                    asm volatile("" : "+v"(acc[ai][bj][m][0]), "+v"(acc[ai][bj][m][1]) :: "memory"); } }
    }
    __device__ __forceinline__ void operator()(f32x4 (&acc)[2][2][4][2], const pg8::Unit& u, int wr, int wc, int fr, int fq) const {
        const int row0 = u.pm * 256 + wr * 64 + fr, col0 = u.pn * 256 + wc * 32 + 8 * fq;
#pragma unroll
        for (int ai = 0; ai < 2; ++ai)
#pragma unroll
            for (int m = 0; m < 4; ++m) { const size_t r = (size_t)(row0 + ai * 128 + m * 16);
#pragma unroll
                for (int bj = 0; bj < 2; ++bj) { float gf[8]; unpack8(*(const u32x4*)(G + r * 4096 + 2048 + col0 + bj * 128), gf);
                    const f32x4 v0 = acc[ai][bj][m][0], v1 = acc[ai][bj][m][1];
                    u32x4 w; w.x = pg8::cvt_pk_bf16(v0[0] * gf[0], v0[1] * gf[1]); w.y = pg8::cvt_pk_bf16(v0[2] * gf[2], v0[3] * gf[3]); w.z = pg8::cvt_pk_bf16(v1[0] * gf[4], v1[1] * gf[5]); w.w = pg8::cvt_pk_bf16(v1[2] * gf[6], v1[3] * gf[7]);
                    *(u32x4*)(O + r * 2048 + col0 + bj * 128) = w; }
                asm volatile("" ::: "memory"); }
    }
};
struct EpiOut {
    static constexpr bool PERM = false, HAS_MID = false;
    const float* X; float* O;
    __device__ __forceinline__ void mid(f32x4 (&)[2][2][4][2], const pg8::Unit&, int, int, int, int) const {}
    __device__ __forceinline__ void operator()(f32x4 (&acc)[2][2][4][2], const pg8::Unit& u, int wr, int wc, int fr, int fq) const {
        const int row0 = u.pm * 256 + wr * 64 + fr, col0 = u.pn * 256 + wc * 32 + 4 * fq;
#pragma unroll
        for (int ai = 0; ai < 2; ++ai)
#pragma unroll
            for (int m = 0; m < 4; ++m) { const size_t off = (size_t)(row0 + ai * 128 + m * 16) * DM + col0;
#pragma unroll
                for (int bj = 0; bj < 2; ++bj)
#pragma unroll
                    for (int n = 0; n < 2; ++n) *(f32x4*)(O + off + bj * 128 + n * 16) = *(const f32x4*)(X + off + bj * 128 + n * 16) + acc[ai][bj][m][n]; }
    }
};
struct EpiGateUp {
    static constexpr bool PERM = true, HAS_MID = false;
    bf16_t* ACT; const float* RSTL;
    __device__ __forceinline__ void mid(f32x4 (&)[2][2][4][2], const pg8::Unit&, int, int, int, int) const {}
    __device__ __forceinline__ void operator()(f32x4 (&acc)[2][2][4][2], const pg8::Unit& u, int wr, int wc, int fr, int fq) const {
        const int row0 = u.x0 + wr * 64 + fr, col0 = u.pn * 128 + wc * 32 + 8 * fq;
#pragma unroll
        for (int ai = 0; ai < 2; ++ai)
#pragma unroll
            for (int m = 0; m < 4; ++m) { float o[8]; const float rr = RSTL[u.x1 + wr * 64 + fr + ai * 128 + m * 16];
#pragma unroll
                for (int n = 0; n < 2; ++n)
#pragma unroll
                    for (int j = 0; j < 4; ++j) { const float g = acc[ai][0][m][n][j] * rr, up = acc[ai][1][m][n][j] * rr; o[4 * n + j] = g * fast_sigmoid(g) * up; }
                u32x4 w; w.x = pg8::cvt_pk_bf16(o[0], o[1]); w.y = pg8::cvt_pk_bf16(o[2], o[3]); w.z = pg8::cvt_pk_bf16(o[4], o[5]); w.w = pg8::cvt_pk_bf16(o[6], o[7]);
                *(u32x4*)(ACT + (size_t)(row0 + ai * 128 + m * 16) * DEXP + col0) = w; }
    }
};
struct EpiDown {
    static constexpr bool PERM = true, HAS_MID = false;
    bf16_t* Y; const float* GATE;
    __device__ __forceinline__ void mid(f32x4 (&)[2][2][4][2], const pg8::Unit&, int, int, int, int) const {}
    __device__ __forceinline__ void operator()(f32x4 (&acc)[2][2][4][2], const pg8::Unit& u, int wr, int wc, int fr, int fq) const {
        const int rl0 = wr * 64 + fr, col0 = u.pn * 256 + wc * 32 + 8 * fq;
#pragma unroll
        for (int ai = 0; ai < 2; ++ai)
#pragma unroll
            for (int m = 0; m < 4; ++m) { const int rl = rl0 + ai * 128 + m * 16; const float gt = GATE[u.x1 + rl];
#pragma unroll
                for (int bj = 0; bj < 2; ++bj) { const f32x4 v0 = acc[ai][bj][m][0] * gt, v1 = acc[ai][bj][m][1] * gt;
                    u32x4 w; w.x = pg8::cvt_pk_bf16(v0[0], v0[1]); w.y = pg8::cvt_pk_bf16(v0[2], v0[3]); w.z = pg8::cvt_pk_bf16(v1[0], v1[1]); w.w = pg8::cvt_pk_bf16(v1[2], v1[3]);
                    *(u32x4*)(Y + (size_t)(u.x0 + rl) * DM + col0 + bj * 128) = w; } }
    }
};
struct MoeOrder {
    const char* Abase; const char* Bbase; size_t Bstride; int K, nN, G, c; bool gather;
    const PG8_LAS int* ps;
    const unsigned* cnt; const int* TOK;
    __device__ bool next(int i, pg8::Unit& u) const {
        const int L0 = i * G + c; const int ntile = ps[NEXP + 2] * nN; if (L0 >= ntile * PROBE_REP_MOE) return false;
        const int L = L0 % ntile; const int sidx = L / nN, pn = L % nN; const int prow = ps[40 + sidx], info = ps[40 + MT_MAX + sidx], valid = ps[40 + 2 * MT_MAX + sidx];
        const int e = info >> 16, mt = info & 0xffff;
        u.pm = mt; u.pn = pn; u.x0 = prow; u.x1 = e * T + mt * MTILE; u.x2 = valid; u.x3 = e;
        u.A = gather ? Abase : Abase + (size_t)prow * K * 2; u.B = Bbase + (size_t)e * Bstride + (size_t)pn * 256 * K * 2; return true;
    }
    __device__ __forceinline__ void rows(const pg8::Unit& u, unsigned (&g)[2][2], const int (&RA)[2]) const {
#pragma unroll
        for (int h = 0; h < 2; ++h)
#pragma unroll
            for (int i = 0; i < 2; ++i) { int r = RA[i] + 128 * h; r = r < u.x2 ? r : u.x2 - 1; g[h][i] = (unsigned)TOK[u.x1 + r] * (unsigned)(K * 2); }
    }
};

struct TItem { const float* src; bf16_t* dst; int ld_src, ld_dst; };
__device__ __forceinline__ void titem_load(const TItem& t, f32x4 (&v)[8], int lane) {
#pragma unroll
    for (int i = 0; i < 8; ++i) v[i] = *(const f32x4*)(t.src + (size_t)((lane >> 3) + 8 * i) * t.ld_src + 4 * (lane & 7));
}
__device__ __forceinline__ void titem_store(const TItem& t, const f32x4 (&v)[8], PG8_LAS float* scr, int lane) {
#pragma unroll
    for (int i = 0; i < 8; ++i) { PG8_LAS float* d = scr + ((lane >> 3) + 8 * i) * 33 + 4 * (lane & 7); d[0] = v[i].x; d[1] = v[i].y; d[2] = v[i].z; d[3] = v[i].w; }
    asm volatile("s_waitcnt lgkmcnt(0)" ::: "memory");
    const int c = lane & 7;
#pragma unroll
    for (int j = 0; j < 4; ++j) { const int n = (lane >> 3) + 8 * j; const PG8_LAS float* s = scr + (8 * c) * 33 + n;
        u32x4 o; o.x = pk2(s[0 * 33], s[1 * 33]); o.y = pk2(s[2 * 33], s[3 * 33]); o.z = pk2(s[4 * 33], s[5 * 33]); o.w = pk2(s[6 * 33], s[7 * 33]);
        *(u32x4*)(t.dst + (size_t)n * t.ld_dst + 8 * c) = o; }
    asm volatile("s_waitcnt lgkmcnt(0)" ::: "memory");
}
constexpr int TI0 = 32 * 288, TI1 = 16 * 64, TI2 = 16 * 64, TI3 = 32 * 64, TI4 = 32 * 512, TI5 = 32 * 512, TI6 = 32 * 512;
constexpr int TI_ALL = TI0 + TI1 + TI2 + TI3 + TI4 + TI5 + TI6;
#ifndef TAIL1_ITEMS
#define TAIL1_ITEMS (TI5)
#endif
__device__ __forceinline__ TItem titem_decode(const Args& A, int r) {
    bf16_t* WIN = (bf16_t*)(A.ws + WS_WIN); bf16_t* WPROJ = (bf16_t*)(A.ws + WS_WPROJ); bf16_t* WOUT = (bf16_t*)(A.ws + WS_WOUT); bf16_t* WGU = (bf16_t*)(A.ws + WS_WGU); bf16_t* WD = (bf16_t*)(A.ws + WS_WD);
    TItem t;
    if (r < TI0) { const int kb = r / 288, nb = r % 288; t.src = A.in[2] + (size_t)(64 * kb) * INCOLS + 32 * nb + (nb >= 160 ? 8 : 0); t.ld_src = INCOLS; t.dst = WIN + (size_t)(32 * nb) * 2048 + 64 * kb; t.ld_dst = 2048; return t; } r -= TI0;
    if (r < TI1) { const int kb = r / 64, nb = r % 64; t.src = A.in[11] + (size_t)(64 * kb) * DM + 32 * nb; t.ld_src = DM; t.dst = WPROJ + (size_t)(32 * nb) * 2048 + 64 * kb; t.ld_dst = 2048; return t; } r -= TI1;
    if (r < TI2) { const int kb = r / 64, nb = r % 64; t.src = A.in[12] + (size_t)(64 * kb) * DM + 32 * nb; t.ld_src = DM; t.dst = WPROJ + (size_t)(32 * nb) * 2048 + 1024 + 64 * kb; t.ld_dst = 2048; return t; } r -= TI2;
    if (r < TI3) { const int kb = r / 64, nb = r % 64; t.src = A.in[13] + (size_t)(64 * kb) * DM + 32 * nb; t.ld_src = DM; t.dst = WOUT + (size_t)(32 * nb) * 2048 + 64 * kb; t.ld_dst = 2048; return t; } r -= TI3;
    if (r < TI4 + TI5) { const int up = r >= TI4; if (up) r -= TI4; const int e = r / 512, q = r % 512, kb = q / 16, nb = q % 16, n = 32 * nb, drow = 256 * (n >> 7) + (n & 127) + (up ? 128 : 0);
        t.src = A.in[up ? 20 : 19] + (size_t)e * DM * DEXP + (size_t)(64 * kb) * DEXP + n; t.ld_src = DEXP; t.dst = WGU + ((size_t)e * 1024 + drow) * 2048 + 64 * kb; t.ld_dst = 2048; return t; } r -= TI4 + TI5;
    { const int e = r / 512, q = r % 512, kb = q / 64, nb = q % 64; t.src = A.in[21] + (size_t)e * DEXP * DM + (size_t)(64 * kb) * DM + 32 * nb; t.ld_src = DM; t.dst = WD + ((size_t)e * 2048 + 32 * nb) * 512 + 64 * kb; t.ld_dst = 512; return t; }
}
__device__ __forceinline__ void p0_weights(const Args& A, PG8_LAS unsigned char* lds, const int part, const int wg0) {
    const int tid = threadIdx.x, lane = tid & 63, wave = tid >> 6;
    PG8_LAS float* scr = (PG8_LAS float*)(lds + wave * 16384);
    if ((int)blockIdx.x < wg0) return;
    const int gw = ((int)blockIdx.x - wg0) * NWAVES + wave, NGW = ((int)gridDim.x - wg0) * NWAVES;
    const int cut1 = TI_ALL - TI6 - TAIL1_ITEMS, cut2 = TI_ALL - TI6;
    const int it_lo = part == 0 ? 0 : (part == 1 ? cut1 : cut2), it_hi = part == 0 ? cut1 : (part == 1 ? cut2 : TI_ALL);
    int it = it_lo + gw; if (it >= it_hi) return;
    TItem cur = titem_decode(A, it); f32x4 va[8], vb[8];
    titem_load(cur, va, lane);
    for (;;) {
        const int itn = it + NGW; const bool more = itn < it_hi; TItem nx = cur;
        if (more) { nx = titem_decode(A, itn); titem_load(nx, vb, lane); }
        titem_store(cur, va, scr, lane);
        if (!more) break;
#pragma unroll
        for (int i = 0; i < 8; ++i) va[i] = vb[i];
        cur = nx; it = itn;
    }
}

__device__ __forceinline__ void p1_fast(const Args& A, PG8_LAS unsigned char* lds) {
    pg8::DenseOrder S; S.init(A.ws + WS_H, A.ws + WS_WIN, T, 9216, DM, gridDim.x, blockIdx.x, PROBE_REP_P1);
    EpiIn E{(bf16_t*)(A.ws + WS_U), (bf16_t*)(A.ws + WS_V), (bf16_t*)(A.ws + WS_Q), (bf16_t*)(A.ws + WS_K), (bf16_t*)(A.ws + WS_VA), (bf16_t*)(A.ws + WS_G), A.in[3], A.in[9], A.in[10], (float*)(A.ws + WS_VSTAT), lds};
    pg8::gemm_phase<EpiIn, pg8::DenseOrder, true, false>(lds, DM, S, E);
}
__device__ __forceinline__ void p3_fast(const Args& A, PG8_LAS unsigned char* lds) {
    pg8::DenseOrder S; S.init(A.ws + WS_MIXIN, A.ws + WS_WPROJ, T, DM, 2048, gridDim.x, blockIdx.x, PROBE_REP_P4);
    EpiProj E{(const bf16_t*)(A.ws + WS_G), (bf16_t*)(A.ws + WS_MIXED)};
    pg8::gemm_phase<EpiProj, pg8::DenseOrder, true, false>(lds, 2048, S, E);
}
__device__ __forceinline__ void p4_fast(const Args& A, PG8_LAS unsigned char* lds) {
    pg8::DenseOrder S; S.init(A.ws + WS_MIXED, A.ws + WS_WOUT, T, DM, DM, gridDim.x, blockIdx.x, PROBE_REP_P5);
    EpiOut E{A.in[0], A.out};
    pg8::gemm_phase<EpiOut, pg8::DenseOrder, true, false>(lds, DM, S, E);
}
__device__ __forceinline__ void moe_layout_lds(const Args& A, PG8_LAS unsigned char* lds) {
    PG8_LAS int* ps = (PG8_LAS int*)(lds + LDS_MISC_OFF); PG8_LAS int* tprow = ps + 40; PG8_LAS int* tinfo = tprow + MT_MAX; PG8_LAS int* tvalid = tinfo + MT_MAX;
    const unsigned* cnt = (const unsigned*)(A.ws + WS_CTL) + CW_CNT;
    if (threadIdx.x == 0) { int acc = 0;
        for (int e = 0; e < NEXP; ++e) { ps[e] = acc; acc += ((int)cnt[(e) * CNT_STRIDE] + MTILE - 1) / MTILE * MTILE; }
        ps[NEXP] = acc; ps[NEXP + 1] = acc / MTILE; }
    __syncthreads();
    const int nt = ps[NEXP + 1]; PG8_LAS int* uval = tvalid + MT_MAX;
    int prow = 0, e = 0, mt = 0, valid = 0;
    if ((int)threadIdx.x < nt) { prow = (int)threadIdx.x * MTILE;
        for (int j = 1; j < NEXP; ++j) if (ps[j] <= prow) e = j;
        mt = (prow - ps[e]) / MTILE; valid = (int)cnt[(e) * CNT_STRIDE] - mt * MTILE; valid = valid > MTILE ? MTILE : valid; uval[threadIdx.x] = valid; }
    __syncthreads();
    if ((int)threadIdx.x < nt) { int rank = 0;
        for (int j = 0; j < nt; ++j) { const int vj = uval[j]; rank += (vj > valid || (vj == valid && j < (int)threadIdx.x)) ? 1 : 0; }
        tprow[rank] = prow; tinfo[rank] = (e << 16) | mt; tvalid[rank] = valid; }
    if (threadIdx.x == 0) { int nb = 0; for (int j = 0; j < nt; ++j) nb += uval[j] > TINY_ROWS ? 1 : 0; ps[NEXP + 2] = nb; }
    __syncthreads();
}
namespace sm {
typedef short bf16x8 __attribute__((ext_vector_type(8))); typedef float f32x16 __attribute__((ext_vector_type(16)));
constexpr int TINY = 64;
__device__ __forceinline__ void gateup_small(const Args& A, PG8_LAS unsigned char* lds) {
    const PG8_LAS int* ps = (const PG8_LAS int*)(lds + LDS_MISC_OFF); const int nt = ps[NEXP + 1], nbig = ps[NEXP + 2];
    const bf16_t* H2 = (const bf16_t*)(A.ws + WS_H2); const bf16_t* WGU = (const bf16_t*)(A.ws + WS_WGU); bf16_t* ACT = (bf16_t*)(A.ws + WS_ACT); const int* TOK = (const int*)(A.ws + WS_TOK);
    const int tid = threadIdx.x, lane = tid & 63, w = __builtin_amdgcn_readfirstlane(tid >> 6), r32 = lane & 31, hi = lane >> 5;
    PG8_LAS float* red = (PG8_LAS float*)lds;
    for (int su = blockIdx.x; su < (nt - nbig) * 16; su += gridDim.x) {
        const int sidx = nbig + (su >> 4), sl = su & 15; const int prow = ps[40 + sidx], info = ps[40 + MT_MAX + sidx], valid = ps[40 + 2 * MT_MAX + sidx];
        const int e = info >> 16, mt = info & 0xffff, lbase = e * T + mt * MTILE;
        const int ra = r32 < valid ? r32 : valid - 1, rb = 32 + r32 < valid ? 32 + r32 : valid - 1;
        const bf16_t* a0p = H2 + (size_t)TOK[lbase + ra] * DM + 256 * w + 8 * hi; const bf16_t* a1p = H2 + (size_t)TOK[lbase + rb] * DM + 256 * w + 8 * hi;
        const bf16_t* b0p = WGU + ((size_t)e * 1024 + 256 * (sl >> 2) + 32 * (sl & 3) + r32) * DM + 256 * w + 8 * hi; const bf16_t* b1p = b0p + (size_t)128 * DM;
        f32x16 acc[2][2];
#pragma unroll
        for (int i = 0; i < 2; ++i)
#pragma unroll
            for (int j = 0; j < 2; ++j)
#pragma unroll
                for (int r = 0; r < 16; ++r) acc[i][j][r] = 0.f;
#pragma unroll 4
        for (int ks = 0; ks < 16; ++ks) { const bf16x8 a0 = *(const bf16x8*)(a0p + 16 * ks), a1 = *(const bf16x8*)(a1p + 16 * ks), b0 = *(const bf16x8*)(b0p + 16 * ks), b1 = *(const bf16x8*)(b1p + 16 * ks);
            acc[0][0] = __builtin_amdgcn_mfma_f32_32x32x16_bf16(a0, b0, acc[0][0], 0, 0, 0); acc[0][1] = __builtin_amdgcn_mfma_f32_32x32x16_bf16(a0, b1, acc[0][1], 0, 0, 0);
            acc[1][0] = __builtin_amdgcn_mfma_f32_32x32x16_bf16(a1, b0, acc[1][0], 0, 0, 0); acc[1][1] = __builtin_amdgcn_mfma_f32_32x32x16_bf16(a1, b1, acc[1][1], 0, 0, 0); }
#pragma unroll
        for (int i = 0; i < 2; ++i)
#pragma unroll
            for (int j = 0; j < 2; ++j)
#pragma unroll
                for (int r = 0; r < 16; ++r) red[(((w * 2 + i) * 2 + j) * 16 + r) * 64 + lane] = acc[i][j][r];
        __syncthreads();
#pragma unroll
        for (int i = 0; i < 2; ++i)
#pragma unroll
            for (int rr = 0; rr < 2; ++rr) { const int r = 2 * w + rr; float g = 0.f, u = 0.f;
#pragma unroll
                for (int w2 = 0; w2 < 8; ++w2) { g += red[(((w2 * 2 + i) * 2 + 0) * 16 + r) * 64 + lane]; u += red[(((w2 * 2 + i) * 2 + 1) * 16 + r) * 64 + lane]; }
                const int row = 32 * i + (r & 3) + 8 * (r >> 2) + 4 * hi; const float rr2 = ((const float*)(A.ws + WS_RSTL))[lbase + (row < valid ? row : valid - 1)]; g *= rr2; u *= rr2;
                ACT[(size_t)(prow + row) * DEXP + 32 * sl + r32] = f2bf(g * fast_sigmoid(g) * u); }
        __syncthreads();
    }
}
__device__ __forceinline__ void down_small(const Args& A, PG8_LAS unsigned char* lds) {
    const PG8_LAS int* ps = (const PG8_LAS int*)(lds + LDS_MISC_OFF); const int nt = ps[NEXP + 1], nbig = ps[NEXP + 2];
    const bf16_t* ACT = (const bf16_t*)(A.ws + WS_ACT); const bf16_t* WD = (const bf16_t*)(A.ws + WS_WD); bf16_t* Y = (bf16_t*)(A.ws + WS_YBUF); const float* GATE = (const float*)(A.ws + WS_GATE);
    const int tid = threadIdx.x, lane = tid & 63, w = __builtin_amdgcn_readfirstlane(tid >> 6), wn = w & 3, wk = w >> 2, r32 = lane & 31, hi = lane >> 5;
    PG8_LAS float* red = (PG8_LAS float*)lds;
    for (int su = blockIdx.x; su < (nt - nbig) * 16; su += gridDim.x) {
        const int sidx = nbig + (su >> 4), sl = su & 15; const int prow = ps[40 + sidx], info = ps[40 + MT_MAX + sidx], valid = ps[40 + 2 * MT_MAX + sidx];
        const int e = info >> 16, mt = info & 0xffff, lbase = e * T + mt * MTILE;
        const int ra = r32 < valid ? r32 : valid - 1, rb = 32 + r32 < valid ? 32 + r32 : valid - 1;
        const bf16_t* a0p = ACT + (size_t)(prow + ra) * DEXP + 256 * wk + 8 * hi; const bf16_t* a1p = ACT + (size_t)(prow + rb) * DEXP + 256 * wk + 8 * hi;
        const bf16_t* bp = WD + ((size_t)e * 2048 + 128 * sl + 32 * wn + r32) * DEXP + 256 * wk + 8 * hi;
        f32x16 acc[2];
#pragma unroll
        for (int i = 0; i < 2; ++i)
#pragma unroll
            for (int r = 0; r < 16; ++r) acc[i][r] = 0.f;
#pragma unroll 4
        for (int ks = 0; ks < 16; ++ks) { const bf16x8 a0 = *(const bf16x8*)(a0p + 16 * ks), a1 = *(const bf16x8*)(a1p + 16 * ks), b = *(const bf16x8*)(bp + 16 * ks);
            acc[0] = __builtin_amdgcn_mfma_f32_32x32x16_bf16(a0, b, acc[0], 0, 0, 0); acc[1] = __builtin_amdgcn_mfma_f32_32x32x16_bf16(a1, b, acc[1], 0, 0, 0); }
        if (wk == 1) {
#pragma unroll
            for (int i = 0; i < 2; ++i)
#pragma unroll
                for (int r = 0; r < 16; ++r) red[((wn * 2 + i) * 16 + r) * 64 + lane] = acc[i][r]; }
        __syncthreads();
        if (wk == 0) {
#pragma unroll
            for (int i = 0; i < 2; ++i)
#pragma unroll
                for (int r = 0; r < 16; ++r) { const int row = 32 * i + (r & 3) + 8 * (r >> 2) + 4 * hi; const float gt = GATE[lbase + (row < valid ? row : valid - 1)];
                    Y[(size_t)(prow + row) * DM + 128 * sl + 32 * wn + r32] = f2bf((acc[i][r] + red[((wn * 2 + i) * 16 + r) * 64 + lane]) * gt); } }
        __syncthreads();
    }
}
}

__device__ __forceinline__ void p6_fast(const Args& A, PG8_LAS unsigned char* lds) {
    moe_layout_lds(A, lds);
    MoeOrder S{(const char*)(A.ws + WS_H2), (const char*)(A.ws + WS_WGU), (size_t)1024 * 2048 * 2, DM, 4, (int)gridDim.x, (int)blockIdx.x, true,
               (const PG8_LAS int*)(lds + LDS_MISC_OFF), (const unsigned*)(A.ws + WS_CTL) + CW_CNT, (const int*)(A.ws + WS_TOK)};
    EpiGateUp E{(bf16_t*)(A.ws + WS_ACT), (const float*)(A.ws + WS_RSTL)};
    pg8::gemm_phase<EpiGateUp, MoeOrder, true, true>(lds, DM, S, E);
    sm::gateup_small(A, lds);
    { const int ntile = ((const PG8_LAS int*)(lds + LDS_MISC_OFF))[NEXP + 2] * 4; __syncthreads(); p0_weights(A, lds, 2, ntile % (int)gridDim.x); }
}
__device__ __forceinline__ void p7_fast(const Args& A, PG8_LAS unsigned char* lds) {
    moe_layout_lds(A, lds);
    MoeOrder S{(const char*)(A.ws + WS_ACT), (const char*)(A.ws + WS_WD), (size_t)2048 * 512 * 2, DEXP, 8, (int)gridDim.x, (int)blockIdx.x, false,
               (const PG8_LAS int*)(lds + LDS_MISC_OFF), (const unsigned*)(A.ws + WS_CTL) + CW_CNT, (const int*)(A.ws + WS_TOK)};
    EpiDown E{(bf16_t*)(A.ws + WS_YBUF), (const float*)(A.ws + WS_GATE)};
    pg8::gemm_phase<EpiDown, MoeOrder, true, false>(lds, DEXP, S, E);
    sm::down_small(A, lds);
}

namespace fa {
typedef short bf16x8 __attribute__((ext_vector_type(8)));
typedef short v4i16 __attribute__((ext_vector_type(4)));
typedef float f32x16 __attribute__((ext_vector_type(16)));
#define FA_LAS __attribute__((address_space(3)))
constexpr int KVBUF = 65536, LDS_CK = 131072, LDS_ML = 131072 + 8192;
__device__ __forceinline__ unsigned cvtpk(float lo, float hi) { unsigned r; asm("v_cvt_pk_bf16_f32 %0, %1, %2" : "=v"(r) : "v"(lo), "v"(hi)); return r; }
__device__ __forceinline__ bf16x8 pack8(const f32x16& p, int b) { u32x4 w; w.x = cvtpk(p[b], p[b + 1]); w.y = cvtpk(p[b + 2], p[b + 3]); w.z = cvtpk(p[b + 4], p[b + 5]); w.w = cvtpk(p[b + 6], p[b + 7]); return __builtin_bit_cast(bf16x8, w); }
__device__ __forceinline__ float swapmax(float v) { auto rr = __builtin_amdgcn_permlane32_swap(__float_as_uint(v), __float_as_uint(v), false, false); return fmaxf(__uint_as_float(rr[0]), __uint_as_float(rr[1])); }
__device__ __forceinline__ float swapsum(float v) { auto rr = __builtin_amdgcn_permlane32_swap(__float_as_uint(v), __float_as_uint(v), false, false); return __uint_as_float(rr[0]) + __uint_as_float(rr[1]); }
#define FA_WAITBAR() do { asm volatile("s_waitcnt vmcnt(0) lgkmcnt(0)" ::: "memory"); __builtin_amdgcn_s_barrier(); asm volatile("" ::: "memory"); } while (0)

__device__ __forceinline__ void attn_phase(const Args& A, FA_LAS unsigned char* lds) {
    const bf16_t* Q = (const bf16_t*)(A.ws + WS_Q); const bf16_t* Kt = (const bf16_t*)(A.ws + WS_K); const bf16_t* Vt = (const bf16_t*)(A.ws + WS_VA);
    const float* CKL = (const float*)(A.ws + WS_CKL); bf16_t* MIXIN = (bf16_t*)(A.ws + WS_MIXIN);
    const int tid = threadIdx.x, lane = tid & 63, wid = __builtin_amdgcn_readfirstlane(tid >> 6), rg = wid & 3, kh = wid >> 2, r32 = lane & 31, hi = lane >> 5;
    int koff[4];
#pragma unroll
    for (int i = 0; i < 4; ++i) { const int rl = 4 * i + (lane >> 4); koff[i] = rl * 1024 + (((lane & 15) ^ rl) * 8); }
    const int voff = (lane >> 4) * 1024 + (((lane & 15) ^ ((lane >> 4) << 2)) * 8);
    int kfo[8];
#pragma unroll
    for (int d0 = 0; d0 < 8; ++d0) kfo[d0] = (kh * 64 + r32) * 256 + (((2 * d0 + hi) ^ (r32 & 15)) * 16);
    int vfo[4];
    { const int dh = (lane >> 4) & 1, q = (lane & 15) >> 2, p = lane & 3;
#pragma unroll
      for (int db = 0; db < 4; ++db) vfo[db] = (kh * 64 + 4 * hi + q) * 256 + ((db ^ q) * 64) + dh * 32 + p * 8; }
    const unsigned ldsb = (unsigned)(uintptr_t)lds;
    const int G = gridDim.x;
    for (int vb0 = blockIdx.x; vb0 < 256 * PROBE_REP_ATTN; vb0 += G) { const int vb = vb0 % 256;
        const int item = (G % 8 == 0) ? ((vb % 8) * 32 + (vb / 8)) % 256 : vb;
        const int bh = item >> 3, ii = item & 7, b = bh >> 3, h = bh & 7;
        const bf16_t* Kg = Kt + (size_t)b * SEQ * 1024 + h * 128; const bf16_t* Vg = Vt + (size_t)b * SEQ * 1024 + h * 128;
        { const f32x4 c = *(const f32x4*)(CKL + (size_t)bh * SEQ + tid * 4); *(FA_LAS f32x4*)(lds + LDS_CK + tid * 16) = (f32x4){-c.x, -c.y, -c.z, -c.w}; }
#define FA_ISSUE_K(key0, kb_) do { const bf16_t* kg_ = Kg + (size_t)((key0) + 16 * wid) * 1024; \
        _Pragma("unroll") for (int i_ = 0; i_ < 4; ++i_) __builtin_amdgcn_global_load_lds((const unsigned*)(kg_ + koff[i_]), (FA_LAS unsigned*)(lds + (kb_) * 32768 + (wid * 4 + i_) * 1024), 16, 0, 0); } while (0)
#define FA_ISSUE_V(key0, vb_) do { const bf16_t* vg_ = Vg + (size_t)((key0) + 16 * wid) * 1024; \
        _Pragma("unroll") for (int i_ = 0; i_ < 4; ++i_) __builtin_amdgcn_global_load_lds((const unsigned*)(vg_ + i_ * 4096 + voff), (FA_LAS unsigned*)(lds + 65536 + (vb_) * 32768 + (wid * 4 + i_) * 1024), 16, 0, 0); } while (0)
#define FA_DSR128(dst, addr, off) asm volatile("ds_read_b128 %0, %1 offset:%2" : "=v"(dst) : "v"(addr), "n"(off))
#define FA_DSTR(dst, addr, off) asm volatile("ds_read_b64_tr_b16 %0, %1 offset:%2" : "=v"(dst) : "v"(addr), "n"(off))
#define FA_LGKM(n) asm volatile("s_waitcnt lgkmcnt(" #n ")" ::: "memory")
#define FA_SB() __builtin_amdgcn_sched_barrier(0)
#define FA_QK_STEP(i, P0, P1, W) do { FA_LGKM(W); FA_SB(); \
        if (((i) & 1) == 0) P0 = __builtin_amdgcn_mfma_f32_32x32x16_bf16(kr[(i) & 3], qf[(i) >> 1], P0, 0, 0, 0); else P1 = __builtin_amdgcn_mfma_f32_32x32x16_bf16(kr[(i) & 3], qf[(i) >> 1], P1, 0, 0, 0); \
        FA_SB(); if ((i) + 4 < 16) FA_DSR128(kr[(i) & 3], ka_[((i) + 4) >> 1], (((i) + 4) & 1) * 8192); } while (0)
#define FA_QK(P0, P1, kbuf, kbk) do { FA_LAS const float* nck = (FA_LAS const float*)(lds + LDS_CK) + (kbk) * 128 + kh * 64 + 4 * hi; \
        _Pragma("unroll") for (int g_ = 0; g_ < 4; ++g_) { const f32x4 t0 = *(FA_LAS const f32x4*)(nck + 8 * g_), t1 = *(FA_LAS const f32x4*)(nck + 32 + 8 * g_); \
            _Pragma("unroll") for (int j_ = 0; j_ < 4; ++j_) { P0[4 * g_ + j_] = t0[j_]; P1[4 * g_ + j_] = t1[j_]; } } \
        unsigned ka_[8]; _Pragma("unroll") for (int d0 = 0; d0 < 8; ++d0) ka_[d0] = ldsb + (unsigned)((kbuf) * 32768 + kfo[d0]); \
        bf16x8 kr[4]; FA_SB(); FA_DSR128(kr[0], ka_[0], 0); FA_DSR128(kr[1], ka_[0], 8192); FA_DSR128(kr[2], ka_[1], 0); FA_DSR128(kr[3], ka_[1], 8192); \
        FA_QK_STEP(0, P0, P1, 3); FA_QK_STEP(1, P0, P1, 3); FA_QK_STEP(2, P0, P1, 3); FA_QK_STEP(3, P0, P1, 3); FA_QK_STEP(4, P0, P1, 3); FA_QK_STEP(5, P0, P1, 3); FA_QK_STEP(6, P0, P1, 3); FA_QK_STEP(7, P0, P1, 3); \
        FA_QK_STEP(8, P0, P1, 3); FA_QK_STEP(9, P0, P1, 3); FA_QK_STEP(10, P0, P1, 3); FA_QK_STEP(11, P0, P1, 3); FA_QK_STEP(12, P0, P1, 3); FA_QK_STEP(13, P0, P1, 2); FA_QK_STEP(14, P0, P1, 1); FA_QK_STEP(15, P0, P1, 0); } while (0)
#define FA_PV_STEP(i, W) do { FA_LGKM(W); FA_SB(); \
        { const bf16x8 vf_ = (bf16x8){vl[(i) & 1][0], vl[(i) & 1][1], vl[(i) & 1][2], vl[(i) & 1][3], vh[(i) & 1][0], vh[(i) & 1][1], vh[(i) & 1][2], vh[(i) & 1][3]}; \
          o[(i) >> 2] = __builtin_amdgcn_mfma_f32_32x32x16_bf16(vf_, pf[(i) & 3], o[(i) >> 2], 0, 0, 0); } \
        FA_SB(); if ((i) + 2 < 16) { FA_DSTR(vl[(i) & 1], va_[((i) + 2) >> 2], (((i) + 2) & 3) * 4096); FA_DSTR(vh[(i) & 1], va_[((i) + 2) >> 2], (((i) + 2) & 3) * 4096 + 2048); } } while (0)
        const int qbL = 15 - ii, nsteps = 17;
#define FA_KB(s_) ((s_) <= qbL ? (s_) : ii - ((s_) - qbL - 1))
        int u = 0, qb = qbL, kb = 0, g = 0;
        FA_ISSUE_K(0, 0); FA_ISSUE_V(0, 0); FA_ISSUE_K(FA_KB(1) * 128, 1);
        bf16x8 qf[8]; f32x16 o[4]; float m = -1e30f, l = 0.f;
        { const bf16_t* qp = Q + (size_t)(b * SEQ + qb * 128 + rg * 32 + r32) * 1024 + h * 128 + 8 * hi;
#pragma unroll
          for (int d0 = 0; d0 < 8; ++d0) qf[d0] = *(const bf16x8*)(qp + 16 * d0); }
#pragma unroll
        for (int db = 0; db < 4; ++db)
#pragma unroll
            for (int r = 0; r < 16; ++r) o[db][r] = 0.f;
        FA_WAITBAR();
        f32x16 p0, p1, n0, n1;
        FA_QK(p0, p1, 0, 0);
        FA_WAITBAR();
        bool diag = false, lastb = false, done = false;
#define FA_SOFTPV(C0, C1) do { \
            if (diag) { const int qrel = rg * 32 + r32, k0 = kh * 64 + 4 * hi; \
                _Pragma("unroll") for (int r = 0; r < 16; ++r) { const int kr = k0 + (r & 3) + 8 * (r >> 2); if (kr > qrel) C0[r] = -INFINITY; if (kr + 32 > qrel) C1[r] = -INFINITY; } } \
            float mx = fmaxf(C0[0], C1[0]); \
            _Pragma("unroll") for (int r = 1; r < 16; ++r) mx = fmaxf(mx, fmaxf(C0[r], C1[r])); \
            mx = swapmax(mx); \
            const float mn = fmaxf(m, mx), alpha = __builtin_amdgcn_exp2f(m - mn); m = mn; \
            float ps = 0.f; \
            _Pragma("unroll") for (int r = 0; r < 16; ++r) { C0[r] = __builtin_amdgcn_exp2f(C0[r] - mn); C1[r] = __builtin_amdgcn_exp2f(C1[r] - mn); ps += C0[r] + C1[r]; } \
            l = l * alpha + ps; \
            if (!__all(alpha == 1.0f)) { \
                _Pragma("unroll") for (int db = 0; db < 4; ++db) _Pragma("unroll") for (int r = 0; r < 16; ++r) o[db][r] *= alpha; } \
            bf16x8 pf[4]; pf[0] = pack8(C0, 0); pf[1] = pack8(C0, 8); pf[2] = pack8(C1, 0); pf[3] = pack8(C1, 8); \
            { unsigned va_[4]; \
              _Pragma("unroll") for (int db = 0; db < 4; ++db) va_[db] = ldsb + (unsigned)(65536 + (g & 1) * 32768 + vfo[db]); \
              v4i16 vl[2], vh[2]; FA_SB(); FA_DSTR(vl[0], va_[0], 0); FA_DSTR(vh[0], va_[0], 2048); FA_DSTR(vl[1], va_[0], 4096); FA_DSTR(vh[1], va_[0], 4096 + 2048); \
              FA_PV_STEP(0, 2); FA_PV_STEP(1, 2); FA_PV_STEP(2, 2); FA_PV_STEP(3, 2); FA_PV_STEP(4, 2); FA_PV_STEP(5, 2); FA_PV_STEP(6, 2); FA_PV_STEP(7, 2); \
              FA_PV_STEP(8, 2); FA_PV_STEP(9, 2); FA_PV_STEP(10, 2); FA_PV_STEP(11, 2); FA_PV_STEP(12, 2); FA_PV_STEP(13, 2); FA_PV_STEP(14, 2); FA_PV_STEP(15, 0); } } while (0)
#define FA_STEP(C0, C1, N0, N1) do { \
            diag = (kb == qb); lastb = (u == 0 ? kb == qb : kb == 0); \
            if (g + 2 < nsteps) FA_ISSUE_K(FA_KB(g + 2) * 128, g & 1); \
            if (g + 1 < nsteps) FA_ISSUE_V(FA_KB(g + 1) * 128, (g + 1) & 1); \
            const int kbn_ = (u == 0 ? kb + 1 : kb - 1); \
            if (kh == 0 && !lastb) FA_QK(N0, N1, (g + 1) & 1, kbn_); \
            FA_SOFTPV(C0, C1); \
            if (kh == 1 && !lastb) FA_QK(N0, N1, (g + 1) & 1, kbn_); \
            FA_WAITBAR(); } while (0)
#define FA_UNIT_END() do { \
            FA_LAS float* mb = (FA_LAS float*)(lds + 65536 + (g & 1) * 32768) + rg * 2048; FA_LAS float* ml = (FA_LAS float*)(lds + LDS_ML) + rg * 128; \
            const float lt = swapsum(l); \
            if (kh == 1) { ml[lane] = m; ml[64 + lane] = lt; } \
            float s1 = 0.f, s2m = 0.f; \
            _Pragma("unroll") for (int half = 0; half < 2; ++half) { \
                if (kh == 1) { \
                    _Pragma("unroll") for (int d2 = 0; d2 < 2; ++d2) _Pragma("unroll") for (int r = 0; r < 16; ++r) mb[(d2 * 16 + r) * 64 + lane] = o[2 * half + d2][r]; } \
                FA_WAITBAR(); \
                if (kh == 0) { \
                    if (half == 0) { const float m2 = ml[lane], l2 = ml[64 + lane], mm = fmaxf(m, m2), a1 = __builtin_amdgcn_exp2f(m - mm), a2 = __builtin_amdgcn_exp2f(m2 - mm); \
                        const float inv = 1.0f / (lt * a1 + l2 * a2); s1 = a1 * inv; s2m = a2 * inv; } \
                    bf16_t* op = MIXIN + (size_t)(b * SEQ + qb * 128 + rg * 32 + r32) * 2048 + 1024 + h * 128 + 4 * hi; \
                    _Pragma("unroll") for (int d2 = 0; d2 < 2; ++d2) _Pragma("unroll") for (int g4 = 0; g4 < 4; ++g4) { float v[4]; \
                        _Pragma("unroll") for (int j = 0; j < 4; ++j) v[j] = o[2 * half + d2][4 * g4 + j] * s1 + mb[(d2 * 16 + 4 * g4 + j) * 64 + lane] * s2m; \
                        u32x2 w; w.x = cvtpk(v[0], v[1]); w.y = cvtpk(v[2], v[3]); *(u32x2*)(op + 32 * (2 * half + d2) + 8 * g4) = w; } } \
                FA_WAITBAR(); } \
            if (u == 1) { done = true; } else { \
                u = 1; qb = ii; kb = ii; ++g; \
                { const bf16_t* qp = Q + (size_t)(b * SEQ + qb * 128 + rg * 32 + r32) * 1024 + h * 128 + 8 * hi; \
                  _Pragma("unroll") for (int d0 = 0; d0 < 8; ++d0) qf[d0] = *(const bf16x8*)(qp + 16 * d0); } \
                _Pragma("unroll") for (int db = 0; db < 4; ++db) _Pragma("unroll") for (int r = 0; r < 16; ++r) o[db][r] = 0.f; \
                m = -1e30f; l = 0.f; \
                FA_QK(p0, p1, g & 1, kb); \
                FA_WAITBAR(); } } while (0)
        for (;;) {
            FA_STEP(p0, p1, n0, n1);
            if (lastb) { FA_UNIT_END(); if (done) break; continue; }
            kb += (u == 0 ? 1 : -1); ++g; p0 = n0; p1 = n1;
        }
#undef FA_SOFTPV
#undef FA_STEP
#undef FA_UNIT_END
#undef FA_ISSUE_K
#undef FA_ISSUE_V
#undef FA_QK
#undef FA_QK_STEP
#undef FA_PV_STEP
#undef FA_KB
    }
}
}

namespace fs {
#define FS_LAS __attribute__((address_space(3)))
__device__ __forceinline__ void sgu_phase(const Args& A, FS_LAS unsigned char* lds) {
    const bf16_t* U = (const bf16_t*)(A.ws + WS_U); const bf16_t* V = (const bf16_t*)(A.ws + WS_V); bf16_t* MIXIN = (bf16_t*)(A.ws + WS_MIXIN);
    const float* wsp = A.in[7]; const float* bsp = A.in[8]; const float* ln_g = A.in[5]; const float* ln_b = A.in[6]; const float* VSTAT = (const float*)(A.ws + WS_VSTAT);
    const int tid = threadIdx.x, lane = tid & 63, wid = __builtin_amdgcn_readfirstlane(tid >> 6), tb = wid & 3, dh = wid >> 2, r32 = lane & 31, hi = lane >> 5;
    const int frow = tid >> 2, fq4 = tid & 3;
    int vfo[2];
    { const int d16 = (lane >> 4) & 1, q = (lane & 15) >> 2, p = lane & 3;
#pragma unroll
      for (int j = 0; j < 2; ++j) vfo[j] = 32768 + (8 * hi + q) * 256 + (((2 * dh + j) ^ q) * 64) + d16 * 32 + p * 8; }
    const int wfo = (32 * tb + r32) * 256;
    for (int u0 = blockIdx.x; u0 < (T / CHUNK) * NG * PROBE_REP_SGU; u0 += gridDim.x) { const int u = u0 % ((T / CHUNK) * NG);
        const int rc = u / NG, g = u % NG, row0 = rc * CHUNK;
        { const float* wr = wsp + ((size_t)g * CHUNK + frow) * CHUNK + fq4 * 32;
#pragma unroll
          for (int c = 0; c < 4; ++c) { const f32x4 a = *(const f32x4*)(wr + 8 * c), b2 = *(const f32x4*)(wr + 8 * c + 4); const int s0 = fq4 * 32 + 8 * c; float v[8] = {a.x, a.y, a.z, a.w, b2.x, b2.y, b2.z, b2.w};
#pragma unroll
              for (int j = 0; j < 8; ++j) if (s0 + j > frow) v[j] = 0.f;
              u32x4 w; w.x = pk2(v[0], v[1]); w.y = pk2(v[2], v[3]); w.z = pk2(v[4], v[5]); w.w = pk2(v[6], v[7]);
              *(FS_LAS u32x4*)(lds + frow * 256 + (((4 * fq4 + c) ^ (frow & 15)) * 16)) = w; }
          const bf16_t* vr = V + (size_t)(row0 + frow) * 1024 + g * 128 + fq4 * 32;
          float mean, rstd;
          { const f32x4 pa = *(const f32x4*)(VSTAT + ((size_t)(row0 + frow) * 16 + 4 * fq4) * 2), pb = *(const f32x4*)(VSTAT + ((size_t)(row0 + frow) * 16 + 4 * fq4) * 2 + 4);
            float s1 = (pa[0] + pa[2]) + (pb[0] + pb[2]), s2 = (pa[1] + pa[3]) + (pb[1] + pb[3]);
            s1 += __shfl_xor(s1, 1); s1 += __shfl_xor(s1, 2); s2 += __shfl_xor(s2, 1); s2 += __shfl_xor(s2, 2);
            mean = s1 * (1.f / 1024.f); rstd = rsqrtf(fmaxf(s2 * (1.f / 1024.f) - mean * mean, 0.f) + EPS); }
#pragma unroll
          for (int c = 0; c < 4; ++c) { const u32x4 w = *(const u32x4*)(vr + 8 * c); const int cb = g * 128 + fq4 * 32 + 8 * c;
              const f32x4 ga = *(const f32x4*)(ln_g + cb), gb = *(const f32x4*)(ln_g + cb + 4), ba = *(const f32x4*)(ln_b + cb), bb = *(const f32x4*)(ln_b + cb + 4);
              float v[8];
#pragma unroll
              for (int e2 = 0; e2 < 4; ++e2) { v[2 * e2] = __uint_as_float(w[e2] << 16); v[2 * e2 + 1] = __uint_as_float(w[e2] & 0xffff0000u); }
              u32x4 o; o.x = pk2((v[0] - mean) * rstd * ga[0] + ba[0], (v[1] - mean) * rstd * ga[1] + ba[1]); o.y = pk2((v[2] - mean) * rstd * ga[2] + ba[2], (v[3] - mean) * rstd * ga[3] + ba[3]);
              o.z = pk2((v[4] - mean) * rstd * gb[0] + bb[0], (v[5] - mean) * rstd * gb[1] + bb[1]); o.w = pk2((v[6] - mean) * rstd * gb[2] + bb[2], (v[7] - mean) * rstd * gb[3] + bb[3]);
              *(FS_LAS u32x4*)(lds + 32768 + frow * 256 + (((4 * fq4 + c) ^ ((frow & 3) << 2)) * 16)) = o; } }
        __syncthreads();
        fa::f32x16 acc[2];
#pragma unroll
        for (int j = 0; j < 2; ++j)
#pragma unroll
            for (int r = 0; r < 16; ++r) acc[j][r] = 0.f;
        for (int s = 0; s <= 2 * tb + 1; ++s) {
            const fa::bf16x8 wf = *(FS_LAS const fa::bf16x8*)(lds + wfo + (((2 * s + hi) ^ (r32 & 15)) * 16));
#pragma unroll
            for (int j = 0; j < 2; ++j) {
                const fa::v4i16 lo = __builtin_amdgcn_ds_read_tr16_b64_v4i16((FS_LAS fa::v4i16*)(lds + vfo[j] + s * 4096));
                const fa::v4i16 hh = __builtin_amdgcn_ds_read_tr16_b64_v4i16((FS_LAS fa::v4i16*)(lds + vfo[j] + s * 4096 + 1024));
                const fa::bf16x8 vf = (fa::bf16x8){lo[0], lo[1], lo[2], lo[3], hh[0], hh[1], hh[2], hh[3]};
                acc[j] = __builtin_amdgcn_mfma_f32_32x32x16_bf16(vf, wf, acc[j], 0, 0, 0); }
        }
        { const int tt = 32 * tb + r32; const float bb = bsp[g * CHUNK + tt]; const size_t rw = (size_t)(row0 + tt);
#pragma unroll
          for (int j = 0; j < 2; ++j)
#pragma unroll
              for (int g4 = 0; g4 < 4; ++g4) { const int d = 32 * (2 * dh + j) + 8 * g4 + 4 * hi; const u32x2 uu = *(const u32x2*)(U + rw * 1024 + g * 128 + d);
                  const float u0 = __uint_as_float(uu.x << 16), u1 = __uint_as_float(uu.x & 0xffff0000u), u2 = __uint_as_float(uu.y << 16), u3 = __uint_as_float(uu.y & 0xffff0000u);
                  u32x2 w; w.x = fa::cvtpk(u0 * (acc[j][4 * g4] + bb), u1 * (acc[j][4 * g4 + 1] + bb)); w.y = fa::cvtpk(u2 * (acc[j][4 * g4 + 2] + bb), u3 * (acc[j][4 * g4 + 3] + bb));
                  *(u32x2*)(MIXIN + rw * 2048 + g * 128 + d) = w; } }
        __syncthreads();
    }
}
}


#define XB_TMO      128
#define XB_XCNT(j)  (256  + 64 * (j))
#define XB_XSUB(j)  (1280 + 64 * (j))
#define XB_XGEN(j)  (2304 + 64 * (j))
#define XB_TOP      3328
#define XB_TOPGEN   3392
#define XCD_BAR_WORDS 3456
#define XB_SPIN_CAP (1u << 18)
#define XLAS __attribute__((address_space(3)))
__device__ __forceinline__ unsigned xb_ld(unsigned* p)              { return __hip_atomic_load(p, __ATOMIC_RELAXED, __HIP_MEMORY_SCOPE_AGENT); }
__device__ __forceinline__ unsigned xb_add(unsigned* p, unsigned v) { return __hip_atomic_fetch_add(p, v, __ATOMIC_RELAXED, __HIP_MEMORY_SCOPE_AGENT); }
__device__ __forceinline__ unsigned xb_xcc_id() { return (unsigned)__builtin_amdgcn_s_getreg((3 << 11) | 20) & 0xFu; }
#define XB_SPIN(cond, bar) do { unsigned _sp = 0; while (cond) { __builtin_amdgcn_s_sleep(1); \
    if ((++_sp & 255u) == 0u) { if (xb_ld(&(bar)[XB_TMO])) break; if (_sp > XB_SPIN_CAP) { atomicAdd(&(bar)[XB_TMO], 1u); break; } } } } while (0)
struct XcdBarrier { unsigned* bar; unsigned x; volatile XLAS unsigned* st; };
__device__ __forceinline__ XcdBarrier xcd_barrier_post(unsigned* bar, volatile XLAS unsigned* st) {
    XcdBarrier b; b.bar = bar; b.x = xb_xcc_id(); b.st = st;
    if (threadIdx.x == 0) (void)xb_add(&bar[XB_XCNT(b.x)], 1u);
    return b;
}
__device__ __forceinline__ void xcd_barrier_complete(unsigned* bar, unsigned x, unsigned& nloc, unsigned& nx) {
    const unsigned G = gridDim.x * gridDim.y * gridDim.z;
    unsigned sum, cnt, mine, sp = 0u;
    for (;;) {
        sum = 0u; cnt = 0u; mine = 0u;
#pragma unroll
        for (unsigned j = 0; j < 16; ++j) { const unsigned c = xb_ld(&bar[XB_XCNT(j)]); sum += c; cnt += (c > 0u) ? 1u : 0u; mine = (j == x) ? c : mine; }
        if (sum == G) break;
        __builtin_amdgcn_s_sleep(1);
        if ((++sp & 255u) == 0u) { if (xb_ld(&bar[XB_TMO])) break; if (sp > XB_SPIN_CAP) { atomicAdd(&bar[XB_TMO], 1u); break; } }
    }
    nloc = mine > 0u ? mine : 1u; nx = cnt > 0u ? cnt : 1u;
}
__device__ __forceinline__ void xcd_barrier(const XcdBarrier& b) {
    asm volatile("s_waitcnt vmcnt(0)" ::: "memory");
    __syncthreads();
    if (threadIdx.x == 0) {
        unsigned* bar = b.bar;
        __builtin_amdgcn_s_waitcnt(0);
        unsigned nloc = b.st[0], nx = b.st[1];
        if (nloc == 0u) { xcd_barrier_complete(bar, b.x, nloc, nx); b.st[0] = nloc; b.st[1] = nx; }
        const unsigned old = xb_add(&bar[XB_XSUB(b.x)], 1u);
        const unsigned gen = old / nloc;
        if (old + 1u == (gen + 1u) * nloc) {
            __builtin_amdgcn_fence(__ATOMIC_RELEASE, "agent");
            asm volatile("s_waitcnt vmcnt(0)" ::: "memory");
            const unsigned og = xb_add(&bar[XB_TOP], 1u);
            const unsigned tg = og / nx;
            if (og + 1u == (tg + 1u) * nx) xb_add(&bar[XB_TOPGEN], 1u);
            else XB_SPIN(xb_ld(&bar[XB_TOPGEN]) == tg, bar);
            __builtin_amdgcn_fence(__ATOMIC_ACQUIRE, "agent");
            xb_add(&bar[XB_XGEN(b.x)], 1u);
            asm volatile("s_waitcnt vmcnt(0)" ::: "memory");
        } else {
            XB_SPIN(xb_ld(&bar[XB_XGEN(b.x)]) == gen, bar);
            __builtin_amdgcn_fence(__ATOMIC_ACQUIRE, "agent");
            asm volatile("s_waitcnt vmcnt(0)" ::: "memory");
        }
    }
    __syncthreads();
}
constexpr int CW_BAR = 4096;
constexpr size_t CTL_ZERO_BYTES = 65536;
constexpr int LDS_BARST_OFF = LDS_BYTES - 16;

constexpr bool FAST_P1 = true, FAST_P3 = true, FAST_P4 = true, FAST_P6 = true, FAST_P7 = true;
constexpr bool FAST_ATTN = true, FAST_SGU = true;
constexpr bool FAST_ANY = FAST_P1 || FAST_P3 || FAST_P4 || FAST_P6 || FAST_P7;
constexpr int N_PHASES = 10;
__global__ void __launch_bounds__(NTHREADS, 2) fwd(Args A) {
    extern __shared__ __attribute__((aligned(16))) unsigned char lds[];
    float* ldsf = (float*)lds;
    const int lo = A.ph_lo, hi = A.ph_hi;
    if (threadIdx.x < 4) ((volatile XLAS unsigned*)((XLAS unsigned char*)lds + LDS_BARST_OFF))[threadIdx.x] = 0u;
    __syncthreads();
    XcdBarrier bar = xcd_barrier_post((unsigned*)(A.ws + WS_CTL) + CW_BAR, (volatile XLAS unsigned*)((XLAS unsigned char*)lds + LDS_BARST_OFF));
#define IN(k) (lo <= (k) && (k) < hi)
#define SEAM(k) do { if (IN(k) && IN((k) + 1)) xcd_barrier(bar); STAMP((k) + 1); } while (0)
    unsigned long long t_lo = 0, t_hi = 0;
#define STAMP(i) do { if (STAMP_PHASE >= 0) { if ((i) == STAMP_PHASE || (STAMP_PHASE == 98 && (i) == 0)) t_lo = __builtin_amdgcn_s_memrealtime(); if ((i) == STAMP_PHASE + 1 || (STAMP_PHASE == 98 && (i) == 9)) t_hi = __builtin_amdgcn_s_memrealtime(); } } while (0)
    STAMP(0);
    PG8_LAS unsigned char* l3 = (PG8_LAS unsigned char*)lds;
    if (IN(0)) { if (FAST_ANY) { p0_weights(A, l3, 0, 0); __syncthreads(); } p0_router_weights(A); p0_rows(A, ldsf); } SEAM(0);
    if (IN(1)) { if (FAST_P1 && FAST_ATTN && blockIdx.x < NB * NH) cumsum_bh(A, blockIdx.x, ldsf); if (FAST_P1) p1_fast(A, l3); else p1_naive(A, ldsf); if (FAST_ANY) { __syncthreads(); p0_weights(A, l3, 1, (1152 % (int)gridDim.x == 0) ? 0 : 1152 % (int)gridDim.x); } } SEAM(1);
    if (!(FAST_P1 && FAST_SGU && FAST_ATTN)) { if (IN(2)) { p1b_fix<0>(A, ldsf); } SEAM(2); }
    if (IN(3)) { if (FAST_SGU) fs::sgu_phase(A, l3); else p2_sgu_naive(A); if (FAST_ATTN) { __syncthreads(); fa::attn_phase(A, l3); } else p2_attn_naive(A, ldsf); } SEAM(3);
    if (IN(4)) { if (FAST_P3) p3_fast(A, l3); else p3_naive(A, ldsf); } SEAM(4);
    if (IN(5)) { if (FAST_P4) p4_fast(A, l3); else p4_naive(A, ldsf); } SEAM(5);
    if (IN(6)) { if (PROBE_ALT == 6) { p5_router3<1>(A, ldsf); __syncthreads(); } if (PROBE_ALT == 62) { p5_router3<2>(A, ldsf); __syncthreads(); } if (PROBE_ALT == 63) { p5_router3<3>(A, ldsf); __syncthreads(); } p5_router3<0>(A, ldsf); } SEAM(6);
    if (IN(7)) { if (FAST_P6) p6_fast(A, l3); else p6_naive(A, ldsf); } SEAM(7);
    if (IN(8)) { if (FAST_P7) p7_fast(A, l3); else p7_naive(A, ldsf); } SEAM(8);
    if (IN(9)) { if (PROBE_ALT == 9) { p8_combine<1>(A, ldsf); __syncthreads(); } p8_combine<0>(A, ldsf, STAMP_PHASE < 0 ? 0.f : (STAMP_PHASE == 99 ? 1.0f : (float)(t_hi - t_lo) * 0.01f * 0.001f * STAMP_SCALE)); }
#undef IN
#undef SEAM
}

#ifndef MK_N_LAUNCHES
#define MK_N_LAUNCHES 1
#endif
extern "C" void kernel_launch(void* const* d_in, const int* in_sizes, int n_in, void* d_out, int out_size, void* d_ws, size_t ws_size, hipStream_t stream) {
    static int grid = 0;
    if (grid == 0) {
        if (n_in != 22 || out_size != T * DM || ws_size < WS_END) { fprintf(stderr, "kernel_launch: unexpected shapes (n_in %d out %d ws %zu)\n", n_in, out_size, ws_size); grid = -1; return; }
        int dev = 0, cus = 0, per_cu = 0;
        hipGetDevice(&dev); hipDeviceGetAttribute(&cus, hipDeviceAttributeMultiprocessorCount, dev);
        hipFuncSetAttribute((const void*)fwd, hipFuncAttributeMaxDynamicSharedMemorySize, LDS_BYTES);
        hipOccupancyMaxActiveBlocksPerMultiprocessor(&per_cu, (const void*)fwd, NTHREADS, LDS_BYTES);
        if (per_cu < 1) { fprintf(stderr, "kernel_launch: occupancy query says %d blocks per CU\n", per_cu); per_cu = 1; }
        (void)hipGetLastError();
        grid = cus;
    }
    if (grid < 0) return;
    Args a{};
    for (int i = 0; i < 22; ++i) a.in[i] = (const float*)d_in[i];
    a.out = (float*)d_out; a.ws = (unsigned char*)d_ws;
    if (hipMemsetAsync((char*)d_ws + WS_CTL, 0, CTL_ZERO_BYTES, stream) != hipSuccess) { fprintf(stderr, "kernel_launch: memset failed\n"); return; }
    if (MK_N_LAUNCHES == 1) {
        a.ph_lo = 0; a.ph_hi = N_PHASES;
        hipLaunchKernelGGL(fwd, dim3(grid), dim3(NTHREADS), LDS_BYTES, stream, a);
    } else {
        for (int p = 0; p < N_PHASES; ++p) { a.ph_lo = p; a.ph_hi = p + 1; hipLaunchKernelGGL(fwd, dim3(grid), dim3(NTHREADS), LDS_BYTES, stream, a); }
    }
}
```

```cpp
#include <hip/hip_runtime.h>
#include <hip/hip_cooperative_groups.h>
#include <cstdio>
#include <cstdint>
namespace cg = cooperative_groups;

#ifndef STAMP_PHASE
#define STAMP_PHASE -1
#endif
#ifndef STAMP_SEL
#define STAMP_SEL 0
#endif
#ifndef STAMP_SCALE
#define STAMP_SCALE 0.5f
#endif
#ifndef PROBE_REP_P1
#define PROBE_REP_P1 1
#endif
#ifndef PROBE_REP_P4
#define PROBE_REP_P4 1
#endif
#ifndef PROBE_REP_P5
#define PROBE_REP_P5 1
#endif
#ifndef PROBE_REP_MOE
#define PROBE_REP_MOE 1
#endif
#ifndef PROBE_REP_ATTN
#define PROBE_REP_ATTN 1
#endif
#ifndef PROBE_REP_SGU
#define PROBE_REP_SGU 1
#endif
#ifndef PROBE_ATTN_VAR
#define PROBE_ATTN_VAR 0
#endif
#ifndef PROBE_ALT
#define PROBE_ALT -1
#endif
constexpr int T = 8192, SEQ = 2048, NB = 4, DM = 2048, SGUW = 1024, FOXW = 1024, NH = 8, HD = 128, CHUNK = 128, NG = 8;
constexpr int INCOLS = 9224, OFF_F = 5120, OFF_GATE = 5128;
constexpr int NEXP = 32, EPG = 8, NGRP = 4, DEXP = 512;
constexpr float EPS = 1e-6f;
constexpr float LOG2E = 1.4426950408889634f;
constexpr float QSCALE = 0.08838834764831845f * LOG2E;
constexpr int NTHREADS = 512, NWAVES = 8;
constexpr int LDS_BYTES = 160 * 1024;
constexpr int MTILE = 256;
constexpr int PMAX = 2 * T + NEXP * MTILE;
constexpr int MT_MAX = PMAX / MTILE;
constexpr bool XCDM_GU = true;
constexpr int TINY_ROWS = 0;

typedef unsigned short bf16_t;
typedef float f32x4 __attribute__((ext_vector_type(4)));
typedef unsigned u32x4 __attribute__((ext_vector_type(4)));
typedef unsigned u32x2 __attribute__((ext_vector_type(2)));

constexpr size_t MiB = 1u << 20;
constexpr size_t WS_CTL = 0;
constexpr size_t WS_LOGF = 1 * MiB;
constexpr size_t WS_CKL = 2 * MiB;
constexpr size_t WS_TOK = 3 * MiB;
constexpr size_t WS_GATE = 4 * MiB;
constexpr size_t WS_ASG = 5 * MiB;
constexpr size_t WS_WIN = 8 * MiB;
constexpr size_t WS_WPROJ = 44 * MiB;
constexpr size_t WS_WOUT = 52 * MiB;
constexpr size_t WS_WGU = 60 * MiB;
constexpr size_t WS_WD = 188 * MiB;
constexpr size_t WS_H = 252 * MiB;
constexpr size_t WS_MIXED = WS_H;
constexpr size_t WS_U = 284 * MiB;
constexpr size_t WS_V = 300 * MiB;
constexpr size_t WS_G = 316 * MiB;
constexpr size_t WS_YBUF = WS_U;
constexpr size_t WS_Q = 380 * MiB;
constexpr size_t WS_K = 396 * MiB;
constexpr size_t WS_VA = 412 * MiB;
constexpr size_t WS_ACT = WS_Q;
constexpr size_t WS_MIXIN = 428 * MiB;
constexpr size_t WS_H2 = WS_MIXIN;
constexpr size_t WS_END = 460 * MiB;
static_assert((size_t)PMAX * 2048 * 2 <= 96 * MiB && (size_t)PMAX * 512 * 2 <= 32 * MiB, "overlay sizes");

constexpr int CW_CNT = 0;
constexpr int CNT_STRIDE = 64;

__device__ __forceinline__ float bf2f(bf16_t v) { return __uint_as_float((unsigned)v << 16); }
__device__ __forceinline__ bf16_t f2bf(float f) { unsigned u = __float_as_uint(f); return (bf16_t)((u + 0x7fffu + ((u >> 16) & 1u)) >> 16); }
__device__ __forceinline__ unsigned pk2(float lo, float hi) { return (unsigned)f2bf(lo) | ((unsigned)f2bf(hi) << 16); }
__device__ __forceinline__ unsigned cvtpk_rne(float lo, float hi) { unsigned r; asm("v_cvt_pk_bf16_f32 %0, %1, %2" : "=v"(r) : "v"(lo), "v"(hi)); return r; }
__device__ __forceinline__ float wave_sum(float v) {
#pragma unroll
    for (int o = 1; o < 64; o <<= 1) v += __shfl_xor(v, o);
    return v;
}
__device__ __forceinline__ float wave_max(float v) {
#pragma unroll
    for (int o = 1; o < 64; o <<= 1) v = fmaxf(v, __shfl_xor(v, o));
    return v;
}
__device__ __forceinline__ float gelu_tanh(float x) {
    const float c = 0.7978845608028654f; const float y = c * (x + 0.044715f * x * x * x);
    return x / (1.0f + __expf(-2.0f * y));
}
__device__ __forceinline__ float sigmoidf_(float x) { return 1.0f / (1.0f + __expf(-x)); }
__device__ __forceinline__ float log_sigmoid(float z) { return fminf(z, 0.f) - log1pf(__expf(-fabsf(z))); }

struct Args {
    const float* in[22];
    float* out;
    unsigned char* ws;
    int ph_lo, ph_hi;
};

template <class AF, class BF, class EF>
__device__ __forceinline__ void naive_gemm_tile(float* lds, int m0, int n0, int M, int N, int K, int Ksplit, AF a, BF b, EF epi) {
    float* As = lds;
    float* Bs = lds + 16 * 132;
    const int tid = threadIdx.x, ty = tid >> 4, tx = tid & 15;
    float acc[4][8], acc1[4][8];
#pragma unroll
    for (int i = 0; i < 4; ++i)
#pragma unroll
        for (int j = 0; j < 8; ++j) { acc[i][j] = 0.f; acc1[i][j] = 0.f; }
    const bool split = Ksplit < K;
#pragma unroll 1
    for (int pass = 0; pass < 2; ++pass) {
        const int kb = pass == 0 ? 0 : Ksplit, ke = pass == 0 ? (split ? Ksplit : K) : K;
        if (pass == 1) {
            if (!split) break;
#pragma unroll
            for (int i = 0; i < 4; ++i)
#pragma unroll
                for (int j = 0; j < 8; ++j) { acc1[i][j] = acc[i][j]; acc[i][j] = 0.f; }
        }
#pragma unroll 1
        for (int k0 = kb; k0 < ke; k0 += 16) {
#pragma unroll
            for (int i = 0; i < 4; ++i) { const int idx = tid + i * 512, r = idx >> 4, kk = idx & 15; const int m = m0 + r; As[kk * 132 + r] = (m < M) ? a(m, k0 + kk) : 0.f; }
#pragma unroll
            for (int i = 0; i < 4; ++i) { const int idx = tid + i * 512, kk = idx >> 7, n = idx & 127; Bs[kk * 132 + n] = (n0 + n < N) ? b(k0 + kk, n0 + n) : 0.f; }
            __syncthreads();
#pragma unroll 4
            for (int kk = 0; kk < 16; ++kk) {
                float av[4], bv[8];
#pragma unroll
                for (int i = 0; i < 4; ++i) av[i] = As[kk * 132 + ty * 4 + i];
#pragma unroll
                for (int j = 0; j < 8; ++j) bv[j] = Bs[kk * 132 + tx * 8 + j];
#pragma unroll
                for (int i = 0; i < 4; ++i)
#pragma unroll
                    for (int j = 0; j < 8; ++j) acc[i][j] = fmaf(av[i], bv[j], acc[i][j]);
            }
            __syncthreads();
        }
    }
#pragma unroll
    for (int i = 0; i < 4; ++i)
#pragma unroll
        for (int j = 0; j < 8; ++j) { const int m = m0 + ty * 4 + i, n = n0 + tx * 8 + j; if (m < M && n < N) epi(m, n, split ? acc1[i][j] : acc[i][j], split ? acc[i][j] : 0.f); }
}
template <class AF, class BF, class EF>
__device__ __forceinline__ void naive_gemm(float* lds, int M, int N, int K, int Ksplit, AF a, BF b, EF epi) {
    const int ntm = (M + 127) / 128, ntn = (N + 127) / 128;
    for (int t = blockIdx.x; t < ntm * ntn; t += gridDim.x) naive_gemm_tile(lds, (t / ntn) * 128, (t % ntn) * 128, M, N, K, Ksplit, a, b, epi);
}

__device__ __forceinline__ void p0_rows(const Args& A, float* ldsf) {
    const float* x = A.in[0]; const float* g1 = A.in[1]; const float* w_in = A.in[2]; const float* b_forget = A.in[4];
    bf16_t* H = (bf16_t*)(A.ws + WS_H); float* LOGF = (float*)(A.ws + WS_LOGF);
    const int tid = threadIdx.x, lane = tid & 63, wave = tid >> 6;
    for (int i = tid; i < DM * 8; i += NTHREADS) ldsf[i] = w_in[(size_t)(i >> 3) * INCOLS + OFF_F + (i & 7)];
    __syncthreads();
    const int gw = blockIdx.x * NWAVES + wave, NGW = gridDim.x * NWAVES;
    for (int row = gw; row < T; row += NGW) {
        const f32x4* xr = (const f32x4*)(x + (size_t)row * DM) + lane;
        f32x4 xv[8]; float ss = 0.f;
#pragma unroll
        for (int j = 0; j < 8; ++j) xv[j] = xr[64 * j];
#pragma unroll
        for (int j = 0; j < 8; ++j) ss += xv[j].x * xv[j].x + xv[j].y * xv[j].y + xv[j].z * xv[j].z + xv[j].w * xv[j].w;
        const float rstd = rsqrtf(wave_sum(ss) * (1.f / DM) + EPS);
        float f[8];
#pragma unroll
        for (int h = 0; h < 8; ++h) f[h] = 0.f;
#pragma unroll
        for (int j = 0; j < 8; ++j) {
            const int c0 = 256 * j + 4 * lane; const f32x4 g = *(const f32x4*)(g1 + c0);
            f32x4 hv; hv.x = xv[j].x * rstd * g.x; hv.y = xv[j].y * rstd * g.y; hv.z = xv[j].z * rstd * g.z; hv.w = xv[j].w * rstd * g.w;
            u32x2 o; o.x = pk2(hv.x, hv.y); o.y = pk2(hv.z, hv.w);
            *(u32x2*)(H + (size_t)row * DM + c0) = o;
#pragma unroll
            for (int e = 0; e < 4; ++e) { const float hx = hv[e]; const float* wf = ldsf + (c0 + e) * 8;
#pragma unroll
                for (int h = 0; h < 8; ++h) f[h] = fmaf(hx, wf[h], f[h]); }
            asm volatile("" ::: "memory");
        }
#pragma unroll
        for (int h = 0; h < 8; ++h) f[h] = wave_sum(f[h]);
        if (lane < 8) { float z = 0.f;
#pragma unroll
            for (int h = 0; h < 8; ++h) if (lane == h) z = f[h];
            LOGF[(size_t)row * 8 + lane] = log_sigmoid(z + b_forget[lane]); }
    }
}

__device__ __forceinline__ void p1_naive(const Args& A, float* ldsf) {
    const bf16_t* H = (const bf16_t*)(A.ws + WS_H); const float* w_in = A.in[2]; const float* b_gate = A.in[3];
    bf16_t* U = (bf16_t*)(A.ws + WS_U); bf16_t* V = (bf16_t*)(A.ws + WS_V); bf16_t* Q = (bf16_t*)(A.ws + WS_Q); bf16_t* K = (bf16_t*)(A.ws + WS_K);
    bf16_t* VA = (bf16_t*)(A.ws + WS_VA); bf16_t* G = (bf16_t*)(A.ws + WS_G);
    naive_gemm(ldsf, T, 9216, DM, DM,
        [=](int m, int k) { return bf2f(H[(size_t)m * DM + k]); },
        [=](int k, int n) { const int c = n < 5120 ? n : n + 8; return w_in[(size_t)k * INCOLS + c]; },
        [=](int m, int n, float s, float) {
            if (n < 1024) U[(size_t)m * 1024 + n] = f2bf(gelu_tanh(s));
            else if (n < 2048) V[(size_t)m * 1024 + n - 1024] = f2bf(gelu_tanh(s));
            else if (n < 3072) Q[(size_t)m * 1024 + n - 2048] = f2bf(s);
            else if (n < 4096) K[(size_t)m * 1024 + n - 3072] = f2bf(s);
            else if (n < 5120) VA[(size_t)m * 1024 + n - 4096] = f2bf(s);
            else G[(size_t)m * 4096 + n - 5120] = f2bf(sigmoidf_(s + b_gate[n - 5120]));
        });
}

template <int ALT> __device__ __forceinline__ void p1b_fix(const Args& A, float* ldsf) {
    bf16_t* V = (bf16_t*)(A.ws + WS_V); bf16_t* Q = (bf16_t*)(A.ws + WS_Q); bf16_t* K = (bf16_t*)(A.ws + WS_K);
    const size_t altoff = ALT ? ((size_t)((unsigned char*)A.out - (A.ws + WS_V))) / 2 : 0;
    const size_t altq = ALT ? ((size_t)((unsigned char*)A.out + 16 * MiB - (A.ws + WS_Q))) / 2 : 0, altk = ALT ? ((size_t)((unsigned char*)A.out + 32 * MiB - (A.ws + WS_K))) / 2 : 0;
    const float* ln_g = A.in[5]; const float* ln_b = A.in[6]; const float* qg = A.in[9]; const float* kg = A.in[10];
    const int tid = threadIdx.x, lane = tid & 63, wave = tid >> 6;
    const int gw = blockIdx.x * NWAVES + wave, NGW = gridDim.x * NWAVES;
    for (int row = gw; row < T; row += NGW) {
        {
            bf16_t* vr = V + (size_t)row * 1024; float v[16]; float s = 0.f;
#pragma unroll
            for (int j = 0; j < 2; ++j) { const u32x4 w = *(const u32x4*)(vr + 512 * j + 8 * lane);
#pragma unroll
                for (int e = 0; e < 4; ++e) { v[8 * j + 2 * e] = __uint_as_float(w[e] << 16); v[8 * j + 2 * e + 1] = __uint_as_float(w[e] & 0xffff0000u); } }
#pragma unroll
            for (int i = 0; i < 16; ++i) s += v[i];
            const float mean = wave_sum(s) * (1.f / 1024.f); float q = 0.f;
#pragma unroll
            for (int i = 0; i < 16; ++i) { v[i] -= mean; q += v[i] * v[i]; }
            const float rstd = rsqrtf(wave_sum(q) * (1.f / 1024.f) + EPS);
#pragma unroll
            for (int j = 0; j < 2; ++j) { const int c0 = 512 * j + 8 * lane; u32x4 o;
#pragma unroll
                for (int e = 0; e < 4; ++e) o[e] = pk2(v[8 * j + 2 * e] * rstd * ln_g[c0 + 2 * e] + ln_b[c0 + 2 * e], v[8 * j + 2 * e + 1] * rstd * ln_g[c0 + 2 * e + 1] + ln_b[c0 + 2 * e + 1]);
                *(u32x4*)(vr + altoff + c0) = o; }
        }
#pragma unroll
        for (int which = 0; which < 2; ++which) {
            bf16_t* pr = (which == 0 ? Q : K) + (size_t)row * 1024 + 16 * lane; const float* gg = which == 0 ? qg : kg; float v[16]; float s = 0.f;
#pragma unroll
            for (int j = 0; j < 2; ++j) { const u32x4 w = *(const u32x4*)(pr + 8 * j);
#pragma unroll
                for (int e = 0; e < 4; ++e) { v[8 * j + 2 * e] = __uint_as_float(w[e] << 16); v[8 * j + 2 * e + 1] = __uint_as_float(w[e] & 0xffff0000u); } }
#pragma unroll
            for (int i = 0; i < 16; ++i) s += v[i] * v[i];
            s += __shfl_xor(s, 1); s += __shfl_xor(s, 2); s += __shfl_xor(s, 4);
            const float sc = rsqrtf(s * (1.f / 128.f) + EPS) * (which == 0 ? QSCALE : 1.f); const int d0 = (16 * lane) & 127;
#pragma unroll
            for (int j = 0; j < 2; ++j) { u32x4 o;
#pragma unroll
                for (int e = 0; e < 4; ++e) o[e] = pk2(v[8 * j + 2 * e] * sc * gg[d0 + 8 * j + 2 * e], v[8 * j + 2 * e + 1] * sc * gg[d0 + 8 * j + 2 * e + 1]);
                *(u32x4*)(pr + (which == 0 ? altq : altk) + 8 * j) = o; }
        }
    }
    if (blockIdx.x < NB * NH) {
        const int b = blockIdx.x / NH, h = blockIdx.x % NH; const float* LOGF = (const float*)(A.ws + WS_LOGF); float* CKL = (float*)(A.ws + WS_CKL) + (size_t)blockIdx.x * SEQ + (ALT ? 65536 : 0);
        float v[4]; float s = 0.f;
#pragma unroll
        for (int i = 0; i < 4; ++i) { v[i] = LOGF[(size_t)(b * SEQ + tid * 4 + i) * 8 + h]; s += v[i]; }
        float incl = s;
#pragma unroll
        for (int o = 1; o < 64; o <<= 1) { const float t = __shfl_up(incl, o); if (lane >= o) incl += t; }
        __syncthreads();
        if (lane == 63) ldsf[wave] = incl;
        __syncthreads();
        float base = 0.f;
        for (int w = 0; w < wave; ++w) base += ldsf[w];
        float run = base + incl - s;
#pragma unroll
        for (int i = 0; i < 4; ++i) { run += v[i]; CKL[tid * 4 + i] = run * LOG2E; }
        __syncthreads();
    }
}


__device__ __forceinline__ void cumsum_bh(const Args& A, int bh, float* ldsf) {
    const int tid = threadIdx.x, lane = tid & 63, wave = tid >> 6, b = bh / NH, h = bh % NH;
    const float* LOGF = (const float*)(A.ws + WS_LOGF); float* CKL = (float*)(A.ws + WS_CKL) + (size_t)bh * SEQ;
    float v[4]; float sm = 0.f;
#pragma unroll
    for (int i = 0; i < 4; ++i) { v[i] = LOGF[(size_t)(b * SEQ + tid * 4 + i) * 8 + h]; sm += v[i]; }
    float incl = sm;
#pragma unroll
    for (int o = 1; o < 64; o <<= 1) { const float t = __shfl_up(incl, o); if (lane >= o) incl += t; }
    if (lane == 63) ldsf[wave] = incl;
    __syncthreads();
    float run = incl - sm;
    for (int w = 0; w < wave; ++w) run += ldsf[w];
    f32x4 o4;
#pragma unroll
    for (int i = 0; i < 4; ++i) { run += v[i]; o4[i] = run * LOG2E; }
    *(f32x4*)(CKL + tid * 4) = o4;
    __syncthreads();
}

__device__ __forceinline__ void p2_sgu_naive(const Args& A) {
    const bf16_t* U = (const bf16_t*)(A.ws + WS_U); const bf16_t* V = (const bf16_t*)(A.ws + WS_V); bf16_t* MIXIN = (bf16_t*)(A.ws + WS_MIXIN);
    const float* wsp = A.in[7]; const float* bsp = A.in[8];
    const int tid = threadIdx.x, tt = tid >> 2, dp = tid & 3;
    for (int u = blockIdx.x; u < (T / CHUNK) * NG; u += gridDim.x) {
        const int rc = u / NG, g = u % NG; const int row0 = rc * CHUNK;
        float acc[32];
#pragma unroll
        for (int i = 0; i < 32; ++i) acc[i] = 0.f;
        for (int ss = 0; ss <= tt; ++ss) {
            const float w = wsp[((size_t)g * CHUNK + tt) * CHUNK + ss];
            const bf16_t* vr = V + (size_t)(row0 + ss) * 1024 + g * 128 + dp * 32;
#pragma unroll
            for (int i = 0; i < 32; ++i) acc[i] = fmaf(w, bf2f(vr[i]), acc[i]);
        }
        const float bb = bsp[g * CHUNK + tt];
        const bf16_t* ur = U + (size_t)(row0 + tt) * 1024 + g * 128 + dp * 32; bf16_t* orow = MIXIN + (size_t)(row0 + tt) * 2048 + g * 128 + dp * 32;
#pragma unroll
        for (int i = 0; i < 32; ++i) orow[i] = f2bf(bf2f(ur[i]) * (acc[i] + bb));
    }
}
__device__ __forceinline__ void p2_attn_naive(const Args& A, float* ldsf) {
    const bf16_t* Q = (const bf16_t*)(A.ws + WS_Q); const bf16_t* K = (const bf16_t*)(A.ws + WS_K); const bf16_t* VA = (const bf16_t*)(A.ws + WS_VA);
    const float* CKL = (const float*)(A.ws + WS_CKL); bf16_t* MIXIN = (bf16_t*)(A.ws + WS_MIXIN);
    const int tid = threadIdx.x, lane = tid & 63, wave = tid >> 6;
    float* qs = ldsf + wave * 128;
    const int gw = blockIdx.x * NWAVES + wave, NGW = gridDim.x * NWAVES;
    for (int item = gw; item < T * NH; item += NGW) {
        const int row = item / NH, h = item % NH, b = row / SEQ, t = row % SEQ;
        const bf16_t* qr = Q + (size_t)row * 1024 + h * 128;
        qs[lane] = bf2f(qr[lane]); qs[64 + lane] = bf2f(qr[64 + lane]);
        __builtin_amdgcn_s_waitcnt(0);
        const float* ck = CKL + (size_t)(b * NH + h) * SEQ;
        float m = -1e30f, l = 0.f, o0 = 0.f, o1 = 0.f;
        for (int s0 = 0; s0 <= t; s0 += 64) {
            const int s = s0 + lane; float sc = -INFINITY;
            if (s <= t) { const bf16_t* kr = K + (size_t)(b * SEQ + s) * 1024 + h * 128; float d = 0.f;
                for (int c = 0; c < 16; ++c) { const u32x4 w = *(const u32x4*)(kr + 8 * c);
#pragma unroll
                    for (int e = 0; e < 4; ++e) { d = fmaf(qs[8 * c + 2 * e], __uint_as_float(w[e] << 16), d); d = fmaf(qs[8 * c + 2 * e + 1], __uint_as_float(w[e] & 0xffff0000u), d); } }
                sc = d - ck[s]; }
            const float mn = fmaxf(m, wave_max(sc)); const float alpha = exp2f(m - mn); const float p = exp2f(sc - mn);
            l = l * alpha + wave_sum(p); o0 *= alpha; o1 *= alpha; m = mn;
            const int nk = min(64, t - s0 + 1);
            for (int j = 0; j < nk; ++j) { const float pj = __shfl(p, j); const unsigned w = *(const unsigned*)(VA + (size_t)(b * SEQ + s0 + j) * 1024 + h * 128 + 2 * lane);
                o0 = fmaf(pj, __uint_as_float(w << 16), o0); o1 = fmaf(pj, __uint_as_float(w & 0xffff0000u), o1); }
        }
        const float il = 1.f / l;
        *(unsigned*)(MIXIN + (size_t)row * 2048 + 1024 + h * 128 + 2 * lane) = pk2(o0 * il, o1 * il);
    }
}

__device__ __forceinline__ void p3_naive(const Args& A, float* ldsf) {
    const bf16_t* MIXIN = (const bf16_t*)(A.ws + WS_MIXIN); const bf16_t* G = (const bf16_t*)(A.ws + WS_G); bf16_t* MIXED = (bf16_t*)(A.ws + WS_MIXED);
    const float* wps = A.in[11]; const float* wpf = A.in[12];
    naive_gemm(ldsf, T, DM, 2048, 1024,
        [=](int m, int k) { return bf2f(MIXIN[(size_t)m * 2048 + k]); },
        [=](int k, int n) { return k < 1024 ? wps[(size_t)k * DM + n] : wpf[(size_t)(k - 1024) * DM + n]; },
        [=](int m, int n, float s1, float s2) { MIXED[(size_t)m * DM + n] = f2bf(bf2f(G[(size_t)m * 4096 + n]) * s1 + bf2f(G[(size_t)m * 4096 + 2048 + n]) * s2); });
}
__device__ __forceinline__ void p4_naive(const Args& A, float* ldsf) {
    const bf16_t* MIXED = (const bf16_t*)(A.ws + WS_MIXED); const float* wo = A.in[13]; const float* x = A.in[0]; float* X1 = A.out;
    naive_gemm(ldsf, T, DM, DM, DM,
        [=](int m, int k) { return bf2f(MIXED[(size_t)m * DM + k]); },
        [=](int k, int n) { return wo[(size_t)k * DM + n]; },
        [=](int m, int n, float s, float) { X1[(size_t)m * DM + n] = x[(size_t)m * DM + n] + s; });
}

template <int ALT> __device__ __forceinline__ void p5_router(const Args& A, float* ldsf) {
    const float* X1 = A.out; const float* g2 = A.in[14]; const float* wrg = A.in[15]; const float* brg = A.in[16]; const float* wre = A.in[17]; const float* bre = A.in[18];
    bf16_t* H2 = (bf16_t*)(A.ws + WS_H2); unsigned* cnt = (unsigned*)(A.ws + WS_CTL) + CW_CNT + (ALT ? 2048 : 0);
    int* TOK = (int*)(A.ws + (ALT ? WS_H : WS_TOK)); float* GATE = (float*)(A.ws + (ALT ? WS_H + 2 * MiB : WS_GATE)); int* ASG = (int*)(A.ws + (ALT ? WS_H + 4 * MiB : WS_ASG));
    const int tid = threadIdx.x, lane = tid & 63, wave = tid >> 6, r = tid >> 4, ks = tid & 15;
    float* Ws = ldsf;
    float* Xs = ldsf + 256 * 36;
    float* rs = Xs + 32 * 260;
    int* hist = (int*)(rs + 32);
    int* hbase = hist + 32;
    int* sel = hbase + 32;
    int* lpos = sel + 64;
    float* selw = (float*)(lpos + 64);
    for (int rb = blockIdx.x; rb < T / 32; rb += gridDim.x) {
        const int row0 = rb * 32;
        for (int i = 0; i < 4; ++i) { const int rr = wave * 4 + i; const f32x4* xr = (const f32x4*)(X1 + (size_t)(row0 + rr) * DM) + lane; float ss = 0.f;
#pragma unroll
            for (int j = 0; j < 8; ++j) { const f32x4 v = xr[64 * j]; ss += v.x * v.x + v.y * v.y + v.z * v.z + v.w * v.w; }
            ss = wave_sum(ss); if (lane == 0) rs[rr] = rsqrtf(ss * (1.f / DM) + EPS); }
        if (tid < 32) hist[tid] = 0;
        __syncthreads();
        float acc[36];
#pragma unroll
        for (int j = 0; j < 36; ++j) acc[j] = 0.f;
        for (int k0 = 0; k0 < DM; k0 += 256) {
            for (int i = tid; i < 256 * 36; i += NTHREADS) { const int kk = i / 36, j = i % 36; Ws[i] = j < 4 ? wrg[(size_t)(k0 + kk) * 4 + j] : wre[(size_t)(k0 + kk) * 32 + j - 4]; }
            for (int i = tid; i < 32 * 256; i += NTHREADS) { const int rr = i >> 8, kk = i & 255; const float hv = X1[(size_t)(row0 + rr) * DM + k0 + kk] * rs[rr] * g2[k0 + kk];
                Xs[rr * 260 + kk] = hv; H2[(size_t)(row0 + rr) * DM + k0 + kk] = f2bf(hv); }
            __syncthreads();
            for (int kk = ks; kk < 256; kk += 16) { const float xv = Xs[r * 260 + kk]; const float* wr = Ws + kk * 36;
#pragma unroll
                for (int j = 0; j < 36; ++j) acc[j] = fmaf(xv, wr[j], acc[j]); }
            __syncthreads();
        }
#pragma unroll
        for (int j = 0; j < 36; ++j) { float v = acc[j]; v += __shfl_xor(v, 1); v += __shfl_xor(v, 2); v += __shfl_xor(v, 4); v += __shfl_xor(v, 8); acc[j] = v; }
        if (ks == 0) {
            float gl[4]; int grp = 0; float gm;
#pragma unroll
            for (int j = 0; j < 4; ++j) gl[j] = acc[j] + brg[j];
            gm = gl[0];
#pragma unroll
            for (int j = 1; j < 4; ++j) if (gl[j] > gm) { gm = gl[j]; grp = j; }
            float den = 0.f;
#pragma unroll
            for (int j = 0; j < 4; ++j) den += __expf(gl[j] - gm);
            const float pg = 1.f / den;
            float el[8];
#pragma unroll
            for (int j = 0; j < 8; ++j) { float v = 0.f;
#pragma unroll
                for (int g = 0; g < 4; ++g) if (g == grp) v = acc[4 + g * 8 + j] + bre[g * 8 + j];
                el[j] = v; }
            int i0 = 0; float v0 = el[0];
#pragma unroll
            for (int j = 1; j < 8; ++j) if (el[j] > v0) { v0 = el[j]; i0 = j; }
            int i1 = -1; float v1 = -INFINITY;
#pragma unroll
            for (int j = 0; j < 8; ++j) if (j != i0 && el[j] > v1) { v1 = el[j]; i1 = j; }
            const float e1 = __expf(v1 - v0); const float w0 = pg / (1.f + e1), w1 = pg * e1 / (1.f + e1);
            const int ea = grp * 8 + i0, eb = grp * 8 + i1;
            sel[r * 2] = ea; sel[r * 2 + 1] = eb; selw[r * 2] = w0; selw[r * 2 + 1] = w1;
            lpos[r * 2] = atomicAdd(&hist[ea], 1); lpos[r * 2 + 1] = atomicAdd(&hist[eb], 1);
        }
        __syncthreads();
        if (tid < 32) hbase[tid] = hist[tid] > 0 ? (int)atomicAdd(&cnt[(tid) * CNT_STRIDE], (unsigned)hist[tid]) : 0;
        __syncthreads();
        if (tid < 64) { const int e = sel[tid], pos = hbase[e] + lpos[tid]; const int tok = row0 + (tid >> 1);
            TOK[(size_t)e * T + pos] = tok; GATE[(size_t)e * T + pos] = selw[tid]; ASG[tok * 2 + (tid & 1)] = (e << 16) | pos; }
        __syncthreads();
    }
}

template <int ALT> __device__ __forceinline__ void p5_router2(const Args& A, float* ldsf) {
    const float* X1 = A.out; const float* g2 = A.in[14]; const float* wrg = A.in[15]; const float* brg = A.in[16]; const float* wre = A.in[17]; const float* bre = A.in[18];
    bf16_t* H2 = (bf16_t*)(A.ws + WS_H2); unsigned* cnt = (unsigned*)(A.ws + WS_CTL) + CW_CNT + (ALT ? 2048 : 0);
    int* TOK = (int*)(A.ws + (ALT ? WS_H : WS_TOK)); float* GATE = (float*)(A.ws + (ALT ? WS_H + 2 * MiB : WS_GATE)); int* ASG = (int*)(A.ws + (ALT ? WS_H + 4 * MiB : WS_ASG));
    const int tid = threadIdx.x, lane = tid & 63, wave = tid >> 6;
    constexpr int XP = 260, XB = 32 * XP, WP = 40, WB = 256 * WP;
    float* Xs = ldsf;
    float* Ws = ldsf + 2 * XB;
    float* misc = ldsf + 2 * XB + 2 * WB;
    float* rs = misc;
    float* lg = misc + 32;
    int* hist = (int*)(misc + 32 + 1280); int* hbase = hist + 32; int* sel = hbase + 32; int* lpos = sel + 64; float* selw = (float*)(lpos + 64);
    const int kh2 = lane >> 5, rp = (lane >> 1) & 15, cg = lane & 1;
    for (int rb = blockIdx.x; rb < T / 32; rb += gridDim.x) {
        const int row0 = rb * 32;
        float ssq[4] = {0.f, 0.f, 0.f, 0.f};
        float acc0[20], acc1[20];
#pragma unroll
        for (int j = 0; j < 20; ++j) { acc0[j] = 0.f; acc1[j] = 0.f; }
        if (tid < 32) hist[tid] = 0;
        f32x4 xr[4], wv[5], gv;
        for (int i = tid; i < 2 * 256; i += NTHREADS) *(f32x4*)(Ws + (i >> 8) * WB + (i & 255) * WP + 36) = (f32x4){0.f, 0.f, 0.f, 0.f};
#define R2_LOAD(k0) do { gv = *(const f32x4*)(g2 + (k0) + 4 * (tid & 63)); \
        _Pragma("unroll") for (int i = 0; i < 4; ++i) xr[i] = *(const f32x4*)(X1 + (size_t)(row0 + wave + 8 * i) * DM + (k0) + 4 * (tid & 63)); \
        _Pragma("unroll") for (int i = 0; i < 5; ++i) { const int idx = tid + i * 512; if (idx < 2304) { const int kk = idx / 9, j4 = idx - kk * 9; \
            wv[i] = j4 == 0 ? *(const f32x4*)(wrg + (size_t)((k0) + kk) * 4) : *(const f32x4*)(wre + (size_t)((k0) + kk) * 32 + 4 * (j4 - 1)); } } } while (0)
#define R2_STORE(buf) do { \
        _Pragma("unroll") for (int i = 0; i < 4; ++i) { ssq[i] += xr[i].x * xr[i].x + xr[i].y * xr[i].y + xr[i].z * xr[i].z + xr[i].w * xr[i].w; \
            *(f32x4*)(Xs + (buf) * XB + (wave + 8 * i) * XP + 4 * (tid & 63)) = xr[i] * gv; } \
        _Pragma("unroll") for (int i = 0; i < 5; ++i) { const int idx = tid + i * 512; if (idx < 2304) { const int kk = idx / 9, j4 = idx - kk * 9; *(f32x4*)(Ws + (buf) * WB + kk * WP + 4 * j4) = wv[i]; } } } while (0)
        R2_LOAD(0); R2_STORE(0);
        __syncthreads();
#pragma unroll 1
        for (int c = 0; c < 8; ++c) {
            const int buf = c & 1;
            if (c < 7) R2_LOAD((c + 1) * 256);
            const float* xa = Xs + buf * XB + (2 * rp) * XP + (wave * 2 + kh2) * 16; const float* wa = Ws + buf * WB + ((wave * 2 + kh2) * 16) * WP + 20 * cg;
#pragma unroll 1
            for (int k4 = 0; k4 < 4; ++k4) {
                const f32x4 x0 = *(const f32x4*)(xa + 4 * k4), x1 = *(const f32x4*)(xa + XP + 4 * k4);
#pragma unroll
                for (int kk = 0; kk < 4; ++kk) { const float* wr = wa + (4 * k4 + kk) * WP;
#pragma unroll
                    for (int j4 = 0; j4 < 5; ++j4) { const f32x4 w = *(const f32x4*)(wr + 4 * j4);
#pragma unroll
                        for (int e = 0; e < 4; ++e) { acc0[4 * j4 + e] = fmaf(x0[kk], w[e], acc0[4 * j4 + e]); acc1[4 * j4 + e] = fmaf(x1[kk], w[e], acc1[4 * j4 + e]); } }
                    asm volatile("" ::: "memory"); }
            }
            if (c < 7) R2_STORE(buf ^ 1);
            __syncthreads();
        }
#undef R2_LOAD
#undef R2_STORE
#pragma unroll
        for (int j = 0; j < 20; ++j) { acc0[j] += __shfl_xor(acc0[j], 32); acc1[j] += __shfl_xor(acc1[j], 32); }
        float* red = Xs;
        if (kh2 == 0) {
#pragma unroll
            for (int j = 0; j < 20; ++j) { red[(wave * 32 + 2 * rp) * 40 + 20 * cg + j] = acc0[j]; red[(wave * 32 + 2 * rp + 1) * 40 + 20 * cg + j] = acc1[j]; } }
#pragma unroll
        for (int i = 0; i < 4; ++i) { const float s = wave_sum(ssq[i]); if (lane == 0) rs[wave + 8 * i] = rsqrtf(s * (1.f / DM) + EPS); }
        __syncthreads();
        for (int i = tid; i < 32 * 40; i += NTHREADS) { float s = 0.f;
#pragma unroll
            for (int w = 0; w < 8; ++w) s += red[w * 1280 + i];
            lg[i] = s * rs[i / 40]; }
        __syncthreads();
#pragma unroll 1
        for (int i = 0; i < 4; ++i) { const int rr = wave + 8 * i; const float rstd = rs[rr]; const float* xp = X1 + (size_t)(row0 + rr) * DM; bf16_t* hp = H2 + (size_t)(row0 + rr) * DM;
#pragma unroll 2
            for (int j = 0; j < 8; ++j) { const int c0 = 256 * j + 4 * lane; const f32x4 v = *(const f32x4*)(xp + c0), g = *(const f32x4*)(g2 + c0);
                u32x2 o; o.x = pk2(v.x * rstd * g.x, v.y * rstd * g.y); o.y = pk2(v.z * rstd * g.z, v.w * rstd * g.w); *(u32x2*)(hp + c0) = o; } }
        if (tid < 32) {
            const int r = tid; const float* L = lg + r * 40;
            float gl[4]; int grp = 0;
#pragma unroll
            for (int j = 0; j < 4; ++j) gl[j] = L[j] + brg[j];
            float gm = gl[0];
#pragma unroll
            for (int j = 1; j < 4; ++j) if (gl[j] > gm) { gm = gl[j]; grp = j; }
            float den = 0.f;
#pragma unroll
            for (int j = 0; j < 4; ++j) den += __expf(gl[j] - gm);
            const float pg = 1.f / den;
            float el[8];
#pragma unroll
            for (int j = 0; j < 8; ++j) el[j] = L[4 + grp * 8 + j] + bre[grp * 8 + j];
            int i0 = 0; float v0 = el[0];
#pragma unroll
            for (int j = 1; j < 8; ++j) if (el[j] > v0) { v0 = el[j]; i0 = j; }
            int i1 = -1; float v1 = -INFINITY;
#pragma unroll
            for (int j = 0; j < 8; ++j) if (j != i0 && el[j] > v1) { v1 = el[j]; i1 = j; }
            const float e1 = __expf(v1 - v0); const float w0 = pg / (1.f + e1), w1 = pg * e1 / (1.f + e1);
            const int ea = grp * 8 + i0, eb = grp * 8 + i1;
            sel[r * 2] = ea; sel[r * 2 + 1] = eb; selw[r * 2] = w0; selw[r * 2 + 1] = w1;
            lpos[r * 2] = atomicAdd(&hist[ea], 1); lpos[r * 2 + 1] = atomicAdd(&hist[eb], 1);
        }
        __syncthreads();
        if (tid < 32) hbase[tid] = hist[tid] > 0 ? (int)atomicAdd(&cnt[(tid) * CNT_STRIDE], (unsigned)hist[tid]) : 0;
        __syncthreads();
        if (tid < 64) { const int e = sel[tid], pos = hbase[e] + lpos[tid]; const int tok = row0 + (tid >> 1);
            TOK[(size_t)e * T + pos] = tok; GATE[(size_t)e * T + pos] = selw[tid]; ASG[tok * 2 + (tid & 1)] = (e << 16) | pos; }
        __syncthreads();
    }
}

constexpr size_t WS_WR = 7 * MiB;
__device__ __forceinline__ void p0_router_weights(const Args& A) {
    const float* g2 = A.in[14]; const float* wrg = A.in[15]; const float* wre = A.in[17]; bf16_t* WR = (bf16_t*)(A.ws + WS_WR);
    for (int i = blockIdx.x * NTHREADS + threadIdx.x; i < 64 * DM; i += gridDim.x * NTHREADS) { const int n = i >> 11, k = i & (DM - 1);
        const float w = n < 4 ? wrg[(size_t)k * 4 + n] * g2[k] : (n < 36 ? wre[(size_t)k * 32 + n - 4] * g2[k] : 0.f);
        const bf16_t h = f2bf(w); WR[i] = h; WR[64 * DM + i] = f2bf(w - bf2f(h)); }
}
constexpr size_t WS_RSTL = WS_CKL;
template <int ALT> __device__ __forceinline__ void p5_router3(const Args& A, float* ldsf) {
    float* RSTL = (float*)(A.ws + (ALT ? WS_H + 6 * MiB : WS_RSTL));
    typedef short bf16x8 __attribute__((ext_vector_type(8))); typedef float f32x16 __attribute__((ext_vector_type(16)));
    const float* X1 = A.out; const float* g2 = A.in[14]; const float* brg = A.in[16]; const float* bre = A.in[18]; const bf16_t* WR = (const bf16_t*)(A.ws + WS_WR);
    bf16_t* H2 = (bf16_t*)(A.ws + WS_H2); unsigned* cnt = (unsigned*)(A.ws + WS_CTL) + CW_CNT + (ALT ? 2048 : 0);
    int* TOK = (int*)(A.ws + (ALT ? WS_H : WS_TOK)); float* GATE = (float*)(A.ws + (ALT ? WS_H + 2 * MiB : WS_GATE)); int* ASG = (int*)(A.ws + (ALT ? WS_H + 4 * MiB : WS_ASG));
    const int tid = threadIdx.x, lane = tid & 63, wave = tid >> 6, r32 = lane & 31, hi = lane >> 5;
    float* red = ldsf;
    float* lg = ldsf + 16384;
    float* sq = lg + 2048;
    float* rs = sq + 256;
    int* hist = (int*)(rs + 32); int* hbase = hist + 32; int* sel = hbase + 32; int* lpos = sel + 64; float* selw = (float*)(lpos + 64);
    for (int rb = blockIdx.x; rb < T / 32; rb += gridDim.x) {
        const int row0 = rb * 32;
        if (tid < 32) hist[tid] = 0;
        const float* xp = X1 + (size_t)(row0 + r32) * DM + 256 * wave + 8 * hi;
        const bf16_t* wp = WR + (size_t)r32 * DM + 256 * wave + 8 * hi;
        f32x16 acc[2];
#pragma unroll
        for (int j = 0; j < 2; ++j)
#pragma unroll
            for (int r = 0; r < 16; ++r) acc[j][r] = 0.f;
        float ssq = 0.f;
        f32x4 xa[4], xb[4], xna[4], xnb[4];
#pragma unroll
        for (int i = 0; i < 4; ++i) { xa[i] = *(const f32x4*)(xp + 16 * i); xb[i] = *(const f32x4*)(xp + 16 * i + 4); }
#pragma unroll 1
        for (int kb = 0; kb < (ALT == 3 ? 0 : 4); ++kb) {
            bf16x8 wh0[4], wh1[4], wl0[4], wl1[4]; f32x4 ga[4], gb[4];
#pragma unroll
            for (int i = 0; i < 4; ++i) { const int ko = 64 * kb + 16 * i;
                wh0[i] = *(const bf16x8*)(wp + ko); wh1[i] = *(const bf16x8*)(wp + (size_t)32 * DM + ko); wl0[i] = *(const bf16x8*)(wp + (size_t)64 * DM + ko); wl1[i] = *(const bf16x8*)(wp + (size_t)96 * DM + ko);
                ga[i] = *(const f32x4*)(g2 + 256 * wave + 8 * hi + ko); gb[i] = *(const f32x4*)(g2 + 256 * wave + 8 * hi + ko + 4); }
            asm volatile("" ::: "memory");
            if (kb < 3) {
#pragma unroll
                for (int i = 0; i < 4; ++i) { xna[i] = *(const f32x4*)(xp + 64 * (kb + 1) + 16 * i); xnb[i] = *(const f32x4*)(xp + 64 * (kb + 1) + 16 * i + 4); } }
            asm volatile("" ::: "memory");
#pragma unroll
            for (int i = 0; i < 4; ++i) { const int ko = 64 * kb + 16 * i;
                { u32x4 hw; hw.x = cvtpk_rne(xa[i][0] * ga[i][0], xa[i][1] * ga[i][1]); hw.y = cvtpk_rne(xa[i][2] * ga[i][2], xa[i][3] * ga[i][3]); hw.z = cvtpk_rne(xb[i][0] * gb[i][0], xb[i][1] * gb[i][1]); hw.w = cvtpk_rne(xb[i][2] * gb[i][2], xb[i][3] * gb[i][3]);
                  *(u32x4*)(H2 + (size_t)(row0 + r32) * DM + 256 * wave + 8 * hi + ko) = hw; }
                float xv[8] = {xa[i][0], xa[i][1], xa[i][2], xa[i][3], xb[i][0], xb[i][1], xb[i][2], xb[i][3]}; u32x4 ph, pl;
#pragma unroll
                for (int e = 0; e < 4; ++e) { const float a = xv[2 * e], b2 = xv[2 * e + 1]; ssq += a * a + b2 * b2; const unsigned hh = cvtpk_rne(a, b2); ph[e] = hh;
                    pl[e] = cvtpk_rne(a - __uint_as_float(hh << 16), b2 - __uint_as_float(hh & 0xffff0000u)); }
                const bf16x8 xh = __builtin_bit_cast(bf16x8, ph), xl = __builtin_bit_cast(bf16x8, pl);
                acc[0] = __builtin_amdgcn_mfma_f32_32x32x16_bf16(xh, wh0[i], acc[0], 0, 0, 0); acc[0] = __builtin_amdgcn_mfma_f32_32x32x16_bf16(xl, wh0[i], acc[0], 0, 0, 0); acc[0] = __builtin_amdgcn_mfma_f32_32x32x16_bf16(xh, wl0[i], acc[0], 0, 0, 0);
                acc[1] = __builtin_amdgcn_mfma_f32_32x32x16_bf16(xh, wh1[i], acc[1], 0, 0, 0); acc[1] = __builtin_amdgcn_mfma_f32_32x32x16_bf16(xl, wh1[i], acc[1], 0, 0, 0); acc[1] = __builtin_amdgcn_mfma_f32_32x32x16_bf16(xh, wl1[i], acc[1], 0, 0, 0); }
#pragma unroll
            for (int i = 0; i < 4; ++i) { xa[i] = xna[i]; xb[i] = xnb[i]; }
        }
#pragma unroll
        for (int j = 0; j < 2; ++j)
#pragma unroll
            for (int r = 0; r < 16; ++r) red[((wave * 2 + j) * 16 + r) * 64 + lane] = acc[j][r];
        ssq += __shfl_xor(ssq, 32);
        if (hi == 0) sq[wave * 32 + r32] = ssq;
        __syncthreads();
        if (ALT == 2) continue;
#pragma unroll
        for (int j = 0; j < 2; ++j)
#pragma unroll
            for (int rr = 0; rr < 2; ++rr) { const int r = 2 * wave + rr; float s = 0.f;
#pragma unroll
                for (int w2 = 0; w2 < 8; ++w2) s += red[((w2 * 2 + j) * 16 + r) * 64 + lane];
                lg[((r & 3) + 8 * (r >> 2) + 4 * hi) * 64 + 32 * j + r32] = s; }
        if (tid < 32) { float s = 0.f;
#pragma unroll
            for (int w2 = 0; w2 < 8; ++w2) s += sq[w2 * 32 + tid];
            rs[tid] = rsqrtf(s * (1.f / DM) + EPS); }
        __syncthreads();
        if (tid < 32) {
            const int r = tid; const float* L = lg + r * 64; const float rstd = rs[r];
            float gl[4]; int grp = 0;
#pragma unroll
            for (int j = 0; j < 4; ++j) gl[j] = L[j] * rstd + brg[j];
            float gm = gl[0];
#pragma unroll
            for (int j = 1; j < 4; ++j) if (gl[j] > gm) { gm = gl[j]; grp = j; }
            float den = 0.f;
#pragma unroll
            for (int j = 0; j < 4; ++j) den += __expf(gl[j] - gm);
            const float pg = 1.f / den;
            float el[8];
#pragma unroll
            for (int j = 0; j < 8; ++j) el[j] = L[4 + grp * 8 + j] * rstd + bre[grp * 8 + j];
            int i0 = 0; float v0 = el[0];
#pragma unroll
            for (int j = 1; j < 8; ++j) if (el[j] > v0) { v0 = el[j]; i0 = j; }
            int i1 = -1; float v1 = -INFINITY;
#pragma unroll
            for (int j = 0; j < 8; ++j) if (j != i0 && el[j] > v1) { v1 = el[j]; i1 = j; }
            const float e1 = __expf(v1 - v0); const float w0 = pg / (1.f + e1), w1 = pg * e1 / (1.f + e1);
            const int ea = grp * 8 + i0, eb = grp * 8 + i1;
            sel[r * 2] = ea; sel[r * 2 + 1] = eb; selw[r * 2] = w0; selw[r * 2 + 1] = w1;
            lpos[r * 2] = atomicAdd(&hist[ea], 1); lpos[r * 2 + 1] = atomicAdd(&hist[eb], 1);
        }
        __syncthreads();
        if (tid < 32) hbase[tid] = hist[tid] > 0 ? (int)atomicAdd(&cnt[(tid) * CNT_STRIDE], (unsigned)hist[tid]) : 0;
        __syncthreads();
        if (tid < 64) { const int e = sel[tid], pos = hbase[e] + lpos[tid]; const int tok = row0 + (tid >> 1);
            TOK[(size_t)e * T + pos] = tok; GATE[(size_t)e * T + pos] = selw[tid]; RSTL[(size_t)e * T + pos] = rs[tid >> 1]; ASG[tok * 2 + (tid & 1)] = (e << 16) | pos; }
        __syncthreads();
    }
}

__device__ __forceinline__ void expert_layout(const unsigned* cnt, int* pstart  ) {
    int acc = 0;
    for (int e = 0; e < NEXP; ++e) { pstart[e] = acc; acc += ((int)cnt[(e) * CNT_STRIDE] + MTILE - 1) / MTILE * MTILE; }
    pstart[NEXP] = acc;
}

__device__ __forceinline__ void p6_naive(const Args& A, float* ldsf) {
    const bf16_t* H2 = (const bf16_t*)(A.ws + WS_H2); const float* wg = A.in[19]; const float* wu = A.in[20]; bf16_t* ACT = (bf16_t*)(A.ws + WS_ACT);
    const unsigned* cnt = (const unsigned*)(A.ws + WS_CTL) + CW_CNT; const int* TOK = (const int*)(A.ws + WS_TOK);
    int* ps = (int*)(ldsf + 2 * 16 * 132);
    if (threadIdx.x == 0) expert_layout(cnt, ps);
    __syncthreads();
    int ntot = 0;
    for (int e = 0; e < NEXP; ++e) ntot += (((int)cnt[(e) * CNT_STRIDE] + 127) / 128) * 4;
    for (int t = blockIdx.x; t < ntot; t += gridDim.x) {
        int e = 0, rem = t;
        for (; e < NEXP; ++e) { const int n = (((int)cnt[(e) * CNT_STRIDE] + 127) / 128) * 4; if (rem < n) break; rem -= n; }
        const int c = (int)cnt[(e) * CNT_STRIDE]; const int tm = rem / 4, tn = rem % 4; const int* tl = TOK + (size_t)e * T; const int prow = ps[e];
        const float* wge = wg + (size_t)e * DM * DEXP; const float* wue = wu + (size_t)e * DM * DEXP;
        naive_gemm_tile(ldsf, tm * 128, tn * 128, c, DEXP, 2 * DM, DM,
            [=](int m, int k) { return bf2f(H2[(size_t)tl[m] * DM + (k & (DM - 1))]); },
            [=](int k, int n) { return k < DM ? wge[(size_t)k * DEXP + n] : wue[(size_t)(k - DM) * DEXP + n]; },
            [=](int m, int n, float sg, float su) { ACT[(size_t)(prow + m) * DEXP + n] = f2bf(sg / (1.f + __expf(-sg)) * su); });
    }
}
__device__ __forceinline__ void p7_naive(const Args& A, float* ldsf) {
    const bf16_t* ACT = (const bf16_t*)(A.ws + WS_ACT); const float* wd = A.in[21]; bf16_t* YBUF = (bf16_t*)(A.ws + WS_YBUF);
    const unsigned* cnt = (const unsigned*)(A.ws + WS_CTL) + CW_CNT; const float* GATE = (const float*)(A.ws + WS_GATE);
    int* ps = (int*)(ldsf + 2 * 16 * 132);
    if (threadIdx.x == 0) expert_layout(cnt, ps);
    __syncthreads();
    int ntot = 0;
    for (int e = 0; e < NEXP; ++e) ntot += (((int)cnt[(e) * CNT_STRIDE] + 127) / 128) * 16;
    for (int t = blockIdx.x; t < ntot; t += gridDim.x) {
        int e = 0, rem = t;
        for (; e < NEXP; ++e) { const int n = (((int)cnt[(e) * CNT_STRIDE] + 127) / 128) * 16; if (rem < n) break; rem -= n; }
        const int c = (int)cnt[(e) * CNT_STRIDE]; const int tm = rem / 16, tn = rem % 16; const float* gl = GATE + (size_t)e * T; const int prow = ps[e];
        const float* wde = wd + (size_t)e * DEXP * DM;
        naive_gemm_tile(ldsf, tm * 128, tn * 128, c, DM, DEXP, DEXP,
            [=](int m, int k) { return bf2f(ACT[(size_t)(prow + m) * DEXP + k]); },
            [=](int k, int n) { return wde[(size_t)k * DM + n]; },
            [=](int m, int n, float s, float) { YBUF[(size_t)(prow + m) * DM + n] = f2bf(s * gl[m]); });
    }
}

template <int ALT> __device__ __forceinline__ void p8_combine(const Args& A, float* ldsf, const float dlt = 0.f) {
    float* X1 = A.out; float* XO = ALT ? (float*)(A.ws + WS_WGU) : A.out; const bf16_t* YBUF = (const bf16_t*)(A.ws + WS_YBUF); const int* ASG = (const int*)(A.ws + WS_ASG);
    const unsigned* cnt = (const unsigned*)(A.ws + WS_CTL) + CW_CNT;
    int* ps = (int*)ldsf;
    if (threadIdx.x == 0) expert_layout(cnt, ps);
    __syncthreads();
    float dl2 = dlt;
    if (STAMP_PHASE == 97) { int v = 0, mx = 0, mn = 1 << 30, nt_ = 0, tiny = 0, half = 0; for (int e = 0; e < NEXP; ++e) { const int c = (int)cnt[(e) * CNT_STRIDE]; mx = c > mx ? c : mx; mn = c < mn ? c : mn; nt_ += (c + 255) / 256; const int rem = c % 256; tiny += (rem > 0 && rem <= 64) ? 1 : 0; half += (rem > 0 && rem <= 128) ? 1 : 0; }
        v = STAMP_SEL == 0 ? nt_ : STAMP_SEL == 1 ? mx : STAMP_SEL == 2 ? mn : STAMP_SEL == 3 ? tiny : half; dl2 = 0.01f * (float)v; }
    const int tid = threadIdx.x, lane = tid & 63, wave = tid >> 6;
    const int gw = blockIdx.x * NWAVES + wave, NGW = gridDim.x * NWAVES;
    for (int row = gw; row < T; row += NGW) {
        const int a0 = ASG[row * 2], a1 = ASG[row * 2 + 1];
        const bf16_t* y0 = YBUF + (size_t)(ps[a0 >> 16] + (a0 & 0xffff)) * DM; const bf16_t* y1 = YBUF + (size_t)(ps[a1 >> 16] + (a1 & 0xffff)) * DM;
        const float* xr = X1 + (size_t)row * DM; float* xo = XO + (size_t)row * DM;
        u32x4 w0[4], w1[4]; f32x4 xa[4], xb[4];
#pragma unroll
        for (int j = 0; j < 4; ++j) { const int c0 = 512 * j + 8 * lane; w0[j] = *(const u32x4*)(y0 + c0); w1[j] = *(const u32x4*)(y1 + c0); xa[j] = *(const f32x4*)(xr + c0); xb[j] = *(const f32x4*)(xr + c0 + 4); }
#pragma unroll
        for (int j = 0; j < 4; ++j) { const int c0 = 512 * j + 8 * lane; f32x4 a = xa[j], b2 = xb[j];
            a.x += __uint_as_float(w0[j][0] << 16) + __uint_as_float(w1[j][0] << 16); a.y += __uint_as_float(w0[j][0] & 0xffff0000u) + __uint_as_float(w1[j][0] & 0xffff0000u);
            a.z += __uint_as_float(w0[j][1] << 16) + __uint_as_float(w1[j][1] << 16); a.w += __uint_as_float(w0[j][1] & 0xffff0000u) + __uint_as_float(w1[j][1] & 0xffff0000u);
            b2.x += __uint_as_float(w0[j][2] << 16) + __uint_as_float(w1[j][2] << 16); b2.y += __uint_as_float(w0[j][2] & 0xffff0000u) + __uint_as_float(w1[j][2] & 0xffff0000u);
            b2.z += __uint_as_float(w0[j][3] << 16) + __uint_as_float(w1[j][3] << 16); b2.w += __uint_as_float(w0[j][3] & 0xffff0000u) + __uint_as_float(w1[j][3] & 0xffff0000u);
            if (STAMP_PHASE >= 0) { a += dl2; b2 += dl2; }
            *(f32x4*)(xo + c0) = a; *(f32x4*)(xo + c0 + 4) = b2; }
    }
}

namespace pg8 {
#define PG8_LAS __attribute__((address_space(3)))
typedef short bf16x8 __attribute__((ext_vector_type(8)));
constexpr int BM = 256, BK = 64, HALF = 128, HTB = HALF * BK * 2, STAGE_BYTES = 8 * HTB, NXCD = 8, WGM = 8;
__host__ __device__ __forceinline__ int lds_byte(int r, int c) { const int st = (r >> 4) * 2 + (c >> 5), rr = r & 15, cc = c & 31, ob = rr * 64 + cc * 2; return st * 1024 + (ob ^ (((ob >> 9) & 1) << 5)); }
__host__ __device__ __forceinline__ void stage_rc(int b, int& R, int& C) { const int st = b / 1024, sb = b % 1024, swz = sb ^ (((sb >> 9) & 1) << 5); R = (st >> 1) * 16 + swz / 64; C = (st & 1) * 32 + (swz % 64) / 2; }
__host__ __device__ __forceinline__ int perm32(int rho) { const int n = rho >> 4, i = rho & 15; return 8 * (i >> 2) + 4 * n + (i & 3); }

struct Unit { const char* A; const char* B; int pm, pn, x0, x1, x2, x3; };

struct DenseOrder {
    const char* A; const char* Bt; int K, nM, nN, nwg, G, c, rep;
    __device__ void init(const void* A_, const void* Bt_, int M, int N, int K_, int G_, int c_, int rep_ = 1) { A = (const char*)A_; Bt = (const char*)Bt_; K = K_; nM = M / BM; nN = N / BM; nwg = nM * nN; G = G_; c = c_; rep = rep_; }
    __device__ bool next(int i, Unit& u) const {
        const long L = (long)i * G + c; if (L >= (long)nwg * rep) return false;
        int wgid = (int)(L % nwg); { const int q = nwg / NXCD, r = nwg % NXCD, xcd = wgid % NXCD, off = wgid / NXCD; wgid = (xcd < r ? xcd * (q + 1) : r * (q + 1) + (xcd - r) * q) + off; }
        const int nig = WGM * nN, gid = wgid / nig, fm = gid * WGM, gsz = (nM - fm) < WGM ? (nM - fm) : WGM;
        u.pm = fm + ((wgid % nig) % gsz); u.pn = (wgid % nig) / gsz; u.x0 = 0; u.x1 = 0; u.x2 = 0; u.x3 = 0;
        u.A = A + (size_t)u.pm * BM * K * 2; u.B = Bt + (size_t)u.pn * BM * K * 2; return true;
    }
    __device__ __forceinline__ void rows(const Unit&, unsigned (&)[2][2], const int (&)[2]) const {}
};

__device__ __forceinline__ unsigned cvt_pk_bf16(float lo, float hi) { unsigned r; asm volatile("v_cvt_pk_bf16_f32 %0, %1, %2" : "=v"(r) : "v"(lo), "v"(hi)); return r; }

template <class Epi, class Sched, bool ALIGN_EPI, bool GATHER, bool SKIP = false>
__device__ __forceinline__ void gemm_phase(PG8_LAS unsigned char* lds, const int K, const Sched& S, const Epi& E) {
    const int tid = threadIdx.x, wid = __builtin_amdgcn_readfirstlane(tid >> 6), lane = tid & 63, wr = wid >> 2, wc = wid & 3, fr = lane & 15, fq = lane >> 4;
    const int nt = K / BK;
    unsigned voffA[2], voffB[2]; int RA[2];
#pragma unroll
    for (int i = 0; i < 2; ++i) { int R, C; stage_rc(tid * 16 + i * 8192, R, C); const int Rb = Epi::PERM ? ((R & ~31) + perm32(R & 31)) : R;
        voffA[i] = GATHER ? (unsigned)(C * 2) : (unsigned)(R * K + C) * 2u; voffB[i] = (unsigned)(Rb * K + C) * 2u; RA[i] = R; }
    const size_t kstep = (size_t)(BK * 2);
    const size_t hstep = (size_t)HALF * K * 2;
    const size_t hstepA = GATHER ? 0 : hstep;
    const unsigned ldsw = (unsigned)wid * 1024u;
    const int aoff = lds_byte(wr * 64 + fr, fq * 8), boff = lds_byte(wc * 32 + fr, fq * 8);
    unsigned gA[2][2], gAn[2][2];
#define PG8_SA(b, h) (((b) * 2 + (h)) * HTB)
#define PG8_SB(b, h) ((4 + (b) * 2 + (h)) * HTB)
#define PG8_STAGE(bufoff, gbase, voff) do { _Pragma("unroll") for (int _i = 0; _i < 2; ++_i) \
        __builtin_amdgcn_global_load_lds((const unsigned*)((const char*)(gbase) + (voff)[_i]), (PG8_LAS unsigned*)(lds + (bufoff) + ldsw + _i * 8192), 16, 0, 0); } while (0)
#define PG8_STAGE_A(bufoff, gbase, h, nx) do { _Pragma("unroll") for (int _i = 0; _i < 2; ++_i) { \
        const unsigned _o = GATHER ? ((nx) ? gAn[h][_i] : gA[h][_i]) + voffA[_i] : voffA[_i]; \
        __builtin_amdgcn_global_load_lds((const unsigned*)((const char*)(gbase) + (h) * hstepA + _o), (PG8_LAS unsigned*)(lds + (bufoff) + ldsw + _i * 8192), 16, 0, 0); } } while (0)
#define PG8_LDA(dst, b, h) do { _Pragma("unroll") for (int m = 0; m < 4; ++m) _Pragma("unroll") for (int k = 0; k < 2; ++k) dst[m][k] = *(const PG8_LAS bf16x8*)(lds + PG8_SA(b, h) + aoff + m * 2048 + k * 1024); } while (0)
#define PG8_LDB(dst, b, h) do { _Pragma("unroll") for (int n = 0; n < 2; ++n) _Pragma("unroll") for (int k = 0; k < 2; ++k) dst[n][k] = *(const PG8_LAS bf16x8*)(lds + PG8_SB(b, h) + boff + n * 2048 + k * 1024); } while (0)
#define PG8_MMA(ai, bj, At, Bt) do { __builtin_amdgcn_s_setprio(1); _Pragma("unroll") for (int m = 0; m < 4; ++m) { if (!SKIP || m < ((ai) == 0 ? mc0 : mc1)) { _Pragma("unroll") for (int n = 0; n < 2; ++n) _Pragma("unroll") for (int k = 0; k < 2; ++k) \
        acc[ai][bj][m][n] = __builtin_amdgcn_mfma_f32_16x16x32_bf16(Bt[n][k], At[m][k], acc[ai][bj][m][n], 0, 0, 0); } } __builtin_amdgcn_s_setprio(0); } while (0)
#define PG8_WAIT_V(n) asm volatile("s_waitcnt vmcnt(" #n ")" ::: "memory")
#define PG8_WAIT_L(n) asm volatile("s_waitcnt lgkmcnt(" #n ")" ::: "memory")
#define PG8_BAR __builtin_amdgcn_s_barrier()
#define PG8_SCHED __builtin_amdgcn_sched_barrier(0)
    Unit cur, nxt; int ui = 0;
    if (!S.next(0, cur)) return;
    int mc0 = 4, mc1 = 4;
#define PG8_MC(u) do { if (SKIP) { const int a_ = ((u).x2 - 64 * wr + 15) >> 4, b_ = ((u).x2 - 128 - 64 * wr + 15) >> 4; mc0 = a_ < 0 ? 0 : (a_ > 4 ? 4 : a_); mc1 = b_ < 0 ? 0 : (b_ > 4 ? 4 : b_); } } while (0)
    PG8_MC(cur);
    f32x4 acc[2][2][4][2];
#pragma unroll
    for (int a = 0; a < 2; ++a)
#pragma unroll
        for (int b = 0; b < 2; ++b)
#pragma unroll
            for (int m = 0; m < 4; ++m)
#pragma unroll
                for (int n = 0; n < 2; ++n) acc[a][b][m][n] = (f32x4){0.f, 0.f, 0.f, 0.f};
    bf16x8 At[4][2], B0[2][2], B1[2][2];
    const char* cA = cur.A; const char* cB = cur.B;
    if constexpr (GATHER) { S.rows(cur, gA, RA);
#pragma unroll
        for (int h = 0; h < 2; ++h)
#pragma unroll
            for (int i = 0; i < 2; ++i) gAn[h][i] = gA[h][i]; }
    PG8_STAGE(PG8_SB(0, 0), cB, voffB); PG8_STAGE(PG8_SB(0, 1), cB + hstep, voffB); PG8_STAGE_A(PG8_SA(0, 0), cA, 0, false); PG8_STAGE_A(PG8_SA(0, 1), cA, 1, false);
    if (wr == 1) PG8_BAR;
    PG8_WAIT_V(2); PG8_BAR;
    PG8_STAGE(PG8_SB(1, 0), cB + kstep, voffB); PG8_STAGE_A(PG8_SA(1, 0), cA + kstep, 0, false); PG8_STAGE(PG8_SB(1, 1), cB + hstep + kstep, voffB);
    PG8_WAIT_V(6); PG8_BAR;
    for (;;) {
        const bool has_next = S.next(ui + 1, nxt);
        const char* nA = has_next ? nxt.A : cA; const char* nB = has_next ? nxt.B : cB;
        if constexpr (GATHER) { if (has_next) { S.rows(nxt, gAn, RA); } }
        for (int t = 0; t < nt; t += 2) {
            const bool last = (t == nt - 2);
            const char* a1 = cA + (size_t)(t + 1) * kstep;
            const char* a2 = last ? nA : cA + (size_t)(t + 2) * kstep; const char* b2 = last ? nB : cB + (size_t)(t + 2) * kstep;
            const char* a3 = a2 + kstep; const char* b3 = b2 + kstep;
            if constexpr (Epi::HAS_MID) { if (t == nt / 2) { int frl = fr, fql = fq; asm volatile("" : "+v"(frl), "+v"(fql)); E.mid(acc, cur, wr, wc, frl, fql); } }
            PG8_LDB(B0, 0, 0); PG8_LDB(B1, 0, 1); PG8_SCHED; PG8_LDA(At, 0, 0); PG8_STAGE_A(PG8_SA(1, 1), a1, 1, false);
            PG8_WAIT_V(8); PG8_WAIT_L(0); PG8_BAR; PG8_MMA(0, 0, At, B0); PG8_MMA(0, 1, At, B1); PG8_BAR; PG8_SCHED;
            PG8_LDA(At, 0, 1); PG8_STAGE(PG8_SB(0, 0), b2, voffB); PG8_STAGE(PG8_SB(0, 1), b2 + hstep, voffB); PG8_STAGE_A(PG8_SA(0, 0), a2, 0, last);
            PG8_WAIT_V(8); PG8_WAIT_L(0); PG8_BAR; PG8_MMA(1, 0, At, B0); PG8_MMA(1, 1, At, B1); PG8_BAR; PG8_SCHED;
            PG8_LDB(B0, 1, 0); PG8_LDB(B1, 1, 1); PG8_SCHED; PG8_LDA(At, 1, 0); PG8_STAGE_A(PG8_SA(0, 1), a2, 1, last);
            PG8_WAIT_V(8); PG8_WAIT_L(0); PG8_BAR; PG8_MMA(0, 0, At, B0); PG8_MMA(0, 1, At, B1); PG8_BAR; PG8_SCHED;
            PG8_LDA(At, 1, 1); PG8_STAGE(PG8_SB(1, 0), b3, voffB); PG8_STAGE(PG8_SB(1, 1), b3 + hstep, voffB); PG8_STAGE_A(PG8_SA(1, 0), a3, 0, last);
            PG8_WAIT_V(8); PG8_WAIT_L(0); PG8_BAR; PG8_MMA(1, 0, At, B0); PG8_MMA(1, 1, At, B1); PG8_BAR; PG8_SCHED;
        }
        if constexpr (ALIGN_EPI) { if (wr == 0) PG8_BAR; }
        { int frl = fr, fql = fq; asm volatile("" : "+v"(frl), "+v"(fql)); E(acc, cur, wr, wc, frl, fql); }
        if (!has_next) break;
#pragma unroll
        for (int a = 0; a < 2; ++a)
#pragma unroll
            for (int b = 0; b < 2; ++b)
#pragma unroll
                for (int m = 0; m < 4; ++m)
#pragma unroll
                    for (int n = 0; n < 2; ++n) acc[a][b][m][n] = (f32x4){0.f, 0.f, 0.f, 0.f};
        cur = nxt; cA = nA; cB = nB; ++ui; PG8_MC(cur);
        if constexpr (GATHER) {
#pragma unroll
            for (int h = 0; h < 2; ++h)
#pragma unroll
                for (int i = 0; i < 2; ++i) gA[h][i] = gAn[h][i]; }
        if constexpr (ALIGN_EPI) { if (wr == 1) PG8_BAR; }
    }
    PG8_WAIT_V(0);
    if constexpr (!ALIGN_EPI) { if (wr == 0) PG8_BAR; }
    PG8_BAR;
#undef PG8_SA
#undef PG8_SB
#undef PG8_STAGE
#undef PG8_STAGE_A
#undef PG8_LDA
#undef PG8_LDB
#undef PG8_MMA
#undef PG8_WAIT_V
#undef PG8_WAIT_L
#undef PG8_BAR
#undef PG8_SCHED
#undef PG8_MC
}
}

constexpr int LDS_MISC_OFF = 131072;
__device__ __forceinline__ float fast_gelu(float x) { const float y = x + 0.044715f * x * x * x; return x * __builtin_amdgcn_rcpf(1.0f + __builtin_amdgcn_exp2f(-2.0f * 0.7978845608028654f * LOG2E * y)); }
__device__ __forceinline__ float fast_sigmoid(float x) { return __builtin_amdgcn_rcpf(1.0f + __builtin_amdgcn_exp2f(-LOG2E * x)); }
__device__ __forceinline__ void unpack8(const u32x4 w, float (&v)[8]) {
#pragma unroll
    for (int e = 0; e < 4; ++e) { v[2 * e] = __uint_as_float(w[e] << 16); v[2 * e + 1] = __uint_as_float(w[e] & 0xffff0000u); } }

constexpr size_t WS_VSTAT = 6 * MiB;
constexpr int LDS_EPI_OFF = 131072 + 4096;
struct EpiIn {
    static constexpr bool PERM = true, HAS_MID = false;
    bf16_t *U, *V, *Q, *K, *VA, *G; const float* b_gate; const float* qg; const float* kg; float* VSTAT; PG8_LAS unsigned char* lds;
    __device__ __forceinline__ void mid(f32x4 (&)[2][2][4][2], const pg8::Unit&, int, int, int, int) const {}
    __device__ __forceinline__ void operator()(f32x4 (&acc)[2][2][4][2], const pg8::Unit& u, int wr, int wc, int fr, int fq) const {
        const int pn = u.pn; bf16_t* base; int ld, colt, mode;
        if (pn < 4) { base = U; ld = 1024; colt = pn * 256; mode = 1; }
        else if (pn < 8) { base = V; ld = 1024; colt = (pn - 4) * 256; mode = 3; }
        else if (pn < 12) { base = Q; ld = 1024; colt = (pn - 8) * 256; mode = 4; }
        else if (pn < 16) { base = K; ld = 1024; colt = (pn - 12) * 256; mode = 5; }
        else if (pn < 20) { base = VA; ld = 1024; colt = (pn - 16) * 256; mode = 0; }
        else { base = G; ld = 4096; colt = (pn - 20) * 256; mode = 2; }
        const int row0 = u.pm * 256 + wr * 64 + fr, col0 = colt + wc * 32 + 8 * fq;
        if (mode >= 4) {
            PG8_LAS float* P = (PG8_LAS float*)(lds + LDS_EPI_OFF);
#pragma unroll
            for (int ai = 0; ai < 2; ++ai)
#pragma unroll
                for (int m = 0; m < 4; ++m)
#pragma unroll
                    for (int bj = 0; bj < 2; ++bj) { const f32x4 a = acc[ai][bj][m][0], b = acc[ai][bj][m][1];
                        float s = (a[0] * a[0] + a[1] * a[1]) + (a[2] * a[2] + a[3] * a[3]) + (b[0] * b[0] + b[1] * b[1]) + (b[2] * b[2] + b[3] * b[3]);
                        s += __shfl_xor(s, 16); s += __shfl_xor(s, 32);
                        if (fq == 0) P[((ai * 128 + wr * 64 + m * 16 + fr) * 2 + bj) * 4 + wc] = s; }
            asm volatile("s_waitcnt lgkmcnt(0)" ::: "memory"); __builtin_amdgcn_s_barrier(); asm volatile("" ::: "memory");
            const float* gg = mode == 4 ? qg : kg; const float qs = mode == 4 ? QSCALE : 1.0f;
            const f32x4 g0 = *(const f32x4*)(gg + wc * 32 + 8 * fq), g1 = *(const f32x4*)(gg + wc * 32 + 8 * fq + 4);
#pragma unroll
            for (int ai = 0; ai < 2; ++ai)
#pragma unroll
                for (int m = 0; m < 4; ++m) { bf16_t* rowp = base + (size_t)(row0 + ai * 128 + m * 16) * ld + col0;
#pragma unroll
                    for (int bj = 0; bj < 2; ++bj) { const f32x4 pp = *(const PG8_LAS f32x4*)(P + ((ai * 128 + wr * 64 + m * 16 + fr) * 2 + bj) * 4);
                        const float sc = rsqrtf(((pp[0] + pp[1]) + (pp[2] + pp[3])) * (1.f / 128.f) + EPS) * qs;
                        const f32x4 v0 = acc[ai][bj][m][0] * g0 * sc, v1 = acc[ai][bj][m][1] * g1 * sc;
                        u32x4 w; w.x = pg8::cvt_pk_bf16(v0[0], v0[1]); w.y = pg8::cvt_pk_bf16(v0[2], v0[3]); w.z = pg8::cvt_pk_bf16(v1[0], v1[1]); w.w = pg8::cvt_pk_bf16(v1[2], v1[3]);
                        *(u32x4*)(rowp + bj * 128) = w; } }
            return;
        }
        f32x4 bv[2][2];
#pragma unroll
        for (int bj = 0; bj < 2; ++bj)
#pragma unroll
            for (int n = 0; n < 2; ++n) bv[bj][n] = (mode == 2) ? *(const f32x4*)(b_gate + col0 + bj * 128 + 4 * n) : (f32x4){0.f, 0.f, 0.f, 0.f};
#pragma unroll
        for (int ai = 0; ai < 2; ++ai)
#pragma unroll
            for (int m = 0; m < 4; ++m) { bf16_t* rowp = base + (size_t)(row0 + ai * 128 + m * 16) * ld + col0; float s1 = 0.f, s2 = 0.f;
#pragma unroll
                for (int bj = 0; bj < 2; ++bj) { f32x4 v0 = acc[ai][bj][m][0], v1 = acc[ai][bj][m][1];
                    if (mode == 1 || mode == 3) {
#pragma unroll
                        for (int j = 0; j < 4; ++j) { v0[j] = fast_gelu(v0[j]); v1[j] = fast_gelu(v1[j]); } }
                    else if (mode == 2) { v0 += bv[bj][0]; v1 += bv[bj][1];
#pragma unroll
                        for (int j = 0; j < 4; ++j) { v0[j] = fast_sigmoid(v0[j]); v1[j] = fast_sigmoid(v1[j]); } }
                    if (mode == 3) {
#pragma unroll
                        for (int j = 0; j < 4; ++j) { s1 += v0[j] + v1[j]; s2 += v0[j] * v0[j] + v1[j] * v1[j]; } }
                    u32x4 w; w.x = pg8::cvt_pk_bf16(v0[0], v0[1]); w.y = pg8::cvt_pk_bf16(v0[2], v0[3]); w.z = pg8::cvt_pk_bf16(v1[0], v1[1]); w.w = pg8::cvt_pk_bf16(v1[2], v1[3]);
                    *(u32x4*)(rowp + bj * 128) = w; }
                if (mode == 3) { s1 += __shfl_xor(s1, 16); s1 += __shfl_xor(s1, 32); s2 += __shfl_xor(s2, 16); s2 += __shfl_xor(s2, 32);
                    if (fq == 0) { typedef float f32x2_ __attribute__((ext_vector_type(2))); *(f32x2_*)(VSTAT + ((size_t)(row0 + ai * 128 + m * 16) * 16 + (pn - 4) * 4 + wc) * 2) = (f32x2_){s1, s2}; } } }
    }
};
struct EpiProj {
    static constexpr bool PERM = true, HAS_MID = true;
    const bf16_t* G; bf16_t* O;
    __device__ __forceinline__ void mid(f32x4 (&acc)[2][2][4][2], const pg8::Unit& u, int wr, int wc, int fr, int fq) const {
        const int row0 = u.pm * 256 + wr * 64 + fr, col0 = u.pn * 256 + wc * 32 + 8 * fq;
#pragma unroll
        for (int ai = 0; ai < 2; ++ai)
#pragma unroll
            for (int m = 0; m < 4; ++m) { const bf16_t* gp = G + (size_t)(row0 + ai * 128 + m * 16) * 4096 + col0;
#pragma unroll
                for (int bj = 0; bj < 2; ++bj) { float gs[8], gf[8]; unpack8(*(const u32x4*)(gp + bj * 128), gs); unpack8(*(const u32x4*)(gp + 2048 + bj * 128), gf);
#pragma unroll
                    for (int j = 0; j < 4; ++j) { acc[ai][bj][m][0][j] *= gs[j] * __builtin_amdgcn_rcpf(gf[j]); acc[ai][bj][m][1][j] *= gs[4 + j] * __builtin_amdgcn_rcpf(gf[4 + j]); }
                    asm volatile("" : "+v"(acc[ai][bj][m][0]), "+v"(acc[ai][bj][m][1]) :: "memory"); } }
    }
    __device__ __forceinline__ void operator()(f32x4 (&acc)[2][2][4][2], const pg8::Unit& u, int wr, int wc, int fr, int fq) const {
        const int row0 = u.pm * 256 + wr * 64 + fr, col0 = u.pn * 256 + wc * 32 + 8 * fq;
#pragma unroll
        for (int ai = 0; ai < 2; ++ai)
#pragma unroll
            for (int m = 0; m < 4; ++m) { const size_t r = (size_t)(row0 + ai * 128 + m * 16);
#pragma unroll
                for (int bj = 0; bj < 2; ++bj) { float gf[8]; unpack8(*(const u32x4*)(G + r * 4096 + 2048 + col0 + bj * 128), gf);
                    const f32x4 v0 = acc[ai][bj][m][0], v1 = acc[ai][bj][m][1];
                    u32x4 w; w.x = pg8::cvt_pk_bf16(v0[0] * gf[0], v0[1] * gf[1]); w.y = pg8::cvt_pk_bf16(v0[2] * gf[2], v0[3] * gf[3]); w.z = pg8::cvt_pk_bf16(v1[0] * gf[4], v1[1] * gf[5]); w.w = pg8::cvt_pk_bf16(v1[2] * gf[6], v1[3] * gf[7]);
                    *(u32x4*)(O + r * 2048 + col0 + bj * 128) = w; }
                asm volatile("" ::: "memory"); }
    }
};
struct EpiOut {
    static constexpr bool PERM = false, HAS_MID = false;
    const float* X; float* O;
    __device__ __forceinline__ void mid(f32x4 (&)[2][2][4][2], const pg8::Unit&, int, int, int, int) const {}
    __device__ __forceinline__ void operator()(f32x4 (&acc)[2][2][4][2], const pg8::Unit& u, int wr, int wc, int fr, int fq) const {
        const int row0 = u.pm * 256 + wr * 64 + fr, col0 = u.pn * 256 + wc * 32 + 4 * fq;
#pragma unroll
        for (int ai = 0; ai < 2; ++ai)
#pragma unroll
            for (int m = 0; m < 4; ++m) { const size_t off = (size_t)(row0 + ai * 128 + m * 16) * DM + col0;
#pragma unroll
                for (int bj = 0; bj < 2; ++bj)
#pragma unroll
                    for (int n = 0; n < 2; ++n) *(f32x4*)(O + off + bj * 128 + n * 16) = *(const f32x4*)(X + off + bj * 128 + n * 16) + acc[ai][bj][m][n]; }
    }
};
struct EpiGateUp {
    static constexpr bool PERM = true, HAS_MID = false;
    bf16_t* ACT; const float* RSTL;
    __device__ __forceinline__ void mid(f32x4 (&)[2][2][4][2], const pg8::Unit&, int, int, int, int) const {}
    __device__ __forceinline__ void operator()(f32x4 (&acc)[2][2][4][2], const pg8::Unit& u, int wr, int wc, int fr, int fq) const {
        const int row0 = u.x0 + wr * 64 + fr, col0 = u.pn * 128 + wc * 32 + 8 * fq;
#pragma unroll
        for (int ai = 0; ai < 2; ++ai)
#pragma unroll
            for (int m = 0; m < 4; ++m) { float o[8]; const float rr = RSTL[u.x1 + wr * 64 + fr + ai * 128 + m * 16];
#pragma unroll
                for (int n = 0; n < 2; ++n)
#pragma unroll
                    for (int j = 0; j < 4; ++j) { const float g = acc[ai][0][m][n][j] * rr, up = acc[ai][1][m][n][j] * rr; o[4 * n + j] = g * fast_sigmoid(g) * up; }
                u32x4 w; w.x = pg8::cvt_pk_bf16(o[0], o[1]); w.y = pg8::cvt_pk_bf16(o[2], o[3]); w.z = pg8::cvt_pk_bf16(o[4], o[5]); w.w = pg8::cvt_pk_bf16(o[6], o[7]);
                *(u32x4*)(ACT + (size_t)(row0 + ai * 128 + m * 16) * DEXP + col0) = w; }
    }
};
struct EpiDown {
    static constexpr bool PERM = true, HAS_MID = false;
    bf16_t* Y; const float* GATE;
    __device__ __forceinline__ void mid(f32x4 (&)[2][2][4][2], const pg8::Unit&, int, int, int, int) const {}
    __device__ __forceinline__ void operator()(f32x4 (&acc)[2][2][4][2], const pg8::Unit& u, int wr, int wc, int fr, int fq) const {
        const int rl0 = wr * 64 + fr, col0 = u.pn * 256 + wc * 32 + 8 * fq;
#pragma unroll
        for (int ai = 0; ai < 2; ++ai)
#pragma unroll
            for (int m = 0; m < 4; ++m) { const int rl = rl0 + ai * 128 + m * 16; const float gt = GATE[u.x1 + rl];
#pragma unroll
                for (int bj = 0; bj < 2; ++bj) { const f32x4 v0 = acc[ai][bj][m][0] * gt, v1 = acc[ai][bj][m][1] * gt;
                    u32x4 w; w.x = pg8::cvt_pk_bf16(v0[0], v0[1]); w.y = pg8::cvt_pk_bf16(v0[2], v0[3]); w.z = pg8::cvt_pk_bf16(v1[0], v1[1]); w.w = pg8::cvt_pk_bf16(v1[2], v1[3]);
                    *(u32x4*)(Y + (size_t)(u.x0 + rl) * DM + col0 + bj * 128) = w; } }
    }
};
struct MoeOrder {
    const char* Abase; const char* Bbase; size_t Bstride; int K, nN, G, c; bool gather;
    const PG8_LAS int* ps;
    const unsigned* cnt; const int* TOK; bool xcdm;
    __device__ static int tile_of(int i, int c, int G, int nN, int nb, int& pn, bool xcdm) {
        const int S = (G / 8) / nN;
        if (!xcdm || G % 8 != 0 || S < 1) { const int L = i * G + c; pn = L % nN; return L / nN < nb ? L / nN : -1; }
        const int x = c % 8, slot = c / 8; pn = slot % nN;
        if (slot >= S * nN) return -1;
        const int sidx = i * (8 * S) + x * S + slot / nN; return sidx < nb ? sidx : -1;
    }
    __device__ bool next(int i, pg8::Unit& u) const {
        int pn; const int sidx = tile_of(i, c, G, nN, ps[NEXP + 2], pn, xcdm); if (sidx < 0) return false;
        const int prow = ps[40 + sidx], info = ps[40 + MT_MAX + sidx], valid = ps[40 + 2 * MT_MAX + sidx];
        const int e = info >> 16, mt = info & 0xffff;
        u.pm = mt; u.pn = pn; u.x0 = prow; u.x1 = e * T + mt * MTILE; u.x2 = valid; u.x3 = e;
        u.A = gather ? Abase : Abase + (size_t)prow * K * 2; u.B = Bbase + (size_t)e * Bstride + (size_t)pn * 256 * K * 2; return true;
    }
    __device__ __forceinline__ void rows(const pg8::Unit& u, unsigned (&g)[2][2], const int (&RA)[2]) const {
#pragma unroll
        for (int h = 0; h < 2; ++h)
#pragma unroll
            for (int i = 0; i < 2; ++i) { int r = RA[i] + 128 * h; r = r < u.x2 ? r : u.x2 - 1; g[h][i] = (unsigned)TOK[u.x1 + r] * (unsigned)(K * 2); }
    }
};

struct TItem { const float* src; bf16_t* dst; int ld_src, ld_dst; };
__device__ __forceinline__ void titem_load(const TItem& t, f32x4 (&v)[8], int lane) {
#pragma unroll
    for (int i = 0; i < 8; ++i) v[i] = *(const f32x4*)(t.src + (size_t)((lane >> 3) + 8 * i) * t.ld_src + 4 * (lane & 7));
}
__device__ __forceinline__ void titem_store(const TItem& t, const f32x4 (&v)[8], PG8_LAS float* scr, int lane) {
#pragma unroll
    for (int i = 0; i < 8; ++i) { PG8_LAS float* d = scr + ((lane >> 3) + 8 * i) * 33 + 4 * (lane & 7); d[0] = v[i].x; d[1] = v[i].y; d[2] = v[i].z; d[3] = v[i].w; }
    asm volatile("s_waitcnt lgkmcnt(0)" ::: "memory");
    const int c = lane & 7;
#pragma unroll
    for (int j = 0; j < 4; ++j) { const int n = (lane >> 3) + 8 * j; const PG8_LAS float* s = scr + (8 * c) * 33 + n;
        u32x4 o; o.x = pk2(s[0 * 33], s[1 * 33]); o.y = pk2(s[2 * 33], s[3 * 33]); o.z = pk2(s[4 * 33], s[5 * 33]); o.w = pk2(s[6 * 33], s[7 * 33]);
        *(u32x4*)(t.dst + (size_t)n * t.ld_dst + 8 * c) = o; }
    asm volatile("s_waitcnt lgkmcnt(0)" ::: "memory");
}
constexpr int TI0 = 32 * 288, TI1 = 16 * 64, TI2 = 16 * 64, TI3 = 32 * 64, TI4 = 32 * 512, TI5 = 32 * 512, TI6 = 32 * 512;
constexpr int TI_ALL = TI0 + TI1 + TI2 + TI3 + TI4 + TI5 + TI6;
#ifndef TAIL1_ITEMS
#define TAIL1_ITEMS (TI5)
#endif
__device__ __forceinline__ TItem titem_decode(const Args& A, int r) {
    bf16_t* WIN = (bf16_t*)(A.ws + WS_WIN); bf16_t* WPROJ = (bf16_t*)(A.ws + WS_WPROJ); bf16_t* WOUT = (bf16_t*)(A.ws + WS_WOUT); bf16_t* WGU = (bf16_t*)(A.ws + WS_WGU); bf16_t* WD = (bf16_t*)(A.ws + WS_WD);
    TItem t;
    if (r < TI0) { const int kb = r / 288, nb = r % 288; t.src = A.in[2] + (size_t)(64 * kb) * INCOLS + 32 * nb + (nb >= 160 ? 8 : 0); t.ld_src = INCOLS; t.dst = WIN + (size_t)(32 * nb) * 2048 + 64 * kb; t.ld_dst = 2048; return t; } r -= TI0;
    if (r < TI1) { const int kb = r / 64, nb = r % 64; t.src = A.in[11] + (size_t)(64 * kb) * DM + 32 * nb; t.ld_src = DM; t.dst = WPROJ + (size_t)(32 * nb) * 2048 + 64 * kb; t.ld_dst = 2048; return t; } r -= TI1;
    if (r < TI2) { const int kb = r / 64, nb = r % 64; t.src = A.in[12] + (size_t)(64 * kb) * DM + 32 * nb; t.ld_src = DM; t.dst = WPROJ + (size_t)(32 * nb) * 2048 + 1024 + 64 * kb; t.ld_dst = 2048; return t; } r -= TI2;
    if (r < TI3) { const int kb = r / 64, nb = r % 64; t.src = A.in[13] + (size_t)(64 * kb) * DM + 32 * nb; t.ld_src = DM; t.dst = WOUT + (size_t)(32 * nb) * 2048 + 64 * kb; t.ld_dst = 2048; return t; } r -= TI3;
    if (r < TI4 + TI5) { const int up = r >= TI4; if (up) r -= TI4; const int e = r / 512, q = r % 512, kb = q / 16, nb = q % 16, n = 32 * nb, drow = 256 * (n >> 7) + (n & 127) + (up ? 128 : 0);
        t.src = A.in[up ? 20 : 19] + (size_t)e * DM * DEXP + (size_t)(64 * kb) * DEXP + n; t.ld_src = DEXP; t.dst = WGU + ((size_t)e * 1024 + drow) * 2048 + 64 * kb; t.ld_dst = 2048; return t; } r -= TI4 + TI5;
    { const int e = r / 512, q = r % 512, kb = q / 64, nb = q % 64; t.src = A.in[21] + (size_t)e * DEXP * DM + (size_t)(64 * kb) * DM + 32 * nb; t.ld_src = DM; t.dst = WD + ((size_t)e * 2048 + 32 * nb) * 512 + 64 * kb; t.ld_dst = 512; return t; }
}
__device__ __forceinline__ void p0_weights(const Args& A, PG8_LAS unsigned char* lds, const int part, const int wrank, const int wcount) {
    const int tid = threadIdx.x, lane = tid & 63, wave = tid >> 6;
    PG8_LAS float* scr = (PG8_LAS float*)(lds + wave * 16384);
    if (wrank < 0 || wcount < 1) return;
    const int gw = wrank * NWAVES + wave, NGW = wcount * NWAVES;
    const int cut1 = TI_ALL - TI6 - TAIL1_ITEMS, cut2 = TI_ALL - TI6;
    const int it_lo = part == 0 ? 0 : (part == 1 ? cut1 : cut2), it_hi = part == 0 ? cut1 : (part == 1 ? cut2 : TI_ALL);
    int it = it_lo + gw; if (it >= it_hi) return;
    TItem cur = titem_decode(A, it); f32x4 va[8], vb[8];
    titem_load(cur, va, lane);
    for (;;) {
        const int itn = it + NGW; const bool more = itn < it_hi; TItem nx = cur;
        if (more) { nx = titem_decode(A, itn); titem_load(nx, vb, lane); }
        titem_store(cur, va, scr, lane);
        if (!more) break;
#pragma unroll
        for (int i = 0; i < 8; ++i) va[i] = vb[i];
        cur = nx; it = itn;
    }
}

__device__ __forceinline__ void p1_fast(const Args& A, PG8_LAS unsigned char* lds) {
    pg8::DenseOrder S; S.init(A.ws + WS_H, A.ws + WS_WIN, T, 9216, DM, gridDim.x, blockIdx.x, PROBE_REP_P1);
    EpiIn E{(bf16_t*)(A.ws + WS_U), (bf16_t*)(A.ws + WS_V), (bf16_t*)(A.ws + WS_Q), (bf16_t*)(A.ws + WS_K), (bf16_t*)(A.ws + WS_VA), (bf16_t*)(A.ws + WS_G), A.in[3], A.in[9], A.in[10], (float*)(A.ws + WS_VSTAT), lds};
    pg8::gemm_phase<EpiIn, pg8::DenseOrder, true, false>(lds, DM, S, E);
}
__device__ __forceinline__ void p3_fast(const Args& A, PG8_LAS unsigned char* lds) {
    pg8::DenseOrder S; S.init(A.ws + WS_MIXIN, A.ws + WS_WPROJ, T, DM, 2048, gridDim.x, blockIdx.x, PROBE_REP_P4);
    EpiProj E{(const bf16_t*)(A.ws + WS_G), (bf16_t*)(A.ws + WS_MIXED)};
    pg8::gemm_phase<EpiProj, pg8::DenseOrder, true, false>(lds, 2048, S, E);
}
__device__ __forceinline__ void p4_fast(const Args& A, PG8_LAS unsigned char* lds) {
    pg8::DenseOrder S; S.init(A.ws + WS_MIXED, A.ws + WS_WOUT, T, DM, DM, gridDim.x, blockIdx.x, PROBE_REP_P5);
    EpiOut E{A.in[0], A.out};
    pg8::gemm_phase<EpiOut, pg8::DenseOrder, true, false>(lds, DM, S, E);
}
__device__ __forceinline__ void moe_layout_lds(const Args& A, PG8_LAS unsigned char* lds) {
    PG8_LAS int* ps = (PG8_LAS int*)(lds + LDS_MISC_OFF); PG8_LAS int* tprow = ps + 40; PG8_LAS int* tinfo = tprow + MT_MAX; PG8_LAS int* tvalid = tinfo + MT_MAX;
    const unsigned* cnt = (const unsigned*)(A.ws + WS_CTL) + CW_CNT;
    if (threadIdx.x == 0) { int acc = 0;
        for (int e = 0; e < NEXP; ++e) { ps[e] = acc; acc += ((int)cnt[(e) * CNT_STRIDE] + MTILE - 1) / MTILE * MTILE; }
        ps[NEXP] = acc; ps[NEXP + 1] = acc / MTILE; }
    __syncthreads();
    const int nt = ps[NEXP + 1]; PG8_LAS int* uval = tvalid + MT_MAX;
    int prow = 0, e = 0, mt = 0, valid = 0;
    if ((int)threadIdx.x < nt) { prow = (int)threadIdx.x * MTILE;
        for (int j = 1; j < NEXP; ++j) if (ps[j] <= prow) e = j;
        mt = (prow - ps[e]) / MTILE; valid = (int)cnt[(e) * CNT_STRIDE] - mt * MTILE; valid = valid > MTILE ? MTILE : valid; uval[threadIdx.x] = valid; }
    __syncthreads();
    if ((int)threadIdx.x < nt) { int rank = 0;
        if (TINY_ROWS > 0) { for (int j = 0; j < nt; ++j) { const int vj = uval[j]; rank += (vj > valid || (vj == valid && j < (int)threadIdx.x)) ? 1 : 0; } } else rank = (int)threadIdx.x;
        tprow[rank] = prow; tinfo[rank] = (e << 16) | mt; tvalid[rank] = valid; }
    if (threadIdx.x == 0) { int nb = 0; for (int j = 0; j < nt; ++j) nb += uval[j] > TINY_ROWS ? 1 : 0; ps[NEXP + 2] = nb; }
    __syncthreads();
}
namespace sm {
typedef short bf16x8 __attribute__((ext_vector_type(8))); typedef float f32x16 __attribute__((ext_vector_type(16)));
constexpr int TINY = 64;
__device__ __forceinline__ void gateup_small(const Args& A, PG8_LAS unsigned char* lds) {
    const PG8_LAS int* ps = (const PG8_LAS int*)(lds + LDS_MISC_OFF); const int nt = ps[NEXP + 1], nbig = ps[NEXP + 2];
    const bf16_t* H2 = (const bf16_t*)(A.ws + WS_H2); const bf16_t* WGU = (const bf16_t*)(A.ws + WS_WGU); bf16_t* ACT = (bf16_t*)(A.ws + WS_ACT); const int* TOK = (const int*)(A.ws + WS_TOK);
    const int tid = threadIdx.x, lane = tid & 63, w = __builtin_amdgcn_readfirstlane(tid >> 6), r32 = lane & 31, hi = lane >> 5;
    PG8_LAS float* red = (PG8_LAS float*)lds;
    for (int su = blockIdx.x; su < (nt - nbig) * 16; su += gridDim.x) {
        const int sidx = nbig + (su >> 4), sl = su & 15; const int prow = ps[40 + sidx], info = ps[40 + MT_MAX + sidx], valid = ps[40 + 2 * MT_MAX + sidx];
        const int e = info >> 16, mt = info & 0xffff, lbase = e * T + mt * MTILE;
        const int ra = r32 < valid ? r32 : valid - 1, rb = 32 + r32 < valid ? 32 + r32 : valid - 1;
        const bf16_t* a0p = H2 + (size_t)TOK[lbase + ra] * DM + 256 * w + 8 * hi; const bf16_t* a1p = H2 + (size_t)TOK[lbase + rb] * DM + 256 * w + 8 * hi;
        const bf16_t* b0p = WGU + ((size_t)e * 1024 + 256 * (sl >> 2) + 32 * (sl & 3) + r32) * DM + 256 * w + 8 * hi; const bf16_t* b1p = b0p + (size_t)128 * DM;
        f32x16 acc[2][2];
#pragma unroll
        for (int i = 0; i < 2; ++i)
#pragma unroll
            for (int j = 0; j < 2; ++j)
#pragma unroll
                for (int r = 0; r < 16; ++r) acc[i][j][r] = 0.f;
#pragma unroll 4
        for (int ks = 0; ks < 16; ++ks) { const bf16x8 a0 = *(const bf16x8*)(a0p + 16 * ks), a1 = *(const bf16x8*)(a1p + 16 * ks), b0 = *(const bf16x8*)(b0p + 16 * ks), b1 = *(const bf16x8*)(b1p + 16 * ks);
            acc[0][0] = __builtin_amdgcn_mfma_f32_32x32x16_bf16(a0, b0, acc[0][0], 0, 0, 0); acc[0][1] = __builtin_amdgcn_mfma_f32_32x32x16_bf16(a0, b1, acc[0][1], 0, 0, 0);
            acc[1][0] = __builtin_amdgcn_mfma_f32_32x32x16_bf16(a1, b0, acc[1][0], 0, 0, 0); acc[1][1] = __builtin_amdgcn_mfma_f32_32x32x16_bf16(a1, b1, acc[1][1], 0, 0, 0); }
#pragma unroll
        for (int i = 0; i < 2; ++i)
#pragma unroll
            for (int j = 0; j < 2; ++j)
#pragma unroll
                for (int r = 0; r < 16; ++r) red[(((w * 2 + i) * 2 + j) * 16 + r) * 64 + lane] = acc[i][j][r];
        __syncthreads();
#pragma unroll
        for (int i = 0; i < 2; ++i)
#pragma unroll
            for (int rr = 0; rr < 2; ++rr) { const int r = 2 * w + rr; float g = 0.f, u = 0.f;
#pragma unroll
                for (int w2 = 0; w2 < 8; ++w2) { g += red[(((w2 * 2 + i) * 2 + 0) * 16 + r) * 64 + lane]; u += red[(((w2 * 2 + i) * 2 + 1) * 16 + r) * 64 + lane]; }
                const int row = 32 * i + (r & 3) + 8 * (r >> 2) + 4 * hi; const float rr2 = ((const float*)(A.ws + WS_RSTL))[lbase + (row < valid ? row : valid - 1)]; g *= rr2; u *= rr2;
                ACT[(size_t)(prow + row) * DEXP + 32 * sl + r32] = f2bf(g * fast_sigmoid(g) * u); }
        __syncthreads();
    }
}
__device__ __forceinline__ void down_small(const Args& A, PG8_LAS unsigned char* lds) {
    const PG8_LAS int* ps = (const PG8_LAS int*)(lds + LDS_MISC_OFF); const int nt = ps[NEXP + 1], nbig = ps[NEXP + 2];
    const bf16_t* ACT = (const bf16_t*)(A.ws + WS_ACT); const bf16_t* WD = (const bf16_t*)(A.ws + WS_WD); bf16_t* Y = (bf16_t*)(A.ws + WS_YBUF); const float* GATE = (const float*)(A.ws + WS_GATE);
    const int tid = threadIdx.x, lane = tid & 63, w = __builtin_amdgcn_readfirstlane(tid >> 6), wn = w & 3, wk = w >> 2, r32 = lane & 31, hi = lane >> 5;
    PG8_LAS float* red = (PG8_LAS float*)lds;
    for (int su = blockIdx.x; su < (nt - nbig) * 16; su += gridDim.x) {
        const int sidx = nbig + (su >> 4), sl = su & 15; const int prow = ps[40 + sidx], info = ps[40 + MT_MAX + sidx], valid = ps[40 + 2 * MT_MAX + sidx];
        const int e = info >> 16, mt = info & 0xffff, lbase = e * T + mt * MTILE;
        const int ra = r32 < valid ? r32 : valid - 1, rb = 32 + r32 < valid ? 32 + r32 : valid - 1;
        const bf16_t* a0p = ACT + (size_t)(prow + ra) * DEXP + 256 * wk + 8 * hi; const bf16_t* a1p = ACT + (size_t)(prow + rb) * DEXP + 256 * wk + 8 * hi;
        const bf16_t* bp = WD + ((size_t)e * 2048 + 128 * sl + 32 * wn + r32) * DEXP + 256 * wk + 8 * hi;
        f32x16 acc[2];
#pragma unroll
        for (int i = 0; i < 2; ++i)
#pragma unroll
            for (int r = 0; r < 16; ++r) acc[i][r] = 0.f;
#pragma unroll 4
        for (int ks = 0; ks < 16; ++ks) { const bf16x8 a0 = *(const bf16x8*)(a0p + 16 * ks), a1 = *(const bf16x8*)(a1p + 16 * ks), b = *(const bf16x8*)(bp + 16 * ks);
            acc[0] = __builtin_amdgcn_mfma_f32_32x32x16_bf16(a0, b, acc[0], 0, 0, 0); acc[1] = __builtin_amdgcn_mfma_f32_32x32x16_bf16(a1, b, acc[1], 0, 0, 0); }
        if (wk == 1) {
#pragma unroll
            for (int i = 0; i < 2; ++i)
#pragma unroll
                for (int r = 0; r < 16; ++r) red[((wn * 2 + i) * 16 + r) * 64 + lane] = acc[i][r]; }
        __syncthreads();
        if (wk == 0) {
#pragma unroll
            for (int i = 0; i < 2; ++i)
#pragma unroll
                for (int r = 0; r < 16; ++r) { const int row = 32 * i + (r & 3) + 8 * (r >> 2) + 4 * hi; const float gt = GATE[lbase + (row < valid ? row : valid - 1)];
                    Y[(size_t)(prow + row) * DM + 128 * sl + 32 * wn + r32] = f2bf((acc[i][r] + red[((wn * 2 + i) * 16 + r) * 64 + lane]) * gt); } }
        __syncthreads();
    }
}
}

__device__ __forceinline__ void p6_fast(const Args& A, PG8_LAS unsigned char* lds) {
    moe_layout_lds(A, lds);
    MoeOrder S{(const char*)(A.ws + WS_H2), (const char*)(A.ws + WS_WGU), (size_t)1024 * 2048 * 2, DM, 4, (int)gridDim.x, (int)blockIdx.x, true,
               (const PG8_LAS int*)(lds + LDS_MISC_OFF), (const unsigned*)(A.ws + WS_CTL) + CW_CNT, (const int*)(A.ws + WS_TOK), XCDM_GU};
    EpiGateUp E{(bf16_t*)(A.ws + WS_ACT), (const float*)(A.ws + WS_RSTL)};
    pg8::gemm_phase<EpiGateUp, MoeOrder, true, true>(lds, DM, S, E);
    sm::gateup_small(A, lds);
    {
        PG8_LAS int* pw = (PG8_LAS int*)(lds + LDS_MISC_OFF) + 40 + 4 * MT_MAX;
        const int nb = ((const PG8_LAS int*)(lds + LDS_MISC_OFF))[NEXP + 2], G = (int)gridDim.x; int pn_;
        const int per = XCDM_GU ? 8 * ((G / 8) / 4) : G / 4, rounds = per > 0 ? (nb + per - 1) / per : 1;
        const int t = (int)threadIdx.x; const bool idle_t = t < G && MoeOrder::tile_of(rounds - 1, t, G, 4, nb, pn_, XCDM_GU) < 0;
        float before = (idle_t && t < (int)blockIdx.x) ? 1.f : 0.f, all = idle_t ? 1.f : 0.f;
        before = wave_sum(before); all = wave_sum(all);
        __syncthreads();
        if ((t & 63) == 0) { pw[2 + (t >> 6)] = (int)before; pw[10 + (t >> 6)] = (int)all; }
        __syncthreads();
        if (t == 0) { int rk = 0, tot = 0; for (int w = 0; w < NWAVES; ++w) { rk += pw[2 + w]; tot += pw[10 + w]; }
            const bool me_idle = MoeOrder::tile_of(rounds - 1, (int)blockIdx.x, G, 4, nb, pn_, XCDM_GU) < 0;
            pw[0] = tot == 0 ? (int)blockIdx.x : (me_idle ? rk : -1); pw[1] = tot == 0 ? G : tot; }
        __syncthreads();
        p0_weights(A, lds, 2, pw[0], pw[1]); }
}
__device__ __forceinline__ void p7_fast(const Args& A, PG8_LAS unsigned char* lds) {
    moe_layout_lds(A, lds);
    MoeOrder S{(const char*)(A.ws + WS_ACT), (const char*)(A.ws + WS_WD), (size_t)2048 * 512 * 2, DEXP, 8, (int)gridDim.x, (int)blockIdx.x, false,
               (const PG8_LAS int*)(lds + LDS_MISC_OFF), (const unsigned*)(A.ws + WS_CTL) + CW_CNT, (const int*)(A.ws + WS_TOK), true};
    EpiDown E{(bf16_t*)(A.ws + WS_YBUF), (const float*)(A.ws + WS_GATE)};
    pg8::gemm_phase<EpiDown, MoeOrder, true, false>(lds, DEXP, S, E);
    sm::down_small(A, lds);
}

namespace fa {
typedef short bf16x8 __attribute__((ext_vector_type(8)));
typedef short v4i16 __attribute__((ext_vector_type(4)));
typedef float f32x16 __attribute__((ext_vector_type(16)));
#define FA_LAS __attribute__((address_space(3)))
constexpr int KVBUF = 65536, LDS_CK = 131072, LDS_ML = 131072 + 8192;
__device__ __forceinline__ unsigned cvtpk(float lo, float hi) { unsigned r; asm("v_cvt_pk_bf16_f32 %0, %1, %2" : "=v"(r) : "v"(lo), "v"(hi)); return r; }
__device__ __forceinline__ bf16x8 pack8(const f32x16& p, int b) { u32x4 w; w.x = cvtpk(p[b], p[b + 1]); w.y = cvtpk(p[b + 2], p[b + 3]); w.z = cvtpk(p[b + 4], p[b + 5]); w.w = cvtpk(p[b + 6], p[b + 7]); return __builtin_bit_cast(bf16x8, w); }
__device__ __forceinline__ float swapmax(float v) { auto rr = __builtin_amdgcn_permlane32_swap(__float_as_uint(v), __float_as_uint(v), false, false); return fmaxf(__uint_as_float(rr[0]), __uint_as_float(rr[1])); }
__device__ __forceinline__ float swapsum(float v) { auto rr = __builtin_amdgcn_permlane32_swap(__float_as_uint(v), __float_as_uint(v), false, false); return __uint_as_float(rr[0]) + __uint_as_float(rr[1]); }
#define FA_WAITBAR() do { asm volatile("s_waitcnt vmcnt(0) lgkmcnt(0)" ::: "memory"); __builtin_amdgcn_s_barrier(); asm volatile("" ::: "memory"); } while (0)

__device__ __forceinline__ void attn_phase(const Args& A, FA_LAS unsigned char* lds) {
    const bf16_t* Q = (const bf16_t*)(A.ws + WS_Q); const bf16_t* Kt = (const bf16_t*)(A.ws + WS_K); const bf16_t* Vt = (const bf16_t*)(A.ws + WS_VA);
    const float* CKL = (const float*)(A.ws + WS_CKL); bf16_t* MIXIN = (bf16_t*)(A.ws + WS_MIXIN);
    const int tid = threadIdx.x, lane = tid & 63, wid = __builtin_amdgcn_readfirstlane(tid >> 6), rg = wid & 3, kh = wid >> 2, r32 = lane & 31, hi = lane >> 5;
    int koff[4];
#pragma unroll
    for (int i = 0; i < 4; ++i) { const int rl = 4 * i + (lane >> 4); koff[i] = rl * 1024 + (((lane & 15) ^ rl) * 8); }
    const int voff = (lane >> 4) * 1024 + (((lane & 15) ^ ((lane >> 4) << 2)) * 8);
    int kfo[8];
#pragma unroll
    for (int d0 = 0; d0 < 8; ++d0) kfo[d0] = (kh * 64 + r32) * 256 + (((2 * d0 + hi) ^ (r32 & 15)) * 16);
    int vfo[4];
    { const int dh = (lane >> 4) & 1, q = (lane & 15) >> 2, p = lane & 3;
#pragma unroll
      for (int db = 0; db < 4; ++db) vfo[db] = (kh * 64 + 4 * hi + q) * 256 + ((db ^ q) * 64) + dh * 32 + p * 8; }
    const unsigned ldsb = (unsigned)(uintptr_t)lds;
    const int G = gridDim.x;
    for (int vb0 = blockIdx.x; vb0 < 256 * PROBE_REP_ATTN; vb0 += G) { const int vb = vb0 % 256;
        const int item = (G % 8 == 0) ? ((vb % 8) * 32 + (vb / 8)) % 256 : vb;
        const int bh = item >> 3, ii = item & 7, b = bh >> 3, h = bh & 7;
        const bf16_t* Kg = Kt + (size_t)b * SEQ * 1024 + h * 128; const bf16_t* Vg = Vt + (size_t)b * SEQ * 1024 + h * 128;
        { const f32x4 c = *(const f32x4*)(CKL + (size_t)bh * SEQ + tid * 4); *(FA_LAS f32x4*)(lds + LDS_CK + tid * 16) = (f32x4){-c.x, -c.y, -c.z, -c.w}; }
#define FA_ISSUE_K(key0, kb_) do { const bf16_t* kg_ = Kg + (size_t)((key0) + 16 * wid) * 1024; \
        _Pragma("unroll") for (int i_ = 0; i_ < 4; ++i_) __builtin_amdgcn_global_load_lds((const unsigned*)(kg_ + koff[i_]), (FA_LAS unsigned*)(lds + (kb_) * 32768 + (wid * 4 + i_) * 1024), 16, 0, 0); } while (0)
#define FA_ISSUE_V(key0, vb_) do { const bf16_t* vg_ = Vg + (size_t)((key0) + 16 * wid) * 1024; \
        _Pragma("unroll") for (int i_ = 0; i_ < 4; ++i_) __builtin_amdgcn_global_load_lds((const unsigned*)(vg_ + i_ * 4096 + voff), (FA_LAS unsigned*)(lds + 65536 + (vb_) * 32768 + (wid * 4 + i_) * 1024), 16, 0, 0); } while (0)
#define FA_DSR128(dst, addr, off) asm volatile("ds_read_b128 %0, %1 offset:%2" : "=v"(dst) : "v"(addr), "n"(off))
#define FA_DSTR(dst, addr, off) asm volatile("ds_read_b64_tr_b16 %0, %1 offset:%2" : "=v"(dst) : "v"(addr), "n"(off))
#define FA_LGKM(n) asm volatile("s_waitcnt lgkmcnt(" #n ")" ::: "memory")
#define FA_SB() __builtin_amdgcn_sched_barrier(0)
#define FA_QK_STEP(i, P0, P1, W) do { FA_LGKM(W); FA_SB(); \
        if (((i) & 1) == 0) P0 = __builtin_amdgcn_mfma_f32_32x32x16_bf16(kr[(i) & 3], qf[(i) >> 1], P0, 0, 0, 0); else P1 = __builtin_amdgcn_mfma_f32_32x32x16_bf16(kr[(i) & 3], qf[(i) >> 1], P1, 0, 0, 0); \
        FA_SB(); if ((i) + 4 < 16) FA_DSR128(kr[(i) & 3], ka_[((i) + 4) >> 1], (((i) + 4) & 1) * 8192); } while (0)
#define FA_QK(P0, P1, kbuf, kbk) do { FA_LAS const float* nck = (FA_LAS const float*)(lds + LDS_CK) + (kbk) * 128 + kh * 64 + 4 * hi; \
        _Pragma("unroll") for (int g_ = 0; g_ < 4; ++g_) { const f32x4 t0 = *(FA_LAS const f32x4*)(nck + 8 * g_), t1 = *(FA_LAS const f32x4*)(nck + 32 + 8 * g_); \
            _Pragma("unroll") for (int j_ = 0; j_ < 4; ++j_) { P0[4 * g_ + j_] = t0[j_]; P1[4 * g_ + j_] = t1[j_]; } } \
        unsigned ka_[8]; _Pragma("unroll") for (int d0 = 0; d0 < 8; ++d0) ka_[d0] = ldsb + (unsigned)((kbuf) * 32768 + kfo[d0]); \
        bf16x8 kr[4]; FA_SB(); FA_DSR128(kr[0], ka_[0], 0); FA_DSR128(kr[1], ka_[0], 8192); FA_DSR128(kr[2], ka_[1], 0); FA_DSR128(kr[3], ka_[1], 8192); \
        FA_QK_STEP(0, P0, P1, 3); FA_QK_STEP(1, P0, P1, 3); FA_QK_STEP(2, P0, P1, 3); FA_QK_STEP(3, P0, P1, 3); FA_QK_STEP(4, P0, P1, 3); FA_QK_STEP(5, P0, P1, 3); FA_QK_STEP(6, P0, P1, 3); FA_QK_STEP(7, P0, P1, 3); \
        FA_QK_STEP(8, P0, P1, 3); FA_QK_STEP(9, P0, P1, 3); FA_QK_STEP(10, P0, P1, 3); FA_QK_STEP(11, P0, P1, 3); FA_QK_STEP(12, P0, P1, 3); FA_QK_STEP(13, P0, P1, 2); FA_QK_STEP(14, P0, P1, 1); FA_QK_STEP(15, P0, P1, 0); } while (0)
#define FA_PV_STEP(i, W) do { FA_LGKM(W); FA_SB(); \
        { const bf16x8 vf_ = (bf16x8){vl[(i) & 1][0], vl[(i) & 1][1], vl[(i) & 1][2], vl[(i) & 1][3], vh[(i) & 1][0], vh[(i) & 1][1], vh[(i) & 1][2], vh[(i) & 1][3]}; \
          o[(i) >> 2] = __builtin_amdgcn_mfma_f32_32x32x16_bf16(vf_, pf[(i) & 3], o[(i) >> 2], 0, 0, 0); } \
        FA_SB(); if ((i) + 2 < 16) { FA_DSTR(vl[(i) & 1], va_[((i) + 2) >> 2], (((i) + 2) & 3) * 4096); FA_DSTR(vh[(i) & 1], va_[((i) + 2) >> 2], (((i) + 2) & 3) * 4096 + 2048); } } while (0)
        const int qbL = 15 - ii, nsteps = 17;
#define FA_KB(s_) ((s_) <= qbL ? (s_) : ii - ((s_) - qbL - 1))
        int u = 0, qb = qbL, kb = 0, g = 0;
        FA_ISSUE_K(0, 0); FA_ISSUE_V(0, 0); FA_ISSUE_K(FA_KB(1) * 128, 1);
        bf16x8 qf[8]; f32x16 o[4]; float m = -1e30f, l = 0.f;
        { const bf16_t* qp = Q + (size_t)(b * SEQ + qb * 128 + rg * 32 + r32) * 1024 + h * 128 + 8 * hi;
#pragma unroll
          for (int d0 = 0; d0 < 8; ++d0) qf[d0] = *(const bf16x8*)(qp + 16 * d0); }
#pragma unroll
        for (int db = 0; db < 4; ++db)
#pragma unroll
            for (int r = 0; r < 16; ++r) o[db][r] = 0.f;
        FA_WAITBAR();
        f32x16 p0, p1, n0, n1;
        FA_QK(p0, p1, 0, 0);
        FA_WAITBAR();
        bool diag = false, lastb = false, done = false;
#define FA_SOFTPV(C0, C1) do { \
            if (diag) { const int qrel = rg * 32 + r32, k0 = kh * 64 + 4 * hi; \
                _Pragma("unroll") for (int r = 0; r < 16; ++r) { const int kr = k0 + (r & 3) + 8 * (r >> 2); if (kr > qrel) C0[r] = -INFINITY; if (kr + 32 > qrel) C1[r] = -INFINITY; } } \
            float mx = fmaxf(C0[0], C1[0]); \
            _Pragma("unroll") for (int r = 1; r < 16; ++r) mx = fmaxf(mx, fmaxf(C0[r], C1[r])); \
            mx = swapmax(mx); \
            const float mn = fmaxf(m, mx), alpha = __builtin_amdgcn_exp2f(m - mn); m = mn; \
            float ps = 0.f; \
            _Pragma("unroll") for (int r = 0; r < 16; ++r) { C0[r] = __builtin_amdgcn_exp2f(C0[r] - mn); C1[r] = __builtin_amdgcn_exp2f(C1[r] - mn); ps += C0[r] + C1[r]; } \
            l = l * alpha + ps; \
            if (!__all(alpha == 1.0f)) { \
                _Pragma("unroll") for (int db = 0; db < 4; ++db) _Pragma("unroll") for (int r = 0; r < 16; ++r) o[db][r] *= alpha; } \
            bf16x8 pf[4]; pf[0] = pack8(C0, 0); pf[1] = pack8(C0, 8); pf[2] = pack8(C1, 0); pf[3] = pack8(C1, 8); \
            { unsigned va_[4]; \
              _Pragma("unroll") for (int db = 0; db < 4; ++db) va_[db] = ldsb + (unsigned)(65536 + (g & 1) * 32768 + vfo[db]); \
              v4i16 vl[2], vh[2]; FA_SB(); FA_DSTR(vl[0], va_[0], 0); FA_DSTR(vh[0], va_[0], 2048); FA_DSTR(vl[1], va_[0], 4096); FA_DSTR(vh[1], va_[0], 4096 + 2048); \
              FA_PV_STEP(0, 2); FA_PV_STEP(1, 2); FA_PV_STEP(2, 2); FA_PV_STEP(3, 2); FA_PV_STEP(4, 2); FA_PV_STEP(5, 2); FA_PV_STEP(6, 2); FA_PV_STEP(7, 2); \
              FA_PV_STEP(8, 2); FA_PV_STEP(9, 2); FA_PV_STEP(10, 2); FA_PV_STEP(11, 2); FA_PV_STEP(12, 2); FA_PV_STEP(13, 2); FA_PV_STEP(14, 2); FA_PV_STEP(15, 0); } } while (0)
#define FA_STEP(C0, C1, N0, N1) do { \
            diag = (kb == qb); lastb = (u == 0 ? kb == qb : kb == 0); \
            if (g + 2 < nsteps) FA_ISSUE_K(FA_KB(g + 2) * 128, g & 1); \
            if (g + 1 < nsteps) FA_ISSUE_V(FA_KB(g + 1) * 128, (g + 1) & 1); \
            const int kbn_ = (u == 0 ? kb + 1 : kb - 1); \
            if (kh == 0 && !lastb) FA_QK(N0, N1, (g + 1) & 1, kbn_); \
            FA_SOFTPV(C0, C1); \
            if (kh == 1 && !lastb) FA_QK(N0, N1, (g + 1) & 1, kbn_); \
            FA_WAITBAR(); } while (0)
#define FA_UNIT_END() do { \
            FA_LAS float* mb = (FA_LAS float*)(lds + 65536 + (g & 1) * 32768) + rg * 2048; FA_LAS float* ml = (FA_LAS float*)(lds + LDS_ML) + rg * 128; \
            const float lt = swapsum(l); \
            if (kh == 1) { ml[lane] = m; ml[64 + lane] = lt; } \
            float s1 = 0.f, s2m = 0.f; \
            _Pragma("unroll") for (int half = 0; half < 2; ++half) { \
                if (kh == 1) { \
                    _Pragma("unroll") for (int d2 = 0; d2 < 2; ++d2) _Pragma("unroll") for (int r = 0; r < 16; ++r) mb[(d2 * 16 + r) * 64 + lane] = o[2 * half + d2][r]; } \
                FA_WAITBAR(); \
                if (kh == 0) { \
                    if (half == 0) { const float m2 = ml[lane], l2 = ml[64 + lane], mm = fmaxf(m, m2), a1 = __builtin_amdgcn_exp2f(m - mm), a2 = __builtin_amdgcn_exp2f(m2 - mm); \
                        const float inv = 1.0f / (lt * a1 + l2 * a2); s1 = a1 * inv; s2m = a2 * inv; } \
                    bf16_t* op = MIXIN + (size_t)(b * SEQ + qb * 128 + rg * 32 + r32) * 2048 + 1024 + h * 128 + 4 * hi; \
                    _Pragma("unroll") for (int d2 = 0; d2 < 2; ++d2) _Pragma("unroll") for (int g4 = 0; g4 < 4; ++g4) { float v[4]; \
                        _Pragma("unroll") for (int j = 0; j < 4; ++j) v[j] = o[2 * half + d2][4 * g4 + j] * s1 + mb[(d2 * 16 + 4 * g4 + j) * 64 + lane] * s2m; \
                        u32x2 w; w.x = cvtpk(v[0], v[1]); w.y = cvtpk(v[2], v[3]); *(u32x2*)(op + 32 * (2 * half + d2) + 8 * g4) = w; } } \
                FA_WAITBAR(); } \
            if (u == 1) { done = true; } else { \
                u = 1; qb = ii; kb = ii; ++g; \
                { const bf16_t* qp = Q + (size_t)(b * SEQ + qb * 128 + rg * 32 + r32) * 1024 + h * 128 + 8 * hi; \
                  _Pragma("unroll") for (int d0 = 0; d0 < 8; ++d0) qf[d0] = *(const bf16x8*)(qp + 16 * d0); } \
                _Pragma("unroll") for (int db = 0; db < 4; ++db) _Pragma("unroll") for (int r = 0; r < 16; ++r) o[db][r] = 0.f; \
                m = -1e30f; l = 0.f; \
                FA_QK(p0, p1, g & 1, kb); \
                FA_WAITBAR(); } } while (0)
        for (;;) {
            FA_STEP(p0, p1, n0, n1);
            if (lastb) { FA_UNIT_END(); if (done) break; continue; }
            kb += (u == 0 ? 1 : -1); ++g; p0 = n0; p1 = n1;
        }
#undef FA_SOFTPV
#undef FA_STEP
#undef FA_UNIT_END
#undef FA_ISSUE_K
#undef FA_ISSUE_V
#undef FA_QK
#undef FA_QK_STEP
#undef FA_PV_STEP
#undef FA_KB
    }
}
}

namespace fs {
#define FS_LAS __attribute__((address_space(3)))
__device__ __forceinline__ void sgu_phase(const Args& A, FS_LAS unsigned char* lds) {
    const bf16_t* U = (const bf16_t*)(A.ws + WS_U); const bf16_t* V = (const bf16_t*)(A.ws + WS_V); bf16_t* MIXIN = (bf16_t*)(A.ws + WS_MIXIN);
    const float* wsp = A.in[7]; const float* bsp = A.in[8]; const float* ln_g = A.in[5]; const float* ln_b = A.in[6]; const float* VSTAT = (const float*)(A.ws + WS_VSTAT);
    const int tid = threadIdx.x, lane = tid & 63, wid = __builtin_amdgcn_readfirstlane(tid >> 6), tb = wid & 3, dh = wid >> 2, r32 = lane & 31, hi = lane >> 5;
    const int frow = tid >> 2, fq4 = tid & 3;
    int vfo[2];
    { const int d16 = (lane >> 4) & 1, q = (lane & 15) >> 2, p = lane & 3;
#pragma unroll
      for (int j = 0; j < 2; ++j) vfo[j] = 32768 + (8 * hi + q) * 256 + (((2 * dh + j) ^ q) * 64) + d16 * 32 + p * 8; }
    const int wfo = (32 * tb + r32) * 256;
    for (int u0 = blockIdx.x; u0 < (T / CHUNK) * NG * PROBE_REP_SGU; u0 += gridDim.x) { const int u = u0 % ((T / CHUNK) * NG);
        const int rc = u / NG, g = u % NG, row0 = rc * CHUNK;
        { const float* wr = wsp + ((size_t)g * CHUNK + frow) * CHUNK + fq4 * 32;
#pragma unroll
          for (int c = 0; c < 4; ++c) { const f32x4 a = *(const f32x4*)(wr + 8 * c), b2 = *(const f32x4*)(wr + 8 * c + 4); const int s0 = fq4 * 32 + 8 * c; float v[8] = {a.x, a.y, a.z, a.w, b2.x, b2.y, b2.z, b2.w};
#pragma unroll
              for (int j = 0; j < 8; ++j) if (s0 + j > frow) v[j] = 0.f;
              u32x4 w; w.x = pk2(v[0], v[1]); w.y = pk2(v[2], v[3]); w.z = pk2(v[4], v[5]); w.w = pk2(v[6], v[7]);
              *(FS_LAS u32x4*)(lds + frow * 256 + (((4 * fq4 + c) ^ (frow & 15)) * 16)) = w; }
          const bf16_t* vr = V + (size_t)(row0 + frow) * 1024 + g * 128 + fq4 * 32;
          float mean, rstd;
          { const f32x4 pa = *(const f32x4*)(VSTAT + ((size_t)(row0 + frow) * 16 + 4 * fq4) * 2), pb = *(const f32x4*)(VSTAT + ((size_t)(row0 + frow) * 16 + 4 * fq4) * 2 + 4);
            float s1 = (pa[0] + pa[2]) + (pb[0] + pb[2]), s2 = (pa[1] + pa[3]) + (pb[1] + pb[3]);
            s1 += __shfl_xor(s1, 1); s1 += __shfl_xor(s1, 2); s2 += __shfl_xor(s2, 1); s2 += __shfl_xor(s2, 2);
            mean = s1 * (1.f / 1024.f); rstd = rsqrtf(fmaxf(s2 * (1.f / 1024.f) - mean * mean, 0.f) + EPS); }
#pragma unroll
          for (int c = 0; c < 4; ++c) { const u32x4 w = *(const u32x4*)(vr + 8 * c); const int cb = g * 128 + fq4 * 32 + 8 * c;
              const f32x4 ga = *(const f32x4*)(ln_g + cb), gb = *(const f32x4*)(ln_g + cb + 4), ba = *(const f32x4*)(ln_b + cb), bb = *(const f32x4*)(ln_b + cb + 4);
              float v[8];
#pragma unroll
              for (int e2 = 0; e2 < 4; ++e2) { v[2 * e2] = __uint_as_float(w[e2] << 16); v[2 * e2 + 1] = __uint_as_float(w[e2] & 0xffff0000u); }
              u32x4 o; o.x = pk2((v[0] - mean) * rstd * ga[0] + ba[0], (v[1] - mean) * rstd * ga[1] + ba[1]); o.y = pk2((v[2] - mean) * rstd * ga[2] + ba[2], (v[3] - mean) * rstd * ga[3] + ba[3]);
              o.z = pk2((v[4] - mean) * rstd * gb[0] + bb[0], (v[5] - mean) * rstd * gb[1] + bb[1]); o.w = pk2((v[6] - mean) * rstd * gb[2] + bb[2], (v[7] - mean) * rstd * gb[3] + bb[3]);
              *(FS_LAS u32x4*)(lds + 32768 + frow * 256 + (((4 * fq4 + c) ^ ((frow & 3) << 2)) * 16)) = o; } }
        __syncthreads();
        fa::f32x16 acc[2];
#pragma unroll
        for (int j = 0; j < 2; ++j)
#pragma unroll
            for (int r = 0; r < 16; ++r) acc[j][r] = 0.f;
        for (int s = 0; s <= 2 * tb + 1; ++s) {
            const fa::bf16x8 wf = *(FS_LAS const fa::bf16x8*)(lds + wfo + (((2 * s + hi) ^ (r32 & 15)) * 16));
#pragma unroll
            for (int j = 0; j < 2; ++j) {
                const fa::v4i16 lo = __builtin_amdgcn_ds_read_tr16_b64_v4i16((FS_LAS fa::v4i16*)(lds + vfo[j] + s * 4096));
                const fa::v4i16 hh = __builtin_amdgcn_ds_read_tr16_b64_v4i16((FS_LAS fa::v4i16*)(lds + vfo[j] + s * 4096 + 1024));
                const fa::bf16x8 vf = (fa::bf16x8){lo[0], lo[1], lo[2], lo[3], hh[0], hh[1], hh[2], hh[3]};
                acc[j] = __builtin_amdgcn_mfma_f32_32x32x16_bf16(vf, wf, acc[j], 0, 0, 0); }
        }
        { const int tt = 32 * tb + r32; const float bb = bsp[g * CHUNK + tt]; const size_t rw = (size_t)(row0 + tt);
#pragma unroll
          for (int j = 0; j < 2; ++j)
#pragma unroll
              for (int g4 = 0; g4 < 4; ++g4) { const int d = 32 * (2 * dh + j) + 8 * g4 + 4 * hi; const u32x2 uu = *(const u32x2*)(U + rw * 1024 + g * 128 + d);
                  const float u0 = __uint_as_float(uu.x << 16), u1 = __uint_as_float(uu.x & 0xffff0000u), u2 = __uint_as_float(uu.y << 16), u3 = __uint_as_float(uu.y & 0xffff0000u);
                  u32x2 w; w.x = fa::cvtpk(u0 * (acc[j][4 * g4] + bb), u1 * (acc[j][4 * g4 + 1] + bb)); w.y = fa::cvtpk(u2 * (acc[j][4 * g4 + 2] + bb), u3 * (acc[j][4 * g4 + 3] + bb));
                  *(u32x2*)(MIXIN + rw * 2048 + g * 128 + d) = w; } }
        __syncthreads();
    }
}
}


#define XB_TMO      128
#define XB_XCNT(j)  (256  + 64 * (j))
#define XB_XSUB(j)  (1280 + 64 * (j))
#define XB_XGEN(j)  (2304 + 64 * (j))
#define XB_TOP      3328
#define XB_TOPGEN   3392
#define XCD_BAR_WORDS 3456
#define XB_SPIN_CAP (1u << 18)
#define XLAS __attribute__((address_space(3)))
__device__ __forceinline__ unsigned xb_ld(unsigned* p)              { return __hip_atomic_load(p, __ATOMIC_RELAXED, __HIP_MEMORY_SCOPE_AGENT); }
__device__ __forceinline__ unsigned xb_add(unsigned* p, unsigned v) { return __hip_atomic_fetch_add(p, v, __ATOMIC_RELAXED, __HIP_MEMORY_SCOPE_AGENT); }
__device__ __forceinline__ unsigned xb_xcc_id() { return (unsigned)__builtin_amdgcn_s_getreg((3 << 11) | 20) & 0xFu; }
#define XB_SPIN(cond, bar) do { unsigned _sp = 0; while (cond) { __builtin_amdgcn_s_sleep(1); \
    if ((++_sp & 255u) == 0u) { if (xb_ld(&(bar)[XB_TMO])) break; if (_sp > XB_SPIN_CAP) { atomicAdd(&(bar)[XB_TMO], 1u); break; } } } } while (0)
struct XcdBarrier { unsigned* bar; unsigned x; volatile XLAS unsigned* st; };
__device__ __forceinline__ XcdBarrier xcd_barrier_post(unsigned* bar, volatile XLAS unsigned* st) {
    XcdBarrier b; b.bar = bar; b.x = xb_xcc_id(); b.st = st;
    if (threadIdx.x == 0) (void)xb_add(&bar[XB_XCNT(b.x)], 1u);
    return b;
}
__device__ __forceinline__ void xcd_barrier_complete(unsigned* bar, unsigned x, unsigned& nloc, unsigned& nx) {
    const unsigned G = gridDim.x * gridDim.y * gridDim.z;
    unsigned sum, cnt, mine, sp = 0u;
    for (;;) {
        sum = 0u; cnt = 0u; mine = 0u;
#pragma unroll
        for (unsigned j = 0; j < 16; ++j) { const unsigned c = xb_ld(&bar[XB_XCNT(j)]); sum += c; cnt += (c > 0u) ? 1u : 0u; mine = (j == x) ? c : mine; }
        if (sum == G) break;
        __builtin_amdgcn_s_sleep(1);
        if ((++sp & 255u) == 0u) { if (xb_ld(&bar[XB_TMO])) break; if (sp > XB_SPIN_CAP) { atomicAdd(&bar[XB_TMO], 1u); break; } }
    }
    nloc = mine > 0u ? mine : 1u; nx = cnt > 0u ? cnt : 1u;
}
__device__ __forceinline__ void xcd_barrier(const XcdBarrier& b) {
    asm volatile("s_waitcnt vmcnt(0)" ::: "memory");
    __syncthreads();
    if (threadIdx.x == 0) {
        unsigned* bar = b.bar;
        __builtin_amdgcn_s_waitcnt(0);
        unsigned nloc = b.st[0], nx = b.st[1];
        if (nloc == 0u) { xcd_barrier_complete(bar, b.x, nloc, nx); b.st[0] = nloc; b.st[1] = nx; }
        const unsigned old = xb_add(&bar[XB_XSUB(b.x)], 1u);
        const unsigned gen = old / nloc;
        if (old + 1u == (gen + 1u) * nloc) {
            __builtin_amdgcn_fence(__ATOMIC_RELEASE, "agent");
            asm volatile("s_waitcnt vmcnt(0)" ::: "memory");
            const unsigned og = xb_add(&bar[XB_TOP], 1u);
            const unsigned tg = og / nx;
            if (og + 1u == (tg + 1u) * nx) xb_add(&bar[XB_TOPGEN], 1u);
            else XB_SPIN(xb_ld(&bar[XB_TOPGEN]) == tg, bar);
            __builtin_amdgcn_fence(__ATOMIC_ACQUIRE, "agent");
            xb_add(&bar[XB_XGEN(b.x)], 1u);
            asm volatile("s_waitcnt vmcnt(0)" ::: "memory");
        } else {
            XB_SPIN(xb_ld(&bar[XB_XGEN(b.x)]) == gen, bar);
            __builtin_amdgcn_fence(__ATOMIC_ACQUIRE, "agent");
            asm volatile("s_waitcnt vmcnt(0)" ::: "memory");
        }
    }
    __syncthreads();
}
constexpr int CW_BAR = 4096;
constexpr size_t CTL_ZERO_BYTES = 65536;
constexpr int LDS_BARST_OFF = LDS_BYTES - 16;

constexpr bool FAST_P1 = true, FAST_P3 = true, FAST_P4 = true, FAST_P6 = true, FAST_P7 = true;
constexpr bool FAST_ATTN = true, FAST_SGU = true;
constexpr bool FAST_ANY = FAST_P1 || FAST_P3 || FAST_P4 || FAST_P6 || FAST_P7;
constexpr int N_PHASES = 10;
__global__ void __launch_bounds__(NTHREADS, 2) fwd(Args A) {
    extern __shared__ __attribute__((aligned(16))) unsigned char lds[];
    float* ldsf = (float*)lds;
    const int lo = A.ph_lo, hi = A.ph_hi;
    if (threadIdx.x < 4) ((volatile XLAS unsigned*)((XLAS unsigned char*)lds + LDS_BARST_OFF))[threadIdx.x] = 0u;
    __syncthreads();
    XcdBarrier bar = xcd_barrier_post((unsigned*)(A.ws + WS_CTL) + CW_BAR, (volatile XLAS unsigned*)((XLAS unsigned char*)lds + LDS_BARST_OFF));
#define IN(k) (lo <= (k) && (k) < hi)
#define SEAM(k) do { if (IN(k) && IN((k) + 1)) xcd_barrier(bar); STAMP((k) + 1); } while (0)
    unsigned long long t_lo = 0, t_hi = 0;
#define STAMP(i) do { if (STAMP_PHASE >= 0) { if ((i) == STAMP_PHASE || (STAMP_PHASE == 98 && (i) == 0)) t_lo = __builtin_amdgcn_s_memrealtime(); if ((i) == STAMP_PHASE + 1 || (STAMP_PHASE == 98 && (i) == 9)) t_hi = __builtin_amdgcn_s_memrealtime(); } } while (0)
    STAMP(0);
    PG8_LAS unsigned char* l3 = (PG8_LAS unsigned char*)lds;
    if (IN(0)) { if (FAST_ANY) { p0_weights(A, l3, 0, (int)blockIdx.x, (int)gridDim.x); __syncthreads(); } p0_router_weights(A); p0_rows(A, ldsf); } SEAM(0);
    if (IN(1)) { if (FAST_P1 && FAST_ATTN && (int)blockIdx.x >= (int)gridDim.x - NB * NH) cumsum_bh(A, (int)blockIdx.x - ((int)gridDim.x - NB * NH), ldsf); if (FAST_P1) p1_fast(A, l3); else p1_naive(A, ldsf); if (FAST_ANY) { __syncthreads(); { const int r_ = 1152 % (int)gridDim.x; p0_weights(A, l3, 1, r_ == 0 ? (int)blockIdx.x : (int)blockIdx.x - r_, r_ == 0 ? (int)gridDim.x : (int)gridDim.x - r_); } } } SEAM(1);
    if (!(FAST_P1 && FAST_SGU && FAST_ATTN)) { if (IN(2)) { p1b_fix<0>(A, ldsf); } SEAM(2); }
    if (IN(3)) { if (FAST_SGU) fs::sgu_phase(A, l3); else p2_sgu_naive(A); if (FAST_ATTN) { __syncthreads(); fa::attn_phase(A, l3); } else p2_attn_naive(A, ldsf); } SEAM(3);
    if (IN(4)) { if (FAST_P3) p3_fast(A, l3); else p3_naive(A, ldsf); } SEAM(4);
    if (IN(5)) { if (FAST_P4) p4_fast(A, l3); else p4_naive(A, ldsf); } SEAM(5);
    if (IN(6)) { if (PROBE_ALT == 6) { p5_router3<1>(A, ldsf); __syncthreads(); } if (PROBE_ALT == 62) { p5_router3<2>(A, ldsf); __syncthreads(); } if (PROBE_ALT == 63) { p5_router3<3>(A, ldsf); __syncthreads(); } p5_router3<0>(A, ldsf); } SEAM(6);
    if (IN(7)) { if (FAST_P6) p6_fast(A, l3); else p6_naive(A, ldsf); } SEAM(7);
    if (IN(8)) { if (FAST_P7) p7_fast(A, l3); else p7_naive(A, ldsf); } SEAM(8);
    if (IN(9)) { if (PROBE_ALT == 9) { p8_combine<1>(A, ldsf); __syncthreads(); } p8_combine<0>(A, ldsf, STAMP_PHASE < 0 ? 0.f : (STAMP_PHASE == 99 ? 1.0f : (float)(t_hi - t_lo) * 0.01f * 0.001f * STAMP_SCALE)); }
#undef IN
#undef SEAM
}

#ifndef MK_N_LAUNCHES
#define MK_N_LAUNCHES 1
#endif
extern "C" void kernel_launch(void* const* d_in, const int* in_sizes, int n_in, void* d_out, int out_size, void* d_ws, size_t ws_size, hipStream_t stream) {
    static int grid = 0;
    if (grid == 0) {
        if (n_in != 22 || out_size != T * DM || ws_size < WS_END) { fprintf(stderr, "kernel_launch: unexpected shapes (n_in %d out %d ws %zu)\n", n_in, out_size, ws_size); grid = -1; return; }
        int dev = 0, cus = 0, per_cu = 0;
        hipGetDevice(&dev); hipDeviceGetAttribute(&cus, hipDeviceAttributeMultiprocessorCount, dev);
        hipFuncSetAttribute((const void*)fwd, hipFuncAttributeMaxDynamicSharedMemorySize, LDS_BYTES);
        hipOccupancyMaxActiveBlocksPerMultiprocessor(&per_cu, (const void*)fwd, NTHREADS, LDS_BYTES);
        if (per_cu < 1) { fprintf(stderr, "kernel_launch: occupancy query says %d blocks per CU\n", per_cu); per_cu = 1; }
        (void)hipGetLastError();
        grid = cus;
    }
    if (grid < 0) return;
    Args a{};
    for (int i = 0; i < 22; ++i) a.in[i] = (const float*)d_in[i];
    a.out = (float*)d_out; a.ws = (unsigned char*)d_ws;
    if (hipMemsetAsync((char*)d_ws + WS_CTL, 0, CTL_ZERO_BYTES, stream) != hipSuccess) { fprintf(stderr, "kernel_launch: memset failed\n"); return; }
    if (MK_N_LAUNCHES == 1) {
        a.ph_lo = 0; a.ph_hi = N_PHASES;
        hipLaunchKernelGGL(fwd, dim3(grid), dim3(NTHREADS), LDS_BYTES, stream, a);
    } else {
        for (int p = 0; p < N_PHASES; ++p) { a.ph_lo = p; a.ph_hi = p + 1; hipLaunchKernelGGL(fwd, dim3(grid), dim3(NTHREADS), LDS_BYTES, stream, a); }
    }
}
```

```cpp
#include <hip/hip_runtime.h>
#include <hip/hip_cooperative_groups.h>
#include <cstdio>
#include <cstdint>
namespace cg = cooperative_groups;

#ifndef STAMP_PHASE
#define STAMP_PHASE -1
#endif
#ifndef STAMP_SEL
#define STAMP_SEL 0
#endif
#ifndef STAMP_SCALE
#define STAMP_SCALE 0.5f
#endif
#ifndef PROBE_REP_P1
#define PROBE_REP_P1 1
#endif
#ifndef PROBE_REP_P4
#define PROBE_REP_P4 1
#endif
#ifndef PROBE_REP_P5
#define PROBE_REP_P5 1
#endif
#ifndef PROBE_REP_MOE
#define PROBE_REP_MOE 1
#endif
#ifndef PROBE_REP_ATTN
#define PROBE_REP_ATTN 1
#endif
#ifndef PROBE_REP_SGU
#define PROBE_REP_SGU 1
#endif
#ifndef PROBE_ATTN_VAR
#define PROBE_ATTN_VAR 0
#endif
#ifndef PROBE_ALT
#define PROBE_ALT -1
#endif
constexpr int T = 8192, SEQ = 2048, NB = 4, DM = 2048, SGUW = 1024, FOXW = 1024, NH = 8, HD = 128, CHUNK = 128, NG = 8;
constexpr int INCOLS = 9224, OFF_F = 5120, OFF_GATE = 5128;
constexpr int NEXP = 32, EPG = 8, NGRP = 4, DEXP = 512;
constexpr float EPS = 1e-6f;
constexpr float LOG2E = 1.4426950408889634f;
constexpr float QSCALE = 0.08838834764831845f * LOG2E;
constexpr int NTHREADS = 512, NWAVES = 8;
constexpr int LDS_BYTES = 160 * 1024;
constexpr int MTILE = 256;
constexpr int PMAX = 2 * T + NEXP * MTILE;
constexpr int MT_MAX = PMAX / MTILE;
constexpr bool XCDM_GU = true;
constexpr int TINY_ROWS = 0;

typedef unsigned short bf16_t;
typedef float f32x4 __attribute__((ext_vector_type(4)));
typedef unsigned u32x4 __attribute__((ext_vector_type(4)));
typedef unsigned u32x2 __attribute__((ext_vector_type(2)));

constexpr size_t MiB = 1u << 20;
constexpr size_t WS_CTL = 0;
constexpr size_t WS_LOGF = 1 * MiB;
constexpr size_t WS_CKL = 2 * MiB;
constexpr size_t WS_TOK = 3 * MiB;
constexpr size_t WS_GATE = 4 * MiB;
constexpr size_t WS_ASG = 5 * MiB;
constexpr size_t WS_WIN = 8 * MiB;
constexpr size_t WS_WPROJ = 44 * MiB;
constexpr size_t WS_WOUT = 52 * MiB;
constexpr size_t WS_WGU = 60 * MiB;
constexpr size_t WS_WD = 188 * MiB;
constexpr size_t WS_H = 252 * MiB;
constexpr size_t WS_MIXED = WS_H;
constexpr size_t WS_U = 284 * MiB;
constexpr size_t WS_V = 300 * MiB;
constexpr size_t WS_G = 316 * MiB;
constexpr size_t WS_YBUF = WS_U;
constexpr size_t WS_Q = 380 * MiB;
constexpr size_t WS_K = 396 * MiB;
constexpr size_t WS_VA = 412 * MiB;
constexpr size_t WS_ACT = WS_Q;
constexpr size_t WS_MIXIN = 428 * MiB;
constexpr size_t WS_H2 = WS_MIXIN;
constexpr size_t WS_END = 460 * MiB;
static_assert((size_t)PMAX * 2048 * 2 <= 96 * MiB && (size_t)PMAX * 512 * 2 <= 32 * MiB, "overlay sizes");

constexpr int CW_CNT = 0;
constexpr int CNT_STRIDE = 64;

__device__ __forceinline__ float bf2f(bf16_t v) { return __uint_as_float((unsigned)v << 16); }
__device__ __forceinline__ bf16_t f2bf(float f) { unsigned u = __float_as_uint(f); return (bf16_t)((u + 0x7fffu + ((u >> 16) & 1u)) >> 16); }
__device__ __forceinline__ unsigned pk2(float lo, float hi) { return (unsigned)f2bf(lo) | ((unsigned)f2bf(hi) << 16); }
__device__ __forceinline__ unsigned cvtpk_rne(float lo, float hi) { unsigned r; asm("v_cvt_pk_bf16_f32 %0, %1, %2" : "=v"(r) : "v"(lo), "v"(hi)); return r; }
__device__ __forceinline__ float wave_sum(float v) {
#pragma unroll
    for (int o = 1; o < 64; o <<= 1) v += __shfl_xor(v, o);
    return v;
}
__device__ __forceinline__ float wave_max(float v) {
#pragma unroll
    for (int o = 1; o < 64; o <<= 1) v = fmaxf(v, __shfl_xor(v, o));
    return v;
}
__device__ __forceinline__ float gelu_tanh(float x) {
    const float c = 0.7978845608028654f; const float y = c * (x + 0.044715f * x * x * x);
    return x / (1.0f + __expf(-2.0f * y));
}
__device__ __forceinline__ float sigmoidf_(float x) { return 1.0f / (1.0f + __expf(-x)); }
__device__ __forceinline__ float log_sigmoid(float z) { return fminf(z, 0.f) - log1pf(__expf(-fabsf(z))); }

struct Args {
    const float* in[22];
    float* out;
    unsigned char* ws;
    int ph_lo, ph_hi;
};

template <class AF, class BF, class EF>
__device__ __forceinline__ void naive_gemm_tile(float* lds, int m0, int n0, int M, int N, int K, int Ksplit, AF a, BF b, EF epi) {
    float* As = lds;
    float* Bs = lds + 16 * 132;
    const int tid = threadIdx.x, ty = tid >> 4, tx = tid & 15;
    float acc[4][8], acc1[4][8];
#pragma unroll
    for (int i = 0; i < 4; ++i)
#pragma unroll
        for (int j = 0; j < 8; ++j) { acc[i][j] = 0.f; acc1[i][j] = 0.f; }
    const bool split = Ksplit < K;
#pragma unroll 1
    for (int pass = 0; pass < 2; ++pass) {
        const int kb = pass == 0 ? 0 : Ksplit, ke = pass == 0 ? (split ? Ksplit : K) : K;
        if (pass == 1) {
            if (!split) break;
#pragma unroll
            for (int i = 0; i < 4; ++i)
#pragma unroll
                for (int j = 0; j < 8; ++j) { acc1[i][j] = acc[i][j]; acc[i][j] = 0.f; }
        }
#pragma unroll 1
        for (int k0 = kb; k0 < ke; k0 += 16) {
#pragma unroll
            for (int i = 0; i < 4; ++i) { const int idx = tid + i * 512, r = idx >> 4, kk = idx & 15; const int m = m0 + r; As[kk * 132 + r] = (m < M) ? a(m, k0 + kk) : 0.f; }
#pragma unroll
            for (int i = 0; i < 4; ++i) { const int idx = tid + i * 512, kk = idx >> 7, n = idx & 127; Bs[kk * 132 + n] = (n0 + n < N) ? b(k0 + kk, n0 + n) : 0.f; }
            __syncthreads();
#pragma unroll 4
            for (int kk = 0; kk < 16; ++kk) {
                float av[4], bv[8];
#pragma unroll
                for (int i = 0; i < 4; ++i) av[i] = As[kk * 132 + ty * 4 + i];
#pragma unroll
                for (int j = 0; j < 8; ++j) bv[j] = Bs[kk * 132 + tx * 8 + j];
#pragma unroll
                for (int i = 0; i < 4; ++i)
#pragma unroll
                    for (int j = 0; j < 8; ++j) acc[i][j] = fmaf(av[i], bv[j], acc[i][j]);
            }
            __syncthreads();
        }
    }
#pragma unroll
    for (int i = 0; i < 4; ++i)
#pragma unroll
        for (int j = 0; j < 8; ++j) { const int m = m0 + ty * 4 + i, n = n0 + tx * 8 + j; if (m < M && n < N) epi(m, n, split ? acc1[i][j] : acc[i][j], split ? acc[i][j] : 0.f); }
}
template <class AF, class BF, class EF>
__device__ __forceinline__ void naive_gemm(float* lds, int M, int N, int K, int Ksplit, AF a, BF b, EF epi) {
    const int ntm = (M + 127) / 128, ntn = (N + 127) / 128;
    for (int t = blockIdx.x; t < ntm * ntn; t += gridDim.x) naive_gemm_tile(lds, (t / ntn) * 128, (t % ntn) * 128, M, N, K, Ksplit, a, b, epi);
}

__device__ __forceinline__ void p0_rows(const Args& A, float* ldsf) {
    const float* x = A.in[0]; const float* g1 = A.in[1]; const float* w_in = A.in[2]; const float* b_forget = A.in[4];
    bf16_t* H = (bf16_t*)(A.ws + WS_H); float* LOGF = (float*)(A.ws + WS_LOGF);
    const int tid = threadIdx.x, lane = tid & 63, wave = tid >> 6;
    for (int i = tid; i < DM * 8; i += NTHREADS) ldsf[i] = w_in[(size_t)(i >> 3) * INCOLS + OFF_F + (i & 7)];
    __syncthreads();
    const int gw = blockIdx.x * NWAVES + wave, NGW = gridDim.x * NWAVES;
    for (int row = gw; row < T; row += NGW) {
        const f32x4* xr = (const f32x4*)(x + (size_t)row * DM) + lane;
        f32x4 xv[8]; float ss = 0.f;
#pragma unroll
        for (int j = 0; j < 8; ++j) xv[j] = xr[64 * j];
#pragma unroll
        for (int j = 0; j < 8; ++j) ss += xv[j].x * xv[j].x + xv[j].y * xv[j].y + xv[j].z * xv[j].z + xv[j].w * xv[j].w;
        const float rstd = rsqrtf(wave_sum(ss) * (1.f / DM) + EPS);
        float f[8];
#pragma unroll
        for (int h = 0; h < 8; ++h) f[h] = 0.f;
#pragma unroll
        for (int j = 0; j < 8; ++j) {
            const int c0 = 256 * j + 4 * lane; const f32x4 g = *(const f32x4*)(g1 + c0);
            f32x4 hv; hv.x = xv[j].x * rstd * g.x; hv.y = xv[j].y * rstd * g.y; hv.z = xv[j].z * rstd * g.z; hv.w = xv[j].w * rstd * g.w;
            u32x2 o; o.x = pk2(hv.x, hv.y); o.y = pk2(hv.z, hv.w);
            *(u32x2*)(H + (size_t)row * DM + c0) = o;
#pragma unroll
            for (int e = 0; e < 4; ++e) { const float hx = hv[e]; const float* wf = ldsf + (c0 + e) * 8;
#pragma unroll
                for (int h = 0; h < 8; ++h) f[h] = fmaf(hx, wf[h], f[h]); }
            asm volatile("" ::: "memory");
        }
#pragma unroll
        for (int h = 0; h < 8; ++h) f[h] = wave_sum(f[h]);
        if (lane < 8) { float z = 0.f;
#pragma unroll
            for (int h = 0; h < 8; ++h) if (lane == h) z = f[h];
            LOGF[(size_t)row * 8 + lane] = log_sigmoid(z + b_forget[lane]); }
    }
}

__device__ __forceinline__ void p1_naive(const Args& A, float* ldsf) {
    const bf16_t* H = (const bf16_t*)(A.ws + WS_H); const float* w_in = A.in[2]; const float* b_gate = A.in[3];
    bf16_t* U = (bf16_t*)(A.ws + WS_U); bf16_t* V = (bf16_t*)(A.ws + WS_V); bf16_t* Q = (bf16_t*)(A.ws + WS_Q); bf16_t* K = (bf16_t*)(A.ws + WS_K);
    bf16_t* VA = (bf16_t*)(A.ws + WS_VA); bf16_t* G = (bf16_t*)(A.ws + WS_G);
    naive_gemm(ldsf, T, 9216, DM, DM,
        [=](int m, int k) { return bf2f(H[(size_t)m * DM + k]); },
        [=](int k, int n) { const int c = n < 5120 ? n : n + 8; return w_in[(size_t)k * INCOLS + c]; },
        [=](int m, int n, float s, float) {
            if (n < 1024) U[(size_t)m * 1024 + n] = f2bf(gelu_tanh(s));
            else if (n < 2048) V[(size_t)m * 1024 + n - 1024] = f2bf(gelu_tanh(s));
            else if (n < 3072) Q[(size_t)m * 1024 + n - 2048] = f2bf(s);
            else if (n < 4096) K[(size_t)m * 1024 + n - 3072] = f2bf(s);
            else if (n < 5120) VA[(size_t)m * 1024 + n - 4096] = f2bf(s);
            else G[(size_t)m * 4096 + n - 5120] = f2bf(sigmoidf_(s + b_gate[n - 5120]));
        });
}

template <int ALT> __device__ __forceinline__ void p1b_fix(const Args& A, float* ldsf) {
    bf16_t* V = (bf16_t*)(A.ws + WS_V); bf16_t* Q = (bf16_t*)(A.ws + WS_Q); bf16_t* K = (bf16_t*)(A.ws + WS_K);
    const size_t altoff = ALT ? ((size_t)((unsigned char*)A.out - (A.ws + WS_V))) / 2 : 0;
    const size_t altq = ALT ? ((size_t)((unsigned char*)A.out + 16 * MiB - (A.ws + WS_Q))) / 2 : 0, altk = ALT ? ((size_t)((unsigned char*)A.out + 32 * MiB - (A.ws + WS_K))) / 2 : 0;
    const float* ln_g = A.in[5]; const float* ln_b = A.in[6]; const float* qg = A.in[9]; const float* kg = A.in[10];
    const int tid = threadIdx.x, lane = tid & 63, wave = tid >> 6;
    const int gw = blockIdx.x * NWAVES + wave, NGW = gridDim.x * NWAVES;
    for (int row = gw; row < T; row += NGW) {
        {
            bf16_t* vr = V + (size_t)row * 1024; float v[16]; float s = 0.f;
#pragma unroll
            for (int j = 0; j < 2; ++j) { const u32x4 w = *(const u32x4*)(vr + 512 * j + 8 * lane);
#pragma unroll
                for (int e = 0; e < 4; ++e) { v[8 * j + 2 * e] = __uint_as_float(w[e] << 16); v[8 * j + 2 * e + 1] = __uint_as_float(w[e] & 0xffff0000u); } }
#pragma unroll
            for (int i = 0; i < 16; ++i) s += v[i];
            const float mean = wave_sum(s) * (1.f / 1024.f); float q = 0.f;
#pragma unroll
            for (int i = 0; i < 16; ++i) { v[i] -= mean; q += v[i] * v[i]; }
            const float rstd = rsqrtf(wave_sum(q) * (1.f / 1024.f) + EPS);
#pragma unroll
            for (int j = 0; j < 2; ++j) { const int c0 = 512 * j + 8 * lane; u32x4 o;
#pragma unroll
                for (int e = 0; e < 4; ++e) o[e] = pk2(v[8 * j + 2 * e] * rstd * ln_g[c0 + 2 * e] + ln_b[c0 + 2 * e], v[8 * j + 2 * e + 1] * rstd * ln_g[c0 + 2 * e + 1] + ln_b[c0 + 2 * e + 1]);
                *(u32x4*)(vr + altoff + c0) = o; }
        }
#pragma unroll
        for (int which = 0; which < 2; ++which) {
            bf16_t* pr = (which == 0 ? Q : K) + (size_t)row * 1024 + 16 * lane; const float* gg = which == 0 ? qg : kg; float v[16]; float s = 0.f;
#pragma unroll
            for (int j = 0; j < 2; ++j) { const u32x4 w = *(const u32x4*)(pr + 8 * j);
#pragma unroll
                for (int e = 0; e < 4; ++e) { v[8 * j + 2 * e] = __uint_as_float(w[e] << 16); v[8 * j + 2 * e + 1] = __uint_as_float(w[e] & 0xffff0000u); } }
#pragma unroll
            for (int i = 0; i < 16; ++i) s += v[i] * v[i];
            s += __shfl_xor(s, 1); s += __shfl_xor(s, 2); s += __shfl_xor(s, 4);
            const float sc = rsqrtf(s * (1.f / 128.f) + EPS) * (which == 0 ? QSCALE : 1.f); const int d0 = (16 * lane) & 127;
#pragma unroll
            for (int j = 0; j < 2; ++j) { u32x4 o;
#pragma unroll
                for (int e = 0; e < 4; ++e) o[e] = pk2(v[8 * j + 2 * e] * sc * gg[d0 + 8 * j + 2 * e], v[8 * j + 2 * e + 1] * sc * gg[d0 + 8 * j + 2 * e + 1]);
                *(u32x4*)(pr + (which == 0 ? altq : altk) + 8 * j) = o; }
        }
    }
    if (blockIdx.x < NB * NH) {
        const int b = blockIdx.x / NH, h = blockIdx.x % NH; const float* LOGF = (const float*)(A.ws + WS_LOGF); float* CKL = (float*)(A.ws + WS_CKL) + (size_t)blockIdx.x * SEQ + (ALT ? 65536 : 0);
        float v[4]; float s = 0.f;
#pragma unroll
        for (int i = 0; i < 4; ++i) { v[i] = LOGF[(size_t)(b * SEQ + tid * 4 + i) * 8 + h]; s += v[i]; }
        float incl = s;
#pragma unroll
        for (int o = 1; o < 64; o <<= 1) { const float t = __shfl_up(incl, o); if (lane >= o) incl += t; }
        __syncthreads();
        if (lane == 63) ldsf[wave] = incl;
        __syncthreads();
        float base = 0.f;
        for (int w = 0; w < wave; ++w) base += ldsf[w];
        float run = base + incl - s;
#pragma unroll
        for (int i = 0; i < 4; ++i) { run += v[i]; CKL[tid * 4 + i] = run * LOG2E; }
        __syncthreads();
    }
}


__device__ __forceinline__ void cumsum_bh(const Args& A, int bh, float* ldsf) {
    const int tid = threadIdx.x, lane = tid & 63, wave = tid >> 6, b = bh / NH, h = bh % NH;
    const float* LOGF = (const float*)(A.ws + WS_LOGF); float* CKL = (float*)(A.ws + WS_CKL) + (size_t)bh * SEQ;
    float v[4]; float sm = 0.f;
#pragma unroll
    for (int i = 0; i < 4; ++i) { v[i] = LOGF[(size_t)(b * SEQ + tid * 4 + i) * 8 + h]; sm += v[i]; }
    float incl = sm;
#pragma unroll
    for (int o = 1; o < 64; o <<= 1) { const float t = __shfl_up(incl, o); if (lane >= o) incl += t; }
    if (lane == 63) ldsf[wave] = incl;
    __syncthreads();
    float run = incl - sm;
    for (int w = 0; w < wave; ++w) run += ldsf[w];
    f32x4 o4;
#pragma unroll
    for (int i = 0; i < 4; ++i) { run += v[i]; o4[i] = run * LOG2E; }
    *(f32x4*)(CKL + tid * 4) = o4;
    __syncthreads();
}

__device__ __forceinline__ void p2_sgu_naive(const Args& A) {
    const bf16_t* U = (const bf16_t*)(A.ws + WS_U); const bf16_t* V = (const bf16_t*)(A.ws + WS_V); bf16_t* MIXIN = (bf16_t*)(A.ws + WS_MIXIN);
    const float* wsp = A.in[7]; const float* bsp = A.in[8];
    const int tid = threadIdx.x, tt = tid >> 2, dp = tid & 3;
    for (int u = blockIdx.x; u < (T / CHUNK) * NG; u += gridDim.x) {
        const int rc = u / NG, g = u % NG; const int row0 = rc * CHUNK;
        float acc[32];
#pragma unroll
        for (int i = 0; i < 32; ++i) acc[i] = 0.f;
        for (int ss = 0; ss <= tt; ++ss) {
            const float w = wsp[((size_t)g * CHUNK + tt) * CHUNK + ss];
            const bf16_t* vr = V + (size_t)(row0 + ss) * 1024 + g * 128 + dp * 32;
#pragma unroll
            for (int i = 0; i < 32; ++i) acc[i] = fmaf(w, bf2f(vr[i]), acc[i]);
        }
        const float bb = bsp[g * CHUNK + tt];
        const bf16_t* ur = U + (size_t)(row0 + tt) * 1024 + g * 128 + dp * 32; bf16_t* orow = MIXIN + (size_t)(row0 + tt) * 2048 + g * 128 + dp * 32;
#pragma unroll
        for (int i = 0; i < 32; ++i) orow[i] = f2bf(bf2f(ur[i]) * (acc[i] + bb));
    }
}
__device__ __forceinline__ void p2_attn_naive(const Args& A, float* ldsf) {
    const bf16_t* Q = (const bf16_t*)(A.ws + WS_Q); const bf16_t* K = (const bf16_t*)(A.ws + WS_K); const bf16_t* VA = (const bf16_t*)(A.ws + WS_VA);
    const float* CKL = (const float*)(A.ws + WS_CKL); bf16_t* MIXIN = (bf16_t*)(A.ws + WS_MIXIN);
    const int tid = threadIdx.x, lane = tid & 63, wave = tid >> 6;
    float* qs = ldsf + wave * 128;
    const int gw = blockIdx.x * NWAVES + wave, NGW = gridDim.x * NWAVES;
    for (int item = gw; item < T * NH; item += NGW) {
        const int row = item / NH, h = item % NH, b = row / SEQ, t = row % SEQ;
        const bf16_t* qr = Q + (size_t)row * 1024 + h * 128;
        qs[lane] = bf2f(qr[lane]); qs[64 + lane] = bf2f(qr[64 + lane]);
        __builtin_amdgcn_s_waitcnt(0);
        const float* ck = CKL + (size_t)(b * NH + h) * SEQ;
        float m = -1e30f, l = 0.f, o0 = 0.f, o1 = 0.f;
        for (int s0 = 0; s0 <= t; s0 += 64) {
            const int s = s0 + lane; float sc = -INFINITY;
            if (s <= t) { const bf16_t* kr = K + (size_t)(b * SEQ + s) * 1024 + h * 128; float d = 0.f;
                for (int c = 0; c < 16; ++c) { const u32x4 w = *(const u32x4*)(kr + 8 * c);
#pragma unroll
                    for (int e = 0; e < 4; ++e) { d = fmaf(qs[8 * c + 2 * e], __uint_as_float(w[e] << 16), d); d = fmaf(qs[8 * c + 2 * e + 1], __uint_as_float(w[e] & 0xffff0000u), d); } }
                sc = d - ck[s]; }
            const float mn = fmaxf(m, wave_max(sc)); const float alpha = exp2f(m - mn); const float p = exp2f(sc - mn);
            l = l * alpha + wave_sum(p); o0 *= alpha; o1 *= alpha; m = mn;
            const int nk = min(64, t - s0 + 1);
            for (int j = 0; j < nk; ++j) { const float pj = __shfl(p, j); const unsigned w = *(const unsigned*)(VA + (size_t)(b * SEQ + s0 + j) * 1024 + h * 128 + 2 * lane);
                o0 = fmaf(pj, __uint_as_float(w << 16), o0); o1 = fmaf(pj, __uint_as_float(w & 0xffff0000u), o1); }
        }
        const float il = 1.f / l;
        *(unsigned*)(MIXIN + (size_t)row * 2048 + 1024 + h * 128 + 2 * lane) = pk2(o0 * il, o1 * il);
    }
}

__device__ __forceinline__ void p3_naive(const Args& A, float* ldsf) {
    const bf16_t* MIXIN = (const bf16_t*)(A.ws + WS_MIXIN); const bf16_t* G = (const bf16_t*)(A.ws + WS_G); bf16_t* MIXED = (bf16_t*)(A.ws + WS_MIXED);
    const float* wps = A.in[11]; const float* wpf = A.in[12];
    naive_gemm(ldsf, T, DM, 2048, 1024,
        [=](int m, int k) { return bf2f(MIXIN[(size_t)m * 2048 + k]); },
        [=](int k, int n) { return k < 1024 ? wps[(size_t)k * DM + n] : wpf[(size_t)(k - 1024) * DM + n]; },
        [=](int m, int n, float s1, float s2) { MIXED[(size_t)m * DM + n] = f2bf(bf2f(G[(size_t)m * 4096 + n]) * s1 + bf2f(G[(size_t)m * 4096 + 2048 + n]) * s2); });
}
__device__ __forceinline__ void p4_naive(const Args& A, float* ldsf) {
    const bf16_t* MIXED = (const bf16_t*)(A.ws + WS_MIXED); const float* wo = A.in[13]; const float* x = A.in[0]; float* X1 = A.out;
    naive_gemm(ldsf, T, DM, DM, DM,
        [=](int m, int k) { return bf2f(MIXED[(size_t)m * DM + k]); },
        [=](int k, int n) { return wo[(size_t)k * DM + n]; },
        [=](int m, int n, float s, float) { X1[(size_t)m * DM + n] = x[(size_t)m * DM + n] + s; });
}

template <int ALT> __device__ __forceinline__ void p5_router(const Args& A, float* ldsf) {
    const float* X1 = A.out; const float* g2 = A.in[14]; const float* wrg = A.in[15]; const float* brg = A.in[16]; const float* wre = A.in[17]; const float* bre = A.in[18];
    bf16_t* H2 = (bf16_t*)(A.ws + WS_H2); unsigned* cnt = (unsigned*)(A.ws + WS_CTL) + CW_CNT + (ALT ? 2048 : 0);
    int* TOK = (int*)(A.ws + (ALT ? WS_H : WS_TOK)); float* GATE = (float*)(A.ws + (ALT ? WS_H + 2 * MiB : WS_GATE)); int* ASG = (int*)(A.ws + (ALT ? WS_H + 4 * MiB : WS_ASG));
    const int tid = threadIdx.x, lane = tid & 63, wave = tid >> 6, r = tid >> 4, ks = tid & 15;
    float* Ws = ldsf;
    float* Xs = ldsf + 256 * 36;
    float* rs = Xs + 32 * 260;
    int* hist = (int*)(rs + 32);
    int* hbase = hist + 32;
    int* sel = hbase + 32;
    int* lpos = sel + 64;
    float* selw = (float*)(lpos + 64);
    for (int rb = blockIdx.x; rb < T / 32; rb += gridDim.x) {
        const int row0 = rb * 32;
        for (int i = 0; i < 4; ++i) { const int rr = wave * 4 + i; const f32x4* xr = (const f32x4*)(X1 + (size_t)(row0 + rr) * DM) + lane; float ss = 0.f;
#pragma unroll
            for (int j = 0; j < 8; ++j) { const f32x4 v = xr[64 * j]; ss += v.x * v.x + v.y * v.y + v.z * v.z + v.w * v.w; }
            ss = wave_sum(ss); if (lane == 0) rs[rr] = rsqrtf(ss * (1.f / DM) + EPS); }
        if (tid < 32) hist[tid] = 0;
        __syncthreads();
        float acc[36];
#pragma unroll
        for (int j = 0; j < 36; ++j) acc[j] = 0.f;
        for (int k0 = 0; k0 < DM; k0 += 256) {
            for (int i = tid; i < 256 * 36; i += NTHREADS) { const int kk = i / 36, j = i % 36; Ws[i] = j < 4 ? wrg[(size_t)(k0 + kk) * 4 + j] : wre[(size_t)(k0 + kk) * 32 + j - 4]; }
            for (int i = tid; i < 32 * 256; i += NTHREADS) { const int rr = i >> 8, kk = i & 255; const float hv = X1[(size_t)(row0 + rr) * DM + k0 + kk] * rs[rr] * g2[k0 + kk];
                Xs[rr * 260 + kk] = hv; H2[(size_t)(row0 + rr) * DM + k0 + kk] = f2bf(hv); }
            __syncthreads();
            for (int kk = ks; kk < 256; kk += 16) { const float xv = Xs[r * 260 + kk]; const float* wr = Ws + kk * 36;
#pragma unroll
                for (int j = 0; j < 36; ++j) acc[j] = fmaf(xv, wr[j], acc[j]); }
            __syncthreads();
        }
#pragma unroll
        for (int j = 0; j < 36; ++j) { float v = acc[j]; v += __shfl_xor(v, 1); v += __shfl_xor(v, 2); v += __shfl_xor(v, 4); v += __shfl_xor(v, 8); acc[j] = v; }
        if (ks == 0) {
            float gl[4]; int grp = 0; float gm;
#pragma unroll
            for (int j = 0; j < 4; ++j) gl[j] = acc[j] + brg[j];
            gm = gl[0];
#pragma unroll
            for (int j = 1; j < 4; ++j) if (gl[j] > gm) { gm = gl[j]; grp = j; }
            float den = 0.f;
#pragma unroll
            for (int j = 0; j < 4; ++j) den += __expf(gl[j] - gm);
            const float pg = 1.f / den;
            float el[8];
#pragma unroll
            for (int j = 0; j < 8; ++j) { float v = 0.f;
#pragma unroll
                for (int g = 0; g < 4; ++g) if (g == grp) v = acc[4 + g * 8 + j] + bre[g * 8 + j];
                el[j] = v; }
            int i0 = 0; float v0 = el[0];
#pragma unroll
            for (int j = 1; j < 8; ++j) if (el[j] > v0) { v0 = el[j]; i0 = j; }
            int i1 = -1; float v1 = -INFINITY;
#pragma unroll
            for (int j = 0; j < 8; ++j) if (j != i0 && el[j] > v1) { v1 = el[j]; i1 = j; }
            const float e1 = __expf(v1 - v0); const float w0 = pg / (1.f + e1), w1 = pg * e1 / (1.f + e1);
            const int ea = grp * 8 + i0, eb = grp * 8 + i1;
            sel[r * 2] = ea; sel[r * 2 + 1] = eb; selw[r * 2] = w0; selw[r * 2 + 1] = w1;
            lpos[r * 2] = atomicAdd(&hist[ea], 1); lpos[r * 2 + 1] = atomicAdd(&hist[eb], 1);
        }
        __syncthreads();
        if (tid < 32) hbase[tid] = hist[tid] > 0 ? (int)atomicAdd(&cnt[(tid) * CNT_STRIDE], (unsigned)hist[tid]) : 0;
        __syncthreads();
        if (tid < 64) { const int e = sel[tid], pos = hbase[e] + lpos[tid]; const int tok = row0 + (tid >> 1);
            TOK[(size_t)e * T + pos] = tok; GATE[(size_t)e * T + pos] = selw[tid]; ASG[tok * 2 + (tid & 1)] = (e << 16) | pos; }
        __syncthreads();
    }
}

template <int ALT> __device__ __forceinline__ void p5_router2(const Args& A, float* ldsf) {
    const float* X1 = A.out; const float* g2 = A.in[14]; const float* wrg = A.in[15]; const float* brg = A.in[16]; const float* wre = A.in[17]; const float* bre = A.in[18];
    bf16_t* H2 = (bf16_t*)(A.ws + WS_H2); unsigned* cnt = (unsigned*)(A.ws + WS_CTL) + CW_CNT + (ALT ? 2048 : 0);
    int* TOK = (int*)(A.ws + (ALT ? WS_H : WS_TOK)); float* GATE = (float*)(A.ws + (ALT ? WS_H + 2 * MiB : WS_GATE)); int* ASG = (int*)(A.ws + (ALT ? WS_H + 4 * MiB : WS_ASG));
    const int tid = threadIdx.x, lane = tid & 63, wave = tid >> 6;
    constexpr int XP = 260, XB = 32 * XP, WP = 40, WB = 256 * WP;
    float* Xs = ldsf;
    float* Ws = ldsf + 2 * XB;
    float* misc = ldsf + 2 * XB + 2 * WB;
    float* rs = misc;
    float* lg = misc + 32;
    int* hist = (int*)(misc + 32 + 1280); int* hbase = hist + 32; int* sel = hbase + 32; int* lpos = sel + 64; float* selw = (float*)(lpos + 64);
    const int kh2 = lane >> 5, rp = (lane >> 1) & 15, cg = lane & 1;
    for (int rb = blockIdx.x; rb < T / 32; rb += gridDim.x) {
        const int row0 = rb * 32;
        float ssq[4] = {0.f, 0.f, 0.f, 0.f};
        float acc0[20], acc1[20];
#pragma unroll
        for (int j = 0; j < 20; ++j) { acc0[j] = 0.f; acc1[j] = 0.f; }
        if (tid < 32) hist[tid] = 0;
        f32x4 xr[4], wv[5], gv;
        for (int i = tid; i < 2 * 256; i += NTHREADS) *(f32x4*)(Ws + (i >> 8) * WB + (i & 255) * WP + 36) = (f32x4){0.f, 0.f, 0.f, 0.f};
#define R2_LOAD(k0) do { gv = *(const f32x4*)(g2 + (k0) + 4 * (tid & 63)); \
        _Pragma("unroll") for (int i = 0; i < 4; ++i) xr[i] = *(const f32x4*)(X1 + (size_t)(row0 + wave + 8 * i) * DM + (k0) + 4 * (tid & 63)); \
        _Pragma("unroll") for (int i = 0; i < 5; ++i) { const int idx = tid + i * 512; if (idx < 2304) { const int kk = idx / 9, j4 = idx - kk * 9; \
            wv[i] = j4 == 0 ? *(const f32x4*)(wrg + (size_t)((k0) + kk) * 4) : *(const f32x4*)(wre + (size_t)((k0) + kk) * 32 + 4 * (j4 - 1)); } } } while (0)
#define R2_STORE(buf) do { \
        _Pragma("unroll") for (int i = 0; i < 4; ++i) { ssq[i] += xr[i].x * xr[i].x + xr[i].y * xr[i].y + xr[i].z * xr[i].z + xr[i].w * xr[i].w; \
            *(f32x4*)(Xs + (buf) * XB + (wave + 8 * i) * XP + 4 * (tid & 63)) = xr[i] * gv; } \
        _Pragma("unroll") for (int i = 0; i < 5; ++i) { const int idx = tid + i * 512; if (idx < 2304) { const int kk = idx / 9, j4 = idx - kk * 9; *(f32x4*)(Ws + (buf) * WB + kk * WP + 4 * j4) = wv[i]; } } } while (0)
        R2_LOAD(0); R2_STORE(0);
        __syncthreads();
#pragma unroll 1
        for (int c = 0; c < 8; ++c) {
            const int buf = c & 1;
            if (c < 7) R2_LOAD((c + 1) * 256);
            const float* xa = Xs + buf * XB + (2 * rp) * XP + (wave * 2 + kh2) * 16; const float* wa = Ws + buf * WB + ((wave * 2 + kh2) * 16) * WP + 20 * cg;
#pragma unroll 1
            for (int k4 = 0; k4 < 4; ++k4) {
                const f32x4 x0 = *(const f32x4*)(xa + 4 * k4), x1 = *(const f32x4*)(xa + XP + 4 * k4);
#pragma unroll
                for (int kk = 0; kk < 4; ++kk) { const float* wr = wa + (4 * k4 + kk) * WP;
#pragma unroll
                    for (int j4 = 0; j4 < 5; ++j4) { const f32x4 w = *(const f32x4*)(wr + 4 * j4);
#pragma unroll
                        for (int e = 0; e < 4; ++e) { acc0[4 * j4 + e] = fmaf(x0[kk], w[e], acc0[4 * j4 + e]); acc1[4 * j4 + e] = fmaf(x1[kk], w[e], acc1[4 * j4 + e]); } }
                    asm volatile("" ::: "memory"); }
            }
            if (c < 7) R2_STORE(buf ^ 1);
            __syncthreads();
        }
#undef R2_LOAD
#undef R2_STORE
#pragma unroll
        for (int j = 0; j < 20; ++j) { acc0[j] += __shfl_xor(acc0[j], 32); acc1[j] += __shfl_xor(acc1[j], 32); }
        float* red = Xs;
        if (kh2 == 0) {
#pragma unroll
            for (int j = 0; j < 20; ++j) { red[(wave * 32 + 2 * rp) * 40 + 20 * cg + j] = acc0[j]; red[(wave * 32 + 2 * rp + 1) * 40 + 20 * cg + j] = acc1[j]; } }
#pragma unroll
        for (int i = 0; i < 4; ++i) { const float s = wave_sum(ssq[i]); if (lane == 0) rs[wave + 8 * i] = rsqrtf(s * (1.f / DM) + EPS); }
        __syncthreads();
        for (int i = tid; i < 32 * 40; i += NTHREADS) { float s = 0.f;
#pragma unroll
            for (int w = 0; w < 8; ++w) s += red[w * 1280 + i];
            lg[i] = s * rs[i / 40]; }
        __syncthreads();
#pragma unroll 1
        for (int i = 0; i < 4; ++i) { const int rr = wave + 8 * i; const float rstd = rs[rr]; const float* xp = X1 + (size_t)(row0 + rr) * DM; bf16_t* hp = H2 + (size_t)(row0 + rr) * DM;
#pragma unroll 2
            for (int j = 0; j < 8; ++j) { const int c0 = 256 * j + 4 * lane; const f32x4 v = *(const f32x4*)(xp + c0), g = *(const f32x4*)(g2 + c0);
                u32x2 o; o.x = pk2(v.x * rstd * g.x, v.y * rstd * g.y); o.y = pk2(v.z * rstd * g.z, v.w * rstd * g.w); *(u32x2*)(hp + c0) = o; } }
        if (tid < 32) {
            const int r = tid; const float* L = lg + r * 40;
            float gl[4]; int grp = 0;
#pragma unroll
            for (int j = 0; j < 4; ++j) gl[j] = L[j] + brg[j];
            float gm = gl[0];
#pragma unroll
            for (int j = 1; j < 4; ++j) if (gl[j] > gm) { gm = gl[j]; grp = j; }
            float den = 0.f;
#pragma unroll
            for (int j = 0; j < 4; ++j) den += __expf(gl[j] - gm);
            const float pg = 1.f / den;
            float el[8];
#pragma unroll
            for (int j = 0; j < 8; ++j) el[j] = L[4 + grp * 8 + j] + bre[grp * 8 + j];
            int i0 = 0; float v0 = el[0];
#pragma unroll
            for (int j = 1; j < 8; ++j) if (el[j] > v0) { v0 = el[j]; i0 = j; }
            int i1 = -1; float v1 = -INFINITY;
#pragma unroll
            for (int j = 0; j < 8; ++j) if (j != i0 && el[j] > v1) { v1 = el[j]; i1 = j; }
            const float e1 = __expf(v1 - v0); const float w0 = pg / (1.f + e1), w1 = pg * e1 / (1.f + e1);
            const int ea = grp * 8 + i0, eb = grp * 8 + i1;
            sel[r * 2] = ea; sel[r * 2 + 1] = eb; selw[r * 2] = w0; selw[r * 2 + 1] = w1;
            lpos[r * 2] = atomicAdd(&hist[ea], 1); lpos[r * 2 + 1] = atomicAdd(&hist[eb], 1);
        }
        __syncthreads();
        if (tid < 32) hbase[tid] = hist[tid] > 0 ? (int)atomicAdd(&cnt[(tid) * CNT_STRIDE], (unsigned)hist[tid]) : 0;
        __syncthreads();
        if (tid < 64) { const int e = sel[tid], pos = hbase[e] + lpos[tid]; const int tok = row0 + (tid >> 1);
            TOK[(size_t)e * T + pos] = tok; GATE[(size_t)e * T + pos] = selw[tid]; ASG[tok * 2 + (tid & 1)] = (e << 16) | pos; }
        __syncthreads();
    }
}

constexpr size_t WS_WR = 7 * MiB;
__device__ __forceinline__ void p0_router_weights(const Args& A) {
    const float* g2 = A.in[14]; const float* wrg = A.in[15]; const float* wre = A.in[17]; bf16_t* WR = (bf16_t*)(A.ws + WS_WR);
    for (int i = blockIdx.x * NTHREADS + threadIdx.x; i < 64 * DM; i += gridDim.x * NTHREADS) { const int n = i >> 11, k = i & (DM - 1);
        const float w = n < 4 ? wrg[(size_t)k * 4 + n] * g2[k] : (n < 36 ? wre[(size_t)k * 32 + n - 4] * g2[k] : 0.f);
        const bf16_t h = f2bf(w); WR[i] = h; WR[64 * DM + i] = f2bf(w - bf2f(h)); }
}
constexpr size_t WS_RSTL = WS_CKL;
template <int ALT> __device__ __forceinline__ void p5_router3(const Args& A, float* ldsf) {
    float* RSTL = (float*)(A.ws + (ALT ? WS_H + 6 * MiB : WS_RSTL));
    typedef short bf16x8 __attribute__((ext_vector_type(8))); typedef float f32x16 __attribute__((ext_vector_type(16)));
    const float* X1 = A.out; const float* g2 = A.in[14]; const float* brg = A.in[16]; const float* bre = A.in[18]; const bf16_t* WR = (const bf16_t*)(A.ws + WS_WR);
    bf16_t* H2 = (bf16_t*)(A.ws + WS_H2); unsigned* cnt = (unsigned*)(A.ws + WS_CTL) + CW_CNT + (ALT ? 2048 : 0);
    int* TOK = (int*)(A.ws + (ALT ? WS_H : WS_TOK)); float* GATE = (float*)(A.ws + (ALT ? WS_H + 2 * MiB : WS_GATE)); int* ASG = (int*)(A.ws + (ALT ? WS_H + 4 * MiB : WS_ASG));
    const int tid = threadIdx.x, lane = tid & 63, wave = tid >> 6, r32 = lane & 31, hi = lane >> 5;
    float* red = ldsf;
    float* lg = ldsf + 16384;
    float* sq = lg + 2048;
    float* rs = sq + 256;
    int* hist = (int*)(rs + 32); int* hbase = hist + 32; int* sel = hbase + 32; int* lpos = sel + 64; float* selw = (float*)(lpos + 64);
    for (int rb = blockIdx.x; rb < T / 32; rb += gridDim.x) {
        const int row0 = rb * 32;
        if (tid < 32) hist[tid] = 0;
        const float* xp = X1 + (size_t)(row0 + r32) * DM + 256 * wave + 8 * hi;
        const bf16_t* wp = WR + (size_t)r32 * DM + 256 * wave + 8 * hi;
        f32x16 acc[2];
#pragma unroll
        for (int j = 0; j < 2; ++j)
#pragma unroll
            for (int r = 0; r < 16; ++r) acc[j][r] = 0.f;
        float ssq = 0.f;
        f32x4 xa[4], xb[4], xna[4], xnb[4];
#pragma unroll
        for (int i = 0; i < 4; ++i) { xa[i] = *(const f32x4*)(xp + 16 * i); xb[i] = *(const f32x4*)(xp + 16 * i + 4); }
#pragma unroll 1
        for (int kb = 0; kb < (ALT == 3 ? 0 : 4); ++kb) {
            bf16x8 wh0[4], wh1[4], wl0[4], wl1[4]; f32x4 ga[4], gb[4];
#pragma unroll
            for (int i = 0; i < 4; ++i) { const int ko = 64 * kb + 16 * i;
                wh0[i] = *(const bf16x8*)(wp + ko); wh1[i] = *(const bf16x8*)(wp + (size_t)32 * DM + ko); wl0[i] = *(const bf16x8*)(wp + (size_t)64 * DM + ko); wl1[i] = *(const bf16x8*)(wp + (size_t)96 * DM + ko);
                ga[i] = *(const f32x4*)(g2 + 256 * wave + 8 * hi + ko); gb[i] = *(const f32x4*)(g2 + 256 * wave + 8 * hi + ko + 4); }
            asm volatile("" ::: "memory");
            if (kb < 3) {
#pragma unroll
                for (int i = 0; i < 4; ++i) { xna[i] = *(const f32x4*)(xp + 64 * (kb + 1) + 16 * i); xnb[i] = *(const f32x4*)(xp + 64 * (kb + 1) + 16 * i + 4); } }
            asm volatile("" ::: "memory");
#pragma unroll
            for (int i = 0; i < 4; ++i) { const int ko = 64 * kb + 16 * i;
                { u32x4 hw; hw.x = cvtpk_rne(xa[i][0] * ga[i][0], xa[i][1] * ga[i][1]); hw.y = cvtpk_rne(xa[i][2] * ga[i][2], xa[i][3] * ga[i][3]); hw.z = cvtpk_rne(xb[i][0] * gb[i][0], xb[i][1] * gb[i][1]); hw.w = cvtpk_rne(xb[i][2] * gb[i][2], xb[i][3] * gb[i][3]);
                  *(u32x4*)(H2 + (size_t)(row0 + r32) * DM + 256 * wave + 8 * hi + ko) = hw; }
                float xv[8] = {xa[i][0], xa[i][1], xa[i][2], xa[i][3], xb[i][0], xb[i][1], xb[i][2], xb[i][3]}; u32x4 ph, pl;
#pragma unroll
                for (int e = 0; e < 4; ++e) { const float a = xv[2 * e], b2 = xv[2 * e + 1]; ssq += a * a + b2 * b2; const unsigned hh = cvtpk_rne(a, b2); ph[e] = hh;
                    pl[e] = cvtpk_rne(a - __uint_as_float(hh << 16), b2 - __uint_as_float(hh & 0xffff0000u)); }
                const bf16x8 xh = __builtin_bit_cast(bf16x8, ph), xl = __builtin_bit_cast(bf16x8, pl);
                acc[0] = __builtin_amdgcn_mfma_f32_32x32x16_bf16(xh, wh0[i], acc[0], 0, 0, 0); acc[0] = __builtin_amdgcn_mfma_f32_32x32x16_bf16(xl, wh0[i], acc[0], 0, 0, 0); acc[0] = __builtin_amdgcn_mfma_f32_32x32x16_bf16(xh, wl0[i], acc[0], 0, 0, 0);
                acc[1] = __builtin_amdgcn_mfma_f32_32x32x16_bf16(xh, wh1[i], acc[1], 0, 0, 0); acc[1] = __builtin_amdgcn_mfma_f32_32x32x16_bf16(xl, wh1[i], acc[1], 0, 0, 0); acc[1] = __builtin_amdgcn_mfma_f32_32x32x16_bf16(xh, wl1[i], acc[1], 0, 0, 0); }
#pragma unroll
            for (int i = 0; i < 4; ++i) { xa[i] = xna[i]; xb[i] = xnb[i]; }
        }
#pragma unroll
        for (int j = 0; j < 2; ++j)
#pragma unroll
            for (int r = 0; r < 16; ++r) red[((wave * 2 + j) * 16 + r) * 64 + lane] = acc[j][r];
        ssq += __shfl_xor(ssq, 32);
        if (hi == 0) sq[wave * 32 + r32] = ssq;
        __syncthreads();
        if (ALT == 2) continue;
#pragma unroll
        for (int j = 0; j < 2; ++j)
#pragma unroll
            for (int rr = 0; rr < 2; ++rr) { const int r = 2 * wave + rr; float s = 0.f;
#pragma unroll
                for (int w2 = 0; w2 < 8; ++w2) s += red[((w2 * 2 + j) * 16 + r) * 64 + lane];
                lg[((r & 3) + 8 * (r >> 2) + 4 * hi) * 64 + 32 * j + r32] = s; }
        if (tid < 32) { float s = 0.f;
#pragma unroll
            for (int w2 = 0; w2 < 8; ++w2) s += sq[w2 * 32 + tid];
            rs[tid] = rsqrtf(s * (1.f / DM) + EPS); }
        __syncthreads();
        if (tid < 32) {
            const int r = tid; const float* L = lg + r * 64; const float rstd = rs[r];
            float gl[4]; int grp = 0;
#pragma unroll
            for (int j = 0; j < 4; ++j) gl[j] = L[j] * rstd + brg[j];
            float gm = gl[0];
#pragma unroll
            for (int j = 1; j < 4; ++j) if (gl[j] > gm) { gm = gl[j]; grp = j; }
            float den = 0.f;
#pragma unroll
            for (int j = 0; j < 4; ++j) den += __expf(gl[j] - gm);
            const float pg = 1.f / den;
            float el[8];
#pragma unroll
            for (int j = 0; j < 8; ++j) el[j] = L[4 + grp * 8 + j] * rstd + bre[grp * 8 + j];
            int i0 = 0; float v0 = el[0];
#pragma unroll
            for (int j = 1; j < 8; ++j) if (el[j] > v0) { v0 = el[j]; i0 = j; }
            int i1 = -1; float v1 = -INFINITY;
#pragma unroll
            for (int j = 0; j < 8; ++j) if (j != i0 && el[j] > v1) { v1 = el[j]; i1 = j; }
            const float e1 = __expf(v1 - v0); const float w0 = pg / (1.f + e1), w1 = pg * e1 / (1.f + e1);
            const int ea = grp * 8 + i0, eb = grp * 8 + i1;
            sel[r * 2] = ea; sel[r * 2 + 1] = eb; selw[r * 2] = w0; selw[r * 2 + 1] = w1;
            lpos[r * 2] = atomicAdd(&hist[ea], 1); lpos[r * 2 + 1] = atomicAdd(&hist[eb], 1);
        }
        __syncthreads();
        if (tid < 32) hbase[tid] = hist[tid] > 0 ? (int)atomicAdd(&cnt[(tid) * CNT_STRIDE], (unsigned)hist[tid]) : 0;
        __syncthreads();
        if (tid < 64) { const int e = sel[tid], pos = hbase[e] + lpos[tid]; const int tok = row0 + (tid >> 1);
            TOK[(size_t)e * T + pos] = tok; GATE[(size_t)e * T + pos] = selw[tid]; RSTL[(size_t)e * T + pos] = rs[tid >> 1]; ASG[tok * 2 + (tid & 1)] = (e << 16) | pos; }
        __syncthreads();
    }
}

__device__ __forceinline__ void expert_layout(const unsigned* cnt, int* pstart  ) {
    int acc = 0;
    for (int e = 0; e < NEXP; ++e) { pstart[e] = acc; acc += ((int)cnt[(e) * CNT_STRIDE] + MTILE - 1) / MTILE * MTILE; }
    pstart[NEXP] = acc;
}

__device__ __forceinline__ void p6_naive(const Args& A, float* ldsf) {
    const bf16_t* H2 = (const bf16_t*)(A.ws + WS_H2); const float* wg = A.in[19]; const float* wu = A.in[20]; bf16_t* ACT = (bf16_t*)(A.ws + WS_ACT);
    const unsigned* cnt = (const unsigned*)(A.ws + WS_CTL) + CW_CNT; const int* TOK = (const int*)(A.ws + WS_TOK);
    int* ps = (int*)(ldsf + 2 * 16 * 132);
    if (threadIdx.x == 0) expert_layout(cnt, ps);
    __syncthreads();
    int ntot = 0;
    for (int e = 0; e < NEXP; ++e) ntot += (((int)cnt[(e) * CNT_STRIDE] + 127) / 128) * 4;
    for (int t = blockIdx.x; t < ntot; t += gridDim.x) {
        int e = 0, rem = t;
        for (; e < NEXP; ++e) { const int n = (((int)cnt[(e) * CNT_STRIDE] + 127) / 128) * 4; if (rem < n) break; rem -= n; }
        const int c = (int)cnt[(e) * CNT_STRIDE]; const int tm = rem / 4, tn = rem % 4; const int* tl = TOK + (size_t)e * T; const int prow = ps[e];
        const float* wge = wg + (size_t)e * DM * DEXP; const float* wue = wu + (size_t)e * DM * DEXP;
        naive_gemm_tile(ldsf, tm * 128, tn * 128, c, DEXP, 2 * DM, DM,
            [=](int m, int k) { return bf2f(H2[(size_t)tl[m] * DM + (k & (DM - 1))]); },
            [=](int k, int n) { return k < DM ? wge[(size_t)k * DEXP + n] : wue[(size_t)(k - DM) * DEXP + n]; },
            [=](int m, int n, float sg, float su) { ACT[(size_t)(prow + m) * DEXP + n] = f2bf(sg / (1.f + __expf(-sg)) * su); });
    }
}
__device__ __forceinline__ void p7_naive(const Args& A, float* ldsf) {
    const bf16_t* ACT = (const bf16_t*)(A.ws + WS_ACT); const float* wd = A.in[21]; bf16_t* YBUF = (bf16_t*)(A.ws + WS_YBUF);
    const unsigned* cnt = (const unsigned*)(A.ws + WS_CTL) + CW_CNT; const float* GATE = (const float*)(A.ws + WS_GATE);
    int* ps = (int*)(ldsf + 2 * 16 * 132);
    if (threadIdx.x == 0) expert_layout(cnt, ps);
    __syncthreads();
    int ntot = 0;
    for (int e = 0; e < NEXP; ++e) ntot += (((int)cnt[(e) * CNT_STRIDE] + 127) / 128) * 16;
    for (int t = blockIdx.x; t < ntot; t += gridDim.x) {
        int e = 0, rem = t;
        for (; e < NEXP; ++e) { const int n = (((int)cnt[(e) * CNT_STRIDE] + 127) / 128) * 16; if (rem < n) break; rem -= n; }
        const int c = (int)cnt[(e) * CNT_STRIDE]; const int tm = rem / 16, tn = rem % 16; const float* gl = GATE + (size_t)e * T; const int prow = ps[e];
        const float* wde = wd + (size_t)e * DEXP * DM;
        naive_gemm_tile(ldsf, tm * 128, tn * 128, c, DM, DEXP, DEXP,
            [=](int m, int k) { return bf2f(ACT[(size_t)(prow + m) * DEXP + k]); },
            [=](int k, int n) { return wde[(size_t)k * DM + n]; },
            [=](int m, int n, float s, float) { YBUF[(size_t)(prow + m) * DM + n] = f2bf(s * gl[m]); });
    }
}

template <int ALT> __device__ __forceinline__ void p8_combine(const Args& A, float* ldsf, const float dlt = 0.f) {
    float* X1 = A.out; float* XO = ALT ? (float*)(A.ws + WS_WGU) : A.out; const bf16_t* YBUF = (const bf16_t*)(A.ws + WS_YBUF); const int* ASG = (const int*)(A.ws + WS_ASG);
    const unsigned* cnt = (const unsigned*)(A.ws + WS_CTL) + CW_CNT;
    int* ps = (int*)ldsf;
    if (threadIdx.x == 0) expert_layout(cnt, ps);
    __syncthreads();
    float dl2 = dlt;
    if (STAMP_PHASE == 97) { int v = 0, mx = 0, mn = 1 << 30, nt_ = 0, tiny = 0, half = 0; for (int e = 0; e < NEXP; ++e) { const int c = (int)cnt[(e) * CNT_STRIDE]; mx = c > mx ? c : mx; mn = c < mn ? c : mn; nt_ += (c + 255) / 256; const int rem = c % 256; tiny += (rem > 0 && rem <= 64) ? 1 : 0; half += (rem > 0 && rem <= 128) ? 1 : 0; }
        v = STAMP_SEL == 0 ? nt_ : STAMP_SEL == 1 ? mx : STAMP_SEL == 2 ? mn : STAMP_SEL == 3 ? tiny : half; dl2 = 0.01f * (float)v; }
    const int tid = threadIdx.x, lane = tid & 63, wave = tid >> 6;
    const int gw = blockIdx.x * NWAVES + wave, NGW = gridDim.x * NWAVES;
    for (int row = gw; row < T; row += NGW) {
        const int a0 = ASG[row * 2], a1 = ASG[row * 2 + 1];
        const bf16_t* y0 = YBUF + (size_t)(ps[a0 >> 16] + (a0 & 0xffff)) * DM; const bf16_t* y1 = YBUF + (size_t)(ps[a1 >> 16] + (a1 & 0xffff)) * DM;
        const float* xr = X1 + (size_t)row * DM; float* xo = XO + (size_t)row * DM;
        u32x4 w0[4], w1[4]; f32x4 xa[4], xb[4];
#pragma unroll
        for (int j = 0; j < 4; ++j) { const int c0 = 512 * j + 8 * lane; w0[j] = *(const u32x4*)(y0 + c0); w1[j] = *(const u32x4*)(y1 + c0); xa[j] = *(const f32x4*)(xr + c0); xb[j] = *(const f32x4*)(xr + c0 + 4); }
#pragma unroll
        for (int j = 0; j < 4; ++j) { const int c0 = 512 * j + 8 * lane; f32x4 a = xa[j], b2 = xb[j];
            a.x += __uint_as_float(w0[j][0] << 16) + __uint_as_float(w1[j][0] << 16); a.y += __uint_as_float(w0[j][0] & 0xffff0000u) + __uint_as_float(w1[j][0] & 0xffff0000u);
            a.z += __uint_as_float(w0[j][1] << 16) + __uint_as_float(w1[j][1] << 16); a.w += __uint_as_float(w0[j][1] & 0xffff0000u) + __uint_as_float(w1[j][1] & 0xffff0000u);
            b2.x += __uint_as_float(w0[j][2] << 16) + __uint_as_float(w1[j][2] << 16); b2.y += __uint_as_float(w0[j][2] & 0xffff0000u) + __uint_as_float(w1[j][2] & 0xffff0000u);
            b2.z += __uint_as_float(w0[j][3] << 16) + __uint_as_float(w1[j][3] << 16); b2.w += __uint_as_float(w0[j][3] & 0xffff0000u) + __uint_as_float(w1[j][3] & 0xffff0000u);
            if (STAMP_PHASE >= 0) { a += dl2; b2 += dl2; }
            *(f32x4*)(xo + c0) = a; *(f32x4*)(xo + c0 + 4) = b2; }
    }
}

namespace pg8 {
#define PG8_LAS __attribute__((address_space(3)))
typedef short bf16x8 __attribute__((ext_vector_type(8)));
constexpr int BM = 256, BK = 64, HALF = 128, HTB = HALF * BK * 2, STAGE_BYTES = 8 * HTB, NXCD = 8, WGM = 8;
__host__ __device__ __forceinline__ int lds_byte(int r, int c) { const int st = (r >> 4) * 2 + (c >> 5), rr = r & 15, cc = c & 31, ob = rr * 64 + cc * 2; return st * 1024 + (ob ^ (((ob >> 9) & 1) << 5)); }
__host__ __device__ __forceinline__ void stage_rc(int b, int& R, int& C) { const int st = b / 1024, sb = b % 1024, swz = sb ^ (((sb >> 9) & 1) << 5); R = (st >> 1) * 16 + swz / 64; C = (st & 1) * 32 + (swz % 64) / 2; }
__host__ __device__ __forceinline__ int perm32(int rho) { const int n = rho >> 4, i = rho & 15; return 8 * (i >> 2) + 4 * n + (i & 3); }

struct Unit { const char* A; const char* B; int pm, pn, x0, x1, x2, x3; };

struct DenseOrder {
    const char* A; const char* Bt; int K, nM, nN, nwg, G, c, rep;
    __device__ void init(const void* A_, const void* Bt_, int M, int N, int K_, int G_, int c_, int rep_ = 1) { A = (const char*)A_; Bt = (const char*)Bt_; K = K_; nM = M / BM; nN = N / BM; nwg = nM * nN; G = G_; c = c_; rep = rep_; }
    __device__ bool next(int i, Unit& u) const {
        const long L = (long)i * G + c; if (L >= (long)nwg * rep) return false;
        int wgid = (int)(L % nwg); { const int q = nwg / NXCD, r = nwg % NXCD, xcd = wgid % NXCD, off = wgid / NXCD; wgid = (xcd < r ? xcd * (q + 1) : r * (q + 1) + (xcd - r) * q) + off; }
        const int nig = WGM * nN, gid = wgid / nig, fm = gid * WGM, gsz = (nM - fm) < WGM ? (nM - fm) : WGM;
        u.pm = fm + ((wgid % nig) % gsz); u.pn = (wgid % nig) / gsz; u.x0 = 0; u.x1 = 0; u.x2 = 0; u.x3 = 0;
        u.A = A + (size_t)u.pm * BM * K * 2; u.B = Bt + (size_t)u.pn * BM * K * 2; return true;
    }
    __device__ __forceinline__ void rows(const Unit&, unsigned (&)[2][2], const int (&)[2]) const {}
};

__device__ __forceinline__ unsigned cvt_pk_bf16(float lo, float hi) { unsigned r; asm volatile("v_cvt_pk_bf16_f32 %0, %1, %2" : "=v"(r) : "v"(lo), "v"(hi)); return r; }

template <class Epi, class Sched, bool ALIGN_EPI, bool GATHER, bool SKIP = false>
__device__ __forceinline__ void gemm_phase(PG8_LAS unsigned char* lds, const int K, const Sched& S, const Epi& E) {
    const int tid = threadIdx.x, wid = __builtin_amdgcn_readfirstlane(tid >> 6), lane = tid & 63, wr = wid >> 2, wc = wid & 3, fr = lane & 15, fq = lane >> 4;
    const int nt = K / BK;
    unsigned voffA[2], voffB[2]; int RA[2];
#pragma unroll
    for (int i = 0; i < 2; ++i) { int R, C; stage_rc(tid * 16 + i * 8192, R, C); const int Rb = Epi::PERM ? ((R & ~31) + perm32(R & 31)) : R;
        voffA[i] = GATHER ? (unsigned)(C * 2) : (unsigned)(R * K + C) * 2u; voffB[i] = (unsigned)(Rb * K + C) * 2u; RA[i] = R; }
    const size_t kstep = (size_t)(BK * 2);
    const size_t hstep = (size_t)HALF * K * 2;
    const size_t hstepA = GATHER ? 0 : hstep;
    const unsigned ldsw = (unsigned)wid * 1024u;
    const int aoff = lds_byte(wr * 64 + fr, fq * 8), boff = lds_byte(wc * 32 + fr, fq * 8);
    unsigned gA[2][2], gAn[2][2];
#define PG8_SA(b, h) (((b) * 2 + (h)) * HTB)
#define PG8_SB(b, h) ((4 + (b) * 2 + (h)) * HTB)
#define PG8_STAGE(bufoff, gbase, voff) do { _Pragma("unroll") for (int _i = 0; _i < 2; ++_i) \
        __builtin_amdgcn_global_load_lds((const unsigned*)((const char*)(gbase) + (voff)[_i]), (PG8_LAS unsigned*)(lds + (bufoff) + ldsw + _i * 8192), 16, 0, 0); } while (0)
#define PG8_STAGE_A(bufoff, gbase, h, nx) do { _Pragma("unroll") for (int _i = 0; _i < 2; ++_i) { \
        const unsigned _o = GATHER ? ((nx) ? gAn[h][_i] : gA[h][_i]) + voffA[_i] : voffA[_i]; \
        __builtin_amdgcn_global_load_lds((const unsigned*)((const char*)(gbase) + (h) * hstepA + _o), (PG8_LAS unsigned*)(lds + (bufoff) + ldsw + _i * 8192), 16, 0, 0); } } while (0)
#define PG8_LDA(dst, b, h) do { _Pragma("unroll") for (int m = 0; m < 4; ++m) _Pragma("unroll") for (int k = 0; k < 2; ++k) dst[m][k] = *(const PG8_LAS bf16x8*)(lds + PG8_SA(b, h) + aoff + m * 2048 + k * 1024); } while (0)
#define PG8_LDB(dst, b, h) do { _Pragma("unroll") for (int n = 0; n < 2; ++n) _Pragma("unroll") for (int k = 0; k < 2; ++k) dst[n][k] = *(const PG8_LAS bf16x8*)(lds + PG8_SB(b, h) + boff + n * 2048 + k * 1024); } while (0)
#define PG8_MMA(ai, bj, At, Bt) do { __builtin_amdgcn_s_setprio(1); _Pragma("unroll") for (int m = 0; m < 4; ++m) { if (!SKIP || m < ((ai) == 0 ? mc0 : mc1)) { _Pragma("unroll") for (int n = 0; n < 2; ++n) _Pragma("unroll") for (int k = 0; k < 2; ++k) \
        acc[ai][bj][m][n] = __builtin_amdgcn_mfma_f32_16x16x32_bf16(Bt[n][k], At[m][k], acc[ai][bj][m][n], 0, 0, 0); } } __builtin_amdgcn_s_setprio(0); } while (0)
#define PG8_WAIT_V(n) asm volatile("s_waitcnt vmcnt(" #n ")" ::: "memory")
#define PG8_WAIT_L(n) asm volatile("s_waitcnt lgkmcnt(" #n ")" ::: "memory")
#define PG8_BAR __builtin_amdgcn_s_barrier()
#define PG8_SCHED __builtin_amdgcn_sched_barrier(0)
    Unit cur, nxt; int ui = 0;
    if (!S.next(0, cur)) return;
    int mc0 = 4, mc1 = 4;
#define PG8_MC(u) do { if (SKIP) { const int a_ = ((u).x2 - 64 * wr + 15) >> 4, b_ = ((u).x2 - 128 - 64 * wr + 15) >> 4; mc0 = a_ < 0 ? 0 : (a_ > 4 ? 4 : a_); mc1 = b_ < 0 ? 0 : (b_ > 4 ? 4 : b_); } } while (0)
    PG8_MC(cur);
    f32x4 acc[2][2][4][2];
#pragma unroll
    for (int a = 0; a < 2; ++a)
#pragma unroll
        for (int b = 0; b < 2; ++b)
#pragma unroll
            for (int m = 0; m < 4; ++m)
#pragma unroll
                for (int n = 0; n < 2; ++n) acc[a][b][m][n] = (f32x4){0.f, 0.f, 0.f, 0.f};
    bf16x8 At[4][2], B0[2][2], B1[2][2];
    const char* cA = cur.A; const char* cB = cur.B;
    if constexpr (GATHER) { S.rows(cur, gA, RA);
#pragma unroll
        for (int h = 0; h < 2; ++h)
#pragma unroll
            for (int i = 0; i < 2; ++i) gAn[h][i] = gA[h][i]; }
    PG8_STAGE(PG8_SB(0, 0), cB, voffB); PG8_STAGE(PG8_SB(0, 1), cB + hstep, voffB); PG8_STAGE_A(PG8_SA(0, 0), cA, 0, false); PG8_STAGE_A(PG8_SA(0, 1), cA, 1, false);
    if (wr == 1) PG8_BAR;
    PG8_WAIT_V(2); PG8_BAR;
    PG8_STAGE(PG8_SB(1, 0), cB + kstep, voffB); PG8_STAGE_A(PG8_SA(1, 0), cA + kstep, 0, false); PG8_STAGE(PG8_SB(1, 1), cB + hstep + kstep, voffB);
    PG8_WAIT_V(6); PG8_BAR;
    for (;;) {
        const bool has_next = S.next(ui + 1, nxt);
        const char* nA = has_next ? nxt.A : cA; const char* nB = has_next ? nxt.B : cB;
        if constexpr (GATHER) { if (has_next) { S.rows(nxt, gAn, RA); } }
        for (int t = 0; t < nt; t += 2) {
            const bool last = (t == nt - 2);
            const char* a1 = cA + (size_t)(t + 1) * kstep;
            const char* a2 = last ? nA : cA + (size_t)(t + 2) * kstep; const char* b2 = last ? nB : cB + (size_t)(t + 2) * kstep;
            const char* a3 = a2 + kstep; const char* b3 = b2 + kstep;
            if constexpr (Epi::HAS_MID) { if (t == nt / 2) { int frl = fr, fql = fq; asm volatile("" : "+v"(frl), "+v"(fql)); E.mid(acc, cur, wr, wc, frl, fql); } }
            PG8_LDB(B0, 0, 0); PG8_LDB(B1, 0, 1); PG8_SCHED; PG8_LDA(At, 0, 0); PG8_STAGE_A(PG8_SA(1, 1), a1, 1, false);
            PG8_WAIT_V(8); PG8_WAIT_L(0); PG8_BAR; PG8_MMA(0, 0, At, B0); PG8_MMA(0, 1, At, B1); PG8_BAR; PG8_SCHED;
            PG8_LDA(At, 0, 1); PG8_STAGE(PG8_SB(0, 0), b2, voffB); PG8_STAGE(PG8_SB(0, 1), b2 + hstep, voffB); PG8_STAGE_A(PG8_SA(0, 0), a2, 0, last);
            PG8_WAIT_V(8); PG8_WAIT_L(0); PG8_BAR; PG8_MMA(1, 0, At, B0); PG8_MMA(1, 1, At, B1); PG8_BAR; PG8_SCHED;
            PG8_LDB(B0, 1, 0); PG8_LDB(B1, 1, 1); PG8_SCHED; PG8_LDA(At, 1, 0); PG8_STAGE_A(PG8_SA(0, 1), a2, 1, last);
            PG8_WAIT_V(8); PG8_WAIT_L(0); PG8_BAR; PG8_MMA(0, 0, At, B0); PG8_MMA(0, 1, At, B1); PG8_BAR; PG8_SCHED;
            PG8_LDA(At, 1, 1); PG8_STAGE(PG8_SB(1, 0), b3, voffB); PG8_STAGE(PG8_SB(1, 1), b3 + hstep, voffB); PG8_STAGE_A(PG8_SA(1, 0), a3, 0, last);
            PG8_WAIT_V(8); PG8_WAIT_L(0); PG8_BAR; PG8_MMA(1, 0, At, B0); PG8_MMA(1, 1, At, B1); PG8_BAR; PG8_SCHED;
        }
        if constexpr (ALIGN_EPI) { if (wr == 0) PG8_BAR; }
        { int frl = fr, fql = fq; asm volatile("" : "+v"(frl), "+v"(fql)); E(acc, cur, wr, wc, frl, fql); }
        if (!has_next) break;
#pragma unroll
        for (int a = 0; a < 2; ++a)
#pragma unroll
            for (int b = 0; b < 2; ++b)
#pragma unroll
                for (int m = 0; m < 4; ++m)
#pragma unroll
                    for (int n = 0; n < 2; ++n) acc[a][b][m][n] = (f32x4){0.f, 0.f, 0.f, 0.f};
        cur = nxt; cA = nA; cB = nB; ++ui; PG8_MC(cur);
        if constexpr (GATHER) {
#pragma unroll
            for (int h = 0; h < 2; ++h)
#pragma unroll
                for (int i = 0; i < 2; ++i) gA[h][i] = gAn[h][i]; }
        if constexpr (ALIGN_EPI) { if (wr == 1) PG8_BAR; }
    }
    PG8_WAIT_V(0);
    if constexpr (!ALIGN_EPI) { if (wr == 0) PG8_BAR; }
    PG8_BAR;
#undef PG8_SA
#undef PG8_SB
#undef PG8_STAGE
#undef PG8_STAGE_A
#undef PG8_LDA
#undef PG8_LDB
#undef PG8_MMA
#undef PG8_WAIT_V
#undef PG8_WAIT_L
#undef PG8_BAR
#undef PG8_SCHED
#undef PG8_MC
}
}

constexpr int LDS_MISC_OFF = 131072;
__device__ __forceinline__ float fast_gelu(float x) { const float y = x + 0.044715f * x * x * x; return x * __builtin_amdgcn_rcpf(1.0f + __builtin_amdgcn_exp2f(-2.0f * 0.7978845608028654f * LOG2E * y)); }
__device__ __forceinline__ float fast_sigmoid(float x) { return __builtin_amdgcn_rcpf(1.0f + __builtin_amdgcn_exp2f(-LOG2E * x)); }
__device__ __forceinline__ void unpack8(const u32x4 w, float (&v)[8]) {
#pragma unroll
    for (int e = 0; e < 4; ++e) { v[2 * e] = __uint_as_float(w[e] << 16); v[2 * e + 1] = __uint_as_float(w[e] & 0xffff0000u); } }

constexpr size_t WS_VSTAT = 6 * MiB;
constexpr int LDS_EPI_OFF = 131072 + 4096;
struct EpiIn {
    static constexpr bool PERM = true, HAS_MID = false;
    bf16_t *U, *V, *Q, *K, *VA, *G; const float* b_gate; const float* qg; const float* kg; float* VSTAT; PG8_LAS unsigned char* lds;
    __device__ __forceinline__ void mid(f32x4 (&)[2][2][4][2], const pg8::Unit&, int, int, int, int) const {}
    __device__ __forceinline__ void operator()(f32x4 (&acc)[2][2][4][2], const pg8::Unit& u, int wr, int wc, int fr, int fq) const {
        const int pn = u.pn; bf16_t* base; int ld, colt, mode;
        if (pn < 4) { base = U; ld = 1024; colt = pn * 256; mode = 1; }
        else if (pn < 8) { base = V; ld = 1024; colt = (pn - 4) * 256; mode = 3; }
        else if (pn < 12) { base = Q; ld = 1024; colt = (pn - 8) * 256; mode = 4; }
        else if (pn < 16) { base = K; ld = 1024; colt = (pn - 12) * 256; mode = 5; }
        else if (pn < 20) { base = VA; ld = 1024; colt = (pn - 16) * 256; mode = 0; }
        else { base = G; ld = 4096; colt = (pn - 20) * 256; mode = 2; }
        const int row0 = u.pm * 256 + wr * 64 + fr, col0 = colt + wc * 32 + 8 * fq;
        if (mode >= 4) {
            PG8_LAS float* P = (PG8_LAS float*)(lds + LDS_EPI_OFF);
#pragma unroll
            for (int ai = 0; ai < 2; ++ai)
#pragma unroll
                for (int m = 0; m < 4; ++m)
#pragma unroll
                    for (int bj = 0; bj < 2; ++bj) { const f32x4 a = acc[ai][bj][m][0], b = acc[ai][bj][m][1];
                        float s = (a[0] * a[0] + a[1] * a[1]) + (a[2] * a[2] + a[3] * a[3]) + (b[0] * b[0] + b[1] * b[1]) + (b[2] * b[2] + b[3] * b[3]);
                        s += __shfl_xor(s, 16); s += __shfl_xor(s, 32);
                        if (fq == 0) P[((ai * 128 + wr * 64 + m * 16 + fr) * 2 + bj) * 4 + wc] = s; }
            asm volatile("s_waitcnt lgkmcnt(0)" ::: "memory"); __builtin_amdgcn_s_barrier(); asm volatile("" ::: "memory");
            const float* gg = mode == 4 ? qg : kg; const float qs = mode == 4 ? QSCALE : 1.0f;
            const f32x4 g0 = *(const f32x4*)(gg + wc * 32 + 8 * fq), g1 = *(const f32x4*)(gg + wc * 32 + 8 * fq + 4);
#pragma unroll
            for (int ai = 0; ai < 2; ++ai)
#pragma unroll
                for (int m = 0; m < 4; ++m) { bf16_t* rowp = base + (size_t)(row0 + ai * 128 + m * 16) * ld + col0;
#pragma unroll
                    for (int bj = 0; bj < 2; ++bj) { const f32x4 pp = *(const PG8_LAS f32x4*)(P + ((ai * 128 + wr * 64 + m * 16 + fr) * 2 + bj) * 4);
                        const float sc = rsqrtf(((pp[0] + pp[1]) + (pp[2] + pp[3])) * (1.f / 128.f) + EPS) * qs;
                        const f32x4 v0 = acc[ai][bj][m][0] * g0 * sc, v1 = acc[ai][bj][m][1] * g1 * sc;
                        u32x4 w; w.x = pg8::cvt_pk_bf16(v0[0], v0[1]); w.y = pg8::cvt_pk_bf16(v0[2], v0[3]); w.z = pg8::cvt_pk_bf16(v1[0], v1[1]); w.w = pg8::cvt_pk_bf16(v1[2], v1[3]);
                        *(u32x4*)(rowp + bj * 128) = w; } }
            return;
        }
        f32x4 bv[2][2];
#pragma unroll
        for (int bj = 0; bj < 2; ++bj)
#pragma unroll
            for (int n = 0; n < 2; ++n) bv[bj][n] = (mode == 2) ? *(const f32x4*)(b_gate + col0 + bj * 128 + 4 * n) : (f32x4){0.f, 0.f, 0.f, 0.f};
#pragma unroll
        for (int ai = 0; ai < 2; ++ai)
#pragma unroll
            for (int m = 0; m < 4; ++m) { bf16_t* rowp = base + (size_t)(row0 + ai * 128 + m * 16) * ld + col0; float s1 = 0.f, s2 = 0.f;
#pragma unroll
                for (int bj = 0; bj < 2; ++bj) { f32x4 v0 = acc[ai][bj][m][0], v1 = acc[ai][bj][m][1];
                    if (mode == 1 || mode == 3) {
#pragma unroll
                        for (int j = 0; j < 4; ++j) { v0[j] = fast_gelu(v0[j]); v1[j] = fast_gelu(v1[j]); } }
                    else if (mode == 2) { v0 += bv[bj][0]; v1 += bv[bj][1];
#pragma unroll
                        for (int j = 0; j < 4; ++j) { v0[j] = fast_sigmoid(v0[j]); v1[j] = fast_sigmoid(v1[j]); } }
                    if (mode == 3) {
#pragma unroll
                        for (int j = 0; j < 4; ++j) { s1 += v0[j] + v1[j]; s2 += v0[j] * v0[j] + v1[j] * v1[j]; } }
                    u32x4 w; w.x = pg8::cvt_pk_bf16(v0[0], v0[1]); w.y = pg8::cvt_pk_bf16(v0[2], v0[3]); w.z = pg8::cvt_pk_bf16(v1[0], v1[1]); w.w = pg8::cvt_pk_bf16(v1[2], v1[3]);
                    *(u32x4*)(rowp + bj * 128) = w; }
                if (mode == 3) { s1 += __shfl_xor(s1, 16); s1 += __shfl_xor(s1, 32); s2 += __shfl_xor(s2, 16); s2 += __shfl_xor(s2, 32);
                    if (fq == 0) { typedef float f32x2_ __attribute__((ext_vector_type(2))); *(f32x2_*)(VSTAT + ((size_t)(row0 + ai * 128 + m * 16) * 16 + (pn - 4) * 4 + wc) * 2) = (f32x2_){s1, s2}; } } }
    }
};
struct EpiProj {
    static constexpr bool PERM = true, HAS_MID = true;
    const bf16_t* G; bf16_t* O;
    __device__ __forceinline__ void mid(f32x4 (&acc)[2][2][4][2], const pg8::Unit& u, int wr, int wc, int fr, int fq) const {
        const int row0 = u.pm * 256 + wr * 64 + fr, col0 = u.pn * 256 + wc * 32 + 8 * fq;
#pragma unroll
        for (int ai = 0; ai < 2; ++ai) { u32x4 ws[4][2], wf[4][2];
#pragma unroll
            for (int m = 0; m < 4; ++m) { const bf16_t* gp = G + (size_t)(row0 + ai * 128 + m * 16) * 4096 + col0;
#pragma unroll
                for (int bj = 0; bj < 2; ++bj) { ws[m][bj] = *(const u32x4*)(gp + bj * 128); wf[m][bj] = *(const u32x4*)(gp + 2048 + bj * 128); } }
#pragma unroll
            for (int m = 0; m < 4; ++m)
#pragma unroll
                for (int bj = 0; bj < 2; ++bj) { float gs[8], gf[8]; unpack8(ws[m][bj], gs); unpack8(wf[m][bj], gf);
#pragma unroll
                    for (int j = 0; j < 4; ++j) { acc[ai][bj][m][0][j] *= gs[j] * __builtin_amdgcn_rcpf(gf[j]); acc[ai][bj][m][1][j] *= gs[4 + j] * __builtin_amdgcn_rcpf(gf[4 + j]); } }
            asm volatile("" ::: "memory"); }
    }
    __device__ __forceinline__ void operator()(f32x4 (&acc)[2][2][4][2], const pg8::Unit& u, int wr, int wc, int fr, int fq) const {
        const int row0 = u.pm * 256 + wr * 64 + fr, col0 = u.pn * 256 + wc * 32 + 8 * fq;
#pragma unroll
        for (int ai = 0; ai < 2; ++ai) { u32x4 wf[4][2];
#pragma unroll
            for (int m = 0; m < 4; ++m)
#pragma unroll
                for (int bj = 0; bj < 2; ++bj) wf[m][bj] = *(const u32x4*)(G + (size_t)(row0 + ai * 128 + m * 16) * 4096 + 2048 + col0 + bj * 128);
#pragma unroll
            for (int m = 0; m < 4; ++m) { const size_t r = (size_t)(row0 + ai * 128 + m * 16);
#pragma unroll
                for (int bj = 0; bj < 2; ++bj) { float gf[8]; unpack8(wf[m][bj], gf);
                    const f32x4 v0 = acc[ai][bj][m][0], v1 = acc[ai][bj][m][1];
                    u32x4 w; w.x = pg8::cvt_pk_bf16(v0[0] * gf[0], v0[1] * gf[1]); w.y = pg8::cvt_pk_bf16(v0[2] * gf[2], v0[3] * gf[3]); w.z = pg8::cvt_pk_bf16(v1[0] * gf[4], v1[1] * gf[5]); w.w = pg8::cvt_pk_bf16(v1[2] * gf[6], v1[3] * gf[7]);
                    *(u32x4*)(O + r * 2048 + col0 + bj * 128) = w; } }
            asm volatile("" ::: "memory"); }
    }
};
struct EpiOut {
    static constexpr bool PERM = false, HAS_MID = false;
    const float* X; float* O;
    __device__ __forceinline__ void mid(f32x4 (&)[2][2][4][2], const pg8::Unit&, int, int, int, int) const {}
    __device__ __forceinline__ void operator()(f32x4 (&acc)[2][2][4][2], const pg8::Unit& u, int wr, int wc, int fr, int fq) const {
        const int row0 = u.pm * 256 + wr * 64 + fr, col0 = u.pn * 256 + wc * 32 + 4 * fq;
#pragma unroll
        for (int ai = 0; ai < 2; ++ai) { f32x4 xv[4][2][2];
#pragma unroll
            for (int m = 0; m < 4; ++m) { const size_t off = (size_t)(row0 + ai * 128 + m * 16) * DM + col0;
#pragma unroll
                for (int bj = 0; bj < 2; ++bj)
#pragma unroll
                    for (int n = 0; n < 2; ++n) xv[m][bj][n] = *(const f32x4*)(X + off + bj * 128 + n * 16); }
#pragma unroll
            for (int m = 0; m < 4; ++m) { const size_t off = (size_t)(row0 + ai * 128 + m * 16) * DM + col0;
#pragma unroll
                for (int bj = 0; bj < 2; ++bj)
#pragma unroll
                    for (int n = 0; n < 2; ++n) *(f32x4*)(O + off + bj * 128 + n * 16) = xv[m][bj][n] + acc[ai][bj][m][n]; }
            asm volatile("" ::: "memory"); }
    }
};
struct EpiGateUp {
    static constexpr bool PERM = true, HAS_MID = false;
    bf16_t* ACT; const float* RSTL;
    __device__ __forceinline__ void mid(f32x4 (&)[2][2][4][2], const pg8::Unit&, int, int, int, int) const {}
    __device__ __forceinline__ void operator()(f32x4 (&acc)[2][2][4][2], const pg8::Unit& u, int wr, int wc, int fr, int fq) const {
        const int row0 = u.x0 + wr * 64 + fr, col0 = u.pn * 128 + wc * 32 + 8 * fq;
        float rrv[2][4];
#pragma unroll
        for (int ai = 0; ai < 2; ++ai)
#pragma unroll
            for (int m = 0; m < 4; ++m) rrv[ai][m] = RSTL[u.x1 + wr * 64 + fr + ai * 128 + m * 16];
#pragma unroll
        for (int ai = 0; ai < 2; ++ai)
#pragma unroll
            for (int m = 0; m < 4; ++m) { float o[8]; const float rr = rrv[ai][m];
#pragma unroll
                for (int n = 0; n < 2; ++n)
#pragma unroll
                    for (int j = 0; j < 4; ++j) { const float g = acc[ai][0][m][n][j] * rr, up = acc[ai][1][m][n][j] * rr; o[4 * n + j] = g * fast_sigmoid(g) * up; }
                u32x4 w; w.x = pg8::cvt_pk_bf16(o[0], o[1]); w.y = pg8::cvt_pk_bf16(o[2], o[3]); w.z = pg8::cvt_pk_bf16(o[4], o[5]); w.w = pg8::cvt_pk_bf16(o[6], o[7]);
                *(u32x4*)(ACT + (size_t)(row0 + ai * 128 + m * 16) * DEXP + col0) = w; }
    }
};
struct EpiDown {
    static constexpr bool PERM = true, HAS_MID = false;
    bf16_t* Y; const float* GATE;
    __device__ __forceinline__ void mid(f32x4 (&)[2][2][4][2], const pg8::Unit&, int, int, int, int) const {}
    __device__ __forceinline__ void operator()(f32x4 (&acc)[2][2][4][2], const pg8::Unit& u, int wr, int wc, int fr, int fq) const {
        const int rl0 = wr * 64 + fr, col0 = u.pn * 256 + wc * 32 + 8 * fq;
        float gtv[2][4];
#pragma unroll
        for (int ai = 0; ai < 2; ++ai)
#pragma unroll
            for (int m = 0; m < 4; ++m) gtv[ai][m] = GATE[u.x1 + rl0 + ai * 128 + m * 16];
#pragma unroll
        for (int ai = 0; ai < 2; ++ai)
#pragma unroll
            for (int m = 0; m < 4; ++m) { const int rl = rl0 + ai * 128 + m * 16; const float gt = gtv[ai][m];
#pragma unroll
                for (int bj = 0; bj < 2; ++bj) { const f32x4 v0 = acc[ai][bj][m][0] * gt, v1 = acc[ai][bj][m][1] * gt;
                    u32x4 w; w.x = pg8::cvt_pk_bf16(v0[0], v0[1]); w.y = pg8::cvt_pk_bf16(v0[2], v0[3]); w.z = pg8::cvt_pk_bf16(v1[0], v1[1]); w.w = pg8::cvt_pk_bf16(v1[2], v1[3]);
                    *(u32x4*)(Y + (size_t)(u.x0 + rl) * DM + col0 + bj * 128) = w; } }
    }
};
struct MoeOrder {
    const char* Abase; const char* Bbase; size_t Bstride; int K, nN, G, c; bool gather;
    const PG8_LAS int* ps;
    const unsigned* cnt; const int* TOK; bool xcdm;
    __device__ static int tile_of(int i, int c, int G, int nN, int nb, int& pn, bool xcdm) {
        const int S = (G / 8) / nN;
        if (!xcdm || G % 8 != 0 || S < 1) { const int L = i * G + c; pn = L % nN; return L / nN < nb ? L / nN : -1; }
        const int x = c % 8, slot = c / 8; pn = slot % nN;
        if (slot >= S * nN) return -1;
        const int sidx = i * (8 * S) + x * S + slot / nN; return sidx < nb ? sidx : -1;
    }
    __device__ bool next(int i, pg8::Unit& u) const {
        int pn; const int sidx = tile_of(i, c, G, nN, ps[NEXP + 2], pn, xcdm); if (sidx < 0) return false;
        const int prow = ps[40 + sidx], info = ps[40 + MT_MAX + sidx], valid = ps[40 + 2 * MT_MAX + sidx];
        const int e = info >> 16, mt = info & 0xffff;
        u.pm = mt; u.pn = pn; u.x0 = prow; u.x1 = e * T + mt * MTILE; u.x2 = valid; u.x3 = e;
        u.A = gather ? Abase : Abase + (size_t)prow * K * 2; u.B = Bbase + (size_t)e * Bstride + (size_t)pn * 256 * K * 2; return true;
    }
    __device__ __forceinline__ void rows(const pg8::Unit& u, unsigned (&g)[2][2], const int (&RA)[2]) const {
#pragma unroll
        for (int h = 0; h < 2; ++h)
#pragma unroll
            for (int i = 0; i < 2; ++i) { int r = RA[i] + 128 * h; r = r < u.x2 ? r : u.x2 - 1; g[h][i] = (unsigned)TOK[u.x1 + r] * (unsigned)(K * 2); }
    }
};

struct TItem { const float* src; bf16_t* dst; int ld_src, ld_dst; };
__device__ __forceinline__ void titem_load(const TItem& t, f32x4 (&v)[8], int lane) {
#pragma unroll
    for (int i = 0; i < 8; ++i) v[i] = *(const f32x4*)(t.src + (size_t)((lane >> 3) + 8 * i) * t.ld_src + 4 * (lane & 7));
}
__device__ __forceinline__ void titem_store(const TItem& t, const f32x4 (&v)[8], PG8_LAS float* scr, int lane) {
#pragma unroll
    for (int i = 0; i < 8; ++i) { PG8_LAS float* d = scr + ((lane >> 3) + 8 * i) * 33 + 4 * (lane & 7); d[0] = v[i].x; d[1] = v[i].y; d[2] = v[i].z; d[3] = v[i].w; }
    asm volatile("s_waitcnt lgkmcnt(0)" ::: "memory");
    const int c = lane & 7;
#pragma unroll
    for (int j = 0; j < 4; ++j) { const int n = (lane >> 3) + 8 * j; const PG8_LAS float* s = scr + (8 * c) * 33 + n;
        u32x4 o; o.x = pk2(s[0 * 33], s[1 * 33]); o.y = pk2(s[2 * 33], s[3 * 33]); o.z = pk2(s[4 * 33], s[5 * 33]); o.w = pk2(s[6 * 33], s[7 * 33]);
        *(u32x4*)(t.dst + (size_t)n * t.ld_dst + 8 * c) = o; }
    asm volatile("s_waitcnt lgkmcnt(0)" ::: "memory");
}
constexpr int TI0 = 32 * 288, TI1 = 16 * 64, TI2 = 16 * 64, TI3 = 32 * 64, TI4 = 32 * 512, TI5 = 32 * 512, TI6 = 32 * 512;
constexpr int TI_ALL = TI0 + TI1 + TI2 + TI3 + TI4 + TI5 + TI6;
#ifndef TAIL1_ITEMS
#define TAIL1_ITEMS (TI5)
#endif
__device__ __forceinline__ TItem titem_decode(const Args& A, int r) {
    bf16_t* WIN = (bf16_t*)(A.ws + WS_WIN); bf16_t* WPROJ = (bf16_t*)(A.ws + WS_WPROJ); bf16_t* WOUT = (bf16_t*)(A.ws + WS_WOUT); bf16_t* WGU = (bf16_t*)(A.ws + WS_WGU); bf16_t* WD = (bf16_t*)(A.ws + WS_WD);
    TItem t;
    if (r < TI0) { const int kb = r / 288, nb = r % 288; t.src = A.in[2] + (size_t)(64 * kb) * INCOLS + 32 * nb + (nb >= 160 ? 8 : 0); t.ld_src = INCOLS; t.dst = WIN + (size_t)(32 * nb) * 2048 + 64 * kb; t.ld_dst = 2048; return t; } r -= TI0;
    if (r < TI1) { const int kb = r / 64, nb = r % 64; t.src = A.in[11] + (size_t)(64 * kb) * DM + 32 * nb; t.ld_src = DM; t.dst = WPROJ + (size_t)(32 * nb) * 2048 + 64 * kb; t.ld_dst = 2048; return t; } r -= TI1;
    if (r < TI2) { const int kb = r / 64, nb = r % 64; t.src = A.in[12] + (size_t)(64 * kb) * DM + 32 * nb; t.ld_src = DM; t.dst = WPROJ + (size_t)(32 * nb) * 2048 + 1024 + 64 * kb; t.ld_dst = 2048; return t; } r -= TI2;
    if (r < TI3) { const int kb = r / 64, nb = r % 64; t.src = A.in[13] + (size_t)(64 * kb) * DM + 32 * nb; t.ld_src = DM; t.dst = WOUT + (size_t)(32 * nb) * 2048 + 64 * kb; t.ld_dst = 2048; return t; } r -= TI3;
    if (r < TI4 + TI5) { const int up = r >= TI4; if (up) r -= TI4; const int e = r / 512, q = r % 512, kb = q / 16, nb = q % 16, n = 32 * nb, drow = 256 * (n >> 7) + (n & 127) + (up ? 128 : 0);
        t.src = A.in[up ? 20 : 19] + (size_t)e * DM * DEXP + (size_t)(64 * kb) * DEXP + n; t.ld_src = DEXP; t.dst = WGU + ((size_t)e * 1024 + drow) * 2048 + 64 * kb; t.ld_dst = 2048; return t; } r -= TI4 + TI5;
    { const int e = r / 512, q = r % 512, kb = q / 64, nb = q % 64; t.src = A.in[21] + (size_t)e * DEXP * DM + (size_t)(64 * kb) * DM + 32 * nb; t.ld_src = DM; t.dst = WD + ((size_t)e * 2048 + 32 * nb) * 512 + 64 * kb; t.ld_dst = 512; return t; }
}
__device__ __forceinline__ void p0_weights(const Args& A, PG8_LAS unsigned char* lds, const int part, const int wrank, const int wcount) {
    const int tid = threadIdx.x, lane = tid & 63, wave = tid >> 6;
    PG8_LAS float* scr = (PG8_LAS float*)(lds + wave * 16384);
    if (wrank < 0 || wcount < 1) return;
    const int gw = wrank * NWAVES + wave, NGW = wcount * NWAVES;
    const int cut1 = TI_ALL - TI6 - TAIL1_ITEMS, cut2 = TI_ALL - TI6;
    const int it_lo = part == 0 ? 0 : (part == 1 ? cut1 : cut2), it_hi = part == 0 ? cut1 : (part == 1 ? cut2 : TI_ALL);
    int it = it_lo + gw; if (it >= it_hi) return;
    TItem cur = titem_decode(A, it); f32x4 va[8], vb[8];
    titem_load(cur, va, lane);
    for (;;) {
        const int itn = it + NGW; const bool more = itn < it_hi; TItem nx = cur;
        if (more) { nx = titem_decode(A, itn); titem_load(nx, vb, lane); }
        titem_store(cur, va, scr, lane);
        if (!more) break;
#pragma unroll
        for (int i = 0; i < 8; ++i) va[i] = vb[i];
        cur = nx; it = itn;
    }
}

__device__ __forceinline__ void p1_fast(const Args& A, PG8_LAS unsigned char* lds) {
    pg8::DenseOrder S; S.init(A.ws + WS_H, A.ws + WS_WIN, T, 9216, DM, gridDim.x, blockIdx.x, PROBE_REP_P1);
    EpiIn E{(bf16_t*)(A.ws + WS_U), (bf16_t*)(A.ws + WS_V), (bf16_t*)(A.ws + WS_Q), (bf16_t*)(A.ws + WS_K), (bf16_t*)(A.ws + WS_VA), (bf16_t*)(A.ws + WS_G), A.in[3], A.in[9], A.in[10], (float*)(A.ws + WS_VSTAT), lds};
    pg8::gemm_phase<EpiIn, pg8::DenseOrder, true, false>(lds, DM, S, E);
}
__device__ __forceinline__ void p3_fast(const Args& A, PG8_LAS unsigned char* lds) {
    pg8::DenseOrder S; S.init(A.ws + WS_MIXIN, A.ws + WS_WPROJ, T, DM, 2048, gridDim.x, blockIdx.x, PROBE_REP_P4);
    EpiProj E{(const bf16_t*)(A.ws + WS_G), (bf16_t*)(A.ws + WS_MIXED)};
    pg8::gemm_phase<EpiProj, pg8::DenseOrder, true, false>(lds, 2048, S, E);
}
__device__ __forceinline__ void p4_fast(const Args& A, PG8_LAS unsigned char* lds) {
    pg8::DenseOrder S; S.init(A.ws + WS_MIXED, A.ws + WS_WOUT, T, DM, DM, gridDim.x, blockIdx.x, PROBE_REP_P5);
    EpiOut E{A.in[0], A.out};
    pg8::gemm_phase<EpiOut, pg8::DenseOrder, true, false>(lds, DM, S, E);
}
__device__ __forceinline__ void moe_layout_lds(const Args& A, PG8_LAS unsigned char* lds) {
    PG8_LAS int* ps = (PG8_LAS int*)(lds + LDS_MISC_OFF); PG8_LAS int* tprow = ps + 40; PG8_LAS int* tinfo = tprow + MT_MAX; PG8_LAS int* tvalid = tinfo + MT_MAX;
    const unsigned* cnt = (const unsigned*)(A.ws + WS_CTL) + CW_CNT;
    if (threadIdx.x == 0) { int acc = 0;
        for (int e = 0; e < NEXP; ++e) { ps[e] = acc; acc += ((int)cnt[(e) * CNT_STRIDE] + MTILE - 1) / MTILE * MTILE; }
        ps[NEXP] = acc; ps[NEXP + 1] = acc / MTILE; }
    __syncthreads();
    const int nt = ps[NEXP + 1]; PG8_LAS int* uval = tvalid + MT_MAX;
    int prow = 0, e = 0, mt = 0, valid = 0;
    if ((int)threadIdx.x < nt) { prow = (int)threadIdx.x * MTILE;
        for (int j = 1; j < NEXP; ++j) if (ps[j] <= prow) e = j;
        mt = (prow - ps[e]) / MTILE; valid = (int)cnt[(e) * CNT_STRIDE] - mt * MTILE; valid = valid > MTILE ? MTILE : valid; uval[threadIdx.x] = valid; }
    __syncthreads();
    if ((int)threadIdx.x < nt) { int rank = 0;
        if (TINY_ROWS > 0) { for (int j = 0; j < nt; ++j) { const int vj = uval[j]; rank += (vj > valid || (vj == valid && j < (int)threadIdx.x)) ? 1 : 0; } } else rank = (int)threadIdx.x;
        tprow[rank] = prow; tinfo[rank] = (e << 16) | mt; tvalid[rank] = valid; }
    if (threadIdx.x == 0) { int nb = 0; for (int j = 0; j < nt; ++j) nb += uval[j] > TINY_ROWS ? 1 : 0; ps[NEXP + 2] = nb; }
    __syncthreads();
}
namespace sm {
typedef short bf16x8 __attribute__((ext_vector_type(8))); typedef float f32x16 __attribute__((ext_vector_type(16)));
constexpr int TINY = 64;
__device__ __forceinline__ void gateup_small(const Args& A, PG8_LAS unsigned char* lds) {
    const PG8_LAS int* ps = (const PG8_LAS int*)(lds + LDS_MISC_OFF); const int nt = ps[NEXP + 1], nbig = ps[NEXP + 2];
    const bf16_t* H2 = (const bf16_t*)(A.ws + WS_H2); const bf16_t* WGU = (const bf16_t*)(A.ws + WS_WGU); bf16_t* ACT = (bf16_t*)(A.ws + WS_ACT); const int* TOK = (const int*)(A.ws + WS_TOK);
    const int tid = threadIdx.x, lane = tid & 63, w = __builtin_amdgcn_readfirstlane(tid >> 6), r32 = lane & 31, hi = lane >> 5;
    PG8_LAS float* red = (PG8_LAS float*)lds;
    for (int su = blockIdx.x; su < (nt - nbig) * 16; su += gridDim.x) {
        const int sidx = nbig + (su >> 4), sl = su & 15; const int prow = ps[40 + sidx], info = ps[40 + MT_MAX + sidx], valid = ps[40 + 2 * MT_MAX + sidx];
        const int e = info >> 16, mt = info & 0xffff, lbase = e * T + mt * MTILE;
        const int ra = r32 < valid ? r32 : valid - 1, rb = 32 + r32 < valid ? 32 + r32 : valid - 1;
        const bf16_t* a0p = H2 + (size_t)TOK[lbase + ra] * DM + 256 * w + 8 * hi; const bf16_t* a1p = H2 + (size_t)TOK[lbase + rb] * DM + 256 * w + 8 * hi;
        const bf16_t* b0p = WGU + ((size_t)e * 1024 + 256 * (sl >> 2) + 32 * (sl & 3) + r32) * DM + 256 * w + 8 * hi; const bf16_t* b1p = b0p + (size_t)128 * DM;
        f32x16 acc[2][2];
#pragma unroll
        for (int i = 0; i < 2; ++i)
#pragma unroll
            for (int j = 0; j < 2; ++j)
#pragma unroll
                for (int r = 0; r < 16; ++r) acc[i][j][r] = 0.f;
#pragma unroll 4
        for (int ks = 0; ks < 16; ++ks) { const bf16x8 a0 = *(const bf16x8*)(a0p + 16 * ks), a1 = *(const bf16x8*)(a1p + 16 * ks), b0 = *(const bf16x8*)(b0p + 16 * ks), b1 = *(const bf16x8*)(b1p + 16 * ks);
            acc[0][0] = __builtin_amdgcn_mfma_f32_32x32x16_bf16(a0, b0, acc[0][0], 0, 0, 0); acc[0][1] = __builtin_amdgcn_mfma_f32_32x32x16_bf16(a0, b1, acc[0][1], 0, 0, 0);
            acc[1][0] = __builtin_amdgcn_mfma_f32_32x32x16_bf16(a1, b0, acc[1][0], 0, 0, 0); acc[1][1] = __builtin_amdgcn_mfma_f32_32x32x16_bf16(a1, b1, acc[1][1], 0, 0, 0); }
#pragma unroll
        for (int i = 0; i < 2; ++i)
#pragma unroll
            for (int j = 0; j < 2; ++j)
#pragma unroll
                for (int r = 0; r < 16; ++r) red[(((w * 2 + i) * 2 + j) * 16 + r) * 64 + lane] = acc[i][j][r];
        __syncthreads();
#pragma unroll
        for (int i = 0; i < 2; ++i)
#pragma unroll
            for (int rr = 0; rr < 2; ++rr) { const int r = 2 * w + rr; float g = 0.f, u = 0.f;
#pragma unroll
                for (int w2 = 0; w2 < 8; ++w2) { g += red[(((w2 * 2 + i) * 2 + 0) * 16 + r) * 64 + lane]; u += red[(((w2 * 2 + i) * 2 + 1) * 16 + r) * 64 + lane]; }
                const int row = 32 * i + (r & 3) + 8 * (r >> 2) + 4 * hi; const float rr2 = ((const float*)(A.ws + WS_RSTL))[lbase + (row < valid ? row : valid - 1)]; g *= rr2; u *= rr2;
                ACT[(size_t)(prow + row) * DEXP + 32 * sl + r32] = f2bf(g * fast_sigmoid(g) * u); }
        __syncthreads();
    }
}
__device__ __forceinline__ void down_small(const Args& A, PG8_LAS unsigned char* lds) {
    const PG8_LAS int* ps = (const PG8_LAS int*)(lds + LDS_MISC_OFF); const int nt = ps[NEXP + 1], nbig = ps[NEXP + 2];
    const bf16_t* ACT = (const bf16_t*)(A.ws + WS_ACT); const bf16_t* WD = (const bf16_t*)(A.ws + WS_WD); bf16_t* Y = (bf16_t*)(A.ws + WS_YBUF); const float* GATE = (const float*)(A.ws + WS_GATE);
    const int tid = threadIdx.x, lane = tid & 63, w = __builtin_amdgcn_readfirstlane(tid >> 6), wn = w & 3, wk = w >> 2, r32 = lane & 31, hi = lane >> 5;
    PG8_LAS float* red = (PG8_LAS float*)lds;
    for (int su = blockIdx.x; su < (nt - nbig) * 16; su += gridDim.x) {
        const int sidx = nbig + (su >> 4), sl = su & 15; const int prow = ps[40 + sidx], info = ps[40 + MT_MAX + sidx], valid = ps[40 + 2 * MT_MAX + sidx];
        const int e = info >> 16, mt = info & 0xffff, lbase = e * T + mt * MTILE;
        const int ra = r32 < valid ? r32 : valid - 1, rb = 32 + r32 < valid ? 32 + r32 : valid - 1;
        const bf16_t* a0p = ACT + (size_t)(prow + ra) * DEXP + 256 * wk + 8 * hi; const bf16_t* a1p = ACT + (size_t)(prow + rb) * DEXP + 256 * wk + 8 * hi;
        const bf16_t* bp = WD + ((size_t)e * 2048 + 128 * sl + 32 * wn + r32) * DEXP + 256 * wk + 8 * hi;
        f32x16 acc[2];
#pragma unroll
        for (int i = 0; i < 2; ++i)
#pragma unroll
            for (int r = 0; r < 16; ++r) acc[i][r] = 0.f;
#pragma unroll 4
        for (int ks = 0; ks < 16; ++ks) { const bf16x8 a0 = *(const bf16x8*)(a0p + 16 * ks), a1 = *(const bf16x8*)(a1p + 16 * ks), b = *(const bf16x8*)(bp + 16 * ks);
            acc[0] = __builtin_amdgcn_mfma_f32_32x32x16_bf16(a0, b, acc[0], 0, 0, 0); acc[1] = __builtin_amdgcn_mfma_f32_32x32x16_bf16(a1, b, acc[1], 0, 0, 0); }
        if (wk == 1) {
#pragma unroll
            for (int i = 0; i < 2; ++i)
#pragma unroll
                for (int r = 0; r < 16; ++r) red[((wn * 2 + i) * 16 + r) * 64 + lane] = acc[i][r]; }
        __syncthreads();
        if (wk == 0) {
#pragma unroll
            for (int i = 0; i < 2; ++i)
#pragma unroll
                for (int r = 0; r < 16; ++r) { const int row = 32 * i + (r & 3) + 8 * (r >> 2) + 4 * hi; const float gt = GATE[lbase + (row < valid ? row : valid - 1)];
                    Y[(size_t)(prow + row) * DM + 128 * sl + 32 * wn + r32] = f2bf((acc[i][r] + red[((wn * 2 + i) * 16 + r) * 64 + lane]) * gt); } }
        __syncthreads();
    }
}
}

__device__ __forceinline__ void p6_fast(const Args& A, PG8_LAS unsigned char* lds) {
    moe_layout_lds(A, lds);
    MoeOrder S{(const char*)(A.ws + WS_H2), (const char*)(A.ws + WS_WGU), (size_t)1024 * 2048 * 2, DM, 4, (int)gridDim.x, (int)blockIdx.x, true,
               (const PG8_LAS int*)(lds + LDS_MISC_OFF), (const unsigned*)(A.ws + WS_CTL) + CW_CNT, (const int*)(A.ws + WS_TOK), XCDM_GU};
    EpiGateUp E{(bf16_t*)(A.ws + WS_ACT), (const float*)(A.ws + WS_RSTL)};
    pg8::gemm_phase<EpiGateUp, MoeOrder, true, true>(lds, DM, S, E);
    sm::gateup_small(A, lds);
    {
        PG8_LAS int* pw = (PG8_LAS int*)(lds + LDS_MISC_OFF) + 40 + 4 * MT_MAX;
        const int nb = ((const PG8_LAS int*)(lds + LDS_MISC_OFF))[NEXP + 2], G = (int)gridDim.x; int pn_;
        const int per = XCDM_GU ? 8 * ((G / 8) / 4) : G / 4, rounds = per > 0 ? (nb + per - 1) / per : 1;
        const int t = (int)threadIdx.x; const bool idle_t = t < G && MoeOrder::tile_of(rounds - 1, t, G, 4, nb, pn_, XCDM_GU) < 0;
        float before = (idle_t && t < (int)blockIdx.x) ? 1.f : 0.f, all = idle_t ? 1.f : 0.f;
        before = wave_sum(before); all = wave_sum(all);
        __syncthreads();
        if ((t & 63) == 0) { pw[2 + (t >> 6)] = (int)before; pw[10 + (t >> 6)] = (int)all; }
        __syncthreads();
        if (t == 0) { int rk = 0, tot = 0; for (int w = 0; w < NWAVES; ++w) { rk += pw[2 + w]; tot += pw[10 + w]; }
            const bool me_idle = MoeOrder::tile_of(rounds - 1, (int)blockIdx.x, G, 4, nb, pn_, XCDM_GU) < 0;
            pw[0] = tot == 0 ? (int)blockIdx.x : (me_idle ? rk : -1); pw[1] = tot == 0 ? G : tot; }
        __syncthreads();
        p0_weights(A, lds, 2, pw[0], pw[1]); }
}
__device__ __forceinline__ void p7_fast(const Args& A, PG8_LAS unsigned char* lds) {
    moe_layout_lds(A, lds);
    MoeOrder S{(const char*)(A.ws + WS_ACT), (const char*)(A.ws + WS_WD), (size_t)2048 * 512 * 2, DEXP, 8, (int)gridDim.x, (int)blockIdx.x, false,
               (const PG8_LAS int*)(lds + LDS_MISC_OFF), (const unsigned*)(A.ws + WS_CTL) + CW_CNT, (const int*)(A.ws + WS_TOK), true};
    EpiDown E{(bf16_t*)(A.ws + WS_YBUF), (const float*)(A.ws + WS_GATE)};
    pg8::gemm_phase<EpiDown, MoeOrder, true, false>(lds, DEXP, S, E);
    sm::down_small(A, lds);
}

namespace fa {
typedef short bf16x8 __attribute__((ext_vector_type(8)));
typedef short v4i16 __attribute__((ext_vector_type(4)));
typedef float f32x16 __attribute__((ext_vector_type(16)));
#define FA_LAS __attribute__((address_space(3)))
constexpr int KVBUF = 65536, LDS_CK = 131072, LDS_ML = 131072 + 8192;
__device__ __forceinline__ unsigned cvtpk(float lo, float hi) { unsigned r; asm("v_cvt_pk_bf16_f32 %0, %1, %2" : "=v"(r) : "v"(lo), "v"(hi)); return r; }
__device__ __forceinline__ bf16x8 pack8(const f32x16& p, int b) { u32x4 w; w.x = cvtpk(p[b], p[b + 1]); w.y = cvtpk(p[b + 2], p[b + 3]); w.z = cvtpk(p[b + 4], p[b + 5]); w.w = cvtpk(p[b + 6], p[b + 7]); return __builtin_bit_cast(bf16x8, w); }
__device__ __forceinline__ float swapmax(float v) { auto rr = __builtin_amdgcn_permlane32_swap(__float_as_uint(v), __float_as_uint(v), false, false); return fmaxf(__uint_as_float(rr[0]), __uint_as_float(rr[1])); }
__device__ __forceinline__ float swapsum(float v) { auto rr = __builtin_amdgcn_permlane32_swap(__float_as_uint(v), __float_as_uint(v), false, false); return __uint_as_float(rr[0]) + __uint_as_float(rr[1]); }
#define FA_WAITBAR() do { asm volatile("s_waitcnt vmcnt(0) lgkmcnt(0)" ::: "memory"); __builtin_amdgcn_s_barrier(); asm volatile("" ::: "memory"); } while (0)

__device__ __forceinline__ void attn_phase(const Args& A, FA_LAS unsigned char* lds) {
    const bf16_t* Q = (const bf16_t*)(A.ws + WS_Q); const bf16_t* Kt = (const bf16_t*)(A.ws + WS_K); const bf16_t* Vt = (const bf16_t*)(A.ws + WS_VA);
    const float* CKL = (const float*)(A.ws + WS_CKL); bf16_t* MIXIN = (bf16_t*)(A.ws + WS_MIXIN);
    const int tid = threadIdx.x, lane = tid & 63, wid = __builtin_amdgcn_readfirstlane(tid >> 6), rg = wid & 3, kh = wid >> 2, r32 = lane & 31, hi = lane >> 5;
    int koff[4];
#pragma unroll
    for (int i = 0; i < 4; ++i) { const int rl = 4 * i + (lane >> 4); koff[i] = rl * 1024 + (((lane & 15) ^ rl) * 8); }
    const int voff = (lane >> 4) * 1024 + (((lane & 15) ^ ((lane >> 4) << 2)) * 8);
    int kfo[8];
#pragma unroll
    for (int d0 = 0; d0 < 8; ++d0) kfo[d0] = (kh * 64 + r32) * 256 + (((2 * d0 + hi) ^ (r32 & 15)) * 16);
    int vfo[4];
    { const int dh = (lane >> 4) & 1, q = (lane & 15) >> 2, p = lane & 3;
#pragma unroll
      for (int db = 0; db < 4; ++db) vfo[db] = (kh * 64 + 4 * hi + q) * 256 + ((db ^ q) * 64) + dh * 32 + p * 8; }
    const unsigned ldsb = (unsigned)(uintptr_t)lds;
    const int G = gridDim.x;
    for (int vb0 = blockIdx.x; vb0 < 256 * PROBE_REP_ATTN; vb0 += G) { const int vb = vb0 % 256;
        const int item = (G % 8 == 0) ? ((vb % 8) * 32 + (vb / 8)) % 256 : vb;
        const int bh = item >> 3, ii = item & 7, b = bh >> 3, h = bh & 7;
        const bf16_t* Kg = Kt + (size_t)b * SEQ * 1024 + h * 128; const bf16_t* Vg = Vt + (size_t)b * SEQ * 1024 + h * 128;
        { const f32x4 c = *(const f32x4*)(CKL + (size_t)bh * SEQ + tid * 4); *(FA_LAS f32x4*)(lds + LDS_CK + tid * 16) = (f32x4){-c.x, -c.y, -c.z, -c.w}; }
#define FA_ISSUE_K(key0, kb_) do { const bf16_t* kg_ = Kg + (size_t)((key0) + 16 * wid) * 1024; \
        _Pragma("unroll") for (int i_ = 0; i_ < 4; ++i_) __builtin_amdgcn_global_load_lds((const unsigned*)(kg_ + koff[i_]), (FA_LAS unsigned*)(lds + (kb_) * 32768 + (wid * 4 + i_) * 1024), 16, 0, 0); } while (0)
#define FA_ISSUE_V(key0, vb_) do { const bf16_t* vg_ = Vg + (size_t)((key0) + 16 * wid) * 1024; \
        _Pragma("unroll") for (int i_ = 0; i_ < 4; ++i_) __builtin_amdgcn_global_load_lds((const unsigned*)(vg_ + i_ * 4096 + voff), (FA_LAS unsigned*)(lds + 65536 + (vb_) * 32768 + (wid * 4 + i_) * 1024), 16, 0, 0); } while (0)
#define FA_DSR128(dst, addr, off) asm volatile("ds_read_b128 %0, %1 offset:%2" : "=v"(dst) : "v"(addr), "n"(off))
#define FA_DSTR(dst, addr, off) asm volatile("ds_read_b64_tr_b16 %0, %1 offset:%2" : "=v"(dst) : "v"(addr), "n"(off))
#define FA_LGKM(n) asm volatile("s_waitcnt lgkmcnt(" #n ")" ::: "memory")
#define FA_SB() __builtin_amdgcn_sched_barrier(0)
#define FA_QK_STEP(i, P0, P1, W) do { FA_LGKM(W); FA_SB(); \
        if (((i) & 1) == 0) P0 = __builtin_amdgcn_mfma_f32_32x32x16_bf16(kr[(i) & 3], qf[(i) >> 1], P0, 0, 0, 0); else P1 = __builtin_amdgcn_mfma_f32_32x32x16_bf16(kr[(i) & 3], qf[(i) >> 1], P1, 0, 0, 0); \
        FA_SB(); if ((i) + 4 < 16) FA_DSR128(kr[(i) & 3], ka_[((i) + 4) >> 1], (((i) + 4) & 1) * 8192); } while (0)
#define FA_QK(P0, P1, kbuf, kbk) do { FA_LAS const float* nck = (FA_LAS const float*)(lds + LDS_CK) + (kbk) * 128 + kh * 64 + 4 * hi; \
        _Pragma("unroll") for (int g_ = 0; g_ < 4; ++g_) { const f32x4 t0 = *(FA_LAS const f32x4*)(nck + 8 * g_), t1 = *(FA_LAS const f32x4*)(nck + 32 + 8 * g_); \
            _Pragma("unroll") for (int j_ = 0; j_ < 4; ++j_) { P0[4 * g_ + j_] = t0[j_]; P1[4 * g_ + j_] = t1[j_]; } } \
        unsigned ka_[8]; _Pragma("unroll") for (int d0 = 0; d0 < 8; ++d0) ka_[d0] = ldsb + (unsigned)((kbuf) * 32768 + kfo[d0]); \
        bf16x8 kr[4]; FA_SB(); FA_DSR128(kr[0], ka_[0], 0); FA_DSR128(kr[1], ka_[0], 8192); FA_DSR128(kr[2], ka_[1], 0); FA_DSR128(kr[3], ka_[1], 8192); \
        FA_QK_STEP(0, P0, P1, 3); FA_QK_STEP(1, P0, P1, 3); FA_QK_STEP(2, P0, P1, 3); FA_QK_STEP(3, P0, P1, 3); FA_QK_STEP(4, P0, P1, 3); FA_QK_STEP(5, P0, P1, 3); FA_QK_STEP(6, P0, P1, 3); FA_QK_STEP(7, P0, P1, 3); \
        FA_QK_STEP(8, P0, P1, 3); FA_QK_STEP(9, P0, P1, 3); FA_QK_STEP(10, P0, P1, 3); FA_QK_STEP(11, P0, P1, 3); FA_QK_STEP(12, P0, P1, 3); FA_QK_STEP(13, P0, P1, 2); FA_QK_STEP(14, P0, P1, 1); FA_QK_STEP(15, P0, P1, 0); } while (0)
#define FA_PV_STEP(i, W) do { FA_LGKM(W); FA_SB(); \
        { const bf16x8 vf_ = (bf16x8){vl[(i) & 1][0], vl[(i) & 1][1], vl[(i) & 1][2], vl[(i) & 1][3], vh[(i) & 1][0], vh[(i) & 1][1], vh[(i) & 1][2], vh[(i) & 1][3]}; \
          o[(i) >> 2] = __builtin_amdgcn_mfma_f32_32x32x16_bf16(vf_, pf[(i) & 3], o[(i) >> 2], 0, 0, 0); } \
        FA_SB(); if ((i) + 2 < 16) { FA_DSTR(vl[(i) & 1], va_[((i) + 2) >> 2], (((i) + 2) & 3) * 4096); FA_DSTR(vh[(i) & 1], va_[((i) + 2) >> 2], (((i) + 2) & 3) * 4096 + 2048); } } while (0)
        const int qbL = 15 - ii, nsteps = 17;
#define FA_KB(s_) ((s_) <= qbL ? (s_) : ii - ((s_) - qbL - 1))
        int u = 0, qb = qbL, kb = 0, g = 0;
        FA_ISSUE_K(0, 0); FA_ISSUE_V(0, 0); FA_ISSUE_K(FA_KB(1) * 128, 1);
        bf16x8 qf[8]; f32x16 o[4]; float m = -1e30f, l = 0.f;
        { const bf16_t* qp = Q + (size_t)(b * SEQ + qb * 128 + rg * 32 + r32) * 1024 + h * 128 + 8 * hi;
#pragma unroll
          for (int d0 = 0; d0 < 8; ++d0) qf[d0] = *(const bf16x8*)(qp + 16 * d0); }
#pragma unroll
        for (int db = 0; db < 4; ++db)
#pragma unroll
            for (int r = 0; r < 16; ++r) o[db][r] = 0.f;
        FA_WAITBAR();
        f32x16 p0, p1, n0, n1;
        FA_QK(p0, p1, 0, 0);
        FA_WAITBAR();
        bool diag = false, lastb = false, done = false;
#define FA_SOFTPV(C0, C1) do { \
            if (diag) { const int qrel = rg * 32 + r32, k0 = kh * 64 + 4 * hi; \
                _Pragma("unroll") for (int r = 0; r < 16; ++r) { const int kr = k0 + (r & 3) + 8 * (r >> 2); if (kr > qrel) C0[r] = -INFINITY; if (kr + 32 > qrel) C1[r] = -INFINITY; } } \
            float mx = fmaxf(C0[0], C1[0]); \
            _Pragma("unroll") for (int r = 1; r < 16; ++r) mx = fmaxf(mx, fmaxf(C0[r], C1[r])); \
            mx = swapmax(mx); \
            const float mn = fmaxf(m, mx), alpha = __builtin_amdgcn_exp2f(m - mn); m = mn; \
            float ps = 0.f; \
            _Pragma("unroll") for (int r = 0; r < 16; ++r) { C0[r] = __builtin_amdgcn_exp2f(C0[r] - mn); C1[r] = __builtin_amdgcn_exp2f(C1[r] - mn); ps += C0[r] + C1[r]; } \
            l = l * alpha + ps; \
            if (!__all(alpha == 1.0f)) { \
                _Pragma("unroll") for (int db = 0; db < 4; ++db) _Pragma("unroll") for (int r = 0; r < 16; ++r) o[db][r] *= alpha; } \
            bf16x8 pf[4]; pf[0] = pack8(C0, 0); pf[1] = pack8(C0, 8); pf[2] = pack8(C1, 0); pf[3] = pack8(C1, 8); \
            { unsigned va_[4]; \
              _Pragma("unroll") for (int db = 0; db < 4; ++db) va_[db] = ldsb + (unsigned)(65536 + (g & 1) * 32768 + vfo[db]); \
              v4i16 vl[2], vh[2]; FA_SB(); FA_DSTR(vl[0], va_[0], 0); FA_DSTR(vh[0], va_[0], 2048); FA_DSTR(vl[1], va_[0], 4096); FA_DSTR(vh[1], va_[0], 4096 + 2048); \
              FA_PV_STEP(0, 2); FA_PV_STEP(1, 2); FA_PV_STEP(2, 2); FA_PV_STEP(3, 2); FA_PV_STEP(4, 2); FA_PV_STEP(5, 2); FA_PV_STEP(6, 2); FA_PV_STEP(7, 2); \
              FA_PV_STEP(8, 2); FA_PV_STEP(9, 2); FA_PV_STEP(10, 2); FA_PV_STEP(11, 2); FA_PV_STEP(12, 2); FA_PV_STEP(13, 2); FA_PV_STEP(14, 2); FA_PV_STEP(15, 0); } } while (0)
#define FA_STEP(C0, C1, N0, N1) do { \
            diag = (kb == qb); lastb = (u == 0 ? kb == qb : kb == 0); \
            if (g + 2 < nsteps) FA_ISSUE_K(FA_KB(g + 2) * 128, g & 1); \
            if (g + 1 < nsteps) FA_ISSUE_V(FA_KB(g + 1) * 128, (g + 1) & 1); \
            const int kbn_ = (u == 0 ? kb + 1 : kb - 1); \
            if (kh == 0 && !lastb) FA_QK(N0, N1, (g + 1) & 1, kbn_); \
            FA_SOFTPV(C0, C1); \
            if (kh == 1 && !lastb) FA_QK(N0, N1, (g + 1) & 1, kbn_); \
            FA_WAITBAR(); } while (0)
#define FA_UNIT_END() do { \
            FA_LAS float* mb = (FA_LAS float*)(lds + 65536 + (g & 1) * 32768) + rg * 2048; FA_LAS float* ml = (FA_LAS float*)(lds + LDS_ML) + rg * 128; \
            const float lt = swapsum(l); \
            if (kh == 1) { ml[lane] = m; ml[64 + lane] = lt; } \
            float s1 = 0.f, s2m = 0.f; \
            _Pragma("unroll") for (int half = 0; half < 2; ++half) { \
                if (kh == 1) { \
                    _Pragma("unroll") for (int d2 = 0; d2 < 2; ++d2) _Pragma("unroll") for (int r = 0; r < 16; ++r) mb[(d2 * 16 + r) * 64 + lane] = o[2 * half + d2][r]; } \
                FA_WAITBAR(); \
                if (kh == 0) { \
                    if (half == 0) { const float m2 = ml[lane], l2 = ml[64 + lane], mm = fmaxf(m, m2), a1 = __builtin_amdgcn_exp2f(m - mm), a2 = __builtin_amdgcn_exp2f(m2 - mm); \
                        const float inv = 1.0f / (lt * a1 + l2 * a2); s1 = a1 * inv; s2m = a2 * inv; } \
                    bf16_t* op = MIXIN + (size_t)(b * SEQ + qb * 128 + rg * 32 + r32) * 2048 + 1024 + h * 128 + 4 * hi; \
                    _Pragma("unroll") for (int d2 = 0; d2 < 2; ++d2) _Pragma("unroll") for (int g4 = 0; g4 < 4; ++g4) { float v[4]; \
                        _Pragma("unroll") for (int j = 0; j < 4; ++j) v[j] = o[2 * half + d2][4 * g4 + j] * s1 + mb[(d2 * 16 + 4 * g4 + j) * 64 + lane] * s2m; \
                        u32x2 w; w.x = cvtpk(v[0], v[1]); w.y = cvtpk(v[2], v[3]); *(u32x2*)(op + 32 * (2 * half + d2) + 8 * g4) = w; } } \
                FA_WAITBAR(); } \
            if (u == 1) { done = true; } else { \
                u = 1; qb = ii; kb = ii; ++g; \
                { const bf16_t* qp = Q + (size_t)(b * SEQ + qb * 128 + rg * 32 + r32) * 1024 + h * 128 + 8 * hi; \
                  _Pragma("unroll") for (int d0 = 0; d0 < 8; ++d0) qf[d0] = *(const bf16x8*)(qp + 16 * d0); } \
                _Pragma("unroll") for (int db = 0; db < 4; ++db) _Pragma("unroll") for (int r = 0; r < 16; ++r) o[db][r] = 0.f; \
                m = -1e30f; l = 0.f; \
                FA_QK(p0, p1, g & 1, kb); \
                FA_WAITBAR(); } } while (0)
        for (;;) {
            FA_STEP(p0, p1, n0, n1);
            if (lastb) { FA_UNIT_END(); if (done) break; continue; }
            kb += (u == 0 ? 1 : -1); ++g; p0 = n0; p1 = n1;
        }
#undef FA_SOFTPV
#undef FA_STEP
#undef FA_UNIT_END
#undef FA_ISSUE_K
#undef FA_ISSUE_V
#undef FA_QK
#undef FA_QK_STEP
#undef FA_PV_STEP
#undef FA_KB
    }
}
}

namespace fs {
#define FS_LAS __attribute__((address_space(3)))
__device__ __forceinline__ void sgu_phase(const Args& A, FS_LAS unsigned char* lds) {
    const bf16_t* U = (const bf16_t*)(A.ws + WS_U); const bf16_t* V = (const bf16_t*)(A.ws + WS_V); bf16_t* MIXIN = (bf16_t*)(A.ws + WS_MIXIN);
    const float* wsp = A.in[7]; const float* bsp = A.in[8]; const float* ln_g = A.in[5]; const float* ln_b = A.in[6]; const float* VSTAT = (const float*)(A.ws + WS_VSTAT);
    const int tid = threadIdx.x, lane = tid & 63, wid = __builtin_amdgcn_readfirstlane(tid >> 6), tb = wid & 3, dh = wid >> 2, r32 = lane & 31, hi = lane >> 5;
    const int frow = tid >> 2, fq4 = tid & 3;
    int vfo[2];
    { const int d16 = (lane >> 4) & 1, q = (lane & 15) >> 2, p = lane & 3;
#pragma unroll
      for (int j = 0; j < 2; ++j) vfo[j] = 32768 + (8 * hi + q) * 256 + (((2 * dh + j) ^ q) * 64) + d16 * 32 + p * 8; }
    const int wfo = (32 * tb + r32) * 256;
    for (int u0 = blockIdx.x; u0 < (T / CHUNK) * NG * PROBE_REP_SGU; u0 += gridDim.x) { const int u = u0 % ((T / CHUNK) * NG);
        const int rc = u / NG, g = u % NG, row0 = rc * CHUNK;
        { const float* wr = wsp + ((size_t)g * CHUNK + frow) * CHUNK + fq4 * 32;
#pragma unroll
          for (int c = 0; c < 4; ++c) { const f32x4 a = *(const f32x4*)(wr + 8 * c), b2 = *(const f32x4*)(wr + 8 * c + 4); const int s0 = fq4 * 32 + 8 * c; float v[8] = {a.x, a.y, a.z, a.w, b2.x, b2.y, b2.z, b2.w};
#pragma unroll
              for (int j = 0; j < 8; ++j) if (s0 + j > frow) v[j] = 0.f;
              u32x4 w; w.x = pk2(v[0], v[1]); w.y = pk2(v[2], v[3]); w.z = pk2(v[4], v[5]); w.w = pk2(v[6], v[7]);
              *(FS_LAS u32x4*)(lds + frow * 256 + (((4 * fq4 + c) ^ (frow & 15)) * 16)) = w; }
          const bf16_t* vr = V + (size_t)(row0 + frow) * 1024 + g * 128 + fq4 * 32;
          float mean, rstd;
          { const f32x4 pa = *(const f32x4*)(VSTAT + ((size_t)(row0 + frow) * 16 + 4 * fq4) * 2), pb = *(const f32x4*)(VSTAT + ((size_t)(row0 + frow) * 16 + 4 * fq4) * 2 + 4);
            float s1 = (pa[0] + pa[2]) + (pb[0] + pb[2]), s2 = (pa[1] + pa[3]) + (pb[1] + pb[3]);
            s1 += __shfl_xor(s1, 1); s1 += __shfl_xor(s1, 2); s2 += __shfl_xor(s2, 1); s2 += __shfl_xor(s2, 2);
            mean = s1 * (1.f / 1024.f); rstd = rsqrtf(fmaxf(s2 * (1.f / 1024.f) - mean * mean, 0.f) + EPS); }
#pragma unroll
          for (int c = 0; c < 4; ++c) { const u32x4 w = *(const u32x4*)(vr + 8 * c); const int cb = g * 128 + fq4 * 32 + 8 * c;
              const f32x4 ga = *(const f32x4*)(ln_g + cb), gb = *(const f32x4*)(ln_g + cb + 4), ba = *(const f32x4*)(ln_b + cb), bb = *(const f32x4*)(ln_b + cb + 4);
              float v[8];
#pragma unroll
              for (int e2 = 0; e2 < 4; ++e2) { v[2 * e2] = __uint_as_float(w[e2] << 16); v[2 * e2 + 1] = __uint_as_float(w[e2] & 0xffff0000u); }
              u32x4 o; o.x = pk2((v[0] - mean) * rstd * ga[0] + ba[0], (v[1] - mean) * rstd * ga[1] + ba[1]); o.y = pk2((v[2] - mean) * rstd * ga[2] + ba[2], (v[3] - mean) * rstd * ga[3] + ba[3]);
              o.z = pk2((v[4] - mean) * rstd * gb[0] + bb[0], (v[5] - mean) * rstd * gb[1] + bb[1]); o.w = pk2((v[6] - mean) * rstd * gb[2] + bb[2], (v[7] - mean) * rstd * gb[3] + bb[3]);
              *(FS_LAS u32x4*)(lds + 32768 + frow * 256 + (((4 * fq4 + c) ^ ((frow & 3) << 2)) * 16)) = o; } }
        __syncthreads();
        fa::f32x16 acc[2];
#pragma unroll
        for (int j = 0; j < 2; ++j)
#pragma unroll
            for (int r = 0; r < 16; ++r) acc[j][r] = 0.f;
        for (int s = 0; s <= 2 * tb + 1; ++s) {
            const fa::bf16x8 wf = *(FS_LAS const fa::bf16x8*)(lds + wfo + (((2 * s + hi) ^ (r32 & 15)) * 16));
#pragma unroll
            for (int j = 0; j < 2; ++j) {
                const fa::v4i16 lo = __builtin_amdgcn_ds_read_tr16_b64_v4i16((FS_LAS fa::v4i16*)(lds + vfo[j] + s * 4096));
                const fa::v4i16 hh = __builtin_amdgcn_ds_read_tr16_b64_v4i16((FS_LAS fa::v4i16*)(lds + vfo[j] + s * 4096 + 1024));
                const fa::bf16x8 vf = (fa::bf16x8){lo[0], lo[1], lo[2], lo[3], hh[0], hh[1], hh[2], hh[3]};
                acc[j] = __builtin_amdgcn_mfma_f32_32x32x16_bf16(vf, wf, acc[j], 0, 0, 0); }
        }
        { const int tt = 32 * tb + r32; const float bb = bsp[g * CHUNK + tt]; const size_t rw = (size_t)(row0 + tt);
          u32x2 uu[2][4];
#pragma unroll
          for (int j = 0; j < 2; ++j)
#pragma unroll
              for (int g4 = 0; g4 < 4; ++g4) uu[j][g4] = *(const u32x2*)(U + rw * 1024 + g * 128 + 32 * (2 * dh + j) + 8 * g4 + 4 * hi);
#pragma unroll
          for (int j = 0; j < 2; ++j)
#pragma unroll
              for (int g4 = 0; g4 < 4; ++g4) { const int d = 32 * (2 * dh + j) + 8 * g4 + 4 * hi; const u32x2 u2 = uu[j][g4];
                  const float u0 = __uint_as_float(u2.x << 16), u1 = __uint_as_float(u2.x & 0xffff0000u), u2f = __uint_as_float(u2.y << 16), u3 = __uint_as_float(u2.y & 0xffff0000u);
                  u32x2 w; w.x = fa::cvtpk(u0 * (acc[j][4 * g4] + bb), u1 * (acc[j][4 * g4 + 1] + bb)); w.y = fa::cvtpk(u2f * (acc[j][4 * g4 + 2] + bb), u3 * (acc[j][4 * g4 + 3] + bb));
                  *(u32x2*)(MIXIN + rw * 2048 + g * 128 + d) = w; } }
        __syncthreads();
    }
}
}


#define XB_TMO      128
#define XB_XCNT(j)  (256  + 64 * (j))
#define XB_XSUB(j)  (1280 + 64 * (j))
#define XB_XGEN(j)  (2304 + 64 * (j))
#define XB_TOP      3328
#define XB_TOPGEN   3392
#define XCD_BAR_WORDS 3456
#define XB_SPIN_CAP (1u << 18)
#define XLAS __attribute__((address_space(3)))
__device__ __forceinline__ unsigned xb_ld(unsigned* p)              { return __hip_atomic_load(p, __ATOMIC_RELAXED, __HIP_MEMORY_SCOPE_AGENT); }
__device__ __forceinline__ unsigned xb_add(unsigned* p, unsigned v) { return __hip_atomic_fetch_add(p, v, __ATOMIC_RELAXED, __HIP_MEMORY_SCOPE_AGENT); }
__device__ __forceinline__ unsigned xb_xcc_id() { return (unsigned)__builtin_amdgcn_s_getreg((3 << 11) | 20) & 0xFu; }
#define XB_SPIN(cond, bar) do { unsigned _sp = 0; while (cond) { __builtin_amdgcn_s_sleep(1); \
    if ((++_sp & 255u) == 0u) { if (xb_ld(&(bar)[XB_TMO])) break; if (_sp > XB_SPIN_CAP) { atomicAdd(&(bar)[XB_TMO], 1u); break; } } } } while (0)
struct XcdBarrier { unsigned* bar; unsigned x; volatile XLAS unsigned* st; };
__device__ __forceinline__ XcdBarrier xcd_barrier_post(unsigned* bar, volatile XLAS unsigned* st) {
    XcdBarrier b; b.bar = bar; b.x = xb_xcc_id(); b.st = st;
    if (threadIdx.x == 0) (void)xb_add(&bar[XB_XCNT(b.x)], 1u);
    return b;
}
__device__ __forceinline__ void xcd_barrier_complete(unsigned* bar, unsigned x, unsigned& nloc, unsigned& nx) {
    const unsigned G = gridDim.x * gridDim.y * gridDim.z;
    unsigned sum, cnt, mine, sp = 0u;
    for (;;) {
        sum = 0u; cnt = 0u; mine = 0u;
#pragma unroll
        for (unsigned j = 0; j < 16; ++j) { const unsigned c = xb_ld(&bar[XB_XCNT(j)]); sum += c; cnt += (c > 0u) ? 1u : 0u; mine = (j == x) ? c : mine; }
        if (sum == G) break;
        __builtin_amdgcn_s_sleep(1);
        if ((++sp & 255u) == 0u) { if (xb_ld(&bar[XB_TMO])) break; if (sp > XB_SPIN_CAP) { atomicAdd(&bar[XB_TMO], 1u); break; } }
    }
    nloc = mine > 0u ? mine : 1u; nx = cnt > 0u ? cnt : 1u;
}
__device__ __forceinline__ void xcd_barrier(const XcdBarrier& b) {
    asm volatile("s_waitcnt vmcnt(0)" ::: "memory");
    __syncthreads();
    if (threadIdx.x == 0) {
        unsigned* bar = b.bar;
        __builtin_amdgcn_s_waitcnt(0);
        unsigned nloc = b.st[0], nx = b.st[1];
        if (nloc == 0u) { xcd_barrier_complete(bar, b.x, nloc, nx); b.st[0] = nloc; b.st[1] = nx; }
        const unsigned old = xb_add(&bar[XB_XSUB(b.x)], 1u);
        const unsigned gen = old / nloc;
        if (old + 1u == (gen + 1u) * nloc) {
            __builtin_amdgcn_fence(__ATOMIC_RELEASE, "agent");
            asm volatile("s_waitcnt vmcnt(0)" ::: "memory");
            const unsigned og = xb_add(&bar[XB_TOP], 1u);
            const unsigned tg = og / nx;
            if (og + 1u == (tg + 1u) * nx) xb_add(&bar[XB_TOPGEN], 1u);
            else XB_SPIN(xb_ld(&bar[XB_TOPGEN]) == tg, bar);
            __builtin_amdgcn_fence(__ATOMIC_ACQUIRE, "agent");
            xb_add(&bar[XB_XGEN(b.x)], 1u);
            asm volatile("s_waitcnt vmcnt(0)" ::: "memory");
        } else {
            XB_SPIN(xb_ld(&bar[XB_XGEN(b.x)]) == gen, bar);
            __builtin_amdgcn_fence(__ATOMIC_ACQUIRE, "agent");
            asm volatile("s_waitcnt vmcnt(0)" ::: "memory");
        }
    }
    __syncthreads();
}
constexpr int CW_BAR = 4096;
constexpr size_t CTL_ZERO_BYTES = 65536;
constexpr int LDS_BARST_OFF = LDS_BYTES - 16;

constexpr bool FAST_P1 = true, FAST_P3 = true, FAST_P4 = true, FAST_P6 = true, FAST_P7 = true;
constexpr bool FAST_ATTN = true, FAST_SGU = true;
constexpr bool FAST_ANY = FAST_P1 || FAST_P3 || FAST_P4 || FAST_P6 || FAST_P7;
constexpr int N_PHASES = 10;
__global__ void __launch_bounds__(NTHREADS, 2) fwd(Args A) {
    extern __shared__ __attribute__((aligned(16))) unsigned char lds[];
    float* ldsf = (float*)lds;
    const int lo = A.ph_lo, hi = A.ph_hi;
    if (threadIdx.x < 4) ((volatile XLAS unsigned*)((XLAS unsigned char*)lds + LDS_BARST_OFF))[threadIdx.x] = 0u;
    __syncthreads();
    XcdBarrier bar = xcd_barrier_post((unsigned*)(A.ws + WS_CTL) + CW_BAR, (volatile XLAS unsigned*)((XLAS unsigned char*)lds + LDS_BARST_OFF));
#define IN(k) (lo <= (k) && (k) < hi)
#define SEAM(k) do { if (IN(k) && IN((k) + 1)) xcd_barrier(bar); STAMP((k) + 1); } while (0)
    unsigned long long t_lo = 0, t_hi = 0;
#define STAMP(i) do { if (STAMP_PHASE >= 0) { if ((i) == STAMP_PHASE || (STAMP_PHASE == 98 && (i) == 0)) t_lo = __builtin_amdgcn_s_memrealtime(); if ((i) == STAMP_PHASE + 1 || (STAMP_PHASE == 98 && (i) == 9)) t_hi = __builtin_amdgcn_s_memrealtime(); } } while (0)
    STAMP(0);
    PG8_LAS unsigned char* l3 = (PG8_LAS unsigned char*)lds;
    if (IN(0)) { if (FAST_ANY) { p0_weights(A, l3, 0, (int)blockIdx.x, (int)gridDim.x); __syncthreads(); } p0_router_weights(A); p0_rows(A, ldsf); } SEAM(0);
    if (IN(1)) { if (FAST_P1 && FAST_ATTN && (int)blockIdx.x >= (int)gridDim.x - NB * NH) cumsum_bh(A, (int)blockIdx.x - ((int)gridDim.x - NB * NH), ldsf); if (FAST_P1) p1_fast(A, l3); else p1_naive(A, ldsf); if (FAST_ANY) { __syncthreads(); { const int r_ = 1152 % (int)gridDim.x; p0_weights(A, l3, 1, r_ == 0 ? (int)blockIdx.x : (int)blockIdx.x - r_, r_ == 0 ? (int)gridDim.x : (int)gridDim.x - r_); } } } SEAM(1);
    if (!(FAST_P1 && FAST_SGU && FAST_ATTN)) { if (IN(2)) { p1b_fix<0>(A, ldsf); } SEAM(2); }
    if (IN(3)) { if (FAST_SGU) fs::sgu_phase(A, l3); else p2_sgu_naive(A); if (FAST_ATTN) { __syncthreads(); fa::attn_phase(A, l3); } else p2_attn_naive(A, ldsf); } SEAM(3);
    if (IN(4)) { if (FAST_P3) p3_fast(A, l3); else p3_naive(A, ldsf); } SEAM(4);
    if (IN(5)) { if (FAST_P4) p4_fast(A, l3); else p4_naive(A, ldsf); } SEAM(5);
    if (IN(6)) { if (PROBE_ALT == 6) { p5_router3<1>(A, ldsf); __syncthreads(); } if (PROBE_ALT == 62) { p5_router3<2>(A, ldsf); __syncthreads(); } if (PROBE_ALT == 63) { p5_router3<3>(A, ldsf); __syncthreads(); } p5_router3<0>(A, ldsf); } SEAM(6);
    if (IN(7)) { if (FAST_P6) p6_fast(A, l3); else p6_naive(A, ldsf); } SEAM(7);
    if (IN(8)) { if (FAST_P7) p7_fast(A, l3); else p7_naive(A, ldsf); } SEAM(8);
    if (IN(9)) { if (PROBE_ALT == 9) { p8_combine<1>(A, ldsf); __syncthreads(); } p8_combine<0>(A, ldsf, STAMP_PHASE < 0 ? 0.f : (STAMP_PHASE == 99 ? 1.0f : (float)(t_hi - t_lo) * 0.01f * 0.001f * STAMP_SCALE)); }
#undef IN
#undef SEAM
}

#ifndef MK_N_LAUNCHES
#define MK_N_LAUNCHES 1
#endif
extern "C" void kernel_launch(void* const* d_in, const int* in_sizes, int n_in, void* d_out, int out_size, void* d_ws, size_t ws_size, hipStream_t stream) {
    static int grid = 0;
    if (grid == 0) {
        if (n_in != 22 || out_size != T * DM || ws_size < WS_END) { fprintf(stderr, "kernel_launch: unexpected shapes (n_in %d out %d ws %zu)\n", n_in, out_size, ws_size); grid = -1; return; }
        int dev = 0, cus = 0, per_cu = 0;
        hipGetDevice(&dev); hipDeviceGetAttribute(&cus, hipDeviceAttributeMultiprocessorCount, dev);
        hipFuncSetAttribute((const void*)fwd, hipFuncAttributeMaxDynamicSharedMemorySize, LDS_BYTES);
        hipOccupancyMaxActiveBlocksPerMultiprocessor(&per_cu, (const void*)fwd, NTHREADS, LDS_BYTES);
        if (per_cu < 1) { fprintf(stderr, "kernel_launch: occupancy query says %d blocks per CU\n", per_cu); per_cu = 1; }
        (void)hipGetLastError();
        grid = cus;
    }
    if (grid < 0) return;
    Args a{};
    for (int i = 0; i < 22; ++i) a.in[i] = (const float*)d_in[i];
    a.out = (float*)d_out; a.ws = (unsigned char*)d_ws;
    if (hipMemsetAsync((char*)d_ws + WS_CTL, 0, CTL_ZERO_BYTES, stream) != hipSuccess) { fprintf(stderr, "kernel_launch: memset failed\n"); return; }
    if (MK_N_LAUNCHES == 1) {
        a.ph_lo = 0; a.ph_hi = N_PHASES;
        hipLaunchKernelGGL(fwd, dim3(grid), dim3(NTHREADS), LDS_BYTES, stream, a);
    } else {
        for (int p = 0; p < N_PHASES; ++p) { a.ph_lo = p; a.ph_hi = p + 1; hipLaunchKernelGGL(fwd, dim3(grid), dim3(NTHREADS), LDS_BYTES, stream, a); }
    }
}
```

```cpp
#include <hip/hip_runtime.h>
#include <hip/hip_cooperative_groups.h>
#include <cstdio>
#include <cstdint>
namespace cg = cooperative_groups;

#ifndef STAMP_PHASE
#define STAMP_PHASE -1
#endif
#ifndef STAMP_SEL
#define STAMP_SEL 0
#endif
#ifndef STAMP_SCALE
#define STAMP_SCALE 0.5f
#endif
#ifndef PROBE_REP_P1
#define PROBE_REP_P1 1
#endif
#ifndef PROBE_REP_P4
#define PROBE_REP_P4 1
#endif
#ifndef PROBE_REP_P5
#define PROBE_REP_P5 1
#endif
#ifndef PROBE_REP_MOE
#define PROBE_REP_MOE 1
#endif
#ifndef PROBE_REP_ATTN
#define PROBE_REP_ATTN 1
#endif
#ifndef PROBE_REP_SGU
#define PROBE_REP_SGU 1
#endif
#ifndef PROBE_ATTN_VAR
#define PROBE_ATTN_VAR 0
#endif
#ifndef PROBE_ALT
#define PROBE_ALT -1
#endif
constexpr int T = 8192, SEQ = 2048, NB = 4, DM = 2048, SGUW = 1024, FOXW = 1024, NH = 8, HD = 128, CHUNK = 128, NG = 8;
constexpr int INCOLS = 9224, OFF_F = 5120, OFF_GATE = 5128;
constexpr int NEXP = 32, EPG = 8, NGRP = 4, DEXP = 512;
constexpr float EPS = 1e-6f;
constexpr float LOG2E = 1.4426950408889634f;
constexpr float QSCALE = 0.08838834764831845f * LOG2E;
constexpr int NTHREADS = 512, NWAVES = 8;
constexpr int LDS_BYTES = 160 * 1024;
constexpr int MTILE = 256;
constexpr int PMAX = 2 * T + NEXP * MTILE;
constexpr int MT_MAX = PMAX / MTILE;
constexpr bool XCDM_GU = true;
constexpr int TINY_ROWS = 0;

typedef unsigned short bf16_t;
typedef float f32x4 __attribute__((ext_vector_type(4)));
typedef unsigned u32x4 __attribute__((ext_vector_type(4)));
typedef unsigned u32x2 __attribute__((ext_vector_type(2)));

constexpr size_t MiB = 1u << 20;
constexpr size_t WS_CTL = 0;
constexpr size_t WS_LOGF = 1 * MiB;
constexpr size_t WS_CKL = 2 * MiB;
constexpr size_t WS_TOK = 3 * MiB;
constexpr size_t WS_GATE = 4 * MiB;
constexpr size_t WS_ASG = 5 * MiB;
constexpr size_t WS_WIN = 8 * MiB;
constexpr size_t WS_WPROJ = 44 * MiB;
constexpr size_t WS_WOUT = 52 * MiB;
constexpr size_t WS_WGU = 60 * MiB;
constexpr size_t WS_WD = 188 * MiB;
constexpr size_t WS_H = 252 * MiB;
constexpr size_t WS_MIXED = WS_H;
constexpr size_t WS_U = 284 * MiB;
constexpr size_t WS_V = 300 * MiB;
constexpr size_t WS_G = 316 * MiB;
constexpr size_t WS_YBUF = WS_U;
constexpr size_t WS_Q = 380 * MiB;
constexpr size_t WS_K = 396 * MiB;
constexpr size_t WS_VA = 412 * MiB;
constexpr size_t WS_ACT = WS_Q;
constexpr size_t WS_MIXIN = 428 * MiB;
constexpr size_t WS_H2 = WS_MIXIN;
constexpr size_t WS_END = 460 * MiB;
static_assert((size_t)PMAX * 2048 * 2 <= 96 * MiB && (size_t)PMAX * 512 * 2 <= 32 * MiB, "overlay sizes");

constexpr int CW_CNT = 0;
constexpr int CNT_STRIDE = 64;

__device__ __forceinline__ float bf2f(bf16_t v) { return __uint_as_float((unsigned)v << 16); }
__device__ __forceinline__ bf16_t f2bf(float f) { unsigned u = __float_as_uint(f); return (bf16_t)((u + 0x7fffu + ((u >> 16) & 1u)) >> 16); }
__device__ __forceinline__ unsigned pk2(float lo, float hi) { return (unsigned)f2bf(lo) | ((unsigned)f2bf(hi) << 16); }
__device__ __forceinline__ unsigned cvtpk_rne(float lo, float hi) { unsigned r; asm("v_cvt_pk_bf16_f32 %0, %1, %2" : "=v"(r) : "v"(lo), "v"(hi)); return r; }
__device__ __forceinline__ float wave_sum(float v) {
#pragma unroll
    for (int o = 1; o < 64; o <<= 1) v += __shfl_xor(v, o);
    return v;
}
__device__ __forceinline__ float wave_max(float v) {
#pragma unroll
    for (int o = 1; o < 64; o <<= 1) v = fmaxf(v, __shfl_xor(v, o));
    return v;
}
__device__ __forceinline__ float gelu_tanh(float x) {
    const float c = 0.7978845608028654f; const float y = c * (x + 0.044715f * x * x * x);
    return x / (1.0f + __expf(-2.0f * y));
}
__device__ __forceinline__ float sigmoidf_(float x) { return 1.0f / (1.0f + __expf(-x)); }
__device__ __forceinline__ float log_sigmoid(float z) { return fminf(z, 0.f) - log1pf(__expf(-fabsf(z))); }

struct Args {
    const float* in[22];
    float* out;
    unsigned char* ws;
    int ph_lo, ph_hi;
};

template <class AF, class BF, class EF>
__device__ __forceinline__ void naive_gemm_tile(float* lds, int m0, int n0, int M, int N, int K, int Ksplit, AF a, BF b, EF epi) {
    float* As = lds;
    float* Bs = lds + 16 * 132;
    const int tid = threadIdx.x, ty = tid >> 4, tx = tid & 15;
    float acc[4][8], acc1[4][8];
#pragma unroll
    for (int i = 0; i < 4; ++i)
#pragma unroll
        for (int j = 0; j < 8; ++j) { acc[i][j] = 0.f; acc1[i][j] = 0.f; }
    const bool split = Ksplit < K;
#pragma unroll 1
    for (int pass = 0; pass < 2; ++pass) {
        const int kb = pass == 0 ? 0 : Ksplit, ke = pass == 0 ? (split ? Ksplit : K) : K;
        if (pass == 1) {
            if (!split) break;
#pragma unroll
            for (int i = 0; i < 4; ++i)
#pragma unroll
                for (int j = 0; j < 8; ++j) { acc1[i][j] = acc[i][j]; acc[i][j] = 0.f; }
        }
#pragma unroll 1
        for (int k0 = kb; k0 < ke; k0 += 16) {
#pragma unroll
            for (int i = 0; i < 4; ++i) { const int idx = tid + i * 512, r = idx >> 4, kk = idx & 15; const int m = m0 + r; As[kk * 132 + r] = (m < M) ? a(m, k0 + kk) : 0.f; }
#pragma unroll
            for (int i = 0; i < 4; ++i) { const int idx = tid + i * 512, kk = idx >> 7, n = idx & 127; Bs[kk * 132 + n] = (n0 + n < N) ? b(k0 + kk, n0 + n) : 0.f; }
            __syncthreads();
#pragma unroll 4
            for (int kk = 0; kk < 16; ++kk) {
                float av[4], bv[8];
#pragma unroll
                for (int i = 0; i < 4; ++i) av[i] = As[kk * 132 + ty * 4 + i];
#pragma unroll
                for (int j = 0; j < 8; ++j) bv[j] = Bs[kk * 132 + tx * 8 + j];
#pragma unroll
                for (int i = 0; i < 4; ++i)
#pragma unroll
                    for (int j = 0; j < 8; ++j) acc[i][j] = fmaf(av[i], bv[j], acc[i][j]);
            }
            __syncthreads();
        }
    }
#pragma unroll
    for (int i = 0; i < 4; ++i)
#pragma unroll
        for (int j = 0; j < 8; ++j) { const int m = m0 + ty * 4 + i, n = n0 + tx * 8 + j; if (m < M && n < N) epi(m, n, split ? acc1[i][j] : acc[i][j], split ? acc[i][j] : 0.f); }
}
template <class AF, class BF, class EF>
__device__ __forceinline__ void naive_gemm(float* lds, int M, int N, int K, int Ksplit, AF a, BF b, EF epi) {
    const int ntm = (M + 127) / 128, ntn = (N + 127) / 128;
    for (int t = blockIdx.x; t < ntm * ntn; t += gridDim.x) naive_gemm_tile(lds, (t / ntn) * 128, (t % ntn) * 128, M, N, K, Ksplit, a, b, epi);
}

__device__ __forceinline__ void p0_rows(const Args& A, float* ldsf) {
    const float* x = A.in[0]; const float* g1 = A.in[1]; const float* w_in = A.in[2]; const float* b_forget = A.in[4];
    bf16_t* H = (bf16_t*)(A.ws + WS_H); float* LOGF = (float*)(A.ws + WS_LOGF);
    const int tid = threadIdx.x, lane = tid & 63, wave = tid >> 6;
    for (int i = tid; i < DM * 8; i += NTHREADS) ldsf[i] = w_in[(size_t)(i >> 3) * INCOLS + OFF_F + (i & 7)];
    __syncthreads();
    const int gw = blockIdx.x * NWAVES + wave, NGW = gridDim.x * NWAVES;
    for (int row = gw; row < T; row += NGW) {
        const f32x4* xr = (const f32x4*)(x + (size_t)row * DM) + lane;
        f32x4 xv[8]; float ss = 0.f;
#pragma unroll
        for (int j = 0; j < 8; ++j) xv[j] = xr[64 * j];
#pragma unroll
        for (int j = 0; j < 8; ++j) ss += xv[j].x * xv[j].x + xv[j].y * xv[j].y + xv[j].z * xv[j].z + xv[j].w * xv[j].w;
        const float rstd = rsqrtf(wave_sum(ss) * (1.f / DM) + EPS);
        float f[8];
#pragma unroll
        for (int h = 0; h < 8; ++h) f[h] = 0.f;
#pragma unroll
        for (int j = 0; j < 8; ++j) {
            const int c0 = 256 * j + 4 * lane; const f32x4 g = *(const f32x4*)(g1 + c0);
            f32x4 hv; hv.x = xv[j].x * rstd * g.x; hv.y = xv[j].y * rstd * g.y; hv.z = xv[j].z * rstd * g.z; hv.w = xv[j].w * rstd * g.w;
            u32x2 o; o.x = pk2(hv.x, hv.y); o.y = pk2(hv.z, hv.w);
            *(u32x2*)(H + (size_t)row * DM + c0) = o;
#pragma unroll
            for (int e = 0; e < 4; ++e) { const float hx = hv[e]; const float* wf = ldsf + (c0 + e) * 8;
#pragma unroll
                for (int h = 0; h < 8; ++h) f[h] = fmaf(hx, wf[h], f[h]); }
            asm volatile("" ::: "memory");
        }
#pragma unroll
        for (int h = 0; h < 8; ++h) f[h] = wave_sum(f[h]);
        if (lane < 8) { float z = 0.f;
#pragma unroll
            for (int h = 0; h < 8; ++h) if (lane == h) z = f[h];
            LOGF[(size_t)row * 8 + lane] = log_sigmoid(z + b_forget[lane]); }
    }
}

__device__ __forceinline__ void p1_naive(const Args& A, float* ldsf) {
    const bf16_t* H = (const bf16_t*)(A.ws + WS_H); const float* w_in = A.in[2]; const float* b_gate = A.in[3];
    bf16_t* U = (bf16_t*)(A.ws + WS_U); bf16_t* V = (bf16_t*)(A.ws + WS_V); bf16_t* Q = (bf16_t*)(A.ws + WS_Q); bf16_t* K = (bf16_t*)(A.ws + WS_K);
    bf16_t* VA = (bf16_t*)(A.ws + WS_VA); bf16_t* G = (bf16_t*)(A.ws + WS_G);
    naive_gemm(ldsf, T, 9216, DM, DM,
        [=](int m, int k) { return bf2f(H[(size_t)m * DM + k]); },
        [=](int k, int n) { const int c = n < 5120 ? n : n + 8; return w_in[(size_t)k * INCOLS + c]; },
        [=](int m, int n, float s, float) {
            if (n < 1024) U[(size_t)m * 1024 + n] = f2bf(gelu_tanh(s));
            else if (n < 2048) V[(size_t)m * 1024 + n - 1024] = f2bf(gelu_tanh(s));
            else if (n < 3072) Q[(size_t)m * 1024 + n - 2048] = f2bf(s);
            else if (n < 4096) K[(size_t)m * 1024 + n - 3072] = f2bf(s);
            else if (n < 5120) VA[(size_t)m * 1024 + n - 4096] = f2bf(s);
            else G[(size_t)m * 4096 + n - 5120] = f2bf(sigmoidf_(s + b_gate[n - 5120]));
        });
}

template <int ALT> __device__ __forceinline__ void p1b_fix(const Args& A, float* ldsf) {
    bf16_t* V = (bf16_t*)(A.ws + WS_V); bf16_t* Q = (bf16_t*)(A.ws + WS_Q); bf16_t* K = (bf16_t*)(A.ws + WS_K);
    const size_t altoff = ALT ? ((size_t)((unsigned char*)A.out - (A.ws + WS_V))) / 2 : 0;
    const size_t altq = ALT ? ((size_t)((unsigned char*)A.out + 16 * MiB - (A.ws + WS_Q))) / 2 : 0, altk = ALT ? ((size_t)((unsigned char*)A.out + 32 * MiB - (A.ws + WS_K))) / 2 : 0;
    const float* ln_g = A.in[5]; const float* ln_b = A.in[6]; const float* qg = A.in[9]; const float* kg = A.in[10];
    const int tid = threadIdx.x, lane = tid & 63, wave = tid >> 6;
    const int gw = blockIdx.x * NWAVES + wave, NGW = gridDim.x * NWAVES;
    for (int row = gw; row < T; row += NGW) {
        {
            bf16_t* vr = V + (size_t)row * 1024; float v[16]; float s = 0.f;
#pragma unroll
            for (int j = 0; j < 2; ++j) { const u32x4 w = *(const u32x4*)(vr + 512 * j + 8 * lane);
#pragma unroll
                for (int e = 0; e < 4; ++e) { v[8 * j + 2 * e] = __uint_as_float(w[e] << 16); v[8 * j + 2 * e + 1] = __uint_as_float(w[e] & 0xffff0000u); } }
#pragma unroll
            for (int i = 0; i < 16; ++i) s += v[i];
            const float mean = wave_sum(s) * (1.f / 1024.f); float q = 0.f;
#pragma unroll
            for (int i = 0; i < 16; ++i) { v[i] -= mean; q += v[i] * v[i]; }
            const float rstd = rsqrtf(wave_sum(q) * (1.f / 1024.f) + EPS);
#pragma unroll
            for (int j = 0; j < 2; ++j) { const int c0 = 512 * j + 8 * lane; u32x4 o;
#pragma unroll
                for (int e = 0; e < 4; ++e) o[e] = pk2(v[8 * j + 2 * e] * rstd * ln_g[c0 + 2 * e] + ln_b[c0 + 2 * e], v[8 * j + 2 * e + 1] * rstd * ln_g[c0 + 2 * e + 1] + ln_b[c0 + 2 * e + 1]);
                *(u32x4*)(vr + altoff + c0) = o; }
        }
#pragma unroll
        for (int which = 0; which < 2; ++which) {
            bf16_t* pr = (which == 0 ? Q : K) + (size_t)row * 1024 + 16 * lane; const float* gg = which == 0 ? qg : kg; float v[16]; float s = 0.f;
#pragma unroll
            for (int j = 0; j < 2; ++j) { const u32x4 w = *(const u32x4*)(pr + 8 * j);
#pragma unroll
                for (int e = 0; e < 4; ++e) { v[8 * j + 2 * e] = __uint_as_float(w[e] << 16); v[8 * j + 2 * e + 1] = __uint_as_float(w[e] & 0xffff0000u); } }
#pragma unroll
            for (int i = 0; i < 16; ++i) s += v[i] * v[i];
            s += __shfl_xor(s, 1); s += __shfl_xor(s, 2); s += __shfl_xor(s, 4);
            const float sc = rsqrtf(s * (1.f / 128.f) + EPS) * (which == 0 ? QSCALE : 1.f); const int d0 = (16 * lane) & 127;
#pragma unroll
            for (int j = 0; j < 2; ++j) { u32x4 o;
#pragma unroll
                for (int e = 0; e < 4; ++e) o[e] = pk2(v[8 * j + 2 * e] * sc * gg[d0 + 8 * j + 2 * e], v[8 * j + 2 * e + 1] * sc * gg[d0 + 8 * j + 2 * e + 1]);
                *(u32x4*)(pr + (which == 0 ? altq : altk) + 8 * j) = o; }
        }
    }
    if (blockIdx.x < NB * NH) {
        const int b = blockIdx.x / NH, h = blockIdx.x % NH; const float* LOGF = (const float*)(A.ws + WS_LOGF); float* CKL = (float*)(A.ws + WS_CKL) + (size_t)blockIdx.x * SEQ + (ALT ? 65536 : 0);
        float v[4]; float s = 0.f;
#pragma unroll
        for (int i = 0; i < 4; ++i) { v[i] = LOGF[(size_t)(b * SEQ + tid * 4 + i) * 8 + h]; s += v[i]; }
        float incl = s;
#pragma unroll
        for (int o = 1; o < 64; o <<= 1) { const float t = __shfl_up(incl, o); if (lane >= o) incl += t; }
        __syncthreads();
        if (lane == 63) ldsf[wave] = incl;
        __syncthreads();
        float base = 0.f;
        for (int w = 0; w < wave; ++w) base += ldsf[w];
        float run = base + incl - s;
#pragma unroll
        for (int i = 0; i < 4; ++i) { run += v[i]; CKL[tid * 4 + i] = run * LOG2E; }
        __syncthreads();
    }
}


__device__ __forceinline__ void cumsum_bh(const Args& A, int bh, float* ldsf) {
    const int tid = threadIdx.x, lane = tid & 63, wave = tid >> 6, b = bh / NH, h = bh % NH;
    const float* LOGF = (const float*)(A.ws + WS_LOGF); float* CKL = (float*)(A.ws + WS_CKL) + (size_t)bh * SEQ;
    float v[4]; float sm = 0.f;
#pragma unroll
    for (int i = 0; i < 4; ++i) { v[i] = LOGF[(size_t)(b * SEQ + tid * 4 + i) * 8 + h]; sm += v[i]; }
    float incl = sm;
#pragma unroll
    for (int o = 1; o < 64; o <<= 1) { const float t = __shfl_up(incl, o); if (lane >= o) incl += t; }
    if (lane == 63) ldsf[wave] = incl;
    __syncthreads();
    float run = incl - sm;
    for (int w = 0; w < wave; ++w) run += ldsf[w];
    f32x4 o4;
#pragma unroll
    for (int i = 0; i < 4; ++i) { run += v[i]; o4[i] = run * LOG2E; }
    *(f32x4*)(CKL + tid * 4) = o4;
    __syncthreads();
}

__device__ __forceinline__ void p2_sgu_naive(const Args& A) {
    const bf16_t* U = (const bf16_t*)(A.ws + WS_U); const bf16_t* V = (const bf16_t*)(A.ws + WS_V); bf16_t* MIXIN = (bf16_t*)(A.ws + WS_MIXIN);
    const float* wsp = A.in[7]; const float* bsp = A.in[8];
    const int tid = threadIdx.x, tt = tid >> 2, dp = tid & 3;
    for (int u = blockIdx.x; u < (T / CHUNK) * NG; u += gridDim.x) {
        const int rc = u / NG, g = u % NG; const int row0 = rc * CHUNK;
        float acc[32];
#pragma unroll
        for (int i = 0; i < 32; ++i) acc[i] = 0.f;
        for (int ss = 0; ss <= tt; ++ss) {
            const float w = wsp[((size_t)g * CHUNK + tt) * CHUNK + ss];
            const bf16_t* vr = V + (size_t)(row0 + ss) * 1024 + g * 128 + dp * 32;
#pragma unroll
            for (int i = 0; i < 32; ++i) acc[i] = fmaf(w, bf2f(vr[i]), acc[i]);
        }
        const float bb = bsp[g * CHUNK + tt];
        const bf16_t* ur = U + (size_t)(row0 + tt) * 1024 + g * 128 + dp * 32; bf16_t* orow = MIXIN + (size_t)(row0 + tt) * 2048 + g * 128 + dp * 32;
#pragma unroll
        for (int i = 0; i < 32; ++i) orow[i] = f2bf(bf2f(ur[i]) * (acc[i] + bb));
    }
}
__device__ __forceinline__ void p2_attn_naive(const Args& A, float* ldsf) {
    const bf16_t* Q = (const bf16_t*)(A.ws + WS_Q); const bf16_t* K = (const bf16_t*)(A.ws + WS_K); const bf16_t* VA = (const bf16_t*)(A.ws + WS_VA);
    const float* CKL = (const float*)(A.ws + WS_CKL); bf16_t* MIXIN = (bf16_t*)(A.ws + WS_MIXIN);
    const int tid = threadIdx.x, lane = tid & 63, wave = tid >> 6;
    float* qs = ldsf + wave * 128;
    const int gw = blockIdx.x * NWAVES + wave, NGW = gridDim.x * NWAVES;
    for (int item = gw; item < T * NH; item += NGW) {
        const int row = item / NH, h = item % NH, b = row / SEQ, t = row % SEQ;
        const bf16_t* qr = Q + (size_t)row * 1024 + h * 128;
        qs[lane] = bf2f(qr[lane]); qs[64 + lane] = bf2f(qr[64 + lane]);
        __builtin_amdgcn_s_waitcnt(0);
        const float* ck = CKL + (size_t)(b * NH + h) * SEQ;
        float m = -1e30f, l = 0.f, o0 = 0.f, o1 = 0.f;
        for (int s0 = 0; s0 <= t; s0 += 64) {
            const int s = s0 + lane; float sc = -INFINITY;
            if (s <= t) { const bf16_t* kr = K + (size_t)(b * SEQ + s) * 1024 + h * 128; float d = 0.f;
                for (int c = 0; c < 16; ++c) { const u32x4 w = *(const u32x4*)(kr + 8 * c);
#pragma unroll
                    for (int e = 0; e < 4; ++e) { d = fmaf(qs[8 * c + 2 * e], __uint_as_float(w[e] << 16), d); d = fmaf(qs[8 * c + 2 * e + 1], __uint_as_float(w[e] & 0xffff0000u), d); } }
                sc = d - ck[s]; }
            const float mn = fmaxf(m, wave_max(sc)); const float alpha = exp2f(m - mn); const float p = exp2f(sc - mn);
            l = l * alpha + wave_sum(p); o0 *= alpha; o1 *= alpha; m = mn;
            const int nk = min(64, t - s0 + 1);
            for (int j = 0; j < nk; ++j) { const float pj = __shfl(p, j); const unsigned w = *(const unsigned*)(VA + (size_t)(b * SEQ + s0 + j) * 1024 + h * 128 + 2 * lane);
                o0 = fmaf(pj, __uint_as_float(w << 16), o0); o1 = fmaf(pj, __uint_as_float(w & 0xffff0000u), o1); }
        }
        const float il = 1.f / l;
        *(unsigned*)(MIXIN + (size_t)row * 2048 + 1024 + h * 128 + 2 * lane) = pk2(o0 * il, o1 * il);
    }
}

__device__ __forceinline__ void p3_naive(const Args& A, float* ldsf) {
    const bf16_t* MIXIN = (const bf16_t*)(A.ws + WS_MIXIN); const bf16_t* G = (const bf16_t*)(A.ws + WS_G); bf16_t* MIXED = (bf16_t*)(A.ws + WS_MIXED);
    const float* wps = A.in[11]; const float* wpf = A.in[12];
    naive_gemm(ldsf, T, DM, 2048, 1024,
        [=](int m, int k) { return bf2f(MIXIN[(size_t)m * 2048 + k]); },
        [=](int k, int n) { return k < 1024 ? wps[(size_t)k * DM + n] : wpf[(size_t)(k - 1024) * DM + n]; },
        [=](int m, int n, float s1, float s2) { MIXED[(size_t)m * DM + n] = f2bf(bf2f(G[(size_t)m * 4096 + n]) * s1 + bf2f(G[(size_t)m * 4096 + 2048 + n]) * s2); });
}
__device__ __forceinline__ void p4_naive(const Args& A, float* ldsf) {
    const bf16_t* MIXED = (const bf16_t*)(A.ws + WS_MIXED); const float* wo = A.in[13]; const float* x = A.in[0]; float* X1 = A.out;
    naive_gemm(ldsf, T, DM, DM, DM,
        [=](int m, int k) { return bf2f(MIXED[(size_t)m * DM + k]); },
        [=](int k, int n) { return wo[(size_t)k * DM + n]; },
        [=](int m, int n, float s, float) { X1[(size_t)m * DM + n] = x[(size_t)m * DM + n] + s; });
}

template <int ALT> __device__ __forceinline__ void p5_router(const Args& A, float* ldsf) {
    const float* X1 = A.out; const float* g2 = A.in[14]; const float* wrg = A.in[15]; const float* brg = A.in[16]; const float* wre = A.in[17]; const float* bre = A.in[18];
    bf16_t* H2 = (bf16_t*)(A.ws + WS_H2); unsigned* cnt = (unsigned*)(A.ws + WS_CTL) + CW_CNT + (ALT ? 2048 : 0);
    int* TOK = (int*)(A.ws + (ALT ? WS_H : WS_TOK)); float* GATE = (float*)(A.ws + (ALT ? WS_H + 2 * MiB : WS_GATE)); int* ASG = (int*)(A.ws + (ALT ? WS_H + 4 * MiB : WS_ASG));
    const int tid = threadIdx.x, lane = tid & 63, wave = tid >> 6, r = tid >> 4, ks = tid & 15;
    float* Ws = ldsf;
    float* Xs = ldsf + 256 * 36;
    float* rs = Xs + 32 * 260;
    int* hist = (int*)(rs + 32);
    int* hbase = hist + 32;
    int* sel = hbase + 32;
    int* lpos = sel + 64;
    float* selw = (float*)(lpos + 64);
    for (int rb = blockIdx.x; rb < T / 32; rb += gridDim.x) {
        const int row0 = rb * 32;
        for (int i = 0; i < 4; ++i) { const int rr = wave * 4 + i; const f32x4* xr = (const f32x4*)(X1 + (size_t)(row0 + rr) * DM) + lane; float ss = 0.f;
#pragma unroll
            for (int j = 0; j < 8; ++j) { const f32x4 v = xr[64 * j]; ss += v.x * v.x + v.y * v.y + v.z * v.z + v.w * v.w; }
            ss = wave_sum(ss); if (lane == 0) rs[rr] = rsqrtf(ss * (1.f / DM) + EPS); }
        if (tid < 32) hist[tid] = 0;
        __syncthreads();
        float acc[36];
#pragma unroll
        for (int j = 0; j < 36; ++j) acc[j] = 0.f;
        for (int k0 = 0; k0 < DM; k0 += 256) {
            for (int i = tid; i < 256 * 36; i += NTHREADS) { const int kk = i / 36, j = i % 36; Ws[i] = j < 4 ? wrg[(size_t)(k0 + kk) * 4 + j] : wre[(size_t)(k0 + kk) * 32 + j - 4]; }
            for (int i = tid; i < 32 * 256; i += NTHREADS) { const int rr = i >> 8, kk = i & 255; const float hv = X1[(size_t)(row0 + rr) * DM + k0 + kk] * rs[rr] * g2[k0 + kk];
                Xs[rr * 260 + kk] = hv; H2[(size_t)(row0 + rr) * DM + k0 + kk] = f2bf(hv); }
            __syncthreads();
            for (int kk = ks; kk < 256; kk += 16) { const float xv = Xs[r * 260 + kk]; const float* wr = Ws + kk * 36;
#pragma unroll
                for (int j = 0; j < 36; ++j) acc[j] = fmaf(xv, wr[j], acc[j]); }
            __syncthreads();
        }
#pragma unroll
        for (int j = 0; j < 36; ++j) { float v = acc[j]; v += __shfl_xor(v, 1); v += __shfl_xor(v, 2); v += __shfl_xor(v, 4); v += __shfl_xor(v, 8); acc[j] = v; }
        if (ks == 0) {
            float gl[4]; int grp = 0; float gm;
#pragma unroll
            for (int j = 0; j < 4; ++j) gl[j] = acc[j] + brg[j];
            gm = gl[0];
#pragma unroll
            for (int j = 1; j < 4; ++j) if (gl[j] > gm) { gm = gl[j]; grp = j; }
            float den = 0.f;
#pragma unroll
            for (int j = 0; j < 4; ++j) den += __expf(gl[j] - gm);
            const float pg = 1.f / den;
            float el[8];
#pragma unroll
            for (int j = 0; j < 8; ++j) { float v = 0.f;
#pragma unroll
                for (int g = 0; g < 4; ++g) if (g == grp) v = acc[4 + g * 8 + j] + bre[g * 8 + j];
                el[j] = v; }
            int i0 = 0; float v0 = el[0];
#pragma unroll
            for (int j = 1; j < 8; ++j) if (el[j] > v0) { v0 = el[j]; i0 = j; }
            int i1 = -1; float v1 = -INFINITY;
#pragma unroll
            for (int j = 0; j < 8; ++j) if (j != i0 && el[j] > v1) { v1 = el[j]; i1 = j; }
            const float e1 = __expf(v1 - v0); const float w0 = pg / (1.f + e1), w1 = pg * e1 / (1.f + e1);
            const int ea = grp * 8 + i0, eb = grp * 8 + i1;
            sel[r * 2] = ea; sel[r * 2 + 1] = eb; selw[r * 2] = w0; selw[r * 2 + 1] = w1;
            lpos[r * 2] = atomicAdd(&hist[ea], 1); lpos[r * 2 + 1] = atomicAdd(&hist[eb], 1);
        }
        __syncthreads();
        if (tid < 32) hbase[tid] = hist[tid] > 0 ? (int)atomicAdd(&cnt[(tid) * CNT_STRIDE], (unsigned)hist[tid]) : 0;
        __syncthreads();
        if (tid < 64) { const int e = sel[tid], pos = hbase[e] + lpos[tid]; const int tok = row0 + (tid >> 1);
            TOK[(size_t)e * T + pos] = tok; GATE[(size_t)e * T + pos] = selw[tid]; ASG[tok * 2 + (tid & 1)] = (e << 16) | pos; }
        __syncthreads();
    }
}

template <int ALT> __device__ __forceinline__ void p5_router2(const Args& A, float* ldsf) {
    const float* X1 = A.out; const float* g2 = A.in[14]; const float* wrg = A.in[15]; const float* brg = A.in[16]; const float* wre = A.in[17]; const float* bre = A.in[18];
    bf16_t* H2 = (bf16_t*)(A.ws + WS_H2); unsigned* cnt = (unsigned*)(A.ws + WS_CTL) + CW_CNT + (ALT ? 2048 : 0);
    int* TOK = (int*)(A.ws + (ALT ? WS_H : WS_TOK)); float* GATE = (float*)(A.ws + (ALT ? WS_H + 2 * MiB : WS_GATE)); int* ASG = (int*)(A.ws + (ALT ? WS_H + 4 * MiB : WS_ASG));
    const int tid = threadIdx.x, lane = tid & 63, wave = tid >> 6;
    constexpr int XP = 260, XB = 32 * XP, WP = 40, WB = 256 * WP;
    float* Xs = ldsf;
    float* Ws = ldsf + 2 * XB;
    float* misc = ldsf + 2 * XB + 2 * WB;
    float* rs = misc;
    float* lg = misc + 32;
    int* hist = (int*)(misc + 32 + 1280); int* hbase = hist + 32; int* sel = hbase + 32; int* lpos = sel + 64; float* selw = (float*)(lpos + 64);
    const int kh2 = lane >> 5, rp = (lane >> 1) & 15, cg = lane & 1;
    for (int rb = blockIdx.x; rb < T / 32; rb += gridDim.x) {
        const int row0 = rb * 32;
        float ssq[4] = {0.f, 0.f, 0.f, 0.f};
        float acc0[20], acc1[20];
#pragma unroll
        for (int j = 0; j < 20; ++j) { acc0[j] = 0.f; acc1[j] = 0.f; }
        if (tid < 32) hist[tid] = 0;
        f32x4 xr[4], wv[5], gv;
        for (int i = tid; i < 2 * 256; i += NTHREADS) *(f32x4*)(Ws + (i >> 8) * WB + (i & 255) * WP + 36) = (f32x4){0.f, 0.f, 0.f, 0.f};
#define R2_LOAD(k0) do { gv = *(const f32x4*)(g2 + (k0) + 4 * (tid & 63)); \
        _Pragma("unroll") for (int i = 0; i < 4; ++i) xr[i] = *(const f32x4*)(X1 + (size_t)(row0 + wave + 8 * i) * DM + (k0) + 4 * (tid & 63)); \
        _Pragma("unroll") for (int i = 0; i < 5; ++i) { const int idx = tid + i * 512; if (idx < 2304) { const int kk = idx / 9, j4 = idx - kk * 9; \
            wv[i] = j4 == 0 ? *(const f32x4*)(wrg + (size_t)((k0) + kk) * 4) : *(const f32x4*)(wre + (size_t)((k0) + kk) * 32 + 4 * (j4 - 1)); } } } while (0)
#define R2_STORE(buf) do { \
        _Pragma("unroll") for (int i = 0; i < 4; ++i) { ssq[i] += xr[i].x * xr[i].x + xr[i].y * xr[i].y + xr[i].z * xr[i].z + xr[i].w * xr[i].w; \
            *(f32x4*)(Xs + (buf) * XB + (wave + 8 * i) * XP + 4 * (tid & 63)) = xr[i] * gv; } \
        _Pragma("unroll") for (int i = 0; i < 5; ++i) { const int idx = tid + i * 512; if (idx < 2304) { const int kk = idx / 9, j4 = idx - kk * 9; *(f32x4*)(Ws + (buf) * WB + kk * WP + 4 * j4) = wv[i]; } } } while (0)
        R2_LOAD(0); R2_STORE(0);
        __syncthreads();
#pragma unroll 1
        for (int c = 0; c < 8; ++c) {
            const int buf = c & 1;
            if (c < 7) R2_LOAD((c + 1) * 256);
            const float* xa = Xs + buf * XB + (2 * rp) * XP + (wave * 2 + kh2) * 16; const float* wa = Ws + buf * WB + ((wave * 2 + kh2) * 16) * WP + 20 * cg;
#pragma unroll 1
            for (int k4 = 0; k4 < 4; ++k4) {
                const f32x4 x0 = *(const f32x4*)(xa + 4 * k4), x1 = *(const f32x4*)(xa + XP + 4 * k4);
#pragma unroll
                for (int kk = 0; kk < 4; ++kk) { const float* wr = wa + (4 * k4 + kk) * WP;
#pragma unroll
                    for (int j4 = 0; j4 < 5; ++j4) { const f32x4 w = *(const f32x4*)(wr + 4 * j4);
#pragma unroll
                        for (int e = 0; e < 4; ++e) { acc0[4 * j4 + e] = fmaf(x0[kk], w[e], acc0[4 * j4 + e]); acc1[4 * j4 + e] = fmaf(x1[kk], w[e], acc1[4 * j4 + e]); } }
                    asm volatile("" ::: "memory"); }
            }
            if (c < 7) R2_STORE(buf ^ 1);
            __syncthreads();
        }
#undef R2_LOAD
#undef R2_STORE
#pragma unroll
        for (int j = 0; j < 20; ++j) { acc0[j] += __shfl_xor(acc0[j], 32); acc1[j] += __shfl_xor(acc1[j], 32); }
        float* red = Xs;
        if (kh2 == 0) {
#pragma unroll
            for (int j = 0; j < 20; ++j) { red[(wave * 32 + 2 * rp) * 40 + 20 * cg + j] = acc0[j]; red[(wave * 32 + 2 * rp + 1) * 40 + 20 * cg + j] = acc1[j]; } }
#pragma unroll
        for (int i = 0; i < 4; ++i) { const float s = wave_sum(ssq[i]); if (lane == 0) rs[wave + 8 * i] = rsqrtf(s * (1.f / DM) + EPS); }
        __syncthreads();
        for (int i = tid; i < 32 * 40; i += NTHREADS) { float s = 0.f;
#pragma unroll
            for (int w = 0; w < 8; ++w) s += red[w * 1280 + i];
            lg[i] = s * rs[i / 40]; }
        __syncthreads();
#pragma unroll 1
        for (int i = 0; i < 4; ++i) { const int rr = wave + 8 * i; const float rstd = rs[rr]; const float* xp = X1 + (size_t)(row0 + rr) * DM; bf16_t* hp = H2 + (size_t)(row0 + rr) * DM;
#pragma unroll 2
            for (int j = 0; j < 8; ++j) { const int c0 = 256 * j + 4 * lane; const f32x4 v = *(const f32x4*)(xp + c0), g = *(const f32x4*)(g2 + c0);
                u32x2 o; o.x = pk2(v.x * rstd * g.x, v.y * rstd * g.y); o.y = pk2(v.z * rstd * g.z, v.w * rstd * g.w); *(u32x2*)(hp + c0) = o; } }
        if (tid < 32) {
            const int r = tid; const float* L = lg + r * 40;
            float gl[4]; int grp = 0;
#pragma unroll
            for (int j = 0; j < 4; ++j) gl[j] = L[j] + brg[j];
            float gm = gl[0];
#pragma unroll
            for (int j = 1; j < 4; ++j) if (gl[j] > gm) { gm = gl[j]; grp = j; }
            float den = 0.f;
#pragma unroll
            for (int j = 0; j < 4; ++j) den += __expf(gl[j] - gm);
            const float pg = 1.f / den;
            float el[8];
#pragma unroll
            for (int j = 0; j < 8; ++j) el[j] = L[4 + grp * 8 + j] + bre[grp * 8 + j];
            int i0 = 0; float v0 = el[0];
#pragma unroll
            for (int j = 1; j < 8; ++j) if (el[j] > v0) { v0 = el[j]; i0 = j; }
            int i1 = -1; float v1 = -INFINITY;
#pragma unroll
            for (int j = 0; j < 8; ++j) if (j != i0 && el[j] > v1) { v1 = el[j]; i1 = j; }
            const float e1 = __expf(v1 - v0); const float w0 = pg / (1.f + e1), w1 = pg * e1 / (1.f + e1);
            const int ea = grp * 8 + i0, eb = grp * 8 + i1;
            sel[r * 2] = ea; sel[r * 2 + 1] = eb; selw[r * 2] = w0; selw[r * 2 + 1] = w1;
            lpos[r * 2] = atomicAdd(&hist[ea], 1); lpos[r * 2 + 1] = atomicAdd(&hist[eb], 1);
        }
        __syncthreads();
        if (tid < 32) hbase[tid] = hist[tid] > 0 ? (int)atomicAdd(&cnt[(tid) * CNT_STRIDE], (unsigned)hist[tid]) : 0;
        __syncthreads();
        if (tid < 64) { const int e = sel[tid], pos = hbase[e] + lpos[tid]; const int tok = row0 + (tid >> 1);
            TOK[(size_t)e * T + pos] = tok; GATE[(size_t)e * T + pos] = selw[tid]; ASG[tok * 2 + (tid & 1)] = (e << 16) | pos; }
        __syncthreads();
    }
}

constexpr size_t WS_WR = 7 * MiB;
__device__ __forceinline__ void p0_router_weights(const Args& A) {
    const float* g2 = A.in[14]; const float* wrg = A.in[15]; const float* wre = A.in[17]; bf16_t* WR = (bf16_t*)(A.ws + WS_WR);
    for (int i = blockIdx.x * NTHREADS + threadIdx.x; i < 64 * DM; i += gridDim.x * NTHREADS) { const int n = i >> 11, k = i & (DM - 1);
        const float w = n < 4 ? wrg[(size_t)k * 4 + n] * g2[k] : (n < 36 ? wre[(size_t)k * 32 + n - 4] * g2[k] : 0.f);
        const bf16_t h = f2bf(w); WR[i] = h; WR[64 * DM + i] = f2bf(w - bf2f(h)); }
}
constexpr size_t WS_RSTL = WS_CKL;
template <int ALT> __device__ __forceinline__ void p5_router3(const Args& A, float* ldsf) {
    float* RSTL = (float*)(A.ws + (ALT ? WS_H + 6 * MiB : WS_RSTL));
    typedef short bf16x8 __attribute__((ext_vector_type(8))); typedef float f32x16 __attribute__((ext_vector_type(16)));
    const float* X1 = A.out; const float* g2 = A.in[14]; const float* brg = A.in[16]; const float* bre = A.in[18]; const bf16_t* WR = (const bf16_t*)(A.ws + WS_WR);
    bf16_t* H2 = (bf16_t*)(A.ws + WS_H2); unsigned* cnt = (unsigned*)(A.ws + WS_CTL) + CW_CNT + (ALT ? 2048 : 0);
    int* TOK = (int*)(A.ws + (ALT ? WS_H : WS_TOK)); float* GATE = (float*)(A.ws + (ALT ? WS_H + 2 * MiB : WS_GATE)); int* ASG = (int*)(A.ws + (ALT ? WS_H + 4 * MiB : WS_ASG));
    const int tid = threadIdx.x, lane = tid & 63, wave = tid >> 6, r32 = lane & 31, hi = lane >> 5;
    float* red = ldsf;
    float* lg = ldsf + 16384;
    float* sq = lg + 2048;
    float* rs = sq + 256;
    int* hist = (int*)(rs + 32); int* hbase = hist + 32; int* sel = hbase + 32; int* lpos = sel + 64; float* selw = (float*)(lpos + 64);
    for (int rb = blockIdx.x; rb < T / 32; rb += gridDim.x) {
        const int row0 = rb * 32;
        if (tid < 32) hist[tid] = 0;
        const float* xp = X1 + (size_t)(row0 + r32) * DM + 256 * wave + 8 * hi;
        const bf16_t* wp = WR + (size_t)r32 * DM + 256 * wave + 8 * hi;
        f32x16 acc[2];
#pragma unroll
        for (int j = 0; j < 2; ++j)
#pragma unroll
            for (int r = 0; r < 16; ++r) acc[j][r] = 0.f;
        float ssq = 0.f;
        f32x4 xa[4], xb[4], xna[4], xnb[4];
#pragma unroll
        for (int i = 0; i < 4; ++i) { xa[i] = *(const f32x4*)(xp + 16 * i); xb[i] = *(const f32x4*)(xp + 16 * i + 4); }
#pragma unroll 1
        for (int kb = 0; kb < (ALT == 3 ? 0 : 4); ++kb) {
            bf16x8 wh0[4], wh1[4], wl0[4], wl1[4]; f32x4 ga[4], gb[4];
#pragma unroll
            for (int i = 0; i < 4; ++i) { const int ko = 64 * kb + 16 * i;
                wh0[i] = *(const bf16x8*)(wp + ko); wh1[i] = *(const bf16x8*)(wp + (size_t)32 * DM + ko); wl0[i] = *(const bf16x8*)(wp + (size_t)64 * DM + ko); wl1[i] = *(const bf16x8*)(wp + (size_t)96 * DM + ko);
                ga[i] = *(const f32x4*)(g2 + 256 * wave + 8 * hi + ko); gb[i] = *(const f32x4*)(g2 + 256 * wave + 8 * hi + ko + 4); }
            asm volatile("" ::: "memory");
            if (kb < 3) {
#pragma unroll
                for (int i = 0; i < 4; ++i) { xna[i] = *(const f32x4*)(xp + 64 * (kb + 1) + 16 * i); xnb[i] = *(const f32x4*)(xp + 64 * (kb + 1) + 16 * i + 4); } }
            asm volatile("" ::: "memory");
#pragma unroll
            for (int i = 0; i < 4; ++i) { const int ko = 64 * kb + 16 * i;
                { u32x4 hw; hw.x = cvtpk_rne(xa[i][0] * ga[i][0], xa[i][1] * ga[i][1]); hw.y = cvtpk_rne(xa[i][2] * ga[i][2], xa[i][3] * ga[i][3]); hw.z = cvtpk_rne(xb[i][0] * gb[i][0], xb[i][1] * gb[i][1]); hw.w = cvtpk_rne(xb[i][2] * gb[i][2], xb[i][3] * gb[i][3]);
                  *(u32x4*)(H2 + (size_t)(row0 + r32) * DM + 256 * wave + 8 * hi + ko) = hw; }
                float xv[8] = {xa[i][0], xa[i][1], xa[i][2], xa[i][3], xb[i][0], xb[i][1], xb[i][2], xb[i][3]}; u32x4 ph, pl;
#pragma unroll
                for (int e = 0; e < 4; ++e) { const float a = xv[2 * e], b2 = xv[2 * e + 1]; ssq += a * a + b2 * b2; const unsigned hh = cvtpk_rne(a, b2); ph[e] = hh;
                    pl[e] = cvtpk_rne(a - __uint_as_float(hh << 16), b2 - __uint_as_float(hh & 0xffff0000u)); }
                const bf16x8 xh = __builtin_bit_cast(bf16x8, ph), xl = __builtin_bit_cast(bf16x8, pl);
                acc[0] = __builtin_amdgcn_mfma_f32_32x32x16_bf16(xh, wh0[i], acc[0], 0, 0, 0); acc[0] = __builtin_amdgcn_mfma_f32_32x32x16_bf16(xl, wh0[i], acc[0], 0, 0, 0); acc[0] = __builtin_amdgcn_mfma_f32_32x32x16_bf16(xh, wl0[i], acc[0], 0, 0, 0);
                acc[1] = __builtin_amdgcn_mfma_f32_32x32x16_bf16(xh, wh1[i], acc[1], 0, 0, 0); acc[1] = __builtin_amdgcn_mfma_f32_32x32x16_bf16(xl, wh1[i], acc[1], 0, 0, 0); acc[1] = __builtin_amdgcn_mfma_f32_32x32x16_bf16(xh, wl1[i], acc[1], 0, 0, 0); }
#pragma unroll
            for (int i = 0; i < 4; ++i) { xa[i] = xna[i]; xb[i] = xnb[i]; }
        }
#pragma unroll
        for (int j = 0; j < 2; ++j)
#pragma unroll
            for (int r = 0; r < 16; ++r) red[((wave * 2 + j) * 16 + r) * 64 + lane] = acc[j][r];
        ssq += __shfl_xor(ssq, 32);
        if (hi == 0) sq[wave * 32 + r32] = ssq;
        __syncthreads();
        if (ALT == 2) continue;
#pragma unroll
        for (int j = 0; j < 2; ++j)
#pragma unroll
            for (int rr = 0; rr < 2; ++rr) { const int r = 2 * wave + rr; float s = 0.f;
#pragma unroll
                for (int w2 = 0; w2 < 8; ++w2) s += red[((w2 * 2 + j) * 16 + r) * 64 + lane];
                lg[((r & 3) + 8 * (r >> 2) + 4 * hi) * 64 + 32 * j + r32] = s; }
        if (tid < 32) { float s = 0.f;
#pragma unroll
            for (int w2 = 0; w2 < 8; ++w2) s += sq[w2 * 32 + tid];
            rs[tid] = rsqrtf(s * (1.f / DM) + EPS); }
        __syncthreads();
        if (tid < 32) {
            const int r = tid; const float* L = lg + r * 64; const float rstd = rs[r];
            float gl[4]; int grp = 0;
#pragma unroll
            for (int j = 0; j < 4; ++j) gl[j] = L[j] * rstd + brg[j];
            float gm = gl[0];
#pragma unroll
            for (int j = 1; j < 4; ++j) if (gl[j] > gm) { gm = gl[j]; grp = j; }
            float den = 0.f;
#pragma unroll
            for (int j = 0; j < 4; ++j) den += __expf(gl[j] - gm);
            const float pg = 1.f / den;
            float el[8];
#pragma unroll
            for (int j = 0; j < 8; ++j) el[j] = L[4 + grp * 8 + j] * rstd + bre[grp * 8 + j];
            int i0 = 0; float v0 = el[0];
#pragma unroll
            for (int j = 1; j < 8; ++j) if (el[j] > v0) { v0 = el[j]; i0 = j; }
            int i1 = -1; float v1 = -INFINITY;
#pragma unroll
            for (int j = 0; j < 8; ++j) if (j != i0 && el[j] > v1) { v1 = el[j]; i1 = j; }
            const float e1 = __expf(v1 - v0); const float w0 = pg / (1.f + e1), w1 = pg * e1 / (1.f + e1);
            const int ea = grp * 8 + i0, eb = grp * 8 + i1;
            sel[r * 2] = ea; sel[r * 2 + 1] = eb; selw[r * 2] = w0; selw[r * 2 + 1] = w1;
            lpos[r * 2] = atomicAdd(&hist[ea], 1); lpos[r * 2 + 1] = atomicAdd(&hist[eb], 1);
        }
        __syncthreads();
        if (tid < 32) hbase[tid] = hist[tid] > 0 ? (int)atomicAdd(&cnt[(tid) * CNT_STRIDE], (unsigned)hist[tid]) : 0;
        __syncthreads();
        if (tid < 64) { const int e = sel[tid], pos = hbase[e] + lpos[tid]; const int tok = row0 + (tid >> 1);
            TOK[(size_t)e * T + pos] = tok; GATE[(size_t)e * T + pos] = selw[tid]; RSTL[(size_t)e * T + pos] = rs[tid >> 1]; ASG[tok * 2 + (tid & 1)] = (e << 16) | pos; }
        __syncthreads();
    }
}

__device__ __forceinline__ void expert_layout(const unsigned* cnt, int* pstart  ) {
    int acc = 0;
    for (int e = 0; e < NEXP; ++e) { pstart[e] = acc; acc += ((int)cnt[(e) * CNT_STRIDE] + MTILE - 1) / MTILE * MTILE; }
    pstart[NEXP] = acc;
}

__device__ __forceinline__ void p6_naive(const Args& A, float* ldsf) {
    const bf16_t* H2 = (const bf16_t*)(A.ws + WS_H2); const float* wg = A.in[19]; const float* wu = A.in[20]; bf16_t* ACT = (bf16_t*)(A.ws + WS_ACT);
    const unsigned* cnt = (const unsigned*)(A.ws + WS_CTL) + CW_CNT; const int* TOK = (const int*)(A.ws + WS_TOK);
    int* ps = (int*)(ldsf + 2 * 16 * 132);
    if (threadIdx.x == 0) expert_layout(cnt, ps);
    __syncthreads();
    int ntot = 0;
    for (int e = 0; e < NEXP; ++e) ntot += (((int)cnt[(e) * CNT_STRIDE] + 127) / 128) * 4;
    for (int t = blockIdx.x; t < ntot; t += gridDim.x) {
        int e = 0, rem = t;
        for (; e < NEXP; ++e) { const int n = (((int)cnt[(e) * CNT_STRIDE] + 127) / 128) * 4; if (rem < n) break; rem -= n; }
        const int c = (int)cnt[(e) * CNT_STRIDE]; const int tm = rem / 4, tn = rem % 4; const int* tl = TOK + (size_t)e * T; const int prow = ps[e];
        const float* wge = wg + (size_t)e * DM * DEXP; const float* wue = wu + (size_t)e * DM * DEXP;
        naive_gemm_tile(ldsf, tm * 128, tn * 128, c, DEXP, 2 * DM, DM,
            [=](int m, int k) { return bf2f(H2[(size_t)tl[m] * DM + (k & (DM - 1))]); },
            [=](int k, int n) { return k < DM ? wge[(size_t)k * DEXP + n] : wue[(size_t)(k - DM) * DEXP + n]; },
            [=](int m, int n, float sg, float su) { ACT[(size_t)(prow + m) * DEXP + n] = f2bf(sg / (1.f + __expf(-sg)) * su); });
    }
}
__device__ __forceinline__ void p7_naive(const Args& A, float* ldsf) {
    const bf16_t* ACT = (const bf16_t*)(A.ws + WS_ACT); const float* wd = A.in[21]; bf16_t* YBUF = (bf16_t*)(A.ws + WS_YBUF);
    const unsigned* cnt = (const unsigned*)(A.ws + WS_CTL) + CW_CNT; const float* GATE = (const float*)(A.ws + WS_GATE);
    int* ps = (int*)(ldsf + 2 * 16 * 132);
    if (threadIdx.x == 0) expert_layout(cnt, ps);
    __syncthreads();
    int ntot = 0;
    for (int e = 0; e < NEXP; ++e) ntot += (((int)cnt[(e) * CNT_STRIDE] + 127) / 128) * 16;
    for (int t = blockIdx.x; t < ntot; t += gridDim.x) {
        int e = 0, rem = t;
        for (; e < NEXP; ++e) { const int n = (((int)cnt[(e) * CNT_STRIDE] + 127) / 128) * 16; if (rem < n) break; rem -= n; }
        const int c = (int)cnt[(e) * CNT_STRIDE]; const int tm = rem / 16, tn = rem % 16; const float* gl = GATE + (size_t)e * T; const int prow = ps[e];
        const float* wde = wd + (size_t)e * DEXP * DM;
        naive_gemm_tile(ldsf, tm * 128, tn * 128, c, DM, DEXP, DEXP,
            [=](int m, int k) { return bf2f(ACT[(size_t)(prow + m) * DEXP + k]); },
            [=](int k, int n) { return wde[(size_t)k * DM + n]; },
            [=](int m, int n, float s, float) { YBUF[(size_t)(prow + m) * DM + n] = f2bf(s * gl[m]); });
    }
}

template <int ALT> __device__ __forceinline__ void p8_combine(const Args& A, float* ldsf, const float dlt = 0.f) {
    float* X1 = A.out; float* XO = ALT ? (float*)(A.ws + WS_WGU) : A.out; const bf16_t* YBUF = (const bf16_t*)(A.ws + WS_YBUF); const int* ASG = (const int*)(A.ws + WS_ASG);
    const unsigned* cnt = (const unsigned*)(A.ws + WS_CTL) + CW_CNT;
    int* ps = (int*)ldsf;
    if (threadIdx.x == 0) expert_layout(cnt, ps);
    __syncthreads();
    float dl2 = dlt;
    if (STAMP_PHASE == 97) { int v = 0, mx = 0, mn = 1 << 30, nt_ = 0, tiny = 0, half = 0; for (int e = 0; e < NEXP; ++e) { const int c = (int)cnt[(e) * CNT_STRIDE]; mx = c > mx ? c : mx; mn = c < mn ? c : mn; nt_ += (c + 255) / 256; const int rem = c % 256; tiny += (rem > 0 && rem <= 64) ? 1 : 0; half += (rem > 0 && rem <= 128) ? 1 : 0; }
        v = STAMP_SEL == 0 ? nt_ : STAMP_SEL == 1 ? mx : STAMP_SEL == 2 ? mn : STAMP_SEL == 3 ? tiny : half; dl2 = 0.01f * (float)v; }
    const int tid = threadIdx.x, lane = tid & 63, wave = tid >> 6;
    const int gw = blockIdx.x * NWAVES + wave, NGW = gridDim.x * NWAVES;
    u32x4 w0[4], w1[4], n0[4], n1[4]; f32x4 xa[4], xb[4], na[4], nb[4];
#define P8_LOAD(row_, W0, W1, XA, XB) do { const int a0_ = ASG[(row_) * 2], a1_ = ASG[(row_) * 2 + 1]; \
        const bf16_t* y0_ = YBUF + (size_t)(ps[a0_ >> 16] + (a0_ & 0xffff)) * DM; const bf16_t* y1_ = YBUF + (size_t)(ps[a1_ >> 16] + (a1_ & 0xffff)) * DM; const float* xr_ = X1 + (size_t)(row_) * DM; \
        _Pragma("unroll") for (int j = 0; j < 4; ++j) { const int c0 = 512 * j + 8 * lane; W0[j] = *(const u32x4*)(y0_ + c0); W1[j] = *(const u32x4*)(y1_ + c0); XA[j] = *(const f32x4*)(xr_ + c0); XB[j] = *(const f32x4*)(xr_ + c0 + 4); } } while (0)
    int row = gw;
    if (row < T) P8_LOAD(row, w0, w1, xa, xb);
    for (; row < T; row += NGW) {
        const int nrow = row + NGW; const bool more = nrow < T;
        if (more) P8_LOAD(nrow, n0, n1, na, nb);
        float* xo = XO + (size_t)row * DM;
#pragma unroll
        for (int j = 0; j < 4; ++j) { const int c0 = 512 * j + 8 * lane; f32x4 a = xa[j], b2 = xb[j];
            a.x += __uint_as_float(w0[j][0] << 16) + __uint_as_float(w1[j][0] << 16); a.y += __uint_as_float(w0[j][0] & 0xffff0000u) + __uint_as_float(w1[j][0] & 0xffff0000u);
            a.z += __uint_as_float(w0[j][1] << 16) + __uint_as_float(w1[j][1] << 16); a.w += __uint_as_float(w0[j][1] & 0xffff0000u) + __uint_as_float(w1[j][1] & 0xffff0000u);
            b2.x += __uint_as_float(w0[j][2] << 16) + __uint_as_float(w1[j][2] << 16); b2.y += __uint_as_float(w0[j][2] & 0xffff0000u) + __uint_as_float(w1[j][2] & 0xffff0000u);
            b2.z += __uint_as_float(w0[j][3] << 16) + __uint_as_float(w1[j][3] << 16); b2.w += __uint_as_float(w0[j][3] & 0xffff0000u) + __uint_as_float(w1[j][3] & 0xffff0000u);
            if (STAMP_PHASE >= 0) { a += dl2; b2 += dl2; }
            *(f32x4*)(xo + c0) = a; *(f32x4*)(xo + c0 + 4) = b2; }
        if (more) {
#pragma unroll
            for (int j = 0; j < 4; ++j) { w0[j] = n0[j]; w1[j] = n1[j]; xa[j] = na[j]; xb[j] = nb[j]; } }
    }
#undef P8_LOAD
}

namespace pg8 {
#define PG8_LAS __attribute__((address_space(3)))
typedef short bf16x8 __attribute__((ext_vector_type(8)));
constexpr int BM = 256, BK = 64, HALF = 128, HTB = HALF * BK * 2, STAGE_BYTES = 8 * HTB, NXCD = 8, WGM = 8;
__host__ __device__ __forceinline__ int lds_byte(int r, int c) { const int st = (r >> 4) * 2 + (c >> 5), rr = r & 15, cc = c & 31, ob = rr * 64 + cc * 2; return st * 1024 + (ob ^ (((ob >> 9) & 1) << 5)); }
__host__ __device__ __forceinline__ void stage_rc(int b, int& R, int& C) { const int st = b / 1024, sb = b % 1024, swz = sb ^ (((sb >> 9) & 1) << 5); R = (st >> 1) * 16 + swz / 64; C = (st & 1) * 32 + (swz % 64) / 2; }
__host__ __device__ __forceinline__ int perm32(int rho) { const int n = rho >> 4, i = rho & 15; return 8 * (i >> 2) + 4 * n + (i & 3); }

struct Unit { const char* A; const char* B; int pm, pn, x0, x1, x2, x3; };

struct DenseOrder {
    const char* A; const char* Bt; int K, nM, nN, nwg, G, c, rep;
    __device__ void init(const void* A_, const void* Bt_, int M, int N, int K_, int G_, int c_, int rep_ = 1) { A = (const char*)A_; Bt = (const char*)Bt_; K = K_; nM = M / BM; nN = N / BM; nwg = nM * nN; G = G_; c = c_; rep = rep_; }
    __device__ bool next(int i, Unit& u) const {
        const long L = (long)i * G + c; if (L >= (long)nwg * rep) return false;
        int wgid = (int)(L % nwg); { const int q = nwg / NXCD, r = nwg % NXCD, xcd = wgid % NXCD, off = wgid / NXCD; wgid = (xcd < r ? xcd * (q + 1) : r * (q + 1) + (xcd - r) * q) + off; }
        const int nig = WGM * nN, gid = wgid / nig, fm = gid * WGM, gsz = (nM - fm) < WGM ? (nM - fm) : WGM;
        u.pm = fm + ((wgid % nig) % gsz); u.pn = (wgid % nig) / gsz; u.x0 = 0; u.x1 = 0; u.x2 = 0; u.x3 = 0;
        u.A = A + (size_t)u.pm * BM * K * 2; u.B = Bt + (size_t)u.pn * BM * K * 2; return true;
    }
    __device__ __forceinline__ void rows(const Unit&, unsigned (&)[2][2], const int (&)[2]) const {}
};

__device__ __forceinline__ unsigned cvt_pk_bf16(float lo, float hi) { unsigned r; asm volatile("v_cvt_pk_bf16_f32 %0, %1, %2" : "=v"(r) : "v"(lo), "v"(hi)); return r; }

template <class Epi, class Sched, bool ALIGN_EPI, bool GATHER, bool SKIP = false>
__device__ __forceinline__ void gemm_phase(PG8_LAS unsigned char* lds, const int K, const Sched& S, const Epi& E) {
    const int tid = threadIdx.x, wid = __builtin_amdgcn_readfirstlane(tid >> 6), lane = tid & 63, wr = wid >> 2, wc = wid & 3, fr = lane & 15, fq = lane >> 4;
    const int nt = K / BK;
    unsigned voffA[2], voffB[2]; int RA[2];
#pragma unroll
    for (int i = 0; i < 2; ++i) { int R, C; stage_rc(tid * 16 + i * 8192, R, C); const int Rb = Epi::PERM ? ((R & ~31) + perm32(R & 31)) : R;
        voffA[i] = GATHER ? (unsigned)(C * 2) : (unsigned)(R * K + C) * 2u; voffB[i] = (unsigned)(Rb * K + C) * 2u; RA[i] = R; }
    const size_t kstep = (size_t)(BK * 2);
    const size_t hstep = (size_t)HALF * K * 2;
    const size_t hstepA = GATHER ? 0 : hstep;
    const unsigned ldsw = (unsigned)wid * 1024u;
    const int aoff = lds_byte(wr * 64 + fr, fq * 8), boff = lds_byte(wc * 32 + fr, fq * 8);
    unsigned gA[2][2], gAn[2][2];
#define PG8_SA(b, h) (((b) * 2 + (h)) * HTB)
#define PG8_SB(b, h) ((4 + (b) * 2 + (h)) * HTB)
#define PG8_STAGE(bufoff, gbase, voff) do { _Pragma("unroll") for (int _i = 0; _i < 2; ++_i) \
        __builtin_amdgcn_global_load_lds((const unsigned*)((const char*)(gbase) + (voff)[_i]), (PG8_LAS unsigned*)(lds + (bufoff) + ldsw + _i * 8192), 16, 0, 0); } while (0)
#define PG8_STAGE_A(bufoff, gbase, h, nx) do { _Pragma("unroll") for (int _i = 0; _i < 2; ++_i) { \
        const unsigned _o = GATHER ? ((nx) ? gAn[h][_i] : gA[h][_i]) + voffA[_i] : voffA[_i]; \
        __builtin_amdgcn_global_load_lds((const unsigned*)((const char*)(gbase) + (h) * hstepA + _o), (PG8_LAS unsigned*)(lds + (bufoff) + ldsw + _i * 8192), 16, 0, 0); } } while (0)
#define PG8_LDA(dst, b, h) do { _Pragma("unroll") for (int m = 0; m < 4; ++m) _Pragma("unroll") for (int k = 0; k < 2; ++k) dst[m][k] = *(const PG8_LAS bf16x8*)(lds + PG8_SA(b, h) + aoff + m * 2048 + k * 1024); } while (0)
#define PG8_LDB(dst, b, h) do { _Pragma("unroll") for (int n = 0; n < 2; ++n) _Pragma("unroll") for (int k = 0; k < 2; ++k) dst[n][k] = *(const PG8_LAS bf16x8*)(lds + PG8_SB(b, h) + boff + n * 2048 + k * 1024); } while (0)
#define PG8_MMA(ai, bj, At, Bt) do { __builtin_amdgcn_s_setprio(1); _Pragma("unroll") for (int m = 0; m < 4; ++m) { if (!SKIP || m < ((ai) == 0 ? mc0 : mc1)) { _Pragma("unroll") for (int n = 0; n < 2; ++n) _Pragma("unroll") for (int k = 0; k < 2; ++k) \
        acc[ai][bj][m][n] = __builtin_amdgcn_mfma_f32_16x16x32_bf16(Bt[n][k], At[m][k], acc[ai][bj][m][n], 0, 0, 0); } } __builtin_amdgcn_s_setprio(0); } while (0)
#define PG8_WAIT_V(n) asm volatile("s_waitcnt vmcnt(" #n ")" ::: "memory")
#define PG8_WAIT_L(n) asm volatile("s_waitcnt lgkmcnt(" #n ")" ::: "memory")
#define PG8_BAR __builtin_amdgcn_s_barrier()
#define PG8_SCHED __builtin_amdgcn_sched_barrier(0)
    Unit cur, nxt; int ui = 0;
    if (!S.next(0, cur)) return;
    int mc0 = 4, mc1 = 4;
#define PG8_MC(u) do { if (SKIP) { const int a_ = ((u).x2 - 64 * wr + 15) >> 4, b_ = ((u).x2 - 128 - 64 * wr + 15) >> 4; mc0 = a_ < 0 ? 0 : (a_ > 4 ? 4 : a_); mc1 = b_ < 0 ? 0 : (b_ > 4 ? 4 : b_); } } while (0)
    PG8_MC(cur);
    f32x4 acc[2][2][4][2];
#pragma unroll
    for (int a = 0; a < 2; ++a)
#pragma unroll
        for (int b = 0; b < 2; ++b)
#pragma unroll
            for (int m = 0; m < 4; ++m)
#pragma unroll
                for (int n = 0; n < 2; ++n) acc[a][b][m][n] = (f32x4){0.f, 0.f, 0.f, 0.f};
    bf16x8 At[4][2], B0[2][2], B1[2][2];
    const char* cA = cur.A; const char* cB = cur.B;
    if constexpr (GATHER) { S.rows(cur, gA, RA);
#pragma unroll
        for (int h = 0; h < 2; ++h)
#pragma unroll
            for (int i = 0; i < 2; ++i) gAn[h][i] = gA[h][i]; }
    PG8_STAGE(PG8_SB(0, 0), cB, voffB); PG8_STAGE(PG8_SB(0, 1), cB + hstep, voffB); PG8_STAGE_A(PG8_SA(0, 0), cA, 0, false); PG8_STAGE_A(PG8_SA(0, 1), cA, 1, false);
    if (wr == 1) PG8_BAR;
    PG8_WAIT_V(2); PG8_BAR;
    PG8_STAGE(PG8_SB(1, 0), cB + kstep, voffB); PG8_STAGE_A(PG8_SA(1, 0), cA + kstep, 0, false); PG8_STAGE(PG8_SB(1, 1), cB + hstep + kstep, voffB);
    PG8_WAIT_V(6); PG8_BAR;
    for (;;) {
        const bool has_next = S.next(ui + 1, nxt);
        const char* nA = has_next ? nxt.A : cA; const char* nB = has_next ? nxt.B : cB;
        if constexpr (GATHER) { if (has_next) { S.rows(nxt, gAn, RA); } }
        for (int t = 0; t < nt; t += 2) {
            const bool last = (t == nt - 2);
            const char* a1 = cA + (size_t)(t + 1) * kstep;
            const char* a2 = last ? nA : cA + (size_t)(t + 2) * kstep; const char* b2 = last ? nB : cB + (size_t)(t + 2) * kstep;
            const char* a3 = a2 + kstep; const char* b3 = b2 + kstep;
            if constexpr (Epi::HAS_MID) { if (t == nt / 2) { int frl = fr, fql = fq; asm volatile("" : "+v"(frl), "+v"(fql)); E.mid(acc, cur, wr, wc, frl, fql); } }
            PG8_LDB(B0, 0, 0); PG8_LDB(B1, 0, 1); PG8_SCHED; PG8_LDA(At, 0, 0); PG8_STAGE_A(PG8_SA(1, 1), a1, 1, false);
            PG8_WAIT_V(8); PG8_WAIT_L(0); PG8_BAR; PG8_MMA(0, 0, At, B0); PG8_MMA(0, 1, At, B1); PG8_BAR; PG8_SCHED;
            PG8_LDA(At, 0, 1); PG8_STAGE(PG8_SB(0, 0), b2, voffB); PG8_STAGE(PG8_SB(0, 1), b2 + hstep, voffB); PG8_STAGE_A(PG8_SA(0, 0), a2, 0, last);
            PG8_WAIT_V(8); PG8_WAIT_L(0); PG8_BAR; PG8_MMA(1, 0, At, B0); PG8_MMA(1, 1, At, B1); PG8_BAR; PG8_SCHED;
            PG8_LDB(B0, 1, 0); PG8_LDB(B1, 1, 1); PG8_SCHED; PG8_LDA(At, 1, 0); PG8_STAGE_A(PG8_SA(0, 1), a2, 1, last);
            PG8_WAIT_V(8); PG8_WAIT_L(0); PG8_BAR; PG8_MMA(0, 0, At, B0); PG8_MMA(0, 1, At, B1); PG8_BAR; PG8_SCHED;
            PG8_LDA(At, 1, 1); PG8_STAGE(PG8_SB(1, 0), b3, voffB); PG8_STAGE(PG8_SB(1, 1), b3 + hstep, voffB); PG8_STAGE_A(PG8_SA(1, 0), a3, 0, last);
            PG8_WAIT_V(8); PG8_WAIT_L(0); PG8_BAR; PG8_MMA(1, 0, At, B0); PG8_MMA(1, 1, At, B1); PG8_BAR; PG8_SCHED;
        }
        if constexpr (ALIGN_EPI) { if (wr == 0) PG8_BAR; }
        { int frl = fr, fql = fq; asm volatile("" : "+v"(frl), "+v"(fql)); E(acc, cur, wr, wc, frl, fql); }
        if (!has_next) break;
#pragma unroll
        for (int a = 0; a < 2; ++a)
#pragma unroll
            for (int b = 0; b < 2; ++b)
#pragma unroll
                for (int m = 0; m < 4; ++m)
#pragma unroll
                    for (int n = 0; n < 2; ++n) acc[a][b][m][n] = (f32x4){0.f, 0.f, 0.f, 0.f};
        cur = nxt; cA = nA; cB = nB; ++ui; PG8_MC(cur);
        if constexpr (GATHER) {
#pragma unroll
            for (int h = 0; h < 2; ++h)
#pragma unroll
                for (int i = 0; i < 2; ++i) gA[h][i] = gAn[h][i]; }
        if constexpr (ALIGN_EPI) { if (wr == 1) PG8_BAR; }
    }
    PG8_WAIT_V(0);
    if constexpr (!ALIGN_EPI) { if (wr == 0) PG8_BAR; }
    PG8_BAR;
#undef PG8_SA
#undef PG8_SB
#undef PG8_STAGE
#undef PG8_STAGE_A
#undef PG8_LDA
#undef PG8_LDB
#undef PG8_MMA
#undef PG8_WAIT_V
#undef PG8_WAIT_L
#undef PG8_BAR
#undef PG8_SCHED
#undef PG8_MC
}
}

constexpr int LDS_MISC_OFF = 131072;
__device__ __forceinline__ float fast_gelu(float x) { const float y = x + 0.044715f * x * x * x; return x * __builtin_amdgcn_rcpf(1.0f + __builtin_amdgcn_exp2f(-2.0f * 0.7978845608028654f * LOG2E * y)); }
__device__ __forceinline__ float fast_sigmoid(float x) { return __builtin_amdgcn_rcpf(1.0f + __builtin_amdgcn_exp2f(-LOG2E * x)); }
__device__ __forceinline__ void unpack8(const u32x4 w, float (&v)[8]) {
#pragma unroll
    for (int e = 0; e < 4; ++e) { v[2 * e] = __uint_as_float(w[e] << 16); v[2 * e + 1] = __uint_as_float(w[e] & 0xffff0000u); } }

constexpr size_t WS_VSTAT = 6 * MiB;
constexpr int LDS_EPI_OFF = 131072 + 4096;
struct EpiIn {
    static constexpr bool PERM = true, HAS_MID = false;
    bf16_t *U, *V, *Q, *K, *VA, *G; const float* b_gate; const float* qg; const float* kg; float* VSTAT; PG8_LAS unsigned char* lds;
    __device__ __forceinline__ void mid(f32x4 (&)[2][2][4][2], const pg8::Unit&, int, int, int, int) const {}
    __device__ __forceinline__ void operator()(f32x4 (&acc)[2][2][4][2], const pg8::Unit& u, int wr, int wc, int fr, int fq) const {
        const int pn = u.pn; bf16_t* base; int ld, colt, mode;
        if (pn < 4) { base = U; ld = 1024; colt = pn * 256; mode = 1; }
        else if (pn < 8) { base = V; ld = 1024; colt = (pn - 4) * 256; mode = 3; }
        else if (pn < 12) { base = Q; ld = 1024; colt = (pn - 8) * 256; mode = 4; }
        else if (pn < 16) { base = K; ld = 1024; colt = (pn - 12) * 256; mode = 5; }
        else if (pn < 20) { base = VA; ld = 1024; colt = (pn - 16) * 256; mode = 0; }
        else { base = G; ld = 4096; colt = (pn - 20) * 256; mode = 2; }
        const int row0 = u.pm * 256 + wr * 64 + fr, col0 = colt + wc * 32 + 8 * fq;
        if (mode >= 4) {
            PG8_LAS float* P = (PG8_LAS float*)(lds + LDS_EPI_OFF);
#pragma unroll
            for (int ai = 0; ai < 2; ++ai)
#pragma unroll
                for (int m = 0; m < 4; ++m)
#pragma unroll
                    for (int bj = 0; bj < 2; ++bj) { const f32x4 a = acc[ai][bj][m][0], b = acc[ai][bj][m][1];
                        float s = (a[0] * a[0] + a[1] * a[1]) + (a[2] * a[2] + a[3] * a[3]) + (b[0] * b[0] + b[1] * b[1]) + (b[2] * b[2] + b[3] * b[3]);
                        s += __shfl_xor(s, 16); s += __shfl_xor(s, 32);
                        if (fq == 0) P[((ai * 128 + wr * 64 + m * 16 + fr) * 2 + bj) * 4 + wc] = s; }
            asm volatile("s_waitcnt lgkmcnt(0)" ::: "memory"); __builtin_amdgcn_s_barrier(); asm volatile("" ::: "memory");
            const float* gg = mode == 4 ? qg : kg; const float qs = mode == 4 ? QSCALE : 1.0f;
            const f32x4 g0 = *(const f32x4*)(gg + wc * 32 + 8 * fq), g1 = *(const f32x4*)(gg + wc * 32 + 8 * fq + 4);
#pragma unroll
            for (int ai = 0; ai < 2; ++ai)
#pragma unroll
                for (int m = 0; m < 4; ++m) { bf16_t* rowp = base + (size_t)(row0 + ai * 128 + m * 16) * ld + col0;
#pragma unroll
                    for (int bj = 0; bj < 2; ++bj) { const f32x4 pp = *(const PG8_LAS f32x4*)(P + ((ai * 128 + wr * 64 + m * 16 + fr) * 2 + bj) * 4);
                        const float sc = rsqrtf(((pp[0] + pp[1]) + (pp[2] + pp[3])) * (1.f / 128.f) + EPS) * qs;
                        const f32x4 v0 = acc[ai][bj][m][0] * g0 * sc, v1 = acc[ai][bj][m][1] * g1 * sc;
                        u32x4 w; w.x = pg8::cvt_pk_bf16(v0[0], v0[1]); w.y = pg8::cvt_pk_bf16(v0[2], v0[3]); w.z = pg8::cvt_pk_bf16(v1[0], v1[1]); w.w = pg8::cvt_pk_bf16(v1[2], v1[3]);
                        *(u32x4*)(rowp + bj * 128) = w; } }
            return;
        }
        f32x4 bv[2][2];
#pragma unroll
        for (int bj = 0; bj < 2; ++bj)
#pragma unroll
            for (int n = 0; n < 2; ++n) bv[bj][n] = (mode == 2) ? *(const f32x4*)(b_gate + col0 + bj * 128 + 4 * n) : (f32x4){0.f, 0.f, 0.f, 0.f};
#pragma unroll
        for (int ai = 0; ai < 2; ++ai)
#pragma unroll
            for (int m = 0; m < 4; ++m) { bf16_t* rowp = base + (size_t)(row0 + ai * 128 + m * 16) * ld + col0; float s1 = 0.f, s2 = 0.f;
#pragma unroll
                for (int bj = 0; bj < 2; ++bj) { f32x4 v0 = acc[ai][bj][m][0], v1 = acc[ai][bj][m][1];
                    if (mode == 1 || mode == 3) {
#pragma unroll
                        for (int j = 0; j < 4; ++j) { v0[j] = fast_gelu(v0[j]); v1[j] = fast_gelu(v1[j]); } }
                    else if (mode == 2) { v0 += bv[bj][0]; v1 += bv[bj][1];
#pragma unroll
                        for (int j = 0; j < 4; ++j) { v0[j] = fast_sigmoid(v0[j]); v1[j] = fast_sigmoid(v1[j]); } }
                    if (mode == 3) {
#pragma unroll
                        for (int j = 0; j < 4; ++j) { s1 += v0[j] + v1[j]; s2 += v0[j] * v0[j] + v1[j] * v1[j]; } }
                    u32x4 w; w.x = pg8::cvt_pk_bf16(v0[0], v0[1]); w.y = pg8::cvt_pk_bf16(v0[2], v0[3]); w.z = pg8::cvt_pk_bf16(v1[0], v1[1]); w.w = pg8::cvt_pk_bf16(v1[2], v1[3]);
                    *(u32x4*)(rowp + bj * 128) = w; }
                if (mode == 3) { s1 += __shfl_xor(s1, 16); s1 += __shfl_xor(s1, 32); s2 += __shfl_xor(s2, 16); s2 += __shfl_xor(s2, 32);
                    if (fq == 0) { typedef float f32x2_ __attribute__((ext_vector_type(2))); *(f32x2_*)(VSTAT + ((size_t)(row0 + ai * 128 + m * 16) * 16 + (pn - 4) * 4 + wc) * 2) = (f32x2_){s1, s2}; } } }
    }
};
struct EpiProj {
    static constexpr bool PERM = true, HAS_MID = true;
    const bf16_t* G; bf16_t* O;
    __device__ __forceinline__ void mid(f32x4 (&acc)[2][2][4][2], const pg8::Unit& u, int wr, int wc, int fr, int fq) const {
        const int row0 = u.pm * 256 + wr * 64 + fr, col0 = u.pn * 256 + wc * 32 + 8 * fq;
#pragma unroll
        for (int ai = 0; ai < 2; ++ai) { u32x4 ws[4][2], wf[4][2];
#pragma unroll
            for (int m = 0; m < 4; ++m) { const bf16_t* gp = G + (size_t)(row0 + ai * 128 + m * 16) * 4096 + col0;
#pragma unroll
                for (int bj = 0; bj < 2; ++bj) { ws[m][bj] = *(const u32x4*)(gp + bj * 128); wf[m][bj] = *(const u32x4*)(gp + 2048 + bj * 128); } }
#pragma unroll
            for (int m = 0; m < 4; ++m)
#pragma unroll
                for (int bj = 0; bj < 2; ++bj) { float gs[8], gf[8]; unpack8(ws[m][bj], gs); unpack8(wf[m][bj], gf);
#pragma unroll
                    for (int j = 0; j < 4; ++j) { acc[ai][bj][m][0][j] *= gs[j] * __builtin_amdgcn_rcpf(gf[j]); acc[ai][bj][m][1][j] *= gs[4 + j] * __builtin_amdgcn_rcpf(gf[4 + j]); } }
            asm volatile("" ::: "memory"); }
    }
    __device__ __forceinline__ void operator()(f32x4 (&acc)[2][2][4][2], const pg8::Unit& u, int wr, int wc, int fr, int fq) const {
        const int row0 = u.pm * 256 + wr * 64 + fr, col0 = u.pn * 256 + wc * 32 + 8 * fq;
#pragma unroll
        for (int ai = 0; ai < 2; ++ai) { u32x4 wf[4][2];
#pragma unroll
            for (int m = 0; m < 4; ++m)
#pragma unroll
                for (int bj = 0; bj < 2; ++bj) wf[m][bj] = *(const u32x4*)(G + (size_t)(row0 + ai * 128 + m * 16) * 4096 + 2048 + col0 + bj * 128);
#pragma unroll
            for (int m = 0; m < 4; ++m) { const size_t r = (size_t)(row0 + ai * 128 + m * 16);
#pragma unroll
                for (int bj = 0; bj < 2; ++bj) { float gf[8]; unpack8(wf[m][bj], gf);
                    const f32x4 v0 = acc[ai][bj][m][0], v1 = acc[ai][bj][m][1];
                    u32x4 w; w.x = pg8::cvt_pk_bf16(v0[0] * gf[0], v0[1] * gf[1]); w.y = pg8::cvt_pk_bf16(v0[2] * gf[2], v0[3] * gf[3]); w.z = pg8::cvt_pk_bf16(v1[0] * gf[4], v1[1] * gf[5]); w.w = pg8::cvt_pk_bf16(v1[2] * gf[6], v1[3] * gf[7]);
                    *(u32x4*)(O + r * 2048 + col0 + bj * 128) = w; } }
            asm volatile("" ::: "memory"); }
    }
};
struct EpiOut {
    static constexpr bool PERM = false, HAS_MID = false;
    const float* X; float* O;
    __device__ __forceinline__ void mid(f32x4 (&)[2][2][4][2], const pg8::Unit&, int, int, int, int) const {}
    __device__ __forceinline__ void operator()(f32x4 (&acc)[2][2][4][2], const pg8::Unit& u, int wr, int wc, int fr, int fq) const {
        const int row0 = u.pm * 256 + wr * 64 + fr, col0 = u.pn * 256 + wc * 32 + 4 * fq;
#pragma unroll
        for (int ai = 0; ai < 2; ++ai) { f32x4 xv[4][2][2];
#pragma unroll
            for (int m = 0; m < 4; ++m) { const size_t off = (size_t)(row0 + ai * 128 + m * 16) * DM + col0;
#pragma unroll
                for (int bj = 0; bj < 2; ++bj)
#pragma unroll
                    for (int n = 0; n < 2; ++n) xv[m][bj][n] = *(const f32x4*)(X + off + bj * 128 + n * 16); }
#pragma unroll
            for (int m = 0; m < 4; ++m) { const size_t off = (size_t)(row0 + ai * 128 + m * 16) * DM + col0;
#pragma unroll
                for (int bj = 0; bj < 2; ++bj)
#pragma unroll
                    for (int n = 0; n < 2; ++n) *(f32x4*)(O + off + bj * 128 + n * 16) = xv[m][bj][n] + acc[ai][bj][m][n]; }
            asm volatile("" ::: "memory"); }
    }
};
struct EpiGateUp {
    static constexpr bool PERM = true, HAS_MID = false;
    bf16_t* ACT; const float* RSTL;
    __device__ __forceinline__ void mid(f32x4 (&)[2][2][4][2], const pg8::Unit&, int, int, int, int) const {}
    __device__ __forceinline__ void operator()(f32x4 (&acc)[2][2][4][2], const pg8::Unit& u, int wr, int wc, int fr, int fq) const {
        const int row0 = u.x0 + wr * 64 + fr, col0 = u.pn * 128 + wc * 32 + 8 * fq;
        float rrv[2][4];
#pragma unroll
        for (int ai = 0; ai < 2; ++ai)
#pragma unroll
            for (int m = 0; m < 4; ++m) rrv[ai][m] = RSTL[u.x1 + wr * 64 + fr + ai * 128 + m * 16];
#pragma unroll
        for (int ai = 0; ai < 2; ++ai)
#pragma unroll
            for (int m = 0; m < 4; ++m) { float o[8]; const float rr = rrv[ai][m];
#pragma unroll
                for (int n = 0; n < 2; ++n)
#pragma unroll
                    for (int j = 0; j < 4; ++j) { const float g = acc[ai][0][m][n][j] * rr, up = acc[ai][1][m][n][j] * rr; o[4 * n + j] = g * fast_sigmoid(g) * up; }
                u32x4 w; w.x = pg8::cvt_pk_bf16(o[0], o[1]); w.y = pg8::cvt_pk_bf16(o[2], o[3]); w.z = pg8::cvt_pk_bf16(o[4], o[5]); w.w = pg8::cvt_pk_bf16(o[6], o[7]);
                *(u32x4*)(ACT + (size_t)(row0 + ai * 128 + m * 16) * DEXP + col0) = w; }
    }
};
struct EpiDown {
    static constexpr bool PERM = true, HAS_MID = false;
    bf16_t* Y; const float* GATE;
    __device__ __forceinline__ void mid(f32x4 (&)[2][2][4][2], const pg8::Unit&, int, int, int, int) const {}
    __device__ __forceinline__ void operator()(f32x4 (&acc)[2][2][4][2], const pg8::Unit& u, int wr, int wc, int fr, int fq) const {
        const int rl0 = wr * 64 + fr, col0 = u.pn * 256 + wc * 32 + 8 * fq;
        float gtv[2][4];
#pragma unroll
        for (int ai = 0; ai < 2; ++ai)
#pragma unroll
            for (int m = 0; m < 4; ++m) gtv[ai][m] = GATE[u.x1 + rl0 + ai * 128 + m * 16];
#pragma unroll
        for (int ai = 0; ai < 2; ++ai)
#pragma unroll
            for (int m = 0; m < 4; ++m) { const int rl = rl0 + ai * 128 + m * 16; const float gt = gtv[ai][m];
#pragma unroll
                for (int bj = 0; bj < 2; ++bj) { const f32x4 v0 = acc[ai][bj][m][0] * gt, v1 = acc[ai][bj][m][1] * gt;
                    u32x4 w; w.x = pg8::cvt_pk_bf16(v0[0], v0[1]); w.y = pg8::cvt_pk_bf16(v0[2], v0[3]); w.z = pg8::cvt_pk_bf16(v1[0], v1[1]); w.w = pg8::cvt_pk_bf16(v1[2], v1[3]);
                    *(u32x4*)(Y + (size_t)(u.x0 + rl) * DM + col0 + bj * 128) = w; } }
    }
};
struct MoeOrder {
    const char* Abase; const char* Bbase; size_t Bstride; int K, nN, G, c; bool gather;
    const PG8_LAS int* ps;
    const unsigned* cnt; const int* TOK; bool xcdm;
    __device__ static int tile_of(int i, int c, int G, int nN, int nb, int& pn, bool xcdm) {
        const int S = (G / 8) / nN;
        if (!xcdm || G % 8 != 0 || S < 1) { const int L = i * G + c; pn = L % nN; return L / nN < nb ? L / nN : -1; }
        const int x = c % 8, slot = c / 8; pn = slot % nN;
        if (slot >= S * nN) return -1;
        const int sidx = i * (8 * S) + x * S + slot / nN; return sidx < nb ? sidx : -1;
    }
    __device__ bool next(int i, pg8::Unit& u) const {
        int pn; const int sidx = tile_of(i, c, G, nN, ps[NEXP + 2], pn, xcdm); if (sidx < 0) return false;
        const int prow = ps[40 + sidx], info = ps[40 + MT_MAX + sidx], valid = ps[40 + 2 * MT_MAX + sidx];
        const int e = info >> 16, mt = info & 0xffff;
        u.pm = mt; u.pn = pn; u.x0 = prow; u.x1 = e * T + mt * MTILE; u.x2 = valid; u.x3 = e;
        u.A = gather ? Abase : Abase + (size_t)prow * K * 2; u.B = Bbase + (size_t)e * Bstride + (size_t)pn * 256 * K * 2; return true;
    }
    __device__ __forceinline__ void rows(const pg8::Unit& u, unsigned (&g)[2][2], const int (&RA)[2]) const {
#pragma unroll
        for (int h = 0; h < 2; ++h)
#pragma unroll
            for (int i = 0; i < 2; ++i) { int r = RA[i] + 128 * h; r = r < u.x2 ? r : u.x2 - 1; g[h][i] = (unsigned)TOK[u.x1 + r] * (unsigned)(K * 2); }
    }
};

struct TItem { const float* src; bf16_t* dst; int ld_src, ld_dst; };
__device__ __forceinline__ void titem_load(const TItem& t, f32x4 (&v)[8], int lane) {
#pragma unroll
    for (int i = 0; i < 8; ++i) v[i] = *(const f32x4*)(t.src + (size_t)((lane >> 3) + 8 * i) * t.ld_src + 4 * (lane & 7));
}
__device__ __forceinline__ void titem_store(const TItem& t, const f32x4 (&v)[8], PG8_LAS float* scr, int lane) {
#pragma unroll
    for (int i = 0; i < 8; ++i) { PG8_LAS float* d = scr + ((lane >> 3) + 8 * i) * 33 + 4 * (lane & 7); d[0] = v[i].x; d[1] = v[i].y; d[2] = v[i].z; d[3] = v[i].w; }
    asm volatile("s_waitcnt lgkmcnt(0)" ::: "memory");
    const int c = lane & 7;
#pragma unroll
    for (int j = 0; j < 4; ++j) { const int n = (lane >> 3) + 8 * j; const PG8_LAS float* s = scr + (8 * c) * 33 + n;
        u32x4 o; o.x = pk2(s[0 * 33], s[1 * 33]); o.y = pk2(s[2 * 33], s[3 * 33]); o.z = pk2(s[4 * 33], s[5 * 33]); o.w = pk2(s[6 * 33], s[7 * 33]);
        *(u32x4*)(t.dst + (size_t)n * t.ld_dst + 8 * c) = o; }
    asm volatile("s_waitcnt lgkmcnt(0)" ::: "memory");
}
constexpr int TI0 = 32 * 288, TI1 = 16 * 64, TI2 = 16 * 64, TI3 = 32 * 64, TI4 = 32 * 512, TI5 = 32 * 512, TI6 = 32 * 512;
constexpr int TI_ALL = TI0 + TI1 + TI2 + TI3 + TI4 + TI5 + TI6;
#ifndef TAIL1_ITEMS
#define TAIL1_ITEMS (TI5)
#endif
__device__ __forceinline__ TItem titem_decode(const Args& A, int r) {
    bf16_t* WIN = (bf16_t*)(A.ws + WS_WIN); bf16_t* WPROJ = (bf16_t*)(A.ws + WS_WPROJ); bf16_t* WOUT = (bf16_t*)(A.ws + WS_WOUT); bf16_t* WGU = (bf16_t*)(A.ws + WS_WGU); bf16_t* WD = (bf16_t*)(A.ws + WS_WD);
    TItem t;
    if (r < TI0) { const int kb = r / 288, nb = r % 288; t.src = A.in[2] + (size_t)(64 * kb) * INCOLS + 32 * nb + (nb >= 160 ? 8 : 0); t.ld_src = INCOLS; t.dst = WIN + (size_t)(32 * nb) * 2048 + 64 * kb; t.ld_dst = 2048; return t; } r -= TI0;
    if (r < TI1) { const int kb = r / 64, nb = r % 64; t.src = A.in[11] + (size_t)(64 * kb) * DM + 32 * nb; t.ld_src = DM; t.dst = WPROJ + (size_t)(32 * nb) * 2048 + 64 * kb; t.ld_dst = 2048; return t; } r -= TI1;
    if (r < TI2) { const int kb = r / 64, nb = r % 64; t.src = A.in[12] + (size_t)(64 * kb) * DM + 32 * nb; t.ld_src = DM; t.dst = WPROJ + (size_t)(32 * nb) * 2048 + 1024 + 64 * kb; t.ld_dst = 2048; return t; } r -= TI2;
    if (r < TI3) { const int kb = r / 64, nb = r % 64; t.src = A.in[13] + (size_t)(64 * kb) * DM + 32 * nb; t.ld_src = DM; t.dst = WOUT + (size_t)(32 * nb) * 2048 + 64 * kb; t.ld_dst = 2048; return t; } r -= TI3;
    if (r < TI4 + TI5) { const int up = r >= TI4; if (up) r -= TI4; const int e = r / 512, q = r % 512, kb = q / 16, nb = q % 16, n = 32 * nb, drow = 256 * (n >> 7) + (n & 127) + (up ? 128 : 0);
        t.src = A.in[up ? 20 : 19] + (size_t)e * DM * DEXP + (size_t)(64 * kb) * DEXP + n; t.ld_src = DEXP; t.dst = WGU + ((size_t)e * 1024 + drow) * 2048 + 64 * kb; t.ld_dst = 2048; return t; } r -= TI4 + TI5;
    { const int e = r / 512, q = r % 512, kb = q / 64, nb = q % 64; t.src = A.in[21] + (size_t)e * DEXP * DM + (size_t)(64 * kb) * DM + 32 * nb; t.ld_src = DM; t.dst = WD + ((size_t)e * 2048 + 32 * nb) * 512 + 64 * kb; t.ld_dst = 512; return t; }
}
__device__ __forceinline__ void p0_weights(const Args& A, PG8_LAS unsigned char* lds, const int part, const int wrank, const int wcount) {
    const int tid = threadIdx.x, lane = tid & 63, wave = tid >> 6;
    PG8_LAS float* scr = (PG8_LAS float*)(lds + wave * 16384);
    if (wrank < 0 || wcount < 1) return;
    const int gw = wrank * NWAVES + wave, NGW = wcount * NWAVES;
    const int cut1 = TI_ALL - TI6 - TAIL1_ITEMS, cut2 = TI_ALL - TI6;
    const int it_lo = part == 0 ? 0 : (part == 1 ? cut1 : cut2), it_hi = part == 0 ? cut1 : (part == 1 ? cut2 : TI_ALL);
    int it = it_lo + gw; if (it >= it_hi) return;
    TItem cur = titem_decode(A, it); f32x4 va[8], vb[8];
    titem_load(cur, va, lane);
    for (;;) {
        const int itn = it + NGW; const bool more = itn < it_hi; TItem nx = cur;
        if (more) { nx = titem_decode(A, itn); titem_load(nx, vb, lane); }
        titem_store(cur, va, scr, lane);
        if (!more) break;
#pragma unroll
        for (int i = 0; i < 8; ++i) va[i] = vb[i];
        cur = nx; it = itn;
    }
}

__device__ __forceinline__ void p1_fast(const Args& A, PG8_LAS unsigned char* lds) {
    pg8::DenseOrder S; S.init(A.ws + WS_H, A.ws + WS_WIN, T, 9216, DM, gridDim.x, blockIdx.x, PROBE_REP_P1);
    EpiIn E{(bf16_t*)(A.ws + WS_U), (bf16_t*)(A.ws + WS_V), (bf16_t*)(A.ws + WS_Q), (bf16_t*)(A.ws + WS_K), (bf16_t*)(A.ws + WS_VA), (bf16_t*)(A.ws + WS_G), A.in[3], A.in[9], A.in[10], (float*)(A.ws + WS_VSTAT), lds};
    pg8::gemm_phase<EpiIn, pg8::DenseOrder, true, false>(lds, DM, S, E);
}
__device__ __forceinline__ void p3_fast(const Args& A, PG8_LAS unsigned char* lds) {
    pg8::DenseOrder S; S.init(A.ws + WS_MIXIN, A.ws + WS_WPROJ, T, DM, 2048, gridDim.x, blockIdx.x, PROBE_REP_P4);
    EpiProj E{(const bf16_t*)(A.ws + WS_G), (bf16_t*)(A.ws + WS_MIXED)};
    pg8::gemm_phase<EpiProj, pg8::DenseOrder, true, false>(lds, 2048, S, E);
}
__device__ __forceinline__ void p4_fast(const Args& A, PG8_LAS unsigned char* lds) {
    pg8::DenseOrder S; S.init(A.ws + WS_MIXED, A.ws + WS_WOUT, T, DM, DM, gridDim.x, blockIdx.x, PROBE_REP_P5);
    EpiOut E{A.in[0], A.out};
    pg8::gemm_phase<EpiOut, pg8::DenseOrder, true, false>(lds, DM, S, E);
}
__device__ __forceinline__ void moe_layout_lds(const Args& A, PG8_LAS unsigned char* lds) {
    PG8_LAS int* ps = (PG8_LAS int*)(lds + LDS_MISC_OFF); PG8_LAS int* tprow = ps + 40; PG8_LAS int* tinfo = tprow + MT_MAX; PG8_LAS int* tvalid = tinfo + MT_MAX;
    const unsigned* cnt = (const unsigned*)(A.ws + WS_CTL) + CW_CNT;
    if (threadIdx.x == 0) { int acc = 0;
        for (int e = 0; e < NEXP; ++e) { ps[e] = acc; acc += ((int)cnt[(e) * CNT_STRIDE] + MTILE - 1) / MTILE * MTILE; }
        ps[NEXP] = acc; ps[NEXP + 1] = acc / MTILE; }
    __syncthreads();
    const int nt = ps[NEXP + 1]; PG8_LAS int* uval = tvalid + MT_MAX;
    int prow = 0, e = 0, mt = 0, valid = 0;
    if ((int)threadIdx.x < nt) { prow = (int)threadIdx.x * MTILE;
        for (int j = 1; j < NEXP; ++j) if (ps[j] <= prow) e = j;
        mt = (prow - ps[e]) / MTILE; valid = (int)cnt[(e) * CNT_STRIDE] - mt * MTILE; valid = valid > MTILE ? MTILE : valid; uval[threadIdx.x] = valid; }
    __syncthreads();
    if ((int)threadIdx.x < nt) { int rank = 0;
        if (TINY_ROWS > 0) { for (int j = 0; j < nt; ++j) { const int vj = uval[j]; rank += (vj > valid || (vj == valid && j < (int)threadIdx.x)) ? 1 : 0; } } else rank = (int)threadIdx.x;
        tprow[rank] = prow; tinfo[rank] = (e << 16) | mt; tvalid[rank] = valid; }
    if (threadIdx.x == 0) { int nb = 0; for (int j = 0; j < nt; ++j) nb += uval[j] > TINY_ROWS ? 1 : 0; ps[NEXP + 2] = nb; }
    __syncthreads();
}
namespace sm {
typedef short bf16x8 __attribute__((ext_vector_type(8))); typedef float f32x16 __attribute__((ext_vector_type(16)));
constexpr int TINY = 64;
__device__ __forceinline__ void gateup_small(const Args& A, PG8_LAS unsigned char* lds) {
    const PG8_LAS int* ps = (const PG8_LAS int*)(lds + LDS_MISC_OFF); const int nt = ps[NEXP + 1], nbig = ps[NEXP + 2];
    const bf16_t* H2 = (const bf16_t*)(A.ws + WS_H2); const bf16_t* WGU = (const bf16_t*)(A.ws + WS_WGU); bf16_t* ACT = (bf16_t*)(A.ws + WS_ACT); const int* TOK = (const int*)(A.ws + WS_TOK);
    const int tid = threadIdx.x, lane = tid & 63, w = __builtin_amdgcn_readfirstlane(tid >> 6), r32 = lane & 31, hi = lane >> 5;
    PG8_LAS float* red = (PG8_LAS float*)lds;
    for (int su = blockIdx.x; su < (nt - nbig) * 16; su += gridDim.x) {
        const int sidx = nbig + (su >> 4), sl = su & 15; const int prow = ps[40 + sidx], info = ps[40 + MT_MAX + sidx], valid = ps[40 + 2 * MT_MAX + sidx];
        const int e = info >> 16, mt = info & 0xffff, lbase = e * T + mt * MTILE;
        const int ra = r32 < valid ? r32 : valid - 1, rb = 32 + r32 < valid ? 32 + r32 : valid - 1;
        const bf16_t* a0p = H2 + (size_t)TOK[lbase + ra] * DM + 256 * w + 8 * hi; const bf16_t* a1p = H2 + (size_t)TOK[lbase + rb] * DM + 256 * w + 8 * hi;
        const bf16_t* b0p = WGU + ((size_t)e * 1024 + 256 * (sl >> 2) + 32 * (sl & 3) + r32) * DM + 256 * w + 8 * hi; const bf16_t* b1p = b0p + (size_t)128 * DM;
        f32x16 acc[2][2];
#pragma unroll
        for (int i = 0; i < 2; ++i)
#pragma unroll
            for (int j = 0; j < 2; ++j)
#pragma unroll
                for (int r = 0; r < 16; ++r) acc[i][j][r] = 0.f;
#pragma unroll 4
        for (int ks = 0; ks < 16; ++ks) { const bf16x8 a0 = *(const bf16x8*)(a0p + 16 * ks), a1 = *(const bf16x8*)(a1p + 16 * ks), b0 = *(const bf16x8*)(b0p + 16 * ks), b1 = *(const bf16x8*)(b1p + 16 * ks);
            acc[0][0] = __builtin_amdgcn_mfma_f32_32x32x16_bf16(a0, b0, acc[0][0], 0, 0, 0); acc[0][1] = __builtin_amdgcn_mfma_f32_32x32x16_bf16(a0, b1, acc[0][1], 0, 0, 0);
            acc[1][0] = __builtin_amdgcn_mfma_f32_32x32x16_bf16(a1, b0, acc[1][0], 0, 0, 0); acc[1][1] = __builtin_amdgcn_mfma_f32_32x32x16_bf16(a1, b1, acc[1][1], 0, 0, 0); }
#pragma unroll
        for (int i = 0; i < 2; ++i)
#pragma unroll
            for (int j = 0; j < 2; ++j)
#pragma unroll
                for (int r = 0; r < 16; ++r) red[(((w * 2 + i) * 2 + j) * 16 + r) * 64 + lane] = acc[i][j][r];
        __syncthreads();
#pragma unroll
        for (int i = 0; i < 2; ++i)
#pragma unroll
            for (int rr = 0; rr < 2; ++rr) { const int r = 2 * w + rr; float g = 0.f, u = 0.f;
#pragma unroll
                for (int w2 = 0; w2 < 8; ++w2) { g += red[(((w2 * 2 + i) * 2 + 0) * 16 + r) * 64 + lane]; u += red[(((w2 * 2 + i) * 2 + 1) * 16 + r) * 64 + lane]; }
                const int row = 32 * i + (r & 3) + 8 * (r >> 2) + 4 * hi; const float rr2 = ((const float*)(A.ws + WS_RSTL))[lbase + (row < valid ? row : valid - 1)]; g *= rr2; u *= rr2;
                ACT[(size_t)(prow + row) * DEXP + 32 * sl + r32] = f2bf(g * fast_sigmoid(g) * u); }
        __syncthreads();
    }
}
__device__ __forceinline__ void down_small(const Args& A, PG8_LAS unsigned char* lds) {
    const PG8_LAS int* ps = (const PG8_LAS int*)(lds + LDS_MISC_OFF); const int nt = ps[NEXP + 1], nbig = ps[NEXP + 2];
    const bf16_t* ACT = (const bf16_t*)(A.ws + WS_ACT); const bf16_t* WD = (const bf16_t*)(A.ws + WS_WD); bf16_t* Y = (bf16_t*)(A.ws + WS_YBUF); const float* GATE = (const float*)(A.ws + WS_GATE);
    const int tid = threadIdx.x, lane = tid & 63, w = __builtin_amdgcn_readfirstlane(tid >> 6), wn = w & 3, wk = w >> 2, r32 = lane & 31, hi = lane >> 5;
    PG8_LAS float* red = (PG8_LAS float*)lds;
    for (int su = blockIdx.x; su < (nt - nbig) * 16; su += gridDim.x) {
        const int sidx = nbig + (su >> 4), sl = su & 15; const int prow = ps[40 + sidx], info = ps[40 + MT_MAX + sidx], valid = ps[40 + 2 * MT_MAX + sidx];
        const int e = info >> 16, mt = info & 0xffff, lbase = e * T + mt * MTILE;
        const int ra = r32 < valid ? r32 : valid - 1, rb = 32 + r32 < valid ? 32 + r32 : valid - 1;
        const bf16_t* a0p = ACT + (size_t)(prow + ra) * DEXP + 256 * wk + 8 * hi; const bf16_t* a1p = ACT + (size_t)(prow + rb) * DEXP + 256 * wk + 8 * hi;
        const bf16_t* bp = WD + ((size_t)e * 2048 + 128 * sl + 32 * wn + r32) * DEXP + 256 * wk + 8 * hi;
        f32x16 acc[2];
#pragma unroll
        for (int i = 0; i < 2; ++i)
#pragma unroll
            for (int r = 0; r < 16; ++r) acc[i][r] = 0.f;
#pragma unroll 4
        for (int ks = 0; ks < 16; ++ks) { const bf16x8 a0 = *(const bf16x8*)(a0p + 16 * ks), a1 = *(const bf16x8*)(a1p + 16 * ks), b = *(const bf16x8*)(bp + 16 * ks);
            acc[0] = __builtin_amdgcn_mfma_f32_32x32x16_bf16(a0, b, acc[0], 0, 0, 0); acc[1] = __builtin_amdgcn_mfma_f32_32x32x16_bf16(a1, b, acc[1], 0, 0, 0); }
        if (wk == 1) {
#pragma unroll
            for (int i = 0; i < 2; ++i)
#pragma unroll
                for (int r = 0; r < 16; ++r) red[((wn * 2 + i) * 16 + r) * 64 + lane] = acc[i][r]; }
        __syncthreads();
        if (wk == 0) {
#pragma unroll
            for (int i = 0; i < 2; ++i)
#pragma unroll
                for (int r = 0; r < 16; ++r) { const int row = 32 * i + (r & 3) + 8 * (r >> 2) + 4 * hi; const float gt = GATE[lbase + (row < valid ? row : valid - 1)];
                    Y[(size_t)(prow + row) * DM + 128 * sl + 32 * wn + r32] = f2bf((acc[i][r] + red[((wn * 2 + i) * 16 + r) * 64 + lane]) * gt); } }
        __syncthreads();
    }
}
}

__device__ __forceinline__ void p6_fast(const Args& A, PG8_LAS unsigned char* lds) {
    moe_layout_lds(A, lds);
    MoeOrder S{(const char*)(A.ws + WS_H2), (const char*)(A.ws + WS_WGU), (size_t)1024 * 2048 * 2, DM, 4, (int)gridDim.x, (int)blockIdx.x, true,
               (const PG8_LAS int*)(lds + LDS_MISC_OFF), (const unsigned*)(A.ws + WS_CTL) + CW_CNT, (const int*)(A.ws + WS_TOK), XCDM_GU};
    EpiGateUp E{(bf16_t*)(A.ws + WS_ACT), (const float*)(A.ws + WS_RSTL)};
    pg8::gemm_phase<EpiGateUp, MoeOrder, true, true>(lds, DM, S, E);
    sm::gateup_small(A, lds);
    {
        PG8_LAS int* pw = (PG8_LAS int*)(lds + LDS_MISC_OFF) + 40 + 4 * MT_MAX;
        const int nb = ((const PG8_LAS int*)(lds + LDS_MISC_OFF))[NEXP + 2], G = (int)gridDim.x; int pn_;
        const int per = XCDM_GU ? 8 * ((G / 8) / 4) : G / 4, rounds = per > 0 ? (nb + per - 1) / per : 1;
        const int t = (int)threadIdx.x; const bool idle_t = t < G && MoeOrder::tile_of(rounds - 1, t, G, 4, nb, pn_, XCDM_GU) < 0;
        float before = (idle_t && t < (int)blockIdx.x) ? 1.f : 0.f, all = idle_t ? 1.f : 0.f;
        before = wave_sum(before); all = wave_sum(all);
        __syncthreads();
        if ((t & 63) == 0) { pw[2 + (t >> 6)] = (int)before; pw[10 + (t >> 6)] = (int)all; }
        __syncthreads();
        if (t == 0) { int rk = 0, tot = 0; for (int w = 0; w < NWAVES; ++w) { rk += pw[2 + w]; tot += pw[10 + w]; }
            const bool me_idle = MoeOrder::tile_of(rounds - 1, (int)blockIdx.x, G, 4, nb, pn_, XCDM_GU) < 0;
            pw[0] = tot == 0 ? (int)blockIdx.x : (me_idle ? rk : -1); pw[1] = tot == 0 ? G : tot; }
        __syncthreads();
        p0_weights(A, lds, 2, pw[0], pw[1]); }
}
__device__ __forceinline__ void p7_fast(const Args& A, PG8_LAS unsigned char* lds) {
    moe_layout_lds(A, lds);
    MoeOrder S{(const char*)(A.ws + WS_ACT), (const char*)(A.ws + WS_WD), (size_t)2048 * 512 * 2, DEXP, 8, (int)gridDim.x, (int)blockIdx.x, false,
               (const PG8_LAS int*)(lds + LDS_MISC_OFF), (const unsigned*)(A.ws + WS_CTL) + CW_CNT, (const int*)(A.ws + WS_TOK), true};
    EpiDown E{(bf16_t*)(A.ws + WS_YBUF), (const float*)(A.ws + WS_GATE)};
    pg8::gemm_phase<EpiDown, MoeOrder, true, false>(lds, DEXP, S, E);
    sm::down_small(A, lds);
}

namespace fa {
typedef short bf16x8 __attribute__((ext_vector_type(8)));
typedef short v4i16 __attribute__((ext_vector_type(4)));
typedef float f32x16 __attribute__((ext_vector_type(16)));
#define FA_LAS __attribute__((address_space(3)))
constexpr int KVBUF = 65536, LDS_CK = 131072, LDS_ML = 131072 + 8192;
__device__ __forceinline__ unsigned cvtpk(float lo, float hi) { unsigned r; asm("v_cvt_pk_bf16_f32 %0, %1, %2" : "=v"(r) : "v"(lo), "v"(hi)); return r; }
__device__ __forceinline__ bf16x8 pack8(const f32x16& p, int b) { u32x4 w; w.x = cvtpk(p[b], p[b + 1]); w.y = cvtpk(p[b + 2], p[b + 3]); w.z = cvtpk(p[b + 4], p[b + 5]); w.w = cvtpk(p[b + 6], p[b + 7]); return __builtin_bit_cast(bf16x8, w); }
__device__ __forceinline__ float swapmax(float v) { auto rr = __builtin_amdgcn_permlane32_swap(__float_as_uint(v), __float_as_uint(v), false, false); return fmaxf(__uint_as_float(rr[0]), __uint_as_float(rr[1])); }
__device__ __forceinline__ float swapsum(float v) { auto rr = __builtin_amdgcn_permlane32_swap(__float_as_uint(v), __float_as_uint(v), false, false); return __uint_as_float(rr[0]) + __uint_as_float(rr[1]); }
#define FA_WAITBAR() do { asm volatile("s_waitcnt vmcnt(0) lgkmcnt(0)" ::: "memory"); __builtin_amdgcn_s_barrier(); asm volatile("" ::: "memory"); } while (0)

__device__ __forceinline__ void attn_phase(const Args& A, FA_LAS unsigned char* lds) {
    const bf16_t* Q = (const bf16_t*)(A.ws + WS_Q); const bf16_t* Kt = (const bf16_t*)(A.ws + WS_K); const bf16_t* Vt = (const bf16_t*)(A.ws + WS_VA);
    const float* CKL = (const float*)(A.ws + WS_CKL); bf16_t* MIXIN = (bf16_t*)(A.ws + WS_MIXIN);
    const int tid = threadIdx.x, lane = tid & 63, wid = __builtin_amdgcn_readfirstlane(tid >> 6), rg = wid & 3, kh = wid >> 2, r32 = lane & 31, hi = lane >> 5;
    int koff[4];
#pragma unroll
    for (int i = 0; i < 4; ++i) { const int rl = 4 * i + (lane >> 4); koff[i] = rl * 1024 + (((lane & 15) ^ rl) * 8); }
    const int voff = (lane >> 4) * 1024 + (((lane & 15) ^ ((lane >> 4) << 2)) * 8);
    int kfo[8];
#pragma unroll
    for (int d0 = 0; d0 < 8; ++d0) kfo[d0] = (kh * 64 + r32) * 256 + (((2 * d0 + hi) ^ (r32 & 15)) * 16);
    int vfo[4];
    { const int dh = (lane >> 4) & 1, q = (lane & 15) >> 2, p = lane & 3;
#pragma unroll
      for (int db = 0; db < 4; ++db) vfo[db] = (kh * 64 + 4 * hi + q) * 256 + ((db ^ q) * 64) + dh * 32 + p * 8; }
    const unsigned ldsb = (unsigned)(uintptr_t)lds;
    const int G = gridDim.x;
    for (int vb0 = blockIdx.x; vb0 < 256 * PROBE_REP_ATTN; vb0 += G) { const int vb = vb0 % 256;
        const int item = (G % 8 == 0) ? ((vb % 8) * 32 + (vb / 8)) % 256 : vb;
        const int bh = item >> 3, ii = item & 7, b = bh >> 3, h = bh & 7;
        const bf16_t* Kg = Kt + (size_t)b * SEQ * 1024 + h * 128; const bf16_t* Vg = Vt + (size_t)b * SEQ * 1024 + h * 128;
        { const f32x4 c = *(const f32x4*)(CKL + (size_t)bh * SEQ + tid * 4); *(FA_LAS f32x4*)(lds + LDS_CK + tid * 16) = (f32x4){-c.x, -c.y, -c.z, -c.w}; }
#define FA_ISSUE_K(key0, kb_) do { const bf16_t* kg_ = Kg + (size_t)((key0) + 16 * wid) * 1024; \
        _Pragma("unroll") for (int i_ = 0; i_ < 4; ++i_) __builtin_amdgcn_global_load_lds((const unsigned*)(kg_ + koff[i_]), (FA_LAS unsigned*)(lds + (kb_) * 32768 + (wid * 4 + i_) * 1024), 16, 0, 0); } while (0)
#define FA_ISSUE_V(key0, vb_) do { const bf16_t* vg_ = Vg + (size_t)((key0) + 16 * wid) * 1024; \
        _Pragma("unroll") for (int i_ = 0; i_ < 4; ++i_) __builtin_amdgcn_global_load_lds((const unsigned*)(vg_ + i_ * 4096 + voff), (FA_LAS unsigned*)(lds + 65536 + (vb_) * 32768 + (wid * 4 + i_) * 1024), 16, 0, 0); } while (0)
#define FA_DSR128(dst, addr, off) asm volatile("ds_read_b128 %0, %1 offset:%2" : "=v"(dst) : "v"(addr), "n"(off))
#define FA_DSTR(dst, addr, off) asm volatile("ds_read_b64_tr_b16 %0, %1 offset:%2" : "=v"(dst) : "v"(addr), "n"(off))
#define FA_LGKM(n) asm volatile("s_waitcnt lgkmcnt(" #n ")" ::: "memory")
#define FA_SB() __builtin_amdgcn_sched_barrier(0)
#define FA_QK_STEP(i, P0, P1, W) do { FA_LGKM(W); FA_SB(); \
        if (((i) & 1) == 0) P0 = __builtin_amdgcn_mfma_f32_32x32x16_bf16(kr[(i) & 3], qf[(i) >> 1], P0, 0, 0, 0); else P1 = __builtin_amdgcn_mfma_f32_32x32x16_bf16(kr[(i) & 3], qf[(i) >> 1], P1, 0, 0, 0); \
        FA_SB(); if ((i) + 4 < 16) FA_DSR128(kr[(i) & 3], ka_[((i) + 4) >> 1], (((i) + 4) & 1) * 8192); } while (0)
#define FA_QK(P0, P1, kbuf, kbk) do { FA_LAS const float* nck = (FA_LAS const float*)(lds + LDS_CK) + (kbk) * 128 + kh * 64 + 4 * hi; \
        _Pragma("unroll") for (int g_ = 0; g_ < 4; ++g_) { const f32x4 t0 = *(FA_LAS const f32x4*)(nck + 8 * g_), t1 = *(FA_LAS const f32x4*)(nck + 32 + 8 * g_); \
            _Pragma("unroll") for (int j_ = 0; j_ < 4; ++j_) { P0[4 * g_ + j_] = t0[j_]; P1[4 * g_ + j_] = t1[j_]; } } \
        unsigned ka_[8]; _Pragma("unroll") for (int d0 = 0; d0 < 8; ++d0) ka_[d0] = ldsb + (unsigned)((kbuf) * 32768 + kfo[d0]); \
        bf16x8 kr[4]; FA_SB(); FA_DSR128(kr[0], ka_[0], 0); FA_DSR128(kr[1], ka_[0], 8192); FA_DSR128(kr[2], ka_[1], 0); FA_DSR128(kr[3], ka_[1], 8192); \
        FA_QK_STEP(0, P0, P1, 3); FA_QK_STEP(1, P0, P1, 3); FA_QK_STEP(2, P0, P1, 3); FA_QK_STEP(3, P0, P1, 3); FA_QK_STEP(4, P0, P1, 3); FA_QK_STEP(5, P0, P1, 3); FA_QK_STEP(6, P0, P1, 3); FA_QK_STEP(7, P0, P1, 3); \
        FA_QK_STEP(8, P0, P1, 3); FA_QK_STEP(9, P0, P1, 3); FA_QK_STEP(10, P0, P1, 3); FA_QK_STEP(11, P0, P1, 3); FA_QK_STEP(12, P0, P1, 3); FA_QK_STEP(13, P0, P1, 2); FA_QK_STEP(14, P0, P1, 1); FA_QK_STEP(15, P0, P1, 0); } while (0)
#define FA_PV_STEP(i, W) do { FA_LGKM(W); FA_SB(); \
        { const bf16x8 vf_ = (bf16x8){vl[(i) & 1][0], vl[(i) & 1][1], vl[(i) & 1][2], vl[(i) & 1][3], vh[(i) & 1][0], vh[(i) & 1][1], vh[(i) & 1][2], vh[(i) & 1][3]}; \
          o[(i) >> 2] = __builtin_amdgcn_mfma_f32_32x32x16_bf16(vf_, pf[(i) & 3], o[(i) >> 2], 0, 0, 0); } \
        FA_SB(); if ((i) + 2 < 16) { FA_DSTR(vl[(i) & 1], va_[((i) + 2) >> 2], (((i) + 2) & 3) * 4096); FA_DSTR(vh[(i) & 1], va_[((i) + 2) >> 2], (((i) + 2) & 3) * 4096 + 2048); } } while (0)
        const int qbL = 15 - ii, nsteps = 17;
#define FA_KB(s_) ((s_) <= qbL ? (s_) : ii - ((s_) - qbL - 1))
        int u = 0, qb = qbL, kb = 0, g = 0;
        FA_ISSUE_K(0, 0); FA_ISSUE_V(0, 0); FA_ISSUE_K(FA_KB(1) * 128, 1);
        bf16x8 qf[8]; f32x16 o[4]; float m = -1e30f, l = 0.f;
        { const bf16_t* qp = Q + (size_t)(b * SEQ + qb * 128 + rg * 32 + r32) * 1024 + h * 128 + 8 * hi;
#pragma unroll
          for (int d0 = 0; d0 < 8; ++d0) qf[d0] = *(const bf16x8*)(qp + 16 * d0); }
#pragma unroll
        for (int db = 0; db < 4; ++db)
#pragma unroll
            for (int r = 0; r < 16; ++r) o[db][r] = 0.f;
        FA_WAITBAR();
        f32x16 p0, p1, n0, n1;
        FA_QK(p0, p1, 0, 0);
        FA_WAITBAR();
        bool diag = false, lastb = false, done = false;
#define FA_SOFTPV(C0, C1) do { \
            if (diag) { const int qrel = rg * 32 + r32, k0 = kh * 64 + 4 * hi; \
                _Pragma("unroll") for (int r = 0; r < 16; ++r) { const int kr = k0 + (r & 3) + 8 * (r >> 2); if (kr > qrel) C0[r] = -INFINITY; if (kr + 32 > qrel) C1[r] = -INFINITY; } } \
            float mx = fmaxf(C0[0], C1[0]); \
            _Pragma("unroll") for (int r = 1; r < 16; ++r) mx = fmaxf(mx, fmaxf(C0[r], C1[r])); \
            mx = swapmax(mx); \
            const float mn = fmaxf(m, mx), alpha = __builtin_amdgcn_exp2f(m - mn); m = mn; \
            float ps = 0.f; \
            _Pragma("unroll") for (int r = 0; r < 16; ++r) { C0[r] = __builtin_amdgcn_exp2f(C0[r] - mn); C1[r] = __builtin_amdgcn_exp2f(C1[r] - mn); ps += C0[r] + C1[r]; } \
            l = l * alpha + ps; \
            if (!__all(alpha == 1.0f)) { \
                _Pragma("unroll") for (int db = 0; db < 4; ++db) _Pragma("unroll") for (int r = 0; r < 16; ++r) o[db][r] *= alpha; } \
            bf16x8 pf[4]; pf[0] = pack8(C0, 0); pf[1] = pack8(C0, 8); pf[2] = pack8(C1, 0); pf[3] = pack8(C1, 8); \
            { unsigned va_[4]; \
              _Pragma("unroll") for (int db = 0; db < 4; ++db) va_[db] = ldsb + (unsigned)(65536 + (g & 1) * 32768 + vfo[db]); \
              v4i16 vl[2], vh[2]; FA_SB(); FA_DSTR(vl[0], va_[0], 0); FA_DSTR(vh[0], va_[0], 2048); FA_DSTR(vl[1], va_[0], 4096); FA_DSTR(vh[1], va_[0], 4096 + 2048); \
              FA_PV_STEP(0, 2); FA_PV_STEP(1, 2); FA_PV_STEP(2, 2); FA_PV_STEP(3, 2); FA_PV_STEP(4, 2); FA_PV_STEP(5, 2); FA_PV_STEP(6, 2); FA_PV_STEP(7, 2); \
              FA_PV_STEP(8, 2); FA_PV_STEP(9, 2); FA_PV_STEP(10, 2); FA_PV_STEP(11, 2); FA_PV_STEP(12, 2); FA_PV_STEP(13, 2); FA_PV_STEP(14, 2); FA_PV_STEP(15, 0); } } while (0)
#define FA_STEP(C0, C1, N0, N1) do { \
            diag = (kb == qb); lastb = (u == 0 ? kb == qb : kb == 0); \
            if (g + 2 < nsteps) FA_ISSUE_K(FA_KB(g + 2) * 128, g & 1); \
            if (g + 1 < nsteps) FA_ISSUE_V(FA_KB(g + 1) * 128, (g + 1) & 1); \
            const int kbn_ = (u == 0 ? kb + 1 : kb - 1); \
            if (kh == 0 && !lastb) FA_QK(N0, N1, (g + 1) & 1, kbn_); \
            FA_SOFTPV(C0, C1); \
            if (kh == 1 && !lastb) FA_QK(N0, N1, (g + 1) & 1, kbn_); \
            FA_WAITBAR(); } while (0)
#define FA_UNIT_END() do { \
            FA_LAS float* mb = (FA_LAS float*)(lds + 65536 + (g & 1) * 32768) + rg * 2048; FA_LAS float* ml = (FA_LAS float*)(lds + LDS_ML) + rg * 128; \
            const float lt = swapsum(l); \
            if (kh == 1) { ml[lane] = m; ml[64 + lane] = lt; } \
            float s1 = 0.f, s2m = 0.f; \
            _Pragma("unroll") for (int half = 0; half < 2; ++half) { \
                if (kh == 1) { \
                    _Pragma("unroll") for (int d2 = 0; d2 < 2; ++d2) _Pragma("unroll") for (int r = 0; r < 16; ++r) mb[(d2 * 16 + r) * 64 + lane] = o[2 * half + d2][r]; } \
                FA_WAITBAR(); \
                if (kh == 0) { \
                    if (half == 0) { const float m2 = ml[lane], l2 = ml[64 + lane], mm = fmaxf(m, m2), a1 = __builtin_amdgcn_exp2f(m - mm), a2 = __builtin_amdgcn_exp2f(m2 - mm); \
                        const float inv = 1.0f / (lt * a1 + l2 * a2); s1 = a1 * inv; s2m = a2 * inv; } \
                    bf16_t* op = MIXIN + (size_t)(b * SEQ + qb * 128 + rg * 32 + r32) * 2048 + 1024 + h * 128 + 4 * hi; \
                    _Pragma("unroll") for (int d2 = 0; d2 < 2; ++d2) _Pragma("unroll") for (int g4 = 0; g4 < 4; ++g4) { float v[4]; \
                        _Pragma("unroll") for (int j = 0; j < 4; ++j) v[j] = o[2 * half + d2][4 * g4 + j] * s1 + mb[(d2 * 16 + 4 * g4 + j) * 64 + lane] * s2m; \
                        u32x2 w; w.x = cvtpk(v[0], v[1]); w.y = cvtpk(v[2], v[3]); *(u32x2*)(op + 32 * (2 * half + d2) + 8 * g4) = w; } } \
                FA_WAITBAR(); } \
            if (u == 1) { done = true; } else { \
                u = 1; qb = ii; kb = ii; ++g; \
                { const bf16_t* qp = Q + (size_t)(b * SEQ + qb * 128 + rg * 32 + r32) * 1024 + h * 128 + 8 * hi; \
                  _Pragma("unroll") for (int d0 = 0; d0 < 8; ++d0) qf[d0] = *(const bf16x8*)(qp + 16 * d0); } \
                _Pragma("unroll") for (int db = 0; db < 4; ++db) _Pragma("unroll") for (int r = 0; r < 16; ++r) o[db][r] = 0.f; \
                m = -1e30f; l = 0.f; \
                FA_QK(p0, p1, g & 1, kb); \
                FA_WAITBAR(); } } while (0)
        for (;;) {
            FA_STEP(p0, p1, n0, n1);
            if (lastb) { FA_UNIT_END(); if (done) break; continue; }
            kb += (u == 0 ? 1 : -1); ++g; p0 = n0; p1 = n1;
        }
#undef FA_SOFTPV
#undef FA_STEP
#undef FA_UNIT_END
#undef FA_ISSUE_K
#undef FA_ISSUE_V
#undef FA_QK
#undef FA_QK_STEP
#undef FA_PV_STEP
#undef FA_KB
    }
}
}

namespace fs {
#define FS_LAS __attribute__((address_space(3)))
__device__ __forceinline__ void sgu_phase(const Args& A, FS_LAS unsigned char* lds) {
    const bf16_t* U = (const bf16_t*)(A.ws + WS_U); const bf16_t* V = (const bf16_t*)(A.ws + WS_V); bf16_t* MIXIN = (bf16_t*)(A.ws + WS_MIXIN);
    const float* wsp = A.in[7]; const float* bsp = A.in[8]; const float* ln_g = A.in[5]; const float* ln_b = A.in[6]; const float* VSTAT = (const float*)(A.ws + WS_VSTAT);
    const int tid = threadIdx.x, lane = tid & 63, wid = __builtin_amdgcn_readfirstlane(tid >> 6), tb = wid & 3, dh = wid >> 2, r32 = lane & 31, hi = lane >> 5;
    const int frow = tid >> 2, fq4 = tid & 3;
    int vfo[2];
    { const int d16 = (lane >> 4) & 1, q = (lane & 15) >> 2, p = lane & 3;
#pragma unroll
      for (int j = 0; j < 2; ++j) vfo[j] = 32768 + (8 * hi + q) * 256 + (((2 * dh + j) ^ q) * 64) + d16 * 32 + p * 8; }
    const int wfo = (32 * tb + r32) * 256;
    for (int u0 = blockIdx.x; u0 < (T / CHUNK) * NG * PROBE_REP_SGU; u0 += gridDim.x) { const int u = u0 % ((T / CHUNK) * NG);
        const int rc = u / NG, g = u % NG, row0 = rc * CHUNK;
        { const float* wr = wsp + ((size_t)g * CHUNK + frow) * CHUNK + fq4 * 32;
#pragma unroll
          for (int c = 0; c < 4; ++c) { const f32x4 a = *(const f32x4*)(wr + 8 * c), b2 = *(const f32x4*)(wr + 8 * c + 4); const int s0 = fq4 * 32 + 8 * c; float v[8] = {a.x, a.y, a.z, a.w, b2.x, b2.y, b2.z, b2.w};
#pragma unroll
              for (int j = 0; j < 8; ++j) if (s0 + j > frow) v[j] = 0.f;
              u32x4 w; w.x = pk2(v[0], v[1]); w.y = pk2(v[2], v[3]); w.z = pk2(v[4], v[5]); w.w = pk2(v[6], v[7]);
              *(FS_LAS u32x4*)(lds + frow * 256 + (((4 * fq4 + c) ^ (frow & 15)) * 16)) = w; }
          const bf16_t* vr = V + (size_t)(row0 + frow) * 1024 + g * 128 + fq4 * 32;
          float mean, rstd;
          { const f32x4 pa = *(const f32x4*)(VSTAT + ((size_t)(row0 + frow) * 16 + 4 * fq4) * 2), pb = *(const f32x4*)(VSTAT + ((size_t)(row0 + frow) * 16 + 4 * fq4) * 2 + 4);
            float s1 = (pa[0] + pa[2]) + (pb[0] + pb[2]), s2 = (pa[1] + pa[3]) + (pb[1] + pb[3]);
            s1 += __shfl_xor(s1, 1); s1 += __shfl_xor(s1, 2); s2 += __shfl_xor(s2, 1); s2 += __shfl_xor(s2, 2);
            mean = s1 * (1.f / 1024.f); rstd = rsqrtf(fmaxf(s2 * (1.f / 1024.f) - mean * mean, 0.f) + EPS); }
#pragma unroll
          for (int c = 0; c < 4; ++c) { const u32x4 w = *(const u32x4*)(vr + 8 * c); const int cb = g * 128 + fq4 * 32 + 8 * c;
              const f32x4 ga = *(const f32x4*)(ln_g + cb), gb = *(const f32x4*)(ln_g + cb + 4), ba = *(const f32x4*)(ln_b + cb), bb = *(const f32x4*)(ln_b + cb + 4);
              float v[8];
#pragma unroll
              for (int e2 = 0; e2 < 4; ++e2) { v[2 * e2] = __uint_as_float(w[e2] << 16); v[2 * e2 + 1] = __uint_as_float(w[e2] & 0xffff0000u); }
              u32x4 o; o.x = pk2((v[0] - mean) * rstd * ga[0] + ba[0], (v[1] - mean) * rstd * ga[1] + ba[1]); o.y = pk2((v[2] - mean) * rstd * ga[2] + ba[2], (v[3] - mean) * rstd * ga[3] + ba[3]);
              o.z = pk2((v[4] - mean) * rstd * gb[0] + bb[0], (v[5] - mean) * rstd * gb[1] + bb[1]); o.w = pk2((v[6] - mean) * rstd * gb[2] + bb[2], (v[7] - mean) * rstd * gb[3] + bb[3]);
              *(FS_LAS u32x4*)(lds + 32768 + frow * 256 + (((4 * fq4 + c) ^ ((frow & 3) << 2)) * 16)) = o; } }
        __syncthreads();
        fa::f32x16 acc[2];
#pragma unroll
        for (int j = 0; j < 2; ++j)
#pragma unroll
            for (int r = 0; r < 16; ++r) acc[j][r] = 0.f;
        for (int s = 0; s <= 2 * tb + 1; ++s) {
            const fa::bf16x8 wf = *(FS_LAS const fa::bf16x8*)(lds + wfo + (((2 * s + hi) ^ (r32 & 15)) * 16));
#pragma unroll
            for (int j = 0; j < 2; ++j) {
                const fa::v4i16 lo = __builtin_amdgcn_ds_read_tr16_b64_v4i16((FS_LAS fa::v4i16*)(lds + vfo[j] + s * 4096));
                const fa::v4i16 hh = __builtin_amdgcn_ds_read_tr16_b64_v4i16((FS_LAS fa::v4i16*)(lds + vfo[j] + s * 4096 + 1024));
                const fa::bf16x8 vf = (fa::bf16x8){lo[0], lo[1], lo[2], lo[3], hh[0], hh[1], hh[2], hh[3]};
                acc[j] = __builtin_amdgcn_mfma_f32_32x32x16_bf16(vf, wf, acc[j], 0, 0, 0); }
        }
        { const int tt = 32 * tb + r32; const float bb = bsp[g * CHUNK + tt]; const size_t rw = (size_t)(row0 + tt);
          u32x2 uu[2][4];
#pragma unroll
          for (int j = 0; j < 2; ++j)
#pragma unroll
              for (int g4 = 0; g4 < 4; ++g4) uu[j][g4] = *(const u32x2*)(U + rw * 1024 + g * 128 + 32 * (2 * dh + j) + 8 * g4 + 4 * hi);
#pragma unroll
          for (int j = 0; j < 2; ++j)
#pragma unroll
              for (int g4 = 0; g4 < 4; ++g4) { const int d = 32 * (2 * dh + j) + 8 * g4 + 4 * hi; const u32x2 u2 = uu[j][g4];
                  const float u0 = __uint_as_float(u2.x << 16), u1 = __uint_as_float(u2.x & 0xffff0000u), u2f = __uint_as_float(u2.y << 16), u3 = __uint_as_float(u2.y & 0xffff0000u);
                  u32x2 w; w.x = fa::cvtpk(u0 * (acc[j][4 * g4] + bb), u1 * (acc[j][4 * g4 + 1] + bb)); w.y = fa::cvtpk(u2f * (acc[j][4 * g4 + 2] + bb), u3 * (acc[j][4 * g4 + 3] + bb));
                  *(u32x2*)(MIXIN + rw * 2048 + g * 128 + d) = w; } }
        __syncthreads();
    }
}
}


#define XB_TMO      128
#define XB_XCNT(j)  (256  + 64 * (j))
#define XB_XSUB(j)  (1280 + 64 * (j))
#define XB_XGEN(j)  (2304 + 64 * (j))
#define XB_TOP      3328
#define XB_TOPGEN   3392
#define XCD_BAR_WORDS 3456
#define XB_SPIN_CAP (1u << 18)
#define XLAS __attribute__((address_space(3)))
__device__ __forceinline__ unsigned xb_ld(unsigned* p)              { return __hip_atomic_load(p, __ATOMIC_RELAXED, __HIP_MEMORY_SCOPE_AGENT); }
__device__ __forceinline__ unsigned xb_add(unsigned* p, unsigned v) { return __hip_atomic_fetch_add(p, v, __ATOMIC_RELAXED, __HIP_MEMORY_SCOPE_AGENT); }
__device__ __forceinline__ unsigned xb_xcc_id() { return (unsigned)__builtin_amdgcn_s_getreg((3 << 11) | 20) & 0xFu; }
#define XB_SPIN(cond, bar) do { unsigned _sp = 0; while (cond) { __builtin_amdgcn_s_sleep(1); \
    if ((++_sp & 255u) == 0u) { if (xb_ld(&(bar)[XB_TMO])) break; if (_sp > XB_SPIN_CAP) { atomicAdd(&(bar)[XB_TMO], 1u); break; } } } } while (0)
struct XcdBarrier { unsigned* bar; unsigned x; volatile XLAS unsigned* st; };
__device__ __forceinline__ XcdBarrier xcd_barrier_post(unsigned* bar, volatile XLAS unsigned* st) {
    XcdBarrier b; b.bar = bar; b.x = xb_xcc_id(); b.st = st;
    if (threadIdx.x == 0) (void)xb_add(&bar[XB_XCNT(b.x)], 1u);
    return b;
}
__device__ __forceinline__ void xcd_barrier_complete(unsigned* bar, unsigned x, unsigned& nloc, unsigned& nx) {
    const unsigned G = gridDim.x * gridDim.y * gridDim.z;
    unsigned sum, cnt, mine, sp = 0u;
    for (;;) {
        sum = 0u; cnt = 0u; mine = 0u;
#pragma unroll
        for (unsigned j = 0; j < 16; ++j) { const unsigned c = xb_ld(&bar[XB_XCNT(j)]); sum += c; cnt += (c > 0u) ? 1u : 0u; mine = (j == x) ? c : mine; }
        if (sum == G) break;
        __builtin_amdgcn_s_sleep(1);
        if ((++sp & 255u) == 0u) { if (xb_ld(&bar[XB_TMO])) break; if (sp > XB_SPIN_CAP) { atomicAdd(&bar[XB_TMO], 1u); break; } }
    }
    nloc = mine > 0u ? mine : 1u; nx = cnt > 0u ? cnt : 1u;
}
__device__ __forceinline__ void xcd_barrier(const XcdBarrier& b) {
    asm volatile("s_waitcnt vmcnt(0)" ::: "memory");
    __syncthreads();
    if (threadIdx.x == 0) {
        unsigned* bar = b.bar;
        __builtin_amdgcn_s_waitcnt(0);
        unsigned nloc = b.st[0], nx = b.st[1];
        if (nloc == 0u) { xcd_barrier_complete(bar, b.x, nloc, nx); b.st[0] = nloc; b.st[1] = nx; }
        const unsigned old = xb_add(&bar[XB_XSUB(b.x)], 1u);
        const unsigned gen = old / nloc;
        if (old + 1u == (gen + 1u) * nloc) {
            __builtin_amdgcn_fence(__ATOMIC_RELEASE, "agent");
            asm volatile("s_waitcnt vmcnt(0)" ::: "memory");
            const unsigned og = xb_add(&bar[XB_TOP], 1u);
            const unsigned tg = og / nx;
            if (og + 1u == (tg + 1u) * nx) xb_add(&bar[XB_TOPGEN], 1u);
            else XB_SPIN(xb_ld(&bar[XB_TOPGEN]) == tg, bar);
            __builtin_amdgcn_fence(__ATOMIC_ACQUIRE, "agent");
            xb_add(&bar[XB_XGEN(b.x)], 1u);
            asm volatile("s_waitcnt vmcnt(0)" ::: "memory");
        } else {
            XB_SPIN(xb_ld(&bar[XB_XGEN(b.x)]) == gen, bar);
            __builtin_amdgcn_fence(__ATOMIC_ACQUIRE, "agent");
            asm volatile("s_waitcnt vmcnt(0)" ::: "memory");
        }
    }
    __syncthreads();
}
constexpr int CW_BAR = 4096;
constexpr size_t CTL_ZERO_BYTES = 65536;
constexpr int LDS_BARST_OFF = LDS_BYTES - 16;

constexpr bool FAST_P1 = true, FAST_P3 = true, FAST_P4 = true, FAST_P6 = true, FAST_P7 = true;
constexpr bool FAST_ATTN = true, FAST_SGU = true;
constexpr bool FAST_ANY = FAST_P1 || FAST_P3 || FAST_P4 || FAST_P6 || FAST_P7;
constexpr int N_PHASES = 10;
__global__ void __launch_bounds__(NTHREADS, 2) fwd(Args A) {
    extern __shared__ __attribute__((aligned(16))) unsigned char lds[];
    float* ldsf = (float*)lds;
    const int lo = A.ph_lo, hi = A.ph_hi;
    if (threadIdx.x < 4) ((volatile XLAS unsigned*)((XLAS unsigned char*)lds + LDS_BARST_OFF))[threadIdx.x] = 0u;
    __syncthreads();
    XcdBarrier bar = xcd_barrier_post((unsigned*)(A.ws + WS_CTL) + CW_BAR, (volatile XLAS unsigned*)((XLAS unsigned char*)lds + LDS_BARST_OFF));
#define IN(k) (lo <= (k) && (k) < hi)
#define SEAM(k) do { if (IN(k) && IN((k) + 1)) xcd_barrier(bar); STAMP((k) + 1); } while (0)
    unsigned long long t_lo = 0, t_hi = 0;
#define STAMP(i) do { if (STAMP_PHASE >= 0) { if ((i) == STAMP_PHASE || (STAMP_PHASE == 98 && (i) == 0)) t_lo = __builtin_amdgcn_s_memrealtime(); if ((i) == STAMP_PHASE + 1 || (STAMP_PHASE == 98 && (i) == 9)) t_hi = __builtin_amdgcn_s_memrealtime(); } } while (0)
    STAMP(0);
    PG8_LAS unsigned char* l3 = (PG8_LAS unsigned char*)lds;
    if (IN(0)) { if (FAST_ANY) { p0_weights(A, l3, 0, (int)blockIdx.x, (int)gridDim.x); __syncthreads(); } p0_router_weights(A); p0_rows(A, ldsf); } SEAM(0);
    if (IN(1)) { if (FAST_P1 && FAST_ATTN && (int)blockIdx.x >= (int)gridDim.x - NB * NH) cumsum_bh(A, (int)blockIdx.x - ((int)gridDim.x - NB * NH), ldsf); if (FAST_P1) p1_fast(A, l3); else p1_naive(A, ldsf); if (FAST_ANY) { __syncthreads(); { const int r_ = 1152 % (int)gridDim.x; p0_weights(A, l3, 1, r_ == 0 ? (int)blockIdx.x : (int)blockIdx.x - r_, r_ == 0 ? (int)gridDim.x : (int)gridDim.x - r_); } } } SEAM(1);
    if (!(FAST_P1 && FAST_SGU && FAST_ATTN)) { if (IN(2)) { p1b_fix<0>(A, ldsf); } SEAM(2); }
    if (IN(3)) { if (FAST_SGU) fs::sgu_phase(A, l3); else p2_sgu_naive(A); if (FAST_ATTN) { __syncthreads(); fa::attn_phase(A, l3); } else p2_attn_naive(A, ldsf); } SEAM(3);
    if (IN(4)) { if (FAST_P3) p3_fast(A, l3); else p3_naive(A, ldsf); } SEAM(4);
    if (IN(5)) { if (FAST_P4) p4_fast(A, l3); else p4_naive(A, ldsf); } SEAM(5);
    if (IN(6)) { if (PROBE_ALT == 6) { p5_router3<1>(A, ldsf); __syncthreads(); } if (PROBE_ALT == 62) { p5_router3<2>(A, ldsf); __syncthreads(); } if (PROBE_ALT == 63) { p5_router3<3>(A, ldsf); __syncthreads(); } p5_router3<0>(A, ldsf); } SEAM(6);
    if (IN(7)) { if (FAST_P6) p6_fast(A, l3); else p6_naive(A, ldsf); } SEAM(7);
    if (IN(8)) { if (FAST_P7) p7_fast(A, l3); else p7_naive(A, ldsf); } SEAM(8);
    if (IN(9)) { if (PROBE_ALT == 9) { p8_combine<1>(A, ldsf); __syncthreads(); } p8_combine<0>(A, ldsf, STAMP_PHASE < 0 ? 0.f : (STAMP_PHASE == 99 ? 1.0f : (float)(t_hi - t_lo) * 0.01f * 0.001f * STAMP_SCALE)); }
#undef IN
#undef SEAM
}

#ifndef MK_N_LAUNCHES
#define MK_N_LAUNCHES 1
#endif
extern "C" void kernel_launch(void* const* d_in, const int* in_sizes, int n_in, void* d_out, int out_size, void* d_ws, size_t ws_size, hipStream_t stream) {
    static int grid = 0;
    if (grid == 0) {
        if (n_in != 22 || out_size != T * DM || ws_size < WS_END) { fprintf(stderr, "kernel_launch: unexpected shapes (n_in %d out %d ws %zu)\n", n_in, out_size, ws_size); grid = -1; return; }
        int dev = 0, cus = 0, per_cu = 0;
        hipGetDevice(&dev); hipDeviceGetAttribute(&cus, hipDeviceAttributeMultiprocessorCount, dev);
        hipFuncSetAttribute((const void*)fwd, hipFuncAttributeMaxDynamicSharedMemorySize, LDS_BYTES);
        hipOccupancyMaxActiveBlocksPerMultiprocessor(&per_cu, (const void*)fwd, NTHREADS, LDS_BYTES);
        if (per_cu < 1) { fprintf(stderr, "kernel_launch: occupancy query says %d blocks per CU\n", per_cu); per_cu = 1; }
        (void)hipGetLastError();
        grid = cus;
    }
    if (grid < 0) return;
    Args a{};
    for (int i = 0; i < 22; ++i) a.in[i] = (const float*)d_in[i];
    a.out = (float*)d_out; a.ws = (unsigned char*)d_ws;
    if (hipMemsetAsync((char*)d_ws + WS_CTL, 0, CTL_ZERO_BYTES, stream) != hipSuccess) { fprintf(stderr, "kernel_launch: memset failed\n"); return; }
    if (MK_N_LAUNCHES == 1) {
        a.ph_lo = 0; a.ph_hi = N_PHASES;
        hipLaunchKernelGGL(fwd, dim3(grid), dim3(NTHREADS), LDS_BYTES, stream, a);
    } else {
        for (int p = 0; p < N_PHASES; ++p) { a.ph_lo = p; a.ph_hi = p + 1; hipLaunchKernelGGL(fwd, dim3(grid), dim3(NTHREADS), LDS_BYTES, stream, a); }
    }
}
```

```cpp
#include <hip/hip_runtime.h>
#include <hip/hip_cooperative_groups.h>
#include <cstdio>
#include <cstdint>
namespace cg = cooperative_groups;

#ifndef STAMP_PHASE
#define STAMP_PHASE -1
#endif
#ifndef STAMP_SEL
#define STAMP_SEL 0
#endif
#ifndef STAMP_SCALE
#define STAMP_SCALE 0.5f
#endif
#ifndef PROBE_REP_P1
#define PROBE_REP_P1 1
#endif
#ifndef PROBE_REP_P4
#define PROBE_REP_P4 1
#endif
#ifndef PROBE_REP_P5
#define PROBE_REP_P5 1
#endif
#ifndef PROBE_REP_MOE
#define PROBE_REP_MOE 1
#endif
#ifndef PROBE_REP_ATTN
#define PROBE_REP_ATTN 1
#endif
#ifndef PROBE_REP_SGU
#define PROBE_REP_SGU 1
#endif
#ifndef PROBE_ATTN_VAR
#define PROBE_ATTN_VAR 0
#endif
#ifndef PROBE_ALT
#define PROBE_ALT -1
#endif
constexpr int T = 8192, SEQ = 2048, NB = 4, DM = 2048, SGUW = 1024, FOXW = 1024, NH = 8, HD = 128, CHUNK = 128, NG = 8;
constexpr int INCOLS = 9224, OFF_F = 5120, OFF_GATE = 5128;
constexpr int NEXP = 32, EPG = 8, NGRP = 4, DEXP = 512;
constexpr float EPS = 1e-6f;
constexpr float LOG2E = 1.4426950408889634f;
constexpr float QSCALE = 0.08838834764831845f * LOG2E;
constexpr int NTHREADS = 512, NWAVES = 8;
constexpr int LDS_BYTES = 160 * 1024;
constexpr int MTILE = 256;
constexpr int PMAX = 2 * T + NEXP * MTILE;
constexpr int MT_MAX = PMAX / MTILE;
constexpr bool XCDM_GU = true;
constexpr int TINY_ROWS = 0;

typedef unsigned short bf16_t;
typedef float f32x4 __attribute__((ext_vector_type(4)));
typedef unsigned u32x4 __attribute__((ext_vector_type(4)));
typedef unsigned u32x2 __attribute__((ext_vector_type(2)));

constexpr size_t MiB = 1u << 20;
constexpr size_t WS_CTL = 0;
constexpr size_t WS_LOGF = 1 * MiB;
constexpr size_t WS_CKL = 2 * MiB;
constexpr size_t WS_TOK = 3 * MiB;
constexpr size_t WS_GATE = 4 * MiB;
constexpr size_t WS_ASG = 5 * MiB;
constexpr size_t WS_WIN = 8 * MiB;
constexpr size_t WS_WPROJ = 44 * MiB;
constexpr size_t WS_WOUT = 52 * MiB;
constexpr size_t WS_WGU = 60 * MiB;
constexpr size_t WS_WD = 188 * MiB;
constexpr size_t WS_H = 252 * MiB;
constexpr size_t WS_MIXED = WS_H;
constexpr size_t WS_U = 284 * MiB;
constexpr size_t WS_V = 300 * MiB;
constexpr size_t WS_G = 316 * MiB;
constexpr size_t WS_YBUF = WS_U;
constexpr size_t WS_Q = 380 * MiB;
constexpr size_t WS_K = 396 * MiB;
constexpr size_t WS_VA = 412 * MiB;
constexpr size_t WS_ACT = WS_Q;
constexpr size_t WS_MIXIN = 428 * MiB;
constexpr size_t WS_H2 = WS_MIXIN;
constexpr size_t WS_END = 460 * MiB;
static_assert((size_t)PMAX * 2048 * 2 <= 96 * MiB && (size_t)PMAX * 512 * 2 <= 32 * MiB, "overlay sizes");

constexpr int CW_CNT = 0;
constexpr int CNT_STRIDE = 64;

__device__ __forceinline__ float bf2f(bf16_t v) { return __uint_as_float((unsigned)v << 16); }
__device__ __forceinline__ bf16_t f2bf(float f) { unsigned u = __float_as_uint(f); return (bf16_t)((u + 0x7fffu + ((u >> 16) & 1u)) >> 16); }
__device__ __forceinline__ unsigned pk2(float lo, float hi) { return (unsigned)f2bf(lo) | ((unsigned)f2bf(hi) << 16); }
__device__ __forceinline__ unsigned cvtpk_rne(float lo, float hi) { unsigned r; asm("v_cvt_pk_bf16_f32 %0, %1, %2" : "=v"(r) : "v"(lo), "v"(hi)); return r; }
__device__ __forceinline__ float wave_sum(float v) {
#pragma unroll
    for (int o = 1; o < 64; o <<= 1) v += __shfl_xor(v, o);
    return v;
}
__device__ __forceinline__ float wave_max(float v) {
#pragma unroll
    for (int o = 1; o < 64; o <<= 1) v = fmaxf(v, __shfl_xor(v, o));
    return v;
}
__device__ __forceinline__ float gelu_tanh(float x) {
    const float c = 0.7978845608028654f; const float y = c * (x + 0.044715f * x * x * x);
    return x / (1.0f + __expf(-2.0f * y));
}
__device__ __forceinline__ float sigmoidf_(float x) { return 1.0f / (1.0f + __expf(-x)); }
__device__ __forceinline__ float log_sigmoid(float z) { return fminf(z, 0.f) - log1pf(__expf(-fabsf(z))); }

struct Args {
    const float* in[22];
    float* out;
    unsigned char* ws;
    int ph_lo, ph_hi;
};

template <class AF, class BF, class EF>
__device__ __forceinline__ void naive_gemm_tile(float* lds, int m0, int n0, int M, int N, int K, int Ksplit, AF a, BF b, EF epi) {
    float* As = lds;
    float* Bs = lds + 16 * 132;
    const int tid = threadIdx.x, ty = tid >> 4, tx = tid & 15;
    float acc[4][8], acc1[4][8];
#pragma unroll
    for (int i = 0; i < 4; ++i)
#pragma unroll
        for (int j = 0; j < 8; ++j) { acc[i][j] = 0.f; acc1[i][j] = 0.f; }
    const bool split = Ksplit < K;
#pragma unroll 1
    for (int pass = 0; pass < 2; ++pass) {
        const int kb = pass == 0 ? 0 : Ksplit, ke = pass == 0 ? (split ? Ksplit : K) : K;
        if (pass == 1) {
            if (!split) break;
#pragma unroll
            for (int i = 0; i < 4; ++i)
#pragma unroll
                for (int j = 0; j < 8; ++j) { acc1[i][j] = acc[i][j]; acc[i][j] = 0.f; }
        }
#pragma unroll 1
        for (int k0 = kb; k0 < ke; k0 += 16) {
#pragma unroll
            for (int i = 0; i < 4; ++i) { const int idx = tid + i * 512, r = idx >> 4, kk = idx & 15; const int m = m0 + r; As[kk * 132 + r] = (m < M) ? a(m, k0 + kk) : 0.f; }
#pragma unroll
            for (int i = 0; i < 4; ++i) { const int idx = tid + i * 512, kk = idx >> 7, n = idx & 127; Bs[kk * 132 + n] = (n0 + n < N) ? b(k0 + kk, n0 + n) : 0.f; }
            __syncthreads();
#pragma unroll 4
            for (int kk = 0; kk < 16; ++kk) {
                float av[4], bv[8];
#pragma unroll
                for (int i = 0; i < 4; ++i) av[i] = As[kk * 132 + ty * 4 + i];
#pragma unroll
                for (int j = 0; j < 8; ++j) bv[j] = Bs[kk * 132 + tx * 8 + j];
#pragma unroll
                for (int i = 0; i < 4; ++i)
#pragma unroll
                    for (int j = 0; j < 8; ++j) acc[i][j] = fmaf(av[i], bv[j], acc[i][j]);
            }
            __syncthreads();
        }
    }
#pragma unroll
    for (int i = 0; i < 4; ++i)
#pragma unroll
        for (int j = 0; j < 8; ++j) { const int m = m0 + ty * 4 + i, n = n0 + tx * 8 + j; if (m < M && n < N) epi(m, n, split ? acc1[i][j] : acc[i][j], split ? acc[i][j] : 0.f); }
}
template <class AF, class BF, class EF>
__device__ __forceinline__ void naive_gemm(float* lds, int M, int N, int K, int Ksplit, AF a, BF b, EF epi) {
    const int ntm = (M + 127) / 128, ntn = (N + 127) / 128;
    for (int t = blockIdx.x; t < ntm * ntn; t += gridDim.x) naive_gemm_tile(lds, (t / ntn) * 128, (t % ntn) * 128, M, N, K, Ksplit, a, b, epi);
}

__device__ __forceinline__ void p0_rows(const Args& A, float* ldsf) {
    const float* x = A.in[0]; const float* g1 = A.in[1]; const float* w_in = A.in[2]; const float* b_forget = A.in[4];
    bf16_t* H = (bf16_t*)(A.ws + WS_H); float* LOGF = (float*)(A.ws + WS_LOGF);
    const int tid = threadIdx.x, lane = tid & 63, wave = tid >> 6;
    for (int i = tid; i < DM * 8; i += NTHREADS) ldsf[i] = w_in[(size_t)(i >> 3) * INCOLS + OFF_F + (i & 7)];
    __syncthreads();
    const int gw = blockIdx.x * NWAVES + wave, NGW = gridDim.x * NWAVES;
    for (int row = gw; row < T; row += NGW) {
        const f32x4* xr = (const f32x4*)(x + (size_t)row * DM) + lane;
        f32x4 xv[8]; float ss = 0.f;
#pragma unroll
        for (int j = 0; j < 8; ++j) xv[j] = xr[64 * j];
#pragma unroll
        for (int j = 0; j < 8; ++j) ss += xv[j].x * xv[j].x + xv[j].y * xv[j].y + xv[j].z * xv[j].z + xv[j].w * xv[j].w;
        const float rstd = rsqrtf(wave_sum(ss) * (1.f / DM) + EPS);
        float f[8];
#pragma unroll
        for (int h = 0; h < 8; ++h) f[h] = 0.f;
#pragma unroll
        for (int j = 0; j < 8; ++j) {
            const int c0 = 256 * j + 4 * lane; const f32x4 g = *(const f32x4*)(g1 + c0);
            f32x4 hv; hv.x = xv[j].x * rstd * g.x; hv.y = xv[j].y * rstd * g.y; hv.z = xv[j].z * rstd * g.z; hv.w = xv[j].w * rstd * g.w;
            u32x2 o; o.x = pk2(hv.x, hv.y); o.y = pk2(hv.z, hv.w);
            *(u32x2*)(H + (size_t)row * DM + c0) = o;
#pragma unroll
            for (int e = 0; e < 4; ++e) { const float hx = hv[e]; const float* wf = ldsf + (c0 + e) * 8;
#pragma unroll
                for (int h = 0; h < 8; ++h) f[h] = fmaf(hx, wf[h], f[h]); }
            asm volatile("" ::: "memory");
        }
#pragma unroll
        for (int h = 0; h < 8; ++h) f[h] = wave_sum(f[h]);
        if (lane < 8) { float z = 0.f;
#pragma unroll
            for (int h = 0; h < 8; ++h) if (lane == h) z = f[h];
            LOGF[(size_t)row * 8 + lane] = log_sigmoid(z + b_forget[lane]); }
    }
}

__device__ __forceinline__ void p1_naive(const Args& A, float* ldsf) {
    const bf16_t* H = (const bf16_t*)(A.ws + WS_H); const float* w_in = A.in[2]; const float* b_gate = A.in[3];
    bf16_t* U = (bf16_t*)(A.ws + WS_U); bf16_t* V = (bf16_t*)(A.ws + WS_V); bf16_t* Q = (bf16_t*)(A.ws + WS_Q); bf16_t* K = (bf16_t*)(A.ws + WS_K);
    bf16_t* VA = (bf16_t*)(A.ws + WS_VA); bf16_t* G = (bf16_t*)(A.ws + WS_G);
    naive_gemm(ldsf, T, 9216, DM, DM,
        [=](int m, int k) { return bf2f(H[(size_t)m * DM + k]); },
        [=](int k, int n) { const int c = n < 5120 ? n : n + 8; return w_in[(size_t)k * INCOLS + c]; },
        [=](int m, int n, float s, float) {
            if (n < 1024) U[(size_t)m * 1024 + n] = f2bf(gelu_tanh(s));
            else if (n < 2048) V[(size_t)m * 1024 + n - 1024] = f2bf(gelu_tanh(s));
            else if (n < 3072) Q[(size_t)m * 1024 + n - 2048] = f2bf(s);
            else if (n < 4096) K[(size_t)m * 1024 + n - 3072] = f2bf(s);
            else if (n < 5120) VA[(size_t)m * 1024 + n - 4096] = f2bf(s);
            else G[(size_t)m * 4096 + n - 5120] = f2bf(sigmoidf_(s + b_gate[n - 5120]));
        });
}

template <int ALT> __device__ __forceinline__ void p1b_fix(const Args& A, float* ldsf) {
    bf16_t* V = (bf16_t*)(A.ws + WS_V); bf16_t* Q = (bf16_t*)(A.ws + WS_Q); bf16_t* K = (bf16_t*)(A.ws + WS_K);
    const size_t altoff = ALT ? ((size_t)((unsigned char*)A.out - (A.ws + WS_V))) / 2 : 0;
    const size_t altq = ALT ? ((size_t)((unsigned char*)A.out + 16 * MiB - (A.ws + WS_Q))) / 2 : 0, altk = ALT ? ((size_t)((unsigned char*)A.out + 32 * MiB - (A.ws + WS_K))) / 2 : 0;
    const float* ln_g = A.in[5]; const float* ln_b = A.in[6]; const float* qg = A.in[9]; const float* kg = A.in[10];
    const int tid = threadIdx.x, lane = tid & 63, wave = tid >> 6;
    const int gw = blockIdx.x * NWAVES + wave, NGW = gridDim.x * NWAVES;
    for (int row = gw; row < T; row += NGW) {
        {
            bf16_t* vr = V + (size_t)row * 1024; float v[16]; float s = 0.f;
#pragma unroll
            for (int j = 0; j < 2; ++j) { const u32x4 w = *(const u32x4*)(vr + 512 * j + 8 * lane);
#pragma unroll
                for (int e = 0; e < 4; ++e) { v[8 * j + 2 * e] = __uint_as_float(w[e] << 16); v[8 * j + 2 * e + 1] = __uint_as_float(w[e] & 0xffff0000u); } }
#pragma unroll
            for (int i = 0; i < 16; ++i) s += v[i];
            const float mean = wave_sum(s) * (1.f / 1024.f); float q = 0.f;
#pragma unroll
            for (int i = 0; i < 16; ++i) { v[i] -= mean; q += v[i] * v[i]; }
            const float rstd = rsqrtf(wave_sum(q) * (1.f / 1024.f) + EPS);
#pragma unroll
            for (int j = 0; j < 2; ++j) { const int c0 = 512 * j + 8 * lane; u32x4 o;
#pragma unroll
                for (int e = 0; e < 4; ++e) o[e] = pk2(v[8 * j + 2 * e] * rstd * ln_g[c0 + 2 * e] + ln_b[c0 + 2 * e], v[8 * j + 2 * e + 1] * rstd * ln_g[c0 + 2 * e + 1] + ln_b[c0 + 2 * e + 1]);
                *(u32x4*)(vr + altoff + c0) = o; }
        }
#pragma unroll
        for (int which = 0; which < 2; ++which) {
            bf16_t* pr = (which == 0 ? Q : K) + (size_t)row * 1024 + 16 * lane; const float* gg = which == 0 ? qg : kg; float v[16]; float s = 0.f;
#pragma unroll
            for (int j = 0; j < 2; ++j) { const u32x4 w = *(const u32x4*)(pr + 8 * j);
#pragma unroll
                for (int e = 0; e < 4; ++e) { v[8 * j + 2 * e] = __uint_as_float(w[e] << 16); v[8 * j + 2 * e + 1] = __uint_as_float(w[e] & 0xffff0000u); } }
#pragma unroll
            for (int i = 0; i < 16; ++i) s += v[i] * v[i];
            s += __shfl_xor(s, 1); s += __shfl_xor(s, 2); s += __shfl_xor(s, 4);
            const float sc = rsqrtf(s * (1.f / 128.f) + EPS) * (which == 0 ? QSCALE : 1.f); const int d0 = (16 * lane) & 127;
#pragma unroll
            for (int j = 0; j < 2; ++j) { u32x4 o;
#pragma unroll
                for (int e = 0; e < 4; ++e) o[e] = pk2(v[8 * j + 2 * e] * sc * gg[d0 + 8 * j + 2 * e], v[8 * j + 2 * e + 1] * sc * gg[d0 + 8 * j + 2 * e + 1]);
                *(u32x4*)(pr + (which == 0 ? altq : altk) + 8 * j) = o; }
        }
    }
    if (blockIdx.x < NB * NH) {
        const int b = blockIdx.x / NH, h = blockIdx.x % NH; const float* LOGF = (const float*)(A.ws + WS_LOGF); float* CKL = (float*)(A.ws + WS_CKL) + (size_t)blockIdx.x * SEQ + (ALT ? 65536 : 0);
        float v[4]; float s = 0.f;
#pragma unroll
        for (int i = 0; i < 4; ++i) { v[i] = LOGF[(size_t)(b * SEQ + tid * 4 + i) * 8 + h]; s += v[i]; }
        float incl = s;
#pragma unroll
        for (int o = 1; o < 64; o <<= 1) { const float t = __shfl_up(incl, o); if (lane >= o) incl += t; }
        __syncthreads();
        if (lane == 63) ldsf[wave] = incl;
        __syncthreads();
        float base = 0.f;
        for (int w = 0; w < wave; ++w) base += ldsf[w];
        float run = base + incl - s;
#pragma unroll
        for (int i = 0; i < 4; ++i) { run += v[i]; CKL[tid * 4 + i] = run * LOG2E; }
        __syncthreads();
    }
}


__device__ __forceinline__ void cumsum_bh(const Args& A, int bh, float* ldsf) {
    const int tid = threadIdx.x, lane = tid & 63, wave = tid >> 6, b = bh / NH, h = bh % NH;
    const float* LOGF = (const float*)(A.ws + WS_LOGF); float* CKL = (float*)(A.ws + WS_CKL) + (size_t)bh * SEQ;
    float v[4]; float sm = 0.f;
#pragma unroll
    for (int i = 0; i < 4; ++i) { v[i] = LOGF[(size_t)(b * SEQ + tid * 4 + i) * 8 + h]; sm += v[i]; }
    float incl = sm;
#pragma unroll
    for (int o = 1; o < 64; o <<= 1) { const float t = __shfl_up(incl, o); if (lane >= o) incl += t; }
    if (lane == 63) ldsf[wave] = incl;
    __syncthreads();
    float run = incl - sm;
    for (int w = 0; w < wave; ++w) run += ldsf[w];
    f32x4 o4;
#pragma unroll
    for (int i = 0; i < 4; ++i) { run += v[i]; o4[i] = run * LOG2E; }
    *(f32x4*)(CKL + tid * 4) = o4;
    __syncthreads();
}

__device__ __forceinline__ void p2_sgu_naive(const Args& A) {
    const bf16_t* U = (const bf16_t*)(A.ws + WS_U); const bf16_t* V = (const bf16_t*)(A.ws + WS_V); bf16_t* MIXIN = (bf16_t*)(A.ws + WS_MIXIN);
    const float* wsp = A.in[7]; const float* bsp = A.in[8];
    const int tid = threadIdx.x, tt = tid >> 2, dp = tid & 3;
    for (int u = blockIdx.x; u < (T / CHUNK) * NG; u += gridDim.x) {
        const int rc = u / NG, g = u % NG; const int row0 = rc * CHUNK;
        float acc[32];
#pragma unroll
        for (int i = 0; i < 32; ++i) acc[i] = 0.f;
        for (int ss = 0; ss <= tt; ++ss) {
            const float w = wsp[((size_t)g * CHUNK + tt) * CHUNK + ss];
            const bf16_t* vr = V + (size_t)(row0 + ss) * 1024 + g * 128 + dp * 32;
#pragma unroll
            for (int i = 0; i < 32; ++i) acc[i] = fmaf(w, bf2f(vr[i]), acc[i]);
        }
        const float bb = bsp[g * CHUNK + tt];
        const bf16_t* ur = U + (size_t)(row0 + tt) * 1024 + g * 128 + dp * 32; bf16_t* orow = MIXIN + (size_t)(row0 + tt) * 2048 + g * 128 + dp * 32;
#pragma unroll
        for (int i = 0; i < 32; ++i) orow[i] = f2bf(bf2f(ur[i]) * (acc[i] + bb));
    }
}
__device__ __forceinline__ void p2_attn_naive(const Args& A, float* ldsf) {
    const bf16_t* Q = (const bf16_t*)(A.ws + WS_Q); const bf16_t* K = (const bf16_t*)(A.ws + WS_K); const bf16_t* VA = (const bf16_t*)(A.ws + WS_VA);
    const float* CKL = (const float*)(A.ws + WS_CKL); bf16_t* MIXIN = (bf16_t*)(A.ws + WS_MIXIN);
    const int tid = threadIdx.x, lane = tid & 63, wave = tid >> 6;
    float* qs = ldsf + wave * 128;
    const int gw = blockIdx.x * NWAVES + wave, NGW = gridDim.x * NWAVES;
    for (int item = gw; item < T * NH; item += NGW) {
        const int row = item / NH, h = item % NH, b = row / SEQ, t = row % SEQ;
        const bf16_t* qr = Q + (size_t)row * 1024 + h * 128;
        qs[lane] = bf2f(qr[lane]); qs[64 + lane] = bf2f(qr[64 + lane]);
        __builtin_amdgcn_s_waitcnt(0);
        const float* ck = CKL + (size_t)(b * NH + h) * SEQ;
        float m = -1e30f, l = 0.f, o0 = 0.f, o1 = 0.f;
        for (int s0 = 0; s0 <= t; s0 += 64) {
            const int s = s0 + lane; float sc = -INFINITY;
            if (s <= t) { const bf16_t* kr = K + (size_t)(b * SEQ + s) * 1024 + h * 128; float d = 0.f;
                for (int c = 0; c < 16; ++c) { const u32x4 w = *(const u32x4*)(kr + 8 * c);
#pragma unroll
                    for (int e = 0; e < 4; ++e) { d = fmaf(qs[8 * c + 2 * e], __uint_as_float(w[e] << 16), d); d = fmaf(qs[8 * c + 2 * e + 1], __uint_as_float(w[e] & 0xffff0000u), d); } }
                sc = d - ck[s]; }
            const float mn = fmaxf(m, wave_max(sc)); const float alpha = exp2f(m - mn); const float p = exp2f(sc - mn);
            l = l * alpha + wave_sum(p); o0 *= alpha; o1 *= alpha; m = mn;
            const int nk = min(64, t - s0 + 1);
            for (int j = 0; j < nk; ++j) { const float pj = __shfl(p, j); const unsigned w = *(const unsigned*)(VA + (size_t)(b * SEQ + s0 + j) * 1024 + h * 128 + 2 * lane);
                o0 = fmaf(pj, __uint_as_float(w << 16), o0); o1 = fmaf(pj, __uint_as_float(w & 0xffff0000u), o1); }
        }
        const float il = 1.f / l;
        *(unsigned*)(MIXIN + (size_t)row * 2048 + 1024 + h * 128 + 2 * lane) = pk2(o0 * il, o1 * il);
    }
}

__device__ __forceinline__ void p3_naive(const Args& A, float* ldsf) {
    const bf16_t* MIXIN = (const bf16_t*)(A.ws + WS_MIXIN); const bf16_t* G = (const bf16_t*)(A.ws + WS_G); bf16_t* MIXED = (bf16_t*)(A.ws + WS_MIXED);
    const float* wps = A.in[11]; const float* wpf = A.in[12];
    naive_gemm(ldsf, T, DM, 2048, 1024,
        [=](int m, int k) { return bf2f(MIXIN[(size_t)m * 2048 + k]); },
        [=](int k, int n) { return k < 1024 ? wps[(size_t)k * DM + n] : wpf[(size_t)(k - 1024) * DM + n]; },
        [=](int m, int n, float s1, float s2) { MIXED[(size_t)m * DM + n] = f2bf(bf2f(G[(size_t)m * 4096 + n]) * s1 + bf2f(G[(size_t)m * 4096 + 2048 + n]) * s2); });
}
__device__ __forceinline__ void p4_naive(const Args& A, float* ldsf) {
    const bf16_t* MIXED = (const bf16_t*)(A.ws + WS_MIXED); const float* wo = A.in[13]; const float* x = A.in[0]; float* X1 = A.out;
    naive_gemm(ldsf, T, DM, DM, DM,
        [=](int m, int k) { return bf2f(MIXED[(size_t)m * DM + k]); },
        [=](int k, int n) { return wo[(size_t)k * DM + n]; },
        [=](int m, int n, float s, float) { X1[(size_t)m * DM + n] = x[(size_t)m * DM + n] + s; });
}

template <int ALT> __device__ __forceinline__ void p5_router(const Args& A, float* ldsf) {
    const float* X1 = A.out; const float* g2 = A.in[14]; const float* wrg = A.in[15]; const float* brg = A.in[16]; const float* wre = A.in[17]; const float* bre = A.in[18];
    bf16_t* H2 = (bf16_t*)(A.ws + WS_H2); unsigned* cnt = (unsigned*)(A.ws + WS_CTL) + CW_CNT + (ALT ? 2048 : 0);
    int* TOK = (int*)(A.ws + (ALT ? WS_H : WS_TOK)); float* GATE = (float*)(A.ws + (ALT ? WS_H + 2 * MiB : WS_GATE)); int* ASG = (int*)(A.ws + (ALT ? WS_H + 4 * MiB : WS_ASG));
    const int tid = threadIdx.x, lane = tid & 63, wave = tid >> 6, r = tid >> 4, ks = tid & 15;
    float* Ws = ldsf;
    float* Xs = ldsf + 256 * 36;
    float* rs = Xs + 32 * 260;
    int* hist = (int*)(rs + 32);
    int* hbase = hist + 32;
    int* sel = hbase + 32;
    int* lpos = sel + 64;
    float* selw = (float*)(lpos + 64);
    for (int rb = blockIdx.x; rb < T / 32; rb += gridDim.x) {
        const int row0 = rb * 32;
        for (int i = 0; i < 4; ++i) { const int rr = wave * 4 + i; const f32x4* xr = (const f32x4*)(X1 + (size_t)(row0 + rr) * DM) + lane; float ss = 0.f;
#pragma unroll
            for (int j = 0; j < 8; ++j) { const f32x4 v = xr[64 * j]; ss += v.x * v.x + v.y * v.y + v.z * v.z + v.w * v.w; }
            ss = wave_sum(ss); if (lane == 0) rs[rr] = rsqrtf(ss * (1.f / DM) + EPS); }
        if (tid < 32) hist[tid] = 0;
        __syncthreads();
        float acc[36];
#pragma unroll
        for (int j = 0; j < 36; ++j) acc[j] = 0.f;
        for (int k0 = 0; k0 < DM; k0 += 256) {
            for (int i = tid; i < 256 * 36; i += NTHREADS) { const int kk = i / 36, j = i % 36; Ws[i] = j < 4 ? wrg[(size_t)(k0 + kk) * 4 + j] : wre[(size_t)(k0 + kk) * 32 + j - 4]; }
            for (int i = tid; i < 32 * 256; i += NTHREADS) { const int rr = i >> 8, kk = i & 255; const float hv = X1[(size_t)(row0 + rr) * DM + k0 + kk] * rs[rr] * g2[k0 + kk];
                Xs[rr * 260 + kk] = hv; H2[(size_t)(row0 + rr) * DM + k0 + kk] = f2bf(hv); }
            __syncthreads();
            for (int kk = ks; kk < 256; kk += 16) { const float xv = Xs[r * 260 + kk]; const float* wr = Ws + kk * 36;
#pragma unroll
                for (int j = 0; j < 36; ++j) acc[j] = fmaf(xv, wr[j], acc[j]); }
            __syncthreads();
        }
#pragma unroll
        for (int j = 0; j < 36; ++j) { float v = acc[j]; v += __shfl_xor(v, 1); v += __shfl_xor(v, 2); v += __shfl_xor(v, 4); v += __shfl_xor(v, 8); acc[j] = v; }
        if (ks == 0) {
            float gl[4]; int grp = 0; float gm;
#pragma unroll
            for (int j = 0; j < 4; ++j) gl[j] = acc[j] + brg[j];
            gm = gl[0];
#pragma unroll
            for (int j = 1; j < 4; ++j) if (gl[j] > gm) { gm = gl[j]; grp = j; }
            float den = 0.f;
#pragma unroll
            for (int j = 0; j < 4; ++j) den += __expf(gl[j] - gm);
            const float pg = 1.f / den;
            float el[8];
#pragma unroll
            for (int j = 0; j < 8; ++j) { float v = 0.f;
#pragma unroll
                for (int g = 0; g < 4; ++g) if (g == grp) v = acc[4 + g * 8 + j] + bre[g * 8 + j];
                el[j] = v; }
            int i0 = 0; float v0 = el[0];
#pragma unroll
            for (int j = 1; j < 8; ++j) if (el[j] > v0) { v0 = el[j]; i0 = j; }
            int i1 = -1; float v1 = -INFINITY;
#pragma unroll
            for (int j = 0; j < 8; ++j) if (j != i0 && el[j] > v1) { v1 = el[j]; i1 = j; }
            const float e1 = __expf(v1 - v0); const float w0 = pg / (1.f + e1), w1 = pg * e1 / (1.f + e1);
            const int ea = grp * 8 + i0, eb = grp * 8 + i1;
            sel[r * 2] = ea; sel[r * 2 + 1] = eb; selw[r * 2] = w0; selw[r * 2 + 1] = w1;
            lpos[r * 2] = atomicAdd(&hist[ea], 1); lpos[r * 2 + 1] = atomicAdd(&hist[eb], 1);
        }
        __syncthreads();
        if (tid < 32) hbase[tid] = hist[tid] > 0 ? (int)atomicAdd(&cnt[(tid) * CNT_STRIDE], (unsigned)hist[tid]) : 0;
        __syncthreads();
        if (tid < 64) { const int e = sel[tid], pos = hbase[e] + lpos[tid]; const int tok = row0 + (tid >> 1);
            TOK[(size_t)e * T + pos] = tok; GATE[(size_t)e * T + pos] = selw[tid]; ASG[tok * 2 + (tid & 1)] = (e << 16) | pos; }
        __syncthreads();
    }
}

template <int ALT> __device__ __forceinline__ void p5_router2(const Args& A, float* ldsf) {
    const float* X1 = A.out; const float* g2 = A.in[14]; const float* wrg = A.in[15]; const float* brg = A.in[16]; const float* wre = A.in[17]; const float* bre = A.in[18];
    bf16_t* H2 = (bf16_t*)(A.ws + WS_H2); unsigned* cnt = (unsigned*)(A.ws + WS_CTL) + CW_CNT + (ALT ? 2048 : 0);
    int* TOK = (int*)(A.ws + (ALT ? WS_H : WS_TOK)); float* GATE = (float*)(A.ws + (ALT ? WS_H + 2 * MiB : WS_GATE)); int* ASG = (int*)(A.ws + (ALT ? WS_H + 4 * MiB : WS_ASG));
    const int tid = threadIdx.x, lane = tid & 63, wave = tid >> 6;
    constexpr int XP = 260, XB = 32 * XP, WP = 40, WB = 256 * WP;
    float* Xs = ldsf;
    float* Ws = ldsf + 2 * XB;
    float* misc = ldsf + 2 * XB + 2 * WB;
    float* rs = misc;
    float* lg = misc + 32;
    int* hist = (int*)(misc + 32 + 1280); int* hbase = hist + 32; int* sel = hbase + 32; int* lpos = sel + 64; float* selw = (float*)(lpos + 64);
    const int kh2 = lane >> 5, rp = (lane >> 1) & 15, cg = lane & 1;
    for (int rb = blockIdx.x; rb < T / 32; rb += gridDim.x) {
        const int row0 = rb * 32;
        float ssq[4] = {0.f, 0.f, 0.f, 0.f};
        float acc0[20], acc1[20];
#pragma unroll
        for (int j = 0; j < 20; ++j) { acc0[j] = 0.f; acc1[j] = 0.f; }
        if (tid < 32) hist[tid] = 0;
        f32x4 xr[4], wv[5], gv;
        for (int i = tid; i < 2 * 256; i += NTHREADS) *(f32x4*)(Ws + (i >> 8) * WB + (i & 255) * WP + 36) = (f32x4){0.f, 0.f, 0.f, 0.f};
#define R2_LOAD(k0) do { gv = *(const f32x4*)(g2 + (k0) + 4 * (tid & 63)); \
        _Pragma("unroll") for (int i = 0; i < 4; ++i) xr[i] = *(const f32x4*)(X1 + (size_t)(row0 + wave + 8 * i) * DM + (k0) + 4 * (tid & 63)); \
        _Pragma("unroll") for (int i = 0; i < 5; ++i) { const int idx = tid + i * 512; if (idx < 2304) { const int kk = idx / 9, j4 = idx - kk * 9; \
            wv[i] = j4 == 0 ? *(const f32x4*)(wrg + (size_t)((k0) + kk) * 4) : *(const f32x4*)(wre + (size_t)((k0) + kk) * 32 + 4 * (j4 - 1)); } } } while (0)
#define R2_STORE(buf) do { \
        _Pragma("unroll") for (int i = 0; i < 4; ++i) { ssq[i] += xr[i].x * xr[i].x + xr[i].y * xr[i].y + xr[i].z * xr[i].z + xr[i].w * xr[i].w; \
            *(f32x4*)(Xs + (buf) * XB + (wave + 8 * i) * XP + 4 * (tid & 63)) = xr[i] * gv; } \
        _Pragma("unroll") for (int i = 0; i < 5; ++i) { const int idx = tid + i * 512; if (idx < 2304) { const int kk = idx / 9, j4 = idx - kk * 9; *(f32x4*)(Ws + (buf) * WB + kk * WP + 4 * j4) = wv[i]; } } } while (0)
        R2_LOAD(0); R2_STORE(0);
        __syncthreads();
#pragma unroll 1
        for (int c = 0; c < 8; ++c) {
            const int buf = c & 1;
            if (c < 7) R2_LOAD((c + 1) * 256);
            const float* xa = Xs + buf * XB + (2 * rp) * XP + (wave * 2 + kh2) * 16; const float* wa = Ws + buf * WB + ((wave * 2 + kh2) * 16) * WP + 20 * cg;
#pragma unroll 1
            for (int k4 = 0; k4 < 4; ++k4) {
                const f32x4 x0 = *(const f32x4*)(xa + 4 * k4), x1 = *(const f32x4*)(xa + XP + 4 * k4);
#pragma unroll
                for (int kk = 0; kk < 4; ++kk) { const float* wr = wa + (4 * k4 + kk) * WP;
#pragma unroll
                    for (int j4 = 0; j4 < 5; ++j4) { const f32x4 w = *(const f32x4*)(wr + 4 * j4);
#pragma unroll
                        for (int e = 0; e < 4; ++e) { acc0[4 * j4 + e] = fmaf(x0[kk], w[e], acc0[4 * j4 + e]); acc1[4 * j4 + e] = fmaf(x1[kk], w[e], acc1[4 * j4 + e]); } }
                    asm volatile("" ::: "memory"); }
            }
            if (c < 7) R2_STORE(buf ^ 1);
            __syncthreads();
        }
#undef R2_LOAD
#undef R2_STORE
#pragma unroll
        for (int j = 0; j < 20; ++j) { acc0[j] += __shfl_xor(acc0[j], 32); acc1[j] += __shfl_xor(acc1[j], 32); }
        float* red = Xs;
        if (kh2 == 0) {
#pragma unroll
            for (int j = 0; j < 20; ++j) { red[(wave * 32 + 2 * rp) * 40 + 20 * cg + j] = acc0[j]; red[(wave * 32 + 2 * rp + 1) * 40 + 20 * cg + j] = acc1[j]; } }
#pragma unroll
        for (int i = 0; i < 4; ++i) { const float s = wave_sum(ssq[i]); if (lane == 0) rs[wave + 8 * i] = rsqrtf(s * (1.f / DM) + EPS); }
        __syncthreads();
        for (int i = tid; i < 32 * 40; i += NTHREADS) { float s = 0.f;
#pragma unroll
            for (int w = 0; w < 8; ++w) s += red[w * 1280 + i];
            lg[i] = s * rs[i / 40]; }
        __syncthreads();
#pragma unroll 1
        for (int i = 0; i < 4; ++i) { const int rr = wave + 8 * i; const float rstd = rs[rr]; const float* xp = X1 + (size_t)(row0 + rr) * DM; bf16_t* hp = H2 + (size_t)(row0 + rr) * DM;
#pragma unroll 2
            for (int j = 0; j < 8; ++j) { const int c0 = 256 * j + 4 * lane; const f32x4 v = *(const f32x4*)(xp + c0), g = *(const f32x4*)(g2 + c0);
                u32x2 o; o.x = pk2(v.x * rstd * g.x, v.y * rstd * g.y); o.y = pk2(v.z * rstd * g.z, v.w * rstd * g.w); *(u32x2*)(hp + c0) = o; } }
        if (tid < 32) {
            const int r = tid; const float* L = lg + r * 40;
            float gl[4]; int grp = 0;
#pragma unroll
            for (int j = 0; j < 4; ++j) gl[j] = L[j] + brg[j];
            float gm = gl[0];
#pragma unroll
            for (int j = 1; j < 4; ++j) if (gl[j] > gm) { gm = gl[j]; grp = j; }
            float den = 0.f;
#pragma unroll
            for (int j = 0; j < 4; ++j) den += __expf(gl[j] - gm);
            const float pg = 1.f / den;
            float el[8];
#pragma unroll
            for (int j = 0; j < 8; ++j) el[j] = L[4 + grp * 8 + j] + bre[grp * 8 + j];
            int i0 = 0; float v0 = el[0];
#pragma unroll
            for (int j = 1; j < 8; ++j) if (el[j] > v0) { v0 = el[j]; i0 = j; }
            int i1 = -1; float v1 = -INFINITY;
#pragma unroll
            for (int j = 0; j < 8; ++j) if (j != i0 && el[j] > v1) { v1 = el[j]; i1 = j; }
            const float e1 = __expf(v1 - v0); const float w0 = pg / (1.f + e1), w1 = pg * e1 / (1.f + e1);
            const int ea = grp * 8 + i0, eb = grp * 8 + i1;
            sel[r * 2] = ea; sel[r * 2 + 1] = eb; selw[r * 2] = w0; selw[r * 2 + 1] = w1;
            lpos[r * 2] = atomicAdd(&hist[ea], 1); lpos[r * 2 + 1] = atomicAdd(&hist[eb], 1);
        }
        __syncthreads();
        if (tid < 32) hbase[tid] = hist[tid] > 0 ? (int)atomicAdd(&cnt[(tid) * CNT_STRIDE], (unsigned)hist[tid]) : 0;
        __syncthreads();
        if (tid < 64) { const int e = sel[tid], pos = hbase[e] + lpos[tid]; const int tok = row0 + (tid >> 1);
            TOK[(size_t)e * T + pos] = tok; GATE[(size_t)e * T + pos] = selw[tid]; ASG[tok * 2 + (tid & 1)] = (e << 16) | pos; }
        __syncthreads();
    }
}

constexpr size_t WS_WR = 7 * MiB;
__device__ __forceinline__ void p0_router_weights(const Args& A) {
    const float* g2 = A.in[14]; const float* wrg = A.in[15]; const float* wre = A.in[17]; bf16_t* WR = (bf16_t*)(A.ws + WS_WR);
    for (int i = blockIdx.x * NTHREADS + threadIdx.x; i < 64 * DM; i += gridDim.x * NTHREADS) { const int n = i >> 11, k = i & (DM - 1);
        const float w = n < 4 ? wrg[(size_t)k * 4 + n] * g2[k] : (n < 36 ? wre[(size_t)k * 32 + n - 4] * g2[k] : 0.f);
        const bf16_t h = f2bf(w); WR[i] = h; WR[64 * DM + i] = f2bf(w - bf2f(h)); }
}
constexpr size_t WS_RSTL = WS_CKL;
template <int ALT> __device__ __forceinline__ void p5_router3(const Args& A, float* ldsf) {
    float* RSTL = (float*)(A.ws + (ALT ? WS_H + 6 * MiB : WS_RSTL));
    typedef short bf16x8 __attribute__((ext_vector_type(8))); typedef float f32x16 __attribute__((ext_vector_type(16)));
    const float* X1 = A.out; const float* g2 = A.in[14]; const float* brg = A.in[16]; const float* bre = A.in[18]; const bf16_t* WR = (const bf16_t*)(A.ws + WS_WR);
    bf16_t* H2 = (bf16_t*)(A.ws + WS_H2); unsigned* cnt = (unsigned*)(A.ws + WS_CTL) + CW_CNT + (ALT ? 2048 : 0);
    int* TOK = (int*)(A.ws + (ALT ? WS_H : WS_TOK)); float* GATE = (float*)(A.ws + (ALT ? WS_H + 2 * MiB : WS_GATE)); int* ASG = (int*)(A.ws + (ALT ? WS_H + 4 * MiB : WS_ASG));
    const int tid = threadIdx.x, lane = tid & 63, wave = tid >> 6, r32 = lane & 31, hi = lane >> 5;
    float* red = ldsf;
    float* lg = ldsf + 16384;
    float* sq = lg + 2048;
    float* rs = sq + 256;
    int* hist = (int*)(rs + 32); int* hbase = hist + 32; int* sel = hbase + 32; int* lpos = sel + 64; float* selw = (float*)(lpos + 64);
    for (int rb = blockIdx.x; rb < T / 32; rb += gridDim.x) {
        const int row0 = rb * 32;
        if (tid < 32) hist[tid] = 0;
        const float* xp = X1 + (size_t)(row0 + r32) * DM + 256 * wave + 8 * hi;
        const bf16_t* wp = WR + (size_t)r32 * DM + 256 * wave + 8 * hi;
        f32x16 acc[2];
#pragma unroll
        for (int j = 0; j < 2; ++j)
#pragma unroll
            for (int r = 0; r < 16; ++r) acc[j][r] = 0.f;
        float ssq = 0.f;
        f32x4 xa[4], xb[4], xna[4], xnb[4];
#pragma unroll
        for (int i = 0; i < 4; ++i) { xa[i] = *(const f32x4*)(xp + 16 * i); xb[i] = *(const f32x4*)(xp + 16 * i + 4); }
#pragma unroll 1
        for (int kb = 0; kb < (ALT == 3 ? 0 : 4); ++kb) {
            bf16x8 wh0[4], wh1[4], wl0[4], wl1[4]; f32x4 ga[4], gb[4];
#pragma unroll
            for (int i = 0; i < 4; ++i) { const int ko = 64 * kb + 16 * i;
                wh0[i] = *(const bf16x8*)(wp + ko); wh1[i] = *(const bf16x8*)(wp + (size_t)32 * DM + ko); wl0[i] = *(const bf16x8*)(wp + (size_t)64 * DM + ko); wl1[i] = *(const bf16x8*)(wp + (size_t)96 * DM + ko);
                ga[i] = *(const f32x4*)(g2 + 256 * wave + 8 * hi + ko); gb[i] = *(const f32x4*)(g2 + 256 * wave + 8 * hi + ko + 4); }
            asm volatile("" ::: "memory");
            if (kb < 3) {
#pragma unroll
                for (int i = 0; i < 4; ++i) { xna[i] = *(const f32x4*)(xp + 64 * (kb + 1) + 16 * i); xnb[i] = *(const f32x4*)(xp + 64 * (kb + 1) + 16 * i + 4); } }
            asm volatile("" ::: "memory");
#pragma unroll
            for (int i = 0; i < 4; ++i) { const int ko = 64 * kb + 16 * i;
                { u32x4 hw; hw.x = cvtpk_rne(xa[i][0] * ga[i][0], xa[i][1] * ga[i][1]); hw.y = cvtpk_rne(xa[i][2] * ga[i][2], xa[i][3] * ga[i][3]); hw.z = cvtpk_rne(xb[i][0] * gb[i][0], xb[i][1] * gb[i][1]); hw.w = cvtpk_rne(xb[i][2] * gb[i][2], xb[i][3] * gb[i][3]);
                  *(u32x4*)(H2 + (size_t)(row0 + r32) * DM + 256 * wave + 8 * hi + ko) = hw; }
                float xv[8] = {xa[i][0], xa[i][1], xa[i][2], xa[i][3], xb[i][0], xb[i][1], xb[i][2], xb[i][3]}; u32x4 ph, pl;
#pragma unroll
                for (int e = 0; e < 4; ++e) { const float a = xv[2 * e], b2 = xv[2 * e + 1]; ssq += a * a + b2 * b2; const unsigned hh = cvtpk_rne(a, b2); ph[e] = hh;
                    pl[e] = cvtpk_rne(a - __uint_as_float(hh << 16), b2 - __uint_as_float(hh & 0xffff0000u)); }
                const bf16x8 xh = __builtin_bit_cast(bf16x8, ph), xl = __builtin_bit_cast(bf16x8, pl);
                acc[0] = __builtin_amdgcn_mfma_f32_32x32x16_bf16(xh, wh0[i], acc[0], 0, 0, 0); acc[0] = __builtin_amdgcn_mfma_f32_32x32x16_bf16(xl, wh0[i], acc[0], 0, 0, 0); acc[0] = __builtin_amdgcn_mfma_f32_32x32x16_bf16(xh, wl0[i], acc[0], 0, 0, 0);
                acc[1] = __builtin_amdgcn_mfma_f32_32x32x16_bf16(xh, wh1[i], acc[1], 0, 0, 0); acc[1] = __builtin_amdgcn_mfma_f32_32x32x16_bf16(xl, wh1[i], acc[1], 0, 0, 0); acc[1] = __builtin_amdgcn_mfma_f32_32x32x16_bf16(xh, wl1[i], acc[1], 0, 0, 0); }
#pragma unroll
            for (int i = 0; i < 4; ++i) { xa[i] = xna[i]; xb[i] = xnb[i]; }
        }
#pragma unroll
        for (int j = 0; j < 2; ++j)
#pragma unroll
            for (int r = 0; r < 16; ++r) red[((wave * 2 + j) * 16 + r) * 64 + lane] = acc[j][r];
        ssq += __shfl_xor(ssq, 32);
        if (hi == 0) sq[wave * 32 + r32] = ssq;
        __syncthreads();
        if (ALT == 2) continue;
#pragma unroll
        for (int j = 0; j < 2; ++j)
#pragma unroll
            for (int rr = 0; rr < 2; ++rr) { const int r = 2 * wave + rr; float s = 0.f;
#pragma unroll
                for (int w2 = 0; w2 < 8; ++w2) s += red[((w2 * 2 + j) * 16 + r) * 64 + lane];
                lg[((r & 3) + 8 * (r >> 2) + 4 * hi) * 64 + 32 * j + r32] = s; }
        if (tid < 32) { float s = 0.f;
#pragma unroll
            for (int w2 = 0; w2 < 8; ++w2) s += sq[w2 * 32 + tid];
            rs[tid] = rsqrtf(s * (1.f / DM) + EPS); }
        __syncthreads();
        if (tid < 32) {
            const int r = tid; const float* L = lg + r * 64; const float rstd = rs[r];
            float gl[4]; int grp = 0;
#pragma unroll
            for (int j = 0; j < 4; ++j) gl[j] = L[j] * rstd + brg[j];
            float gm = gl[0];
#pragma unroll
            for (int j = 1; j < 4; ++j) if (gl[j] > gm) { gm = gl[j]; grp = j; }
            float den = 0.f;
#pragma unroll
            for (int j = 0; j < 4; ++j) den += __expf(gl[j] - gm);
            const float pg = 1.f / den;
            float el[8];
#pragma unroll
            for (int j = 0; j < 8; ++j) el[j] = L[4 + grp * 8 + j] * rstd + bre[grp * 8 + j];
            int i0 = 0; float v0 = el[0];
#pragma unroll
            for (int j = 1; j < 8; ++j) if (el[j] > v0) { v0 = el[j]; i0 = j; }
            int i1 = -1; float v1 = -INFINITY;
#pragma unroll
            for (int j = 0; j < 8; ++j) if (j != i0 && el[j] > v1) { v1 = el[j]; i1 = j; }
            const float e1 = __expf(v1 - v0); const float w0 = pg / (1.f + e1), w1 = pg * e1 / (1.f + e1);
            const int ea = grp * 8 + i0, eb = grp * 8 + i1;
            sel[r * 2] = ea; sel[r * 2 + 1] = eb; selw[r * 2] = w0; selw[r * 2 + 1] = w1;
            lpos[r * 2] = atomicAdd(&hist[ea], 1); lpos[r * 2 + 1] = atomicAdd(&hist[eb], 1);
        }
        __syncthreads();
        if (tid < 32) hbase[tid] = hist[tid] > 0 ? (int)atomicAdd(&cnt[(tid) * CNT_STRIDE], (unsigned)hist[tid]) : 0;
        __syncthreads();
        if (tid < 64) { const int e = sel[tid], pos = hbase[e] + lpos[tid]; const int tok = row0 + (tid >> 1);
            TOK[(size_t)e * T + pos] = tok; GATE[(size_t)e * T + pos] = selw[tid]; RSTL[(size_t)e * T + pos] = rs[tid >> 1]; ASG[tok * 2 + (tid & 1)] = (e << 16) | pos; }
        __syncthreads();
    }
}

__device__ __forceinline__ void expert_layout(const unsigned* cnt, int* pstart  ) {
    int acc = 0;
    for (int e = 0; e < NEXP; ++e) { pstart[e] = acc; acc += ((int)cnt[(e) * CNT_STRIDE] + MTILE - 1) / MTILE * MTILE; }
    pstart[NEXP] = acc;
}

__device__ __forceinline__ void p6_naive(const Args& A, float* ldsf) {
    const bf16_t* H2 = (const bf16_t*)(A.ws + WS_H2); const float* wg = A.in[19]; const float* wu = A.in[20]; bf16_t* ACT = (bf16_t*)(A.ws + WS_ACT);
    const unsigned* cnt = (const unsigned*)(A.ws + WS_CTL) + CW_CNT; const int* TOK = (const int*)(A.ws + WS_TOK);
    int* ps = (int*)(ldsf + 2 * 16 * 132);
    if (threadIdx.x == 0) expert_layout(cnt, ps);
    __syncthreads();
    int ntot = 0;
    for (int e = 0; e < NEXP; ++e) ntot += (((int)cnt[(e) * CNT_STRIDE] + 127) / 128) * 4;
    for (int t = blockIdx.x; t < ntot; t += gridDim.x) {
        int e = 0, rem = t;
        for (; e < NEXP; ++e) { const int n = (((int)cnt[(e) * CNT_STRIDE] + 127) / 128) * 4; if (rem < n) break; rem -= n; }
        const int c = (int)cnt[(e) * CNT_STRIDE]; const int tm = rem / 4, tn = rem % 4; const int* tl = TOK + (size_t)e * T; const int prow = ps[e];
        const float* wge = wg + (size_t)e * DM * DEXP; const float* wue = wu + (size_t)e * DM * DEXP;
        naive_gemm_tile(ldsf, tm * 128, tn * 128, c, DEXP, 2 * DM, DM,
            [=](int m, int k) { return bf2f(H2[(size_t)tl[m] * DM + (k & (DM - 1))]); },
            [=](int k, int n) { return k < DM ? wge[(size_t)k * DEXP + n] : wue[(size_t)(k - DM) * DEXP + n]; },
            [=](int m, int n, float sg, float su) { ACT[(size_t)(prow + m) * DEXP + n] = f2bf(sg / (1.f + __expf(-sg)) * su); });
    }
}
__device__ __forceinline__ void p7_naive(const Args& A, float* ldsf) {
    const bf16_t* ACT = (const bf16_t*)(A.ws + WS_ACT); const float* wd = A.in[21]; bf16_t* YBUF = (bf16_t*)(A.ws + WS_YBUF);
    const unsigned* cnt = (const unsigned*)(A.ws + WS_CTL) + CW_CNT; const float* GATE = (const float*)(A.ws + WS_GATE);
    int* ps = (int*)(ldsf + 2 * 16 * 132);
    if (threadIdx.x == 0) expert_layout(cnt, ps);
    __syncthreads();
    int ntot = 0;
    for (int e = 0; e < NEXP; ++e) ntot += (((int)cnt[(e) * CNT_STRIDE] + 127) / 128) * 16;
    for (int t = blockIdx.x; t < ntot; t += gridDim.x) {
        int e = 0, rem = t;
        for (; e < NEXP; ++e) { const int n = (((int)cnt[(e) * CNT_STRIDE] + 127) / 128) * 16; if (rem < n) break; rem -= n; }
        const int c = (int)cnt[(e) * CNT_STRIDE]; const int tm = rem / 16, tn = rem % 16; const float* gl = GATE + (size_t)e * T; const int prow = ps[e];
        const float* wde = wd + (size_t)e * DEXP * DM;
        naive_gemm_tile(ldsf, tm * 128, tn * 128, c, DM, DEXP, DEXP,
            [=](int m, int k) { return bf2f(ACT[(size_t)(prow + m) * DEXP + k]); },
            [=](int k, int n) { return wde[(size_t)k * DM + n]; },
            [=](int m, int n, float s, float) { YBUF[(size_t)(prow + m) * DM + n] = f2bf(s * gl[m]); });
    }
}

template <int ALT> __device__ __forceinline__ void p8_combine(const Args& A, float* ldsf, const float dlt = 0.f) {
    float* X1 = A.out; float* XO = ALT ? (float*)(A.ws + WS_WGU) : A.out; const bf16_t* YBUF = (const bf16_t*)(A.ws + WS_YBUF); const int* ASG = (const int*)(A.ws + WS_ASG);
    const unsigned* cnt = (const unsigned*)(A.ws + WS_CTL) + CW_CNT;
    int* ps = (int*)ldsf;
    if (threadIdx.x == 0) expert_layout(cnt, ps);
    __syncthreads();
    float dl2 = dlt;
    if (STAMP_PHASE == 97) { int v = 0, mx = 0, mn = 1 << 30, nt_ = 0, tiny = 0, half = 0; for (int e = 0; e < NEXP; ++e) { const int c = (int)cnt[(e) * CNT_STRIDE]; mx = c > mx ? c : mx; mn = c < mn ? c : mn; nt_ += (c + 255) / 256; const int rem = c % 256; tiny += (rem > 0 && rem <= 64) ? 1 : 0; half += (rem > 0 && rem <= 128) ? 1 : 0; }
        v = STAMP_SEL == 0 ? nt_ : STAMP_SEL == 1 ? mx : STAMP_SEL == 2 ? mn : STAMP_SEL == 3 ? tiny : half; dl2 = 0.01f * (float)v; }
    const int tid = threadIdx.x, lane = tid & 63, wave = tid >> 6;
    const int gw = blockIdx.x * NWAVES + wave, NGW = gridDim.x * NWAVES;
    u32x4 w0[4], w1[4], n0[4], n1[4]; f32x4 xa[4], xb[4], na[4], nb[4];
#define P8_LOAD(row_, W0, W1, XA, XB) do { const int a0_ = ASG[(row_) * 2], a1_ = ASG[(row_) * 2 + 1]; \
        const bf16_t* y0_ = YBUF + (size_t)(ps[a0_ >> 16] + (a0_ & 0xffff)) * DM; const bf16_t* y1_ = YBUF + (size_t)(ps[a1_ >> 16] + (a1_ & 0xffff)) * DM; const float* xr_ = X1 + (size_t)(row_) * DM; \
        _Pragma("unroll") for (int j = 0; j < 4; ++j) { const int c0 = 512 * j + 8 * lane; W0[j] = *(const u32x4*)(y0_ + c0); W1[j] = *(const u32x4*)(y1_ + c0); XA[j] = *(const f32x4*)(xr_ + c0); XB[j] = *(const f32x4*)(xr_ + c0 + 4); } } while (0)
    int row = gw;
    if (row < T) P8_LOAD(row, w0, w1, xa, xb);
    for (; row < T; row += NGW) {
        const int nrow = row + NGW; const bool more = nrow < T;
        if (more) P8_LOAD(nrow, n0, n1, na, nb);
        float* xo = XO + (size_t)row * DM;
#pragma unroll
        for (int j = 0; j < 4; ++j) { const int c0 = 512 * j + 8 * lane; f32x4 a = xa[j], b2 = xb[j];
            a.x += __uint_as_float(w0[j][0] << 16) + __uint_as_float(w1[j][0] << 16); a.y += __uint_as_float(w0[j][0] & 0xffff0000u) + __uint_as_float(w1[j][0] & 0xffff0000u);
            a.z += __uint_as_float(w0[j][1] << 16) + __uint_as_float(w1[j][1] << 16); a.w += __uint_as_float(w0[j][1] & 0xffff0000u) + __uint_as_float(w1[j][1] & 0xffff0000u);
            b2.x += __uint_as_float(w0[j][2] << 16) + __uint_as_float(w1[j][2] << 16); b2.y += __uint_as_float(w0[j][2] & 0xffff0000u) + __uint_as_float(w1[j][2] & 0xffff0000u);
            b2.z += __uint_as_float(w0[j][3] << 16) + __uint_as_float(w1[j][3] << 16); b2.w += __uint_as_float(w0[j][3] & 0xffff0000u) + __uint_as_float(w1[j][3] & 0xffff0000u);
            if (STAMP_PHASE >= 0) { a += dl2; b2 += dl2; }
            *(f32x4*)(xo + c0) = a; *(f32x4*)(xo + c0 + 4) = b2; }
        if (more) {
#pragma unroll
            for (int j = 0; j < 4; ++j) { w0[j] = n0[j]; w1[j] = n1[j]; xa[j] = na[j]; xb[j] = nb[j]; } }
    }
#undef P8_LOAD
}

namespace pg8 {
#define PG8_LAS __attribute__((address_space(3)))
typedef short bf16x8 __attribute__((ext_vector_type(8)));
constexpr int BM = 256, BK = 64, HALF = 128, HTB = HALF * BK * 2, STAGE_BYTES = 8 * HTB, NXCD = 8, WGM = 8;
__host__ __device__ __forceinline__ int lds_byte(int r, int c) { const int st = (r >> 4) * 2 + (c >> 5), rr = r & 15, cc = c & 31, ob = rr * 64 + cc * 2; return st * 1024 + (ob ^ (((ob >> 9) & 1) << 5)); }
__host__ __device__ __forceinline__ void stage_rc(int b, int& R, int& C) { const int st = b / 1024, sb = b % 1024, swz = sb ^ (((sb >> 9) & 1) << 5); R = (st >> 1) * 16 + swz / 64; C = (st & 1) * 32 + (swz % 64) / 2; }
__host__ __device__ __forceinline__ int perm32(int rho) { const int n = rho >> 4, i = rho & 15; return 8 * (i >> 2) + 4 * n + (i & 3); }

struct Unit { const char* A; const char* B; int pm, pn, x0, x1, x2, x3; };

struct DenseOrder {
    const char* A; const char* Bt; int K, nM, nN, nwg, G, c, rep;
    __device__ void init(const void* A_, const void* Bt_, int M, int N, int K_, int G_, int c_, int rep_ = 1) { A = (const char*)A_; Bt = (const char*)Bt_; K = K_; nM = M / BM; nN = N / BM; nwg = nM * nN; G = G_; c = c_; rep = rep_; }
    __device__ bool next(int i, Unit& u) const {
        const long L = (long)i * G + c; if (L >= (long)nwg * rep) return false;
        int wgid = (int)(L % nwg); { const int q = nwg / NXCD, r = nwg % NXCD, xcd = wgid % NXCD, off = wgid / NXCD; wgid = (xcd < r ? xcd * (q + 1) : r * (q + 1) + (xcd - r) * q) + off; }
        const int nig = WGM * nN, gid = wgid / nig, fm = gid * WGM, gsz = (nM - fm) < WGM ? (nM - fm) : WGM;
        u.pm = fm + ((wgid % nig) % gsz); u.pn = (wgid % nig) / gsz; u.x0 = 0; u.x1 = 0; u.x2 = 0; u.x3 = 0;
        u.A = A + (size_t)u.pm * BM * K * 2; u.B = Bt + (size_t)u.pn * BM * K * 2; return true;
    }
    __device__ __forceinline__ void rows(const Unit&, unsigned (&)[2][2], const int (&)[2]) const {}
};

__device__ __forceinline__ unsigned cvt_pk_bf16(float lo, float hi) { unsigned r; asm volatile("v_cvt_pk_bf16_f32 %0, %1, %2" : "=v"(r) : "v"(lo), "v"(hi)); return r; }

template <class Epi, class Sched, bool ALIGN_EPI, bool GATHER, bool SKIP = false>
__device__ __forceinline__ void gemm_phase(PG8_LAS unsigned char* lds, const int K, const Sched& S, const Epi& E) {
    const int tid = threadIdx.x, wid = __builtin_amdgcn_readfirstlane(tid >> 6), lane = tid & 63, wr = wid >> 2, wc = wid & 3, fr = lane & 15, fq = lane >> 4;
    const int nt = K / BK;
    unsigned voffA[2], voffB[2]; int RA[2];
#pragma unroll
    for (int i = 0; i < 2; ++i) { int R, C; stage_rc(tid * 16 + i * 8192, R, C); const int Rb = Epi::PERM ? ((R & ~31) + perm32(R & 31)) : R;
        voffA[i] = GATHER ? (unsigned)(C * 2) : (unsigned)(R * K + C) * 2u; voffB[i] = (unsigned)(Rb * K + C) * 2u; RA[i] = R; }
    const size_t kstep = (size_t)(BK * 2);
    const size_t hstep = (size_t)HALF * K * 2;
    const size_t hstepA = GATHER ? 0 : hstep;
    const unsigned ldsw = (unsigned)wid * 1024u;
    const int aoff = lds_byte(wr * 64 + fr, fq * 8), boff = lds_byte(wc * 32 + fr, fq * 8);
    unsigned gA[2][2], gAn[2][2];
#define PG8_SA(b, h) (((b) * 2 + (h)) * HTB)
#define PG8_SB(b, h) ((4 + (b) * 2 + (h)) * HTB)
#define PG8_STAGE(bufoff, gbase, voff) do { _Pragma("unroll") for (int _i = 0; _i < 2; ++_i) \
        __builtin_amdgcn_global_load_lds((const unsigned*)((const char*)(gbase) + (voff)[_i]), (PG8_LAS unsigned*)(lds + (bufoff) + ldsw + _i * 8192), 16, 0, 0); } while (0)
#define PG8_STAGE_A(bufoff, gbase, h, nx) do { _Pragma("unroll") for (int _i = 0; _i < 2; ++_i) { \
        const unsigned _o = GATHER ? ((nx) ? gAn[h][_i] : gA[h][_i]) + voffA[_i] : voffA[_i]; \
        __builtin_amdgcn_global_load_lds((const unsigned*)((const char*)(gbase) + (h) * hstepA + _o), (PG8_LAS unsigned*)(lds + (bufoff) + ldsw + _i * 8192), 16, 0, 0); } } while (0)
#define PG8_LDA(dst, b, h) do { _Pragma("unroll") for (int m = 0; m < 4; ++m) _Pragma("unroll") for (int k = 0; k < 2; ++k) dst[m][k] = *(const PG8_LAS bf16x8*)(lds + PG8_SA(b, h) + aoff + m * 2048 + k * 1024); } while (0)
#define PG8_LDB(dst, b, h) do { _Pragma("unroll") for (int n = 0; n < 2; ++n) _Pragma("unroll") for (int k = 0; k < 2; ++k) dst[n][k] = *(const PG8_LAS bf16x8*)(lds + PG8_SB(b, h) + boff + n * 2048 + k * 1024); } while (0)
#define PG8_MMA(ai, bj, At, Bt) do { __builtin_amdgcn_s_setprio(1); _Pragma("unroll") for (int m = 0; m < 4; ++m) { if (!SKIP || m < ((ai) == 0 ? mc0 : mc1)) { _Pragma("unroll") for (int n = 0; n < 2; ++n) _Pragma("unroll") for (int k = 0; k < 2; ++k) \
        acc[ai][bj][m][n] = __builtin_amdgcn_mfma_f32_16x16x32_bf16(Bt[n][k], At[m][k], acc[ai][bj][m][n], 0, 0, 0); } } __builtin_amdgcn_s_setprio(0); } while (0)
#define PG8_WAIT_V(n) asm volatile("s_waitcnt vmcnt(" #n ")" ::: "memory")
#define PG8_WAIT_L(n) asm volatile("s_waitcnt lgkmcnt(" #n ")" ::: "memory")
#define PG8_BAR __builtin_amdgcn_s_barrier()
#define PG8_SCHED __builtin_amdgcn_sched_barrier(0)
    Unit cur, nxt; int ui = 0;
    if (!S.next(0, cur)) return;
    int mc0 = 4, mc1 = 4;
#define PG8_MC(u) do { if (SKIP) { const int a_ = ((u).x2 - 64 * wr + 15) >> 4, b_ = ((u).x2 - 128 - 64 * wr + 15) >> 4; mc0 = a_ < 0 ? 0 : (a_ > 4 ? 4 : a_); mc1 = b_ < 0 ? 0 : (b_ > 4 ? 4 : b_); } } while (0)
    PG8_MC(cur);
    f32x4 acc[2][2][4][2];
#pragma unroll
    for (int a = 0; a < 2; ++a)
#pragma unroll
        for (int b = 0; b < 2; ++b)
#pragma unroll
            for (int m = 0; m < 4; ++m)
#pragma unroll
                for (int n = 0; n < 2; ++n) acc[a][b][m][n] = (f32x4){0.f, 0.f, 0.f, 0.f};
    bf16x8 At[4][2], B0[2][2], B1[2][2];
    const char* cA = cur.A; const char* cB = cur.B;
    if constexpr (GATHER) { S.rows(cur, gA, RA);
#pragma unroll
        for (int h = 0; h < 2; ++h)
#pragma unroll
            for (int i = 0; i < 2; ++i) gAn[h][i] = gA[h][i]; }
    PG8_STAGE(PG8_SB(0, 0), cB, voffB); PG8_STAGE(PG8_SB(0, 1), cB + hstep, voffB); PG8_STAGE_A(PG8_SA(0, 0), cA, 0, false); PG8_STAGE_A(PG8_SA(0, 1), cA, 1, false);
    if (wr == 1) PG8_BAR;
    PG8_WAIT_V(2); PG8_BAR;
    PG8_STAGE(PG8_SB(1, 0), cB + kstep, voffB); PG8_STAGE_A(PG8_SA(1, 0), cA + kstep, 0, false); PG8_STAGE(PG8_SB(1, 1), cB + hstep + kstep, voffB);
    PG8_WAIT_V(6); PG8_BAR;
    for (;;) {
        const bool has_next = S.next(ui + 1, nxt);
        const char* nA = has_next ? nxt.A : cA; const char* nB = has_next ? nxt.B : cB;
        if constexpr (GATHER) { if (has_next) { S.rows(nxt, gAn, RA); } }
        for (int t = 0; t < nt; t += 2) {
            const bool last = (t == nt - 2);
            const char* a1 = cA + (size_t)(t + 1) * kstep;
            const char* a2 = last ? nA : cA + (size_t)(t + 2) * kstep; const char* b2 = last ? nB : cB + (size_t)(t + 2) * kstep;
            const char* a3 = a2 + kstep; const char* b3 = b2 + kstep;
            if constexpr (Epi::HAS_MID) { if (t == nt / 2) { int frl = fr, fql = fq; asm volatile("" : "+v"(frl), "+v"(fql)); E.mid(acc, cur, wr, wc, frl, fql); } }
            PG8_LDB(B0, 0, 0); PG8_LDB(B1, 0, 1); PG8_SCHED; PG8_LDA(At, 0, 0); PG8_STAGE_A(PG8_SA(1, 1), a1, 1, false);
            PG8_WAIT_V(8); PG8_WAIT_L(0); PG8_BAR; PG8_MMA(0, 0, At, B0); PG8_MMA(0, 1, At, B1); PG8_BAR; PG8_SCHED;
            PG8_LDA(At, 0, 1); PG8_STAGE(PG8_SB(0, 0), b2, voffB); PG8_STAGE(PG8_SB(0, 1), b2 + hstep, voffB); PG8_STAGE_A(PG8_SA(0, 0), a2, 0, last);
            PG8_WAIT_V(8); PG8_WAIT_L(0); PG8_BAR; PG8_MMA(1, 0, At, B0); PG8_MMA(1, 1, At, B1); PG8_BAR; PG8_SCHED;
            PG8_LDB(B0, 1, 0); PG8_LDB(B1, 1, 1); PG8_SCHED; PG8_LDA(At, 1, 0); PG8_STAGE_A(PG8_SA(0, 1), a2, 1, last);
            PG8_WAIT_V(8); PG8_WAIT_L(0); PG8_BAR; PG8_MMA(0, 0, At, B0); PG8_MMA(0, 1, At, B1); PG8_BAR; PG8_SCHED;
            PG8_LDA(At, 1, 1); PG8_STAGE(PG8_SB(1, 0), b3, voffB); PG8_STAGE(PG8_SB(1, 1), b3 + hstep, voffB); PG8_STAGE_A(PG8_SA(1, 0), a3, 0, last);
            PG8_WAIT_V(8); PG8_WAIT_L(0); PG8_BAR; PG8_MMA(1, 0, At, B0); PG8_MMA(1, 1, At, B1); PG8_BAR; PG8_SCHED;
        }
        if constexpr (ALIGN_EPI) { if (wr == 0) PG8_BAR; }
        { int frl = fr, fql = fq; asm volatile("" : "+v"(frl), "+v"(fql)); E(acc, cur, wr, wc, frl, fql); }
        if (!has_next) break;
#pragma unroll
        for (int a = 0; a < 2; ++a)
#pragma unroll
            for (int b = 0; b < 2; ++b)
#pragma unroll
                for (int m = 0; m < 4; ++m)
#pragma unroll
                    for (int n = 0; n < 2; ++n) acc[a][b][m][n] = (f32x4){0.f, 0.f, 0.f, 0.f};
        cur = nxt; cA = nA; cB = nB; ++ui; PG8_MC(cur);
        if constexpr (GATHER) {
#pragma unroll
            for (int h = 0; h < 2; ++h)
#pragma unroll
                for (int i = 0; i < 2; ++i) gA[h][i] = gAn[h][i]; }
        if constexpr (ALIGN_EPI) { if (wr == 1) PG8_BAR; }
    }
    PG8_WAIT_V(0);
    if constexpr (!ALIGN_EPI) { if (wr == 0) PG8_BAR; }
    PG8_BAR;
#undef PG8_SA
#undef PG8_SB
#undef PG8_STAGE
#undef PG8_STAGE_A
#undef PG8_LDA
#undef PG8_LDB
#undef PG8_MMA
#undef PG8_WAIT_V
#undef PG8_WAIT_L
#undef PG8_BAR
#undef PG8_SCHED
#undef PG8_MC
}
}

constexpr int LDS_MISC_OFF = 131072;
__device__ __forceinline__ float fast_gelu(float x) { const float y = x + 0.044715f * x * x * x; return x * __builtin_amdgcn_rcpf(1.0f + __builtin_amdgcn_exp2f(-2.0f * 0.7978845608028654f * LOG2E * y)); }
__device__ __forceinline__ float fast_sigmoid(float x) { return __builtin_amdgcn_rcpf(1.0f + __builtin_amdgcn_exp2f(-LOG2E * x)); }
__device__ __forceinline__ void unpack8(const u32x4 w, float (&v)[8]) {
#pragma unroll
    for (int e = 0; e < 4; ++e) { v[2 * e] = __uint_as_float(w[e] << 16); v[2 * e + 1] = __uint_as_float(w[e] & 0xffff0000u); } }

constexpr size_t WS_VSTAT = 6 * MiB;
constexpr int LDS_EPI_OFF = 131072 + 4096;
struct EpiIn {
    static constexpr bool PERM = true, HAS_MID = false;
    bf16_t *U, *V, *Q, *K, *VA, *G; const float* b_gate; const float* qg; const float* kg; float* VSTAT; PG8_LAS unsigned char* lds;
    __device__ __forceinline__ void mid(f32x4 (&)[2][2][4][2], const pg8::Unit&, int, int, int, int) const {}
    __device__ __forceinline__ void operator()(f32x4 (&acc)[2][2][4][2], const pg8::Unit& u, int wr, int wc, int fr, int fq) const {
        const int pn = u.pn; bf16_t* base; int ld, colt, mode;
        if (pn < 4) { base = U; ld = 1024; colt = pn * 256; mode = 1; }
        else if (pn < 8) { base = V; ld = 1024; colt = (pn - 4) * 256; mode = 3; }
        else if (pn < 12) { base = Q; ld = 1024; colt = (pn - 8) * 256; mode = 4; }
        else if (pn < 16) { base = K; ld = 1024; colt = (pn - 12) * 256; mode = 5; }
        else if (pn < 20) { base = VA; ld = 1024; colt = (pn - 16) * 256; mode = 0; }
        else { base = G; ld = 4096; colt = (pn - 20) * 256; mode = 2; }
        const int row0 = u.pm * 256 + wr * 64 + fr, col0 = colt + wc * 32 + 8 * fq;
        if (mode >= 4) {
            PG8_LAS float* P = (PG8_LAS float*)(lds + LDS_EPI_OFF);
#pragma unroll
            for (int ai = 0; ai < 2; ++ai)
#pragma unroll
                for (int m = 0; m < 4; ++m)
#pragma unroll
                    for (int bj = 0; bj < 2; ++bj) { const f32x4 a = acc[ai][bj][m][0], b = acc[ai][bj][m][1];
                        float s = (a[0] * a[0] + a[1] * a[1]) + (a[2] * a[2] + a[3] * a[3]) + (b[0] * b[0] + b[1] * b[1]) + (b[2] * b[2] + b[3] * b[3]);
                        s += __shfl_xor(s, 16); s += __shfl_xor(s, 32);
                        if (fq == 0) P[((ai * 128 + wr * 64 + m * 16 + fr) * 2 + bj) * 4 + wc] = s; }
            asm volatile("s_waitcnt lgkmcnt(0)" ::: "memory"); __builtin_amdgcn_s_barrier(); asm volatile("" ::: "memory");
            const float* gg = mode == 4 ? qg : kg; const float qs = mode == 4 ? QSCALE : 1.0f;
            const f32x4 g0 = *(const f32x4*)(gg + wc * 32 + 8 * fq), g1 = *(const f32x4*)(gg + wc * 32 + 8 * fq + 4);
#pragma unroll
            for (int ai = 0; ai < 2; ++ai)
#pragma unroll
                for (int m = 0; m < 4; ++m) { bf16_t* rowp = base + (size_t)(row0 + ai * 128 + m * 16) * ld + col0;
#pragma unroll
                    for (int bj = 0; bj < 2; ++bj) { const f32x4 pp = *(const PG8_LAS f32x4*)(P + ((ai * 128 + wr * 64 + m * 16 + fr) * 2 + bj) * 4);
                        const float sc = rsqrtf(((pp[0] + pp[1]) + (pp[2] + pp[3])) * (1.f / 128.f) + EPS) * qs;
                        const f32x4 v0 = acc[ai][bj][m][0] * g0 * sc, v1 = acc[ai][bj][m][1] * g1 * sc;
                        u32x4 w; w.x = pg8::cvt_pk_bf16(v0[0], v0[1]); w.y = pg8::cvt_pk_bf16(v0[2], v0[3]); w.z = pg8::cvt_pk_bf16(v1[0], v1[1]); w.w = pg8::cvt_pk_bf16(v1[2], v1[3]);
                        *(u32x4*)(rowp + bj * 128) = w; } }
            return;
        }
        f32x4 bv[2][2];
#pragma unroll
        for (int bj = 0; bj < 2; ++bj)
#pragma unroll
            for (int n = 0; n < 2; ++n) bv[bj][n] = (mode == 2) ? *(const f32x4*)(b_gate + col0 + bj * 128 + 4 * n) : (f32x4){0.f, 0.f, 0.f, 0.f};
#pragma unroll
        for (int ai = 0; ai < 2; ++ai)
#pragma unroll
            for (int m = 0; m < 4; ++m) { bf16_t* rowp = base + (size_t)(row0 + ai * 128 + m * 16) * ld + col0; float s1 = 0.f, s2 = 0.f;
#pragma unroll
                for (int bj = 0; bj < 2; ++bj) { f32x4 v0 = acc[ai][bj][m][0], v1 = acc[ai][bj][m][1];
                    if (mode == 1 || mode == 3) {
#pragma unroll
                        for (int j = 0; j < 4; ++j) { v0[j] = fast_gelu(v0[j]); v1[j] = fast_gelu(v1[j]); } }
                    else if (mode == 2) { v0 += bv[bj][0]; v1 += bv[bj][1];
#pragma unroll
                        for (int j = 0; j < 4; ++j) { v0[j] = fast_sigmoid(v0[j]); v1[j] = fast_sigmoid(v1[j]); } }
                    if (mode == 3) {
#pragma unroll
                        for (int j = 0; j < 4; ++j) { s1 += v0[j] + v1[j]; s2 += v0[j] * v0[j] + v1[j] * v1[j]; } }
                    u32x4 w; w.x = pg8::cvt_pk_bf16(v0[0], v0[1]); w.y = pg8::cvt_pk_bf16(v0[2], v0[3]); w.z = pg8::cvt_pk_bf16(v1[0], v1[1]); w.w = pg8::cvt_pk_bf16(v1[2], v1[3]);
                    *(u32x4*)(rowp + bj * 128) = w; }
                if (mode == 3) { s1 += __shfl_xor(s1, 16); s1 += __shfl_xor(s1, 32); s2 += __shfl_xor(s2, 16); s2 += __shfl_xor(s2, 32);
                    if (fq == 0) { typedef float f32x2_ __attribute__((ext_vector_type(2))); *(f32x2_*)(VSTAT + ((size_t)(row0 + ai * 128 + m * 16) * 16 + (pn - 4) * 4 + wc) * 2) = (f32x2_){s1, s2}; } } }
    }
};
struct EpiProj {
    static constexpr bool PERM = true, HAS_MID = true;
    const bf16_t* G; bf16_t* O;
    __device__ __forceinline__ void mid(f32x4 (&acc)[2][2][4][2], const pg8::Unit& u, int wr, int wc, int fr, int fq) const {
        const int row0 = u.pm * 256 + wr * 64 + fr, col0 = u.pn * 256 + wc * 32 + 8 * fq;
#pragma unroll
        for (int ai = 0; ai < 2; ++ai) { u32x4 ws[4][2], wf[4][2];
#pragma unroll
            for (int m = 0; m < 4; ++m) { const bf16_t* gp = G + (size_t)(row0 + ai * 128 + m * 16) * 4096 + col0;
#pragma unroll
                for (int bj = 0; bj < 2; ++bj) { ws[m][bj] = *(const u32x4*)(gp + bj * 128); wf[m][bj] = *(const u32x4*)(gp + 2048 + bj * 128); } }
#pragma unroll
            for (int m = 0; m < 4; ++m)
#pragma unroll
                for (int bj = 0; bj < 2; ++bj) { float gs[8], gf[8]; unpack8(ws[m][bj], gs); unpack8(wf[m][bj], gf);
#pragma unroll
                    for (int j = 0; j < 4; ++j) { acc[ai][bj][m][0][j] *= gs[j] * __builtin_amdgcn_rcpf(gf[j]); acc[ai][bj][m][1][j] *= gs[4 + j] * __builtin_amdgcn_rcpf(gf[4 + j]); } }
            asm volatile("" ::: "memory"); }
    }
    __device__ __forceinline__ void operator()(f32x4 (&acc)[2][2][4][2], const pg8::Unit& u, int wr, int wc, int fr, int fq) const {
        const int row0 = u.pm * 256 + wr * 64 + fr, col0 = u.pn * 256 + wc * 32 + 8 * fq;
#pragma unroll
        for (int ai = 0; ai < 2; ++ai) { u32x4 wf[4][2];
#pragma unroll
            for (int m = 0; m < 4; ++m)
#pragma unroll
                for (int bj = 0; bj < 2; ++bj) wf[m][bj] = *(const u32x4*)(G + (size_t)(row0 + ai * 128 + m * 16) * 4096 + 2048 + col0 + bj * 128);
#pragma unroll
            for (int m = 0; m < 4; ++m) { const size_t r = (size_t)(row0 + ai * 128 + m * 16);
#pragma unroll
                for (int bj = 0; bj < 2; ++bj) { float gf[8]; unpack8(wf[m][bj], gf);
                    const f32x4 v0 = acc[ai][bj][m][0], v1 = acc[ai][bj][m][1];
                    u32x4 w; w.x = pg8::cvt_pk_bf16(v0[0] * gf[0], v0[1] * gf[1]); w.y = pg8::cvt_pk_bf16(v0[2] * gf[2], v0[3] * gf[3]); w.z = pg8::cvt_pk_bf16(v1[0] * gf[4], v1[1] * gf[5]); w.w = pg8::cvt_pk_bf16(v1[2] * gf[6], v1[3] * gf[7]);
                    *(u32x4*)(O + r * 2048 + col0 + bj * 128) = w; } }
            asm volatile("" ::: "memory"); }
    }
};
struct EpiOut {
    static constexpr bool PERM = false, HAS_MID = false;
    const float* X; float* O;
    __device__ __forceinline__ void mid(f32x4 (&)[2][2][4][2], const pg8::Unit&, int, int, int, int) const {}
    __device__ __forceinline__ void operator()(f32x4 (&acc)[2][2][4][2], const pg8::Unit& u, int wr, int wc, int fr, int fq) const {
        const int row0 = u.pm * 256 + wr * 64 + fr, col0 = u.pn * 256 + wc * 32 + 4 * fq;
#pragma unroll
        for (int ai = 0; ai < 2; ++ai) { f32x4 xv[4][2][2];
#pragma unroll
            for (int m = 0; m < 4; ++m) { const size_t off = (size_t)(row0 + ai * 128 + m * 16) * DM + col0;
#pragma unroll
                for (int bj = 0; bj < 2; ++bj)
#pragma unroll
                    for (int n = 0; n < 2; ++n) xv[m][bj][n] = *(const f32x4*)(X + off + bj * 128 + n * 16); }
#pragma unroll
            for (int m = 0; m < 4; ++m) { const size_t off = (size_t)(row0 + ai * 128 + m * 16) * DM + col0;
#pragma unroll
                for (int bj = 0; bj < 2; ++bj)
#pragma unroll
                    for (int n = 0; n < 2; ++n) *(f32x4*)(O + off + bj * 128 + n * 16) = xv[m][bj][n] + acc[ai][bj][m][n]; }
            asm volatile("" ::: "memory"); }
    }
};
struct EpiGateUp {
    static constexpr bool PERM = true, HAS_MID = false;
    bf16_t* ACT; const float* RSTL;
    __device__ __forceinline__ void mid(f32x4 (&)[2][2][4][2], const pg8::Unit&, int, int, int, int) const {}
    __device__ __forceinline__ void operator()(f32x4 (&acc)[2][2][4][2], const pg8::Unit& u, int wr, int wc, int fr, int fq) const {
        const int row0 = u.x0 + wr * 64 + fr, col0 = u.pn * 128 + wc * 32 + 8 * fq;
        float rrv[2][4];
#pragma unroll
        for (int ai = 0; ai < 2; ++ai)
#pragma unroll
            for (int m = 0; m < 4; ++m) rrv[ai][m] = RSTL[u.x1 + wr * 64 + fr + ai * 128 + m * 16];
#pragma unroll
        for (int ai = 0; ai < 2; ++ai)
#pragma unroll
            for (int m = 0; m < 4; ++m) { float o[8]; const float rr = rrv[ai][m];
#pragma unroll
                for (int n = 0; n < 2; ++n)
#pragma unroll
                    for (int j = 0; j < 4; ++j) { const float g = acc[ai][0][m][n][j] * rr, up = acc[ai][1][m][n][j] * rr; o[4 * n + j] = g * fast_sigmoid(g) * up; }
                u32x4 w; w.x = pg8::cvt_pk_bf16(o[0], o[1]); w.y = pg8::cvt_pk_bf16(o[2], o[3]); w.z = pg8::cvt_pk_bf16(o[4], o[5]); w.w = pg8::cvt_pk_bf16(o[6], o[7]);
                *(u32x4*)(ACT + (size_t)(row0 + ai * 128 + m * 16) * DEXP + col0) = w; }
    }
};
struct EpiDown {
    static constexpr bool PERM = true, HAS_MID = false;
    bf16_t* Y; const float* GATE;
    __device__ __forceinline__ void mid(f32x4 (&)[2][2][4][2], const pg8::Unit&, int, int, int, int) const {}
    __device__ __forceinline__ void operator()(f32x4 (&acc)[2][2][4][2], const pg8::Unit& u, int wr, int wc, int fr, int fq) const {
        const int rl0 = wr * 64 + fr, col0 = u.pn * 256 + wc * 32 + 8 * fq;
        float gtv[2][4];
#pragma unroll
        for (int ai = 0; ai < 2; ++ai)
#pragma unroll
            for (int m = 0; m < 4; ++m) gtv[ai][m] = GATE[u.x1 + rl0 + ai * 128 + m * 16];
#pragma unroll
        for (int ai = 0; ai < 2; ++ai)
#pragma unroll
            for (int m = 0; m < 4; ++m) { const int rl = rl0 + ai * 128 + m * 16; const float gt = gtv[ai][m];
#pragma unroll
                for (int bj = 0; bj < 2; ++bj) { const f32x4 v0 = acc[ai][bj][m][0] * gt, v1 = acc[ai][bj][m][1] * gt;
                    u32x4 w; w.x = pg8::cvt_pk_bf16(v0[0], v0[1]); w.y = pg8::cvt_pk_bf16(v0[2], v0[3]); w.z = pg8::cvt_pk_bf16(v1[0], v1[1]); w.w = pg8::cvt_pk_bf16(v1[2], v1[3]);
                    *(u32x4*)(Y + (size_t)(u.x0 + rl) * DM + col0 + bj * 128) = w; } }
    }
};
struct MoeOrder {
    const char* Abase; const char* Bbase; size_t Bstride; int K, nN, G, c; bool gather;
    const PG8_LAS int* ps;
    const unsigned* cnt; const int* TOK; bool xcdm;
    __device__ static int tile_of(int i, int c, int G, int nN, int nb, int& pn, bool xcdm) {
        const int S = (G / 8) / nN;
        if (!xcdm || G % 8 != 0 || S < 1) { const int L = i * G + c; pn = L % nN; return L / nN < nb ? L / nN : -1; }
        const int x = c % 8, slot = c / 8; pn = slot % nN;
        if (slot >= S * nN) return -1;
        const int sidx = i * (8 * S) + x * S + slot / nN; return sidx < nb ? sidx : -1;
    }
    __device__ bool next(int i, pg8::Unit& u) const {
        int pn; const int sidx = tile_of(i, c, G, nN, ps[NEXP + 2], pn, xcdm); if (sidx < 0) return false;
        const int prow = ps[40 + sidx], info = ps[40 + MT_MAX + sidx], valid = ps[40 + 2 * MT_MAX + sidx];
        const int e = info >> 16, mt = info & 0xffff;
        u.pm = mt; u.pn = pn; u.x0 = prow; u.x1 = e * T + mt * MTILE; u.x2 = valid; u.x3 = e;
        u.A = gather ? Abase : Abase + (size_t)prow * K * 2; u.B = Bbase + (size_t)e * Bstride + (size_t)pn * 256 * K * 2; return true;
    }
    __device__ __forceinline__ void rows(const pg8::Unit& u, unsigned (&g)[2][2], const int (&RA)[2]) const {
#pragma unroll
        for (int h = 0; h < 2; ++h)
#pragma unroll
            for (int i = 0; i < 2; ++i) { int r = RA[i] + 128 * h; r = r < u.x2 ? r : u.x2 - 1; g[h][i] = (unsigned)TOK[u.x1 + r] * (unsigned)(K * 2); }
    }
};

struct TItem { const float* src; bf16_t* dst; int ld_src, ld_dst; };
__device__ __forceinline__ void titem_load(const TItem& t, f32x4 (&v)[8], int lane) {
#pragma unroll
    for (int i = 0; i < 8; ++i) v[i] = *(const f32x4*)(t.src + (size_t)((lane >> 3) + 8 * i) * t.ld_src + 4 * (lane & 7));
}
__device__ __forceinline__ void titem_store(const TItem& t, const f32x4 (&v)[8], PG8_LAS float* scr, int lane) {
#pragma unroll
    for (int i = 0; i < 8; ++i) { PG8_LAS float* d = scr + ((lane >> 3) + 8 * i) * 33 + 4 * (lane & 7); d[0] = v[i].x; d[1] = v[i].y; d[2] = v[i].z; d[3] = v[i].w; }
    asm volatile("s_waitcnt lgkmcnt(0)" ::: "memory");
    const int c = lane & 7;
#pragma unroll
    for (int j = 0; j < 4; ++j) { const int n = (lane >> 3) + 8 * j; const PG8_LAS float* s = scr + (8 * c) * 33 + n;
        u32x4 o; o.x = pk2(s[0 * 33], s[1 * 33]); o.y = pk2(s[2 * 33], s[3 * 33]); o.z = pk2(s[4 * 33], s[5 * 33]); o.w = pk2(s[6 * 33], s[7 * 33]);
        *(u32x4*)(t.dst + (size_t)n * t.ld_dst + 8 * c) = o; }
    asm volatile("s_waitcnt lgkmcnt(0)" ::: "memory");
}
constexpr int TI0 = 32 * 288, TI1 = 16 * 64, TI2 = 16 * 64, TI3 = 32 * 64, TI4 = 32 * 512, TI5 = 32 * 512, TI6 = 32 * 512;
constexpr int TI_ALL = TI0 + TI1 + TI2 + TI3 + TI4 + TI5 + TI6;
#ifndef TAIL1_ITEMS
#define TAIL1_ITEMS (TI5)
#endif
__device__ __forceinline__ TItem titem_decode(const Args& A, int r) {
    bf16_t* WIN = (bf16_t*)(A.ws + WS_WIN); bf16_t* WPROJ = (bf16_t*)(A.ws + WS_WPROJ); bf16_t* WOUT = (bf16_t*)(A.ws + WS_WOUT); bf16_t* WGU = (bf16_t*)(A.ws + WS_WGU); bf16_t* WD = (bf16_t*)(A.ws + WS_WD);
    TItem t;
    if (r < TI0) { const int kb = r / 288, nb = r % 288; t.src = A.in[2] + (size_t)(64 * kb) * INCOLS + 32 * nb + (nb >= 160 ? 8 : 0); t.ld_src = INCOLS; t.dst = WIN + (size_t)(32 * nb) * 2048 + 64 * kb; t.ld_dst = 2048; return t; } r -= TI0;
    if (r < TI1) { const int kb = r / 64, nb = r % 64; t.src = A.in[11] + (size_t)(64 * kb) * DM + 32 * nb; t.ld_src = DM; t.dst = WPROJ + (size_t)(32 * nb) * 2048 + 64 * kb; t.ld_dst = 2048; return t; } r -= TI1;
    if (r < TI2) { const int kb = r / 64, nb = r % 64; t.src = A.in[12] + (size_t)(64 * kb) * DM + 32 * nb; t.ld_src = DM; t.dst = WPROJ + (size_t)(32 * nb) * 2048 + 1024 + 64 * kb; t.ld_dst = 2048; return t; } r -= TI2;
    if (r < TI3) { const int kb = r / 64, nb = r % 64; t.src = A.in[13] + (size_t)(64 * kb) * DM + 32 * nb; t.ld_src = DM; t.dst = WOUT + (size_t)(32 * nb) * 2048 + 64 * kb; t.ld_dst = 2048; return t; } r -= TI3;
    if (r < TI4 + TI5) { const int up = r >= TI4; if (up) r -= TI4; const int e = r / 512, q = r % 512, kb = q / 16, nb = q % 16, n = 32 * nb, drow = 256 * (n >> 7) + (n & 127) + (up ? 128 : 0);
        t.src = A.in[up ? 20 : 19] + (size_t)e * DM * DEXP + (size_t)(64 * kb) * DEXP + n; t.ld_src = DEXP; t.dst = WGU + ((size_t)e * 1024 + drow) * 2048 + 64 * kb; t.ld_dst = 2048; return t; } r -= TI4 + TI5;
    { const int e = r / 512, q = r % 512, kb = q / 64, nb = q % 64; t.src = A.in[21] + (size_t)e * DEXP * DM + (size_t)(64 * kb) * DM + 32 * nb; t.ld_src = DM; t.dst = WD + ((size_t)e * 2048 + 32 * nb) * 512 + 64 * kb; t.ld_dst = 512; return t; }
}
__device__ __forceinline__ void p0_weights(const Args& A, PG8_LAS unsigned char* lds, const int part, const int wrank, const int wcount) {
    const int tid = threadIdx.x, lane = tid & 63, wave = tid >> 6;
    PG8_LAS float* scr = (PG8_LAS float*)(lds + wave * 16384);
    if (wrank < 0 || wcount < 1) return;
    const int gw = wrank * NWAVES + wave, NGW = wcount * NWAVES;
    const int cut1 = TI_ALL - TI6 - TAIL1_ITEMS, cut2 = TI_ALL - TI6;
    const int it_lo = part == 0 ? 0 : (part == 1 ? cut1 : cut2), it_hi = part == 0 ? cut1 : (part == 1 ? cut2 : TI_ALL);
    int it = it_lo + gw; if (it >= it_hi) return;
    TItem cur = titem_decode(A, it); f32x4 va[8], vb[8];
    titem_load(cur, va, lane);
    for (;;) {
        const int itn = it + NGW; const bool more = itn < it_hi; TItem nx = cur;
        if (more) { nx = titem_decode(A, itn); titem_load(nx, vb, lane); }
        titem_store(cur, va, scr, lane);
        if (!more) break;
#pragma unroll
        for (int i = 0; i < 8; ++i) va[i] = vb[i];
        cur = nx; it = itn;
    }
}

__device__ __forceinline__ void p1_fast(const Args& A, PG8_LAS unsigned char* lds) {
    pg8::DenseOrder S; S.init(A.ws + WS_H, A.ws + WS_WIN, T, 9216, DM, gridDim.x, blockIdx.x, PROBE_REP_P1);
    EpiIn E{(bf16_t*)(A.ws + WS_U), (bf16_t*)(A.ws + WS_V), (bf16_t*)(A.ws + WS_Q), (bf16_t*)(A.ws + WS_K), (bf16_t*)(A.ws + WS_VA), (bf16_t*)(A.ws + WS_G), A.in[3], A.in[9], A.in[10], (float*)(A.ws + WS_VSTAT), lds};
    pg8::gemm_phase<EpiIn, pg8::DenseOrder, true, false>(lds, DM, S, E);
}
__device__ __forceinline__ void p3_fast(const Args& A, PG8_LAS unsigned char* lds) {
    pg8::DenseOrder S; S.init(A.ws + WS_MIXIN, A.ws + WS_WPROJ, T, DM, 2048, gridDim.x, blockIdx.x, PROBE_REP_P4);
    EpiProj E{(const bf16_t*)(A.ws + WS_G), (bf16_t*)(A.ws + WS_MIXED)};
    pg8::gemm_phase<EpiProj, pg8::DenseOrder, true, false>(lds, 2048, S, E);
}
__device__ __forceinline__ void p4_fast(const Args& A, PG8_LAS unsigned char* lds) {
    pg8::DenseOrder S; S.init(A.ws + WS_MIXED, A.ws + WS_WOUT, T, DM, DM, gridDim.x, blockIdx.x, PROBE_REP_P5);
    EpiOut E{A.in[0], A.out};
    pg8::gemm_phase<EpiOut, pg8::DenseOrder, true, false>(lds, DM, S, E);
}
__device__ __forceinline__ void moe_layout_lds(const Args& A, PG8_LAS unsigned char* lds) {
    PG8_LAS int* ps = (PG8_LAS int*)(lds + LDS_MISC_OFF); PG8_LAS int* tprow = ps + 40; PG8_LAS int* tinfo = tprow + MT_MAX; PG8_LAS int* tvalid = tinfo + MT_MAX;
    const unsigned* cnt = (const unsigned*)(A.ws + WS_CTL) + CW_CNT;
    if (threadIdx.x == 0) { int acc = 0;
        for (int e = 0; e < NEXP; ++e) { ps[e] = acc; acc += ((int)cnt[(e) * CNT_STRIDE] + MTILE - 1) / MTILE * MTILE; }
        ps[NEXP] = acc; ps[NEXP + 1] = acc / MTILE; }
    __syncthreads();
    const int nt = ps[NEXP + 1]; PG8_LAS int* uval = tvalid + MT_MAX;
    int prow = 0, e = 0, mt = 0, valid = 0;
    if ((int)threadIdx.x < nt) { prow = (int)threadIdx.x * MTILE;
        for (int j = 1; j < NEXP; ++j) if (ps[j] <= prow) e = j;
        mt = (prow - ps[e]) / MTILE; valid = (int)cnt[(e) * CNT_STRIDE] - mt * MTILE; valid = valid > MTILE ? MTILE : valid; uval[threadIdx.x] = valid; }
    __syncthreads();
    if ((int)threadIdx.x < nt) { int rank = 0;
        if (TINY_ROWS > 0) { for (int j = 0; j < nt; ++j) { const int vj = uval[j]; rank += (vj > valid || (vj == valid && j < (int)threadIdx.x)) ? 1 : 0; } } else rank = (int)threadIdx.x;
        tprow[rank] = prow; tinfo[rank] = (e << 16) | mt; tvalid[rank] = valid; }
    if (threadIdx.x == 0) { int nb = 0; for (int j = 0; j < nt; ++j) nb += uval[j] > TINY_ROWS ? 1 : 0; ps[NEXP + 2] = nb; }
    __syncthreads();
}
namespace sm {
typedef short bf16x8 __attribute__((ext_vector_type(8))); typedef float f32x16 __attribute__((ext_vector_type(16)));
constexpr int TINY = 64;
__device__ __forceinline__ void gateup_small(const Args& A, PG8_LAS unsigned char* lds) {
    const PG8_LAS int* ps = (const PG8_LAS int*)(lds + LDS_MISC_OFF); const int nt = ps[NEXP + 1], nbig = ps[NEXP + 2];
    const bf16_t* H2 = (const bf16_t*)(A.ws + WS_H2); const bf16_t* WGU = (const bf16_t*)(A.ws + WS_WGU); bf16_t* ACT = (bf16_t*)(A.ws + WS_ACT); const int* TOK = (const int*)(A.ws + WS_TOK);
    const int tid = threadIdx.x, lane = tid & 63, w = __builtin_amdgcn_readfirstlane(tid >> 6), r32 = lane & 31, hi = lane >> 5;
    PG8_LAS float* red = (PG8_LAS float*)lds;
    for (int su = blockIdx.x; su < (nt - nbig) * 16; su += gridDim.x) {
        const int sidx = nbig + (su >> 4), sl = su & 15; const int prow = ps[40 + sidx], info = ps[40 + MT_MAX + sidx], valid = ps[40 + 2 * MT_MAX + sidx];
        const int e = info >> 16, mt = info & 0xffff, lbase = e * T + mt * MTILE;
        const int ra = r32 < valid ? r32 : valid - 1, rb = 32 + r32 < valid ? 32 + r32 : valid - 1;
        const bf16_t* a0p = H2 + (size_t)TOK[lbase + ra] * DM + 256 * w + 8 * hi; const bf16_t* a1p = H2 + (size_t)TOK[lbase + rb] * DM + 256 * w + 8 * hi;
        const bf16_t* b0p = WGU + ((size_t)e * 1024 + 256 * (sl >> 2) + 32 * (sl & 3) + r32) * DM + 256 * w + 8 * hi; const bf16_t* b1p = b0p + (size_t)128 * DM;
        f32x16 acc[2][2];
#pragma unroll
        for (int i = 0; i < 2; ++i)
#pragma unroll
            for (int j = 0; j < 2; ++j)
#pragma unroll
                for (int r = 0; r < 16; ++r) acc[i][j][r] = 0.f;
#pragma unroll 4
        for (int ks = 0; ks < 16; ++ks) { const bf16x8 a0 = *(const bf16x8*)(a0p + 16 * ks), a1 = *(const bf16x8*)(a1p + 16 * ks), b0 = *(const bf16x8*)(b0p + 16 * ks), b1 = *(const bf16x8*)(b1p + 16 * ks);
            acc[0][0] = __builtin_amdgcn_mfma_f32_32x32x16_bf16(a0, b0, acc[0][0], 0, 0, 0); acc[0][1] = __builtin_amdgcn_mfma_f32_32x32x16_bf16(a0, b1, acc[0][1], 0, 0, 0);
            acc[1][0] = __builtin_amdgcn_mfma_f32_32x32x16_bf16(a1, b0, acc[1][0], 0, 0, 0); acc[1][1] = __builtin_amdgcn_mfma_f32_32x32x16_bf16(a1, b1, acc[1][1], 0, 0, 0); }
#pragma unroll
        for (int i = 0; i < 2; ++i)
#pragma unroll
            for (int j = 0; j < 2; ++j)
#pragma unroll
                for (int r = 0; r < 16; ++r) red[(((w * 2 + i) * 2 + j) * 16 + r) * 64 + lane] = acc[i][j][r];
        __syncthreads();
#pragma unroll
        for (int i = 0; i < 2; ++i)
#pragma unroll
            for (int rr = 0; rr < 2; ++rr) { const int r = 2 * w + rr; float g = 0.f, u = 0.f;
#pragma unroll
                for (int w2 = 0; w2 < 8; ++w2) { g += red[(((w2 * 2 + i) * 2 + 0) * 16 + r) * 64 + lane]; u += red[(((w2 * 2 + i) * 2 + 1) * 16 + r) * 64 + lane]; }
                const int row = 32 * i + (r & 3) + 8 * (r >> 2) + 4 * hi; const float rr2 = ((const float*)(A.ws + WS_RSTL))[lbase + (row < valid ? row : valid - 1)]; g *= rr2; u *= rr2;
                ACT[(size_t)(prow + row) * DEXP + 32 * sl + r32] = f2bf(g * fast_sigmoid(g) * u); }
        __syncthreads();
    }
}
__device__ __forceinline__ void down_small(const Args& A, PG8_LAS unsigned char* lds) {
    const PG8_LAS int* ps = (const PG8_LAS int*)(lds + LDS_MISC_OFF); const int nt = ps[NEXP + 1], nbig = ps[NEXP + 2];
    const bf16_t* ACT = (const bf16_t*)(A.ws + WS_ACT); const bf16_t* WD = (const bf16_t*)(A.ws + WS_WD); bf16_t* Y = (bf16_t*)(A.ws + WS_YBUF); const float* GATE = (const float*)(A.ws + WS_GATE);
    const int tid = threadIdx.x, lane = tid & 63, w = __builtin_amdgcn_readfirstlane(tid >> 6), wn = w & 3, wk = w >> 2, r32 = lane & 31, hi = lane >> 5;
    PG8_LAS float* red = (PG8_LAS float*)lds;
    for (int su = blockIdx.x; su < (nt - nbig) * 16; su += gridDim.x) {
        const int sidx = nbig + (su >> 4), sl = su & 15; const int prow = ps[40 + sidx], info = ps[40 + MT_MAX + sidx], valid = ps[40 + 2 * MT_MAX + sidx];
        const int e = info >> 16, mt = info & 0xffff, lbase = e * T + mt * MTILE;
        const int ra = r32 < valid ? r32 : valid - 1, rb = 32 + r32 < valid ? 32 + r32 : valid - 1;
        const bf16_t* a0p = ACT + (size_t)(prow + ra) * DEXP + 256 * wk + 8 * hi; const bf16_t* a1p = ACT + (size_t)(prow + rb) * DEXP + 256 * wk + 8 * hi;
        const bf16_t* bp = WD + ((size_t)e * 2048 + 128 * sl + 32 * wn + r32) * DEXP + 256 * wk + 8 * hi;
        f32x16 acc[2];
#pragma unroll
        for (int i = 0; i < 2; ++i)
#pragma unroll
            for (int r = 0; r < 16; ++r) acc[i][r] = 0.f;
#pragma unroll 4
        for (int ks = 0; ks < 16; ++ks) { const bf16x8 a0 = *(const bf16x8*)(a0p + 16 * ks), a1 = *(const bf16x8*)(a1p + 16 * ks), b = *(const bf16x8*)(bp + 16 * ks);
            acc[0] = __builtin_amdgcn_mfma_f32_32x32x16_bf16(a0, b, acc[0], 0, 0, 0); acc[1] = __builtin_amdgcn_mfma_f32_32x32x16_bf16(a1, b, acc[1], 0, 0, 0); }
        if (wk == 1) {
#pragma unroll
            for (int i = 0; i < 2; ++i)
#pragma unroll
                for (int r = 0; r < 16; ++r) red[((wn * 2 + i) * 16 + r) * 64 + lane] = acc[i][r]; }
        __syncthreads();
        if (wk == 0) {
#pragma unroll
            for (int i = 0; i < 2; ++i)
#pragma unroll
                for (int r = 0; r < 16; ++r) { const int row = 32 * i + (r & 3) + 8 * (r >> 2) + 4 * hi; const float gt = GATE[lbase + (row < valid ? row : valid - 1)];
                    Y[(size_t)(prow + row) * DM + 128 * sl + 32 * wn + r32] = f2bf((acc[i][r] + red[((wn * 2 + i) * 16 + r) * 64 + lane]) * gt); } }
        __syncthreads();
    }
}
}

__device__ __forceinline__ void p6_fast(const Args& A, PG8_LAS unsigned char* lds) {
    moe_layout_lds(A, lds);
    MoeOrder S{(const char*)(A.ws + WS_H2), (const char*)(A.ws + WS_WGU), (size_t)1024 * 2048 * 2, DM, 4, (int)gridDim.x, (int)blockIdx.x, true,
               (const PG8_LAS int*)(lds + LDS_MISC_OFF), (const unsigned*)(A.ws + WS_CTL) + CW_CNT, (const int*)(A.ws + WS_TOK), XCDM_GU};
    EpiGateUp E{(bf16_t*)(A.ws + WS_ACT), (const float*)(A.ws + WS_RSTL)};
    pg8::gemm_phase<EpiGateUp, MoeOrder, true, true>(lds, DM, S, E);
    sm::gateup_small(A, lds);
    {
        PG8_LAS int* pw = (PG8_LAS int*)(lds + LDS_MISC_OFF) + 40 + 4 * MT_MAX;
        const int nb = ((const PG8_LAS int*)(lds + LDS_MISC_OFF))[NEXP + 2], G = (int)gridDim.x; int pn_;
        const int per = XCDM_GU ? 8 * ((G / 8) / 4) : G / 4, rounds = per > 0 ? (nb + per - 1) / per : 1;
        const int t = (int)threadIdx.x; const bool idle_t = t < G && MoeOrder::tile_of(rounds - 1, t, G, 4, nb, pn_, XCDM_GU) < 0;
        float before = (idle_t && t < (int)blockIdx.x) ? 1.f : 0.f, all = idle_t ? 1.f : 0.f;
        before = wave_sum(before); all = wave_sum(all);
        __syncthreads();
        if ((t & 63) == 0) { pw[2 + (t >> 6)] = (int)before; pw[10 + (t >> 6)] = (int)all; }
        __syncthreads();
        if (t == 0) { int rk = 0, tot = 0; for (int w = 0; w < NWAVES; ++w) { rk += pw[2 + w]; tot += pw[10 + w]; }
            const bool me_idle = MoeOrder::tile_of(rounds - 1, (int)blockIdx.x, G, 4, nb, pn_, XCDM_GU) < 0;
            pw[0] = tot == 0 ? (int)blockIdx.x : (me_idle ? rk : -1); pw[1] = tot == 0 ? G : tot; }
        __syncthreads();
        p0_weights(A, lds, 2, pw[0], pw[1]); }
}
__device__ __forceinline__ void p7_fast(const Args& A, PG8_LAS unsigned char* lds) {
    moe_layout_lds(A, lds);
    MoeOrder S{(const char*)(A.ws + WS_ACT), (const char*)(A.ws + WS_WD), (size_t)2048 * 512 * 2, DEXP, 8, (int)gridDim.x, (int)blockIdx.x, false,
               (const PG8_LAS int*)(lds + LDS_MISC_OFF), (const unsigned*)(A.ws + WS_CTL) + CW_CNT, (const int*)(A.ws + WS_TOK), true};
    EpiDown E{(bf16_t*)(A.ws + WS_YBUF), (const float*)(A.ws + WS_GATE)};
    pg8::gemm_phase<EpiDown, MoeOrder, true, false>(lds, DEXP, S, E);
    sm::down_small(A, lds);
}

namespace fa {
typedef short bf16x8 __attribute__((ext_vector_type(8)));
typedef short v4i16 __attribute__((ext_vector_type(4)));
typedef float f32x16 __attribute__((ext_vector_type(16)));
#define FA_LAS __attribute__((address_space(3)))
constexpr int KVBUF = 65536, LDS_CK = 131072, LDS_ML = 131072 + 8192;
__device__ __forceinline__ unsigned cvtpk(float lo, float hi) { unsigned r; asm("v_cvt_pk_bf16_f32 %0, %1, %2" : "=v"(r) : "v"(lo), "v"(hi)); return r; }
__device__ __forceinline__ bf16x8 pack8(const f32x16& p, int b) { u32x4 w; w.x = cvtpk(p[b], p[b + 1]); w.y = cvtpk(p[b + 2], p[b + 3]); w.z = cvtpk(p[b + 4], p[b + 5]); w.w = cvtpk(p[b + 6], p[b + 7]); return __builtin_bit_cast(bf16x8, w); }
__device__ __forceinline__ float swapmax(float v) { auto rr = __builtin_amdgcn_permlane32_swap(__float_as_uint(v), __float_as_uint(v), false, false); return fmaxf(__uint_as_float(rr[0]), __uint_as_float(rr[1])); }
__device__ __forceinline__ float swapsum(float v) { auto rr = __builtin_amdgcn_permlane32_swap(__float_as_uint(v), __float_as_uint(v), false, false); return __uint_as_float(rr[0]) + __uint_as_float(rr[1]); }
#define FA_WAITBAR() do { asm volatile("s_waitcnt vmcnt(0) lgkmcnt(0)" ::: "memory"); __builtin_amdgcn_s_barrier(); asm volatile("" ::: "memory"); } while (0)

__device__ __forceinline__ void attn_phase(const Args& A, FA_LAS unsigned char* lds) {
    const bf16_t* Q = (const bf16_t*)(A.ws + WS_Q); const bf16_t* Kt = (const bf16_t*)(A.ws + WS_K); const bf16_t* Vt = (const bf16_t*)(A.ws + WS_VA);
    const float* CKL = (const float*)(A.ws + WS_CKL); bf16_t* MIXIN = (bf16_t*)(A.ws + WS_MIXIN);
    const int tid = threadIdx.x, lane = tid & 63, wid = __builtin_amdgcn_readfirstlane(tid >> 6), rg = wid & 3, kh = wid >> 2, r32 = lane & 31, hi = lane >> 5;
    int koff[4];
#pragma unroll
    for (int i = 0; i < 4; ++i) { const int rl = 4 * i + (lane >> 4); koff[i] = rl * 1024 + (((lane & 15) ^ rl) * 8); }
    const int voff = (lane >> 4) * 1024 + (((lane & 15) ^ ((lane >> 4) << 2)) * 8);
    int kfo[8];
#pragma unroll
    for (int d0 = 0; d0 < 8; ++d0) kfo[d0] = (kh * 64 + r32) * 256 + (((2 * d0 + hi) ^ (r32 & 15)) * 16);
    int vfo[4];
    { const int dh = (lane >> 4) & 1, q = (lane & 15) >> 2, p = lane & 3;
#pragma unroll
      for (int db = 0; db < 4; ++db) vfo[db] = (kh * 64 + 4 * hi + q) * 256 + ((db ^ q) * 64) + dh * 32 + p * 8; }
    const unsigned ldsb = (unsigned)(uintptr_t)lds;
    const int G = gridDim.x;
    for (int vb0 = blockIdx.x; vb0 < 256 * PROBE_REP_ATTN; vb0 += G) { const int vb = vb0 % 256;
        const int item = (G % 8 == 0) ? ((vb % 8) * 32 + (vb / 8)) % 256 : vb;
        const int bh = item >> 3, ii = item & 7, b = bh >> 3, h = bh & 7;
        const bf16_t* Kg = Kt + (size_t)b * SEQ * 1024 + h * 128; const bf16_t* Vg = Vt + (size_t)b * SEQ * 1024 + h * 128;
        { const f32x4 c = *(const f32x4*)(CKL + (size_t)bh * SEQ + tid * 4); *(FA_LAS f32x4*)(lds + LDS_CK + tid * 16) = (f32x4){-c.x, -c.y, -c.z, -c.w}; }
#define FA_ISSUE_K(key0, kb_) do { const bf16_t* kg_ = Kg + (size_t)((key0) + 16 * wid) * 1024; \
        _Pragma("unroll") for (int i_ = 0; i_ < 4; ++i_) __builtin_amdgcn_global_load_lds((const unsigned*)(kg_ + koff[i_]), (FA_LAS unsigned*)(lds + (kb_) * 32768 + (wid * 4 + i_) * 1024), 16, 0, 0); } while (0)
#define FA_ISSUE_V(key0, vb_) do { const bf16_t* vg_ = Vg + (size_t)((key0) + 16 * wid) * 1024; \
        _Pragma("unroll") for (int i_ = 0; i_ < 4; ++i_) __builtin_amdgcn_global_load_lds((const unsigned*)(vg_ + i_ * 4096 + voff), (FA_LAS unsigned*)(lds + 65536 + (vb_) * 32768 + (wid * 4 + i_) * 1024), 16, 0, 0); } while (0)
#define FA_DSR128(dst, addr, off) asm volatile("ds_read_b128 %0, %1 offset:%2" : "=v"(dst) : "v"(addr), "n"(off))
#define FA_DSTR(dst, addr, off) asm volatile("ds_read_b64_tr_b16 %0, %1 offset:%2" : "=v"(dst) : "v"(addr), "n"(off))
#define FA_LGKM(n) asm volatile("s_waitcnt lgkmcnt(" #n ")" ::: "memory")
#define FA_SB() __builtin_amdgcn_sched_barrier(0)
#define FA_QK_STEP(i, P0, P1, W) do { FA_LGKM(W); FA_SB(); \
        if (((i) & 1) == 0) P0 = __builtin_amdgcn_mfma_f32_32x32x16_bf16(kr[(i) & 3], qf[(i) >> 1], P0, 0, 0, 0); else P1 = __builtin_amdgcn_mfma_f32_32x32x16_bf16(kr[(i) & 3], qf[(i) >> 1], P1, 0, 0, 0); \
        FA_SB(); if ((i) + 4 < 16) FA_DSR128(kr[(i) & 3], ka_[((i) + 4) >> 1], (((i) + 4) & 1) * 8192); } while (0)
#define FA_QK(P0, P1, kbuf, kbk) do { FA_LAS const float* nck = (FA_LAS const float*)(lds + LDS_CK) + (kbk) * 128 + kh * 64 + 4 * hi; \
        _Pragma("unroll") for (int g_ = 0; g_ < 4; ++g_) { const f32x4 t0 = *(FA_LAS const f32x4*)(nck + 8 * g_), t1 = *(FA_LAS const f32x4*)(nck + 32 + 8 * g_); \
            _Pragma("unroll") for (int j_ = 0; j_ < 4; ++j_) { P0[4 * g_ + j_] = t0[j_]; P1[4 * g_ + j_] = t1[j_]; } } \
        unsigned ka_[8]; _Pragma("unroll") for (int d0 = 0; d0 < 8; ++d0) ka_[d0] = ldsb + (unsigned)((kbuf) * 32768 + kfo[d0]); \
        bf16x8 kr[4]; FA_SB(); FA_DSR128(kr[0], ka_[0], 0); FA_DSR128(kr[1], ka_[0], 8192); FA_DSR128(kr[2], ka_[1], 0); FA_DSR128(kr[3], ka_[1], 8192); \
        FA_QK_STEP(0, P0, P1, 3); FA_QK_STEP(1, P0, P1, 3); FA_QK_STEP(2, P0, P1, 3); FA_QK_STEP(3, P0, P1, 3); FA_QK_STEP(4, P0, P1, 3); FA_QK_STEP(5, P0, P1, 3); FA_QK_STEP(6, P0, P1, 3); FA_QK_STEP(7, P0, P1, 3); \
        FA_QK_STEP(8, P0, P1, 3); FA_QK_STEP(9, P0, P1, 3); FA_QK_STEP(10, P0, P1, 3); FA_QK_STEP(11, P0, P1, 3); FA_QK_STEP(12, P0, P1, 3); FA_QK_STEP(13, P0, P1, 2); FA_QK_STEP(14, P0, P1, 1); FA_QK_STEP(15, P0, P1, 0); } while (0)
#define FA_PV_STEP(i, W) do { FA_LGKM(W); FA_SB(); \
        { const bf16x8 vf_ = (bf16x8){vl[(i) & 1][0], vl[(i) & 1][1], vl[(i) & 1][2], vl[(i) & 1][3], vh[(i) & 1][0], vh[(i) & 1][1], vh[(i) & 1][2], vh[(i) & 1][3]}; \
          o[(i) >> 2] = __builtin_amdgcn_mfma_f32_32x32x16_bf16(vf_, pf[(i) & 3], o[(i) >> 2], 0, 0, 0); } \
        FA_SB(); if ((i) + 2 < 16) { FA_DSTR(vl[(i) & 1], va_[((i) + 2) >> 2], (((i) + 2) & 3) * 4096); FA_DSTR(vh[(i) & 1], va_[((i) + 2) >> 2], (((i) + 2) & 3) * 4096 + 2048); } } while (0)
        const int qbL = 15 - ii, nsteps = 17;
#define FA_KB(s_) ((s_) <= qbL ? (s_) : ii - ((s_) - qbL - 1))
        int u = 0, qb = qbL, kb = 0, g = 0;
        FA_ISSUE_K(0, 0); FA_ISSUE_V(0, 0); FA_ISSUE_K(FA_KB(1) * 128, 1);
        bf16x8 qf[8]; f32x16 o[4]; float m = -1e30f, l = 0.f;
        { const bf16_t* qp = Q + (size_t)(b * SEQ + qb * 128 + rg * 32 + r32) * 1024 + h * 128 + 8 * hi;
#pragma unroll
          for (int d0 = 0; d0 < 8; ++d0) qf[d0] = *(const bf16x8*)(qp + 16 * d0); }
#pragma unroll
        for (int db = 0; db < 4; ++db)
#pragma unroll
            for (int r = 0; r < 16; ++r) o[db][r] = 0.f;
        FA_WAITBAR();
        f32x16 p0, p1, n0, n1;
        FA_QK(p0, p1, 0, 0);
        FA_WAITBAR();
        bool diag = false, lastb = false, done = false;
#define FA_SOFTPV(C0, C1) do { \
            if (diag) { const int qrel = rg * 32 + r32, k0 = kh * 64 + 4 * hi; \
                _Pragma("unroll") for (int r = 0; r < 16; ++r) { const int kr = k0 + (r & 3) + 8 * (r >> 2); if (kr > qrel) C0[r] = -INFINITY; if (kr + 32 > qrel) C1[r] = -INFINITY; } } \
            float mx = fmaxf(C0[0], C1[0]); \
            _Pragma("unroll") for (int r = 1; r < 16; ++r) mx = fmaxf(mx, fmaxf(C0[r], C1[r])); \
            mx = swapmax(mx); \
            const float mn = fmaxf(m, mx), alpha = __builtin_amdgcn_exp2f(m - mn); m = mn; \
            float ps = 0.f; \
            _Pragma("unroll") for (int r = 0; r < 16; ++r) { C0[r] = __builtin_amdgcn_exp2f(C0[r] - mn); C1[r] = __builtin_amdgcn_exp2f(C1[r] - mn); ps += C0[r] + C1[r]; } \
            l = l * alpha + ps; \
            if (!__all(alpha == 1.0f)) { \
                _Pragma("unroll") for (int db = 0; db < 4; ++db) _Pragma("unroll") for (int r = 0; r < 16; ++r) o[db][r] *= alpha; } \
            bf16x8 pf[4]; pf[0] = pack8(C0, 0); pf[1] = pack8(C0, 8); pf[2] = pack8(C1, 0); pf[3] = pack8(C1, 8); \
            { unsigned va_[4]; \
              _Pragma("unroll") for (int db = 0; db < 4; ++db) va_[db] = ldsb + (unsigned)(65536 + (g & 1) * 32768 + vfo[db]); \
              v4i16 vl[2], vh[2]; FA_SB(); FA_DSTR(vl[0], va_[0], 0); FA_DSTR(vh[0], va_[0], 2048); FA_DSTR(vl[1], va_[0], 4096); FA_DSTR(vh[1], va_[0], 4096 + 2048); \
              FA_PV_STEP(0, 2); FA_PV_STEP(1, 2); FA_PV_STEP(2, 2); FA_PV_STEP(3, 2); FA_PV_STEP(4, 2); FA_PV_STEP(5, 2); FA_PV_STEP(6, 2); FA_PV_STEP(7, 2); \
              FA_PV_STEP(8, 2); FA_PV_STEP(9, 2); FA_PV_STEP(10, 2); FA_PV_STEP(11, 2); FA_PV_STEP(12, 2); FA_PV_STEP(13, 2); FA_PV_STEP(14, 2); FA_PV_STEP(15, 0); } } while (0)
#define FA_STEP(C0, C1, N0, N1) do { \
            diag = (kb == qb); lastb = (u == 0 ? kb == qb : kb == 0); \
            if (g + 2 < nsteps) FA_ISSUE_K(FA_KB(g + 2) * 128, g & 1); \
            if (g + 1 < nsteps) FA_ISSUE_V(FA_KB(g + 1) * 128, (g + 1) & 1); \
            const int kbn_ = (u == 0 ? kb + 1 : kb - 1); \
            if (kh == 0 && !lastb) FA_QK(N0, N1, (g + 1) & 1, kbn_); \
            FA_SOFTPV(C0, C1); \
            if (kh == 1 && !lastb) FA_QK(N0, N1, (g + 1) & 1, kbn_); \
            FA_WAITBAR(); } while (0)
#define FA_UNIT_END() do { \
            FA_LAS float* mb = (FA_LAS float*)(lds + 65536 + (g & 1) * 32768) + rg * 2048; FA_LAS float* ml = (FA_LAS float*)(lds + LDS_ML) + rg * 128; \
            const float lt = swapsum(l); \
            if (kh == 1) { ml[lane] = m; ml[64 + lane] = lt; } \
            float s1 = 0.f, s2m = 0.f; \
            _Pragma("unroll") for (int half = 0; half < 2; ++half) { \
                if (kh == 1) { \
                    _Pragma("unroll") for (int d2 = 0; d2 < 2; ++d2) _Pragma("unroll") for (int r = 0; r < 16; ++r) mb[(d2 * 16 + r) * 64 + lane] = o[2 * half + d2][r]; } \
                FA_WAITBAR(); \
                if (kh == 0) { \
                    if (half == 0) { const float m2 = ml[lane], l2 = ml[64 + lane], mm = fmaxf(m, m2), a1 = __builtin_amdgcn_exp2f(m - mm), a2 = __builtin_amdgcn_exp2f(m2 - mm); \
                        const float inv = 1.0f / (lt * a1 + l2 * a2); s1 = a1 * inv; s2m = a2 * inv; } \
                    bf16_t* op = MIXIN + (size_t)(b * SEQ + qb * 128 + rg * 32 + r32) * 2048 + 1024 + h * 128 + 4 * hi; \
                    _Pragma("unroll") for (int d2 = 0; d2 < 2; ++d2) _Pragma("unroll") for (int g4 = 0; g4 < 4; ++g4) { float v[4]; \
                        _Pragma("unroll") for (int j = 0; j < 4; ++j) v[j] = o[2 * half + d2][4 * g4 + j] * s1 + mb[(d2 * 16 + 4 * g4 + j) * 64 + lane] * s2m; \
                        u32x2 w; w.x = cvtpk(v[0], v[1]); w.y = cvtpk(v[2], v[3]); *(u32x2*)(op + 32 * (2 * half + d2) + 8 * g4) = w; } } \
                FA_WAITBAR(); } \
            if (u == 1) { done = true; } else { \
                u = 1; qb = ii; kb = ii; ++g; \
                { const bf16_t* qp = Q + (size_t)(b * SEQ + qb * 128 + rg * 32 + r32) * 1024 + h * 128 + 8 * hi; \
                  _Pragma("unroll") for (int d0 = 0; d0 < 8; ++d0) qf[d0] = *(const bf16x8*)(qp + 16 * d0); } \
                _Pragma("unroll") for (int db = 0; db < 4; ++db) _Pragma("unroll") for (int r = 0; r < 16; ++r) o[db][r] = 0.f; \
                m = -1e30f; l = 0.f; \
                FA_QK(p0, p1, g & 1, kb); \
                FA_WAITBAR(); } } while (0)
        for (;;) {
            FA_STEP(p0, p1, n0, n1);
            if (lastb) { FA_UNIT_END(); if (done) break; continue; }
            kb += (u == 0 ? 1 : -1); ++g; p0 = n0; p1 = n1;
        }
#undef FA_SOFTPV
#undef FA_STEP
#undef FA_UNIT_END
#undef FA_ISSUE_K
#undef FA_ISSUE_V
#undef FA_QK
#undef FA_QK_STEP
#undef FA_PV_STEP
#undef FA_KB
    }
}
}

namespace fs {
#define FS_LAS __attribute__((address_space(3)))
__device__ __forceinline__ void sgu_phase(const Args& A, FS_LAS unsigned char* lds) {
    const bf16_t* U = (const bf16_t*)(A.ws + WS_U); const bf16_t* V = (const bf16_t*)(A.ws + WS_V); bf16_t* MIXIN = (bf16_t*)(A.ws + WS_MIXIN);
    const float* wsp = A.in[7]; const float* bsp = A.in[8]; const float* ln_g = A.in[5]; const float* ln_b = A.in[6]; const float* VSTAT = (const float*)(A.ws + WS_VSTAT);
    const int tid = threadIdx.x, lane = tid & 63, wid = __builtin_amdgcn_readfirstlane(tid >> 6), tb = wid & 3, dh = wid >> 2, r32 = lane & 31, hi = lane >> 5;
    const int frow = tid >> 2, fq4 = tid & 3;
    int vfo[2];
    { const int d16 = (lane >> 4) & 1, q = (lane & 15) >> 2, p = lane & 3;
#pragma unroll
      for (int j = 0; j < 2; ++j) vfo[j] = 32768 + (8 * hi + q) * 256 + (((2 * dh + j) ^ q) * 64) + d16 * 32 + p * 8; }
    const int wfo = (32 * tb + r32) * 256;
    const int NU = (T / CHUNK) * NG * PROBE_REP_SGU, UM = (T / CHUNK) * NG;
    f32x4 wa[4], wb[4], pa, pb, nwa[4], nwb[4], npa, npb; u32x4 vv[4], nvv[4];
#define FS_LOAD(u0_, WA, WB, VV, PA, PB) do { const int u_ = (u0_) % UM, rc_ = u_ / NG, g_ = u_ % NG, row0_ = rc_ * CHUNK; \
        const float* wr_ = wsp + ((size_t)g_ * CHUNK + frow) * CHUNK + fq4 * 32; const bf16_t* vr_ = V + (size_t)(row0_ + frow) * 1024 + g_ * 128 + fq4 * 32; \
        _Pragma("unroll") for (int c = 0; c < 4; ++c) { WA[c] = *(const f32x4*)(wr_ + 8 * c); WB[c] = *(const f32x4*)(wr_ + 8 * c + 4); VV[c] = *(const u32x4*)(vr_ + 8 * c); } \
        PA = *(const f32x4*)(VSTAT + ((size_t)(row0_ + frow) * 16 + 4 * fq4) * 2); PB = *(const f32x4*)(VSTAT + ((size_t)(row0_ + frow) * 16 + 4 * fq4) * 2 + 4); } while (0)
    int u0 = blockIdx.x;
    if (u0 < NU) FS_LOAD(u0, wa, wb, vv, pa, pb);
    for (; u0 < NU; u0 += gridDim.x) { const int u = u0 % UM;
        const int rc = u / NG, g = u % NG, row0 = rc * CHUNK;
        {
#pragma unroll
          for (int c = 0; c < 4; ++c) { const f32x4 a = wa[c], b2 = wb[c]; const int s0 = fq4 * 32 + 8 * c; float v[8] = {a.x, a.y, a.z, a.w, b2.x, b2.y, b2.z, b2.w};
#pragma unroll
              for (int j = 0; j < 8; ++j) if (s0 + j > frow) v[j] = 0.f;
              u32x4 w; w.x = pk2(v[0], v[1]); w.y = pk2(v[2], v[3]); w.z = pk2(v[4], v[5]); w.w = pk2(v[6], v[7]);
              *(FS_LAS u32x4*)(lds + frow * 256 + (((4 * fq4 + c) ^ (frow & 15)) * 16)) = w; }
          float mean, rstd;
          { float s1 = (pa[0] + pa[2]) + (pb[0] + pb[2]), s2 = (pa[1] + pa[3]) + (pb[1] + pb[3]);
            s1 += __shfl_xor(s1, 1); s1 += __shfl_xor(s1, 2); s2 += __shfl_xor(s2, 1); s2 += __shfl_xor(s2, 2);
            mean = s1 * (1.f / 1024.f); rstd = rsqrtf(fmaxf(s2 * (1.f / 1024.f) - mean * mean, 0.f) + EPS); }
#pragma unroll
          for (int c = 0; c < 4; ++c) { const u32x4 w = vv[c]; const int cb = g * 128 + fq4 * 32 + 8 * c;
              const f32x4 ga = *(const f32x4*)(ln_g + cb), gb = *(const f32x4*)(ln_g + cb + 4), ba = *(const f32x4*)(ln_b + cb), bb = *(const f32x4*)(ln_b + cb + 4);
              float v[8];
#pragma unroll
              for (int e2 = 0; e2 < 4; ++e2) { v[2 * e2] = __uint_as_float(w[e2] << 16); v[2 * e2 + 1] = __uint_as_float(w[e2] & 0xffff0000u); }
              u32x4 o; o.x = pk2((v[0] - mean) * rstd * ga[0] + ba[0], (v[1] - mean) * rstd * ga[1] + ba[1]); o.y = pk2((v[2] - mean) * rstd * ga[2] + ba[2], (v[3] - mean) * rstd * ga[3] + ba[3]);
              o.z = pk2((v[4] - mean) * rstd * gb[0] + bb[0], (v[5] - mean) * rstd * gb[1] + bb[1]); o.w = pk2((v[6] - mean) * rstd * gb[2] + bb[2], (v[7] - mean) * rstd * gb[3] + bb[3]);
              *(FS_LAS u32x4*)(lds + 32768 + frow * 256 + (((4 * fq4 + c) ^ ((frow & 3) << 2)) * 16)) = o; } }
        __syncthreads();
        const bool more = u0 + (int)gridDim.x < NU;
        if (more) FS_LOAD(u0 + (int)gridDim.x, nwa, nwb, nvv, npa, npb);
        const int tt = 32 * tb + r32; const float bb = bsp[g * CHUNK + tt]; const size_t rw = (size_t)(row0 + tt);
        u32x2 uu[2][4];
#pragma unroll
        for (int j = 0; j < 2; ++j)
#pragma unroll
            for (int g4 = 0; g4 < 4; ++g4) uu[j][g4] = *(const u32x2*)(U + rw * 1024 + g * 128 + 32 * (2 * dh + j) + 8 * g4 + 4 * hi);
        fa::f32x16 acc[2];
#pragma unroll
        for (int j = 0; j < 2; ++j)
#pragma unroll
            for (int r = 0; r < 16; ++r) acc[j][r] = 0.f;
        for (int s = 0; s <= 2 * tb + 1; ++s) {
            const fa::bf16x8 wf = *(FS_LAS const fa::bf16x8*)(lds + wfo + (((2 * s + hi) ^ (r32 & 15)) * 16));
#pragma unroll
            for (int j = 0; j < 2; ++j) {
                const fa::v4i16 lo = __builtin_amdgcn_ds_read_tr16_b64_v4i16((FS_LAS fa::v4i16*)(lds + vfo[j] + s * 4096));
                const fa::v4i16 hh = __builtin_amdgcn_ds_read_tr16_b64_v4i16((FS_LAS fa::v4i16*)(lds + vfo[j] + s * 4096 + 1024));
                const fa::bf16x8 vf = (fa::bf16x8){lo[0], lo[1], lo[2], lo[3], hh[0], hh[1], hh[2], hh[3]};
                acc[j] = __builtin_amdgcn_mfma_f32_32x32x16_bf16(vf, wf, acc[j], 0, 0, 0); }
        }
#pragma unroll
        for (int j = 0; j < 2; ++j)
#pragma unroll
            for (int g4 = 0; g4 < 4; ++g4) { const int d = 32 * (2 * dh + j) + 8 * g4 + 4 * hi; const u32x2 u2 = uu[j][g4];
                const float u0f = __uint_as_float(u2.x << 16), u1 = __uint_as_float(u2.x & 0xffff0000u), u2f = __uint_as_float(u2.y << 16), u3 = __uint_as_float(u2.y & 0xffff0000u);
                u32x2 w; w.x = fa::cvtpk(u0f * (acc[j][4 * g4] + bb), u1 * (acc[j][4 * g4 + 1] + bb)); w.y = fa::cvtpk(u2f * (acc[j][4 * g4 + 2] + bb), u3 * (acc[j][4 * g4 + 3] + bb));
                *(u32x2*)(MIXIN + rw * 2048 + g * 128 + d) = w; }
        __syncthreads();
        if (more) {
#pragma unroll
            for (int c = 0; c < 4; ++c) { wa[c] = nwa[c]; wb[c] = nwb[c]; vv[c] = nvv[c]; }
            pa = npa; pb = npb; }
    }
#undef FS_LOAD
}
}


#define XB_TMO      128
#define XB_XCNT(j)  (256  + 64 * (j))
#define XB_XSUB(j)  (1280 + 64 * (j))
#define XB_XGEN(j)  (2304 + 64 * (j))
#define XB_TOP      3328
#define XB_TOPGEN   3392
#define XCD_BAR_WORDS 3456
#define XB_SPIN_CAP (1u << 18)
#define XLAS __attribute__((address_space(3)))
__device__ __forceinline__ unsigned xb_ld(unsigned* p)              { return __hip_atomic_load(p, __ATOMIC_RELAXED, __HIP_MEMORY_SCOPE_AGENT); }
__device__ __forceinline__ unsigned xb_add(unsigned* p, unsigned v) { return __hip_atomic_fetch_add(p, v, __ATOMIC_RELAXED, __HIP_MEMORY_SCOPE_AGENT); }
__device__ __forceinline__ unsigned xb_xcc_id() { return (unsigned)__builtin_amdgcn_s_getreg((3 << 11) | 20) & 0xFu; }
#define XB_SPIN(cond, bar) do { unsigned _sp = 0; while (cond) { __builtin_amdgcn_s_sleep(1); \
    if ((++_sp & 255u) == 0u) { if (xb_ld(&(bar)[XB_TMO])) break; if (_sp > XB_SPIN_CAP) { atomicAdd(&(bar)[XB_TMO], 1u); break; } } } } while (0)
struct XcdBarrier { unsigned* bar; unsigned x; volatile XLAS unsigned* st; };
__device__ __forceinline__ XcdBarrier xcd_barrier_post(unsigned* bar, volatile XLAS unsigned* st) {
    XcdBarrier b; b.bar = bar; b.x = xb_xcc_id(); b.st = st;
    if (threadIdx.x == 0) (void)xb_add(&bar[XB_XCNT(b.x)], 1u);
    return b;
}
__device__ __forceinline__ void xcd_barrier_complete(unsigned* bar, unsigned x, unsigned& nloc, unsigned& nx) {
    const unsigned G = gridDim.x * gridDim.y * gridDim.z;
    unsigned sum, cnt, mine, sp = 0u;
    for (;;) {
        sum = 0u; cnt = 0u; mine = 0u;
#pragma unroll
        for (unsigned j = 0; j < 16; ++j) { const unsigned c = xb_ld(&bar[XB_XCNT(j)]); sum += c; cnt += (c > 0u) ? 1u : 0u; mine = (j == x) ? c : mine; }
        if (sum == G) break;
        __builtin_amdgcn_s_sleep(1);
        if ((++sp & 255u) == 0u) { if (xb_ld(&bar[XB_TMO])) break; if (sp > XB_SPIN_CAP) { atomicAdd(&bar[XB_TMO], 1u); break; } }
    }
    nloc = mine > 0u ? mine : 1u; nx = cnt > 0u ? cnt : 1u;
}
__device__ __forceinline__ void xcd_barrier(const XcdBarrier& b) {
    asm volatile("s_waitcnt vmcnt(0)" ::: "memory");
    __syncthreads();
    if (threadIdx.x == 0) {
        unsigned* bar = b.bar;
        __builtin_amdgcn_s_waitcnt(0);
        unsigned nloc = b.st[0], nx = b.st[1];
        if (nloc == 0u) { xcd_barrier_complete(bar, b.x, nloc, nx); b.st[0] = nloc; b.st[1] = nx; }
        const unsigned old = xb_add(&bar[XB_XSUB(b.x)], 1u);
        const unsigned gen = old / nloc;
        if (old + 1u == (gen + 1u) * nloc) {
            __builtin_amdgcn_fence(__ATOMIC_RELEASE, "agent");
            asm volatile("s_waitcnt vmcnt(0)" ::: "memory");
            const unsigned og = xb_add(&bar[XB_TOP], 1u);
            const unsigned tg = og / nx;
            if (og + 1u == (tg + 1u) * nx) xb_add(&bar[XB_TOPGEN], 1u);
            else XB_SPIN(xb_ld(&bar[XB_TOPGEN]) == tg, bar);
            __builtin_amdgcn_fence(__ATOMIC_ACQUIRE, "agent");
            xb_add(&bar[XB_XGEN(b.x)], 1u);
            asm volatile("s_waitcnt vmcnt(0)" ::: "memory");
        } else {
            XB_SPIN(xb_ld(&bar[XB_XGEN(b.x)]) == gen, bar);
            __builtin_amdgcn_fence(__ATOMIC_ACQUIRE, "agent");
            asm volatile("s_waitcnt vmcnt(0)" ::: "memory");
        }
    }
    __syncthreads();
}
constexpr int CW_BAR = 4096;
constexpr size_t CTL_ZERO_BYTES = 65536;
constexpr int LDS_BARST_OFF = LDS_BYTES - 16;

constexpr bool FAST_P1 = true, FAST_P3 = true, FAST_P4 = true, FAST_P6 = true, FAST_P7 = true;
constexpr bool FAST_ATTN = true, FAST_SGU = true;
constexpr bool FAST_ANY = FAST_P1 || FAST_P3 || FAST_P4 || FAST_P6 || FAST_P7;
constexpr int N_PHASES = 10;
__global__ void __launch_bounds__(NTHREADS, 2) fwd(Args A) {
    extern __shared__ __attribute__((aligned(16))) unsigned char lds[];
    float* ldsf = (float*)lds;
    const int lo = A.ph_lo, hi = A.ph_hi;
    if (threadIdx.x < 4) ((volatile XLAS unsigned*)((XLAS unsigned char*)lds + LDS_BARST_OFF))[threadIdx.x] = 0u;
    __syncthreads();
    XcdBarrier bar = xcd_barrier_post((unsigned*)(A.ws + WS_CTL) + CW_BAR, (volatile XLAS unsigned*)((XLAS unsigned char*)lds + LDS_BARST_OFF));
#define IN(k) (lo <= (k) && (k) < hi)
#define SEAM(k) do { if (IN(k) && IN((k) + 1)) xcd_barrier(bar); STAMP((k) + 1); } while (0)
    unsigned long long t_lo = 0, t_hi = 0;
#define STAMP(i) do { if (STAMP_PHASE >= 0) { if ((i) == STAMP_PHASE || (STAMP_PHASE == 98 && (i) == 0)) t_lo = __builtin_amdgcn_s_memrealtime(); if ((i) == STAMP_PHASE + 1 || (STAMP_PHASE == 98 && (i) == 9)) t_hi = __builtin_amdgcn_s_memrealtime(); } } while (0)
    STAMP(0);
    PG8_LAS unsigned char* l3 = (PG8_LAS unsigned char*)lds;
    if (IN(0)) { if (FAST_ANY) { p0_weights(A, l3, 0, (int)blockIdx.x, (int)gridDim.x); __syncthreads(); } p0_router_weights(A); p0_rows(A, ldsf); } SEAM(0);
    if (IN(1)) { if (FAST_P1 && FAST_ATTN && (int)blockIdx.x >= (int)gridDim.x - NB * NH) cumsum_bh(A, (int)blockIdx.x - ((int)gridDim.x - NB * NH), ldsf); if (FAST_P1) p1_fast(A, l3); else p1_naive(A, ldsf); if (FAST_ANY) { __syncthreads(); { const int r_ = 1152 % (int)gridDim.x; p0_weights(A, l3, 1, r_ == 0 ? (int)blockIdx.x : (int)blockIdx.x - r_, r_ == 0 ? (int)gridDim.x : (int)gridDim.x - r_); } } } SEAM(1);
    if (!(FAST_P1 && FAST_SGU && FAST_ATTN)) { if (IN(2)) { p1b_fix<0>(A, ldsf); } SEAM(2); }
    if (IN(3)) { if (FAST_SGU) fs::sgu_phase(A, l3); else p2_sgu_naive(A); if (FAST_ATTN) { __syncthreads(); fa::attn_phase(A, l3); } else p2_attn_naive(A, ldsf); } SEAM(3);
    if (IN(4)) { if (FAST_P3) p3_fast(A, l3); else p3_naive(A, ldsf); } SEAM(4);
    if (IN(5)) { if (FAST_P4) p4_fast(A, l3); else p4_naive(A, ldsf); } SEAM(5);
    if (IN(6)) { if (PROBE_ALT == 6) { p5_router3<1>(A, ldsf); __syncthreads(); } if (PROBE_ALT == 62) { p5_router3<2>(A, ldsf); __syncthreads(); } if (PROBE_ALT == 63) { p5_router3<3>(A, ldsf); __syncthreads(); } p5_router3<0>(A, ldsf); } SEAM(6);
    if (IN(7)) { if (FAST_P6) p6_fast(A, l3); else p6_naive(A, ldsf); } SEAM(7);
    if (IN(8)) { if (FAST_P7) p7_fast(A, l3); else p7_naive(A, ldsf); } SEAM(8);
    if (IN(9)) { if (PROBE_ALT == 9) { p8_combine<1>(A, ldsf); __syncthreads(); } p8_combine<0>(A, ldsf, STAMP_PHASE < 0 ? 0.f : (STAMP_PHASE == 99 ? 1.0f : (float)(t_hi - t_lo) * 0.01f * 0.001f * STAMP_SCALE)); }
#undef IN
#undef SEAM
}

#ifndef MK_N_LAUNCHES
#define MK_N_LAUNCHES 1
#endif
extern "C" void kernel_launch(void* const* d_in, const int* in_sizes, int n_in, void* d_out, int out_size, void* d_ws, size_t ws_size, hipStream_t stream) {
    static int grid = 0;
    if (grid == 0) {
        if (n_in != 22 || out_size != T * DM || ws_size < WS_END) { fprintf(stderr, "kernel_launch: unexpected shapes (n_in %d out %d ws %zu)\n", n_in, out_size, ws_size); grid = -1; return; }
        int dev = 0, cus = 0, per_cu = 0;
        hipGetDevice(&dev); hipDeviceGetAttribute(&cus, hipDeviceAttributeMultiprocessorCount, dev);
        hipFuncSetAttribute((const void*)fwd, hipFuncAttributeMaxDynamicSharedMemorySize, LDS_BYTES);
        hipOccupancyMaxActiveBlocksPerMultiprocessor(&per_cu, (const void*)fwd, NTHREADS, LDS_BYTES);
        if (per_cu < 1) { fprintf(stderr, "kernel_launch: occupancy query says %d blocks per CU\n", per_cu); per_cu = 1; }
        (void)hipGetLastError();
        grid = cus;
    }
    if (grid < 0) return;
    Args a{};
    for (int i = 0; i < 22; ++i) a.in[i] = (const float*)d_in[i];
    a.out = (float*)d_out; a.ws = (unsigned char*)d_ws;
    if (hipMemsetAsync((char*)d_ws + WS_CTL, 0, CTL_ZERO_BYTES, stream) != hipSuccess) { fprintf(stderr, "kernel_launch: memset failed\n"); return; }
    if (MK_N_LAUNCHES == 1) {
        a.ph_lo = 0; a.ph_hi = N_PHASES;
        hipLaunchKernelGGL(fwd, dim3(grid), dim3(NTHREADS), LDS_BYTES, stream, a);
    } else {
        for (int p = 0; p < N_PHASES; ++p) { a.ph_lo = p; a.ph_hi = p + 1; hipLaunchKernelGGL(fwd, dim3(grid), dim3(NTHREADS), LDS_BYTES, stream, a); }
    }
}
```

```cpp
#include <hip/hip_runtime.h>
#include <hip/hip_cooperative_groups.h>
#include <cstdio>
#include <cstdint>
namespace cg = cooperative_groups;

#ifndef STAMP_PHASE
#define STAMP_PHASE -1
#endif
#ifndef STAMP_SEL
#define STAMP_SEL 0
#endif
#ifndef STAMP_SCALE
#define STAMP_SCALE 0.5f
#endif
#ifndef PROBE_REP_P1
#define PROBE_REP_P1 1
#endif
#ifndef PROBE_REP_P4
#define PROBE_REP_P4 1
#endif
#ifndef PROBE_REP_P5
#define PROBE_REP_P5 1
#endif
#ifndef PROBE_REP_MOE
#define PROBE_REP_MOE 1
#endif
#ifndef PROBE_REP_ATTN
#define PROBE_REP_ATTN 1
#endif
#ifndef PROBE_REP_SGU
#define PROBE_REP_SGU 1
#endif
#ifndef PROBE_ATTN_VAR
#define PROBE_ATTN_VAR 0
#endif
#ifndef PROBE_ALT
#define PROBE_ALT -1
#endif
constexpr int T = 8192, SEQ = 2048, NB = 4, DM = 2048, SGUW = 1024, FOXW = 1024, NH = 8, HD = 128, CHUNK = 128, NG = 8;
constexpr int INCOLS = 9224, OFF_F = 5120, OFF_GATE = 5128;
constexpr int NEXP = 32, EPG = 8, NGRP = 4, DEXP = 512;
constexpr float EPS = 1e-6f;
constexpr float LOG2E = 1.4426950408889634f;
constexpr float QSCALE = 0.08838834764831845f * LOG2E;
constexpr int NTHREADS = 512, NWAVES = 8;
constexpr int LDS_BYTES = 160 * 1024;
constexpr int MTILE = 256;
constexpr int PMAX = 2 * T + NEXP * MTILE;
constexpr int MT_MAX = PMAX / MTILE;
constexpr bool XCDM_GU = true;
constexpr int TINY_ROWS = 0;

typedef unsigned short bf16_t;
typedef float f32x4 __attribute__((ext_vector_type(4)));
typedef unsigned u32x4 __attribute__((ext_vector_type(4)));
typedef unsigned u32x2 __attribute__((ext_vector_type(2)));

constexpr size_t MiB = 1u << 20;
constexpr size_t WS_CTL = 0;
constexpr size_t WS_LOGF = 1 * MiB;
constexpr size_t WS_CKL = 2 * MiB;
constexpr size_t WS_TOK = 3 * MiB;
constexpr size_t WS_GATE = 4 * MiB;
constexpr size_t WS_ASG = 5 * MiB;
constexpr size_t WS_WIN = 8 * MiB;
constexpr size_t WS_WPROJ = 44 * MiB;
constexpr size_t WS_WOUT = 52 * MiB;
constexpr size_t WS_WGU = 60 * MiB;
constexpr size_t WS_WD = 188 * MiB;
constexpr size_t WS_H = 252 * MiB;
constexpr size_t WS_MIXED = WS_H;
constexpr size_t WS_U = 284 * MiB;
constexpr size_t WS_V = 300 * MiB;
constexpr size_t WS_G = 316 * MiB;
constexpr size_t WS_YBUF = WS_U;
constexpr size_t WS_Q = 380 * MiB;
constexpr size_t WS_K = 396 * MiB;
constexpr size_t WS_VA = 412 * MiB;
constexpr size_t WS_ACT = WS_Q;
constexpr size_t WS_MIXIN = 428 * MiB;
constexpr size_t WS_H2 = WS_MIXIN;
constexpr size_t WS_END = 460 * MiB;
static_assert((size_t)PMAX * 2048 * 2 <= 96 * MiB && (size_t)PMAX * 512 * 2 <= 32 * MiB, "overlay sizes");

constexpr int CW_CNT = 0;
constexpr int CNT_STRIDE = 64;

__device__ __forceinline__ float bf2f(bf16_t v) { return __uint_as_float((unsigned)v << 16); }
__device__ __forceinline__ bf16_t f2bf(float f) { unsigned u = __float_as_uint(f); return (bf16_t)((u + 0x7fffu + ((u >> 16) & 1u)) >> 16); }
__device__ __forceinline__ unsigned pk2(float lo, float hi) { return (unsigned)f2bf(lo) | ((unsigned)f2bf(hi) << 16); }
__device__ __forceinline__ unsigned cvtpk_rne(float lo, float hi) { unsigned r; asm("v_cvt_pk_bf16_f32 %0, %1, %2" : "=v"(r) : "v"(lo), "v"(hi)); return r; }
__device__ __forceinline__ float wave_sum(float v) {
#pragma unroll
    for (int o = 1; o < 64; o <<= 1) v += __shfl_xor(v, o);
    return v;
}
__device__ __forceinline__ float wave_max(float v) {
#pragma unroll
    for (int o = 1; o < 64; o <<= 1) v = fmaxf(v, __shfl_xor(v, o));
    return v;
}
__device__ __forceinline__ float gelu_tanh(float x) {
    const float c = 0.7978845608028654f; const float y = c * (x + 0.044715f * x * x * x);
    return x / (1.0f + __expf(-2.0f * y));
}
__device__ __forceinline__ float sigmoidf_(float x) { return 1.0f / (1.0f + __expf(-x)); }
__device__ __forceinline__ float log_sigmoid(float z) { return fminf(z, 0.f) - log1pf(__expf(-fabsf(z))); }

struct Args {
    const float* in[22];
    float* out;
    unsigned char* ws;
    int ph_lo, ph_hi;
};

template <class AF, class BF, class EF>
__device__ __forceinline__ void naive_gemm_tile(float* lds, int m0, int n0, int M, int N, int K, int Ksplit, AF a, BF b, EF epi) {
    float* As = lds;
    float* Bs = lds + 16 * 132;
    const int tid = threadIdx.x, ty = tid >> 4, tx = tid & 15;
    float acc[4][8], acc1[4][8];
#pragma unroll
    for (int i = 0; i < 4; ++i)
#pragma unroll
        for (int j = 0; j < 8; ++j) { acc[i][j] = 0.f; acc1[i][j] = 0.f; }
    const bool split = Ksplit < K;
#pragma unroll 1
    for (int pass = 0; pass < 2; ++pass) {
        const int kb = pass == 0 ? 0 : Ksplit, ke = pass == 0 ? (split ? Ksplit : K) : K;
        if (pass == 1) {
            if (!split) break;
#pragma unroll
            for (int i = 0; i < 4; ++i)
#pragma unroll
                for (int j = 0; j < 8; ++j) { acc1[i][j] = acc[i][j]; acc[i][j] = 0.f; }
        }
#pragma unroll 1
        for (int k0 = kb; k0 < ke; k0 += 16) {
#pragma unroll
            for (int i = 0; i < 4; ++i) { const int idx = tid + i * 512, r = idx >> 4, kk = idx & 15; const int m = m0 + r; As[kk * 132 + r] = (m < M) ? a(m, k0 + kk) : 0.f; }
#pragma unroll
            for (int i = 0; i < 4; ++i) { const int idx = tid + i * 512, kk = idx >> 7, n = idx & 127; Bs[kk * 132 + n] = (n0 + n < N) ? b(k0 + kk, n0 + n) : 0.f; }
            __syncthreads();
#pragma unroll 4
            for (int kk = 0; kk < 16; ++kk) {
                float av[4], bv[8];
#pragma unroll
                for (int i = 0; i < 4; ++i) av[i] = As[kk * 132 + ty * 4 + i];
#pragma unroll
                for (int j = 0; j < 8; ++j) bv[j] = Bs[kk * 132 + tx * 8 + j];
#pragma unroll
                for (int i = 0; i < 4; ++i)
#pragma unroll
                    for (int j = 0; j < 8; ++j) acc[i][j] = fmaf(av[i], bv[j], acc[i][j]);
            }
            __syncthreads();
        }
    }
#pragma unroll
    for (int i = 0; i < 4; ++i)
#pragma unroll
        for (int j = 0; j < 8; ++j) { const int m = m0 + ty * 4 + i, n = n0 + tx * 8 + j; if (m < M && n < N) epi(m, n, split ? acc1[i][j] : acc[i][j], split ? acc[i][j] : 0.f); }
}
template <class AF, class BF, class EF>
__device__ __forceinline__ void naive_gemm(float* lds, int M, int N, int K, int Ksplit, AF a, BF b, EF epi) {
    const int ntm = (M + 127) / 128, ntn = (N + 127) / 128;
    for (int t = blockIdx.x; t < ntm * ntn; t += gridDim.x) naive_gemm_tile(lds, (t / ntn) * 128, (t % ntn) * 128, M, N, K, Ksplit, a, b, epi);
}

__device__ __forceinline__ void p0_rows(const Args& A, float* ldsf) {
    const float* x = A.in[0]; const float* g1 = A.in[1]; const float* w_in = A.in[2]; const float* b_forget = A.in[4];
    bf16_t* H = (bf16_t*)(A.ws + WS_H); float* LOGF = (float*)(A.ws + WS_LOGF);
    const int tid = threadIdx.x, lane = tid & 63, wave = tid >> 6;
    for (int i = tid; i < DM * 8; i += NTHREADS) ldsf[i] = w_in[(size_t)(i >> 3) * INCOLS + OFF_F + (i & 7)];
    __syncthreads();
    const int gw = blockIdx.x * NWAVES + wave, NGW = gridDim.x * NWAVES;
    for (int row = gw; row < T; row += NGW) {
        const f32x4* xr = (const f32x4*)(x + (size_t)row * DM) + lane;
        f32x4 xv[8]; float ss = 0.f;
#pragma unroll
        for (int j = 0; j < 8; ++j) xv[j] = xr[64 * j];
#pragma unroll
        for (int j = 0; j < 8; ++j) ss += xv[j].x * xv[j].x + xv[j].y * xv[j].y + xv[j].z * xv[j].z + xv[j].w * xv[j].w;
        const float rstd = rsqrtf(wave_sum(ss) * (1.f / DM) + EPS);
        float f[8];
#pragma unroll
        for (int h = 0; h < 8; ++h) f[h] = 0.f;
#pragma unroll
        for (int j = 0; j < 8; ++j) {
            const int c0 = 256 * j + 4 * lane; const f32x4 g = *(const f32x4*)(g1 + c0);
            f32x4 hv; hv.x = xv[j].x * rstd * g.x; hv.y = xv[j].y * rstd * g.y; hv.z = xv[j].z * rstd * g.z; hv.w = xv[j].w * rstd * g.w;
            u32x2 o; o.x = pk2(hv.x, hv.y); o.y = pk2(hv.z, hv.w);
            *(u32x2*)(H + (size_t)row * DM + c0) = o;
#pragma unroll
            for (int e = 0; e < 4; ++e) { const float hx = hv[e]; const float* wf = ldsf + (c0 + e) * 8;
#pragma unroll
                for (int h = 0; h < 8; ++h) f[h] = fmaf(hx, wf[h], f[h]); }
            asm volatile("" ::: "memory");
        }
#pragma unroll
        for (int h = 0; h < 8; ++h) f[h] = wave_sum(f[h]);
        if (lane < 8) { float z = 0.f;
#pragma unroll
            for (int h = 0; h < 8; ++h) if (lane == h) z = f[h];
            LOGF[(size_t)row * 8 + lane] = log_sigmoid(z + b_forget[lane]); }
    }
}

__device__ __forceinline__ void p1_naive(const Args& A, float* ldsf) {
    const bf16_t* H = (const bf16_t*)(A.ws + WS_H); const float* w_in = A.in[2]; const float* b_gate = A.in[3];
    bf16_t* U = (bf16_t*)(A.ws + WS_U); bf16_t* V = (bf16_t*)(A.ws + WS_V); bf16_t* Q = (bf16_t*)(A.ws + WS_Q); bf16_t* K = (bf16_t*)(A.ws + WS_K);
    bf16_t* VA = (bf16_t*)(A.ws + WS_VA); bf16_t* G = (bf16_t*)(A.ws + WS_G);
    naive_gemm(ldsf, T, 9216, DM, DM,
        [=](int m, int k) { return bf2f(H[(size_t)m * DM + k]); },
        [=](int k, int n) { const int c = n < 5120 ? n : n + 8; return w_in[(size_t)k * INCOLS + c]; },
        [=](int m, int n, float s, float) {
            if (n < 1024) U[(size_t)m * 1024 + n] = f2bf(gelu_tanh(s));
            else if (n < 2048) V[(size_t)m * 1024 + n - 1024] = f2bf(gelu_tanh(s));
            else if (n < 3072) Q[(size_t)m * 1024 + n - 2048] = f2bf(s);
            else if (n < 4096) K[(size_t)m * 1024 + n - 3072] = f2bf(s);
            else if (n < 5120) VA[(size_t)m * 1024 + n - 4096] = f2bf(s);
            else G[(size_t)m * 4096 + n - 5120] = f2bf(sigmoidf_(s + b_gate[n - 5120]));
        });
}

template <int ALT> __device__ __forceinline__ void p1b_fix(const Args& A, float* ldsf) {
    bf16_t* V = (bf16_t*)(A.ws + WS_V); bf16_t* Q = (bf16_t*)(A.ws + WS_Q); bf16_t* K = (bf16_t*)(A.ws + WS_K);
    const size_t altoff = ALT ? ((size_t)((unsigned char*)A.out - (A.ws + WS_V))) / 2 : 0;
    const size_t altq = ALT ? ((size_t)((unsigned char*)A.out + 16 * MiB - (A.ws + WS_Q))) / 2 : 0, altk = ALT ? ((size_t)((unsigned char*)A.out + 32 * MiB - (A.ws + WS_K))) / 2 : 0;
    const float* ln_g = A.in[5]; const float* ln_b = A.in[6]; const float* qg = A.in[9]; const float* kg = A.in[10];
    const int tid = threadIdx.x, lane = tid & 63, wave = tid >> 6;
    const int gw = blockIdx.x * NWAVES + wave, NGW = gridDim.x * NWAVES;
    for (int row = gw; row < T; row += NGW) {
        {
            bf16_t* vr = V + (size_t)row * 1024; float v[16]; float s = 0.f;
#pragma unroll
            for (int j = 0; j < 2; ++j) { const u32x4 w = *(const u32x4*)(vr + 512 * j + 8 * lane);
#pragma unroll
                for (int e = 0; e < 4; ++e) { v[8 * j + 2 * e] = __uint_as_float(w[e] << 16); v[8 * j + 2 * e + 1] = __uint_as_float(w[e] & 0xffff0000u); } }
#pragma unroll
            for (int i = 0; i < 16; ++i) s += v[i];
            const float mean = wave_sum(s) * (1.f / 1024.f); float q = 0.f;
#pragma unroll
            for (int i = 0; i < 16; ++i) { v[i] -= mean; q += v[i] * v[i]; }
            const float rstd = rsqrtf(wave_sum(q) * (1.f / 1024.f) + EPS);
#pragma unroll
            for (int j = 0; j < 2; ++j) { const int c0 = 512 * j + 8 * lane; u32x4 o;
#pragma unroll
                for (int e = 0; e < 4; ++e) o[e] = pk2(v[8 * j + 2 * e] * rstd * ln_g[c0 + 2 * e] + ln_b[c0 + 2 * e], v[8 * j + 2 * e + 1] * rstd * ln_g[c0 + 2 * e + 1] + ln_b[c0 + 2 * e + 1]);
                *(u32x4*)(vr + altoff + c0) = o; }
        }
#pragma unroll
        for (int which = 0; which < 2; ++which) {
            bf16_t* pr = (which == 0 ? Q : K) + (size_t)row * 1024 + 16 * lane; const float* gg = which == 0 ? qg : kg; float v[16]; float s = 0.f;
#pragma unroll
            for (int j = 0; j < 2; ++j) { const u32x4 w = *(const u32x4*)(pr + 8 * j);
#pragma unroll
                for (int e = 0; e < 4; ++e) { v[8 * j + 2 * e] = __uint_as_float(w[e] << 16); v[8 * j + 2 * e + 1] = __uint_as_float(w[e] & 0xffff0000u); } }
#pragma unroll
            for (int i = 0; i < 16; ++i) s += v[i] * v[i];
            s += __shfl_xor(s, 1); s += __shfl_xor(s, 2); s += __shfl_xor(s, 4);
            const float sc = rsqrtf(s * (1.f / 128.f) + EPS) * (which == 0 ? QSCALE : 1.f); const int d0 = (16 * lane) & 127;
#pragma unroll
            for (int j = 0; j < 2; ++j) { u32x4 o;
#pragma unroll
                for (int e = 0; e < 4; ++e) o[e] = pk2(v[8 * j + 2 * e] * sc * gg[d0 + 8 * j + 2 * e], v[8 * j + 2 * e + 1] * sc * gg[d0 + 8 * j + 2 * e + 1]);
                *(u32x4*)(pr + (which == 0 ? altq : altk) + 8 * j) = o; }
        }
    }
    if (blockIdx.x < NB * NH) {
        const int b = blockIdx.x / NH, h = blockIdx.x % NH; const float* LOGF = (const float*)(A.ws + WS_LOGF); float* CKL = (float*)(A.ws + WS_CKL) + (size_t)blockIdx.x * SEQ + (ALT ? 65536 : 0);
        float v[4]; float s = 0.f;
#pragma unroll
        for (int i = 0; i < 4; ++i) { v[i] = LOGF[(size_t)(b * SEQ + tid * 4 + i) * 8 + h]; s += v[i]; }
        float incl = s;
#pragma unroll
        for (int o = 1; o < 64; o <<= 1) { const float t = __shfl_up(incl, o); if (lane >= o) incl += t; }
        __syncthreads();
        if (lane == 63) ldsf[wave] = incl;
        __syncthreads();
        float base = 0.f;
        for (int w = 0; w < wave; ++w) base += ldsf[w];
        float run = base + incl - s;
#pragma unroll
        for (int i = 0; i < 4; ++i) { run += v[i]; CKL[tid * 4 + i] = run * LOG2E; }
        __syncthreads();
    }
}


__device__ __forceinline__ void cumsum_bh(const Args& A, int bh, float* ldsf) {
    const int tid = threadIdx.x, lane = tid & 63, wave = tid >> 6, b = bh / NH, h = bh % NH;
    const float* LOGF = (const float*)(A.ws + WS_LOGF); float* CKL = (float*)(A.ws + WS_CKL) + (size_t)bh * SEQ;
    float v[4]; float sm = 0.f;
#pragma unroll
    for (int i = 0; i < 4; ++i) { v[i] = LOGF[(size_t)(b * SEQ + tid * 4 + i) * 8 + h]; sm += v[i]; }
    float incl = sm;
#pragma unroll
    for (int o = 1; o < 64; o <<= 1) { const float t = __shfl_up(incl, o); if (lane >= o) incl += t; }
    if (lane == 63) ldsf[wave] = incl;
    __syncthreads();
    float run = incl - sm;
    for (int w = 0; w < wave; ++w) run += ldsf[w];
    f32x4 o4;
#pragma unroll
    for (int i = 0; i < 4; ++i) { run += v[i]; o4[i] = run * LOG2E; }
    *(f32x4*)(CKL + tid * 4) = o4;
    __syncthreads();
}

__device__ __forceinline__ void p2_sgu_naive(const Args& A) {
    const bf16_t* U = (const bf16_t*)(A.ws + WS_U); const bf16_t* V = (const bf16_t*)(A.ws + WS_V); bf16_t* MIXIN = (bf16_t*)(A.ws + WS_MIXIN);
    const float* wsp = A.in[7]; const float* bsp = A.in[8];
    const int tid = threadIdx.x, tt = tid >> 2, dp = tid & 3;
    for (int u = blockIdx.x; u < (T / CHUNK) * NG; u += gridDim.x) {
        const int rc = u / NG, g = u % NG; const int row0 = rc * CHUNK;
        float acc[32];
#pragma unroll
        for (int i = 0; i < 32; ++i) acc[i] = 0.f;
        for (int ss = 0; ss <= tt; ++ss) {
            const float w = wsp[((size_t)g * CHUNK + tt) * CHUNK + ss];
            const bf16_t* vr = V + (size_t)(row0 + ss) * 1024 + g * 128 + dp * 32;
#pragma unroll
            for (int i = 0; i < 32; ++i) acc[i] = fmaf(w, bf2f(vr[i]), acc[i]);
        }
        const float bb = bsp[g * CHUNK + tt];
        const bf16_t* ur = U + (size_t)(row0 + tt) * 1024 + g * 128 + dp * 32; bf16_t* orow = MIXIN + (size_t)(row0 + tt) * 2048 + g * 128 + dp * 32;
#pragma unroll
        for (int i = 0; i < 32; ++i) orow[i] = f2bf(bf2f(ur[i]) * (acc[i] + bb));
    }
}
__device__ __forceinline__ void p2_attn_naive(const Args& A, float* ldsf) {
    const bf16_t* Q = (const bf16_t*)(A.ws + WS_Q); const bf16_t* K = (const bf16_t*)(A.ws + WS_K); const bf16_t* VA = (const bf16_t*)(A.ws + WS_VA);
    const float* CKL = (const float*)(A.ws + WS_CKL); bf16_t* MIXIN = (bf16_t*)(A.ws + WS_MIXIN);
    const int tid = threadIdx.x, lane = tid & 63, wave = tid >> 6;
    float* qs = ldsf + wave * 128;
    const int gw = blockIdx.x * NWAVES + wave, NGW = gridDim.x * NWAVES;
    for (int item = gw; item < T * NH; item += NGW) {
        const int row = item / NH, h = item % NH, b = row / SEQ, t = row % SEQ;
        const bf16_t* qr = Q + (size_t)row * 1024 + h * 128;
        qs[lane] = bf2f(qr[lane]); qs[64 + lane] = bf2f(qr[64 + lane]);
        __builtin_amdgcn_s_waitcnt(0);
        const float* ck = CKL + (size_t)(b * NH + h) * SEQ;
        float m = -1e30f, l = 0.f, o0 = 0.f, o1 = 0.f;
        for (int s0 = 0; s0 <= t; s0 += 64) {
            const int s = s0 + lane; float sc = -INFINITY;
            if (s <= t) { const bf16_t* kr = K + (size_t)(b * SEQ + s) * 1024 + h * 128; float d = 0.f;
                for (int c = 0; c < 16; ++c) { const u32x4 w = *(const u32x4*)(kr + 8 * c);
#pragma unroll
                    for (int e = 0; e < 4; ++e) { d = fmaf(qs[8 * c + 2 * e], __uint_as_float(w[e] << 16), d); d = fmaf(qs[8 * c + 2 * e + 1], __uint_as_float(w[e] & 0xffff0000u), d); } }
                sc = d - ck[s]; }
            const float mn = fmaxf(m, wave_max(sc)); const float alpha = exp2f(m - mn); const float p = exp2f(sc - mn);
            l = l * alpha + wave_sum(p); o0 *= alpha; o1 *= alpha; m = mn;
            const int nk = min(64, t - s0 + 1);
            for (int j = 0; j < nk; ++j) { const float pj = __shfl(p, j); const unsigned w = *(const unsigned*)(VA + (size_t)(b * SEQ + s0 + j) * 1024 + h * 128 + 2 * lane);
                o0 = fmaf(pj, __uint_as_float(w << 16), o0); o1 = fmaf(pj, __uint_as_float(w & 0xffff0000u), o1); }
        }
        const float il = 1.f / l;
        *(unsigned*)(MIXIN + (size_t)row * 2048 + 1024 + h * 128 + 2 * lane) = pk2(o0 * il, o1 * il);
    }
}

__device__ __forceinline__ void p3_naive(const Args& A, float* ldsf) {
    const bf16_t* MIXIN = (const bf16_t*)(A.ws + WS_MIXIN); const bf16_t* G = (const bf16_t*)(A.ws + WS_G); bf16_t* MIXED = (bf16_t*)(A.ws + WS_MIXED);
    const float* wps = A.in[11]; const float* wpf = A.in[12];
    naive_gemm(ldsf, T, DM, 2048, 1024,
        [=](int m, int k) { return bf2f(MIXIN[(size_t)m * 2048 + k]); },
        [=](int k, int n) { return k < 1024 ? wps[(size_t)k * DM + n] : wpf[(size_t)(k - 1024) * DM + n]; },
        [=](int m, int n, float s1, float s2) { MIXED[(size_t)m * DM + n] = f2bf(bf2f(G[(size_t)m * 4096 + n]) * s1 + bf2f(G[(size_t)m * 4096 + 2048 + n]) * s2); });
}
__device__ __forceinline__ void p4_naive(const Args& A, float* ldsf) {
    const bf16_t* MIXED = (const bf16_t*)(A.ws + WS_MIXED); const float* wo = A.in[13]; const float* x = A.in[0]; float* X1 = A.out;
    naive_gemm(ldsf, T, DM, DM, DM,
        [=](int m, int k) { return bf2f(MIXED[(size_t)m * DM + k]); },
        [=](int k, int n) { return wo[(size_t)k * DM + n]; },
        [=](int m, int n, float s, float) { X1[(size_t)m * DM + n] = x[(size_t)m * DM + n] + s; });
}

template <int ALT> __device__ __forceinline__ void p5_router(const Args& A, float* ldsf) {
    const float* X1 = A.out; const float* g2 = A.in[14]; const float* wrg = A.in[15]; const float* brg = A.in[16]; const float* wre = A.in[17]; const float* bre = A.in[18];
    bf16_t* H2 = (bf16_t*)(A.ws + WS_H2); unsigned* cnt = (unsigned*)(A.ws + WS_CTL) + CW_CNT + (ALT ? 2048 : 0);
    int* TOK = (int*)(A.ws + (ALT ? WS_H : WS_TOK)); float* GATE = (float*)(A.ws + (ALT ? WS_H + 2 * MiB : WS_GATE)); int* ASG = (int*)(A.ws + (ALT ? WS_H + 4 * MiB : WS_ASG));
    const int tid = threadIdx.x, lane = tid & 63, wave = tid >> 6, r = tid >> 4, ks = tid & 15;
    float* Ws = ldsf;
    float* Xs = ldsf + 256 * 36;
    float* rs = Xs + 32 * 260;
    int* hist = (int*)(rs + 32);
    int* hbase = hist + 32;
    int* sel = hbase + 32;
    int* lpos = sel + 64;
    float* selw = (float*)(lpos + 64);
    for (int rb = blockIdx.x; rb < T / 32; rb += gridDim.x) {
        const int row0 = rb * 32;
        for (int i = 0; i < 4; ++i) { const int rr = wave * 4 + i; const f32x4* xr = (const f32x4*)(X1 + (size_t)(row0 + rr) * DM) + lane; float ss = 0.f;
#pragma unroll
            for (int j = 0; j < 8; ++j) { const f32x4 v = xr[64 * j]; ss += v.x * v.x + v.y * v.y + v.z * v.z + v.w * v.w; }
            ss = wave_sum(ss); if (lane == 0) rs[rr] = rsqrtf(ss * (1.f / DM) + EPS); }
        if (tid < 32) hist[tid] = 0;
        __syncthreads();
        float acc[36];
#pragma unroll
        for (int j = 0; j < 36; ++j) acc[j] = 0.f;
        for (int k0 = 0; k0 < DM; k0 += 256) {
            for (int i = tid; i < 256 * 36; i += NTHREADS) { const int kk = i / 36, j = i % 36; Ws[i] = j < 4 ? wrg[(size_t)(k0 + kk) * 4 + j] : wre[(size_t)(k0 + kk) * 32 + j - 4]; }
            for (int i = tid; i < 32 * 256; i += NTHREADS) { const int rr = i >> 8, kk = i & 255; const float hv = X1[(size_t)(row0 + rr) * DM + k0 + kk] * rs[rr] * g2[k0 + kk];
                Xs[rr * 260 + kk] = hv; H2[(size_t)(row0 + rr) * DM + k0 + kk] = f2bf(hv); }
            __syncthreads();
            for (int kk = ks; kk < 256; kk += 16) { const float xv = Xs[r * 260 + kk]; const float* wr = Ws + kk * 36;
#pragma unroll
                for (int j = 0; j < 36; ++j) acc[j] = fmaf(xv, wr[j], acc[j]); }
            __syncthreads();
        }
#pragma unroll
        for (int j = 0; j < 36; ++j) { float v = acc[j]; v += __shfl_xor(v, 1); v += __shfl_xor(v, 2); v += __shfl_xor(v, 4); v += __shfl_xor(v, 8); acc[j] = v; }
        if (ks == 0) {
            float gl[4]; int grp = 0; float gm;
#pragma unroll
            for (int j = 0; j < 4; ++j) gl[j] = acc[j] + brg[j];
            gm = gl[0];
#pragma unroll
            for (int j = 1; j < 4; ++j) if (gl[j] > gm) { gm = gl[j]; grp = j; }
            float den = 0.f;
#pragma unroll
            for (int j = 0; j < 4; ++j) den += __expf(gl[j] - gm);
            const float pg = 1.f / den;
            float el[8];
#pragma unroll
            for (int j = 0; j < 8; ++j) { float v = 0.f;
#pragma unroll
                for (int g = 0; g < 4; ++g) if (g == grp) v = acc[4 + g * 8 + j] + bre[g * 8 + j];
                el[j] = v; }
            int i0 = 0; float v0 = el[0];
#pragma unroll
            for (int j = 1; j < 8; ++j) if (el[j] > v0) { v0 = el[j]; i0 = j; }
            int i1 = -1; float v1 = -INFINITY;
#pragma unroll
            for (int j = 0; j < 8; ++j) if (j != i0 && el[j] > v1) { v1 = el[j]; i1 = j; }
            const float e1 = __expf(v1 - v0); const float w0 = pg / (1.f + e1), w1 = pg * e1 / (1.f + e1);
            const int ea = grp * 8 + i0, eb = grp * 8 + i1;
            sel[r * 2] = ea; sel[r * 2 + 1] = eb; selw[r * 2] = w0; selw[r * 2 + 1] = w1;
            lpos[r * 2] = atomicAdd(&hist[ea], 1); lpos[r * 2 + 1] = atomicAdd(&hist[eb], 1);
        }
        __syncthreads();
        if (tid < 32) hbase[tid] = hist[tid] > 0 ? (int)atomicAdd(&cnt[(tid) * CNT_STRIDE], (unsigned)hist[tid]) : 0;
        __syncthreads();
        if (tid < 64) { const int e = sel[tid], pos = hbase[e] + lpos[tid]; const int tok = row0 + (tid >> 1);
            TOK[(size_t)e * T + pos] = tok; GATE[(size_t)e * T + pos] = selw[tid]; ASG[tok * 2 + (tid & 1)] = (e << 16) | pos; }
        __syncthreads();
    }
}

template <int ALT> __device__ __forceinline__ void p5_router2(const Args& A, float* ldsf) {
    const float* X1 = A.out; const float* g2 = A.in[14]; const float* wrg = A.in[15]; const float* brg = A.in[16]; const float* wre = A.in[17]; const float* bre = A.in[18];
    bf16_t* H2 = (bf16_t*)(A.ws + WS_H2); unsigned* cnt = (unsigned*)(A.ws + WS_CTL) + CW_CNT + (ALT ? 2048 : 0);
    int* TOK = (int*)(A.ws + (ALT ? WS_H : WS_TOK)); float* GATE = (float*)(A.ws + (ALT ? WS_H + 2 * MiB : WS_GATE)); int* ASG = (int*)(A.ws + (ALT ? WS_H + 4 * MiB : WS_ASG));
    const int tid = threadIdx.x, lane = tid & 63, wave = tid >> 6;
    constexpr int XP = 260, XB = 32 * XP, WP = 40, WB = 256 * WP;
    float* Xs = ldsf;
    float* Ws = ldsf + 2 * XB;
    float* misc = ldsf + 2 * XB + 2 * WB;
    float* rs = misc;
    float* lg = misc + 32;
    int* hist = (int*)(misc + 32 + 1280); int* hbase = hist + 32; int* sel = hbase + 32; int* lpos = sel + 64; float* selw = (float*)(lpos + 64);
    const int kh2 = lane >> 5, rp = (lane >> 1) & 15, cg = lane & 1;
    for (int rb = blockIdx.x; rb < T / 32; rb += gridDim.x) {
        const int row0 = rb * 32;
        float ssq[4] = {0.f, 0.f, 0.f, 0.f};
        float acc0[20], acc1[20];
#pragma unroll
        for (int j = 0; j < 20; ++j) { acc0[j] = 0.f; acc1[j] = 0.f; }
        if (tid < 32) hist[tid] = 0;
        f32x4 xr[4], wv[5], gv;
        for (int i = tid; i < 2 * 256; i += NTHREADS) *(f32x4*)(Ws + (i >> 8) * WB + (i & 255) * WP + 36) = (f32x4){0.f, 0.f, 0.f, 0.f};
#define R2_LOAD(k0) do { gv = *(const f32x4*)(g2 + (k0) + 4 * (tid & 63)); \
        _Pragma("unroll") for (int i = 0; i < 4; ++i) xr[i] = *(const f32x4*)(X1 + (size_t)(row0 + wave + 8 * i) * DM + (k0) + 4 * (tid & 63)); \
        _Pragma("unroll") for (int i = 0; i < 5; ++i) { const int idx = tid + i * 512; if (idx < 2304) { const int kk = idx / 9, j4 = idx - kk * 9; \
            wv[i] = j4 == 0 ? *(const f32x4*)(wrg + (size_t)((k0) + kk) * 4) : *(const f32x4*)(wre + (size_t)((k0) + kk) * 32 + 4 * (j4 - 1)); } } } while (0)
#define R2_STORE(buf) do { \
        _Pragma("unroll") for (int i = 0; i < 4; ++i) { ssq[i] += xr[i].x * xr[i].x + xr[i].y * xr[i].y + xr[i].z * xr[i].z + xr[i].w * xr[i].w; \
            *(f32x4*)(Xs + (buf) * XB + (wave + 8 * i) * XP + 4 * (tid & 63)) = xr[i] * gv; } \
        _Pragma("unroll") for (int i = 0; i < 5; ++i) { const int idx = tid + i * 512; if (idx < 2304) { const int kk = idx / 9, j4 = idx - kk * 9; *(f32x4*)(Ws + (buf) * WB + kk * WP + 4 * j4) = wv[i]; } } } while (0)
        R2_LOAD(0); R2_STORE(0);
        __syncthreads();
#pragma unroll 1
        for (int c = 0; c < 8; ++c) {
            const int buf = c & 1;
            if (c < 7) R2_LOAD((c + 1) * 256);
            const float* xa = Xs + buf * XB + (2 * rp) * XP + (wave * 2 + kh2) * 16; const float* wa = Ws + buf * WB + ((wave * 2 + kh2) * 16) * WP + 20 * cg;
#pragma unroll 1
            for (int k4 = 0; k4 < 4; ++k4) {
                const f32x4 x0 = *(const f32x4*)(xa + 4 * k4), x1 = *(const f32x4*)(xa + XP + 4 * k4);
#pragma unroll
                for (int kk = 0; kk < 4; ++kk) { const float* wr = wa + (4 * k4 + kk) * WP;
#pragma unroll
                    for (int j4 = 0; j4 < 5; ++j4) { const f32x4 w = *(const f32x4*)(wr + 4 * j4);
#pragma unroll
                        for (int e = 0; e < 4; ++e) { acc0[4 * j4 + e] = fmaf(x0[kk], w[e], acc0[4 * j4 + e]); acc1[4 * j4 + e] = fmaf(x1[kk], w[e], acc1[4 * j4 + e]); } }
                    asm volatile("" ::: "memory"); }
            }
            if (c < 7) R2_STORE(buf ^ 1);
            __syncthreads();
        }
#undef R2_LOAD
#undef R2_STORE
#pragma unroll
        for (int j = 0; j < 20; ++j) { acc0[j] += __shfl_xor(acc0[j], 32); acc1[j] += __shfl_xor(acc1[j], 32); }
        float* red = Xs;
        if (kh2 == 0) {
#pragma unroll
            for (int j = 0; j < 20; ++j) { red[(wave * 32 + 2 * rp) * 40 + 20 * cg + j] = acc0[j]; red[(wave * 32 + 2 * rp + 1) * 40 + 20 * cg + j] = acc1[j]; } }
#pragma unroll
        for (int i = 0; i < 4; ++i) { const float s = wave_sum(ssq[i]); if (lane == 0) rs[wave + 8 * i] = rsqrtf(s * (1.f / DM) + EPS); }
        __syncthreads();
        for (int i = tid; i < 32 * 40; i += NTHREADS) { float s = 0.f;
#pragma unroll
            for (int w = 0; w < 8; ++w) s += red[w * 1280 + i];
            lg[i] = s * rs[i / 40]; }
        __syncthreads();
#pragma unroll 1
        for (int i = 0; i < 4; ++i) { const int rr = wave + 8 * i; const float rstd = rs[rr]; const float* xp = X1 + (size_t)(row0 + rr) * DM; bf16_t* hp = H2 + (size_t)(row0 + rr) * DM;
#pragma unroll 2
            for (int j = 0; j < 8; ++j) { const int c0 = 256 * j + 4 * lane; const f32x4 v = *(const f32x4*)(xp + c0), g = *(const f32x4*)(g2 + c0);
                u32x2 o; o.x = pk2(v.x * rstd * g.x, v.y * rstd * g.y); o.y = pk2(v.z * rstd * g.z, v.w * rstd * g.w); *(u32x2*)(hp + c0) = o; } }
        if (tid < 32) {
            const int r = tid; const float* L = lg + r * 40;
            float gl[4]; int grp = 0;
#pragma unroll
            for (int j = 0; j < 4; ++j) gl[j] = L[j] + brg[j];
            float gm = gl[0];
#pragma unroll
            for (int j = 1; j < 4; ++j) if (gl[j] > gm) { gm = gl[j]; grp = j; }
            float den = 0.f;
#pragma unroll
            for (int j = 0; j < 4; ++j) den += __expf(gl[j] - gm);
            const float pg = 1.f / den;
            float el[8];
#pragma unroll
            for (int j = 0; j < 8; ++j) el[j] = L[4 + grp * 8 + j] + bre[grp * 8 + j];
            int i0 = 0; float v0 = el[0];
#pragma unroll
            for (int j = 1; j < 8; ++j) if (el[j] > v0) { v0 = el[j]; i0 = j; }
            int i1 = -1; float v1 = -INFINITY;
#pragma unroll
            for (int j = 0; j < 8; ++j) if (j != i0 && el[j] > v1) { v1 = el[j]; i1 = j; }
            const float e1 = __expf(v1 - v0); const float w0 = pg / (1.f + e1), w1 = pg * e1 / (1.f + e1);
            const int ea = grp * 8 + i0, eb = grp * 8 + i1;
            sel[r * 2] = ea; sel[r * 2 + 1] = eb; selw[r * 2] = w0; selw[r * 2 + 1] = w1;
            lpos[r * 2] = atomicAdd(&hist[ea], 1); lpos[r * 2 + 1] = atomicAdd(&hist[eb], 1);
        }
        __syncthreads();
        if (tid < 32) hbase[tid] = hist[tid] > 0 ? (int)atomicAdd(&cnt[(tid) * CNT_STRIDE], (unsigned)hist[tid]) : 0;
        __syncthreads();
        if (tid < 64) { const int e = sel[tid], pos = hbase[e] + lpos[tid]; const int tok = row0 + (tid >> 1);
            TOK[(size_t)e * T + pos] = tok; GATE[(size_t)e * T + pos] = selw[tid]; ASG[tok * 2 + (tid & 1)] = (e << 16) | pos; }
        __syncthreads();
    }
}

constexpr size_t WS_WR = 7 * MiB;
__device__ __forceinline__ void p0_router_weights(const Args& A) {
    const float* g2 = A.in[14]; const float* wrg = A.in[15]; const float* wre = A.in[17]; bf16_t* WR = (bf16_t*)(A.ws + WS_WR);
    for (int i = blockIdx.x * NTHREADS + threadIdx.x; i < 64 * DM; i += gridDim.x * NTHREADS) { const int n = i >> 11, k = i & (DM - 1);
        const float w = n < 4 ? wrg[(size_t)k * 4 + n] * g2[k] : (n < 36 ? wre[(size_t)k * 32 + n - 4] * g2[k] : 0.f);
        const bf16_t h = f2bf(w); const int j = ((k >> 4) * 64 + n) * 16 + (k & 15);
        WR[j] = h; WR[64 * DM + j] = f2bf(w - bf2f(h)); }
}
constexpr size_t WS_RSTL = WS_CKL;
template <int ALT> __device__ __forceinline__ void p5_router3(const Args& A, float* ldsf) {
    float* RSTL = (float*)(A.ws + (ALT ? WS_H + 6 * MiB : WS_RSTL));
    typedef short bf16x8 __attribute__((ext_vector_type(8))); typedef float f32x16 __attribute__((ext_vector_type(16)));
    const float* X1 = A.out; const float* g2 = A.in[14]; const float* brg = A.in[16]; const float* bre = A.in[18]; const bf16_t* WR = (const bf16_t*)(A.ws + WS_WR);
    bf16_t* H2 = (bf16_t*)(A.ws + WS_H2); unsigned* cnt = (unsigned*)(A.ws + WS_CTL) + CW_CNT + (ALT ? 2048 : 0);
    int* TOK = (int*)(A.ws + (ALT ? WS_H : WS_TOK)); float* GATE = (float*)(A.ws + (ALT ? WS_H + 2 * MiB : WS_GATE)); int* ASG = (int*)(A.ws + (ALT ? WS_H + 4 * MiB : WS_ASG));
    const int tid = threadIdx.x, lane = tid & 63, wave = tid >> 6, r32 = lane & 31, hi = lane >> 5;
    float* red = ldsf;
    float* lg = ldsf + 16384;
    float* sq = lg + 2048;
    float* rs = sq + 256;
    int* hist = (int*)(rs + 32); int* hbase = hist + 32; int* sel = hbase + 32; int* lpos = sel + 64; float* selw = (float*)(lpos + 64);
    for (int rb = blockIdx.x; rb < T / 32; rb += gridDim.x) {
        const int row0 = rb * 32;
        if (tid < 32) hist[tid] = 0;
        const float* xp = X1 + (size_t)(row0 + r32) * DM + 256 * wave + 8 * hi;
        const bf16_t* wp = WR + (size_t)((16 * wave) * 64 + r32) * 16 + 8 * hi;
        f32x16 acc[2];
#pragma unroll
        for (int j = 0; j < 2; ++j)
#pragma unroll
            for (int r = 0; r < 16; ++r) acc[j][r] = 0.f;
        float ssq = 0.f;
        f32x4 xa[4], xb[4], xna[4], xnb[4];
#pragma unroll
        for (int i = 0; i < 4; ++i) { xa[i] = *(const f32x4*)(xp + 16 * i); xb[i] = *(const f32x4*)(xp + 16 * i + 4); }
#pragma unroll 1
        for (int kb = 0; kb < (ALT == 3 ? 0 : 4); ++kb) {
            bf16x8 wh0[4], wh1[4], wl0[4], wl1[4]; f32x4 ga[4], gb[4];
#pragma unroll
            for (int i = 0; i < 4; ++i) { const int ko = 64 * kb + 16 * i;
                const int wo = (4 * kb + i) * 1024;
                wh0[i] = *(const bf16x8*)(wp + wo); wh1[i] = *(const bf16x8*)(wp + 512 + wo); wl0[i] = *(const bf16x8*)(wp + (size_t)64 * DM + wo); wl1[i] = *(const bf16x8*)(wp + (size_t)64 * DM + 512 + wo);
                ga[i] = *(const f32x4*)(g2 + 256 * wave + 8 * hi + ko); gb[i] = *(const f32x4*)(g2 + 256 * wave + 8 * hi + ko + 4); }
            asm volatile("" ::: "memory");
            if (kb < 3) {
#pragma unroll
                for (int i = 0; i < 4; ++i) { xna[i] = *(const f32x4*)(xp + 64 * (kb + 1) + 16 * i); xnb[i] = *(const f32x4*)(xp + 64 * (kb + 1) + 16 * i + 4); } }
            asm volatile("" ::: "memory");
#pragma unroll
            for (int i = 0; i < 4; ++i) { const int ko = 64 * kb + 16 * i;
                { u32x4 hw; hw.x = cvtpk_rne(xa[i][0] * ga[i][0], xa[i][1] * ga[i][1]); hw.y = cvtpk_rne(xa[i][2] * ga[i][2], xa[i][3] * ga[i][3]); hw.z = cvtpk_rne(xb[i][0] * gb[i][0], xb[i][1] * gb[i][1]); hw.w = cvtpk_rne(xb[i][2] * gb[i][2], xb[i][3] * gb[i][3]);
                  *(u32x4*)(H2 + (size_t)(row0 + r32) * DM + 256 * wave + 8 * hi + ko) = hw; }
                float xv[8] = {xa[i][0], xa[i][1], xa[i][2], xa[i][3], xb[i][0], xb[i][1], xb[i][2], xb[i][3]}; u32x4 ph, pl;
#pragma unroll
                for (int e = 0; e < 4; ++e) { const float a = xv[2 * e], b2 = xv[2 * e + 1]; ssq += a * a + b2 * b2; const unsigned hh = cvtpk_rne(a, b2); ph[e] = hh;
                    pl[e] = cvtpk_rne(a - __uint_as_float(hh << 16), b2 - __uint_as_float(hh & 0xffff0000u)); }
                const bf16x8 xh = __builtin_bit_cast(bf16x8, ph), xl = __builtin_bit_cast(bf16x8, pl);
                acc[0] = __builtin_amdgcn_mfma_f32_32x32x16_bf16(xh, wh0[i], acc[0], 0, 0, 0); acc[0] = __builtin_amdgcn_mfma_f32_32x32x16_bf16(xl, wh0[i], acc[0], 0, 0, 0); acc[0] = __builtin_amdgcn_mfma_f32_32x32x16_bf16(xh, wl0[i], acc[0], 0, 0, 0);
                acc[1] = __builtin_amdgcn_mfma_f32_32x32x16_bf16(xh, wh1[i], acc[1], 0, 0, 0); acc[1] = __builtin_amdgcn_mfma_f32_32x32x16_bf16(xl, wh1[i], acc[1], 0, 0, 0); acc[1] = __builtin_amdgcn_mfma_f32_32x32x16_bf16(xh, wl1[i], acc[1], 0, 0, 0); }
#pragma unroll
            for (int i = 0; i < 4; ++i) { xa[i] = xna[i]; xb[i] = xnb[i]; }
        }
#pragma unroll
        for (int j = 0; j < 2; ++j)
#pragma unroll
            for (int r = 0; r < 16; ++r) red[((wave * 2 + j) * 16 + r) * 64 + lane] = acc[j][r];
        ssq += __shfl_xor(ssq, 32);
        if (hi == 0) sq[wave * 32 + r32] = ssq;
        __syncthreads();
        if (ALT == 2) continue;
#pragma unroll
        for (int j = 0; j < 2; ++j)
#pragma unroll
            for (int rr = 0; rr < 2; ++rr) { const int r = 2 * wave + rr; float s = 0.f;
#pragma unroll
                for (int w2 = 0; w2 < 8; ++w2) s += red[((w2 * 2 + j) * 16 + r) * 64 + lane];
                lg[((r & 3) + 8 * (r >> 2) + 4 * hi) * 64 + 32 * j + r32] = s; }
        if (tid < 32) { float s = 0.f;
#pragma unroll
            for (int w2 = 0; w2 < 8; ++w2) s += sq[w2 * 32 + tid];
            rs[tid] = rsqrtf(s * (1.f / DM) + EPS); }
        __syncthreads();
        if (tid < 32) {
            const int r = tid; const float* L = lg + r * 64; const float rstd = rs[r];
            float gl[4]; int grp = 0;
#pragma unroll
            for (int j = 0; j < 4; ++j) gl[j] = L[j] * rstd + brg[j];
            float gm = gl[0];
#pragma unroll
            for (int j = 1; j < 4; ++j) if (gl[j] > gm) { gm = gl[j]; grp = j; }
            float den = 0.f;
#pragma unroll
            for (int j = 0; j < 4; ++j) den += __expf(gl[j] - gm);
            const float pg = 1.f / den;
            float el[8];
#pragma unroll
            for (int j = 0; j < 8; ++j) el[j] = L[4 + grp * 8 + j] * rstd + bre[grp * 8 + j];
            int i0 = 0; float v0 = el[0];
#pragma unroll
            for (int j = 1; j < 8; ++j) if (el[j] > v0) { v0 = el[j]; i0 = j; }
            int i1 = -1; float v1 = -INFINITY;
#pragma unroll
            for (int j = 0; j < 8; ++j) if (j != i0 && el[j] > v1) { v1 = el[j]; i1 = j; }
            const float e1 = __expf(v1 - v0); const float w0 = pg / (1.f + e1), w1 = pg * e1 / (1.f + e1);
            const int ea = grp * 8 + i0, eb = grp * 8 + i1;
            sel[r * 2] = ea; sel[r * 2 + 1] = eb; selw[r * 2] = w0; selw[r * 2 + 1] = w1;
            lpos[r * 2] = atomicAdd(&hist[ea], 1); lpos[r * 2 + 1] = atomicAdd(&hist[eb], 1);
        }
        __syncthreads();
        if (tid < 32) hbase[tid] = hist[tid] > 0 ? (int)atomicAdd(&cnt[(tid) * CNT_STRIDE], (unsigned)hist[tid]) : 0;
        __syncthreads();
        if (tid < 64) { const int e = sel[tid], pos = hbase[e] + lpos[tid]; const int tok = row0 + (tid >> 1);
            TOK[(size_t)e * T + pos] = tok; GATE[(size_t)e * T + pos] = selw[tid]; RSTL[(size_t)e * T + pos] = rs[tid >> 1]; ASG[tok * 2 + (tid & 1)] = (e << 16) | pos; }
        __syncthreads();
    }
}

__device__ __forceinline__ void expert_layout(const unsigned* cnt, int* pstart  ) {
    int acc = 0;
    for (int e = 0; e < NEXP; ++e) { pstart[e] = acc; acc += ((int)cnt[(e) * CNT_STRIDE] + MTILE - 1) / MTILE * MTILE; }
    pstart[NEXP] = acc;
}

__device__ __forceinline__ void p6_naive(const Args& A, float* ldsf) {
    const bf16_t* H2 = (const bf16_t*)(A.ws + WS_H2); const float* wg = A.in[19]; const float* wu = A.in[20]; bf16_t* ACT = (bf16_t*)(A.ws + WS_ACT);
    const unsigned* cnt = (const unsigned*)(A.ws + WS_CTL) + CW_CNT; const int* TOK = (const int*)(A.ws + WS_TOK);
    int* ps = (int*)(ldsf + 2 * 16 * 132);
    if (threadIdx.x == 0) expert_layout(cnt, ps);
    __syncthreads();
    int ntot = 0;
    for (int e = 0; e < NEXP; ++e) ntot += (((int)cnt[(e) * CNT_STRIDE] + 127) / 128) * 4;
    for (int t = blockIdx.x; t < ntot; t += gridDim.x) {
        int e = 0, rem = t;
        for (; e < NEXP; ++e) { const int n = (((int)cnt[(e) * CNT_STRIDE] + 127) / 128) * 4; if (rem < n) break; rem -= n; }
        const int c = (int)cnt[(e) * CNT_STRIDE]; const int tm = rem / 4, tn = rem % 4; const int* tl = TOK + (size_t)e * T; const int prow = ps[e];
        const float* wge = wg + (size_t)e * DM * DEXP; const float* wue = wu + (size_t)e * DM * DEXP;
        naive_gemm_tile(ldsf, tm * 128, tn * 128, c, DEXP, 2 * DM, DM,
            [=](int m, int k) { return bf2f(H2[(size_t)tl[m] * DM + (k & (DM - 1))]); },
            [=](int k, int n) { return k < DM ? wge[(size_t)k * DEXP + n] : wue[(size_t)(k - DM) * DEXP + n]; },
            [=](int m, int n, float sg, float su) { ACT[(size_t)(prow + m) * DEXP + n] = f2bf(sg / (1.f + __expf(-sg)) * su); });
    }
}
__device__ __forceinline__ void p7_naive(const Args& A, float* ldsf) {
    const bf16_t* ACT = (const bf16_t*)(A.ws + WS_ACT); const float* wd = A.in[21]; bf16_t* YBUF = (bf16_t*)(A.ws + WS_YBUF);
    const unsigned* cnt = (const unsigned*)(A.ws + WS_CTL) + CW_CNT; const float* GATE = (const float*)(A.ws + WS_GATE);
    int* ps = (int*)(ldsf + 2 * 16 * 132);
    if (threadIdx.x == 0) expert_layout(cnt, ps);
    __syncthreads();
    int ntot = 0;
    for (int e = 0; e < NEXP; ++e) ntot += (((int)cnt[(e) * CNT_STRIDE] + 127) / 128) * 16;
    for (int t = blockIdx.x; t < ntot; t += gridDim.x) {
        int e = 0, rem = t;
        for (; e < NEXP; ++e) { const int n = (((int)cnt[(e) * CNT_STRIDE] + 127) / 128) * 16; if (rem < n) break; rem -= n; }
        const int c = (int)cnt[(e) * CNT_STRIDE]; const int tm = rem / 16, tn = rem % 16; const float* gl = GATE + (size_t)e * T; const int prow = ps[e];
        const float* wde = wd + (size_t)e * DEXP * DM;
        naive_gemm_tile(ldsf, tm * 128, tn * 128, c, DM, DEXP, DEXP,
            [=](int m, int k) { return bf2f(ACT[(size_t)(prow + m) * DEXP + k]); },
            [=](int k, int n) { return wde[(size_t)k * DM + n]; },
            [=](int m, int n, float s, float) { YBUF[(size_t)(prow + m) * DM + n] = f2bf(s * gl[m]); });
    }
}

template <int ALT> __device__ __forceinline__ void p8_combine(const Args& A, float* ldsf, const float dlt = 0.f) {
    float* X1 = A.out; float* XO = ALT ? (float*)(A.ws + WS_WGU) : A.out; const bf16_t* YBUF = (const bf16_t*)(A.ws + WS_YBUF); const int* ASG = (const int*)(A.ws + WS_ASG);
    const unsigned* cnt = (const unsigned*)(A.ws + WS_CTL) + CW_CNT;
    int* ps = (int*)ldsf;
    if (threadIdx.x == 0) expert_layout(cnt, ps);
    __syncthreads();
    float dl2 = dlt;
    if (STAMP_PHASE == 97) { int v = 0, mx = 0, mn = 1 << 30, nt_ = 0, tiny = 0, half = 0; for (int e = 0; e < NEXP; ++e) { const int c = (int)cnt[(e) * CNT_STRIDE]; mx = c > mx ? c : mx; mn = c < mn ? c : mn; nt_ += (c + 255) / 256; const int rem = c % 256; tiny += (rem > 0 && rem <= 64) ? 1 : 0; half += (rem > 0 && rem <= 128) ? 1 : 0; }
        v = STAMP_SEL == 0 ? nt_ : STAMP_SEL == 1 ? mx : STAMP_SEL == 2 ? mn : STAMP_SEL == 3 ? tiny : half; dl2 = 0.01f * (float)v; }
    const int tid = threadIdx.x, lane = tid & 63, wave = tid >> 6;
    const int gw = blockIdx.x * NWAVES + wave, NGW = gridDim.x * NWAVES;
    u32x4 w0[4], w1[4], n0[4], n1[4]; f32x4 xa[4], xb[4], na[4], nb[4];
#define P8_LOAD(row_, W0, W1, XA, XB) do { const int a0_ = ASG[(row_) * 2], a1_ = ASG[(row_) * 2 + 1]; \
        const bf16_t* y0_ = YBUF + (size_t)(ps[a0_ >> 16] + (a0_ & 0xffff)) * DM; const bf16_t* y1_ = YBUF + (size_t)(ps[a1_ >> 16] + (a1_ & 0xffff)) * DM; const float* xr_ = X1 + (size_t)(row_) * DM; \
        _Pragma("unroll") for (int j = 0; j < 4; ++j) { const int c0 = 512 * j + 8 * lane; W0[j] = *(const u32x4*)(y0_ + c0); W1[j] = *(const u32x4*)(y1_ + c0); XA[j] = *(const f32x4*)(xr_ + c0); XB[j] = *(const f32x4*)(xr_ + c0 + 4); } } while (0)
    int row = gw;
    if (row < T) P8_LOAD(row, w0, w1, xa, xb);
    for (; row < T; row += NGW) {
        const int nrow = row + NGW; const bool more = nrow < T;
        if (more) P8_LOAD(nrow, n0, n1, na, nb);
        float* xo = XO + (size_t)row * DM;
#pragma unroll
        for (int j = 0; j < 4; ++j) { const int c0 = 512 * j + 8 * lane; f32x4 a = xa[j], b2 = xb[j];
            a.x += __uint_as_float(w0[j][0] << 16) + __uint_as_float(w1[j][0] << 16); a.y += __uint_as_float(w0[j][0] & 0xffff0000u) + __uint_as_float(w1[j][0] & 0xffff0000u);
            a.z += __uint_as_float(w0[j][1] << 16) + __uint_as_float(w1[j][1] << 16); a.w += __uint_as_float(w0[j][1] & 0xffff0000u) + __uint_as_float(w1[j][1] & 0xffff0000u);
            b2.x += __uint_as_float(w0[j][2] << 16) + __uint_as_float(w1[j][2] << 16); b2.y += __uint_as_float(w0[j][2] & 0xffff0000u) + __uint_as_float(w1[j][2] & 0xffff0000u);
            b2.z += __uint_as_float(w0[j][3] << 16) + __uint_as_float(w1[j][3] << 16); b2.w += __uint_as_float(w0[j][3] & 0xffff0000u) + __uint_as_float(w1[j][3] & 0xffff0000u);
            if (STAMP_PHASE >= 0) { a += dl2; b2 += dl2; }
            *(f32x4*)(xo + c0) = a; *(f32x4*)(xo + c0 + 4) = b2; }
        if (more) {
#pragma unroll
            for (int j = 0; j < 4; ++j) { w0[j] = n0[j]; w1[j] = n1[j]; xa[j] = na[j]; xb[j] = nb[j]; } }
    }
#undef P8_LOAD
}

namespace pg8 {
#define PG8_LAS __attribute__((address_space(3)))
typedef short bf16x8 __attribute__((ext_vector_type(8)));
constexpr int BM = 256, BK = 64, HALF = 128, HTB = HALF * BK * 2, STAGE_BYTES = 8 * HTB, NXCD = 8, WGM = 8;
__host__ __device__ __forceinline__ int lds_byte(int r, int c) { const int st = (r >> 4) * 2 + (c >> 5), rr = r & 15, cc = c & 31, ob = rr * 64 + cc * 2; return st * 1024 + (ob ^ (((ob >> 9) & 1) << 5)); }
__host__ __device__ __forceinline__ void stage_rc(int b, int& R, int& C) { const int st = b / 1024, sb = b % 1024, swz = sb ^ (((sb >> 9) & 1) << 5); R = (st >> 1) * 16 + swz / 64; C = (st & 1) * 32 + (swz % 64) / 2; }
__host__ __device__ __forceinline__ int perm32(int rho) { const int n = rho >> 4, i = rho & 15; return 8 * (i >> 2) + 4 * n + (i & 3); }

struct Unit { const char* A; const char* B; int pm, pn, x0, x1, x2, x3; };

struct DenseOrder {
    const char* A; const char* Bt; int K, nM, nN, nwg, G, c, rep;
    __device__ void init(const void* A_, const void* Bt_, int M, int N, int K_, int G_, int c_, int rep_ = 1) { A = (const char*)A_; Bt = (const char*)Bt_; K = K_; nM = M / BM; nN = N / BM; nwg = nM * nN; G = G_; c = c_; rep = rep_; }
    __device__ bool next(int i, Unit& u) const {
        const long L = (long)i * G + c; if (L >= (long)nwg * rep) return false;
        int wgid = (int)(L % nwg); { const int q = nwg / NXCD, r = nwg % NXCD, xcd = wgid % NXCD, off = wgid / NXCD; wgid = (xcd < r ? xcd * (q + 1) : r * (q + 1) + (xcd - r) * q) + off; }
        const int nig = WGM * nN, gid = wgid / nig, fm = gid * WGM, gsz = (nM - fm) < WGM ? (nM - fm) : WGM;
        u.pm = fm + ((wgid % nig) % gsz); u.pn = (wgid % nig) / gsz; u.x0 = 0; u.x1 = 0; u.x2 = 0; u.x3 = 0;
        u.A = A + (size_t)u.pm * BM * K * 2; u.B = Bt + (size_t)u.pn * BM * K * 2; return true;
    }
    __device__ __forceinline__ void rows(const Unit&, unsigned (&)[2][2], const int (&)[2]) const {}
};

__device__ __forceinline__ unsigned cvt_pk_bf16(float lo, float hi) { unsigned r; asm volatile("v_cvt_pk_bf16_f32 %0, %1, %2" : "=v"(r) : "v"(lo), "v"(hi)); return r; }

template <class Epi, class Sched, bool ALIGN_EPI, bool GATHER, bool SKIP = false>
__device__ __forceinline__ void gemm_phase(PG8_LAS unsigned char* lds, const int K, const Sched& S, const Epi& E) {
    const int tid = threadIdx.x, wid = __builtin_amdgcn_readfirstlane(tid >> 6), lane = tid & 63, wr = wid >> 2, wc = wid & 3, fr = lane & 15, fq = lane >> 4;
    const int nt = K / BK;
    unsigned voffA[2], voffB[2]; int RA[2];
#pragma unroll
    for (int i = 0; i < 2; ++i) { int R, C; stage_rc(tid * 16 + i * 8192, R, C); const int Rb = Epi::PERM ? ((R & ~31) + perm32(R & 31)) : R;
        voffA[i] = GATHER ? (unsigned)(C * 2) : (unsigned)(R * K + C) * 2u; voffB[i] = (unsigned)(Rb * K + C) * 2u; RA[i] = R; }
    const size_t kstep = (size_t)(BK * 2);
    const size_t hstep = (size_t)HALF * K * 2;
    const size_t hstepA = GATHER ? 0 : hstep;
    const unsigned ldsw = (unsigned)wid * 1024u;
    const int aoff = lds_byte(wr * 64 + fr, fq * 8), boff = lds_byte(wc * 32 + fr, fq * 8);
    unsigned gA[2][2], gAn[2][2];
#define PG8_SA(b, h) (((b) * 2 + (h)) * HTB)
#define PG8_SB(b, h) ((4 + (b) * 2 + (h)) * HTB)
#define PG8_STAGE(bufoff, gbase, voff) do { _Pragma("unroll") for (int _i = 0; _i < 2; ++_i) \
        __builtin_amdgcn_global_load_lds((const unsigned*)((const char*)(gbase) + (voff)[_i]), (PG8_LAS unsigned*)(lds + (bufoff) + ldsw + _i * 8192), 16, 0, 0); } while (0)
#define PG8_STAGE_A(bufoff, gbase, h, nx) do { _Pragma("unroll") for (int _i = 0; _i < 2; ++_i) { \
        const unsigned _o = GATHER ? ((nx) ? gAn[h][_i] : gA[h][_i]) + voffA[_i] : voffA[_i]; \
        __builtin_amdgcn_global_load_lds((const unsigned*)((const char*)(gbase) + (h) * hstepA + _o), (PG8_LAS unsigned*)(lds + (bufoff) + ldsw + _i * 8192), 16, 0, 0); } } while (0)
#define PG8_LDA(dst, b, h) do { _Pragma("unroll") for (int m = 0; m < 4; ++m) _Pragma("unroll") for (int k = 0; k < 2; ++k) dst[m][k] = *(const PG8_LAS bf16x8*)(lds + PG8_SA(b, h) + aoff + m * 2048 + k * 1024); } while (0)
#define PG8_LDB(dst, b, h) do { _Pragma("unroll") for (int n = 0; n < 2; ++n) _Pragma("unroll") for (int k = 0; k < 2; ++k) dst[n][k] = *(const PG8_LAS bf16x8*)(lds + PG8_SB(b, h) + boff + n * 2048 + k * 1024); } while (0)
#define PG8_MMA(ai, bj, At, Bt) do { __builtin_amdgcn_s_setprio(1); _Pragma("unroll") for (int m = 0; m < 4; ++m) { if (!SKIP || m < ((ai) == 0 ? mc0 : mc1)) { _Pragma("unroll") for (int n = 0; n < 2; ++n) _Pragma("unroll") for (int k = 0; k < 2; ++k) \
        acc[ai][bj][m][n] = __builtin_amdgcn_mfma_f32_16x16x32_bf16(Bt[n][k], At[m][k], acc[ai][bj][m][n], 0, 0, 0); } } __builtin_amdgcn_s_setprio(0); } while (0)
#define PG8_WAIT_V(n) asm volatile("s_waitcnt vmcnt(" #n ")" ::: "memory")
#define PG8_WAIT_L(n) asm volatile("s_waitcnt lgkmcnt(" #n ")" ::: "memory")
#define PG8_BAR __builtin_amdgcn_s_barrier()
#define PG8_SCHED __builtin_amdgcn_sched_barrier(0)
    Unit cur, nxt; int ui = 0;
    if (!S.next(0, cur)) return;
    int mc0 = 4, mc1 = 4;
#define PG8_MC(u) do { if (SKIP) { const int a_ = ((u).x2 - 64 * wr + 15) >> 4, b_ = ((u).x2 - 128 - 64 * wr + 15) >> 4; mc0 = a_ < 0 ? 0 : (a_ > 4 ? 4 : a_); mc1 = b_ < 0 ? 0 : (b_ > 4 ? 4 : b_); } } while (0)
    PG8_MC(cur);
    f32x4 acc[2][2][4][2];
#pragma unroll
    for (int a = 0; a < 2; ++a)
#pragma unroll
        for (int b = 0; b < 2; ++b)
#pragma unroll
            for (int m = 0; m < 4; ++m)
#pragma unroll
                for (int n = 0; n < 2; ++n) acc[a][b][m][n] = (f32x4){0.f, 0.f, 0.f, 0.f};
    bf16x8 At[4][2], B0[2][2], B1[2][2];
    const char* cA = cur.A; const char* cB = cur.B;
    if constexpr (GATHER) { S.rows(cur, gA, RA);
#pragma unroll
        for (int h = 0; h < 2; ++h)
#pragma unroll
            for (int i = 0; i < 2; ++i) gAn[h][i] = gA[h][i]; }
    PG8_STAGE(PG8_SB(0, 0), cB, voffB); PG8_STAGE(PG8_SB(0, 1), cB + hstep, voffB); PG8_STAGE_A(PG8_SA(0, 0), cA, 0, false); PG8_STAGE_A(PG8_SA(0, 1), cA, 1, false);
    if (wr == 1) PG8_BAR;
    PG8_WAIT_V(2); PG8_BAR;
    PG8_STAGE(PG8_SB(1, 0), cB + kstep, voffB); PG8_STAGE_A(PG8_SA(1, 0), cA + kstep, 0, false); PG8_STAGE(PG8_SB(1, 1), cB + hstep + kstep, voffB);
    PG8_WAIT_V(6); PG8_BAR;
    for (;;) {
        const bool has_next = S.next(ui + 1, nxt);
        const char* nA = has_next ? nxt.A : cA; const char* nB = has_next ? nxt.B : cB;
        if constexpr (GATHER) { if (has_next) { S.rows(nxt, gAn, RA); } }
        for (int t = 0; t < nt; t += 2) {
            const bool last = (t == nt - 2);
            const char* a1 = cA + (size_t)(t + 1) * kstep;
            const char* a2 = last ? nA : cA + (size_t)(t + 2) * kstep; const char* b2 = last ? nB : cB + (size_t)(t + 2) * kstep;
            const char* a3 = a2 + kstep; const char* b3 = b2 + kstep;
            if constexpr (Epi::HAS_MID) { if (t == nt / 2) { int frl = fr, fql = fq; asm volatile("" : "+v"(frl), "+v"(fql)); E.mid(acc, cur, wr, wc, frl, fql); } }
            PG8_LDB(B0, 0, 0); PG8_LDB(B1, 0, 1); PG8_SCHED; PG8_LDA(At, 0, 0); PG8_STAGE_A(PG8_SA(1, 1), a1, 1, false);
            PG8_WAIT_V(8); PG8_WAIT_L(0); PG8_BAR; PG8_MMA(0, 0, At, B0); PG8_MMA(0, 1, At, B1); PG8_BAR; PG8_SCHED;
            PG8_LDA(At, 0, 1); PG8_STAGE(PG8_SB(0, 0), b2, voffB); PG8_STAGE(PG8_SB(0, 1), b2 + hstep, voffB); PG8_STAGE_A(PG8_SA(0, 0), a2, 0, last);
            PG8_WAIT_V(8); PG8_WAIT_L(0); PG8_BAR; PG8_MMA(1, 0, At, B0); PG8_MMA(1, 1, At, B1); PG8_BAR; PG8_SCHED;
            PG8_LDB(B0, 1, 0); PG8_LDB(B1, 1, 1); PG8_SCHED; PG8_LDA(At, 1, 0); PG8_STAGE_A(PG8_SA(0, 1), a2, 1, last);
            PG8_WAIT_V(8); PG8_WAIT_L(0); PG8_BAR; PG8_MMA(0, 0, At, B0); PG8_MMA(0, 1, At, B1); PG8_BAR; PG8_SCHED;
            PG8_LDA(At, 1, 1); PG8_STAGE(PG8_SB(1, 0), b3, voffB); PG8_STAGE(PG8_SB(1, 1), b3 + hstep, voffB); PG8_STAGE_A(PG8_SA(1, 0), a3, 0, last);
            PG8_WAIT_V(8); PG8_WAIT_L(0); PG8_BAR; PG8_MMA(1, 0, At, B0); PG8_MMA(1, 1, At, B1); PG8_BAR; PG8_SCHED;
        }
        if constexpr (ALIGN_EPI) { if (wr == 0) PG8_BAR; }
        { int frl = fr, fql = fq; asm volatile("" : "+v"(frl), "+v"(fql)); E(acc, cur, wr, wc, frl, fql); }
        if (!has_next) break;
#pragma unroll
        for (int a = 0; a < 2; ++a)
#pragma unroll
            for (int b = 0; b < 2; ++b)
#pragma unroll
                for (int m = 0; m < 4; ++m)
#pragma unroll
                    for (int n = 0; n < 2; ++n) acc[a][b][m][n] = (f32x4){0.f, 0.f, 0.f, 0.f};
        cur = nxt; cA = nA; cB = nB; ++ui; PG8_MC(cur);
        if constexpr (GATHER) {
#pragma unroll
            for (int h = 0; h < 2; ++h)
#pragma unroll
                for (int i = 0; i < 2; ++i) gA[h][i] = gAn[h][i]; }
        if constexpr (ALIGN_EPI) { if (wr == 1) PG8_BAR; }
    }
    PG8_WAIT_V(0);
    if constexpr (!ALIGN_EPI) { if (wr == 0) PG8_BAR; }
    PG8_BAR;
#undef PG8_SA
#undef PG8_SB
#undef PG8_STAGE
#undef PG8_STAGE_A
#undef PG8_LDA
#undef PG8_LDB
#undef PG8_MMA
#undef PG8_WAIT_V
#undef PG8_WAIT_L
#undef PG8_BAR
#undef PG8_SCHED
#undef PG8_MC
}
}

constexpr int LDS_MISC_OFF = 131072;
__device__ __forceinline__ float fast_gelu(float x) { const float y = x + 0.044715f * x * x * x; return x * __builtin_amdgcn_rcpf(1.0f + __builtin_amdgcn_exp2f(-2.0f * 0.7978845608028654f * LOG2E * y)); }
__device__ __forceinline__ float fast_sigmoid(float x) { return __builtin_amdgcn_rcpf(1.0f + __builtin_amdgcn_exp2f(-LOG2E * x)); }
__device__ __forceinline__ void unpack8(const u32x4 w, float (&v)[8]) {
#pragma unroll
    for (int e = 0; e < 4; ++e) { v[2 * e] = __uint_as_float(w[e] << 16); v[2 * e + 1] = __uint_as_float(w[e] & 0xffff0000u); } }

constexpr size_t WS_VSTAT = 6 * MiB;
constexpr int LDS_EPI_OFF = 131072 + 4096;
struct EpiIn {
    static constexpr bool PERM = true, HAS_MID = false;
    bf16_t *U, *V, *Q, *K, *VA, *G; const float* b_gate; const float* qg; const float* kg; float* VSTAT; PG8_LAS unsigned char* lds;
    __device__ __forceinline__ void mid(f32x4 (&)[2][2][4][2], const pg8::Unit&, int, int, int, int) const {}
    __device__ __forceinline__ void operator()(f32x4 (&acc)[2][2][4][2], const pg8::Unit& u, int wr, int wc, int fr, int fq) const {
        const int pn = u.pn; bf16_t* base; int ld, colt, mode;
        if (pn < 4) { base = U; ld = 1024; colt = pn * 256; mode = 1; }
        else if (pn < 8) { base = V; ld = 1024; colt = (pn - 4) * 256; mode = 3; }
        else if (pn < 12) { base = Q; ld = 1024; colt = (pn - 8) * 256; mode = 4; }
        else if (pn < 16) { base = K; ld = 1024; colt = (pn - 12) * 256; mode = 5; }
        else if (pn < 20) { base = VA; ld = 1024; colt = (pn - 16) * 256; mode = 0; }
        else { base = G; ld = 4096; colt = (pn - 20) * 256; mode = 2; }
        const int row0 = u.pm * 256 + wr * 64 + fr, col0 = colt + wc * 32 + 8 * fq;
        if (mode >= 4) {
            PG8_LAS float* P = (PG8_LAS float*)(lds + LDS_EPI_OFF);
#pragma unroll
            for (int ai = 0; ai < 2; ++ai)
#pragma unroll
                for (int m = 0; m < 4; ++m)
#pragma unroll
                    for (int bj = 0; bj < 2; ++bj) { const f32x4 a = acc[ai][bj][m][0], b = acc[ai][bj][m][1];
                        float s = (a[0] * a[0] + a[1] * a[1]) + (a[2] * a[2] + a[3] * a[3]) + (b[0] * b[0] + b[1] * b[1]) + (b[2] * b[2] + b[3] * b[3]);
                        s += __shfl_xor(s, 16); s += __shfl_xor(s, 32);
                        if (fq == 0) P[((ai * 128 + wr * 64 + m * 16 + fr) * 2 + bj) * 4 + wc] = s; }
            asm volatile("s_waitcnt lgkmcnt(0)" ::: "memory"); __builtin_amdgcn_s_barrier(); asm volatile("" ::: "memory");
            const float* gg = mode == 4 ? qg : kg; const float qs = mode == 4 ? QSCALE : 1.0f;
            const f32x4 g0 = *(const f32x4*)(gg + wc * 32 + 8 * fq), g1 = *(const f32x4*)(gg + wc * 32 + 8 * fq + 4);
#pragma unroll
            for (int ai = 0; ai < 2; ++ai)
#pragma unroll
                for (int m = 0; m < 4; ++m) { bf16_t* rowp = base + (size_t)(row0 + ai * 128 + m * 16) * ld + col0;
#pragma unroll
                    for (int bj = 0; bj < 2; ++bj) { const f32x4 pp = *(const PG8_LAS f32x4*)(P + ((ai * 128 + wr * 64 + m * 16 + fr) * 2 + bj) * 4);
                        const float sc = rsqrtf(((pp[0] + pp[1]) + (pp[2] + pp[3])) * (1.f / 128.f) + EPS) * qs;
                        const f32x4 v0 = acc[ai][bj][m][0] * g0 * sc, v1 = acc[ai][bj][m][1] * g1 * sc;
                        u32x4 w; w.x = pg8::cvt_pk_bf16(v0[0], v0[1]); w.y = pg8::cvt_pk_bf16(v0[2], v0[3]); w.z = pg8::cvt_pk_bf16(v1[0], v1[1]); w.w = pg8::cvt_pk_bf16(v1[2], v1[3]);
                        *(u32x4*)(rowp + bj * 128) = w; } }
            return;
        }
        f32x4 bv[2][2];
#pragma unroll
        for (int bj = 0; bj < 2; ++bj)
#pragma unroll
            for (int n = 0; n < 2; ++n) bv[bj][n] = (mode == 2) ? *(const f32x4*)(b_gate + col0 + bj * 128 + 4 * n) : (f32x4){0.f, 0.f, 0.f, 0.f};
#pragma unroll
        for (int ai = 0; ai < 2; ++ai)
#pragma unroll
            for (int m = 0; m < 4; ++m) { bf16_t* rowp = base + (size_t)(row0 + ai * 128 + m * 16) * ld + col0; float s1 = 0.f, s2 = 0.f;
#pragma unroll
                for (int bj = 0; bj < 2; ++bj) { f32x4 v0 = acc[ai][bj][m][0], v1 = acc[ai][bj][m][1];
                    if (mode == 1 || mode == 3) {
#pragma unroll
                        for (int j = 0; j < 4; ++j) { v0[j] = fast_gelu(v0[j]); v1[j] = fast_gelu(v1[j]); } }
                    else if (mode == 2) { v0 += bv[bj][0]; v1 += bv[bj][1];
#pragma unroll
                        for (int j = 0; j < 4; ++j) { v0[j] = fast_sigmoid(v0[j]); v1[j] = fast_sigmoid(v1[j]); } }
                    if (mode == 3) {
#pragma unroll
                        for (int j = 0; j < 4; ++j) { s1 += v0[j] + v1[j]; s2 += v0[j] * v0[j] + v1[j] * v1[j]; } }
                    u32x4 w; w.x = pg8::cvt_pk_bf16(v0[0], v0[1]); w.y = pg8::cvt_pk_bf16(v0[2], v0[3]); w.z = pg8::cvt_pk_bf16(v1[0], v1[1]); w.w = pg8::cvt_pk_bf16(v1[2], v1[3]);
                    *(u32x4*)(rowp + bj * 128) = w; }
                if (mode == 3) { s1 += __shfl_xor(s1, 16); s1 += __shfl_xor(s1, 32); s2 += __shfl_xor(s2, 16); s2 += __shfl_xor(s2, 32);
                    if (fq == 0) { typedef float f32x2_ __attribute__((ext_vector_type(2))); *(f32x2_*)(VSTAT + ((size_t)(row0 + ai * 128 + m * 16) * 16 + (pn - 4) * 4 + wc) * 2) = (f32x2_){s1, s2}; } } }
    }
};
struct EpiProj {
    static constexpr bool PERM = true, HAS_MID = true;
    const bf16_t* G; bf16_t* O;
    __device__ __forceinline__ void mid(f32x4 (&acc)[2][2][4][2], const pg8::Unit& u, int wr, int wc, int fr, int fq) const {
        const int row0 = u.pm * 256 + wr * 64 + fr, col0 = u.pn * 256 + wc * 32 + 8 * fq;
#pragma unroll
        for (int ai = 0; ai < 2; ++ai) { u32x4 ws[4][2], wf[4][2];
#pragma unroll
            for (int m = 0; m < 4; ++m) { const bf16_t* gp = G + (size_t)(row0 + ai * 128 + m * 16) * 4096 + col0;
#pragma unroll
                for (int bj = 0; bj < 2; ++bj) { ws[m][bj] = *(const u32x4*)(gp + bj * 128); wf[m][bj] = *(const u32x4*)(gp + 2048 + bj * 128); } }
#pragma unroll
            for (int m = 0; m < 4; ++m)
#pragma unroll
                for (int bj = 0; bj < 2; ++bj) { float gs[8], gf[8]; unpack8(ws[m][bj], gs); unpack8(wf[m][bj], gf);
#pragma unroll
                    for (int j = 0; j < 4; ++j) { acc[ai][bj][m][0][j] *= gs[j] * __builtin_amdgcn_rcpf(gf[j]); acc[ai][bj][m][1][j] *= gs[4 + j] * __builtin_amdgcn_rcpf(gf[4 + j]); } }
            asm volatile("" ::: "memory"); }
    }
    __device__ __forceinline__ void operator()(f32x4 (&acc)[2][2][4][2], const pg8::Unit& u, int wr, int wc, int fr, int fq) const {
        const int row0 = u.pm * 256 + wr * 64 + fr, col0 = u.pn * 256 + wc * 32 + 8 * fq;
#pragma unroll
        for (int ai = 0; ai < 2; ++ai) { u32x4 wf[4][2];
#pragma unroll
            for (int m = 0; m < 4; ++m)
#pragma unroll
                for (int bj = 0; bj < 2; ++bj) wf[m][bj] = *(const u32x4*)(G + (size_t)(row0 + ai * 128 + m * 16) * 4096 + 2048 + col0 + bj * 128);
#pragma unroll
            for (int m = 0; m < 4; ++m) { const size_t r = (size_t)(row0 + ai * 128 + m * 16);
#pragma unroll
                for (int bj = 0; bj < 2; ++bj) { float gf[8]; unpack8(wf[m][bj], gf);
                    const f32x4 v0 = acc[ai][bj][m][0], v1 = acc[ai][bj][m][1];
                    u32x4 w; w.x = pg8::cvt_pk_bf16(v0[0] * gf[0], v0[1] * gf[1]); w.y = pg8::cvt_pk_bf16(v0[2] * gf[2], v0[3] * gf[3]); w.z = pg8::cvt_pk_bf16(v1[0] * gf[4], v1[1] * gf[5]); w.w = pg8::cvt_pk_bf16(v1[2] * gf[6], v1[3] * gf[7]);
                    *(u32x4*)(O + r * 2048 + col0 + bj * 128) = w; } }
            asm volatile("" ::: "memory"); }
    }
};
struct EpiOut {
    static constexpr bool PERM = false, HAS_MID = false;
    const float* X; float* O;
    __device__ __forceinline__ void mid(f32x4 (&)[2][2][4][2], const pg8::Unit&, int, int, int, int) const {}
    __device__ __forceinline__ void operator()(f32x4 (&acc)[2][2][4][2], const pg8::Unit& u, int wr, int wc, int fr, int fq) const {
        const int row0 = u.pm * 256 + wr * 64 + fr, col0 = u.pn * 256 + wc * 32 + 4 * fq;
#pragma unroll
        for (int ai = 0; ai < 2; ++ai) { f32x4 xv[4][2][2];
#pragma unroll
            for (int m = 0; m < 4; ++m) { const size_t off = (size_t)(row0 + ai * 128 + m * 16) * DM + col0;
#pragma unroll
                for (int bj = 0; bj < 2; ++bj)
#pragma unroll
                    for (int n = 0; n < 2; ++n) xv[m][bj][n] = *(const f32x4*)(X + off + bj * 128 + n * 16); }
#pragma unroll
            for (int m = 0; m < 4; ++m) { const size_t off = (size_t)(row0 + ai * 128 + m * 16) * DM + col0;
#pragma unroll
                for (int bj = 0; bj < 2; ++bj)
#pragma unroll
                    for (int n = 0; n < 2; ++n) *(f32x4*)(O + off + bj * 128 + n * 16) = xv[m][bj][n] + acc[ai][bj][m][n]; }
            asm volatile("" ::: "memory"); }
    }
};
struct EpiGateUp {
    static constexpr bool PERM = true, HAS_MID = false;
    bf16_t* ACT; const float* RSTL;
    __device__ __forceinline__ void mid(f32x4 (&)[2][2][4][2], const pg8::Unit&, int, int, int, int) const {}
    __device__ __forceinline__ void operator()(f32x4 (&acc)[2][2][4][2], const pg8::Unit& u, int wr, int wc, int fr, int fq) const {
        const int row0 = u.x0 + wr * 64 + fr, col0 = u.pn * 128 + wc * 32 + 8 * fq;
        float rrv[2][4];
#pragma unroll
        for (int ai = 0; ai < 2; ++ai)
#pragma unroll
            for (int m = 0; m < 4; ++m) rrv[ai][m] = RSTL[u.x1 + wr * 64 + fr + ai * 128 + m * 16];
#pragma unroll
        for (int ai = 0; ai < 2; ++ai)
#pragma unroll
            for (int m = 0; m < 4; ++m) { float o[8]; const float rr = rrv[ai][m];
#pragma unroll
                for (int n = 0; n < 2; ++n)
#pragma unroll
                    for (int j = 0; j < 4; ++j) { const float g = acc[ai][0][m][n][j] * rr, up = acc[ai][1][m][n][j] * rr; o[4 * n + j] = g * fast_sigmoid(g) * up; }
                u32x4 w; w.x = pg8::cvt_pk_bf16(o[0], o[1]); w.y = pg8::cvt_pk_bf16(o[2], o[3]); w.z = pg8::cvt_pk_bf16(o[4], o[5]); w.w = pg8::cvt_pk_bf16(o[6], o[7]);
                *(u32x4*)(ACT + (size_t)(row0 + ai * 128 + m * 16) * DEXP + col0) = w; }
    }
};
struct EpiDown {
    static constexpr bool PERM = true, HAS_MID = false;
    bf16_t* Y; const float* GATE;
    __device__ __forceinline__ void mid(f32x4 (&)[2][2][4][2], const pg8::Unit&, int, int, int, int) const {}
    __device__ __forceinline__ void operator()(f32x4 (&acc)[2][2][4][2], const pg8::Unit& u, int wr, int wc, int fr, int fq) const {
        const int rl0 = wr * 64 + fr, col0 = u.pn * 256 + wc * 32 + 8 * fq;
        float gtv[2][4];
#pragma unroll
        for (int ai = 0; ai < 2; ++ai)
#pragma unroll
            for (int m = 0; m < 4; ++m) gtv[ai][m] = GATE[u.x1 + rl0 + ai * 128 + m * 16];
#pragma unroll
        for (int ai = 0; ai < 2; ++ai)
#pragma unroll
            for (int m = 0; m < 4; ++m) { const int rl = rl0 + ai * 128 + m * 16; const float gt = gtv[ai][m];
#pragma unroll
                for (int bj = 0; bj < 2; ++bj) { const f32x4 v0 = acc[ai][bj][m][0] * gt, v1 = acc[ai][bj][m][1] * gt;
                    u32x4 w; w.x = pg8::cvt_pk_bf16(v0[0], v0[1]); w.y = pg8::cvt_pk_bf16(v0[2], v0[3]); w.z = pg8::cvt_pk_bf16(v1[0], v1[1]); w.w = pg8::cvt_pk_bf16(v1[2], v1[3]);
                    *(u32x4*)(Y + (size_t)(u.x0 + rl) * DM + col0 + bj * 128) = w; } }
    }
};
struct MoeOrder {
    const char* Abase; const char* Bbase; size_t Bstride; int K, nN, G, c; bool gather;
    const PG8_LAS int* ps;
    const unsigned* cnt; const int* TOK; bool xcdm;
    __device__ static int tile_of(int i, int c, int G, int nN, int nb, int& pn, bool xcdm) {
        const int S = (G / 8) / nN;
        if (!xcdm || G % 8 != 0 || S < 1) { const int L = i * G + c; pn = L % nN; return L / nN < nb ? L / nN : -1; }
        const int x = c % 8, slot = c / 8; pn = slot % nN;
        if (slot >= S * nN) return -1;
        const int sidx = i * (8 * S) + x * S + slot / nN; return sidx < nb ? sidx : -1;
    }
    __device__ bool next(int i, pg8::Unit& u) const {
        int pn; const int sidx = tile_of(i, c, G, nN, ps[NEXP + 2], pn, xcdm); if (sidx < 0) return false;
        const int prow = ps[40 + sidx], info = ps[40 + MT_MAX + sidx], valid = ps[40 + 2 * MT_MAX + sidx];
        const int e = info >> 16, mt = info & 0xffff;
        u.pm = mt; u.pn = pn; u.x0 = prow; u.x1 = e * T + mt * MTILE; u.x2 = valid; u.x3 = e;
        u.A = gather ? Abase : Abase + (size_t)prow * K * 2; u.B = Bbase + (size_t)e * Bstride + (size_t)pn * 256 * K * 2; return true;
    }
    __device__ __forceinline__ void rows(const pg8::Unit& u, unsigned (&g)[2][2], const int (&RA)[2]) const {
#pragma unroll
        for (int h = 0; h < 2; ++h)
#pragma unroll
            for (int i = 0; i < 2; ++i) { int r = RA[i] + 128 * h; r = r < u.x2 ? r : u.x2 - 1; g[h][i] = (unsigned)TOK[u.x1 + r] * (unsigned)(K * 2); }
    }
};

struct TItem { const float* src; bf16_t* dst; int ld_src, ld_dst; };
__device__ __forceinline__ void titem_load(const TItem& t, f32x4 (&v)[8], int lane) {
#pragma unroll
    for (int i = 0; i < 8; ++i) v[i] = *(const f32x4*)(t.src + (size_t)((lane >> 3) + 8 * i) * t.ld_src + 4 * (lane & 7));
}
__device__ __forceinline__ void titem_store(const TItem& t, const f32x4 (&v)[8], PG8_LAS float* scr, int lane) {
#pragma unroll
    for (int i = 0; i < 8; ++i) { PG8_LAS float* d = scr + ((lane >> 3) + 8 * i) * 33 + 4 * (lane & 7); d[0] = v[i].x; d[1] = v[i].y; d[2] = v[i].z; d[3] = v[i].w; }
    asm volatile("s_waitcnt lgkmcnt(0)" ::: "memory");
    const int c = lane & 7;
#pragma unroll
    for (int j = 0; j < 4; ++j) { const int n = (lane >> 3) + 8 * j; const PG8_LAS float* s = scr + (8 * c) * 33 + n;
        u32x4 o; o.x = pk2(s[0 * 33], s[1 * 33]); o.y = pk2(s[2 * 33], s[3 * 33]); o.z = pk2(s[4 * 33], s[5 * 33]); o.w = pk2(s[6 * 33], s[7 * 33]);
        *(u32x4*)(t.dst + (size_t)n * t.ld_dst + 8 * c) = o; }
    asm volatile("s_waitcnt lgkmcnt(0)" ::: "memory");
}
constexpr int TI0 = 32 * 288, TI1 = 16 * 64, TI2 = 16 * 64, TI3 = 32 * 64, TI4 = 32 * 512, TI5 = 32 * 512, TI6 = 32 * 512;
constexpr int TI_ALL = TI0 + TI1 + TI2 + TI3 + TI4 + TI5 + TI6;
#ifndef TAIL1_ITEMS
#define TAIL1_ITEMS (TI5)
#endif
__device__ __forceinline__ TItem titem_decode(const Args& A, int r) {
    bf16_t* WIN = (bf16_t*)(A.ws + WS_WIN); bf16_t* WPROJ = (bf16_t*)(A.ws + WS_WPROJ); bf16_t* WOUT = (bf16_t*)(A.ws + WS_WOUT); bf16_t* WGU = (bf16_t*)(A.ws + WS_WGU); bf16_t* WD = (bf16_t*)(A.ws + WS_WD);
    TItem t;
    if (r < TI0) { const int kb = r / 288, nb = r % 288; t.src = A.in[2] + (size_t)(64 * kb) * INCOLS + 32 * nb + (nb >= 160 ? 8 : 0); t.ld_src = INCOLS; t.dst = WIN + (size_t)(32 * nb) * 2048 + 64 * kb; t.ld_dst = 2048; return t; } r -= TI0;
    if (r < TI1) { const int kb = r / 64, nb = r % 64; t.src = A.in[11] + (size_t)(64 * kb) * DM + 32 * nb; t.ld_src = DM; t.dst = WPROJ + (size_t)(32 * nb) * 2048 + 64 * kb; t.ld_dst = 2048; return t; } r -= TI1;
    if (r < TI2) { const int kb = r / 64, nb = r % 64; t.src = A.in[12] + (size_t)(64 * kb) * DM + 32 * nb; t.ld_src = DM; t.dst = WPROJ + (size_t)(32 * nb) * 2048 + 1024 + 64 * kb; t.ld_dst = 2048; return t; } r -= TI2;
    if (r < TI3) { const int kb = r / 64, nb = r % 64; t.src = A.in[13] + (size_t)(64 * kb) * DM + 32 * nb; t.ld_src = DM; t.dst = WOUT + (size_t)(32 * nb) * 2048 + 64 * kb; t.ld_dst = 2048; return t; } r -= TI3;
    if (r < TI4 + TI5) { const int up = r >= TI4; if (up) r -= TI4; const int e = r / 512, q = r % 512, kb = q / 16, nb = q % 16, n = 32 * nb, drow = 256 * (n >> 7) + (n & 127) + (up ? 128 : 0);
        t.src = A.in[up ? 20 : 19] + (size_t)e * DM * DEXP + (size_t)(64 * kb) * DEXP + n; t.ld_src = DEXP; t.dst = WGU + ((size_t)e * 1024 + drow) * 2048 + 64 * kb; t.ld_dst = 2048; return t; } r -= TI4 + TI5;
    { const int e = r / 512, q = r % 512, kb = q / 64, nb = q % 64; t.src = A.in[21] + (size_t)e * DEXP * DM + (size_t)(64 * kb) * DM + 32 * nb; t.ld_src = DM; t.dst = WD + ((size_t)e * 2048 + 32 * nb) * 512 + 64 * kb; t.ld_dst = 512; return t; }
}
__device__ __forceinline__ void p0_weights(const Args& A, PG8_LAS unsigned char* lds, const int part, const int wrank, const int wcount) {
    const int tid = threadIdx.x, lane = tid & 63, wave = tid >> 6;
    PG8_LAS float* scr = (PG8_LAS float*)(lds + wave * 16384);
    if (wrank < 0 || wcount < 1) return;
    const int gw = wrank * NWAVES + wave, NGW = wcount * NWAVES;
    const int cut1 = TI_ALL - TI6 - TAIL1_ITEMS, cut2 = TI_ALL - TI6;
    const int it_lo = part == 0 ? 0 : (part == 1 ? cut1 : cut2), it_hi = part == 0 ? cut1 : (part == 1 ? cut2 : TI_ALL);
    int it = it_lo + gw; if (it >= it_hi) return;
    TItem cur = titem_decode(A, it); f32x4 va[8], vb[8];
    titem_load(cur, va, lane);
    for (;;) {
        const int itn = it + NGW; const bool more = itn < it_hi; TItem nx = cur;
        if (more) { nx = titem_decode(A, itn); titem_load(nx, vb, lane); }
        titem_store(cur, va, scr, lane);
        if (!more) break;
#pragma unroll
        for (int i = 0; i < 8; ++i) va[i] = vb[i];
        cur = nx; it = itn;
    }
}

__device__ __forceinline__ void p1_fast(const Args& A, PG8_LAS unsigned char* lds) {
    pg8::DenseOrder S; S.init(A.ws + WS_H, A.ws + WS_WIN, T, 9216, DM, gridDim.x, blockIdx.x, PROBE_REP_P1);
    EpiIn E{(bf16_t*)(A.ws + WS_U), (bf16_t*)(A.ws + WS_V), (bf16_t*)(A.ws + WS_Q), (bf16_t*)(A.ws + WS_K), (bf16_t*)(A.ws + WS_VA), (bf16_t*)(A.ws + WS_G), A.in[3], A.in[9], A.in[10], (float*)(A.ws + WS_VSTAT), lds};
    pg8::gemm_phase<EpiIn, pg8::DenseOrder, true, false>(lds, DM, S, E);
}
__device__ __forceinline__ void p3_fast(const Args& A, PG8_LAS unsigned char* lds) {
    pg8::DenseOrder S; S.init(A.ws + WS_MIXIN, A.ws + WS_WPROJ, T, DM, 2048, gridDim.x, blockIdx.x, PROBE_REP_P4);
    EpiProj E{(const bf16_t*)(A.ws + WS_G), (bf16_t*)(A.ws + WS_MIXED)};
    pg8::gemm_phase<EpiProj, pg8::DenseOrder, true, false>(lds, 2048, S, E);
}
__device__ __forceinline__ void p4_fast(const Args& A, PG8_LAS unsigned char* lds) {
    pg8::DenseOrder S; S.init(A.ws + WS_MIXED, A.ws + WS_WOUT, T, DM, DM, gridDim.x, blockIdx.x, PROBE_REP_P5);
    EpiOut E{A.in[0], A.out};
    pg8::gemm_phase<EpiOut, pg8::DenseOrder, true, false>(lds, DM, S, E);
}
__device__ __forceinline__ void moe_layout_lds(const Args& A, PG8_LAS unsigned char* lds) {
    PG8_LAS int* ps = (PG8_LAS int*)(lds + LDS_MISC_OFF); PG8_LAS int* tprow = ps + 40; PG8_LAS int* tinfo = tprow + MT_MAX; PG8_LAS int* tvalid = tinfo + MT_MAX;
    const unsigned* cnt = (const unsigned*)(A.ws + WS_CTL) + CW_CNT;
    if (threadIdx.x == 0) { int acc = 0;
        for (int e = 0; e < NEXP; ++e) { ps[e] = acc; acc += ((int)cnt[(e) * CNT_STRIDE] + MTILE - 1) / MTILE * MTILE; }
        ps[NEXP] = acc; ps[NEXP + 1] = acc / MTILE; }
    __syncthreads();
    const int nt = ps[NEXP + 1]; PG8_LAS int* uval = tvalid + MT_MAX;
    int prow = 0, e = 0, mt = 0, valid = 0;
    if ((int)threadIdx.x < nt) { prow = (int)threadIdx.x * MTILE;
        for (int j = 1; j < NEXP; ++j) if (ps[j] <= prow) e = j;
        mt = (prow - ps[e]) / MTILE; valid = (int)cnt[(e) * CNT_STRIDE] - mt * MTILE; valid = valid > MTILE ? MTILE : valid; uval[threadIdx.x] = valid; }
    __syncthreads();
    if ((int)threadIdx.x < nt) { int rank = 0;
        if (TINY_ROWS > 0) { for (int j = 0; j < nt; ++j) { const int vj = uval[j]; rank += (vj > valid || (vj == valid && j < (int)threadIdx.x)) ? 1 : 0; } } else rank = (int)threadIdx.x;
        tprow[rank] = prow; tinfo[rank] = (e << 16) | mt; tvalid[rank] = valid; }
    if (threadIdx.x == 0) { int nb = 0; for (int j = 0; j < nt; ++j) nb += uval[j] > TINY_ROWS ? 1 : 0; ps[NEXP + 2] = nb; }
    __syncthreads();
}
namespace sm {
typedef short bf16x8 __attribute__((ext_vector_type(8))); typedef float f32x16 __attribute__((ext_vector_type(16)));
constexpr int TINY = 64;
__device__ __forceinline__ void gateup_small(const Args& A, PG8_LAS unsigned char* lds) {
    const PG8_LAS int* ps = (const PG8_LAS int*)(lds + LDS_MISC_OFF); const int nt = ps[NEXP + 1], nbig = ps[NEXP + 2];
    const bf16_t* H2 = (const bf16_t*)(A.ws + WS_H2); const bf16_t* WGU = (const bf16_t*)(A.ws + WS_WGU); bf16_t* ACT = (bf16_t*)(A.ws + WS_ACT); const int* TOK = (const int*)(A.ws + WS_TOK);
    const int tid = threadIdx.x, lane = tid & 63, w = __builtin_amdgcn_readfirstlane(tid >> 6), r32 = lane & 31, hi = lane >> 5;
    PG8_LAS float* red = (PG8_LAS float*)lds;
    for (int su = blockIdx.x; su < (nt - nbig) * 16; su += gridDim.x) {
        const int sidx = nbig + (su >> 4), sl = su & 15; const int prow = ps[40 + sidx], info = ps[40 + MT_MAX + sidx], valid = ps[40 + 2 * MT_MAX + sidx];
        const int e = info >> 16, mt = info & 0xffff, lbase = e * T + mt * MTILE;
        const int ra = r32 < valid ? r32 : valid - 1, rb = 32 + r32 < valid ? 32 + r32 : valid - 1;
        const bf16_t* a0p = H2 + (size_t)TOK[lbase + ra] * DM + 256 * w + 8 * hi; const bf16_t* a1p = H2 + (size_t)TOK[lbase + rb] * DM + 256 * w + 8 * hi;
        const bf16_t* b0p = WGU + ((size_t)e * 1024 + 256 * (sl >> 2) + 32 * (sl & 3) + r32) * DM + 256 * w + 8 * hi; const bf16_t* b1p = b0p + (size_t)128 * DM;
        f32x16 acc[2][2];
#pragma unroll
        for (int i = 0; i < 2; ++i)
#pragma unroll
            for (int j = 0; j < 2; ++j)
#pragma unroll
                for (int r = 0; r < 16; ++r) acc[i][j][r] = 0.f;
#pragma unroll 4
        for (int ks = 0; ks < 16; ++ks) { const bf16x8 a0 = *(const bf16x8*)(a0p + 16 * ks), a1 = *(const bf16x8*)(a1p + 16 * ks), b0 = *(const bf16x8*)(b0p + 16 * ks), b1 = *(const bf16x8*)(b1p + 16 * ks);
            acc[0][0] = __builtin_amdgcn_mfma_f32_32x32x16_bf16(a0, b0, acc[0][0], 0, 0, 0); acc[0][1] = __builtin_amdgcn_mfma_f32_32x32x16_bf16(a0, b1, acc[0][1], 0, 0, 0);
            acc[1][0] = __builtin_amdgcn_mfma_f32_32x32x16_bf16(a1, b0, acc[1][0], 0, 0, 0); acc[1][1] = __builtin_amdgcn_mfma_f32_32x32x16_bf16(a1, b1, acc[1][1], 0, 0, 0); }
#pragma unroll
        for (int i = 0; i < 2; ++i)
#pragma unroll
            for (int j = 0; j < 2; ++j)
#pragma unroll
                for (int r = 0; r < 16; ++r) red[(((w * 2 + i) * 2 + j) * 16 + r) * 64 + lane] = acc[i][j][r];
        __syncthreads();
#pragma unroll
        for (int i = 0; i < 2; ++i)
#pragma unroll
            for (int rr = 0; rr < 2; ++rr) { const int r = 2 * w + rr; float g = 0.f, u = 0.f;
#pragma unroll
                for (int w2 = 0; w2 < 8; ++w2) { g += red[(((w2 * 2 + i) * 2 + 0) * 16 + r) * 64 + lane]; u += red[(((w2 * 2 + i) * 2 + 1) * 16 + r) * 64 + lane]; }
                const int row = 32 * i + (r & 3) + 8 * (r >> 2) + 4 * hi; const float rr2 = ((const float*)(A.ws + WS_RSTL))[lbase + (row < valid ? row : valid - 1)]; g *= rr2; u *= rr2;
                ACT[(size_t)(prow + row) * DEXP + 32 * sl + r32] = f2bf(g * fast_sigmoid(g) * u); }
        __syncthreads();
    }
}
__device__ __forceinline__ void down_small(const Args& A, PG8_LAS unsigned char* lds) {
    const PG8_LAS int* ps = (const PG8_LAS int*)(lds + LDS_MISC_OFF); const int nt = ps[NEXP + 1], nbig = ps[NEXP + 2];
    const bf16_t* ACT = (const bf16_t*)(A.ws + WS_ACT); const bf16_t* WD = (const bf16_t*)(A.ws + WS_WD); bf16_t* Y = (bf16_t*)(A.ws + WS_YBUF); const float* GATE = (const float*)(A.ws + WS_GATE);
    const int tid = threadIdx.x, lane = tid & 63, w = __builtin_amdgcn_readfirstlane(tid >> 6), wn = w & 3, wk = w >> 2, r32 = lane & 31, hi = lane >> 5;
    PG8_LAS float* red = (PG8_LAS float*)lds;
    for (int su = blockIdx.x; su < (nt - nbig) * 16; su += gridDim.x) {
        const int sidx = nbig + (su >> 4), sl = su & 15; const int prow = ps[40 + sidx], info = ps[40 + MT_MAX + sidx], valid = ps[40 + 2 * MT_MAX + sidx];
        const int e = info >> 16, mt = info & 0xffff, lbase = e * T + mt * MTILE;
        const int ra = r32 < valid ? r32 : valid - 1, rb = 32 + r32 < valid ? 32 + r32 : valid - 1;
        const bf16_t* a0p = ACT + (size_t)(prow + ra) * DEXP + 256 * wk + 8 * hi; const bf16_t* a1p = ACT + (size_t)(prow + rb) * DEXP + 256 * wk + 8 * hi;
        const bf16_t* bp = WD + ((size_t)e * 2048 + 128 * sl + 32 * wn + r32) * DEXP + 256 * wk + 8 * hi;
        f32x16 acc[2];
#pragma unroll
        for (int i = 0; i < 2; ++i)
#pragma unroll
            for (int r = 0; r < 16; ++r) acc[i][r] = 0.f;
#pragma unroll 4
        for (int ks = 0; ks < 16; ++ks) { const bf16x8 a0 = *(const bf16x8*)(a0p + 16 * ks), a1 = *(const bf16x8*)(a1p + 16 * ks), b = *(const bf16x8*)(bp + 16 * ks);
            acc[0] = __builtin_amdgcn_mfma_f32_32x32x16_bf16(a0, b, acc[0], 0, 0, 0); acc[1] = __builtin_amdgcn_mfma_f32_32x32x16_bf16(a1, b, acc[1], 0, 0, 0); }
        if (wk == 1) {
#pragma unroll
            for (int i = 0; i < 2; ++i)
#pragma unroll
                for (int r = 0; r < 16; ++r) red[((wn * 2 + i) * 16 + r) * 64 + lane] = acc[i][r]; }
        __syncthreads();
        if (wk == 0) {
#pragma unroll
            for (int i = 0; i < 2; ++i)
#pragma unroll
                for (int r = 0; r < 16; ++r) { const int row = 32 * i + (r & 3) + 8 * (r >> 2) + 4 * hi; const float gt = GATE[lbase + (row < valid ? row : valid - 1)];
                    Y[(size_t)(prow + row) * DM + 128 * sl + 32 * wn + r32] = f2bf((acc[i][r] + red[((wn * 2 + i) * 16 + r) * 64 + lane]) * gt); } }
        __syncthreads();
    }
}
}

__device__ __forceinline__ void p6_fast(const Args& A, PG8_LAS unsigned char* lds) {
    moe_layout_lds(A, lds);
    MoeOrder S{(const char*)(A.ws + WS_H2), (const char*)(A.ws + WS_WGU), (size_t)1024 * 2048 * 2, DM, 4, (int)gridDim.x, (int)blockIdx.x, true,
               (const PG8_LAS int*)(lds + LDS_MISC_OFF), (const unsigned*)(A.ws + WS_CTL) + CW_CNT, (const int*)(A.ws + WS_TOK), XCDM_GU};
    EpiGateUp E{(bf16_t*)(A.ws + WS_ACT), (const float*)(A.ws + WS_RSTL)};
    pg8::gemm_phase<EpiGateUp, MoeOrder, true, true>(lds, DM, S, E);
    sm::gateup_small(A, lds);
    {
        PG8_LAS int* pw = (PG8_LAS int*)(lds + LDS_MISC_OFF) + 40 + 4 * MT_MAX;
        const int nb = ((const PG8_LAS int*)(lds + LDS_MISC_OFF))[NEXP + 2], G = (int)gridDim.x; int pn_;
        const int per = XCDM_GU ? 8 * ((G / 8) / 4) : G / 4, rounds = per > 0 ? (nb + per - 1) / per : 1;
        const int t = (int)threadIdx.x; const bool idle_t = t < G && MoeOrder::tile_of(rounds - 1, t, G, 4, nb, pn_, XCDM_GU) < 0;
        float before = (idle_t && t < (int)blockIdx.x) ? 1.f : 0.f, all = idle_t ? 1.f : 0.f;
        before = wave_sum(before); all = wave_sum(all);
        __syncthreads();
        if ((t & 63) == 0) { pw[2 + (t >> 6)] = (int)before; pw[10 + (t >> 6)] = (int)all; }
        __syncthreads();
        if (t == 0) { int rk = 0, tot = 0; for (int w = 0; w < NWAVES; ++w) { rk += pw[2 + w]; tot += pw[10 + w]; }
            const bool me_idle = MoeOrder::tile_of(rounds - 1, (int)blockIdx.x, G, 4, nb, pn_, XCDM_GU) < 0;
            pw[0] = tot == 0 ? (int)blockIdx.x : (me_idle ? rk : -1); pw[1] = tot == 0 ? G : tot; }
        __syncthreads();
        p0_weights(A, lds, 2, pw[0], pw[1]); }
}
__device__ __forceinline__ void p7_fast(const Args& A, PG8_LAS unsigned char* lds) {
    moe_layout_lds(A, lds);
    MoeOrder S{(const char*)(A.ws + WS_ACT), (const char*)(A.ws + WS_WD), (size_t)2048 * 512 * 2, DEXP, 8, (int)gridDim.x, (int)blockIdx.x, false,
               (const PG8_LAS int*)(lds + LDS_MISC_OFF), (const unsigned*)(A.ws + WS_CTL) + CW_CNT, (const int*)(A.ws + WS_TOK), true};
    EpiDown E{(bf16_t*)(A.ws + WS_YBUF), (const float*)(A.ws + WS_GATE)};
    pg8::gemm_phase<EpiDown, MoeOrder, true, false>(lds, DEXP, S, E);
    sm::down_small(A, lds);
}

namespace fa {
typedef short bf16x8 __attribute__((ext_vector_type(8)));
typedef short v4i16 __attribute__((ext_vector_type(4)));
typedef float f32x16 __attribute__((ext_vector_type(16)));
#define FA_LAS __attribute__((address_space(3)))
constexpr int KVBUF = 65536, LDS_CK = 131072, LDS_ML = 131072 + 8192;
__device__ __forceinline__ unsigned cvtpk(float lo, float hi) { unsigned r; asm("v_cvt_pk_bf16_f32 %0, %1, %2" : "=v"(r) : "v"(lo), "v"(hi)); return r; }
__device__ __forceinline__ bf16x8 pack8(const f32x16& p, int b) { u32x4 w; w.x = cvtpk(p[b], p[b + 1]); w.y = cvtpk(p[b + 2], p[b + 3]); w.z = cvtpk(p[b + 4], p[b + 5]); w.w = cvtpk(p[b + 6], p[b + 7]); return __builtin_bit_cast(bf16x8, w); }
__device__ __forceinline__ float swapmax(float v) { auto rr = __builtin_amdgcn_permlane32_swap(__float_as_uint(v), __float_as_uint(v), false, false); return fmaxf(__uint_as_float(rr[0]), __uint_as_float(rr[1])); }
__device__ __forceinline__ float swapsum(float v) { auto rr = __builtin_amdgcn_permlane32_swap(__float_as_uint(v), __float_as_uint(v), false, false); return __uint_as_float(rr[0]) + __uint_as_float(rr[1]); }
#define FA_WAITBAR() do { asm volatile("s_waitcnt vmcnt(0) lgkmcnt(0)" ::: "memory"); __builtin_amdgcn_s_barrier(); asm volatile("" ::: "memory"); } while (0)

__device__ __forceinline__ void attn_phase(const Args& A, FA_LAS unsigned char* lds) {
    const bf16_t* Q = (const bf16_t*)(A.ws + WS_Q); const bf16_t* Kt = (const bf16_t*)(A.ws + WS_K); const bf16_t* Vt = (const bf16_t*)(A.ws + WS_VA);
    const float* CKL = (const float*)(A.ws + WS_CKL); bf16_t* MIXIN = (bf16_t*)(A.ws + WS_MIXIN);
    const int tid = threadIdx.x, lane = tid & 63, wid = __builtin_amdgcn_readfirstlane(tid >> 6), rg = wid & 3, kh = wid >> 2, r32 = lane & 31, hi = lane >> 5;
    int koff[4];
#pragma unroll
    for (int i = 0; i < 4; ++i) { const int rl = 4 * i + (lane >> 4); koff[i] = rl * 1024 + (((lane & 15) ^ rl) * 8); }
    const int voff = (lane >> 4) * 1024 + (((lane & 15) ^ ((lane >> 4) << 2)) * 8);
    int kfo[8];
#pragma unroll
    for (int d0 = 0; d0 < 8; ++d0) kfo[d0] = (kh * 64 + r32) * 256 + (((2 * d0 + hi) ^ (r32 & 15)) * 16);
    int vfo[4];
    { const int dh = (lane >> 4) & 1, q = (lane & 15) >> 2, p = lane & 3;
#pragma unroll
      for (int db = 0; db < 4; ++db) vfo[db] = (kh * 64 + 4 * hi + q) * 256 + ((db ^ q) * 64) + dh * 32 + p * 8; }
    const unsigned ldsb = (unsigned)(uintptr_t)lds;
    const int G = gridDim.x;
    for (int vb0 = blockIdx.x; vb0 < 256 * PROBE_REP_ATTN; vb0 += G) { const int vb = vb0 % 256;
        const int item = (G % 8 == 0) ? ((vb % 8) * 32 + (vb / 8)) % 256 : vb;
        const int bh = item >> 3, ii = item & 7, b = bh >> 3, h = bh & 7;
        const bf16_t* Kg = Kt + (size_t)b * SEQ * 1024 + h * 128; const bf16_t* Vg = Vt + (size_t)b * SEQ * 1024 + h * 128;
        { const f32x4 c = *(const f32x4*)(CKL + (size_t)bh * SEQ + tid * 4); *(FA_LAS f32x4*)(lds + LDS_CK + tid * 16) = (f32x4){-c.x, -c.y, -c.z, -c.w}; }
#define FA_ISSUE_K(key0, kb_) do { const bf16_t* kg_ = Kg + (size_t)((key0) + 16 * wid) * 1024; \
        _Pragma("unroll") for (int i_ = 0; i_ < 4; ++i_) __builtin_amdgcn_global_load_lds((const unsigned*)(kg_ + koff[i_]), (FA_LAS unsigned*)(lds + (kb_) * 32768 + (wid * 4 + i_) * 1024), 16, 0, 0); } while (0)
#define FA_ISSUE_V(key0, vb_) do { const bf16_t* vg_ = Vg + (size_t)((key0) + 16 * wid) * 1024; \
        _Pragma("unroll") for (int i_ = 0; i_ < 4; ++i_) __builtin_amdgcn_global_load_lds((const unsigned*)(vg_ + i_ * 4096 + voff), (FA_LAS unsigned*)(lds + 65536 + (vb_) * 32768 + (wid * 4 + i_) * 1024), 16, 0, 0); } while (0)
#define FA_DSR128(dst, addr, off) asm volatile("ds_read_b128 %0, %1 offset:%2" : "=v"(dst) : "v"(addr), "n"(off))
#define FA_DSTR(dst, addr, off) asm volatile("ds_read_b64_tr_b16 %0, %1 offset:%2" : "=v"(dst) : "v"(addr), "n"(off))
#define FA_LGKM(n) asm volatile("s_waitcnt lgkmcnt(" #n ")" ::: "memory")
#define FA_SB() __builtin_amdgcn_sched_barrier(0)
#define FA_QK_STEP(i, P0, P1, W) do { FA_LGKM(W); FA_SB(); \
        if (((i) & 1) == 0) P0 = __builtin_amdgcn_mfma_f32_32x32x16_bf16(kr[(i) & 3], qf[(i) >> 1], P0, 0, 0, 0); else P1 = __builtin_amdgcn_mfma_f32_32x32x16_bf16(kr[(i) & 3], qf[(i) >> 1], P1, 0, 0, 0); \
        FA_SB(); if ((i) + 4 < 16) FA_DSR128(kr[(i) & 3], ka_[((i) + 4) >> 1], (((i) + 4) & 1) * 8192); } while (0)
#define FA_QK(P0, P1, kbuf, kbk) do { FA_LAS const float* nck = (FA_LAS const float*)(lds + LDS_CK) + (kbk) * 128 + kh * 64 + 4 * hi; \
        _Pragma("unroll") for (int g_ = 0; g_ < 4; ++g_) { const f32x4 t0 = *(FA_LAS const f32x4*)(nck + 8 * g_), t1 = *(FA_LAS const f32x4*)(nck + 32 + 8 * g_); \
            _Pragma("unroll") for (int j_ = 0; j_ < 4; ++j_) { P0[4 * g_ + j_] = t0[j_]; P1[4 * g_ + j_] = t1[j_]; } } \
        unsigned ka_[8]; _Pragma("unroll") for (int d0 = 0; d0 < 8; ++d0) ka_[d0] = ldsb + (unsigned)((kbuf) * 32768 + kfo[d0]); \
        bf16x8 kr[4]; FA_SB(); FA_DSR128(kr[0], ka_[0], 0); FA_DSR128(kr[1], ka_[0], 8192); FA_DSR128(kr[2], ka_[1], 0); FA_DSR128(kr[3], ka_[1], 8192); \
        FA_QK_STEP(0, P0, P1, 3); FA_QK_STEP(1, P0, P1, 3); FA_QK_STEP(2, P0, P1, 3); FA_QK_STEP(3, P0, P1, 3); FA_QK_STEP(4, P0, P1, 3); FA_QK_STEP(5, P0, P1, 3); FA_QK_STEP(6, P0, P1, 3); FA_QK_STEP(7, P0, P1, 3); \
        FA_QK_STEP(8, P0, P1, 3); FA_QK_STEP(9, P0, P1, 3); FA_QK_STEP(10, P0, P1, 3); FA_QK_STEP(11, P0, P1, 3); FA_QK_STEP(12, P0, P1, 3); FA_QK_STEP(13, P0, P1, 2); FA_QK_STEP(14, P0, P1, 1); FA_QK_STEP(15, P0, P1, 0); } while (0)
#define FA_PV_STEP(i, W) do { FA_LGKM(W); FA_SB(); \
        { const bf16x8 vf_ = (bf16x8){vl[(i) & 1][0], vl[(i) & 1][1], vl[(i) & 1][2], vl[(i) & 1][3], vh[(i) & 1][0], vh[(i) & 1][1], vh[(i) & 1][2], vh[(i) & 1][3]}; \
          o[(i) >> 2] = __builtin_amdgcn_mfma_f32_32x32x16_bf16(vf_, pf[(i) & 3], o[(i) >> 2], 0, 0, 0); } \
        FA_SB(); if ((i) + 2 < 16) { FA_DSTR(vl[(i) & 1], va_[((i) + 2) >> 2], (((i) + 2) & 3) * 4096); FA_DSTR(vh[(i) & 1], va_[((i) + 2) >> 2], (((i) + 2) & 3) * 4096 + 2048); } } while (0)
        const int qbL = 15 - ii, nsteps = 17;
#define FA_KB(s_) ((s_) <= qbL ? (s_) : ii - ((s_) - qbL - 1))
        int u = 0, qb = qbL, kb = 0, g = 0;
        FA_ISSUE_K(0, 0); FA_ISSUE_V(0, 0); FA_ISSUE_K(FA_KB(1) * 128, 1);
        bf16x8 qf[8]; f32x16 o[4]; float m = -1e30f, l = 0.f;
        { const bf16_t* qp = Q + (size_t)(b * SEQ + qb * 128 + rg * 32 + r32) * 1024 + h * 128 + 8 * hi;
#pragma unroll
          for (int d0 = 0; d0 < 8; ++d0) qf[d0] = *(const bf16x8*)(qp + 16 * d0); }
#pragma unroll
        for (int db = 0; db < 4; ++db)
#pragma unroll
            for (int r = 0; r < 16; ++r) o[db][r] = 0.f;
        FA_WAITBAR();
        f32x16 p0, p1, n0, n1;
        FA_QK(p0, p1, 0, 0);
        FA_WAITBAR();
        bool diag = false, lastb = false, done = false;
#define FA_SOFTPV(C0, C1) do { \
            if (diag) { const int qrel = rg * 32 + r32, k0 = kh * 64 + 4 * hi; \
                _Pragma("unroll") for (int r = 0; r < 16; ++r) { const int kr = k0 + (r & 3) + 8 * (r >> 2); if (kr > qrel) C0[r] = -INFINITY; if (kr + 32 > qrel) C1[r] = -INFINITY; } } \
            float mx = fmaxf(C0[0], C1[0]); \
            _Pragma("unroll") for (int r = 1; r < 16; ++r) mx = fmaxf(mx, fmaxf(C0[r], C1[r])); \
            mx = swapmax(mx); \
            const float mn = fmaxf(m, mx), alpha = __builtin_amdgcn_exp2f(m - mn); m = mn; \
            float ps = 0.f; \
            _Pragma("unroll") for (int r = 0; r < 16; ++r) { C0[r] = __builtin_amdgcn_exp2f(C0[r] - mn); C1[r] = __builtin_amdgcn_exp2f(C1[r] - mn); ps += C0[r] + C1[r]; } \
            l = l * alpha + ps; \
            if (!__all(alpha == 1.0f)) { \
                _Pragma("unroll") for (int db = 0; db < 4; ++db) _Pragma("unroll") for (int r = 0; r < 16; ++r) o[db][r] *= alpha; } \
            bf16x8 pf[4]; pf[0] = pack8(C0, 0); pf[1] = pack8(C0, 8); pf[2] = pack8(C1, 0); pf[3] = pack8(C1, 8); \
            { unsigned va_[4]; \
              _Pragma("unroll") for (int db = 0; db < 4; ++db) va_[db] = ldsb + (unsigned)(65536 + (g & 1) * 32768 + vfo[db]); \
              v4i16 vl[2], vh[2]; FA_SB(); FA_DSTR(vl[0], va_[0], 0); FA_DSTR(vh[0], va_[0], 2048); FA_DSTR(vl[1], va_[0], 4096); FA_DSTR(vh[1], va_[0], 4096 + 2048); \
              FA_PV_STEP(0, 2); FA_PV_STEP(1, 2); FA_PV_STEP(2, 2); FA_PV_STEP(3, 2); FA_PV_STEP(4, 2); FA_PV_STEP(5, 2); FA_PV_STEP(6, 2); FA_PV_STEP(7, 2); \
              FA_PV_STEP(8, 2); FA_PV_STEP(9, 2); FA_PV_STEP(10, 2); FA_PV_STEP(11, 2); FA_PV_STEP(12, 2); FA_PV_STEP(13, 2); FA_PV_STEP(14, 2); FA_PV_STEP(15, 0); } } while (0)
#define FA_STEP(C0, C1, N0, N1) do { \
            diag = (kb == qb); lastb = (u == 0 ? kb == qb : kb == 0); \
            if (g + 2 < nsteps) FA_ISSUE_K(FA_KB(g + 2) * 128, g & 1); \
            if (g + 1 < nsteps) FA_ISSUE_V(FA_KB(g + 1) * 128, (g + 1) & 1); \
            const int kbn_ = (u == 0 ? kb + 1 : kb - 1); \
            if (kh == 0 && !lastb) FA_QK(N0, N1, (g + 1) & 1, kbn_); \
            FA_SOFTPV(C0, C1); \
            if (kh == 1 && !lastb) FA_QK(N0, N1, (g + 1) & 1, kbn_); \
            FA_WAITBAR(); } while (0)
#define FA_UNIT_END() do { \
            FA_LAS float* mb = (FA_LAS float*)(lds + 65536 + (g & 1) * 32768) + rg * 2048; FA_LAS float* ml = (FA_LAS float*)(lds + LDS_ML) + rg * 128; \
            const float lt = swapsum(l); \
            if (kh == 1) { ml[lane] = m; ml[64 + lane] = lt; } \
            float s1 = 0.f, s2m = 0.f; \
            _Pragma("unroll") for (int half = 0; half < 2; ++half) { \
                if (kh == 1) { \
                    _Pragma("unroll") for (int d2 = 0; d2 < 2; ++d2) _Pragma("unroll") for (int r = 0; r < 16; ++r) mb[(d2 * 16 + r) * 64 + lane] = o[2 * half + d2][r]; } \
                FA_WAITBAR(); \
                if (kh == 0) { \
                    if (half == 0) { const float m2 = ml[lane], l2 = ml[64 + lane], mm = fmaxf(m, m2), a1 = __builtin_amdgcn_exp2f(m - mm), a2 = __builtin_amdgcn_exp2f(m2 - mm); \
                        const float inv = 1.0f / (lt * a1 + l2 * a2); s1 = a1 * inv; s2m = a2 * inv; } \
                    bf16_t* op = MIXIN + (size_t)(b * SEQ + qb * 128 + rg * 32 + r32) * 2048 + 1024 + h * 128 + 4 * hi; \
                    _Pragma("unroll") for (int d2 = 0; d2 < 2; ++d2) _Pragma("unroll") for (int g4 = 0; g4 < 4; ++g4) { float v[4]; \
                        _Pragma("unroll") for (int j = 0; j < 4; ++j) v[j] = o[2 * half + d2][4 * g4 + j] * s1 + mb[(d2 * 16 + 4 * g4 + j) * 64 + lane] * s2m; \
                        u32x2 w; w.x = cvtpk(v[0], v[1]); w.y = cvtpk(v[2], v[3]); *(u32x2*)(op + 32 * (2 * half + d2) + 8 * g4) = w; } } \
                FA_WAITBAR(); } \
            if (u == 1) { done = true; } else { \
                u = 1; qb = ii; kb = ii; ++g; \
                { const bf16_t* qp = Q + (size_t)(b * SEQ + qb * 128 + rg * 32 + r32) * 1024 + h * 128 + 8 * hi; \
                  _Pragma("unroll") for (int d0 = 0; d0 < 8; ++d0) qf[d0] = *(const bf16x8*)(qp + 16 * d0); } \
                _Pragma("unroll") for (int db = 0; db < 4; ++db) _Pragma("unroll") for (int r = 0; r < 16; ++r) o[db][r] = 0.f; \
                m = -1e30f; l = 0.f; \
                FA_QK(p0, p1, g & 1, kb); \
                FA_WAITBAR(); } } while (0)
        for (;;) {
            FA_STEP(p0, p1, n0, n1);
            if (lastb) { FA_UNIT_END(); if (done) break; continue; }
            kb += (u == 0 ? 1 : -1); ++g; p0 = n0; p1 = n1;
        }
#undef FA_SOFTPV
#undef FA_STEP
#undef FA_UNIT_END
#undef FA_ISSUE_K
#undef FA_ISSUE_V
#undef FA_QK
#undef FA_QK_STEP
#undef FA_PV_STEP
#undef FA_KB
    }
}
}

namespace fs {
#define FS_LAS __attribute__((address_space(3)))
__device__ __forceinline__ void sgu_phase(const Args& A, FS_LAS unsigned char* lds) {
    const bf16_t* U = (const bf16_t*)(A.ws + WS_U); const bf16_t* V = (const bf16_t*)(A.ws + WS_V); bf16_t* MIXIN = (bf16_t*)(A.ws + WS_MIXIN);
    const float* wsp = A.in[7]; const float* bsp = A.in[8]; const float* ln_g = A.in[5]; const float* ln_b = A.in[6]; const float* VSTAT = (const float*)(A.ws + WS_VSTAT);
    const int tid = threadIdx.x, lane = tid & 63, wid = __builtin_amdgcn_readfirstlane(tid >> 6), tb = wid & 3, dh = wid >> 2, r32 = lane & 31, hi = lane >> 5;
    const int frow = tid >> 2, fq4 = tid & 3;
    int vfo[2];
    { const int d16 = (lane >> 4) & 1, q = (lane & 15) >> 2, p = lane & 3;
#pragma unroll
      for (int j = 0; j < 2; ++j) vfo[j] = 32768 + (8 * hi + q) * 256 + (((2 * dh + j) ^ q) * 64) + d16 * 32 + p * 8; }
    const int wfo = (32 * tb + r32) * 256;
    const int NU = (T / CHUNK) * NG * PROBE_REP_SGU, UM = (T / CHUNK) * NG;
    f32x4 wa[4], wb[4], pa, pb, nwa[4], nwb[4], npa, npb; u32x4 vv[4], nvv[4];
#define FS_LOAD(u0_, WA, WB, VV, PA, PB) do { const int u_ = (u0_) % UM, rc_ = u_ / NG, g_ = u_ % NG, row0_ = rc_ * CHUNK; \
        const float* wr_ = wsp + ((size_t)g_ * CHUNK + frow) * CHUNK + fq4 * 32; const bf16_t* vr_ = V + (size_t)(row0_ + frow) * 1024 + g_ * 128 + fq4 * 32; \
        _Pragma("unroll") for (int c = 0; c < 4; ++c) { WA[c] = *(const f32x4*)(wr_ + 8 * c); WB[c] = *(const f32x4*)(wr_ + 8 * c + 4); VV[c] = *(const u32x4*)(vr_ + 8 * c); } \
        PA = *(const f32x4*)(VSTAT + ((size_t)(row0_ + frow) * 16 + 4 * fq4) * 2); PB = *(const f32x4*)(VSTAT + ((size_t)(row0_ + frow) * 16 + 4 * fq4) * 2 + 4); } while (0)
    int u0 = blockIdx.x;
    if (u0 < NU) FS_LOAD(u0, wa, wb, vv, pa, pb);
    for (; u0 < NU; u0 += gridDim.x) { const int u = u0 % UM;
        const int rc = u / NG, g = u % NG, row0 = rc * CHUNK;
        {
#pragma unroll
          for (int c = 0; c < 4; ++c) { const f32x4 a = wa[c], b2 = wb[c]; const int s0 = fq4 * 32 + 8 * c; float v[8] = {a.x, a.y, a.z, a.w, b2.x, b2.y, b2.z, b2.w};
#pragma unroll
              for (int j = 0; j < 8; ++j) if (s0 + j > frow) v[j] = 0.f;
              u32x4 w; w.x = pk2(v[0], v[1]); w.y = pk2(v[2], v[3]); w.z = pk2(v[4], v[5]); w.w = pk2(v[6], v[7]);
              *(FS_LAS u32x4*)(lds + frow * 256 + (((4 * fq4 + c) ^ (frow & 15)) * 16)) = w; }
          float mean, rstd;
          { float s1 = (pa[0] + pa[2]) + (pb[0] + pb[2]), s2 = (pa[1] + pa[3]) + (pb[1] + pb[3]);
            s1 += __shfl_xor(s1, 1); s1 += __shfl_xor(s1, 2); s2 += __shfl_xor(s2, 1); s2 += __shfl_xor(s2, 2);
            mean = s1 * (1.f / 1024.f); rstd = rsqrtf(fmaxf(s2 * (1.f / 1024.f) - mean * mean, 0.f) + EPS); }
#pragma unroll
          for (int c = 0; c < 4; ++c) { const u32x4 w = vv[c]; const int cb = g * 128 + fq4 * 32 + 8 * c;
              const f32x4 ga = *(const f32x4*)(ln_g + cb), gb = *(const f32x4*)(ln_g + cb + 4), ba = *(const f32x4*)(ln_b + cb), bb = *(const f32x4*)(ln_b + cb + 4);
              float v[8];
#pragma unroll
              for (int e2 = 0; e2 < 4; ++e2) { v[2 * e2] = __uint_as_float(w[e2] << 16); v[2 * e2 + 1] = __uint_as_float(w[e2] & 0xffff0000u); }
              u32x4 o; o.x = pk2((v[0] - mean) * rstd * ga[0] + ba[0], (v[1] - mean) * rstd * ga[1] + ba[1]); o.y = pk2((v[2] - mean) * rstd * ga[2] + ba[2], (v[3] - mean) * rstd * ga[3] + ba[3]);
              o.z = pk2((v[4] - mean) * rstd * gb[0] + bb[0], (v[5] - mean) * rstd * gb[1] + bb[1]); o.w = pk2((v[6] - mean) * rstd * gb[2] + bb[2], (v[7] - mean) * rstd * gb[3] + bb[3]);
              *(FS_LAS u32x4*)(lds + 32768 + frow * 256 + (((4 * fq4 + c) ^ ((frow & 3) << 2)) * 16)) = o; } }
        __syncthreads();
        const bool more = u0 + (int)gridDim.x < NU;
        if (more) FS_LOAD(u0 + (int)gridDim.x, nwa, nwb, nvv, npa, npb);
        const int tt = 32 * tb + r32; const float bb = bsp[g * CHUNK + tt]; const size_t rw = (size_t)(row0 + tt);
        u32x2 uu[2][4];
#pragma unroll
        for (int j = 0; j < 2; ++j)
#pragma unroll
            for (int g4 = 0; g4 < 4; ++g4) uu[j][g4] = *(const u32x2*)(U + rw * 1024 + g * 128 + 32 * (2 * dh + j) + 8 * g4 + 4 * hi);
        fa::f32x16 acc[2];
#pragma unroll
        for (int j = 0; j < 2; ++j)
#pragma unroll
            for (int r = 0; r < 16; ++r) acc[j][r] = 0.f;
        for (int s = 0; s <= 2 * tb + 1; ++s) {
            const fa::bf16x8 wf = *(FS_LAS const fa::bf16x8*)(lds + wfo + (((2 * s + hi) ^ (r32 & 15)) * 16));
#pragma unroll
            for (int j = 0; j < 2; ++j) {
                const fa::v4i16 lo = __builtin_amdgcn_ds_read_tr16_b64_v4i16((FS_LAS fa::v4i16*)(lds + vfo[j] + s * 4096));
                const fa::v4i16 hh = __builtin_amdgcn_ds_read_tr16_b64_v4i16((FS_LAS fa::v4i16*)(lds + vfo[j] + s * 4096 + 1024));
                const fa::bf16x8 vf = (fa::bf16x8){lo[0], lo[1], lo[2], lo[3], hh[0], hh[1], hh[2], hh[3]};
                acc[j] = __builtin_amdgcn_mfma_f32_32x32x16_bf16(vf, wf, acc[j], 0, 0, 0); }
        }
#pragma unroll
        for (int j = 0; j < 2; ++j)
#pragma unroll
            for (int g4 = 0; g4 < 4; ++g4) { const int d = 32 * (2 * dh + j) + 8 * g4 + 4 * hi; const u32x2 u2 = uu[j][g4];
                const float u0f = __uint_as_float(u2.x << 16), u1 = __uint_as_float(u2.x & 0xffff0000u), u2f = __uint_as_float(u2.y << 16), u3 = __uint_as_float(u2.y & 0xffff0000u);
                u32x2 w; w.x = fa::cvtpk(u0f * (acc[j][4 * g4] + bb), u1 * (acc[j][4 * g4 + 1] + bb)); w.y = fa::cvtpk(u2f * (acc[j][4 * g4 + 2] + bb), u3 * (acc[j][4 * g4 + 3] + bb));
                *(u32x2*)(MIXIN + rw * 2048 + g * 128 + d) = w; }
        __syncthreads();
        if (more) {
#pragma unroll
            for (int c = 0; c < 4; ++c) { wa[c] = nwa[c]; wb[c] = nwb[c]; vv[c] = nvv[c]; }
            pa = npa; pb = npb; }
    }
#undef FS_LOAD
}
}


#define XB_TMO      128
#define XB_XCNT(j)  (256  + 64 * (j))
#define XB_XSUB(j)  (1280 + 64 * (j))
#define XB_XGEN(j)  (2304 + 64 * (j))
#define XB_TOP      3328
#define XB_TOPGEN   3392
#define XCD_BAR_WORDS 3456
#define XB_SPIN_CAP (1u << 18)
#define XLAS __attribute__((address_space(3)))
__device__ __forceinline__ unsigned xb_ld(unsigned* p)              { return __hip_atomic_load(p, __ATOMIC_RELAXED, __HIP_MEMORY_SCOPE_AGENT); }
__device__ __forceinline__ unsigned xb_add(unsigned* p, unsigned v) { return __hip_atomic_fetch_add(p, v, __ATOMIC_RELAXED, __HIP_MEMORY_SCOPE_AGENT); }
__device__ __forceinline__ unsigned xb_xcc_id() { return (unsigned)__builtin_amdgcn_s_getreg((3 << 11) | 20) & 0xFu; }
#define XB_SPIN(cond, bar) do { unsigned _sp = 0; while (cond) { __builtin_amdgcn_s_sleep(1); \
    if ((++_sp & 255u) == 0u) { if (xb_ld(&(bar)[XB_TMO])) break; if (_sp > XB_SPIN_CAP) { atomicAdd(&(bar)[XB_TMO], 1u); break; } } } } while (0)
struct XcdBarrier { unsigned* bar; unsigned x; volatile XLAS unsigned* st; };
__device__ __forceinline__ XcdBarrier xcd_barrier_post(unsigned* bar, volatile XLAS unsigned* st) {
    XcdBarrier b; b.bar = bar; b.x = xb_xcc_id(); b.st = st;
    if (threadIdx.x == 0) (void)xb_add(&bar[XB_XCNT(b.x)], 1u);
    return b;
}
__device__ __forceinline__ void xcd_barrier_complete(unsigned* bar, unsigned x, unsigned& nloc, unsigned& nx) {
    const unsigned G = gridDim.x * gridDim.y * gridDim.z;
    unsigned sum, cnt, mine, sp = 0u;
    for (;;) {
        sum = 0u; cnt = 0u; mine = 0u;
#pragma unroll
        for (unsigned j = 0; j < 16; ++j) { const unsigned c = xb_ld(&bar[XB_XCNT(j)]); sum += c; cnt += (c > 0u) ? 1u : 0u; mine = (j == x) ? c : mine; }
        if (sum == G) break;
        __builtin_amdgcn_s_sleep(1);
        if ((++sp & 255u) == 0u) { if (xb_ld(&bar[XB_TMO])) break; if (sp > XB_SPIN_CAP) { atomicAdd(&bar[XB_TMO], 1u); break; } }
    }
    nloc = mine > 0u ? mine : 1u; nx = cnt > 0u ? cnt : 1u;
}
__device__ __forceinline__ void xcd_barrier(const XcdBarrier& b) {
    asm volatile("s_waitcnt vmcnt(0)" ::: "memory");
    __syncthreads();
    if (threadIdx.x == 0) {
        unsigned* bar = b.bar;
        __builtin_amdgcn_s_waitcnt(0);
        unsigned nloc = b.st[0], nx = b.st[1];
        if (nloc == 0u) { xcd_barrier_complete(bar, b.x, nloc, nx); b.st[0] = nloc; b.st[1] = nx; }
        const unsigned old = xb_add(&bar[XB_XSUB(b.x)], 1u);
        const unsigned gen = old / nloc;
        if (old + 1u == (gen + 1u) * nloc) {
            __builtin_amdgcn_fence(__ATOMIC_RELEASE, "agent");
            asm volatile("s_waitcnt vmcnt(0)" ::: "memory");
            const unsigned og = xb_add(&bar[XB_TOP], 1u);
            const unsigned tg = og / nx;
            if (og + 1u == (tg + 1u) * nx) xb_add(&bar[XB_TOPGEN], 1u);
            else XB_SPIN(xb_ld(&bar[XB_TOPGEN]) == tg, bar);
            __builtin_amdgcn_fence(__ATOMIC_ACQUIRE, "agent");
            xb_add(&bar[XB_XGEN(b.x)], 1u);
            asm volatile("s_waitcnt vmcnt(0)" ::: "memory");
        } else {
            XB_SPIN(xb_ld(&bar[XB_XGEN(b.x)]) == gen, bar);
            __builtin_amdgcn_fence(__ATOMIC_ACQUIRE, "agent");
            asm volatile("s_waitcnt vmcnt(0)" ::: "memory");
        }
    }
    __syncthreads();
}
constexpr int CW_BAR = 4096;
constexpr size_t CTL_ZERO_BYTES = 65536;
constexpr int LDS_BARST_OFF = LDS_BYTES - 16;

constexpr bool FAST_P1 = true, FAST_P3 = true, FAST_P4 = true, FAST_P6 = true, FAST_P7 = true;
constexpr bool FAST_ATTN = true, FAST_SGU = true;
constexpr bool FAST_ANY = FAST_P1 || FAST_P3 || FAST_P4 || FAST_P6 || FAST_P7;
constexpr int N_PHASES = 10;
__global__ void __launch_bounds__(NTHREADS, 2) fwd(Args A) {
    extern __shared__ __attribute__((aligned(16))) unsigned char lds[];
    float* ldsf = (float*)lds;
    const int lo = A.ph_lo, hi = A.ph_hi;
    if (threadIdx.x < 4) ((volatile XLAS unsigned*)((XLAS unsigned char*)lds + LDS_BARST_OFF))[threadIdx.x] = 0u;
    __syncthreads();
    XcdBarrier bar = xcd_barrier_post((unsigned*)(A.ws + WS_CTL) + CW_BAR, (volatile XLAS unsigned*)((XLAS unsigned char*)lds + LDS_BARST_OFF));
#define IN(k) (lo <= (k) && (k) < hi)
#define SEAM(k) do { if (IN(k) && IN((k) + 1)) xcd_barrier(bar); STAMP((k) + 1); } while (0)
    unsigned long long t_lo = 0, t_hi = 0;
#define STAMP(i) do { if (STAMP_PHASE >= 0) { if ((i) == STAMP_PHASE || (STAMP_PHASE == 98 && (i) == 0)) t_lo = __builtin_amdgcn_s_memrealtime(); if ((i) == STAMP_PHASE + 1 || (STAMP_PHASE == 98 && (i) == 9)) t_hi = __builtin_amdgcn_s_memrealtime(); } } while (0)
    STAMP(0);
    PG8_LAS unsigned char* l3 = (PG8_LAS unsigned char*)lds;
    if (IN(0)) { if (FAST_ANY) { p0_weights(A, l3, 0, (int)blockIdx.x, (int)gridDim.x); __syncthreads(); } p0_router_weights(A); p0_rows(A, ldsf); } SEAM(0);
    if (IN(1)) { if (FAST_P1 && FAST_ATTN && (int)blockIdx.x >= (int)gridDim.x - NB * NH) cumsum_bh(A, (int)blockIdx.x - ((int)gridDim.x - NB * NH), ldsf); if (FAST_P1) p1_fast(A, l3); else p1_naive(A, ldsf); if (FAST_ANY) { __syncthreads(); { const int r_ = 1152 % (int)gridDim.x; p0_weights(A, l3, 1, r_ == 0 ? (int)blockIdx.x : (int)blockIdx.x - r_, r_ == 0 ? (int)gridDim.x : (int)gridDim.x - r_); } } } SEAM(1);
    if (!(FAST_P1 && FAST_SGU && FAST_ATTN)) { if (IN(2)) { p1b_fix<0>(A, ldsf); } SEAM(2); }
    if (IN(3)) { if (FAST_SGU) fs::sgu_phase(A, l3); else p2_sgu_naive(A); if (FAST_ATTN) { __syncthreads(); fa::attn_phase(A, l3); } else p2_attn_naive(A, ldsf); } SEAM(3);
    if (IN(4)) { if (FAST_P3) p3_fast(A, l3); else p3_naive(A, ldsf); } SEAM(4);
    if (IN(5)) { if (FAST_P4) p4_fast(A, l3); else p4_naive(A, ldsf); } SEAM(5);
    if (IN(6)) { if (PROBE_ALT == 6) { p5_router3<1>(A, ldsf); __syncthreads(); } if (PROBE_ALT == 62) { p5_router3<2>(A, ldsf); __syncthreads(); } if (PROBE_ALT == 63) { p5_router3<3>(A, ldsf); __syncthreads(); } p5_router3<0>(A, ldsf); } SEAM(6);
    if (IN(7)) { if (FAST_P6) p6_fast(A, l3); else p6_naive(A, ldsf); } SEAM(7);
    if (IN(8)) { if (FAST_P7) p7_fast(A, l3); else p7_naive(A, ldsf); } SEAM(8);
    if (IN(9)) { if (PROBE_ALT == 9) { p8_combine<1>(A, ldsf); __syncthreads(); } p8_combine<0>(A, ldsf, STAMP_PHASE < 0 ? 0.f : (STAMP_PHASE == 99 ? 1.0f : (float)(t_hi - t_lo) * 0.01f * 0.001f * STAMP_SCALE)); }
#undef IN
#undef SEAM
}

#ifndef MK_N_LAUNCHES
#define MK_N_LAUNCHES 1
#endif
extern "C" void kernel_launch(void* const* d_in, const int* in_sizes, int n_in, void* d_out, int out_size, void* d_ws, size_t ws_size, hipStream_t stream) {
    static int grid = 0;
    if (grid == 0) {
        if (n_in != 22 || out_size != T * DM || ws_size < WS_END) { fprintf(stderr, "kernel_launch: unexpected shapes (n_in %d out %d ws %zu)\n", n_in, out_size, ws_size); grid = -1; return; }
        int dev = 0, cus = 0, per_cu = 0;
        hipGetDevice(&dev); hipDeviceGetAttribute(&cus, hipDeviceAttributeMultiprocessorCount, dev);
        hipFuncSetAttribute((const void*)fwd, hipFuncAttributeMaxDynamicSharedMemorySize, LDS_BYTES);
        hipOccupancyMaxActiveBlocksPerMultiprocessor(&per_cu, (const void*)fwd, NTHREADS, LDS_BYTES);
        if (per_cu < 1) { fprintf(stderr, "kernel_launch: occupancy query says %d blocks per CU\n", per_cu); per_cu = 1; }
        (void)hipGetLastError();
        grid = cus;
    }
    if (grid < 0) return;
    Args a{};
    for (int i = 0; i < 22; ++i) a.in[i] = (const float*)d_in[i];
    a.out = (float*)d_out; a.ws = (unsigned char*)d_ws;
    if (hipMemsetAsync((char*)d_ws + WS_CTL, 0, CTL_ZERO_BYTES, stream) != hipSuccess) { fprintf(stderr, "kernel_launch: memset failed\n"); return; }
    if (MK_N_LAUNCHES == 1) {
        a.ph_lo = 0; a.ph_hi = N_PHASES;
        hipLaunchKernelGGL(fwd, dim3(grid), dim3(NTHREADS), LDS_BYTES, stream, a);
    } else {
        for (int p = 0; p < N_PHASES; ++p) { a.ph_lo = p; a.ph_hi = p + 1; hipLaunchKernelGGL(fwd, dim3(grid), dim3(NTHREADS), LDS_BYTES, stream, a); }
    }
}
```

```cpp
#include <hip/hip_runtime.h>
#include <hip/hip_cooperative_groups.h>
#include <cstdio>
#include <cstdint>
namespace cg = cooperative_groups;

#ifndef STAMP_PHASE
#define STAMP_PHASE -1
#endif
#ifndef STAMP_SEL
#define STAMP_SEL 0
#endif
#ifndef STAMP_SCALE
#define STAMP_SCALE 0.5f
#endif
#ifndef PROBE_REP_P1
#define PROBE_REP_P1 1
#endif
#ifndef PROBE_REP_P4
#define PROBE_REP_P4 1
#endif
#ifndef PROBE_REP_P5
#define PROBE_REP_P5 1
#endif
#ifndef PROBE_REP_MOE
#define PROBE_REP_MOE 1
#endif
#ifndef PROBE_REP_ATTN
#define PROBE_REP_ATTN 1
#endif
#ifndef PROBE_REP_SGU
#define PROBE_REP_SGU 1
#endif
#ifndef PROBE_ATTN_VAR
#define PROBE_ATTN_VAR 0
#endif
#ifndef PROBE_ALT
#define PROBE_ALT -1
#endif
constexpr int T = 8192, SEQ = 2048, NB = 4, DM = 2048, SGUW = 1024, FOXW = 1024, NH = 8, HD = 128, CHUNK = 128, NG = 8;
constexpr int INCOLS = 9224, OFF_F = 5120, OFF_GATE = 5128;
constexpr int NEXP = 32, EPG = 8, NGRP = 4, DEXP = 512;
constexpr float EPS = 1e-6f;
constexpr float LOG2E = 1.4426950408889634f;
constexpr float QSCALE = 0.08838834764831845f * LOG2E;
constexpr int NTHREADS = 512, NWAVES = 8;
constexpr int LDS_BYTES = 160 * 1024;
constexpr int MTILE = 256;
constexpr int PMAX = 2 * T + NEXP * MTILE;
constexpr int MT_MAX = PMAX / MTILE;
constexpr bool HELPERS = true;
constexpr bool XCDM_GU = true;
constexpr int TINY_ROWS = 0;

typedef unsigned short bf16_t;
typedef float f32x4 __attribute__((ext_vector_type(4)));
typedef unsigned u32x4 __attribute__((ext_vector_type(4)));
typedef unsigned u32x2 __attribute__((ext_vector_type(2)));

constexpr size_t MiB = 1u << 20;
constexpr size_t WS_CTL = 0;
constexpr size_t WS_LOGF = 1 * MiB;
constexpr size_t WS_CKL = 2 * MiB;
constexpr size_t WS_TOK = 3 * MiB;
constexpr size_t WS_GATE = 4 * MiB;
constexpr size_t WS_ASG = 5 * MiB;
constexpr size_t WS_WIN = 8 * MiB;
constexpr size_t WS_WPROJ = 44 * MiB;
constexpr size_t WS_WOUT = 52 * MiB;
constexpr size_t WS_WGU = 60 * MiB;
constexpr size_t WS_WD = 188 * MiB;
constexpr size_t WS_H = 252 * MiB;
constexpr size_t WS_MIXED = WS_H;
constexpr size_t WS_U = 284 * MiB;
constexpr size_t WS_V = 300 * MiB;
constexpr size_t WS_G = 316 * MiB;
constexpr size_t WS_YBUF = WS_U;
constexpr size_t WS_Q = 380 * MiB;
constexpr size_t WS_K = 396 * MiB;
constexpr size_t WS_VA = 412 * MiB;
constexpr size_t WS_ACT = WS_Q;
constexpr size_t WS_MIXIN = 428 * MiB;
constexpr size_t WS_H2 = WS_MIXIN;
constexpr size_t WS_END = 460 * MiB;
static_assert((size_t)PMAX * 2048 * 2 <= 96 * MiB && (size_t)PMAX * 512 * 2 <= 32 * MiB, "overlay sizes");

constexpr int CW_CNT = 0;
constexpr int CNT_STRIDE = 64;

__device__ __forceinline__ float bf2f(bf16_t v) { return __uint_as_float((unsigned)v << 16); }
__device__ __forceinline__ bf16_t f2bf(float f) { unsigned u = __float_as_uint(f); return (bf16_t)((u + 0x7fffu + ((u >> 16) & 1u)) >> 16); }
__device__ __forceinline__ unsigned pk2(float lo, float hi) { return (unsigned)f2bf(lo) | ((unsigned)f2bf(hi) << 16); }
__device__ __forceinline__ unsigned cvtpk_rne(float lo, float hi) { unsigned r; asm("v_cvt_pk_bf16_f32 %0, %1, %2" : "=v"(r) : "v"(lo), "v"(hi)); return r; }
__device__ __forceinline__ float wave_sum(float v) {
#pragma unroll
    for (int o = 1; o < 64; o <<= 1) v += __shfl_xor(v, o);
    return v;
}
__device__ __forceinline__ float wave_max(float v) {
#pragma unroll
    for (int o = 1; o < 64; o <<= 1) v = fmaxf(v, __shfl_xor(v, o));
    return v;
}
__device__ __forceinline__ float gelu_tanh(float x) {
    const float c = 0.7978845608028654f; const float y = c * (x + 0.044715f * x * x * x);
    return x / (1.0f + __expf(-2.0f * y));
}
__device__ __forceinline__ float sigmoidf_(float x) { return 1.0f / (1.0f + __expf(-x)); }
__device__ __forceinline__ float log_sigmoid(float z) { return fminf(z, 0.f) - log1pf(__expf(-fabsf(z))); }

struct Args {
    const float* in[22];
    float* out;
    unsigned char* ws;
    int ph_lo, ph_hi;
};

template <class AF, class BF, class EF>
__device__ __forceinline__ void naive_gemm_tile(float* lds, int m0, int n0, int M, int N, int K, int Ksplit, AF a, BF b, EF epi) {
    float* As = lds;
    float* Bs = lds + 16 * 132;
    const int tid = threadIdx.x, ty = tid >> 4, tx = tid & 15;
    float acc[4][8], acc1[4][8];
#pragma unroll
    for (int i = 0; i < 4; ++i)
#pragma unroll
        for (int j = 0; j < 8; ++j) { acc[i][j] = 0.f; acc1[i][j] = 0.f; }
    const bool split = Ksplit < K;
#pragma unroll 1
    for (int pass = 0; pass < 2; ++pass) {
        const int kb = pass == 0 ? 0 : Ksplit, ke = pass == 0 ? (split ? Ksplit : K) : K;
        if (pass == 1) {
            if (!split) break;
#pragma unroll
            for (int i = 0; i < 4; ++i)
#pragma unroll
                for (int j = 0; j < 8; ++j) { acc1[i][j] = acc[i][j]; acc[i][j] = 0.f; }
        }
#pragma unroll 1
        for (int k0 = kb; k0 < ke; k0 += 16) {
#pragma unroll
            for (int i = 0; i < 4; ++i) { const int idx = tid + i * 512, r = idx >> 4, kk = idx & 15; const int m = m0 + r; As[kk * 132 + r] = (m < M) ? a(m, k0 + kk) : 0.f; }
#pragma unroll
            for (int i = 0; i < 4; ++i) { const int idx = tid + i * 512, kk = idx >> 7, n = idx & 127; Bs[kk * 132 + n] = (n0 + n < N) ? b(k0 + kk, n0 + n) : 0.f; }
            __syncthreads();
#pragma unroll 4
            for (int kk = 0; kk < 16; ++kk) {
                float av[4], bv[8];
#pragma unroll
                for (int i = 0; i < 4; ++i) av[i] = As[kk * 132 + ty * 4 + i];
#pragma unroll
                for (int j = 0; j < 8; ++j) bv[j] = Bs[kk * 132 + tx * 8 + j];
#pragma unroll
                for (int i = 0; i < 4; ++i)
#pragma unroll
                    for (int j = 0; j < 8; ++j) acc[i][j] = fmaf(av[i], bv[j], acc[i][j]);
            }
            __syncthreads();
        }
    }
#pragma unroll
    for (int i = 0; i < 4; ++i)
#pragma unroll
        for (int j = 0; j < 8; ++j) { const int m = m0 + ty * 4 + i, n = n0 + tx * 8 + j; if (m < M && n < N) epi(m, n, split ? acc1[i][j] : acc[i][j], split ? acc[i][j] : 0.f); }
}
template <class AF, class BF, class EF>
__device__ __forceinline__ void naive_gemm(float* lds, int M, int N, int K, int Ksplit, AF a, BF b, EF epi) {
    const int ntm = (M + 127) / 128, ntn = (N + 127) / 128;
    for (int t = blockIdx.x; t < ntm * ntn; t += gridDim.x) naive_gemm_tile(lds, (t / ntn) * 128, (t % ntn) * 128, M, N, K, Ksplit, a, b, epi);
}

__device__ __forceinline__ void p0_rows(const Args& A, float* ldsf) {
    const float* x = A.in[0]; const float* g1 = A.in[1]; const float* w_in = A.in[2]; const float* b_forget = A.in[4];
    bf16_t* H = (bf16_t*)(A.ws + WS_H); float* LOGF = (float*)(A.ws + WS_LOGF);
    const int tid = threadIdx.x, lane = tid & 63, wave = tid >> 6;
    for (int i = tid; i < DM * 8; i += NTHREADS) ldsf[i] = w_in[(size_t)(i >> 3) * INCOLS + OFF_F + (i & 7)];
    __syncthreads();
    const int gw = blockIdx.x * NWAVES + wave, NGW = gridDim.x * NWAVES;
    for (int row = gw; row < T; row += NGW) {
        const f32x4* xr = (const f32x4*)(x + (size_t)row * DM) + lane;
        f32x4 xv[8]; float ss = 0.f;
#pragma unroll
        for (int j = 0; j < 8; ++j) xv[j] = xr[64 * j];
#pragma unroll
        for (int j = 0; j < 8; ++j) ss += xv[j].x * xv[j].x + xv[j].y * xv[j].y + xv[j].z * xv[j].z + xv[j].w * xv[j].w;
        const float rstd = rsqrtf(wave_sum(ss) * (1.f / DM) + EPS);
        float f[8];
#pragma unroll
        for (int h = 0; h < 8; ++h) f[h] = 0.f;
#pragma unroll
        for (int j = 0; j < 8; ++j) {
            const int c0 = 256 * j + 4 * lane; const f32x4 g = *(const f32x4*)(g1 + c0);
            f32x4 hv; hv.x = xv[j].x * rstd * g.x; hv.y = xv[j].y * rstd * g.y; hv.z = xv[j].z * rstd * g.z; hv.w = xv[j].w * rstd * g.w;
            u32x2 o; o.x = pk2(hv.x, hv.y); o.y = pk2(hv.z, hv.w);
            *(u32x2*)(H + (size_t)row * DM + c0) = o;
#pragma unroll
            for (int e = 0; e < 4; ++e) { const float hx = hv[e]; const float* wf = ldsf + (c0 + e) * 8;
#pragma unroll
                for (int h = 0; h < 8; ++h) f[h] = fmaf(hx, wf[h], f[h]); }
            asm volatile("" ::: "memory");
        }
#pragma unroll
        for (int h = 0; h < 8; ++h) f[h] = wave_sum(f[h]);
        if (lane < 8) { float z = 0.f;
#pragma unroll
            for (int h = 0; h < 8; ++h) if (lane == h) z = f[h];
            LOGF[(size_t)row * 8 + lane] = log_sigmoid(z + b_forget[lane]); }
    }
}

__device__ __forceinline__ void p1_naive(const Args& A, float* ldsf) {
    const bf16_t* H = (const bf16_t*)(A.ws + WS_H); const float* w_in = A.in[2]; const float* b_gate = A.in[3];
    bf16_t* U = (bf16_t*)(A.ws + WS_U); bf16_t* V = (bf16_t*)(A.ws + WS_V); bf16_t* Q = (bf16_t*)(A.ws + WS_Q); bf16_t* K = (bf16_t*)(A.ws + WS_K);
    bf16_t* VA = (bf16_t*)(A.ws + WS_VA); bf16_t* G = (bf16_t*)(A.ws + WS_G);
    naive_gemm(ldsf, T, 9216, DM, DM,
        [=](int m, int k) { return bf2f(H[(size_t)m * DM + k]); },
        [=](int k, int n) { const int c = n < 5120 ? n : n + 8; return w_in[(size_t)k * INCOLS + c]; },
        [=](int m, int n, float s, float) {
            if (n < 1024) U[(size_t)m * 1024 + n] = f2bf(gelu_tanh(s));
            else if (n < 2048) V[(size_t)m * 1024 + n - 1024] = f2bf(gelu_tanh(s));
            else if (n < 3072) Q[(size_t)m * 1024 + n - 2048] = f2bf(s);
            else if (n < 4096) K[(size_t)m * 1024 + n - 3072] = f2bf(s);
            else if (n < 5120) VA[(size_t)m * 1024 + n - 4096] = f2bf(s);
            else G[(size_t)m * 4096 + n - 5120] = f2bf(sigmoidf_(s + b_gate[n - 5120]));
        });
}

template <int ALT> __device__ __forceinline__ void p1b_fix(const Args& A, float* ldsf) {
    bf16_t* V = (bf16_t*)(A.ws + WS_V); bf16_t* Q = (bf16_t*)(A.ws + WS_Q); bf16_t* K = (bf16_t*)(A.ws + WS_K);
    const size_t altoff = ALT ? ((size_t)((unsigned char*)A.out - (A.ws + WS_V))) / 2 : 0;
    const size_t altq = ALT ? ((size_t)((unsigned char*)A.out + 16 * MiB - (A.ws + WS_Q))) / 2 : 0, altk = ALT ? ((size_t)((unsigned char*)A.out + 32 * MiB - (A.ws + WS_K))) / 2 : 0;
    const float* ln_g = A.in[5]; const float* ln_b = A.in[6]; const float* qg = A.in[9]; const float* kg = A.in[10];
    const int tid = threadIdx.x, lane = tid & 63, wave = tid >> 6;
    const int gw = blockIdx.x * NWAVES + wave, NGW = gridDim.x * NWAVES;
    for (int row = gw; row < T; row += NGW) {
        {
            bf16_t* vr = V + (size_t)row * 1024; float v[16]; float s = 0.f;
#pragma unroll
            for (int j = 0; j < 2; ++j) { const u32x4 w = *(const u32x4*)(vr + 512 * j + 8 * lane);
#pragma unroll
                for (int e = 0; e < 4; ++e) { v[8 * j + 2 * e] = __uint_as_float(w[e] << 16); v[8 * j + 2 * e + 1] = __uint_as_float(w[e] & 0xffff0000u); } }
#pragma unroll
            for (int i = 0; i < 16; ++i) s += v[i];
            const float mean = wave_sum(s) * (1.f / 1024.f); float q = 0.f;
#pragma unroll
            for (int i = 0; i < 16; ++i) { v[i] -= mean; q += v[i] * v[i]; }
            const float rstd = rsqrtf(wave_sum(q) * (1.f / 1024.f) + EPS);
#pragma unroll
            for (int j = 0; j < 2; ++j) { const int c0 = 512 * j + 8 * lane; u32x4 o;
#pragma unroll
                for (int e = 0; e < 4; ++e) o[e] = pk2(v[8 * j + 2 * e] * rstd * ln_g[c0 + 2 * e] + ln_b[c0 + 2 * e], v[8 * j + 2 * e + 1] * rstd * ln_g[c0 + 2 * e + 1] + ln_b[c0 + 2 * e + 1]);
                *(u32x4*)(vr + altoff + c0) = o; }
        }
#pragma unroll
        for (int which = 0; which < 2; ++which) {
            bf16_t* pr = (which == 0 ? Q : K) + (size_t)row * 1024 + 16 * lane; const float* gg = which == 0 ? qg : kg; float v[16]; float s = 0.f;
#pragma unroll
            for (int j = 0; j < 2; ++j) { const u32x4 w = *(const u32x4*)(pr + 8 * j);
#pragma unroll
                for (int e = 0; e < 4; ++e) { v[8 * j + 2 * e] = __uint_as_float(w[e] << 16); v[8 * j + 2 * e + 1] = __uint_as_float(w[e] & 0xffff0000u); } }
#pragma unroll
            for (int i = 0; i < 16; ++i) s += v[i] * v[i];
            s += __shfl_xor(s, 1); s += __shfl_xor(s, 2); s += __shfl_xor(s, 4);
            const float sc = rsqrtf(s * (1.f / 128.f) + EPS) * (which == 0 ? QSCALE : 1.f); const int d0 = (16 * lane) & 127;
#pragma unroll
            for (int j = 0; j < 2; ++j) { u32x4 o;
#pragma unroll
                for (int e = 0; e < 4; ++e) o[e] = pk2(v[8 * j + 2 * e] * sc * gg[d0 + 8 * j + 2 * e], v[8 * j + 2 * e + 1] * sc * gg[d0 + 8 * j + 2 * e + 1]);
                *(u32x4*)(pr + (which == 0 ? altq : altk) + 8 * j) = o; }
        }
    }
    if (blockIdx.x < NB * NH) {
        const int b = blockIdx.x / NH, h = blockIdx.x % NH; const float* LOGF = (const float*)(A.ws + WS_LOGF); float* CKL = (float*)(A.ws + WS_CKL) + (size_t)blockIdx.x * SEQ + (ALT ? 65536 : 0);
        float v[4]; float s = 0.f;
#pragma unroll
        for (int i = 0; i < 4; ++i) { v[i] = LOGF[(size_t)(b * SEQ + tid * 4 + i) * 8 + h]; s += v[i]; }
        float incl = s;
#pragma unroll
        for (int o = 1; o < 64; o <<= 1) { const float t = __shfl_up(incl, o); if (lane >= o) incl += t; }
        __syncthreads();
        if (lane == 63) ldsf[wave] = incl;
        __syncthreads();
        float base = 0.f;
        for (int w = 0; w < wave; ++w) base += ldsf[w];
        float run = base + incl - s;
#pragma unroll
        for (int i = 0; i < 4; ++i) { run += v[i]; CKL[tid * 4 + i] = run * LOG2E; }
        __syncthreads();
    }
}


__device__ __forceinline__ void cumsum_bh(const Args& A, int bh, float* ldsf) {
    const int tid = threadIdx.x, lane = tid & 63, wave = tid >> 6, b = bh / NH, h = bh % NH;
    const float* LOGF = (const float*)(A.ws + WS_LOGF); float* CKL = (float*)(A.ws + WS_CKL) + (size_t)bh * SEQ;
    float v[4]; float sm = 0.f;
#pragma unroll
    for (int i = 0; i < 4; ++i) { v[i] = LOGF[(size_t)(b * SEQ + tid * 4 + i) * 8 + h]; sm += v[i]; }
    float incl = sm;
#pragma unroll
    for (int o = 1; o < 64; o <<= 1) { const float t = __shfl_up(incl, o); if (lane >= o) incl += t; }
    if (lane == 63) ldsf[wave] = incl;
    __syncthreads();
    float run = incl - sm;
    for (int w = 0; w < wave; ++w) run += ldsf[w];
    f32x4 o4;
#pragma unroll
    for (int i = 0; i < 4; ++i) { run += v[i]; o4[i] = run * LOG2E; }
    *(f32x4*)(CKL + tid * 4) = o4;
    __syncthreads();
}

__device__ __forceinline__ void p2_sgu_naive(const Args& A) {
    const bf16_t* U = (const bf16_t*)(A.ws + WS_U); const bf16_t* V = (const bf16_t*)(A.ws + WS_V); bf16_t* MIXIN = (bf16_t*)(A.ws + WS_MIXIN);
    const float* wsp = A.in[7]; const float* bsp = A.in[8];
    const int tid = threadIdx.x, tt = tid >> 2, dp = tid & 3;
    for (int u = blockIdx.x; u < (T / CHUNK) * NG; u += gridDim.x) {
        const int rc = u / NG, g = u % NG; const int row0 = rc * CHUNK;
        float acc[32];
#pragma unroll
        for (int i = 0; i < 32; ++i) acc[i] = 0.f;
        for (int ss = 0; ss <= tt; ++ss) {
            const float w = wsp[((size_t)g * CHUNK + tt) * CHUNK + ss];
            const bf16_t* vr = V + (size_t)(row0 + ss) * 1024 + g * 128 + dp * 32;
#pragma unroll
            for (int i = 0; i < 32; ++i) acc[i] = fmaf(w, bf2f(vr[i]), acc[i]);
        }
        const float bb = bsp[g * CHUNK + tt];
        const bf16_t* ur = U + (size_t)(row0 + tt) * 1024 + g * 128 + dp * 32; bf16_t* orow = MIXIN + (size_t)(row0 + tt) * 2048 + g * 128 + dp * 32;
#pragma unroll
        for (int i = 0; i < 32; ++i) orow[i] = f2bf(bf2f(ur[i]) * (acc[i] + bb));
    }
}
__device__ __forceinline__ void p2_attn_naive(const Args& A, float* ldsf) {
    const bf16_t* Q = (const bf16_t*)(A.ws + WS_Q); const bf16_t* K = (const bf16_t*)(A.ws + WS_K); const bf16_t* VA = (const bf16_t*)(A.ws + WS_VA);
    const float* CKL = (const float*)(A.ws + WS_CKL); bf16_t* MIXIN = (bf16_t*)(A.ws + WS_MIXIN);
    const int tid = threadIdx.x, lane = tid & 63, wave = tid >> 6;
    float* qs = ldsf + wave * 128;
    const int gw = blockIdx.x * NWAVES + wave, NGW = gridDim.x * NWAVES;
    for (int item = gw; item < T * NH; item += NGW) {
        const int row = item / NH, h = item % NH, b = row / SEQ, t = row % SEQ;
        const bf16_t* qr = Q + (size_t)row * 1024 + h * 128;
        qs[lane] = bf2f(qr[lane]); qs[64 + lane] = bf2f(qr[64 + lane]);
        __builtin_amdgcn_s_waitcnt(0);
        const float* ck = CKL + (size_t)(b * NH + h) * SEQ;
        float m = -1e30f, l = 0.f, o0 = 0.f, o1 = 0.f;
        for (int s0 = 0; s0 <= t; s0 += 64) {
            const int s = s0 + lane; float sc = -INFINITY;
            if (s <= t) { const bf16_t* kr = K + (size_t)(b * SEQ + s) * 1024 + h * 128; float d = 0.f;
                for (int c = 0; c < 16; ++c) { const u32x4 w = *(const u32x4*)(kr + 8 * c);
#pragma unroll
                    for (int e = 0; e < 4; ++e) { d = fmaf(qs[8 * c + 2 * e], __uint_as_float(w[e] << 16), d); d = fmaf(qs[8 * c + 2 * e + 1], __uint_as_float(w[e] & 0xffff0000u), d); } }
                sc = d - ck[s]; }
            const float mn = fmaxf(m, wave_max(sc)); const float alpha = exp2f(m - mn); const float p = exp2f(sc - mn);
            l = l * alpha + wave_sum(p); o0 *= alpha; o1 *= alpha; m = mn;
            const int nk = min(64, t - s0 + 1);
            for (int j = 0; j < nk; ++j) { const float pj = __shfl(p, j); const unsigned w = *(const unsigned*)(VA + (size_t)(b * SEQ + s0 + j) * 1024 + h * 128 + 2 * lane);
                o0 = fmaf(pj, __uint_as_float(w << 16), o0); o1 = fmaf(pj, __uint_as_float(w & 0xffff0000u), o1); }
        }
        const float il = 1.f / l;
        *(unsigned*)(MIXIN + (size_t)row * 2048 + 1024 + h * 128 + 2 * lane) = pk2(o0 * il, o1 * il);
    }
}

__device__ __forceinline__ void p3_naive(const Args& A, float* ldsf) {
    const bf16_t* MIXIN = (const bf16_t*)(A.ws + WS_MIXIN); const bf16_t* G = (const bf16_t*)(A.ws + WS_G); bf16_t* MIXED = (bf16_t*)(A.ws + WS_MIXED);
    const float* wps = A.in[11]; const float* wpf = A.in[12];
    naive_gemm(ldsf, T, DM, 2048, 1024,
        [=](int m, int k) { return bf2f(MIXIN[(size_t)m * 2048 + k]); },
        [=](int k, int n) { return k < 1024 ? wps[(size_t)k * DM + n] : wpf[(size_t)(k - 1024) * DM + n]; },
        [=](int m, int n, float s1, float s2) { MIXED[(size_t)m * DM + n] = f2bf(bf2f(G[(size_t)m * 4096 + n]) * s1 + bf2f(G[(size_t)m * 4096 + 2048 + n]) * s2); });
}
__device__ __forceinline__ void p4_naive(const Args& A, float* ldsf) {
    const bf16_t* MIXED = (const bf16_t*)(A.ws + WS_MIXED); const float* wo = A.in[13]; const float* x = A.in[0]; float* X1 = A.out;
    naive_gemm(ldsf, T, DM, DM, DM,
        [=](int m, int k) { return bf2f(MIXED[(size_t)m * DM + k]); },
        [=](int k, int n) { return wo[(size_t)k * DM + n]; },
        [=](int m, int n, float s, float) { X1[(size_t)m * DM + n] = x[(size_t)m * DM + n] + s; });
}

template <int ALT> __device__ __forceinline__ void p5_router(const Args& A, float* ldsf) {
    const float* X1 = A.out; const float* g2 = A.in[14]; const float* wrg = A.in[15]; const float* brg = A.in[16]; const float* wre = A.in[17]; const float* bre = A.in[18];
    bf16_t* H2 = (bf16_t*)(A.ws + WS_H2); unsigned* cnt = (unsigned*)(A.ws + WS_CTL) + CW_CNT + (ALT ? 2048 : 0);
    int* TOK = (int*)(A.ws + (ALT ? WS_H : WS_TOK)); float* GATE = (float*)(A.ws + (ALT ? WS_H + 2 * MiB : WS_GATE)); int* ASG = (int*)(A.ws + (ALT ? WS_H + 4 * MiB : WS_ASG));
    const int tid = threadIdx.x, lane = tid & 63, wave = tid >> 6, r = tid >> 4, ks = tid & 15;
    float* Ws = ldsf;
    float* Xs = ldsf + 256 * 36;
    float* rs = Xs + 32 * 260;
    int* hist = (int*)(rs + 32);
    int* hbase = hist + 32;
    int* sel = hbase + 32;
    int* lpos = sel + 64;
    float* selw = (float*)(lpos + 64);
    for (int rb = blockIdx.x; rb < T / 32; rb += gridDim.x) {
        const int row0 = rb * 32;
        for (int i = 0; i < 4; ++i) { const int rr = wave * 4 + i; const f32x4* xr = (const f32x4*)(X1 + (size_t)(row0 + rr) * DM) + lane; float ss = 0.f;
#pragma unroll
            for (int j = 0; j < 8; ++j) { const f32x4 v = xr[64 * j]; ss += v.x * v.x + v.y * v.y + v.z * v.z + v.w * v.w; }
            ss = wave_sum(ss); if (lane == 0) rs[rr] = rsqrtf(ss * (1.f / DM) + EPS); }
        if (tid < 32) hist[tid] = 0;
        __syncthreads();
        float acc[36];
#pragma unroll
        for (int j = 0; j < 36; ++j) acc[j] = 0.f;
        for (int k0 = 0; k0 < DM; k0 += 256) {
            for (int i = tid; i < 256 * 36; i += NTHREADS) { const int kk = i / 36, j = i % 36; Ws[i] = j < 4 ? wrg[(size_t)(k0 + kk) * 4 + j] : wre[(size_t)(k0 + kk) * 32 + j - 4]; }
            for (int i = tid; i < 32 * 256; i += NTHREADS) { const int rr = i >> 8, kk = i & 255; const float hv = X1[(size_t)(row0 + rr) * DM + k0 + kk] * rs[rr] * g2[k0 + kk];
                Xs[rr * 260 + kk] = hv; H2[(size_t)(row0 + rr) * DM + k0 + kk] = f2bf(hv); }
            __syncthreads();
            for (int kk = ks; kk < 256; kk += 16) { const float xv = Xs[r * 260 + kk]; const float* wr = Ws + kk * 36;
#pragma unroll
                for (int j = 0; j < 36; ++j) acc[j] = fmaf(xv, wr[j], acc[j]); }
            __syncthreads();
        }
#pragma unroll
        for (int j = 0; j < 36; ++j) { float v = acc[j]; v += __shfl_xor(v, 1); v += __shfl_xor(v, 2); v += __shfl_xor(v, 4); v += __shfl_xor(v, 8); acc[j] = v; }
        if (ks == 0) {
            float gl[4]; int grp = 0; float gm;
#pragma unroll
            for (int j = 0; j < 4; ++j) gl[j] = acc[j] + brg[j];
            gm = gl[0];
#pragma unroll
            for (int j = 1; j < 4; ++j) if (gl[j] > gm) { gm = gl[j]; grp = j; }
            float den = 0.f;
#pragma unroll
            for (int j = 0; j < 4; ++j) den += __expf(gl[j] - gm);
            const float pg = 1.f / den;
            float el[8];
#pragma unroll
            for (int j = 0; j < 8; ++j) { float v = 0.f;
#pragma unroll
                for (int g = 0; g < 4; ++g) if (g == grp) v = acc[4 + g * 8 + j] + bre[g * 8 + j];
                el[j] = v; }
            int i0 = 0; float v0 = el[0];
#pragma unroll
            for (int j = 1; j < 8; ++j) if (el[j] > v0) { v0 = el[j]; i0 = j; }
            int i1 = -1; float v1 = -INFINITY;
#pragma unroll
            for (int j = 0; j < 8; ++j) if (j != i0 && el[j] > v1) { v1 = el[j]; i1 = j; }
            const float e1 = __expf(v1 - v0); const float w0 = pg / (1.f + e1), w1 = pg * e1 / (1.f + e1);
            const int ea = grp * 8 + i0, eb = grp * 8 + i1;
            sel[r * 2] = ea; sel[r * 2 + 1] = eb; selw[r * 2] = w0; selw[r * 2 + 1] = w1;
            lpos[r * 2] = atomicAdd(&hist[ea], 1); lpos[r * 2 + 1] = atomicAdd(&hist[eb], 1);
        }
        __syncthreads();
        if (tid < 32) hbase[tid] = hist[tid] > 0 ? (int)atomicAdd(&cnt[(tid) * CNT_STRIDE], (unsigned)hist[tid]) : 0;
        __syncthreads();
        if (tid < 64) { const int e = sel[tid], pos = hbase[e] + lpos[tid]; const int tok = row0 + (tid >> 1);
            TOK[(size_t)e * T + pos] = tok; GATE[(size_t)e * T + pos] = selw[tid]; ASG[tok * 2 + (tid & 1)] = (e << 16) | pos; }
        __syncthreads();
    }
}

template <int ALT> __device__ __forceinline__ void p5_router2(const Args& A, float* ldsf) {
    const float* X1 = A.out; const float* g2 = A.in[14]; const float* wrg = A.in[15]; const float* brg = A.in[16]; const float* wre = A.in[17]; const float* bre = A.in[18];
    bf16_t* H2 = (bf16_t*)(A.ws + WS_H2); unsigned* cnt = (unsigned*)(A.ws + WS_CTL) + CW_CNT + (ALT ? 2048 : 0);
    int* TOK = (int*)(A.ws + (ALT ? WS_H : WS_TOK)); float* GATE = (float*)(A.ws + (ALT ? WS_H + 2 * MiB : WS_GATE)); int* ASG = (int*)(A.ws + (ALT ? WS_H + 4 * MiB : WS_ASG));
    const int tid = threadIdx.x, lane = tid & 63, wave = tid >> 6;
    constexpr int XP = 260, XB = 32 * XP, WP = 40, WB = 256 * WP;
    float* Xs = ldsf;
    float* Ws = ldsf + 2 * XB;
    float* misc = ldsf + 2 * XB + 2 * WB;
    float* rs = misc;
    float* lg = misc + 32;
    int* hist = (int*)(misc + 32 + 1280); int* hbase = hist + 32; int* sel = hbase + 32; int* lpos = sel + 64; float* selw = (float*)(lpos + 64);
    const int kh2 = lane >> 5, rp = (lane >> 1) & 15, cg = lane & 1;
    for (int rb = blockIdx.x; rb < T / 32; rb += gridDim.x) {
        const int row0 = rb * 32;
        float ssq[4] = {0.f, 0.f, 0.f, 0.f};
        float acc0[20], acc1[20];
#pragma unroll
        for (int j = 0; j < 20; ++j) { acc0[j] = 0.f; acc1[j] = 0.f; }
        if (tid < 32) hist[tid] = 0;
        f32x4 xr[4], wv[5], gv;
        for (int i = tid; i < 2 * 256; i += NTHREADS) *(f32x4*)(Ws + (i >> 8) * WB + (i & 255) * WP + 36) = (f32x4){0.f, 0.f, 0.f, 0.f};
#define R2_LOAD(k0) do { gv = *(const f32x4*)(g2 + (k0) + 4 * (tid & 63)); \
        _Pragma("unroll") for (int i = 0; i < 4; ++i) xr[i] = *(const f32x4*)(X1 + (size_t)(row0 + wave + 8 * i) * DM + (k0) + 4 * (tid & 63)); \
        _Pragma("unroll") for (int i = 0; i < 5; ++i) { const int idx = tid + i * 512; if (idx < 2304) { const int kk = idx / 9, j4 = idx - kk * 9; \
            wv[i] = j4 == 0 ? *(const f32x4*)(wrg + (size_t)((k0) + kk) * 4) : *(const f32x4*)(wre + (size_t)((k0) + kk) * 32 + 4 * (j4 - 1)); } } } while (0)
#define R2_STORE(buf) do { \
        _Pragma("unroll") for (int i = 0; i < 4; ++i) { ssq[i] += xr[i].x * xr[i].x + xr[i].y * xr[i].y + xr[i].z * xr[i].z + xr[i].w * xr[i].w; \
            *(f32x4*)(Xs + (buf) * XB + (wave + 8 * i) * XP + 4 * (tid & 63)) = xr[i] * gv; } \
        _Pragma("unroll") for (int i = 0; i < 5; ++i) { const int idx = tid + i * 512; if (idx < 2304) { const int kk = idx / 9, j4 = idx - kk * 9; *(f32x4*)(Ws + (buf) * WB + kk * WP + 4 * j4) = wv[i]; } } } while (0)
        R2_LOAD(0); R2_STORE(0);
        __syncthreads();
#pragma unroll 1
        for (int c = 0; c < 8; ++c) {
            const int buf = c & 1;
            if (c < 7) R2_LOAD((c + 1) * 256);
            const float* xa = Xs + buf * XB + (2 * rp) * XP + (wave * 2 + kh2) * 16; const float* wa = Ws + buf * WB + ((wave * 2 + kh2) * 16) * WP + 20 * cg;
#pragma unroll 1
            for (int k4 = 0; k4 < 4; ++k4) {
                const f32x4 x0 = *(const f32x4*)(xa + 4 * k4), x1 = *(const f32x4*)(xa + XP + 4 * k4);
#pragma unroll
                for (int kk = 0; kk < 4; ++kk) { const float* wr = wa + (4 * k4 + kk) * WP;
#pragma unroll
                    for (int j4 = 0; j4 < 5; ++j4) { const f32x4 w = *(const f32x4*)(wr + 4 * j4);
#pragma unroll
                        for (int e = 0; e < 4; ++e) { acc0[4 * j4 + e] = fmaf(x0[kk], w[e], acc0[4 * j4 + e]); acc1[4 * j4 + e] = fmaf(x1[kk], w[e], acc1[4 * j4 + e]); } }
                    asm volatile("" ::: "memory"); }
            }
            if (c < 7) R2_STORE(buf ^ 1);
            __syncthreads();
        }
#undef R2_LOAD
#undef R2_STORE
#pragma unroll
        for (int j = 0; j < 20; ++j) { acc0[j] += __shfl_xor(acc0[j], 32); acc1[j] += __shfl_xor(acc1[j], 32); }
        float* red = Xs;
        if (kh2 == 0) {
#pragma unroll
            for (int j = 0; j < 20; ++j) { red[(wave * 32 + 2 * rp) * 40 + 20 * cg + j] = acc0[j]; red[(wave * 32 + 2 * rp + 1) * 40 + 20 * cg + j] = acc1[j]; } }
#pragma unroll
        for (int i = 0; i < 4; ++i) { const float s = wave_sum(ssq[i]); if (lane == 0) rs[wave + 8 * i] = rsqrtf(s * (1.f / DM) + EPS); }
        __syncthreads();
        for (int i = tid; i < 32 * 40; i += NTHREADS) { float s = 0.f;
#pragma unroll
            for (int w = 0; w < 8; ++w) s += red[w * 1280 + i];
            lg[i] = s * rs[i / 40]; }
        __syncthreads();
#pragma unroll 1
        for (int i = 0; i < 4; ++i) { const int rr = wave + 8 * i; const float rstd = rs[rr]; const float* xp = X1 + (size_t)(row0 + rr) * DM; bf16_t* hp = H2 + (size_t)(row0 + rr) * DM;
#pragma unroll 2
            for (int j = 0; j < 8; ++j) { const int c0 = 256 * j + 4 * lane; const f32x4 v = *(const f32x4*)(xp + c0), g = *(const f32x4*)(g2 + c0);
                u32x2 o; o.x = pk2(v.x * rstd * g.x, v.y * rstd * g.y); o.y = pk2(v.z * rstd * g.z, v.w * rstd * g.w); *(u32x2*)(hp + c0) = o; } }
        if (tid < 32) {
            const int r = tid; const float* L = lg + r * 40;
            float gl[4]; int grp = 0;
#pragma unroll
            for (int j = 0; j < 4; ++j) gl[j] = L[j] + brg[j];
            float gm = gl[0];
#pragma unroll
            for (int j = 1; j < 4; ++j) if (gl[j] > gm) { gm = gl[j]; grp = j; }
            float den = 0.f;
#pragma unroll
            for (int j = 0; j < 4; ++j) den += __expf(gl[j] - gm);
            const float pg = 1.f / den;
            float el[8];
#pragma unroll
            for (int j = 0; j < 8; ++j) el[j] = L[4 + grp * 8 + j] + bre[grp * 8 + j];
            int i0 = 0; float v0 = el[0];
#pragma unroll
            for (int j = 1; j < 8; ++j) if (el[j] > v0) { v0 = el[j]; i0 = j; }
            int i1 = -1; float v1 = -INFINITY;
#pragma unroll
            for (int j = 0; j < 8; ++j) if (j != i0 && el[j] > v1) { v1 = el[j]; i1 = j; }
            const float e1 = __expf(v1 - v0); const float w0 = pg / (1.f + e1), w1 = pg * e1 / (1.f + e1);
            const int ea = grp * 8 + i0, eb = grp * 8 + i1;
            sel[r * 2] = ea; sel[r * 2 + 1] = eb; selw[r * 2] = w0; selw[r * 2 + 1] = w1;
            lpos[r * 2] = atomicAdd(&hist[ea], 1); lpos[r * 2 + 1] = atomicAdd(&hist[eb], 1);
        }
        __syncthreads();
        if (tid < 32) hbase[tid] = hist[tid] > 0 ? (int)atomicAdd(&cnt[(tid) * CNT_STRIDE], (unsigned)hist[tid]) : 0;
        __syncthreads();
        if (tid < 64) { const int e = sel[tid], pos = hbase[e] + lpos[tid]; const int tok = row0 + (tid >> 1);
            TOK[(size_t)e * T + pos] = tok; GATE[(size_t)e * T + pos] = selw[tid]; ASG[tok * 2 + (tid & 1)] = (e << 16) | pos; }
        __syncthreads();
    }
}

constexpr size_t WS_WR = 7 * MiB;
__device__ __forceinline__ void p0_router_weights(const Args& A) {
    const float* g2 = A.in[14]; const float* wrg = A.in[15]; const float* wre = A.in[17]; bf16_t* WR = (bf16_t*)(A.ws + WS_WR);
    for (int i = blockIdx.x * NTHREADS + threadIdx.x; i < 64 * DM; i += gridDim.x * NTHREADS) { const int n = i >> 11, k = i & (DM - 1);
        const float w = n < 4 ? wrg[(size_t)k * 4 + n] * g2[k] : (n < 36 ? wre[(size_t)k * 32 + n - 4] * g2[k] : 0.f);
        const bf16_t h = f2bf(w); const int j = ((k >> 4) * 64 + n) * 16 + (k & 15);
        WR[j] = h; WR[64 * DM + j] = f2bf(w - bf2f(h)); }
}
constexpr size_t WS_RSTL = WS_CKL;
template <int ALT> __device__ __forceinline__ void p5_router3(const Args& A, float* ldsf) {
    float* RSTL = (float*)(A.ws + (ALT ? WS_H + 6 * MiB : WS_RSTL));
    typedef short bf16x8 __attribute__((ext_vector_type(8))); typedef float f32x16 __attribute__((ext_vector_type(16)));
    const float* X1 = A.out; const float* g2 = A.in[14]; const float* brg = A.in[16]; const float* bre = A.in[18]; const bf16_t* WR = (const bf16_t*)(A.ws + WS_WR);
    bf16_t* H2 = (bf16_t*)(A.ws + WS_H2); unsigned* cnt = (unsigned*)(A.ws + WS_CTL) + CW_CNT + (ALT ? 2048 : 0);
    int* TOK = (int*)(A.ws + (ALT ? WS_H : WS_TOK)); float* GATE = (float*)(A.ws + (ALT ? WS_H + 2 * MiB : WS_GATE)); int* ASG = (int*)(A.ws + (ALT ? WS_H + 4 * MiB : WS_ASG));
    const int tid = threadIdx.x, lane = tid & 63, wave = tid >> 6, r32 = lane & 31, hi = lane >> 5;
    float* red = ldsf;
    float* lg = ldsf + 16384;
    float* sq = lg + 2048;
    float* rs = sq + 256;
    int* hist = (int*)(rs + 32); int* hbase = hist + 32; int* sel = hbase + 32; int* lpos = sel + 64; float* selw = (float*)(lpos + 64);
    for (int rb = blockIdx.x; rb < T / 32; rb += gridDim.x) {
        const int row0 = rb * 32;
        if (tid < 32) hist[tid] = 0;
        const float* xp = X1 + (size_t)(row0 + r32) * DM + 256 * wave + 8 * hi;
        const bf16_t* wp = WR + (size_t)((16 * wave) * 64 + r32) * 16 + 8 * hi;
        f32x16 acc[2];
#pragma unroll
        for (int j = 0; j < 2; ++j)
#pragma unroll
            for (int r = 0; r < 16; ++r) acc[j][r] = 0.f;
        float ssq = 0.f;
        f32x4 xa[4], xb[4], xna[4], xnb[4];
#pragma unroll
        for (int i = 0; i < 4; ++i) { xa[i] = *(const f32x4*)(xp + 16 * i); xb[i] = *(const f32x4*)(xp + 16 * i + 4); }
#pragma unroll 1
        for (int kb = 0; kb < (ALT == 3 ? 0 : 4); ++kb) {
            bf16x8 wh0[4], wh1[4], wl0[4], wl1[4]; f32x4 ga[4], gb[4];
#pragma unroll
            for (int i = 0; i < 4; ++i) { const int ko = 64 * kb + 16 * i;
                const int wo = (4 * kb + i) * 1024;
                wh0[i] = *(const bf16x8*)(wp + wo); wh1[i] = *(const bf16x8*)(wp + 512 + wo); wl0[i] = *(const bf16x8*)(wp + (size_t)64 * DM + wo); wl1[i] = *(const bf16x8*)(wp + (size_t)64 * DM + 512 + wo);
                ga[i] = *(const f32x4*)(g2 + 256 * wave + 8 * hi + ko); gb[i] = *(const f32x4*)(g2 + 256 * wave + 8 * hi + ko + 4); }
            asm volatile("" ::: "memory");
            if (kb < 3) {
#pragma unroll
                for (int i = 0; i < 4; ++i) { xna[i] = *(const f32x4*)(xp + 64 * (kb + 1) + 16 * i); xnb[i] = *(const f32x4*)(xp + 64 * (kb + 1) + 16 * i + 4); } }
            asm volatile("" ::: "memory");
#pragma unroll
            for (int i = 0; i < 4; ++i) { const int ko = 64 * kb + 16 * i;
                { u32x4 hw; hw.x = cvtpk_rne(xa[i][0] * ga[i][0], xa[i][1] * ga[i][1]); hw.y = cvtpk_rne(xa[i][2] * ga[i][2], xa[i][3] * ga[i][3]); hw.z = cvtpk_rne(xb[i][0] * gb[i][0], xb[i][1] * gb[i][1]); hw.w = cvtpk_rne(xb[i][2] * gb[i][2], xb[i][3] * gb[i][3]);
                  *(u32x4*)(H2 + (size_t)(row0 + r32) * DM + 256 * wave + 8 * hi + ko) = hw; }
                float xv[8] = {xa[i][0], xa[i][1], xa[i][2], xa[i][3], xb[i][0], xb[i][1], xb[i][2], xb[i][3]}; u32x4 ph, pl;
#pragma unroll
                for (int e = 0; e < 4; ++e) { const float a = xv[2 * e], b2 = xv[2 * e + 1]; ssq += a * a + b2 * b2; const unsigned hh = cvtpk_rne(a, b2); ph[e] = hh;
                    pl[e] = cvtpk_rne(a - __uint_as_float(hh << 16), b2 - __uint_as_float(hh & 0xffff0000u)); }
                const bf16x8 xh = __builtin_bit_cast(bf16x8, ph), xl = __builtin_bit_cast(bf16x8, pl);
                acc[0] = __builtin_amdgcn_mfma_f32_32x32x16_bf16(xh, wh0[i], acc[0], 0, 0, 0); acc[0] = __builtin_amdgcn_mfma_f32_32x32x16_bf16(xl, wh0[i], acc[0], 0, 0, 0); acc[0] = __builtin_amdgcn_mfma_f32_32x32x16_bf16(xh, wl0[i], acc[0], 0, 0, 0);
                acc[1] = __builtin_amdgcn_mfma_f32_32x32x16_bf16(xh, wh1[i], acc[1], 0, 0, 0); acc[1] = __builtin_amdgcn_mfma_f32_32x32x16_bf16(xl, wh1[i], acc[1], 0, 0, 0); acc[1] = __builtin_amdgcn_mfma_f32_32x32x16_bf16(xh, wl1[i], acc[1], 0, 0, 0); }
#pragma unroll
            for (int i = 0; i < 4; ++i) { xa[i] = xna[i]; xb[i] = xnb[i]; }
        }
#pragma unroll
        for (int j = 0; j < 2; ++j)
#pragma unroll
            for (int r = 0; r < 16; ++r) red[((wave * 2 + j) * 16 + r) * 64 + lane] = acc[j][r];
        ssq += __shfl_xor(ssq, 32);
        if (hi == 0) sq[wave * 32 + r32] = ssq;
        __syncthreads();
        if (ALT == 2) continue;
#pragma unroll
        for (int j = 0; j < 2; ++j)
#pragma unroll
            for (int rr = 0; rr < 2; ++rr) { const int r = 2 * wave + rr; float s = 0.f;
#pragma unroll
                for (int w2 = 0; w2 < 8; ++w2) s += red[((w2 * 2 + j) * 16 + r) * 64 + lane];
                lg[((r & 3) + 8 * (r >> 2) + 4 * hi) * 64 + 32 * j + r32] = s; }
        if (tid < 32) { float s = 0.f;
#pragma unroll
            for (int w2 = 0; w2 < 8; ++w2) s += sq[w2 * 32 + tid];
            rs[tid] = rsqrtf(s * (1.f / DM) + EPS); }
        __syncthreads();
        if (tid < 32) {
            const int r = tid; const float* L = lg + r * 64; const float rstd = rs[r];
            float gl[4]; int grp = 0;
#pragma unroll
            for (int j = 0; j < 4; ++j) gl[j] = L[j] * rstd + brg[j];
            float gm = gl[0];
#pragma unroll
            for (int j = 1; j < 4; ++j) if (gl[j] > gm) { gm = gl[j]; grp = j; }
            float den = 0.f;
#pragma unroll
            for (int j = 0; j < 4; ++j) den += __expf(gl[j] - gm);
            const float pg = 1.f / den;
            float el[8];
#pragma unroll
            for (int j = 0; j < 8; ++j) el[j] = L[4 + grp * 8 + j] * rstd + bre[grp * 8 + j];
            int i0 = 0; float v0 = el[0];
#pragma unroll
            for (int j = 1; j < 8; ++j) if (el[j] > v0) { v0 = el[j]; i0 = j; }
            int i1 = -1; float v1 = -INFINITY;
#pragma unroll
            for (int j = 0; j < 8; ++j) if (j != i0 && el[j] > v1) { v1 = el[j]; i1 = j; }
            const float e1 = __expf(v1 - v0); const float w0 = pg / (1.f + e1), w1 = pg * e1 / (1.f + e1);
            const int ea = grp * 8 + i0, eb = grp * 8 + i1;
            sel[r * 2] = ea; sel[r * 2 + 1] = eb; selw[r * 2] = w0; selw[r * 2 + 1] = w1;
            lpos[r * 2] = atomicAdd(&hist[ea], 1); lpos[r * 2 + 1] = atomicAdd(&hist[eb], 1);
        }
        __syncthreads();
        if (tid < 32) hbase[tid] = hist[tid] > 0 ? (int)atomicAdd(&cnt[(tid) * CNT_STRIDE], (unsigned)hist[tid]) : 0;
        __syncthreads();
        if (tid < 64) { const int e = sel[tid], pos = hbase[e] + lpos[tid]; const int tok = row0 + (tid >> 1);
            TOK[(size_t)e * T + pos] = tok; GATE[(size_t)e * T + pos] = selw[tid]; RSTL[(size_t)e * T + pos] = rs[tid >> 1]; ASG[tok * 2 + (tid & 1)] = (e << 16) | pos; }
        __syncthreads();
    }
}

__device__ __forceinline__ void expert_layout(const unsigned* cnt, int* pstart  ) {
    int acc = 0;
    for (int e = 0; e < NEXP; ++e) { pstart[e] = acc; acc += ((int)cnt[(e) * CNT_STRIDE] + MTILE - 1) / MTILE * MTILE; }
    pstart[NEXP] = acc;
}

__device__ __forceinline__ void p6_naive(const Args& A, float* ldsf) {
    const bf16_t* H2 = (const bf16_t*)(A.ws + WS_H2); const float* wg = A.in[19]; const float* wu = A.in[20]; bf16_t* ACT = (bf16_t*)(A.ws + WS_ACT);
    const unsigned* cnt = (const unsigned*)(A.ws + WS_CTL) + CW_CNT; const int* TOK = (const int*)(A.ws + WS_TOK);
    int* ps = (int*)(ldsf + 2 * 16 * 132);
    if (threadIdx.x == 0) expert_layout(cnt, ps);
    __syncthreads();
    int ntot = 0;
    for (int e = 0; e < NEXP; ++e) ntot += (((int)cnt[(e) * CNT_STRIDE] + 127) / 128) * 4;
    for (int t = blockIdx.x; t < ntot; t += gridDim.x) {
        int e = 0, rem = t;
        for (; e < NEXP; ++e) { const int n = (((int)cnt[(e) * CNT_STRIDE] + 127) / 128) * 4; if (rem < n) break; rem -= n; }
        const int c = (int)cnt[(e) * CNT_STRIDE]; const int tm = rem / 4, tn = rem % 4; const int* tl = TOK + (size_t)e * T; const int prow = ps[e];
        const float* wge = wg + (size_t)e * DM * DEXP; const float* wue = wu + (size_t)e * DM * DEXP;
        naive_gemm_tile(ldsf, tm * 128, tn * 128, c, DEXP, 2 * DM, DM,
            [=](int m, int k) { return bf2f(H2[(size_t)tl[m] * DM + (k & (DM - 1))]); },
            [=](int k, int n) { return k < DM ? wge[(size_t)k * DEXP + n] : wue[(size_t)(k - DM) * DEXP + n]; },
            [=](int m, int n, float sg, float su) { ACT[(size_t)(prow + m) * DEXP + n] = f2bf(sg / (1.f + __expf(-sg)) * su); });
    }
}
__device__ __forceinline__ void p7_naive(const Args& A, float* ldsf) {
    const bf16_t* ACT = (const bf16_t*)(A.ws + WS_ACT); const float* wd = A.in[21]; bf16_t* YBUF = (bf16_t*)(A.ws + WS_YBUF);
    const unsigned* cnt = (const unsigned*)(A.ws + WS_CTL) + CW_CNT; const float* GATE = (const float*)(A.ws + WS_GATE);
    int* ps = (int*)(ldsf + 2 * 16 * 132);
    if (threadIdx.x == 0) expert_layout(cnt, ps);
    __syncthreads();
    int ntot = 0;
    for (int e = 0; e < NEXP; ++e) ntot += (((int)cnt[(e) * CNT_STRIDE] + 127) / 128) * 16;
    for (int t = blockIdx.x; t < ntot; t += gridDim.x) {
        int e = 0, rem = t;
        for (; e < NEXP; ++e) { const int n = (((int)cnt[(e) * CNT_STRIDE] + 127) / 128) * 16; if (rem < n) break; rem -= n; }
        const int c = (int)cnt[(e) * CNT_STRIDE]; const int tm = rem / 16, tn = rem % 16; const float* gl = GATE + (size_t)e * T; const int prow = ps[e];
        const float* wde = wd + (size_t)e * DEXP * DM;
        naive_gemm_tile(ldsf, tm * 128, tn * 128, c, DM, DEXP, DEXP,
            [=](int m, int k) { return bf2f(ACT[(size_t)(prow + m) * DEXP + k]); },
            [=](int k, int n) { return wde[(size_t)k * DM + n]; },
            [=](int m, int n, float s, float) { YBUF[(size_t)(prow + m) * DM + n] = f2bf(s * gl[m]); });
    }
}

template <int ALT> __device__ __forceinline__ void p8_combine(const Args& A, float* ldsf, const float dlt = 0.f) {
    float* X1 = A.out; float* XO = ALT ? (float*)(A.ws + WS_WGU) : A.out; const bf16_t* YBUF = (const bf16_t*)(A.ws + WS_YBUF); const int* ASG = (const int*)(A.ws + WS_ASG);
    const unsigned* cnt = (const unsigned*)(A.ws + WS_CTL) + CW_CNT;
    int* ps = (int*)ldsf;
    if (threadIdx.x == 0) expert_layout(cnt, ps);
    __syncthreads();
    float dl2 = dlt;
    if (STAMP_PHASE == 97) { int v = 0, mx = 0, mn = 1 << 30, nt_ = 0, tiny = 0, half = 0; for (int e = 0; e < NEXP; ++e) { const int c = (int)cnt[(e) * CNT_STRIDE]; mx = c > mx ? c : mx; mn = c < mn ? c : mn; nt_ += (c + 255) / 256; const int rem = c % 256; tiny += (rem > 0 && rem <= 64) ? 1 : 0; half += (rem > 0 && rem <= 128) ? 1 : 0; }
        v = STAMP_SEL == 0 ? nt_ : STAMP_SEL == 1 ? mx : STAMP_SEL == 2 ? mn : STAMP_SEL == 3 ? tiny : half; dl2 = 0.01f * (float)v; }
    const int tid = threadIdx.x, lane = tid & 63, wave = tid >> 6;
    const int gw = blockIdx.x * NWAVES + wave, NGW = gridDim.x * NWAVES;
    u32x4 w0[4], w1[4], n0[4], n1[4]; f32x4 xa[4], xb[4], na[4], nb[4];
#define P8_LOAD(row_, W0, W1, XA, XB) do { const int a0_ = ASG[(row_) * 2], a1_ = ASG[(row_) * 2 + 1]; \
        const bf16_t* y0_ = YBUF + (size_t)(ps[a0_ >> 16] + (a0_ & 0xffff)) * DM; const bf16_t* y1_ = YBUF + (size_t)(ps[a1_ >> 16] + (a1_ & 0xffff)) * DM; const float* xr_ = X1 + (size_t)(row_) * DM; \
        _Pragma("unroll") for (int j = 0; j < 4; ++j) { const int c0 = 512 * j + 8 * lane; W0[j] = *(const u32x4*)(y0_ + c0); W1[j] = *(const u32x4*)(y1_ + c0); XA[j] = *(const f32x4*)(xr_ + c0); XB[j] = *(const f32x4*)(xr_ + c0 + 4); } } while (0)
    int row = gw;
    if (row < T) P8_LOAD(row, w0, w1, xa, xb);
    for (; row < T; row += NGW) {
        const int nrow = row + NGW; const bool more = nrow < T;
        if (more) P8_LOAD(nrow, n0, n1, na, nb);
        float* xo = XO + (size_t)row * DM;
#pragma unroll
        for (int j = 0; j < 4; ++j) { const int c0 = 512 * j + 8 * lane; f32x4 a = xa[j], b2 = xb[j];
            a.x += __uint_as_float(w0[j][0] << 16) + __uint_as_float(w1[j][0] << 16); a.y += __uint_as_float(w0[j][0] & 0xffff0000u) + __uint_as_float(w1[j][0] & 0xffff0000u);
            a.z += __uint_as_float(w0[j][1] << 16) + __uint_as_float(w1[j][1] << 16); a.w += __uint_as_float(w0[j][1] & 0xffff0000u) + __uint_as_float(w1[j][1] & 0xffff0000u);
            b2.x += __uint_as_float(w0[j][2] << 16) + __uint_as_float(w1[j][2] << 16); b2.y += __uint_as_float(w0[j][2] & 0xffff0000u) + __uint_as_float(w1[j][2] & 0xffff0000u);
            b2.z += __uint_as_float(w0[j][3] << 16) + __uint_as_float(w1[j][3] << 16); b2.w += __uint_as_float(w0[j][3] & 0xffff0000u) + __uint_as_float(w1[j][3] & 0xffff0000u);
            if (STAMP_PHASE >= 0) { a += dl2; b2 += dl2; }
            *(f32x4*)(xo + c0) = a; *(f32x4*)(xo + c0 + 4) = b2; }
        if (more) {
#pragma unroll
            for (int j = 0; j < 4; ++j) { w0[j] = n0[j]; w1[j] = n1[j]; xa[j] = na[j]; xb[j] = nb[j]; } }
    }
#undef P8_LOAD
}

namespace pg8 {
#define PG8_LAS __attribute__((address_space(3)))
typedef short bf16x8 __attribute__((ext_vector_type(8)));
constexpr int BM = 256, BK = 64, HALF = 128, HTB = HALF * BK * 2, STAGE_BYTES = 8 * HTB, NXCD = 8, WGM = 8;
__host__ __device__ __forceinline__ int lds_byte(int r, int c) { const int st = (r >> 4) * 2 + (c >> 5), rr = r & 15, cc = c & 31, ob = rr * 64 + cc * 2; return st * 1024 + (ob ^ (((ob >> 9) & 1) << 5)); }
__host__ __device__ __forceinline__ void stage_rc(int b, int& R, int& C) { const int st = b / 1024, sb = b % 1024, swz = sb ^ (((sb >> 9) & 1) << 5); R = (st >> 1) * 16 + swz / 64; C = (st & 1) * 32 + (swz % 64) / 2; }
__host__ __device__ __forceinline__ int perm32(int rho) { const int n = rho >> 4, i = rho & 15; return 8 * (i >> 2) + 4 * n + (i & 3); }

struct Unit { const char* A; const char* B; int pm, pn, x0, x1, x2, x3; };

struct DenseOrder {
    const char* A; const char* Bt; int K, nM, nN, nwg, G, c, rep;
    __device__ void init(const void* A_, const void* Bt_, int M, int N, int K_, int G_, int c_, int rep_ = 1) { A = (const char*)A_; Bt = (const char*)Bt_; K = K_; nM = M / BM; nN = N / BM; nwg = nM * nN; G = G_; c = c_; rep = rep_; }
    __device__ bool next(int i, Unit& u) const {
        const long L = (long)i * G + c; if (L >= (long)nwg * rep) return false;
        int wgid = (int)(L % nwg); { const int q = nwg / NXCD, r = nwg % NXCD, xcd = wgid % NXCD, off = wgid / NXCD; wgid = (xcd < r ? xcd * (q + 1) : r * (q + 1) + (xcd - r) * q) + off; }
        const int nig = WGM * nN, gid = wgid / nig, fm = gid * WGM, gsz = (nM - fm) < WGM ? (nM - fm) : WGM;
        u.pm = fm + ((wgid % nig) % gsz); u.pn = (wgid % nig) / gsz; u.x0 = 0; u.x1 = 0; u.x2 = 0; u.x3 = 0;
        u.A = A + (size_t)u.pm * BM * K * 2; u.B = Bt + (size_t)u.pn * BM * K * 2; return true;
    }
    __device__ __forceinline__ void rows(const Unit&, unsigned (&)[2][2], const int (&)[2]) const {}
};

__device__ __forceinline__ unsigned cvt_pk_bf16(float lo, float hi) { unsigned r; asm volatile("v_cvt_pk_bf16_f32 %0, %1, %2" : "=v"(r) : "v"(lo), "v"(hi)); return r; }

template <class Epi, class Sched, bool ALIGN_EPI, bool GATHER, bool SKIP = false>
__device__ __forceinline__ void gemm_phase(PG8_LAS unsigned char* lds, const int K, const Sched& S, const Epi& E) {
    const int tid = threadIdx.x, wid = __builtin_amdgcn_readfirstlane(tid >> 6), lane = tid & 63, wr = wid >> 2, wc = wid & 3, fr = lane & 15, fq = lane >> 4;
    const int nt = K / BK;
    unsigned voffA[2], voffB[2]; int RA[2];
#pragma unroll
    for (int i = 0; i < 2; ++i) { int R, C; stage_rc(tid * 16 + i * 8192, R, C); const int Rb = Epi::PERM ? ((R & ~31) + perm32(R & 31)) : R;
        voffA[i] = GATHER ? (unsigned)(C * 2) : (unsigned)(R * K + C) * 2u; voffB[i] = (unsigned)(Rb * K + C) * 2u; RA[i] = R; }
    const size_t kstep = (size_t)(BK * 2);
    const size_t hstep = (size_t)HALF * K * 2;
    const size_t hstepA = GATHER ? 0 : hstep;
    const unsigned ldsw = (unsigned)wid * 1024u;
    const int aoff = lds_byte(wr * 64 + fr, fq * 8), boff = lds_byte(wc * 32 + fr, fq * 8);
    unsigned gA[2][2], gAn[2][2];
#define PG8_SA(b, h) (((b) * 2 + (h)) * HTB)
#define PG8_SB(b, h) ((4 + (b) * 2 + (h)) * HTB)
#define PG8_STAGE(bufoff, gbase, voff) do { _Pragma("unroll") for (int _i = 0; _i < 2; ++_i) \
        __builtin_amdgcn_global_load_lds((const unsigned*)((const char*)(gbase) + (voff)[_i]), (PG8_LAS unsigned*)(lds + (bufoff) + ldsw + _i * 8192), 16, 0, 0); } while (0)
#define PG8_STAGE_A(bufoff, gbase, h, nx) do { _Pragma("unroll") for (int _i = 0; _i < 2; ++_i) { \
        const unsigned _o = GATHER ? ((nx) ? gAn[h][_i] : gA[h][_i]) + voffA[_i] : voffA[_i]; \
        __builtin_amdgcn_global_load_lds((const unsigned*)((const char*)(gbase) + (h) * hstepA + _o), (PG8_LAS unsigned*)(lds + (bufoff) + ldsw + _i * 8192), 16, 0, 0); } } while (0)
#define PG8_LDA(dst, b, h) do { _Pragma("unroll") for (int m = 0; m < 4; ++m) _Pragma("unroll") for (int k = 0; k < 2; ++k) dst[m][k] = *(const PG8_LAS bf16x8*)(lds + PG8_SA(b, h) + aoff + m * 2048 + k * 1024); } while (0)
#define PG8_LDB(dst, b, h) do { _Pragma("unroll") for (int n = 0; n < 2; ++n) _Pragma("unroll") for (int k = 0; k < 2; ++k) dst[n][k] = *(const PG8_LAS bf16x8*)(lds + PG8_SB(b, h) + boff + n * 2048 + k * 1024); } while (0)
#define PG8_MMA(ai, bj, At, Bt) do { __builtin_amdgcn_s_setprio(1); _Pragma("unroll") for (int m = 0; m < 4; ++m) { if (!SKIP || m < ((ai) == 0 ? mc0 : mc1)) { _Pragma("unroll") for (int n = 0; n < 2; ++n) _Pragma("unroll") for (int k = 0; k < 2; ++k) \
        acc[ai][bj][m][n] = __builtin_amdgcn_mfma_f32_16x16x32_bf16(Bt[n][k], At[m][k], acc[ai][bj][m][n], 0, 0, 0); } } __builtin_amdgcn_s_setprio(0); } while (0)
#define PG8_WAIT_V(n) asm volatile("s_waitcnt vmcnt(" #n ")" ::: "memory")
#define PG8_WAIT_L(n) asm volatile("s_waitcnt lgkmcnt(" #n ")" ::: "memory")
#define PG8_BAR __builtin_amdgcn_s_barrier()
#define PG8_SCHED __builtin_amdgcn_sched_barrier(0)
    Unit cur, nxt; int ui = 0;
    if (!S.next(0, cur)) return;
    int mc0 = 4, mc1 = 4;
#define PG8_MC(u) do { if (SKIP) { const int a_ = ((u).x2 - 64 * wr + 15) >> 4, b_ = ((u).x2 - 128 - 64 * wr + 15) >> 4; mc0 = a_ < 0 ? 0 : (a_ > 4 ? 4 : a_); mc1 = b_ < 0 ? 0 : (b_ > 4 ? 4 : b_); } } while (0)
    PG8_MC(cur);
    f32x4 acc[2][2][4][2];
#pragma unroll
    for (int a = 0; a < 2; ++a)
#pragma unroll
        for (int b = 0; b < 2; ++b)
#pragma unroll
            for (int m = 0; m < 4; ++m)
#pragma unroll
                for (int n = 0; n < 2; ++n) acc[a][b][m][n] = (f32x4){0.f, 0.f, 0.f, 0.f};
    bf16x8 At[4][2], B0[2][2], B1[2][2];
    const char* cA = cur.A; const char* cB = cur.B;
    if constexpr (GATHER) { S.rows(cur, gA, RA);
#pragma unroll
        for (int h = 0; h < 2; ++h)
#pragma unroll
            for (int i = 0; i < 2; ++i) gAn[h][i] = gA[h][i]; }
    PG8_STAGE(PG8_SB(0, 0), cB, voffB); PG8_STAGE(PG8_SB(0, 1), cB + hstep, voffB); PG8_STAGE_A(PG8_SA(0, 0), cA, 0, false); PG8_STAGE_A(PG8_SA(0, 1), cA, 1, false);
    if (wr == 1) PG8_BAR;
    PG8_WAIT_V(2); PG8_BAR;
    PG8_STAGE(PG8_SB(1, 0), cB + kstep, voffB); PG8_STAGE_A(PG8_SA(1, 0), cA + kstep, 0, false); PG8_STAGE(PG8_SB(1, 1), cB + hstep + kstep, voffB);
    PG8_WAIT_V(6); PG8_BAR;
    for (;;) {
        const bool has_next = S.next(ui + 1, nxt);
        const char* nA = has_next ? nxt.A : cA; const char* nB = has_next ? nxt.B : cB;
        if constexpr (GATHER) { if (has_next) { S.rows(nxt, gAn, RA); } }
        for (int t = 0; t < nt; t += 2) {
            const bool last = (t == nt - 2);
            const char* a1 = cA + (size_t)(t + 1) * kstep;
            const char* a2 = last ? nA : cA + (size_t)(t + 2) * kstep; const char* b2 = last ? nB : cB + (size_t)(t + 2) * kstep;
            const char* a3 = a2 + kstep; const char* b3 = b2 + kstep;
            if constexpr (Epi::HAS_MID) { if (t == nt / 2) { int frl = fr, fql = fq; asm volatile("" : "+v"(frl), "+v"(fql)); E.mid(acc, cur, wr, wc, frl, fql); } }
            PG8_LDB(B0, 0, 0); PG8_LDB(B1, 0, 1); PG8_SCHED; PG8_LDA(At, 0, 0); PG8_STAGE_A(PG8_SA(1, 1), a1, 1, false);
            PG8_WAIT_V(8); PG8_WAIT_L(0); PG8_BAR; PG8_MMA(0, 0, At, B0); PG8_MMA(0, 1, At, B1); PG8_BAR; PG8_SCHED;
            PG8_LDA(At, 0, 1); PG8_STAGE(PG8_SB(0, 0), b2, voffB); PG8_STAGE(PG8_SB(0, 1), b2 + hstep, voffB); PG8_STAGE_A(PG8_SA(0, 0), a2, 0, last);
            PG8_WAIT_V(8); PG8_WAIT_L(0); PG8_BAR; PG8_MMA(1, 0, At, B0); PG8_MMA(1, 1, At, B1); PG8_BAR; PG8_SCHED;
            PG8_LDB(B0, 1, 0); PG8_LDB(B1, 1, 1); PG8_SCHED; PG8_LDA(At, 1, 0); PG8_STAGE_A(PG8_SA(0, 1), a2, 1, last);
            PG8_WAIT_V(8); PG8_WAIT_L(0); PG8_BAR; PG8_MMA(0, 0, At, B0); PG8_MMA(0, 1, At, B1); PG8_BAR; PG8_SCHED;
            PG8_LDA(At, 1, 1); PG8_STAGE(PG8_SB(1, 0), b3, voffB); PG8_STAGE(PG8_SB(1, 1), b3 + hstep, voffB); PG8_STAGE_A(PG8_SA(1, 0), a3, 0, last);
            PG8_WAIT_V(8); PG8_WAIT_L(0); PG8_BAR; PG8_MMA(1, 0, At, B0); PG8_MMA(1, 1, At, B1); PG8_BAR; PG8_SCHED;
        }
        if constexpr (ALIGN_EPI) { if (wr == 0) PG8_BAR; }
        { int frl = fr, fql = fq; asm volatile("" : "+v"(frl), "+v"(fql)); E(acc, cur, wr, wc, frl, fql); }
        if (!has_next) break;
#pragma unroll
        for (int a = 0; a < 2; ++a)
#pragma unroll
            for (int b = 0; b < 2; ++b)
#pragma unroll
                for (int m = 0; m < 4; ++m)
#pragma unroll
                    for (int n = 0; n < 2; ++n) acc[a][b][m][n] = (f32x4){0.f, 0.f, 0.f, 0.f};
        cur = nxt; cA = nA; cB = nB; ++ui; PG8_MC(cur);
        if constexpr (GATHER) {
#pragma unroll
            for (int h = 0; h < 2; ++h)
#pragma unroll
                for (int i = 0; i < 2; ++i) gA[h][i] = gAn[h][i]; }
        if constexpr (ALIGN_EPI) { if (wr == 1) PG8_BAR; }
    }
    PG8_WAIT_V(0);
    if constexpr (!ALIGN_EPI) { if (wr == 0) PG8_BAR; }
    PG8_BAR;
#undef PG8_SA
#undef PG8_SB
#undef PG8_STAGE
#undef PG8_STAGE_A
#undef PG8_LDA
#undef PG8_LDB
#undef PG8_MMA
#undef PG8_WAIT_V
#undef PG8_WAIT_L
#undef PG8_BAR
#undef PG8_SCHED
#undef PG8_MC
}
}

constexpr int LDS_MISC_OFF = 131072;
__device__ __forceinline__ float fast_gelu(float x) { const float y = x + 0.044715f * x * x * x; return x * __builtin_amdgcn_rcpf(1.0f + __builtin_amdgcn_exp2f(-2.0f * 0.7978845608028654f * LOG2E * y)); }
__device__ __forceinline__ float fast_sigmoid(float x) { return __builtin_amdgcn_rcpf(1.0f + __builtin_amdgcn_exp2f(-LOG2E * x)); }
__device__ __forceinline__ void unpack8(const u32x4 w, float (&v)[8]) {
#pragma unroll
    for (int e = 0; e < 4; ++e) { v[2 * e] = __uint_as_float(w[e] << 16); v[2 * e + 1] = __uint_as_float(w[e] & 0xffff0000u); } }

constexpr size_t WS_VSTAT = 6 * MiB;
constexpr int LDS_EPI_OFF = 131072 + 4096;
struct EpiIn {
    static constexpr bool PERM = true, HAS_MID = false;
    bf16_t *U, *V, *Q, *K, *VA, *G; const float* b_gate; const float* qg; const float* kg; float* VSTAT; PG8_LAS unsigned char* lds;
    __device__ __forceinline__ void mid(f32x4 (&)[2][2][4][2], const pg8::Unit&, int, int, int, int) const {}
    __device__ __forceinline__ void operator()(f32x4 (&acc)[2][2][4][2], const pg8::Unit& u, int wr, int wc, int fr, int fq) const {
        const int pn = u.pn; bf16_t* base; int ld, colt, mode;
        if (pn < 4) { base = U; ld = 1024; colt = pn * 256; mode = 1; }
        else if (pn < 8) { base = V; ld = 1024; colt = (pn - 4) * 256; mode = 3; }
        else if (pn < 12) { base = Q; ld = 1024; colt = (pn - 8) * 256; mode = 4; }
        else if (pn < 16) { base = K; ld = 1024; colt = (pn - 12) * 256; mode = 5; }
        else if (pn < 20) { base = VA; ld = 1024; colt = (pn - 16) * 256; mode = 0; }
        else { base = G; ld = 4096; colt = (pn - 20) * 256; mode = 2; }
        const int row0 = u.pm * 256 + wr * 64 + fr, col0 = colt + wc * 32 + 8 * fq;
        if (mode >= 4) {
            PG8_LAS float* P = (PG8_LAS float*)(lds + LDS_EPI_OFF);
#pragma unroll
            for (int ai = 0; ai < 2; ++ai)
#pragma unroll
                for (int m = 0; m < 4; ++m)
#pragma unroll
                    for (int bj = 0; bj < 2; ++bj) { const f32x4 a = acc[ai][bj][m][0], b = acc[ai][bj][m][1];
                        float s = (a[0] * a[0] + a[1] * a[1]) + (a[2] * a[2] + a[3] * a[3]) + (b[0] * b[0] + b[1] * b[1]) + (b[2] * b[2] + b[3] * b[3]);
                        s += __shfl_xor(s, 16); s += __shfl_xor(s, 32);
                        if (fq == 0) P[((ai * 128 + wr * 64 + m * 16 + fr) * 2 + bj) * 4 + wc] = s; }
            asm volatile("s_waitcnt lgkmcnt(0)" ::: "memory"); __builtin_amdgcn_s_barrier(); asm volatile("" ::: "memory");
            const float* gg = mode == 4 ? qg : kg; const float qs = mode == 4 ? QSCALE : 1.0f;
            const f32x4 g0 = *(const f32x4*)(gg + wc * 32 + 8 * fq), g1 = *(const f32x4*)(gg + wc * 32 + 8 * fq + 4);
#pragma unroll
            for (int ai = 0; ai < 2; ++ai)
#pragma unroll
                for (int m = 0; m < 4; ++m) { bf16_t* rowp = base + (size_t)(row0 + ai * 128 + m * 16) * ld + col0;
#pragma unroll
                    for (int bj = 0; bj < 2; ++bj) { const f32x4 pp = *(const PG8_LAS f32x4*)(P + ((ai * 128 + wr * 64 + m * 16 + fr) * 2 + bj) * 4);
                        const float sc = rsqrtf(((pp[0] + pp[1]) + (pp[2] + pp[3])) * (1.f / 128.f) + EPS) * qs;
                        const f32x4 v0 = acc[ai][bj][m][0] * g0 * sc, v1 = acc[ai][bj][m][1] * g1 * sc;
                        u32x4 w; w.x = pg8::cvt_pk_bf16(v0[0], v0[1]); w.y = pg8::cvt_pk_bf16(v0[2], v0[3]); w.z = pg8::cvt_pk_bf16(v1[0], v1[1]); w.w = pg8::cvt_pk_bf16(v1[2], v1[3]);
                        *(u32x4*)(rowp + bj * 128) = w; } }
            return;
        }
        f32x4 bv[2][2];
#pragma unroll
        for (int bj = 0; bj < 2; ++bj)
#pragma unroll
            for (int n = 0; n < 2; ++n) bv[bj][n] = (mode == 2) ? *(const f32x4*)(b_gate + col0 + bj * 128 + 4 * n) : (f32x4){0.f, 0.f, 0.f, 0.f};
#pragma unroll
        for (int ai = 0; ai < 2; ++ai)
#pragma unroll
            for (int m = 0; m < 4; ++m) { bf16_t* rowp = base + (size_t)(row0 + ai * 128 + m * 16) * ld + col0; float s1 = 0.f, s2 = 0.f;
#pragma unroll
                for (int bj = 0; bj < 2; ++bj) { f32x4 v0 = acc[ai][bj][m][0], v1 = acc[ai][bj][m][1];
                    if (mode == 1 || mode == 3) {
#pragma unroll
                        for (int j = 0; j < 4; ++j) { v0[j] = fast_gelu(v0[j]); v1[j] = fast_gelu(v1[j]); } }
                    else if (mode == 2) { v0 += bv[bj][0]; v1 += bv[bj][1];
#pragma unroll
                        for (int j = 0; j < 4; ++j) { v0[j] = fast_sigmoid(v0[j]); v1[j] = fast_sigmoid(v1[j]); } }
                    if (mode == 3) {
#pragma unroll
                        for (int j = 0; j < 4; ++j) { s1 += v0[j] + v1[j]; s2 += v0[j] * v0[j] + v1[j] * v1[j]; } }
                    u32x4 w; w.x = pg8::cvt_pk_bf16(v0[0], v0[1]); w.y = pg8::cvt_pk_bf16(v0[2], v0[3]); w.z = pg8::cvt_pk_bf16(v1[0], v1[1]); w.w = pg8::cvt_pk_bf16(v1[2], v1[3]);
                    *(u32x4*)(rowp + bj * 128) = w; }
                if (mode == 3) { s1 += __shfl_xor(s1, 16); s1 += __shfl_xor(s1, 32); s2 += __shfl_xor(s2, 16); s2 += __shfl_xor(s2, 32);
                    if (fq == 0) { typedef float f32x2_ __attribute__((ext_vector_type(2))); *(f32x2_*)(VSTAT + ((size_t)(row0 + ai * 128 + m * 16) * 16 + (pn - 4) * 4 + wc) * 2) = (f32x2_){s1, s2}; } } }
    }
};
struct EpiProj {
    static constexpr bool PERM = true, HAS_MID = true;
    const bf16_t* G; bf16_t* O;
    __device__ __forceinline__ void mid(f32x4 (&acc)[2][2][4][2], const pg8::Unit& u, int wr, int wc, int fr, int fq) const {
        const int row0 = u.pm * 256 + wr * 64 + fr, col0 = u.pn * 256 + wc * 32 + 8 * fq;
#pragma unroll
        for (int ai = 0; ai < 2; ++ai) { u32x4 ws[4][2], wf[4][2];
#pragma unroll
            for (int m = 0; m < 4; ++m) { const bf16_t* gp = G + (size_t)(row0 + ai * 128 + m * 16) * 4096 + col0;
#pragma unroll
                for (int bj = 0; bj < 2; ++bj) { ws[m][bj] = *(const u32x4*)(gp + bj * 128); wf[m][bj] = *(const u32x4*)(gp + 2048 + bj * 128); } }
#pragma unroll
            for (int m = 0; m < 4; ++m)
#pragma unroll
                for (int bj = 0; bj < 2; ++bj) { float gs[8], gf[8]; unpack8(ws[m][bj], gs); unpack8(wf[m][bj], gf);
#pragma unroll
                    for (int j = 0; j < 4; ++j) { acc[ai][bj][m][0][j] *= gs[j] * __builtin_amdgcn_rcpf(gf[j]); acc[ai][bj][m][1][j] *= gs[4 + j] * __builtin_amdgcn_rcpf(gf[4 + j]); } }
            asm volatile("" ::: "memory"); }
    }
    __device__ __forceinline__ void operator()(f32x4 (&acc)[2][2][4][2], const pg8::Unit& u, int wr, int wc, int fr, int fq) const {
        const int row0 = u.pm * 256 + wr * 64 + fr, col0 = u.pn * 256 + wc * 32 + 8 * fq;
#pragma unroll
        for (int ai = 0; ai < 2; ++ai) { u32x4 wf[4][2];
#pragma unroll
            for (int m = 0; m < 4; ++m)
#pragma unroll
                for (int bj = 0; bj < 2; ++bj) wf[m][bj] = *(const u32x4*)(G + (size_t)(row0 + ai * 128 + m * 16) * 4096 + 2048 + col0 + bj * 128);
#pragma unroll
            for (int m = 0; m < 4; ++m) { const size_t r = (size_t)(row0 + ai * 128 + m * 16);
#pragma unroll
                for (int bj = 0; bj < 2; ++bj) { float gf[8]; unpack8(wf[m][bj], gf);
                    const f32x4 v0 = acc[ai][bj][m][0], v1 = acc[ai][bj][m][1];
                    u32x4 w; w.x = pg8::cvt_pk_bf16(v0[0] * gf[0], v0[1] * gf[1]); w.y = pg8::cvt_pk_bf16(v0[2] * gf[2], v0[3] * gf[3]); w.z = pg8::cvt_pk_bf16(v1[0] * gf[4], v1[1] * gf[5]); w.w = pg8::cvt_pk_bf16(v1[2] * gf[6], v1[3] * gf[7]);
                    *(u32x4*)(O + r * 2048 + col0 + bj * 128) = w; } }
            asm volatile("" ::: "memory"); }
    }
};
struct EpiOut {
    static constexpr bool PERM = false, HAS_MID = false;
    const float* X; float* O;
    __device__ __forceinline__ void mid(f32x4 (&)[2][2][4][2], const pg8::Unit&, int, int, int, int) const {}
    __device__ __forceinline__ void operator()(f32x4 (&acc)[2][2][4][2], const pg8::Unit& u, int wr, int wc, int fr, int fq) const {
        const int row0 = u.pm * 256 + wr * 64 + fr, col0 = u.pn * 256 + wc * 32 + 4 * fq;
#pragma unroll
        for (int ai = 0; ai < 2; ++ai) { f32x4 xv[4][2][2];
#pragma unroll
            for (int m = 0; m < 4; ++m) { const size_t off = (size_t)(row0 + ai * 128 + m * 16) * DM + col0;
#pragma unroll
                for (int bj = 0; bj < 2; ++bj)
#pragma unroll
                    for (int n = 0; n < 2; ++n) xv[m][bj][n] = *(const f32x4*)(X + off + bj * 128 + n * 16); }
#pragma unroll
            for (int m = 0; m < 4; ++m) { const size_t off = (size_t)(row0 + ai * 128 + m * 16) * DM + col0;
#pragma unroll
                for (int bj = 0; bj < 2; ++bj)
#pragma unroll
                    for (int n = 0; n < 2; ++n) *(f32x4*)(O + off + bj * 128 + n * 16) = xv[m][bj][n] + acc[ai][bj][m][n]; }
            asm volatile("" ::: "memory"); }
    }
};
struct EpiGateUp {
    static constexpr bool PERM = true, HAS_MID = false;
    bf16_t* ACT; const float* RSTL;
    __device__ __forceinline__ void mid(f32x4 (&)[2][2][4][2], const pg8::Unit&, int, int, int, int) const {}
    __device__ __forceinline__ void operator()(f32x4 (&acc)[2][2][4][2], const pg8::Unit& u, int wr, int wc, int fr, int fq) const {
        const int row0 = u.x0 + wr * 64 + fr, col0 = u.pn * 128 + wc * 32 + 8 * fq;
        float rrv[2][4];
#pragma unroll
        for (int ai = 0; ai < 2; ++ai)
#pragma unroll
            for (int m = 0; m < 4; ++m) rrv[ai][m] = RSTL[u.x1 + wr * 64 + fr + ai * 128 + m * 16];
#pragma unroll
        for (int ai = 0; ai < 2; ++ai)
#pragma unroll
            for (int m = 0; m < 4; ++m) { float o[8]; const float rr = rrv[ai][m];
#pragma unroll
                for (int n = 0; n < 2; ++n)
#pragma unroll
                    for (int j = 0; j < 4; ++j) { const float g = acc[ai][0][m][n][j] * rr, up = acc[ai][1][m][n][j] * rr; o[4 * n + j] = g * fast_sigmoid(g) * up; }
                u32x4 w; w.x = pg8::cvt_pk_bf16(o[0], o[1]); w.y = pg8::cvt_pk_bf16(o[2], o[3]); w.z = pg8::cvt_pk_bf16(o[4], o[5]); w.w = pg8::cvt_pk_bf16(o[6], o[7]);
                *(u32x4*)(ACT + (size_t)(row0 + ai * 128 + m * 16) * DEXP + col0) = w; }
    }
};
struct EpiDown {
    static constexpr bool PERM = true, HAS_MID = false;
    bf16_t* Y; const float* GATE;
    __device__ __forceinline__ void mid(f32x4 (&)[2][2][4][2], const pg8::Unit&, int, int, int, int) const {}
    __device__ __forceinline__ void operator()(f32x4 (&acc)[2][2][4][2], const pg8::Unit& u, int wr, int wc, int fr, int fq) const {
        const int rl0 = wr * 64 + fr, col0 = u.pn * 256 + wc * 32 + 8 * fq;
        float gtv[2][4];
#pragma unroll
        for (int ai = 0; ai < 2; ++ai)
#pragma unroll
            for (int m = 0; m < 4; ++m) gtv[ai][m] = GATE[u.x1 + rl0 + ai * 128 + m * 16];
#pragma unroll
        for (int ai = 0; ai < 2; ++ai)
#pragma unroll
            for (int m = 0; m < 4; ++m) { const int rl = rl0 + ai * 128 + m * 16; const float gt = gtv[ai][m];
#pragma unroll
                for (int bj = 0; bj < 2; ++bj) { const f32x4 v0 = acc[ai][bj][m][0] * gt, v1 = acc[ai][bj][m][1] * gt;
                    u32x4 w; w.x = pg8::cvt_pk_bf16(v0[0], v0[1]); w.y = pg8::cvt_pk_bf16(v0[2], v0[3]); w.z = pg8::cvt_pk_bf16(v1[0], v1[1]); w.w = pg8::cvt_pk_bf16(v1[2], v1[3]);
                    *(u32x4*)(Y + (size_t)(u.x0 + rl) * DM + col0 + bj * 128) = w; } }
    }
};
struct MoeOrder {
    const char* Abase; const char* Bbase; size_t Bstride; int K, nN, G, c; bool gather;
    const PG8_LAS int* ps;
    const unsigned* cnt; const int* TOK; bool xcdm;
    __device__ static int tile_of(int i, int c, int G, int nN, int nb, int& pn, bool xcdm) {
        const int S = (G / 8) / nN;
        if (!xcdm || G % 8 != 0 || S < 1) { const int L = i * G + c; pn = L % nN; return L / nN < nb ? L / nN : -1; }
        const int x = c % 8, slot = c / 8; pn = slot % nN;
        if (slot >= S * nN) return -1;
        const int sidx = i * (8 * S) + x * S + slot / nN; return sidx < nb ? sidx : -1;
    }
    __device__ bool next(int i, pg8::Unit& u) const {
        int pn; const int sidx = tile_of(i, c, G, nN, ps[NEXP + 2], pn, xcdm); if (sidx < 0) return false;
        const int prow = ps[40 + sidx], info = ps[40 + MT_MAX + sidx], valid = ps[40 + 2 * MT_MAX + sidx];
        const int e = info >> 16, mt = info & 0xffff;
        u.pm = mt; u.pn = pn; u.x0 = prow; u.x1 = e * T + mt * MTILE; u.x2 = valid; u.x3 = e;
        u.A = gather ? Abase : Abase + (size_t)prow * K * 2; u.B = Bbase + (size_t)e * Bstride + (size_t)pn * 256 * K * 2; return true;
    }
    __device__ __forceinline__ void rows(const pg8::Unit& u, unsigned (&g)[2][2], const int (&RA)[2]) const {
#pragma unroll
        for (int h = 0; h < 2; ++h)
#pragma unroll
            for (int i = 0; i < 2; ++i) { int r = RA[i] + 128 * h; r = r < u.x2 ? r : u.x2 - 1; g[h][i] = (unsigned)TOK[u.x1 + r] * (unsigned)(K * 2); }
    }
};

struct TItem { const float* src; bf16_t* dst; int ld_src, ld_dst; };
__device__ __forceinline__ void titem_load(const TItem& t, f32x4 (&v)[8], int lane) {
#pragma unroll
    for (int i = 0; i < 8; ++i) v[i] = *(const f32x4*)(t.src + (size_t)((lane >> 3) + 8 * i) * t.ld_src + 4 * (lane & 7));
}
__device__ __forceinline__ void titem_store(const TItem& t, const f32x4 (&v)[8], PG8_LAS float* scr, int lane) {
#pragma unroll
    for (int i = 0; i < 8; ++i) { PG8_LAS float* d = scr + ((lane >> 3) + 8 * i) * 33 + 4 * (lane & 7); d[0] = v[i].x; d[1] = v[i].y; d[2] = v[i].z; d[3] = v[i].w; }
    asm volatile("s_waitcnt lgkmcnt(0)" ::: "memory");
    const int c = lane & 7;
#pragma unroll
    for (int j = 0; j < 4; ++j) { const int n = (lane >> 3) + 8 * j; const PG8_LAS float* s = scr + (8 * c) * 33 + n;
        u32x4 o; o.x = cvtpk_rne(s[0 * 33], s[1 * 33]); o.y = cvtpk_rne(s[2 * 33], s[3 * 33]); o.z = cvtpk_rne(s[4 * 33], s[5 * 33]); o.w = cvtpk_rne(s[6 * 33], s[7 * 33]);
        *(u32x4*)(t.dst + (size_t)n * t.ld_dst + 8 * c) = o; }
    asm volatile("s_waitcnt lgkmcnt(0)" ::: "memory");
}
constexpr int TI0 = 32 * 288, TI1 = 16 * 64, TI2 = 16 * 64, TI3 = 32 * 64, TI4 = 32 * 512, TI5 = 32 * 512, TI6 = 32 * 512;
constexpr int TI_ALL = TI0 + TI1 + TI2 + TI3 + TI4 + TI5 + TI6;
#ifndef HELPER_SKIP_ITEMS
#define HELPER_SKIP_ITEMS 0
#endif
#ifndef TAIL1_ITEMS
#define TAIL1_ITEMS (TI5)
#endif
__device__ __forceinline__ TItem titem_decode(const Args& A, int r) {
    bf16_t* WIN = (bf16_t*)(A.ws + WS_WIN); bf16_t* WPROJ = (bf16_t*)(A.ws + WS_WPROJ); bf16_t* WOUT = (bf16_t*)(A.ws + WS_WOUT); bf16_t* WGU = (bf16_t*)(A.ws + WS_WGU); bf16_t* WD = (bf16_t*)(A.ws + WS_WD);
    TItem t;
    if (r < TI0) { const int kb = r / 288, nb = r % 288; t.src = A.in[2] + (size_t)(64 * kb) * INCOLS + 32 * nb + (nb >= 160 ? 8 : 0); t.ld_src = INCOLS; t.dst = WIN + (size_t)(32 * nb) * 2048 + 64 * kb; t.ld_dst = 2048; return t; } r -= TI0;
    if (r < TI1) { const int kb = r / 64, nb = r % 64; t.src = A.in[11] + (size_t)(64 * kb) * DM + 32 * nb; t.ld_src = DM; t.dst = WPROJ + (size_t)(32 * nb) * 2048 + 64 * kb; t.ld_dst = 2048; return t; } r -= TI1;
    if (r < TI2) { const int kb = r / 64, nb = r % 64; t.src = A.in[12] + (size_t)(64 * kb) * DM + 32 * nb; t.ld_src = DM; t.dst = WPROJ + (size_t)(32 * nb) * 2048 + 1024 + 64 * kb; t.ld_dst = 2048; return t; } r -= TI2;
    if (r < TI3) { const int kb = r / 64, nb = r % 64; t.src = A.in[13] + (size_t)(64 * kb) * DM + 32 * nb; t.ld_src = DM; t.dst = WOUT + (size_t)(32 * nb) * 2048 + 64 * kb; t.ld_dst = 2048; return t; } r -= TI3;
    if (r < TI4 + TI5) { const int up = r >= TI4; if (up) r -= TI4; const int e = r / 512, q = r % 512, kb = q / 16, nb = q % 16, n = 32 * nb, drow = 256 * (n >> 7) + (n & 127) + (up ? 128 : 0);
        t.src = A.in[up ? 20 : 19] + (size_t)e * DM * DEXP + (size_t)(64 * kb) * DEXP + n; t.ld_src = DEXP; t.dst = WGU + ((size_t)e * 1024 + drow) * 2048 + 64 * kb; t.ld_dst = 2048; return t; } r -= TI4 + TI5;
    { const int e = r / 512, q = r % 512, kb = q / 64, nb = q % 64; t.src = A.in[21] + (size_t)e * DEXP * DM + (size_t)(64 * kb) * DM + 32 * nb; t.ld_src = DM; t.dst = WD + ((size_t)e * 2048 + 32 * nb) * 512 + 64 * kb; t.ld_dst = 512; return t; }
}
__device__ __forceinline__ void p0_weights(const Args& A, PG8_LAS unsigned char* lds, const int part, const int wrank, const int wcount) {
    const int tid = threadIdx.x, lane = tid & 63, wave = tid >> 6;
    PG8_LAS float* scr = (PG8_LAS float*)(lds + wave * 16384);
    if (wrank < 0 || wcount < 1) return;
    const int gw = wrank * NWAVES + wave, NGW = wcount * NWAVES;
    const int cut1 = TI0 + HELPER_SKIP_ITEMS;
    const int it_lo = part == 0 ? 0 : cut1, it_hi = part == 0 ? cut1 : TI_ALL;
    int it = it_lo + gw; if (it >= it_hi) return;
    TItem t0, t1, t2, t3; f32x4 v0[8], v1[8], v2[8], v3[8];
    t0 = titem_decode(A, it); titem_load(t0, v0, lane);
    t1 = t0; t2 = t0; t3 = t0;
    if (it + NGW < it_hi) { t1 = titem_decode(A, it + NGW); titem_load(t1, v1, lane); }
    if (it + 2 * NGW < it_hi) { t2 = titem_decode(A, it + 2 * NGW); titem_load(t2, v2, lane); }
    for (;;) {
        if (it + 3 * NGW < it_hi) { t3 = titem_decode(A, it + 3 * NGW); titem_load(t3, v3, lane); }
        titem_store(t0, v0, scr, lane); it += NGW; if (it >= it_hi) break;
        if (it + 3 * NGW < it_hi) { t0 = titem_decode(A, it + 3 * NGW); titem_load(t0, v0, lane); }
        titem_store(t1, v1, scr, lane); it += NGW; if (it >= it_hi) break;
        if (it + 3 * NGW < it_hi) { t1 = titem_decode(A, it + 3 * NGW); titem_load(t1, v1, lane); }
        titem_store(t2, v2, scr, lane); it += NGW; if (it >= it_hi) break;
        if (it + 3 * NGW < it_hi) { t2 = titem_decode(A, it + 3 * NGW); titem_load(t2, v2, lane); }
        titem_store(t3, v3, scr, lane); it += NGW; if (it >= it_hi) break;
    }
}

__device__ __forceinline__ void p1_fast(const Args& A, PG8_LAS unsigned char* lds) {
    const int G_ = (int)gridDim.x, c_ = (int)blockIdx.x; const bool split = HELPERS && (G_ % 32 == 0); const int slot_ = c_ >> 3;
    if (split && (slot_ & 3) == 3) { p0_weights(A, lds, 1, (slot_ >> 2) * 8 + (c_ & 7), G_ / 4); return; }
    pg8::DenseOrder S; S.init(A.ws + WS_H, A.ws + WS_WIN, T, 9216, DM, split ? G_ / 4 * 3 : G_, split ? (slot_ - (slot_ >> 2)) * 8 + (c_ & 7) : c_, PROBE_REP_P1);
    EpiIn E{(bf16_t*)(A.ws + WS_U), (bf16_t*)(A.ws + WS_V), (bf16_t*)(A.ws + WS_Q), (bf16_t*)(A.ws + WS_K), (bf16_t*)(A.ws + WS_VA), (bf16_t*)(A.ws + WS_G), A.in[3], A.in[9], A.in[10], (float*)(A.ws + WS_VSTAT), lds};
    pg8::gemm_phase<EpiIn, pg8::DenseOrder, true, false>(lds, DM, S, E);
}
__device__ __forceinline__ void p3_fast(const Args& A, PG8_LAS unsigned char* lds) {
    pg8::DenseOrder S; S.init(A.ws + WS_MIXIN, A.ws + WS_WPROJ, T, DM, 2048, gridDim.x, blockIdx.x, PROBE_REP_P4);
    EpiProj E{(const bf16_t*)(A.ws + WS_G), (bf16_t*)(A.ws + WS_MIXED)};
    pg8::gemm_phase<EpiProj, pg8::DenseOrder, true, false>(lds, 2048, S, E);
}
__device__ __forceinline__ void p4_fast(const Args& A, PG8_LAS unsigned char* lds) {
    pg8::DenseOrder S; S.init(A.ws + WS_MIXED, A.ws + WS_WOUT, T, DM, DM, gridDim.x, blockIdx.x, PROBE_REP_P5);
    EpiOut E{A.in[0], A.out};
    pg8::gemm_phase<EpiOut, pg8::DenseOrder, true, false>(lds, DM, S, E);
}
__device__ __forceinline__ void moe_layout_lds(const Args& A, PG8_LAS unsigned char* lds) {
    PG8_LAS int* ps = (PG8_LAS int*)(lds + LDS_MISC_OFF); PG8_LAS int* tprow = ps + 40; PG8_LAS int* tinfo = tprow + MT_MAX; PG8_LAS int* tvalid = tinfo + MT_MAX;
    const unsigned* cnt = (const unsigned*)(A.ws + WS_CTL) + CW_CNT;
    if (threadIdx.x == 0) { int acc = 0;
        for (int e = 0; e < NEXP; ++e) { ps[e] = acc; acc += ((int)cnt[(e) * CNT_STRIDE] + MTILE - 1) / MTILE * MTILE; }
        ps[NEXP] = acc; ps[NEXP + 1] = acc / MTILE; }
    __syncthreads();
    const int nt = ps[NEXP + 1]; PG8_LAS int* uval = tvalid + MT_MAX;
    int prow = 0, e = 0, mt = 0, valid = 0;
    if ((int)threadIdx.x < nt) { prow = (int)threadIdx.x * MTILE;
        for (int j = 1; j < NEXP; ++j) if (ps[j] <= prow) e = j;
        mt = (prow - ps[e]) / MTILE; valid = (int)cnt[(e) * CNT_STRIDE] - mt * MTILE; valid = valid > MTILE ? MTILE : valid; uval[threadIdx.x] = valid; }
    __syncthreads();
    if ((int)threadIdx.x < nt) { int rank = 0;
        if (TINY_ROWS > 0) { for (int j = 0; j < nt; ++j) { const int vj = uval[j]; rank += (vj > valid || (vj == valid && j < (int)threadIdx.x)) ? 1 : 0; } } else rank = (int)threadIdx.x;
        tprow[rank] = prow; tinfo[rank] = (e << 16) | mt; tvalid[rank] = valid; }
    if (threadIdx.x == 0) { int nb = 0; for (int j = 0; j < nt; ++j) nb += uval[j] > TINY_ROWS ? 1 : 0; ps[NEXP + 2] = nb; }
    __syncthreads();
}
namespace sm {
typedef short bf16x8 __attribute__((ext_vector_type(8))); typedef float f32x16 __attribute__((ext_vector_type(16)));
constexpr int TINY = 64;
__device__ __forceinline__ void gateup_small(const Args& A, PG8_LAS unsigned char* lds) {
    const PG8_LAS int* ps = (const PG8_LAS int*)(lds + LDS_MISC_OFF); const int nt = ps[NEXP + 1], nbig = ps[NEXP + 2];
    const bf16_t* H2 = (const bf16_t*)(A.ws + WS_H2); const bf16_t* WGU = (const bf16_t*)(A.ws + WS_WGU); bf16_t* ACT = (bf16_t*)(A.ws + WS_ACT); const int* TOK = (const int*)(A.ws + WS_TOK);
    const int tid = threadIdx.x, lane = tid & 63, w = __builtin_amdgcn_readfirstlane(tid >> 6), r32 = lane & 31, hi = lane >> 5;
    PG8_LAS float* red = (PG8_LAS float*)lds;
    for (int su = blockIdx.x; su < (nt - nbig) * 16; su += gridDim.x) {
        const int sidx = nbig + (su >> 4), sl = su & 15; const int prow = ps[40 + sidx], info = ps[40 + MT_MAX + sidx], valid = ps[40 + 2 * MT_MAX + sidx];
        const int e = info >> 16, mt = info & 0xffff, lbase = e * T + mt * MTILE;
        const int ra = r32 < valid ? r32 : valid - 1, rb = 32 + r32 < valid ? 32 + r32 : valid - 1;
        const bf16_t* a0p = H2 + (size_t)TOK[lbase + ra] * DM + 256 * w + 8 * hi; const bf16_t* a1p = H2 + (size_t)TOK[lbase + rb] * DM + 256 * w + 8 * hi;
        const bf16_t* b0p = WGU + ((size_t)e * 1024 + 256 * (sl >> 2) + 32 * (sl & 3) + r32) * DM + 256 * w + 8 * hi; const bf16_t* b1p = b0p + (size_t)128 * DM;
        f32x16 acc[2][2];
#pragma unroll
        for (int i = 0; i < 2; ++i)
#pragma unroll
            for (int j = 0; j < 2; ++j)
#pragma unroll
                for (int r = 0; r < 16; ++r) acc[i][j][r] = 0.f;
#pragma unroll 4
        for (int ks = 0; ks < 16; ++ks) { const bf16x8 a0 = *(const bf16x8*)(a0p + 16 * ks), a1 = *(const bf16x8*)(a1p + 16 * ks), b0 = *(const bf16x8*)(b0p + 16 * ks), b1 = *(const bf16x8*)(b1p + 16 * ks);
            acc[0][0] = __builtin_amdgcn_mfma_f32_32x32x16_bf16(a0, b0, acc[0][0], 0, 0, 0); acc[0][1] = __builtin_amdgcn_mfma_f32_32x32x16_bf16(a0, b1, acc[0][1], 0, 0, 0);
            acc[1][0] = __builtin_amdgcn_mfma_f32_32x32x16_bf16(a1, b0, acc[1][0], 0, 0, 0); acc[1][1] = __builtin_amdgcn_mfma_f32_32x32x16_bf16(a1, b1, acc[1][1], 0, 0, 0); }
#pragma unroll
        for (int i = 0; i < 2; ++i)
#pragma unroll
            for (int j = 0; j < 2; ++j)
#pragma unroll
                for (int r = 0; r < 16; ++r) red[(((w * 2 + i) * 2 + j) * 16 + r) * 64 + lane] = acc[i][j][r];
        __syncthreads();
#pragma unroll
        for (int i = 0; i < 2; ++i)
#pragma unroll
            for (int rr = 0; rr < 2; ++rr) { const int r = 2 * w + rr; float g = 0.f, u = 0.f;
#pragma unroll
                for (int w2 = 0; w2 < 8; ++w2) { g += red[(((w2 * 2 + i) * 2 + 0) * 16 + r) * 64 + lane]; u += red[(((w2 * 2 + i) * 2 + 1) * 16 + r) * 64 + lane]; }
                const int row = 32 * i + (r & 3) + 8 * (r >> 2) + 4 * hi; const float rr2 = ((const float*)(A.ws + WS_RSTL))[lbase + (row < valid ? row : valid - 1)]; g *= rr2; u *= rr2;
                ACT[(size_t)(prow + row) * DEXP + 32 * sl + r32] = f2bf(g * fast_sigmoid(g) * u); }
        __syncthreads();
    }
}
__device__ __forceinline__ void down_small(const Args& A, PG8_LAS unsigned char* lds) {
    const PG8_LAS int* ps = (const PG8_LAS int*)(lds + LDS_MISC_OFF); const int nt = ps[NEXP + 1], nbig = ps[NEXP + 2];
    const bf16_t* ACT = (const bf16_t*)(A.ws + WS_ACT); const bf16_t* WD = (const bf16_t*)(A.ws + WS_WD); bf16_t* Y = (bf16_t*)(A.ws + WS_YBUF); const float* GATE = (const float*)(A.ws + WS_GATE);
    const int tid = threadIdx.x, lane = tid & 63, w = __builtin_amdgcn_readfirstlane(tid >> 6), wn = w & 3, wk = w >> 2, r32 = lane & 31, hi = lane >> 5;
    PG8_LAS float* red = (PG8_LAS float*)lds;
    for (int su = blockIdx.x; su < (nt - nbig) * 16; su += gridDim.x) {
        const int sidx = nbig + (su >> 4), sl = su & 15; const int prow = ps[40 + sidx], info = ps[40 + MT_MAX + sidx], valid = ps[40 + 2 * MT_MAX + sidx];
        const int e = info >> 16, mt = info & 0xffff, lbase = e * T + mt * MTILE;
        const int ra = r32 < valid ? r32 : valid - 1, rb = 32 + r32 < valid ? 32 + r32 : valid - 1;
        const bf16_t* a0p = ACT + (size_t)(prow + ra) * DEXP + 256 * wk + 8 * hi; const bf16_t* a1p = ACT + (size_t)(prow + rb) * DEXP + 256 * wk + 8 * hi;
        const bf16_t* bp = WD + ((size_t)e * 2048 + 128 * sl + 32 * wn + r32) * DEXP + 256 * wk + 8 * hi;
        f32x16 acc[2];
#pragma unroll
        for (int i = 0; i < 2; ++i)
#pragma unroll
            for (int r = 0; r < 16; ++r) acc[i][r] = 0.f;
#pragma unroll 4
        for (int ks = 0; ks < 16; ++ks) { const bf16x8 a0 = *(const bf16x8*)(a0p + 16 * ks), a1 = *(const bf16x8*)(a1p + 16 * ks), b = *(const bf16x8*)(bp + 16 * ks);
            acc[0] = __builtin_amdgcn_mfma_f32_32x32x16_bf16(a0, b, acc[0], 0, 0, 0); acc[1] = __builtin_amdgcn_mfma_f32_32x32x16_bf16(a1, b, acc[1], 0, 0, 0); }
        if (wk == 1) {
#pragma unroll
            for (int i = 0; i < 2; ++i)
#pragma unroll
                for (int r = 0; r < 16; ++r) red[((wn * 2 + i) * 16 + r) * 64 + lane] = acc[i][r]; }
        __syncthreads();
        if (wk == 0) {
#pragma unroll
            for (int i = 0; i < 2; ++i)
#pragma unroll
                for (int r = 0; r < 16; ++r) { const int row = 32 * i + (r & 3) + 8 * (r >> 2) + 4 * hi; const float gt = GATE[lbase + (row < valid ? row : valid - 1)];
                    Y[(size_t)(prow + row) * DM + 128 * sl + 32 * wn + r32] = f2bf((acc[i][r] + red[((wn * 2 + i) * 16 + r) * 64 + lane]) * gt); } }
        __syncthreads();
    }
}
}

__device__ __forceinline__ void p6_fast(const Args& A, PG8_LAS unsigned char* lds) {
    moe_layout_lds(A, lds);
    MoeOrder S{(const char*)(A.ws + WS_H2), (const char*)(A.ws + WS_WGU), (size_t)1024 * 2048 * 2, DM, 4, (int)gridDim.x, (int)blockIdx.x, true,
               (const PG8_LAS int*)(lds + LDS_MISC_OFF), (const unsigned*)(A.ws + WS_CTL) + CW_CNT, (const int*)(A.ws + WS_TOK), XCDM_GU};
    EpiGateUp E{(bf16_t*)(A.ws + WS_ACT), (const float*)(A.ws + WS_RSTL)};
    pg8::gemm_phase<EpiGateUp, MoeOrder, true, true>(lds, DM, S, E);
    sm::gateup_small(A, lds);

}
__device__ __forceinline__ void p7_fast(const Args& A, PG8_LAS unsigned char* lds) {
    moe_layout_lds(A, lds);
    MoeOrder S{(const char*)(A.ws + WS_ACT), (const char*)(A.ws + WS_WD), (size_t)2048 * 512 * 2, DEXP, 8, (int)gridDim.x, (int)blockIdx.x, false,
               (const PG8_LAS int*)(lds + LDS_MISC_OFF), (const unsigned*)(A.ws + WS_CTL) + CW_CNT, (const int*)(A.ws + WS_TOK), true};
    EpiDown E{(bf16_t*)(A.ws + WS_YBUF), (const float*)(A.ws + WS_GATE)};
    pg8::gemm_phase<EpiDown, MoeOrder, true, false>(lds, DEXP, S, E);
    sm::down_small(A, lds);
}

namespace fa {
typedef short bf16x8 __attribute__((ext_vector_type(8)));
typedef short v4i16 __attribute__((ext_vector_type(4)));
typedef float f32x16 __attribute__((ext_vector_type(16)));
#define FA_LAS __attribute__((address_space(3)))
constexpr int KVBUF = 65536, LDS_CK = 131072, LDS_ML = 131072 + 8192;
__device__ __forceinline__ unsigned cvtpk(float lo, float hi) { unsigned r; asm("v_cvt_pk_bf16_f32 %0, %1, %2" : "=v"(r) : "v"(lo), "v"(hi)); return r; }
__device__ __forceinline__ bf16x8 pack8(const f32x16& p, int b) { u32x4 w; w.x = cvtpk(p[b], p[b + 1]); w.y = cvtpk(p[b + 2], p[b + 3]); w.z = cvtpk(p[b + 4], p[b + 5]); w.w = cvtpk(p[b + 6], p[b + 7]); return __builtin_bit_cast(bf16x8, w); }
__device__ __forceinline__ float swapmax(float v) { auto rr = __builtin_amdgcn_permlane32_swap(__float_as_uint(v), __float_as_uint(v), false, false); return fmaxf(__uint_as_float(rr[0]), __uint_as_float(rr[1])); }
__device__ __forceinline__ float swapsum(float v) { auto rr = __builtin_amdgcn_permlane32_swap(__float_as_uint(v), __float_as_uint(v), false, false); return __uint_as_float(rr[0]) + __uint_as_float(rr[1]); }
#define FA_WAITBAR() do { asm volatile("s_waitcnt vmcnt(0) lgkmcnt(0)" ::: "memory"); __builtin_amdgcn_s_barrier(); asm volatile("" ::: "memory"); } while (0)

__device__ __forceinline__ void attn_phase(const Args& A, FA_LAS unsigned char* lds) {
    const bf16_t* Q = (const bf16_t*)(A.ws + WS_Q); const bf16_t* Kt = (const bf16_t*)(A.ws + WS_K); const bf16_t* Vt = (const bf16_t*)(A.ws + WS_VA);
    const float* CKL = (const float*)(A.ws + WS_CKL); bf16_t* MIXIN = (bf16_t*)(A.ws + WS_MIXIN);
    const int tid = threadIdx.x, lane = tid & 63, wid = __builtin_amdgcn_readfirstlane(tid >> 6), rg = wid & 3, kh = wid >> 2, r32 = lane & 31, hi = lane >> 5;
    int koff[4];
#pragma unroll
    for (int i = 0; i < 4; ++i) { const int rl = 4 * i + (lane >> 4); koff[i] = rl * 1024 + (((lane & 15) ^ rl) * 8); }
    const int voff = (lane >> 4) * 1024 + (((lane & 15) ^ ((lane >> 4) << 2)) * 8);
    int kfo[8];
#pragma unroll
    for (int d0 = 0; d0 < 8; ++d0) kfo[d0] = (kh * 64 + r32) * 256 + (((2 * d0 + hi) ^ (r32 & 15)) * 16);
    int vfo[4];
    { const int dh = (lane >> 4) & 1, q = (lane & 15) >> 2, p = lane & 3;
#pragma unroll
      for (int db = 0; db < 4; ++db) vfo[db] = (kh * 64 + 4 * hi + q) * 256 + ((db ^ q) * 64) + dh * 32 + p * 8; }
    const unsigned ldsb = (unsigned)(uintptr_t)lds;
    const int G = gridDim.x;
    for (int vb0 = blockIdx.x; vb0 < 256 * PROBE_REP_ATTN; vb0 += G) { const int vb = vb0 % 256;
        const int item = (G % 8 == 0) ? ((vb % 8) * 32 + (vb / 8)) % 256 : vb;
        const int bh = item >> 3, ii = item & 7, b = bh >> 3, h = bh & 7;
        const bf16_t* Kg = Kt + (size_t)b * SEQ * 1024 + h * 128; const bf16_t* Vg = Vt + (size_t)b * SEQ * 1024 + h * 128;
        { const f32x4 c = *(const f32x4*)(CKL + (size_t)bh * SEQ + tid * 4); *(FA_LAS f32x4*)(lds + LDS_CK + tid * 16) = (f32x4){-c.x, -c.y, -c.z, -c.w}; }
#define FA_ISSUE_K(key0, kb_) do { const bf16_t* kg_ = Kg + (size_t)((key0) + 16 * wid) * 1024; \
        _Pragma("unroll") for (int i_ = 0; i_ < 4; ++i_) __builtin_amdgcn_global_load_lds((const unsigned*)(kg_ + koff[i_]), (FA_LAS unsigned*)(lds + (kb_) * 32768 + (wid * 4 + i_) * 1024), 16, 0, 0); } while (0)
#define FA_ISSUE_V(key0, vb_) do { const bf16_t* vg_ = Vg + (size_t)((key0) + 16 * wid) * 1024; \
        _Pragma("unroll") for (int i_ = 0; i_ < 4; ++i_) __builtin_amdgcn_global_load_lds((const unsigned*)(vg_ + i_ * 4096 + voff), (FA_LAS unsigned*)(lds + 65536 + (vb_) * 32768 + (wid * 4 + i_) * 1024), 16, 0, 0); } while (0)
#define FA_DSR128(dst, addr, off) asm volatile("ds_read_b128 %0, %1 offset:%2" : "=v"(dst) : "v"(addr), "n"(off))
#define FA_DSTR(dst, addr, off) asm volatile("ds_read_b64_tr_b16 %0, %1 offset:%2" : "=v"(dst) : "v"(addr), "n"(off))
#define FA_LGKM(n) asm volatile("s_waitcnt lgkmcnt(" #n ")" ::: "memory")
#define FA_SB() __builtin_amdgcn_sched_barrier(0)
#define FA_QK_STEP(i, P0, P1, W) do { FA_LGKM(W); FA_SB(); \
        if (((i) & 1) == 0) P0 = __builtin_amdgcn_mfma_f32_32x32x16_bf16(kr[(i) & 3], qf[(i) >> 1], P0, 0, 0, 0); else P1 = __builtin_amdgcn_mfma_f32_32x32x16_bf16(kr[(i) & 3], qf[(i) >> 1], P1, 0, 0, 0); \
        FA_SB(); if ((i) + 4 < 16) FA_DSR128(kr[(i) & 3], ka_[((i) + 4) >> 1], (((i) + 4) & 1) * 8192); } while (0)
#define FA_QK(P0, P1, kbuf, kbk) do { FA_LAS const float* nck = (FA_LAS const float*)(lds + LDS_CK) + (kbk) * 128 + kh * 64 + 4 * hi; \
        _Pragma("unroll") for (int g_ = 0; g_ < 4; ++g_) { const f32x4 t0 = *(FA_LAS const f32x4*)(nck + 8 * g_), t1 = *(FA_LAS const f32x4*)(nck + 32 + 8 * g_); \
            _Pragma("unroll") for (int j_ = 0; j_ < 4; ++j_) { P0[4 * g_ + j_] = t0[j_]; P1[4 * g_ + j_] = t1[j_]; } } \
        unsigned ka_[8]; _Pragma("unroll") for (int d0 = 0; d0 < 8; ++d0) ka_[d0] = ldsb + (unsigned)((kbuf) * 32768 + kfo[d0]); \
        bf16x8 kr[4]; FA_SB(); FA_DSR128(kr[0], ka_[0], 0); FA_DSR128(kr[1], ka_[0], 8192); FA_DSR128(kr[2], ka_[1], 0); FA_DSR128(kr[3], ka_[1], 8192); \
        FA_QK_STEP(0, P0, P1, 3); FA_QK_STEP(1, P0, P1, 3); FA_QK_STEP(2, P0, P1, 3); FA_QK_STEP(3, P0, P1, 3); FA_QK_STEP(4, P0, P1, 3); FA_QK_STEP(5, P0, P1, 3); FA_QK_STEP(6, P0, P1, 3); FA_QK_STEP(7, P0, P1, 3); \
        FA_QK_STEP(8, P0, P1, 3); FA_QK_STEP(9, P0, P1, 3); FA_QK_STEP(10, P0, P1, 3); FA_QK_STEP(11, P0, P1, 3); FA_QK_STEP(12, P0, P1, 3); FA_QK_STEP(13, P0, P1, 2); FA_QK_STEP(14, P0, P1, 1); FA_QK_STEP(15, P0, P1, 0); } while (0)
#define FA_PV_STEP(i, W) do { FA_LGKM(W); FA_SB(); \
        { const bf16x8 vf_ = (bf16x8){vl[(i) & 1][0], vl[(i) & 1][1], vl[(i) & 1][2], vl[(i) & 1][3], vh[(i) & 1][0], vh[(i) & 1][1], vh[(i) & 1][2], vh[(i) & 1][3]}; \
          o[(i) >> 2] = __builtin_amdgcn_mfma_f32_32x32x16_bf16(vf_, pf[(i) & 3], o[(i) >> 2], 0, 0, 0); } \
        FA_SB(); if ((i) + 2 < 16) { FA_DSTR(vl[(i) & 1], va_[((i) + 2) >> 2], (((i) + 2) & 3) * 4096); FA_DSTR(vh[(i) & 1], va_[((i) + 2) >> 2], (((i) + 2) & 3) * 4096 + 2048); } } while (0)
        const int qbL = 15 - ii, nsteps = 17;
#define FA_KB(s_) ((s_) <= qbL ? (s_) : ii - ((s_) - qbL - 1))
        int u = 0, qb = qbL, kb = 0, g = 0;
        FA_ISSUE_K(0, 0); FA_ISSUE_V(0, 0); FA_ISSUE_K(FA_KB(1) * 128, 1);
        bf16x8 qf[8]; f32x16 o[4]; float m = -1e30f, l = 0.f;
        { const bf16_t* qp = Q + (size_t)(b * SEQ + qb * 128 + rg * 32 + r32) * 1024 + h * 128 + 8 * hi;
#pragma unroll
          for (int d0 = 0; d0 < 8; ++d0) qf[d0] = *(const bf16x8*)(qp + 16 * d0); }
#pragma unroll
        for (int db = 0; db < 4; ++db)
#pragma unroll
            for (int r = 0; r < 16; ++r) o[db][r] = 0.f;
        FA_WAITBAR();
        f32x16 p0, p1, n0, n1;
        FA_QK(p0, p1, 0, 0);
        FA_WAITBAR();
        bool diag = false, lastb = false, done = false;
#define FA_SOFTPV(C0, C1) do { \
            if (diag) { const int qrel = rg * 32 + r32, k0 = kh * 64 + 4 * hi; \
                _Pragma("unroll") for (int r = 0; r < 16; ++r) { const int kr = k0 + (r & 3) + 8 * (r >> 2); if (kr > qrel) C0[r] = -INFINITY; if (kr + 32 > qrel) C1[r] = -INFINITY; } } \
            float mx = fmaxf(C0[0], C1[0]); \
            _Pragma("unroll") for (int r = 1; r < 16; ++r) mx = fmaxf(mx, fmaxf(C0[r], C1[r])); \
            mx = swapmax(mx); \
            const float mn = fmaxf(m, mx), alpha = __builtin_amdgcn_exp2f(m - mn); m = mn; \
            float ps = 0.f; \
            _Pragma("unroll") for (int r = 0; r < 16; ++r) { C0[r] = __builtin_amdgcn_exp2f(C0[r] - mn); C1[r] = __builtin_amdgcn_exp2f(C1[r] - mn); ps += C0[r] + C1[r]; } \
            l = l * alpha + ps; \
            if (!__all(alpha == 1.0f)) { \
                _Pragma("unroll") for (int db = 0; db < 4; ++db) _Pragma("unroll") for (int r = 0; r < 16; ++r) o[db][r] *= alpha; } \
            bf16x8 pf[4]; pf[0] = pack8(C0, 0); pf[1] = pack8(C0, 8); pf[2] = pack8(C1, 0); pf[3] = pack8(C1, 8); \
            { unsigned va_[4]; \
              _Pragma("unroll") for (int db = 0; db < 4; ++db) va_[db] = ldsb + (unsigned)(65536 + (g & 1) * 32768 + vfo[db]); \
              v4i16 vl[2], vh[2]; FA_SB(); FA_DSTR(vl[0], va_[0], 0); FA_DSTR(vh[0], va_[0], 2048); FA_DSTR(vl[1], va_[0], 4096); FA_DSTR(vh[1], va_[0], 4096 + 2048); \
              FA_PV_STEP(0, 2); FA_PV_STEP(1, 2); FA_PV_STEP(2, 2); FA_PV_STEP(3, 2); FA_PV_STEP(4, 2); FA_PV_STEP(5, 2); FA_PV_STEP(6, 2); FA_PV_STEP(7, 2); \
              FA_PV_STEP(8, 2); FA_PV_STEP(9, 2); FA_PV_STEP(10, 2); FA_PV_STEP(11, 2); FA_PV_STEP(12, 2); FA_PV_STEP(13, 2); FA_PV_STEP(14, 2); FA_PV_STEP(15, 0); } } while (0)
#define FA_STEP(C0, C1, N0, N1) do { \
            diag = (kb == qb); lastb = (u == 0 ? kb == qb : kb == 0); \
            if (g + 2 < nsteps) FA_ISSUE_K(FA_KB(g + 2) * 128, g & 1); \
            if (g + 1 < nsteps) FA_ISSUE_V(FA_KB(g + 1) * 128, (g + 1) & 1); \
            const int kbn_ = (u == 0 ? kb + 1 : kb - 1); \
            if (kh == 0 && !lastb) FA_QK(N0, N1, (g + 1) & 1, kbn_); \
            FA_SOFTPV(C0, C1); \
            if (kh == 1 && !lastb) FA_QK(N0, N1, (g + 1) & 1, kbn_); \
            FA_WAITBAR(); } while (0)
#define FA_UNIT_END() do { \
            FA_LAS float* mb = (FA_LAS float*)(lds + 65536 + (g & 1) * 32768) + rg * 2048; FA_LAS float* ml = (FA_LAS float*)(lds + LDS_ML) + rg * 128; \
            const float lt = swapsum(l); \
            if (kh == 1) { ml[lane] = m; ml[64 + lane] = lt; } \
            float s1 = 0.f, s2m = 0.f; \
            _Pragma("unroll") for (int half = 0; half < 2; ++half) { \
                if (kh == 1) { \
                    _Pragma("unroll") for (int d2 = 0; d2 < 2; ++d2) _Pragma("unroll") for (int r = 0; r < 16; ++r) mb[(d2 * 16 + r) * 64 + lane] = o[2 * half + d2][r]; } \
                FA_WAITBAR(); \
                if (kh == 0) { \
                    if (half == 0) { const float m2 = ml[lane], l2 = ml[64 + lane], mm = fmaxf(m, m2), a1 = __builtin_amdgcn_exp2f(m - mm), a2 = __builtin_amdgcn_exp2f(m2 - mm); \
                        const float inv = 1.0f / (lt * a1 + l2 * a2); s1 = a1 * inv; s2m = a2 * inv; } \
                    bf16_t* op = MIXIN + (size_t)(b * SEQ + qb * 128 + rg * 32 + r32) * 2048 + 1024 + h * 128 + 4 * hi; \
                    _Pragma("unroll") for (int d2 = 0; d2 < 2; ++d2) _Pragma("unroll") for (int g4 = 0; g4 < 4; ++g4) { float v[4]; \
                        _Pragma("unroll") for (int j = 0; j < 4; ++j) v[j] = o[2 * half + d2][4 * g4 + j] * s1 + mb[(d2 * 16 + 4 * g4 + j) * 64 + lane] * s2m; \
                        u32x2 w; w.x = cvtpk(v[0], v[1]); w.y = cvtpk(v[2], v[3]); *(u32x2*)(op + 32 * (2 * half + d2) + 8 * g4) = w; } } \
                FA_WAITBAR(); } \
            if (u == 1) { done = true; } else { \
                u = 1; qb = ii; kb = ii; ++g; \
                { const bf16_t* qp = Q + (size_t)(b * SEQ + qb * 128 + rg * 32 + r32) * 1024 + h * 128 + 8 * hi; \
                  _Pragma("unroll") for (int d0 = 0; d0 < 8; ++d0) qf[d0] = *(const bf16x8*)(qp + 16 * d0); } \
                _Pragma("unroll") for (int db = 0; db < 4; ++db) _Pragma("unroll") for (int r = 0; r < 16; ++r) o[db][r] = 0.f; \
                m = -1e30f; l = 0.f; \
                FA_QK(p0, p1, g & 1, kb); \
                FA_WAITBAR(); } } while (0)
        for (;;) {
            FA_STEP(p0, p1, n0, n1);
            if (lastb) { FA_UNIT_END(); if (done) break; continue; }
            kb += (u == 0 ? 1 : -1); ++g; p0 = n0; p1 = n1;
        }
#undef FA_SOFTPV
#undef FA_STEP
#undef FA_UNIT_END
#undef FA_ISSUE_K
#undef FA_ISSUE_V
#undef FA_QK
#undef FA_QK_STEP
#undef FA_PV_STEP
#undef FA_KB
    }
}
}

namespace fs {
#define FS_LAS __attribute__((address_space(3)))
__device__ __forceinline__ void sgu_phase(const Args& A, FS_LAS unsigned char* lds) {
    const bf16_t* U = (const bf16_t*)(A.ws + WS_U); const bf16_t* V = (const bf16_t*)(A.ws + WS_V); bf16_t* MIXIN = (bf16_t*)(A.ws + WS_MIXIN);
    const float* wsp = A.in[7]; const float* bsp = A.in[8]; const float* ln_g = A.in[5]; const float* ln_b = A.in[6]; const float* VSTAT = (const float*)(A.ws + WS_VSTAT);
    const int tid = threadIdx.x, lane = tid & 63, wid = __builtin_amdgcn_readfirstlane(tid >> 6), tb = wid & 3, dh = wid >> 2, r32 = lane & 31, hi = lane >> 5;
    const int frow = tid >> 2, fq4 = tid & 3;
    int vfo[2];
    { const int d16 = (lane >> 4) & 1, q = (lane & 15) >> 2, p = lane & 3;
#pragma unroll
      for (int j = 0; j < 2; ++j) vfo[j] = 32768 + (8 * hi + q) * 256 + (((2 * dh + j) ^ q) * 64) + d16 * 32 + p * 8; }
    const int wfo = (32 * tb + r32) * 256;
    const int NU = (T / CHUNK) * NG * PROBE_REP_SGU, UM = (T / CHUNK) * NG;
    f32x4 wa[4], wb[4], pa, pb, nwa[4], nwb[4], npa, npb; u32x4 vv[4], nvv[4];
#define FS_LOAD(u0_, WA, WB, VV, PA, PB) do { const int u_ = (u0_) % UM, rc_ = u_ / NG, g_ = u_ % NG, row0_ = rc_ * CHUNK; \
        const float* wr_ = wsp + ((size_t)g_ * CHUNK + frow) * CHUNK + fq4 * 32; const bf16_t* vr_ = V + (size_t)(row0_ + frow) * 1024 + g_ * 128 + fq4 * 32; \
        _Pragma("unroll") for (int c = 0; c < 4; ++c) { WA[c] = *(const f32x4*)(wr_ + 8 * c); WB[c] = *(const f32x4*)(wr_ + 8 * c + 4); VV[c] = *(const u32x4*)(vr_ + 8 * c); } \
        PA = *(const f32x4*)(VSTAT + ((size_t)(row0_ + frow) * 16 + 4 * fq4) * 2); PB = *(const f32x4*)(VSTAT + ((size_t)(row0_ + frow) * 16 + 4 * fq4) * 2 + 4); } while (0)
    int u0 = blockIdx.x;
    if (u0 < NU) FS_LOAD(u0, wa, wb, vv, pa, pb);
    for (; u0 < NU; u0 += gridDim.x) { const int u = u0 % UM;
        const int rc = u / NG, g = u % NG, row0 = rc * CHUNK;
        {
#pragma unroll
          for (int c = 0; c < 4; ++c) { const f32x4 a = wa[c], b2 = wb[c]; const int s0 = fq4 * 32 + 8 * c; float v[8] = {a.x, a.y, a.z, a.w, b2.x, b2.y, b2.z, b2.w};
#pragma unroll
              for (int j = 0; j < 8; ++j) if (s0 + j > frow) v[j] = 0.f;
              u32x4 w; w.x = pk2(v[0], v[1]); w.y = pk2(v[2], v[3]); w.z = pk2(v[4], v[5]); w.w = pk2(v[6], v[7]);
              *(FS_LAS u32x4*)(lds + frow * 256 + (((4 * fq4 + c) ^ (frow & 15)) * 16)) = w; }
          float mean, rstd;
          { float s1 = (pa[0] + pa[2]) + (pb[0] + pb[2]), s2 = (pa[1] + pa[3]) + (pb[1] + pb[3]);
            s1 += __shfl_xor(s1, 1); s1 += __shfl_xor(s1, 2); s2 += __shfl_xor(s2, 1); s2 += __shfl_xor(s2, 2);
            mean = s1 * (1.f / 1024.f); rstd = rsqrtf(fmaxf(s2 * (1.f / 1024.f) - mean * mean, 0.f) + EPS); }
#pragma unroll
          for (int c = 0; c < 4; ++c) { const u32x4 w = vv[c]; const int cb = g * 128 + fq4 * 32 + 8 * c;
              const f32x4 ga = *(const f32x4*)(ln_g + cb), gb = *(const f32x4*)(ln_g + cb + 4), ba = *(const f32x4*)(ln_b + cb), bb = *(const f32x4*)(ln_b + cb + 4);
              float v[8];
#pragma unroll
              for (int e2 = 0; e2 < 4; ++e2) { v[2 * e2] = __uint_as_float(w[e2] << 16); v[2 * e2 + 1] = __uint_as_float(w[e2] & 0xffff0000u); }
              u32x4 o; o.x = pk2((v[0] - mean) * rstd * ga[0] + ba[0], (v[1] - mean) * rstd * ga[1] + ba[1]); o.y = pk2((v[2] - mean) * rstd * ga[2] + ba[2], (v[3] - mean) * rstd * ga[3] + ba[3]);
              o.z = pk2((v[4] - mean) * rstd * gb[0] + bb[0], (v[5] - mean) * rstd * gb[1] + bb[1]); o.w = pk2((v[6] - mean) * rstd * gb[2] + bb[2], (v[7] - mean) * rstd * gb[3] + bb[3]);
              *(FS_LAS u32x4*)(lds + 32768 + frow * 256 + (((4 * fq4 + c) ^ ((frow & 3) << 2)) * 16)) = o; } }
        __syncthreads();
        const bool more = u0 + (int)gridDim.x < NU;
        if (more) FS_LOAD(u0 + (int)gridDim.x, nwa, nwb, nvv, npa, npb);
        const int tt = 32 * tb + r32; const float bb = bsp[g * CHUNK + tt]; const size_t rw = (size_t)(row0 + tt);
        u32x2 uu[2][4];
#pragma unroll
        for (int j = 0; j < 2; ++j)
#pragma unroll
            for (int g4 = 0; g4 < 4; ++g4) uu[j][g4] = *(const u32x2*)(U + rw * 1024 + g * 128 + 32 * (2 * dh + j) + 8 * g4 + 4 * hi);
        fa::f32x16 acc[2];
#pragma unroll
        for (int j = 0; j < 2; ++j)
#pragma unroll
            for (int r = 0; r < 16; ++r) acc[j][r] = 0.f;
        for (int s = 0; s <= 2 * tb + 1; ++s) {
            const fa::bf16x8 wf = *(FS_LAS const fa::bf16x8*)(lds + wfo + (((2 * s + hi) ^ (r32 & 15)) * 16));
#pragma unroll
            for (int j = 0; j < 2; ++j) {
                const fa::v4i16 lo = __builtin_amdgcn_ds_read_tr16_b64_v4i16((FS_LAS fa::v4i16*)(lds + vfo[j] + s * 4096));
                const fa::v4i16 hh = __builtin_amdgcn_ds_read_tr16_b64_v4i16((FS_LAS fa::v4i16*)(lds + vfo[j] + s * 4096 + 1024));
                const fa::bf16x8 vf = (fa::bf16x8){lo[0], lo[1], lo[2], lo[3], hh[0], hh[1], hh[2], hh[3]};
                acc[j] = __builtin_amdgcn_mfma_f32_32x32x16_bf16(vf, wf, acc[j], 0, 0, 0); }
        }
#pragma unroll
        for (int j = 0; j < 2; ++j)
#pragma unroll
            for (int g4 = 0; g4 < 4; ++g4) { const int d = 32 * (2 * dh + j) + 8 * g4 + 4 * hi; const u32x2 u2 = uu[j][g4];
                const float u0f = __uint_as_float(u2.x << 16), u1 = __uint_as_float(u2.x & 0xffff0000u), u2f = __uint_as_float(u2.y << 16), u3 = __uint_as_float(u2.y & 0xffff0000u);
                u32x2 w; w.x = fa::cvtpk(u0f * (acc[j][4 * g4] + bb), u1 * (acc[j][4 * g4 + 1] + bb)); w.y = fa::cvtpk(u2f * (acc[j][4 * g4 + 2] + bb), u3 * (acc[j][4 * g4 + 3] + bb));
                *(u32x2*)(MIXIN + rw * 2048 + g * 128 + d) = w; }
        __syncthreads();
        if (more) {
#pragma unroll
            for (int c = 0; c < 4; ++c) { wa[c] = nwa[c]; wb[c] = nwb[c]; vv[c] = nvv[c]; }
            pa = npa; pb = npb; }
    }
#undef FS_LOAD
}
}


#define XB_TMO      128
#define XB_XCNT(j)  (256  + 64 * (j))
#define XB_XSUB(j)  (1280 + 64 * (j))
#define XB_XGEN(j)  (2304 + 64 * (j))
#define XB_TOP      3328
#define XB_TOPGEN   3392
#define XCD_BAR_WORDS 3456
#define XB_SPIN_CAP (1u << 18)
#define XLAS __attribute__((address_space(3)))
__device__ __forceinline__ unsigned xb_ld(unsigned* p)              { return __hip_atomic_load(p, __ATOMIC_RELAXED, __HIP_MEMORY_SCOPE_AGENT); }
__device__ __forceinline__ unsigned xb_add(unsigned* p, unsigned v) { return __hip_atomic_fetch_add(p, v, __ATOMIC_RELAXED, __HIP_MEMORY_SCOPE_AGENT); }
__device__ __forceinline__ unsigned xb_xcc_id() { return (unsigned)__builtin_amdgcn_s_getreg((3 << 11) | 20) & 0xFu; }
#define XB_SPIN(cond, bar) do { unsigned _sp = 0; while (cond) { __builtin_amdgcn_s_sleep(1); \
    if ((++_sp & 255u) == 0u) { if (xb_ld(&(bar)[XB_TMO])) break; if (_sp > XB_SPIN_CAP) { atomicAdd(&(bar)[XB_TMO], 1u); break; } } } } while (0)
struct XcdBarrier { unsigned* bar; unsigned x; volatile XLAS unsigned* st; };
__device__ __forceinline__ XcdBarrier xcd_barrier_post(unsigned* bar, volatile XLAS unsigned* st) {
    XcdBarrier b; b.bar = bar; b.x = xb_xcc_id(); b.st = st;
    if (threadIdx.x == 0) (void)xb_add(&bar[XB_XCNT(b.x)], 1u);
    return b;
}
__device__ __forceinline__ void xcd_barrier_complete(unsigned* bar, unsigned x, unsigned& nloc, unsigned& nx) {
    const unsigned G = gridDim.x * gridDim.y * gridDim.z;
    unsigned sum, cnt, mine, sp = 0u;
    for (;;) {
        sum = 0u; cnt = 0u; mine = 0u;
#pragma unroll
        for (unsigned j = 0; j < 16; ++j) { const unsigned c = xb_ld(&bar[XB_XCNT(j)]); sum += c; cnt += (c > 0u) ? 1u : 0u; mine = (j == x) ? c : mine; }
        if (sum == G) break;
        __builtin_amdgcn_s_sleep(1);
        if ((++sp & 255u) == 0u) { if (xb_ld(&bar[XB_TMO])) break; if (sp > XB_SPIN_CAP) { atomicAdd(&bar[XB_TMO], 1u); break; } }
    }
    nloc = mine > 0u ? mine : 1u; nx = cnt > 0u ? cnt : 1u;
}
__device__ __forceinline__ void xcd_barrier(const XcdBarrier& b) {
    asm volatile("s_waitcnt vmcnt(0)" ::: "memory");
    __syncthreads();
    if (threadIdx.x == 0) {
        unsigned* bar = b.bar;
        __builtin_amdgcn_s_waitcnt(0);
        unsigned nloc = b.st[0], nx = b.st[1];
        if (nloc == 0u) { xcd_barrier_complete(bar, b.x, nloc, nx); b.st[0] = nloc; b.st[1] = nx; }
        const unsigned old = xb_add(&bar[XB_XSUB(b.x)], 1u);
        const unsigned gen = old / nloc;
        if (old + 1u == (gen + 1u) * nloc) {
            __builtin_amdgcn_fence(__ATOMIC_RELEASE, "agent");
            asm volatile("s_waitcnt vmcnt(0)" ::: "memory");
            const unsigned og = xb_add(&bar[XB_TOP], 1u);
            const unsigned tg = og / nx;
            if (og + 1u == (tg + 1u) * nx) xb_add(&bar[XB_TOPGEN], 1u);
            else XB_SPIN(xb_ld(&bar[XB_TOPGEN]) == tg, bar);
            __builtin_amdgcn_fence(__ATOMIC_ACQUIRE, "agent");
            xb_add(&bar[XB_XGEN(b.x)], 1u);
            asm volatile("s_waitcnt vmcnt(0)" ::: "memory");
        } else {
            XB_SPIN(xb_ld(&bar[XB_XGEN(b.x)]) == gen, bar);
            __builtin_amdgcn_fence(__ATOMIC_ACQUIRE, "agent");
            asm volatile("s_waitcnt vmcnt(0)" ::: "memory");
        }
    }
    __syncthreads();
}
constexpr int CW_BAR = 4096;
constexpr size_t CTL_ZERO_BYTES = 65536;
constexpr int LDS_BARST_OFF = LDS_BYTES - 16;

constexpr bool FAST_P1 = true, FAST_P3 = true, FAST_P4 = true, FAST_P6 = true, FAST_P7 = true;
constexpr bool FAST_ATTN = true, FAST_SGU = true;
constexpr bool FAST_ANY = FAST_P1 || FAST_P3 || FAST_P4 || FAST_P6 || FAST_P7;
constexpr int N_PHASES = 10;
__global__ void __launch_bounds__(NTHREADS, 2) fwd(Args A) {
    extern __shared__ __attribute__((aligned(16))) unsigned char lds[];
    float* ldsf = (float*)lds;
    const int lo = A.ph_lo, hi = A.ph_hi;
    if (threadIdx.x < 4) ((volatile XLAS unsigned*)((XLAS unsigned char*)lds + LDS_BARST_OFF))[threadIdx.x] = 0u;
    __syncthreads();
    XcdBarrier bar = xcd_barrier_post((unsigned*)(A.ws + WS_CTL) + CW_BAR, (volatile XLAS unsigned*)((XLAS unsigned char*)lds + LDS_BARST_OFF));
#define IN(k) (lo <= (k) && (k) < hi)
#define SEAM(k) do { if (IN(k) && IN((k) + 1)) xcd_barrier(bar); STAMP((k) + 1); } while (0)
    unsigned long long t_lo = 0, t_hi = 0;
#define STAMP(i) do { if (STAMP_PHASE >= 0) { if ((i) == STAMP_PHASE || (STAMP_PHASE == 98 && (i) == 0)) t_lo = __builtin_amdgcn_s_memrealtime(); if ((i) == STAMP_PHASE + 1 || (STAMP_PHASE == 98 && (i) == 9)) t_hi = __builtin_amdgcn_s_memrealtime(); } } while (0)
    STAMP(0);
    PG8_LAS unsigned char* l3 = (PG8_LAS unsigned char*)lds;
    if (IN(0)) { if (FAST_ANY) { p0_weights(A, l3, 0, (int)blockIdx.x, (int)gridDim.x); __syncthreads(); if (!(HELPERS && gridDim.x % 32 == 0 && FAST_P1)) { p0_weights(A, l3, 1, (int)blockIdx.x, (int)gridDim.x); __syncthreads(); } } p0_router_weights(A); p0_rows(A, ldsf); } SEAM(0);
    if (IN(1)) { if (FAST_P1 && FAST_ATTN) { const int c_ = (int)blockIdx.x, G_ = (int)gridDim.x; const bool hs_ = HELPERS && (G_ % 32 == 0) && G_ / 4 >= NB * NH; const int hr_ = hs_ ? ((((c_ >> 3) & 3) == 3) ? (c_ >> 5) * 8 + (c_ & 7) : -1) : c_ - (G_ - NB * NH); if (hr_ >= 0 && hr_ < NB * NH) cumsum_bh(A, hr_, ldsf); } if (FAST_P1) p1_fast(A, l3); else p1_naive(A, ldsf); } SEAM(1);
    if (!(FAST_P1 && FAST_SGU && FAST_ATTN)) { if (IN(2)) { p1b_fix<0>(A, ldsf); } SEAM(2); }
    if (IN(3)) { if (FAST_SGU) fs::sgu_phase(A, l3); else p2_sgu_naive(A); if (FAST_ATTN) { __syncthreads(); fa::attn_phase(A, l3); } else p2_attn_naive(A, ldsf); } SEAM(3);
    if (IN(4)) { if (FAST_P3) p3_fast(A, l3); else p3_naive(A, ldsf); } SEAM(4);
    if (IN(5)) { if (FAST_P4) p4_fast(A, l3); else p4_naive(A, ldsf); } SEAM(5);
    if (IN(6)) { if (PROBE_ALT == 6) { p5_router3<1>(A, ldsf); __syncthreads(); } if (PROBE_ALT == 62) { p5_router3<2>(A, ldsf); __syncthreads(); } if (PROBE_ALT == 63) { p5_router3<3>(A, ldsf); __syncthreads(); } p5_router3<0>(A, ldsf); } SEAM(6);
    if (IN(7)) { if (FAST_P6) p6_fast(A, l3); else p6_naive(A, ldsf); } SEAM(7);
    if (IN(8)) { if (FAST_P7) p7_fast(A, l3); else p7_naive(A, ldsf); } SEAM(8);
    if (IN(9)) { if (PROBE_ALT == 9) { p8_combine<1>(A, ldsf); __syncthreads(); } p8_combine<0>(A, ldsf, STAMP_PHASE < 0 ? 0.f : (STAMP_PHASE == 99 ? 1.0f : (float)(t_hi - t_lo) * 0.01f * 0.001f * STAMP_SCALE)); }
#undef IN
#undef SEAM
}

#ifndef MK_N_LAUNCHES
#define MK_N_LAUNCHES 1
#endif
extern "C" void kernel_launch(void* const* d_in, const int* in_sizes, int n_in, void* d_out, int out_size, void* d_ws, size_t ws_size, hipStream_t stream) {
    static int grid = 0;
    if (grid == 0) {
        if (n_in != 22 || out_size != T * DM || ws_size < WS_END) { fprintf(stderr, "kernel_launch: unexpected shapes (n_in %d out %d ws %zu)\n", n_in, out_size, ws_size); grid = -1; return; }
        int dev = 0, cus = 0, per_cu = 0;
        hipGetDevice(&dev); hipDeviceGetAttribute(&cus, hipDeviceAttributeMultiprocessorCount, dev);
        hipFuncSetAttribute((const void*)fwd, hipFuncAttributeMaxDynamicSharedMemorySize, LDS_BYTES);
        hipOccupancyMaxActiveBlocksPerMultiprocessor(&per_cu, (const void*)fwd, NTHREADS, LDS_BYTES);
        if (per_cu < 1) { fprintf(stderr, "kernel_launch: occupancy query says %d blocks per CU\n", per_cu); per_cu = 1; }
        (void)hipGetLastError();
        grid = cus;
    }
    if (grid < 0) return;
    Args a{};
    for (int i = 0; i < 22; ++i) a.in[i] = (const float*)d_in[i];
    a.out = (float*)d_out; a.ws = (unsigned char*)d_ws;
    if (hipMemsetAsync((char*)d_ws + WS_CTL, 0, CTL_ZERO_BYTES, stream) != hipSuccess) { fprintf(stderr, "kernel_launch: memset failed\n"); return; }
    if (MK_N_LAUNCHES == 1) {
        a.ph_lo = 0; a.ph_hi = N_PHASES;
        hipLaunchKernelGGL(fwd, dim3(grid), dim3(NTHREADS), LDS_BYTES, stream, a);
    } else {
        for (int p = 0; p < N_PHASES; ++p) { a.ph_lo = p; a.ph_hi = p + 1; hipLaunchKernelGGL(fwd, dim3(grid), dim3(NTHREADS), LDS_BYTES, stream, a); }
    }
}
```

```cpp
#include <hip/hip_runtime.h>
#include <hip/hip_cooperative_groups.h>
#include <cstdio>
#include <cstdint>
namespace cg = cooperative_groups;

#ifndef STAMP_PHASE
#define STAMP_PHASE -1
#endif
#ifndef STAMP_SEL
#define STAMP_SEL 0
#endif
#ifndef STAMP_SCALE
#define STAMP_SCALE 0.5f
#endif
#ifndef PROBE_REP_P1
#define PROBE_REP_P1 1
#endif
#ifndef PROBE_REP_P4
#define PROBE_REP_P4 1
#endif
#ifndef PROBE_REP_P5
#define PROBE_REP_P5 1
#endif
#ifndef PROBE_REP_MOE
#define PROBE_REP_MOE 1
#endif
#ifndef PROBE_REP_ATTN
#define PROBE_REP_ATTN 1
#endif
#ifndef PROBE_REP_SGU
#define PROBE_REP_SGU 1
#endif
#ifndef PROBE_ATTN_VAR
#define PROBE_ATTN_VAR 0
#endif
#ifndef PROBE_ALT
#define PROBE_ALT -1
#endif
constexpr int T = 8192, SEQ = 2048, NB = 4, DM = 2048, SGUW = 1024, FOXW = 1024, NH = 8, HD = 128, CHUNK = 128, NG = 8;
constexpr int INCOLS = 9224, OFF_F = 5120, OFF_GATE = 5128;
constexpr int NEXP = 32, EPG = 8, NGRP = 4, DEXP = 512;
constexpr float EPS = 1e-6f;
constexpr float LOG2E = 1.4426950408889634f;
constexpr float QSCALE = 0.08838834764831845f * LOG2E;
constexpr int NTHREADS = 512, NWAVES = 8;
constexpr int LDS_BYTES = 160 * 1024;
constexpr int MTILE = 256;
constexpr int PMAX = 2 * T + NEXP * MTILE;
constexpr int MT_MAX = PMAX / MTILE;
constexpr bool HELPERS = true;
constexpr bool XCDM_GU = true;
constexpr int TINY_ROWS = 0;

typedef unsigned short bf16_t;
typedef float f32x4 __attribute__((ext_vector_type(4)));
typedef unsigned u32x4 __attribute__((ext_vector_type(4)));
typedef unsigned u32x2 __attribute__((ext_vector_type(2)));

constexpr size_t MiB = 1u << 20;
constexpr size_t WS_CTL = 0;
constexpr size_t WS_LOGF = 1 * MiB;
constexpr size_t WS_CKL = 2 * MiB;
constexpr size_t WS_TOK = 3 * MiB;
constexpr size_t WS_GATE = 4 * MiB;
constexpr size_t WS_ASG = 5 * MiB;
constexpr size_t WS_WIN = 8 * MiB;
constexpr size_t WS_WPROJ = 44 * MiB;
constexpr size_t WS_WOUT = 52 * MiB;
constexpr size_t WS_WGU = 60 * MiB;
constexpr size_t WS_WD = 188 * MiB;
constexpr size_t WS_H = 252 * MiB;
constexpr size_t WS_MIXED = WS_H;
constexpr size_t WS_U = 284 * MiB;
constexpr size_t WS_V = 300 * MiB;
constexpr size_t WS_G = 316 * MiB;
constexpr size_t WS_YBUF = WS_U;
constexpr size_t WS_Q = 380 * MiB;
constexpr size_t WS_K = 396 * MiB;
constexpr size_t WS_VA = 412 * MiB;
constexpr size_t WS_ACT = WS_Q;
constexpr size_t WS_MIXIN = 428 * MiB;
constexpr size_t WS_H2 = WS_MIXIN;
constexpr size_t WS_END = 460 * MiB;
static_assert((size_t)PMAX * 2048 * 2 <= 96 * MiB && (size_t)PMAX * 512 * 2 <= 32 * MiB, "overlay sizes");

constexpr int CW_CNT = 0;
constexpr int CNT_STRIDE = 64;

__device__ __forceinline__ float bf2f(bf16_t v) { return __uint_as_float((unsigned)v << 16); }
__device__ __forceinline__ bf16_t f2bf(float f) { unsigned u = __float_as_uint(f); return (bf16_t)((u + 0x7fffu + ((u >> 16) & 1u)) >> 16); }
__device__ __forceinline__ unsigned pk2(float lo, float hi) { return (unsigned)f2bf(lo) | ((unsigned)f2bf(hi) << 16); }
__device__ __forceinline__ unsigned cvtpk_rne(float lo, float hi) { unsigned r; asm("v_cvt_pk_bf16_f32 %0, %1, %2" : "=v"(r) : "v"(lo), "v"(hi)); return r; }
constexpr size_t WS_X1B = WS_WIN;
constexpr size_t WS_F8SC = 49152;
__device__ __forceinline__ unsigned pk4_fp8(float a, float b, float c, float d) {
    a = __builtin_amdgcn_fmed3f(a, -448.f, 448.f); b = __builtin_amdgcn_fmed3f(b, -448.f, 448.f); c = __builtin_amdgcn_fmed3f(c, -448.f, 448.f); d = __builtin_amdgcn_fmed3f(d, -448.f, 448.f);
    int w = __builtin_amdgcn_cvt_pk_fp8_f32(a, b, 0, false); w = __builtin_amdgcn_cvt_pk_fp8_f32(c, d, w, true); return (unsigned)w; }
__device__ __forceinline__ float wave_sum(float v) {
#pragma unroll
    for (int o = 1; o < 64; o <<= 1) v += __shfl_xor(v, o);
    return v;
}
__device__ __forceinline__ float wave_max(float v) {
#pragma unroll
    for (int o = 1; o < 64; o <<= 1) v = fmaxf(v, __shfl_xor(v, o));
    return v;
}
__device__ __forceinline__ float gelu_tanh(float x) {
    const float c = 0.7978845608028654f; const float y = c * (x + 0.044715f * x * x * x);
    return x / (1.0f + __expf(-2.0f * y));
}
__device__ __forceinline__ float sigmoidf_(float x) { return 1.0f / (1.0f + __expf(-x)); }
__device__ __forceinline__ float log_sigmoid(float z) { return fminf(z, 0.f) - log1pf(__expf(-fabsf(z))); }

struct Args {
    const float* in[22];
    float* out;
    unsigned char* ws;
    int ph_lo, ph_hi;
};

template <class AF, class BF, class EF>
__device__ __forceinline__ void naive_gemm_tile(float* lds, int m0, int n0, int M, int N, int K, int Ksplit, AF a, BF b, EF epi) {
    float* As = lds;
    float* Bs = lds + 16 * 132;
    const int tid = threadIdx.x, ty = tid >> 4, tx = tid & 15;
    float acc[4][8], acc1[4][8];
#pragma unroll
    for (int i = 0; i < 4; ++i)
#pragma unroll
        for (int j = 0; j < 8; ++j) { acc[i][j] = 0.f; acc1[i][j] = 0.f; }
    const bool split = Ksplit < K;
#pragma unroll 1
    for (int pass = 0; pass < 2; ++pass) {
        const int kb = pass == 0 ? 0 : Ksplit, ke = pass == 0 ? (split ? Ksplit : K) : K;
        if (pass == 1) {
            if (!split) break;
#pragma unroll
            for (int i = 0; i < 4; ++i)
#pragma unroll
                for (int j = 0; j < 8; ++j) { acc1[i][j] = acc[i][j]; acc[i][j] = 0.f; }
        }
#pragma unroll 1
        for (int k0 = kb; k0 < ke; k0 += 16) {
#pragma unroll
            for (int i = 0; i < 4; ++i) { const int idx = tid + i * 512, r = idx >> 4, kk = idx & 15; const int m = m0 + r; As[kk * 132 + r] = (m < M) ? a(m, k0 + kk) : 0.f; }
#pragma unroll
            for (int i = 0; i < 4; ++i) { const int idx = tid + i * 512, kk = idx >> 7, n = idx & 127; Bs[kk * 132 + n] = (n0 + n < N) ? b(k0 + kk, n0 + n) : 0.f; }
            __syncthreads();
#pragma unroll 4
            for (int kk = 0; kk < 16; ++kk) {
                float av[4], bv[8];
#pragma unroll
                for (int i = 0; i < 4; ++i) av[i] = As[kk * 132 + ty * 4 + i];
#pragma unroll
                for (int j = 0; j < 8; ++j) bv[j] = Bs[kk * 132 + tx * 8 + j];
#pragma unroll
                for (int i = 0; i < 4; ++i)
#pragma unroll
                    for (int j = 0; j < 8; ++j) acc[i][j] = fmaf(av[i], bv[j], acc[i][j]);
            }
            __syncthreads();
        }
    }
#pragma unroll
    for (int i = 0; i < 4; ++i)
#pragma unroll
        for (int j = 0; j < 8; ++j) { const int m = m0 + ty * 4 + i, n = n0 + tx * 8 + j; if (m < M && n < N) epi(m, n, split ? acc1[i][j] : acc[i][j], split ? acc[i][j] : 0.f); }
}
template <class AF, class BF, class EF>
__device__ __forceinline__ void naive_gemm(float* lds, int M, int N, int K, int Ksplit, AF a, BF b, EF epi) {
    const int ntm = (M + 127) / 128, ntn = (N + 127) / 128;
    for (int t = blockIdx.x; t < ntm * ntn; t += gridDim.x) naive_gemm_tile(lds, (t / ntn) * 128, (t % ntn) * 128, M, N, K, Ksplit, a, b, epi);
}

__device__ __forceinline__ float f8_pow2(float target) { float e = floorf(__log2f(target)); e = e < -40.f ? -40.f : (e > 40.f ? 40.f : e); return exp2f(e); }
__device__ __forceinline__ void f8_scales(const Args& A, float* red) {
    if (blockIdx.x != 0) return;
    const int tid = threadIdx.x, lane = tid & 63, wave = tid >> 6;
    const float* src[4] = {A.in[19], A.in[20], A.in[21], A.in[0]};
    float v[4];
#pragma unroll
    for (int q = 0; q < 4; ++q) { float a = 0.f;
#pragma unroll
        for (int j = 0; j < 4; ++j) { const f32x4 w = *(const f32x4*)(src[q] + (size_t)(j * NTHREADS + tid) * 4);
            a += q == 3 ? (w.x * w.x + w.y * w.y) + (w.z * w.z + w.w * w.w) : (fabsf(w.x) + fabsf(w.y)) + (fabsf(w.z) + fabsf(w.w)); }
        v[q] = wave_sum(a); }
    if (lane == 0) {
#pragma unroll
        for (int q = 0; q < 4; ++q) red[q * 8 + wave] = v[q]; }
    __syncthreads();
    if (tid == 0) { float t[4];
#pragma unroll
        for (int q = 0; q < 4; ++q) { float a = 0.f;
#pragma unroll
            for (int w = 0; w < NWAVES; ++w) a += red[q * 8 + w];
            t[q] = a * (1.f / 8192.f); }
        const float mgu = fmaxf(0.5f * (t[0] + t[1]), 1e-30f), md = fmaxf(t[2], 1e-30f), rx = fmaxf(sqrtf(t[3]), 1e-30f);
        const float sig = 1.2533f * mgu, ract = fmaxf(0.6f * sig * sig * (float)DM, 1e-30f);
        float* sc = (float*)(A.ws + WS_F8SC);
        sc[0] = f8_pow2(4.8f / rx); sc[1] = f8_pow2(3.0f / mgu); sc[2] = f8_pow2(3.0f / ract); sc[3] = f8_pow2(3.0f / md);
        sc[4] = f8_pow2(4.0f / fmaxf(ract * 1.2533f * md * 22.627f, 1e-30f)); }
    __syncthreads();
}
__device__ __forceinline__ void p0_stage_wf(const Args& A, float* ldsf) {
    const float* w_in = A.in[2];
    for (int i = threadIdx.x; i < DM * 8; i += NTHREADS) ldsf[(i & 7) * DM + (i >> 3)] = w_in[(size_t)(i >> 3) * INCOLS + OFF_F + (i & 7)];
}
__device__ __forceinline__ void p0_rows(const Args& A, float* ldsf, const int nw) {
    const float* x = A.in[0]; const float* g1 = A.in[1]; const float* b_forget = A.in[4];
    bf16_t* H = (bf16_t*)(A.ws + WS_H); float* LOGF = (float*)(A.ws + WS_LOGF);
    const int tid = threadIdx.x, lane = tid & 63, wave = tid >> 6;
    if (wave >= nw) return;
    const int gw = blockIdx.x * nw + wave, NGW = gridDim.x * nw;
    f32x4 gv[8];
#pragma unroll
    for (int j = 0; j < 8; ++j) gv[j] = *(const f32x4*)(g1 + 256 * j + 4 * lane);
    const float bfl = b_forget[lane & 7];
    f32x4 xv[8], xn[8];
    if (gw < T) { const f32x4* xr0 = (const f32x4*)(x + (size_t)gw * DM) + lane;
#pragma unroll
        for (int j = 0; j < 8; ++j) xv[j] = __builtin_nontemporal_load(xr0 + 64 * j); }
    asm volatile("" ::: "memory");
    for (int row = gw; row < T; row += NGW) {
        { const int nrow = row + NGW; if (nrow < T) { const f32x4* xr1 = (const f32x4*)(x + (size_t)nrow * DM) + lane;
#pragma unroll
            for (int j = 0; j < 8; ++j) xn[j] = __builtin_nontemporal_load(xr1 + 64 * j); } }
        float ss = 0.f;
#pragma unroll
        for (int j = 0; j < 8; ++j) ss += xv[j].x * xv[j].x + xv[j].y * xv[j].y + xv[j].z * xv[j].z + xv[j].w * xv[j].w;
        const float rstd = rsqrtf(wave_sum(ss) * (1.f / DM) + EPS);
        float f[8];
#pragma unroll
        for (int h = 0; h < 8; ++h) f[h] = 0.f;
#pragma unroll
        for (int j = 0; j < 8; ++j) {
            const int c0 = 256 * j + 4 * lane; const f32x4 g = gv[j];
            f32x4 hv; hv.x = xv[j].x * rstd * g.x; hv.y = xv[j].y * rstd * g.y; hv.z = xv[j].z * rstd * g.z; hv.w = xv[j].w * rstd * g.w;
            u32x2 o; o.x = cvtpk_rne(hv.x, hv.y); o.y = cvtpk_rne(hv.z, hv.w);
            *(u32x2*)(H + (size_t)row * DM + c0) = o;
#pragma unroll
            for (int h = 0; h < 8; ++h) { const f32x4 w4 = *(const f32x4*)(ldsf + h * DM + c0); f[h] = fmaf(hv.x, w4.x, fmaf(hv.y, w4.y, fmaf(hv.z, w4.z, fmaf(hv.w, w4.w, f[h])))); }
            asm volatile("" ::: "memory");
        }
#pragma unroll
        for (int h = 0; h < 8; ++h) f[h] = wave_sum(f[h]);
        if (lane < 8) { float z = 0.f;
#pragma unroll
            for (int h = 0; h < 8; ++h) if (lane == h) z = f[h];
            LOGF[(size_t)row * 8 + lane] = log_sigmoid(z + bfl); }
#pragma unroll
        for (int j = 0; j < 8; ++j) xv[j] = xn[j];
    }
}

__device__ __forceinline__ void p1_naive(const Args& A, float* ldsf) {
    const bf16_t* H = (const bf16_t*)(A.ws + WS_H); const float* w_in = A.in[2]; const float* b_gate = A.in[3];
    bf16_t* U = (bf16_t*)(A.ws + WS_U); bf16_t* V = (bf16_t*)(A.ws + WS_V); bf16_t* Q = (bf16_t*)(A.ws + WS_Q); bf16_t* K = (bf16_t*)(A.ws + WS_K);
    bf16_t* VA = (bf16_t*)(A.ws + WS_VA); bf16_t* G = (bf16_t*)(A.ws + WS_G);
    naive_gemm(ldsf, T, 9216, DM, DM,
        [=](int m, int k) { return bf2f(H[(size_t)m * DM + k]); },
        [=](int k, int n) { const int c = n < 5120 ? n : n + 8; return w_in[(size_t)k * INCOLS + c]; },
        [=](int m, int n, float s, float) {
            if (n < 1024) U[(size_t)m * 1024 + n] = f2bf(gelu_tanh(s));
            else if (n < 2048) V[(size_t)m * 1024 + n - 1024] = f2bf(gelu_tanh(s));
            else if (n < 3072) Q[(size_t)m * 1024 + n - 2048] = f2bf(s);
            else if (n < 4096) K[(size_t)m * 1024 + n - 3072] = f2bf(s);
            else if (n < 5120) VA[(size_t)m * 1024 + n - 4096] = f2bf(s);
            else G[(size_t)m * 4096 + n - 5120] = f2bf(sigmoidf_(s + b_gate[n - 5120]));
        });
}

template <int ALT> __device__ __forceinline__ void p1b_fix(const Args& A, float* ldsf) {
    bf16_t* V = (bf16_t*)(A.ws + WS_V); bf16_t* Q = (bf16_t*)(A.ws + WS_Q); bf16_t* K = (bf16_t*)(A.ws + WS_K);
    const size_t altoff = ALT ? ((size_t)((unsigned char*)A.out - (A.ws + WS_V))) / 2 : 0;
    const size_t altq = ALT ? ((size_t)((unsigned char*)A.out + 16 * MiB - (A.ws + WS_Q))) / 2 : 0, altk = ALT ? ((size_t)((unsigned char*)A.out + 32 * MiB - (A.ws + WS_K))) / 2 : 0;
    const float* ln_g = A.in[5]; const float* ln_b = A.in[6]; const float* qg = A.in[9]; const float* kg = A.in[10];
    const int tid = threadIdx.x, lane = tid & 63, wave = tid >> 6;
    const int gw = blockIdx.x * NWAVES + wave, NGW = gridDim.x * NWAVES;
    for (int row = gw; row < T; row += NGW) {
        {
            bf16_t* vr = V + (size_t)row * 1024; float v[16]; float s = 0.f;
#pragma unroll
            for (int j = 0; j < 2; ++j) { const u32x4 w = *(const u32x4*)(vr + 512 * j + 8 * lane);
#pragma unroll
                for (int e = 0; e < 4; ++e) { v[8 * j + 2 * e] = __uint_as_float(w[e] << 16); v[8 * j + 2 * e + 1] = __uint_as_float(w[e] & 0xffff0000u); } }
#pragma unroll
            for (int i = 0; i < 16; ++i) s += v[i];
            const float mean = wave_sum(s) * (1.f / 1024.f); float q = 0.f;
#pragma unroll
            for (int i = 0; i < 16; ++i) { v[i] -= mean; q += v[i] * v[i]; }
            const float rstd = rsqrtf(wave_sum(q) * (1.f / 1024.f) + EPS);
#pragma unroll
            for (int j = 0; j < 2; ++j) { const int c0 = 512 * j + 8 * lane; u32x4 o;
#pragma unroll
                for (int e = 0; e < 4; ++e) o[e] = pk2(v[8 * j + 2 * e] * rstd * ln_g[c0 + 2 * e] + ln_b[c0 + 2 * e], v[8 * j + 2 * e + 1] * rstd * ln_g[c0 + 2 * e + 1] + ln_b[c0 + 2 * e + 1]);
                *(u32x4*)(vr + altoff + c0) = o; }
        }
#pragma unroll
        for (int which = 0; which < 2; ++which) {
            bf16_t* pr = (which == 0 ? Q : K) + (size_t)row * 1024 + 16 * lane; const float* gg = which == 0 ? qg : kg; float v[16]; float s = 0.f;
#pragma unroll
            for (int j = 0; j < 2; ++j) { const u32x4 w = *(const u32x4*)(pr + 8 * j);
#pragma unroll
                for (int e = 0; e < 4; ++e) { v[8 * j + 2 * e] = __uint_as_float(w[e] << 16); v[8 * j + 2 * e + 1] = __uint_as_float(w[e] & 0xffff0000u); } }
#pragma unroll
            for (int i = 0; i < 16; ++i) s += v[i] * v[i];
            s += __shfl_xor(s, 1); s += __shfl_xor(s, 2); s += __shfl_xor(s, 4);
            const float sc = rsqrtf(s * (1.f / 128.f) + EPS) * (which == 0 ? QSCALE : 1.f); const int d0 = (16 * lane) & 127;
#pragma unroll
            for (int j = 0; j < 2; ++j) { u32x4 o;
#pragma unroll
                for (int e = 0; e < 4; ++e) o[e] = pk2(v[8 * j + 2 * e] * sc * gg[d0 + 8 * j + 2 * e], v[8 * j + 2 * e + 1] * sc * gg[d0 + 8 * j + 2 * e + 1]);
                *(u32x4*)(pr + (which == 0 ? altq : altk) + 8 * j) = o; }
        }
    }
    if (blockIdx.x < NB * NH) {
        const int b = blockIdx.x / NH, h = blockIdx.x % NH; const float* LOGF = (const float*)(A.ws + WS_LOGF); float* CKL = (float*)(A.ws + WS_CKL) + (size_t)blockIdx.x * SEQ + (ALT ? 65536 : 0);
        float v[4]; float s = 0.f;
#pragma unroll
        for (int i = 0; i < 4; ++i) { v[i] = LOGF[(size_t)(b * SEQ + tid * 4 + i) * 8 + h]; s += v[i]; }
        float incl = s;
#pragma unroll
        for (int o = 1; o < 64; o <<= 1) { const float t = __shfl_up(incl, o); if (lane >= o) incl += t; }
        __syncthreads();
        if (lane == 63) ldsf[wave] = incl;
        __syncthreads();
        float base = 0.f;
        for (int w = 0; w < wave; ++w) base += ldsf[w];
        float run = base + incl - s;
#pragma unroll
        for (int i = 0; i < 4; ++i) { run += v[i]; CKL[tid * 4 + i] = run * LOG2E; }
        __syncthreads();
    }
}


__device__ __forceinline__ void cumsum_bh(const Args& A, int bh, float* ldsf) {
    const int tid = threadIdx.x, lane = tid & 63, wave = tid >> 6, b = bh / NH, h = bh % NH;
    const float* LOGF = (const float*)(A.ws + WS_LOGF); float* CKL = (float*)(A.ws + WS_CKL) + (size_t)bh * SEQ;
    float v[4]; float sm = 0.f;
#pragma unroll
    for (int i = 0; i < 4; ++i) { v[i] = LOGF[(size_t)(b * SEQ + tid * 4 + i) * 8 + h]; sm += v[i]; }
    float incl = sm;
#pragma unroll
    for (int o = 1; o < 64; o <<= 1) { const float t = __shfl_up(incl, o); if (lane >= o) incl += t; }
    if (lane == 63) ldsf[wave] = incl;
    __syncthreads();
    float run = incl - sm;
    for (int w = 0; w < wave; ++w) run += ldsf[w];
    f32x4 o4;
#pragma unroll
    for (int i = 0; i < 4; ++i) { run += v[i]; o4[i] = run * LOG2E; }
    *(f32x4*)(CKL + tid * 4) = o4;
    __syncthreads();
}

__device__ __forceinline__ void p2_sgu_naive(const Args& A) {
    const bf16_t* U = (const bf16_t*)(A.ws + WS_U); const bf16_t* V = (const bf16_t*)(A.ws + WS_V); bf16_t* MIXIN = (bf16_t*)(A.ws + WS_MIXIN);
    const float* wsp = A.in[7]; const float* bsp = A.in[8];
    const int tid = threadIdx.x, tt = tid >> 2, dp = tid & 3;
    for (int u = blockIdx.x; u < (T / CHUNK) * NG; u += gridDim.x) {
        const int rc = u / NG, g = u % NG; const int row0 = rc * CHUNK;
        float acc[32];
#pragma unroll
        for (int i = 0; i < 32; ++i) acc[i] = 0.f;
        for (int ss = 0; ss <= tt; ++ss) {
            const float w = wsp[((size_t)g * CHUNK + tt) * CHUNK + ss];
            const bf16_t* vr = V + (size_t)(row0 + ss) * 1024 + g * 128 + dp * 32;
#pragma unroll
            for (int i = 0; i < 32; ++i) acc[i] = fmaf(w, bf2f(vr[i]), acc[i]);
        }
        const float bb = bsp[g * CHUNK + tt];
        const bf16_t* ur = U + (size_t)(row0 + tt) * 1024 + g * 128 + dp * 32; bf16_t* orow = MIXIN + (size_t)(row0 + tt) * 2048 + g * 128 + dp * 32;
#pragma unroll
        for (int i = 0; i < 32; ++i) orow[i] = f2bf(bf2f(ur[i]) * (acc[i] + bb));
    }
}
__device__ __forceinline__ void p2_attn_naive(const Args& A, float* ldsf) {
    const bf16_t* Q = (const bf16_t*)(A.ws + WS_Q); const bf16_t* K = (const bf16_t*)(A.ws + WS_K); const bf16_t* VA = (const bf16_t*)(A.ws + WS_VA);
    const float* CKL = (const float*)(A.ws + WS_CKL); bf16_t* MIXIN = (bf16_t*)(A.ws + WS_MIXIN);
    const int tid = threadIdx.x, lane = tid & 63, wave = tid >> 6;
    float* qs = ldsf + wave * 128;
    const int gw = blockIdx.x * NWAVES + wave, NGW = gridDim.x * NWAVES;
    for (int item = gw; item < T * NH; item += NGW) {
        const int row = item / NH, h = item % NH, b = row / SEQ, t = row % SEQ;
        const bf16_t* qr = Q + (size_t)row * 1024 + h * 128;
        qs[lane] = bf2f(qr[lane]); qs[64 + lane] = bf2f(qr[64 + lane]);
        __builtin_amdgcn_s_waitcnt(0);
        const float* ck = CKL + (size_t)(b * NH + h) * SEQ;
        float m = -1e30f, l = 0.f, o0 = 0.f, o1 = 0.f;
        for (int s0 = 0; s0 <= t; s0 += 64) {
            const int s = s0 + lane; float sc = -INFINITY;
            if (s <= t) { const bf16_t* kr = K + (size_t)(b * SEQ + s) * 1024 + h * 128; float d = 0.f;
                for (int c = 0; c < 16; ++c) { const u32x4 w = *(const u32x4*)(kr + 8 * c);
#pragma unroll
                    for (int e = 0; e < 4; ++e) { d = fmaf(qs[8 * c + 2 * e], __uint_as_float(w[e] << 16), d); d = fmaf(qs[8 * c + 2 * e + 1], __uint_as_float(w[e] & 0xffff0000u), d); } }
                sc = d - ck[s]; }
            const float mn = fmaxf(m, wave_max(sc)); const float alpha = exp2f(m - mn); const float p = exp2f(sc - mn);
            l = l * alpha + wave_sum(p); o0 *= alpha; o1 *= alpha; m = mn;
            const int nk = min(64, t - s0 + 1);
            for (int j = 0; j < nk; ++j) { const float pj = __shfl(p, j); const unsigned w = *(const unsigned*)(VA + (size_t)(b * SEQ + s0 + j) * 1024 + h * 128 + 2 * lane);
                o0 = fmaf(pj, __uint_as_float(w << 16), o0); o1 = fmaf(pj, __uint_as_float(w & 0xffff0000u), o1); }
        }
        const float il = 1.f / l;
        *(unsigned*)(MIXIN + (size_t)row * 2048 + 1024 + h * 128 + 2 * lane) = pk2(o0 * il, o1 * il);
    }
}

__device__ __forceinline__ void p3_naive(const Args& A, float* ldsf) {
    const bf16_t* MIXIN = (const bf16_t*)(A.ws + WS_MIXIN); const bf16_t* G = (const bf16_t*)(A.ws + WS_G); bf16_t* MIXED = (bf16_t*)(A.ws + WS_MIXED);
    const float* wps = A.in[11]; const float* wpf = A.in[12];
    naive_gemm(ldsf, T, DM, 2048, 1024,
        [=](int m, int k) { return bf2f(MIXIN[(size_t)m * 2048 + k]); },
        [=](int k, int n) { return k < 1024 ? wps[(size_t)k * DM + n] : wpf[(size_t)(k - 1024) * DM + n]; },
        [=](int m, int n, float s1, float s2) { MIXED[(size_t)m * DM + n] = f2bf(bf2f(G[(size_t)m * 4096 + n]) * s1 + bf2f(G[(size_t)m * 4096 + 2048 + n]) * s2); });
}
__device__ __forceinline__ void p4_naive(const Args& A, float* ldsf) {
    const bf16_t* MIXED = (const bf16_t*)(A.ws + WS_MIXED); const float* wo = A.in[13]; const float* x = A.in[0]; float* X1 = A.out;
    naive_gemm(ldsf, T, DM, DM, DM,
        [=](int m, int k) { return bf2f(MIXED[(size_t)m * DM + k]); },
        [=](int k, int n) { return wo[(size_t)k * DM + n]; },
        [=](int m, int n, float s, float) { X1[(size_t)m * DM + n] = x[(size_t)m * DM + n] + s; });
}

template <int ALT> __device__ __forceinline__ void p5_router(const Args& A, float* ldsf) {
    const float* X1 = A.out; const float* g2 = A.in[14]; const float* wrg = A.in[15]; const float* brg = A.in[16]; const float* wre = A.in[17]; const float* bre = A.in[18];
    bf16_t* H2 = (bf16_t*)(A.ws + WS_H2); unsigned* cnt = (unsigned*)(A.ws + WS_CTL) + CW_CNT + (ALT ? 2048 : 0);
    int* TOK = (int*)(A.ws + (ALT ? WS_H : WS_TOK)); float* GATE = (float*)(A.ws + (ALT ? WS_H + 2 * MiB : WS_GATE)); int* ASG = (int*)(A.ws + (ALT ? WS_H + 4 * MiB : WS_ASG));
    const int tid = threadIdx.x, lane = tid & 63, wave = tid >> 6, r = tid >> 4, ks = tid & 15;
    float* Ws = ldsf;
    float* Xs = ldsf + 256 * 36;
    float* rs = Xs + 32 * 260;
    int* hist = (int*)(rs + 32);
    int* hbase = hist + 32;
    int* sel = hbase + 32;
    int* lpos = sel + 64;
    float* selw = (float*)(lpos + 64);
    for (int rb = blockIdx.x; rb < T / 32; rb += gridDim.x) {
        const int row0 = rb * 32;
        for (int i = 0; i < 4; ++i) { const int rr = wave * 4 + i; const f32x4* xr = (const f32x4*)(X1 + (size_t)(row0 + rr) * DM) + lane; float ss = 0.f;
#pragma unroll
            for (int j = 0; j < 8; ++j) { const f32x4 v = xr[64 * j]; ss += v.x * v.x + v.y * v.y + v.z * v.z + v.w * v.w; }
            ss = wave_sum(ss); if (lane == 0) rs[rr] = rsqrtf(ss * (1.f / DM) + EPS); }
        if (tid < 32) hist[tid] = 0;
        __syncthreads();
        float acc[36];
#pragma unroll
        for (int j = 0; j < 36; ++j) acc[j] = 0.f;
        for (int k0 = 0; k0 < DM; k0 += 256) {
            for (int i = tid; i < 256 * 36; i += NTHREADS) { const int kk = i / 36, j = i % 36; Ws[i] = j < 4 ? wrg[(size_t)(k0 + kk) * 4 + j] : wre[(size_t)(k0 + kk) * 32 + j - 4]; }
            for (int i = tid; i < 32 * 256; i += NTHREADS) { const int rr = i >> 8, kk = i & 255; const float hv = X1[(size_t)(row0 + rr) * DM + k0 + kk] * rs[rr] * g2[k0 + kk];
                Xs[rr * 260 + kk] = hv; H2[(size_t)(row0 + rr) * DM + k0 + kk] = f2bf(hv); }
            __syncthreads();
            for (int kk = ks; kk < 256; kk += 16) { const float xv = Xs[r * 260 + kk]; const float* wr = Ws + kk * 36;
#pragma unroll
                for (int j = 0; j < 36; ++j) acc[j] = fmaf(xv, wr[j], acc[j]); }
            __syncthreads();
        }
#pragma unroll
        for (int j = 0; j < 36; ++j) { float v = acc[j]; v += __shfl_xor(v, 1); v += __shfl_xor(v, 2); v += __shfl_xor(v, 4); v += __shfl_xor(v, 8); acc[j] = v; }
        if (ks == 0) {
            float gl[4]; int grp = 0; float gm;
#pragma unroll
            for (int j = 0; j < 4; ++j) gl[j] = acc[j] + brg[j];
            gm = gl[0];
#pragma unroll
            for (int j = 1; j < 4; ++j) if (gl[j] > gm) { gm = gl[j]; grp = j; }
            float den = 0.f;
#pragma unroll
            for (int j = 0; j < 4; ++j) den += __expf(gl[j] - gm);
            const float pg = 1.f / den;
            float el[8];
#pragma unroll
            for (int j = 0; j < 8; ++j) { float v = 0.f;
#pragma unroll
                for (int g = 0; g < 4; ++g) if (g == grp) v = acc[4 + g * 8 + j] + bre[g * 8 + j];
                el[j] = v; }
            int i0 = 0; float v0 = el[0];
#pragma unroll
            for (int j = 1; j < 8; ++j) if (el[j] > v0) { v0 = el[j]; i0 = j; }
            int i1 = -1; float v1 = -INFINITY;
#pragma unroll
            for (int j = 0; j < 8; ++j) if (j != i0 && el[j] > v1) { v1 = el[j]; i1 = j; }
            const float e1 = __expf(v1 - v0); const float w0 = pg / (1.f + e1), w1 = pg * e1 / (1.f + e1);
            const int ea = grp * 8 + i0, eb = grp * 8 + i1;
            sel[r * 2] = ea; sel[r * 2 + 1] = eb; selw[r * 2] = w0; selw[r * 2 + 1] = w1;
            lpos[r * 2] = atomicAdd(&hist[ea], 1); lpos[r * 2 + 1] = atomicAdd(&hist[eb], 1);
        }
        __syncthreads();
        if (tid < 32) hbase[tid] = hist[tid] > 0 ? (int)atomicAdd(&cnt[(tid) * CNT_STRIDE], (unsigned)hist[tid]) : 0;
        __syncthreads();
        if (tid < 64) { const int e = sel[tid], pos = hbase[e] + lpos[tid]; const int tok = row0 + (tid >> 1);
            TOK[(size_t)e * T + pos] = tok; GATE[(size_t)e * T + pos] = selw[tid]; ASG[tok * 2 + (tid & 1)] = (e << 16) | pos; }
        __syncthreads();
    }
}

template <int ALT> __device__ __forceinline__ void p5_router2(const Args& A, float* ldsf) {
    const float* X1 = A.out; const float* g2 = A.in[14]; const float* wrg = A.in[15]; const float* brg = A.in[16]; const float* wre = A.in[17]; const float* bre = A.in[18];
    bf16_t* H2 = (bf16_t*)(A.ws + WS_H2); unsigned* cnt = (unsigned*)(A.ws + WS_CTL) + CW_CNT + (ALT ? 2048 : 0);
    int* TOK = (int*)(A.ws + (ALT ? WS_H : WS_TOK)); float* GATE = (float*)(A.ws + (ALT ? WS_H + 2 * MiB : WS_GATE)); int* ASG = (int*)(A.ws + (ALT ? WS_H + 4 * MiB : WS_ASG));
    const int tid = threadIdx.x, lane = tid & 63, wave = tid >> 6;
    constexpr int XP = 260, XB = 32 * XP, WP = 40, WB = 256 * WP;
    float* Xs = ldsf;
    float* Ws = ldsf + 2 * XB;
    float* misc = ldsf + 2 * XB + 2 * WB;
    float* rs = misc;
    float* lg = misc + 32;
    int* hist = (int*)(misc + 32 + 1280); int* hbase = hist + 32; int* sel = hbase + 32; int* lpos = sel + 64; float* selw = (float*)(lpos + 64);
    const int kh2 = lane >> 5, rp = (lane >> 1) & 15, cg = lane & 1;
    for (int rb = blockIdx.x; rb < T / 32; rb += gridDim.x) {
        const int row0 = rb * 32;
        float ssq[4] = {0.f, 0.f, 0.f, 0.f};
        float acc0[20], acc1[20];
#pragma unroll
        for (int j = 0; j < 20; ++j) { acc0[j] = 0.f; acc1[j] = 0.f; }
        if (tid < 32) hist[tid] = 0;
        f32x4 xr[4], wv[5], gv;
        for (int i = tid; i < 2 * 256; i += NTHREADS) *(f32x4*)(Ws + (i >> 8) * WB + (i & 255) * WP + 36) = (f32x4){0.f, 0.f, 0.f, 0.f};
#define R2_LOAD(k0) do { gv = *(const f32x4*)(g2 + (k0) + 4 * (tid & 63)); \
        _Pragma("unroll") for (int i = 0; i < 4; ++i) xr[i] = *(const f32x4*)(X1 + (size_t)(row0 + wave + 8 * i) * DM + (k0) + 4 * (tid & 63)); \
        _Pragma("unroll") for (int i = 0; i < 5; ++i) { const int idx = tid + i * 512; if (idx < 2304) { const int kk = idx / 9, j4 = idx - kk * 9; \
            wv[i] = j4 == 0 ? *(const f32x4*)(wrg + (size_t)((k0) + kk) * 4) : *(const f32x4*)(wre + (size_t)((k0) + kk) * 32 + 4 * (j4 - 1)); } } } while (0)
#define R2_STORE(buf) do { \
        _Pragma("unroll") for (int i = 0; i < 4; ++i) { ssq[i] += xr[i].x * xr[i].x + xr[i].y * xr[i].y + xr[i].z * xr[i].z + xr[i].w * xr[i].w; \
            *(f32x4*)(Xs + (buf) * XB + (wave + 8 * i) * XP + 4 * (tid & 63)) = xr[i] * gv; } \
        _Pragma("unroll") for (int i = 0; i < 5; ++i) { const int idx = tid + i * 512; if (idx < 2304) { const int kk = idx / 9, j4 = idx - kk * 9; *(f32x4*)(Ws + (buf) * WB + kk * WP + 4 * j4) = wv[i]; } } } while (0)
        R2_LOAD(0); R2_STORE(0);
        __syncthreads();
#pragma unroll 1
        for (int c = 0; c < 8; ++c) {
            const int buf = c & 1;
            if (c < 7) R2_LOAD((c + 1) * 256);
            const float* xa = Xs + buf * XB + (2 * rp) * XP + (wave * 2 + kh2) * 16; const float* wa = Ws + buf * WB + ((wave * 2 + kh2) * 16) * WP + 20 * cg;
#pragma unroll 1
            for (int k4 = 0; k4 < 4; ++k4) {
                const f32x4 x0 = *(const f32x4*)(xa + 4 * k4), x1 = *(const f32x4*)(xa + XP + 4 * k4);
#pragma unroll
                for (int kk = 0; kk < 4; ++kk) { const float* wr = wa + (4 * k4 + kk) * WP;
#pragma unroll
                    for (int j4 = 0; j4 < 5; ++j4) { const f32x4 w = *(const f32x4*)(wr + 4 * j4);
#pragma unroll
                        for (int e = 0; e < 4; ++e) { acc0[4 * j4 + e] = fmaf(x0[kk], w[e], acc0[4 * j4 + e]); acc1[4 * j4 + e] = fmaf(x1[kk], w[e], acc1[4 * j4 + e]); } }
                    asm volatile("" ::: "memory"); }
            }
            if (c < 7) R2_STORE(buf ^ 1);
            __syncthreads();
        }
#undef R2_LOAD
#undef R2_STORE
#pragma unroll
        for (int j = 0; j < 20; ++j) { acc0[j] += __shfl_xor(acc0[j], 32); acc1[j] += __shfl_xor(acc1[j], 32); }
        float* red = Xs;
        if (kh2 == 0) {
#pragma unroll
            for (int j = 0; j < 20; ++j) { red[(wave * 32 + 2 * rp) * 40 + 20 * cg + j] = acc0[j]; red[(wave * 32 + 2 * rp + 1) * 40 + 20 * cg + j] = acc1[j]; } }
#pragma unroll
        for (int i = 0; i < 4; ++i) { const float s = wave_sum(ssq[i]); if (lane == 0) rs[wave + 8 * i] = rsqrtf(s * (1.f / DM) + EPS); }
        __syncthreads();
        for (int i = tid; i < 32 * 40; i += NTHREADS) { float s = 0.f;
#pragma unroll
            for (int w = 0; w < 8; ++w) s += red[w * 1280 + i];
            lg[i] = s * rs[i / 40]; }
        __syncthreads();
#pragma unroll 1
        for (int i = 0; i < 4; ++i) { const int rr = wave + 8 * i; const float rstd = rs[rr]; const float* xp = X1 + (size_t)(row0 + rr) * DM; bf16_t* hp = H2 + (size_t)(row0 + rr) * DM;
#pragma unroll 2
            for (int j = 0; j < 8; ++j) { const int c0 = 256 * j + 4 * lane; const f32x4 v = *(const f32x4*)(xp + c0), g = *(const f32x4*)(g2 + c0);
                u32x2 o; o.x = pk2(v.x * rstd * g.x, v.y * rstd * g.y); o.y = pk2(v.z * rstd * g.z, v.w * rstd * g.w); *(u32x2*)(hp + c0) = o; } }
        if (tid < 32) {
            const int r = tid; const float* L = lg + r * 40;
            float gl[4]; int grp = 0;
#pragma unroll
            for (int j = 0; j < 4; ++j) gl[j] = L[j] + brg[j];
            float gm = gl[0];
#pragma unroll
            for (int j = 1; j < 4; ++j) if (gl[j] > gm) { gm = gl[j]; grp = j; }
            float den = 0.f;
#pragma unroll
            for (int j = 0; j < 4; ++j) den += __expf(gl[j] - gm);
            const float pg = 1.f / den;
            float el[8];
#pragma unroll
            for (int j = 0; j < 8; ++j) el[j] = L[4 + grp * 8 + j] + bre[grp * 8 + j];
            int i0 = 0; float v0 = el[0];
#pragma unroll
            for (int j = 1; j < 8; ++j) if (el[j] > v0) { v0 = el[j]; i0 = j; }
            int i1 = -1; float v1 = -INFINITY;
#pragma unroll
            for (int j = 0; j < 8; ++j) if (j != i0 && el[j] > v1) { v1 = el[j]; i1 = j; }
            const float e1 = __expf(v1 - v0); const float w0 = pg / (1.f + e1), w1 = pg * e1 / (1.f + e1);
            const int ea = grp * 8 + i0, eb = grp * 8 + i1;
            sel[r * 2] = ea; sel[r * 2 + 1] = eb; selw[r * 2] = w0; selw[r * 2 + 1] = w1;
            lpos[r * 2] = atomicAdd(&hist[ea], 1); lpos[r * 2 + 1] = atomicAdd(&hist[eb], 1);
        }
        __syncthreads();
        if (tid < 32) hbase[tid] = hist[tid] > 0 ? (int)atomicAdd(&cnt[(tid) * CNT_STRIDE], (unsigned)hist[tid]) : 0;
        __syncthreads();
        if (tid < 64) { const int e = sel[tid], pos = hbase[e] + lpos[tid]; const int tok = row0 + (tid >> 1);
            TOK[(size_t)e * T + pos] = tok; GATE[(size_t)e * T + pos] = selw[tid]; ASG[tok * 2 + (tid & 1)] = (e << 16) | pos; }
        __syncthreads();
    }
}

constexpr size_t WS_WR = 7 * MiB;
__device__ __forceinline__ void p0_router_weights(const Args& A) {
    const float* g2 = A.in[14]; const float* wrg = A.in[15]; const float* wre = A.in[17]; bf16_t* WR = (bf16_t*)(A.ws + WS_WR);
    for (int i = blockIdx.x * NTHREADS + threadIdx.x; i < 64 * DM; i += gridDim.x * NTHREADS) { const int n = i >> 11, k = i & (DM - 1);
        const float w = n < 4 ? wrg[(size_t)k * 4 + n] * g2[k] : (n < 36 ? wre[(size_t)k * 32 + n - 4] * g2[k] : 0.f);
        const bf16_t h = f2bf(w); const int j = ((k >> 4) * 64 + n) * 16 + (k & 15);
        WR[j] = h; WR[64 * DM + j] = f2bf(w - bf2f(h)); }
}
constexpr size_t WS_RSTL = WS_CKL;
template <int ALT> __device__ __forceinline__ void p5_router3(const Args& A, float* ldsf) {
    float* RSTL = (float*)(A.ws + (ALT ? WS_H + 6 * MiB : WS_RSTL));
    typedef short bf16x8 __attribute__((ext_vector_type(8))); typedef float f32x16 __attribute__((ext_vector_type(16)));
    const bf16_t* X1 = (const bf16_t*)(A.ws + WS_X1B); const float* g2 = A.in[14]; const float* brg = A.in[16]; const float* bre = A.in[18]; const bf16_t* WR = (const bf16_t*)(A.ws + WS_WR);
    bf16_t* H2 = (bf16_t*)(A.ws + WS_H2); unsigned* cnt = (unsigned*)(A.ws + WS_CTL) + CW_CNT + (ALT ? 2048 : 0);
    int* TOK = (int*)(A.ws + (ALT ? WS_H : WS_TOK)); float* GATE = (float*)(A.ws + (ALT ? WS_H + 2 * MiB : WS_GATE)); int* ASG = (int*)(A.ws + (ALT ? WS_H + 4 * MiB : WS_ASG));
    const int tid = threadIdx.x, lane = tid & 63, wave = tid >> 6, r32 = lane & 31, hi = lane >> 5;
    float* red = ldsf;
    float* lg = ldsf + 16384;
    float* sq = lg + 2048;
    float* rs = sq + 256;
    int* hist = (int*)(rs + 32); int* hbase = hist + 32; int* sel = hbase + 32; int* lpos = sel + 64; float* selw = (float*)(lpos + 64);
    float* g2s = ldsf + 24576;
    { const float f8sa = ((const float*)(A.ws + WS_F8SC))[0]; for (int i = tid; i < DM; i += NTHREADS) g2s[i] = g2[i] * f8sa; }
    __syncthreads();
    for (int rb = blockIdx.x; rb < T / 32; rb += gridDim.x) {
        const int row0 = rb * 32;
        if (tid < 32) hist[tid] = 0;
        const bf16_t* xp = X1 + (size_t)(row0 + r32) * DM + 256 * wave + 8 * hi;
        const bf16_t* wp = WR + (size_t)((16 * wave) * 64 + r32) * 16 + 8 * hi;
        f32x16 acc[2];
#pragma unroll
        for (int j = 0; j < 2; ++j)
#pragma unroll
            for (int r = 0; r < 16; ++r) acc[j][r] = 0.f;
        float ssq = 0.f;
        u32x4 xw[4], xnw[4];
#pragma unroll
        for (int i = 0; i < 4; ++i) xw[i] = *(const u32x4*)(xp + 16 * i);
        u32x2 hsave[4];
#pragma unroll 1
        for (int kb = 0; kb < (ALT == 3 ? 0 : 4); ++kb) {
            bf16x8 wh0[4], wh1[4], wl0[4], wl1[4];
#pragma unroll
            for (int i = 0; i < 4; ++i) { const int ko = 64 * kb + 16 * i;
                const int wo = (4 * kb + i) * 1024;
                wh0[i] = *(const bf16x8*)(wp + wo); wh1[i] = *(const bf16x8*)(wp + 512 + wo); wl0[i] = *(const bf16x8*)(wp + (size_t)64 * DM + wo); wl1[i] = *(const bf16x8*)(wp + (size_t)64 * DM + 512 + wo);
                (void)ko; }
            asm volatile("" ::: "memory");
            if (kb < 3) {
#pragma unroll
                for (int i = 0; i < 4; ++i) xnw[i] = *(const u32x4*)(xp + 64 * (kb + 1) + 16 * i); }
            asm volatile("" ::: "memory");
            if (kb > 0) {
#pragma unroll
                for (int i = 0; i < 4; ++i) *(u32x2*)((unsigned char*)H2 + (size_t)(row0 + r32) * DM + 256 * wave + 8 * hi + 64 * (kb - 1) + 16 * i) = hsave[i]; }
            asm volatile("" ::: "memory");
#pragma unroll
            for (int i = 0; i < 4; ++i) { const int ko = 64 * kb + 16 * i; (void)ko;
                float xv[8];
#pragma unroll
                for (int e = 0; e < 4; ++e) { xv[2 * e] = __uint_as_float(xw[i][e] << 16); xv[2 * e + 1] = __uint_as_float(xw[i][e] & 0xffff0000u); }
                { const f32x4 fa = *(const f32x4*)(g2s + 256 * wave + 8 * hi + 64 * kb + 16 * i), fb = *(const f32x4*)(g2s + 256 * wave + 8 * hi + 64 * kb + 16 * i + 4);
                  u32x2 hw; hw.x = pk4_fp8(xv[0] * fa[0], xv[1] * fa[1], xv[2] * fa[2], xv[3] * fa[3]); hw.y = pk4_fp8(xv[4] * fb[0], xv[5] * fb[1], xv[6] * fb[2], xv[7] * fb[3]);
                  hsave[i] = hw; }
#pragma unroll
                for (int e = 0; e < 8; ++e) ssq += xv[e] * xv[e];
                const bf16x8 xh = __builtin_bit_cast(bf16x8, xw[i]);
                acc[0] = __builtin_amdgcn_mfma_f32_32x32x16_bf16(xh, wh0[i], acc[0], 0, 0, 0); acc[0] = __builtin_amdgcn_mfma_f32_32x32x16_bf16(xh, wl0[i], acc[0], 0, 0, 0);
                acc[1] = __builtin_amdgcn_mfma_f32_32x32x16_bf16(xh, wh1[i], acc[1], 0, 0, 0); acc[1] = __builtin_amdgcn_mfma_f32_32x32x16_bf16(xh, wl1[i], acc[1], 0, 0, 0); }
#pragma unroll
            for (int i = 0; i < 4; ++i) xw[i] = xnw[i];
        }
        if (ALT != 3) {
#pragma unroll
            for (int i = 0; i < 4; ++i) *(u32x2*)((unsigned char*)H2 + (size_t)(row0 + r32) * DM + 256 * wave + 8 * hi + 64 * 3 + 16 * i) = hsave[i]; }
#pragma unroll
        for (int j = 0; j < 2; ++j)
#pragma unroll
            for (int r = 0; r < 16; ++r) red[((wave * 2 + j) * 16 + r) * 64 + lane] = acc[j][r];
        ssq += __shfl_xor(ssq, 32);
        if (hi == 0) sq[wave * 32 + r32] = ssq;
        __syncthreads();
        if (ALT == 2) continue;
#pragma unroll
        for (int j = 0; j < 2; ++j)
#pragma unroll
            for (int rr = 0; rr < 2; ++rr) { const int r = 2 * wave + rr; float s = 0.f;
#pragma unroll
                for (int w2 = 0; w2 < 8; ++w2) s += red[((w2 * 2 + j) * 16 + r) * 64 + lane];
                lg[((r & 3) + 8 * (r >> 2) + 4 * hi) * 64 + 32 * j + r32] = s; }
        if (tid < 32) { float s = 0.f;
#pragma unroll
            for (int w2 = 0; w2 < 8; ++w2) s += sq[w2 * 32 + tid];
            rs[tid] = rsqrtf(s * (1.f / DM) + EPS); }
        __syncthreads();
        if (tid < 32) {
            const int r = tid; const float* L = lg + r * 64; const float rstd = rs[r];
            float gl[4]; int grp = 0;
#pragma unroll
            for (int j = 0; j < 4; ++j) gl[j] = L[j] * rstd + brg[j];
            float gm = gl[0];
#pragma unroll
            for (int j = 1; j < 4; ++j) if (gl[j] > gm) { gm = gl[j]; grp = j; }
            float den = 0.f;
#pragma unroll
            for (int j = 0; j < 4; ++j) den += __expf(gl[j] - gm);
            const float pg = 1.f / den;
            float el[8];
#pragma unroll
            for (int j = 0; j < 8; ++j) el[j] = L[4 + grp * 8 + j] * rstd + bre[grp * 8 + j];
            int i0 = 0; float v0 = el[0];
#pragma unroll
            for (int j = 1; j < 8; ++j) if (el[j] > v0) { v0 = el[j]; i0 = j; }
            int i1 = -1; float v1 = -INFINITY;
#pragma unroll
            for (int j = 0; j < 8; ++j) if (j != i0 && el[j] > v1) { v1 = el[j]; i1 = j; }
            const float e1 = __expf(v1 - v0); const float w0 = pg / (1.f + e1), w1 = pg * e1 / (1.f + e1);
            const int ea = grp * 8 + i0, eb = grp * 8 + i1;
            sel[r * 2] = ea; sel[r * 2 + 1] = eb; selw[r * 2] = w0; selw[r * 2 + 1] = w1;
            lpos[r * 2] = atomicAdd(&hist[ea], 1); lpos[r * 2 + 1] = atomicAdd(&hist[eb], 1);
        }
        __syncthreads();
        if (tid < 32) hbase[tid] = hist[tid] > 0 ? (int)atomicAdd(&cnt[(tid) * CNT_STRIDE], (unsigned)hist[tid]) : 0;
        __syncthreads();
        if (tid < 64) { const int e = sel[tid], pos = hbase[e] + lpos[tid]; const int tok = row0 + (tid >> 1);
            TOK[(size_t)e * T + pos] = tok; GATE[(size_t)e * T + pos] = selw[tid]; RSTL[(size_t)e * T + pos] = rs[tid >> 1]; ASG[tok * 2 + (tid & 1)] = (e << 16) | pos; }
        __syncthreads();
    }
}

__device__ __forceinline__ void expert_layout(const unsigned* cnt, int* pstart  ) {
    int acc = 0;
    for (int e = 0; e < NEXP; ++e) { pstart[e] = acc; acc += ((int)cnt[(e) * CNT_STRIDE] + MTILE - 1) / MTILE * MTILE; }
    pstart[NEXP] = acc;
}

__device__ __forceinline__ void p6_naive(const Args& A, float* ldsf) {
    const bf16_t* H2 = (const bf16_t*)(A.ws + WS_H2); const float* wg = A.in[19]; const float* wu = A.in[20]; bf16_t* ACT = (bf16_t*)(A.ws + WS_ACT);
    const unsigned* cnt = (const unsigned*)(A.ws + WS_CTL) + CW_CNT; const int* TOK = (const int*)(A.ws + WS_TOK);
    int* ps = (int*)(ldsf + 2 * 16 * 132);
    if (threadIdx.x == 0) expert_layout(cnt, ps);
    __syncthreads();
    int ntot = 0;
    for (int e = 0; e < NEXP; ++e) ntot += (((int)cnt[(e) * CNT_STRIDE] + 127) / 128) * 4;
    for (int t = blockIdx.x; t < ntot; t += gridDim.x) {
        int e = 0, rem = t;
        for (; e < NEXP; ++e) { const int n = (((int)cnt[(e) * CNT_STRIDE] + 127) / 128) * 4; if (rem < n) break; rem -= n; }
        const int c = (int)cnt[(e) * CNT_STRIDE]; const int tm = rem / 4, tn = rem % 4; const int* tl = TOK + (size_t)e * T; const int prow = ps[e];
        const float* wge = wg + (size_t)e * DM * DEXP; const float* wue = wu + (size_t)e * DM * DEXP;
        naive_gemm_tile(ldsf, tm * 128, tn * 128, c, DEXP, 2 * DM, DM,
            [=](int m, int k) { return bf2f(H2[(size_t)tl[m] * DM + (k & (DM - 1))]); },
            [=](int k, int n) { return k < DM ? wge[(size_t)k * DEXP + n] : wue[(size_t)(k - DM) * DEXP + n]; },
            [=](int m, int n, float sg, float su) { ACT[(size_t)(prow + m) * DEXP + n] = f2bf(sg / (1.f + __expf(-sg)) * su); });
    }
}
__device__ __forceinline__ void p7_naive(const Args& A, float* ldsf) {
    const bf16_t* ACT = (const bf16_t*)(A.ws + WS_ACT); const float* wd = A.in[21]; bf16_t* YBUF = (bf16_t*)(A.ws + WS_YBUF);
    const unsigned* cnt = (const unsigned*)(A.ws + WS_CTL) + CW_CNT; const float* GATE = (const float*)(A.ws + WS_GATE);
    int* ps = (int*)(ldsf + 2 * 16 * 132);
    if (threadIdx.x == 0) expert_layout(cnt, ps);
    __syncthreads();
    int ntot = 0;
    for (int e = 0; e < NEXP; ++e) ntot += (((int)cnt[(e) * CNT_STRIDE] + 127) / 128) * 16;
    for (int t = blockIdx.x; t < ntot; t += gridDim.x) {
        int e = 0, rem = t;
        for (; e < NEXP; ++e) { const int n = (((int)cnt[(e) * CNT_STRIDE] + 127) / 128) * 16; if (rem < n) break; rem -= n; }
        const int c = (int)cnt[(e) * CNT_STRIDE]; const int tm = rem / 16, tn = rem % 16; const float* gl = GATE + (size_t)e * T; const int prow = ps[e];
        const float* wde = wd + (size_t)e * DEXP * DM;
        naive_gemm_tile(ldsf, tm * 128, tn * 128, c, DM, DEXP, DEXP,
            [=](int m, int k) { return bf2f(ACT[(size_t)(prow + m) * DEXP + k]); },
            [=](int k, int n) { return wde[(size_t)k * DM + n]; },
            [=](int m, int n, float s, float) { YBUF[(size_t)(prow + m) * DM + n] = f2bf(s * gl[m]); });
    }
}

template <int ALT> __device__ __forceinline__ void p8_combine(const Args& A, float* ldsf, const float dlt = 0.f) {
    const bf16_t* X1 = (const bf16_t*)(A.ws + WS_X1B); float* XO = ALT ? (float*)(A.ws + WS_WGU) : A.out; const bf16_t* YBUF = (const bf16_t*)(A.ws + WS_YBUF); const int* ASG = (const int*)(A.ws + WS_ASG);
    const unsigned* cnt = (const unsigned*)(A.ws + WS_CTL) + CW_CNT;
    int* ps = (int*)ldsf;
    if (threadIdx.x == 0) expert_layout(cnt, ps);
    __syncthreads();
    float dl2 = dlt;
    if (STAMP_PHASE == 97) { int v = 0, mx = 0, mn = 1 << 30, nt_ = 0, tiny = 0, half = 0; for (int e = 0; e < NEXP; ++e) { const int c = (int)cnt[(e) * CNT_STRIDE]; mx = c > mx ? c : mx; mn = c < mn ? c : mn; nt_ += (c + 255) / 256; const int rem = c % 256; tiny += (rem > 0 && rem <= 64) ? 1 : 0; half += (rem > 0 && rem <= 128) ? 1 : 0; }
        v = STAMP_SEL == 0 ? nt_ : STAMP_SEL == 1 ? mx : STAMP_SEL == 2 ? mn : STAMP_SEL == 3 ? tiny : half; dl2 = 0.01f * (float)v; }
    const int tid = threadIdx.x, lane = tid & 63, wave = tid >> 6;
    const int gw = blockIdx.x * NWAVES + wave, NGW = gridDim.x * NWAVES;
    u32x2 w0[4], w1[4], n0[4], n1[4]; u32x4 xa[4], na[4]; int xb = 0, nb = 0; (void)xb; (void)nb;
    const float ysc = 1.0f / ((const float*)(A.ws + WS_F8SC))[4];
#define P8_LOAD(row_, W0, W1, XA, XB) do { const int a0_ = ASG[(row_) * 2], a1_ = ASG[(row_) * 2 + 1]; \
        const unsigned char* y0_ = (const unsigned char*)YBUF + (size_t)(ps[a0_ >> 16] + (a0_ & 0xffff)) * DM; const unsigned char* y1_ = (const unsigned char*)YBUF + (size_t)(ps[a1_ >> 16] + (a1_ & 0xffff)) * DM; const bf16_t* xr_ = X1 + (size_t)(row_) * DM; \
        _Pragma("unroll") for (int j = 0; j < 4; ++j) { const int c0 = 512 * j + 8 * lane; W0[j] = *(const u32x2*)(y0_ + c0); W1[j] = *(const u32x2*)(y1_ + c0); XA[j] = *(const u32x4*)(xr_ + c0); } } while (0)
    int row = gw;
    if (row < T) P8_LOAD(row, w0, w1, xa, xb);
    for (; row < T; row += NGW) {
        const int nrow = row + NGW; const bool more = nrow < T;
        if (more) P8_LOAD(nrow, n0, n1, na, nb);
        float* xo = XO + (size_t)row * DM;
#pragma unroll
        for (int j = 0; j < 4; ++j) { const int c0 = 512 * j + 8 * lane; f32x4 a, b2;
            a.x = __uint_as_float(xa[j][0] << 16); a.y = __uint_as_float(xa[j][0] & 0xffff0000u); a.z = __uint_as_float(xa[j][1] << 16); a.w = __uint_as_float(xa[j][1] & 0xffff0000u);
            b2.x = __uint_as_float(xa[j][2] << 16); b2.y = __uint_as_float(xa[j][2] & 0xffff0000u); b2.z = __uint_as_float(xa[j][3] << 16); b2.w = __uint_as_float(xa[j][3] & 0xffff0000u);
            { typedef float f32x2_ __attribute__((ext_vector_type(2)));
              const f32x2_ p0 = __builtin_amdgcn_cvt_pk_f32_fp8((int)w0[j][0], false), p1 = __builtin_amdgcn_cvt_pk_f32_fp8((int)w0[j][0], true), p2 = __builtin_amdgcn_cvt_pk_f32_fp8((int)w0[j][1], false), p3 = __builtin_amdgcn_cvt_pk_f32_fp8((int)w0[j][1], true);
              const f32x2_ q0 = __builtin_amdgcn_cvt_pk_f32_fp8((int)w1[j][0], false), q1 = __builtin_amdgcn_cvt_pk_f32_fp8((int)w1[j][0], true), q2 = __builtin_amdgcn_cvt_pk_f32_fp8((int)w1[j][1], false), q3 = __builtin_amdgcn_cvt_pk_f32_fp8((int)w1[j][1], true);
              a.x += (p0[0] + q0[0]) * ysc; a.y += (p0[1] + q0[1]) * ysc; a.z += (p1[0] + q1[0]) * ysc; a.w += (p1[1] + q1[1]) * ysc;
              b2.x += (p2[0] + q2[0]) * ysc; b2.y += (p2[1] + q2[1]) * ysc; b2.z += (p3[0] + q3[0]) * ysc; b2.w += (p3[1] + q3[1]) * ysc; }
            if (STAMP_PHASE >= 0) { a += dl2; b2 += dl2; }
            __builtin_nontemporal_store(a, (f32x4*)(xo + c0)); __builtin_nontemporal_store(b2, (f32x4*)(xo + c0 + 4)); }
        if (more) {
#pragma unroll
            for (int j = 0; j < 4; ++j) { w0[j] = n0[j]; w1[j] = n1[j]; xa[j] = na[j]; } }
    }
#undef P8_LOAD
}

namespace pg8 {
#define PG8_LAS __attribute__((address_space(3)))
typedef short bf16x8 __attribute__((ext_vector_type(8))); typedef int v4i_t __attribute__((ext_vector_type(4))); typedef int v8i_t __attribute__((ext_vector_type(8)));
constexpr int BM = 256, BK = 64, HALF = 128, HTB = HALF * BK * 2, STAGE_BYTES = 8 * HTB, NXCD = 8, WGM = 8;
__host__ __device__ __forceinline__ int lds_byte(int r, int c) { const int st = (r >> 4) * 2 + (c >> 5), rr = r & 15, cc = c & 31, ob = rr * 64 + cc * 2; return st * 1024 + (ob ^ (((ob >> 9) & 1) << 5)); }
__host__ __device__ __forceinline__ void stage_rc(int b, int& R, int& C) { const int st = b / 1024, sb = b % 1024, swz = sb ^ (((sb >> 9) & 1) << 5); R = (st >> 1) * 16 + swz / 64; C = (st & 1) * 32 + (swz % 64) / 2; }
__host__ __device__ __forceinline__ int perm32(int rho) { const int n = rho >> 4, i = rho & 15; return 8 * (i >> 2) + 4 * n + (i & 3); }

struct Unit { const char* A; const char* B; int pm, pn, x0, x1, x2, x3; };

struct DenseOrder {
    const char* A; const char* Bt; int K, nM, nN, nwg, G, c, rep;
    __device__ void init(const void* A_, const void* Bt_, int M, int N, int K_, int G_, int c_, int rep_ = 1) { A = (const char*)A_; Bt = (const char*)Bt_; K = K_; nM = M / BM; nN = N / BM; nwg = nM * nN; G = G_; c = c_; rep = rep_; }
    __device__ bool next(int i, Unit& u) const {
        const long L = (long)i * G + c; if (L >= (long)nwg * rep) return false;
        int wgid = (int)(L % nwg); { const int q = nwg / NXCD, r = nwg % NXCD, xcd = wgid % NXCD, off = wgid / NXCD; wgid = (xcd < r ? xcd * (q + 1) : r * (q + 1) + (xcd - r) * q) + off; }
        const int nig = WGM * nN, gid = wgid / nig, fm = gid * WGM, gsz = (nM - fm) < WGM ? (nM - fm) : WGM;
        u.pm = fm + ((wgid % nig) % gsz); u.pn = (wgid % nig) / gsz; u.x0 = 0; u.x1 = 0; u.x2 = 0; u.x3 = 0;
        u.A = A + (size_t)u.pm * BM * K * 2; u.B = Bt + (size_t)u.pn * BM * K * 2; return true;
    }
    __device__ __forceinline__ void rows(const Unit&, unsigned (&)[2][2], const int (&)[2]) const {}
};

__device__ __forceinline__ unsigned cvt_pk_bf16(float lo, float hi) { unsigned r; asm volatile("v_cvt_pk_bf16_f32 %0, %1, %2" : "=v"(r) : "v"(lo), "v"(hi)); return r; }

template <class Epi, class Sched, bool ALIGN_EPI, bool GATHER, bool SKIP = false>
__device__ __forceinline__ void gemm_phase(PG8_LAS unsigned char* lds, const int K, const Sched& S, const Epi& E) {
    const int tid = threadIdx.x, wid = __builtin_amdgcn_readfirstlane(tid >> 6), lane = tid & 63, wr = wid >> 2, wc = wid & 3, fr = lane & 15, fq = lane >> 4;
    const int nt = K / BK;
    unsigned voffA[2], voffB[2]; int RA[2];
#pragma unroll
    for (int i = 0; i < 2; ++i) { int R, C; stage_rc(tid * 16 + i * 8192, R, C); const int Rb = Epi::PERM ? ((R & ~31) + perm32(R & 31)) : R;
        voffA[i] = GATHER ? (unsigned)(C * 2) : (unsigned)(R * K + C) * 2u; voffB[i] = (unsigned)(Rb * K + C) * 2u; RA[i] = R; }
    const size_t kstep = (size_t)(BK * 2);
    const size_t hstep = (size_t)HALF * K * 2;
    const size_t hstepA = GATHER ? 0 : hstep;
    const unsigned ldsw = (unsigned)wid * 1024u;
    const int aoff = lds_byte(wr * 64 + fr, fq * 8), boff = lds_byte(wc * 32 + fr, fq * 8);
    unsigned gA[2][2], gAn[2][2];
#define PG8_SA(b, h) (((b) * 2 + (h)) * HTB)
#define PG8_SB(b, h) ((4 + (b) * 2 + (h)) * HTB)
#define PG8_STAGE(bufoff, gbase, voff) do { _Pragma("unroll") for (int _i = 0; _i < 2; ++_i) \
        __builtin_amdgcn_global_load_lds((const unsigned*)((const char*)(gbase) + (voff)[_i]), (PG8_LAS unsigned*)(lds + (bufoff) + ldsw + _i * 8192), 16, 0, 0); } while (0)
#define PG8_STAGE_A(bufoff, gbase, h, nx) do { _Pragma("unroll") for (int _i = 0; _i < 2; ++_i) { \
        const unsigned _o = GATHER ? ((nx) ? gAn[h][_i] : gA[h][_i]) + voffA[_i] : voffA[_i]; \
        __builtin_amdgcn_global_load_lds((const unsigned*)((const char*)(gbase) + (h) * hstepA + _o), (PG8_LAS unsigned*)(lds + (bufoff) + ldsw + _i * 8192), 16, 0, 0); } } while (0)
#define PG8_LDA(dst, b, h) do { _Pragma("unroll") for (int m = 0; m < 4; ++m) _Pragma("unroll") for (int k = 0; k < 2; ++k) dst[m][k] = *(const PG8_LAS bf16x8*)(lds + PG8_SA(b, h) + aoff + m * 2048 + k * 1024); } while (0)
#define PG8_LDB(dst, b, h) do { _Pragma("unroll") for (int n = 0; n < 2; ++n) _Pragma("unroll") for (int k = 0; k < 2; ++k) dst[n][k] = *(const PG8_LAS bf16x8*)(lds + PG8_SB(b, h) + boff + n * 2048 + k * 1024); } while (0)
#define PG8_MMA(ai, bj, At, Bt) do { __builtin_amdgcn_s_setprio(1); _Pragma("unroll") for (int m = 0; m < 4; ++m) { if (!SKIP || m < ((ai) == 0 ? mc0 : mc1)) { _Pragma("unroll") for (int n = 0; n < 2; ++n) { \
        if constexpr (Epi::FP8) { const v8i_t b8_ = __builtin_shufflevector(__builtin_bit_cast(v4i_t, Bt[n][0]), __builtin_bit_cast(v4i_t, Bt[n][1]), 0, 1, 2, 3, 4, 5, 6, 7), \
                                               a8_ = __builtin_shufflevector(__builtin_bit_cast(v4i_t, At[m][0]), __builtin_bit_cast(v4i_t, At[m][1]), 0, 1, 2, 3, 4, 5, 6, 7); \
            asm volatile("v_mfma_scale_f32_16x16x128_f8f6f4 %0, %1, %2, %0, %3, %3 op_sel_hi:[0,0,0]" : "+v"(acc[ai][bj][m][n]) : "v"(b8_), "v"(a8_), "v"(f8one)); } \
        else { _Pragma("unroll") for (int k = 0; k < 2; ++k) acc[ai][bj][m][n] = __builtin_amdgcn_mfma_f32_16x16x32_bf16(Bt[n][k], At[m][k], acc[ai][bj][m][n], 0, 0, 0); } } } } __builtin_amdgcn_s_setprio(0); } while (0)
#define PG8_WAIT_V(n) asm volatile("s_waitcnt vmcnt(" #n ")" ::: "memory")
#define PG8_WAIT_L(n) asm volatile("s_waitcnt lgkmcnt(" #n ")" ::: "memory")
#define PG8_BAR __builtin_amdgcn_s_barrier()
#define PG8_SCHED __builtin_amdgcn_sched_barrier(0)
    Unit cur, nxt; int ui = 0;
    if (!S.next(0, cur)) return;
    int mc0 = 4, mc1 = 4;
#define PG8_MC(u) do { if (SKIP) { const int a_ = ((u).x2 - 64 * wr + 15) >> 4, b_ = ((u).x2 - 128 - 64 * wr + 15) >> 4; mc0 = a_ < 0 ? 0 : (a_ > 4 ? 4 : a_); mc1 = b_ < 0 ? 0 : (b_ > 4 ? 4 : b_); } } while (0)
    PG8_MC(cur);
    f32x4 acc[2][2][4][2];
#pragma unroll
    for (int a = 0; a < 2; ++a)
#pragma unroll
        for (int b = 0; b < 2; ++b)
#pragma unroll
            for (int m = 0; m < 4; ++m)
#pragma unroll
                for (int n = 0; n < 2; ++n) acc[a][b][m][n] = (f32x4){0.f, 0.f, 0.f, 0.f};
    int f8one = 0x7F7F7F7F; asm volatile("" : "+v"(f8one));
    bf16x8 At[4][2], B0[2][2], B1[2][2];
    const char* cA = cur.A; const char* cB = cur.B;
    if constexpr (GATHER) { S.rows(cur, gA, RA);
#pragma unroll
        for (int h = 0; h < 2; ++h)
#pragma unroll
            for (int i = 0; i < 2; ++i) gAn[h][i] = gA[h][i]; }
    PG8_STAGE(PG8_SB(0, 0), cB, voffB); PG8_STAGE(PG8_SB(0, 1), cB + hstep, voffB); PG8_STAGE_A(PG8_SA(0, 0), cA, 0, false); PG8_STAGE_A(PG8_SA(0, 1), cA, 1, false);
    if (wr == 1) PG8_BAR;
    PG8_WAIT_V(2); PG8_BAR;
    PG8_STAGE(PG8_SB(1, 0), cB + kstep, voffB); PG8_STAGE_A(PG8_SA(1, 0), cA + kstep, 0, false); PG8_STAGE(PG8_SB(1, 1), cB + hstep + kstep, voffB);
    PG8_WAIT_V(6); PG8_BAR;
    for (;;) {
        const bool has_next = S.next(ui + 1, nxt);
        const char* nA = has_next ? nxt.A : cA; const char* nB = has_next ? nxt.B : cB;
        if constexpr (GATHER) { if (has_next) { S.rows(nxt, gAn, RA); } }
        for (int t = 0; t < nt; t += 2) {
            const bool last = (t == nt - 2);
            const char* a1 = cA + (size_t)(t + 1) * kstep;
            const char* a2 = last ? nA : cA + (size_t)(t + 2) * kstep; const char* b2 = last ? nB : cB + (size_t)(t + 2) * kstep;
            const char* a3 = a2 + kstep; const char* b3 = b2 + kstep;
            if constexpr (Epi::HAS_MID) { if (t == nt / 2) { int frl = fr, fql = fq; asm volatile("" : "+v"(frl), "+v"(fql)); E.mid(acc, cur, wr, wc, frl, fql); } }
            PG8_LDB(B0, 0, 0); PG8_LDB(B1, 0, 1); PG8_SCHED; PG8_LDA(At, 0, 0); PG8_STAGE_A(PG8_SA(1, 1), a1, 1, false);
            PG8_WAIT_V(8); PG8_WAIT_L(0); PG8_BAR; PG8_MMA(0, 0, At, B0); PG8_MMA(0, 1, At, B1); PG8_BAR; PG8_SCHED;
            PG8_LDA(At, 0, 1); PG8_STAGE(PG8_SB(0, 0), b2, voffB); PG8_STAGE(PG8_SB(0, 1), b2 + hstep, voffB); PG8_STAGE_A(PG8_SA(0, 0), a2, 0, last);
            PG8_WAIT_V(8); PG8_WAIT_L(0); PG8_BAR; PG8_MMA(1, 0, At, B0); PG8_MMA(1, 1, At, B1); PG8_BAR; PG8_SCHED;
            PG8_LDB(B0, 1, 0); PG8_LDB(B1, 1, 1); PG8_SCHED; PG8_LDA(At, 1, 0); PG8_STAGE_A(PG8_SA(0, 1), a2, 1, last);
            PG8_WAIT_V(8); PG8_WAIT_L(0); PG8_BAR; PG8_MMA(0, 0, At, B0); PG8_MMA(0, 1, At, B1); PG8_BAR; PG8_SCHED;
            PG8_LDA(At, 1, 1); PG8_STAGE(PG8_SB(1, 0), b3, voffB); PG8_STAGE(PG8_SB(1, 1), b3 + hstep, voffB); PG8_STAGE_A(PG8_SA(1, 0), a3, 0, last);
            PG8_WAIT_V(8); PG8_WAIT_L(0); PG8_BAR; PG8_MMA(1, 0, At, B0); PG8_MMA(1, 1, At, B1); PG8_BAR; PG8_SCHED;
        }
        if constexpr (ALIGN_EPI) { if (wr == 0) PG8_BAR; }
        { int frl = fr, fql = fq; asm volatile("" : "+v"(frl), "+v"(fql)); E(acc, cur, wr, wc, frl, fql); }
        if (!has_next) break;
#pragma unroll
        for (int a = 0; a < 2; ++a)
#pragma unroll
            for (int b = 0; b < 2; ++b)
#pragma unroll
                for (int m = 0; m < 4; ++m)
#pragma unroll
                    for (int n = 0; n < 2; ++n) acc[a][b][m][n] = (f32x4){0.f, 0.f, 0.f, 0.f};
        cur = nxt; cA = nA; cB = nB; ++ui; PG8_MC(cur);
        if constexpr (GATHER) {
#pragma unroll
            for (int h = 0; h < 2; ++h)
#pragma unroll
                for (int i = 0; i < 2; ++i) gA[h][i] = gAn[h][i]; }
        if constexpr (ALIGN_EPI) { if (wr == 1) PG8_BAR; }
    }
    PG8_WAIT_V(0);
    if constexpr (!ALIGN_EPI) { if (wr == 0) PG8_BAR; }
    PG8_BAR;
#undef PG8_SA
#undef PG8_SB
#undef PG8_STAGE
#undef PG8_STAGE_A
#undef PG8_LDA
#undef PG8_LDB
#undef PG8_MMA
#undef PG8_WAIT_V
#undef PG8_WAIT_L
#undef PG8_BAR
#undef PG8_SCHED
#undef PG8_MC
}
}

constexpr int LDS_MISC_OFF = 131072;
__device__ __forceinline__ float fast_gelu(float x) { const float y = x + 0.044715f * x * x * x; return x * __builtin_amdgcn_rcpf(1.0f + __builtin_amdgcn_exp2f(-2.0f * 0.7978845608028654f * LOG2E * y)); }
__device__ __forceinline__ float fast_sigmoid(float x) { return __builtin_amdgcn_rcpf(1.0f + __builtin_amdgcn_exp2f(-LOG2E * x)); }
__device__ __forceinline__ unsigned pk4_u8(float a, float b, float c, float d) {
    unsigned w = __builtin_amdgcn_cvt_pk_u8_f32(fmaxf(a * 255.f, 1.f), 0, 0); w = __builtin_amdgcn_cvt_pk_u8_f32(fmaxf(b * 255.f, 1.f), 1, w); w = __builtin_amdgcn_cvt_pk_u8_f32(fmaxf(c * 255.f, 1.f), 2, w); return __builtin_amdgcn_cvt_pk_u8_f32(fmaxf(d * 255.f, 1.f), 3, w); }
__device__ __forceinline__ void unpack8u(const u32x2 w, float (&v)[8]) {
#pragma unroll
    for (int e = 0; e < 2; ++e) { v[4 * e] = (float)(w[e] & 0xffu); v[4 * e + 1] = (float)((w[e] >> 8) & 0xffu); v[4 * e + 2] = (float)((w[e] >> 16) & 0xffu); v[4 * e + 3] = (float)(w[e] >> 24); } }
__device__ __forceinline__ void unpack8(const u32x4 w, float (&v)[8]) {
#pragma unroll
    for (int e = 0; e < 4; ++e) { v[2 * e] = __uint_as_float(w[e] << 16); v[2 * e + 1] = __uint_as_float(w[e] & 0xffff0000u); } }

constexpr size_t WS_VSTAT = 6 * MiB;
constexpr int LDS_EPI_OFF = 131072 + 4096;
struct EpiIn {
    static constexpr bool PERM = true, HAS_MID = false; static constexpr bool FP8 = false;
    bf16_t *U, *V, *Q, *K, *VA, *G; const float* b_gate; const float* qg; const float* kg; float* VSTAT; PG8_LAS unsigned char* lds;
    __device__ __forceinline__ void mid(f32x4 (&)[2][2][4][2], const pg8::Unit&, int, int, int, int) const {}
    __device__ __forceinline__ void operator()(f32x4 (&acc)[2][2][4][2], const pg8::Unit& u, int wr, int wc, int fr, int fq) const {
        const int pn = u.pn; bf16_t* base; int ld, colt, mode;
        if (pn < 4) { base = U; ld = 1024; colt = pn * 256; mode = 1; }
        else if (pn < 8) { base = V; ld = 1024; colt = (pn - 4) * 256; mode = 3; }
        else if (pn < 12) { base = Q; ld = 1024; colt = (pn - 8) * 256; mode = 4; }
        else if (pn < 16) { base = K; ld = 1024; colt = (pn - 12) * 256; mode = 5; }
        else if (pn < 20) { base = VA; ld = 1024; colt = (pn - 16) * 256; mode = 0; }
        else { base = G; ld = 4096; colt = (pn - 20) * 256; mode = 2; }
        const int row0 = u.pm * 256 + wr * 64 + fr, col0 = colt + wc * 32 + 8 * fq;
        if (mode >= 4) {
            PG8_LAS float* P = (PG8_LAS float*)(lds + LDS_EPI_OFF);
#pragma unroll
            for (int ai = 0; ai < 2; ++ai)
#pragma unroll
                for (int m = 0; m < 4; ++m)
#pragma unroll
                    for (int bj = 0; bj < 2; ++bj) { const f32x4 a = acc[ai][bj][m][0], b = acc[ai][bj][m][1];
                        float s = (a[0] * a[0] + a[1] * a[1]) + (a[2] * a[2] + a[3] * a[3]) + (b[0] * b[0] + b[1] * b[1]) + (b[2] * b[2] + b[3] * b[3]);
                        s += __shfl_xor(s, 16); s += __shfl_xor(s, 32);
                        if (fq == 0) P[((ai * 128 + wr * 64 + m * 16 + fr) * 2 + bj) * 4 + wc] = s; }
            asm volatile("s_waitcnt lgkmcnt(0)" ::: "memory"); __builtin_amdgcn_s_barrier(); asm volatile("" ::: "memory");
            const float* gg = mode == 4 ? qg : kg; const float qs = mode == 4 ? QSCALE : 1.0f;
            const f32x4 g0 = *(const f32x4*)(gg + wc * 32 + 8 * fq), g1 = *(const f32x4*)(gg + wc * 32 + 8 * fq + 4);
#pragma unroll
            for (int ai = 0; ai < 2; ++ai)
#pragma unroll
                for (int m = 0; m < 4; ++m) { bf16_t* rowp = base + (size_t)(row0 + ai * 128 + m * 16) * ld + col0;
#pragma unroll
                    for (int bj = 0; bj < 2; ++bj) { const f32x4 pp = *(const PG8_LAS f32x4*)(P + ((ai * 128 + wr * 64 + m * 16 + fr) * 2 + bj) * 4);
                        const float sc = rsqrtf(((pp[0] + pp[1]) + (pp[2] + pp[3])) * (1.f / 128.f) + EPS) * qs;
                        const f32x4 v0 = acc[ai][bj][m][0] * g0 * sc, v1 = acc[ai][bj][m][1] * g1 * sc;
                        u32x4 w; w.x = pg8::cvt_pk_bf16(v0[0], v0[1]); w.y = pg8::cvt_pk_bf16(v0[2], v0[3]); w.z = pg8::cvt_pk_bf16(v1[0], v1[1]); w.w = pg8::cvt_pk_bf16(v1[2], v1[3]);
                        *(u32x4*)(rowp + bj * 128) = w; } }
            return;
        }
        f32x4 bv[2][2];
#pragma unroll
        for (int bj = 0; bj < 2; ++bj)
#pragma unroll
            for (int n = 0; n < 2; ++n) bv[bj][n] = (mode == 2) ? *(const f32x4*)(b_gate + col0 + bj * 128 + 4 * n) : (f32x4){0.f, 0.f, 0.f, 0.f};
#pragma unroll
        for (int ai = 0; ai < 2; ++ai)
#pragma unroll
            for (int m = 0; m < 4; ++m) { bf16_t* rowp = base + (size_t)(row0 + ai * 128 + m * 16) * ld + col0; float s1 = 0.f, s2 = 0.f;
#pragma unroll
                for (int bj = 0; bj < 2; ++bj) { f32x4 v0 = acc[ai][bj][m][0], v1 = acc[ai][bj][m][1];
                    if (mode == 1 || mode == 3) {
#pragma unroll
                        for (int j = 0; j < 4; ++j) { v0[j] = fast_gelu(v0[j]); v1[j] = fast_gelu(v1[j]); } }
                    else if (mode == 2) { v0 += bv[bj][0]; v1 += bv[bj][1];
#pragma unroll
                        for (int j = 0; j < 4; ++j) { v0[j] = fast_sigmoid(v0[j]); v1[j] = fast_sigmoid(v1[j]); } }
                    if (mode == 3) {
#pragma unroll
                        for (int j = 0; j < 4; ++j) { s1 += v0[j] + v1[j]; s2 += v0[j] * v0[j] + v1[j] * v1[j]; } }
                    if (mode == 2) { u32x2 w8; w8.x = pk4_u8(v0[0], v0[1], v0[2], v0[3]); w8.y = pk4_u8(v1[0], v1[1], v1[2], v1[3]);
                        *(u32x2*)((unsigned char*)base + (size_t)(row0 + ai * 128 + m * 16) * ld + col0 + bj * 128) = w8; }
                    else { u32x4 w; w.x = pg8::cvt_pk_bf16(v0[0], v0[1]); w.y = pg8::cvt_pk_bf16(v0[2], v0[3]); w.z = pg8::cvt_pk_bf16(v1[0], v1[1]); w.w = pg8::cvt_pk_bf16(v1[2], v1[3]);
                        *(u32x4*)(rowp + bj * 128) = w; } }
                if (mode == 3) { s1 += __shfl_xor(s1, 16); s1 += __shfl_xor(s1, 32); s2 += __shfl_xor(s2, 16); s2 += __shfl_xor(s2, 32);
                    if (fq == 0) { typedef float f32x2_ __attribute__((ext_vector_type(2))); *(f32x2_*)(VSTAT + ((size_t)(row0 + ai * 128 + m * 16) * 16 + (pn - 4) * 4 + wc) * 2) = (f32x2_){s1, s2}; } } }
    }
};
struct EpiProj {
    static constexpr bool PERM = true, HAS_MID = true; static constexpr bool FP8 = false;
    const bf16_t* G; bf16_t* O;
    __device__ __forceinline__ void mid(f32x4 (&acc)[2][2][4][2], const pg8::Unit& u, int wr, int wc, int fr, int fq) const {
        const int row0 = u.pm * 256 + wr * 64 + fr, col0 = u.pn * 256 + wc * 32 + 8 * fq;
#pragma unroll
        for (int ai = 0; ai < 2; ++ai) { u32x2 ws[4][2], wf[4][2];
#pragma unroll
            for (int m = 0; m < 4; ++m) { const unsigned char* gp = (const unsigned char*)G + (size_t)(row0 + ai * 128 + m * 16) * 4096 + col0;
#pragma unroll
                for (int bj = 0; bj < 2; ++bj) { ws[m][bj] = *(const u32x2*)(gp + bj * 128); wf[m][bj] = *(const u32x2*)(gp + 2048 + bj * 128); } }
#pragma unroll
            for (int m = 0; m < 4; ++m)
#pragma unroll
                for (int bj = 0; bj < 2; ++bj) { float gs[8], gf[8]; unpack8u(ws[m][bj], gs); unpack8u(wf[m][bj], gf);
#pragma unroll
                    for (int j = 0; j < 4; ++j) { acc[ai][bj][m][0][j] *= gs[j] * __builtin_amdgcn_rcpf(gf[j]); acc[ai][bj][m][1][j] *= gs[4 + j] * __builtin_amdgcn_rcpf(gf[4 + j]); } }
            asm volatile("" ::: "memory"); }
    }
    __device__ __forceinline__ void operator()(f32x4 (&acc)[2][2][4][2], const pg8::Unit& u, int wr, int wc, int fr, int fq) const {
        const int row0 = u.pm * 256 + wr * 64 + fr, col0 = u.pn * 256 + wc * 32 + 8 * fq;
#pragma unroll
        for (int ai = 0; ai < 2; ++ai) { u32x2 wf[4][2];
#pragma unroll
            for (int m = 0; m < 4; ++m)
#pragma unroll
                for (int bj = 0; bj < 2; ++bj) wf[m][bj] = *(const u32x2*)((const unsigned char*)G + (size_t)(row0 + ai * 128 + m * 16) * 4096 + 2048 + col0 + bj * 128);
#pragma unroll
            for (int m = 0; m < 4; ++m) { const size_t r = (size_t)(row0 + ai * 128 + m * 16);
#pragma unroll
                for (int bj = 0; bj < 2; ++bj) { float gf[8]; unpack8u(wf[m][bj], gf);
#pragma unroll
                    for (int j = 0; j < 8; ++j) gf[j] *= (1.f / 255.f);
                    const f32x4 v0 = acc[ai][bj][m][0], v1 = acc[ai][bj][m][1];
                    u32x4 w; w.x = pg8::cvt_pk_bf16(v0[0] * gf[0], v0[1] * gf[1]); w.y = pg8::cvt_pk_bf16(v0[2] * gf[2], v0[3] * gf[3]); w.z = pg8::cvt_pk_bf16(v1[0] * gf[4], v1[1] * gf[5]); w.w = pg8::cvt_pk_bf16(v1[2] * gf[6], v1[3] * gf[7]);
                    *(u32x4*)(O + r * 2048 + col0 + bj * 128) = w; } }
            asm volatile("" ::: "memory"); }
    }
};
struct EpiOut {
    static constexpr bool PERM = true, HAS_MID = false; static constexpr bool FP8 = false;
    const float* X; bf16_t* O;
    __device__ __forceinline__ void mid(f32x4 (&)[2][2][4][2], const pg8::Unit&, int, int, int, int) const {}
    __device__ __forceinline__ void operator()(f32x4 (&acc)[2][2][4][2], const pg8::Unit& u, int wr, int wc, int fr, int fq) const {
        const int row0 = u.pm * 256 + wr * 64 + fr, col0 = u.pn * 256 + wc * 32 + 8 * fq;
#pragma unroll
        for (int ai = 0; ai < 2; ++ai) { f32x4 xv[4][2][2];
#pragma unroll
            for (int m = 0; m < 4; ++m) { const size_t off = (size_t)(row0 + ai * 128 + m * 16) * DM + col0;
#pragma unroll
                for (int bj = 0; bj < 2; ++bj)
#pragma unroll
                    for (int n = 0; n < 2; ++n) xv[m][bj][n] = __builtin_nontemporal_load((const f32x4*)(X + off + bj * 128 + n * 4)); }
#pragma unroll
            for (int m = 0; m < 4; ++m) { const size_t off = (size_t)(row0 + ai * 128 + m * 16) * DM + col0;
#pragma unroll
                for (int bj = 0; bj < 2; ++bj) { const f32x4 v0 = xv[m][bj][0] + acc[ai][bj][m][0], v1 = xv[m][bj][1] + acc[ai][bj][m][1];
                    u32x4 o; o.x = pg8::cvt_pk_bf16(v0[0], v0[1]); o.y = pg8::cvt_pk_bf16(v0[2], v0[3]); o.z = pg8::cvt_pk_bf16(v1[0], v1[1]); o.w = pg8::cvt_pk_bf16(v1[2], v1[3]);
                    *(u32x4*)(O + off + bj * 128) = o; } }
            asm volatile("" ::: "memory"); }
    }
};
struct EpiGateUp {
    static constexpr bool PERM = true, HAS_MID = false; static constexpr bool FP8 = true;
    bf16_t* ACT; const float* RSTL; float ds, sact;
    __device__ __forceinline__ void mid(f32x4 (&)[2][2][4][2], const pg8::Unit&, int, int, int, int) const {}
    __device__ __forceinline__ void operator()(f32x4 (&acc)[2][2][4][2], const pg8::Unit& u, int wr, int wc, int fr, int fq) const {
        const int row0 = u.x0 + wr * 64 + fr, col0 = u.pn * 128 + wc * 32 + 8 * fq;
        float rrv[2][4];
#pragma unroll
        for (int ai = 0; ai < 2; ++ai)
#pragma unroll
            for (int m = 0; m < 4; ++m) rrv[ai][m] = RSTL[u.x1 + wr * 64 + fr + ai * 128 + m * 16] * ds;
#pragma unroll
        for (int ai = 0; ai < 2; ++ai)
#pragma unroll
            for (int m = 0; m < 4; ++m) { float o[8]; const float rr = rrv[ai][m];
#pragma unroll
                for (int n = 0; n < 2; ++n)
#pragma unroll
                    for (int j = 0; j < 4; ++j) { const float g = acc[ai][0][m][n][j] * rr, up = acc[ai][1][m][n][j] * rr; o[4 * n + j] = g * fast_sigmoid(g) * up; }
                u32x2 w; w.x = pk4_fp8(o[0] * sact, o[1] * sact, o[2] * sact, o[3] * sact); w.y = pk4_fp8(o[4] * sact, o[5] * sact, o[6] * sact, o[7] * sact);
                *(u32x2*)((unsigned char*)ACT + (size_t)(row0 + ai * 128 + m * 16) * DEXP + col0) = w; }
    }
};
struct EpiDown {
    static constexpr bool PERM = true, HAS_MID = false; static constexpr bool FP8 = true;
    bf16_t* Y; const float* GATE; float ds;
    __device__ __forceinline__ void mid(f32x4 (&)[2][2][4][2], const pg8::Unit&, int, int, int, int) const {}
    __device__ __forceinline__ void operator()(f32x4 (&acc)[2][2][4][2], const pg8::Unit& u, int wr, int wc, int fr, int fq) const {
        const int rl0 = wr * 64 + fr, col0 = u.pn * 256 + wc * 32 + 8 * fq;
        float gtv[2][4];
#pragma unroll
        for (int ai = 0; ai < 2; ++ai)
#pragma unroll
            for (int m = 0; m < 4; ++m) gtv[ai][m] = GATE[u.x1 + rl0 + ai * 128 + m * 16] * ds;
#pragma unroll
        for (int ai = 0; ai < 2; ++ai)
#pragma unroll
            for (int m = 0; m < 4; ++m) { const int rl = rl0 + ai * 128 + m * 16; const float gt = gtv[ai][m];
#pragma unroll
                for (int bj = 0; bj < 2; ++bj) { const f32x4 v0 = acc[ai][bj][m][0] * gt, v1 = acc[ai][bj][m][1] * gt;
                    u32x2 w; w.x = pk4_fp8(v0[0], v0[1], v0[2], v0[3]); w.y = pk4_fp8(v1[0], v1[1], v1[2], v1[3]);
                    *(u32x2*)((unsigned char*)Y + (size_t)(u.x0 + rl) * DM + col0 + bj * 128) = w; } }
    }
};
struct MoeOrder {
    const char* Abase; const char* Bbase; size_t Bstride; int K, nN, G, c; bool gather;
    const PG8_LAS int* ps;
    const unsigned* cnt; const int* TOK; bool xcdm;
    const PG8_LAS int* remap = nullptr; int nremap = 0;
    __device__ static int tile_of(int i, int c, int G, int nN, int nb, int& pn, bool xcdm) {
        const int S = (G / 8) / nN;
        if (!xcdm || G % 8 != 0 || S < 1) { const int L = i * G + c; pn = L % nN; return L / nN < nb ? L / nN : -1; }
        const int x = c % 8, slot = c / 8; pn = slot % nN;
        if (slot >= S * nN) return -1;
        const int sidx = i * (8 * S) + x * S + slot / nN; return sidx < nb ? sidx : -1;
    }
    __device__ bool next(int i, pg8::Unit& u) const {
        int pn; int sidx = tile_of(i, c, G, nN, remap ? nremap : ps[NEXP + 2], pn, xcdm); if (sidx < 0) return false;
        if (remap) sidx = remap[sidx];
        const int prow = ps[40 + sidx], info = ps[40 + MT_MAX + sidx], valid = ps[40 + 2 * MT_MAX + sidx];
        const int e = info >> 16, mt = info & 0xffff;
        u.pm = mt; u.pn = pn; u.x0 = prow; u.x1 = e * T + mt * MTILE; u.x2 = valid; u.x3 = e;
        u.A = gather ? Abase : Abase + (size_t)prow * K * 2; u.B = Bbase + (size_t)e * Bstride + (size_t)pn * 256 * K * 2; return true;
    }
    __device__ __forceinline__ void rows(const pg8::Unit& u, unsigned (&g)[2][2], const int (&RA)[2]) const {
#pragma unroll
        for (int h = 0; h < 2; ++h)
#pragma unroll
            for (int i = 0; i < 2; ++i) { int r = RA[i] + 128 * h; r = r < u.x2 ? r : u.x2 - 1; g[h][i] = (unsigned)TOK[u.x1 + r] * (unsigned)(K * 2); }
    }
};

struct TItem { const float* src; bf16_t* dst; int ld_src, ld_dst; float f8; };
__device__ __forceinline__ void titem_load(const TItem& t, f32x4 (&v)[8], int lane) {
#pragma unroll
    for (int i = 0; i < 8; ++i) v[i] = __builtin_nontemporal_load((const f32x4*)(t.src + (size_t)((lane >> 3) + 8 * i) * t.ld_src + 4 * (lane & 7)));
}
__device__ __forceinline__ void titem_store(const TItem& t, const f32x4 (&v)[8], PG8_LAS float* scr, int lane) {
#pragma unroll
    for (int i = 0; i < 8; ++i) { PG8_LAS float* d = scr + ((lane >> 3) + 8 * i) * 33 + 4 * (lane & 7); d[0] = v[i].x; d[1] = v[i].y; d[2] = v[i].z; d[3] = v[i].w; }
    asm volatile("s_waitcnt lgkmcnt(0)" ::: "memory");
    const int c = lane & 7;
#pragma unroll
    for (int j = 0; j < 4; ++j) { const int n = (lane >> 3) + 8 * j; const PG8_LAS float* s = scr + (8 * c) * 33 + n;
        if (t.f8 > 0.f) { const float f = t.f8; u32x2 o; o.x = pk4_fp8(s[0 * 33] * f, s[1 * 33] * f, s[2 * 33] * f, s[3 * 33] * f); o.y = pk4_fp8(s[4 * 33] * f, s[5 * 33] * f, s[6 * 33] * f, s[7 * 33] * f);
            __builtin_nontemporal_store(o, (u32x2*)((unsigned char*)t.dst + (size_t)n * t.ld_dst + 8 * c)); }
        else { u32x4 o; o.x = cvtpk_rne(s[0 * 33], s[1 * 33]); o.y = cvtpk_rne(s[2 * 33], s[3 * 33]); o.z = cvtpk_rne(s[4 * 33], s[5 * 33]); o.w = cvtpk_rne(s[6 * 33], s[7 * 33]);
            *(u32x4*)(t.dst + (size_t)n * t.ld_dst + 8 * c) = o; } }
    asm volatile("s_waitcnt lgkmcnt(0)" ::: "memory");
}
constexpr int TI0 = 32 * 288, TI1 = 16 * 64, TI2 = 16 * 64, TI3 = 32 * 64, TI4 = 32 * 512, TI5 = 32 * 512, TI6 = 32 * 512;
constexpr int TI_ALL = TI0 + TI1 + TI2 + TI3 + TI4 + TI5 + TI6;
#ifndef HELPER_SKIP_ITEMS
#define HELPER_SKIP_ITEMS 0
#endif
#ifndef TAIL1_ITEMS
#define TAIL1_ITEMS (TI5)
#endif
__device__ __forceinline__ TItem titem_decode(const Args& A, int r) {
    bf16_t* WIN = (bf16_t*)(A.ws + WS_WIN); bf16_t* WPROJ = (bf16_t*)(A.ws + WS_WPROJ); bf16_t* WOUT = (bf16_t*)(A.ws + WS_WOUT); bf16_t* WGU = (bf16_t*)(A.ws + WS_WGU); bf16_t* WD = (bf16_t*)(A.ws + WS_WD);
    TItem t; t.f8 = 0.f;
    if (r < TI0) { const int kb = r / 288, nb = r % 288; t.src = A.in[2] + (size_t)(64 * kb) * INCOLS + 32 * nb + (nb >= 160 ? 8 : 0); t.ld_src = INCOLS; t.dst = WIN + (size_t)(32 * nb) * 2048 + 64 * kb; t.ld_dst = 2048; return t; } r -= TI0;
    if (r < TI1) { const int kb = r / 64, nb = r % 64; t.src = A.in[11] + (size_t)(64 * kb) * DM + 32 * nb; t.ld_src = DM; t.dst = WPROJ + (size_t)(32 * nb) * 2048 + 64 * kb; t.ld_dst = 2048; return t; } r -= TI1;
    if (r < TI2) { const int kb = r / 64, nb = r % 64; t.src = A.in[12] + (size_t)(64 * kb) * DM + 32 * nb; t.ld_src = DM; t.dst = WPROJ + (size_t)(32 * nb) * 2048 + 1024 + 64 * kb; t.ld_dst = 2048; return t; } r -= TI2;
    if (r < TI3) { const int kb = r / 64, nb = r % 64; t.src = A.in[13] + (size_t)(64 * kb) * DM + 32 * nb; t.ld_src = DM; t.dst = WOUT + (size_t)(32 * nb) * 2048 + 64 * kb; t.ld_dst = 2048; return t; } r -= TI3;
    if (r < TI4 + TI5) { const int up = r >= TI4; if (up) r -= TI4; const int e = r / 512, q = r % 512, kb = q / 16, nb = q % 16, n = 32 * nb, drow = 256 * (n >> 7) + (n & 127) + (up ? 128 : 0);
        t.src = A.in[up ? 20 : 19] + (size_t)e * DM * DEXP + (size_t)(64 * kb) * DEXP + n; t.ld_src = DEXP; t.dst = (bf16_t*)((unsigned char*)WGU + ((size_t)e * 1024 + drow) * 2048 + 64 * kb); t.ld_dst = 2048; t.f8 = ((const float*)(A.ws + WS_F8SC))[1]; return t; } r -= TI4 + TI5;
    { const int e = r / 512, q = r % 512, kb = q / 64, nb = q % 64; t.src = A.in[21] + (size_t)e * DEXP * DM + (size_t)(64 * kb) * DM + 32 * nb; t.ld_src = DM; t.dst = (bf16_t*)((unsigned char*)WD + ((size_t)e * 2048 + 32 * nb) * 512 + 64 * kb); t.ld_dst = 512; t.f8 = ((const float*)(A.ws + WS_F8SC))[3]; return t; }
}
__device__ __forceinline__ void p0_weights(const Args& A, PG8_LAS unsigned char* lds, const int part, const int wrank, const int wcount, const int w0 = 0) {
    const int tid = threadIdx.x, lane = tid & 63, wave = tid >> 6;
    PG8_LAS float* scr = (PG8_LAS float*)(lds + wave * 16384);
    if (wrank < 0 || wcount < 1 || wave < w0) return;
    const int gw = wrank * (NWAVES - w0) + (wave - w0), NGW = wcount * (NWAVES - w0);
    const int cut1 = TI0 + HELPER_SKIP_ITEMS;
    const int it_lo = part == 0 ? 0 : cut1, it_hi = part == 0 ? cut1 : TI_ALL;
    int it = it_lo + gw; if (it >= it_hi) return;
    TItem t0, t1, t2, t3; f32x4 v0[8], v1[8], v2[8], v3[8];
    t0 = titem_decode(A, it); titem_load(t0, v0, lane);
    t1 = t0; t2 = t0; t3 = t0;
    if (it + NGW < it_hi) { t1 = titem_decode(A, it + NGW); titem_load(t1, v1, lane); }
    if (it + 2 * NGW < it_hi) { t2 = titem_decode(A, it + 2 * NGW); titem_load(t2, v2, lane); }
    for (;;) {
        if (it + 3 * NGW < it_hi) { t3 = titem_decode(A, it + 3 * NGW); titem_load(t3, v3, lane); }
        titem_store(t0, v0, scr, lane); it += NGW; if (it >= it_hi) break;
        if (it + 3 * NGW < it_hi) { t0 = titem_decode(A, it + 3 * NGW); titem_load(t0, v0, lane); }
        titem_store(t1, v1, scr, lane); it += NGW; if (it >= it_hi) break;
        if (it + 3 * NGW < it_hi) { t1 = titem_decode(A, it + 3 * NGW); titem_load(t1, v1, lane); }
        titem_store(t2, v2, scr, lane); it += NGW; if (it >= it_hi) break;
        if (it + 3 * NGW < it_hi) { t2 = titem_decode(A, it + 3 * NGW); titem_load(t2, v2, lane); }
        titem_store(t3, v3, scr, lane); it += NGW; if (it >= it_hi) break;
    }
}

struct PermOrder { pg8::DenseOrder base; const char* Bt; int K;
    __device__ bool next(int i, pg8::Unit& u) const {
        if (!base.next(i, u)) return false;
        const int s = u.pn, p = s / 18, j = s % 18, g = j % 3, k = j / 3;
        int t;
        if (g < 2) { const int gate0 = 20 + 8 * p + 3 * g; t = (k & 1) == 0 ? gate0 + (k >> 1) : (k == 1 ? 2 * p + 4 * g : (k == 3 ? 8 + 2 * p + g : 12 + 2 * p + g)); }
        else { const int gate0 = 26 + 8 * p; t = k == 0 ? gate0 : (k == 3 ? gate0 + 1 : (k == 1 ? 1 + 2 * p : (k == 4 ? 5 + 2 * p : (k == 2 ? 16 + 2 * p : 17 + 2 * p)))); }
        u.pn = t; u.B = Bt + (size_t)t * 256 * K * 2; return true; }
    __device__ __forceinline__ void rows(const pg8::Unit&, unsigned (&)[2][2], const int (&)[2]) const {}
};
__device__ __forceinline__ void p1_fast(const Args& A, PG8_LAS unsigned char* lds) {
    const int G_ = (int)gridDim.x, c_ = (int)blockIdx.x; const bool split = HELPERS && (G_ % 32 == 0); const int slot_ = c_ >> 3;
    if (split && (slot_ & 3) == 3) { p0_weights(A, lds, 1, (slot_ >> 2) * 8 + (c_ & 7), G_ / 4); return; }
    pg8::DenseOrder S; S.init(A.ws + WS_H, A.ws + WS_WIN, T, 9216, DM, split ? G_ / 4 * 3 : G_, split ? (slot_ - (slot_ >> 2)) * 8 + (c_ & 7) : c_, PROBE_REP_P1);
    EpiIn E{(bf16_t*)(A.ws + WS_U), (bf16_t*)(A.ws + WS_V), (bf16_t*)(A.ws + WS_Q), (bf16_t*)(A.ws + WS_K), (bf16_t*)(A.ws + WS_VA), (bf16_t*)(A.ws + WS_G), A.in[3], A.in[9], A.in[10], (float*)(A.ws + WS_VSTAT), lds};
    PermOrder SP{S, (const char*)(A.ws + WS_WIN), DM};
    pg8::gemm_phase<EpiIn, PermOrder, true, false>(lds, DM, SP, E);
}
__device__ __forceinline__ void p3_fast(const Args& A, PG8_LAS unsigned char* lds) {
    pg8::DenseOrder S; S.init(A.ws + WS_MIXIN, A.ws + WS_WPROJ, T, DM, 2048, gridDim.x, blockIdx.x, PROBE_REP_P4);
    EpiProj E{(const bf16_t*)(A.ws + WS_G), (bf16_t*)(A.ws + WS_MIXED)};
    pg8::gemm_phase<EpiProj, pg8::DenseOrder, true, false>(lds, 2048, S, E);
}
__device__ __forceinline__ void p4_fast(const Args& A, PG8_LAS unsigned char* lds) {
    pg8::DenseOrder S; S.init(A.ws + WS_MIXED, A.ws + WS_WOUT, T, DM, DM, gridDim.x, blockIdx.x, PROBE_REP_P5);
    EpiOut E{A.in[0], (bf16_t*)(A.ws + WS_X1B)};
    pg8::gemm_phase<EpiOut, pg8::DenseOrder, true, false>(lds, DM, S, E);
}
__device__ __forceinline__ void moe_layout_lds(const Args& A, PG8_LAS unsigned char* lds) {
    PG8_LAS int* ps = (PG8_LAS int*)(lds + LDS_MISC_OFF); PG8_LAS int* tprow = ps + 40; PG8_LAS int* tinfo = tprow + MT_MAX; PG8_LAS int* tvalid = tinfo + MT_MAX;
    const unsigned* cnt = (const unsigned*)(A.ws + WS_CTL) + CW_CNT;
    if (threadIdx.x == 0) { int acc = 0;
        for (int e = 0; e < NEXP; ++e) { ps[e] = acc; acc += ((int)cnt[(e) * CNT_STRIDE] + MTILE - 1) / MTILE * MTILE; }
        ps[NEXP] = acc; ps[NEXP + 1] = acc / MTILE; }
    __syncthreads();
    const int nt = ps[NEXP + 1]; PG8_LAS int* uval = tvalid + MT_MAX;
    int prow = 0, e = 0, mt = 0, valid = 0;
    if ((int)threadIdx.x < nt) { prow = (int)threadIdx.x * MTILE;
        for (int j = 1; j < NEXP; ++j) if (ps[j] <= prow) e = j;
        mt = (prow - ps[e]) / MTILE; valid = (int)cnt[(e) * CNT_STRIDE] - mt * MTILE; valid = valid > MTILE ? MTILE : valid; uval[threadIdx.x] = valid; }
    __syncthreads();
    if ((int)threadIdx.x < nt) { int rank = 0;
        if (TINY_ROWS > 0) { for (int j = 0; j < nt; ++j) { const int vj = uval[j]; rank += (vj > valid || (vj == valid && j < (int)threadIdx.x)) ? 1 : 0; } } else rank = (int)threadIdx.x;
        tprow[rank] = prow; tinfo[rank] = (e << 16) | mt; tvalid[rank] = valid; }
    if (threadIdx.x == 0) { int nb = 0; for (int j = 0; j < nt; ++j) nb += uval[j] > TINY_ROWS ? 1 : 0; ps[NEXP + 2] = nb; }
    __syncthreads();
}
namespace sm {
typedef short bf16x8 __attribute__((ext_vector_type(8))); typedef float f32x16 __attribute__((ext_vector_type(16)));
constexpr int TINY = 64;
__device__ __forceinline__ void gateup_small(const Args& A, PG8_LAS unsigned char* lds) {
    const PG8_LAS int* ps = (const PG8_LAS int*)(lds + LDS_MISC_OFF); const int nt = ps[NEXP + 1], nbig = ps[NEXP + 2];
    const bf16_t* H2 = (const bf16_t*)(A.ws + WS_H2); const bf16_t* WGU = (const bf16_t*)(A.ws + WS_WGU); bf16_t* ACT = (bf16_t*)(A.ws + WS_ACT); const int* TOK = (const int*)(A.ws + WS_TOK);
    const int tid = threadIdx.x, lane = tid & 63, w = __builtin_amdgcn_readfirstlane(tid >> 6), r32 = lane & 31, hi = lane >> 5;
    PG8_LAS float* red = (PG8_LAS float*)lds;
    for (int su = blockIdx.x; su < (nt - nbig) * 16; su += gridDim.x) {
        const int sidx = nbig + (su >> 4), sl = su & 15; const int prow = ps[40 + sidx], info = ps[40 + MT_MAX + sidx], valid = ps[40 + 2 * MT_MAX + sidx];
        const int e = info >> 16, mt = info & 0xffff, lbase = e * T + mt * MTILE;
        const int ra = r32 < valid ? r32 : valid - 1, rb = 32 + r32 < valid ? 32 + r32 : valid - 1;
        const bf16_t* a0p = H2 + (size_t)TOK[lbase + ra] * DM + 256 * w + 8 * hi; const bf16_t* a1p = H2 + (size_t)TOK[lbase + rb] * DM + 256 * w + 8 * hi;
        const bf16_t* b0p = WGU + ((size_t)e * 1024 + 256 * (sl >> 2) + 32 * (sl & 3) + r32) * DM + 256 * w + 8 * hi; const bf16_t* b1p = b0p + (size_t)128 * DM;
        f32x16 acc[2][2];
#pragma unroll
        for (int i = 0; i < 2; ++i)
#pragma unroll
            for (int j = 0; j < 2; ++j)
#pragma unroll
                for (int r = 0; r < 16; ++r) acc[i][j][r] = 0.f;
#pragma unroll 4
        for (int ks = 0; ks < 16; ++ks) { const bf16x8 a0 = *(const bf16x8*)(a0p + 16 * ks), a1 = *(const bf16x8*)(a1p + 16 * ks), b0 = *(const bf16x8*)(b0p + 16 * ks), b1 = *(const bf16x8*)(b1p + 16 * ks);
            acc[0][0] = __builtin_amdgcn_mfma_f32_32x32x16_bf16(a0, b0, acc[0][0], 0, 0, 0); acc[0][1] = __builtin_amdgcn_mfma_f32_32x32x16_bf16(a0, b1, acc[0][1], 0, 0, 0);
            acc[1][0] = __builtin_amdgcn_mfma_f32_32x32x16_bf16(a1, b0, acc[1][0], 0, 0, 0); acc[1][1] = __builtin_amdgcn_mfma_f32_32x32x16_bf16(a1, b1, acc[1][1], 0, 0, 0); }
#pragma unroll
        for (int i = 0; i < 2; ++i)
#pragma unroll
            for (int j = 0; j < 2; ++j)
#pragma unroll
                for (int r = 0; r < 16; ++r) red[(((w * 2 + i) * 2 + j) * 16 + r) * 64 + lane] = acc[i][j][r];
        __syncthreads();
#pragma unroll
        for (int i = 0; i < 2; ++i)
#pragma unroll
            for (int rr = 0; rr < 2; ++rr) { const int r = 2 * w + rr; float g = 0.f, u = 0.f;
#pragma unroll
                for (int w2 = 0; w2 < 8; ++w2) { g += red[(((w2 * 2 + i) * 2 + 0) * 16 + r) * 64 + lane]; u += red[(((w2 * 2 + i) * 2 + 1) * 16 + r) * 64 + lane]; }
                const int row = 32 * i + (r & 3) + 8 * (r >> 2) + 4 * hi; const float rr2 = ((const float*)(A.ws + WS_RSTL))[lbase + (row < valid ? row : valid - 1)]; g *= rr2; u *= rr2;
                ACT[(size_t)(prow + row) * DEXP + 32 * sl + r32] = f2bf(g * fast_sigmoid(g) * u); }
        __syncthreads();
    }
}
__device__ __forceinline__ void down_small(const Args& A, PG8_LAS unsigned char* lds) {
    const PG8_LAS int* ps = (const PG8_LAS int*)(lds + LDS_MISC_OFF); const int nt = ps[NEXP + 1], nbig = ps[NEXP + 2];
    const bf16_t* ACT = (const bf16_t*)(A.ws + WS_ACT); const bf16_t* WD = (const bf16_t*)(A.ws + WS_WD); bf16_t* Y = (bf16_t*)(A.ws + WS_YBUF); const float* GATE = (const float*)(A.ws + WS_GATE);
    const int tid = threadIdx.x, lane = tid & 63, w = __builtin_amdgcn_readfirstlane(tid >> 6), wn = w & 3, wk = w >> 2, r32 = lane & 31, hi = lane >> 5;
    PG8_LAS float* red = (PG8_LAS float*)lds;
    for (int su = blockIdx.x; su < (nt - nbig) * 16; su += gridDim.x) {
        const int sidx = nbig + (su >> 4), sl = su & 15; const int prow = ps[40 + sidx], info = ps[40 + MT_MAX + sidx], valid = ps[40 + 2 * MT_MAX + sidx];
        const int e = info >> 16, mt = info & 0xffff, lbase = e * T + mt * MTILE;
        const int ra = r32 < valid ? r32 : valid - 1, rb = 32 + r32 < valid ? 32 + r32 : valid - 1;
        const bf16_t* a0p = ACT + (size_t)(prow + ra) * DEXP + 256 * wk + 8 * hi; const bf16_t* a1p = ACT + (size_t)(prow + rb) * DEXP + 256 * wk + 8 * hi;
        const bf16_t* bp = WD + ((size_t)e * 2048 + 128 * sl + 32 * wn + r32) * DEXP + 256 * wk + 8 * hi;
        f32x16 acc[2];
#pragma unroll
        for (int i = 0; i < 2; ++i)
#pragma unroll
            for (int r = 0; r < 16; ++r) acc[i][r] = 0.f;
#pragma unroll 4
        for (int ks = 0; ks < 16; ++ks) { const bf16x8 a0 = *(const bf16x8*)(a0p + 16 * ks), a1 = *(const bf16x8*)(a1p + 16 * ks), b = *(const bf16x8*)(bp + 16 * ks);
            acc[0] = __builtin_amdgcn_mfma_f32_32x32x16_bf16(a0, b, acc[0], 0, 0, 0); acc[1] = __builtin_amdgcn_mfma_f32_32x32x16_bf16(a1, b, acc[1], 0, 0, 0); }
        if (wk == 1) {
#pragma unroll
            for (int i = 0; i < 2; ++i)
#pragma unroll
                for (int r = 0; r < 16; ++r) red[((wn * 2 + i) * 16 + r) * 64 + lane] = acc[i][r]; }
        __syncthreads();
        if (wk == 0) {
#pragma unroll
            for (int i = 0; i < 2; ++i)
#pragma unroll
                for (int r = 0; r < 16; ++r) { const int row = 32 * i + (r & 3) + 8 * (r >> 2) + 4 * hi; const float gt = GATE[lbase + (row < valid ? row : valid - 1)];
                    Y[(size_t)(prow + row) * DM + 128 * sl + 32 * wn + r32] = f2bf((acc[i][r] + red[((wn * 2 + i) * 16 + r) * 64 + lane]) * gt); } }
        __syncthreads();
    }
}
}

constexpr bool EARLY_DOWN = true;
constexpr int CW_EARLY = 8192;
struct EarlyInfo { bool on; int S, x, s, nbusy, qmin, nidle; };
__device__ __forceinline__ EarlyInfo moe_early(const PG8_LAS int* ps, int G, int c) {
    EarlyInfo e; const int nb = ps[NEXP + 2]; e.S = G / 32; e.on = EARLY_DOWN && XCDM_GU && (G % 32 == 0) && e.S >= 1 && nb > 8 * e.S && nb <= 16 * e.S;
    e.x = c % 8; e.s = c / 8;
    int nbz = 4 * (nb - 8 * e.S - e.x * e.S); nbz = nbz < 0 ? 0 : (nbz > 4 * e.S ? 4 * e.S : nbz);
    e.nbusy = nbz; e.qmin = nbz / 4; e.nidle = 4 * e.S - nbz; return e;
}
struct EarlyOrder {
    const char* Abase; const char* Bbase; size_t Bstride; int K, tile0, ntile, nidle, j; const PG8_LAS int* ps;
    __device__ bool next(int i, pg8::Unit& u) const {
        const int ui = i * nidle + j; if (i >= 2 || ui >= 8 * ntile) return false;
        const int sidx = tile0 + ui / 8, pn = ui % 8;
        const int prow = ps[40 + sidx], info = ps[40 + MT_MAX + sidx], valid = ps[40 + 2 * MT_MAX + sidx];
        const int e = info >> 16, mt = info & 0xffff;
        u.pm = mt; u.pn = pn; u.x0 = prow; u.x1 = e * T + mt * MTILE; u.x2 = valid; u.x3 = e;
        u.A = Abase + (size_t)prow * K * 2; u.B = Bbase + (size_t)e * Bstride + (size_t)pn * 256 * K * 2; return true;
    }
    __device__ __forceinline__ void rows(const pg8::Unit&, unsigned (&)[2][2], const int (&)[2]) const {}
};
__device__ __forceinline__ void p6_fast(const Args& A, PG8_LAS unsigned char* lds) {
    moe_layout_lds(A, lds);
    const PG8_LAS int* ps = (const PG8_LAS int*)(lds + LDS_MISC_OFF);
    const float* f8sc = (const float*)(A.ws + WS_F8SC);
    { MoeOrder S{(const char*)(A.ws + WS_H2), (const char*)(A.ws + WS_WGU), (size_t)1024 * 2048, DM / 2, 4, (int)gridDim.x, (int)blockIdx.x, true,
                 ps, (const unsigned*)(A.ws + WS_CTL) + CW_CNT, (const int*)(A.ws + WS_TOK), XCDM_GU};
      EpiGateUp E{(bf16_t*)(A.ws + WS_ACT), (const float*)(A.ws + WS_RSTL), 1.0f / (f8sc[0] * f8sc[1]), f8sc[2]};
      pg8::gemm_phase<EpiGateUp, MoeOrder, true, true>(lds, DM / 2, S, E); }
    sm::gateup_small(A, lds);
    const EarlyInfo ei = moe_early(ps, (int)gridDim.x, (int)blockIdx.x);
    if (ei.on && ei.s >= ei.nbusy) {
        asm volatile("s_waitcnt vmcnt(0)" ::: "memory");
        __syncthreads();
        if (threadIdx.x == 0) { unsigned* cw = (unsigned*)(A.ws + WS_CTL) + CW_EARLY + ei.x * 64;
            __builtin_amdgcn_fence(__ATOMIC_RELEASE, "agent");
            asm volatile("s_waitcnt vmcnt(0)" ::: "memory");
            (void)__hip_atomic_fetch_add(cw, 1u, __ATOMIC_RELAXED, __HIP_MEMORY_SCOPE_AGENT);
            const unsigned want = (unsigned)ei.nidle; unsigned sp = 0;
            while (__hip_atomic_load(cw, __ATOMIC_RELAXED, __HIP_MEMORY_SCOPE_AGENT) < want) { __builtin_amdgcn_s_sleep(2); if (++sp > (1u << 20)) break; }
            __builtin_amdgcn_fence(__ATOMIC_ACQUIRE, "agent");
            asm volatile("s_waitcnt vmcnt(0)" ::: "memory"); }
        __syncthreads();
        EarlyOrder S{(const char*)(A.ws + WS_ACT), (const char*)(A.ws + WS_WD), (size_t)2048 * 512, DEXP / 2, ei.x * ei.S + ei.qmin, ei.S - ei.qmin, ei.nidle, ei.s - ei.nbusy, ps};
        EpiDown E{(bf16_t*)(A.ws + WS_YBUF), (const float*)(A.ws + WS_GATE), f8sc[4] / (f8sc[2] * f8sc[3])};
        pg8::gemm_phase<EpiDown, EarlyOrder, true, false>(lds, DEXP / 2, S, E);
    }
}
__device__ __forceinline__ void p7_fast(const Args& A, PG8_LAS unsigned char* lds) {
    moe_layout_lds(A, lds);
    const PG8_LAS int* ps = (const PG8_LAS int*)(lds + LDS_MISC_OFF);
    PG8_LAS int* lt = (PG8_LAS int*)(lds + LDS_MISC_OFF) + 40 + 4 * MT_MAX;
    const EarlyInfo e0 = moe_early(ps, (int)gridDim.x, 0);
    if (e0.on) {
        if (threadIdx.x == 0) { int n = 0; const int nb = ps[NEXP + 2];
            for (int x = 0; x < 8; ++x) { const EarlyInfo ex = moe_early(ps, (int)gridDim.x, x); for (int q = 0; q < ex.qmin; ++q) lt[n++] = x * ex.S + q; }
            for (int t = 8 * e0.S; t < nb; ++t) lt[n++] = t;
            lt[MT_MAX] = n; }
        __syncthreads();
    }
    MoeOrder S{(const char*)(A.ws + WS_ACT), (const char*)(A.ws + WS_WD), (size_t)2048 * 512, DEXP / 2, 8, (int)gridDim.x, (int)blockIdx.x, false,
               ps, (const unsigned*)(A.ws + WS_CTL) + CW_CNT, (const int*)(A.ws + WS_TOK), true};
    if (e0.on) { S.remap = lt; S.nremap = lt[MT_MAX]; }
    const float* f8sc = (const float*)(A.ws + WS_F8SC);
    EpiDown E{(bf16_t*)(A.ws + WS_YBUF), (const float*)(A.ws + WS_GATE), f8sc[4] / (f8sc[2] * f8sc[3])};
    pg8::gemm_phase<EpiDown, MoeOrder, true, false>(lds, DEXP / 2, S, E);
    sm::down_small(A, lds);
}

namespace fa {
typedef short bf16x8 __attribute__((ext_vector_type(8)));
typedef short v4i16 __attribute__((ext_vector_type(4)));
typedef float f32x16 __attribute__((ext_vector_type(16)));
#define FA_LAS __attribute__((address_space(3)))
constexpr int KVBUF = 65536, LDS_CK = 131072, LDS_ML = 131072 + 8192;
__device__ __forceinline__ unsigned cvtpk(float lo, float hi) { unsigned r; asm("v_cvt_pk_bf16_f32 %0, %1, %2" : "=v"(r) : "v"(lo), "v"(hi)); return r; }
__device__ __forceinline__ bf16x8 pack8(const f32x16& p, int b) { u32x4 w; w.x = cvtpk(p[b], p[b + 1]); w.y = cvtpk(p[b + 2], p[b + 3]); w.z = cvtpk(p[b + 4], p[b + 5]); w.w = cvtpk(p[b + 6], p[b + 7]); return __builtin_bit_cast(bf16x8, w); }
__device__ __forceinline__ float swapmax(float v) { auto rr = __builtin_amdgcn_permlane32_swap(__float_as_uint(v), __float_as_uint(v), false, false); return fmaxf(__uint_as_float(rr[0]), __uint_as_float(rr[1])); }
__device__ __forceinline__ float swapsum(float v) { auto rr = __builtin_amdgcn_permlane32_swap(__float_as_uint(v), __float_as_uint(v), false, false); return __uint_as_float(rr[0]) + __uint_as_float(rr[1]); }
#define FA_WAITBAR() do { asm volatile("s_waitcnt vmcnt(0) lgkmcnt(0)" ::: "memory"); __builtin_amdgcn_s_barrier(); asm volatile("" ::: "memory"); } while (0)

__device__ __forceinline__ void attn_phase(const Args& A, FA_LAS unsigned char* lds) {
    const bf16_t* Q = (const bf16_t*)(A.ws + WS_Q); const bf16_t* Kt = (const bf16_t*)(A.ws + WS_K); const bf16_t* Vt = (const bf16_t*)(A.ws + WS_VA);
    const float* CKL = (const float*)(A.ws + WS_CKL); bf16_t* MIXIN = (bf16_t*)(A.ws + WS_MIXIN);
    const int tid = threadIdx.x, lane = tid & 63, wid = __builtin_amdgcn_readfirstlane(tid >> 6), rg = wid & 3, kh = wid >> 2, r32 = lane & 31, hi = lane >> 5;
    int koff[4];
#pragma unroll
    for (int i = 0; i < 4; ++i) { const int rl = 4 * i + (lane >> 4); koff[i] = rl * 1024 + (((lane & 15) ^ rl) * 8); }
    const int voff = (lane >> 4) * 1024 + (((lane & 15) ^ ((lane >> 4) << 2)) * 8);
    int kfo[8];
#pragma unroll
    for (int d0 = 0; d0 < 8; ++d0) kfo[d0] = (kh * 64 + r32) * 256 + (((2 * d0 + hi) ^ (r32 & 15)) * 16);
    int vfo[4];
    { const int dh = (lane >> 4) & 1, q = (lane & 15) >> 2, p = lane & 3;
#pragma unroll
      for (int db = 0; db < 4; ++db) vfo[db] = (kh * 64 + 4 * hi + q) * 256 + ((db ^ q) * 64) + dh * 32 + p * 8; }
    const unsigned ldsb = (unsigned)(uintptr_t)lds;
    const int G = gridDim.x;
    for (int vb0 = blockIdx.x; vb0 < 256 * PROBE_REP_ATTN; vb0 += G) { const int vb = vb0 % 256;
        const int item = (G % 8 == 0) ? ((vb % 8) * 32 + (vb / 8)) % 256 : vb;
        const int bh = item >> 3, ii = item & 7, b = bh >> 3, h = bh & 7;
        const bf16_t* Kg = Kt + (size_t)b * SEQ * 1024 + h * 128; const bf16_t* Vg = Vt + (size_t)b * SEQ * 1024 + h * 128;
        { const f32x4 c = *(const f32x4*)(CKL + (size_t)bh * SEQ + tid * 4); *(FA_LAS f32x4*)(lds + LDS_CK + tid * 16) = (f32x4){-c.x, -c.y, -c.z, -c.w}; }
#define FA_ISSUE_K(key0, kb_) do { const bf16_t* kg_ = Kg + (size_t)((key0) + 16 * wid) * 1024; \
        _Pragma("unroll") for (int i_ = 0; i_ < 4; ++i_) __builtin_amdgcn_global_load_lds((const unsigned*)(kg_ + koff[i_]), (FA_LAS unsigned*)(lds + (kb_) * 32768 + (wid * 4 + i_) * 1024), 16, 0, 0); } while (0)
#define FA_ISSUE_V(key0, vb_) do { const bf16_t* vg_ = Vg + (size_t)((key0) + 16 * wid) * 1024; \
        _Pragma("unroll") for (int i_ = 0; i_ < 4; ++i_) __builtin_amdgcn_global_load_lds((const unsigned*)(vg_ + i_ * 4096 + voff), (FA_LAS unsigned*)(lds + 65536 + (vb_) * 32768 + (wid * 4 + i_) * 1024), 16, 0, 0); } while (0)
#define FA_DSR128(dst, addr, off) asm volatile("ds_read_b128 %0, %1 offset:%2" : "=v"(dst) : "v"(addr), "n"(off))
#define FA_DSTR(dst, addr, off) asm volatile("ds_read_b64_tr_b16 %0, %1 offset:%2" : "=v"(dst) : "v"(addr), "n"(off))
#define FA_LGKM(n) asm volatile("s_waitcnt lgkmcnt(" #n ")" ::: "memory")
#define FA_SB() __builtin_amdgcn_sched_barrier(0)
#define FA_QK_STEP(i, P0, P1, W) do { FA_LGKM(W); FA_SB(); \
        if (((i) & 1) == 0) P0 = __builtin_amdgcn_mfma_f32_32x32x16_bf16(kr[(i) & 3], qf[(i) >> 1], P0, 0, 0, 0); else P1 = __builtin_amdgcn_mfma_f32_32x32x16_bf16(kr[(i) & 3], qf[(i) >> 1], P1, 0, 0, 0); \
        FA_SB(); if ((i) + 4 < 16) FA_DSR128(kr[(i) & 3], ka_[((i) + 4) >> 1], (((i) + 4) & 1) * 8192); } while (0)
#define FA_QK(P0, P1, kbuf, kbk) do { FA_LAS const float* nck = (FA_LAS const float*)(lds + LDS_CK) + (kbk) * 128 + kh * 64 + 4 * hi; \
        _Pragma("unroll") for (int g_ = 0; g_ < 4; ++g_) { const f32x4 t0 = *(FA_LAS const f32x4*)(nck + 8 * g_), t1 = *(FA_LAS const f32x4*)(nck + 32 + 8 * g_); \
            _Pragma("unroll") for (int j_ = 0; j_ < 4; ++j_) { P0[4 * g_ + j_] = t0[j_]; P1[4 * g_ + j_] = t1[j_]; } } \
        unsigned ka_[8]; _Pragma("unroll") for (int d0 = 0; d0 < 8; ++d0) ka_[d0] = ldsb + (unsigned)((kbuf) * 32768 + kfo[d0]); \
        bf16x8 kr[4]; FA_SB(); FA_DSR128(kr[0], ka_[0], 0); FA_DSR128(kr[1], ka_[0], 8192); FA_DSR128(kr[2], ka_[1], 0); FA_DSR128(kr[3], ka_[1], 8192); \
        FA_QK_STEP(0, P0, P1, 3); FA_QK_STEP(1, P0, P1, 3); FA_QK_STEP(2, P0, P1, 3); FA_QK_STEP(3, P0, P1, 3); FA_QK_STEP(4, P0, P1, 3); FA_QK_STEP(5, P0, P1, 3); FA_QK_STEP(6, P0, P1, 3); FA_QK_STEP(7, P0, P1, 3); \
        FA_QK_STEP(8, P0, P1, 3); FA_QK_STEP(9, P0, P1, 3); FA_QK_STEP(10, P0, P1, 3); FA_QK_STEP(11, P0, P1, 3); FA_QK_STEP(12, P0, P1, 3); FA_QK_STEP(13, P0, P1, 2); FA_QK_STEP(14, P0, P1, 1); FA_QK_STEP(15, P0, P1, 0); } while (0)
#define FA_PV_STEP(i, W) do { FA_LGKM(W); FA_SB(); \
        { const bf16x8 vf_ = (bf16x8){vl[(i) & 1][0], vl[(i) & 1][1], vl[(i) & 1][2], vl[(i) & 1][3], vh[(i) & 1][0], vh[(i) & 1][1], vh[(i) & 1][2], vh[(i) & 1][3]}; \
          o[(i) >> 2] = __builtin_amdgcn_mfma_f32_32x32x16_bf16(vf_, pf[(i) & 3], o[(i) >> 2], 0, 0, 0); } \
        FA_SB(); if ((i) + 2 < 16) { FA_DSTR(vl[(i) & 1], va_[((i) + 2) >> 2], (((i) + 2) & 3) * 4096); FA_DSTR(vh[(i) & 1], va_[((i) + 2) >> 2], (((i) + 2) & 3) * 4096 + 2048); } } while (0)
        const int qbL = 15 - ii, nsteps = 17;
#define FA_KB(s_) ((s_) <= qbL ? (s_) : ii - ((s_) - qbL - 1))
        int u = 0, qb = qbL, kb = 0, g = 0;
        FA_ISSUE_K(0, 0); FA_ISSUE_V(0, 0); FA_ISSUE_K(FA_KB(1) * 128, 1);
        bf16x8 qf[8]; f32x16 o[4]; float m = -1e30f, l = 0.f;
        { const bf16_t* qp = Q + (size_t)(b * SEQ + qb * 128 + rg * 32 + r32) * 1024 + h * 128 + 8 * hi;
#pragma unroll
          for (int d0 = 0; d0 < 8; ++d0) qf[d0] = *(const bf16x8*)(qp + 16 * d0); }
#pragma unroll
        for (int db = 0; db < 4; ++db)
#pragma unroll
            for (int r = 0; r < 16; ++r) o[db][r] = 0.f;
        FA_WAITBAR();
        f32x16 p0, p1, n0, n1;
        FA_QK(p0, p1, 0, 0);
        FA_WAITBAR();
        bool diag = false, lastb = false, done = false;
#define FA_SOFTPV(C0, C1) do { \
            if (diag) { const int qrel = rg * 32 + r32, k0 = kh * 64 + 4 * hi; \
                _Pragma("unroll") for (int r = 0; r < 16; ++r) { const int kr = k0 + (r & 3) + 8 * (r >> 2); if (kr > qrel) C0[r] = -INFINITY; if (kr + 32 > qrel) C1[r] = -INFINITY; } } \
            float mx = fmaxf(C0[0], C1[0]); \
            _Pragma("unroll") for (int r = 1; r < 16; ++r) mx = fmaxf(mx, fmaxf(C0[r], C1[r])); \
            mx = swapmax(mx); \
            const float mn = fmaxf(m, mx), alpha = __builtin_amdgcn_exp2f(m - mn); m = mn; \
            float ps = 0.f; \
            _Pragma("unroll") for (int r = 0; r < 16; ++r) { C0[r] = __builtin_amdgcn_exp2f(C0[r] - mn); C1[r] = __builtin_amdgcn_exp2f(C1[r] - mn); ps += C0[r] + C1[r]; } \
            l = l * alpha + ps; \
            if (!__all(alpha == 1.0f)) { \
                _Pragma("unroll") for (int db = 0; db < 4; ++db) _Pragma("unroll") for (int r = 0; r < 16; ++r) o[db][r] *= alpha; } \
            bf16x8 pf[4]; pf[0] = pack8(C0, 0); pf[1] = pack8(C0, 8); pf[2] = pack8(C1, 0); pf[3] = pack8(C1, 8); \
            { unsigned va_[4]; \
              _Pragma("unroll") for (int db = 0; db < 4; ++db) va_[db] = ldsb + (unsigned)(65536 + (g & 1) * 32768 + vfo[db]); \
              v4i16 vl[2], vh[2]; FA_SB(); FA_DSTR(vl[0], va_[0], 0); FA_DSTR(vh[0], va_[0], 2048); FA_DSTR(vl[1], va_[0], 4096); FA_DSTR(vh[1], va_[0], 4096 + 2048); \
              FA_PV_STEP(0, 2); FA_PV_STEP(1, 2); FA_PV_STEP(2, 2); FA_PV_STEP(3, 2); FA_PV_STEP(4, 2); FA_PV_STEP(5, 2); FA_PV_STEP(6, 2); FA_PV_STEP(7, 2); \
              FA_PV_STEP(8, 2); FA_PV_STEP(9, 2); FA_PV_STEP(10, 2); FA_PV_STEP(11, 2); FA_PV_STEP(12, 2); FA_PV_STEP(13, 2); FA_PV_STEP(14, 2); FA_PV_STEP(15, 0); } } while (0)
#define FA_STEP(C0, C1, N0, N1) do { \
            diag = (kb == qb); lastb = (u == 0 ? kb == qb : kb == 0); \
            if (g + 2 < nsteps) FA_ISSUE_K(FA_KB(g + 2) * 128, g & 1); \
            if (g + 1 < nsteps) FA_ISSUE_V(FA_KB(g + 1) * 128, (g + 1) & 1); \
            const int kbn_ = (u == 0 ? kb + 1 : kb - 1); \
            if (kh == 0 && !lastb) FA_QK(N0, N1, (g + 1) & 1, kbn_); \
            FA_SOFTPV(C0, C1); \
            if (kh == 1 && !lastb) FA_QK(N0, N1, (g + 1) & 1, kbn_); \
            FA_WAITBAR(); } while (0)
#define FA_UNIT_END() do { \
            FA_LAS float* mb = (FA_LAS float*)(lds + 65536 + (g & 1) * 32768) + rg * 2048; FA_LAS float* ml = (FA_LAS float*)(lds + LDS_ML) + rg * 128; \
            const float lt = swapsum(l); \
            if (kh == 1) { ml[lane] = m; ml[64 + lane] = lt; } \
            float s1 = 0.f, s2m = 0.f; \
            _Pragma("unroll") for (int half = 0; half < 2; ++half) { \
                if (kh == 1) { \
                    _Pragma("unroll") for (int d2 = 0; d2 < 2; ++d2) _Pragma("unroll") for (int r = 0; r < 16; ++r) mb[(d2 * 16 + r) * 64 + lane] = o[2 * half + d2][r]; } \
                FA_WAITBAR(); \
                if (kh == 0) { \
                    if (half == 0) { const float m2 = ml[lane], l2 = ml[64 + lane], mm = fmaxf(m, m2), a1 = __builtin_amdgcn_exp2f(m - mm), a2 = __builtin_amdgcn_exp2f(m2 - mm); \
                        const float inv = 1.0f / (lt * a1 + l2 * a2); s1 = a1 * inv; s2m = a2 * inv; } \
                    bf16_t* op = MIXIN + (size_t)(b * SEQ + qb * 128 + rg * 32 + r32) * 2048 + 1024 + h * 128 + 4 * hi; \
                    _Pragma("unroll") for (int d2 = 0; d2 < 2; ++d2) _Pragma("unroll") for (int g4 = 0; g4 < 4; ++g4) { float v[4]; \
                        _Pragma("unroll") for (int j = 0; j < 4; ++j) v[j] = o[2 * half + d2][4 * g4 + j] * s1 + mb[(d2 * 16 + 4 * g4 + j) * 64 + lane] * s2m; \
                        u32x2 w; w.x = cvtpk(v[0], v[1]); w.y = cvtpk(v[2], v[3]); *(u32x2*)(op + 32 * (2 * half + d2) + 8 * g4) = w; } } \
                FA_WAITBAR(); } \
            if (u == 1) { done = true; } else { \
                u = 1; qb = ii; kb = ii; ++g; \
                { const bf16_t* qp = Q + (size_t)(b * SEQ + qb * 128 + rg * 32 + r32) * 1024 + h * 128 + 8 * hi; \
                  _Pragma("unroll") for (int d0 = 0; d0 < 8; ++d0) qf[d0] = *(const bf16x8*)(qp + 16 * d0); } \
                _Pragma("unroll") for (int db = 0; db < 4; ++db) _Pragma("unroll") for (int r = 0; r < 16; ++r) o[db][r] = 0.f; \
                m = -1e30f; l = 0.f; \
                FA_QK(p0, p1, g & 1, kb); \
                FA_WAITBAR(); } } while (0)
        for (;;) {
            FA_STEP(p0, p1, n0, n1);
            if (lastb) { FA_UNIT_END(); if (done) break; continue; }
            kb += (u == 0 ? 1 : -1); ++g; p0 = n0; p1 = n1;
        }
#undef FA_SOFTPV
#undef FA_STEP
#undef FA_UNIT_END
#undef FA_ISSUE_K
#undef FA_ISSUE_V
#undef FA_QK
#undef FA_QK_STEP
#undef FA_PV_STEP
#undef FA_KB
    }
}
}

namespace fs {
#define FS_LAS __attribute__((address_space(3)))
__device__ __forceinline__ void sgu_phase(const Args& A, FS_LAS unsigned char* lds) {
    const bf16_t* U = (const bf16_t*)(A.ws + WS_U); const bf16_t* V = (const bf16_t*)(A.ws + WS_V); bf16_t* MIXIN = (bf16_t*)(A.ws + WS_MIXIN);
    const float* wsp = A.in[7]; const float* bsp = A.in[8]; const float* ln_g = A.in[5]; const float* ln_b = A.in[6]; const float* VSTAT = (const float*)(A.ws + WS_VSTAT);
    const int tid = threadIdx.x, lane = tid & 63, wid = __builtin_amdgcn_readfirstlane(tid >> 6), tb = wid & 3, dh = wid >> 2, r32 = lane & 31, hi = lane >> 5;
    const int frow = tid >> 2, fq4 = tid & 3;
    int vfo[2];
    { const int d16 = (lane >> 4) & 1, q = (lane & 15) >> 2, p = lane & 3;
#pragma unroll
      for (int j = 0; j < 2; ++j) vfo[j] = 32768 + (8 * hi + q) * 256 + (((2 * dh + j) ^ q) * 64) + d16 * 32 + p * 8; }
    const int wfo = (32 * tb + r32) * 256;
    const int NU = (T / CHUNK) * NG * PROBE_REP_SGU, UM = (T / CHUNK) * NG;
    f32x4 wa[4], wb[4], pa, pb, nwa[4], nwb[4], npa, npb; u32x4 vv[4], nvv[4];
#define FS_LOAD(u0_, WA, WB, VV, PA, PB) do { const int u_ = (u0_) % UM, rc_ = u_ / NG, g_ = u_ % NG, row0_ = rc_ * CHUNK; \
        const float* wr_ = wsp + ((size_t)g_ * CHUNK + frow) * CHUNK + fq4 * 32; const bf16_t* vr_ = V + (size_t)(row0_ + frow) * 1024 + g_ * 128 + fq4 * 32; \
        _Pragma("unroll") for (int c = 0; c < 4; ++c) { WA[c] = *(const f32x4*)(wr_ + 8 * c); WB[c] = *(const f32x4*)(wr_ + 8 * c + 4); VV[c] = *(const u32x4*)(vr_ + 8 * c); } \
        PA = *(const f32x4*)(VSTAT + ((size_t)(row0_ + frow) * 16 + 4 * fq4) * 2); PB = *(const f32x4*)(VSTAT + ((size_t)(row0_ + frow) * 16 + 4 * fq4) * 2 + 4); } while (0)
    int u0 = blockIdx.x;
    if (u0 < NU) FS_LOAD(u0, wa, wb, vv, pa, pb);
    for (; u0 < NU; u0 += gridDim.x) { const int u = u0 % UM;
        const int rc = u / NG, g = u % NG, row0 = rc * CHUNK;
        {
#pragma unroll
          for (int c = 0; c < 4; ++c) { const f32x4 a = wa[c], b2 = wb[c]; const int s0 = fq4 * 32 + 8 * c; float v[8] = {a.x, a.y, a.z, a.w, b2.x, b2.y, b2.z, b2.w};
#pragma unroll
              for (int j = 0; j < 8; ++j) if (s0 + j > frow) v[j] = 0.f;
              u32x4 w; w.x = cvtpk_rne(v[0], v[1]); w.y = cvtpk_rne(v[2], v[3]); w.z = cvtpk_rne(v[4], v[5]); w.w = cvtpk_rne(v[6], v[7]);
              *(FS_LAS u32x4*)(lds + frow * 256 + (((4 * fq4 + c) ^ (frow & 15)) * 16)) = w; }
          float mean, rstd;
          { float s1 = (pa[0] + pa[2]) + (pb[0] + pb[2]), s2 = (pa[1] + pa[3]) + (pb[1] + pb[3]);
            s1 += __shfl_xor(s1, 1); s1 += __shfl_xor(s1, 2); s2 += __shfl_xor(s2, 1); s2 += __shfl_xor(s2, 2);
            mean = s1 * (1.f / 1024.f); rstd = rsqrtf(fmaxf(s2 * (1.f / 1024.f) - mean * mean, 0.f) + EPS); }
#pragma unroll
          for (int c = 0; c < 4; ++c) { const u32x4 w = vv[c]; const int cb = g * 128 + fq4 * 32 + 8 * c;
              const f32x4 ga = *(const f32x4*)(ln_g + cb), gb = *(const f32x4*)(ln_g + cb + 4), ba = *(const f32x4*)(ln_b + cb), bb = *(const f32x4*)(ln_b + cb + 4);
              float v[8];
#pragma unroll
              for (int e2 = 0; e2 < 4; ++e2) { v[2 * e2] = __uint_as_float(w[e2] << 16); v[2 * e2 + 1] = __uint_as_float(w[e2] & 0xffff0000u); }
              u32x4 o; o.x = cvtpk_rne((v[0] - mean) * rstd * ga[0] + ba[0], (v[1] - mean) * rstd * ga[1] + ba[1]); o.y = cvtpk_rne((v[2] - mean) * rstd * ga[2] + ba[2], (v[3] - mean) * rstd * ga[3] + ba[3]);
              o.z = cvtpk_rne((v[4] - mean) * rstd * gb[0] + bb[0], (v[5] - mean) * rstd * gb[1] + bb[1]); o.w = cvtpk_rne((v[6] - mean) * rstd * gb[2] + bb[2], (v[7] - mean) * rstd * gb[3] + bb[3]);
              *(FS_LAS u32x4*)(lds + 32768 + frow * 256 + (((4 * fq4 + c) ^ ((frow & 3) << 2)) * 16)) = o; } }
        __syncthreads();
        const bool more = u0 + (int)gridDim.x < NU;
        const int tt = 32 * tb + r32; const float bb = bsp[g * CHUNK + tt]; const size_t rw = (size_t)(row0 + tt);
        u32x2 uu[2][4];
#pragma unroll
        for (int j = 0; j < 2; ++j)
#pragma unroll
            for (int g4 = 0; g4 < 4; ++g4) uu[j][g4] = *(const u32x2*)(U + rw * 1024 + g * 128 + 32 * (2 * dh + j) + 8 * g4 + 4 * hi);
        asm volatile("" ::: "memory");
        if (more) FS_LOAD(u0 + (int)gridDim.x, nwa, nwb, nvv, npa, npb);
        fa::f32x16 acc[2];
#pragma unroll
        for (int j = 0; j < 2; ++j)
#pragma unroll
            for (int r = 0; r < 16; ++r) acc[j][r] = 0.f;
        for (int s = 0; s <= 2 * tb + 1; ++s) {
            const fa::bf16x8 wf = *(FS_LAS const fa::bf16x8*)(lds + wfo + (((2 * s + hi) ^ (r32 & 15)) * 16));
#pragma unroll
            for (int j = 0; j < 2; ++j) {
                const fa::v4i16 lo = __builtin_amdgcn_ds_read_tr16_b64_v4i16((FS_LAS fa::v4i16*)(lds + vfo[j] + s * 4096));
                const fa::v4i16 hh = __builtin_amdgcn_ds_read_tr16_b64_v4i16((FS_LAS fa::v4i16*)(lds + vfo[j] + s * 4096 + 1024));
                const fa::bf16x8 vf = (fa::bf16x8){lo[0], lo[1], lo[2], lo[3], hh[0], hh[1], hh[2], hh[3]};
                acc[j] = __builtin_amdgcn_mfma_f32_32x32x16_bf16(vf, wf, acc[j], 0, 0, 0); }
        }
#pragma unroll
        for (int j = 0; j < 2; ++j)
#pragma unroll
            for (int g4 = 0; g4 < 4; ++g4) { const int d = 32 * (2 * dh + j) + 8 * g4 + 4 * hi; const u32x2 u2 = uu[j][g4];
                const float u0f = __uint_as_float(u2.x << 16), u1 = __uint_as_float(u2.x & 0xffff0000u), u2f = __uint_as_float(u2.y << 16), u3 = __uint_as_float(u2.y & 0xffff0000u);
                u32x2 w; w.x = fa::cvtpk(u0f * (acc[j][4 * g4] + bb), u1 * (acc[j][4 * g4 + 1] + bb)); w.y = fa::cvtpk(u2f * (acc[j][4 * g4 + 2] + bb), u3 * (acc[j][4 * g4 + 3] + bb));
                *(u32x2*)(MIXIN + rw * 2048 + g * 128 + d) = w; }
        __syncthreads();
        if (more) {
#pragma unroll
            for (int c = 0; c < 4; ++c) { wa[c] = nwa[c]; wb[c] = nwb[c]; vv[c] = nvv[c]; }
            pa = npa; pb = npb; }
    }
#undef FS_LOAD
}
}


#define XB_TMO      128
#define XB_XCNT(j)  (256  + 64 * (j))
#define XB_XSUB(j)  (1280 + 64 * (j))
#define XB_XGEN(j)  (2304 + 64 * (j))
#define XB_TOP      3328
#define XB_TOPGEN   3392
#define XCD_BAR_WORDS 3456
#define XB_SPIN_CAP (1u << 18)
#define XLAS __attribute__((address_space(3)))
__device__ __forceinline__ unsigned xb_ld(unsigned* p)              { return __hip_atomic_load(p, __ATOMIC_RELAXED, __HIP_MEMORY_SCOPE_AGENT); }
__device__ __forceinline__ unsigned xb_add(unsigned* p, unsigned v) { return __hip_atomic_fetch_add(p, v, __ATOMIC_RELAXED, __HIP_MEMORY_SCOPE_AGENT); }
__device__ __forceinline__ unsigned xb_xcc_id() { return (unsigned)__builtin_amdgcn_s_getreg((3 << 11) | 20) & 0xFu; }
#define XB_SPIN(cond, bar) do { unsigned _sp = 0; while (cond) { __builtin_amdgcn_s_sleep(1); \
    if ((++_sp & 255u) == 0u) { if (xb_ld(&(bar)[XB_TMO])) break; if (_sp > XB_SPIN_CAP) { atomicAdd(&(bar)[XB_TMO], 1u); break; } } } } while (0)
struct XcdBarrier { unsigned* bar; unsigned x; volatile XLAS unsigned* st; };
__device__ __forceinline__ XcdBarrier xcd_barrier_post(unsigned* bar, volatile XLAS unsigned* st) {
    XcdBarrier b; b.bar = bar; b.x = xb_xcc_id(); b.st = st;
    if (threadIdx.x == 0) (void)xb_add(&bar[XB_XCNT(b.x)], 1u);
    return b;
}
__device__ __forceinline__ void xcd_barrier_complete(unsigned* bar, unsigned x, unsigned& nloc, unsigned& nx) {
    const unsigned G = gridDim.x * gridDim.y * gridDim.z;
    unsigned sum, cnt, mine, sp = 0u;
    for (;;) {
        sum = 0u; cnt = 0u; mine = 0u;
#pragma unroll
        for (unsigned j = 0; j < 16; ++j) { const unsigned c = xb_ld(&bar[XB_XCNT(j)]); sum += c; cnt += (c > 0u) ? 1u : 0u; mine = (j == x) ? c : mine; }
        if (sum == G) break;
        __builtin_amdgcn_s_sleep(1);
        if ((++sp & 255u) == 0u) { if (xb_ld(&bar[XB_TMO])) break; if (sp > XB_SPIN_CAP) { atomicAdd(&bar[XB_TMO], 1u); break; } }
    }
    nloc = mine > 0u ? mine : 1u; nx = cnt > 0u ? cnt : 1u;
}
__device__ __forceinline__ void xcd_barrier(const XcdBarrier& b) {
    asm volatile("s_waitcnt vmcnt(0)" ::: "memory");
    __syncthreads();
    if (threadIdx.x == 0) {
        unsigned* bar = b.bar;
        __builtin_amdgcn_s_waitcnt(0);
        unsigned nloc = b.st[0], nx = b.st[1];
        if (nloc == 0u) { xcd_barrier_complete(bar, b.x, nloc, nx); b.st[0] = nloc; b.st[1] = nx; }
        const unsigned old = xb_add(&bar[XB_XSUB(b.x)], 1u);
        const unsigned gen = old / nloc;
        if (old + 1u == (gen + 1u) * nloc) {
            __builtin_amdgcn_fence(__ATOMIC_RELEASE, "agent");
            asm volatile("s_waitcnt vmcnt(0)" ::: "memory");
            const unsigned og = xb_add(&bar[XB_TOP], 1u);
            const unsigned tg = og / nx;
            if (og + 1u == (tg + 1u) * nx) xb_add(&bar[XB_TOPGEN], 1u);
            else XB_SPIN(xb_ld(&bar[XB_TOPGEN]) == tg, bar);
            __builtin_amdgcn_fence(__ATOMIC_ACQUIRE, "agent");
            xb_add(&bar[XB_XGEN(b.x)], 1u);
            asm volatile("s_waitcnt vmcnt(0)" ::: "memory");
        } else {
            XB_SPIN(xb_ld(&bar[XB_XGEN(b.x)]) == gen, bar);
            __builtin_amdgcn_fence(__ATOMIC_ACQUIRE, "agent");
            asm volatile("s_waitcnt vmcnt(0)" ::: "memory");
        }
    }
    __syncthreads();
}
constexpr int CW_BAR = 4096;
constexpr size_t CTL_ZERO_BYTES = 65536;
constexpr int LDS_BARST_OFF = LDS_BYTES - 16;

constexpr bool FAST_P1 = true, FAST_P3 = true, FAST_P4 = true, FAST_P6 = true, FAST_P7 = true;
constexpr bool FAST_ATTN = true, FAST_SGU = true;
constexpr bool FAST_ANY = FAST_P1 || FAST_P3 || FAST_P4 || FAST_P6 || FAST_P7;
constexpr int N_PHASES = 10;
__global__ void __launch_bounds__(NTHREADS, 2) fwd(Args A) {
    extern __shared__ __attribute__((aligned(16))) unsigned char lds[];
    float* ldsf = (float*)lds;
    const int lo = A.ph_lo, hi = A.ph_hi;
    if (threadIdx.x < 4) ((volatile XLAS unsigned*)((XLAS unsigned char*)lds + LDS_BARST_OFF))[threadIdx.x] = 0u;
    __syncthreads();
    XcdBarrier bar = xcd_barrier_post((unsigned*)(A.ws + WS_CTL) + CW_BAR, (volatile XLAS unsigned*)((XLAS unsigned char*)lds + LDS_BARST_OFF));
#define IN(k) (lo <= (k) && (k) < hi)
#define SEAM(k) do { if (IN(k) && IN((k) + 1)) xcd_barrier(bar); STAMP((k) + 1); } while (0)
    unsigned long long t_lo = 0, t_hi = 0;
#define STAMP(i) do { if (STAMP_PHASE >= 0) { if ((i) == STAMP_PHASE || (STAMP_PHASE == 98 && (i) == 0)) t_lo = __builtin_amdgcn_s_memrealtime(); if ((i) == STAMP_PHASE + 1 || (STAMP_PHASE == 98 && (i) == 9)) t_hi = __builtin_amdgcn_s_memrealtime(); } } while (0)
    STAMP(0);
    PG8_LAS unsigned char* l3 = (PG8_LAS unsigned char*)lds;
    if (IN(0)) { f8_scales(A, ldsf + 36864); p0_router_weights(A); p0_stage_wf(A, ldsf); __syncthreads();
        if (FAST_ANY && HELPERS && gridDim.x % 32 == 0 && FAST_P1) { p0_rows(A, ldsf, 4); p0_weights(A, l3, 0, (int)blockIdx.x, (int)gridDim.x, 4); }
        else { p0_rows(A, ldsf, NWAVES); __syncthreads(); if (FAST_ANY) { p0_weights(A, l3, 0, (int)blockIdx.x, (int)gridDim.x); __syncthreads(); p0_weights(A, l3, 1, (int)blockIdx.x, (int)gridDim.x); } } } SEAM(0);
    if (IN(1)) { if (FAST_P1 && FAST_ATTN) { const int c_ = (int)blockIdx.x, G_ = (int)gridDim.x; const bool hs_ = HELPERS && (G_ % 32 == 0) && G_ / 4 >= NB * NH; const int hr_ = hs_ ? ((((c_ >> 3) & 3) == 3) ? (c_ >> 5) * 8 + (c_ & 7) : -1) : c_ - (G_ - NB * NH); if (hr_ >= 0 && hr_ < NB * NH) cumsum_bh(A, hr_, ldsf); } if (FAST_P1) p1_fast(A, l3); else p1_naive(A, ldsf); } SEAM(1);
    if (!(FAST_P1 && FAST_SGU && FAST_ATTN)) { if (IN(2)) { p1b_fix<0>(A, ldsf); } SEAM(2); }
    if (IN(3)) { if (FAST_SGU) fs::sgu_phase(A, l3); else p2_sgu_naive(A); if (FAST_ATTN) { __syncthreads(); fa::attn_phase(A, l3); } else p2_attn_naive(A, ldsf); } SEAM(3);
    if (IN(4)) { if (FAST_P3) p3_fast(A, l3); else p3_naive(A, ldsf); } SEAM(4);
    if (IN(5)) { if (FAST_P4) p4_fast(A, l3); else p4_naive(A, ldsf); } SEAM(5);
    if (IN(6)) { if (PROBE_ALT == 6) { p5_router3<1>(A, ldsf); __syncthreads(); } if (PROBE_ALT == 62) { p5_router3<2>(A, ldsf); __syncthreads(); } if (PROBE_ALT == 63) { p5_router3<3>(A, ldsf); __syncthreads(); } p5_router3<0>(A, ldsf); } SEAM(6);
    if (IN(7)) { if (FAST_P6) p6_fast(A, l3); else p6_naive(A, ldsf); } SEAM(7);
    if (IN(8)) { if (FAST_P7) p7_fast(A, l3); else p7_naive(A, ldsf); } SEAM(8);
    if (IN(9)) { if (PROBE_ALT == 9) { p8_combine<1>(A, ldsf); __syncthreads(); } p8_combine<0>(A, ldsf, STAMP_PHASE < 0 ? 0.f : (STAMP_PHASE == 99 ? 1.0f : (float)(t_hi - t_lo) * 0.01f * 0.001f * STAMP_SCALE)); }
#undef IN
#undef SEAM
}

#ifndef MK_N_LAUNCHES
#define MK_N_LAUNCHES 1
#endif
extern "C" void kernel_launch(void* const* d_in, const int* in_sizes, int n_in, void* d_out, int out_size, void* d_ws, size_t ws_size, hipStream_t stream) {
    static int grid = 0;
    if (grid == 0) {
        if (n_in != 22 || out_size != T * DM || ws_size < WS_END) { fprintf(stderr, "kernel_launch: unexpected shapes (n_in %d out %d ws %zu)\n", n_in, out_size, ws_size); grid = -1; return; }
        int dev = 0, cus = 0, per_cu = 0;
        hipGetDevice(&dev); hipDeviceGetAttribute(&cus, hipDeviceAttributeMultiprocessorCount, dev);
        hipFuncSetAttribute((const void*)fwd, hipFuncAttributeMaxDynamicSharedMemorySize, LDS_BYTES);
        hipOccupancyMaxActiveBlocksPerMultiprocessor(&per_cu, (const void*)fwd, NTHREADS, LDS_BYTES);
        if (per_cu < 1) { fprintf(stderr, "kernel_launch: occupancy query says %d blocks per CU\n", per_cu); per_cu = 1; }
        (void)hipGetLastError();
        grid = cus;
    }
    if (grid < 0) return;
    Args a{};
    for (int i = 0; i < 22; ++i) a.in[i] = (const float*)d_in[i];
    a.out = (float*)d_out; a.ws = (unsigned char*)d_ws;
    if (hipMemsetAsync((char*)d_ws + WS_CTL, 0, CTL_ZERO_BYTES, stream) != hipSuccess) { fprintf(stderr, "kernel_launch: memset failed\n"); return; }
    if (MK_N_LAUNCHES == 1) {
        a.ph_lo = 0; a.ph_hi = N_PHASES;
        hipLaunchKernelGGL(fwd, dim3(grid), dim3(NTHREADS), LDS_BYTES, stream, a);
    } else {
        for (int p = 0; p < N_PHASES; ++p) { a.ph_lo = p; a.ph_hi = p + 1; hipLaunchKernelGGL(fwd, dim3(grid), dim3(NTHREADS), LDS_BYTES, stream, a); }
    }
}
```
